# Optimizing an MI355X kernel written in HIP

```python
import math
import jax, jax.numpy as jnp
from jax import lax
import numpy as np

D_MODEL = 2048
BATCH = 8
SEQ = 2048
DEPTH = 2

HEAD_DIM = 64
D_MIX = D_MODEL
N_MIXERS = 4
GROUP_WIDTH = D_MIX // N_MIXERS
N_HEADS_GROUP = GROUP_WIDTH // HEAD_DIM

DILATED_PATTERNS = ((128, 1), (512, 4), (2048, 16))
DIL_BLOCK = 128

SGU_CHUNK = 128
SGU_LN_EPS = 1e-5

MOBA_BLOCK = 256
MOBA_TOPK = 3
MOBA_Q_CHUNK = 16

RWKV_W_LORA = 96
RWKV_A_LORA = 96
RWKV_G_LORA = 256
RWKV_LN_EPS = 64e-5
RWKV_WIDTH = 3 * GROUP_WIDTH + RWKV_W_LORA + RWKV_A_LORA + RWKV_G_LORA
RWKV_SPLITS = (GROUP_WIDTH, GROUP_WIDTH + RWKV_W_LORA, 2 * GROUP_WIDTH + RWKV_W_LORA,
               3 * GROUP_WIDTH + RWKV_W_LORA, 3 * GROUP_WIDTH + RWKV_W_LORA + RWKV_A_LORA)

NUM_BUCKETS = 32
MAX_DISTANCE = 2048

D_FF = -(-8 * D_MODEL // (3 * 256)) * 256

QKV_WIDTH = 3 * GROUP_WIDTH
SGU_WIDTH = 2 * GROUP_WIDTH
IN_SPLITS = (QKV_WIDTH, QKV_WIDTH + SGU_WIDTH, 2 * QKV_WIDTH + SGU_WIDTH)
D_IN_PROJ = 2 * QKV_WIDTH + SGU_WIDTH + RWKV_WIDTH

NORM_EPS = 1e-6
NEG_INF = -1e30

kernel_name = 'hymba_style_dilated_sgu_moba_rwkv7_hybrid'


def rmsnorm(x, g):
    xf = x.astype(jnp.float32)
    y = xf * lax.rsqrt(jnp.mean(xf * xf, axis=-1, keepdims=True) + NORM_EPS)
    return (y * g.astype(jnp.float32)).astype(x.dtype)


def t5_bucket(dist):
    dist = jnp.maximum(dist, 0)
    max_exact = NUM_BUCKETS // 2
    d = jnp.maximum(dist, 1).astype(jnp.float32)
    large = max_exact + (jnp.log(d / max_exact) / math.log(MAX_DISTANCE / max_exact)
                         * (NUM_BUCKETS - max_exact)).astype(jnp.int32)
    large = jnp.minimum(large, NUM_BUCKETS - 1)
    return jnp.where(dist < max_exact, dist, large)


def split_qkv_heads(p):
    B, S, _ = p.shape
    t = p.reshape(B, S, 3, N_HEADS_GROUP, HEAD_DIM).transpose(2, 0, 3, 1, 4)
    return t[0], t[1], t[2]


def merge_heads(y):
    B, H, S, Dh = y.shape
    return y.transpose(0, 2, 1, 3).reshape(B, S, H * Dh)


def dilated_window_attention(q, k, v, bias_hb, window, dilation):
    B, H, S, Dh = q.shape
    steps = window // dilation
    C = DIL_BLOCK
    L = S // dilation
    nb = -(-L // C)
    Lp = nb * C

    def to_sub(t):
        return t.reshape(B, H, L, dilation, Dh).transpose(0, 1, 3, 2, 4)

    qb = jnp.pad(to_sub(q), ((0, 0), (0, 0), (0, 0), (0, Lp - L), (0, 0))).reshape(B, H, dilation, nb, C, Dh)

    def band(t):
        tp = jnp.pad(to_sub(t), ((0, 0), (0, 0), (0, 0), (C, Lp - L), (0, 0))).reshape(B, H, dilation, nb + 1, C, Dh)
        return jnp.concatenate([tp[:, :, :, :-1], tp[:, :, :, 1:]], axis=4)

    kb, vb = band(k), band(v)
    logits = jnp.einsum('bhrnqd,bhrnkd->bhrnqk', qb, kb).astype(jnp.float32) * (Dh ** -0.5)
    qa = jnp.arange(C)[:, None]
    kbi = jnp.arange(2 * C)[None, :]
    delta = qa + C - kbi
    blk = jnp.arange(nb)[:, None, None]
    valid = (delta >= 0) & (delta <= steps) & ((blk > 0) | (kbi >= C))
    bias = bias_hb[:, t5_bucket(delta * dilation)].astype(jnp.float32)
    logits = logits + bias[None, :, None, None]
    logits = jnp.where(valid[None, None, None], logits, NEG_INF)
    m = jnp.max(logits, axis=-1, keepdims=True)
    p = jnp.exp(logits - m)
    den = jnp.sum(p, axis=-1, keepdims=True)
    out = jnp.einsum('bhrnqk,bhrnkd->bhrnqd', (p / den).astype(v.dtype), vb)
    lse = (m + jnp.log(den))[..., 0]

    def from_sub(t):
        t = t[:, :, :, :L]
        return jnp.moveaxis(t, 2, 3).reshape((B, H, S) + t.shape[4:])

    return from_sub(out.reshape(B, H, dilation, Lp, Dh)), from_sub(lse.reshape(B, H, dilation, Lp))


def mixer_dilated(q, k, v, bias_hb):
    results = [dilated_window_attention(q, k, v, bias_hb, w, d) for (w, d) in DILATED_PATTERNS]
    outs = jnp.stack([r[0] for r in results], axis=0)
    lses = jnp.stack([r[1] for r in results], axis=0)
    wts = jax.nn.softmax(lses, axis=0)
    return jnp.einsum('pbhs,pbhsd->bhsd', wts.astype(outs.dtype), outs)


def mixer_sgu(z, ln_g, w_s, b_s):
    B, S, _ = z.shape
    z = jax.nn.gelu(z)
    u, vv = jnp.split(z, 2, axis=-1)
    vf = vv.astype(jnp.float32)
    mu = jnp.mean(vf, axis=-1, keepdims=True)
    var = jnp.mean(jnp.square(vf - mu), axis=-1, keepdims=True)
    vv = ((vf - mu) * lax.rsqrt(var + SGU_LN_EPS) * ln_g.astype(jnp.float32)).astype(z.dtype)
    nc = S // SGU_CHUNK
    vv = vv.reshape(B, nc, SGU_CHUNK, N_HEADS_GROUP, HEAD_DIM)
    w = jnp.tril(w_s)
    mixed = jnp.einsum('gts,bnsgc->bntgc', w, vv) + b_s.T[None, None, :, :, None]
    return u * mixed.reshape(B, S, GROUP_WIDTH)


def mixer_moba(q, k, v, bias_hb):
    B, H, S, Dh = q.shape
    BS = MOBA_BLOCK
    nblk = -(-S // BS)
    Sp = nblk * BS
    pad = ((0, 0), (0, 0), (0, Sp - S), (0, 0))
    qp, kp, vp = jnp.pad(q, pad), jnp.pad(k, pad), jnp.pad(v, pad)
    kb = kp.reshape(B, H, nblk, BS, Dh)
    vb = vp.reshape(B, H, nblk, BS, Dh)
    kbar = jnp.mean(kb.astype(jnp.float32), axis=3)
    topk = min(MOBA_TOPK, nblk)
    QC = MOBA_Q_CHUNK
    n_chunks = Sp // QC
    scale = Dh ** -0.5
    gather_blocks = jax.vmap(jax.vmap(lambda blocks, ids: blocks[ids]))
    head_bias = jax.vmap(lambda tbl, bk: tbl[bk], in_axes=(0, 1), out_axes=1)
    key_off = jnp.arange(BS)

    def chunk(c):
        s0 = c * QC
        ob = s0 // BS
        qc = lax.dynamic_slice_in_dim(qp, s0, QC, axis=2)
        qpos = s0 + jnp.arange(QC)
        gate = jnp.einsum('bhqd,bhnd->bhqn', qc.astype(jnp.float32), kbar)
        gate = jnp.where(jnp.arange(nblk) < ob, gate, NEG_INF)
        _, idx = lax.top_k(gate, topk)
        sel_valid = idx < ob
        ksel = gather_blocks(kb, idx)
        vsel = gather_blocks(vb, idx)
        kpos_sel = idx[..., None] * BS + key_off
        dist_sel = qpos[None, None, :, None, None] - kpos_sel
        l_sel = jnp.einsum('bhqd,bhqjkd->bhqjk', qc, ksel).astype(jnp.float32) * scale
        l_sel = l_sel + head_bias(bias_hb, t5_bucket(dist_sel)).astype(jnp.float32)
        l_sel = jnp.where(sel_valid[..., None], l_sel, NEG_INF)
        kown = lax.dynamic_index_in_dim(kb, ob, axis=2, keepdims=False)
        vown = lax.dynamic_index_in_dim(vb, ob, axis=2, keepdims=False)
        dist_own = qpos[:, None] - (ob * BS + key_off)[None, :]
        l_own = jnp.einsum('bhqd,bhkd->bhqk', qc, kown).astype(jnp.float32) * scale
        l_own = l_own + bias_hb[:, t5_bucket(dist_own)].astype(jnp.float32)[None]
        l_own = jnp.where((dist_own >= 0)[None, None], l_own, NEG_INF)
        logits = jnp.concatenate([l_sel.reshape(B, H, QC, topk * BS), l_own], axis=-1)
        p = jax.nn.softmax(logits, axis=-1).astype(v.dtype)
        p_sel = p[..., :topk * BS].reshape(B, H, QC, topk, BS)
        p_own = p[..., topk * BS:]
        return (jnp.einsum('bhqjk,bhqjkd->bhqd', p_sel, vsel)
                + jnp.einsum('bhqk,bhkd->bhqd', p_own, vown))

    outs = lax.map(chunk, jnp.arange(n_chunks))
    return outs.transpose(1, 2, 0, 3, 4).reshape(B, H, Sp, Dh)[:, :, :S]


def token_shift(y, mu):
    y_prev = jnp.pad(y, ((0, 0), (1, 0), (0, 0)))[:, :-1]
    return y + (y_prev - y) * mu


def rwkv7_scan(r, w, k, v, a, b):
    def step(state, inp):
        r_t, w_t, k_t, v_t, a_t, b_t = inp
        sa = jnp.einsum('bhvk,bhk->bhv', state, a_t)
        state = (state * w_t[:, :, None, :] + sa[..., None] * b_t[:, :, None, :]
                 + v_t[..., None] * k_t[:, :, None, :])
        return state, jnp.einsum('bhvk,bhk->bhv', state, r_t)

    B, S, H, N = r.shape
    xs = tuple(jnp.moveaxis(t, 1, 0) for t in (r, w, k, v, a, b))
    _, ys = lax.scan(step, jnp.zeros((B, H, N, N), jnp.float32), xs)
    return jnp.moveaxis(ys, 0, 1)


def mixer_rwkv7(p, mu, w0, w2, a0, a2, g2, k_k, k_a, r_k, lnx_g, lnx_b):
    B, S, _ = p.shape
    H, N = N_HEADS_GROUP, HEAD_DIM
    p = token_shift(p, mu)
    r, wd, k, v, ad, gd = jnp.split(p, RWKV_SPLITS, axis=-1)
    w_log = -jax.nn.softplus(-(w0 + jnp.tanh(wd) @ w2).astype(jnp.float32)) - 0.5
    decay = jnp.exp(-jnp.exp(w_log))
    a = jax.nn.sigmoid(a0 + ad @ a2)
    g = jax.nn.sigmoid(gd) @ g2
    heads = lambda t: t.reshape(B, S, H, N).astype(jnp.float32)
    kk = heads(k * k_k)
    kk = kk / jnp.maximum(jnp.sqrt(jnp.sum(kk * kk, axis=-1, keepdims=True)), 1e-12)
    k = k * (1 + (a - 1) * k_a)
    rh, kh, vh, ah = heads(r), heads(k), heads(v), heads(a)
    y = rwkv7_scan(rh, heads(decay), kh, vh, -kk, kk * ah)
    ym = jnp.mean(y, axis=-1, keepdims=True)
    yv = jnp.mean(jnp.square(y - ym), axis=-1, keepdims=True)
    y = ((y - ym) * lax.rsqrt(yv + RWKV_LN_EPS)).reshape(B, S, GROUP_WIDTH)
    y = y * lnx_g.astype(jnp.float32) + lnx_b.astype(jnp.float32)
    bonus = jnp.sum(rh * kh * r_k.astype(jnp.float32), axis=-1, keepdims=True) * vh
    y = y + bonus.reshape(B, S, GROUP_WIDTH)
    return (y * g.astype(jnp.float32)).astype(p.dtype)


def swiglu(h, w_gate, w_up, w_down):
    return (jax.nn.silu(h @ w_gate) * (h @ w_up)) @ w_down


def setup_inputs(seed: int = 0) -> dict:
    key = jax.random.key(seed)
    ks = iter(jax.random.split(key, 32))
    nrm = lambda shape, scale: jax.random.normal(next(ks), shape, jnp.float32) * scale
    uni = lambda shape, lo, hi: jax.random.uniform(next(ks), shape, jnp.float32, lo, hi)
    H, N, GW, T = N_HEADS_GROUP, HEAD_DIM, GROUP_WIDTH, SGU_CHUNK
    return {
        'x': nrm((BATCH, SEQ, D_MODEL), 1.0),
        'norm_mix_g': 1.0 + nrm((DEPTH, D_MODEL), 0.02),
        'w_in': nrm((DEPTH, D_MODEL, D_IN_PROJ), D_MODEL ** -0.5),
        'pos_bias': nrm((NUM_BUCKETS, 2 * H), 0.3),
        'sgu_ln_g': 1.0 + nrm((DEPTH, GW), 0.02),
        'sgu_w': nrm((DEPTH, H, T, T), T ** -0.5),
        'sgu_b': 1.0 + nrm((DEPTH, H, T), 0.1),
        'rwkv_mu': uni((DEPTH, RWKV_WIDTH), 0.0, 1.0),
        'rwkv_w0': uni((DEPTH, GW), -6.0, -1.0),
        'rwkv_w2': nrm((DEPTH, RWKV_W_LORA, GW), 0.1),
        'rwkv_a0': nrm((DEPTH, GW), 0.1),
        'rwkv_a2': nrm((DEPTH, RWKV_A_LORA, GW), 0.1),
        'rwkv_g2': nrm((DEPTH, RWKV_G_LORA, GW), RWKV_G_LORA ** -0.5),
        'rwkv_k_k': 0.85 + nrm((DEPTH, GW), 0.05),
        'rwkv_k_a': 1.0 + nrm((DEPTH, GW), 0.05),
        'rwkv_r_k': nrm((DEPTH, H, N), 0.1),
        'rwkv_lnx_g': 1.0 + nrm((DEPTH, GW), 0.02),
        'rwkv_lnx_b': nrm((DEPTH, GW), 0.02),
        'branch_norm_g': 1.0 + nrm((DEPTH, D_MIX), 0.02),
        'w_out': nrm((DEPTH, D_MIX, D_MODEL), D_MIX ** -0.5),
        'norm_ffn_g': 1.0 + nrm((DEPTH, D_MODEL), 0.02),
        'w_gate': nrm((DEPTH, D_MODEL, D_FF), D_MODEL ** -0.5),
        'w_up': nrm((DEPTH, D_MODEL, D_FF), D_MODEL ** -0.5),
        'w_down': nrm((DEPTH, D_FF, D_MODEL), D_FF ** -0.5),
        'norm_final_g': 1.0 + nrm((D_MODEL,), 0.02),
    }


def reference(x, norm_mix_g, w_in, pos_bias, sgu_ln_g, sgu_w, sgu_b, rwkv_mu, rwkv_w0,
              rwkv_w2, rwkv_a0, rwkv_a2, rwkv_g2, rwkv_k_k, rwkv_k_a, rwkv_r_k, rwkv_lnx_g,
              rwkv_lnx_b, branch_norm_g, w_out, norm_ffn_g, w_gate, w_up, w_down, norm_final_g):
    B, S, _ = x.shape
    bias_a = pos_bias[:, :N_HEADS_GROUP].T
    bias_c = pos_bias[:, N_HEADS_GROUP:].T
    for l in range(DEPTH):
        h = rmsnorm(x, norm_mix_g[l])
        proj = h @ w_in[l]
        pa, pb, pc, pd = jnp.split(proj, IN_SPLITS, axis=-1)
        ya = merge_heads(mixer_dilated(*split_qkv_heads(pa), bias_a))
        yb = mixer_sgu(pb, sgu_ln_g[l], sgu_w[l], sgu_b[l])
        yc = merge_heads(mixer_moba(*split_qkv_heads(pc), bias_c))
        yd = mixer_rwkv7(pd, rwkv_mu[l], rwkv_w0[l], rwkv_w2[l], rwkv_a0[l], rwkv_a2[l],
                         rwkv_g2[l], rwkv_k_k[l], rwkv_k_a[l], rwkv_r_k[l],
                         rwkv_lnx_g[l], rwkv_lnx_b[l])
        ycat = jnp.stack([ya, yb, yc, yd], axis=2)
        ycat = rmsnorm(ycat, branch_norm_g[l].reshape(N_MIXERS, GROUP_WIDTH))
        x = x + ycat.reshape(B, S, D_MIX) @ w_out[l]
        h = rmsnorm(x, norm_ffn_g[l])
        x = x + swiglu(h, w_gate[l], w_up[l], w_down[l])
    return rmsnorm(x, norm_final_g)
```

```cpp
#define N_LAUNCH_MODE 0
#define REPEAT 0
#define PG8_SP2 true
#include <hip/hip_runtime.h>
#include <cstdio>
#include <cstdint>
namespace pg8 {
#define PG8_LAS __attribute__((address_space(3)))
typedef unsigned short bf16_t;
typedef short bf16x8 __attribute__((ext_vector_type(8)));
typedef float f32x4 __attribute__((ext_vector_type(4)));
typedef unsigned u32x4 __attribute__((ext_vector_type(4)));
constexpr int BM = 256, BK = 64, HALF = 128, HTB = HALF * BK * 2  , STAGE_BYTES = 8 * HTB, NXCD = 8, WGM = 8;

__host__ __device__ __forceinline__ int lds_byte(int r, int c) { const int st = (r >> 4) * 2 + (c >> 5), rr = r & 15, cc = c & 31, ob = rr * 64 + cc * 2; return st * 1024 + (ob ^ (((ob >> 9) & 1) << 5)); }
__host__ __device__ __forceinline__ void stage_rc(int b, int& R, int& C) { const int st = b / 1024, sb = b % 1024, swz = sb ^ (((sb >> 9) & 1) << 5); R = (st >> 1) * 16 + swz / 64; C = (st & 1) * 32 + (swz % 64) / 2; }
__host__ __device__ __forceinline__ int perm32(int rho) { const int n = rho >> 4, i = rho & 15; return 8 * (i >> 2) + 4 * n + (i & 3); }

struct Unit { int pm, pn; };
struct Gemm { const bf16_t* A; const bf16_t* Bt; int M, N, K; };

struct StaticOrder {
    int nM, nN, nwg, G, c;
    __host__ __device__ void init(int M, int N, int G_, int c_) { nM = M / BM; nN = N / BM; nwg = nM * nN; G = G_; c = c_; }
    __host__ __device__ bool next(int i, Unit& u) const {
        const long L = (long)i * G + c; if (L >= nwg) return false;
        int wgid = (int)L; { const int q = nwg / NXCD, r = nwg % NXCD, xcd = wgid % NXCD, off = wgid / NXCD; wgid = (xcd < r ? xcd * (q + 1) : r * (q + 1) + (xcd - r) * q) + off; }
        const int nig = WGM * nN, gid = wgid / nig, fm = gid * WGM, gsz = (nM - fm) < WGM ? (nM - fm) : WGM;
        u.pm = fm + ((wgid % nig) % gsz); u.pn = (wgid % nig) / gsz; return true;
    }
    __device__ __forceinline__ void a_ready(const Unit&) const {}
    __device__ __forceinline__ void done(const Unit&) const {}
};

__device__ __forceinline__ unsigned cvt_pk_bf16(float lo, float hi) { unsigned r; asm volatile("v_cvt_pk_bf16_f32 %0, %1, %2" : "=v"(r) : "v"(lo), "v"(hi)); return r; }
typedef float f32x2 __attribute__((ext_vector_type(2)));

typedef unsigned u32x2 __attribute__((ext_vector_type(2)));
typedef unsigned long long fx_t;
__device__ __forceinline__ void fx_add(fx_t* p, float v) { atomicAdd(p, (fx_t)(long long)__float2ll_rn(v * 1073741824.0f)); }
__device__ __forceinline__ float fx_get(const fx_t* p) { return (float)(long long)(*p) * (1.0f / 1073741824.0f); }
__device__ __forceinline__ float epi_gelu(float x) { const float u = 0.7978845608028654f * (x + 0.044715f * x * x * x); const float e2 = __expf(2.0f * u); return 0.5f * x * (2.0f - 2.0f / (e2 + 1.0f)); }
template <int CTRL> __device__ __forceinline__ float epi_dpp_add(float x) { const int y = __builtin_amdgcn_update_dpp(0, __builtin_bit_cast(int, x), CTRL, 0xF, 0xF, false); return x + __builtin_bit_cast(float, y); }
struct EpiProj {
    static constexpr bool PERM = true, AFTER_DRAIN = false;
    bf16_t* O; int ldc; const fx_t* ssq; float* kbar; fx_t* stats;
    __device__ __forceinline__ void operator()(const f32x4 (&acc)[2][2][4][2], const Unit& u, int wr, int wc, int fr, int fq) const {
        const int row0 = u.pm * BM + wr * 64 + fr, col0 = u.pn * BM + wc * 32 + 8 * fq;
        const bool do_k = (u.pn == 12 || u.pn == 13), do_s = (u.pn == 8 || u.pn == 9);
        float cs[2][8];
#pragma unroll
        for (int bj = 0; bj < 2; ++bj)
#pragma unroll
            for (int e = 0; e < 8; ++e) cs[bj][e] = 0.f;
#pragma unroll
        for (int ai = 0; ai < 2; ++ai)
#pragma unroll
            for (int m = 0; m < 4; ++m) { const int row = row0 + ai * HALF + m * 16; const float rs = __builtin_amdgcn_rsqf(fx_get(ssq + row) * (1.0f / 2048.0f) + 1e-6f);
                bf16_t* rowp = O + (size_t)row * ldc + col0; float s1 = 0.f, s2 = 0.f;
#pragma unroll
                for (int bj = 0; bj < 2; ++bj) { const f32x4 v0 = acc[ai][bj][m][0] * rs, v1 = acc[ai][bj][m][1] * rs;
                    u32x4 w; w.x = cvt_pk_bf16(v0[0], v0[1]); w.y = cvt_pk_bf16(v0[2], v0[3]); w.z = cvt_pk_bf16(v1[0], v1[1]); w.w = cvt_pk_bf16(v1[2], v1[3]);
                    *(u32x4*)(rowp + bj * HALF) = w;
                    if (do_k) {
#pragma unroll
                        for (int e = 0; e < 4; ++e) { cs[bj][e] += v0[e]; cs[bj][4 + e] += v1[e]; } }
                    if (do_s) {
#pragma unroll
                        for (int e = 0; e < 4; ++e) { const float g0 = epi_gelu(v0[e]), g1 = epi_gelu(v1[e]); s1 += g0 + g1; s2 += g0 * g0 + g1 * g1; } } }
                if (do_s) { s1 += __shfl_xor(s1, 16); s1 += __shfl_xor(s1, 32); s2 += __shfl_xor(s2, 16); s2 += __shfl_xor(s2, 32);
                    if (fq == 0) { fx_add(stats + 2 * row, s1); fx_add(stats + 2 * row + 1, s2); } } }
        if (do_k) {
            const int bidx = (u.pm >> 3) * 8, n = u.pm & 7;
#pragma unroll
            for (int bj = 0; bj < 2; ++bj)
#pragma unroll
                for (int e = 0; e < 8; ++e) { float s = cs[bj][e]; s = epi_dpp_add<0xB1>(s); s = epi_dpp_add<0x4E>(s); s = epi_dpp_add<0x141>(s); s = epi_dpp_add<0x140>(s);
                    const int ck = col0 + bj * HALF + e - 3072;
                    if (fr == 0) unsafeAtomicAdd(kbar + ((bidx + (ck >> 6)) * 8 + n) * 64 + (ck & 63), s * (1.0f / 256.0f)); } }
    }
};
struct EpiGU {
    static constexpr bool PERM = true, AFTER_DRAIN = false;
    bf16_t* O; int ldc; const fx_t* ssq;
    __device__ __forceinline__ void operator()(const f32x4 (&acc)[2][2][4][2], const Unit& u, int wr, int wc, int fr, int fq) const {
        const int row0 = u.pm * BM + wr * 64 + fr, col0 = u.pn * HALF + wc * 32 + 8 * fq;
#pragma unroll
        for (int ai = 0; ai < 2; ++ai)
#pragma unroll
            for (int m = 0; m < 4; ++m) { const int row = row0 + ai * HALF + m * 16; const float rs = __builtin_amdgcn_rsqf(fx_get(ssq + row) * (1.0f / 2048.0f) + 1e-6f);
                float o[8];
#pragma unroll
                for (int n = 0; n < 2; ++n)
#pragma unroll
                    for (int e = 0; e < 4; ++e) { const float g = acc[ai][0][m][n][e] * rs, up = acc[ai][1][m][n][e] * rs;
                        o[n * 4 + e] = g * __builtin_amdgcn_rcpf(1.0f + __builtin_amdgcn_exp2f(-1.4426950408889634f * g)) * up; }
                u32x4 w; w.x = cvt_pk_bf16(o[0], o[1]); w.y = cvt_pk_bf16(o[2], o[3]); w.z = cvt_pk_bf16(o[4], o[5]); w.w = cvt_pk_bf16(o[6], o[7]);
                *(u32x4*)(O + (size_t)row * ldc + col0) = w; }
    }
};
struct EpiRes {
    static constexpr bool PERM = true, AFTER_DRAIN = false;
    bf16_t* xb; fx_t* ssq; int ldc;
    __device__ __forceinline__ void operator()(const f32x4 (&acc)[2][2][4][2], const Unit& u, int wr, int wc, int fr, int fq) const {
        const int row0 = u.pm * BM + wr * 64 + fr, col0 = u.pn * BM + wc * 32 + 8 * fq;
#pragma unroll
        for (int ai = 0; ai < 2; ++ai)
#pragma unroll
            for (int m = 0; m < 4; ++m) { const int row = row0 + ai * HALF + m * 16; bf16_t* rowp = xb + (size_t)row * ldc + col0; float s = 0.f;
                u32x4 b[2];
#pragma unroll
                for (int bj = 0; bj < 2; ++bj) b[bj] = *(const u32x4*)(rowp + bj * HALF);
#pragma unroll
                for (int bj = 0; bj < 2; ++bj) { float o[8];
#pragma unroll
                    for (int q = 0; q < 4; ++q) { o[2 * q] = __builtin_bit_cast(float, b[bj][q] << 16) + acc[ai][bj][m][q >> 1][2 * (q & 1)]; o[2 * q + 1] = __builtin_bit_cast(float, b[bj][q] & 0xffff0000u) + acc[ai][bj][m][q >> 1][2 * (q & 1) + 1]; }
                    u32x4 w; w.x = cvt_pk_bf16(o[0], o[1]); w.y = cvt_pk_bf16(o[2], o[3]); w.z = cvt_pk_bf16(o[4], o[5]); w.w = cvt_pk_bf16(o[6], o[7]);
                    *(u32x4*)(rowp + bj * HALF) = w;
#pragma unroll
                    for (int q = 0; q < 8; ++q) s += o[q] * o[q]; }
                s += __shfl_xor(s, 16); s += __shfl_xor(s, 32);
                if (fq == 0) fx_add(ssq + row, s); }
    }
};
template <class Epi, class Sched, bool ALIGN_EPI = false, bool SP2 = false>
__device__ __forceinline__ void gemm_phase(PG8_LAS unsigned char* lds, const Gemm g, const Sched& S, const Epi& E) {
    int tid_ = threadIdx.x; asm volatile("" : "+v"(tid_));
    const int tid = tid_, wid = __builtin_amdgcn_readfirstlane(tid >> 6), lane = tid & 63, wr = wid >> 2, wc = wid & 3, fr = lane & 15, fq = lane >> 4;
    const int K = g.K, nt = K / BK;
    unsigned voffA[2], voffB[2];
#pragma unroll
    for (int i = 0; i < 2; ++i) { int R, C; stage_rc(tid * 16 + i * 8192, R, C); const int Rb = Epi::PERM ? ((R & ~31) + perm32(R & 31)) : R;
        voffA[i] = (unsigned)(R * K + C) * 2u; voffB[i] = (unsigned)(Rb * K + C) * 2u; }
    const size_t kstep = (size_t)(BK * 2);
    const size_t hstep = (size_t)HALF * K * 2;
    const size_t tstep = 2 * hstep;
    const unsigned ldsw = (unsigned)wid * 1024u;
    const int aoff = lds_byte(wr * 64 + fr, fq * 8), boff = lds_byte(wc * 32 + fr, fq * 8);
#define PG8_SA(b, h) (((b) * 2 + (h)) * HTB)
#define PG8_SB(b, h) ((4 + (b) * 2 + (h)) * HTB)
#define PG8_STAGE(bufoff, gbase, voff) do { _Pragma("unroll") for (int _i = 0; _i < 2; ++_i) \
        __builtin_amdgcn_global_load_lds((const unsigned*)((const char*)(gbase) + (voff)[_i]), (PG8_LAS unsigned*)(lds + (bufoff) + ldsw + _i * 8192), 16, 0, 0); } while (0)
#define PG8_LDA(dst, b, h) do { _Pragma("unroll") for (int m = 0; m < 4; ++m) _Pragma("unroll") for (int k = 0; k < 2; ++k) dst[m][k] = *(const PG8_LAS bf16x8*)(lds + PG8_SA(b, h) + aoff + m * 2048 + k * 1024); } while (0)
#define PG8_LDB(dst, b, h) do { _Pragma("unroll") for (int n = 0; n < 2; ++n) _Pragma("unroll") for (int k = 0; k < 2; ++k) dst[n][k] = *(const PG8_LAS bf16x8*)(lds + PG8_SB(b, h) + boff + n * 2048 + k * 1024); } while (0)
#define PG8_MMA(ai, bj, At, Bt) do { __builtin_amdgcn_s_setprio(1); _Pragma("unroll") for (int m = 0; m < 4; ++m) _Pragma("unroll") for (int n = 0; n < 2; ++n) _Pragma("unroll") for (int k = 0; k < 2; ++k) \
        acc[ai][bj][m][n] = __builtin_amdgcn_mfma_f32_16x16x32_bf16(Bt[n][k], At[m][k], acc[ai][bj][m][n], 0, 0, 0); __builtin_amdgcn_s_setprio(0); } while (0)
#define PG8_WAIT_V(n) asm volatile("s_waitcnt vmcnt(" #n ")" ::: "memory")
#define PG8_WAIT_L(n) asm volatile("s_waitcnt lgkmcnt(" #n ")" ::: "memory")
#define PG8_BAR __builtin_amdgcn_s_barrier()
#define PG8_SCHED __builtin_amdgcn_sched_barrier(0)
    Unit cur, nxt; int ui = 0;
    if (!S.next(0, cur)) return;
    f32x4 acc[2][2][4][2];
#pragma unroll
    for (int a = 0; a < 2; ++a)
#pragma unroll
        for (int b = 0; b < 2; ++b)
#pragma unroll
            for (int m = 0; m < 4; ++m)
#pragma unroll
                for (int n = 0; n < 2; ++n) acc[a][b][m][n] = (f32x4){0.f, 0.f, 0.f, 0.f};
    bf16x8 At[4][2], B0[2][2], B1[2][2];
    const char* cA = (const char*)g.A + (size_t)cur.pm * tstep; const char* cB = (const char*)g.Bt + (size_t)cur.pn * tstep;
    S.a_ready(cur);
    if constexpr (SP2) {
        PG8_STAGE(PG8_SB(0, 0), cB, voffB); PG8_STAGE(PG8_SB(0, 1), cB + hstep, voffB); PG8_STAGE(PG8_SA(0, 0), cA, voffA); PG8_STAGE(PG8_SA(0, 1), cA + hstep, voffA);
        if (wr == 1) PG8_BAR;
        PG8_WAIT_V(2); PG8_BAR;
        PG8_STAGE(PG8_SB(1, 0), cB + kstep, voffB); PG8_STAGE(PG8_SA(1, 0), cA + kstep, voffA); PG8_STAGE(PG8_SB(1, 1), cB + hstep + kstep, voffB);
        PG8_WAIT_V(6); PG8_BAR;
    } else {
        PG8_STAGE(PG8_SB(0, 0), cB, voffB); PG8_STAGE(PG8_SA(0, 0), cA, voffA); PG8_STAGE(PG8_SB(0, 1), cB + hstep, voffB); PG8_STAGE(PG8_SA(0, 1), cA + hstep, voffA);
        if (wr == 1) PG8_BAR;
        PG8_WAIT_V(4); PG8_BAR;
        PG8_STAGE(PG8_SB(1, 0), cB + kstep, voffB); PG8_STAGE(PG8_SA(1, 0), cA + kstep, voffA); PG8_STAGE(PG8_SB(1, 1), cB + hstep + kstep, voffB);
        PG8_WAIT_V(6); PG8_BAR;
    }
    for (;;) {
        const bool has_next = S.next(ui + 1, nxt);
        const char* nA = has_next ? (const char*)g.A + (size_t)nxt.pm * tstep : cA; const char* nB = has_next ? (const char*)g.Bt + (size_t)nxt.pn * tstep : cB;
        for (int t = 0; t < nt; t += 2) {
            const bool last = (t == nt - 2);
            const char* a1 = cA + (size_t)(t + 1) * kstep;
            const char* a2 = last ? nA : cA + (size_t)(t + 2) * kstep; const char* b2 = last ? nB : cB + (size_t)(t + 2) * kstep;
            const char* a3 = a2 + kstep; const char* b3 = b2 + kstep;
            if (last && has_next) S.a_ready(nxt);
            if constexpr (SP2) {
            PG8_LDB(B0, 0, 0); PG8_LDB(B1, 0, 1); PG8_SCHED; PG8_LDA(At, 0, 0); PG8_STAGE(PG8_SA(1, 1), a1 + hstep, voffA);
            PG8_WAIT_V(8); PG8_WAIT_L(0); PG8_BAR; PG8_MMA(0, 0, At, B0); PG8_MMA(0, 1, At, B1); PG8_BAR; PG8_SCHED;
            PG8_LDA(At, 0, 1); PG8_STAGE(PG8_SB(0, 0), b2, voffB); PG8_STAGE(PG8_SB(0, 1), b2 + hstep, voffB); PG8_STAGE(PG8_SA(0, 0), a2, voffA);
            PG8_WAIT_V(8); PG8_WAIT_L(0); PG8_BAR; PG8_MMA(1, 0, At, B0); PG8_MMA(1, 1, At, B1); PG8_BAR; PG8_SCHED;
            PG8_LDB(B0, 1, 0); PG8_LDB(B1, 1, 1); PG8_SCHED; PG8_LDA(At, 1, 0); PG8_STAGE(PG8_SA(0, 1), a2 + hstep, voffA);
            PG8_WAIT_V(8); PG8_WAIT_L(0); PG8_BAR; PG8_MMA(0, 0, At, B0); PG8_MMA(0, 1, At, B1); PG8_BAR; PG8_SCHED;
            PG8_LDA(At, 1, 1); PG8_STAGE(PG8_SB(1, 0), b3, voffB); PG8_STAGE(PG8_SB(1, 1), b3 + hstep, voffB); PG8_STAGE(PG8_SA(1, 0), a3, voffA);
            PG8_WAIT_V(8); PG8_WAIT_L(0); PG8_BAR; PG8_MMA(1, 0, At, B0); PG8_MMA(1, 1, At, B1); PG8_BAR; PG8_SCHED;
            } else {
            PG8_LDB(B0, 0, 0); PG8_SCHED; PG8_LDA(At, 0, 0); PG8_STAGE(PG8_SA(1, 1), a1 + hstep, voffA);
            PG8_WAIT_L(8); PG8_BAR; PG8_WAIT_L(0); PG8_MMA(0, 0, At, B0); PG8_BAR; PG8_SCHED;
            PG8_LDB(B1, 0, 1); PG8_STAGE(PG8_SB(0, 0), b2, voffB);
            PG8_BAR; PG8_WAIT_L(0); PG8_MMA(0, 1, At, B1); PG8_BAR;
            PG8_LDA(At, 0, 1); PG8_STAGE(PG8_SA(0, 0), a2, voffA);
            PG8_BAR; PG8_WAIT_L(0); PG8_MMA(1, 0, At, B0); PG8_BAR; PG8_SCHED;
            PG8_STAGE(PG8_SB(0, 1), b2 + hstep, voffB);
            PG8_WAIT_V(6); PG8_BAR; PG8_MMA(1, 1, At, B1); PG8_BAR;
            PG8_LDB(B0, 1, 0); PG8_SCHED; PG8_LDA(At, 1, 0); PG8_STAGE(PG8_SA(0, 1), a2 + hstep, voffA);
            PG8_WAIT_L(8); PG8_BAR; PG8_WAIT_L(0); PG8_MMA(0, 0, At, B0); PG8_BAR; PG8_SCHED;
            PG8_LDB(B1, 1, 1); PG8_STAGE(PG8_SB(1, 0), b3, voffB);
            PG8_BAR; PG8_WAIT_L(0); PG8_MMA(0, 1, At, B1); PG8_BAR;
            PG8_LDA(At, 1, 1); PG8_STAGE(PG8_SA(1, 0), a3, voffA);
            PG8_BAR; PG8_WAIT_L(0); PG8_MMA(1, 0, At, B0); PG8_BAR; PG8_SCHED;
            PG8_STAGE(PG8_SB(1, 1), b3 + hstep, voffB);
            PG8_WAIT_V(6); PG8_BAR; PG8_MMA(1, 1, At, B1); PG8_BAR;
            }
        }
        if constexpr (ALIGN_EPI) { if (wr == 0) PG8_BAR; }
        if constexpr (!Epi::AFTER_DRAIN) { E(acc, cur, wr, wc, fr, fq); S.done(cur); }
        if (!has_next) break;
#pragma unroll
        for (int a = 0; a < 2; ++a)
#pragma unroll
            for (int b = 0; b < 2; ++b)
#pragma unroll
                for (int m = 0; m < 4; ++m)
#pragma unroll
                    for (int n = 0; n < 2; ++n) acc[a][b][m][n] = (f32x4){0.f, 0.f, 0.f, 0.f};
        cur = nxt; cA = nA; cB = nB; ++ui;
        if constexpr (ALIGN_EPI) { if (wr == 1) PG8_BAR; }
    }
    PG8_WAIT_V(0);
    if constexpr (!ALIGN_EPI) { if (wr == 0) PG8_BAR; }
    PG8_BAR;
    if constexpr (Epi::AFTER_DRAIN) { E.fused(acc, cur, wr, wc, fr, fq, lds, wid, lane); S.done(cur); }
#undef PG8_SA
#undef PG8_SB
#undef PG8_STAGE
#undef PG8_LDA
#undef PG8_LDB
#undef PG8_MMA
#undef PG8_WAIT_V
#undef PG8_WAIT_L
#undef PG8_BAR
#undef PG8_SCHED
}
}

constexpr int NWAVES = 8, NTHR = NWAVES * 64;
constexpr int BATCH = 8, SEQ = 2048, DM = 2048, DEPTH = 2, HD = 64, GW = 512, NH = 8;
constexpr int M = BATCH * SEQ;
constexpr int NPROJ = 6080, NPROJ_P = 6144, DFF = 5632;
constexpr int CA_Q = 0, CA_K = 512, CA_V = 1024, CB_U = 1536, CB_V = 2048, CC_Q = 2560, CC_K = 3072, CC_V = 3584, CD = 4096;
constexpr int D_R = 0, D_WD = 512, D_K = 608, D_V = 1120, D_AD = 1632, D_GD = 1728, D_W = 1984;
constexpr float NORM_EPS = 1e-6f;
#ifndef N_LAUNCH_MODE
#define N_LAUNCH_MODE 0
#endif
#ifndef PG8_SP2
#define PG8_SP2 true
#endif
#ifndef REPEAT
#define REPEAT 0
#endif
constexpr int N_PHASES = 16;

constexpr size_t MiB = 1u << 20;
constexpr size_t WS_CTL = 0, CTL_ZERO_BYTES = 2 * MiB;
constexpr size_t WS_WIN = 2 * MiB, WS_WOUT = 26 * MiB, WS_WGU = 34 * MiB, WS_WDN = 78 * MiB, WS_SMALL = 100 * MiB;
constexpr size_t WS_XB = 104 * MiB, WS_PROJ = 168 * MiB, WS_YCAT = 360 * MiB, WS_SC2 = 424 * MiB, WS_YD = 456 * MiB, WS_G = 488 * MiB, WS_BC = 504 * MiB, WS_END = 506 * MiB;
constexpr size_t SC_ARR = (size_t)M * GW * 2;
constexpr size_t SM_TB = 0;
constexpr size_t SM_KBAR = 64 * 1024;
constexpr size_t SM_STATS = 256 * 1024;
constexpr size_t SM_WT = 1024 * 1024;
constexpr int CW_BAR = 4096;
constexpr int CW_Q = 8192;
constexpr int CW_SSQ = 65536;
constexpr size_t CTL_KBAR = 1024 * 1024;
constexpr size_t CTL_STATS = 1280 * 1024;
static_assert((size_t)CW_SSQ * 4 + 5 * (size_t)M * 8 <= CTL_KBAR && CTL_STATS + 2 * (size_t)M * 2 * 8 <= CTL_ZERO_BYTES, "CTL");

constexpr int RING_OFF = 0, RING_BYTES = 131072;
constexpr int LDS_BYTES = 163840, MISC_OFF = LDS_BYTES - 256;

#define GAS __attribute__((address_space(1)))
#define LAS __attribute__((address_space(3)))
typedef unsigned short bf16;
typedef unsigned v4u __attribute__((ext_vector_type(4)));
typedef unsigned v2u __attribute__((ext_vector_type(2)));
typedef float f32x4 __attribute__((ext_vector_type(4)));
typedef short bf16x8 __attribute__((ext_vector_type(8)));
typedef float f32x16 __attribute__((ext_vector_type(16)));
typedef GAS unsigned gu32;
#define RLX_AGENT __ATOMIC_RELAXED, __HIP_MEMORY_SCOPE_AGENT
#define LDS_WAIT() asm volatile("s_waitcnt lgkmcnt(0)" ::: "memory")
#define VM_WAIT() asm volatile("s_waitcnt vmcnt(0)" ::: "memory")
__device__ __forceinline__ unsigned f2bf(float f) { unsigned u = __builtin_bit_cast(unsigned, f); return (u + 0x7fffu + ((u >> 16) & 1u)) >> 16; }
__device__ __forceinline__ unsigned pk2(float lo, float hi) { return f2bf(lo) | (f2bf(hi) << 16); }
__device__ __forceinline__ float bf2f(unsigned short h) { return __builtin_bit_cast(float, (unsigned)h << 16); }
__device__ __forceinline__ float bflo(unsigned w) { return __builtin_bit_cast(float, w << 16); }
__device__ __forceinline__ float bfhi(unsigned w) { return __builtin_bit_cast(float, w & 0xffff0000u); }
__device__ __forceinline__ float sigmoidf_(float x) { return 1.0f / (1.0f + __expf(-x)); }
__device__ __forceinline__ float gelu_tanh(float x) { const float u = 0.7978845608028654f * (x + 0.044715f * x * x * x); const float e = __expf(2.0f * u); const float th = 1.0f - 2.0f / (e + 1.0f); return 0.5f * x * (1.0f + th); }
__device__ __forceinline__ float wave_sum(float v) {
#pragma unroll
    for (int o = 1; o < 64; o <<= 1) v += __shfl_xor(v, o);
    return v;
}
#define XB_TMO      128
#define XB_XCNT(j)  (256  + 64 * (j))
#define XB_XSUB(j)  (1280 + 64 * (j))
#define XB_XGEN(j)  (2304 + 64 * (j))
#define XB_TOP      3328
#define XB_TOPGEN   3392
#define XCD_BAR_WORDS 3456
#define XB_SPIN_CAP (1u << 18)

__device__ __forceinline__ unsigned xb_ld(unsigned* p)              { return __hip_atomic_load(p, __ATOMIC_RELAXED, __HIP_MEMORY_SCOPE_AGENT); }
__device__ __forceinline__ unsigned xb_add(unsigned* p, unsigned v) { return __hip_atomic_fetch_add(p, v, __ATOMIC_RELAXED, __HIP_MEMORY_SCOPE_AGENT); }
__device__ __forceinline__ unsigned xb_xcc_id() { return (unsigned)__builtin_amdgcn_s_getreg((3 << 11) | 20) & 0xFu; }
#define XB_SPIN(cond, bar) do { unsigned _sp = 0; while (cond) { __builtin_amdgcn_s_sleep(1); \
    if ((++_sp & 255u) == 0u) { if (xb_ld(&(bar)[XB_TMO])) break; if (_sp > XB_SPIN_CAP) { atomicAdd(&(bar)[XB_TMO], 1u); break; } } } } while (0)

struct XcdBarrier {
    unsigned* bar; unsigned x;
    volatile LAS unsigned* st;
};

__device__ __forceinline__ XcdBarrier xcd_barrier_post(unsigned* bar, volatile LAS unsigned* st) {
    XcdBarrier b; b.bar = bar; b.x = xb_xcc_id(); b.st = st;
    if (threadIdx.x == 0) (void)xb_add(&bar[XB_XCNT(b.x)], 1u);
    return b;
}
__device__ __forceinline__ void xcd_barrier_complete(unsigned* bar, unsigned x, unsigned& nloc, unsigned& nx) {
    const unsigned G = gridDim.x * gridDim.y * gridDim.z;
    unsigned sum, cnt, mine, sp = 0u;
    for (;;) {
        sum = 0u; cnt = 0u; mine = 0u;
#pragma unroll
        for (unsigned j = 0; j < 16; ++j) { const unsigned c = xb_ld(&bar[XB_XCNT(j)]); sum += c; cnt += (c > 0u) ? 1u : 0u; mine = (j == x) ? c : mine; }
        if (sum == G) break;
        __builtin_amdgcn_s_sleep(1);
        if ((++sp & 255u) == 0u) { if (xb_ld(&bar[XB_TMO])) break; if (sp > XB_SPIN_CAP) { atomicAdd(&bar[XB_TMO], 1u); break; } }
    }
    nloc = mine > 0u ? mine : 1u; nx = cnt > 0u ? cnt : 1u;
}

__device__ __forceinline__ void xcd_barrier(const XcdBarrier& b) {
    asm volatile("s_waitcnt vmcnt(0)" ::: "memory");
    __syncthreads();
    if (threadIdx.x == 0) {
        unsigned* bar = b.bar;
        __builtin_amdgcn_s_waitcnt(0);
        unsigned nloc = b.st[0], nx = b.st[1];
        if (nloc == 0u) { xcd_barrier_complete(bar, b.x, nloc, nx); b.st[0] = nloc; b.st[1] = nx; }
        const unsigned old = xb_add(&bar[XB_XSUB(b.x)], 1u);
        const unsigned gen = old / nloc;
        if (old + 1u == (gen + 1u) * nloc) {
            __builtin_amdgcn_fence(__ATOMIC_RELEASE, "agent");
            asm volatile("s_waitcnt vmcnt(0)" ::: "memory");
            const unsigned og = xb_add(&bar[XB_TOP], 1u);
            const unsigned tg = og / nx;
            if (og + 1u == (tg + 1u) * nx) xb_add(&bar[XB_TOPGEN], 1u);
            else XB_SPIN(xb_ld(&bar[XB_TOPGEN]) == tg, bar);
            __builtin_amdgcn_fence(__ATOMIC_ACQUIRE, "agent");
            xb_add(&bar[XB_XGEN(b.x)], 1u);
            asm volatile("s_waitcnt vmcnt(0)" ::: "memory");
        } else {
            XB_SPIN(xb_ld(&bar[XB_XGEN(b.x)]) == gen, bar);
            __builtin_amdgcn_fence(__ATOMIC_ACQUIRE, "agent");
            asm volatile("s_waitcnt vmcnt(0)" ::: "memory");
        }
    }
    __syncthreads();
}

struct Args { const float* in[25]; float* out; unsigned char* ws; int ph_lo, ph_hi; };
struct Frame {
    LAS unsigned char* lds; int tid, lane, wave, G, vcu, gw, ngw;
};
typedef const __attribute__((address_space(4))) unsigned long long* karg_t;
__device__ __forceinline__ karg_t kargs() { karg_t ka = (karg_t)__builtin_amdgcn_kernarg_segment_ptr(); asm volatile("" : "+s"(ka)); return ka; }
__device__ __forceinline__ const float* inp(int i) { return (const float*)(const GAS float*)kargs()[i]; }
__device__ __forceinline__ float* outp() { return (float*)(GAS float*)kargs()[25]; }
__device__ __forceinline__ unsigned char* wsp() { return (unsigned char*)(GAS unsigned char*)kargs()[26]; }
__device__ __forceinline__ gu32* ctlp() { return (gu32*)(wsp() + WS_CTL); }

__device__ __forceinline__ void conv_item(const float* W, int K, int N, const float* g, bf16* WT, int kind, LAS float* scr, int item, int lane) {
    const int nblk = N / 32, kb = item / nblk, nb = item % nblk, k0 = 64 * kb, n0 = 32 * nb;
    float ld[32];
    { const float* wp = W + (size_t)(k0 + (lane >> 5)) * N + n0 + (lane & 31);
#pragma unroll
      for (int i = 0; i < 32; ++i) ld[i] = wp[(size_t)(2 * i) * N]; }
    if (g) { const float* gp = g + k0 + (lane >> 5);
#pragma unroll
      for (int i = 0; i < 32; ++i) ld[i] *= gp[2 * i]; }
#pragma unroll
    for (int i = 0; i < 32; ++i) scr[(2 * i + (lane >> 5)) * 33 + (lane & 31)] = ld[i];
    LDS_WAIT(); asm volatile("" ::: "memory");
    const int c = lane & 7;
#pragma unroll
    for (int j = 0; j < 4; ++j) { const int n = (lane >> 3) + 8 * j; const LAS float* s = scr + (8 * c) * 33 + n;
        v4u o; o.x = pk2(s[0 * 33], s[1 * 33]); o.y = pk2(s[2 * 33], s[3 * 33]); o.z = pk2(s[4 * 33], s[5 * 33]); o.w = pk2(s[6 * 33], s[7 * 33]);
        const int nn = n0 + n; const int row = kind == 0 ? nn : ((nn >> 7) * 256 + (kind - 1) * 128 + (nn & 127));
        *(GAS v4u*)(WT + (size_t)row * K + k0 + 8 * c) = o; }
    LDS_WAIT(); asm volatile("" ::: "memory");
}
__device__ __forceinline__ void conv_layer_items(Frame& F, int l, int gw, int ngw, bool do_in, bool do_rest) {
    LAS float* scr = (LAS float*)(F.lds + RING_OFF + F.wave * 16384);
    constexpr int I_IN = (DM / 64) * (NPROJ / 32), I_OUT = (DM / 64) * (DM / 32), I_G = (DM / 64) * (DFF / 32), I_D = (DFF / 64) * (DM / 32);
    const float* w_in = inp(2) + (size_t)l * DM * NPROJ; const float* w_out = inp(19) + (size_t)l * DM * DM;
    const float* w_g = inp(21) + (size_t)l * DM * DFF; const float* w_u = inp(22) + (size_t)l * DM * DFF; const float* w_d = inp(23) + (size_t)l * DFF * DM;
    const float* g_mix = inp(1) + l * DM; const float* g_br = inp(18) + l * DM; const float* g_ffn = inp(20) + l * DM;
    bf16* WIN = (bf16*)(wsp() + WS_WIN); bf16* WOUT = (bf16*)(wsp() + WS_WOUT); bf16* WGU = (bf16*)(wsp() + WS_WGU); bf16* WDN = (bf16*)(wsp() + WS_WDN);
    if (do_in) {
        for (int it = gw; it < I_IN; it += ngw) conv_item(w_in, DM, NPROJ, g_mix, WIN, 0, scr, it, F.lane);
    }
    if (do_rest) {
        for (int it = gw; it < I_OUT + 2 * I_G + I_D; it += ngw) {
            int r = it;
            if (r < I_OUT) { conv_item(w_out, DM, DM, g_br, WOUT, 0, scr, r, F.lane); continue; } r -= I_OUT;
            if (r < I_G) { conv_item(w_g, DM, DFF, g_ffn, WGU, 1, scr, r, F.lane); continue; } r -= I_G;
            if (r < I_G) { conv_item(w_u, DM, DFF, g_ffn, WGU, 2, scr, r, F.lane); continue; } r -= I_G;
            conv_item(w_d, DFF, DM, nullptr, WDN, 0, scr, r, F.lane);
        }
    }
}

__device__ __forceinline__ void ph_prologue(Frame& F) {
    conv_layer_items(F, 0, F.gw, F.ngw, true, false);
    { bf16* WIN = (bf16*)(wsp() + WS_WIN);
      for (int i = F.gw * 64 + F.lane; i < 64 * DM / 8; i += F.ngw * 64) *(GAS v4u*)(WIN + (size_t)NPROJ * DM + (size_t)i * 8) = (v4u){0u, 0u, 0u, 0u}; }
    if (blockIdx.x == 0) {
        int* TB = (int*)(wsp() + WS_SMALL + SM_TB);
        for (int d = F.tid; d < 2049; d += NTHR) {
            int bkt = d;
            if (d >= 16) bkt = 16 + (d >= 22) + (d >= 30) + (d >= 40) + (d >= 54) + (d >= 73) + (d >= 99) + (d >= 134) + (d >= 182) + (d >= 246) + (d >= 332) + (d >= 450) + (d >= 609) + (d >= 825) + (d >= 1117) + (d >= 1513);
            TB[d] = bkt;
        }
    }
    { bf16* WT = (bf16*)(wsp() + WS_SMALL + SM_WT); const float* w2 = inp(9); const float* a2 = inp(11); const float* g2 = inp(12);
      for (int idx = blockIdx.x * NTHR + F.tid; idx < DEPTH * 448 * GW; idx += F.G * NTHR) {
          const int c = idx % GW, k = (idx / GW) % 448, l = idx / (GW * 448);
          const float v = k < 96 ? w2[((size_t)l * 96 + k) * GW + c] : (k < 192 ? a2[((size_t)l * 96 + (k - 96)) * GW + c] : g2[((size_t)l * 256 + (k - 192)) * GW + c]);
          const int r32_ = c & 31, hct = c >> 5, ks_ = k >> 4, hh_ = (k >> 3) & 1;
          WT[(size_t)l * GW * 448 + (((size_t)hct * 28 + ks_) * 64 + 32 * hh_ + r32_) * 8 + (k & 7)] = (bf16)f2bf(v); } }
    const float* x = inp(0); bf16* XB = (bf16*)(wsp() + WS_XB); pg8::fx_t* ssq = (pg8::fx_t*)(ctlp() + CW_SSQ);
    for (int m = F.gw; m < M; m += F.ngw) {
        const GAS f32x4* xr = (const GAS f32x4*)(x + (size_t)m * DM) + F.lane; GAS v2u* o = (GAS v2u*)(XB + (size_t)m * DM) + F.lane; float s = 0.f;
#pragma unroll
        for (int j = 0; j < 8; ++j) { const f32x4 v = xr[64 * j]; s += (v.x * v.x + v.y * v.y) + (v.z * v.z + v.w * v.w); o[64 * j] = (v2u){pk2(v.x, v.y), pk2(v.z, v.w)}; }
        s = wave_sum(s); if (F.lane == 0) pg8::fx_add(ssq + m, s);
    }
}

constexpr int PR_PITCH = 912;
constexpr int PR_PRM_OFF = 32768, PR_MUA_OFF = PR_PRM_OFF + 8 * 512 * 4;
__device__ __forceinline__ float fast_tanh(float x) { return 1.0f - 2.0f * __builtin_amdgcn_rcpf(__expf(2.0f * x) + 1.0f); }
__device__ __forceinline__ float fast_sigmoid(float x) { return __builtin_amdgcn_rcpf(1.0f + __expf(-x)); }
constexpr int PR_OT_OFF = 51200, PR_OT_PITCH = 72, PR_OT_TILE = 32 * PR_OT_PITCH, PR_OT_WAVE = 6 * PR_OT_TILE;
static_assert(PR_OT_OFF + 8 * PR_OT_WAVE <= MISC_OFF, "prep LDS");
__device__ __forceinline__ void ph_prep(Frame& F, int l) {
    const bf16* PROJ = (const bf16*)(wsp() + WS_PROJ);
    bf16* R_ = (bf16*)outp();
    bf16* E_ = R_ + (size_t)M * GW; bf16* KP_ = E_ + (size_t)M * GW; bf16* V_ = KP_ + (size_t)M * GW;
    bf16* KK_ = (bf16*)outp() + (size_t)4 * M * GW; bf16* AS_ = KK_ + (size_t)M * GW; bf16* G_ = (bf16*)(wsp() + WS_G); float* BC = (float*)(wsp() + WS_BC);
    const bf16* WT = (const bf16*)(wsp() + WS_SMALL + SM_WT) + (size_t)l * GW * 448;
    LAS unsigned char* actL = F.lds + RING_OFF; LAS float* PRM = (LAS float*)(F.lds + PR_PRM_OFF); LAS float* MUA = (LAS float*)(F.lds + PR_MUA_OFF);
    { const float* mu = inp(7) + l * D_W; const float* w0 = inp(8) + l * GW; const float* a0 = inp(10) + l * GW; const float* k_k = inp(13) + l * GW; const float* k_a = inp(14) + l * GW; const float* r_k = inp(15) + l * GW;
      const int c = F.tid;
      PRM[c] = mu[D_R + c]; PRM[512 + c] = mu[D_K + c]; PRM[1024 + c] = mu[D_V + c]; PRM[1536 + c] = w0[c]; PRM[2048 + c] = a0[c]; PRM[2560 + c] = k_k[c]; PRM[3072 + c] = k_a[c]; PRM[3584 + c] = r_k[c];
      if (c < 448) MUA[c] = mu[c < 96 ? D_WD + c : (c < 192 ? D_AD + (c - 96) : D_GD + (c - 192))]; }
    __syncthreads();
    const int h = F.wave;
    for (int it = blockIdx.x; it < M / 32; it += F.G) {
        const int m0 = it * 32;
        int tid_ = threadIdx.x; asm volatile("" : "+v"(tid_));
        const int tid = tid_, r32 = tid & 31, hh = (tid >> 5) & 1, lane = tid & 63;
        LAS unsigned char* OT = F.lds + PR_OT_OFF + h * PR_OT_WAVE;
        { v2u pc[7], pp[7];
#pragma unroll
          for (int i = 0; i < 7; ++i) { const int gi = tid + NTHR * i, t = gi / 112, k = 4 * (gi % 112), m = m0 + t;
              const int col = k < 96 ? D_WD + k : (k < 192 ? D_AD + (k - 96) : D_GD + (k - 192)); const bf16* src = PROJ + (size_t)m * NPROJ_P + CD + col;
              pc[i] = *(const GAS v2u*)src; pp[i] = (v2u){0u, 0u}; if ((m % SEQ) > 0) pp[i] = *(const GAS v2u*)(src - NPROJ_P); }
#pragma unroll
          for (int i = 0; i < 7; ++i) { const int gi = tid + NTHR * i, t = gi / 112, k = 4 * (gi % 112);
              const f32x4 mv = *(const LAS f32x4*)(MUA + k);
              float x[4] = {bflo(pc[i].x), bfhi(pc[i].x), bflo(pc[i].y), bfhi(pc[i].y)}; const float xp[4] = {bflo(pp[i].x), bfhi(pp[i].x), bflo(pp[i].y), bfhi(pp[i].y)};
#pragma unroll
              for (int e = 0; e < 4; ++e) { x[e] += (xp[e] - x[e]) * mv[e]; x[e] = k < 96 ? fast_tanh(x[e]) : (k < 192 ? x[e] : fast_sigmoid(x[e])); }
              *(LAS v2u*)(actL + t * PR_PITCH + 2 * k) = (v2u){pk2(x[0], x[1]), pk2(x[2], x[3])}; } }
        __syncthreads();
        const int m = m0 + r32; const bool has_prev = (m % SEQ) > 0;
        const bf16* pr = PROJ + (size_t)m * NPROJ_P + CD; const bf16* pq = pr - NPROJ_P;
        const LAS unsigned char* bp = actL + r32 * PR_PITCH + 16 * hh;
        float kkv[2][16]; float n2 = 0.f, bcv = 0.f;
#pragma unroll
        for (int ct = 0; ct < 2; ++ct) {
            const int cb = 64 * h + 32 * ct + 4 * hh;
            v2u rc[4], kc[4], vc[4], rp[4], kp_[4], vp[4];
#pragma unroll
            for (int g4 = 0; g4 < 4; ++g4) { const int c = cb + 8 * g4; rc[g4] = *(const GAS v2u*)(pr + D_R + c); kc[g4] = *(const GAS v2u*)(pr + D_K + c); vc[g4] = *(const GAS v2u*)(pr + D_V + c);
                rp[g4] = (v2u){0u, 0u}; kp_[g4] = (v2u){0u, 0u}; vp[g4] = (v2u){0u, 0u};
                if (has_prev) { rp[g4] = *(const GAS v2u*)(pq + D_R + c); kp_[g4] = *(const GAS v2u*)(pq + D_K + c); vp[g4] = *(const GAS v2u*)(pq + D_V + c); } }
            f32x16 aW, aA, aG;
#pragma unroll
            for (int i = 0; i < 16; ++i) { aW[i] = 0.f; aA[i] = 0.f; aG[i] = 0.f; }
            const bf16* wt0 = WT + ((size_t)(2 * h + ct) * 28 * 64 + lane) * 8;
#pragma unroll
            for (int grp = 0; grp < 4; ++grp) {
                bf16x8 af[7];
#pragma unroll
                for (int q = 0; q < 7; ++q) af[q] = *(const GAS bf16x8*)(wt0 + 512 * (7 * grp + q));
#pragma unroll
                for (int q = 0; q < 7; ++q) { const int ks = 7 * grp + q; const bf16x8 bfr = *(const LAS bf16x8*)(bp + 32 * ks);
                    if (ks < 6) aW = __builtin_amdgcn_mfma_f32_32x32x16_bf16(af[q], bfr, aW, 0, 0, 0);
                    else if (ks < 12) aA = __builtin_amdgcn_mfma_f32_32x32x16_bf16(af[q], bfr, aA, 0, 0, 0);
                    else aG = __builtin_amdgcn_mfma_f32_32x32x16_bf16(af[q], bfr, aG, 0, 0, 0); }
                asm volatile("" ::: "memory");
            }
#pragma unroll
            for (int g4 = 0; g4 < 4; ++g4) {
                const int c = cb + 8 * g4;
                const f32x4 mr = *(const LAS f32x4*)(PRM + c), mk = *(const LAS f32x4*)(PRM + 512 + c), mv = *(const LAS f32x4*)(PRM + 1024 + c), w0v = *(const LAS f32x4*)(PRM + 1536 + c),
                            a0v = *(const LAS f32x4*)(PRM + 2048 + c), kkc = *(const LAS f32x4*)(PRM + 2560 + c), kac = *(const LAS f32x4*)(PRM + 3072 + c), rkc = *(const LAS f32x4*)(PRM + 3584 + c);
                const float rcu[4] = {bflo(rc[g4].x), bfhi(rc[g4].x), bflo(rc[g4].y), bfhi(rc[g4].y)}, kcu[4] = {bflo(kc[g4].x), bfhi(kc[g4].x), bflo(kc[g4].y), bfhi(kc[g4].y)}, vcu[4] = {bflo(vc[g4].x), bfhi(vc[g4].x), bflo(vc[g4].y), bfhi(vc[g4].y)};
                const float rpu[4] = {bflo(rp[g4].x), bfhi(rp[g4].x), bflo(rp[g4].y), bfhi(rp[g4].y)}, kpu[4] = {bflo(kp_[g4].x), bfhi(kp_[g4].x), bflo(kp_[g4].y), bfhi(kp_[g4].y)}, vpu[4] = {bflo(vp[g4].x), bfhi(vp[g4].x), bflo(vp[g4].y), bfhi(vp[g4].y)};
                float ro[4], eo[4], ko[4], vo[4], ao[4], go[4];
#pragma unroll
                for (int e = 0; e < 4; ++e) {
                    const float r = rcu[e] + (rpu[e] - rcu[e]) * mr[e], k = kcu[e] + (kpu[e] - kcu[e]) * mk[e], v = vcu[e] + (vpu[e] - vcu[e]) * mv[e];
                    const float ee = 0.6065306597126334f * fast_sigmoid(w0v[e] + aW[4 * g4 + e]);
                    const float as = fast_sigmoid(a0v[e] + aA[4 * g4 + e]);
                    const float kv = k * kkc[e]; kkv[ct][4 * g4 + e] = kv; n2 += kv * kv;
                    const float kp = k * (1.0f + (as - 1.0f) * kac[e]);
                    bcv += r * kp * rkc[e];
                    ro[e] = r; eo[e] = ee; ko[e] = kp; vo[e] = v; ao[e] = as; go[e] = aG[4 * g4 + e];
                }
                LAS unsigned char* ot = OT + r32 * PR_OT_PITCH + 2 * (8 * g4 + 4 * hh);
                *(LAS v2u*)(ot) = (v2u){pk2(ro[0], ro[1]), pk2(ro[2], ro[3])}; *(LAS v2u*)(ot + PR_OT_TILE) = (v2u){pk2(eo[0], eo[1]), pk2(eo[2], eo[3])};
                *(LAS v2u*)(ot + 2 * PR_OT_TILE) = (v2u){pk2(ko[0], ko[1]), pk2(ko[2], ko[3])}; *(LAS v2u*)(ot + 3 * PR_OT_TILE) = (v2u){pk2(vo[0], vo[1]), pk2(vo[2], vo[3])};
                *(LAS v2u*)(ot + 4 * PR_OT_TILE) = (v2u){pk2(ao[0], ao[1]), pk2(ao[2], ao[3])}; *(LAS v2u*)(ot + 5 * PR_OT_TILE) = (v2u){pk2(go[0], go[1]), pk2(go[2], go[3])};
            }
            asm volatile("" ::: "memory");
            { bf16* const dst[6] = {R_, E_, KP_, V_, AS_, G_};
#pragma unroll
              for (int a = 0; a < 6; ++a)
#pragma unroll
                for (int i = 0; i < 2; ++i) { const int tk = (lane >> 2) + 16 * i, part = lane & 3; const LAS unsigned char* src = OT + a * PR_OT_TILE + tk * PR_OT_PITCH + 16 * part;
                    const v2u lo = *(const LAS v2u*)src, hi = *(const LAS v2u*)(src + 8);
                    *(GAS v4u*)(dst[a] + (size_t)(m0 + tk) * GW + 64 * h + 32 * ct + 8 * part) = (v4u){lo.x, lo.y, hi.x, hi.y}; } }
            asm volatile("" ::: "memory");
        }
        n2 += __shfl_xor(n2, 32); bcv += __shfl_xor(bcv, 32);
        const float inv = 1.0f / fmaxf(sqrtf(n2), 1e-12f);
#pragma unroll
        for (int ct = 0; ct < 2; ++ct)
#pragma unroll
            for (int g4 = 0; g4 < 4; ++g4) *(LAS v2u*)(OT + ct * PR_OT_TILE + r32 * PR_OT_PITCH + 2 * (8 * g4 + 4 * hh)) = (v2u){pk2(kkv[ct][4 * g4] * inv, kkv[ct][4 * g4 + 1] * inv), pk2(kkv[ct][4 * g4 + 2] * inv, kkv[ct][4 * g4 + 3] * inv)};
        asm volatile("" ::: "memory");
#pragma unroll
        for (int ct = 0; ct < 2; ++ct)
#pragma unroll
            for (int i = 0; i < 2; ++i) { const int tk = (lane >> 2) + 16 * i, part = lane & 3; const LAS unsigned char* src = OT + ct * PR_OT_TILE + tk * PR_OT_PITCH + 16 * part;
                const v2u lo = *(const LAS v2u*)src, hi = *(const LAS v2u*)(src + 8);
                *(GAS v4u*)(KK_ + (size_t)(m0 + tk) * GW + 64 * h + 32 * ct + 8 * part) = (v4u){lo.x, lo.y, hi.x, hi.y}; }
        asm volatile("" ::: "memory");
        if (hh == 0) BC[(size_t)m * NH + h] = bcv;
        __syncthreads();
    }
}

__device__ __forceinline__ Frame mkframe(LAS unsigned char* lds) {
    Frame F; F.lds = lds; { int t_ = threadIdx.x; asm volatile("" : "+v"(t_)); F.tid = t_; } F.lane = F.tid & 63; F.wave = __builtin_amdgcn_readfirstlane(F.tid >> 6);
    F.G = gridDim.x; { const int bx = blockIdx.x; F.vcu = (F.G % 8 == 0) ? (bx % 8) * (F.G / 8) + bx / 8 : bx; }
    F.gw = blockIdx.x * NWAVES + F.wave; F.ngw = F.G * NWAVES; return F;
}

#define UNPACK8(dst, o, W_) do { dst[(o)] = bflo((W_).x); dst[(o) + 1] = bfhi((W_).x); dst[(o) + 2] = bflo((W_).y); dst[(o) + 3] = bfhi((W_).y); dst[(o) + 4] = bflo((W_).z); dst[(o) + 5] = bfhi((W_).z); dst[(o) + 6] = bflo((W_).w); dst[(o) + 7] = bfhi((W_).w); } while (0)
#define DOT8(q, o, W_) ((q)[(o)] * bflo((W_).x) + (q)[(o) + 1] * bfhi((W_).x) + (q)[(o) + 2] * bflo((W_).y) + (q)[(o) + 3] * bfhi((W_).y) + (q)[(o) + 4] * bflo((W_).z) + (q)[(o) + 5] * bfhi((W_).z) + (q)[(o) + 6] * bflo((W_).w) + (q)[(o) + 7] * bfhi((W_).w))
#define AXPY8(acc, o, sc, pe, W_) do { acc[(o)] = acc[(o)] * (sc) + (pe) * bflo((W_).x); acc[(o) + 1] = acc[(o) + 1] * (sc) + (pe) * bfhi((W_).x); acc[(o) + 2] = acc[(o) + 2] * (sc) + (pe) * bflo((W_).y); acc[(o) + 3] = acc[(o) + 3] * (sc) + (pe) * bfhi((W_).y); \
    acc[(o) + 4] = acc[(o) + 4] * (sc) + (pe) * bflo((W_).z); acc[(o) + 5] = acc[(o) + 5] * (sc) + (pe) * bfhi((W_).z); acc[(o) + 6] = acc[(o) + 6] * (sc) + (pe) * bflo((W_).w); acc[(o) + 7] = acc[(o) + 7] * (sc) + (pe) * bfhi((W_).w); } while (0)
__device__ __forceinline__ void mix_a_simple(Frame& F) {
    const bf16* PROJ = (const bf16*)(wsp() + WS_PROJ); bf16* YC = (bf16*)(wsp() + WS_YCAT); const int* TB = (const int*)(wsp() + WS_SMALL + SM_TB); const float* pb = inp(3);
    const int nthr = F.G * NTHR;
    for (int idx = blockIdx.x * NTHR + F.tid; idx < M * NH; idx += nthr) {
        const int m = idx >> 3, h = idx & 7, t = m % SEQ;
        float q[64], acc[64];
        { const GAS v4u* qp = (const GAS v4u*)(PROJ + (size_t)m * NPROJ_P + CA_Q + 64 * h);
#pragma unroll
          for (int i = 0; i < 8; ++i) { const v4u w = qp[i]; UNPACK8(q, 8 * i, w); } }
#pragma unroll
        for (int i = 0; i < 64; ++i) acc[i] = 0.f;
        float mx = -1e30f, l = 0.f;
        for (int p = 0; p < 3; ++p) { const int d = p == 0 ? 1 : (p == 1 ? 4 : 16);
            for (int j = 0; j <= 128; ++j) { const int kp = t - j * d; if (kp < 0) break;
                const bf16* row = PROJ + (size_t)(m - j * d) * NPROJ_P; const GAS v4u* kq = (const GAS v4u*)(row + CA_K + 64 * h); const GAS v4u* vq = (const GAS v4u*)(row + CA_V + 64 * h);
                float s = 0.f;
#pragma unroll
                for (int i = 0; i < 8; ++i) { const v4u w = kq[i]; s += DOT8(q, 8 * i, w); }
                s = s * 0.125f + pb[TB[j * d] * 16 + h];
                const float mn = fmaxf(mx, s), sc = __expf(mx - mn), pe = __expf(s - mn); mx = mn; l = l * sc + pe;
#pragma unroll
                for (int i = 0; i < 8; ++i) { const v4u w = vq[i]; AXPY8(acc, 8 * i, sc, pe, w); }
            } }
        const float inv = 1.0f / l; GAS v4u* op = (GAS v4u*)(YC + (size_t)m * DM + 0 * GW + 64 * h);
#pragma unroll
        for (int i = 0; i < 8; ++i) op[i] = (v4u){pk2(acc[8 * i] * inv, acc[8 * i + 1] * inv), pk2(acc[8 * i + 2] * inv, acc[8 * i + 3] * inv), pk2(acc[8 * i + 4] * inv, acc[8 * i + 5] * inv), pk2(acc[8 * i + 6] * inv, acc[8 * i + 7] * inv)};
    }
}
__device__ __forceinline__ void mix_c_simple(Frame& F, int l = 0) {
    const bf16* PROJ = (const bf16*)(wsp() + WS_PROJ); bf16* YC = (bf16*)(wsp() + WS_YCAT); const int* TB = (const int*)(wsp() + WS_SMALL + SM_TB); const float* pb = inp(3);
    const float* KBAR = (const float*)(wsp() + CTL_KBAR) + (size_t)l * 64 * 8 * 64;
    const int nthr = F.G * NTHR;
    for (int idx = blockIdx.x * NTHR + F.tid; idx < M * NH; idx += nthr) {
        const int m = idx >> 3, h = idx & 7, t = m % SEQ, b = m / SEQ, ob = t >> 8;
        float q[64], acc[64];
        { const GAS v4u* qp = (const GAS v4u*)(PROJ + (size_t)m * NPROJ_P + CC_Q + 64 * h);
#pragma unroll
          for (int i = 0; i < 8; ++i) { const v4u w = qp[i]; UNPACK8(q, 8 * i, w); } }
        float gate[8];
#pragma unroll
        for (int n = 0; n < 8; ++n) { float s = 0.f; if (n < ob) { const float* kb = KBAR + ((b * NH + h) * 8 + n) * 64;
#pragma unroll
                for (int i = 0; i < 64; ++i) s += q[i] * kb[i]; } gate[n] = s; }
        unsigned sel = 0u;
#pragma unroll
        for (int n = 0; n < 8; ++n) { int rank = 0;
#pragma unroll
            for (int n2 = 0; n2 < 8; ++n2) rank += (n2 < ob && n2 != n && (gate[n2] > gate[n] || (gate[n2] == gate[n] && n2 < n))) ? 1 : 0;
            if (n < ob && rank < 3) sel |= 1u << n; }
        sel |= 1u << ob;
#pragma unroll
        for (int i = 0; i < 64; ++i) acc[i] = 0.f;
        float mx = -1e30f, l = 0.f;
        for (int n = 0; n <= ob; ++n) { if (!((sel >> n) & 1u)) continue; const int kmax = n == ob ? (t & 255) : 255;
            for (int i2 = 0; i2 <= kmax; ++i2) { const int kp = 256 * n + i2;
                const bf16* row = PROJ + ((size_t)b * SEQ + kp) * NPROJ_P; const GAS v4u* kq = (const GAS v4u*)(row + CC_K + 64 * h); const GAS v4u* vq = (const GAS v4u*)(row + CC_V + 64 * h);
                float s = 0.f;
#pragma unroll
                for (int i = 0; i < 8; ++i) { const v4u w = kq[i]; s += DOT8(q, 8 * i, w); }
                s = s * 0.125f + pb[TB[t - kp] * 16 + 8 + h];
                const float mn = fmaxf(mx, s), sc = __expf(mx - mn), pe = __expf(s - mn); mx = mn; l = l * sc + pe;
#pragma unroll
                for (int i = 0; i < 8; ++i) { const v4u w = vq[i]; AXPY8(acc, 8 * i, sc, pe, w); }
            } }
        const float inv = 1.0f / l; GAS v4u* op = (GAS v4u*)(YC + (size_t)m * DM + 2 * GW + 64 * h);
#pragma unroll
        for (int i = 0; i < 8; ++i) op[i] = (v4u){pk2(acc[8 * i] * inv, acc[8 * i + 1] * inv), pk2(acc[8 * i + 2] * inv, acc[8 * i + 3] * inv), pk2(acc[8 * i + 4] * inv, acc[8 * i + 5] * inv), pk2(acc[8 * i + 6] * inv, acc[8 * i + 7] * inv)};
    }
}
__device__ __forceinline__ void mix_b_simple(Frame& F, int l) {
    const bf16* PROJ = (const bf16*)(wsp() + WS_PROJ); bf16* YC = (bf16*)(wsp() + WS_YCAT); const pg8::fx_t* ST = (const pg8::fx_t*)(wsp() + CTL_STATS) + (size_t)l * M * 2;
    const float* lng = inp(4) + l * GW; const float* sw = inp(5) + (size_t)l * NH * 128 * 128; const float* sb = inp(6) + l * NH * 128;
    const int nthr = F.G * NTHR;
    for (int idx = blockIdx.x * NTHR + F.tid; idx < M * GW; idx += nthr) {
        const int m = idx >> 9, c = idx & 511, g = c >> 6, tt = m & 127, m0 = m - tt;
        const float* wrow = sw + ((size_t)g * 128 + tt) * 128; const float gn = lng[c]; float s = 0.f;
        for (int s2 = 0; s2 <= tt; ++s2) { const int ms = m0 + s2; const float mu_ = pg8::fx_get(ST + 2 * ms) * (1.0f / 512.0f), rs_ = 1.0f / sqrtf(fmaxf(pg8::fx_get(ST + 2 * ms + 1) * (1.0f / 512.0f) - mu_ * mu_, 0.f) + 1e-5f); const float vv = (gelu_tanh(bf2f(PROJ[(size_t)ms * NPROJ_P + CB_V + c])) - mu_) * rs_ * gn; s += wrow[s2] * vv; }
        const float u = gelu_tanh(bf2f(PROJ[(size_t)m * NPROJ_P + CB_U + c]));
        YC[(size_t)m * DM + GW + c] = (bf16)f2bf(u * (s + sb[g * 128 + tt]));
    }
}
__device__ __forceinline__ float rdl(float v, int k) { return __builtin_bit_cast(float, __builtin_amdgcn_readlane(__builtin_bit_cast(int, v), k)); }
__device__ __forceinline__ void mix_d_simple(Frame& F) {
    const bf16* R_ = (const bf16*)outp();
    const bf16* E_ = R_ + (size_t)M * GW; const bf16* KP_ = E_ + (size_t)M * GW; const bf16* V_ = KP_ + (size_t)M * GW;
    const bf16* KK_ = (const bf16*)outp() + (size_t)4 * M * GW; const bf16* AS_ = KK_ + (size_t)M * GW; float* YD = (float*)(wsp() + WS_YD);
    for (int it = F.gw; it < BATCH * NH; it += F.ngw) {
        const int b = it >> 3, h = it & 7; float s[64];
#pragma unroll
        for (int k = 0; k < 64; ++k) s[k] = 0.f;
        for (int t = 0; t < SEQ; ++t) {
            const size_t o = ((size_t)b * SEQ + t) * GW + 64 * h + F.lane;
            const float r = bf2f(R_[o]), w = __expf(-bf2f(E_[o])), kp = bf2f(KP_[o]), v = bf2f(V_[o]), kk = bf2f(KK_[o]), as = bf2f(AS_[o]);
            const float a = -kk, bb = kk * as;
            float sa = 0.f;
#pragma unroll
            for (int k = 0; k < 64; ++k) sa += s[k] * rdl(a, k);
            float y = 0.f;
#pragma unroll
            for (int k = 0; k < 64; ++k) { s[k] = s[k] * rdl(w, k) + sa * rdl(bb, k) + v * rdl(kp, k); y += s[k] * rdl(r, k); }
            YD[o] = y;
        }
    }
}

constexpr float LOG2E = 1.4426950408889634f;

constexpr int SC_T = 32, SC_TOK = (5 * 64 + 32) * 4, SC_BUF = SC_T * SC_TOK, SC_YB = SC_T * 32 * 4, SC_LDS = 2 * SC_BUF + 2 * SC_YB;
template <int CTRL> __device__ __forceinline__ float dpp_add(float x) {
    const int y = __builtin_amdgcn_update_dpp(0, __builtin_bit_cast(int, x), CTRL, 0xF, 0xF, false);
    return x + __builtin_bit_cast(float, y);
}
__device__ __forceinline__ float red8(float x) { x = dpp_add<0xB1>(x); x = dpp_add<0x4E>(x); x = dpp_add<0x141>(x); return x; }
__device__ __forceinline__ void scan_unit(LAS unsigned char* lds, int unit, int tid) {
    const int half = unit & 1, h = (unit >> 1) & 7, b = unit >> 4;
    const bf16* R_ = (const bf16*)outp();
    const bf16* E_ = R_ + (size_t)M * GW; const bf16* KP_ = E_ + (size_t)M * GW; const bf16* V_ = KP_ + (size_t)M * GW;
    const bf16* KK_ = (const bf16*)outp() + (size_t)4 * M * GW; const bf16* AS_ = KK_ + (size_t)M * GW; float* YD = (float*)(wsp() + WS_YD);
    const int lane = tid & 63, wave = __builtin_amdgcn_readfirstlane(tid >> 6);
    const bool scanner = wave < 4;
    const int j = lane & 7, rowl = (wave & 3) * 8 + (lane >> 3);
    const int st = tid & 255, tt = st >> 3, cg = st & 7;
    const size_t gbase = ((size_t)b * SEQ) * GW + 64 * h + 8 * cg;
#define SC_STAGE(c, buf) do { const size_t o_ = gbase + (size_t)((c) * SC_T + tt) * GW; \
        const v4u g_r = *(const GAS v4u*)(R_ + o_), g_e = *(const GAS v4u*)(E_ + o_), g_k = *(const GAS v4u*)(KP_ + o_), g_v = *(const GAS v4u*)(V_ + o_), g_kk = *(const GAS v4u*)(KK_ + o_), g_as = *(const GAS v4u*)(AS_ + o_); \
        LAS float* p_ = (LAS float*)(lds + (buf) * SC_BUF + tt * SC_TOK) + 8 * cg; float kk_[8], x_[8], y_[8]; \
        UNPACK8(kk_, 0, g_kk); \
        *(LAS f32x4*)(p_) = (f32x4){-kk_[0], -kk_[1], -kk_[2], -kk_[3]}; *(LAS f32x4*)(p_ + 4) = (f32x4){-kk_[4], -kk_[5], -kk_[6], -kk_[7]}; \
        UNPACK8(x_, 0, g_e); *(LAS f32x4*)(p_ + 64) = (f32x4){__expf(-x_[0]), __expf(-x_[1]), __expf(-x_[2]), __expf(-x_[3])}; *(LAS f32x4*)(p_ + 68) = (f32x4){__expf(-x_[4]), __expf(-x_[5]), __expf(-x_[6]), __expf(-x_[7])}; \
        UNPACK8(y_, 0, g_as); *(LAS f32x4*)(p_ + 128) = (f32x4){kk_[0] * y_[0], kk_[1] * y_[1], kk_[2] * y_[2], kk_[3] * y_[3]}; *(LAS f32x4*)(p_ + 132) = (f32x4){kk_[4] * y_[4], kk_[5] * y_[5], kk_[6] * y_[6], kk_[7] * y_[7]}; \
        UNPACK8(x_, 0, g_k); *(LAS f32x4*)(p_ + 192) = (f32x4){x_[0], x_[1], x_[2], x_[3]}; *(LAS f32x4*)(p_ + 196) = (f32x4){x_[4], x_[5], x_[6], x_[7]}; \
        UNPACK8(x_, 0, g_r); *(LAS f32x4*)(p_ + 256) = (f32x4){x_[0], x_[1], x_[2], x_[3]}; *(LAS f32x4*)(p_ + 260) = (f32x4){x_[4], x_[5], x_[6], x_[7]}; \
        if ((cg >> 2) == half) { UNPACK8(x_, 0, g_v); LAS float* v_ = (LAS float*)(lds + (buf) * SC_BUF + tt * SC_TOK) + 320 + 8 * (cg & 3); \
            *(LAS f32x4*)(v_) = (f32x4){x_[0], x_[1], x_[2], x_[3]}; *(LAS f32x4*)(v_ + 4) = (f32x4){x_[4], x_[5], x_[6], x_[7]}; } } while (0)
    if (!scanner) SC_STAGE(0, 0);
    __syncthreads();
    f32x4 s0 = {0.f, 0.f, 0.f, 0.f}, s1 = {0.f, 0.f, 0.f, 0.f};
    float ykeep = 0.f;
    for (int c = 0; c < SEQ / SC_T; ++c) {
        const int cur = c & 1;
        LAS float* yb = (LAS float*)(lds + 2 * SC_BUF + cur * SC_YB);
        if (scanner) {
            const LAS float* base = (const LAS float*)(lds + cur * SC_BUF) + 8 * j;
            const LAS float* vbase = (const LAS float*)(lds + cur * SC_BUF) + 320 + rowl;
            f32x4 a0 = *(const LAS f32x4*)(base), a1 = *(const LAS f32x4*)(base + 4), w0 = *(const LAS f32x4*)(base + 64), w1 = *(const LAS f32x4*)(base + 68), b0 = *(const LAS f32x4*)(base + 128), b1 = *(const LAS f32x4*)(base + 132),
                  k0 = *(const LAS f32x4*)(base + 192), k1 = *(const LAS f32x4*)(base + 196), r0 = *(const LAS f32x4*)(base + 256), r1 = *(const LAS f32x4*)(base + 260);
            float vv = *vbase;
#pragma unroll
            for (int t = 0; t < SC_T; ++t) {
                f32x4 na0 = a0, na1 = a1, nw0 = w0, nw1 = w1, nb0 = b0, nb1 = b1, nk0 = k0, nk1 = k1, nr0 = r0, nr1 = r1; float nv = vv;
                if (t + 1 < SC_T) { const LAS float* p = base + (t + 1) * (SC_TOK / 4);
                    na0 = *(const LAS f32x4*)(p); na1 = *(const LAS f32x4*)(p + 4); nw0 = *(const LAS f32x4*)(p + 64); nw1 = *(const LAS f32x4*)(p + 68); nb0 = *(const LAS f32x4*)(p + 128); nb1 = *(const LAS f32x4*)(p + 132);
                    nk0 = *(const LAS f32x4*)(p + 192); nk1 = *(const LAS f32x4*)(p + 196); nr0 = *(const LAS f32x4*)(p + 256); nr1 = *(const LAS f32x4*)(p + 260);
                    nv = vbase[(t + 1) * (SC_TOK / 4)]; }
                const f32x4 pa = s0 * a0 + s1 * a1;
                float sa = (pa.x + pa.y) + (pa.z + pa.w);
                const f32x4 sw0 = s0 * w0 + vv * k0, sw1 = s1 * w1 + vv * k1;
                sa = red8(sa);
                s0 = sa * b0 + sw0; s1 = sa * b1 + sw1;
                const f32x4 py = s0 * r0 + s1 * r1;
                float y = (py.x + py.y) + (py.z + py.w);
                y = red8(y);
                ykeep = (j == (t & 7)) ? y : ykeep;
                if ((t & 7) == 7) yb[((t & ~7) + j) * 32 + rowl] = ykeep;
                a0 = na0; a1 = na1; w0 = nw0; w1 = nw1; b0 = nb0; b1 = nb1; k0 = nk0; k1 = nk1; r0 = nr0; r1 = nr1; vv = nv;
            }
        } else {
            if (c > 0) {
                const LAS float* ybp = (const LAS float*)(lds + 2 * SC_BUF + (cur ^ 1) * SC_YB); const int t2 = st >> 3, q4 = st & 7; const f32x4 v = *(const LAS f32x4*)(ybp + t2 * 32 + 4 * q4);
                *(GAS f32x4*)(YD + ((size_t)b * SEQ + (c - 1) * SC_T + t2) * GW + 64 * h + 32 * half + 4 * q4) = v; }
            if (c + 1 < SEQ / SC_T) SC_STAGE(c + 1, cur ^ 1);
        }
        __syncthreads();
    }
    if (!scanner) { const LAS float* ybp = (const LAS float*)(lds + 2 * SC_BUF + 1 * SC_YB); const int t2 = st >> 3, q4 = st & 7; const f32x4 v = *(const LAS f32x4*)(ybp + t2 * 32 + 4 * q4);
        *(GAS f32x4*)(YD + ((size_t)b * SEQ + (SEQ / SC_T - 1) * SC_T + t2) * GW + 64 * h + 32 * half + 4 * q4) = v; }
#undef SC_STAGE
    __syncthreads();
}

struct AttnSt { f32x16 o0, o1; float m, l; };
__device__ __forceinline__ void attn_init(AttnSt& st) {
#pragma unroll
    for (int i = 0; i < 16; ++i) { st.o0[i] = 0.f; st.o1[i] = 0.f; }
    st.m = -1e30f; st.l = 0.f;
}
__device__ __forceinline__ void attn_tile(AttnSt& st, const bf16x8 (&qf)[4], const bf16* Kcol, const bf16* Vcol, int rowb, int kb, int ks, int qpos, int maxd, bool sel, const LAS float* biasT, int r32, int hh) {
    int kp_l = kb + r32 * ks; kp_l = kp_l < 0 ? 0 : kp_l;
    const bf16* kr_ = Kcol + (size_t)(rowb + kp_l) * NPROJ_P + 8 * hh;
    bf16x8 kf[4];
#pragma unroll
    for (int s = 0; s < 4; ++s) kf[s] = *(const GAS bf16x8*)(kr_ + 16 * s);
    f32x16 sc;
#pragma unroll
    for (int i = 0; i < 16; ++i) sc[i] = 0.f;
#pragma unroll
    for (int s = 0; s < 4; ++s) sc = __builtin_amdgcn_mfma_f32_32x32x16_bf16(kf[s], qf[s], sc, 0, 0, 0);
    unsigned vf[2][2][4];
#pragma unroll
    for (int s2 = 0; s2 < 2; ++s2)
#pragma unroll
        for (int jp = 0; jp < 4; ++jp) {
            const int j0 = 2 * jp, key0 = 16 * s2 + 8 * (j0 >> 2) + 4 * hh + (j0 & 3);
            int kp0 = kb + key0 * ks, kp1 = kp0 + ks; kp0 = kp0 < 0 ? 0 : kp0; kp1 = kp1 < 0 ? 0 : kp1;
            const bf16* v0 = Vcol + (size_t)(rowb + kp0) * NPROJ_P + r32; const bf16* v1 = Vcol + (size_t)(rowb + kp1) * NPROJ_P + r32;
            vf[0][s2][jp] = (unsigned)v0[0] | ((unsigned)v1[0] << 16); vf[1][s2][jp] = (unsigned)v0[32] | ((unsigned)v1[32] << 16);
        }
    float tmax = -INFINITY;
#pragma unroll
    for (int r = 0; r < 16; ++r) {
        const int kr = (r & 3) + 8 * (r >> 2) + 4 * hh, kp = kb + kr * ks, dist = qpos - kp;
        const bool ok = sel && dist >= 0 && dist <= maxd && kp >= 0;
        const float v = sc[r] * (0.125f * LOG2E) + biasT[ok ? dist : 0];
        sc[r] = ok ? v : -INFINITY; tmax = fmaxf(tmax, sc[r]);
    }
    tmax = fmaxf(tmax, __shfl_xor(tmax, 32));
    const float mn = fmaxf(st.m, tmax), scale = __builtin_amdgcn_exp2f(st.m - mn); st.m = mn;
    float ls = 0.f;
#pragma unroll
    for (int r = 0; r < 16; ++r) { sc[r] = __builtin_amdgcn_exp2f(sc[r] - mn); ls += sc[r]; }
    st.l = st.l * scale + ls;
#pragma unroll
    for (int i = 0; i < 16; ++i) { st.o0[i] *= scale; st.o1[i] *= scale; }
    typedef unsigned u32x4_t __attribute__((ext_vector_type(4)));
#pragma unroll
    for (int s2 = 0; s2 < 2; ++s2) {
        u32x4_t pw; pw.x = pg8::cvt_pk_bf16(sc[8 * s2], sc[8 * s2 + 1]); pw.y = pg8::cvt_pk_bf16(sc[8 * s2 + 2], sc[8 * s2 + 3]); pw.z = pg8::cvt_pk_bf16(sc[8 * s2 + 4], sc[8 * s2 + 5]); pw.w = pg8::cvt_pk_bf16(sc[8 * s2 + 6], sc[8 * s2 + 7]);
        const bf16x8 pf = __builtin_bit_cast(bf16x8, pw);
        u32x4_t a0 = {vf[0][s2][0], vf[0][s2][1], vf[0][s2][2], vf[0][s2][3]}, a1 = {vf[1][s2][0], vf[1][s2][1], vf[1][s2][2], vf[1][s2][3]};
        st.o0 = __builtin_amdgcn_mfma_f32_32x32x16_bf16(__builtin_bit_cast(bf16x8, a0), pf, st.o0, 0, 0, 0);
        st.o1 = __builtin_amdgcn_mfma_f32_32x32x16_bf16(__builtin_bit_cast(bf16x8, a1), pf, st.o1, 0, 0, 0);
    }
}
__device__ __forceinline__ void attn_loadq(bf16x8 (&qf)[4], const bf16* Qcol, int row, int hh) {
    const bf16* q = Qcol + (size_t)row * NPROJ_P + 8 * hh;
#pragma unroll
    for (int s = 0; s < 4; ++s) qf[s] = *(const GAS bf16x8*)(q + 16 * s);
}
__device__ __forceinline__ void attn_store(const f32x16& o0, const f32x16& o1, float inv, bf16* yrow, int hh) {
#pragma unroll
    for (int g = 0; g < 4; ++g) {
        *(GAS v2u*)(yrow + 8 * g + 4 * hh) = (v2u){pk2(o0[4 * g] * inv, o0[4 * g + 1] * inv), pk2(o0[4 * g + 2] * inv, o0[4 * g + 3] * inv)};
        *(GAS v2u*)(yrow + 32 + 8 * g + 4 * hh) = (v2u){pk2(o1[4 * g] * inv, o1[4 * g + 1] * inv), pk2(o1[4 * g + 2] * inv, o1[4 * g + 3] * inv)};
    }
}
__device__ __forceinline__ void build_bias(LAS float* biasT, int hcol, int tid) {
    const int* TB = (const int*)(wsp() + WS_SMALL + SM_TB); const float* pb = inp(3); LAS int* bktT = (LAS int*)(biasT + 2048);
    for (int d = tid; d < 2048; d += NTHR) { const int bk = TB[d]; bktT[d] = bk; biasT[d] = pb[bk * 16 + hcol] * LOG2E; }
}

constexpr int MC_KP = 144, MC_VP = 192, MC_KB = 128 * MC_KP, MC_VB = 128 * MC_VP, MC_K_OFF = 16384, MC_V_OFF = MC_K_OFF + 2 * MC_KB, MC_LDS = MC_V_OFF + 2 * MC_VB;
typedef short v4i16_t __attribute__((ext_vector_type(4)));
__device__ __forceinline__ float pl32_max(float a) { float x = a, y = a;
    asm volatile("s_nop 1\n\tv_permlane32_swap_b32_e32 %0, %1\n\ts_nop 0" : "+v"(x), "+v"(y));
    return fmaxf(x, y); }
template <int MODE> __device__ __forceinline__ void moba_tile(AttnSt& st, const bf16x8 (&qf)[4], const LAS unsigned char* Kt, const LAS unsigned char* Vt, const LAS float* biasT, const LAS int* TB, int dlo, bool sel, int lane, int r32, int hh) {
    bf16x8 kf[4];
#pragma unroll
    for (int s = 0; s < 4; ++s) kf[s] = *(const LAS bf16x8*)(Kt + r32 * MC_KP + 32 * s + 16 * hh);
    v4i16_t vt[2][2][2];
    { const LAS unsigned char* vb = Vt + (4 * hh + ((lane & 15) >> 2)) * MC_VP + (16 * ((lane >> 4) & 1) + 4 * (lane & 3)) * 2;
#pragma unroll
      for (int dh = 0; dh < 2; ++dh)
#pragma unroll
        for (int s2 = 0; s2 < 2; ++s2)
#pragma unroll
            for (int h8 = 0; h8 < 2; ++h8) vt[dh][s2][h8] = __builtin_amdgcn_ds_read_tr16_b64_v4i16((LAS v4i16_t*)(vb + (16 * s2 + 8 * h8) * MC_VP + 64 * dh)); }
    f32x16 sc;
#pragma unroll
    for (int i = 0; i < 16; ++i) sc[i] = 0.f;
#pragma unroll
    for (int s = 0; s < 4; ++s) sc = __builtin_amdgcn_mfma_f32_32x32x16_bf16(kf[s], qf[s], sc, 0, 0, 0);
    const int d0 = dlo + r32 + 31 - 4 * hh;
    const int dmin = dlo < 0 ? 0 : dlo, dmax = dlo + 62;
    const bool uni = __builtin_amdgcn_readfirstlane(TB[dmin]) == __builtin_amdgcn_readfirstlane(TB[dmax]);
    float tmax = -INFINITY;
    if (uni) { const float bu = biasT[dmin];
#pragma unroll
        for (int r = 0; r < 16; ++r) { float v = sc[r] * (0.125f * LOG2E) + bu; if (MODE == 1) { const int dist = d0 - (r & 3) - 8 * (r >> 2); v = dist >= 0 ? v : -INFINITY; } sc[r] = v; tmax = fmaxf(tmax, v); }
    } else {
#pragma unroll
        for (int r = 0; r < 16; ++r) { const int dist = d0 - (r & 3) - 8 * (r >> 2); float v = sc[r] * (0.125f * LOG2E) + biasT[dist < 0 ? 0 : dist]; if (MODE == 1) v = dist >= 0 ? v : -INFINITY; sc[r] = v; tmax = fmaxf(tmax, v); }
    }
    if (MODE == 2) tmax = sel ? tmax : -INFINITY;
    tmax = pl32_max(tmax);
    const float mn = fmaxf(st.m, tmax);
    if (__ballot(mn > st.m) != 0ull) { const float scale = __builtin_amdgcn_exp2f(st.m - mn); st.l *= scale;
#pragma unroll
        for (int i = 0; i < 16; ++i) { st.o0[i] *= scale; st.o1[i] *= scale; } }
    st.m = mn;
    const float msub = (MODE == 2 && !sel) ? INFINITY : mn;
    float ls = 0.f;
#pragma unroll
    for (int r = 0; r < 16; ++r) { sc[r] = __builtin_amdgcn_exp2f(sc[r] - msub); ls += sc[r]; }
    st.l += ls;
    typedef unsigned u32x4_t __attribute__((ext_vector_type(4)));
#pragma unroll
    for (int s2 = 0; s2 < 2; ++s2) {
        u32x4_t pw; pw.x = pg8::cvt_pk_bf16(sc[8 * s2], sc[8 * s2 + 1]); pw.y = pg8::cvt_pk_bf16(sc[8 * s2 + 2], sc[8 * s2 + 3]); pw.z = pg8::cvt_pk_bf16(sc[8 * s2 + 4], sc[8 * s2 + 5]); pw.w = pg8::cvt_pk_bf16(sc[8 * s2 + 6], sc[8 * s2 + 7]);
        const bf16x8 pf = __builtin_bit_cast(bf16x8, pw);
        const bf16x8 a0 = {vt[0][s2][0][0], vt[0][s2][0][1], vt[0][s2][0][2], vt[0][s2][0][3], vt[0][s2][1][0], vt[0][s2][1][1], vt[0][s2][1][2], vt[0][s2][1][3]};
        const bf16x8 a1 = {vt[1][s2][0][0], vt[1][s2][0][1], vt[1][s2][0][2], vt[1][s2][0][3], vt[1][s2][1][0], vt[1][s2][1][1], vt[1][s2][1][2], vt[1][s2][1][3]};
        st.o0 = __builtin_amdgcn_mfma_f32_32x32x16_bf16(a0, pf, st.o0, 0, 0, 0);
        st.o1 = __builtin_amdgcn_mfma_f32_32x32x16_bf16(a1, pf, st.o1, 0, 0, 0);
    }
}
__device__ __forceinline__ void moba_unit(LAS unsigned char* lds, int unit, int tid, int l) {
    const int ob = unit & 7, h = (unit >> 3) & 7, b = unit >> 6, lane = tid & 63, wave = __builtin_amdgcn_readfirstlane(tid >> 6), r32 = lane & 31, hh = lane >> 5;
    LAS float* biasT = (LAS float*)lds;
    build_bias(biasT, 8 + h, tid);
    const bf16* PROJ = (const bf16*)(wsp() + WS_PROJ); const float* KBAR = (const float*)(wsp() + CTL_KBAR) + (size_t)l * 64 * 8 * 64 + ((b * NH + h) * 8) * 64; const LAS int* TB = (const LAS int*)(biasT + 2048);
    const int rowb = b * SEQ, qpos = 256 * ob + 32 * wave + r32;
    bf16x8 qf[4]; attn_loadq(qf, PROJ + CC_Q + 64 * h, rowb + qpos, hh);
    float gate[8];
#pragma unroll
    for (int n = 0; n < 8; ++n) { float s = 0.f;
        if (n < ob) {
#pragma unroll
            for (int s4 = 0; s4 < 4; ++s4) { const f32x4 k0 = *(const GAS f32x4*)(KBAR + n * 64 + 16 * s4 + 8 * hh), k1 = *(const GAS f32x4*)(KBAR + n * 64 + 16 * s4 + 8 * hh + 4);
                const v4u qw = __builtin_bit_cast(v4u, qf[s4]);
                s += bflo(qw.x) * k0.x + bfhi(qw.x) * k0.y + bflo(qw.y) * k0.z + bfhi(qw.y) * k0.w + bflo(qw.z) * k1.x + bfhi(qw.z) * k1.y + bflo(qw.w) * k1.z + bfhi(qw.w) * k1.w; }
            s += __shfl_xor(s, 32); }
        gate[n] = s; }
    unsigned selm = 0u;
#pragma unroll
    for (int n = 0; n < 8; ++n) { int rank = 0;
#pragma unroll
        for (int n2 = 0; n2 < 8; ++n2) rank += (n2 < ob && n2 != n && (gate[n2] > gate[n] || (gate[n2] == gate[n] && n2 < n))) ? 1 : 0;
        if (n < ob && rank < 3) selm |= 1u << n; }
    AttnSt st; attn_init(st);
    const int skey = tid >> 2, spart = tid & 3;
    const bf16* Kg = PROJ + (size_t)rowb * NPROJ_P + CC_K + 64 * h + 16 * spart; const bf16* Vg = PROJ + (size_t)rowb * NPROJ_P + CC_V + 64 * h + 16 * spart;
    bf16x8 gk0, gk1, gv0, gv1;
#define MC_GLOAD(i) do { const size_t ro_ = (size_t)(128 * (i) + skey) * NPROJ_P; gk0 = *(const GAS bf16x8*)(Kg + ro_); gk1 = *(const GAS bf16x8*)(Kg + ro_ + 8); gv0 = *(const GAS bf16x8*)(Vg + ro_); gv1 = *(const GAS bf16x8*)(Vg + ro_ + 8); } while (0)
#define MC_LSTORE(bf) do { LAS unsigned char* kd_ = lds + MC_K_OFF + (bf) * MC_KB + skey * MC_KP + 32 * spart; *(LAS bf16x8*)(kd_) = gk0; *(LAS bf16x8*)(kd_ + 16) = gk1; \
        LAS unsigned char* vd_ = lds + MC_V_OFF + (bf) * MC_VB + skey * MC_VP + 32 * spart; *(LAS bf16x8*)(vd_) = gv0; *(LAS bf16x8*)(vd_ + 16) = gv1; } while (0)
    const int nst = 2 * (ob + 1);
    MC_GLOAD(0); MC_LSTORE(0);
    __syncthreads();
    for (int i = 0; i < nst; ++i) {
        if (i + 1 < nst) MC_GLOAD(i + 1);
        const int n = i >> 1, hf = i & 1; const bool own = n == ob, sel = own || ((selm >> n) & 1u);
        const LAS unsigned char* Kb = lds + MC_K_OFF + (i & 1) * MC_KB; const LAS unsigned char* Vb = lds + MC_V_OFF + (i & 1) * MC_VB;
        if (own) {
#pragma unroll 1
            for (int sub = 0; sub < 4; ++sub) { const int jt = 4 * hf + sub; if (jt > wave) break; const int dlo = 32 * wave - (32 * jt + 31);
                if (jt == wave) moba_tile<1>(st, qf, Kb + sub * 32 * MC_KP, Vb + sub * 32 * MC_VP, biasT, TB, dlo, true, lane, r32, hh);
                else moba_tile<0>(st, qf, Kb + sub * 32 * MC_KP, Vb + sub * 32 * MC_VP, biasT, TB, dlo, true, lane, r32, hh); }
        } else if (__ballot(sel) != 0ull) {
#pragma unroll 1
            for (int sub = 0; sub < 4; ++sub) { const int dlo = 256 * ob + 32 * wave - (256 * n + 128 * hf + 32 * sub + 31);
                moba_tile<2>(st, qf, Kb + sub * 32 * MC_KP, Vb + sub * 32 * MC_VP, biasT, TB, dlo, sel, lane, r32, hh); }
        }
        if (i + 1 < nst) MC_LSTORE((i + 1) & 1);
        __syncthreads();
    }
#undef MC_GLOAD
#undef MC_LSTORE
    const float lt = st.l + __shfl_xor(st.l, 32);
    attn_store(st.o0, st.o1, 1.0f / lt, (bf16*)(wsp() + WS_YCAT) + (size_t)(rowb + qpos) * DM + 2 * GW + 64 * h, hh);
}

constexpr int MA_PITCH = 144, MA_ML_OFF = 512 * MA_PITCH, MA_BIAS_OFF = MA_ML_OFF + 512 * 8, MA_V_OFF = MA_BIAS_OFF + 16384, MA_VW = 32 * MC_VP, MA_LDS = MA_V_OFF + 8 * MA_VW;
template <bool MASKED> __device__ __forceinline__ void dil_tile(AttnSt& st, const bf16x8 (&qf)[4], const bf16x8 (&kf)[4], const LAS unsigned char* Vt, const LAS float* biasT, const LAS int* TB, int dl0, int dstep, int kb, int lane, int r32, int hh) {
    v4i16_t vt[2][2][2];
    { const LAS unsigned char* vb = Vt + (4 * hh + ((lane & 15) >> 2)) * MC_VP + (16 * ((lane >> 4) & 1) + 4 * (lane & 3)) * 2;
#pragma unroll
      for (int dh = 0; dh < 2; ++dh)
#pragma unroll
        for (int s2 = 0; s2 < 2; ++s2)
#pragma unroll
            for (int h8 = 0; h8 < 2; ++h8) vt[dh][s2][h8] = __builtin_amdgcn_ds_read_tr16_b64_v4i16((LAS v4i16_t*)(vb + (16 * s2 + 8 * h8) * MC_VP + 64 * dh)); }
    f32x16 sc;
#pragma unroll
    for (int i = 0; i < 16; ++i) sc[i] = 0.f;
#pragma unroll
    for (int s = 0; s < 4; ++s) sc = __builtin_amdgcn_mfma_f32_32x32x16_bf16(kf[s], qf[s], sc, 0, 0, 0);
    const int e0 = dl0 + r32 - 4 * hh;
    int dmin = (dl0 - 31) * dstep, dmax = (dl0 + 31) * dstep; dmin = dmin < 0 ? 0 : dmin; dmax = dmax > 2047 ? 2047 : dmax;
    const bool uni = __builtin_amdgcn_readfirstlane(TB[dmin]) == __builtin_amdgcn_readfirstlane(TB[dmax]);
    const float bu = biasT[dmin];
    float tmax = -INFINITY;
#pragma unroll
    for (int r = 0; r < 16; ++r) {
        const int kr0 = (r & 3) + 8 * (r >> 2), delta = e0 - kr0;
        float bias = bu;
        if (!uni) { int di = delta * dstep; di = di < 0 ? 0 : (di > 2047 ? 2047 : di); bias = biasT[di]; }
        float v = sc[r] * (0.125f * LOG2E) + bias;
        if (MASKED) { const bool ok = delta >= 0 && delta <= 128 && (kb + (kr0 + 4 * hh) * dstep) >= 0; v = ok ? v : -INFINITY; }
        sc[r] = v; tmax = fmaxf(tmax, v);
    }
    tmax = pl32_max(tmax);
    const float mn = fmaxf(st.m, tmax);
    if (__ballot(mn > st.m) != 0ull) { const float scale = __builtin_amdgcn_exp2f(st.m - mn); st.l *= scale;
#pragma unroll
        for (int i = 0; i < 16; ++i) { st.o0[i] *= scale; st.o1[i] *= scale; } }
    st.m = mn;
    float ls = 0.f;
#pragma unroll
    for (int r = 0; r < 16; ++r) { sc[r] = __builtin_amdgcn_exp2f(sc[r] - mn); ls += sc[r]; }
    st.l += ls;
    typedef unsigned u32x4_t __attribute__((ext_vector_type(4)));
#pragma unroll
    for (int s2 = 0; s2 < 2; ++s2) {
        u32x4_t pw; pw.x = pg8::cvt_pk_bf16(sc[8 * s2], sc[8 * s2 + 1]); pw.y = pg8::cvt_pk_bf16(sc[8 * s2 + 2], sc[8 * s2 + 3]); pw.z = pg8::cvt_pk_bf16(sc[8 * s2 + 4], sc[8 * s2 + 5]); pw.w = pg8::cvt_pk_bf16(sc[8 * s2 + 6], sc[8 * s2 + 7]);
        const bf16x8 pf = __builtin_bit_cast(bf16x8, pw);
        const bf16x8 a0 = {vt[0][s2][0][0], vt[0][s2][0][1], vt[0][s2][0][2], vt[0][s2][0][3], vt[0][s2][1][0], vt[0][s2][1][1], vt[0][s2][1][2], vt[0][s2][1][3]};
        const bf16x8 a1 = {vt[1][s2][0][0], vt[1][s2][0][1], vt[1][s2][0][2], vt[1][s2][0][3], vt[1][s2][1][0], vt[1][s2][1][1], vt[1][s2][1][2], vt[1][s2][1][3]};
        st.o0 = __builtin_amdgcn_mfma_f32_32x32x16_bf16(a0, pf, st.o0, 0, 0, 0);
        st.o1 = __builtin_amdgcn_mfma_f32_32x32x16_bf16(a1, pf, st.o1, 0, 0, 0);
    }
}
__device__ __forceinline__ void dil_unit(LAS unsigned char* lds, int unit, int tid) {
    const int sp = unit & 3, h = (unit >> 2) & 7, b = unit >> 5, lane = tid & 63, wave = __builtin_amdgcn_readfirstlane(tid >> 6), r32 = lane & 31, hh = lane >> 5;
    LAS float* biasT = (LAS float*)(lds + MA_BIAS_OFF);
    build_bias(biasT, h, tid);
    __syncthreads();
    const bf16* PROJ = (const bf16*)(wsp() + WS_PROJ); const LAS int* TB = (const LAS int*)(biasT + 2048); const int rowb = b * SEQ, t0 = 512 * sp;
    const bf16* Qc = PROJ + CA_Q + 64 * h; const bf16* Kc = PROJ + CA_K + 64 * h; const bf16* Vc = PROJ + CA_V + 64 * h;
    LAS unsigned char* Vst = lds + MA_V_OFF + wave * MA_VW;
    const int vkey = lane >> 1, vhalf = lane & 1;
#pragma unroll 1
    for (int p = 0; p < 3; ++p) {
        const int d = p == 0 ? 1 : (p == 1 ? 4 : 16);
#pragma unroll 1
        for (int gi = 0; gi < 2; ++gi) {
            const int g = 2 * wave + gi;
            const int qb = t0 + (p == 0 ? 32 * g : (p == 1 ? 128 * (g >> 2) + (g & 3) : g));
            const int qpos = qb + r32 * d, qi = qpos - t0;
            bf16x8 qf[4]; attn_loadq(qf, Qc, rowb + qpos, hh);
            AttnSt st; attn_init(st);
            int jt = 0; while (qb + (32 * jt - 128 + 31) * d < 0) ++jt;
            bf16x8 kfn[4], vrn[4];
#define MA_GLOAD(JT) do { const int kb_ = qb + (32 * (JT) - 128) * d; int kp_ = kb_ + r32 * d; kp_ = kp_ < 0 ? 0 : kp_; const bf16* kr_ = Kc + (size_t)(rowb + kp_) * NPROJ_P + 8 * hh; \
                _Pragma("unroll") for (int s = 0; s < 4; ++s) kfn[s] = *(const GAS bf16x8*)(kr_ + 16 * s); \
                int vp_ = kb_ + vkey * d; vp_ = vp_ < 0 ? 0 : vp_; const bf16* vr_ = Vc + (size_t)(rowb + vp_) * NPROJ_P + 32 * vhalf; \
                _Pragma("unroll") for (int s = 0; s < 4; ++s) vrn[s] = *(const GAS bf16x8*)(vr_ + 8 * s); } while (0)
            MA_GLOAD(jt);
#pragma unroll 1
            for (; jt < 5; ++jt) {
                bf16x8 kf[4] = {kfn[0], kfn[1], kfn[2], kfn[3]};
                { LAS unsigned char* vd = Vst + vkey * MC_VP + 64 * vhalf;
#pragma unroll
                  for (int s = 0; s < 4; ++s) *(LAS bf16x8*)(vd + 16 * s) = vrn[s]; }
                asm volatile("" ::: "memory");
                if (jt + 1 < 5) MA_GLOAD(jt + 1);
                const int kb = qb + (32 * jt - 128) * d, dl0 = 128 - 32 * jt;
                if (jt == 0 || jt == 4 || kb < 0) dil_tile<true>(st, qf, kf, Vst, biasT, TB, dl0, d, kb, lane, r32, hh);
                else dil_tile<false>(st, qf, kf, Vst, biasT, TB, dl0, d, kb, lane, r32, hh);
            }
#undef MA_GLOAD
            float lt = st.l + __shfl_xor(st.l, 32);
            LAS unsigned char* orow = lds + qi * MA_PITCH; LAS float* ml = (LAS float*)(lds + MA_ML_OFF + qi * 8);
            if (p > 0) {
                const float mo = ml[0], lo = ml[1], mn = fmaxf(mo, st.m), fo = __builtin_amdgcn_exp2f(mo - mn), fc = __builtin_amdgcn_exp2f(st.m - mn);
                lt = lo * fo + lt * fc;
#pragma unroll
                for (int g4 = 0; g4 < 4; ++g4) { const v2u a = *(const LAS v2u*)(orow + 2 * (8 * g4 + 4 * hh)), c = *(const LAS v2u*)(orow + 64 + 2 * (8 * g4 + 4 * hh));
                    const float av[4] = {bflo(a.x), bfhi(a.x), bflo(a.y), bfhi(a.y)}, cv[4] = {bflo(c.x), bfhi(c.x), bflo(c.y), bfhi(c.y)};
#pragma unroll
                    for (int e = 0; e < 4; ++e) { st.o0[4 * g4 + e] = av[e] * fo + st.o0[4 * g4 + e] * fc; st.o1[4 * g4 + e] = cv[e] * fo + st.o1[4 * g4 + e] * fc; } }
                st.m = mn;
            }
            if (p < 2) {
#pragma unroll
                for (int g4 = 0; g4 < 4; ++g4) { *(LAS v2u*)(orow + 2 * (8 * g4 + 4 * hh)) = (v2u){pk2(st.o0[4 * g4], st.o0[4 * g4 + 1]), pk2(st.o0[4 * g4 + 2], st.o0[4 * g4 + 3])};
                    *(LAS v2u*)(orow + 64 + 2 * (8 * g4 + 4 * hh)) = (v2u){pk2(st.o1[4 * g4], st.o1[4 * g4 + 1]), pk2(st.o1[4 * g4 + 2], st.o1[4 * g4 + 3])}; }
                if (hh == 0) { ml[0] = st.m; ml[1] = lt; }
            } else attn_store(st.o0, st.o1, 1.0f / lt, (bf16*)(wsp() + WS_YCAT) + (size_t)(rowb + qpos) * DM + 0 * GW + 64 * h, hh);
        }
        __syncthreads();
    }
}

constexpr int SG_PITCH = 144, SG_WAVE = 128 * SG_PITCH, SG_OP = 272;
static_assert(8 * SG_WAVE <= MISC_OFF && 32 * SG_OP <= SG_WAVE, "SGU LDS");
__device__ __forceinline__ void sgu_unit(LAS unsigned char* lds, int unit, int tid, int l) {
    const int lane = tid & 63, g = __builtin_amdgcn_readfirstlane(tid >> 6), r32 = lane & 31, hh = lane >> 5, m0 = unit * 128;
    const bf16* PROJ = (const bf16*)(wsp() + WS_PROJ); bf16* YC = (bf16*)(wsp() + WS_YCAT); const pg8::fx_t* ST = (const pg8::fx_t*)(wsp() + CTL_STATS) + (size_t)l * M * 2;
    const float* lng = inp(4) + l * GW; const float* sw = inp(5) + ((size_t)l * NH + g) * 128 * 128; const float* sb = inp(6) + (l * NH + g) * 128;
    LAS unsigned char* T = lds + g * SG_WAVE;
    const int tk8 = lane >> 3, part = lane & 7;
    { const f32x4 g0 = *(const GAS f32x4*)(lng + 64 * g + 8 * part), g1 = *(const GAS f32x4*)(lng + 64 * g + 8 * part + 4);
      const float gn[8] = {g0.x, g0.y, g0.z, g0.w, g1.x, g1.y, g1.z, g1.w};
#pragma unroll 4
      for (int i = 0; i < 16; ++i) { const int tkn = tk8 + 8 * i, mm = m0 + tkn;
          const v4u w = *(const GAS v4u*)(PROJ + (size_t)mm * NPROJ_P + CB_V + 64 * g + 8 * part);
          const float mu = pg8::fx_get(ST + 2 * mm) * (1.0f / 512.0f), rs = __builtin_amdgcn_rsqf(fmaxf(pg8::fx_get(ST + 2 * mm + 1) * (1.0f / 512.0f) - mu * mu, 0.f) + 1e-5f);
          float x[8] = {bflo(w.x), bfhi(w.x), bflo(w.y), bfhi(w.y), bflo(w.z), bfhi(w.z), bflo(w.w), bfhi(w.w)};
#pragma unroll
          for (int e = 0; e < 8; ++e) x[e] = (gelu_tanh(x[e]) - mu) * rs * gn[e];
          *(LAS v4u*)(T + tkn * SG_PITCH + 16 * part) = (v4u){pk2(x[0], x[1]), pk2(x[2], x[3]), pk2(x[4], x[5]), pk2(x[6], x[7])}; } }
    asm volatile("" ::: "memory");
    f32x16 acc[4][2];
#pragma unroll
    for (int tt = 0; tt < 4; ++tt)
#pragma unroll
        for (int ct = 0; ct < 2; ++ct)
#pragma unroll
            for (int i = 0; i < 16; ++i) acc[tt][ct][i] = 0.f;
    const LAS unsigned char* vb = T + (8 * hh + ((lane & 15) >> 2)) * SG_PITCH + (16 * ((lane >> 4) & 1) + 4 * (lane & 3)) * 2;
#pragma unroll
    for (int k = 0; k < 8; ++k) {
        v4i16_t t00 = __builtin_amdgcn_ds_read_tr16_b64_v4i16((LAS v4i16_t*)(vb + (16 * k) * SG_PITCH)), t01 = __builtin_amdgcn_ds_read_tr16_b64_v4i16((LAS v4i16_t*)(vb + (16 * k + 4) * SG_PITCH));
        v4i16_t t10 = __builtin_amdgcn_ds_read_tr16_b64_v4i16((LAS v4i16_t*)(vb + (16 * k) * SG_PITCH + 64)), t11 = __builtin_amdgcn_ds_read_tr16_b64_v4i16((LAS v4i16_t*)(vb + (16 * k + 4) * SG_PITCH + 64));
        const bf16x8 af0 = {t00[0], t00[1], t00[2], t00[3], t01[0], t01[1], t01[2], t01[3]}, af1 = {t10[0], t10[1], t10[2], t10[3], t11[0], t11[1], t11[2], t11[3]};
#pragma unroll
        for (int tt = 0; tt < 4; ++tt) { if (k < 2 * (tt + 1)) {
                const int t = 32 * tt + r32, s0 = 16 * k + 8 * hh; const float* wrow = sw + (size_t)t * 128 + s0;
                const f32x4 w0 = *(const GAS f32x4*)(wrow), w1 = *(const GAS f32x4*)(wrow + 4);
                float wv[8] = {w0.x, w0.y, w0.z, w0.w, w1.x, w1.y, w1.z, w1.w};
#pragma unroll
                for (int j = 0; j < 8; ++j) wv[j] = (s0 + j <= t) ? wv[j] : 0.f;
                const v4u bw = {pk2(wv[0], wv[1]), pk2(wv[2], wv[3]), pk2(wv[4], wv[5]), pk2(wv[6], wv[7])}; const bf16x8 bfr = __builtin_bit_cast(bf16x8, bw);
                acc[tt][0] = __builtin_amdgcn_mfma_f32_32x32x16_bf16(af0, bfr, acc[tt][0], 0, 0, 0); acc[tt][1] = __builtin_amdgcn_mfma_f32_32x32x16_bf16(af1, bfr, acc[tt][1], 0, 0, 0); } }
    }
    asm volatile("" ::: "memory");
#pragma unroll
    for (int tt = 0; tt < 4; ++tt) {
        const float bias = sb[32 * tt + r32];
#pragma unroll
        for (int ct = 0; ct < 2; ++ct)
#pragma unroll
            for (int g4 = 0; g4 < 4; ++g4) { const f32x16& a = acc[tt][ct];
                *(LAS f32x4*)(T + r32 * SG_OP + 4 * (32 * ct + 8 * g4 + 4 * hh)) = (f32x4){a[4 * g4] + bias, a[4 * g4 + 1] + bias, a[4 * g4 + 2] + bias, a[4 * g4 + 3] + bias}; }
        asm volatile("" ::: "memory");
#pragma unroll
        for (int i = 0; i < 4; ++i) { const int tkn = tk8 + 8 * i, mm = m0 + 32 * tt + tkn;
            const v4u uw = *(const GAS v4u*)(PROJ + (size_t)mm * NPROJ_P + CB_U + 64 * g + 8 * part);
            const f32x4 x0 = *(const LAS f32x4*)(T + tkn * SG_OP + 32 * part), x1 = *(const LAS f32x4*)(T + tkn * SG_OP + 32 * part + 16);
            const float u[8] = {bflo(uw.x), bfhi(uw.x), bflo(uw.y), bfhi(uw.y), bflo(uw.z), bfhi(uw.z), bflo(uw.w), bfhi(uw.w)};
            *(GAS v4u*)(YC + (size_t)mm * DM + GW + 64 * g + 8 * part) = (v4u){pk2(gelu_tanh(u[0]) * x0.x, gelu_tanh(u[1]) * x0.y), pk2(gelu_tanh(u[2]) * x0.z, gelu_tanh(u[3]) * x0.w), pk2(gelu_tanh(u[4]) * x1.x, gelu_tanh(u[5]) * x1.y), pk2(gelu_tanh(u[6]) * x1.z, gelu_tanh(u[7]) * x1.w)}; }
        asm volatile("" ::: "memory");
    }
}

#ifndef SIMPLE_A
#define SIMPLE_A 0
#endif
#ifndef SIMPLE_B
#define SIMPLE_B 0
#endif
#ifndef SIMPLE_C
#define SIMPLE_C 0
#endif
#ifndef SIMPLE_D
#define SIMPLE_D 0
#endif
__device__ __forceinline__ void ph_mixers(LAS unsigned char* L, int l, int phase, int qoff, int mask = 31) {
    Frame F = mkframe(L);
    volatile LAS int* qslot = (volatile LAS int*)(L + MISC_OFF + 64);
    gu32* ctr = ctlp() + CW_Q + 64 * phase + qoff;
    constexpr int I_IN = (DM / 64) * (NPROJ / 32), I_REST = (DM / 64) * (DM / 32) + 2 * (DM / 64) * (DFF / 32) + (DFF / 64) * (DM / 32);
    const int n_scan = (SIMPLE_D || !(mask & 1)) ? 0 : 128, n_c = (SIMPLE_C || !(mask & 2)) ? 0 : 512, n_a = (SIMPLE_A || !(mask & 4)) ? 0 : 256, n_b = (SIMPLE_B || !(mask & 8)) ? 0 : 128;
    const int n_cin = ((l + 1 < DEPTH) && (mask & 16)) ? (I_IN + 7) / 8 : 0, n_crest = (mask & 16) ? (I_REST + 7) / 8 : 0;
    const int e_scan = n_scan, e_a = e_scan + n_a, e_b = e_a + n_b, e_c = e_b + n_c, e_cin = e_c + n_cin, e_crest = e_cin + n_crest;
    for (;;) {
        if (F.tid == 0) *qslot = (int)__hip_atomic_fetch_add(ctr, 1u, RLX_AGENT);
        __syncthreads();
        const int it = __builtin_amdgcn_readfirstlane(*qslot);
        __syncthreads();
        if (it >= e_crest) break;
        int tid = threadIdx.x; asm volatile("" : "+v"(tid));
        if (it < e_scan) scan_unit(L, it, tid);
        else if (it < e_a) dil_unit(L, it - e_scan, tid);
        else if (it < e_b) { sgu_unit(L, it - e_a, tid, l); __syncthreads(); }
        else if (it < e_c) { const int i2 = it - e_b; moba_unit(L, (i2 & 63) * 8 + (7 - (i2 >> 6)), tid, l); }
        else if (it < e_cin) { Frame F2 = mkframe(L); conv_layer_items(F2, l + 1, (it - e_c) * 8 + F2.wave, 1 << 30, true, false); }
        else { Frame F2 = mkframe(L); conv_layer_items(F2, l, (it - e_cin) * 8 + F2.wave, 1 << 30, false, true); }
    }
    if (l + 1 < DEPTH) {
        bf16* WIN = (bf16*)(wsp() + WS_WIN);
        Frame F3 = mkframe(L);
        for (int i = F3.gw * 64 + F3.lane; i < 64 * DM / 8; i += F3.ngw * 64) { v4u z = {0u, 0u, 0u, 0u}; asm volatile("" : "+v"(z)); *(GAS v4u*)(WIN + (size_t)NPROJ * DM + (size_t)i * 8) = z; }
    }
    if (SIMPLE_D) mix_d_simple(F);
    if (SIMPLE_A) mix_a_simple(F);
    if (SIMPLE_C) mix_c_simple(F, l);
    if (SIMPLE_B) mix_b_simple(F, l);
}

__device__ __forceinline__ void ph_finalize(Frame& F, int l) {
    bf16* YC = (bf16*)(wsp() + WS_YCAT); const float* YD = (const float*)(wsp() + WS_YD); const bf16* V_ = (const bf16*)outp() + (size_t)3 * M * GW; const bf16* G_ = (const bf16*)(wsp() + WS_G); const float* BC = (const float*)(wsp() + WS_BC);
    const float* lng = inp(16) + l * GW; const float* lnb = inp(17) + l * GW;
    for (int m = F.gw; m < M; m += F.ngw) {
        const int c0 = 8 * F.lane, hd = F.lane >> 3;
        float y[8];
        { const GAS f32x4* yp = (const GAS f32x4*)(YD + (size_t)m * GW + c0); const f32x4 a = yp[0], b = yp[1]; y[0] = a.x; y[1] = a.y; y[2] = a.z; y[3] = a.w; y[4] = b.x; y[5] = b.y; y[6] = b.z; y[7] = b.w; }
        float s = 0.f;
#pragma unroll
        for (int i = 0; i < 8; ++i) s += y[i];
        s += __shfl_xor(s, 1); s += __shfl_xor(s, 2); s += __shfl_xor(s, 4); const float mean = s * (1.0f / 64.0f); float q = 0.f;
#pragma unroll
        for (int i = 0; i < 8; ++i) { const float d = y[i] - mean; q += d * d; }
        q += __shfl_xor(q, 1); q += __shfl_xor(q, 2); q += __shfl_xor(q, 4); const float rstd = 1.0f / sqrtf(q * (1.0f / 64.0f) + 64e-5f);
        const v4u vw = *(const GAS v4u*)(V_ + (size_t)m * GW + c0), gw4 = *(const GAS v4u*)(G_ + (size_t)m * GW + c0); const float bc = BC[(size_t)m * NH + hd];
        float vv[8], gg[8]; UNPACK8(vv, 0, vw); UNPACK8(gg, 0, gw4);
        float ss = 0.f;
#pragma unroll
        for (int i = 0; i < 8; ++i) { y[i] = ((y[i] - mean) * rstd * lng[c0 + i] + lnb[c0 + i] + bc * vv[i]) * gg[i]; ss += y[i] * y[i]; }
        { const float rs = 1.0f / sqrtf(wave_sum(ss) * (1.0f / 512.0f) + NORM_EPS);
          *(GAS v4u*)(YC + (size_t)m * DM + 3 * GW + c0) = (v4u){pk2(y[0] * rs, y[1] * rs), pk2(y[2] * rs, y[3] * rs), pk2(y[4] * rs, y[5] * rs), pk2(y[6] * rs, y[7] * rs)}; }
#pragma unroll
        for (int br = 0; br < 3; ++br) {
            GAS v4u* p = (GAS v4u*)(YC + (size_t)m * DM + br * GW + c0); const v4u w = *p;
            float x[8]; UNPACK8(x, 0, w); float s2 = 0.f;
#pragma unroll
            for (int i = 0; i < 8; ++i) s2 += x[i] * x[i];
            const float rs = 1.0f / sqrtf(wave_sum(s2) * (1.0f / 512.0f) + NORM_EPS);
            *p = (v4u){pk2(x[0] * rs, x[1] * rs), pk2(x[2] * rs, x[3] * rs), pk2(x[4] * rs, x[5] * rs), pk2(x[6] * rs, x[7] * rs)};
        }
    }
}
__device__ __forceinline__ void ph_final(Frame& F) {
    const pg8::fx_t* ssq = (const pg8::fx_t*)(ctlp() + CW_SSQ) + 4 * M; const float* g = inp(24); float* out = outp(); const bf16* XB = (const bf16*)(wsp() + WS_XB);
    for (int m = F.gw; m < M; m += F.ngw) {
        const float rs = 1.0f / sqrtf(pg8::fx_get(ssq + m) * (1.0f / 2048.0f) + NORM_EPS); GAS f32x4* orow = (GAS f32x4*)(out + (size_t)m * DM); const GAS v4u* xr = (const GAS v4u*)(XB + (size_t)m * DM) + F.lane; const GAS f32x4* gp = (const GAS f32x4*)g;
#pragma unroll
        for (int j = 0; j < 4; ++j) { const v4u w = xr[64 * j]; const int c4 = 2 * (F.lane + 64 * j); const f32x4 g0 = gp[c4], g1 = gp[c4 + 1];
            orow[c4] = (f32x4){bflo(w.x) * rs * g0.x, bfhi(w.x) * rs * g0.y, bflo(w.y) * rs * g0.z, bfhi(w.y) * rs * g0.w};
            orow[c4 + 1] = (f32x4){bflo(w.z) * rs * g1.x, bfhi(w.z) * rs * g1.y, bflo(w.w) * rs * g1.z, bfhi(w.w) * rs * g1.w}; }
    }
}

__global__ void __launch_bounds__(NTHR, 2) hy_fwd(Args args) {
    extern __shared__ __attribute__((aligned(16))) unsigned char lds[];
    LAS unsigned char* L = (LAS unsigned char*)lds;
    volatile LAS unsigned* MISC = (volatile LAS unsigned*)(L + MISC_OFF);
    if (threadIdx.x < 64) MISC[threadIdx.x] = 0u;
    __syncthreads();
    XcdBarrier bar; bar.bar = (unsigned*)(ctlp() + CW_BAR); bar.x = 0; bar.st = nullptr;
    if (N_LAUNCH_MODE == 0) bar = xcd_barrier_post((unsigned*)(ctlp() + CW_BAR), MISC + 8);
    const int lo = args.ph_lo, hi = args.ph_hi;
#define IN(k) (lo <= (k) && (k) < hi)
#define SEAM(k) do { if (IN(k) && IN((k) + 1)) xcd_barrier(bar); } while (0)
    if (IN(0)) { Frame F = mkframe(L); ph_prologue(F); if (REPEAT == 1) ph_prologue(F); }
    SEAM(0);
    for (int l = 0; l < DEPTH; ++l) {
        const int P = 1 + 7 * l;
        if (IN(P)) {
            unsigned char* ws = wsp(); pg8::Gemm g{(const bf16*)(ws + WS_XB), (const bf16*)(ws + WS_WIN), M, NPROJ_P, DM}; pg8::StaticOrder S; S.init(M, NPROJ_P, gridDim.x, (int)blockIdx.x);
            pg8::EpiProj E{(bf16*)(ws + WS_PROJ), NPROJ_P, (const pg8::fx_t*)((gu32*)ws + CW_SSQ) + (size_t)(2 * l) * M, (float*)(ws + CTL_KBAR) + (size_t)l * 64 * 8 * 64, (pg8::fx_t*)(ws + CTL_STATS) + (size_t)l * M * 2};
            pg8::gemm_phase<pg8::EpiProj, pg8::StaticOrder, true, PG8_SP2>(L + RING_OFF, g, S, E);
            if (REPEAT == 2) pg8::gemm_phase<pg8::EpiProj, pg8::StaticOrder, true, PG8_SP2>(L + RING_OFF, g, S, E);
        }
        SEAM(P);
        if (IN(P + 1)) { Frame F = mkframe(L); ph_prep(F, l); if (REPEAT == 3) ph_prep(F, l); }
        SEAM(P + 1);
        if (IN(P + 2)) { ph_mixers(L, l, P + 2, 0); if (REPEAT == 4) ph_mixers(L, l, P + 2, 32); if (REPEAT >= 40 && REPEAT < 50) ph_mixers(L, l, P + 2, 32, REPEAT == 41 ? 1 : (REPEAT == 42 ? 2 : (REPEAT == 43 ? 4 : (REPEAT == 44 ? 8 : 16)))); if (REPEAT >= 430 && REPEAT < 446) ph_mixers(L, l, P + 2, 32, 4); }
        SEAM(P + 2);
        if (IN(P + 3)) { Frame F = mkframe(L); ph_finalize(F, l); if (REPEAT == 5) ph_finalize(F, l); }
        SEAM(P + 3);
        if (IN(P + 4)) {
            unsigned char* ws = wsp(); pg8::Gemm g{(const bf16*)(ws + WS_YCAT), (const bf16*)(ws + WS_WOUT), M, DM, DM}; pg8::StaticOrder S; S.init(M, DM, gridDim.x, (int)blockIdx.x);
            pg8::EpiRes E{(bf16*)(ws + WS_XB), (pg8::fx_t*)((gu32*)ws + CW_SSQ) + (size_t)(2 * l + 1) * M, DM};
            pg8::gemm_phase<pg8::EpiRes, pg8::StaticOrder, true, PG8_SP2>(L + RING_OFF, g, S, E);
        }
        SEAM(P + 4);
        if (IN(P + 5)) {
            unsigned char* ws = wsp(); pg8::Gemm g{(const bf16*)(ws + WS_XB), (const bf16*)(ws + WS_WGU), M, 2 * DFF, DM}; pg8::StaticOrder S; S.init(M, 2 * DFF, gridDim.x, (int)blockIdx.x);
            pg8::EpiGU E{(bf16*)(ws + WS_PROJ), DFF, (const pg8::fx_t*)((gu32*)ws + CW_SSQ) + (size_t)(2 * l + 1) * M};
            pg8::gemm_phase<pg8::EpiGU, pg8::StaticOrder, true, PG8_SP2>(L + RING_OFF, g, S, E);
            if (REPEAT == 6) pg8::gemm_phase<pg8::EpiGU, pg8::StaticOrder, true, PG8_SP2>(L + RING_OFF, g, S, E);
        }
        SEAM(P + 5);
        if (IN(P + 6)) {
            unsigned char* ws = wsp(); pg8::Gemm g{(const bf16*)(ws + WS_PROJ), (const bf16*)(ws + WS_WDN), M, DM, DFF}; pg8::StaticOrder S; S.init(M, DM, gridDim.x, (int)blockIdx.x);
            pg8::EpiRes E{(bf16*)(ws + WS_XB), (pg8::fx_t*)((gu32*)ws + CW_SSQ) + (size_t)(2 * l + 2) * M, DM};
            pg8::gemm_phase<pg8::EpiRes, pg8::StaticOrder, true, PG8_SP2>(L + RING_OFF, g, S, E);
        }
        SEAM(P + 6);
    }
    if (IN(15)) { Frame F = mkframe(L); ph_final(F); }
#undef IN
#undef SEAM
}

extern "C" void kernel_launch(void* const* d_in, const int* in_sizes, int n_in, void* d_out, int out_size, void* d_ws, size_t ws_size, hipStream_t stream) {
    static int grid = 0;
    if (grid == 0) {
        if (n_in != 25 || in_sizes[0] != M * DM || out_size != M * DM || ws_size < WS_END) { fprintf(stderr, "kernel_launch: shape/workspace mismatch: n_in %d in0 %d out %d ws %zu (need %zu)\n", n_in, n_in > 0 ? in_sizes[0] : -1, out_size, ws_size, (size_t)WS_END); grid = -1; return; }
        int dev = 0, cus = 0, per_cu = 0;
        if (hipGetDevice(&dev) != hipSuccess || hipDeviceGetAttribute(&cus, hipDeviceAttributeMultiprocessorCount, dev) != hipSuccess) { grid = -1; return; }
        if (hipFuncSetAttribute((const void*)hy_fwd, hipFuncAttributeMaxDynamicSharedMemorySize, LDS_BYTES) != hipSuccess) { fprintf(stderr, "kernel_launch: hipFuncSetAttribute failed\n"); grid = -1; return; }
        if (hipOccupancyMaxActiveBlocksPerMultiprocessor(&per_cu, (const void*)hy_fwd, NTHR, LDS_BYTES) != hipSuccess || per_cu < 1) fprintf(stderr, "kernel_launch: occupancy query reports %d\n", per_cu);
        (void)hipGetLastError();
        grid = cus;
    }
    if (grid < 0) return;
    if (hipMemsetAsync((char*)d_ws + WS_CTL, 0, CTL_ZERO_BYTES, stream) != hipSuccess) return;
    Args a{};
    for (int i = 0; i < 25; ++i) a.in[i] = (const float*)d_in[i];
    a.out = (float*)d_out; a.ws = (unsigned char*)d_ws;
    if (N_LAUNCH_MODE == 0) { a.ph_lo = 0; a.ph_hi = N_PHASES; hipLaunchKernelGGL(hy_fwd, dim3(grid), dim3(NTHR), LDS_BYTES, stream, a); }
    else for (int p = 0; p < N_PHASES; ++p) { a.ph_lo = p; a.ph_hi = p + 1; hipLaunchKernelGGL(hy_fwd, dim3(grid), dim3(NTHR), LDS_BYTES, stream, a); }
}
```

```cpp
#define N_LAUNCH_MODE 0
#define REPEAT 0
#define PG8_SP2 true
#define FFN_FP8 1
#include <hip/hip_runtime.h>
#include <cstdio>
#include <cstdint>
namespace pg8 {
#define PG8_LAS __attribute__((address_space(3)))
typedef unsigned short bf16_t;
typedef short bf16x8 __attribute__((ext_vector_type(8)));
typedef float f32x4 __attribute__((ext_vector_type(4)));
typedef unsigned u32x4 __attribute__((ext_vector_type(4)));
constexpr int BM = 256, BK = 64, HALF = 128, HTB = HALF * BK * 2  , STAGE_BYTES = 8 * HTB, NXCD = 8, WGM = 8;

__host__ __device__ __forceinline__ int lds_byte(int r, int c) { const int st = (r >> 4) * 2 + (c >> 5), rr = r & 15, cc = c & 31, ob = rr * 64 + cc * 2; return st * 1024 + (ob ^ (((ob >> 9) & 1) << 5)); }
__host__ __device__ __forceinline__ void stage_rc(int b, int& R, int& C) { const int st = b / 1024, sb = b % 1024, swz = sb ^ (((sb >> 9) & 1) << 5); R = (st >> 1) * 16 + swz / 64; C = (st & 1) * 32 + (swz % 64) / 2; }
__host__ __device__ __forceinline__ int perm32(int rho) { const int n = rho >> 4, i = rho & 15; return 8 * (i >> 2) + 4 * n + (i & 3); }

struct Unit { int pm, pn; };
struct Gemm { const bf16_t* A; const bf16_t* Bt; int M, N, K; };

struct StaticOrder {
    int nM, nN, nwg, G, c;
    __host__ __device__ void init(int M, int N, int G_, int c_) { nM = M / BM; nN = N / BM; nwg = nM * nN; G = G_; c = c_; }
    __host__ __device__ bool next(int i, Unit& u) const {
        const long L = (long)i * G + c; if (L >= nwg) return false;
        int wgid = (int)L; { const int q = nwg / NXCD, r = nwg % NXCD, xcd = wgid % NXCD, off = wgid / NXCD; wgid = (xcd < r ? xcd * (q + 1) : r * (q + 1) + (xcd - r) * q) + off; }
        const int nig = WGM * nN, gid = wgid / nig, fm = gid * WGM, gsz = (nM - fm) < WGM ? (nM - fm) : WGM;
        u.pm = fm + ((wgid % nig) % gsz); u.pn = (wgid % nig) / gsz; return true;
    }
    __device__ __forceinline__ void a_ready(const Unit&) const {}
    __device__ __forceinline__ void done(const Unit&) const {}
};

__device__ __forceinline__ unsigned cvt_pk_bf16(float lo, float hi) { unsigned r; asm volatile("v_cvt_pk_bf16_f32 %0, %1, %2" : "=v"(r) : "v"(lo), "v"(hi)); return r; }
typedef float f32x2 __attribute__((ext_vector_type(2)));

typedef unsigned u32x2 __attribute__((ext_vector_type(2)));
typedef unsigned long long fx_t;
__device__ __forceinline__ void fx_add(fx_t* p, float v) { atomicAdd(p, (fx_t)(long long)__float2ll_rn(v * 1073741824.0f)); }
__device__ __forceinline__ float fx_get(const fx_t* p) { return (float)(long long)(*p) * (1.0f / 1073741824.0f); }
__device__ __forceinline__ float epi_gelu(float x) { const float u = 0.7978845608028654f * (x + 0.044715f * x * x * x); const float e2 = __expf(2.0f * u); return 0.5f * x * (2.0f - 2.0f / (e2 + 1.0f)); }
template <int CTRL> __device__ __forceinline__ float epi_dpp_add(float x) { const int y = __builtin_amdgcn_update_dpp(0, __builtin_bit_cast(int, x), CTRL, 0xF, 0xF, false); return x + __builtin_bit_cast(float, y); }
struct EpiProj {
    static constexpr bool PERM = true, AFTER_DRAIN = false;
    bf16_t* O; int ldc; const fx_t* ssq; float* kbar; fx_t* stats;
    __device__ __forceinline__ void operator()(const f32x4 (&acc)[2][2][4][2], const Unit& u, int wr, int wc, int fr, int fq) const {
        const int row0 = u.pm * BM + wr * 64 + fr, col0 = u.pn * BM + wc * 32 + 8 * fq;
        const bool do_k = (u.pn == 12 || u.pn == 13), do_s = (u.pn == 8 || u.pn == 9);
        float cs[2][8];
#pragma unroll
        for (int bj = 0; bj < 2; ++bj)
#pragma unroll
            for (int e = 0; e < 8; ++e) cs[bj][e] = 0.f;
#pragma unroll
        for (int ai = 0; ai < 2; ++ai)
#pragma unroll
            for (int m = 0; m < 4; ++m) { const int row = row0 + ai * HALF + m * 16; const float rs = __builtin_amdgcn_rsqf(fx_get(ssq + row) * (1.0f / 2048.0f) + 1e-6f);
                bf16_t* rowp = O + (size_t)row * ldc + col0; float s1 = 0.f, s2 = 0.f;
#pragma unroll
                for (int bj = 0; bj < 2; ++bj) { const f32x4 v0 = acc[ai][bj][m][0] * rs, v1 = acc[ai][bj][m][1] * rs;
                    u32x4 w; w.x = cvt_pk_bf16(v0[0], v0[1]); w.y = cvt_pk_bf16(v0[2], v0[3]); w.z = cvt_pk_bf16(v1[0], v1[1]); w.w = cvt_pk_bf16(v1[2], v1[3]);
                    *(u32x4*)(rowp + bj * HALF) = w;
                    if (do_k) {
#pragma unroll
                        for (int e = 0; e < 4; ++e) { cs[bj][e] += v0[e]; cs[bj][4 + e] += v1[e]; } }
                    if (do_s) {
#pragma unroll
                        for (int e = 0; e < 4; ++e) { const float g0 = epi_gelu(v0[e]), g1 = epi_gelu(v1[e]); s1 += g0 + g1; s2 += g0 * g0 + g1 * g1; } } }
                if (do_s) { s1 += __shfl_xor(s1, 16); s1 += __shfl_xor(s1, 32); s2 += __shfl_xor(s2, 16); s2 += __shfl_xor(s2, 32);
                    if (fq == 0) { fx_add(stats + 2 * row, s1); fx_add(stats + 2 * row + 1, s2); } } }
        if (do_k) {
            const int bidx = (u.pm >> 3) * 8, n = u.pm & 7;
#pragma unroll
            for (int bj = 0; bj < 2; ++bj)
#pragma unroll
                for (int e = 0; e < 8; ++e) { float s = cs[bj][e]; s = epi_dpp_add<0xB1>(s); s = epi_dpp_add<0x4E>(s); s = epi_dpp_add<0x141>(s); s = epi_dpp_add<0x140>(s);
                    const int ck = col0 + bj * HALF + e - 3072;
                    if (fr == 0) unsafeAtomicAdd(kbar + ((bidx + (ck >> 6)) * 8 + n) * 64 + (ck & 63), s * (1.0f / 256.0f)); } }
    }
};
struct EpiGU {
    static constexpr bool PERM = true, AFTER_DRAIN = false;
    bf16_t* O; int ldc; const fx_t* ssq; float oscale;
    __device__ __forceinline__ void operator()(const f32x4 (&acc)[2][2][4][2], const Unit& u, int wr, int wc, int fr, int fq) const {
        const int row0 = u.pm * BM + wr * 64 + fr, col0 = u.pn * HALF + wc * 32 + 8 * fq;
#pragma unroll
        for (int ai = 0; ai < 2; ++ai)
#pragma unroll
            for (int m = 0; m < 4; ++m) { const int row = row0 + ai * HALF + m * 16; const float rs = __builtin_amdgcn_rsqf(fx_get(ssq + row) * (1.0f / 2048.0f) + 1e-6f) * oscale;
                float o[8];
#pragma unroll
                for (int n = 0; n < 2; ++n)
#pragma unroll
                    for (int e = 0; e < 4; ++e) { const float g = acc[ai][0][m][n][e] * rs, up = acc[ai][1][m][n][e] * rs;
                        o[n * 4 + e] = g * __builtin_amdgcn_rcpf(1.0f + __builtin_amdgcn_exp2f(-1.4426950408889634f * g)) * up; }
                u32x4 w; w.x = cvt_pk_bf16(o[0], o[1]); w.y = cvt_pk_bf16(o[2], o[3]); w.z = cvt_pk_bf16(o[4], o[5]); w.w = cvt_pk_bf16(o[6], o[7]);
                *(u32x4*)(O + (size_t)row * ldc + col0) = w; }
    }
};
struct EpiRes {
    static constexpr bool PERM = true, AFTER_DRAIN = false;
    bf16_t* xb; fx_t* ssq; int ldc; unsigned char* xf;
    __device__ __forceinline__ void operator()(const f32x4 (&acc)[2][2][4][2], const Unit& u, int wr, int wc, int fr, int fq) const {
        const int row0 = u.pm * BM + wr * 64 + fr, col0 = u.pn * BM + wc * 32 + 8 * fq;
#pragma unroll
        for (int ai = 0; ai < 2; ++ai)
#pragma unroll
            for (int m = 0; m < 4; ++m) { const int row = row0 + ai * HALF + m * 16; bf16_t* rowp = xb + (size_t)row * ldc + col0; float s = 0.f;
                u32x4 b[2];
#pragma unroll
                for (int bj = 0; bj < 2; ++bj) b[bj] = *(const u32x4*)(rowp + bj * HALF);
#pragma unroll
                for (int bj = 0; bj < 2; ++bj) { float o[8];
#pragma unroll
                    for (int q = 0; q < 4; ++q) { o[2 * q] = __builtin_bit_cast(float, b[bj][q] << 16) + acc[ai][bj][m][q >> 1][2 * (q & 1)]; o[2 * q + 1] = __builtin_bit_cast(float, b[bj][q] & 0xffff0000u) + acc[ai][bj][m][q >> 1][2 * (q & 1) + 1]; }
                    u32x4 w; w.x = cvt_pk_bf16(o[0], o[1]); w.y = cvt_pk_bf16(o[2], o[3]); w.z = cvt_pk_bf16(o[4], o[5]); w.w = cvt_pk_bf16(o[6], o[7]);
                    *(u32x4*)(rowp + bj * HALF) = w;
                    if (xf) { int f0 = (int)b[bj][0], f1 = (int)b[bj][1]; f0 = __builtin_amdgcn_cvt_pk_fp8_f32(o[0], o[1], f0, false); f0 = __builtin_amdgcn_cvt_pk_fp8_f32(o[2], o[3], f0, true);
                        f1 = __builtin_amdgcn_cvt_pk_fp8_f32(o[4], o[5], f1, false); f1 = __builtin_amdgcn_cvt_pk_fp8_f32(o[6], o[7], f1, true);
                        *(u32x2*)(xf + (size_t)row * ldc + col0 + bj * HALF) = (u32x2){(unsigned)f0, (unsigned)f1}; }
#pragma unroll
                    for (int q = 0; q < 8; ++q) s += o[q] * o[q]; }
                s += __shfl_xor(s, 16); s += __shfl_xor(s, 32);
                if (fq == 0) fx_add(ssq + row, s); }
    }
};
typedef int i32x4_t __attribute__((ext_vector_type(4)));
typedef int i32x8_t __attribute__((ext_vector_type(8)));
template <class Epi, class Sched, bool ALIGN_EPI = false, bool SP2 = false>
__device__ __forceinline__ void gemm_phase(PG8_LAS unsigned char* lds, const Gemm g, const Sched& S, const Epi& E) {
    int tid_ = threadIdx.x; asm volatile("" : "+v"(tid_));
    const int tid = tid_, wid = __builtin_amdgcn_readfirstlane(tid >> 6), lane = tid & 63, wr = wid >> 2, wc = wid & 3, fr = lane & 15, fq = lane >> 4;
    const int K = g.K, nt = K / BK;
    unsigned voffA[2], voffB[2];
#pragma unroll
    for (int i = 0; i < 2; ++i) { int R, C; stage_rc(tid * 16 + i * 8192, R, C); const int Rb = Epi::PERM ? ((R & ~31) + perm32(R & 31)) : R;
        voffA[i] = (unsigned)(R * K + C) * 2u; voffB[i] = (unsigned)(Rb * K + C) * 2u; }
    const unsigned kstep = (unsigned)(BK * 2);
    const unsigned hstep = (unsigned)HALF * K * 2;
    const unsigned tstep = 2 * hstep;
    const unsigned ldsw = (unsigned)wid * 1024u;
    const int aoff = lds_byte(wr * 64 + fr, fq * 8), boff = lds_byte(wc * 32 + fr, fq * 8);
#define PG8_SA(b, h) (((b) * 2 + (h)) * HTB)
#define PG8_SB(b, h) ((4 + (b) * 2 + (h)) * HTB)
#define PG8_STAGE(bufoff, rsrc, soff, voff) do { _Pragma("unroll") for (int _i = 0; _i < 2; ++_i) \
        __builtin_amdgcn_raw_ptr_buffer_load_lds(rsrc, (PG8_LAS void*)(lds + (bufoff) + ldsw + _i * 8192), 16, (int)(voff)[_i], (int)(soff), 0, 0); } while (0)
#define PG8_LDA(dst, b, h) do { _Pragma("unroll") for (int m = 0; m < 4; ++m) _Pragma("unroll") for (int k = 0; k < 2; ++k) dst[m][k] = *(const PG8_LAS bf16x8*)(lds + PG8_SA(b, h) + aoff + m * 2048 + k * 1024); } while (0)
#define PG8_LDB(dst, b, h) do { _Pragma("unroll") for (int n = 0; n < 2; ++n) _Pragma("unroll") for (int k = 0; k < 2; ++k) dst[n][k] = *(const PG8_LAS bf16x8*)(lds + PG8_SB(b, h) + boff + n * 2048 + k * 1024); } while (0)
#define PG8_MMA(ai, bj, At, Bt) do { __builtin_amdgcn_s_setprio(1); _Pragma("unroll") for (int m = 0; m < 4; ++m) _Pragma("unroll") for (int n = 0; n < 2; ++n) _Pragma("unroll") for (int k = 0; k < 2; ++k) \
        acc[ai][bj][m][n] = __builtin_amdgcn_mfma_f32_16x16x32_bf16(Bt[n][k], At[m][k], acc[ai][bj][m][n], 0, 0, 0); __builtin_amdgcn_s_setprio(0); } while (0)
#define PG8_WAIT_V(n) asm volatile("s_waitcnt vmcnt(" #n ")" ::: "memory")
#define PG8_WAIT_L(n) asm volatile("s_waitcnt lgkmcnt(" #n ")" ::: "memory")
#define PG8_BAR __builtin_amdgcn_s_barrier()
#define PG8_SCHED __builtin_amdgcn_sched_barrier(0)
    Unit cur, nxt; int ui = 0;
    if (!S.next(0, cur)) return;
    f32x4 acc[2][2][4][2];
#pragma unroll
    for (int a = 0; a < 2; ++a)
#pragma unroll
        for (int b = 0; b < 2; ++b)
#pragma unroll
            for (int m = 0; m < 4; ++m)
#pragma unroll
                for (int n = 0; n < 2; ++n) acc[a][b][m][n] = (f32x4){0.f, 0.f, 0.f, 0.f};
    bf16x8 At[4][2], B0[2][2], B1[2][2];
    const __amdgpu_buffer_rsrc_t rA = __builtin_amdgcn_make_buffer_rsrc((void*)g.A, (short)0, -1, 0x00020000), rB = __builtin_amdgcn_make_buffer_rsrc((void*)g.Bt, (short)0, -1, 0x00020000);
    unsigned cA = (unsigned)cur.pm * tstep, cB = (unsigned)cur.pn * tstep;
    S.a_ready(cur);
    if constexpr (SP2) {
        PG8_STAGE(PG8_SB(0, 0), rB, cB, voffB); PG8_STAGE(PG8_SB(0, 1), rB, cB + hstep, voffB); PG8_STAGE(PG8_SA(0, 0), rA, cA, voffA); PG8_STAGE(PG8_SA(0, 1), rA, cA + hstep, voffA);
        if (wr == 1) PG8_BAR;
        PG8_WAIT_V(2); PG8_BAR;
        PG8_STAGE(PG8_SB(1, 0), rB, cB + kstep, voffB); PG8_STAGE(PG8_SA(1, 0), rA, cA + kstep, voffA); PG8_STAGE(PG8_SB(1, 1), rB, cB + hstep + kstep, voffB);
        PG8_WAIT_V(6); PG8_BAR;
    } else {
        PG8_STAGE(PG8_SB(0, 0), rB, cB, voffB); PG8_STAGE(PG8_SA(0, 0), rA, cA, voffA); PG8_STAGE(PG8_SB(0, 1), rB, cB + hstep, voffB); PG8_STAGE(PG8_SA(0, 1), rA, cA + hstep, voffA);
        if (wr == 1) PG8_BAR;
        PG8_WAIT_V(4); PG8_BAR;
        PG8_STAGE(PG8_SB(1, 0), rB, cB + kstep, voffB); PG8_STAGE(PG8_SA(1, 0), rA, cA + kstep, voffA); PG8_STAGE(PG8_SB(1, 1), rB, cB + hstep + kstep, voffB);
        PG8_WAIT_V(6); PG8_BAR;
    }
    for (;;) {
        const bool has_next = S.next(ui + 1, nxt);
        const unsigned nA = has_next ? (unsigned)nxt.pm * tstep : cA, nB = has_next ? (unsigned)nxt.pn * tstep : cB;
        for (int t = 0; t < nt; t += 2) {
            const bool last = (t == nt - 2);
            const unsigned a1 = cA + (unsigned)(t + 1) * kstep;
            const unsigned a2 = last ? nA : cA + (unsigned)(t + 2) * kstep, b2 = last ? nB : cB + (unsigned)(t + 2) * kstep;
            const unsigned a3 = a2 + kstep, b3 = b2 + kstep;
            if (last && has_next) S.a_ready(nxt);
            if constexpr (SP2) {
            PG8_LDB(B0, 0, 0); PG8_LDB(B1, 0, 1); PG8_SCHED; PG8_LDA(At, 0, 0); PG8_STAGE(PG8_SA(1, 1), rA, a1 + hstep, voffA);
            PG8_WAIT_V(8); PG8_WAIT_L(0); PG8_BAR; PG8_MMA(0, 0, At, B0); PG8_MMA(0, 1, At, B1); PG8_BAR; PG8_SCHED;
            PG8_LDA(At, 0, 1); PG8_STAGE(PG8_SB(0, 0), rB, b2, voffB); PG8_STAGE(PG8_SB(0, 1), rB, b2 + hstep, voffB); PG8_STAGE(PG8_SA(0, 0), rA, a2, voffA);
            PG8_WAIT_V(8); PG8_WAIT_L(0); PG8_BAR; PG8_MMA(1, 0, At, B0); PG8_MMA(1, 1, At, B1); PG8_BAR; PG8_SCHED;
            PG8_LDB(B0, 1, 0); PG8_LDB(B1, 1, 1); PG8_SCHED; PG8_LDA(At, 1, 0); PG8_STAGE(PG8_SA(0, 1), rA, a2 + hstep, voffA);
            PG8_WAIT_V(8); PG8_WAIT_L(0); PG8_BAR; PG8_MMA(0, 0, At, B0); PG8_MMA(0, 1, At, B1); PG8_BAR; PG8_SCHED;
            PG8_LDA(At, 1, 1); PG8_STAGE(PG8_SB(1, 0), rB, b3, voffB); PG8_STAGE(PG8_SB(1, 1), rB, b3 + hstep, voffB); PG8_STAGE(PG8_SA(1, 0), rA, a3, voffA);
            PG8_WAIT_V(8); PG8_WAIT_L(0); PG8_BAR; PG8_MMA(1, 0, At, B0); PG8_MMA(1, 1, At, B1); PG8_BAR; PG8_SCHED;
            } else {
            PG8_LDB(B0, 0, 0); PG8_SCHED; PG8_LDA(At, 0, 0); PG8_STAGE(PG8_SA(1, 1), rA, a1 + hstep, voffA);
            PG8_WAIT_L(8); PG8_BAR; PG8_WAIT_L(0); PG8_MMA(0, 0, At, B0); PG8_BAR; PG8_SCHED;
            PG8_LDB(B1, 0, 1); PG8_STAGE(PG8_SB(0, 0), rB, b2, voffB);
            PG8_BAR; PG8_WAIT_L(0); PG8_MMA(0, 1, At, B1); PG8_BAR;
            PG8_LDA(At, 0, 1); PG8_STAGE(PG8_SA(0, 0), rA, a2, voffA);
            PG8_BAR; PG8_WAIT_L(0); PG8_MMA(1, 0, At, B0); PG8_BAR; PG8_SCHED;
            PG8_STAGE(PG8_SB(0, 1), rB, b2 + hstep, voffB);
            PG8_WAIT_V(6); PG8_BAR; PG8_MMA(1, 1, At, B1); PG8_BAR;
            PG8_LDB(B0, 1, 0); PG8_SCHED; PG8_LDA(At, 1, 0); PG8_STAGE(PG8_SA(0, 1), rA, a2 + hstep, voffA);
            PG8_WAIT_L(8); PG8_BAR; PG8_WAIT_L(0); PG8_MMA(0, 0, At, B0); PG8_BAR; PG8_SCHED;
            PG8_LDB(B1, 1, 1); PG8_STAGE(PG8_SB(1, 0), rB, b3, voffB);
            PG8_BAR; PG8_WAIT_L(0); PG8_MMA(0, 1, At, B1); PG8_BAR;
            PG8_LDA(At, 1, 1); PG8_STAGE(PG8_SA(1, 0), rA, a3, voffA);
            PG8_BAR; PG8_WAIT_L(0); PG8_MMA(1, 0, At, B0); PG8_BAR; PG8_SCHED;
            PG8_STAGE(PG8_SB(1, 1), rB, b3 + hstep, voffB);
            PG8_WAIT_V(6); PG8_BAR; PG8_MMA(1, 1, At, B1); PG8_BAR;
            }
        }
        if constexpr (ALIGN_EPI) { if (wr == 0) PG8_BAR; }
        if constexpr (!Epi::AFTER_DRAIN) { int ln_ = (int)__builtin_amdgcn_mbcnt_hi(~0u, __builtin_amdgcn_mbcnt_lo(~0u, 0u)); asm volatile("" : "+v"(ln_));
            E(acc, cur, wr, wc, ln_ & 15, ln_ >> 4); S.done(cur); }
        if (!has_next) break;
#pragma unroll
        for (int a = 0; a < 2; ++a)
#pragma unroll
            for (int b = 0; b < 2; ++b)
#pragma unroll
                for (int m = 0; m < 4; ++m)
#pragma unroll
                    for (int n = 0; n < 2; ++n) acc[a][b][m][n] = (f32x4){0.f, 0.f, 0.f, 0.f};
        cur = nxt; cA = nA; cB = nB; ++ui;
        if constexpr (ALIGN_EPI) { if (wr == 1) PG8_BAR; }
    }
    PG8_WAIT_V(0);
    if constexpr (!ALIGN_EPI) { if (wr == 0) PG8_BAR; }
    PG8_BAR;
    if constexpr (Epi::AFTER_DRAIN) { E.fused(acc, cur, wr, wc, fr, fq, lds, wid, lane); S.done(cur); }
#undef PG8_SA
#undef PG8_SB
#undef PG8_STAGE
#undef PG8_LDA
#undef PG8_LDB
#undef PG8_MMA
#undef PG8_WAIT_V
#undef PG8_WAIT_L
#undef PG8_BAR
#undef PG8_SCHED
}
template <class Epi, class Sched, bool ALIGN_EPI = false, bool SP2 = false>
__device__ __forceinline__ void gemm_phase_f8(PG8_LAS unsigned char* lds, const Gemm g, const Sched& S, const Epi& E) {
    int tid_ = threadIdx.x; asm volatile("" : "+v"(tid_));
    const int tid = tid_, wid = __builtin_amdgcn_readfirstlane(tid >> 6), lane = tid & 63, wr = wid >> 2, wc = wid & 3, fr = lane & 15, fq = lane >> 4;
    const int K = g.K, nt = K / (2 * BK);
    unsigned voffA[2], voffB[2];
#pragma unroll
    for (int i = 0; i < 2; ++i) { int R, C; stage_rc(tid * 16 + i * 8192, R, C); const int Rb = Epi::PERM ? ((R & ~31) + perm32(R & 31)) : R;
        voffA[i] = (unsigned)(R * K + 2 * C); voffB[i] = (unsigned)(Rb * K + 2 * C); }
    const unsigned kstep = (unsigned)(BK * 2);
    const unsigned hstep = (unsigned)HALF * K;
    const unsigned tstep = 2 * hstep;
    const unsigned ldsw = (unsigned)wid * 1024u;
    const int aoff = lds_byte(wr * 64 + fr, fq * 16) ^ ((fq & 1) << 4), boff = lds_byte(wc * 32 + fr, fq * 16) ^ ((fq & 1) << 4), aoff2 = aoff ^ 16, boff2 = boff ^ 16;
#define PG8_SA(b, h) (((b) * 2 + (h)) * HTB)
#define PG8_SB(b, h) ((4 + (b) * 2 + (h)) * HTB)
#define PG8_STAGE(bufoff, rsrc, soff, voff) do { _Pragma("unroll") for (int _i = 0; _i < 2; ++_i) \
        __builtin_amdgcn_raw_ptr_buffer_load_lds(rsrc, (PG8_LAS void*)(lds + (bufoff) + ldsw + _i * 8192), 16, (int)(voff)[_i], (int)(soff), 0, 0); } while (0)
#define PG8_LDA(dst, b, h) do { _Pragma("unroll") for (int m = 0; m < 4; ++m) { const i32x4_t lo_ = *(const PG8_LAS i32x4_t*)(lds + PG8_SA(b, h) + aoff + m * 2048), hi_ = *(const PG8_LAS i32x4_t*)(lds + PG8_SA(b, h) + aoff2 + m * 2048); dst[m] = __builtin_shufflevector(lo_, hi_, 0, 1, 2, 3, 4, 5, 6, 7); } } while (0)
#define PG8_LDB(dst, b, h) do { _Pragma("unroll") for (int n = 0; n < 2; ++n) { const i32x4_t lo_ = *(const PG8_LAS i32x4_t*)(lds + PG8_SB(b, h) + boff + n * 2048), hi_ = *(const PG8_LAS i32x4_t*)(lds + PG8_SB(b, h) + boff2 + n * 2048); dst[n] = __builtin_shufflevector(lo_, hi_, 0, 1, 2, 3, 4, 5, 6, 7); } } while (0)
#define PG8_F8CAT(lo, hi) __builtin_shufflevector(__builtin_bit_cast(i32x4_t, lo), __builtin_bit_cast(i32x4_t, hi), 0, 1, 2, 3, 4, 5, 6, 7)
#define PG8_MMA(ai, bj, At, Bt) do { __builtin_amdgcn_s_setprio(1); _Pragma("unroll") for (int m = 0; m < 4; ++m) _Pragma("unroll") for (int n = 0; n < 2; ++n) \
        acc[ai][bj][m][n] = __builtin_amdgcn_mfma_scale_f32_16x16x128_f8f6f4(Bt[n], At[m], acc[ai][bj][m][n], 0, 0, 0, 0, 0, 0); __builtin_amdgcn_s_setprio(0); } while (0)
#define PG8_WAIT_V(n) asm volatile("s_waitcnt vmcnt(" #n ")" ::: "memory")
#define PG8_WAIT_L(n) asm volatile("s_waitcnt lgkmcnt(" #n ")" ::: "memory")
#define PG8_BAR __builtin_amdgcn_s_barrier()
#define PG8_SCHED __builtin_amdgcn_sched_barrier(0)
    Unit cur, nxt; int ui = 0;
    if (!S.next(0, cur)) return;
    f32x4 acc[2][2][4][2];
#pragma unroll
    for (int a = 0; a < 2; ++a)
#pragma unroll
        for (int b = 0; b < 2; ++b)
#pragma unroll
            for (int m = 0; m < 4; ++m)
#pragma unroll
                for (int n = 0; n < 2; ++n) acc[a][b][m][n] = (f32x4){0.f, 0.f, 0.f, 0.f};
    i32x8_t At[4], B0[2], B1[2];
    const __amdgpu_buffer_rsrc_t rA = __builtin_amdgcn_make_buffer_rsrc((void*)g.A, (short)0, -1, 0x00020000), rB = __builtin_amdgcn_make_buffer_rsrc((void*)g.Bt, (short)0, -1, 0x00020000);
    unsigned cA = (unsigned)cur.pm * tstep, cB = (unsigned)cur.pn * tstep;
    S.a_ready(cur);
    if constexpr (SP2) {
        PG8_STAGE(PG8_SB(0, 0), rB, cB, voffB); PG8_STAGE(PG8_SB(0, 1), rB, cB + hstep, voffB); PG8_STAGE(PG8_SA(0, 0), rA, cA, voffA); PG8_STAGE(PG8_SA(0, 1), rA, cA + hstep, voffA);
        if (wr == 1) PG8_BAR;
        PG8_WAIT_V(2); PG8_BAR;
        PG8_STAGE(PG8_SB(1, 0), rB, cB + kstep, voffB); PG8_STAGE(PG8_SA(1, 0), rA, cA + kstep, voffA); PG8_STAGE(PG8_SB(1, 1), rB, cB + hstep + kstep, voffB);
        PG8_WAIT_V(6); PG8_BAR;
    } else {
        PG8_STAGE(PG8_SB(0, 0), rB, cB, voffB); PG8_STAGE(PG8_SA(0, 0), rA, cA, voffA); PG8_STAGE(PG8_SB(0, 1), rB, cB + hstep, voffB); PG8_STAGE(PG8_SA(0, 1), rA, cA + hstep, voffA);
        if (wr == 1) PG8_BAR;
        PG8_WAIT_V(4); PG8_BAR;
        PG8_STAGE(PG8_SB(1, 0), rB, cB + kstep, voffB); PG8_STAGE(PG8_SA(1, 0), rA, cA + kstep, voffA); PG8_STAGE(PG8_SB(1, 1), rB, cB + hstep + kstep, voffB);
        PG8_WAIT_V(6); PG8_BAR;
    }
    for (;;) {
        const bool has_next = S.next(ui + 1, nxt);
        const unsigned nA = has_next ? (unsigned)nxt.pm * tstep : cA, nB = has_next ? (unsigned)nxt.pn * tstep : cB;
        for (int t = 0; t < nt; t += 2) {
            const bool last = (t == nt - 2);
            const unsigned a1 = cA + (unsigned)(t + 1) * kstep;
            const unsigned a2 = last ? nA : cA + (unsigned)(t + 2) * kstep, b2 = last ? nB : cB + (unsigned)(t + 2) * kstep;
            const unsigned a3 = a2 + kstep, b3 = b2 + kstep;
            if (last && has_next) S.a_ready(nxt);
            if constexpr (SP2) {
            PG8_LDB(B0, 0, 0); PG8_LDB(B1, 0, 1); PG8_SCHED; PG8_LDA(At, 0, 0); PG8_STAGE(PG8_SA(1, 1), rA, a1 + hstep, voffA);
            PG8_WAIT_V(8); PG8_WAIT_L(0); PG8_BAR; PG8_MMA(0, 0, At, B0); PG8_MMA(0, 1, At, B1); PG8_BAR; PG8_SCHED;
            PG8_LDA(At, 0, 1); PG8_STAGE(PG8_SB(0, 0), rB, b2, voffB); PG8_STAGE(PG8_SB(0, 1), rB, b2 + hstep, voffB); PG8_STAGE(PG8_SA(0, 0), rA, a2, voffA);
            PG8_WAIT_V(8); PG8_WAIT_L(0); PG8_BAR; PG8_MMA(1, 0, At, B0); PG8_MMA(1, 1, At, B1); PG8_BAR; PG8_SCHED;
            PG8_LDB(B0, 1, 0); PG8_LDB(B1, 1, 1); PG8_SCHED; PG8_LDA(At, 1, 0); PG8_STAGE(PG8_SA(0, 1), rA, a2 + hstep, voffA);
            PG8_WAIT_V(8); PG8_WAIT_L(0); PG8_BAR; PG8_MMA(0, 0, At, B0); PG8_MMA(0, 1, At, B1); PG8_BAR; PG8_SCHED;
            PG8_LDA(At, 1, 1); PG8_STAGE(PG8_SB(1, 0), rB, b3, voffB); PG8_STAGE(PG8_SB(1, 1), rB, b3 + hstep, voffB); PG8_STAGE(PG8_SA(1, 0), rA, a3, voffA);
            PG8_WAIT_V(8); PG8_WAIT_L(0); PG8_BAR; PG8_MMA(1, 0, At, B0); PG8_MMA(1, 1, At, B1); PG8_BAR; PG8_SCHED;
            } else {
            PG8_LDB(B0, 0, 0); PG8_SCHED; PG8_LDA(At, 0, 0); PG8_STAGE(PG8_SA(1, 1), rA, a1 + hstep, voffA);
            PG8_WAIT_L(8); PG8_BAR; PG8_WAIT_L(0); PG8_MMA(0, 0, At, B0); PG8_BAR; PG8_SCHED;
            PG8_LDB(B1, 0, 1); PG8_STAGE(PG8_SB(0, 0), rB, b2, voffB);
            PG8_BAR; PG8_WAIT_L(0); PG8_MMA(0, 1, At, B1); PG8_BAR;
            PG8_LDA(At, 0, 1); PG8_STAGE(PG8_SA(0, 0), rA, a2, voffA);
            PG8_BAR; PG8_WAIT_L(0); PG8_MMA(1, 0, At, B0); PG8_BAR; PG8_SCHED;
            PG8_STAGE(PG8_SB(0, 1), rB, b2 + hstep, voffB);
            PG8_WAIT_V(6); PG8_BAR; PG8_MMA(1, 1, At, B1); PG8_BAR;
            PG8_LDB(B0, 1, 0); PG8_SCHED; PG8_LDA(At, 1, 0); PG8_STAGE(PG8_SA(0, 1), rA, a2 + hstep, voffA);
            PG8_WAIT_L(8); PG8_BAR; PG8_WAIT_L(0); PG8_MMA(0, 0, At, B0); PG8_BAR; PG8_SCHED;
            PG8_LDB(B1, 1, 1); PG8_STAGE(PG8_SB(1, 0), rB, b3, voffB);
            PG8_BAR; PG8_WAIT_L(0); PG8_MMA(0, 1, At, B1); PG8_BAR;
            PG8_LDA(At, 1, 1); PG8_STAGE(PG8_SA(1, 0), rA, a3, voffA);
            PG8_BAR; PG8_WAIT_L(0); PG8_MMA(1, 0, At, B0); PG8_BAR; PG8_SCHED;
            PG8_STAGE(PG8_SB(1, 1), rB, b3 + hstep, voffB);
            PG8_WAIT_V(6); PG8_BAR; PG8_MMA(1, 1, At, B1); PG8_BAR;
            }
        }
        if constexpr (ALIGN_EPI) { if (wr == 0) PG8_BAR; }
        if constexpr (!Epi::AFTER_DRAIN) { int ln_ = (int)__builtin_amdgcn_mbcnt_hi(~0u, __builtin_amdgcn_mbcnt_lo(~0u, 0u)); asm volatile("" : "+v"(ln_));
            E(acc, cur, wr, wc, ln_ & 15, ln_ >> 4); S.done(cur); }
        if (!has_next) break;
#pragma unroll
        for (int a = 0; a < 2; ++a)
#pragma unroll
            for (int b = 0; b < 2; ++b)
#pragma unroll
                for (int m = 0; m < 4; ++m)
#pragma unroll
                    for (int n = 0; n < 2; ++n) acc[a][b][m][n] = (f32x4){0.f, 0.f, 0.f, 0.f};
        cur = nxt; cA = nA; cB = nB; ++ui;
        if constexpr (ALIGN_EPI) { if (wr == 1) PG8_BAR; }
    }
    PG8_WAIT_V(0);
    if constexpr (!ALIGN_EPI) { if (wr == 0) PG8_BAR; }
    PG8_BAR;
    if constexpr (Epi::AFTER_DRAIN) { E.fused(acc, cur, wr, wc, fr, fq, lds, wid, lane); S.done(cur); }
#undef PG8_SA
#undef PG8_SB
#undef PG8_STAGE
#undef PG8_LDA
#undef PG8_LDB
#undef PG8_MMA
#undef PG8_WAIT_V
#undef PG8_WAIT_L
#undef PG8_BAR
#undef PG8_SCHED
#undef PG8_F8CAT
}
}

constexpr int NWAVES = 8, NTHR = NWAVES * 64;
constexpr int BATCH = 8, SEQ = 2048, DM = 2048, DEPTH = 2, HD = 64, GW = 512, NH = 8;
constexpr int M = BATCH * SEQ;
constexpr int NPROJ = 6080, NPROJ_P = 6144, DFF = 5632;
constexpr int CA_Q = 0, CA_K = 512, CA_V = 1024, CB_U = 1536, CB_V = 2048, CC_Q = 2560, CC_K = 3072, CC_V = 3584, CD = 4096;
constexpr int D_R = 0, D_WD = 512, D_K = 608, D_V = 1120, D_AD = 1632, D_GD = 1728, D_W = 1984;
constexpr float NORM_EPS = 1e-6f;
#ifndef N_LAUNCH_MODE
#define N_LAUNCH_MODE 0
#endif
#ifndef PG8_SP2
#define PG8_SP2 true
#endif
#ifndef FFN_FP8
#define FFN_FP8 1
#endif
#ifndef REPEAT
#define REPEAT 0
#endif
constexpr int N_PHASES = 16;

constexpr size_t MiB = 1u << 20;
constexpr size_t WS_CTL = 0, CTL_ZERO_BYTES = 2 * MiB;
constexpr size_t WS_WIN = 2 * MiB, WS_WOUT = 26 * MiB, WS_WGU = 34 * MiB, WS_WDN = 78 * MiB, WS_SMALL = 100 * MiB;
constexpr size_t WS_XB = 104 * MiB, WS_PROJ = 168 * MiB, WS_YCAT = 360 * MiB, WS_SC2 = 424 * MiB, WS_YD = 456 * MiB, WS_G = 488 * MiB, WS_BC = 504 * MiB, WS_END = 506 * MiB;
constexpr size_t SC_ARR = (size_t)M * GW * 2;
constexpr size_t SM_TB = 0;
constexpr size_t SM_KBAR = 64 * 1024;
constexpr size_t SM_STATS = 256 * 1024;
constexpr size_t SM_WT = 1024 * 1024;
constexpr int CW_BAR = 4096;
constexpr int CW_Q = 8192;
constexpr int CW_SSQ = 65536;
constexpr size_t CTL_KBAR = 1024 * 1024;
constexpr size_t CTL_STATS = 1280 * 1024;
static_assert((size_t)CW_SSQ * 4 + 5 * (size_t)M * 8 <= CTL_KBAR && CTL_STATS + 2 * (size_t)M * 2 * 8 <= CTL_ZERO_BYTES, "CTL");

constexpr int RING_OFF = 0, RING_BYTES = 131072;
constexpr int LDS_BYTES = 163840, MISC_OFF = LDS_BYTES - 256;

#define GAS __attribute__((address_space(1)))
#define LAS __attribute__((address_space(3)))
typedef unsigned short bf16;
typedef unsigned v4u __attribute__((ext_vector_type(4)));
typedef unsigned v2u __attribute__((ext_vector_type(2)));
typedef float f32x4 __attribute__((ext_vector_type(4)));
typedef short bf16x8 __attribute__((ext_vector_type(8)));
typedef float f32x16 __attribute__((ext_vector_type(16)));
typedef GAS unsigned gu32;
#define RLX_AGENT __ATOMIC_RELAXED, __HIP_MEMORY_SCOPE_AGENT
#define LDS_WAIT() asm volatile("s_waitcnt lgkmcnt(0)" ::: "memory")
#define VM_WAIT() asm volatile("s_waitcnt vmcnt(0)" ::: "memory")
__device__ __forceinline__ unsigned f2bf(float f) { unsigned u = __builtin_bit_cast(unsigned, f); return (u + 0x7fffu + ((u >> 16) & 1u)) >> 16; }
__device__ __forceinline__ unsigned pk2(float lo, float hi) { return f2bf(lo) | (f2bf(hi) << 16); }
__device__ __forceinline__ float bf2f(unsigned short h) { return __builtin_bit_cast(float, (unsigned)h << 16); }
__device__ __forceinline__ float bflo(unsigned w) { return __builtin_bit_cast(float, w << 16); }
__device__ __forceinline__ float bfhi(unsigned w) { return __builtin_bit_cast(float, w & 0xffff0000u); }
__device__ __forceinline__ float sigmoidf_(float x) { return 1.0f / (1.0f + __expf(-x)); }
__device__ __forceinline__ float gelu_tanh(float x) { const float u = 0.7978845608028654f * (x + 0.044715f * x * x * x); const float e = __expf(2.0f * u); const float th = 1.0f - 2.0f / (e + 1.0f); return 0.5f * x * (1.0f + th); }
__device__ __forceinline__ float wave_sum(float v) {
#pragma unroll
    for (int o = 1; o < 64; o <<= 1) v += __shfl_xor(v, o);
    return v;
}

__device__ __forceinline__ float zero_v() { float z = 0.f; asm volatile("" : "+v"(z)); return z; }

#define UNPACK8(dst, o, W_) do { dst[(o)] = bflo((W_).x); dst[(o) + 1] = bfhi((W_).x); dst[(o) + 2] = bflo((W_).y); dst[(o) + 3] = bfhi((W_).y); dst[(o) + 4] = bflo((W_).z); dst[(o) + 5] = bfhi((W_).z); dst[(o) + 6] = bflo((W_).w); dst[(o) + 7] = bfhi((W_).w); } while (0)
#define XB_TMO      128
#define XB_XCNT(j)  (256  + 64 * (j))
#define XB_XSUB(j)  (1280 + 64 * (j))
#define XB_XGEN(j)  (2304 + 64 * (j))
#define XB_TOP      3328
#define XB_TOPGEN   3392
#define XCD_BAR_WORDS 3456
#define XB_SPIN_CAP (1u << 18)

__device__ __forceinline__ unsigned xb_ld(unsigned* p)              { return __hip_atomic_load(p, __ATOMIC_RELAXED, __HIP_MEMORY_SCOPE_AGENT); }
__device__ __forceinline__ unsigned xb_add(unsigned* p, unsigned v) { return __hip_atomic_fetch_add(p, v, __ATOMIC_RELAXED, __HIP_MEMORY_SCOPE_AGENT); }
__device__ __forceinline__ unsigned xb_xcc_id() { return (unsigned)__builtin_amdgcn_s_getreg((3 << 11) | 20) & 0xFu; }
#define XB_SPIN(cond, bar) do { unsigned _sp = 0; while (cond) { __builtin_amdgcn_s_sleep(1); \
    if ((++_sp & 255u) == 0u) { if (xb_ld(&(bar)[XB_TMO])) break; if (_sp > XB_SPIN_CAP) { atomicAdd(&(bar)[XB_TMO], 1u); break; } } } } while (0)

struct XcdBarrier {
    unsigned* bar; unsigned x;
    volatile LAS unsigned* st;
};

__device__ __forceinline__ XcdBarrier xcd_barrier_post(unsigned* bar, volatile LAS unsigned* st) {
    XcdBarrier b; b.bar = bar; b.x = xb_xcc_id(); b.st = st;
    if (threadIdx.x == 0) (void)xb_add(&bar[XB_XCNT(b.x)], 1u);
    return b;
}
__device__ __forceinline__ void xcd_barrier_complete(unsigned* bar, unsigned x, unsigned& nloc, unsigned& nx) {
    const unsigned G = gridDim.x * gridDim.y * gridDim.z;
    unsigned sum, cnt, mine, sp = 0u;
    for (;;) {
        sum = 0u; cnt = 0u; mine = 0u;
#pragma unroll
        for (unsigned j = 0; j < 16; ++j) { const unsigned c = xb_ld(&bar[XB_XCNT(j)]); sum += c; cnt += (c > 0u) ? 1u : 0u; mine = (j == x) ? c : mine; }
        if (sum == G) break;
        __builtin_amdgcn_s_sleep(1);
        if ((++sp & 255u) == 0u) { if (xb_ld(&bar[XB_TMO])) break; if (sp > XB_SPIN_CAP) { atomicAdd(&bar[XB_TMO], 1u); break; } }
    }
    nloc = mine > 0u ? mine : 1u; nx = cnt > 0u ? cnt : 1u;
}

__device__ __forceinline__ void xcd_barrier(const XcdBarrier& b) {
    asm volatile("s_waitcnt vmcnt(0)" ::: "memory");
    __syncthreads();
    if (threadIdx.x == 0) {
        unsigned* bar = b.bar;
        __builtin_amdgcn_s_waitcnt(0);
        unsigned nloc = b.st[0], nx = b.st[1];
        if (nloc == 0u) { xcd_barrier_complete(bar, b.x, nloc, nx); b.st[0] = nloc; b.st[1] = nx; }
        const unsigned old = xb_add(&bar[XB_XSUB(b.x)], 1u);
        const unsigned gen = old / nloc;
        if (old + 1u == (gen + 1u) * nloc) {
            __builtin_amdgcn_fence(__ATOMIC_RELEASE, "agent");
            asm volatile("s_waitcnt vmcnt(0)" ::: "memory");
            const unsigned og = xb_add(&bar[XB_TOP], 1u);
            const unsigned tg = og / nx;
            if (og + 1u == (tg + 1u) * nx) xb_add(&bar[XB_TOPGEN], 1u);
            else XB_SPIN(xb_ld(&bar[XB_TOPGEN]) == tg, bar);
            __builtin_amdgcn_fence(__ATOMIC_ACQUIRE, "agent");
            xb_add(&bar[XB_XGEN(b.x)], 1u);
            asm volatile("s_waitcnt vmcnt(0)" ::: "memory");
        } else {
            XB_SPIN(xb_ld(&bar[XB_XGEN(b.x)]) == gen, bar);
            __builtin_amdgcn_fence(__ATOMIC_ACQUIRE, "agent");
            asm volatile("s_waitcnt vmcnt(0)" ::: "memory");
        }
    }
    __syncthreads();
}

struct Args { const float* in[25]; float* out; unsigned char* ws; int ph_lo, ph_hi; };
struct Frame {
    LAS unsigned char* lds; int tid, lane, wave, G, vcu, gw, ngw;
};
typedef const __attribute__((address_space(4))) unsigned long long* karg_t;
__device__ __forceinline__ karg_t kargs() { karg_t ka = (karg_t)__builtin_amdgcn_kernarg_segment_ptr(); asm volatile("" : "+s"(ka)); return ka; }
__device__ __forceinline__ const float* inp(int i) { return (const float*)(const GAS float*)kargs()[i]; }
__device__ __forceinline__ float* outp() { return (float*)(GAS float*)kargs()[25]; }
__device__ __forceinline__ unsigned char* wsp() { return (unsigned char*)(GAS unsigned char*)kargs()[26]; }
__device__ __forceinline__ gu32* ctlp() { return (gu32*)(wsp() + WS_CTL); }

__device__ __forceinline__ void conv_item(const float* W, int K, int N, const float* g, bf16* WT, int kind, LAS float* scr, int item, int lane) {
    const int nblk = N / 32, kb = item / nblk, nb = item % nblk, k0 = 64 * kb, n0 = 32 * nb;
    float ld[32];
    { const float* wp = W + (size_t)(k0 + (lane >> 5)) * N + n0 + (lane & 31);
#pragma unroll
      for (int i = 0; i < 32; ++i) ld[i] = wp[(size_t)(2 * i) * N]; }
    if (g) { const float* gp = g + k0 + (lane >> 5);
#pragma unroll
      for (int i = 0; i < 32; ++i) ld[i] *= gp[2 * i]; }
#pragma unroll
    for (int i = 0; i < 32; ++i) scr[(2 * i + (lane >> 5)) * 33 + (lane & 31)] = ld[i];
    LDS_WAIT(); asm volatile("" ::: "memory");
    const int c = lane & 7;
#pragma unroll
    for (int j = 0; j < 4; ++j) { const int n = (lane >> 3) + 8 * j; const LAS float* s = scr + (8 * c) * 33 + n;
        v4u o; o.x = pk2(s[0 * 33], s[1 * 33]); o.y = pk2(s[2 * 33], s[3 * 33]); o.z = pk2(s[4 * 33], s[5 * 33]); o.w = pk2(s[6 * 33], s[7 * 33]);
        const int nn = n0 + n;
        if (kind >= 3) {
            const int row = (nn >> 7) * 256 + (kind - 3) * 128 + (nn & 127); int f0 = (int)o.x, f1 = (int)o.y;
            f0 = __builtin_amdgcn_cvt_pk_fp8_f32(64.f * s[0 * 33], 64.f * s[1 * 33], f0, false); f0 = __builtin_amdgcn_cvt_pk_fp8_f32(64.f * s[2 * 33], 64.f * s[3 * 33], f0, true);
            f1 = __builtin_amdgcn_cvt_pk_fp8_f32(64.f * s[4 * 33], 64.f * s[5 * 33], f1, false); f1 = __builtin_amdgcn_cvt_pk_fp8_f32(64.f * s[6 * 33], 64.f * s[7 * 33], f1, true);
            *(GAS v2u*)((unsigned char*)WT + (size_t)row * K + k0 + 8 * c) = (v2u){(unsigned)f0, (unsigned)f1};
        } else {
        const int row = kind == 0 ? nn : ((nn >> 7) * 256 + (kind - 1) * 128 + (nn & 127));
        *(GAS v4u*)(WT + (size_t)row * K + k0 + 8 * c) = o; } }
    LDS_WAIT(); asm volatile("" ::: "memory");
}
__device__ __forceinline__ void conv_layer_items(Frame& F, int l, int gw, int ngw, bool do_in, bool do_rest) {
    LAS float* scr = (LAS float*)(F.lds + RING_OFF + F.wave * 16384);
    constexpr int I_IN = (DM / 64) * (NPROJ / 32), I_OUT = (DM / 64) * (DM / 32), I_G = (DM / 64) * (DFF / 32), I_D = (DFF / 64) * (DM / 32);
    const float* w_in = inp(2) + (size_t)l * DM * NPROJ; const float* w_out = inp(19) + (size_t)l * DM * DM;
    const float* w_g = inp(21) + (size_t)l * DM * DFF; const float* w_u = inp(22) + (size_t)l * DM * DFF; const float* w_d = inp(23) + (size_t)l * DFF * DM;
    const float* g_mix = inp(1) + l * DM; const float* g_br = inp(18) + l * DM; const float* g_ffn = inp(20) + l * DM;
    bf16* WIN = (bf16*)(wsp() + WS_WIN); bf16* WOUT = (bf16*)(wsp() + WS_WOUT); bf16* WGU = (bf16*)(wsp() + WS_WGU); bf16* WDN = (bf16*)(wsp() + WS_WDN);
    if (do_in) {
        for (int it = gw; it < I_IN; it += ngw) conv_item(w_in, DM, NPROJ, g_mix, WIN, 0, scr, it, F.lane);
    }
    if (do_rest) {
        for (int it = gw; it < I_OUT + 2 * I_G + I_D; it += ngw) {
            int r = it;
            if (r < I_OUT) { conv_item(w_out, DM, DM, g_br, WOUT, 0, scr, r, F.lane); continue; } r -= I_OUT;
            if (r < I_G) { conv_item(w_g, DM, DFF, g_ffn, WGU, FFN_FP8 ? 3 : 1, scr, r, F.lane); continue; } r -= I_G;
            if (r < I_G) { conv_item(w_u, DM, DFF, g_ffn, WGU, FFN_FP8 ? 4 : 2, scr, r, F.lane); continue; } r -= I_G;
            conv_item(w_d, DFF, DM, nullptr, WDN, 0, scr, r, F.lane);
        }
    }
}

__device__ __forceinline__ void ph_prologue(Frame& F) {
    conv_layer_items(F, 0, F.gw, F.ngw, true, false);
    { bf16* WIN = (bf16*)(wsp() + WS_WIN);
      for (int i = F.gw * 64 + F.lane; i < 64 * DM / 8; i += F.ngw * 64) *(GAS v4u*)(WIN + (size_t)NPROJ * DM + (size_t)i * 8) = (v4u){0u, 0u, 0u, 0u}; }
    if (blockIdx.x == 0) {
        int* TB = (int*)(wsp() + WS_SMALL + SM_TB);
        for (int d = F.tid; d < 2049; d += NTHR) {
            int bkt = d;
            if (d >= 16) bkt = 16 + (d >= 22) + (d >= 30) + (d >= 40) + (d >= 54) + (d >= 73) + (d >= 99) + (d >= 134) + (d >= 182) + (d >= 246) + (d >= 332) + (d >= 450) + (d >= 609) + (d >= 825) + (d >= 1117) + (d >= 1513);
            TB[d] = bkt;
        }
    }
    { bf16* WT = (bf16*)(wsp() + WS_SMALL + SM_WT); const float* w2 = inp(9); const float* a2 = inp(11); const float* g2 = inp(12);
      for (int idx = blockIdx.x * NTHR + F.tid; idx < DEPTH * 448 * GW; idx += F.G * NTHR) {
          const int c = idx % GW, k = (idx / GW) % 448, l = idx / (GW * 448);
          const float v = k < 96 ? w2[((size_t)l * 96 + k) * GW + c] : (k < 192 ? a2[((size_t)l * 96 + (k - 96)) * GW + c] : g2[((size_t)l * 256 + (k - 192)) * GW + c]);
          const int r32_ = c & 31, hct = c >> 5, ks_ = k >> 4, hh_ = (k >> 3) & 1;
          WT[(size_t)l * GW * 448 + (((size_t)hct * 28 + ks_) * 64 + 32 * hh_ + r32_) * 8 + (k & 7)] = (bf16)f2bf(v); } }
    const float* x = inp(0); bf16* XB = (bf16*)(wsp() + WS_XB); pg8::fx_t* ssq = (pg8::fx_t*)(ctlp() + CW_SSQ);
    for (int m = F.gw; m < M; m += F.ngw) {
        const GAS f32x4* xr = (const GAS f32x4*)(x + (size_t)m * DM) + F.lane; GAS v2u* o = (GAS v2u*)(XB + (size_t)m * DM) + F.lane; float s = 0.f;
#pragma unroll
        for (int j = 0; j < 8; ++j) { const f32x4 v = xr[64 * j]; s += (v.x * v.x + v.y * v.y) + (v.z * v.z + v.w * v.w); o[64 * j] = (v2u){pk2(v.x, v.y), pk2(v.z, v.w)}; }
        s = wave_sum(s); if (F.lane == 0) pg8::fx_add(ssq + m, s);
    }
}

constexpr int PR_PITCH = 912;
constexpr int PR_PRM_OFF = 32768, PR_MUA_OFF = PR_PRM_OFF + 8 * 512 * 4;
__device__ __forceinline__ float fast_tanh(float x) { return 1.0f - 2.0f * __builtin_amdgcn_rcpf(__expf(2.0f * x) + 1.0f); }
__device__ __forceinline__ float fast_sigmoid(float x) { return __builtin_amdgcn_rcpf(1.0f + __expf(-x)); }
constexpr int PR_OT_OFF = 51200, PR_OT_PITCH = 72, PR_OT_TILE = 32 * PR_OT_PITCH, PR_OT_WAVE = 6 * PR_OT_TILE;
static_assert(PR_OT_OFF + 8 * PR_OT_WAVE <= MISC_OFF, "prep LDS");
__device__ __forceinline__ void ph_prep(Frame& F, int l) {
    const bf16* PROJ = (const bf16*)(wsp() + WS_PROJ);
    bf16* R_ = (bf16*)outp();
    bf16* E_ = R_ + (size_t)M * GW; bf16* KP_ = E_ + (size_t)M * GW; bf16* V_ = KP_ + (size_t)M * GW;
    bf16* KK_ = (bf16*)outp() + (size_t)4 * M * GW; bf16* AS_ = KK_ + (size_t)M * GW; bf16* G_ = (bf16*)(wsp() + WS_G); float* BC = (float*)(wsp() + WS_BC);
    const bf16* WT = (const bf16*)(wsp() + WS_SMALL + SM_WT) + (size_t)l * GW * 448;
    LAS unsigned char* actL = F.lds + RING_OFF; LAS float* PRM = (LAS float*)(F.lds + PR_PRM_OFF); LAS float* MUA = (LAS float*)(F.lds + PR_MUA_OFF);
    { const float* mu = inp(7) + l * D_W; const float* w0 = inp(8) + l * GW; const float* a0 = inp(10) + l * GW; const float* k_k = inp(13) + l * GW; const float* k_a = inp(14) + l * GW; const float* r_k = inp(15) + l * GW;
      const int c = F.tid;
      PRM[c] = mu[D_R + c]; PRM[512 + c] = mu[D_K + c]; PRM[1024 + c] = mu[D_V + c]; PRM[1536 + c] = w0[c]; PRM[2048 + c] = a0[c]; PRM[2560 + c] = k_k[c]; PRM[3072 + c] = k_a[c]; PRM[3584 + c] = r_k[c];
      if (c < 448) MUA[c] = mu[c < 96 ? D_WD + c : (c < 192 ? D_AD + (c - 96) : D_GD + (c - 192))]; }
    __syncthreads();
    const int h = F.wave;
    for (int it = blockIdx.x; it < M / 32; it += F.G) {
        const int m0 = it * 32;
        int tid_ = threadIdx.x; asm volatile("" : "+v"(tid_));
        const int tid = tid_, r32 = tid & 31, hh = (tid >> 5) & 1, lane = tid & 63;
        LAS unsigned char* OT = F.lds + PR_OT_OFF + h * PR_OT_WAVE;
        { v2u pc[7], pp[7];
#pragma unroll
          for (int i = 0; i < 7; ++i) { const int gi = tid + NTHR * i, t = gi / 112, k = 4 * (gi % 112), m = m0 + t;
              const int col = k < 96 ? D_WD + k : (k < 192 ? D_AD + (k - 96) : D_GD + (k - 192)); const bf16* src = PROJ + (size_t)m * NPROJ_P + CD + col;
              pc[i] = *(const GAS v2u*)src; pp[i] = (v2u){0u, 0u}; if ((m % SEQ) > 0) pp[i] = *(const GAS v2u*)(src - NPROJ_P); }
#pragma unroll
          for (int i = 0; i < 7; ++i) { const int gi = tid + NTHR * i, t = gi / 112, k = 4 * (gi % 112);
              const f32x4 mv = *(const LAS f32x4*)(MUA + k);
              float x[4] = {bflo(pc[i].x), bfhi(pc[i].x), bflo(pc[i].y), bfhi(pc[i].y)}; const float xp[4] = {bflo(pp[i].x), bfhi(pp[i].x), bflo(pp[i].y), bfhi(pp[i].y)};
#pragma unroll
              for (int e = 0; e < 4; ++e) { x[e] += (xp[e] - x[e]) * mv[e]; x[e] = k < 96 ? fast_tanh(x[e]) : (k < 192 ? x[e] : fast_sigmoid(x[e])); }
              *(LAS v2u*)(actL + t * PR_PITCH + 2 * k) = (v2u){pk2(x[0], x[1]), pk2(x[2], x[3])}; } }
        __syncthreads();
        const int m = m0 + r32; const bool has_prev = (m % SEQ) > 0;
        const bf16* pr = PROJ + (size_t)m * NPROJ_P + CD; const bf16* pq = pr - NPROJ_P;
        const LAS unsigned char* bp = actL + r32 * PR_PITCH + 16 * hh;
        float kkv[2][16]; float n2 = 0.f, bcv = 0.f;
#pragma unroll
        for (int ct = 0; ct < 2; ++ct) {
            const int cb = 64 * h + 32 * ct + 4 * hh;
            v4u xc[3][2], xp[3][2];
#pragma unroll
            for (int a = 0; a < 3; ++a)
#pragma unroll
                for (int i = 0; i < 2; ++i) { const int mm = m0 + (lane >> 2) + 16 * i; const bf16* src = PROJ + (size_t)mm * NPROJ_P + CD + (a == 0 ? D_R : (a == 1 ? D_K : D_V)) + 64 * h + 32 * ct + 8 * (lane & 3);
                    xc[a][i] = *(const GAS v4u*)src; xp[a][i] = (v4u){0u, 0u, 0u, 0u}; if ((mm % SEQ) > 0) xp[a][i] = *(const GAS v4u*)(src - NPROJ_P); }
            f32x16 aW, aA, aG;
            { const float z_ = zero_v();
#pragma unroll
            for (int i = 0; i < 16; ++i) { aW[i] = z_; aA[i] = z_; aG[i] = z_; } }
            const bf16* wt0 = WT + ((size_t)(2 * h + ct) * 28 * 64 + lane) * 8;
#pragma unroll
            for (int grp = 0; grp < 4; ++grp) {
                bf16x8 af[7];
#pragma unroll
                for (int q = 0; q < 7; ++q) af[q] = *(const GAS bf16x8*)(wt0 + 512 * (7 * grp + q));
#pragma unroll
                for (int q = 0; q < 7; ++q) { const int ks = 7 * grp + q; const bf16x8 bfr = *(const LAS bf16x8*)(bp + 32 * ks);
                    if (ks < 6) aW = __builtin_amdgcn_mfma_f32_32x32x16_bf16(af[q], bfr, aW, 0, 0, 0);
                    else if (ks < 12) aA = __builtin_amdgcn_mfma_f32_32x32x16_bf16(af[q], bfr, aA, 0, 0, 0);
                    else aG = __builtin_amdgcn_mfma_f32_32x32x16_bf16(af[q], bfr, aG, 0, 0, 0); }
                asm volatile("" ::: "memory");
            }
            LAS unsigned char* IN = OT + 3 * PR_OT_TILE;
#pragma unroll
            for (int a = 0; a < 3; ++a)
#pragma unroll
                for (int i = 0; i < 2; ++i) { const int cch = 64 * h + 32 * ct + 8 * (lane & 3); const f32x4 m0v = *(const LAS f32x4*)(PRM + a * 512 + cch), m1v = *(const LAS f32x4*)(PRM + a * 512 + cch + 4);
                    float xcu[8], xpu[8]; UNPACK8(xcu, 0, xc[a][i]); UNPACK8(xpu, 0, xp[a][i]); const float mw[8] = {m0v.x, m0v.y, m0v.z, m0v.w, m1v.x, m1v.y, m1v.z, m1v.w};
#pragma unroll
                    for (int e = 0; e < 8; ++e) xcu[e] += (xpu[e] - xcu[e]) * mw[e];
                    LAS unsigned char* dstp = IN + a * PR_OT_TILE + ((lane >> 2) + 16 * i) * PR_OT_PITCH + 16 * (lane & 3);
                    *(LAS v2u*)dstp = (v2u){pk2(xcu[0], xcu[1]), pk2(xcu[2], xcu[3])}; *(LAS v2u*)(dstp + 8) = (v2u){pk2(xcu[4], xcu[5]), pk2(xcu[6], xcu[7])}; }
            asm volatile("" ::: "memory");
            v2u oE[4], oK[4], oG[4];
#pragma unroll
            for (int g4 = 0; g4 < 4; ++g4) {
                const int c = cb + 8 * g4;
                const f32x4 w0v = *(const LAS f32x4*)(PRM + 1536 + c),
                            a0v = *(const LAS f32x4*)(PRM + 2048 + c), kkc = *(const LAS f32x4*)(PRM + 2560 + c), kac = *(const LAS f32x4*)(PRM + 3072 + c), rkc = *(const LAS f32x4*)(PRM + 3584 + c);
                const LAS unsigned char* inq = IN + r32 * PR_OT_PITCH + 2 * (8 * g4 + 4 * hh);
                const v2u rq = *(const LAS v2u*)inq, kq = *(const LAS v2u*)(inq + PR_OT_TILE), vq = *(const LAS v2u*)(inq + 2 * PR_OT_TILE);
                const float rsu[4] = {bflo(rq.x), bfhi(rq.x), bflo(rq.y), bfhi(rq.y)}, ksu[4] = {bflo(kq.x), bfhi(kq.x), bflo(kq.y), bfhi(kq.y)}, vsu[4] = {bflo(vq.x), bfhi(vq.x), bflo(vq.y), bfhi(vq.y)};
                float ro[4], eo[4], ko[4], vo[4], ao[4], go[4];
#pragma unroll
                for (int e = 0; e < 4; ++e) {
                    const float r = rsu[e], k = ksu[e], v = vsu[e];
                    const float ee = 0.6065306597126334f * fast_sigmoid(w0v[e] + aW[4 * g4 + e]);
                    const float as = fast_sigmoid(a0v[e] + aA[4 * g4 + e]);
                    const float kv = k * kkc[e]; kkv[ct][4 * g4 + e] = kv; n2 += kv * kv;
                    const float kp = k * (1.0f + (as - 1.0f) * kac[e]);
                    bcv += r * kp * rkc[e];
                    ro[e] = r; eo[e] = ee; ko[e] = kp; vo[e] = v; ao[e] = as; go[e] = aG[4 * g4 + e];
                }
                LAS unsigned char* ot = OT + r32 * PR_OT_PITCH + 2 * (8 * g4 + 4 * hh);
                *(LAS v2u*)(ot) = (v2u){pk2(ro[0], ro[1]), pk2(ro[2], ro[3])}; *(LAS v2u*)(ot + PR_OT_TILE) = (v2u){pk2(vo[0], vo[1]), pk2(vo[2], vo[3])}; *(LAS v2u*)(ot + 2 * PR_OT_TILE) = (v2u){pk2(ao[0], ao[1]), pk2(ao[2], ao[3])};
                oE[g4] = (v2u){pk2(eo[0], eo[1]), pk2(eo[2], eo[3])}; oK[g4] = (v2u){pk2(ko[0], ko[1]), pk2(ko[2], ko[3])}; oG[g4] = (v2u){pk2(go[0], go[1]), pk2(go[2], go[3])};
            }
            asm volatile("" ::: "memory");
#pragma unroll
            for (int batch = 0; batch < 2; ++batch) {
                bf16* const dst[3] = {batch == 0 ? R_ : E_, batch == 0 ? V_ : KP_, batch == 0 ? AS_ : G_};
                if (batch == 1) {
#pragma unroll
                    for (int g4 = 0; g4 < 4; ++g4) { LAS unsigned char* ot = OT + r32 * PR_OT_PITCH + 2 * (8 * g4 + 4 * hh); *(LAS v2u*)(ot) = oE[g4]; *(LAS v2u*)(ot + PR_OT_TILE) = oK[g4]; *(LAS v2u*)(ot + 2 * PR_OT_TILE) = oG[g4]; }
                    asm volatile("" ::: "memory"); }
#pragma unroll
                for (int a = 0; a < 3; ++a)
#pragma unroll
                    for (int i = 0; i < 2; ++i) { const int tk = (lane >> 2) + 16 * i, part = lane & 3; const LAS unsigned char* src = OT + a * PR_OT_TILE + tk * PR_OT_PITCH + 16 * part;
                        const v2u lo = *(const LAS v2u*)src, hi = *(const LAS v2u*)(src + 8);
                        *(GAS v4u*)(dst[a] + (size_t)(m0 + tk) * GW + 64 * h + 32 * ct + 8 * part) = (v4u){lo.x, lo.y, hi.x, hi.y}; }
                asm volatile("" ::: "memory");
            }
        }
        n2 += __shfl_xor(n2, 32); bcv += __shfl_xor(bcv, 32);
        const float inv = 1.0f / fmaxf(sqrtf(n2), 1e-12f);
#pragma unroll
        for (int ct = 0; ct < 2; ++ct)
#pragma unroll
            for (int g4 = 0; g4 < 4; ++g4) *(LAS v2u*)(OT + ct * PR_OT_TILE + r32 * PR_OT_PITCH + 2 * (8 * g4 + 4 * hh)) = (v2u){pk2(kkv[ct][4 * g4] * inv, kkv[ct][4 * g4 + 1] * inv), pk2(kkv[ct][4 * g4 + 2] * inv, kkv[ct][4 * g4 + 3] * inv)};
        asm volatile("" ::: "memory");
#pragma unroll
        for (int ct = 0; ct < 2; ++ct)
#pragma unroll
            for (int i = 0; i < 2; ++i) { const int tk = (lane >> 2) + 16 * i, part = lane & 3; const LAS unsigned char* src = OT + ct * PR_OT_TILE + tk * PR_OT_PITCH + 16 * part;
                const v2u lo = *(const LAS v2u*)src, hi = *(const LAS v2u*)(src + 8);
                *(GAS v4u*)(KK_ + (size_t)(m0 + tk) * GW + 64 * h + 32 * ct + 8 * part) = (v4u){lo.x, lo.y, hi.x, hi.y}; }
        asm volatile("" ::: "memory");
        if (hh == 0) BC[(size_t)m * NH + h] = bcv;
        __syncthreads();
    }
}

__device__ __forceinline__ Frame mkframe(LAS unsigned char* lds) {
    Frame F; F.lds = lds; { int t_ = threadIdx.x; asm volatile("" : "+v"(t_)); F.tid = t_; } F.lane = F.tid & 63; F.wave = __builtin_amdgcn_readfirstlane(F.tid >> 6);
    F.G = gridDim.x; { const int bx = blockIdx.x; F.vcu = (F.G % 8 == 0) ? (bx % 8) * (F.G / 8) + bx / 8 : bx; }
    F.gw = blockIdx.x * NWAVES + F.wave; F.ngw = F.G * NWAVES; return F;
}

#ifndef UNPACK8
#define UNPACK8(dst, o, W_) do { dst[(o)] = bflo((W_).x); dst[(o) + 1] = bfhi((W_).x); dst[(o) + 2] = bflo((W_).y); dst[(o) + 3] = bfhi((W_).y); dst[(o) + 4] = bflo((W_).z); dst[(o) + 5] = bfhi((W_).z); dst[(o) + 6] = bflo((W_).w); dst[(o) + 7] = bfhi((W_).w); } while (0)
#endif
#define DOT8(q, o, W_) ((q)[(o)] * bflo((W_).x) + (q)[(o) + 1] * bfhi((W_).x) + (q)[(o) + 2] * bflo((W_).y) + (q)[(o) + 3] * bfhi((W_).y) + (q)[(o) + 4] * bflo((W_).z) + (q)[(o) + 5] * bfhi((W_).z) + (q)[(o) + 6] * bflo((W_).w) + (q)[(o) + 7] * bfhi((W_).w))
#define AXPY8(acc, o, sc, pe, W_) do { acc[(o)] = acc[(o)] * (sc) + (pe) * bflo((W_).x); acc[(o) + 1] = acc[(o) + 1] * (sc) + (pe) * bfhi((W_).x); acc[(o) + 2] = acc[(o) + 2] * (sc) + (pe) * bflo((W_).y); acc[(o) + 3] = acc[(o) + 3] * (sc) + (pe) * bfhi((W_).y); \
    acc[(o) + 4] = acc[(o) + 4] * (sc) + (pe) * bflo((W_).z); acc[(o) + 5] = acc[(o) + 5] * (sc) + (pe) * bfhi((W_).z); acc[(o) + 6] = acc[(o) + 6] * (sc) + (pe) * bflo((W_).w); acc[(o) + 7] = acc[(o) + 7] * (sc) + (pe) * bfhi((W_).w); } while (0)
__device__ __forceinline__ void mix_a_simple(Frame& F) {
    const bf16* PROJ = (const bf16*)(wsp() + WS_PROJ); bf16* YC = (bf16*)(wsp() + WS_YCAT); const int* TB = (const int*)(wsp() + WS_SMALL + SM_TB); const float* pb = inp(3);
    const int nthr = F.G * NTHR;
    for (int idx = blockIdx.x * NTHR + F.tid; idx < M * NH; idx += nthr) {
        const int m = idx >> 3, h = idx & 7, t = m % SEQ;
        float q[64], acc[64];
        { const GAS v4u* qp = (const GAS v4u*)(PROJ + (size_t)m * NPROJ_P + CA_Q + 64 * h);
#pragma unroll
          for (int i = 0; i < 8; ++i) { const v4u w = qp[i]; UNPACK8(q, 8 * i, w); } }
#pragma unroll
        for (int i = 0; i < 64; ++i) acc[i] = 0.f;
        float mx = -1e30f, l = 0.f;
        for (int p = 0; p < 3; ++p) { const int d = p == 0 ? 1 : (p == 1 ? 4 : 16);
            for (int j = 0; j <= 128; ++j) { const int kp = t - j * d; if (kp < 0) break;
                const bf16* row = PROJ + (size_t)(m - j * d) * NPROJ_P; const GAS v4u* kq = (const GAS v4u*)(row + CA_K + 64 * h); const GAS v4u* vq = (const GAS v4u*)(row + CA_V + 64 * h);
                float s = 0.f;
#pragma unroll
                for (int i = 0; i < 8; ++i) { const v4u w = kq[i]; s += DOT8(q, 8 * i, w); }
                s = s * 0.125f + pb[TB[j * d] * 16 + h];
                const float mn = fmaxf(mx, s), sc = __expf(mx - mn), pe = __expf(s - mn); mx = mn; l = l * sc + pe;
#pragma unroll
                for (int i = 0; i < 8; ++i) { const v4u w = vq[i]; AXPY8(acc, 8 * i, sc, pe, w); }
            } }
        const float inv = 1.0f / l; GAS v4u* op = (GAS v4u*)(YC + (size_t)m * DM + 0 * GW + 64 * h);
#pragma unroll
        for (int i = 0; i < 8; ++i) op[i] = (v4u){pk2(acc[8 * i] * inv, acc[8 * i + 1] * inv), pk2(acc[8 * i + 2] * inv, acc[8 * i + 3] * inv), pk2(acc[8 * i + 4] * inv, acc[8 * i + 5] * inv), pk2(acc[8 * i + 6] * inv, acc[8 * i + 7] * inv)};
    }
}
__device__ __forceinline__ void mix_c_simple(Frame& F, int l = 0) {
    const bf16* PROJ = (const bf16*)(wsp() + WS_PROJ); bf16* YC = (bf16*)(wsp() + WS_YCAT); const int* TB = (const int*)(wsp() + WS_SMALL + SM_TB); const float* pb = inp(3);
    const float* KBAR = (const float*)(wsp() + CTL_KBAR) + (size_t)l * 64 * 8 * 64;
    const int nthr = F.G * NTHR;
    for (int idx = blockIdx.x * NTHR + F.tid; idx < M * NH; idx += nthr) {
        const int m = idx >> 3, h = idx & 7, t = m % SEQ, b = m / SEQ, ob = t >> 8;
        float q[64], acc[64];
        { const GAS v4u* qp = (const GAS v4u*)(PROJ + (size_t)m * NPROJ_P + CC_Q + 64 * h);
#pragma unroll
          for (int i = 0; i < 8; ++i) { const v4u w = qp[i]; UNPACK8(q, 8 * i, w); } }
        float gate[8];
#pragma unroll
        for (int n = 0; n < 8; ++n) { float s = 0.f; if (n < ob) { const float* kb = KBAR + ((b * NH + h) * 8 + n) * 64;
#pragma unroll
                for (int i = 0; i < 64; ++i) s += q[i] * kb[i]; } gate[n] = s; }
        unsigned sel = 0u;
#pragma unroll
        for (int n = 0; n < 8; ++n) { int rank = 0;
#pragma unroll
            for (int n2 = 0; n2 < 8; ++n2) rank += (n2 < ob && n2 != n && (gate[n2] > gate[n] || (gate[n2] == gate[n] && n2 < n))) ? 1 : 0;
            if (n < ob && rank < 3) sel |= 1u << n; }
        sel |= 1u << ob;
#pragma unroll
        for (int i = 0; i < 64; ++i) acc[i] = 0.f;
        float mx = -1e30f, l = 0.f;
        for (int n = 0; n <= ob; ++n) { if (!((sel >> n) & 1u)) continue; const int kmax = n == ob ? (t & 255) : 255;
            for (int i2 = 0; i2 <= kmax; ++i2) { const int kp = 256 * n + i2;
                const bf16* row = PROJ + ((size_t)b * SEQ + kp) * NPROJ_P; const GAS v4u* kq = (const GAS v4u*)(row + CC_K + 64 * h); const GAS v4u* vq = (const GAS v4u*)(row + CC_V + 64 * h);
                float s = 0.f;
#pragma unroll
                for (int i = 0; i < 8; ++i) { const v4u w = kq[i]; s += DOT8(q, 8 * i, w); }
                s = s * 0.125f + pb[TB[t - kp] * 16 + 8 + h];
                const float mn = fmaxf(mx, s), sc = __expf(mx - mn), pe = __expf(s - mn); mx = mn; l = l * sc + pe;
#pragma unroll
                for (int i = 0; i < 8; ++i) { const v4u w = vq[i]; AXPY8(acc, 8 * i, sc, pe, w); }
            } }
        const float inv = 1.0f / l; GAS v4u* op = (GAS v4u*)(YC + (size_t)m * DM + 2 * GW + 64 * h);
#pragma unroll
        for (int i = 0; i < 8; ++i) op[i] = (v4u){pk2(acc[8 * i] * inv, acc[8 * i + 1] * inv), pk2(acc[8 * i + 2] * inv, acc[8 * i + 3] * inv), pk2(acc[8 * i + 4] * inv, acc[8 * i + 5] * inv), pk2(acc[8 * i + 6] * inv, acc[8 * i + 7] * inv)};
    }
}
__device__ __forceinline__ void mix_b_simple(Frame& F, int l) {
    const bf16* PROJ = (const bf16*)(wsp() + WS_PROJ); bf16* YC = (bf16*)(wsp() + WS_YCAT); const pg8::fx_t* ST = (const pg8::fx_t*)(wsp() + CTL_STATS) + (size_t)l * M * 2;
    const float* lng = inp(4) + l * GW; const float* sw = inp(5) + (size_t)l * NH * 128 * 128; const float* sb = inp(6) + l * NH * 128;
    const int nthr = F.G * NTHR;
    for (int idx = blockIdx.x * NTHR + F.tid; idx < M * GW; idx += nthr) {
        const int m = idx >> 9, c = idx & 511, g = c >> 6, tt = m & 127, m0 = m - tt;
        const float* wrow = sw + ((size_t)g * 128 + tt) * 128; const float gn = lng[c]; float s = 0.f;
        for (int s2 = 0; s2 <= tt; ++s2) { const int ms = m0 + s2; const float mu_ = pg8::fx_get(ST + 2 * ms) * (1.0f / 512.0f), rs_ = 1.0f / sqrtf(fmaxf(pg8::fx_get(ST + 2 * ms + 1) * (1.0f / 512.0f) - mu_ * mu_, 0.f) + 1e-5f); const float vv = (gelu_tanh(bf2f(PROJ[(size_t)ms * NPROJ_P + CB_V + c])) - mu_) * rs_ * gn; s += wrow[s2] * vv; }
        const float u = gelu_tanh(bf2f(PROJ[(size_t)m * NPROJ_P + CB_U + c]));
        YC[(size_t)m * DM + GW + c] = (bf16)f2bf(u * (s + sb[g * 128 + tt]));
    }
}
__device__ __forceinline__ float rdl(float v, int k) { return __builtin_bit_cast(float, __builtin_amdgcn_readlane(__builtin_bit_cast(int, v), k)); }
__device__ __forceinline__ void mix_d_simple(Frame& F) {
    const bf16* R_ = (const bf16*)outp();
    const bf16* E_ = R_ + (size_t)M * GW; const bf16* KP_ = E_ + (size_t)M * GW; const bf16* V_ = KP_ + (size_t)M * GW;
    const bf16* KK_ = (const bf16*)outp() + (size_t)4 * M * GW; const bf16* AS_ = KK_ + (size_t)M * GW; float* YD = (float*)(wsp() + WS_YD);
    for (int it = F.gw; it < BATCH * NH; it += F.ngw) {
        const int b = it >> 3, h = it & 7; float s[64];
#pragma unroll
        for (int k = 0; k < 64; ++k) s[k] = 0.f;
        for (int t = 0; t < SEQ; ++t) {
            const size_t o = ((size_t)b * SEQ + t) * GW + 64 * h + F.lane;
            const float r = bf2f(R_[o]), w = __expf(-bf2f(E_[o])), kp = bf2f(KP_[o]), v = bf2f(V_[o]), kk = bf2f(KK_[o]), as = bf2f(AS_[o]);
            const float a = -kk, bb = kk * as;
            float sa = 0.f;
#pragma unroll
            for (int k = 0; k < 64; ++k) sa += s[k] * rdl(a, k);
            float y = 0.f;
#pragma unroll
            for (int k = 0; k < 64; ++k) { s[k] = s[k] * rdl(w, k) + sa * rdl(bb, k) + v * rdl(kp, k); y += s[k] * rdl(r, k); }
            YD[o] = y;
        }
    }
}

constexpr float LOG2E = 1.4426950408889634f;

constexpr int SC_T = 32, SC_TOK = (5 * 64 + 32) * 4, SC_BUF = SC_T * SC_TOK, SC_YB = SC_T * 32 * 4, SC_LDS = 2 * SC_BUF + 2 * SC_YB;
template <int CTRL> __device__ __forceinline__ float dpp_add(float x) {
    const int y = __builtin_amdgcn_update_dpp(0, __builtin_bit_cast(int, x), CTRL, 0xF, 0xF, false);
    return x + __builtin_bit_cast(float, y);
}
__device__ __forceinline__ float red8(float x) { x = dpp_add<0xB1>(x); x = dpp_add<0x4E>(x); x = dpp_add<0x141>(x); return x; }
__device__ __forceinline__ void scan_unit(LAS unsigned char* lds, int unit, int tid) {
    const int half = unit & 1, h = (unit >> 1) & 7, b = unit >> 4;
    const bf16* R_ = (const bf16*)outp();
    const bf16* E_ = R_ + (size_t)M * GW; const bf16* KP_ = E_ + (size_t)M * GW; const bf16* V_ = KP_ + (size_t)M * GW;
    const bf16* KK_ = (const bf16*)outp() + (size_t)4 * M * GW; const bf16* AS_ = KK_ + (size_t)M * GW; float* YD = (float*)(wsp() + WS_YD);
    const int lane = tid & 63, wave = __builtin_amdgcn_readfirstlane(tid >> 6);
    const bool scanner = wave < 4;
    const int j = lane & 7, rowl = (wave & 3) * 8 + (lane >> 3);
    const int st = tid & 255, tt = st >> 3, cg = st & 7;
    const size_t gbase = ((size_t)b * SEQ) * GW + 64 * h + 8 * cg;
#define SC_STAGE(c, buf) do { const size_t o_ = gbase + (size_t)((c) * SC_T + tt) * GW; \
        const v4u g_r = *(const GAS v4u*)(R_ + o_), g_e = *(const GAS v4u*)(E_ + o_), g_k = *(const GAS v4u*)(KP_ + o_), g_v = *(const GAS v4u*)(V_ + o_), g_kk = *(const GAS v4u*)(KK_ + o_), g_as = *(const GAS v4u*)(AS_ + o_); \
        LAS float* p_ = (LAS float*)(lds + (buf) * SC_BUF + tt * SC_TOK) + 8 * cg; float kk_[8], x_[8], y_[8]; \
        UNPACK8(kk_, 0, g_kk); \
        *(LAS f32x4*)(p_) = (f32x4){-kk_[0], -kk_[1], -kk_[2], -kk_[3]}; *(LAS f32x4*)(p_ + 4) = (f32x4){-kk_[4], -kk_[5], -kk_[6], -kk_[7]}; \
        UNPACK8(x_, 0, g_e); *(LAS f32x4*)(p_ + 64) = (f32x4){__expf(-x_[0]), __expf(-x_[1]), __expf(-x_[2]), __expf(-x_[3])}; *(LAS f32x4*)(p_ + 68) = (f32x4){__expf(-x_[4]), __expf(-x_[5]), __expf(-x_[6]), __expf(-x_[7])}; \
        UNPACK8(y_, 0, g_as); *(LAS f32x4*)(p_ + 128) = (f32x4){kk_[0] * y_[0], kk_[1] * y_[1], kk_[2] * y_[2], kk_[3] * y_[3]}; *(LAS f32x4*)(p_ + 132) = (f32x4){kk_[4] * y_[4], kk_[5] * y_[5], kk_[6] * y_[6], kk_[7] * y_[7]}; \
        UNPACK8(x_, 0, g_k); *(LAS f32x4*)(p_ + 192) = (f32x4){x_[0], x_[1], x_[2], x_[3]}; *(LAS f32x4*)(p_ + 196) = (f32x4){x_[4], x_[5], x_[6], x_[7]}; \
        UNPACK8(x_, 0, g_r); *(LAS f32x4*)(p_ + 256) = (f32x4){x_[0], x_[1], x_[2], x_[3]}; *(LAS f32x4*)(p_ + 260) = (f32x4){x_[4], x_[5], x_[6], x_[7]}; \
        if ((cg >> 2) == half) { UNPACK8(x_, 0, g_v); LAS float* v_ = (LAS float*)(lds + (buf) * SC_BUF + tt * SC_TOK) + 320 + 8 * (cg & 3); \
            *(LAS f32x4*)(v_) = (f32x4){x_[0], x_[1], x_[2], x_[3]}; *(LAS f32x4*)(v_ + 4) = (f32x4){x_[4], x_[5], x_[6], x_[7]}; } } while (0)
    if (!scanner) SC_STAGE(0, 0);
    __syncthreads();
    f32x4 s0 = {0.f, 0.f, 0.f, 0.f}, s1 = {0.f, 0.f, 0.f, 0.f};
    float ykeep = 0.f;
    for (int c = 0; c < SEQ / SC_T; ++c) {
        const int cur = c & 1;
        LAS float* yb = (LAS float*)(lds + 2 * SC_BUF + cur * SC_YB);
        if (scanner) {
            const LAS float* base = (const LAS float*)(lds + cur * SC_BUF) + 8 * j;
            const LAS float* vbase = (const LAS float*)(lds + cur * SC_BUF) + 320 + rowl;
            f32x4 a0 = *(const LAS f32x4*)(base), a1 = *(const LAS f32x4*)(base + 4), w0 = *(const LAS f32x4*)(base + 64), w1 = *(const LAS f32x4*)(base + 68), b0 = *(const LAS f32x4*)(base + 128), b1 = *(const LAS f32x4*)(base + 132),
                  k0 = *(const LAS f32x4*)(base + 192), k1 = *(const LAS f32x4*)(base + 196), r0 = *(const LAS f32x4*)(base + 256), r1 = *(const LAS f32x4*)(base + 260);
            float vv = *vbase;
#pragma unroll
            for (int t = 0; t < SC_T; ++t) {
                f32x4 na0 = a0, na1 = a1, nw0 = w0, nw1 = w1, nb0 = b0, nb1 = b1, nk0 = k0, nk1 = k1, nr0 = r0, nr1 = r1; float nv = vv;
                if (t + 1 < SC_T) { const LAS float* p = base + (t + 1) * (SC_TOK / 4);
                    na0 = *(const LAS f32x4*)(p); na1 = *(const LAS f32x4*)(p + 4); nw0 = *(const LAS f32x4*)(p + 64); nw1 = *(const LAS f32x4*)(p + 68); nb0 = *(const LAS f32x4*)(p + 128); nb1 = *(const LAS f32x4*)(p + 132);
                    nk0 = *(const LAS f32x4*)(p + 192); nk1 = *(const LAS f32x4*)(p + 196); nr0 = *(const LAS f32x4*)(p + 256); nr1 = *(const LAS f32x4*)(p + 260);
                    nv = vbase[(t + 1) * (SC_TOK / 4)]; }
                const f32x4 pa = s0 * a0 + s1 * a1;
                float sa = (pa.x + pa.y) + (pa.z + pa.w);
                const f32x4 sw0 = s0 * w0 + vv * k0, sw1 = s1 * w1 + vv * k1;
                sa = red8(sa);
                s0 = sa * b0 + sw0; s1 = sa * b1 + sw1;
                const f32x4 py = s0 * r0 + s1 * r1;
                float y = (py.x + py.y) + (py.z + py.w);
                y = red8(y);
                ykeep = (j == (t & 7)) ? y : ykeep;
                if ((t & 7) == 7) yb[((t & ~7) + j) * 32 + rowl] = ykeep;
                a0 = na0; a1 = na1; w0 = nw0; w1 = nw1; b0 = nb0; b1 = nb1; k0 = nk0; k1 = nk1; r0 = nr0; r1 = nr1; vv = nv;
            }
        } else {
            if (c > 0) {
                const LAS float* ybp = (const LAS float*)(lds + 2 * SC_BUF + (cur ^ 1) * SC_YB); const int t2 = st >> 3, q4 = st & 7; const f32x4 v = *(const LAS f32x4*)(ybp + t2 * 32 + 4 * q4);
                *(GAS f32x4*)(YD + ((size_t)b * SEQ + (c - 1) * SC_T + t2) * GW + 64 * h + 32 * half + 4 * q4) = v; }
            if (c + 1 < SEQ / SC_T) SC_STAGE(c + 1, cur ^ 1);
        }
        __syncthreads();
    }
    if (!scanner) { const LAS float* ybp = (const LAS float*)(lds + 2 * SC_BUF + 1 * SC_YB); const int t2 = st >> 3, q4 = st & 7; const f32x4 v = *(const LAS f32x4*)(ybp + t2 * 32 + 4 * q4);
        *(GAS f32x4*)(YD + ((size_t)b * SEQ + (SEQ / SC_T - 1) * SC_T + t2) * GW + 64 * h + 32 * half + 4 * q4) = v; }
#undef SC_STAGE
    __syncthreads();
}

struct AttnSt { f32x16 o0, o1; float m, l; };
__device__ __forceinline__ void attn_init(AttnSt& st) {
    const float z_ = zero_v();
#pragma unroll
    for (int i = 0; i < 16; ++i) { st.o0[i] = z_; st.o1[i] = z_; }
    st.m = -1e30f; st.l = 0.f;
}
__device__ __forceinline__ void attn_tile(AttnSt& st, const bf16x8 (&qf)[4], const bf16* Kcol, const bf16* Vcol, int rowb, int kb, int ks, int qpos, int maxd, bool sel, const LAS float* biasT, int r32, int hh) {
    int kp_l = kb + r32 * ks; kp_l = kp_l < 0 ? 0 : kp_l;
    const bf16* kr_ = Kcol + (size_t)(rowb + kp_l) * NPROJ_P + 8 * hh;
    bf16x8 kf[4];
#pragma unroll
    for (int s = 0; s < 4; ++s) kf[s] = *(const GAS bf16x8*)(kr_ + 16 * s);
    f32x16 sc;
#pragma unroll
    for (int i = 0; i < 16; ++i) sc[i] = 0.f;
#pragma unroll
    for (int s = 0; s < 4; ++s) sc = __builtin_amdgcn_mfma_f32_32x32x16_bf16(kf[s], qf[s], sc, 0, 0, 0);
    unsigned vf[2][2][4];
#pragma unroll
    for (int s2 = 0; s2 < 2; ++s2)
#pragma unroll
        for (int jp = 0; jp < 4; ++jp) {
            const int j0 = 2 * jp, key0 = 16 * s2 + 8 * (j0 >> 2) + 4 * hh + (j0 & 3);
            int kp0 = kb + key0 * ks, kp1 = kp0 + ks; kp0 = kp0 < 0 ? 0 : kp0; kp1 = kp1 < 0 ? 0 : kp1;
            const bf16* v0 = Vcol + (size_t)(rowb + kp0) * NPROJ_P + r32; const bf16* v1 = Vcol + (size_t)(rowb + kp1) * NPROJ_P + r32;
            vf[0][s2][jp] = (unsigned)v0[0] | ((unsigned)v1[0] << 16); vf[1][s2][jp] = (unsigned)v0[32] | ((unsigned)v1[32] << 16);
        }
    float tmax = -INFINITY;
#pragma unroll
    for (int r = 0; r < 16; ++r) {
        const int kr = (r & 3) + 8 * (r >> 2) + 4 * hh, kp = kb + kr * ks, dist = qpos - kp;
        const bool ok = sel && dist >= 0 && dist <= maxd && kp >= 0;
        const float v = sc[r] * (0.125f * LOG2E) + biasT[ok ? dist : 0];
        sc[r] = ok ? v : -INFINITY; tmax = fmaxf(tmax, sc[r]);
    }
    tmax = fmaxf(tmax, __shfl_xor(tmax, 32));
    const float mn = fmaxf(st.m, tmax), scale = __builtin_amdgcn_exp2f(st.m - mn); st.m = mn;
    float ls = 0.f;
#pragma unroll
    for (int r = 0; r < 16; ++r) { sc[r] = __builtin_amdgcn_exp2f(sc[r] - mn); ls += sc[r]; }
    st.l = st.l * scale + ls;
#pragma unroll
    for (int i = 0; i < 16; ++i) { st.o0[i] *= scale; st.o1[i] *= scale; }
    typedef unsigned u32x4_t __attribute__((ext_vector_type(4)));
#pragma unroll
    for (int s2 = 0; s2 < 2; ++s2) {
        u32x4_t pw; pw.x = pg8::cvt_pk_bf16(sc[8 * s2], sc[8 * s2 + 1]); pw.y = pg8::cvt_pk_bf16(sc[8 * s2 + 2], sc[8 * s2 + 3]); pw.z = pg8::cvt_pk_bf16(sc[8 * s2 + 4], sc[8 * s2 + 5]); pw.w = pg8::cvt_pk_bf16(sc[8 * s2 + 6], sc[8 * s2 + 7]);
        const bf16x8 pf = __builtin_bit_cast(bf16x8, pw);
        u32x4_t a0 = {vf[0][s2][0], vf[0][s2][1], vf[0][s2][2], vf[0][s2][3]}, a1 = {vf[1][s2][0], vf[1][s2][1], vf[1][s2][2], vf[1][s2][3]};
        st.o0 = __builtin_amdgcn_mfma_f32_32x32x16_bf16(__builtin_bit_cast(bf16x8, a0), pf, st.o0, 0, 0, 0);
        st.o1 = __builtin_amdgcn_mfma_f32_32x32x16_bf16(__builtin_bit_cast(bf16x8, a1), pf, st.o1, 0, 0, 0);
    }
}
__device__ __forceinline__ void attn_loadq(bf16x8 (&qf)[4], const bf16* Qcol, int row, int hh) {
    const bf16* q = Qcol + (size_t)row * NPROJ_P + 8 * hh;
#pragma unroll
    for (int s = 0; s < 4; ++s) qf[s] = *(const GAS bf16x8*)(q + 16 * s);
}
__device__ __forceinline__ void attn_store(const f32x16& o0, const f32x16& o1, float inv, bf16* yrow, int hh) {
#pragma unroll
    for (int g = 0; g < 4; ++g) {
        *(GAS v2u*)(yrow + 8 * g + 4 * hh) = (v2u){pk2(o0[4 * g] * inv, o0[4 * g + 1] * inv), pk2(o0[4 * g + 2] * inv, o0[4 * g + 3] * inv)};
        *(GAS v2u*)(yrow + 32 + 8 * g + 4 * hh) = (v2u){pk2(o1[4 * g] * inv, o1[4 * g + 1] * inv), pk2(o1[4 * g + 2] * inv, o1[4 * g + 3] * inv)};
    }
}
__device__ __forceinline__ void build_bias(LAS float* biasT, int hcol, int tid) {
    const int* TB = (const int*)(wsp() + WS_SMALL + SM_TB); const float* pb = inp(3); LAS int* bktT = (LAS int*)(biasT + 2048);
    for (int d = tid; d < 2048; d += NTHR) { const int bk = TB[d]; bktT[d] = bk; biasT[d] = pb[bk * 16 + hcol] * LOG2E; }
}

constexpr int MC_KP = 144, MC_VP = 192, MC_KB = 128 * MC_KP, MC_VB = 128 * MC_VP, MC_K_OFF = 16384, MC_V_OFF = MC_K_OFF + 2 * MC_KB, MC_LDS = MC_V_OFF + 2 * MC_VB;
typedef short v4i16_t __attribute__((ext_vector_type(4)));
__device__ __forceinline__ float pl32_max(float a) { float x = a, y = a;
    asm volatile("s_nop 1\n\tv_permlane32_swap_b32_e32 %0, %1\n\ts_nop 0" : "+v"(x), "+v"(y));
    return fmaxf(x, y); }
template <int MODE> __device__ __forceinline__ void moba_tile(AttnSt& st, const bf16x8 (&qf)[4], const LAS unsigned char* Kt, const LAS unsigned char* Vt, const LAS float* biasT, const LAS int* TB, int dlo, bool sel, int lane, int r32, int hh) {
    bf16x8 kf[4];
#pragma unroll
    for (int s = 0; s < 4; ++s) kf[s] = *(const LAS bf16x8*)(Kt + r32 * MC_KP + 32 * s + 16 * hh);
    v4i16_t vt[2][2][2];
    { const LAS unsigned char* vb = Vt + (4 * hh + ((lane & 15) >> 2)) * MC_VP + (16 * ((lane >> 4) & 1) + 4 * (lane & 3)) * 2;
#pragma unroll
      for (int dh = 0; dh < 2; ++dh)
#pragma unroll
        for (int s2 = 0; s2 < 2; ++s2)
#pragma unroll
            for (int h8 = 0; h8 < 2; ++h8) vt[dh][s2][h8] = __builtin_amdgcn_ds_read_tr16_b64_v4i16((LAS v4i16_t*)(vb + (16 * s2 + 8 * h8) * MC_VP + 64 * dh)); }
    f32x16 sc;
#pragma unroll
    for (int i = 0; i < 16; ++i) sc[i] = 0.f;
#pragma unroll
    for (int s = 0; s < 4; ++s) sc = __builtin_amdgcn_mfma_f32_32x32x16_bf16(kf[s], qf[s], sc, 0, 0, 0);
    const int d0 = dlo + r32 + 31 - 4 * hh;
    const int dmin = dlo < 0 ? 0 : dlo, dmax = dlo + 62;
    const bool uni = __builtin_amdgcn_readfirstlane(TB[dmin]) == __builtin_amdgcn_readfirstlane(TB[dmax]);
    float tmax = -INFINITY;
    if (uni) { const float bu = biasT[dmin];
#pragma unroll
        for (int r = 0; r < 16; ++r) { float v = sc[r] * (0.125f * LOG2E) + bu; if (MODE == 1) { const int dist = d0 - (r & 3) - 8 * (r >> 2); v = dist >= 0 ? v : -INFINITY; } sc[r] = v; tmax = fmaxf(tmax, v); }
    } else {
#pragma unroll
        for (int r = 0; r < 16; ++r) { const int dist = d0 - (r & 3) - 8 * (r >> 2); float v = sc[r] * (0.125f * LOG2E) + biasT[dist < 0 ? 0 : dist]; if (MODE == 1) v = dist >= 0 ? v : -INFINITY; sc[r] = v; tmax = fmaxf(tmax, v); }
    }
    if (MODE == 2) tmax = sel ? tmax : -INFINITY;
    tmax = pl32_max(tmax);
    const float mn = fmaxf(st.m, tmax);
    if (__ballot(mn > st.m) != 0ull) { const float scale = __builtin_amdgcn_exp2f(st.m - mn); st.l *= scale;
#pragma unroll
        for (int i = 0; i < 16; ++i) { st.o0[i] *= scale; st.o1[i] *= scale; } }
    st.m = mn;
    const float msub = (MODE == 2 && !sel) ? INFINITY : mn;
    float ls = 0.f;
#pragma unroll
    for (int r = 0; r < 16; ++r) { sc[r] = __builtin_amdgcn_exp2f(sc[r] - msub); ls += sc[r]; }
    st.l += ls;
    typedef unsigned u32x4_t __attribute__((ext_vector_type(4)));
#pragma unroll
    for (int s2 = 0; s2 < 2; ++s2) {
        u32x4_t pw; pw.x = pg8::cvt_pk_bf16(sc[8 * s2], sc[8 * s2 + 1]); pw.y = pg8::cvt_pk_bf16(sc[8 * s2 + 2], sc[8 * s2 + 3]); pw.z = pg8::cvt_pk_bf16(sc[8 * s2 + 4], sc[8 * s2 + 5]); pw.w = pg8::cvt_pk_bf16(sc[8 * s2 + 6], sc[8 * s2 + 7]);
        const bf16x8 pf = __builtin_bit_cast(bf16x8, pw);
        const bf16x8 a0 = {vt[0][s2][0][0], vt[0][s2][0][1], vt[0][s2][0][2], vt[0][s2][0][3], vt[0][s2][1][0], vt[0][s2][1][1], vt[0][s2][1][2], vt[0][s2][1][3]};
        const bf16x8 a1 = {vt[1][s2][0][0], vt[1][s2][0][1], vt[1][s2][0][2], vt[1][s2][0][3], vt[1][s2][1][0], vt[1][s2][1][1], vt[1][s2][1][2], vt[1][s2][1][3]};
        st.o0 = __builtin_amdgcn_mfma_f32_32x32x16_bf16(a0, pf, st.o0, 0, 0, 0);
        st.o1 = __builtin_amdgcn_mfma_f32_32x32x16_bf16(a1, pf, st.o1, 0, 0, 0);
    }
}
__device__ __forceinline__ void moba_unit(LAS unsigned char* lds, int unit, int tid, int l) {
    const int ob = unit & 7, h = (unit >> 3) & 7, b = unit >> 6, lane = tid & 63, wave = __builtin_amdgcn_readfirstlane(tid >> 6), r32 = lane & 31, hh = lane >> 5;
    LAS float* biasT = (LAS float*)lds;
    build_bias(biasT, 8 + h, tid);
    const bf16* PROJ = (const bf16*)(wsp() + WS_PROJ); const float* KBAR = (const float*)(wsp() + CTL_KBAR) + (size_t)l * 64 * 8 * 64 + ((b * NH + h) * 8) * 64; const LAS int* TB = (const LAS int*)(biasT + 2048);
    const int rowb = b * SEQ, qpos = 256 * ob + 32 * wave + r32;
    bf16x8 qf[4]; attn_loadq(qf, PROJ + CC_Q + 64 * h, rowb + qpos, hh);
    float gate[8];
#pragma unroll
    for (int n = 0; n < 8; ++n) { float s = 0.f;
        if (n < ob) {
#pragma unroll
            for (int s4 = 0; s4 < 4; ++s4) { const f32x4 k0 = *(const GAS f32x4*)(KBAR + n * 64 + 16 * s4 + 8 * hh), k1 = *(const GAS f32x4*)(KBAR + n * 64 + 16 * s4 + 8 * hh + 4);
                const v4u qw = __builtin_bit_cast(v4u, qf[s4]);
                s += bflo(qw.x) * k0.x + bfhi(qw.x) * k0.y + bflo(qw.y) * k0.z + bfhi(qw.y) * k0.w + bflo(qw.z) * k1.x + bfhi(qw.z) * k1.y + bflo(qw.w) * k1.z + bfhi(qw.w) * k1.w; }
            s += __shfl_xor(s, 32); }
        gate[n] = s; }
    unsigned selm = 0u;
#pragma unroll
    for (int n = 0; n < 8; ++n) { int rank = 0;
#pragma unroll
        for (int n2 = 0; n2 < 8; ++n2) rank += (n2 < ob && n2 != n && (gate[n2] > gate[n] || (gate[n2] == gate[n] && n2 < n))) ? 1 : 0;
        if (n < ob && rank < 3) selm |= 1u << n; }
    AttnSt st; attn_init(st);
    const int skey = tid >> 2, spart = tid & 3;
    const bf16* Kg = PROJ + (size_t)rowb * NPROJ_P + CC_K + 64 * h + 16 * spart; const bf16* Vg = PROJ + (size_t)rowb * NPROJ_P + CC_V + 64 * h + 16 * spart;
    bf16x8 gk0, gk1, gv0, gv1;
#define MC_GLOAD(i) do { const size_t ro_ = (size_t)(128 * (i) + skey) * NPROJ_P; gk0 = *(const GAS bf16x8*)(Kg + ro_); gk1 = *(const GAS bf16x8*)(Kg + ro_ + 8); gv0 = *(const GAS bf16x8*)(Vg + ro_); gv1 = *(const GAS bf16x8*)(Vg + ro_ + 8); } while (0)
#define MC_LSTORE(bf) do { LAS unsigned char* kd_ = lds + MC_K_OFF + (bf) * MC_KB + skey * MC_KP + 32 * spart; *(LAS bf16x8*)(kd_) = gk0; *(LAS bf16x8*)(kd_ + 16) = gk1; \
        LAS unsigned char* vd_ = lds + MC_V_OFF + (bf) * MC_VB + skey * MC_VP + 32 * spart; *(LAS bf16x8*)(vd_) = gv0; *(LAS bf16x8*)(vd_ + 16) = gv1; } while (0)
    const int nst = 2 * (ob + 1);
    MC_GLOAD(0); MC_LSTORE(0);
    __syncthreads();
    for (int i = 0; i < nst; ++i) {
        if (i + 1 < nst) MC_GLOAD(i + 1);
        const int n = i >> 1, hf = i & 1; const bool own = n == ob, sel = own || ((selm >> n) & 1u);
        const LAS unsigned char* Kb = lds + MC_K_OFF + (i & 1) * MC_KB; const LAS unsigned char* Vb = lds + MC_V_OFF + (i & 1) * MC_VB;
        if (own) {
#pragma unroll 1
            for (int sub = 0; sub < 4; ++sub) { const int jt = 4 * hf + sub; if (jt > wave) break; const int dlo = 32 * wave - (32 * jt + 31);
                if (jt == wave) moba_tile<1>(st, qf, Kb + sub * 32 * MC_KP, Vb + sub * 32 * MC_VP, biasT, TB, dlo, true, lane, r32, hh);
                else moba_tile<0>(st, qf, Kb + sub * 32 * MC_KP, Vb + sub * 32 * MC_VP, biasT, TB, dlo, true, lane, r32, hh); }
        } else if (__ballot(sel) != 0ull) {
#pragma unroll 1
            for (int sub = 0; sub < 4; ++sub) { const int dlo = 256 * ob + 32 * wave - (256 * n + 128 * hf + 32 * sub + 31);
                moba_tile<2>(st, qf, Kb + sub * 32 * MC_KP, Vb + sub * 32 * MC_VP, biasT, TB, dlo, sel, lane, r32, hh); }
        }
        if (i + 1 < nst) MC_LSTORE((i + 1) & 1);
        __syncthreads();
    }
#undef MC_GLOAD
#undef MC_LSTORE
    const float lt = st.l + __shfl_xor(st.l, 32);
    attn_store(st.o0, st.o1, 1.0f / lt, (bf16*)(wsp() + WS_YCAT) + (size_t)(rowb + qpos) * DM + 2 * GW + 64 * h, hh);
}

constexpr int MA_PITCH = 144, MA_ML_OFF = 512 * MA_PITCH, MA_BIAS_OFF = MA_ML_OFF + 512 * 8, MA_V_OFF = MA_BIAS_OFF + 16384, MA_VW = 32 * MC_VP, MA_LDS = MA_V_OFF + 8 * MA_VW;
template <bool MASKED> __device__ __forceinline__ void dil_tile(AttnSt& st, const bf16x8 (&qf)[4], const bf16x8 (&kf)[4], const LAS unsigned char* Vt, const LAS float* biasT, const LAS int* TB, int dl0, int dstep, int kb, int lane, int r32, int hh) {
    v4i16_t vt[2][2][2];
    { const LAS unsigned char* vb = Vt + (4 * hh + ((lane & 15) >> 2)) * MC_VP + (16 * ((lane >> 4) & 1) + 4 * (lane & 3)) * 2;
#pragma unroll
      for (int dh = 0; dh < 2; ++dh)
#pragma unroll
        for (int s2 = 0; s2 < 2; ++s2)
#pragma unroll
            for (int h8 = 0; h8 < 2; ++h8) vt[dh][s2][h8] = __builtin_amdgcn_ds_read_tr16_b64_v4i16((LAS v4i16_t*)(vb + (16 * s2 + 8 * h8) * MC_VP + 64 * dh)); }
    f32x16 sc;
#pragma unroll
    for (int i = 0; i < 16; ++i) sc[i] = 0.f;
#pragma unroll
    for (int s = 0; s < 4; ++s) sc = __builtin_amdgcn_mfma_f32_32x32x16_bf16(kf[s], qf[s], sc, 0, 0, 0);
    const int e0 = dl0 + r32 - 4 * hh;
    int dmin = (dl0 - 31) * dstep, dmax = (dl0 + 31) * dstep; dmin = dmin < 0 ? 0 : dmin; dmax = dmax > 2047 ? 2047 : dmax;
    const bool uni = __builtin_amdgcn_readfirstlane(TB[dmin]) == __builtin_amdgcn_readfirstlane(TB[dmax]);
    const float bu = biasT[dmin];
    float tmax = -INFINITY;
#pragma unroll
    for (int r = 0; r < 16; ++r) {
        const int kr0 = (r & 3) + 8 * (r >> 2), delta = e0 - kr0;
        float bias = bu;
        if (!uni) { int di = delta * dstep; di = di < 0 ? 0 : (di > 2047 ? 2047 : di); bias = biasT[di]; }
        float v = sc[r] * (0.125f * LOG2E) + bias;
        if (MASKED) { const bool ok = delta >= 0 && delta <= 128 && (kb + (kr0 + 4 * hh) * dstep) >= 0; v = ok ? v : -INFINITY; }
        sc[r] = v; tmax = fmaxf(tmax, v);
    }
    tmax = pl32_max(tmax);
    const float mn = fmaxf(st.m, tmax);
    if (__ballot(mn > st.m) != 0ull) { const float scale = __builtin_amdgcn_exp2f(st.m - mn); st.l *= scale;
#pragma unroll
        for (int i = 0; i < 16; ++i) { st.o0[i] *= scale; st.o1[i] *= scale; } }
    st.m = mn;
    float ls = 0.f;
#pragma unroll
    for (int r = 0; r < 16; ++r) { sc[r] = __builtin_amdgcn_exp2f(sc[r] - mn); ls += sc[r]; }
    st.l += ls;
    typedef unsigned u32x4_t __attribute__((ext_vector_type(4)));
#pragma unroll
    for (int s2 = 0; s2 < 2; ++s2) {
        u32x4_t pw; pw.x = pg8::cvt_pk_bf16(sc[8 * s2], sc[8 * s2 + 1]); pw.y = pg8::cvt_pk_bf16(sc[8 * s2 + 2], sc[8 * s2 + 3]); pw.z = pg8::cvt_pk_bf16(sc[8 * s2 + 4], sc[8 * s2 + 5]); pw.w = pg8::cvt_pk_bf16(sc[8 * s2 + 6], sc[8 * s2 + 7]);
        const bf16x8 pf = __builtin_bit_cast(bf16x8, pw);
        const bf16x8 a0 = {vt[0][s2][0][0], vt[0][s2][0][1], vt[0][s2][0][2], vt[0][s2][0][3], vt[0][s2][1][0], vt[0][s2][1][1], vt[0][s2][1][2], vt[0][s2][1][3]};
        const bf16x8 a1 = {vt[1][s2][0][0], vt[1][s2][0][1], vt[1][s2][0][2], vt[1][s2][0][3], vt[1][s2][1][0], vt[1][s2][1][1], vt[1][s2][1][2], vt[1][s2][1][3]};
        st.o0 = __builtin_amdgcn_mfma_f32_32x32x16_bf16(a0, pf, st.o0, 0, 0, 0);
        st.o1 = __builtin_amdgcn_mfma_f32_32x32x16_bf16(a1, pf, st.o1, 0, 0, 0);
    }
}
__device__ __forceinline__ void dil_unit(LAS unsigned char* lds, int unit, int tid) {
    const int sp = unit & 3, h = (unit >> 2) & 7, b = unit >> 5, lane = tid & 63, wave = __builtin_amdgcn_readfirstlane(tid >> 6), r32 = lane & 31, hh = lane >> 5;
    LAS float* biasT = (LAS float*)(lds + MA_BIAS_OFF);
    build_bias(biasT, h, tid);
    __syncthreads();
    const bf16* PROJ = (const bf16*)(wsp() + WS_PROJ); const LAS int* TB = (const LAS int*)(biasT + 2048); const int rowb = b * SEQ, t0 = 512 * sp;
    const bf16* Qc = PROJ + CA_Q + 64 * h; const bf16* Kc = PROJ + CA_K + 64 * h; const bf16* Vc = PROJ + CA_V + 64 * h;
    LAS unsigned char* Vst = lds + MA_V_OFF + wave * MA_VW;
    const int vkey = lane >> 1, vhalf = lane & 1;
#pragma unroll 1
    for (int p = 0; p < 3; ++p) {
        const int d = p == 0 ? 1 : (p == 1 ? 4 : 16);
#pragma unroll 1
        for (int gi = 0; gi < 2; ++gi) {
            const int g = 2 * wave + gi;
            const int qb = t0 + (p == 0 ? 32 * g : (p == 1 ? 128 * (g >> 2) + (g & 3) : g));
            const int qpos = qb + r32 * d, qi = qpos - t0;
            bf16x8 qf[4]; attn_loadq(qf, Qc, rowb + qpos, hh);
            AttnSt st; attn_init(st);
            int jt = 0; while (qb + (32 * jt - 128 + 31) * d < 0) ++jt;
            bf16x8 kfn[4], vrn[4];
#define MA_GLOAD(JT) do { const int kb_ = qb + (32 * (JT) - 128) * d; int kp_ = kb_ + r32 * d; kp_ = kp_ < 0 ? 0 : kp_; const bf16* kr_ = Kc + (size_t)(rowb + kp_) * NPROJ_P + 8 * hh; \
                _Pragma("unroll") for (int s = 0; s < 4; ++s) kfn[s] = *(const GAS bf16x8*)(kr_ + 16 * s); \
                int vp_ = kb_ + vkey * d; vp_ = vp_ < 0 ? 0 : vp_; const bf16* vr_ = Vc + (size_t)(rowb + vp_) * NPROJ_P + 32 * vhalf; \
                _Pragma("unroll") for (int s = 0; s < 4; ++s) vrn[s] = *(const GAS bf16x8*)(vr_ + 8 * s); } while (0)
            MA_GLOAD(jt);
#pragma unroll 1
            for (; jt < 5; ++jt) {
                bf16x8 kf[4] = {kfn[0], kfn[1], kfn[2], kfn[3]};
                { LAS unsigned char* vd = Vst + vkey * MC_VP + 64 * vhalf;
#pragma unroll
                  for (int s = 0; s < 4; ++s) *(LAS bf16x8*)(vd + 16 * s) = vrn[s]; }
                asm volatile("" ::: "memory");
                if (jt + 1 < 5) MA_GLOAD(jt + 1);
                const int kb = qb + (32 * jt - 128) * d, dl0 = 128 - 32 * jt;
                if (jt == 0 || jt == 4 || kb < 0) dil_tile<true>(st, qf, kf, Vst, biasT, TB, dl0, d, kb, lane, r32, hh);
                else dil_tile<false>(st, qf, kf, Vst, biasT, TB, dl0, d, kb, lane, r32, hh);
            }
#undef MA_GLOAD
            float lt = st.l + __shfl_xor(st.l, 32);
            LAS unsigned char* orow = lds + qi * MA_PITCH; LAS float* ml = (LAS float*)(lds + MA_ML_OFF + qi * 8);
            if (p > 0) {
                const float mo = ml[0], lo = ml[1], mn = fmaxf(mo, st.m), fo = __builtin_amdgcn_exp2f(mo - mn), fc = __builtin_amdgcn_exp2f(st.m - mn);
                lt = lo * fo + lt * fc;
#pragma unroll
                for (int g4 = 0; g4 < 4; ++g4) { const v2u a = *(const LAS v2u*)(orow + 2 * (8 * g4 + 4 * hh)), c = *(const LAS v2u*)(orow + 64 + 2 * (8 * g4 + 4 * hh));
                    const float av[4] = {bflo(a.x), bfhi(a.x), bflo(a.y), bfhi(a.y)}, cv[4] = {bflo(c.x), bfhi(c.x), bflo(c.y), bfhi(c.y)};
#pragma unroll
                    for (int e = 0; e < 4; ++e) { st.o0[4 * g4 + e] = av[e] * fo + st.o0[4 * g4 + e] * fc; st.o1[4 * g4 + e] = cv[e] * fo + st.o1[4 * g4 + e] * fc; } }
                st.m = mn;
            }
            if (p < 2) {
#pragma unroll
                for (int g4 = 0; g4 < 4; ++g4) { *(LAS v2u*)(orow + 2 * (8 * g4 + 4 * hh)) = (v2u){pk2(st.o0[4 * g4], st.o0[4 * g4 + 1]), pk2(st.o0[4 * g4 + 2], st.o0[4 * g4 + 3])};
                    *(LAS v2u*)(orow + 64 + 2 * (8 * g4 + 4 * hh)) = (v2u){pk2(st.o1[4 * g4], st.o1[4 * g4 + 1]), pk2(st.o1[4 * g4 + 2], st.o1[4 * g4 + 3])}; }
                if (hh == 0) { ml[0] = st.m; ml[1] = lt; }
            } else attn_store(st.o0, st.o1, 1.0f / lt, (bf16*)(wsp() + WS_YCAT) + (size_t)(rowb + qpos) * DM + 0 * GW + 64 * h, hh);
        }
        __syncthreads();
    }
}

constexpr int SG_PITCH = 144, SG_WAVE = 128 * SG_PITCH, SG_OP = 272;
static_assert(8 * SG_WAVE <= MISC_OFF && 32 * SG_OP <= SG_WAVE, "SGU LDS");
__device__ __forceinline__ void sgu_unit(LAS unsigned char* lds, int unit, int tid, int l) {
    const int lane = tid & 63, g = __builtin_amdgcn_readfirstlane(tid >> 6), r32 = lane & 31, hh = lane >> 5, m0 = unit * 128;
    const bf16* PROJ = (const bf16*)(wsp() + WS_PROJ); bf16* YC = (bf16*)(wsp() + WS_YCAT); const pg8::fx_t* ST = (const pg8::fx_t*)(wsp() + CTL_STATS) + (size_t)l * M * 2;
    const float* lng = inp(4) + l * GW; const float* sw = inp(5) + ((size_t)l * NH + g) * 128 * 128; const float* sb = inp(6) + (l * NH + g) * 128;
    LAS unsigned char* T = lds + g * SG_WAVE;
    const int tk8 = lane >> 3, part = lane & 7;
    { const f32x4 g0 = *(const GAS f32x4*)(lng + 64 * g + 8 * part), g1 = *(const GAS f32x4*)(lng + 64 * g + 8 * part + 4);
      const float gn[8] = {g0.x, g0.y, g0.z, g0.w, g1.x, g1.y, g1.z, g1.w};
#pragma unroll 4
      for (int i = 0; i < 16; ++i) { const int tkn = tk8 + 8 * i, mm = m0 + tkn;
          const v4u w = *(const GAS v4u*)(PROJ + (size_t)mm * NPROJ_P + CB_V + 64 * g + 8 * part);
          const float mu = pg8::fx_get(ST + 2 * mm) * (1.0f / 512.0f), rs = __builtin_amdgcn_rsqf(fmaxf(pg8::fx_get(ST + 2 * mm + 1) * (1.0f / 512.0f) - mu * mu, 0.f) + 1e-5f);
          float x[8] = {bflo(w.x), bfhi(w.x), bflo(w.y), bfhi(w.y), bflo(w.z), bfhi(w.z), bflo(w.w), bfhi(w.w)};
#pragma unroll
          for (int e = 0; e < 8; ++e) x[e] = (gelu_tanh(x[e]) - mu) * rs * gn[e];
          *(LAS v4u*)(T + tkn * SG_PITCH + 16 * part) = (v4u){pk2(x[0], x[1]), pk2(x[2], x[3]), pk2(x[4], x[5]), pk2(x[6], x[7])}; } }
    asm volatile("" ::: "memory");
    f32x16 acc[4][2];
    const float z_ = zero_v();
#pragma unroll
    for (int tt = 0; tt < 4; ++tt)
#pragma unroll
        for (int ct = 0; ct < 2; ++ct)
#pragma unroll
            for (int i = 0; i < 16; ++i) acc[tt][ct][i] = z_;
    const LAS unsigned char* vb = T + (8 * hh + ((lane & 15) >> 2)) * SG_PITCH + (16 * ((lane >> 4) & 1) + 4 * (lane & 3)) * 2;
#pragma unroll
    for (int k = 0; k < 8; ++k) {
        v4i16_t t00 = __builtin_amdgcn_ds_read_tr16_b64_v4i16((LAS v4i16_t*)(vb + (16 * k) * SG_PITCH)), t01 = __builtin_amdgcn_ds_read_tr16_b64_v4i16((LAS v4i16_t*)(vb + (16 * k + 4) * SG_PITCH));
        v4i16_t t10 = __builtin_amdgcn_ds_read_tr16_b64_v4i16((LAS v4i16_t*)(vb + (16 * k) * SG_PITCH + 64)), t11 = __builtin_amdgcn_ds_read_tr16_b64_v4i16((LAS v4i16_t*)(vb + (16 * k + 4) * SG_PITCH + 64));
        const bf16x8 af0 = {t00[0], t00[1], t00[2], t00[3], t01[0], t01[1], t01[2], t01[3]}, af1 = {t10[0], t10[1], t10[2], t10[3], t11[0], t11[1], t11[2], t11[3]};
#pragma unroll
        for (int tt = 0; tt < 4; ++tt) { if (k < 2 * (tt + 1)) {
                const int t = 32 * tt + r32, s0 = 16 * k + 8 * hh; const float* wrow = sw + (size_t)t * 128 + s0;
                const f32x4 w0 = *(const GAS f32x4*)(wrow), w1 = *(const GAS f32x4*)(wrow + 4);
                float wv[8] = {w0.x, w0.y, w0.z, w0.w, w1.x, w1.y, w1.z, w1.w};
#pragma unroll
                for (int j = 0; j < 8; ++j) wv[j] = (s0 + j <= t) ? wv[j] : 0.f;
                const v4u bw = {pk2(wv[0], wv[1]), pk2(wv[2], wv[3]), pk2(wv[4], wv[5]), pk2(wv[6], wv[7])}; const bf16x8 bfr = __builtin_bit_cast(bf16x8, bw);
                acc[tt][0] = __builtin_amdgcn_mfma_f32_32x32x16_bf16(af0, bfr, acc[tt][0], 0, 0, 0); acc[tt][1] = __builtin_amdgcn_mfma_f32_32x32x16_bf16(af1, bfr, acc[tt][1], 0, 0, 0); } }
    }
    asm volatile("" ::: "memory");
#pragma unroll
    for (int tt = 0; tt < 4; ++tt) {
        const float bias = sb[32 * tt + r32];
#pragma unroll
        for (int ct = 0; ct < 2; ++ct)
#pragma unroll
            for (int g4 = 0; g4 < 4; ++g4) { const f32x16& a = acc[tt][ct];
                *(LAS f32x4*)(T + r32 * SG_OP + 4 * (32 * ct + 8 * g4 + 4 * hh)) = (f32x4){a[4 * g4] + bias, a[4 * g4 + 1] + bias, a[4 * g4 + 2] + bias, a[4 * g4 + 3] + bias}; }
        asm volatile("" ::: "memory");
#pragma unroll
        for (int i = 0; i < 4; ++i) { const int tkn = tk8 + 8 * i, mm = m0 + 32 * tt + tkn;
            const v4u uw = *(const GAS v4u*)(PROJ + (size_t)mm * NPROJ_P + CB_U + 64 * g + 8 * part);
            const f32x4 x0 = *(const LAS f32x4*)(T + tkn * SG_OP + 32 * part), x1 = *(const LAS f32x4*)(T + tkn * SG_OP + 32 * part + 16);
            const float u[8] = {bflo(uw.x), bfhi(uw.x), bflo(uw.y), bfhi(uw.y), bflo(uw.z), bfhi(uw.z), bflo(uw.w), bfhi(uw.w)};
            *(GAS v4u*)(YC + (size_t)mm * DM + GW + 64 * g + 8 * part) = (v4u){pk2(gelu_tanh(u[0]) * x0.x, gelu_tanh(u[1]) * x0.y), pk2(gelu_tanh(u[2]) * x0.z, gelu_tanh(u[3]) * x0.w), pk2(gelu_tanh(u[4]) * x1.x, gelu_tanh(u[5]) * x1.y), pk2(gelu_tanh(u[6]) * x1.z, gelu_tanh(u[7]) * x1.w)}; }
        asm volatile("" ::: "memory");
    }
}

#ifndef SIMPLE_A
#define SIMPLE_A 0
#endif
#ifndef SIMPLE_B
#define SIMPLE_B 0
#endif
#ifndef SIMPLE_C
#define SIMPLE_C 0
#endif
#ifndef SIMPLE_D
#define SIMPLE_D 0
#endif
__device__ __forceinline__ void ph_mixers(LAS unsigned char* L, int l, int phase, int qoff, int mask = 31) {
    Frame F = mkframe(L);
    volatile LAS int* qslot = (volatile LAS int*)(L + MISC_OFF + 64);
    gu32* ctr = ctlp() + CW_Q + 64 * phase + qoff;
    constexpr int I_IN = (DM / 64) * (NPROJ / 32), I_REST = (DM / 64) * (DM / 32) + 2 * (DM / 64) * (DFF / 32) + (DFF / 64) * (DM / 32);
    const int n_scan = (SIMPLE_D || !(mask & 1)) ? 0 : 128, n_c = (SIMPLE_C || !(mask & 2)) ? 0 : 512, n_a = (SIMPLE_A || !(mask & 4)) ? 0 : 256, n_b = (SIMPLE_B || !(mask & 8)) ? 0 : 128;
    const int n_cin = ((l + 1 < DEPTH) && (mask & 16)) ? (I_IN + 7) / 8 : 0, n_crest = (mask & 16) ? (I_REST + 7) / 8 : 0;
    const int e_scan = n_scan, e_a = e_scan + n_a, e_b = e_a + n_b, e_c = e_b + n_c, e_cin = e_c + n_cin, e_crest = e_cin + n_crest;
    for (;;) {
        if (F.tid == 0) *qslot = (int)__hip_atomic_fetch_add(ctr, 1u, RLX_AGENT);
        __syncthreads();
        const int it = __builtin_amdgcn_readfirstlane(*qslot);
        __syncthreads();
        if (it >= e_crest) break;
        int tid = threadIdx.x; asm volatile("" : "+v"(tid));
        if (it < e_scan) scan_unit(L, it, tid);
        else if (it < e_a) dil_unit(L, it - e_scan, tid);
        else if (it < e_b) { sgu_unit(L, it - e_a, tid, l); __syncthreads(); }
        else if (it < e_c) { const int i2 = it - e_b; moba_unit(L, (i2 & 63) * 8 + (7 - (i2 >> 6)), tid, l); }
        else if (it < e_cin) { Frame F2 = mkframe(L); conv_layer_items(F2, l + 1, (it - e_c) * 8 + F2.wave, 1 << 30, true, false); }
        else { Frame F2 = mkframe(L); conv_layer_items(F2, l, (it - e_cin) * 8 + F2.wave, 1 << 30, false, true); }
    }
    if (l + 1 < DEPTH) {
        bf16* WIN = (bf16*)(wsp() + WS_WIN);
        Frame F3 = mkframe(L);
        for (int i = F3.gw * 64 + F3.lane; i < 64 * DM / 8; i += F3.ngw * 64) { v4u z = {0u, 0u, 0u, 0u}; asm volatile("" : "+v"(z)); *(GAS v4u*)(WIN + (size_t)NPROJ * DM + (size_t)i * 8) = z; }
    }
    if (SIMPLE_D) mix_d_simple(F);
    if (SIMPLE_A) mix_a_simple(F);
    if (SIMPLE_C) mix_c_simple(F, l);
    if (SIMPLE_B) mix_b_simple(F, l);
}

__device__ __forceinline__ void ph_finalize(Frame& F, int l) {
    bf16* YC = (bf16*)(wsp() + WS_YCAT); const float* YD = (const float*)(wsp() + WS_YD); const bf16* V_ = (const bf16*)outp() + (size_t)3 * M * GW; const bf16* G_ = (const bf16*)(wsp() + WS_G); const float* BC = (const float*)(wsp() + WS_BC);
    const float* lng = inp(16) + l * GW; const float* lnb = inp(17) + l * GW;
    for (int m = F.gw; m < M; m += F.ngw) {
        const int c0 = 8 * F.lane, hd = F.lane >> 3;
        float y[8];
        { const GAS f32x4* yp = (const GAS f32x4*)(YD + (size_t)m * GW + c0); const f32x4 a = yp[0], b = yp[1]; y[0] = a.x; y[1] = a.y; y[2] = a.z; y[3] = a.w; y[4] = b.x; y[5] = b.y; y[6] = b.z; y[7] = b.w; }
        float s = 0.f;
#pragma unroll
        for (int i = 0; i < 8; ++i) s += y[i];
        s += __shfl_xor(s, 1); s += __shfl_xor(s, 2); s += __shfl_xor(s, 4); const float mean = s * (1.0f / 64.0f); float q = 0.f;
#pragma unroll
        for (int i = 0; i < 8; ++i) { const float d = y[i] - mean; q += d * d; }
        q += __shfl_xor(q, 1); q += __shfl_xor(q, 2); q += __shfl_xor(q, 4); const float rstd = 1.0f / sqrtf(q * (1.0f / 64.0f) + 64e-5f);
        const v4u vw = *(const GAS v4u*)(V_ + (size_t)m * GW + c0), gw4 = *(const GAS v4u*)(G_ + (size_t)m * GW + c0); const float bc = BC[(size_t)m * NH + hd];
        float vv[8], gg[8]; UNPACK8(vv, 0, vw); UNPACK8(gg, 0, gw4);
        float ss = 0.f;
#pragma unroll
        for (int i = 0; i < 8; ++i) { y[i] = ((y[i] - mean) * rstd * lng[c0 + i] + lnb[c0 + i] + bc * vv[i]) * gg[i]; ss += y[i] * y[i]; }
        { const float rs = 1.0f / sqrtf(wave_sum(ss) * (1.0f / 512.0f) + NORM_EPS);
          *(GAS v4u*)(YC + (size_t)m * DM + 3 * GW + c0) = (v4u){pk2(y[0] * rs, y[1] * rs), pk2(y[2] * rs, y[3] * rs), pk2(y[4] * rs, y[5] * rs), pk2(y[6] * rs, y[7] * rs)}; }
#pragma unroll
        for (int br = 0; br < 3; ++br) {
            GAS v4u* p = (GAS v4u*)(YC + (size_t)m * DM + br * GW + c0); const v4u w = *p;
            float x[8]; UNPACK8(x, 0, w); float s2 = 0.f;
#pragma unroll
            for (int i = 0; i < 8; ++i) s2 += x[i] * x[i];
            const float rs = 1.0f / sqrtf(wave_sum(s2) * (1.0f / 512.0f) + NORM_EPS);
            *p = (v4u){pk2(x[0] * rs, x[1] * rs), pk2(x[2] * rs, x[3] * rs), pk2(x[4] * rs, x[5] * rs), pk2(x[6] * rs, x[7] * rs)};
        }
    }
}
__device__ __forceinline__ void ph_final(Frame& F) {
    const pg8::fx_t* ssq = (const pg8::fx_t*)(ctlp() + CW_SSQ) + 4 * M; const float* g = inp(24); float* out = outp(); const bf16* XB = (const bf16*)(wsp() + WS_XB);
    for (int m = F.gw; m < M; m += F.ngw) {
        const float rs = 1.0f / sqrtf(pg8::fx_get(ssq + m) * (1.0f / 2048.0f) + NORM_EPS); GAS f32x4* orow = (GAS f32x4*)(out + (size_t)m * DM); const GAS v4u* xr = (const GAS v4u*)(XB + (size_t)m * DM) + F.lane; const GAS f32x4* gp = (const GAS f32x4*)g;
#pragma unroll
        for (int j = 0; j < 4; ++j) { const v4u w = xr[64 * j]; const int c4 = 2 * (F.lane + 64 * j); const f32x4 g0 = gp[c4], g1 = gp[c4 + 1];
            orow[c4] = (f32x4){bflo(w.x) * rs * g0.x, bfhi(w.x) * rs * g0.y, bflo(w.y) * rs * g0.z, bfhi(w.y) * rs * g0.w};
            orow[c4 + 1] = (f32x4){bflo(w.z) * rs * g1.x, bfhi(w.z) * rs * g1.y, bflo(w.w) * rs * g1.z, bfhi(w.w) * rs * g1.w}; }
    }
}

__global__ void __launch_bounds__(NTHR, 2) hy_fwd(Args args) {
    extern __shared__ __attribute__((aligned(16))) unsigned char lds[];
    LAS unsigned char* L = (LAS unsigned char*)lds;
    volatile LAS unsigned* MISC = (volatile LAS unsigned*)(L + MISC_OFF);
    if (threadIdx.x < 64) MISC[threadIdx.x] = 0u;
    __syncthreads();
    XcdBarrier bar; bar.bar = (unsigned*)(ctlp() + CW_BAR); bar.x = 0; bar.st = nullptr;
    if (N_LAUNCH_MODE == 0) bar = xcd_barrier_post((unsigned*)(ctlp() + CW_BAR), MISC + 8);
    const int lo = args.ph_lo, hi = args.ph_hi;
#define IN(k) (lo <= (k) && (k) < hi)
#define SEAM(k) do { if (IN(k) && IN((k) + 1)) xcd_barrier(bar); } while (0)
    if (IN(0)) { Frame F = mkframe(L); ph_prologue(F); if (REPEAT == 1) ph_prologue(F); }
    SEAM(0);
    auto layer = [&](const int l) __attribute__((always_inline)) {
        const int P = 1 + 7 * l;
        if (IN(P)) {
            unsigned char* ws = wsp(); pg8::Gemm g{(const bf16*)(ws + WS_XB), (const bf16*)(ws + WS_WIN), M, NPROJ_P, DM}; pg8::StaticOrder S; S.init(M, NPROJ_P, gridDim.x, (int)blockIdx.x);
            pg8::EpiProj E{(bf16*)(ws + WS_PROJ), NPROJ_P, (const pg8::fx_t*)((gu32*)ws + CW_SSQ) + (size_t)(2 * l) * M, (float*)(ws + CTL_KBAR) + (size_t)l * 64 * 8 * 64, (pg8::fx_t*)(ws + CTL_STATS) + (size_t)l * M * 2};
            pg8::gemm_phase<pg8::EpiProj, pg8::StaticOrder, true, PG8_SP2>(L + RING_OFF, g, S, E);
            if (REPEAT == 2) pg8::gemm_phase<pg8::EpiProj, pg8::StaticOrder, true, PG8_SP2>(L + RING_OFF, g, S, E);
        }
        SEAM(P);
        if (IN(P + 1)) { Frame F = mkframe(L); ph_prep(F, l); if (REPEAT == 3) ph_prep(F, l); }
        SEAM(P + 1);
        if (IN(P + 2)) { ph_mixers(L, l, P + 2, 0); if (REPEAT == 4) ph_mixers(L, l, P + 2, 32); if (REPEAT >= 40 && REPEAT < 50) ph_mixers(L, l, P + 2, 32, REPEAT == 41 ? 1 : (REPEAT == 42 ? 2 : (REPEAT == 43 ? 4 : (REPEAT == 44 ? 8 : 16)))); if (REPEAT >= 430 && REPEAT < 446) ph_mixers(L, l, P + 2, 32, 4); }
        SEAM(P + 2);
        if (IN(P + 3)) { Frame F = mkframe(L); ph_finalize(F, l); if (REPEAT == 5) ph_finalize(F, l); }
        SEAM(P + 3);
        if (IN(P + 4)) {
            unsigned char* ws = wsp(); pg8::Gemm g{(const bf16*)(ws + WS_YCAT), (const bf16*)(ws + WS_WOUT), M, DM, DM}; pg8::StaticOrder S; S.init(M, DM, gridDim.x, (int)blockIdx.x);
            pg8::EpiRes E{(bf16*)(ws + WS_XB), (pg8::fx_t*)((gu32*)ws + CW_SSQ) + (size_t)(2 * l + 1) * M, DM, FFN_FP8 ? (unsigned char*)(ws + WS_SC2) : nullptr};
            pg8::gemm_phase<pg8::EpiRes, pg8::StaticOrder, true, PG8_SP2>(L + RING_OFF, g, S, E);
        }
        SEAM(P + 4);
        if (IN(P + 5)) {
            unsigned char* ws = wsp(); pg8::Gemm g{(const bf16*)(ws + (FFN_FP8 ? WS_SC2 : WS_XB)), (const bf16*)(ws + WS_WGU), M, 2 * DFF, DM}; pg8::StaticOrder S; S.init(M, 2 * DFF, gridDim.x, (int)blockIdx.x);
            pg8::EpiGU E{(bf16*)(ws + WS_PROJ), DFF, (const pg8::fx_t*)((gu32*)ws + CW_SSQ) + (size_t)(2 * l + 1) * M, FFN_FP8 ? (1.0f / 64.0f) : 1.0f};
            if (FFN_FP8) pg8::gemm_phase_f8<pg8::EpiGU, pg8::StaticOrder, true, PG8_SP2>(L + RING_OFF, g, S, E);
            else pg8::gemm_phase<pg8::EpiGU, pg8::StaticOrder, true, PG8_SP2>(L + RING_OFF, g, S, E);
            if (REPEAT == 6) { if (FFN_FP8) pg8::gemm_phase_f8<pg8::EpiGU, pg8::StaticOrder, true, PG8_SP2>(L + RING_OFF, g, S, E); else pg8::gemm_phase<pg8::EpiGU, pg8::StaticOrder, true, PG8_SP2>(L + RING_OFF, g, S, E); }
        }
        SEAM(P + 5);
        if (IN(P + 6)) {
            unsigned char* ws = wsp(); pg8::Gemm g{(const bf16*)(ws + WS_PROJ), (const bf16*)(ws + WS_WDN), M, DM, DFF}; pg8::StaticOrder S; S.init(M, DM, gridDim.x, (int)blockIdx.x);
            pg8::EpiRes E{(bf16*)(ws + WS_XB), (pg8::fx_t*)((gu32*)ws + CW_SSQ) + (size_t)(2 * l + 2) * M, DM, nullptr};
            pg8::gemm_phase<pg8::EpiRes, pg8::StaticOrder, true, PG8_SP2>(L + RING_OFF, g, S, E);
        }
        SEAM(P + 6);
    };
    static_assert(DEPTH == 2, "layers are expanded by hand");
    layer(0); layer(1);
    if (IN(15)) { Frame F = mkframe(L); ph_final(F); }
#undef IN
#undef SEAM
}

extern "C" void kernel_launch(void* const* d_in, const int* in_sizes, int n_in, void* d_out, int out_size, void* d_ws, size_t ws_size, hipStream_t stream) {
    static int grid = 0;
    if (grid == 0) {
        if (n_in != 25 || in_sizes[0] != M * DM || out_size != M * DM || ws_size < WS_END) { fprintf(stderr, "kernel_launch: shape/workspace mismatch: n_in %d in0 %d out %d ws %zu (need %zu)\n", n_in, n_in > 0 ? in_sizes[0] : -1, out_size, ws_size, (size_t)WS_END); grid = -1; return; }
        int dev = 0, cus = 0, per_cu = 0;
        if (hipGetDevice(&dev) != hipSuccess || hipDeviceGetAttribute(&cus, hipDeviceAttributeMultiprocessorCount, dev) != hipSuccess) { grid = -1; return; }
        if (hipFuncSetAttribute((const void*)hy_fwd, hipFuncAttributeMaxDynamicSharedMemorySize, LDS_BYTES) != hipSuccess) { fprintf(stderr, "kernel_launch: hipFuncSetAttribute failed\n"); grid = -1; return; }
        if (hipOccupancyMaxActiveBlocksPerMultiprocessor(&per_cu, (const void*)hy_fwd, NTHR, LDS_BYTES) != hipSuccess || per_cu < 1) fprintf(stderr, "kernel_launch: occupancy query reports %d\n", per_cu);
        (void)hipGetLastError();
        grid = cus;
    }
    if (grid < 0) return;
    if (hipMemsetAsync((char*)d_ws + WS_CTL, 0, CTL_ZERO_BYTES, stream) != hipSuccess) return;
    Args a{};
    for (int i = 0; i < 25; ++i) a.in[i] = (const float*)d_in[i];
    a.out = (float*)d_out; a.ws = (unsigned char*)d_ws;
    if (N_LAUNCH_MODE == 0) { a.ph_lo = 0; a.ph_hi = N_PHASES; hipLaunchKernelGGL(hy_fwd, dim3(grid), dim3(NTHR), LDS_BYTES, stream, a); }
    else for (int p = 0; p < N_PHASES; ++p) { a.ph_lo = p; a.ph_hi = p + 1; hipLaunchKernelGGL(hy_fwd, dim3(grid), dim3(NTHR), LDS_BYTES, stream, a); }
}
```

```cpp
#define N_LAUNCH_MODE 0
#define REPEAT 0
#define PG8_SP2 true
#define FFN_FP8 1
#include <hip/hip_runtime.h>
#include <cstdio>
#include <cstdint>
namespace pg8 {
#define PG8_LAS __attribute__((address_space(3)))
typedef unsigned short bf16_t;
typedef short bf16x8 __attribute__((ext_vector_type(8)));
typedef float f32x4 __attribute__((ext_vector_type(4)));
typedef unsigned u32x4 __attribute__((ext_vector_type(4)));
constexpr int BM = 256, BK = 64, HALF = 128, HTB = HALF * BK * 2  , STAGE_BYTES = 8 * HTB, NXCD = 8, WGM = 8;

__host__ __device__ __forceinline__ int lds_byte(int r, int c) { const int st = (r >> 4) * 2 + (c >> 5), rr = r & 15, cc = c & 31, ob = rr * 64 + cc * 2; return st * 1024 + (ob ^ (((ob >> 9) & 1) << 5)); }
__host__ __device__ __forceinline__ void stage_rc(int b, int& R, int& C) { const int st = b / 1024, sb = b % 1024, swz = sb ^ (((sb >> 9) & 1) << 5); R = (st >> 1) * 16 + swz / 64; C = (st & 1) * 32 + (swz % 64) / 2; }
__host__ __device__ __forceinline__ int perm32(int rho) { const int n = rho >> 4, i = rho & 15; return 8 * (i >> 2) + 4 * n + (i & 3); }

struct Unit { int pm, pn; };
struct Gemm { const bf16_t* A; const bf16_t* Bt; int M, N, K; };

struct StaticOrder {
    int nM, nN, nwg, G, c;
    __host__ __device__ void init(int M, int N, int G_, int c_) { nM = M / BM; nN = N / BM; nwg = nM * nN; G = G_; c = c_; }
    __host__ __device__ bool next(int i, Unit& u) const {
        const long L = (long)i * G + c; if (L >= nwg) return false;
        int wgid = (int)L; { const int q = nwg / NXCD, r = nwg % NXCD, xcd = wgid % NXCD, off = wgid / NXCD; wgid = (xcd < r ? xcd * (q + 1) : r * (q + 1) + (xcd - r) * q) + off; }
        const int nig = WGM * nN, gid = wgid / nig, fm = gid * WGM, gsz = (nM - fm) < WGM ? (nM - fm) : WGM;
        u.pm = fm + ((wgid % nig) % gsz); u.pn = (wgid % nig) / gsz; return true;
    }
    __device__ __forceinline__ void a_ready(const Unit&) const {}
    __device__ __forceinline__ void done(const Unit&) const {}
};

__device__ __forceinline__ unsigned cvt_pk_bf16(float lo, float hi) { unsigned r; asm volatile("v_cvt_pk_bf16_f32 %0, %1, %2" : "=v"(r) : "v"(lo), "v"(hi)); return r; }
typedef float f32x2 __attribute__((ext_vector_type(2)));

typedef unsigned u32x2 __attribute__((ext_vector_type(2)));
typedef unsigned long long fx_t;
__device__ __forceinline__ void fx_add(fx_t* p, float v) { atomicAdd(p, (fx_t)(long long)__float2ll_rn(v * 1073741824.0f)); }
__device__ __forceinline__ float fx_get(const fx_t* p) { return (float)(long long)(*p) * (1.0f / 1073741824.0f); }
__device__ __forceinline__ float epi_gelu(float x) { const float u = 0.7978845608028654f * (x + 0.044715f * x * x * x); const float e2 = __expf(2.0f * u); return 0.5f * x * (2.0f - 2.0f / (e2 + 1.0f)); }
template <int CTRL> __device__ __forceinline__ float epi_dpp_add(float x) { const int y = __builtin_amdgcn_update_dpp(0, __builtin_bit_cast(int, x), CTRL, 0xF, 0xF, false); return x + __builtin_bit_cast(float, y); }
struct EpiProj {
    static constexpr bool PERM = true, AFTER_DRAIN = false;
    bf16_t* O; int ldc; const fx_t* ssq; float* kbar; fx_t* stats;
    __device__ __forceinline__ void operator()(const f32x4 (&acc)[2][2][4][2], const Unit& u, int wr, int wc, int fr, int fq) const {
        const int row0 = u.pm * BM + wr * 64 + fr, col0 = u.pn * BM + wc * 32 + 8 * fq;
        const bool do_k = (u.pn == 12 || u.pn == 13), do_s = (u.pn == 8 || u.pn == 9);
        float cs[2][8];
#pragma unroll
        for (int bj = 0; bj < 2; ++bj)
#pragma unroll
            for (int e = 0; e < 8; ++e) cs[bj][e] = 0.f;
#pragma unroll
        for (int ai = 0; ai < 2; ++ai)
#pragma unroll
            for (int m = 0; m < 4; ++m) { const int row = row0 + ai * HALF + m * 16; const float rs = __builtin_amdgcn_rsqf(fx_get(ssq + row) * (1.0f / 2048.0f) + 1e-6f);
                bf16_t* rowp = O + (size_t)row * ldc + col0; float s1 = 0.f, s2 = 0.f;
#pragma unroll
                for (int bj = 0; bj < 2; ++bj) { const f32x4 v0 = acc[ai][bj][m][0] * rs, v1 = acc[ai][bj][m][1] * rs;
                    u32x4 w; w.x = cvt_pk_bf16(v0[0], v0[1]); w.y = cvt_pk_bf16(v0[2], v0[3]); w.z = cvt_pk_bf16(v1[0], v1[1]); w.w = cvt_pk_bf16(v1[2], v1[3]);
                    *(u32x4*)(rowp + bj * HALF) = w;
                    if (do_k) {
#pragma unroll
                        for (int e = 0; e < 4; ++e) { cs[bj][e] += v0[e]; cs[bj][4 + e] += v1[e]; } }
                    if (do_s) {
#pragma unroll
                        for (int e = 0; e < 4; ++e) { const float g0 = epi_gelu(v0[e]), g1 = epi_gelu(v1[e]); s1 += g0 + g1; s2 += g0 * g0 + g1 * g1; } } }
                if (do_s) { s1 += __shfl_xor(s1, 16); s1 += __shfl_xor(s1, 32); s2 += __shfl_xor(s2, 16); s2 += __shfl_xor(s2, 32);
                    if (fq == 0) { fx_add(stats + 2 * row, s1); fx_add(stats + 2 * row + 1, s2); } } }
        if (do_k) {
            const int bidx = (u.pm >> 3) * 8, n = u.pm & 7;
#pragma unroll
            for (int bj = 0; bj < 2; ++bj)
#pragma unroll
                for (int e = 0; e < 8; ++e) { float s = cs[bj][e]; s = epi_dpp_add<0xB1>(s); s = epi_dpp_add<0x4E>(s); s = epi_dpp_add<0x141>(s); s = epi_dpp_add<0x140>(s);
                    const int ck = col0 + bj * HALF + e - 3072;
                    if (fr == 0) unsafeAtomicAdd(kbar + ((bidx + (ck >> 6)) * 8 + n) * 64 + (ck & 63), s * (1.0f / 256.0f)); } }
    }
};
struct EpiGU {
    static constexpr bool PERM = true, AFTER_DRAIN = false;
    bf16_t* O; int ldc; const fx_t* ssq; float oscale;
    __device__ __forceinline__ void operator()(const f32x4 (&acc)[2][2][4][2], const Unit& u, int wr, int wc, int fr, int fq) const {
        const int row0 = u.pm * BM + wr * 64 + fr, col0 = u.pn * HALF + wc * 32 + 8 * fq;
#pragma unroll
        for (int ai = 0; ai < 2; ++ai)
#pragma unroll
            for (int m = 0; m < 4; ++m) { const int row = row0 + ai * HALF + m * 16; const float rs = __builtin_amdgcn_rsqf(fx_get(ssq + row) * (1.0f / 2048.0f) + 1e-6f) * oscale;
                float o[8];
#pragma unroll
                for (int n = 0; n < 2; ++n)
#pragma unroll
                    for (int e = 0; e < 4; ++e) { const float g = acc[ai][0][m][n][e] * rs, up = acc[ai][1][m][n][e] * rs;
                        o[n * 4 + e] = g * __builtin_amdgcn_rcpf(1.0f + __builtin_amdgcn_exp2f(-1.4426950408889634f * g)) * up; }
                u32x4 w; w.x = cvt_pk_bf16(o[0], o[1]); w.y = cvt_pk_bf16(o[2], o[3]); w.z = cvt_pk_bf16(o[4], o[5]); w.w = cvt_pk_bf16(o[6], o[7]);
                *(u32x4*)(O + (size_t)row * ldc + col0) = w; }
    }
};
__device__ __forceinline__ float epi_clamp8(float v) { return __builtin_amdgcn_fmed3f(v, -448.0f, 448.0f); }
struct EpiGU8 {
    static constexpr bool PERM = true, AFTER_DRAIN = false;
    unsigned char* O; int ldc; const fx_t* ssq; float oscale, ascale;
    __device__ __forceinline__ void operator()(const f32x4 (&acc)[2][2][4][2], const Unit& u, int wr, int wc, int fr, int fq) const {
        const int row0 = u.pm * BM + wr * 64 + fr, col0 = u.pn * HALF + wc * 32 + 8 * fq;
#pragma unroll
        for (int ai = 0; ai < 2; ++ai)
#pragma unroll
            for (int m = 0; m < 4; ++m) { const int row = row0 + ai * HALF + m * 16; const float rs = __builtin_amdgcn_rsqf(fx_get(ssq + row) * (1.0f / 2048.0f) + 1e-6f) * oscale;
                float o[8];
#pragma unroll
                for (int n = 0; n < 2; ++n)
#pragma unroll
                    for (int e = 0; e < 4; ++e) { const float g = acc[ai][0][m][n][e] * rs, up = acc[ai][1][m][n][e] * rs;
                        o[n * 4 + e] = epi_clamp8(g * __builtin_amdgcn_rcpf(1.0f + __builtin_amdgcn_exp2f(-1.4426950408889634f * g)) * up * ascale); }
                int f0 = __builtin_bit_cast(int, o[0]), f1 = __builtin_bit_cast(int, o[4]);
                f0 = __builtin_amdgcn_cvt_pk_fp8_f32(o[0], o[1], f0, false); f0 = __builtin_amdgcn_cvt_pk_fp8_f32(o[2], o[3], f0, true);
                f1 = __builtin_amdgcn_cvt_pk_fp8_f32(o[4], o[5], f1, false); f1 = __builtin_amdgcn_cvt_pk_fp8_f32(o[6], o[7], f1, true);
                *(u32x2*)(O + (size_t)row * ldc + col0) = (u32x2){(unsigned)f0, (unsigned)f1}; }
    }
};
struct EpiRes {
    static constexpr bool PERM = true, AFTER_DRAIN = false;
    bf16_t* xb; fx_t* ssq; int ldc; unsigned char* xf; float oscale;
    __device__ __forceinline__ void operator()(const f32x4 (&acc)[2][2][4][2], const Unit& u, int wr, int wc, int fr, int fq) const {
        const int row0 = u.pm * BM + wr * 64 + fr, col0 = u.pn * BM + wc * 32 + 8 * fq;
#pragma unroll
        for (int ai = 0; ai < 2; ++ai)
#pragma unroll
            for (int m = 0; m < 4; ++m) { const int row = row0 + ai * HALF + m * 16; bf16_t* rowp = xb + (size_t)row * ldc + col0; float s = 0.f;
                u32x4 b[2];
#pragma unroll
                for (int bj = 0; bj < 2; ++bj) b[bj] = *(const u32x4*)(rowp + bj * HALF);
#pragma unroll
                for (int bj = 0; bj < 2; ++bj) { float o[8];
#pragma unroll
                    for (int q = 0; q < 4; ++q) { o[2 * q] = __builtin_fmaf(acc[ai][bj][m][q >> 1][2 * (q & 1)], oscale, __builtin_bit_cast(float, b[bj][q] << 16)); o[2 * q + 1] = __builtin_fmaf(acc[ai][bj][m][q >> 1][2 * (q & 1) + 1], oscale, __builtin_bit_cast(float, b[bj][q] & 0xffff0000u)); }
                    u32x4 w; w.x = cvt_pk_bf16(o[0], o[1]); w.y = cvt_pk_bf16(o[2], o[3]); w.z = cvt_pk_bf16(o[4], o[5]); w.w = cvt_pk_bf16(o[6], o[7]);
                    *(u32x4*)(rowp + bj * HALF) = w;
                    if (xf) { int f0 = (int)b[bj][0], f1 = (int)b[bj][1]; f0 = __builtin_amdgcn_cvt_pk_fp8_f32(epi_clamp8(o[0]), epi_clamp8(o[1]), f0, false); f0 = __builtin_amdgcn_cvt_pk_fp8_f32(epi_clamp8(o[2]), epi_clamp8(o[3]), f0, true);
                        f1 = __builtin_amdgcn_cvt_pk_fp8_f32(epi_clamp8(o[4]), epi_clamp8(o[5]), f1, false); f1 = __builtin_amdgcn_cvt_pk_fp8_f32(epi_clamp8(o[6]), epi_clamp8(o[7]), f1, true);
                        *(u32x2*)(xf + (size_t)row * ldc + col0 + bj * HALF) = (u32x2){(unsigned)f0, (unsigned)f1}; }
#pragma unroll
                    for (int q = 0; q < 8; ++q) s += o[q] * o[q]; }
                s += __shfl_xor(s, 16); s += __shfl_xor(s, 32);
                if (fq == 0) fx_add(ssq + row, s); }
    }
};
typedef int i32x4_t __attribute__((ext_vector_type(4)));
typedef int i32x8_t __attribute__((ext_vector_type(8)));
template <class Epi, class Sched, bool ALIGN_EPI = false, bool SP2 = false>
__device__ __forceinline__ void gemm_phase(PG8_LAS unsigned char* lds, const Gemm g, const Sched& S, const Epi& E) {
    int tid_ = threadIdx.x; asm volatile("" : "+v"(tid_));
    const int tid = tid_, wid = __builtin_amdgcn_readfirstlane(tid >> 6), lane = tid & 63, wr = wid >> 2, wc = wid & 3, fr = lane & 15, fq = lane >> 4;
    const int K = g.K, nt = K / BK;
    unsigned voffA[2], voffB[2];
#pragma unroll
    for (int i = 0; i < 2; ++i) { int R, C; stage_rc(tid * 16 + i * 8192, R, C); const int Rb = Epi::PERM ? ((R & ~31) + perm32(R & 31)) : R;
        voffA[i] = (unsigned)(R * K + C) * 2u; voffB[i] = (unsigned)(Rb * K + C) * 2u; }
    const unsigned kstep = (unsigned)(BK * 2);
    const unsigned hstep = (unsigned)HALF * K * 2;
    const unsigned tstep = 2 * hstep;
    const unsigned ldsw = (unsigned)wid * 1024u;
    const int aoff = lds_byte(wr * 64 + fr, fq * 8), boff = lds_byte(wc * 32 + fr, fq * 8);
#define PG8_SA(b, h) (((b) * 2 + (h)) * HTB)
#define PG8_SB(b, h) ((4 + (b) * 2 + (h)) * HTB)
#define PG8_STAGE(bufoff, rsrc, soff, voff) do { _Pragma("unroll") for (int _i = 0; _i < 2; ++_i) \
        __builtin_amdgcn_raw_ptr_buffer_load_lds(rsrc, (PG8_LAS void*)(lds + (bufoff) + ldsw + _i * 8192), 16, (int)(voff)[_i], (int)(soff), 0, 0); } while (0)
#define PG8_LDA(dst, b, h) do { _Pragma("unroll") for (int m = 0; m < 4; ++m) _Pragma("unroll") for (int k = 0; k < 2; ++k) dst[m][k] = *(const PG8_LAS bf16x8*)(lds + PG8_SA(b, h) + aoff + m * 2048 + k * 1024); } while (0)
#define PG8_LDB(dst, b, h) do { _Pragma("unroll") for (int n = 0; n < 2; ++n) _Pragma("unroll") for (int k = 0; k < 2; ++k) dst[n][k] = *(const PG8_LAS bf16x8*)(lds + PG8_SB(b, h) + boff + n * 2048 + k * 1024); } while (0)
#define PG8_MMA(ai, bj, At, Bt) do { __builtin_amdgcn_s_setprio(1); _Pragma("unroll") for (int m = 0; m < 4; ++m) _Pragma("unroll") for (int n = 0; n < 2; ++n) _Pragma("unroll") for (int k = 0; k < 2; ++k) \
        acc[ai][bj][m][n] = __builtin_amdgcn_mfma_f32_16x16x32_bf16(Bt[n][k], At[m][k], acc[ai][bj][m][n], 0, 0, 0); __builtin_amdgcn_s_setprio(0); } while (0)
#define PG8_WAIT_V(n) asm volatile("s_waitcnt vmcnt(" #n ")" ::: "memory")
#define PG8_WAIT_L(n) asm volatile("s_waitcnt lgkmcnt(" #n ")" ::: "memory")
#define PG8_BAR __builtin_amdgcn_s_barrier()
#define PG8_SCHED __builtin_amdgcn_sched_barrier(0)
    Unit cur, nxt; int ui = 0;
    if (!S.next(0, cur)) return;
    f32x4 acc[2][2][4][2];
#pragma unroll
    for (int a = 0; a < 2; ++a)
#pragma unroll
        for (int b = 0; b < 2; ++b)
#pragma unroll
            for (int m = 0; m < 4; ++m)
#pragma unroll
                for (int n = 0; n < 2; ++n) acc[a][b][m][n] = (f32x4){0.f, 0.f, 0.f, 0.f};
    bf16x8 At[4][2], B0[2][2], B1[2][2];
    const __amdgpu_buffer_rsrc_t rA = __builtin_amdgcn_make_buffer_rsrc((void*)g.A, (short)0, -1, 0x00020000), rB = __builtin_amdgcn_make_buffer_rsrc((void*)g.Bt, (short)0, -1, 0x00020000);
    unsigned cA = (unsigned)cur.pm * tstep, cB = (unsigned)cur.pn * tstep;
    S.a_ready(cur);
    if constexpr (SP2) {
        PG8_STAGE(PG8_SB(0, 0), rB, cB, voffB); PG8_STAGE(PG8_SB(0, 1), rB, cB + hstep, voffB); PG8_STAGE(PG8_SA(0, 0), rA, cA, voffA); PG8_STAGE(PG8_SA(0, 1), rA, cA + hstep, voffA);
        if (wr == 1) PG8_BAR;
        PG8_WAIT_V(2); PG8_BAR;
        PG8_STAGE(PG8_SB(1, 0), rB, cB + kstep, voffB); PG8_STAGE(PG8_SA(1, 0), rA, cA + kstep, voffA); PG8_STAGE(PG8_SB(1, 1), rB, cB + hstep + kstep, voffB);
        PG8_WAIT_V(6); PG8_BAR;
    } else {
        PG8_STAGE(PG8_SB(0, 0), rB, cB, voffB); PG8_STAGE(PG8_SA(0, 0), rA, cA, voffA); PG8_STAGE(PG8_SB(0, 1), rB, cB + hstep, voffB); PG8_STAGE(PG8_SA(0, 1), rA, cA + hstep, voffA);
        if (wr == 1) PG8_BAR;
        PG8_WAIT_V(4); PG8_BAR;
        PG8_STAGE(PG8_SB(1, 0), rB, cB + kstep, voffB); PG8_STAGE(PG8_SA(1, 0), rA, cA + kstep, voffA); PG8_STAGE(PG8_SB(1, 1), rB, cB + hstep + kstep, voffB);
        PG8_WAIT_V(6); PG8_BAR;
    }
    for (;;) {
        const bool has_next = S.next(ui + 1, nxt);
        const unsigned nA = has_next ? (unsigned)nxt.pm * tstep : cA, nB = has_next ? (unsigned)nxt.pn * tstep : cB;
        for (int t = 0; t < nt; t += 2) {
            const bool last = (t == nt - 2);
            const unsigned a1 = cA + (unsigned)(t + 1) * kstep;
            const unsigned a2 = last ? nA : cA + (unsigned)(t + 2) * kstep, b2 = last ? nB : cB + (unsigned)(t + 2) * kstep;
            const unsigned a3 = a2 + kstep, b3 = b2 + kstep;
            if (last && has_next) S.a_ready(nxt);
            if constexpr (SP2) {
            PG8_LDB(B0, 0, 0); PG8_LDB(B1, 0, 1); PG8_SCHED; PG8_LDA(At, 0, 0); PG8_STAGE(PG8_SA(1, 1), rA, a1 + hstep, voffA);
            PG8_WAIT_V(8); PG8_WAIT_L(0); PG8_BAR; PG8_MMA(0, 0, At, B0); PG8_MMA(0, 1, At, B1); PG8_BAR; PG8_SCHED;
            PG8_LDA(At, 0, 1); PG8_STAGE(PG8_SB(0, 0), rB, b2, voffB); PG8_STAGE(PG8_SB(0, 1), rB, b2 + hstep, voffB); PG8_STAGE(PG8_SA(0, 0), rA, a2, voffA);
            PG8_WAIT_V(8); PG8_WAIT_L(0); PG8_BAR; PG8_MMA(1, 0, At, B0); PG8_MMA(1, 1, At, B1); PG8_BAR; PG8_SCHED;
            PG8_LDB(B0, 1, 0); PG8_LDB(B1, 1, 1); PG8_SCHED; PG8_LDA(At, 1, 0); PG8_STAGE(PG8_SA(0, 1), rA, a2 + hstep, voffA);
            PG8_WAIT_V(8); PG8_WAIT_L(0); PG8_BAR; PG8_MMA(0, 0, At, B0); PG8_MMA(0, 1, At, B1); PG8_BAR; PG8_SCHED;
            PG8_LDA(At, 1, 1); PG8_STAGE(PG8_SB(1, 0), rB, b3, voffB); PG8_STAGE(PG8_SB(1, 1), rB, b3 + hstep, voffB); PG8_STAGE(PG8_SA(1, 0), rA, a3, voffA);
            PG8_WAIT_V(8); PG8_WAIT_L(0); PG8_BAR; PG8_MMA(1, 0, At, B0); PG8_MMA(1, 1, At, B1); PG8_BAR; PG8_SCHED;
            } else {
            PG8_LDB(B0, 0, 0); PG8_SCHED; PG8_LDA(At, 0, 0); PG8_STAGE(PG8_SA(1, 1), rA, a1 + hstep, voffA);
            PG8_WAIT_L(8); PG8_BAR; PG8_WAIT_L(0); PG8_MMA(0, 0, At, B0); PG8_BAR; PG8_SCHED;
            PG8_LDB(B1, 0, 1); PG8_STAGE(PG8_SB(0, 0), rB, b2, voffB);
            PG8_BAR; PG8_WAIT_L(0); PG8_MMA(0, 1, At, B1); PG8_BAR;
            PG8_LDA(At, 0, 1); PG8_STAGE(PG8_SA(0, 0), rA, a2, voffA);
            PG8_BAR; PG8_WAIT_L(0); PG8_MMA(1, 0, At, B0); PG8_BAR; PG8_SCHED;
            PG8_STAGE(PG8_SB(0, 1), rB, b2 + hstep, voffB);
            PG8_WAIT_V(6); PG8_BAR; PG8_MMA(1, 1, At, B1); PG8_BAR;
            PG8_LDB(B0, 1, 0); PG8_SCHED; PG8_LDA(At, 1, 0); PG8_STAGE(PG8_SA(0, 1), rA, a2 + hstep, voffA);
            PG8_WAIT_L(8); PG8_BAR; PG8_WAIT_L(0); PG8_MMA(0, 0, At, B0); PG8_BAR; PG8_SCHED;
            PG8_LDB(B1, 1, 1); PG8_STAGE(PG8_SB(1, 0), rB, b3, voffB);
            PG8_BAR; PG8_WAIT_L(0); PG8_MMA(0, 1, At, B1); PG8_BAR;
            PG8_LDA(At, 1, 1); PG8_STAGE(PG8_SA(1, 0), rA, a3, voffA);
            PG8_BAR; PG8_WAIT_L(0); PG8_MMA(1, 0, At, B0); PG8_BAR; PG8_SCHED;
            PG8_STAGE(PG8_SB(1, 1), rB, b3 + hstep, voffB);
            PG8_WAIT_V(6); PG8_BAR; PG8_MMA(1, 1, At, B1); PG8_BAR;
            }
        }
        if constexpr (ALIGN_EPI) { if (wr == 0) PG8_BAR; }
        if constexpr (!Epi::AFTER_DRAIN) { int ln_ = (int)__builtin_amdgcn_mbcnt_hi(~0u, __builtin_amdgcn_mbcnt_lo(~0u, 0u)); asm volatile("" : "+v"(ln_));
            E(acc, cur, wr, wc, ln_ & 15, ln_ >> 4); S.done(cur); }
        if (!has_next) break;
#pragma unroll
        for (int a = 0; a < 2; ++a)
#pragma unroll
            for (int b = 0; b < 2; ++b)
#pragma unroll
                for (int m = 0; m < 4; ++m)
#pragma unroll
                    for (int n = 0; n < 2; ++n) acc[a][b][m][n] = (f32x4){0.f, 0.f, 0.f, 0.f};
        cur = nxt; cA = nA; cB = nB; ++ui;
        if constexpr (ALIGN_EPI) { if (wr == 1) PG8_BAR; }
    }
    PG8_WAIT_V(0);
    if constexpr (!ALIGN_EPI) { if (wr == 0) PG8_BAR; }
    PG8_BAR;
    if constexpr (Epi::AFTER_DRAIN) { E.fused(acc, cur, wr, wc, fr, fq, lds, wid, lane); S.done(cur); }
#undef PG8_SA
#undef PG8_SB
#undef PG8_STAGE
#undef PG8_LDA
#undef PG8_LDB
#undef PG8_MMA
#undef PG8_WAIT_V
#undef PG8_WAIT_L
#undef PG8_BAR
#undef PG8_SCHED
}
template <class Epi, class Sched, bool ALIGN_EPI = false, bool SP2 = false>
__device__ __forceinline__ void gemm_phase_f8(PG8_LAS unsigned char* lds, const Gemm g, const Sched& S, const Epi& E) {
    int tid_ = threadIdx.x; asm volatile("" : "+v"(tid_));
    const int tid = tid_, wid = __builtin_amdgcn_readfirstlane(tid >> 6), lane = tid & 63, wr = wid >> 2, wc = wid & 3, fr = lane & 15, fq = lane >> 4;
    const int K = g.K, nt = K / (2 * BK);
    unsigned voffA[2], voffB[2];
#pragma unroll
    for (int i = 0; i < 2; ++i) { int R, C; stage_rc(tid * 16 + i * 8192, R, C); const int Rb = Epi::PERM ? ((R & ~31) + perm32(R & 31)) : R;
        voffA[i] = (unsigned)(R * K + 2 * C); voffB[i] = (unsigned)(Rb * K + 2 * C); }
    const unsigned kstep = (unsigned)(BK * 2);
    const unsigned hstep = (unsigned)HALF * K;
    const unsigned tstep = 2 * hstep;
    const unsigned ldsw = (unsigned)wid * 1024u;
    const int aoff = lds_byte(wr * 64 + fr, fq * 16) ^ ((fq & 1) << 4), boff = lds_byte(wc * 32 + fr, fq * 16) ^ ((fq & 1) << 4), aoff2 = aoff ^ 16, boff2 = boff ^ 16;
#define PG8_SA(b, h) (((b) * 2 + (h)) * HTB)
#define PG8_SB(b, h) ((4 + (b) * 2 + (h)) * HTB)
#define PG8_STAGE(bufoff, rsrc, soff, voff) do { _Pragma("unroll") for (int _i = 0; _i < 2; ++_i) \
        __builtin_amdgcn_raw_ptr_buffer_load_lds(rsrc, (PG8_LAS void*)(lds + (bufoff) + ldsw + _i * 8192), 16, (int)(voff)[_i], (int)(soff), 0, 0); } while (0)
#define PG8_LDA(dst, b, h) do { _Pragma("unroll") for (int m = 0; m < 4; ++m) { const i32x4_t lo_ = *(const PG8_LAS i32x4_t*)(lds + PG8_SA(b, h) + aoff + m * 2048), hi_ = *(const PG8_LAS i32x4_t*)(lds + PG8_SA(b, h) + aoff2 + m * 2048); dst[m] = __builtin_shufflevector(lo_, hi_, 0, 1, 2, 3, 4, 5, 6, 7); } } while (0)
#define PG8_LDB(dst, b, h) do { _Pragma("unroll") for (int n = 0; n < 2; ++n) { const i32x4_t lo_ = *(const PG8_LAS i32x4_t*)(lds + PG8_SB(b, h) + boff + n * 2048), hi_ = *(const PG8_LAS i32x4_t*)(lds + PG8_SB(b, h) + boff2 + n * 2048); dst[n] = __builtin_shufflevector(lo_, hi_, 0, 1, 2, 3, 4, 5, 6, 7); } } while (0)
#define PG8_F8CAT(lo, hi) __builtin_shufflevector(__builtin_bit_cast(i32x4_t, lo), __builtin_bit_cast(i32x4_t, hi), 0, 1, 2, 3, 4, 5, 6, 7)
#define PG8_MMA(ai, bj, At, Bt) do { __builtin_amdgcn_s_setprio(1); _Pragma("unroll") for (int m = 0; m < 4; ++m) _Pragma("unroll") for (int n = 0; n < 2; ++n) \
        acc[ai][bj][m][n] = __builtin_amdgcn_mfma_scale_f32_16x16x128_f8f6f4(Bt[n], At[m], acc[ai][bj][m][n], 0, 0, 0, 0, 0, 0); __builtin_amdgcn_s_setprio(0); } while (0)
#define PG8_WAIT_V(n) asm volatile("s_waitcnt vmcnt(" #n ")" ::: "memory")
#define PG8_WAIT_L(n) asm volatile("s_waitcnt lgkmcnt(" #n ")" ::: "memory")
#define PG8_BAR __builtin_amdgcn_s_barrier()
#define PG8_SCHED __builtin_amdgcn_sched_barrier(0)
    Unit cur, nxt; int ui = 0;
    if (!S.next(0, cur)) return;
    f32x4 acc[2][2][4][2];
#pragma unroll
    for (int a = 0; a < 2; ++a)
#pragma unroll
        for (int b = 0; b < 2; ++b)
#pragma unroll
            for (int m = 0; m < 4; ++m)
#pragma unroll
                for (int n = 0; n < 2; ++n) acc[a][b][m][n] = (f32x4){0.f, 0.f, 0.f, 0.f};
    i32x8_t At[4], B0[2], B1[2];
    const __amdgpu_buffer_rsrc_t rA = __builtin_amdgcn_make_buffer_rsrc((void*)g.A, (short)0, -1, 0x00020000), rB = __builtin_amdgcn_make_buffer_rsrc((void*)g.Bt, (short)0, -1, 0x00020000);
    unsigned cA = (unsigned)cur.pm * tstep, cB = (unsigned)cur.pn * tstep;
    S.a_ready(cur);
    if constexpr (SP2) {
        PG8_STAGE(PG8_SB(0, 0), rB, cB, voffB); PG8_STAGE(PG8_SB(0, 1), rB, cB + hstep, voffB); PG8_STAGE(PG8_SA(0, 0), rA, cA, voffA); PG8_STAGE(PG8_SA(0, 1), rA, cA + hstep, voffA);
        if (wr == 1) PG8_BAR;
        PG8_WAIT_V(2); PG8_BAR;
        PG8_STAGE(PG8_SB(1, 0), rB, cB + kstep, voffB); PG8_STAGE(PG8_SA(1, 0), rA, cA + kstep, voffA); PG8_STAGE(PG8_SB(1, 1), rB, cB + hstep + kstep, voffB);
        PG8_WAIT_V(6); PG8_BAR;
    } else {
        PG8_STAGE(PG8_SB(0, 0), rB, cB, voffB); PG8_STAGE(PG8_SA(0, 0), rA, cA, voffA); PG8_STAGE(PG8_SB(0, 1), rB, cB + hstep, voffB); PG8_STAGE(PG8_SA(0, 1), rA, cA + hstep, voffA);
        if (wr == 1) PG8_BAR;
        PG8_WAIT_V(4); PG8_BAR;
        PG8_STAGE(PG8_SB(1, 0), rB, cB + kstep, voffB); PG8_STAGE(PG8_SA(1, 0), rA, cA + kstep, voffA); PG8_STAGE(PG8_SB(1, 1), rB, cB + hstep + kstep, voffB);
        PG8_WAIT_V(6); PG8_BAR;
    }
    for (;;) {
        const bool has_next = S.next(ui + 1, nxt);
        const unsigned nA = has_next ? (unsigned)nxt.pm * tstep : cA, nB = has_next ? (unsigned)nxt.pn * tstep : cB;
        for (int t = 0; t < nt; t += 2) {
            const bool last = (t == nt - 2);
            const unsigned a1 = cA + (unsigned)(t + 1) * kstep;
            const unsigned a2 = last ? nA : cA + (unsigned)(t + 2) * kstep, b2 = last ? nB : cB + (unsigned)(t + 2) * kstep;
            const unsigned a3 = a2 + kstep, b3 = b2 + kstep;
            if (last && has_next) S.a_ready(nxt);
            if constexpr (SP2) {
            PG8_LDB(B0, 0, 0); PG8_LDB(B1, 0, 1); PG8_SCHED; PG8_LDA(At, 0, 0); PG8_STAGE(PG8_SA(1, 1), rA, a1 + hstep, voffA);
            PG8_WAIT_V(8); PG8_WAIT_L(0); PG8_BAR; PG8_MMA(0, 0, At, B0); PG8_MMA(0, 1, At, B1); PG8_BAR; PG8_SCHED;
            PG8_LDA(At, 0, 1); PG8_STAGE(PG8_SB(0, 0), rB, b2, voffB); PG8_STAGE(PG8_SB(0, 1), rB, b2 + hstep, voffB); PG8_STAGE(PG8_SA(0, 0), rA, a2, voffA);
            PG8_WAIT_V(8); PG8_WAIT_L(0); PG8_BAR; PG8_MMA(1, 0, At, B0); PG8_MMA(1, 1, At, B1); PG8_BAR; PG8_SCHED;
            PG8_LDB(B0, 1, 0); PG8_LDB(B1, 1, 1); PG8_SCHED; PG8_LDA(At, 1, 0); PG8_STAGE(PG8_SA(0, 1), rA, a2 + hstep, voffA);
            PG8_WAIT_V(8); PG8_WAIT_L(0); PG8_BAR; PG8_MMA(0, 0, At, B0); PG8_MMA(0, 1, At, B1); PG8_BAR; PG8_SCHED;
            PG8_LDA(At, 1, 1); PG8_STAGE(PG8_SB(1, 0), rB, b3, voffB); PG8_STAGE(PG8_SB(1, 1), rB, b3 + hstep, voffB); PG8_STAGE(PG8_SA(1, 0), rA, a3, voffA);
            PG8_WAIT_V(8); PG8_WAIT_L(0); PG8_BAR; PG8_MMA(1, 0, At, B0); PG8_MMA(1, 1, At, B1); PG8_BAR; PG8_SCHED;
            } else {
            PG8_LDB(B0, 0, 0); PG8_SCHED; PG8_LDA(At, 0, 0); PG8_STAGE(PG8_SA(1, 1), rA, a1 + hstep, voffA);
            PG8_WAIT_L(8); PG8_BAR; PG8_WAIT_L(0); PG8_MMA(0, 0, At, B0); PG8_BAR; PG8_SCHED;
            PG8_LDB(B1, 0, 1); PG8_STAGE(PG8_SB(0, 0), rB, b2, voffB);
            PG8_BAR; PG8_WAIT_L(0); PG8_MMA(0, 1, At, B1); PG8_BAR;
            PG8_LDA(At, 0, 1); PG8_STAGE(PG8_SA(0, 0), rA, a2, voffA);
            PG8_BAR; PG8_WAIT_L(0); PG8_MMA(1, 0, At, B0); PG8_BAR; PG8_SCHED;
            PG8_STAGE(PG8_SB(0, 1), rB, b2 + hstep, voffB);
            PG8_WAIT_V(6); PG8_BAR; PG8_MMA(1, 1, At, B1); PG8_BAR;
            PG8_LDB(B0, 1, 0); PG8_SCHED; PG8_LDA(At, 1, 0); PG8_STAGE(PG8_SA(0, 1), rA, a2 + hstep, voffA);
            PG8_WAIT_L(8); PG8_BAR; PG8_WAIT_L(0); PG8_MMA(0, 0, At, B0); PG8_BAR; PG8_SCHED;
            PG8_LDB(B1, 1, 1); PG8_STAGE(PG8_SB(1, 0), rB, b3, voffB);
            PG8_BAR; PG8_WAIT_L(0); PG8_MMA(0, 1, At, B1); PG8_BAR;
            PG8_LDA(At, 1, 1); PG8_STAGE(PG8_SA(1, 0), rA, a3, voffA);
            PG8_BAR; PG8_WAIT_L(0); PG8_MMA(1, 0, At, B0); PG8_BAR; PG8_SCHED;
            PG8_STAGE(PG8_SB(1, 1), rB, b3 + hstep, voffB);
            PG8_WAIT_V(6); PG8_BAR; PG8_MMA(1, 1, At, B1); PG8_BAR;
            }
        }
        if constexpr (ALIGN_EPI) { if (wr == 0) PG8_BAR; }
        if constexpr (!Epi::AFTER_DRAIN) { int ln_ = (int)__builtin_amdgcn_mbcnt_hi(~0u, __builtin_amdgcn_mbcnt_lo(~0u, 0u)); asm volatile("" : "+v"(ln_));
            E(acc, cur, wr, wc, ln_ & 15, ln_ >> 4); S.done(cur); }
        if (!has_next) break;
#pragma unroll
        for (int a = 0; a < 2; ++a)
#pragma unroll
            for (int b = 0; b < 2; ++b)
#pragma unroll
                for (int m = 0; m < 4; ++m)
#pragma unroll
                    for (int n = 0; n < 2; ++n) acc[a][b][m][n] = (f32x4){0.f, 0.f, 0.f, 0.f};
        cur = nxt; cA = nA; cB = nB; ++ui;
        if constexpr (ALIGN_EPI) { if (wr == 1) PG8_BAR; }
    }
    PG8_WAIT_V(0);
    if constexpr (!ALIGN_EPI) { if (wr == 0) PG8_BAR; }
    PG8_BAR;
    if constexpr (Epi::AFTER_DRAIN) { E.fused(acc, cur, wr, wc, fr, fq, lds, wid, lane); S.done(cur); }
#undef PG8_SA
#undef PG8_SB
#undef PG8_STAGE
#undef PG8_LDA
#undef PG8_LDB
#undef PG8_MMA
#undef PG8_WAIT_V
#undef PG8_WAIT_L
#undef PG8_BAR
#undef PG8_SCHED
#undef PG8_F8CAT
}
}

constexpr int NWAVES = 8, NTHR = NWAVES * 64;
constexpr int BATCH = 8, SEQ = 2048, DM = 2048, DEPTH = 2, HD = 64, GW = 512, NH = 8;
constexpr int M = BATCH * SEQ;
constexpr int NPROJ = 6080, NPROJ_P = 6144, DFF = 5632;
constexpr int CA_Q = 0, CA_K = 512, CA_V = 1024, CB_U = 1536, CB_V = 2048, CC_Q = 2560, CC_K = 3072, CC_V = 3584, CD = 4096;
constexpr int D_R = 0, D_WD = 512, D_K = 608, D_V = 1120, D_AD = 1632, D_GD = 1728, D_W = 1984;
constexpr float NORM_EPS = 1e-6f;
#ifndef N_LAUNCH_MODE
#define N_LAUNCH_MODE 0
#endif
#ifndef PG8_SP2
#define PG8_SP2 true
#endif
#ifndef FFN_FP8
#define FFN_FP8 1
#endif
#ifndef REPEAT
#define REPEAT 0
#endif
constexpr int N_PHASES = 16;

constexpr size_t MiB = 1u << 20;
constexpr size_t WS_CTL = 0, CTL_ZERO_BYTES = 2 * MiB;
constexpr size_t WS_WIN = 2 * MiB, WS_WOUT = 26 * MiB, WS_WGU = 34 * MiB, WS_WDN = 78 * MiB, WS_SMALL = 100 * MiB;
constexpr size_t WS_XB = 104 * MiB, WS_PROJ = 168 * MiB, WS_YCAT = 360 * MiB, WS_SC2 = 424 * MiB, WS_YD = 456 * MiB, WS_G = 488 * MiB, WS_BC = 504 * MiB, WS_END = 506 * MiB;
constexpr size_t SC_ARR = (size_t)M * GW * 2;
constexpr size_t SM_TB = 0;
constexpr size_t SM_KBAR = 64 * 1024;
constexpr size_t SM_STATS = 256 * 1024;
constexpr size_t SM_WT = 1024 * 1024;
constexpr int CW_BAR = 4096;
constexpr int CW_Q = 8192;
constexpr int CW_SSQ = 65536;
constexpr size_t CTL_KBAR = 1024 * 1024;
constexpr size_t CTL_STATS = 1280 * 1024;
static_assert((size_t)CW_SSQ * 4 + 5 * (size_t)M * 8 <= CTL_KBAR && CTL_STATS + 2 * (size_t)M * 2 * 8 <= CTL_ZERO_BYTES, "CTL");

constexpr int RING_OFF = 0, RING_BYTES = 131072;
constexpr int LDS_BYTES = 163840, MISC_OFF = LDS_BYTES - 256;

#define GAS __attribute__((address_space(1)))
#define LAS __attribute__((address_space(3)))
typedef unsigned short bf16;
typedef unsigned v4u __attribute__((ext_vector_type(4)));
typedef unsigned v2u __attribute__((ext_vector_type(2)));
typedef float f32x4 __attribute__((ext_vector_type(4)));
typedef short bf16x8 __attribute__((ext_vector_type(8)));
typedef float f32x16 __attribute__((ext_vector_type(16)));
typedef GAS unsigned gu32;
#define RLX_AGENT __ATOMIC_RELAXED, __HIP_MEMORY_SCOPE_AGENT
#define LDS_WAIT() asm volatile("s_waitcnt lgkmcnt(0)" ::: "memory")
#define VM_WAIT() asm volatile("s_waitcnt vmcnt(0)" ::: "memory")
__device__ __forceinline__ unsigned f2bf(float f) { unsigned u = __builtin_bit_cast(unsigned, f); return (u + 0x7fffu + ((u >> 16) & 1u)) >> 16; }
__device__ __forceinline__ unsigned pk2(float lo, float hi) { return f2bf(lo) | (f2bf(hi) << 16); }
__device__ __forceinline__ float bf2f(unsigned short h) { return __builtin_bit_cast(float, (unsigned)h << 16); }
__device__ __forceinline__ float bflo(unsigned w) { return __builtin_bit_cast(float, w << 16); }
__device__ __forceinline__ float bfhi(unsigned w) { return __builtin_bit_cast(float, w & 0xffff0000u); }
__device__ __forceinline__ float sigmoidf_(float x) { return 1.0f / (1.0f + __expf(-x)); }
__device__ __forceinline__ float gelu_tanh(float x) { const float u = 0.7978845608028654f * (x + 0.044715f * x * x * x); const float e = __expf(2.0f * u); const float th = 1.0f - 2.0f / (e + 1.0f); return 0.5f * x * (1.0f + th); }
__device__ __forceinline__ float wave_sum(float v) {
#pragma unroll
    for (int o = 1; o < 64; o <<= 1) v += __shfl_xor(v, o);
    return v;
}

__device__ __forceinline__ float zero_v() { float z = 0.f; asm volatile("" : "+v"(z)); return z; }

#define UNPACK8(dst, o, W_) do { dst[(o)] = bflo((W_).x); dst[(o) + 1] = bfhi((W_).x); dst[(o) + 2] = bflo((W_).y); dst[(o) + 3] = bfhi((W_).y); dst[(o) + 4] = bflo((W_).z); dst[(o) + 5] = bfhi((W_).z); dst[(o) + 6] = bflo((W_).w); dst[(o) + 7] = bfhi((W_).w); } while (0)
#define XB_TMO      128
#define XB_XCNT(j)  (256  + 64 * (j))
#define XB_XSUB(j)  (1280 + 64 * (j))
#define XB_XGEN(j)  (2304 + 64 * (j))
#define XB_TOP      3328
#define XB_TOPGEN   3392
#define XCD_BAR_WORDS 3456
#define XB_SPIN_CAP (1u << 18)

__device__ __forceinline__ unsigned xb_ld(unsigned* p)              { return __hip_atomic_load(p, __ATOMIC_RELAXED, __HIP_MEMORY_SCOPE_AGENT); }
__device__ __forceinline__ unsigned xb_add(unsigned* p, unsigned v) { return __hip_atomic_fetch_add(p, v, __ATOMIC_RELAXED, __HIP_MEMORY_SCOPE_AGENT); }
__device__ __forceinline__ unsigned xb_xcc_id() { return (unsigned)__builtin_amdgcn_s_getreg((3 << 11) | 20) & 0xFu; }
#define XB_SPIN(cond, bar) do { unsigned _sp = 0; while (cond) { __builtin_amdgcn_s_sleep(1); \
    if ((++_sp & 255u) == 0u) { if (xb_ld(&(bar)[XB_TMO])) break; if (_sp > XB_SPIN_CAP) { atomicAdd(&(bar)[XB_TMO], 1u); break; } } } } while (0)

struct XcdBarrier {
    unsigned* bar; unsigned x;
    volatile LAS unsigned* st;
};

__device__ __forceinline__ XcdBarrier xcd_barrier_post(unsigned* bar, volatile LAS unsigned* st) {
    XcdBarrier b; b.bar = bar; b.x = xb_xcc_id(); b.st = st;
    if (threadIdx.x == 0) (void)xb_add(&bar[XB_XCNT(b.x)], 1u);
    return b;
}
__device__ __forceinline__ void xcd_barrier_complete(unsigned* bar, unsigned x, unsigned& nloc, unsigned& nx) {
    const unsigned G = gridDim.x * gridDim.y * gridDim.z;
    unsigned sum, cnt, mine, sp = 0u;
    for (;;) {
        sum = 0u; cnt = 0u; mine = 0u;
#pragma unroll
        for (unsigned j = 0; j < 16; ++j) { const unsigned c = xb_ld(&bar[XB_XCNT(j)]); sum += c; cnt += (c > 0u) ? 1u : 0u; mine = (j == x) ? c : mine; }
        if (sum == G) break;
        __builtin_amdgcn_s_sleep(1);
        if ((++sp & 255u) == 0u) { if (xb_ld(&bar[XB_TMO])) break; if (sp > XB_SPIN_CAP) { atomicAdd(&bar[XB_TMO], 1u); break; } }
    }
    nloc = mine > 0u ? mine : 1u; nx = cnt > 0u ? cnt : 1u;
}

__device__ __forceinline__ void xcd_barrier(const XcdBarrier& b) {
    asm volatile("s_waitcnt vmcnt(0)" ::: "memory");
    __syncthreads();
    if (threadIdx.x == 0) {
        unsigned* bar = b.bar;
        __builtin_amdgcn_s_waitcnt(0);
        unsigned nloc = b.st[0], nx = b.st[1];
        if (nloc == 0u) { xcd_barrier_complete(bar, b.x, nloc, nx); b.st[0] = nloc; b.st[1] = nx; }
        const unsigned old = xb_add(&bar[XB_XSUB(b.x)], 1u);
        const unsigned gen = old / nloc;
        if (old + 1u == (gen + 1u) * nloc) {
            __builtin_amdgcn_fence(__ATOMIC_RELEASE, "agent");
            asm volatile("s_waitcnt vmcnt(0)" ::: "memory");
            const unsigned og = xb_add(&bar[XB_TOP], 1u);
            const unsigned tg = og / nx;
            if (og + 1u == (tg + 1u) * nx) xb_add(&bar[XB_TOPGEN], 1u);
            else XB_SPIN(xb_ld(&bar[XB_TOPGEN]) == tg, bar);
            __builtin_amdgcn_fence(__ATOMIC_ACQUIRE, "agent");
            xb_add(&bar[XB_XGEN(b.x)], 1u);
            asm volatile("s_waitcnt vmcnt(0)" ::: "memory");
        } else {
            XB_SPIN(xb_ld(&bar[XB_XGEN(b.x)]) == gen, bar);
            __builtin_amdgcn_fence(__ATOMIC_ACQUIRE, "agent");
            asm volatile("s_waitcnt vmcnt(0)" ::: "memory");
        }
    }
    __syncthreads();
}

struct Args { const float* in[25]; float* out; unsigned char* ws; int ph_lo, ph_hi; };
struct Frame {
    LAS unsigned char* lds; int tid, lane, wave, G, vcu, gw, ngw;
};
typedef const __attribute__((address_space(4))) unsigned long long* karg_t;
__device__ __forceinline__ karg_t kargs() { karg_t ka = (karg_t)__builtin_amdgcn_kernarg_segment_ptr(); asm volatile("" : "+s"(ka)); return ka; }
__device__ __forceinline__ const float* inp(int i) { return (const float*)(const GAS float*)kargs()[i]; }
__device__ __forceinline__ float* outp() { return (float*)(GAS float*)kargs()[25]; }
__device__ __forceinline__ unsigned char* wsp() { return (unsigned char*)(GAS unsigned char*)kargs()[26]; }
__device__ __forceinline__ gu32* ctlp() { return (gu32*)(wsp() + WS_CTL); }

__device__ __forceinline__ void conv_item(const float* W, int K, int N, const float* g, bf16* WT, int kind, LAS float* scr, int item, int lane) {
    const int nblk = N / 32, kb = item / nblk, nb = item % nblk, k0 = 64 * kb, n0 = 32 * nb;
    float ld[32];
    { const float* wp = W + (size_t)(k0 + (lane >> 5)) * N + n0 + (lane & 31);
#pragma unroll
      for (int i = 0; i < 32; ++i) ld[i] = wp[(size_t)(2 * i) * N]; }
    if (g) { const float* gp = g + k0 + (lane >> 5);
#pragma unroll
      for (int i = 0; i < 32; ++i) ld[i] *= gp[2 * i]; }
#pragma unroll
    for (int i = 0; i < 32; ++i) scr[(2 * i + (lane >> 5)) * 33 + (lane & 31)] = ld[i];
    LDS_WAIT(); asm volatile("" ::: "memory");
    const int c = lane & 7;
#pragma unroll
    for (int j = 0; j < 4; ++j) { const int n = (lane >> 3) + 8 * j; const LAS float* s = scr + (8 * c) * 33 + n;
        v4u o; o.x = pk2(s[0 * 33], s[1 * 33]); o.y = pk2(s[2 * 33], s[3 * 33]); o.z = pk2(s[4 * 33], s[5 * 33]); o.w = pk2(s[6 * 33], s[7 * 33]);
        const int nn = n0 + n;
        if (kind >= 3) {
            const int row = kind == 5 ? nn : ((nn >> 7) * 256 + (kind - 3) * 128 + (nn & 127)); int f0 = (int)o.x, f1 = (int)o.y;
            f0 = __builtin_amdgcn_cvt_pk_fp8_f32(64.f * s[0 * 33], 64.f * s[1 * 33], f0, false); f0 = __builtin_amdgcn_cvt_pk_fp8_f32(64.f * s[2 * 33], 64.f * s[3 * 33], f0, true);
            f1 = __builtin_amdgcn_cvt_pk_fp8_f32(64.f * s[4 * 33], 64.f * s[5 * 33], f1, false); f1 = __builtin_amdgcn_cvt_pk_fp8_f32(64.f * s[6 * 33], 64.f * s[7 * 33], f1, true);
            *(GAS v2u*)((unsigned char*)WT + (size_t)row * K + k0 + 8 * c) = (v2u){(unsigned)f0, (unsigned)f1};
        } else {
        const int row = kind == 0 ? nn : ((nn >> 7) * 256 + (kind - 1) * 128 + (nn & 127));
        *(GAS v4u*)(WT + (size_t)row * K + k0 + 8 * c) = o; } }
    LDS_WAIT(); asm volatile("" ::: "memory");
}
__device__ __forceinline__ void conv_layer_items(Frame& F, int l, int gw, int ngw, bool do_in, bool do_rest) {
    LAS float* scr = (LAS float*)(F.lds + RING_OFF + F.wave * 16384);
    constexpr int I_IN = (DM / 64) * (NPROJ / 32), I_OUT = (DM / 64) * (DM / 32), I_G = (DM / 64) * (DFF / 32), I_D = (DFF / 64) * (DM / 32);
    const float* w_in = inp(2) + (size_t)l * DM * NPROJ; const float* w_out = inp(19) + (size_t)l * DM * DM;
    const float* w_g = inp(21) + (size_t)l * DM * DFF; const float* w_u = inp(22) + (size_t)l * DM * DFF; const float* w_d = inp(23) + (size_t)l * DFF * DM;
    const float* g_mix = inp(1) + l * DM; const float* g_br = inp(18) + l * DM; const float* g_ffn = inp(20) + l * DM;
    bf16* WIN = (bf16*)(wsp() + WS_WIN); bf16* WOUT = (bf16*)(wsp() + WS_WOUT); bf16* WGU = (bf16*)(wsp() + WS_WGU); bf16* WDN = (bf16*)(wsp() + WS_WDN);
    if (do_in) {
        for (int it = gw; it < I_IN; it += ngw) conv_item(w_in, DM, NPROJ, g_mix, WIN, 0, scr, it, F.lane);
    }
    if (do_rest) {
        for (int it = gw; it < I_OUT + 2 * I_G + I_D; it += ngw) {
            int r = it;
            if (r < I_OUT) { conv_item(w_out, DM, DM, g_br, WOUT, 0, scr, r, F.lane); continue; } r -= I_OUT;
            if (r < I_G) { conv_item(w_g, DM, DFF, g_ffn, WGU, FFN_FP8 ? 3 : 1, scr, r, F.lane); continue; } r -= I_G;
            if (r < I_G) { conv_item(w_u, DM, DFF, g_ffn, WGU, FFN_FP8 ? 4 : 2, scr, r, F.lane); continue; } r -= I_G;
            conv_item(w_d, DFF, DM, nullptr, WDN, FFN_FP8 ? 5 : 0, scr, r, F.lane);
        }
    }
}

__device__ __forceinline__ void ph_prologue(Frame& F) {
    conv_layer_items(F, 0, F.gw, F.ngw, true, false);
    { bf16* WIN = (bf16*)(wsp() + WS_WIN);
      for (int i = F.gw * 64 + F.lane; i < 64 * DM / 8; i += F.ngw * 64) *(GAS v4u*)(WIN + (size_t)NPROJ * DM + (size_t)i * 8) = (v4u){0u, 0u, 0u, 0u}; }
    if (blockIdx.x == 0) {
        int* TB = (int*)(wsp() + WS_SMALL + SM_TB);
        for (int d = F.tid; d < 2049; d += NTHR) {
            int bkt = d;
            if (d >= 16) bkt = 16 + (d >= 22) + (d >= 30) + (d >= 40) + (d >= 54) + (d >= 73) + (d >= 99) + (d >= 134) + (d >= 182) + (d >= 246) + (d >= 332) + (d >= 450) + (d >= 609) + (d >= 825) + (d >= 1117) + (d >= 1513);
            TB[d] = bkt;
        }
    }
    { bf16* WT = (bf16*)(wsp() + WS_SMALL + SM_WT); const float* w2 = inp(9); const float* a2 = inp(11); const float* g2 = inp(12);
      for (int idx = blockIdx.x * NTHR + F.tid; idx < DEPTH * 448 * GW; idx += F.G * NTHR) {
          const int c = idx % GW, k = (idx / GW) % 448, l = idx / (GW * 448);
          const float v = k < 96 ? w2[((size_t)l * 96 + k) * GW + c] : (k < 192 ? a2[((size_t)l * 96 + (k - 96)) * GW + c] : g2[((size_t)l * 256 + (k - 192)) * GW + c]);
          const int r32_ = c & 31, hct = c >> 5, ks_ = k >> 4, hh_ = (k >> 3) & 1;
          WT[(size_t)l * GW * 448 + (((size_t)hct * 28 + ks_) * 64 + 32 * hh_ + r32_) * 8 + (k & 7)] = (bf16)f2bf(v); } }
    const float* x = inp(0); bf16* XB = (bf16*)(wsp() + WS_XB); pg8::fx_t* ssq = (pg8::fx_t*)(ctlp() + CW_SSQ);
    for (int m = F.gw; m < M; m += F.ngw) {
        const GAS f32x4* xr = (const GAS f32x4*)(x + (size_t)m * DM) + F.lane; GAS v2u* o = (GAS v2u*)(XB + (size_t)m * DM) + F.lane; float s = 0.f;
#pragma unroll
        for (int j = 0; j < 8; ++j) { const f32x4 v = xr[64 * j]; s += (v.x * v.x + v.y * v.y) + (v.z * v.z + v.w * v.w); o[64 * j] = (v2u){pk2(v.x, v.y), pk2(v.z, v.w)}; }
        s = wave_sum(s); if (F.lane == 0) pg8::fx_add(ssq + m, s);
    }
}

constexpr int PR_PITCH = 912;
constexpr int PR_PRM_OFF = 32768, PR_MUA_OFF = PR_PRM_OFF + 8 * 512 * 4;
__device__ __forceinline__ float fast_tanh(float x) { return 1.0f - 2.0f * __builtin_amdgcn_rcpf(__expf(2.0f * x) + 1.0f); }
__device__ __forceinline__ float fast_sigmoid(float x) { return __builtin_amdgcn_rcpf(1.0f + __expf(-x)); }
constexpr int PR_OT_OFF = 51200, PR_OT_PITCH = 72, PR_OT_TILE = 32 * PR_OT_PITCH, PR_OT_WAVE = 6 * PR_OT_TILE;
static_assert(PR_OT_OFF + 8 * PR_OT_WAVE <= MISC_OFF, "prep LDS");
__device__ __forceinline__ void ph_prep(Frame& F, int l) {
    const bf16* PROJ = (const bf16*)(wsp() + WS_PROJ);
    bf16* R_ = (bf16*)outp();
    bf16* E_ = R_ + (size_t)M * GW; bf16* KP_ = E_ + (size_t)M * GW; bf16* V_ = KP_ + (size_t)M * GW;
    bf16* KK_ = (bf16*)outp() + (size_t)4 * M * GW; bf16* AS_ = KK_ + (size_t)M * GW; bf16* G_ = (bf16*)(wsp() + WS_G); float* BC = (float*)(wsp() + WS_BC);
    const bf16* WT = (const bf16*)(wsp() + WS_SMALL + SM_WT) + (size_t)l * GW * 448;
    LAS unsigned char* actL = F.lds + RING_OFF; LAS float* PRM = (LAS float*)(F.lds + PR_PRM_OFF); LAS float* MUA = (LAS float*)(F.lds + PR_MUA_OFF);
    { const float* mu = inp(7) + l * D_W; const float* w0 = inp(8) + l * GW; const float* a0 = inp(10) + l * GW; const float* k_k = inp(13) + l * GW; const float* k_a = inp(14) + l * GW; const float* r_k = inp(15) + l * GW;
      const int c = F.tid;
      PRM[c] = mu[D_R + c]; PRM[512 + c] = mu[D_K + c]; PRM[1024 + c] = mu[D_V + c]; PRM[1536 + c] = w0[c]; PRM[2048 + c] = a0[c]; PRM[2560 + c] = k_k[c]; PRM[3072 + c] = k_a[c]; PRM[3584 + c] = r_k[c];
      if (c < 448) MUA[c] = mu[c < 96 ? D_WD + c : (c < 192 ? D_AD + (c - 96) : D_GD + (c - 192))]; }
    __syncthreads();
    const int h = F.wave;
    for (int it = blockIdx.x; it < M / 32; it += F.G) {
        const int m0 = it * 32;
        int tid_ = threadIdx.x; asm volatile("" : "+v"(tid_));
        const int tid = tid_, r32 = tid & 31, hh = (tid >> 5) & 1, lane = tid & 63;
        LAS unsigned char* OT = F.lds + PR_OT_OFF + h * PR_OT_WAVE;
        { v2u pc[7], pp[7];
#pragma unroll
          for (int i = 0; i < 7; ++i) { const int gi = tid + NTHR * i, t = gi / 112, k = 4 * (gi % 112), m = m0 + t;
              const int col = k < 96 ? D_WD + k : (k < 192 ? D_AD + (k - 96) : D_GD + (k - 192)); const bf16* src = PROJ + (size_t)m * NPROJ_P + CD + col;
              pc[i] = *(const GAS v2u*)src; pp[i] = (v2u){0u, 0u}; if ((m % SEQ) > 0) pp[i] = *(const GAS v2u*)(src - NPROJ_P); }
#pragma unroll
          for (int i = 0; i < 7; ++i) { const int gi = tid + NTHR * i, t = gi / 112, k = 4 * (gi % 112);
              const f32x4 mv = *(const LAS f32x4*)(MUA + k);
              float x[4] = {bflo(pc[i].x), bfhi(pc[i].x), bflo(pc[i].y), bfhi(pc[i].y)}; const float xp[4] = {bflo(pp[i].x), bfhi(pp[i].x), bflo(pp[i].y), bfhi(pp[i].y)};
#pragma unroll
              for (int e = 0; e < 4; ++e) { x[e] += (xp[e] - x[e]) * mv[e]; x[e] = k < 96 ? fast_tanh(x[e]) : (k < 192 ? x[e] : fast_sigmoid(x[e])); }
              *(LAS v2u*)(actL + t * PR_PITCH + 2 * k) = (v2u){pk2(x[0], x[1]), pk2(x[2], x[3])}; } }
        __syncthreads();
        const int m = m0 + r32; const bool has_prev = (m % SEQ) > 0;
        const bf16* pr = PROJ + (size_t)m * NPROJ_P + CD; const bf16* pq = pr - NPROJ_P;
        const LAS unsigned char* bp = actL + r32 * PR_PITCH + 16 * hh;
        float kkv[2][16]; float n2 = 0.f, bcv = 0.f;
#pragma unroll
        for (int ct = 0; ct < 2; ++ct) {
            const int cb = 64 * h + 32 * ct + 4 * hh;
            v4u xc[3][2], xp[3][2];
#pragma unroll
            for (int a = 0; a < 3; ++a)
#pragma unroll
                for (int i = 0; i < 2; ++i) { const int mm = m0 + (lane >> 2) + 16 * i; const bf16* src = PROJ + (size_t)mm * NPROJ_P + CD + (a == 0 ? D_R : (a == 1 ? D_K : D_V)) + 64 * h + 32 * ct + 8 * (lane & 3);
                    xc[a][i] = *(const GAS v4u*)src; xp[a][i] = (v4u){0u, 0u, 0u, 0u}; if ((mm % SEQ) > 0) xp[a][i] = *(const GAS v4u*)(src - NPROJ_P); }
            f32x16 aW, aA, aG;
            { const float z_ = zero_v();
#pragma unroll
            for (int i = 0; i < 16; ++i) { aW[i] = z_; aA[i] = z_; aG[i] = z_; } }
            const bf16* wt0 = WT + ((size_t)(2 * h + ct) * 28 * 64 + lane) * 8;
#pragma unroll
            for (int grp = 0; grp < 4; ++grp) {
                bf16x8 af[7];
#pragma unroll
                for (int q = 0; q < 7; ++q) af[q] = *(const GAS bf16x8*)(wt0 + 512 * (7 * grp + q));
#pragma unroll
                for (int q = 0; q < 7; ++q) { const int ks = 7 * grp + q; const bf16x8 bfr = *(const LAS bf16x8*)(bp + 32 * ks);
                    if (ks < 6) aW = __builtin_amdgcn_mfma_f32_32x32x16_bf16(af[q], bfr, aW, 0, 0, 0);
                    else if (ks < 12) aA = __builtin_amdgcn_mfma_f32_32x32x16_bf16(af[q], bfr, aA, 0, 0, 0);
                    else aG = __builtin_amdgcn_mfma_f32_32x32x16_bf16(af[q], bfr, aG, 0, 0, 0); }
                asm volatile("" ::: "memory");
            }
            LAS unsigned char* IN = OT + 3 * PR_OT_TILE;
#pragma unroll
            for (int a = 0; a < 3; ++a)
#pragma unroll
                for (int i = 0; i < 2; ++i) { const int cch = 64 * h + 32 * ct + 8 * (lane & 3); const f32x4 m0v = *(const LAS f32x4*)(PRM + a * 512 + cch), m1v = *(const LAS f32x4*)(PRM + a * 512 + cch + 4);
                    float xcu[8], xpu[8]; UNPACK8(xcu, 0, xc[a][i]); UNPACK8(xpu, 0, xp[a][i]); const float mw[8] = {m0v.x, m0v.y, m0v.z, m0v.w, m1v.x, m1v.y, m1v.z, m1v.w};
#pragma unroll
                    for (int e = 0; e < 8; ++e) xcu[e] += (xpu[e] - xcu[e]) * mw[e];
                    LAS unsigned char* dstp = IN + a * PR_OT_TILE + ((lane >> 2) + 16 * i) * PR_OT_PITCH + 16 * (lane & 3);
                    *(LAS v2u*)dstp = (v2u){pk2(xcu[0], xcu[1]), pk2(xcu[2], xcu[3])}; *(LAS v2u*)(dstp + 8) = (v2u){pk2(xcu[4], xcu[5]), pk2(xcu[6], xcu[7])}; }
            asm volatile("" ::: "memory");
            v2u oE[4], oK[4], oG[4];
#pragma unroll
            for (int g4 = 0; g4 < 4; ++g4) {
                const int c = cb + 8 * g4;
                const f32x4 w0v = *(const LAS f32x4*)(PRM + 1536 + c),
                            a0v = *(const LAS f32x4*)(PRM + 2048 + c), kkc = *(const LAS f32x4*)(PRM + 2560 + c), kac = *(const LAS f32x4*)(PRM + 3072 + c), rkc = *(const LAS f32x4*)(PRM + 3584 + c);
                const LAS unsigned char* inq = IN + r32 * PR_OT_PITCH + 2 * (8 * g4 + 4 * hh);
                const v2u rq = *(const LAS v2u*)inq, kq = *(const LAS v2u*)(inq + PR_OT_TILE), vq = *(const LAS v2u*)(inq + 2 * PR_OT_TILE);
                const float rsu[4] = {bflo(rq.x), bfhi(rq.x), bflo(rq.y), bfhi(rq.y)}, ksu[4] = {bflo(kq.x), bfhi(kq.x), bflo(kq.y), bfhi(kq.y)}, vsu[4] = {bflo(vq.x), bfhi(vq.x), bflo(vq.y), bfhi(vq.y)};
                float ro[4], eo[4], ko[4], vo[4], ao[4], go[4];
#pragma unroll
                for (int e = 0; e < 4; ++e) {
                    const float r = rsu[e], k = ksu[e], v = vsu[e];
                    const float ee = 0.6065306597126334f * fast_sigmoid(w0v[e] + aW[4 * g4 + e]);
                    const float as = fast_sigmoid(a0v[e] + aA[4 * g4 + e]);
                    const float kv = k * kkc[e]; kkv[ct][4 * g4 + e] = kv; n2 += kv * kv;
                    const float kp = k * (1.0f + (as - 1.0f) * kac[e]);
                    bcv += r * kp * rkc[e];
                    ro[e] = r; eo[e] = ee; ko[e] = kp; vo[e] = v; ao[e] = as; go[e] = aG[4 * g4 + e];
                }
                LAS unsigned char* ot = OT + r32 * PR_OT_PITCH + 2 * (8 * g4 + 4 * hh);
                *(LAS v2u*)(ot) = (v2u){pk2(ro[0], ro[1]), pk2(ro[2], ro[3])}; *(LAS v2u*)(ot + PR_OT_TILE) = (v2u){pk2(vo[0], vo[1]), pk2(vo[2], vo[3])}; *(LAS v2u*)(ot + 2 * PR_OT_TILE) = (v2u){pk2(ao[0], ao[1]), pk2(ao[2], ao[3])};
                oE[g4] = (v2u){pk2(eo[0], eo[1]), pk2(eo[2], eo[3])}; oK[g4] = (v2u){pk2(ko[0], ko[1]), pk2(ko[2], ko[3])}; oG[g4] = (v2u){pk2(go[0], go[1]), pk2(go[2], go[3])};
            }
            asm volatile("" ::: "memory");
#pragma unroll
            for (int batch = 0; batch < 2; ++batch) {
                bf16* const dst[3] = {batch == 0 ? R_ : E_, batch == 0 ? V_ : KP_, batch == 0 ? AS_ : G_};
                if (batch == 1) {
#pragma unroll
                    for (int g4 = 0; g4 < 4; ++g4) { LAS unsigned char* ot = OT + r32 * PR_OT_PITCH + 2 * (8 * g4 + 4 * hh); *(LAS v2u*)(ot) = oE[g4]; *(LAS v2u*)(ot + PR_OT_TILE) = oK[g4]; *(LAS v2u*)(ot + 2 * PR_OT_TILE) = oG[g4]; }
                    asm volatile("" ::: "memory"); }
#pragma unroll
                for (int a = 0; a < 3; ++a)
#pragma unroll
                    for (int i = 0; i < 2; ++i) { const int tk = (lane >> 2) + 16 * i, part = lane & 3; const LAS unsigned char* src = OT + a * PR_OT_TILE + tk * PR_OT_PITCH + 16 * part;
                        const v2u lo = *(const LAS v2u*)src, hi = *(const LAS v2u*)(src + 8);
                        *(GAS v4u*)(dst[a] + (size_t)(m0 + tk) * GW + 64 * h + 32 * ct + 8 * part) = (v4u){lo.x, lo.y, hi.x, hi.y}; }
                asm volatile("" ::: "memory");
            }
        }
        n2 += __shfl_xor(n2, 32); bcv += __shfl_xor(bcv, 32);
        const float inv = 1.0f / fmaxf(sqrtf(n2), 1e-12f);
#pragma unroll
        for (int ct = 0; ct < 2; ++ct)
#pragma unroll
            for (int g4 = 0; g4 < 4; ++g4) *(LAS v2u*)(OT + ct * PR_OT_TILE + r32 * PR_OT_PITCH + 2 * (8 * g4 + 4 * hh)) = (v2u){pk2(kkv[ct][4 * g4] * inv, kkv[ct][4 * g4 + 1] * inv), pk2(kkv[ct][4 * g4 + 2] * inv, kkv[ct][4 * g4 + 3] * inv)};
        asm volatile("" ::: "memory");
#pragma unroll
        for (int ct = 0; ct < 2; ++ct)
#pragma unroll
            for (int i = 0; i < 2; ++i) { const int tk = (lane >> 2) + 16 * i, part = lane & 3; const LAS unsigned char* src = OT + ct * PR_OT_TILE + tk * PR_OT_PITCH + 16 * part;
                const v2u lo = *(const LAS v2u*)src, hi = *(const LAS v2u*)(src + 8);
                *(GAS v4u*)(KK_ + (size_t)(m0 + tk) * GW + 64 * h + 32 * ct + 8 * part) = (v4u){lo.x, lo.y, hi.x, hi.y}; }
        asm volatile("" ::: "memory");
        if (hh == 0) BC[(size_t)m * NH + h] = bcv;
        __syncthreads();
    }
}

__device__ __forceinline__ Frame mkframe(LAS unsigned char* lds) {
    Frame F; F.lds = lds; { int t_ = threadIdx.x; asm volatile("" : "+v"(t_)); F.tid = t_; } F.lane = F.tid & 63; F.wave = __builtin_amdgcn_readfirstlane(F.tid >> 6);
    F.G = gridDim.x; { const int bx = blockIdx.x; F.vcu = (F.G % 8 == 0) ? (bx % 8) * (F.G / 8) + bx / 8 : bx; }
    F.gw = blockIdx.x * NWAVES + F.wave; F.ngw = F.G * NWAVES; return F;
}

#ifndef UNPACK8
#define UNPACK8(dst, o, W_) do { dst[(o)] = bflo((W_).x); dst[(o) + 1] = bfhi((W_).x); dst[(o) + 2] = bflo((W_).y); dst[(o) + 3] = bfhi((W_).y); dst[(o) + 4] = bflo((W_).z); dst[(o) + 5] = bfhi((W_).z); dst[(o) + 6] = bflo((W_).w); dst[(o) + 7] = bfhi((W_).w); } while (0)
#endif
#define DOT8(q, o, W_) ((q)[(o)] * bflo((W_).x) + (q)[(o) + 1] * bfhi((W_).x) + (q)[(o) + 2] * bflo((W_).y) + (q)[(o) + 3] * bfhi((W_).y) + (q)[(o) + 4] * bflo((W_).z) + (q)[(o) + 5] * bfhi((W_).z) + (q)[(o) + 6] * bflo((W_).w) + (q)[(o) + 7] * bfhi((W_).w))
#define AXPY8(acc, o, sc, pe, W_) do { acc[(o)] = acc[(o)] * (sc) + (pe) * bflo((W_).x); acc[(o) + 1] = acc[(o) + 1] * (sc) + (pe) * bfhi((W_).x); acc[(o) + 2] = acc[(o) + 2] * (sc) + (pe) * bflo((W_).y); acc[(o) + 3] = acc[(o) + 3] * (sc) + (pe) * bfhi((W_).y); \
    acc[(o) + 4] = acc[(o) + 4] * (sc) + (pe) * bflo((W_).z); acc[(o) + 5] = acc[(o) + 5] * (sc) + (pe) * bfhi((W_).z); acc[(o) + 6] = acc[(o) + 6] * (sc) + (pe) * bflo((W_).w); acc[(o) + 7] = acc[(o) + 7] * (sc) + (pe) * bfhi((W_).w); } while (0)
__device__ __forceinline__ void mix_a_simple(Frame& F) {
    const bf16* PROJ = (const bf16*)(wsp() + WS_PROJ); bf16* YC = (bf16*)(wsp() + WS_YCAT); const int* TB = (const int*)(wsp() + WS_SMALL + SM_TB); const float* pb = inp(3);
    const int nthr = F.G * NTHR;
    for (int idx = blockIdx.x * NTHR + F.tid; idx < M * NH; idx += nthr) {
        const int m = idx >> 3, h = idx & 7, t = m % SEQ;
        float q[64], acc[64];
        { const GAS v4u* qp = (const GAS v4u*)(PROJ + (size_t)m * NPROJ_P + CA_Q + 64 * h);
#pragma unroll
          for (int i = 0; i < 8; ++i) { const v4u w = qp[i]; UNPACK8(q, 8 * i, w); } }
#pragma unroll
        for (int i = 0; i < 64; ++i) acc[i] = 0.f;
        float mx = -1e30f, l = 0.f;
        for (int p = 0; p < 3; ++p) { const int d = p == 0 ? 1 : (p == 1 ? 4 : 16);
            for (int j = 0; j <= 128; ++j) { const int kp = t - j * d; if (kp < 0) break;
                const bf16* row = PROJ + (size_t)(m - j * d) * NPROJ_P; const GAS v4u* kq = (const GAS v4u*)(row + CA_K + 64 * h); const GAS v4u* vq = (const GAS v4u*)(row + CA_V + 64 * h);
                float s = 0.f;
#pragma unroll
                for (int i = 0; i < 8; ++i) { const v4u w = kq[i]; s += DOT8(q, 8 * i, w); }
                s = s * 0.125f + pb[TB[j * d] * 16 + h];
                const float mn = fmaxf(mx, s), sc = __expf(mx - mn), pe = __expf(s - mn); mx = mn; l = l * sc + pe;
#pragma unroll
                for (int i = 0; i < 8; ++i) { const v4u w = vq[i]; AXPY8(acc, 8 * i, sc, pe, w); }
            } }
        const float inv = 1.0f / l; GAS v4u* op = (GAS v4u*)(YC + (size_t)m * DM + 0 * GW + 64 * h);
#pragma unroll
        for (int i = 0; i < 8; ++i) op[i] = (v4u){pk2(acc[8 * i] * inv, acc[8 * i + 1] * inv), pk2(acc[8 * i + 2] * inv, acc[8 * i + 3] * inv), pk2(acc[8 * i + 4] * inv, acc[8 * i + 5] * inv), pk2(acc[8 * i + 6] * inv, acc[8 * i + 7] * inv)};
    }
}
__device__ __forceinline__ void mix_c_simple(Frame& F, int l = 0) {
    const bf16* PROJ = (const bf16*)(wsp() + WS_PROJ); bf16* YC = (bf16*)(wsp() + WS_YCAT); const int* TB = (const int*)(wsp() + WS_SMALL + SM_TB); const float* pb = inp(3);
    const float* KBAR = (const float*)(wsp() + CTL_KBAR) + (size_t)l * 64 * 8 * 64;
    const int nthr = F.G * NTHR;
    for (int idx = blockIdx.x * NTHR + F.tid; idx < M * NH; idx += nthr) {
        const int m = idx >> 3, h = idx & 7, t = m % SEQ, b = m / SEQ, ob = t >> 8;
        float q[64], acc[64];
        { const GAS v4u* qp = (const GAS v4u*)(PROJ + (size_t)m * NPROJ_P + CC_Q + 64 * h);
#pragma unroll
          for (int i = 0; i < 8; ++i) { const v4u w = qp[i]; UNPACK8(q, 8 * i, w); } }
        float gate[8];
#pragma unroll
        for (int n = 0; n < 8; ++n) { float s = 0.f; if (n < ob) { const float* kb = KBAR + ((b * NH + h) * 8 + n) * 64;
#pragma unroll
                for (int i = 0; i < 64; ++i) s += q[i] * kb[i]; } gate[n] = s; }
        unsigned sel = 0u;
#pragma unroll
        for (int n = 0; n < 8; ++n) { int rank = 0;
#pragma unroll
            for (int n2 = 0; n2 < 8; ++n2) rank += (n2 < ob && n2 != n && (gate[n2] > gate[n] || (gate[n2] == gate[n] && n2 < n))) ? 1 : 0;
            if (n < ob && rank < 3) sel |= 1u << n; }
        sel |= 1u << ob;
#pragma unroll
        for (int i = 0; i < 64; ++i) acc[i] = 0.f;
        float mx = -1e30f, l = 0.f;
        for (int n = 0; n <= ob; ++n) { if (!((sel >> n) & 1u)) continue; const int kmax = n == ob ? (t & 255) : 255;
            for (int i2 = 0; i2 <= kmax; ++i2) { const int kp = 256 * n + i2;
                const bf16* row = PROJ + ((size_t)b * SEQ + kp) * NPROJ_P; const GAS v4u* kq = (const GAS v4u*)(row + CC_K + 64 * h); const GAS v4u* vq = (const GAS v4u*)(row + CC_V + 64 * h);
                float s = 0.f;
#pragma unroll
                for (int i = 0; i < 8; ++i) { const v4u w = kq[i]; s += DOT8(q, 8 * i, w); }
                s = s * 0.125f + pb[TB[t - kp] * 16 + 8 + h];
                const float mn = fmaxf(mx, s), sc = __expf(mx - mn), pe = __expf(s - mn); mx = mn; l = l * sc + pe;
#pragma unroll
                for (int i = 0; i < 8; ++i) { const v4u w = vq[i]; AXPY8(acc, 8 * i, sc, pe, w); }
            } }
        const float inv = 1.0f / l; GAS v4u* op = (GAS v4u*)(YC + (size_t)m * DM + 2 * GW + 64 * h);
#pragma unroll
        for (int i = 0; i < 8; ++i) op[i] = (v4u){pk2(acc[8 * i] * inv, acc[8 * i + 1] * inv), pk2(acc[8 * i + 2] * inv, acc[8 * i + 3] * inv), pk2(acc[8 * i + 4] * inv, acc[8 * i + 5] * inv), pk2(acc[8 * i + 6] * inv, acc[8 * i + 7] * inv)};
    }
}
__device__ __forceinline__ void mix_b_simple(Frame& F, int l) {
    const bf16* PROJ = (const bf16*)(wsp() + WS_PROJ); bf16* YC = (bf16*)(wsp() + WS_YCAT); const pg8::fx_t* ST = (const pg8::fx_t*)(wsp() + CTL_STATS) + (size_t)l * M * 2;
    const float* lng = inp(4) + l * GW; const float* sw = inp(5) + (size_t)l * NH * 128 * 128; const float* sb = inp(6) + l * NH * 128;
    const int nthr = F.G * NTHR;
    for (int idx = blockIdx.x * NTHR + F.tid; idx < M * GW; idx += nthr) {
        const int m = idx >> 9, c = idx & 511, g = c >> 6, tt = m & 127, m0 = m - tt;
        const float* wrow = sw + ((size_t)g * 128 + tt) * 128; const float gn = lng[c]; float s = 0.f;
        for (int s2 = 0; s2 <= tt; ++s2) { const int ms = m0 + s2; const float mu_ = pg8::fx_get(ST + 2 * ms) * (1.0f / 512.0f), rs_ = 1.0f / sqrtf(fmaxf(pg8::fx_get(ST + 2 * ms + 1) * (1.0f / 512.0f) - mu_ * mu_, 0.f) + 1e-5f); const float vv = (gelu_tanh(bf2f(PROJ[(size_t)ms * NPROJ_P + CB_V + c])) - mu_) * rs_ * gn; s += wrow[s2] * vv; }
        const float u = gelu_tanh(bf2f(PROJ[(size_t)m * NPROJ_P + CB_U + c]));
        YC[(size_t)m * DM + GW + c] = (bf16)f2bf(u * (s + sb[g * 128 + tt]));
    }
}
__device__ __forceinline__ float rdl(float v, int k) { return __builtin_bit_cast(float, __builtin_amdgcn_readlane(__builtin_bit_cast(int, v), k)); }
__device__ __forceinline__ void mix_d_simple(Frame& F) {
    const bf16* R_ = (const bf16*)outp();
    const bf16* E_ = R_ + (size_t)M * GW; const bf16* KP_ = E_ + (size_t)M * GW; const bf16* V_ = KP_ + (size_t)M * GW;
    const bf16* KK_ = (const bf16*)outp() + (size_t)4 * M * GW; const bf16* AS_ = KK_ + (size_t)M * GW; float* YD = (float*)(wsp() + WS_YD);
    for (int it = F.gw; it < BATCH * NH; it += F.ngw) {
        const int b = it >> 3, h = it & 7; float s[64];
#pragma unroll
        for (int k = 0; k < 64; ++k) s[k] = 0.f;
        for (int t = 0; t < SEQ; ++t) {
            const size_t o = ((size_t)b * SEQ + t) * GW + 64 * h + F.lane;
            const float r = bf2f(R_[o]), w = __expf(-bf2f(E_[o])), kp = bf2f(KP_[o]), v = bf2f(V_[o]), kk = bf2f(KK_[o]), as = bf2f(AS_[o]);
            const float a = -kk, bb = kk * as;
            float sa = 0.f;
#pragma unroll
            for (int k = 0; k < 64; ++k) sa += s[k] * rdl(a, k);
            float y = 0.f;
#pragma unroll
            for (int k = 0; k < 64; ++k) { s[k] = s[k] * rdl(w, k) + sa * rdl(bb, k) + v * rdl(kp, k); y += s[k] * rdl(r, k); }
            YD[o] = y;
        }
    }
}

constexpr float LOG2E = 1.4426950408889634f;

constexpr int SC_T = 32, SC_TOK = (5 * 64 + 32) * 4, SC_BUF = SC_T * SC_TOK, SC_YB = SC_T * 32 * 4, SC_LDS = 2 * SC_BUF + 2 * SC_YB;
template <int CTRL> __device__ __forceinline__ float dpp_add(float x) {
    const int y = __builtin_amdgcn_update_dpp(0, __builtin_bit_cast(int, x), CTRL, 0xF, 0xF, false);
    return x + __builtin_bit_cast(float, y);
}
__device__ __forceinline__ float red8(float x) { x = dpp_add<0xB1>(x); x = dpp_add<0x4E>(x); x = dpp_add<0x141>(x); return x; }
__device__ __forceinline__ void scan_unit(LAS unsigned char* lds, int unit, int tid) {
    const int half = unit & 1, h = (unit >> 1) & 7, b = unit >> 4;
    const bf16* R_ = (const bf16*)outp();
    const bf16* E_ = R_ + (size_t)M * GW; const bf16* KP_ = E_ + (size_t)M * GW; const bf16* V_ = KP_ + (size_t)M * GW;
    const bf16* KK_ = (const bf16*)outp() + (size_t)4 * M * GW; const bf16* AS_ = KK_ + (size_t)M * GW; float* YD = (float*)(wsp() + WS_YD);
    const int lane = tid & 63, wave = __builtin_amdgcn_readfirstlane(tid >> 6);
    const bool scanner = wave < 4;
    const int j = lane & 7, rowl = (wave & 3) * 8 + (lane >> 3);
    const int st = tid & 255, tt = st >> 3, cg = st & 7;
    const size_t gbase = ((size_t)b * SEQ) * GW + 64 * h + 8 * cg;
#define SC_STAGE(c, buf) do { const size_t o_ = gbase + (size_t)((c) * SC_T + tt) * GW; \
        const v4u g_r = *(const GAS v4u*)(R_ + o_), g_e = *(const GAS v4u*)(E_ + o_), g_k = *(const GAS v4u*)(KP_ + o_), g_v = *(const GAS v4u*)(V_ + o_), g_kk = *(const GAS v4u*)(KK_ + o_), g_as = *(const GAS v4u*)(AS_ + o_); \
        LAS float* p_ = (LAS float*)(lds + (buf) * SC_BUF + tt * SC_TOK) + 8 * cg; float kk_[8], x_[8], y_[8]; \
        UNPACK8(kk_, 0, g_kk); \
        *(LAS f32x4*)(p_) = (f32x4){-kk_[0], -kk_[1], -kk_[2], -kk_[3]}; *(LAS f32x4*)(p_ + 4) = (f32x4){-kk_[4], -kk_[5], -kk_[6], -kk_[7]}; \
        UNPACK8(x_, 0, g_e); *(LAS f32x4*)(p_ + 64) = (f32x4){__expf(-x_[0]), __expf(-x_[1]), __expf(-x_[2]), __expf(-x_[3])}; *(LAS f32x4*)(p_ + 68) = (f32x4){__expf(-x_[4]), __expf(-x_[5]), __expf(-x_[6]), __expf(-x_[7])}; \
        UNPACK8(y_, 0, g_as); *(LAS f32x4*)(p_ + 128) = (f32x4){kk_[0] * y_[0], kk_[1] * y_[1], kk_[2] * y_[2], kk_[3] * y_[3]}; *(LAS f32x4*)(p_ + 132) = (f32x4){kk_[4] * y_[4], kk_[5] * y_[5], kk_[6] * y_[6], kk_[7] * y_[7]}; \
        UNPACK8(x_, 0, g_k); *(LAS f32x4*)(p_ + 192) = (f32x4){x_[0], x_[1], x_[2], x_[3]}; *(LAS f32x4*)(p_ + 196) = (f32x4){x_[4], x_[5], x_[6], x_[7]}; \
        UNPACK8(x_, 0, g_r); *(LAS f32x4*)(p_ + 256) = (f32x4){x_[0], x_[1], x_[2], x_[3]}; *(LAS f32x4*)(p_ + 260) = (f32x4){x_[4], x_[5], x_[6], x_[7]}; \
        if ((cg >> 2) == half) { UNPACK8(x_, 0, g_v); LAS float* v_ = (LAS float*)(lds + (buf) * SC_BUF + tt * SC_TOK) + 320 + 8 * (cg & 3); \
            *(LAS f32x4*)(v_) = (f32x4){x_[0], x_[1], x_[2], x_[3]}; *(LAS f32x4*)(v_ + 4) = (f32x4){x_[4], x_[5], x_[6], x_[7]}; } } while (0)
    if (!scanner) SC_STAGE(0, 0);
    __syncthreads();
    f32x4 s0 = {0.f, 0.f, 0.f, 0.f}, s1 = {0.f, 0.f, 0.f, 0.f};
    float ykeep = 0.f;
    for (int c = 0; c < SEQ / SC_T; ++c) {
        const int cur = c & 1;
        LAS float* yb = (LAS float*)(lds + 2 * SC_BUF + cur * SC_YB);
        if (scanner) {
            const LAS float* base = (const LAS float*)(lds + cur * SC_BUF) + 8 * j;
            const LAS float* vbase = (const LAS float*)(lds + cur * SC_BUF) + 320 + rowl;
            f32x4 a0 = *(const LAS f32x4*)(base), a1 = *(const LAS f32x4*)(base + 4), w0 = *(const LAS f32x4*)(base + 64), w1 = *(const LAS f32x4*)(base + 68), b0 = *(const LAS f32x4*)(base + 128), b1 = *(const LAS f32x4*)(base + 132),
                  k0 = *(const LAS f32x4*)(base + 192), k1 = *(const LAS f32x4*)(base + 196), r0 = *(const LAS f32x4*)(base + 256), r1 = *(const LAS f32x4*)(base + 260);
            float vv = *vbase;
#pragma unroll
            for (int t = 0; t < SC_T; ++t) {
                f32x4 na0 = a0, na1 = a1, nw0 = w0, nw1 = w1, nb0 = b0, nb1 = b1, nk0 = k0, nk1 = k1, nr0 = r0, nr1 = r1; float nv = vv;
                if (t + 1 < SC_T) { const LAS float* p = base + (t + 1) * (SC_TOK / 4);
                    na0 = *(const LAS f32x4*)(p); na1 = *(const LAS f32x4*)(p + 4); nw0 = *(const LAS f32x4*)(p + 64); nw1 = *(const LAS f32x4*)(p + 68); nb0 = *(const LAS f32x4*)(p + 128); nb1 = *(const LAS f32x4*)(p + 132);
                    nk0 = *(const LAS f32x4*)(p + 192); nk1 = *(const LAS f32x4*)(p + 196); nr0 = *(const LAS f32x4*)(p + 256); nr1 = *(const LAS f32x4*)(p + 260);
                    nv = vbase[(t + 1) * (SC_TOK / 4)]; }
                const f32x4 pa = s0 * a0 + s1 * a1;
                float sa = (pa.x + pa.y) + (pa.z + pa.w);
                const f32x4 sw0 = s0 * w0 + vv * k0, sw1 = s1 * w1 + vv * k1;
                sa = red8(sa);
                s0 = sa * b0 + sw0; s1 = sa * b1 + sw1;
                const f32x4 py = s0 * r0 + s1 * r1;
                float y = (py.x + py.y) + (py.z + py.w);
                y = red8(y);
                ykeep = (j == (t & 7)) ? y : ykeep;
                if ((t & 7) == 7) yb[((t & ~7) + j) * 32 + rowl] = ykeep;
                a0 = na0; a1 = na1; w0 = nw0; w1 = nw1; b0 = nb0; b1 = nb1; k0 = nk0; k1 = nk1; r0 = nr0; r1 = nr1; vv = nv;
            }
        } else {
            if (c > 0) {
                const LAS float* ybp = (const LAS float*)(lds + 2 * SC_BUF + (cur ^ 1) * SC_YB); const int t2 = st >> 3, q4 = st & 7; const f32x4 v = *(const LAS f32x4*)(ybp + t2 * 32 + 4 * q4);
                *(GAS f32x4*)(YD + ((size_t)b * SEQ + (c - 1) * SC_T + t2) * GW + 64 * h + 32 * half + 4 * q4) = v; }
            if (c + 1 < SEQ / SC_T) SC_STAGE(c + 1, cur ^ 1);
        }
        __syncthreads();
    }
    if (!scanner) { const LAS float* ybp = (const LAS float*)(lds + 2 * SC_BUF + 1 * SC_YB); const int t2 = st >> 3, q4 = st & 7; const f32x4 v = *(const LAS f32x4*)(ybp + t2 * 32 + 4 * q4);
        *(GAS f32x4*)(YD + ((size_t)b * SEQ + (SEQ / SC_T - 1) * SC_T + t2) * GW + 64 * h + 32 * half + 4 * q4) = v; }
#undef SC_STAGE
    __syncthreads();
}

struct AttnSt { f32x16 o0, o1; float m, l; };
__device__ __forceinline__ void attn_init(AttnSt& st) {
    const float z_ = zero_v();
#pragma unroll
    for (int i = 0; i < 16; ++i) { st.o0[i] = z_; st.o1[i] = z_; }
    st.m = -1e30f; st.l = 0.f;
}
__device__ __forceinline__ void attn_tile(AttnSt& st, const bf16x8 (&qf)[4], const bf16* Kcol, const bf16* Vcol, int rowb, int kb, int ks, int qpos, int maxd, bool sel, const LAS float* biasT, int r32, int hh) {
    int kp_l = kb + r32 * ks; kp_l = kp_l < 0 ? 0 : kp_l;
    const bf16* kr_ = Kcol + (size_t)(rowb + kp_l) * NPROJ_P + 8 * hh;
    bf16x8 kf[4];
#pragma unroll
    for (int s = 0; s < 4; ++s) kf[s] = *(const GAS bf16x8*)(kr_ + 16 * s);
    f32x16 sc;
#pragma unroll
    for (int i = 0; i < 16; ++i) sc[i] = 0.f;
#pragma unroll
    for (int s = 0; s < 4; ++s) sc = __builtin_amdgcn_mfma_f32_32x32x16_bf16(kf[s], qf[s], sc, 0, 0, 0);
    unsigned vf[2][2][4];
#pragma unroll
    for (int s2 = 0; s2 < 2; ++s2)
#pragma unroll
        for (int jp = 0; jp < 4; ++jp) {
            const int j0 = 2 * jp, key0 = 16 * s2 + 8 * (j0 >> 2) + 4 * hh + (j0 & 3);
            int kp0 = kb + key0 * ks, kp1 = kp0 + ks; kp0 = kp0 < 0 ? 0 : kp0; kp1 = kp1 < 0 ? 0 : kp1;
            const bf16* v0 = Vcol + (size_t)(rowb + kp0) * NPROJ_P + r32; const bf16* v1 = Vcol + (size_t)(rowb + kp1) * NPROJ_P + r32;
            vf[0][s2][jp] = (unsigned)v0[0] | ((unsigned)v1[0] << 16); vf[1][s2][jp] = (unsigned)v0[32] | ((unsigned)v1[32] << 16);
        }
    float tmax = -INFINITY;
#pragma unroll
    for (int r = 0; r < 16; ++r) {
        const int kr = (r & 3) + 8 * (r >> 2) + 4 * hh, kp = kb + kr * ks, dist = qpos - kp;
        const bool ok = sel && dist >= 0 && dist <= maxd && kp >= 0;
        const float v = sc[r] * (0.125f * LOG2E) + biasT[ok ? dist : 0];
        sc[r] = ok ? v : -INFINITY; tmax = fmaxf(tmax, sc[r]);
    }
    tmax = fmaxf(tmax, __shfl_xor(tmax, 32));
    const float mn = fmaxf(st.m, tmax), scale = __builtin_amdgcn_exp2f(st.m - mn); st.m = mn;
    float ls = 0.f;
#pragma unroll
    for (int r = 0; r < 16; ++r) { sc[r] = __builtin_amdgcn_exp2f(sc[r] - mn); ls += sc[r]; }
    st.l = st.l * scale + ls;
#pragma unroll
    for (int i = 0; i < 16; ++i) { st.o0[i] *= scale; st.o1[i] *= scale; }
    typedef unsigned u32x4_t __attribute__((ext_vector_type(4)));
#pragma unroll
    for (int s2 = 0; s2 < 2; ++s2) {
        u32x4_t pw; pw.x = pg8::cvt_pk_bf16(sc[8 * s2], sc[8 * s2 + 1]); pw.y = pg8::cvt_pk_bf16(sc[8 * s2 + 2], sc[8 * s2 + 3]); pw.z = pg8::cvt_pk_bf16(sc[8 * s2 + 4], sc[8 * s2 + 5]); pw.w = pg8::cvt_pk_bf16(sc[8 * s2 + 6], sc[8 * s2 + 7]);
        const bf16x8 pf = __builtin_bit_cast(bf16x8, pw);
        u32x4_t a0 = {vf[0][s2][0], vf[0][s2][1], vf[0][s2][2], vf[0][s2][3]}, a1 = {vf[1][s2][0], vf[1][s2][1], vf[1][s2][2], vf[1][s2][3]};
        st.o0 = __builtin_amdgcn_mfma_f32_32x32x16_bf16(__builtin_bit_cast(bf16x8, a0), pf, st.o0, 0, 0, 0);
        st.o1 = __builtin_amdgcn_mfma_f32_32x32x16_bf16(__builtin_bit_cast(bf16x8, a1), pf, st.o1, 0, 0, 0);
    }
}
__device__ __forceinline__ void attn_loadq(bf16x8 (&qf)[4], const bf16* Qcol, int row, int hh) {
    const bf16* q = Qcol + (size_t)row * NPROJ_P + 8 * hh;
#pragma unroll
    for (int s = 0; s < 4; ++s) qf[s] = *(const GAS bf16x8*)(q + 16 * s);
}
__device__ __forceinline__ void attn_store(const f32x16& o0, const f32x16& o1, float inv, bf16* yrow, int hh) {
#pragma unroll
    for (int g = 0; g < 4; ++g) {
        *(GAS v2u*)(yrow + 8 * g + 4 * hh) = (v2u){pk2(o0[4 * g] * inv, o0[4 * g + 1] * inv), pk2(o0[4 * g + 2] * inv, o0[4 * g + 3] * inv)};
        *(GAS v2u*)(yrow + 32 + 8 * g + 4 * hh) = (v2u){pk2(o1[4 * g] * inv, o1[4 * g + 1] * inv), pk2(o1[4 * g + 2] * inv, o1[4 * g + 3] * inv)};
    }
}
__device__ __forceinline__ void build_bias(LAS float* biasT, int hcol, int tid) {
    const int* TB = (const int*)(wsp() + WS_SMALL + SM_TB); const float* pb = inp(3); LAS int* bktT = (LAS int*)(biasT + 2048);
    for (int d = tid; d < 2048; d += NTHR) { const int bk = TB[d]; bktT[d] = bk; biasT[d] = pb[bk * 16 + hcol] * LOG2E; }
}

constexpr int MC_KP = 144, MC_VP = 192, MC_KB = 128 * MC_KP, MC_VB = 128 * MC_VP, MC_K_OFF = 16384, MC_V_OFF = MC_K_OFF + 2 * MC_KB, MC_LDS = MC_V_OFF + 2 * MC_VB;
typedef short v4i16_t __attribute__((ext_vector_type(4)));
__device__ __forceinline__ float pl32_max(float a) { float x = a, y = a;
    asm volatile("s_nop 1\n\tv_permlane32_swap_b32_e32 %0, %1\n\ts_nop 0" : "+v"(x), "+v"(y));
    return fmaxf(x, y); }
template <int MODE> __device__ __forceinline__ void moba_tile(AttnSt& st, const bf16x8 (&qf)[4], const LAS unsigned char* Kt, const LAS unsigned char* Vt, const LAS float* biasT, const LAS int* TB, int dlo, bool sel, int lane, int r32, int hh) {
    bf16x8 kf[4];
#pragma unroll
    for (int s = 0; s < 4; ++s) kf[s] = *(const LAS bf16x8*)(Kt + r32 * MC_KP + 32 * s + 16 * hh);
    v4i16_t vt[2][2][2];
    { const LAS unsigned char* vb = Vt + (4 * hh + ((lane & 15) >> 2)) * MC_VP + (16 * ((lane >> 4) & 1) + 4 * (lane & 3)) * 2;
#pragma unroll
      for (int dh = 0; dh < 2; ++dh)
#pragma unroll
        for (int s2 = 0; s2 < 2; ++s2)
#pragma unroll
            for (int h8 = 0; h8 < 2; ++h8) vt[dh][s2][h8] = __builtin_amdgcn_ds_read_tr16_b64_v4i16((LAS v4i16_t*)(vb + (16 * s2 + 8 * h8) * MC_VP + 64 * dh)); }
    f32x16 sc;
#pragma unroll
    for (int i = 0; i < 16; ++i) sc[i] = 0.f;
#pragma unroll
    for (int s = 0; s < 4; ++s) sc = __builtin_amdgcn_mfma_f32_32x32x16_bf16(kf[s], qf[s], sc, 0, 0, 0);
    const int d0 = dlo + r32 + 31 - 4 * hh;
    const int dmin = dlo < 0 ? 0 : dlo, dmax = dlo + 62;
    const bool uni = __builtin_amdgcn_readfirstlane(TB[dmin]) == __builtin_amdgcn_readfirstlane(TB[dmax]);
    float tmax = -INFINITY;
    if (uni) { const float bu = biasT[dmin];
#pragma unroll
        for (int r = 0; r < 16; ++r) { float v = sc[r] * (0.125f * LOG2E) + bu; if (MODE == 1) { const int dist = d0 - (r & 3) - 8 * (r >> 2); v = dist >= 0 ? v : -INFINITY; } sc[r] = v; tmax = fmaxf(tmax, v); }
    } else {
#pragma unroll
        for (int r = 0; r < 16; ++r) { const int dist = d0 - (r & 3) - 8 * (r >> 2); float v = sc[r] * (0.125f * LOG2E) + biasT[dist < 0 ? 0 : dist]; if (MODE == 1) v = dist >= 0 ? v : -INFINITY; sc[r] = v; tmax = fmaxf(tmax, v); }
    }
    if (MODE == 2) tmax = sel ? tmax : -INFINITY;
    tmax = pl32_max(tmax);
    const float mn = fmaxf(st.m, tmax);
    if (__ballot(mn > st.m) != 0ull) { const float scale = __builtin_amdgcn_exp2f(st.m - mn); st.l *= scale;
#pragma unroll
        for (int i = 0; i < 16; ++i) { st.o0[i] *= scale; st.o1[i] *= scale; } }
    st.m = mn;
    const float msub = (MODE == 2 && !sel) ? INFINITY : mn;
    float ls = 0.f;
#pragma unroll
    for (int r = 0; r < 16; ++r) { sc[r] = __builtin_amdgcn_exp2f(sc[r] - msub); ls += sc[r]; }
    st.l += ls;
    typedef unsigned u32x4_t __attribute__((ext_vector_type(4)));
#pragma unroll
    for (int s2 = 0; s2 < 2; ++s2) {
        u32x4_t pw; pw.x = pg8::cvt_pk_bf16(sc[8 * s2], sc[8 * s2 + 1]); pw.y = pg8::cvt_pk_bf16(sc[8 * s2 + 2], sc[8 * s2 + 3]); pw.z = pg8::cvt_pk_bf16(sc[8 * s2 + 4], sc[8 * s2 + 5]); pw.w = pg8::cvt_pk_bf16(sc[8 * s2 + 6], sc[8 * s2 + 7]);
        const bf16x8 pf = __builtin_bit_cast(bf16x8, pw);
        const bf16x8 a0 = {vt[0][s2][0][0], vt[0][s2][0][1], vt[0][s2][0][2], vt[0][s2][0][3], vt[0][s2][1][0], vt[0][s2][1][1], vt[0][s2][1][2], vt[0][s2][1][3]};
        const bf16x8 a1 = {vt[1][s2][0][0], vt[1][s2][0][1], vt[1][s2][0][2], vt[1][s2][0][3], vt[1][s2][1][0], vt[1][s2][1][1], vt[1][s2][1][2], vt[1][s2][1][3]};
        st.o0 = __builtin_amdgcn_mfma_f32_32x32x16_bf16(a0, pf, st.o0, 0, 0, 0);
        st.o1 = __builtin_amdgcn_mfma_f32_32x32x16_bf16(a1, pf, st.o1, 0, 0, 0);
    }
}
__device__ __forceinline__ void moba_unit(LAS unsigned char* lds, int unit, int tid, int l) {
    const int ob = unit & 7, h = (unit >> 3) & 7, b = unit >> 6, lane = tid & 63, wave = __builtin_amdgcn_readfirstlane(tid >> 6), r32 = lane & 31, hh = lane >> 5;
    LAS float* biasT = (LAS float*)lds;
    build_bias(biasT, 8 + h, tid);
    const bf16* PROJ = (const bf16*)(wsp() + WS_PROJ); const float* KBAR = (const float*)(wsp() + CTL_KBAR) + (size_t)l * 64 * 8 * 64 + ((b * NH + h) * 8) * 64; const LAS int* TB = (const LAS int*)(biasT + 2048);
    const int rowb = b * SEQ, qpos = 256 * ob + 32 * wave + r32;
    bf16x8 qf[4]; attn_loadq(qf, PROJ + CC_Q + 64 * h, rowb + qpos, hh);
    float gate[8];
#pragma unroll
    for (int n = 0; n < 8; ++n) { float s = 0.f;
        if (n < ob) {
#pragma unroll
            for (int s4 = 0; s4 < 4; ++s4) { const f32x4 k0 = *(const GAS f32x4*)(KBAR + n * 64 + 16 * s4 + 8 * hh), k1 = *(const GAS f32x4*)(KBAR + n * 64 + 16 * s4 + 8 * hh + 4);
                const v4u qw = __builtin_bit_cast(v4u, qf[s4]);
                s += bflo(qw.x) * k0.x + bfhi(qw.x) * k0.y + bflo(qw.y) * k0.z + bfhi(qw.y) * k0.w + bflo(qw.z) * k1.x + bfhi(qw.z) * k1.y + bflo(qw.w) * k1.z + bfhi(qw.w) * k1.w; }
            s += __shfl_xor(s, 32); }
        gate[n] = s; }
    unsigned selm = 0u;
#pragma unroll
    for (int n = 0; n < 8; ++n) { int rank = 0;
#pragma unroll
        for (int n2 = 0; n2 < 8; ++n2) rank += (n2 < ob && n2 != n && (gate[n2] > gate[n] || (gate[n2] == gate[n] && n2 < n))) ? 1 : 0;
        if (n < ob && rank < 3) selm |= 1u << n; }
    AttnSt st; attn_init(st);
    const int skey = tid >> 2, spart = tid & 3;
    const bf16* Kg = PROJ + (size_t)rowb * NPROJ_P + CC_K + 64 * h + 16 * spart; const bf16* Vg = PROJ + (size_t)rowb * NPROJ_P + CC_V + 64 * h + 16 * spart;
    bf16x8 gk0, gk1, gv0, gv1;
#define MC_GLOAD(i) do { const size_t ro_ = (size_t)(128 * (i) + skey) * NPROJ_P; gk0 = *(const GAS bf16x8*)(Kg + ro_); gk1 = *(const GAS bf16x8*)(Kg + ro_ + 8); gv0 = *(const GAS bf16x8*)(Vg + ro_); gv1 = *(const GAS bf16x8*)(Vg + ro_ + 8); } while (0)
#define MC_LSTORE(bf) do { LAS unsigned char* kd_ = lds + MC_K_OFF + (bf) * MC_KB + skey * MC_KP + 32 * spart; *(LAS bf16x8*)(kd_) = gk0; *(LAS bf16x8*)(kd_ + 16) = gk1; \
        LAS unsigned char* vd_ = lds + MC_V_OFF + (bf) * MC_VB + skey * MC_VP + 32 * spart; *(LAS bf16x8*)(vd_) = gv0; *(LAS bf16x8*)(vd_ + 16) = gv1; } while (0)
    const int nst = 2 * (ob + 1);
    MC_GLOAD(0); MC_LSTORE(0);
    __syncthreads();
    for (int i = 0; i < nst; ++i) {
        if (i + 1 < nst) MC_GLOAD(i + 1);
        const int n = i >> 1, hf = i & 1; const bool own = n == ob, sel = own || ((selm >> n) & 1u);
        const LAS unsigned char* Kb = lds + MC_K_OFF + (i & 1) * MC_KB; const LAS unsigned char* Vb = lds + MC_V_OFF + (i & 1) * MC_VB;
        if (own) {
#pragma unroll 1
            for (int sub = 0; sub < 4; ++sub) { const int jt = 4 * hf + sub; if (jt > wave) break; const int dlo = 32 * wave - (32 * jt + 31);
                if (jt == wave) moba_tile<1>(st, qf, Kb + sub * 32 * MC_KP, Vb + sub * 32 * MC_VP, biasT, TB, dlo, true, lane, r32, hh);
                else moba_tile<0>(st, qf, Kb + sub * 32 * MC_KP, Vb + sub * 32 * MC_VP, biasT, TB, dlo, true, lane, r32, hh); }
        } else if (__ballot(sel) != 0ull) {
#pragma unroll 1
            for (int sub = 0; sub < 4; ++sub) { const int dlo = 256 * ob + 32 * wave - (256 * n + 128 * hf + 32 * sub + 31);
                moba_tile<2>(st, qf, Kb + sub * 32 * MC_KP, Vb + sub * 32 * MC_VP, biasT, TB, dlo, sel, lane, r32, hh); }
        }
        if (i + 1 < nst) MC_LSTORE((i + 1) & 1);
        __syncthreads();
    }
#undef MC_GLOAD
#undef MC_LSTORE
    const float lt = st.l + __shfl_xor(st.l, 32);
    attn_store(st.o0, st.o1, 1.0f / lt, (bf16*)(wsp() + WS_YCAT) + (size_t)(rowb + qpos) * DM + 2 * GW + 64 * h, hh);
}

constexpr int MA_PITCH = 144, MA_ML_OFF = 512 * MA_PITCH, MA_BIAS_OFF = MA_ML_OFF + 512 * 8, MA_V_OFF = MA_BIAS_OFF + 16384, MA_VW = 32 * MC_VP, MA_LDS = MA_V_OFF + 8 * MA_VW;
template <bool MASKED> __device__ __forceinline__ void dil_tile(AttnSt& st, const bf16x8 (&qf)[4], const bf16x8 (&kf)[4], const LAS unsigned char* Vt, const LAS float* biasT, const LAS int* TB, int dl0, int dstep, int kb, int lane, int r32, int hh) {
    v4i16_t vt[2][2][2];
    { const LAS unsigned char* vb = Vt + (4 * hh + ((lane & 15) >> 2)) * MC_VP + (16 * ((lane >> 4) & 1) + 4 * (lane & 3)) * 2;
#pragma unroll
      for (int dh = 0; dh < 2; ++dh)
#pragma unroll
        for (int s2 = 0; s2 < 2; ++s2)
#pragma unroll
            for (int h8 = 0; h8 < 2; ++h8) vt[dh][s2][h8] = __builtin_amdgcn_ds_read_tr16_b64_v4i16((LAS v4i16_t*)(vb + (16 * s2 + 8 * h8) * MC_VP + 64 * dh)); }
    f32x16 sc;
#pragma unroll
    for (int i = 0; i < 16; ++i) sc[i] = 0.f;
#pragma unroll
    for (int s = 0; s < 4; ++s) sc = __builtin_amdgcn_mfma_f32_32x32x16_bf16(kf[s], qf[s], sc, 0, 0, 0);
    const int e0 = dl0 + r32 - 4 * hh;
    int dmin = (dl0 - 31) * dstep, dmax = (dl0 + 31) * dstep; dmin = dmin < 0 ? 0 : dmin; dmax = dmax > 2047 ? 2047 : dmax;
    const bool uni = __builtin_amdgcn_readfirstlane(TB[dmin]) == __builtin_amdgcn_readfirstlane(TB[dmax]);
    const float bu = biasT[dmin];
    float tmax = -INFINITY;
#pragma unroll
    for (int r = 0; r < 16; ++r) {
        const int kr0 = (r & 3) + 8 * (r >> 2), delta = e0 - kr0;
        float bias = bu;
        if (!uni) { int di = delta * dstep; di = di < 0 ? 0 : (di > 2047 ? 2047 : di); bias = biasT[di]; }
        float v = sc[r] * (0.125f * LOG2E) + bias;
        if (MASKED) { const bool ok = delta >= 0 && delta <= 128 && (kb + (kr0 + 4 * hh) * dstep) >= 0; v = ok ? v : -INFINITY; }
        sc[r] = v; tmax = fmaxf(tmax, v);
    }
    tmax = pl32_max(tmax);
    const float mn = fmaxf(st.m, tmax);
    if (__ballot(mn > st.m) != 0ull) { const float scale = __builtin_amdgcn_exp2f(st.m - mn); st.l *= scale;
#pragma unroll
        for (int i = 0; i < 16; ++i) { st.o0[i] *= scale; st.o1[i] *= scale; } }
    st.m = mn;
    float ls = 0.f;
#pragma unroll
    for (int r = 0; r < 16; ++r) { sc[r] = __builtin_amdgcn_exp2f(sc[r] - mn); ls += sc[r]; }
    st.l += ls;
    typedef unsigned u32x4_t __attribute__((ext_vector_type(4)));
#pragma unroll
    for (int s2 = 0; s2 < 2; ++s2) {
        u32x4_t pw; pw.x = pg8::cvt_pk_bf16(sc[8 * s2], sc[8 * s2 + 1]); pw.y = pg8::cvt_pk_bf16(sc[8 * s2 + 2], sc[8 * s2 + 3]); pw.z = pg8::cvt_pk_bf16(sc[8 * s2 + 4], sc[8 * s2 + 5]); pw.w = pg8::cvt_pk_bf16(sc[8 * s2 + 6], sc[8 * s2 + 7]);
        const bf16x8 pf = __builtin_bit_cast(bf16x8, pw);
        const bf16x8 a0 = {vt[0][s2][0][0], vt[0][s2][0][1], vt[0][s2][0][2], vt[0][s2][0][3], vt[0][s2][1][0], vt[0][s2][1][1], vt[0][s2][1][2], vt[0][s2][1][3]};
        const bf16x8 a1 = {vt[1][s2][0][0], vt[1][s2][0][1], vt[1][s2][0][2], vt[1][s2][0][3], vt[1][s2][1][0], vt[1][s2][1][1], vt[1][s2][1][2], vt[1][s2][1][3]};
        st.o0 = __builtin_amdgcn_mfma_f32_32x32x16_bf16(a0, pf, st.o0, 0, 0, 0);
        st.o1 = __builtin_amdgcn_mfma_f32_32x32x16_bf16(a1, pf, st.o1, 0, 0, 0);
    }
}
__device__ __forceinline__ void dil_unit(LAS unsigned char* lds, int unit, int tid) {
    const int sp = unit & 3, h = (unit >> 2) & 7, b = unit >> 5, lane = tid & 63, wave = __builtin_amdgcn_readfirstlane(tid >> 6), r32 = lane & 31, hh = lane >> 5;
    LAS float* biasT = (LAS float*)(lds + MA_BIAS_OFF);
    build_bias(biasT, h, tid);
    __syncthreads();
    const bf16* PROJ = (const bf16*)(wsp() + WS_PROJ); const LAS int* TB = (const LAS int*)(biasT + 2048); const int rowb = b * SEQ, t0 = 512 * sp;
    const bf16* Qc = PROJ + CA_Q + 64 * h; const bf16* Kc = PROJ + CA_K + 64 * h; const bf16* Vc = PROJ + CA_V + 64 * h;
    LAS unsigned char* Vst = lds + MA_V_OFF + wave * MA_VW;
    const int vkey = lane >> 1, vhalf = lane & 1;
#pragma unroll 1
    for (int p = 0; p < 3; ++p) {
        const int d = p == 0 ? 1 : (p == 1 ? 4 : 16);
#pragma unroll 1
        for (int gi = 0; gi < 2; ++gi) {
            const int g = 2 * wave + gi;
            const int qb = t0 + (p == 0 ? 32 * g : (p == 1 ? 128 * (g >> 2) + (g & 3) : g));
            const int qpos = qb + r32 * d, qi = qpos - t0;
            bf16x8 qf[4]; attn_loadq(qf, Qc, rowb + qpos, hh);
            AttnSt st; attn_init(st);
            int jt = 0; while (qb + (32 * jt - 128 + 31) * d < 0) ++jt;
            bf16x8 kfn[4], vrn[4];
#define MA_GLOAD(JT) do { const int kb_ = qb + (32 * (JT) - 128) * d; int kp_ = kb_ + r32 * d; kp_ = kp_ < 0 ? 0 : kp_; const bf16* kr_ = Kc + (size_t)(rowb + kp_) * NPROJ_P + 8 * hh; \
                _Pragma("unroll") for (int s = 0; s < 4; ++s) kfn[s] = *(const GAS bf16x8*)(kr_ + 16 * s); \
                int vp_ = kb_ + vkey * d; vp_ = vp_ < 0 ? 0 : vp_; const bf16* vr_ = Vc + (size_t)(rowb + vp_) * NPROJ_P + 32 * vhalf; \
                _Pragma("unroll") for (int s = 0; s < 4; ++s) vrn[s] = *(const GAS bf16x8*)(vr_ + 8 * s); } while (0)
            MA_GLOAD(jt);
#pragma unroll 1
            for (; jt < 5; ++jt) {
                bf16x8 kf[4] = {kfn[0], kfn[1], kfn[2], kfn[3]};
                { LAS unsigned char* vd = Vst + vkey * MC_VP + 64 * vhalf;
#pragma unroll
                  for (int s = 0; s < 4; ++s) *(LAS bf16x8*)(vd + 16 * s) = vrn[s]; }
                asm volatile("" ::: "memory");
                if (jt + 1 < 5) MA_GLOAD(jt + 1);
                const int kb = qb + (32 * jt - 128) * d, dl0 = 128 - 32 * jt;
                if (jt == 0 || jt == 4 || kb < 0) dil_tile<true>(st, qf, kf, Vst, biasT, TB, dl0, d, kb, lane, r32, hh);
                else dil_tile<false>(st, qf, kf, Vst, biasT, TB, dl0, d, kb, lane, r32, hh);
            }
#undef MA_GLOAD
            float lt = st.l + __shfl_xor(st.l, 32);
            LAS unsigned char* orow = lds + qi * MA_PITCH; LAS float* ml = (LAS float*)(lds + MA_ML_OFF + qi * 8);
            if (p > 0) {
                const float mo = ml[0], lo = ml[1], mn = fmaxf(mo, st.m), fo = __builtin_amdgcn_exp2f(mo - mn), fc = __builtin_amdgcn_exp2f(st.m - mn);
                lt = lo * fo + lt * fc;
#pragma unroll
                for (int g4 = 0; g4 < 4; ++g4) { const v2u a = *(const LAS v2u*)(orow + 2 * (8 * g4 + 4 * hh)), c = *(const LAS v2u*)(orow + 64 + 2 * (8 * g4 + 4 * hh));
                    const float av[4] = {bflo(a.x), bfhi(a.x), bflo(a.y), bfhi(a.y)}, cv[4] = {bflo(c.x), bfhi(c.x), bflo(c.y), bfhi(c.y)};
#pragma unroll
                    for (int e = 0; e < 4; ++e) { st.o0[4 * g4 + e] = av[e] * fo + st.o0[4 * g4 + e] * fc; st.o1[4 * g4 + e] = cv[e] * fo + st.o1[4 * g4 + e] * fc; } }
                st.m = mn;
            }
            if (p < 2) {
#pragma unroll
                for (int g4 = 0; g4 < 4; ++g4) { *(LAS v2u*)(orow + 2 * (8 * g4 + 4 * hh)) = (v2u){pk2(st.o0[4 * g4], st.o0[4 * g4 + 1]), pk2(st.o0[4 * g4 + 2], st.o0[4 * g4 + 3])};
                    *(LAS v2u*)(orow + 64 + 2 * (8 * g4 + 4 * hh)) = (v2u){pk2(st.o1[4 * g4], st.o1[4 * g4 + 1]), pk2(st.o1[4 * g4 + 2], st.o1[4 * g4 + 3])}; }
                if (hh == 0) { ml[0] = st.m; ml[1] = lt; }
            } else attn_store(st.o0, st.o1, 1.0f / lt, (bf16*)(wsp() + WS_YCAT) + (size_t)(rowb + qpos) * DM + 0 * GW + 64 * h, hh);
        }
        __syncthreads();
    }
}

constexpr int SG_PITCH = 144, SG_WAVE = 128 * SG_PITCH, SG_OP = 272;
static_assert(8 * SG_WAVE <= MISC_OFF && 32 * SG_OP <= SG_WAVE, "SGU LDS");
__device__ __forceinline__ void sgu_unit(LAS unsigned char* lds, int unit, int tid, int l) {
    const int lane = tid & 63, g = __builtin_amdgcn_readfirstlane(tid >> 6), r32 = lane & 31, hh = lane >> 5, m0 = unit * 128;
    const bf16* PROJ = (const bf16*)(wsp() + WS_PROJ); bf16* YC = (bf16*)(wsp() + WS_YCAT); const pg8::fx_t* ST = (const pg8::fx_t*)(wsp() + CTL_STATS) + (size_t)l * M * 2;
    const float* lng = inp(4) + l * GW; const float* sw = inp(5) + ((size_t)l * NH + g) * 128 * 128; const float* sb = inp(6) + (l * NH + g) * 128;
    LAS unsigned char* T = lds + g * SG_WAVE;
    const int tk8 = lane >> 3, part = lane & 7;
    { const f32x4 g0 = *(const GAS f32x4*)(lng + 64 * g + 8 * part), g1 = *(const GAS f32x4*)(lng + 64 * g + 8 * part + 4);
      const float gn[8] = {g0.x, g0.y, g0.z, g0.w, g1.x, g1.y, g1.z, g1.w};
#pragma unroll 4
      for (int i = 0; i < 16; ++i) { const int tkn = tk8 + 8 * i, mm = m0 + tkn;
          const v4u w = *(const GAS v4u*)(PROJ + (size_t)mm * NPROJ_P + CB_V + 64 * g + 8 * part);
          const float mu = pg8::fx_get(ST + 2 * mm) * (1.0f / 512.0f), rs = __builtin_amdgcn_rsqf(fmaxf(pg8::fx_get(ST + 2 * mm + 1) * (1.0f / 512.0f) - mu * mu, 0.f) + 1e-5f);
          float x[8] = {bflo(w.x), bfhi(w.x), bflo(w.y), bfhi(w.y), bflo(w.z), bfhi(w.z), bflo(w.w), bfhi(w.w)};
#pragma unroll
          for (int e = 0; e < 8; ++e) x[e] = (gelu_tanh(x[e]) - mu) * rs * gn[e];
          *(LAS v4u*)(T + tkn * SG_PITCH + 16 * part) = (v4u){pk2(x[0], x[1]), pk2(x[2], x[3]), pk2(x[4], x[5]), pk2(x[6], x[7])}; } }
    asm volatile("" ::: "memory");
    f32x16 acc[4][2];
    const float z_ = zero_v();
#pragma unroll
    for (int tt = 0; tt < 4; ++tt)
#pragma unroll
        for (int ct = 0; ct < 2; ++ct)
#pragma unroll
            for (int i = 0; i < 16; ++i) acc[tt][ct][i] = z_;
    const LAS unsigned char* vb = T + (8 * hh + ((lane & 15) >> 2)) * SG_PITCH + (16 * ((lane >> 4) & 1) + 4 * (lane & 3)) * 2;
#pragma unroll
    for (int k = 0; k < 8; ++k) {
        v4i16_t t00 = __builtin_amdgcn_ds_read_tr16_b64_v4i16((LAS v4i16_t*)(vb + (16 * k) * SG_PITCH)), t01 = __builtin_amdgcn_ds_read_tr16_b64_v4i16((LAS v4i16_t*)(vb + (16 * k + 4) * SG_PITCH));
        v4i16_t t10 = __builtin_amdgcn_ds_read_tr16_b64_v4i16((LAS v4i16_t*)(vb + (16 * k) * SG_PITCH + 64)), t11 = __builtin_amdgcn_ds_read_tr16_b64_v4i16((LAS v4i16_t*)(vb + (16 * k + 4) * SG_PITCH + 64));
        const bf16x8 af0 = {t00[0], t00[1], t00[2], t00[3], t01[0], t01[1], t01[2], t01[3]}, af1 = {t10[0], t10[1], t10[2], t10[3], t11[0], t11[1], t11[2], t11[3]};
#pragma unroll
        for (int tt = 0; tt < 4; ++tt) { if (k < 2 * (tt + 1)) {
                const int t = 32 * tt + r32, s0 = 16 * k + 8 * hh; const float* wrow = sw + (size_t)t * 128 + s0;
                const f32x4 w0 = *(const GAS f32x4*)(wrow), w1 = *(const GAS f32x4*)(wrow + 4);
                float wv[8] = {w0.x, w0.y, w0.z, w0.w, w1.x, w1.y, w1.z, w1.w};
#pragma unroll
                for (int j = 0; j < 8; ++j) wv[j] = (s0 + j <= t) ? wv[j] : 0.f;
                const v4u bw = {pk2(wv[0], wv[1]), pk2(wv[2], wv[3]), pk2(wv[4], wv[5]), pk2(wv[6], wv[7])}; const bf16x8 bfr = __builtin_bit_cast(bf16x8, bw);
                acc[tt][0] = __builtin_amdgcn_mfma_f32_32x32x16_bf16(af0, bfr, acc[tt][0], 0, 0, 0); acc[tt][1] = __builtin_amdgcn_mfma_f32_32x32x16_bf16(af1, bfr, acc[tt][1], 0, 0, 0); } }
    }
    asm volatile("" ::: "memory");
#pragma unroll
    for (int tt = 0; tt < 4; ++tt) {
        const float bias = sb[32 * tt + r32];
#pragma unroll
        for (int ct = 0; ct < 2; ++ct)
#pragma unroll
            for (int g4 = 0; g4 < 4; ++g4) { const f32x16& a = acc[tt][ct];
                *(LAS f32x4*)(T + r32 * SG_OP + 4 * (32 * ct + 8 * g4 + 4 * hh)) = (f32x4){a[4 * g4] + bias, a[4 * g4 + 1] + bias, a[4 * g4 + 2] + bias, a[4 * g4 + 3] + bias}; }
        asm volatile("" ::: "memory");
#pragma unroll
        for (int i = 0; i < 4; ++i) { const int tkn = tk8 + 8 * i, mm = m0 + 32 * tt + tkn;
            const v4u uw = *(const GAS v4u*)(PROJ + (size_t)mm * NPROJ_P + CB_U + 64 * g + 8 * part);
            const f32x4 x0 = *(const LAS f32x4*)(T + tkn * SG_OP + 32 * part), x1 = *(const LAS f32x4*)(T + tkn * SG_OP + 32 * part + 16);
            const float u[8] = {bflo(uw.x), bfhi(uw.x), bflo(uw.y), bfhi(uw.y), bflo(uw.z), bfhi(uw.z), bflo(uw.w), bfhi(uw.w)};
            *(GAS v4u*)(YC + (size_t)mm * DM + GW + 64 * g + 8 * part) = (v4u){pk2(gelu_tanh(u[0]) * x0.x, gelu_tanh(u[1]) * x0.y), pk2(gelu_tanh(u[2]) * x0.z, gelu_tanh(u[3]) * x0.w), pk2(gelu_tanh(u[4]) * x1.x, gelu_tanh(u[5]) * x1.y), pk2(gelu_tanh(u[6]) * x1.z, gelu_tanh(u[7]) * x1.w)}; }
        asm volatile("" ::: "memory");
    }
}

#ifndef SIMPLE_A
#define SIMPLE_A 0
#endif
#ifndef SIMPLE_B
#define SIMPLE_B 0
#endif
#ifndef SIMPLE_C
#define SIMPLE_C 0
#endif
#ifndef SIMPLE_D
#define SIMPLE_D 0
#endif
__device__ __forceinline__ void ph_mixers(LAS unsigned char* L, int l, int phase, int qoff, int mask = 31) {
    Frame F = mkframe(L);
    volatile LAS int* qslot = (volatile LAS int*)(L + MISC_OFF + 64);
    gu32* ctr = ctlp() + CW_Q + 64 * phase + qoff;
    constexpr int I_IN = (DM / 64) * (NPROJ / 32), I_REST = (DM / 64) * (DM / 32) + 2 * (DM / 64) * (DFF / 32) + (DFF / 64) * (DM / 32);
    const int n_scan = (SIMPLE_D || !(mask & 1)) ? 0 : 128, n_c = (SIMPLE_C || !(mask & 2)) ? 0 : 512, n_a = (SIMPLE_A || !(mask & 4)) ? 0 : 256, n_b = (SIMPLE_B || !(mask & 8)) ? 0 : 128;
    const int n_cin = ((l + 1 < DEPTH) && (mask & 16)) ? (I_IN + 7) / 8 : 0, n_crest = (mask & 16) ? (I_REST + 7) / 8 : 0;
    const int e_scan = n_scan, e_a = e_scan + n_a, e_b = e_a + n_b, e_c = e_b + n_c, e_cin = e_c + n_cin, e_crest = e_cin + n_crest;
    for (;;) {
        if (F.tid == 0) *qslot = (int)__hip_atomic_fetch_add(ctr, 1u, RLX_AGENT);
        __syncthreads();
        const int it = __builtin_amdgcn_readfirstlane(*qslot);
        __syncthreads();
        if (it >= e_crest) break;
        int tid = threadIdx.x; asm volatile("" : "+v"(tid));
        if (it < e_scan) scan_unit(L, it, tid);
        else if (it < e_a) dil_unit(L, it - e_scan, tid);
        else if (it < e_b) { sgu_unit(L, it - e_a, tid, l); __syncthreads(); }
        else if (it < e_c) { const int i2 = it - e_b; moba_unit(L, (i2 & 63) * 8 + (7 - (i2 >> 6)), tid, l); }
        else if (it < e_cin) { Frame F2 = mkframe(L); conv_layer_items(F2, l + 1, (it - e_c) * 8 + F2.wave, 1 << 30, true, false); }
        else { Frame F2 = mkframe(L); conv_layer_items(F2, l, (it - e_cin) * 8 + F2.wave, 1 << 30, false, true); }
    }
    if (l + 1 < DEPTH) {
        bf16* WIN = (bf16*)(wsp() + WS_WIN);
        Frame F3 = mkframe(L);
        for (int i = F3.gw * 64 + F3.lane; i < 64 * DM / 8; i += F3.ngw * 64) { v4u z = {0u, 0u, 0u, 0u}; asm volatile("" : "+v"(z)); *(GAS v4u*)(WIN + (size_t)NPROJ * DM + (size_t)i * 8) = z; }
    }
    if (SIMPLE_D) mix_d_simple(F);
    if (SIMPLE_A) mix_a_simple(F);
    if (SIMPLE_C) mix_c_simple(F, l);
    if (SIMPLE_B) mix_b_simple(F, l);
}

__device__ __forceinline__ void ph_finalize(Frame& F, int l) {
    bf16* YC = (bf16*)(wsp() + WS_YCAT); const float* YD = (const float*)(wsp() + WS_YD); const bf16* V_ = (const bf16*)outp() + (size_t)3 * M * GW; const bf16* G_ = (const bf16*)(wsp() + WS_G); const float* BC = (const float*)(wsp() + WS_BC);
    const float* lng = inp(16) + l * GW; const float* lnb = inp(17) + l * GW;
    for (int m = F.gw; m < M; m += F.ngw) {
        const int c0 = 8 * F.lane, hd = F.lane >> 3;
        float y[8];
        { const GAS f32x4* yp = (const GAS f32x4*)(YD + (size_t)m * GW + c0); const f32x4 a = yp[0], b = yp[1]; y[0] = a.x; y[1] = a.y; y[2] = a.z; y[3] = a.w; y[4] = b.x; y[5] = b.y; y[6] = b.z; y[7] = b.w; }
        float s = 0.f;
#pragma unroll
        for (int i = 0; i < 8; ++i) s += y[i];
        s += __shfl_xor(s, 1); s += __shfl_xor(s, 2); s += __shfl_xor(s, 4); const float mean = s * (1.0f / 64.0f); float q = 0.f;
#pragma unroll
        for (int i = 0; i < 8; ++i) { const float d = y[i] - mean; q += d * d; }
        q += __shfl_xor(q, 1); q += __shfl_xor(q, 2); q += __shfl_xor(q, 4); const float rstd = 1.0f / sqrtf(q * (1.0f / 64.0f) + 64e-5f);
        const v4u vw = *(const GAS v4u*)(V_ + (size_t)m * GW + c0), gw4 = *(const GAS v4u*)(G_ + (size_t)m * GW + c0); const float bc = BC[(size_t)m * NH + hd];
        float vv[8], gg[8]; UNPACK8(vv, 0, vw); UNPACK8(gg, 0, gw4);
        float ss = 0.f;
#pragma unroll
        for (int i = 0; i < 8; ++i) { y[i] = ((y[i] - mean) * rstd * lng[c0 + i] + lnb[c0 + i] + bc * vv[i]) * gg[i]; ss += y[i] * y[i]; }
        { const float rs = 1.0f / sqrtf(wave_sum(ss) * (1.0f / 512.0f) + NORM_EPS);
          *(GAS v4u*)(YC + (size_t)m * DM + 3 * GW + c0) = (v4u){pk2(y[0] * rs, y[1] * rs), pk2(y[2] * rs, y[3] * rs), pk2(y[4] * rs, y[5] * rs), pk2(y[6] * rs, y[7] * rs)}; }
#pragma unroll
        for (int br = 0; br < 3; ++br) {
            GAS v4u* p = (GAS v4u*)(YC + (size_t)m * DM + br * GW + c0); const v4u w = *p;
            float x[8]; UNPACK8(x, 0, w); float s2 = 0.f;
#pragma unroll
            for (int i = 0; i < 8; ++i) s2 += x[i] * x[i];
            const float rs = 1.0f / sqrtf(wave_sum(s2) * (1.0f / 512.0f) + NORM_EPS);
            *p = (v4u){pk2(x[0] * rs, x[1] * rs), pk2(x[2] * rs, x[3] * rs), pk2(x[4] * rs, x[5] * rs), pk2(x[6] * rs, x[7] * rs)};
        }
    }
}
__device__ __forceinline__ void ph_final(Frame& F) {
    const pg8::fx_t* ssq = (const pg8::fx_t*)(ctlp() + CW_SSQ) + 4 * M; const float* g = inp(24); float* out = outp(); const bf16* XB = (const bf16*)(wsp() + WS_XB);
    for (int m = F.gw; m < M; m += F.ngw) {
        const float rs = 1.0f / sqrtf(pg8::fx_get(ssq + m) * (1.0f / 2048.0f) + NORM_EPS); GAS f32x4* orow = (GAS f32x4*)(out + (size_t)m * DM); const GAS v4u* xr = (const GAS v4u*)(XB + (size_t)m * DM) + F.lane; const GAS f32x4* gp = (const GAS f32x4*)g;
#pragma unroll
        for (int j = 0; j < 4; ++j) { const v4u w = xr[64 * j]; const int c4 = 2 * (F.lane + 64 * j); const f32x4 g0 = gp[c4], g1 = gp[c4 + 1];
            orow[c4] = (f32x4){bflo(w.x) * rs * g0.x, bfhi(w.x) * rs * g0.y, bflo(w.y) * rs * g0.z, bfhi(w.y) * rs * g0.w};
            orow[c4 + 1] = (f32x4){bflo(w.z) * rs * g1.x, bfhi(w.z) * rs * g1.y, bflo(w.w) * rs * g1.z, bfhi(w.w) * rs * g1.w}; }
    }
}

__global__ void __launch_bounds__(NTHR, 2) hy_fwd(Args args) {
    extern __shared__ __attribute__((aligned(16))) unsigned char lds[];
    LAS unsigned char* L = (LAS unsigned char*)lds;
    volatile LAS unsigned* MISC = (volatile LAS unsigned*)(L + MISC_OFF);
    if (threadIdx.x < 64) MISC[threadIdx.x] = 0u;
    __syncthreads();
    XcdBarrier bar; bar.bar = (unsigned*)(ctlp() + CW_BAR); bar.x = 0; bar.st = nullptr;
    if (N_LAUNCH_MODE == 0) bar = xcd_barrier_post((unsigned*)(ctlp() + CW_BAR), MISC + 8);
    const int lo = args.ph_lo, hi = args.ph_hi;
#define IN(k) (lo <= (k) && (k) < hi)
#define SEAM(k) do { if (IN(k) && IN((k) + 1)) xcd_barrier(bar); } while (0)
    if (IN(0)) { Frame F = mkframe(L); ph_prologue(F); if (REPEAT == 1) ph_prologue(F); }
    SEAM(0);
    auto layer = [&](const int l) __attribute__((always_inline)) {
        const int P = 1 + 7 * l;
        if (IN(P)) {
            unsigned char* ws = wsp(); pg8::Gemm g{(const bf16*)(ws + WS_XB), (const bf16*)(ws + WS_WIN), M, NPROJ_P, DM}; pg8::StaticOrder S; S.init(M, NPROJ_P, gridDim.x, (int)blockIdx.x);
            pg8::EpiProj E{(bf16*)(ws + WS_PROJ), NPROJ_P, (const pg8::fx_t*)((gu32*)ws + CW_SSQ) + (size_t)(2 * l) * M, (float*)(ws + CTL_KBAR) + (size_t)l * 64 * 8 * 64, (pg8::fx_t*)(ws + CTL_STATS) + (size_t)l * M * 2};
            pg8::gemm_phase<pg8::EpiProj, pg8::StaticOrder, true, PG8_SP2>(L + RING_OFF, g, S, E);
            if (REPEAT == 2) pg8::gemm_phase<pg8::EpiProj, pg8::StaticOrder, true, PG8_SP2>(L + RING_OFF, g, S, E);
        }
        SEAM(P);
        if (IN(P + 1)) { Frame F = mkframe(L); ph_prep(F, l); if (REPEAT == 3) ph_prep(F, l); }
        SEAM(P + 1);
        if (IN(P + 2)) { ph_mixers(L, l, P + 2, 0); if (REPEAT == 4) ph_mixers(L, l, P + 2, 32); if (REPEAT >= 40 && REPEAT < 50) ph_mixers(L, l, P + 2, 32, REPEAT == 41 ? 1 : (REPEAT == 42 ? 2 : (REPEAT == 43 ? 4 : (REPEAT == 44 ? 8 : 16)))); if (REPEAT >= 430 && REPEAT < 446) ph_mixers(L, l, P + 2, 32, 4); }
        SEAM(P + 2);
        if (IN(P + 3)) { Frame F = mkframe(L); ph_finalize(F, l); if (REPEAT == 5) ph_finalize(F, l); }
        SEAM(P + 3);
        if (IN(P + 4)) {
            unsigned char* ws = wsp(); pg8::Gemm g{(const bf16*)(ws + WS_YCAT), (const bf16*)(ws + WS_WOUT), M, DM, DM}; pg8::StaticOrder S; S.init(M, DM, gridDim.x, (int)blockIdx.x);
            pg8::EpiRes E{(bf16*)(ws + WS_XB), (pg8::fx_t*)((gu32*)ws + CW_SSQ) + (size_t)(2 * l + 1) * M, DM, FFN_FP8 ? (unsigned char*)(ws + WS_SC2) : nullptr, 1.0f};
            pg8::gemm_phase<pg8::EpiRes, pg8::StaticOrder, true, PG8_SP2>(L + RING_OFF, g, S, E);
        }
        SEAM(P + 4);
        if (IN(P + 5)) {
            unsigned char* ws = wsp(); pg8::Gemm g{(const bf16*)(ws + (FFN_FP8 ? WS_SC2 : WS_XB)), (const bf16*)(ws + WS_WGU), M, 2 * DFF, DM}; pg8::StaticOrder S; S.init(M, 2 * DFF, gridDim.x, (int)blockIdx.x);
            if (FFN_FP8) { pg8::EpiGU8 E{(unsigned char*)(ws + WS_PROJ), DFF, (const pg8::fx_t*)((gu32*)ws + CW_SSQ) + (size_t)(2 * l + 1) * M, 1.0f / 64.0f, 8.0f};
                pg8::gemm_phase_f8<pg8::EpiGU8, pg8::StaticOrder, true, PG8_SP2>(L + RING_OFF, g, S, E);
                if (REPEAT == 6) pg8::gemm_phase_f8<pg8::EpiGU8, pg8::StaticOrder, true, PG8_SP2>(L + RING_OFF, g, S, E);
            } else { pg8::EpiGU E{(bf16*)(ws + WS_PROJ), DFF, (const pg8::fx_t*)((gu32*)ws + CW_SSQ) + (size_t)(2 * l + 1) * M, 1.0f};
                pg8::gemm_phase<pg8::EpiGU, pg8::StaticOrder, true, PG8_SP2>(L + RING_OFF, g, S, E);
                if (REPEAT == 6) pg8::gemm_phase<pg8::EpiGU, pg8::StaticOrder, true, PG8_SP2>(L + RING_OFF, g, S, E); }
        }
        SEAM(P + 5);
        if (IN(P + 6)) {
            unsigned char* ws = wsp(); pg8::Gemm g{(const bf16*)(ws + WS_PROJ), (const bf16*)(ws + WS_WDN), M, DM, DFF}; pg8::StaticOrder S; S.init(M, DM, gridDim.x, (int)blockIdx.x);
            pg8::EpiRes E{(bf16*)(ws + WS_XB), (pg8::fx_t*)((gu32*)ws + CW_SSQ) + (size_t)(2 * l + 2) * M, DM, nullptr, FFN_FP8 ? 1.0f / 512.0f : 1.0f};
            if (FFN_FP8) pg8::gemm_phase_f8<pg8::EpiRes, pg8::StaticOrder, true, PG8_SP2>(L + RING_OFF, g, S, E);
            else pg8::gemm_phase<pg8::EpiRes, pg8::StaticOrder, true, PG8_SP2>(L + RING_OFF, g, S, E);
        }
        SEAM(P + 6);
    };
    static_assert(DEPTH == 2, "layers are expanded by hand");
    layer(0); layer(1);
    if (IN(15)) { Frame F = mkframe(L); ph_final(F); }
#undef IN
#undef SEAM
}

extern "C" void kernel_launch(void* const* d_in, const int* in_sizes, int n_in, void* d_out, int out_size, void* d_ws, size_t ws_size, hipStream_t stream) {
    static int grid = 0;
    if (grid == 0) {
        if (n_in != 25 || in_sizes[0] != M * DM || out_size != M * DM || ws_size < WS_END) { fprintf(stderr, "kernel_launch: shape/workspace mismatch: n_in %d in0 %d out %d ws %zu (need %zu)\n", n_in, n_in > 0 ? in_sizes[0] : -1, out_size, ws_size, (size_t)WS_END); grid = -1; return; }
        int dev = 0, cus = 0, per_cu = 0;
        if (hipGetDevice(&dev) != hipSuccess || hipDeviceGetAttribute(&cus, hipDeviceAttributeMultiprocessorCount, dev) != hipSuccess) { grid = -1; return; }
        if (hipFuncSetAttribute((const void*)hy_fwd, hipFuncAttributeMaxDynamicSharedMemorySize, LDS_BYTES) != hipSuccess) { fprintf(stderr, "kernel_launch: hipFuncSetAttribute failed\n"); grid = -1; return; }
        if (hipOccupancyMaxActiveBlocksPerMultiprocessor(&per_cu, (const void*)hy_fwd, NTHR, LDS_BYTES) != hipSuccess || per_cu < 1) fprintf(stderr, "kernel_launch: occupancy query reports %d\n", per_cu);
        (void)hipGetLastError();
        grid = cus;
    }
    if (grid < 0) return;
    if (hipMemsetAsync((char*)d_ws + WS_CTL, 0, CTL_ZERO_BYTES, stream) != hipSuccess) return;
    Args a{};
    for (int i = 0; i < 25; ++i) a.in[i] = (const float*)d_in[i];
    a.out = (float*)d_out; a.ws = (unsigned char*)d_ws;
    if (N_LAUNCH_MODE == 0) { a.ph_lo = 0; a.ph_hi = N_PHASES; hipLaunchKernelGGL(hy_fwd, dim3(grid), dim3(NTHR), LDS_BYTES, stream, a); }
    else for (int p = 0; p < N_PHASES; ++p) { a.ph_lo = p; a.ph_hi = p + 1; hipLaunchKernelGGL(hy_fwd, dim3(grid), dim3(NTHR), LDS_BYTES, stream, a); }
}
```

```cpp
#define N_LAUNCH_MODE 0
#define REPEAT 0
#define PG8_SP2 true
#define FFN_FP8 1
#define GEMM_I8 3
#define BFMASK 0x003C0Fu
#include <hip/hip_runtime.h>
#include <cstdio>
#include <cstdint>
namespace pg8 {
#define PG8_LAS __attribute__((address_space(3)))
typedef unsigned short bf16_t;
typedef short bf16x8 __attribute__((ext_vector_type(8)));
typedef float f32x4 __attribute__((ext_vector_type(4)));
typedef unsigned u32x4 __attribute__((ext_vector_type(4)));
constexpr int BM = 256, BK = 64, HALF = 128, HTB = HALF * BK * 2  , STAGE_BYTES = 8 * HTB, NXCD = 8, WGM = 8;

__host__ __device__ __forceinline__ int lds_byte(int r, int c) { const int st = (r >> 4) * 2 + (c >> 5), rr = r & 15, cc = c & 31, ob = rr * 64 + cc * 2; return st * 1024 + (ob ^ (((ob >> 9) & 1) << 5)); }
__host__ __device__ __forceinline__ void stage_rc(int b, int& R, int& C) { const int st = b / 1024, sb = b % 1024, swz = sb ^ (((sb >> 9) & 1) << 5); R = (st >> 1) * 16 + swz / 64; C = (st & 1) * 32 + (swz % 64) / 2; }
__host__ __device__ __forceinline__ int perm32(int rho) { const int n = rho >> 4, i = rho & 15; return 8 * (i >> 2) + 4 * n + (i & 3); }

struct Unit { int pm, pn; };
struct Gemm { const bf16_t* A; const bf16_t* Bt; int M, N, K; };

struct StaticOrder {
    int nM, nN, nwg, G, c;
    __host__ __device__ void init(int M, int N, int G_, int c_) { nM = M / BM; nN = N / BM; nwg = nM * nN; G = G_; c = c_; }
    __host__ __device__ bool next(int i, Unit& u) const {
        const long L = (long)i * G + c; if (L >= nwg) return false;
        int wgid = (int)L; { const int q = nwg / NXCD, r = nwg % NXCD, xcd = wgid % NXCD, off = wgid / NXCD; wgid = (xcd < r ? xcd * (q + 1) : r * (q + 1) + (xcd - r) * q) + off; }
        const int nig = WGM * nN, gid = wgid / nig, fm = gid * WGM, gsz = (nM - fm) < WGM ? (nM - fm) : WGM;
        u.pm = fm + ((wgid % nig) % gsz); u.pn = (wgid % nig) / gsz; return true;
    }
    __device__ __forceinline__ void a_ready(const Unit&) const {}
    __device__ __forceinline__ void done(const Unit&) const {}
};

struct MapOrder {
    StaticOrder s; int from, add;
    __device__ __forceinline__ bool next(int i, Unit& u) const { if (!s.next(i, u)) return false; if (u.pn >= from) u.pn += add; return true; }
    __device__ __forceinline__ void a_ready(const Unit&) const {}
    __device__ __forceinline__ void done(const Unit&) const {}
};

struct MaskOrder {
    StaticOrder s; unsigned mask;
    __device__ __forceinline__ void init(int M, unsigned mask_, int G_, int c_) { mask = mask_; s.init(M, BM * __builtin_popcount(mask_), G_, c_); }
    __device__ __forceinline__ bool next(int i, Unit& u) const { if (!s.next(i, u)) return false; unsigned m = mask; for (int j = 0; j < u.pn; ++j) m &= m - 1; u.pn = __builtin_ctz(m); return true; }
    __device__ __forceinline__ void a_ready(const Unit&) const {}
    __device__ __forceinline__ void done(const Unit&) const {}
};

__device__ __forceinline__ unsigned cvt_pk_bf16(float lo, float hi) { unsigned r; asm volatile("v_cvt_pk_bf16_f32 %0, %1, %2" : "=v"(r) : "v"(lo), "v"(hi)); return r; }
typedef float f32x2 __attribute__((ext_vector_type(2)));

typedef unsigned u32x2 __attribute__((ext_vector_type(2)));
typedef unsigned long long fx_t;
__device__ __forceinline__ void fx_add(fx_t* p, float v) { atomicAdd(p, (fx_t)(long long)__float2ll_rn(v * 1073741824.0f)); }
__device__ __forceinline__ float fx_get(const fx_t* p) { return (float)(long long)(*p) * (1.0f / 1073741824.0f); }
__device__ __forceinline__ float epi_gelu(float x) { const float u = 0.7978845608028654f * (x + 0.044715f * x * x * x); const float e2 = __expf(2.0f * u); return 0.5f * x * (2.0f - 2.0f / (e2 + 1.0f)); }
template <int CTRL> __device__ __forceinline__ float epi_dpp_add(float x) { const int y = __builtin_amdgcn_update_dpp(0, __builtin_bit_cast(int, x), CTRL, 0xF, 0xF, false); return x + __builtin_bit_cast(float, y); }
typedef int i32x4_t __attribute__((ext_vector_type(4)));
__device__ __forceinline__ f32x4 acc_f(const f32x4& v) { return v; }
__device__ __forceinline__ f32x4 acc_f(const i32x4_t& v) { return __builtin_convertvector(v, f32x4); }
template <class T> struct AccIsInt { static constexpr bool v = false; };
template <> struct AccIsInt<i32x4_t> { static constexpr bool v = true; };
struct EpiProj {
    static constexpr bool PERM = true, AFTER_DRAIN = false;
    bf16_t* O; int ldc; const fx_t* ssq; float* kbar; fx_t* stats; const float* sa; const float* sw;
    template <class AccT> __device__ __forceinline__ void operator()(const AccT (&acc)[2][2][4][2], const Unit& u, int wr, int wc, int fr, int fq) const {
        constexpr bool Q = AccIsInt<AccT>::v;
        const int row0 = u.pm * BM + wr * 64 + fr, col0 = u.pn * BM + wc * 32 + 8 * fq;
        f32x4 cw[2][2];
        if constexpr (Q) {
#pragma unroll
            for (int bj = 0; bj < 2; ++bj) { cw[bj][0] = *(const f32x4*)(sw + col0 + bj * HALF); cw[bj][1] = *(const f32x4*)(sw + col0 + bj * HALF + 4); } }
        const bool do_k = (u.pn == 12 || u.pn == 13), do_s = (u.pn == 8 || u.pn == 9);
        float cs[2][8];
#pragma unroll
        for (int bj = 0; bj < 2; ++bj)
#pragma unroll
            for (int e = 0; e < 8; ++e) cs[bj][e] = 0.f;
#pragma unroll
        for (int ai = 0; ai < 2; ++ai)
#pragma unroll
            for (int m = 0; m < 4; ++m) { const int row = row0 + ai * HALF + m * 16; float rs = __builtin_amdgcn_rsqf(fx_get(ssq + row) * (1.0f / 2048.0f) + 1e-6f); if constexpr (Q) rs *= sa[row];
                bf16_t* rowp = O + (size_t)row * ldc + col0; float s1 = 0.f, s2 = 0.f;
#pragma unroll
                for (int bj = 0; bj < 2; ++bj) { f32x4 v0 = acc_f(acc[ai][bj][m][0]) * rs, v1 = acc_f(acc[ai][bj][m][1]) * rs; if constexpr (Q) { v0 *= cw[bj][0]; v1 *= cw[bj][1]; }
                    u32x4 w; w.x = cvt_pk_bf16(v0[0], v0[1]); w.y = cvt_pk_bf16(v0[2], v0[3]); w.z = cvt_pk_bf16(v1[0], v1[1]); w.w = cvt_pk_bf16(v1[2], v1[3]);
                    *(u32x4*)(rowp + bj * HALF) = w;
                    if (do_k) {
#pragma unroll
                        for (int e = 0; e < 4; ++e) { cs[bj][e] += v0[e]; cs[bj][4 + e] += v1[e]; } }
                    if (do_s) {
#pragma unroll
                        for (int e = 0; e < 4; ++e) { const float g0 = epi_gelu(v0[e]), g1 = epi_gelu(v1[e]); s1 += g0 + g1; s2 += g0 * g0 + g1 * g1; } } }
                if (do_s) { s1 += __shfl_xor(s1, 16); s1 += __shfl_xor(s1, 32); s2 += __shfl_xor(s2, 16); s2 += __shfl_xor(s2, 32);
                    if (fq == 0) { fx_add(stats + 2 * row, s1); fx_add(stats + 2 * row + 1, s2); } } }
        if (do_k) {
            const int bidx = (u.pm >> 3) * 8, n = u.pm & 7;
#pragma unroll
            for (int bj = 0; bj < 2; ++bj)
#pragma unroll
                for (int e = 0; e < 8; ++e) { float s = cs[bj][e]; s = epi_dpp_add<0xB1>(s); s = epi_dpp_add<0x4E>(s); s = epi_dpp_add<0x141>(s); s = epi_dpp_add<0x140>(s);
                    const int ck = col0 + bj * HALF + e - 3072;
                    if (fr == 0) unsafeAtomicAdd(kbar + ((bidx + (ck >> 6)) * 8 + n) * 64 + (ck & 63), s * (1.0f / 256.0f)); } }
    }
};
struct EpiGU {
    static constexpr bool PERM = true, AFTER_DRAIN = false;
    bf16_t* O; int ldc; const fx_t* ssq; float oscale;
    __device__ __forceinline__ void operator()(const f32x4 (&acc)[2][2][4][2], const Unit& u, int wr, int wc, int fr, int fq) const {
        const int row0 = u.pm * BM + wr * 64 + fr, col0 = u.pn * HALF + wc * 32 + 8 * fq;
#pragma unroll
        for (int ai = 0; ai < 2; ++ai)
#pragma unroll
            for (int m = 0; m < 4; ++m) { const int row = row0 + ai * HALF + m * 16; const float rs = __builtin_amdgcn_rsqf(fx_get(ssq + row) * (1.0f / 2048.0f) + 1e-6f) * oscale;
                float o[8];
#pragma unroll
                for (int n = 0; n < 2; ++n)
#pragma unroll
                    for (int e = 0; e < 4; ++e) { const float g = acc[ai][0][m][n][e] * rs, up = acc[ai][1][m][n][e] * rs;
                        o[n * 4 + e] = g * __builtin_amdgcn_rcpf(1.0f + __builtin_amdgcn_exp2f(-1.4426950408889634f * g)) * up; }
                u32x4 w; w.x = cvt_pk_bf16(o[0], o[1]); w.y = cvt_pk_bf16(o[2], o[3]); w.z = cvt_pk_bf16(o[4], o[5]); w.w = cvt_pk_bf16(o[6], o[7]);
                *(u32x4*)(O + (size_t)row * ldc + col0) = w; }
    }
};
__device__ __forceinline__ float epi_clamp8(float v) { return __builtin_amdgcn_fmed3f(v, -448.0f, 448.0f); }
struct EpiGU8 {
    static constexpr bool PERM = true, AFTER_DRAIN = false;
    unsigned char* O; int ldc; const fx_t* ssq; float oscale, ascale;
    __device__ __forceinline__ void operator()(const f32x4 (&acc)[2][2][4][2], const Unit& u, int wr, int wc, int fr, int fq) const {
        const int row0 = u.pm * BM + wr * 64 + fr, col0 = u.pn * HALF + wc * 32 + 8 * fq;
#pragma unroll
        for (int ai = 0; ai < 2; ++ai)
#pragma unroll
            for (int m = 0; m < 4; ++m) { const int row = row0 + ai * HALF + m * 16; const float rs = __builtin_amdgcn_rsqf(fx_get(ssq + row) * (1.0f / 2048.0f) + 1e-6f) * oscale;
                float o[8];
#pragma unroll
                for (int n = 0; n < 2; ++n)
#pragma unroll
                    for (int e = 0; e < 4; ++e) { const float g = acc[ai][0][m][n][e] * rs, up = acc[ai][1][m][n][e] * rs;
                        o[n * 4 + e] = epi_clamp8(g * __builtin_amdgcn_rcpf(1.0f + __builtin_amdgcn_exp2f(-1.4426950408889634f * g)) * up * ascale); }
                int f0 = __builtin_bit_cast(int, o[0]), f1 = __builtin_bit_cast(int, o[4]);
                f0 = __builtin_amdgcn_cvt_pk_fp8_f32(o[0], o[1], f0, false); f0 = __builtin_amdgcn_cvt_pk_fp8_f32(o[2], o[3], f0, true);
                f1 = __builtin_amdgcn_cvt_pk_fp8_f32(o[4], o[5], f1, false); f1 = __builtin_amdgcn_cvt_pk_fp8_f32(o[6], o[7], f1, true);
                *(u32x2*)(O + (size_t)row * ldc + col0) = (u32x2){(unsigned)f0, (unsigned)f1}; }
    }
};
struct EpiRes {
    static constexpr bool PERM = true, AFTER_DRAIN = false;
    bf16_t* xb; fx_t* ssq; int ldc; unsigned char* xf; float oscale; const float* sa; const float* sw;
    template <class AccT> __device__ __forceinline__ void operator()(const AccT (&acc)[2][2][4][2], const Unit& u, int wr, int wc, int fr, int fq) const {
        constexpr bool Q = AccIsInt<AccT>::v;
        const int row0 = u.pm * BM + wr * 64 + fr, col0 = u.pn * BM + wc * 32 + 8 * fq;
        f32x4 cw[2][2];
        if constexpr (Q) {
#pragma unroll
            for (int bj = 0; bj < 2; ++bj) { cw[bj][0] = *(const f32x4*)(sw + col0 + bj * HALF); cw[bj][1] = *(const f32x4*)(sw + col0 + bj * HALF + 4); } }
#pragma unroll
        for (int ai = 0; ai < 2; ++ai)
#pragma unroll
            for (int m = 0; m < 4; ++m) { const int row = row0 + ai * HALF + m * 16; bf16_t* rowp = xb + (size_t)row * ldc + col0; float s = 0.f; float osc = oscale; if constexpr (Q) osc = sa[row];
                u32x4 b[2];
#pragma unroll
                for (int bj = 0; bj < 2; ++bj) b[bj] = *(const u32x4*)(rowp + bj * HALF);
#pragma unroll
                for (int bj = 0; bj < 2; ++bj) { float o[8]; f32x4 a2[2] = {acc_f(acc[ai][bj][m][0]), acc_f(acc[ai][bj][m][1])}; if constexpr (Q) { a2[0] *= cw[bj][0]; a2[1] *= cw[bj][1]; }
#pragma unroll
                    for (int q = 0; q < 4; ++q) { o[2 * q] = __builtin_fmaf(a2[q >> 1][2 * (q & 1)], osc, __builtin_bit_cast(float, b[bj][q] << 16)); o[2 * q + 1] = __builtin_fmaf(a2[q >> 1][2 * (q & 1) + 1], osc, __builtin_bit_cast(float, b[bj][q] & 0xffff0000u)); }
                    u32x4 w; w.x = cvt_pk_bf16(o[0], o[1]); w.y = cvt_pk_bf16(o[2], o[3]); w.z = cvt_pk_bf16(o[4], o[5]); w.w = cvt_pk_bf16(o[6], o[7]);
                    *(u32x4*)(rowp + bj * HALF) = w;
                    if (xf) { int f0 = (int)b[bj][0], f1 = (int)b[bj][1]; f0 = __builtin_amdgcn_cvt_pk_fp8_f32(epi_clamp8(o[0]), epi_clamp8(o[1]), f0, false); f0 = __builtin_amdgcn_cvt_pk_fp8_f32(epi_clamp8(o[2]), epi_clamp8(o[3]), f0, true);
                        f1 = __builtin_amdgcn_cvt_pk_fp8_f32(epi_clamp8(o[4]), epi_clamp8(o[5]), f1, false); f1 = __builtin_amdgcn_cvt_pk_fp8_f32(epi_clamp8(o[6]), epi_clamp8(o[7]), f1, true);
                        *(u32x2*)(xf + (size_t)row * ldc + col0 + bj * HALF) = (u32x2){(unsigned)f0, (unsigned)f1}; }
#pragma unroll
                    for (int q = 0; q < 8; ++q) s += o[q] * o[q]; }
                s += __shfl_xor(s, 16); s += __shfl_xor(s, 32);
                if (fq == 0) fx_add(ssq + row, s); }
    }
};
typedef int i32x8_t __attribute__((ext_vector_type(8)));
__device__ __forceinline__ void mma16(f32x4& c, const bf16x8& a, const bf16x8& b) { c = __builtin_amdgcn_mfma_f32_16x16x32_bf16(a, b, c, 0, 0, 0); }
__device__ __forceinline__ void mma16(i32x4_t& c, const bf16x8& a, const bf16x8& b) { c = __builtin_amdgcn_mfma_i32_16x16x64_i8(__builtin_bit_cast(i32x4_t, a), __builtin_bit_cast(i32x4_t, b), c, 0, 0, 0); }
template <int EB> struct AccOf { typedef f32x4 type; };
template <> struct AccOf<1> { typedef i32x4_t type; };
template <class Epi, class Sched, bool ALIGN_EPI = false, bool SP2 = false, int EB = 2>
__device__ __forceinline__ void gemm_phase(PG8_LAS unsigned char* lds, const Gemm g, const Sched& S, const Epi& E) {
    int tid_ = threadIdx.x; asm volatile("" : "+v"(tid_));
    const int tid = tid_, wid = __builtin_amdgcn_readfirstlane(tid >> 6), lane = tid & 63, wr = wid >> 2, wc = wid & 3, fr = lane & 15, fq = lane >> 4;
    const int K = g.K, nt = K * EB / (2 * BK);
    unsigned voffA[2], voffB[2];
#pragma unroll
    for (int i = 0; i < 2; ++i) { int R, C; stage_rc(tid * 16 + i * 8192, R, C); const int Rb = Epi::PERM ? ((R & ~31) + perm32(R & 31)) : R;
        voffA[i] = (unsigned)(R * K * EB + 2 * C); voffB[i] = (unsigned)(Rb * K * EB + 2 * C); }
    const unsigned kstep = (unsigned)(BK * 2);
    const unsigned hstep = (unsigned)HALF * K * EB;
    const unsigned tstep = 2 * hstep;
    const unsigned ldsw = (unsigned)wid * 1024u;
    const int aoff = lds_byte(wr * 64 + fr, fq * 8), boff = lds_byte(wc * 32 + fr, fq * 8);
#define PG8_SA(b, h) (((b) * 2 + (h)) * HTB)
#define PG8_SB(b, h) ((4 + (b) * 2 + (h)) * HTB)
#define PG8_STAGE(bufoff, rsrc, soff, voff) do { _Pragma("unroll") for (int _i = 0; _i < 2; ++_i) \
        __builtin_amdgcn_raw_ptr_buffer_load_lds(rsrc, (PG8_LAS void*)(lds + (bufoff) + ldsw + _i * 8192), 16, (int)(voff)[_i], (int)(soff), 0, 0); } while (0)
#define PG8_LDA(dst, b, h) do { _Pragma("unroll") for (int m = 0; m < 4; ++m) _Pragma("unroll") for (int k = 0; k < 2; ++k) dst[m][k] = *(const PG8_LAS bf16x8*)(lds + PG8_SA(b, h) + aoff + m * 2048 + k * 1024); } while (0)
#define PG8_LDB(dst, b, h) do { _Pragma("unroll") for (int n = 0; n < 2; ++n) _Pragma("unroll") for (int k = 0; k < 2; ++k) dst[n][k] = *(const PG8_LAS bf16x8*)(lds + PG8_SB(b, h) + boff + n * 2048 + k * 1024); } while (0)
#define PG8_MMA(ai, bj, At, Bt) do { __builtin_amdgcn_s_setprio(1); _Pragma("unroll") for (int m = 0; m < 4; ++m) _Pragma("unroll") for (int n = 0; n < 2; ++n) _Pragma("unroll") for (int k = 0; k < 2; ++k) \
        mma16(acc[ai][bj][m][n], Bt[n][k], At[m][k]); __builtin_amdgcn_s_setprio(0); } while (0)
#define PG8_WAIT_V(n) asm volatile("s_waitcnt vmcnt(" #n ")" ::: "memory")
#define PG8_WAIT_L(n) asm volatile("s_waitcnt lgkmcnt(" #n ")" ::: "memory")
#define PG8_BAR __builtin_amdgcn_s_barrier()
#define PG8_SCHED __builtin_amdgcn_sched_barrier(0)
    Unit cur, nxt; int ui = 0;
    if (!S.next(0, cur)) return;
    typedef typename AccOf<EB>::type acc_t; acc_t acc[2][2][4][2];
#pragma unroll
    for (int a = 0; a < 2; ++a)
#pragma unroll
        for (int b = 0; b < 2; ++b)
#pragma unroll
            for (int m = 0; m < 4; ++m)
#pragma unroll
                for (int n = 0; n < 2; ++n) acc[a][b][m][n] = acc_t{};
    bf16x8 At[4][2], B0[2][2], B1[2][2];
    const __amdgpu_buffer_rsrc_t rA = __builtin_amdgcn_make_buffer_rsrc((void*)g.A, (short)0, -1, 0x00020000), rB = __builtin_amdgcn_make_buffer_rsrc((void*)g.Bt, (short)0, -1, 0x00020000);
    unsigned cA = (unsigned)cur.pm * tstep, cB = (unsigned)cur.pn * tstep;
    S.a_ready(cur);
    if constexpr (SP2) {
        PG8_STAGE(PG8_SB(0, 0), rB, cB, voffB); PG8_STAGE(PG8_SB(0, 1), rB, cB + hstep, voffB); PG8_STAGE(PG8_SA(0, 0), rA, cA, voffA); PG8_STAGE(PG8_SA(0, 1), rA, cA + hstep, voffA);
        if (wr == 1) PG8_BAR;
        PG8_WAIT_V(2); PG8_BAR;
        PG8_STAGE(PG8_SB(1, 0), rB, cB + kstep, voffB); PG8_STAGE(PG8_SA(1, 0), rA, cA + kstep, voffA); PG8_STAGE(PG8_SB(1, 1), rB, cB + hstep + kstep, voffB);
        PG8_WAIT_V(6); PG8_BAR;
    } else {
        PG8_STAGE(PG8_SB(0, 0), rB, cB, voffB); PG8_STAGE(PG8_SA(0, 0), rA, cA, voffA); PG8_STAGE(PG8_SB(0, 1), rB, cB + hstep, voffB); PG8_STAGE(PG8_SA(0, 1), rA, cA + hstep, voffA);
        if (wr == 1) PG8_BAR;
        PG8_WAIT_V(4); PG8_BAR;
        PG8_STAGE(PG8_SB(1, 0), rB, cB + kstep, voffB); PG8_STAGE(PG8_SA(1, 0), rA, cA + kstep, voffA); PG8_STAGE(PG8_SB(1, 1), rB, cB + hstep + kstep, voffB);
        PG8_WAIT_V(6); PG8_BAR;
    }
    for (;;) {
        const bool has_next = S.next(ui + 1, nxt);
        const unsigned nA = has_next ? (unsigned)nxt.pm * tstep : cA, nB = has_next ? (unsigned)nxt.pn * tstep : cB;
        for (int t = 0; t < nt; t += 2) {
            const bool last = (t == nt - 2);
            const unsigned a1 = cA + (unsigned)(t + 1) * kstep;
            const unsigned a2 = last ? nA : cA + (unsigned)(t + 2) * kstep, b2 = last ? nB : cB + (unsigned)(t + 2) * kstep;
            const unsigned a3 = a2 + kstep, b3 = b2 + kstep;
            if (last && has_next) S.a_ready(nxt);
            if constexpr (SP2) {
            PG8_LDB(B0, 0, 0); PG8_LDB(B1, 0, 1); PG8_SCHED; PG8_LDA(At, 0, 0); PG8_STAGE(PG8_SA(1, 1), rA, a1 + hstep, voffA);
            PG8_WAIT_V(8); PG8_WAIT_L(0); PG8_BAR; PG8_MMA(0, 0, At, B0); PG8_MMA(0, 1, At, B1); PG8_BAR; PG8_SCHED;
            PG8_LDA(At, 0, 1); PG8_STAGE(PG8_SB(0, 0), rB, b2, voffB); PG8_STAGE(PG8_SB(0, 1), rB, b2 + hstep, voffB); PG8_STAGE(PG8_SA(0, 0), rA, a2, voffA);
            PG8_WAIT_V(8); PG8_WAIT_L(0); PG8_BAR; PG8_MMA(1, 0, At, B0); PG8_MMA(1, 1, At, B1); PG8_BAR; PG8_SCHED;
            PG8_LDB(B0, 1, 0); PG8_LDB(B1, 1, 1); PG8_SCHED; PG8_LDA(At, 1, 0); PG8_STAGE(PG8_SA(0, 1), rA, a2 + hstep, voffA);
            PG8_WAIT_V(8); PG8_WAIT_L(0); PG8_BAR; PG8_MMA(0, 0, At, B0); PG8_MMA(0, 1, At, B1); PG8_BAR; PG8_SCHED;
            PG8_LDA(At, 1, 1); PG8_STAGE(PG8_SB(1, 0), rB, b3, voffB); PG8_STAGE(PG8_SB(1, 1), rB, b3 + hstep, voffB); PG8_STAGE(PG8_SA(1, 0), rA, a3, voffA);
            PG8_WAIT_V(8); PG8_WAIT_L(0); PG8_BAR; PG8_MMA(1, 0, At, B0); PG8_MMA(1, 1, At, B1); PG8_BAR; PG8_SCHED;
            } else {
            PG8_LDB(B0, 0, 0); PG8_SCHED; PG8_LDA(At, 0, 0); PG8_STAGE(PG8_SA(1, 1), rA, a1 + hstep, voffA);
            PG8_WAIT_L(8); PG8_BAR; PG8_WAIT_L(0); PG8_MMA(0, 0, At, B0); PG8_BAR; PG8_SCHED;
            PG8_LDB(B1, 0, 1); PG8_STAGE(PG8_SB(0, 0), rB, b2, voffB);
            PG8_BAR; PG8_WAIT_L(0); PG8_MMA(0, 1, At, B1); PG8_BAR;
            PG8_LDA(At, 0, 1); PG8_STAGE(PG8_SA(0, 0), rA, a2, voffA);
            PG8_BAR; PG8_WAIT_L(0); PG8_MMA(1, 0, At, B0); PG8_BAR; PG8_SCHED;
            PG8_STAGE(PG8_SB(0, 1), rB, b2 + hstep, voffB);
            PG8_WAIT_V(6); PG8_BAR; PG8_MMA(1, 1, At, B1); PG8_BAR;
            PG8_LDB(B0, 1, 0); PG8_SCHED; PG8_LDA(At, 1, 0); PG8_STAGE(PG8_SA(0, 1), rA, a2 + hstep, voffA);
            PG8_WAIT_L(8); PG8_BAR; PG8_WAIT_L(0); PG8_MMA(0, 0, At, B0); PG8_BAR; PG8_SCHED;
            PG8_LDB(B1, 1, 1); PG8_STAGE(PG8_SB(1, 0), rB, b3, voffB);
            PG8_BAR; PG8_WAIT_L(0); PG8_MMA(0, 1, At, B1); PG8_BAR;
            PG8_LDA(At, 1, 1); PG8_STAGE(PG8_SA(1, 0), rA, a3, voffA);
            PG8_BAR; PG8_WAIT_L(0); PG8_MMA(1, 0, At, B0); PG8_BAR; PG8_SCHED;
            PG8_STAGE(PG8_SB(1, 1), rB, b3 + hstep, voffB);
            PG8_WAIT_V(6); PG8_BAR; PG8_MMA(1, 1, At, B1); PG8_BAR;
            }
        }
        if constexpr (ALIGN_EPI) { if (wr == 0) PG8_BAR; }
        if constexpr (!Epi::AFTER_DRAIN) { int ln_ = (int)__builtin_amdgcn_mbcnt_hi(~0u, __builtin_amdgcn_mbcnt_lo(~0u, 0u)); asm volatile("" : "+v"(ln_));
            E(acc, cur, wr, wc, ln_ & 15, ln_ >> 4); S.done(cur); }
        if (!has_next) break;
#pragma unroll
        for (int a = 0; a < 2; ++a)
#pragma unroll
            for (int b = 0; b < 2; ++b)
#pragma unroll
                for (int m = 0; m < 4; ++m)
#pragma unroll
                    for (int n = 0; n < 2; ++n) acc[a][b][m][n] = acc_t{};
        cur = nxt; cA = nA; cB = nB; ++ui;
        if constexpr (ALIGN_EPI) { if (wr == 1) PG8_BAR; }
    }
    PG8_WAIT_V(0);
    if constexpr (!ALIGN_EPI) { if (wr == 0) PG8_BAR; }
    PG8_BAR;
    if constexpr (Epi::AFTER_DRAIN) { E.fused(acc, cur, wr, wc, fr, fq, lds, wid, lane); S.done(cur); }
#undef PG8_SA
#undef PG8_SB
#undef PG8_STAGE
#undef PG8_LDA
#undef PG8_LDB
#undef PG8_MMA
#undef PG8_WAIT_V
#undef PG8_WAIT_L
#undef PG8_BAR
#undef PG8_SCHED
}
template <class Epi, class Sched, bool ALIGN_EPI = false, bool SP2 = false>
__device__ __forceinline__ void gemm_phase_f8(PG8_LAS unsigned char* lds, const Gemm g, const Sched& S, const Epi& E) {
    int tid_ = threadIdx.x; asm volatile("" : "+v"(tid_));
    const int tid = tid_, wid = __builtin_amdgcn_readfirstlane(tid >> 6), lane = tid & 63, wr = wid >> 2, wc = wid & 3, fr = lane & 15, fq = lane >> 4;
    const int K = g.K, nt = K / (2 * BK);
    unsigned voffA[2], voffB[2];
#pragma unroll
    for (int i = 0; i < 2; ++i) { int R, C; stage_rc(tid * 16 + i * 8192, R, C); const int Rb = Epi::PERM ? ((R & ~31) + perm32(R & 31)) : R;
        voffA[i] = (unsigned)(R * K + 2 * C); voffB[i] = (unsigned)(Rb * K + 2 * C); }
    const unsigned kstep = (unsigned)(BK * 2);
    const unsigned hstep = (unsigned)HALF * K;
    const unsigned tstep = 2 * hstep;
    const unsigned ldsw = (unsigned)wid * 1024u;
    const int aoff = lds_byte(wr * 64 + fr, fq * 16) ^ ((fq & 1) << 4), boff = lds_byte(wc * 32 + fr, fq * 16) ^ ((fq & 1) << 4), aoff2 = aoff ^ 16, boff2 = boff ^ 16;
#define PG8_SA(b, h) (((b) * 2 + (h)) * HTB)
#define PG8_SB(b, h) ((4 + (b) * 2 + (h)) * HTB)
#define PG8_STAGE(bufoff, rsrc, soff, voff) do { _Pragma("unroll") for (int _i = 0; _i < 2; ++_i) \
        __builtin_amdgcn_raw_ptr_buffer_load_lds(rsrc, (PG8_LAS void*)(lds + (bufoff) + ldsw + _i * 8192), 16, (int)(voff)[_i], (int)(soff), 0, 0); } while (0)
#define PG8_LDA(dst, b, h) do { _Pragma("unroll") for (int m = 0; m < 4; ++m) { const i32x4_t lo_ = *(const PG8_LAS i32x4_t*)(lds + PG8_SA(b, h) + aoff + m * 2048), hi_ = *(const PG8_LAS i32x4_t*)(lds + PG8_SA(b, h) + aoff2 + m * 2048); dst[m] = __builtin_shufflevector(lo_, hi_, 0, 1, 2, 3, 4, 5, 6, 7); } } while (0)
#define PG8_LDB(dst, b, h) do { _Pragma("unroll") for (int n = 0; n < 2; ++n) { const i32x4_t lo_ = *(const PG8_LAS i32x4_t*)(lds + PG8_SB(b, h) + boff + n * 2048), hi_ = *(const PG8_LAS i32x4_t*)(lds + PG8_SB(b, h) + boff2 + n * 2048); dst[n] = __builtin_shufflevector(lo_, hi_, 0, 1, 2, 3, 4, 5, 6, 7); } } while (0)
#define PG8_F8CAT(lo, hi) __builtin_shufflevector(__builtin_bit_cast(i32x4_t, lo), __builtin_bit_cast(i32x4_t, hi), 0, 1, 2, 3, 4, 5, 6, 7)
#define PG8_MMA(ai, bj, At, Bt) do { __builtin_amdgcn_s_setprio(1); _Pragma("unroll") for (int m = 0; m < 4; ++m) _Pragma("unroll") for (int n = 0; n < 2; ++n) \
        acc[ai][bj][m][n] = __builtin_amdgcn_mfma_scale_f32_16x16x128_f8f6f4(Bt[n], At[m], acc[ai][bj][m][n], 0, 0, 0, 0, 0, 0); __builtin_amdgcn_s_setprio(0); } while (0)
#define PG8_WAIT_V(n) asm volatile("s_waitcnt vmcnt(" #n ")" ::: "memory")
#define PG8_WAIT_L(n) asm volatile("s_waitcnt lgkmcnt(" #n ")" ::: "memory")
#define PG8_BAR __builtin_amdgcn_s_barrier()
#define PG8_SCHED __builtin_amdgcn_sched_barrier(0)
    Unit cur, nxt; int ui = 0;
    if (!S.next(0, cur)) return;
    f32x4 acc[2][2][4][2];
#pragma unroll
    for (int a = 0; a < 2; ++a)
#pragma unroll
        for (int b = 0; b < 2; ++b)
#pragma unroll
            for (int m = 0; m < 4; ++m)
#pragma unroll
                for (int n = 0; n < 2; ++n) acc[a][b][m][n] = (f32x4){0.f, 0.f, 0.f, 0.f};
    i32x8_t At[4], B0[2], B1[2];
    const __amdgpu_buffer_rsrc_t rA = __builtin_amdgcn_make_buffer_rsrc((void*)g.A, (short)0, -1, 0x00020000), rB = __builtin_amdgcn_make_buffer_rsrc((void*)g.Bt, (short)0, -1, 0x00020000);
    unsigned cA = (unsigned)cur.pm * tstep, cB = (unsigned)cur.pn * tstep;
    S.a_ready(cur);
    if constexpr (SP2) {
        PG8_STAGE(PG8_SB(0, 0), rB, cB, voffB); PG8_STAGE(PG8_SB(0, 1), rB, cB + hstep, voffB); PG8_STAGE(PG8_SA(0, 0), rA, cA, voffA); PG8_STAGE(PG8_SA(0, 1), rA, cA + hstep, voffA);
        if (wr == 1) PG8_BAR;
        PG8_WAIT_V(2); PG8_BAR;
        PG8_STAGE(PG8_SB(1, 0), rB, cB + kstep, voffB); PG8_STAGE(PG8_SA(1, 0), rA, cA + kstep, voffA); PG8_STAGE(PG8_SB(1, 1), rB, cB + hstep + kstep, voffB);
        PG8_WAIT_V(6); PG8_BAR;
    } else {
        PG8_STAGE(PG8_SB(0, 0), rB, cB, voffB); PG8_STAGE(PG8_SA(0, 0), rA, cA, voffA); PG8_STAGE(PG8_SB(0, 1), rB, cB + hstep, voffB); PG8_STAGE(PG8_SA(0, 1), rA, cA + hstep, voffA);
        if (wr == 1) PG8_BAR;
        PG8_WAIT_V(4); PG8_BAR;
        PG8_STAGE(PG8_SB(1, 0), rB, cB + kstep, voffB); PG8_STAGE(PG8_SA(1, 0), rA, cA + kstep, voffA); PG8_STAGE(PG8_SB(1, 1), rB, cB + hstep + kstep, voffB);
        PG8_WAIT_V(6); PG8_BAR;
    }
    for (;;) {
        const bool has_next = S.next(ui + 1, nxt);
        const unsigned nA = has_next ? (unsigned)nxt.pm * tstep : cA, nB = has_next ? (unsigned)nxt.pn * tstep : cB;
        for (int t = 0; t < nt; t += 2) {
            const bool last = (t == nt - 2);
            const unsigned a1 = cA + (unsigned)(t + 1) * kstep;
            const unsigned a2 = last ? nA : cA + (unsigned)(t + 2) * kstep, b2 = last ? nB : cB + (unsigned)(t + 2) * kstep;
            const unsigned a3 = a2 + kstep, b3 = b2 + kstep;
            if (last && has_next) S.a_ready(nxt);
            if constexpr (SP2) {
            PG8_LDB(B0, 0, 0); PG8_LDB(B1, 0, 1); PG8_SCHED; PG8_LDA(At, 0, 0); PG8_STAGE(PG8_SA(1, 1), rA, a1 + hstep, voffA);
            PG8_WAIT_V(8); PG8_WAIT_L(0); PG8_BAR; PG8_MMA(0, 0, At, B0); PG8_MMA(0, 1, At, B1); PG8_BAR; PG8_SCHED;
            PG8_LDA(At, 0, 1); PG8_STAGE(PG8_SB(0, 0), rB, b2, voffB); PG8_STAGE(PG8_SB(0, 1), rB, b2 + hstep, voffB); PG8_STAGE(PG8_SA(0, 0), rA, a2, voffA);
            PG8_WAIT_V(8); PG8_WAIT_L(0); PG8_BAR; PG8_MMA(1, 0, At, B0); PG8_MMA(1, 1, At, B1); PG8_BAR; PG8_SCHED;
            PG8_LDB(B0, 1, 0); PG8_LDB(B1, 1, 1); PG8_SCHED; PG8_LDA(At, 1, 0); PG8_STAGE(PG8_SA(0, 1), rA, a2 + hstep, voffA);
            PG8_WAIT_V(8); PG8_WAIT_L(0); PG8_BAR; PG8_MMA(0, 0, At, B0); PG8_MMA(0, 1, At, B1); PG8_BAR; PG8_SCHED;
            PG8_LDA(At, 1, 1); PG8_STAGE(PG8_SB(1, 0), rB, b3, voffB); PG8_STAGE(PG8_SB(1, 1), rB, b3 + hstep, voffB); PG8_STAGE(PG8_SA(1, 0), rA, a3, voffA);
            PG8_WAIT_V(8); PG8_WAIT_L(0); PG8_BAR; PG8_MMA(1, 0, At, B0); PG8_MMA(1, 1, At, B1); PG8_BAR; PG8_SCHED;
            } else {
            PG8_LDB(B0, 0, 0); PG8_SCHED; PG8_LDA(At, 0, 0); PG8_STAGE(PG8_SA(1, 1), rA, a1 + hstep, voffA);
            PG8_WAIT_L(8); PG8_BAR; PG8_WAIT_L(0); PG8_MMA(0, 0, At, B0); PG8_BAR; PG8_SCHED;
            PG8_LDB(B1, 0, 1); PG8_STAGE(PG8_SB(0, 0), rB, b2, voffB);
            PG8_BAR; PG8_WAIT_L(0); PG8_MMA(0, 1, At, B1); PG8_BAR;
            PG8_LDA(At, 0, 1); PG8_STAGE(PG8_SA(0, 0), rA, a2, voffA);
            PG8_BAR; PG8_WAIT_L(0); PG8_MMA(1, 0, At, B0); PG8_BAR; PG8_SCHED;
            PG8_STAGE(PG8_SB(0, 1), rB, b2 + hstep, voffB);
            PG8_WAIT_V(6); PG8_BAR; PG8_MMA(1, 1, At, B1); PG8_BAR;
            PG8_LDB(B0, 1, 0); PG8_SCHED; PG8_LDA(At, 1, 0); PG8_STAGE(PG8_SA(0, 1), rA, a2 + hstep, voffA);
            PG8_WAIT_L(8); PG8_BAR; PG8_WAIT_L(0); PG8_MMA(0, 0, At, B0); PG8_BAR; PG8_SCHED;
            PG8_LDB(B1, 1, 1); PG8_STAGE(PG8_SB(1, 0), rB, b3, voffB);
            PG8_BAR; PG8_WAIT_L(0); PG8_MMA(0, 1, At, B1); PG8_BAR;
            PG8_LDA(At, 1, 1); PG8_STAGE(PG8_SA(1, 0), rA, a3, voffA);
            PG8_BAR; PG8_WAIT_L(0); PG8_MMA(1, 0, At, B0); PG8_BAR; PG8_SCHED;
            PG8_STAGE(PG8_SB(1, 1), rB, b3 + hstep, voffB);
            PG8_WAIT_V(6); PG8_BAR; PG8_MMA(1, 1, At, B1); PG8_BAR;
            }
        }
        if constexpr (ALIGN_EPI) { if (wr == 0) PG8_BAR; }
        if constexpr (!Epi::AFTER_DRAIN) { int ln_ = (int)__builtin_amdgcn_mbcnt_hi(~0u, __builtin_amdgcn_mbcnt_lo(~0u, 0u)); asm volatile("" : "+v"(ln_));
            E(acc, cur, wr, wc, ln_ & 15, ln_ >> 4); S.done(cur); }
        if (!has_next) break;
#pragma unroll
        for (int a = 0; a < 2; ++a)
#pragma unroll
            for (int b = 0; b < 2; ++b)
#pragma unroll
                for (int m = 0; m < 4; ++m)
#pragma unroll
                    for (int n = 0; n < 2; ++n) acc[a][b][m][n] = (f32x4){0.f, 0.f, 0.f, 0.f};
        cur = nxt; cA = nA; cB = nB; ++ui;
        if constexpr (ALIGN_EPI) { if (wr == 1) PG8_BAR; }
    }
    PG8_WAIT_V(0);
    if constexpr (!ALIGN_EPI) { if (wr == 0) PG8_BAR; }
    PG8_BAR;
    if constexpr (Epi::AFTER_DRAIN) { E.fused(acc, cur, wr, wc, fr, fq, lds, wid, lane); S.done(cur); }
#undef PG8_SA
#undef PG8_SB
#undef PG8_STAGE
#undef PG8_LDA
#undef PG8_LDB
#undef PG8_MMA
#undef PG8_WAIT_V
#undef PG8_WAIT_L
#undef PG8_BAR
#undef PG8_SCHED
#undef PG8_F8CAT
}
}

constexpr int NWAVES = 8, NTHR = NWAVES * 64;
constexpr int BATCH = 8, SEQ = 2048, DM = 2048, DEPTH = 2, HD = 64, GW = 512, NH = 8;
constexpr int M = BATCH * SEQ;
constexpr int NPROJ = 6080, NPROJ_P = 6144, DFF = 5632;
constexpr int CA_Q = 0, CA_K = 512, CA_V = 1024, CB_U = 1536, CB_V = 2048, CC_Q = 2560, CC_K = 3072, CC_V = 3584, CD = 4096;
constexpr int D_R = 0, D_WD = 512, D_K = 608, D_V = 1120, D_AD = 1632, D_GD = 1728, D_W = 1984;
constexpr float NORM_EPS = 1e-6f;
#ifndef N_LAUNCH_MODE
#define N_LAUNCH_MODE 0
#endif
#ifndef PG8_SP2
#define PG8_SP2 true
#endif
#ifndef FFN_FP8
#define FFN_FP8 1
#endif
#ifndef REPEAT
#define REPEAT 0
#endif
#ifndef GEMM_I8
#define GEMM_I8 3
#endif
#ifndef BFMASK
#define BFMASK 0x003C0Fu
#endif
#define I8_IN ((GEMM_I8 & 1) != 0)
#define I8_OUT ((GEMM_I8 & 2) != 0)
constexpr int N_PHASES = 17;

constexpr size_t MiB = 1u << 20;
constexpr size_t WS_CTL = 0, CTL_ZERO_BYTES = 2 * MiB;
constexpr size_t WS_WIN = 2 * MiB, WS_WOUT = 26 * MiB, WS_WGU = 34 * MiB, WS_WDN = 78 * MiB, WS_SMALL = 100 * MiB;
constexpr size_t WS_XB = 104 * MiB, WS_PROJ = 168 * MiB, WS_YCAT = 360 * MiB, WS_SC2 = 424 * MiB, WS_YD = 456 * MiB, WS_G = 488 * MiB, WS_BC = 504 * MiB, WS_END = 506 * MiB;
constexpr size_t WS_XQ = WS_YD, WS_YQ = WS_PROJ;
constexpr size_t SC_ARR = (size_t)M * GW * 2;
constexpr size_t SM_TB = 0;
constexpr size_t SM_KBAR = 64 * 1024;
constexpr size_t SM_STATS = 256 * 1024;
constexpr size_t SM_SAX = 2048 * 1024, SM_SAY = SM_SAX + 64 * 1024;
constexpr size_t SM_SWIN = SM_SAY + 64 * 1024, SM_SWOUT = SM_SWIN + 32 * 1024;
constexpr size_t SM_WT = 1024 * 1024;
constexpr int CW_BAR = 4096;
constexpr int CW_Q = 8192;
constexpr int CW_SSQ = 65536;
constexpr size_t CTL_KBAR = 1024 * 1024;
constexpr size_t CTL_STATS = 1280 * 1024;
static_assert((size_t)CW_SSQ * 4 + 5 * (size_t)M * 8 <= CTL_KBAR && CTL_STATS + 2 * (size_t)M * 2 * 8 <= CTL_ZERO_BYTES, "CTL");

constexpr int RING_OFF = 0, RING_BYTES = 131072;
constexpr int LDS_BYTES = 163840, MISC_OFF = LDS_BYTES - 256;

#define GAS __attribute__((address_space(1)))
#define LAS __attribute__((address_space(3)))
typedef unsigned short bf16;
typedef unsigned v4u __attribute__((ext_vector_type(4)));
typedef unsigned v2u __attribute__((ext_vector_type(2)));
typedef float f32x4 __attribute__((ext_vector_type(4)));
typedef short bf16x8 __attribute__((ext_vector_type(8)));
typedef float f32x16 __attribute__((ext_vector_type(16)));
typedef GAS unsigned gu32;
#define RLX_AGENT __ATOMIC_RELAXED, __HIP_MEMORY_SCOPE_AGENT
#define LDS_WAIT() asm volatile("s_waitcnt lgkmcnt(0)" ::: "memory")
#define VM_WAIT() asm volatile("s_waitcnt vmcnt(0)" ::: "memory")
__device__ __forceinline__ unsigned f2bf(float f) { unsigned u = __builtin_bit_cast(unsigned, f); return (u + 0x7fffu + ((u >> 16) & 1u)) >> 16; }
__device__ __forceinline__ unsigned pk2(float lo, float hi) { return f2bf(lo) | (f2bf(hi) << 16); }
__device__ __forceinline__ float bf2f(unsigned short h) { return __builtin_bit_cast(float, (unsigned)h << 16); }
__device__ __forceinline__ float bflo(unsigned w) { return __builtin_bit_cast(float, w << 16); }
__device__ __forceinline__ float bfhi(unsigned w) { return __builtin_bit_cast(float, w & 0xffff0000u); }
__device__ __forceinline__ float sigmoidf_(float x) { return 1.0f / (1.0f + __expf(-x)); }
__device__ __forceinline__ float gelu_tanh(float x) { const float u = 0.7978845608028654f * (x + 0.044715f * x * x * x); const float e = __expf(2.0f * u); const float th = 1.0f - 2.0f / (e + 1.0f); return 0.5f * x * (1.0f + th); }
__device__ __forceinline__ float wave_sum(float v) {
#pragma unroll
    for (int o = 1; o < 64; o <<= 1) v += __shfl_xor(v, o);
    return v;
}

__device__ __forceinline__ float zero_v() { float z = 0.f; asm volatile("" : "+v"(z)); return z; }

__device__ __forceinline__ unsigned q8pack4(float a, float b, float c, float d, float inv) {
    const int ia = (int)__builtin_rintf(a * inv), ib = (int)__builtin_rintf(b * inv), ic = (int)__builtin_rintf(c * inv), id = (int)__builtin_rintf(d * inv);
    return ((unsigned)ia & 0xffu) | (((unsigned)ib & 0xffu) << 8) | (((unsigned)ic & 0xffu) << 16) | ((unsigned)id << 24); }
__device__ __forceinline__ float wave_max(float v) {
#pragma unroll
    for (int o = 1; o < 64; o <<= 1) v = fmaxf(v, __shfl_xor(v, o));
    return v;
}
#define UNPACK8(dst, o, W_) do { dst[(o)] = bflo((W_).x); dst[(o) + 1] = bfhi((W_).x); dst[(o) + 2] = bflo((W_).y); dst[(o) + 3] = bfhi((W_).y); dst[(o) + 4] = bflo((W_).z); dst[(o) + 5] = bfhi((W_).z); dst[(o) + 6] = bflo((W_).w); dst[(o) + 7] = bfhi((W_).w); } while (0)
#define XB_TMO      128
#define XB_XCNT(j)  (256  + 64 * (j))
#define XB_XSUB(j)  (1280 + 64 * (j))
#define XB_XGEN(j)  (2304 + 64 * (j))
#define XB_TOP      3328
#define XB_TOPGEN   3392
#define XCD_BAR_WORDS 3456
#define XB_SPIN_CAP (1u << 18)

__device__ __forceinline__ unsigned xb_ld(unsigned* p)              { return __hip_atomic_load(p, __ATOMIC_RELAXED, __HIP_MEMORY_SCOPE_AGENT); }
__device__ __forceinline__ unsigned xb_add(unsigned* p, unsigned v) { return __hip_atomic_fetch_add(p, v, __ATOMIC_RELAXED, __HIP_MEMORY_SCOPE_AGENT); }
__device__ __forceinline__ unsigned xb_xcc_id() { return (unsigned)__builtin_amdgcn_s_getreg((3 << 11) | 20) & 0xFu; }
#define XB_SPIN(cond, bar) do { unsigned _sp = 0; while (cond) { __builtin_amdgcn_s_sleep(1); \
    if ((++_sp & 255u) == 0u) { if (xb_ld(&(bar)[XB_TMO])) break; if (_sp > XB_SPIN_CAP) { atomicAdd(&(bar)[XB_TMO], 1u); break; } } } } while (0)

struct XcdBarrier {
    unsigned* bar; unsigned x;
    volatile LAS unsigned* st;
};

__device__ __forceinline__ XcdBarrier xcd_barrier_post(unsigned* bar, volatile LAS unsigned* st) {
    XcdBarrier b; b.bar = bar; b.x = xb_xcc_id(); b.st = st;
    if (threadIdx.x == 0) (void)xb_add(&bar[XB_XCNT(b.x)], 1u);
    return b;
}
__device__ __forceinline__ void xcd_barrier_complete(unsigned* bar, unsigned x, unsigned& nloc, unsigned& nx) {
    const unsigned G = gridDim.x * gridDim.y * gridDim.z;
    unsigned sum, cnt, mine, sp = 0u;
    for (;;) {
        sum = 0u; cnt = 0u; mine = 0u;
#pragma unroll
        for (unsigned j = 0; j < 16; ++j) { const unsigned c = xb_ld(&bar[XB_XCNT(j)]); sum += c; cnt += (c > 0u) ? 1u : 0u; mine = (j == x) ? c : mine; }
        if (sum == G) break;
        __builtin_amdgcn_s_sleep(1);
        if ((++sp & 255u) == 0u) { if (xb_ld(&bar[XB_TMO])) break; if (sp > XB_SPIN_CAP) { atomicAdd(&bar[XB_TMO], 1u); break; } }
    }
    nloc = mine > 0u ? mine : 1u; nx = cnt > 0u ? cnt : 1u;
}

__device__ __forceinline__ void xcd_barrier(const XcdBarrier& b) {
    asm volatile("s_waitcnt vmcnt(0)" ::: "memory");
    __syncthreads();
    if (threadIdx.x == 0) {
        unsigned* bar = b.bar;
        __builtin_amdgcn_s_waitcnt(0);
        unsigned nloc = b.st[0], nx = b.st[1];
        if (nloc == 0u) { xcd_barrier_complete(bar, b.x, nloc, nx); b.st[0] = nloc; b.st[1] = nx; }
        const unsigned old = xb_add(&bar[XB_XSUB(b.x)], 1u);
        const unsigned gen = old / nloc;
        if (old + 1u == (gen + 1u) * nloc) {
            __builtin_amdgcn_fence(__ATOMIC_RELEASE, "agent");
            asm volatile("s_waitcnt vmcnt(0)" ::: "memory");
            const unsigned og = xb_add(&bar[XB_TOP], 1u);
            const unsigned tg = og / nx;
            if (og + 1u == (tg + 1u) * nx) xb_add(&bar[XB_TOPGEN], 1u);
            else XB_SPIN(xb_ld(&bar[XB_TOPGEN]) == tg, bar);
            __builtin_amdgcn_fence(__ATOMIC_ACQUIRE, "agent");
            xb_add(&bar[XB_XGEN(b.x)], 1u);
            asm volatile("s_waitcnt vmcnt(0)" ::: "memory");
        } else {
            XB_SPIN(xb_ld(&bar[XB_XGEN(b.x)]) == gen, bar);
            __builtin_amdgcn_fence(__ATOMIC_ACQUIRE, "agent");
            asm volatile("s_waitcnt vmcnt(0)" ::: "memory");
        }
    }
    __syncthreads();
}

struct Args { const float* in[25]; float* out; unsigned char* ws; int ph_lo, ph_hi; };
struct Frame {
    LAS unsigned char* lds; int tid, lane, wave, G, vcu, gw, ngw;
};
typedef const __attribute__((address_space(4))) unsigned long long* karg_t;
__device__ __forceinline__ karg_t kargs() { karg_t ka = (karg_t)__builtin_amdgcn_kernarg_segment_ptr(); asm volatile("" : "+s"(ka)); return ka; }
__device__ __forceinline__ const float* inp(int i) { return (const float*)(const GAS float*)kargs()[i]; }
__device__ __forceinline__ float* outp() { return (float*)(GAS float*)kargs()[25]; }
__device__ __forceinline__ unsigned char* wsp() { return (unsigned char*)(GAS unsigned char*)kargs()[26]; }
__device__ __forceinline__ gu32* ctlp() { return (gu32*)(wsp() + WS_CTL); }

__device__ __forceinline__ void conv_item(const float* W, int K, int N, const float* g, bf16* WT, int kind, LAS float* scr, int item, int lane, int ncols = 0) {
    const int nblk = (ncols ? ncols : N) / 32, kb = item / nblk, nb = item % nblk, k0 = 64 * kb, n0 = 32 * nb;
    float ld[32];
    { const float* wp = W + (size_t)(k0 + (lane >> 5)) * N + n0 + (lane & 31);
#pragma unroll
      for (int i = 0; i < 32; ++i) ld[i] = wp[(size_t)(2 * i) * N]; }
    if (g) { const float* gp = g + k0 + (lane >> 5);
#pragma unroll
      for (int i = 0; i < 32; ++i) ld[i] *= gp[2 * i]; }
#pragma unroll
    for (int i = 0; i < 32; ++i) scr[(2 * i + (lane >> 5)) * 33 + (lane & 31)] = ld[i];
    LDS_WAIT(); asm volatile("" ::: "memory");
    const int c = lane & 7;
#pragma unroll
    for (int j = 0; j < 4; ++j) { const int n = (lane >> 3) + 8 * j; const LAS float* s = scr + (8 * c) * 33 + n;
        v4u o; o.x = pk2(s[0 * 33], s[1 * 33]); o.y = pk2(s[2 * 33], s[3 * 33]); o.z = pk2(s[4 * 33], s[5 * 33]); o.w = pk2(s[6 * 33], s[7 * 33]);
        const int nn = n0 + n;
        if (kind >= 3) {
            const int row = kind == 5 ? nn : ((nn >> 7) * 256 + (kind - 3) * 128 + (nn & 127)); int f0 = (int)o.x, f1 = (int)o.y;
            f0 = __builtin_amdgcn_cvt_pk_fp8_f32(64.f * s[0 * 33], 64.f * s[1 * 33], f0, false); f0 = __builtin_amdgcn_cvt_pk_fp8_f32(64.f * s[2 * 33], 64.f * s[3 * 33], f0, true);
            f1 = __builtin_amdgcn_cvt_pk_fp8_f32(64.f * s[4 * 33], 64.f * s[5 * 33], f1, false); f1 = __builtin_amdgcn_cvt_pk_fp8_f32(64.f * s[6 * 33], 64.f * s[7 * 33], f1, true);
            *(GAS v2u*)((unsigned char*)WT + (size_t)row * K + k0 + 8 * c) = (v2u){(unsigned)f0, (unsigned)f1};
        } else {
        const int row = kind == 0 ? nn : ((nn >> 7) * 256 + (kind - 1) * 128 + (nn & 127));
        *(GAS v4u*)(WT + (size_t)row * K + k0 + 8 * c) = o; } }
    LDS_WAIT(); asm volatile("" ::: "memory");
}
__device__ __forceinline__ void conv_cols_i8(const float* W, int K, int N, const float* g, unsigned char* WQ, float* SW, int nb, Frame& F) {
    LAS float* scr = (LAS float*)(F.lds + RING_OFF + F.wave * 16384); LAS float* red = (LAS float*)(F.lds + RING_OFF + 131072);
    const int n0 = 32 * nb, lane = F.lane, nkb = K / 64;
    const float* wp0 = W + (size_t)(lane >> 5) * N + n0 + (lane & 31);
    float mx = 0.f;
    for (int kb = F.wave; kb < nkb; kb += NWAVES) {
        const float* wp = wp0 + (size_t)(64 * kb) * N; const float* gp = g + 64 * kb + (lane >> 5);
        float ld[32];
#pragma unroll
        for (int i = 0; i < 32; ++i) ld[i] = wp[(size_t)(2 * i) * N];
#pragma unroll
        for (int i = 0; i < 32; ++i) mx = fmaxf(mx, fabsf(ld[i] * gp[2 * i]));
    }
    mx = fmaxf(mx, __shfl_xor(mx, 32));
    if (lane < 32) red[F.wave * 32 + lane] = mx;
    __syncthreads();
    float cm = 0.f;
#pragma unroll
    for (int w = 0; w < NWAVES; ++w) cm = fmaxf(cm, red[w * 32 + (lane & 31)]);
    const float inv = cm > 0.f ? 127.0f / cm : 0.f;
    if (F.wave == 0 && lane < 32) SW[n0 + lane] = cm * (1.0f / 127.0f);
    for (int kb = F.wave; kb < nkb; kb += NWAVES) {
        const float* wp = wp0 + (size_t)(64 * kb) * N; const float* gp = g + 64 * kb + (lane >> 5);
        float ld[32];
#pragma unroll
        for (int i = 0; i < 32; ++i) ld[i] = wp[(size_t)(2 * i) * N];
#pragma unroll
        for (int i = 0; i < 32; ++i) scr[(2 * i + (lane >> 5)) * 33 + (lane & 31)] = ld[i] * gp[2 * i] * inv;
        LDS_WAIT(); asm volatile("" ::: "memory");
        const int c = lane & 7;
#pragma unroll
        for (int j = 0; j < 4; ++j) { const int n = (lane >> 3) + 8 * j; const LAS float* q = scr + (8 * c) * 33 + n;
            *(GAS v2u*)(WQ + (size_t)(n0 + n) * K + 64 * kb + 8 * c) = (v2u){q8pack4(q[0 * 33], q[1 * 33], q[2 * 33], q[3 * 33], 1.0f), q8pack4(q[4 * 33], q[5 * 33], q[6 * 33], q[7 * 33], 1.0f)}; }
        LDS_WAIT(); asm volatile("" ::: "memory");
    }
    __syncthreads();
}
__device__ __forceinline__ void conv_layer_items(Frame& F, int l, int gw, int ngw, bool do_in, bool do_rest) {
    LAS float* scr = (LAS float*)(F.lds + RING_OFF + F.wave * 16384);
    constexpr int I_IN = (DM / 64) * (NPROJ / 32), I_OUT = (DM / 64) * (DM / 32), I_G = (DM / 64) * (DFF / 32), I_D = (DFF / 64) * (DM / 32);
    const float* w_in = inp(2) + (size_t)l * DM * NPROJ; const float* w_out = inp(19) + (size_t)l * DM * DM;
    const float* w_g = inp(21) + (size_t)l * DM * DFF; const float* w_u = inp(22) + (size_t)l * DM * DFF; const float* w_d = inp(23) + (size_t)l * DFF * DM;
    const float* g_mix = inp(1) + l * DM; const float* g_br = inp(18) + l * DM; const float* g_ffn = inp(20) + l * DM;
    bf16* WIN = (bf16*)(wsp() + WS_WIN); bf16* WOUT = (bf16*)(wsp() + WS_WOUT); bf16* WGU = (bf16*)(wsp() + WS_WGU); bf16* WDN = (bf16*)(wsp() + WS_WDN);
    if (do_in) {
        for (int it = gw; it < I_IN; it += ngw) conv_item(w_in, DM, NPROJ, g_mix, WIN, 0, scr, it, F.lane);
    }
    if (do_rest) {
        for (int it = gw; it < (I8_OUT ? 0 : I_OUT) + 2 * I_G + I_D; it += ngw) {
            int r = it + (I8_OUT ? I_OUT : 0);
            if (r < I_OUT) { conv_item(w_out, DM, DM, g_br, WOUT, 0, scr, r, F.lane); continue; } r -= I_OUT;
            if (r < I_G) { conv_item(w_g, DM, DFF, g_ffn, WGU, FFN_FP8 ? 3 : 1, scr, r, F.lane); continue; } r -= I_G;
            if (r < I_G) { conv_item(w_u, DM, DFF, g_ffn, WGU, FFN_FP8 ? 4 : 2, scr, r, F.lane); continue; } r -= I_G;
            conv_item(w_d, DFF, DM, nullptr, WDN, FFN_FP8 ? 5 : 0, scr, r, F.lane);
        }
    }
}

constexpr int WINB_NB = 8 * __builtin_popcount(BFMASK), WINB_ITEMS = (DM / 64) * WINB_NB;
__device__ __forceinline__ bf16* winb_ptr() { return (bf16*)outp() + (size_t)6 * M * GW; }
__device__ __forceinline__ void conv_winb(Frame& F, int l, int item) {
    if (item >= WINB_ITEMS) return;
    const int kb = item / WINB_NB, r = item % WINB_NB; unsigned m = BFMASK; for (int j = 0; j < (r >> 3); ++j) m &= m - 1;
    conv_item(inp(2) + (size_t)l * DM * NPROJ, DM, NPROJ, inp(1) + l * DM, winb_ptr(), 0, (LAS float*)(F.lds + RING_OFF + F.wave * 16384), kb * (NPROJ / 32) + __builtin_ctz(m) * 8 + (r & 7), F.lane);
}
__device__ __forceinline__ void ph_prologue(Frame& F) {
    if (I8_IN) {
        for (int nb = blockIdx.x; nb < NPROJ / 32; nb += F.G) conv_cols_i8(inp(2), DM, NPROJ, inp(1), wsp() + WS_WIN, (float*)(wsp() + WS_SMALL + SM_SWIN), nb, F);
        unsigned char* WIN = wsp() + WS_WIN; float* SWIN = (float*)(wsp() + WS_SMALL + SM_SWIN);
        for (int i = F.gw * 64 + F.lane; i < 64 * DM / 16; i += F.ngw * 64) *(GAS v4u*)(WIN + (size_t)NPROJ * DM + (size_t)i * 16) = (v4u){0u, 0u, 0u, 0u};
        if (blockIdx.x == 0 && F.tid < NPROJ_P - NPROJ) SWIN[NPROJ + F.tid] = 0.f;
        for (int it = F.gw; it < WINB_ITEMS; it += F.ngw) conv_winb(F, 0, it);
    } else {
    conv_layer_items(F, 0, F.gw, F.ngw, true, false);
    { bf16* WIN = (bf16*)(wsp() + WS_WIN);
      for (int i = F.gw * 64 + F.lane; i < 64 * DM / 8; i += F.ngw * 64) *(GAS v4u*)(WIN + (size_t)NPROJ * DM + (size_t)i * 8) = (v4u){0u, 0u, 0u, 0u}; } }
    if (blockIdx.x == 0) {
        int* TB = (int*)(wsp() + WS_SMALL + SM_TB);
        for (int d = F.tid; d < 2049; d += NTHR) {
            int bkt = d;
            if (d >= 16) bkt = 16 + (d >= 22) + (d >= 30) + (d >= 40) + (d >= 54) + (d >= 73) + (d >= 99) + (d >= 134) + (d >= 182) + (d >= 246) + (d >= 332) + (d >= 450) + (d >= 609) + (d >= 825) + (d >= 1117) + (d >= 1513);
            TB[d] = bkt;
        }
    }
    { bf16* WT = (bf16*)(wsp() + WS_SMALL + SM_WT); const float* w2 = inp(9); const float* a2 = inp(11); const float* g2 = inp(12);
      for (int idx = blockIdx.x * NTHR + F.tid; idx < DEPTH * 448 * GW; idx += F.G * NTHR) {
          const int c = idx % GW, k = (idx / GW) % 448, l = idx / (GW * 448);
          const float v = k < 96 ? w2[((size_t)l * 96 + k) * GW + c] : (k < 192 ? a2[((size_t)l * 96 + (k - 96)) * GW + c] : g2[((size_t)l * 256 + (k - 192)) * GW + c]);
          const int r32_ = c & 31, hct = c >> 5, ks_ = k >> 4, hh_ = (k >> 3) & 1;
          WT[(size_t)l * GW * 448 + (((size_t)hct * 28 + ks_) * 64 + 32 * hh_ + r32_) * 8 + (k & 7)] = (bf16)f2bf(v); } }
    const float* x = inp(0); bf16* XB = (bf16*)(wsp() + WS_XB); pg8::fx_t* ssq = (pg8::fx_t*)(ctlp() + CW_SSQ);
    for (int m = F.gw; m < M; m += F.ngw) {
        const GAS f32x4* xr = (const GAS f32x4*)(x + (size_t)m * DM) + F.lane; GAS v2u* o = (GAS v2u*)(XB + (size_t)m * DM) + F.lane; float s = 0.f;
#pragma unroll
        for (int j = 0; j < 8; ++j) { const f32x4 v = xr[64 * j]; s += (v.x * v.x + v.y * v.y) + (v.z * v.z + v.w * v.w); o[64 * j] = (v2u){pk2(v.x, v.y), pk2(v.z, v.w)}; }
        s = wave_sum(s); if (F.lane == 0) pg8::fx_add(ssq + m, s);
        if (I8_IN) {
            float mx = 0.f;
#pragma unroll
            for (int j = 0; j < 8; ++j) { const f32x4 v = xr[64 * j]; mx = fmaxf(fmaxf(mx, fmaxf(fabsf(v.x), fabsf(v.y))), fmaxf(fabsf(v.z), fabsf(v.w))); }
            mx = wave_max(mx); const float inv = mx > 0.f ? 127.0f / mx : 0.f; GAS unsigned* q = (GAS unsigned*)(wsp() + WS_XQ + (size_t)m * DM) + F.lane;
#pragma unroll
            for (int j = 0; j < 8; ++j) { const f32x4 v = xr[64 * j]; q[64 * j] = q8pack4(v.x, v.y, v.z, v.w, inv); }
            if (F.lane == 0) ((float*)(wsp() + WS_SMALL + SM_SAX))[m] = mx * (1.0f / 127.0f);
        }
    }
}

__device__ __forceinline__ void ph_quantx(Frame& F) {
    const bf16* XB = (const bf16*)(wsp() + WS_XB); unsigned char* XQ = wsp() + WS_XQ; float* SAX = (float*)(wsp() + WS_SMALL + SM_SAX);
    for (int m = F.gw; m < M; m += F.ngw) {
        const GAS v4u* xr = (const GAS v4u*)(XB + (size_t)m * DM) + F.lane; v4u w[4]; float mx = 0.f;
#pragma unroll
        for (int j = 0; j < 4; ++j) w[j] = xr[64 * j];
#pragma unroll
        for (int j = 0; j < 4; ++j) { mx = fmaxf(fmaxf(mx, fmaxf(fabsf(bflo(w[j].x)), fabsf(bfhi(w[j].x)))), fmaxf(fabsf(bflo(w[j].y)), fabsf(bfhi(w[j].y))));
            mx = fmaxf(fmaxf(mx, fmaxf(fabsf(bflo(w[j].z)), fabsf(bfhi(w[j].z)))), fmaxf(fabsf(bflo(w[j].w)), fabsf(bfhi(w[j].w)))); }
        mx = wave_max(mx); const float inv = mx > 0.f ? 127.0f / mx : 0.f; GAS v2u* q = (GAS v2u*)(XQ + (size_t)m * DM) + F.lane;
#pragma unroll
        for (int j = 0; j < 4; ++j) q[64 * j] = (v2u){q8pack4(bflo(w[j].x), bfhi(w[j].x), bflo(w[j].y), bfhi(w[j].y), inv), q8pack4(bflo(w[j].z), bfhi(w[j].z), bflo(w[j].w), bfhi(w[j].w), inv)};
        if (F.lane == 0) SAX[m] = mx * (1.0f / 127.0f);
    }
}

constexpr int PR_PITCH = 912;
constexpr int PR_PRM_OFF = 32768, PR_MUA_OFF = PR_PRM_OFF + 8 * 512 * 4;
__device__ __forceinline__ float fast_tanh(float x) { return 1.0f - 2.0f * __builtin_amdgcn_rcpf(__expf(2.0f * x) + 1.0f); }
__device__ __forceinline__ float fast_sigmoid(float x) { return __builtin_amdgcn_rcpf(1.0f + __expf(-x)); }
constexpr int PR_OT_OFF = 51200, PR_OT_PITCH = 72, PR_OT_TILE = 32 * PR_OT_PITCH, PR_OT_WAVE = 6 * PR_OT_TILE;
static_assert(PR_OT_OFF + 8 * PR_OT_WAVE <= MISC_OFF, "prep LDS");
__device__ __forceinline__ void ph_prep(Frame& F, int l) {
    const bf16* PROJ = (const bf16*)(wsp() + WS_PROJ);
    bf16* R_ = (bf16*)outp();
    bf16* E_ = R_ + (size_t)M * GW; bf16* KP_ = E_ + (size_t)M * GW; bf16* V_ = KP_ + (size_t)M * GW;
    bf16* KK_ = (bf16*)outp() + (size_t)4 * M * GW; bf16* AS_ = KK_ + (size_t)M * GW; bf16* G_ = (bf16*)(wsp() + WS_G); float* BC = (float*)(wsp() + WS_BC);
    const bf16* WT = (const bf16*)(wsp() + WS_SMALL + SM_WT) + (size_t)l * GW * 448;
    LAS unsigned char* actL = F.lds + RING_OFF; LAS float* PRM = (LAS float*)(F.lds + PR_PRM_OFF); LAS float* MUA = (LAS float*)(F.lds + PR_MUA_OFF);
    { const float* mu = inp(7) + l * D_W; const float* w0 = inp(8) + l * GW; const float* a0 = inp(10) + l * GW; const float* k_k = inp(13) + l * GW; const float* k_a = inp(14) + l * GW; const float* r_k = inp(15) + l * GW;
      const int c = F.tid;
      PRM[c] = mu[D_R + c]; PRM[512 + c] = mu[D_K + c]; PRM[1024 + c] = mu[D_V + c]; PRM[1536 + c] = w0[c]; PRM[2048 + c] = a0[c]; PRM[2560 + c] = k_k[c]; PRM[3072 + c] = k_a[c]; PRM[3584 + c] = r_k[c];
      if (c < 448) MUA[c] = mu[c < 96 ? D_WD + c : (c < 192 ? D_AD + (c - 96) : D_GD + (c - 192))]; }
    __syncthreads();
    const int h = F.wave;
    for (int it = blockIdx.x; it < M / 32; it += F.G) {
        const int m0 = it * 32;
        int tid_ = threadIdx.x; asm volatile("" : "+v"(tid_));
        const int tid = tid_, r32 = tid & 31, hh = (tid >> 5) & 1, lane = tid & 63;
        LAS unsigned char* OT = F.lds + PR_OT_OFF + h * PR_OT_WAVE;
        { v2u pc[7], pp[7];
#pragma unroll
          for (int i = 0; i < 7; ++i) { const int gi = tid + NTHR * i, t = gi / 112, k = 4 * (gi % 112), m = m0 + t;
              const int col = k < 96 ? D_WD + k : (k < 192 ? D_AD + (k - 96) : D_GD + (k - 192)); const bf16* src = PROJ + (size_t)m * NPROJ_P + CD + col;
              pc[i] = *(const GAS v2u*)src; pp[i] = (v2u){0u, 0u}; if ((m % SEQ) > 0) pp[i] = *(const GAS v2u*)(src - NPROJ_P); }
#pragma unroll
          for (int i = 0; i < 7; ++i) { const int gi = tid + NTHR * i, t = gi / 112, k = 4 * (gi % 112);
              const f32x4 mv = *(const LAS f32x4*)(MUA + k);
              float x[4] = {bflo(pc[i].x), bfhi(pc[i].x), bflo(pc[i].y), bfhi(pc[i].y)}; const float xp[4] = {bflo(pp[i].x), bfhi(pp[i].x), bflo(pp[i].y), bfhi(pp[i].y)};
#pragma unroll
              for (int e = 0; e < 4; ++e) { x[e] += (xp[e] - x[e]) * mv[e]; x[e] = k < 96 ? fast_tanh(x[e]) : (k < 192 ? x[e] : fast_sigmoid(x[e])); }
              *(LAS v2u*)(actL + t * PR_PITCH + 2 * k) = (v2u){pk2(x[0], x[1]), pk2(x[2], x[3])}; } }
        __syncthreads();
        const int m = m0 + r32; const bool has_prev = (m % SEQ) > 0;
        const bf16* pr = PROJ + (size_t)m * NPROJ_P + CD; const bf16* pq = pr - NPROJ_P;
        const LAS unsigned char* bp = actL + r32 * PR_PITCH + 16 * hh;
        float kkv[2][16]; float n2 = 0.f, bcv = 0.f;
#pragma unroll
        for (int ct = 0; ct < 2; ++ct) {
            const int cb = 64 * h + 32 * ct + 4 * hh;
            v4u xc[3][2], xp[3][2];
#pragma unroll
            for (int a = 0; a < 3; ++a)
#pragma unroll
                for (int i = 0; i < 2; ++i) { const int mm = m0 + (lane >> 2) + 16 * i; const bf16* src = PROJ + (size_t)mm * NPROJ_P + CD + (a == 0 ? D_R : (a == 1 ? D_K : D_V)) + 64 * h + 32 * ct + 8 * (lane & 3);
                    xc[a][i] = *(const GAS v4u*)src; xp[a][i] = (v4u){0u, 0u, 0u, 0u}; if ((mm % SEQ) > 0) xp[a][i] = *(const GAS v4u*)(src - NPROJ_P); }
            f32x16 aW, aA, aG;
            { const float z_ = zero_v();
#pragma unroll
            for (int i = 0; i < 16; ++i) { aW[i] = z_; aA[i] = z_; aG[i] = z_; } }
            const bf16* wt0 = WT + ((size_t)(2 * h + ct) * 28 * 64 + lane) * 8;
#pragma unroll
            for (int grp = 0; grp < 4; ++grp) {
                bf16x8 af[7];
#pragma unroll
                for (int q = 0; q < 7; ++q) af[q] = *(const GAS bf16x8*)(wt0 + 512 * (7 * grp + q));
#pragma unroll
                for (int q = 0; q < 7; ++q) { const int ks = 7 * grp + q; const bf16x8 bfr = *(const LAS bf16x8*)(bp + 32 * ks);
                    if (ks < 6) aW = __builtin_amdgcn_mfma_f32_32x32x16_bf16(af[q], bfr, aW, 0, 0, 0);
                    else if (ks < 12) aA = __builtin_amdgcn_mfma_f32_32x32x16_bf16(af[q], bfr, aA, 0, 0, 0);
                    else aG = __builtin_amdgcn_mfma_f32_32x32x16_bf16(af[q], bfr, aG, 0, 0, 0); }
                asm volatile("" ::: "memory");
            }
            LAS unsigned char* IN = OT + 3 * PR_OT_TILE;
#pragma unroll
            for (int a = 0; a < 3; ++a)
#pragma unroll
                for (int i = 0; i < 2; ++i) { const int cch = 64 * h + 32 * ct + 8 * (lane & 3); const f32x4 m0v = *(const LAS f32x4*)(PRM + a * 512 + cch), m1v = *(const LAS f32x4*)(PRM + a * 512 + cch + 4);
                    float xcu[8], xpu[8]; UNPACK8(xcu, 0, xc[a][i]); UNPACK8(xpu, 0, xp[a][i]); const float mw[8] = {m0v.x, m0v.y, m0v.z, m0v.w, m1v.x, m1v.y, m1v.z, m1v.w};
#pragma unroll
                    for (int e = 0; e < 8; ++e) xcu[e] += (xpu[e] - xcu[e]) * mw[e];
                    LAS unsigned char* dstp = IN + a * PR_OT_TILE + ((lane >> 2) + 16 * i) * PR_OT_PITCH + 16 * (lane & 3);
                    *(LAS v2u*)dstp = (v2u){pk2(xcu[0], xcu[1]), pk2(xcu[2], xcu[3])}; *(LAS v2u*)(dstp + 8) = (v2u){pk2(xcu[4], xcu[5]), pk2(xcu[6], xcu[7])}; }
            asm volatile("" ::: "memory");
            v2u oE[4], oK[4], oG[4];
#pragma unroll
            for (int g4 = 0; g4 < 4; ++g4) {
                const int c = cb + 8 * g4;
                const f32x4 w0v = *(const LAS f32x4*)(PRM + 1536 + c),
                            a0v = *(const LAS f32x4*)(PRM + 2048 + c), kkc = *(const LAS f32x4*)(PRM + 2560 + c), kac = *(const LAS f32x4*)(PRM + 3072 + c), rkc = *(const LAS f32x4*)(PRM + 3584 + c);
                const LAS unsigned char* inq = IN + r32 * PR_OT_PITCH + 2 * (8 * g4 + 4 * hh);
                const v2u rq = *(const LAS v2u*)inq, kq = *(const LAS v2u*)(inq + PR_OT_TILE), vq = *(const LAS v2u*)(inq + 2 * PR_OT_TILE);
                const float rsu[4] = {bflo(rq.x), bfhi(rq.x), bflo(rq.y), bfhi(rq.y)}, ksu[4] = {bflo(kq.x), bfhi(kq.x), bflo(kq.y), bfhi(kq.y)}, vsu[4] = {bflo(vq.x), bfhi(vq.x), bflo(vq.y), bfhi(vq.y)};
                float ro[4], eo[4], ko[4], vo[4], ao[4], go[4];
#pragma unroll
                for (int e = 0; e < 4; ++e) {
                    const float r = rsu[e], k = ksu[e], v = vsu[e];
                    const float ee = 0.6065306597126334f * fast_sigmoid(w0v[e] + aW[4 * g4 + e]);
                    const float as = fast_sigmoid(a0v[e] + aA[4 * g4 + e]);
                    const float kv = k * kkc[e]; kkv[ct][4 * g4 + e] = kv; n2 += kv * kv;
                    const float kp = k * (1.0f + (as - 1.0f) * kac[e]);
                    bcv += r * kp * rkc[e];
                    ro[e] = r; eo[e] = ee; ko[e] = kp; vo[e] = v; ao[e] = as; go[e] = aG[4 * g4 + e];
                }
                LAS unsigned char* ot = OT + r32 * PR_OT_PITCH + 2 * (8 * g4 + 4 * hh);
                *(LAS v2u*)(ot) = (v2u){pk2(ro[0], ro[1]), pk2(ro[2], ro[3])}; *(LAS v2u*)(ot + PR_OT_TILE) = (v2u){pk2(vo[0], vo[1]), pk2(vo[2], vo[3])}; *(LAS v2u*)(ot + 2 * PR_OT_TILE) = (v2u){pk2(ao[0], ao[1]), pk2(ao[2], ao[3])};
                oE[g4] = (v2u){pk2(eo[0], eo[1]), pk2(eo[2], eo[3])}; oK[g4] = (v2u){pk2(ko[0], ko[1]), pk2(ko[2], ko[3])}; oG[g4] = (v2u){pk2(go[0], go[1]), pk2(go[2], go[3])};
            }
            asm volatile("" ::: "memory");
#pragma unroll
            for (int batch = 0; batch < 2; ++batch) {
                bf16* const dst[3] = {batch == 0 ? R_ : E_, batch == 0 ? V_ : KP_, batch == 0 ? AS_ : G_};
                if (batch == 1) {
#pragma unroll
                    for (int g4 = 0; g4 < 4; ++g4) { LAS unsigned char* ot = OT + r32 * PR_OT_PITCH + 2 * (8 * g4 + 4 * hh); *(LAS v2u*)(ot) = oE[g4]; *(LAS v2u*)(ot + PR_OT_TILE) = oK[g4]; *(LAS v2u*)(ot + 2 * PR_OT_TILE) = oG[g4]; }
                    asm volatile("" ::: "memory"); }
#pragma unroll
                for (int a = 0; a < 3; ++a)
#pragma unroll
                    for (int i = 0; i < 2; ++i) { const int tk = (lane >> 2) + 16 * i, part = lane & 3; const LAS unsigned char* src = OT + a * PR_OT_TILE + tk * PR_OT_PITCH + 16 * part;
                        const v2u lo = *(const LAS v2u*)src, hi = *(const LAS v2u*)(src + 8);
                        *(GAS v4u*)(dst[a] + (size_t)(m0 + tk) * GW + 64 * h + 32 * ct + 8 * part) = (v4u){lo.x, lo.y, hi.x, hi.y}; }
                asm volatile("" ::: "memory");
            }
        }
        n2 += __shfl_xor(n2, 32); bcv += __shfl_xor(bcv, 32);
        const float inv = 1.0f / fmaxf(sqrtf(n2), 1e-12f);
#pragma unroll
        for (int ct = 0; ct < 2; ++ct)
#pragma unroll
            for (int g4 = 0; g4 < 4; ++g4) *(LAS v2u*)(OT + ct * PR_OT_TILE + r32 * PR_OT_PITCH + 2 * (8 * g4 + 4 * hh)) = (v2u){pk2(kkv[ct][4 * g4] * inv, kkv[ct][4 * g4 + 1] * inv), pk2(kkv[ct][4 * g4 + 2] * inv, kkv[ct][4 * g4 + 3] * inv)};
        asm volatile("" ::: "memory");
#pragma unroll
        for (int ct = 0; ct < 2; ++ct)
#pragma unroll
            for (int i = 0; i < 2; ++i) { const int tk = (lane >> 2) + 16 * i, part = lane & 3; const LAS unsigned char* src = OT + ct * PR_OT_TILE + tk * PR_OT_PITCH + 16 * part;
                const v2u lo = *(const LAS v2u*)src, hi = *(const LAS v2u*)(src + 8);
                *(GAS v4u*)(KK_ + (size_t)(m0 + tk) * GW + 64 * h + 32 * ct + 8 * part) = (v4u){lo.x, lo.y, hi.x, hi.y}; }
        asm volatile("" ::: "memory");
        if (hh == 0) BC[(size_t)m * NH + h] = bcv;
        __syncthreads();
    }
}

__device__ __forceinline__ Frame mkframe(LAS unsigned char* lds) {
    Frame F; F.lds = lds; { int t_ = threadIdx.x; asm volatile("" : "+v"(t_)); F.tid = t_; } F.lane = F.tid & 63; F.wave = __builtin_amdgcn_readfirstlane(F.tid >> 6);
    F.G = gridDim.x; { const int bx = blockIdx.x; F.vcu = (F.G % 8 == 0) ? (bx % 8) * (F.G / 8) + bx / 8 : bx; }
    F.gw = blockIdx.x * NWAVES + F.wave; F.ngw = F.G * NWAVES; return F;
}

#ifndef UNPACK8
#define UNPACK8(dst, o, W_) do { dst[(o)] = bflo((W_).x); dst[(o) + 1] = bfhi((W_).x); dst[(o) + 2] = bflo((W_).y); dst[(o) + 3] = bfhi((W_).y); dst[(o) + 4] = bflo((W_).z); dst[(o) + 5] = bfhi((W_).z); dst[(o) + 6] = bflo((W_).w); dst[(o) + 7] = bfhi((W_).w); } while (0)
#endif
#define DOT8(q, o, W_) ((q)[(o)] * bflo((W_).x) + (q)[(o) + 1] * bfhi((W_).x) + (q)[(o) + 2] * bflo((W_).y) + (q)[(o) + 3] * bfhi((W_).y) + (q)[(o) + 4] * bflo((W_).z) + (q)[(o) + 5] * bfhi((W_).z) + (q)[(o) + 6] * bflo((W_).w) + (q)[(o) + 7] * bfhi((W_).w))
#define AXPY8(acc, o, sc, pe, W_) do { acc[(o)] = acc[(o)] * (sc) + (pe) * bflo((W_).x); acc[(o) + 1] = acc[(o) + 1] * (sc) + (pe) * bfhi((W_).x); acc[(o) + 2] = acc[(o) + 2] * (sc) + (pe) * bflo((W_).y); acc[(o) + 3] = acc[(o) + 3] * (sc) + (pe) * bfhi((W_).y); \
    acc[(o) + 4] = acc[(o) + 4] * (sc) + (pe) * bflo((W_).z); acc[(o) + 5] = acc[(o) + 5] * (sc) + (pe) * bfhi((W_).z); acc[(o) + 6] = acc[(o) + 6] * (sc) + (pe) * bflo((W_).w); acc[(o) + 7] = acc[(o) + 7] * (sc) + (pe) * bfhi((W_).w); } while (0)
__device__ __forceinline__ void mix_a_simple(Frame& F) {
    const bf16* PROJ = (const bf16*)(wsp() + WS_PROJ); bf16* YC = (bf16*)(wsp() + WS_YCAT); const int* TB = (const int*)(wsp() + WS_SMALL + SM_TB); const float* pb = inp(3);
    const int nthr = F.G * NTHR;
    for (int idx = blockIdx.x * NTHR + F.tid; idx < M * NH; idx += nthr) {
        const int m = idx >> 3, h = idx & 7, t = m % SEQ;
        float q[64], acc[64];
        { const GAS v4u* qp = (const GAS v4u*)(PROJ + (size_t)m * NPROJ_P + CA_Q + 64 * h);
#pragma unroll
          for (int i = 0; i < 8; ++i) { const v4u w = qp[i]; UNPACK8(q, 8 * i, w); } }
#pragma unroll
        for (int i = 0; i < 64; ++i) acc[i] = 0.f;
        float mx = -1e30f, l = 0.f;
        for (int p = 0; p < 3; ++p) { const int d = p == 0 ? 1 : (p == 1 ? 4 : 16);
            for (int j = 0; j <= 128; ++j) { const int kp = t - j * d; if (kp < 0) break;
                const bf16* row = PROJ + (size_t)(m - j * d) * NPROJ_P; const GAS v4u* kq = (const GAS v4u*)(row + CA_K + 64 * h); const GAS v4u* vq = (const GAS v4u*)(row + CA_V + 64 * h);
                float s = 0.f;
#pragma unroll
                for (int i = 0; i < 8; ++i) { const v4u w = kq[i]; s += DOT8(q, 8 * i, w); }
                s = s * 0.125f + pb[TB[j * d] * 16 + h];
                const float mn = fmaxf(mx, s), sc = __expf(mx - mn), pe = __expf(s - mn); mx = mn; l = l * sc + pe;
#pragma unroll
                for (int i = 0; i < 8; ++i) { const v4u w = vq[i]; AXPY8(acc, 8 * i, sc, pe, w); }
            } }
        const float inv = 1.0f / l; GAS v4u* op = (GAS v4u*)(YC + (size_t)m * DM + 0 * GW + 64 * h);
#pragma unroll
        for (int i = 0; i < 8; ++i) op[i] = (v4u){pk2(acc[8 * i] * inv, acc[8 * i + 1] * inv), pk2(acc[8 * i + 2] * inv, acc[8 * i + 3] * inv), pk2(acc[8 * i + 4] * inv, acc[8 * i + 5] * inv), pk2(acc[8 * i + 6] * inv, acc[8 * i + 7] * inv)};
    }
}
__device__ __forceinline__ void mix_c_simple(Frame& F, int l = 0) {
    const bf16* PROJ = (const bf16*)(wsp() + WS_PROJ); bf16* YC = (bf16*)(wsp() + WS_YCAT); const int* TB = (const int*)(wsp() + WS_SMALL + SM_TB); const float* pb = inp(3);
    const float* KBAR = (const float*)(wsp() + CTL_KBAR) + (size_t)l * 64 * 8 * 64;
    const int nthr = F.G * NTHR;
    for (int idx = blockIdx.x * NTHR + F.tid; idx < M * NH; idx += nthr) {
        const int m = idx >> 3, h = idx & 7, t = m % SEQ, b = m / SEQ, ob = t >> 8;
        float q[64], acc[64];
        { const GAS v4u* qp = (const GAS v4u*)(PROJ + (size_t)m * NPROJ_P + CC_Q + 64 * h);
#pragma unroll
          for (int i = 0; i < 8; ++i) { const v4u w = qp[i]; UNPACK8(q, 8 * i, w); } }
        float gate[8];
#pragma unroll
        for (int n = 0; n < 8; ++n) { float s = 0.f; if (n < ob) { const float* kb = KBAR + ((b * NH + h) * 8 + n) * 64;
#pragma unroll
                for (int i = 0; i < 64; ++i) s += q[i] * kb[i]; } gate[n] = s; }
        unsigned sel = 0u;
#pragma unroll
        for (int n = 0; n < 8; ++n) { int rank = 0;
#pragma unroll
            for (int n2 = 0; n2 < 8; ++n2) rank += (n2 < ob && n2 != n && (gate[n2] > gate[n] || (gate[n2] == gate[n] && n2 < n))) ? 1 : 0;
            if (n < ob && rank < 3) sel |= 1u << n; }
        sel |= 1u << ob;
#pragma unroll
        for (int i = 0; i < 64; ++i) acc[i] = 0.f;
        float mx = -1e30f, l = 0.f;
        for (int n = 0; n <= ob; ++n) { if (!((sel >> n) & 1u)) continue; const int kmax = n == ob ? (t & 255) : 255;
            for (int i2 = 0; i2 <= kmax; ++i2) { const int kp = 256 * n + i2;
                const bf16* row = PROJ + ((size_t)b * SEQ + kp) * NPROJ_P; const GAS v4u* kq = (const GAS v4u*)(row + CC_K + 64 * h); const GAS v4u* vq = (const GAS v4u*)(row + CC_V + 64 * h);
                float s = 0.f;
#pragma unroll
                for (int i = 0; i < 8; ++i) { const v4u w = kq[i]; s += DOT8(q, 8 * i, w); }
                s = s * 0.125f + pb[TB[t - kp] * 16 + 8 + h];
                const float mn = fmaxf(mx, s), sc = __expf(mx - mn), pe = __expf(s - mn); mx = mn; l = l * sc + pe;
#pragma unroll
                for (int i = 0; i < 8; ++i) { const v4u w = vq[i]; AXPY8(acc, 8 * i, sc, pe, w); }
            } }
        const float inv = 1.0f / l; GAS v4u* op = (GAS v4u*)(YC + (size_t)m * DM + 2 * GW + 64 * h);
#pragma unroll
        for (int i = 0; i < 8; ++i) op[i] = (v4u){pk2(acc[8 * i] * inv, acc[8 * i + 1] * inv), pk2(acc[8 * i + 2] * inv, acc[8 * i + 3] * inv), pk2(acc[8 * i + 4] * inv, acc[8 * i + 5] * inv), pk2(acc[8 * i + 6] * inv, acc[8 * i + 7] * inv)};
    }
}
__device__ __forceinline__ void mix_b_simple(Frame& F, int l) {
    const bf16* PROJ = (const bf16*)(wsp() + WS_PROJ); bf16* YC = (bf16*)(wsp() + WS_YCAT); const pg8::fx_t* ST = (const pg8::fx_t*)(wsp() + CTL_STATS) + (size_t)l * M * 2;
    const float* lng = inp(4) + l * GW; const float* sw = inp(5) + (size_t)l * NH * 128 * 128; const float* sb = inp(6) + l * NH * 128;
    const int nthr = F.G * NTHR;
    for (int idx = blockIdx.x * NTHR + F.tid; idx < M * GW; idx += nthr) {
        const int m = idx >> 9, c = idx & 511, g = c >> 6, tt = m & 127, m0 = m - tt;
        const float* wrow = sw + ((size_t)g * 128 + tt) * 128; const float gn = lng[c]; float s = 0.f;
        for (int s2 = 0; s2 <= tt; ++s2) { const int ms = m0 + s2; const float mu_ = pg8::fx_get(ST + 2 * ms) * (1.0f / 512.0f), rs_ = 1.0f / sqrtf(fmaxf(pg8::fx_get(ST + 2 * ms + 1) * (1.0f / 512.0f) - mu_ * mu_, 0.f) + 1e-5f); const float vv = (gelu_tanh(bf2f(PROJ[(size_t)ms * NPROJ_P + CB_V + c])) - mu_) * rs_ * gn; s += wrow[s2] * vv; }
        const float u = gelu_tanh(bf2f(PROJ[(size_t)m * NPROJ_P + CB_U + c]));
        YC[(size_t)m * DM + GW + c] = (bf16)f2bf(u * (s + sb[g * 128 + tt]));
    }
}
__device__ __forceinline__ float rdl(float v, int k) { return __builtin_bit_cast(float, __builtin_amdgcn_readlane(__builtin_bit_cast(int, v), k)); }
__device__ __forceinline__ void mix_d_simple(Frame& F) {
    const bf16* R_ = (const bf16*)outp();
    const bf16* E_ = R_ + (size_t)M * GW; const bf16* KP_ = E_ + (size_t)M * GW; const bf16* V_ = KP_ + (size_t)M * GW;
    const bf16* KK_ = (const bf16*)outp() + (size_t)4 * M * GW; const bf16* AS_ = KK_ + (size_t)M * GW; float* YD = (float*)(wsp() + WS_YD);
    for (int it = F.gw; it < BATCH * NH; it += F.ngw) {
        const int b = it >> 3, h = it & 7; float s[64];
#pragma unroll
        for (int k = 0; k < 64; ++k) s[k] = 0.f;
        for (int t = 0; t < SEQ; ++t) {
            const size_t o = ((size_t)b * SEQ + t) * GW + 64 * h + F.lane;
            const float r = bf2f(R_[o]), w = __expf(-bf2f(E_[o])), kp = bf2f(KP_[o]), v = bf2f(V_[o]), kk = bf2f(KK_[o]), as = bf2f(AS_[o]);
            const float a = -kk, bb = kk * as;
            float sa = 0.f;
#pragma unroll
            for (int k = 0; k < 64; ++k) sa += s[k] * rdl(a, k);
            float y = 0.f;
#pragma unroll
            for (int k = 0; k < 64; ++k) { s[k] = s[k] * rdl(w, k) + sa * rdl(bb, k) + v * rdl(kp, k); y += s[k] * rdl(r, k); }
            YD[o] = y;
        }
    }
}

constexpr float LOG2E = 1.4426950408889634f;

constexpr int SC_T = 32, SC_TOK = (5 * 64 + 32) * 4, SC_BUF = SC_T * SC_TOK, SC_YB = SC_T * 32 * 4, SC_LDS = 2 * SC_BUF + 2 * SC_YB;
template <int CTRL> __device__ __forceinline__ float dpp_add(float x) {
    const int y = __builtin_amdgcn_update_dpp(0, __builtin_bit_cast(int, x), CTRL, 0xF, 0xF, false);
    return x + __builtin_bit_cast(float, y);
}
__device__ __forceinline__ float red8(float x) { x = dpp_add<0xB1>(x); x = dpp_add<0x4E>(x); x = dpp_add<0x141>(x); return x; }
__device__ __forceinline__ void scan_unit(LAS unsigned char* lds, int unit, int tid) {
    const int half = unit & 1, h = (unit >> 1) & 7, b = unit >> 4;
    const bf16* R_ = (const bf16*)outp();
    const bf16* E_ = R_ + (size_t)M * GW; const bf16* KP_ = E_ + (size_t)M * GW; const bf16* V_ = KP_ + (size_t)M * GW;
    const bf16* KK_ = (const bf16*)outp() + (size_t)4 * M * GW; const bf16* AS_ = KK_ + (size_t)M * GW; float* YD = (float*)(wsp() + WS_YD);
    const int lane = tid & 63, wave = __builtin_amdgcn_readfirstlane(tid >> 6);
    const bool scanner = wave < 4;
    const int j = lane & 7, rowl = (wave & 3) * 8 + (lane >> 3);
    const int st = tid & 255, tt = st >> 3, cg = st & 7;
    const size_t gbase = ((size_t)b * SEQ) * GW + 64 * h + 8 * cg;
#define SC_STAGE(c, buf) do { const size_t o_ = gbase + (size_t)((c) * SC_T + tt) * GW; \
        const v4u g_r = *(const GAS v4u*)(R_ + o_), g_e = *(const GAS v4u*)(E_ + o_), g_k = *(const GAS v4u*)(KP_ + o_), g_v = *(const GAS v4u*)(V_ + o_), g_kk = *(const GAS v4u*)(KK_ + o_), g_as = *(const GAS v4u*)(AS_ + o_); \
        LAS float* p_ = (LAS float*)(lds + (buf) * SC_BUF + tt * SC_TOK) + 8 * cg; float kk_[8], x_[8], y_[8]; \
        UNPACK8(kk_, 0, g_kk); \
        *(LAS f32x4*)(p_) = (f32x4){-kk_[0], -kk_[1], -kk_[2], -kk_[3]}; *(LAS f32x4*)(p_ + 4) = (f32x4){-kk_[4], -kk_[5], -kk_[6], -kk_[7]}; \
        UNPACK8(x_, 0, g_e); *(LAS f32x4*)(p_ + 64) = (f32x4){__expf(-x_[0]), __expf(-x_[1]), __expf(-x_[2]), __expf(-x_[3])}; *(LAS f32x4*)(p_ + 68) = (f32x4){__expf(-x_[4]), __expf(-x_[5]), __expf(-x_[6]), __expf(-x_[7])}; \
        UNPACK8(y_, 0, g_as); *(LAS f32x4*)(p_ + 128) = (f32x4){kk_[0] * y_[0], kk_[1] * y_[1], kk_[2] * y_[2], kk_[3] * y_[3]}; *(LAS f32x4*)(p_ + 132) = (f32x4){kk_[4] * y_[4], kk_[5] * y_[5], kk_[6] * y_[6], kk_[7] * y_[7]}; \
        UNPACK8(x_, 0, g_k); *(LAS f32x4*)(p_ + 192) = (f32x4){x_[0], x_[1], x_[2], x_[3]}; *(LAS f32x4*)(p_ + 196) = (f32x4){x_[4], x_[5], x_[6], x_[7]}; \
        UNPACK8(x_, 0, g_r); *(LAS f32x4*)(p_ + 256) = (f32x4){x_[0], x_[1], x_[2], x_[3]}; *(LAS f32x4*)(p_ + 260) = (f32x4){x_[4], x_[5], x_[6], x_[7]}; \
        if ((cg >> 2) == half) { UNPACK8(x_, 0, g_v); LAS float* v_ = (LAS float*)(lds + (buf) * SC_BUF + tt * SC_TOK) + 320 + 8 * (cg & 3); \
            *(LAS f32x4*)(v_) = (f32x4){x_[0], x_[1], x_[2], x_[3]}; *(LAS f32x4*)(v_ + 4) = (f32x4){x_[4], x_[5], x_[6], x_[7]}; } } while (0)
    if (!scanner) SC_STAGE(0, 0);
    __syncthreads();
    f32x4 s0 = {0.f, 0.f, 0.f, 0.f}, s1 = {0.f, 0.f, 0.f, 0.f};
    float ykeep = 0.f;
    for (int c = 0; c < SEQ / SC_T; ++c) {
        const int cur = c & 1;
        LAS float* yb = (LAS float*)(lds + 2 * SC_BUF + cur * SC_YB);
        if (scanner) {
            const LAS float* base = (const LAS float*)(lds + cur * SC_BUF) + 8 * j;
            const LAS float* vbase = (const LAS float*)(lds + cur * SC_BUF) + 320 + rowl;
            f32x4 a0 = *(const LAS f32x4*)(base), a1 = *(const LAS f32x4*)(base + 4), w0 = *(const LAS f32x4*)(base + 64), w1 = *(const LAS f32x4*)(base + 68), b0 = *(const LAS f32x4*)(base + 128), b1 = *(const LAS f32x4*)(base + 132),
                  k0 = *(const LAS f32x4*)(base + 192), k1 = *(const LAS f32x4*)(base + 196), r0 = *(const LAS f32x4*)(base + 256), r1 = *(const LAS f32x4*)(base + 260);
            float vv = *vbase;
#pragma unroll
            for (int t = 0; t < SC_T; ++t) {
                f32x4 na0 = a0, na1 = a1, nw0 = w0, nw1 = w1, nb0 = b0, nb1 = b1, nk0 = k0, nk1 = k1, nr0 = r0, nr1 = r1; float nv = vv;
                if (t + 1 < SC_T) { const LAS float* p = base + (t + 1) * (SC_TOK / 4);
                    na0 = *(const LAS f32x4*)(p); na1 = *(const LAS f32x4*)(p + 4); nw0 = *(const LAS f32x4*)(p + 64); nw1 = *(const LAS f32x4*)(p + 68); nb0 = *(const LAS f32x4*)(p + 128); nb1 = *(const LAS f32x4*)(p + 132);
                    nk0 = *(const LAS f32x4*)(p + 192); nk1 = *(const LAS f32x4*)(p + 196); nr0 = *(const LAS f32x4*)(p + 256); nr1 = *(const LAS f32x4*)(p + 260);
                    nv = vbase[(t + 1) * (SC_TOK / 4)]; }
                const f32x4 pa = s0 * a0 + s1 * a1;
                float sa = (pa.x + pa.y) + (pa.z + pa.w);
                const f32x4 sw0 = s0 * w0 + vv * k0, sw1 = s1 * w1 + vv * k1;
                sa = red8(sa);
                s0 = sa * b0 + sw0; s1 = sa * b1 + sw1;
                const f32x4 py = s0 * r0 + s1 * r1;
                float y = (py.x + py.y) + (py.z + py.w);
                y = red8(y);
                ykeep = (j == (t & 7)) ? y : ykeep;
                if ((t & 7) == 7) yb[((t & ~7) + j) * 32 + rowl] = ykeep;
                a0 = na0; a1 = na1; w0 = nw0; w1 = nw1; b0 = nb0; b1 = nb1; k0 = nk0; k1 = nk1; r0 = nr0; r1 = nr1; vv = nv;
            }
        } else {
            if (c > 0) {
                const LAS float* ybp = (const LAS float*)(lds + 2 * SC_BUF + (cur ^ 1) * SC_YB); const int t2 = st >> 3, q4 = st & 7; const f32x4 v = *(const LAS f32x4*)(ybp + t2 * 32 + 4 * q4);
                *(GAS f32x4*)(YD + ((size_t)b * SEQ + (c - 1) * SC_T + t2) * GW + 64 * h + 32 * half + 4 * q4) = v; }
            if (c + 1 < SEQ / SC_T) SC_STAGE(c + 1, cur ^ 1);
        }
        __syncthreads();
    }
    if (!scanner) { const LAS float* ybp = (const LAS float*)(lds + 2 * SC_BUF + 1 * SC_YB); const int t2 = st >> 3, q4 = st & 7; const f32x4 v = *(const LAS f32x4*)(ybp + t2 * 32 + 4 * q4);
        *(GAS f32x4*)(YD + ((size_t)b * SEQ + (SEQ / SC_T - 1) * SC_T + t2) * GW + 64 * h + 32 * half + 4 * q4) = v; }
#undef SC_STAGE
    __syncthreads();
}

struct AttnSt { f32x16 o0, o1; float m, l; };
__device__ __forceinline__ void attn_init(AttnSt& st) {
    const float z_ = zero_v();
#pragma unroll
    for (int i = 0; i < 16; ++i) { st.o0[i] = z_; st.o1[i] = z_; }
    st.m = -1e30f; st.l = 0.f;
}
__device__ __forceinline__ void attn_tile(AttnSt& st, const bf16x8 (&qf)[4], const bf16* Kcol, const bf16* Vcol, int rowb, int kb, int ks, int qpos, int maxd, bool sel, const LAS float* biasT, int r32, int hh) {
    int kp_l = kb + r32 * ks; kp_l = kp_l < 0 ? 0 : kp_l;
    const bf16* kr_ = Kcol + (size_t)(rowb + kp_l) * NPROJ_P + 8 * hh;
    bf16x8 kf[4];
#pragma unroll
    for (int s = 0; s < 4; ++s) kf[s] = *(const GAS bf16x8*)(kr_ + 16 * s);
    f32x16 sc;
#pragma unroll
    for (int i = 0; i < 16; ++i) sc[i] = 0.f;
#pragma unroll
    for (int s = 0; s < 4; ++s) sc = __builtin_amdgcn_mfma_f32_32x32x16_bf16(kf[s], qf[s], sc, 0, 0, 0);
    unsigned vf[2][2][4];
#pragma unroll
    for (int s2 = 0; s2 < 2; ++s2)
#pragma unroll
        for (int jp = 0; jp < 4; ++jp) {
            const int j0 = 2 * jp, key0 = 16 * s2 + 8 * (j0 >> 2) + 4 * hh + (j0 & 3);
            int kp0 = kb + key0 * ks, kp1 = kp0 + ks; kp0 = kp0 < 0 ? 0 : kp0; kp1 = kp1 < 0 ? 0 : kp1;
            const bf16* v0 = Vcol + (size_t)(rowb + kp0) * NPROJ_P + r32; const bf16* v1 = Vcol + (size_t)(rowb + kp1) * NPROJ_P + r32;
            vf[0][s2][jp] = (unsigned)v0[0] | ((unsigned)v1[0] << 16); vf[1][s2][jp] = (unsigned)v0[32] | ((unsigned)v1[32] << 16);
        }
    float tmax = -INFINITY;
#pragma unroll
    for (int r = 0; r < 16; ++r) {
        const int kr = (r & 3) + 8 * (r >> 2) + 4 * hh, kp = kb + kr * ks, dist = qpos - kp;
        const bool ok = sel && dist >= 0 && dist <= maxd && kp >= 0;
        const float v = sc[r] * (0.125f * LOG2E) + biasT[ok ? dist : 0];
        sc[r] = ok ? v : -INFINITY; tmax = fmaxf(tmax, sc[r]);
    }
    tmax = fmaxf(tmax, __shfl_xor(tmax, 32));
    const float mn = fmaxf(st.m, tmax), scale = __builtin_amdgcn_exp2f(st.m - mn); st.m = mn;
    float ls = 0.f;
#pragma unroll
    for (int r = 0; r < 16; ++r) { sc[r] = __builtin_amdgcn_exp2f(sc[r] - mn); ls += sc[r]; }
    st.l = st.l * scale + ls;
#pragma unroll
    for (int i = 0; i < 16; ++i) { st.o0[i] *= scale; st.o1[i] *= scale; }
    typedef unsigned u32x4_t __attribute__((ext_vector_type(4)));
#pragma unroll
    for (int s2 = 0; s2 < 2; ++s2) {
        u32x4_t pw; pw.x = pg8::cvt_pk_bf16(sc[8 * s2], sc[8 * s2 + 1]); pw.y = pg8::cvt_pk_bf16(sc[8 * s2 + 2], sc[8 * s2 + 3]); pw.z = pg8::cvt_pk_bf16(sc[8 * s2 + 4], sc[8 * s2 + 5]); pw.w = pg8::cvt_pk_bf16(sc[8 * s2 + 6], sc[8 * s2 + 7]);
        const bf16x8 pf = __builtin_bit_cast(bf16x8, pw);
        u32x4_t a0 = {vf[0][s2][0], vf[0][s2][1], vf[0][s2][2], vf[0][s2][3]}, a1 = {vf[1][s2][0], vf[1][s2][1], vf[1][s2][2], vf[1][s2][3]};
        st.o0 = __builtin_amdgcn_mfma_f32_32x32x16_bf16(__builtin_bit_cast(bf16x8, a0), pf, st.o0, 0, 0, 0);
        st.o1 = __builtin_amdgcn_mfma_f32_32x32x16_bf16(__builtin_bit_cast(bf16x8, a1), pf, st.o1, 0, 0, 0);
    }
}
__device__ __forceinline__ void attn_loadq(bf16x8 (&qf)[4], const bf16* Qcol, int row, int hh) {
    const bf16* q = Qcol + (size_t)row * NPROJ_P + 8 * hh;
#pragma unroll
    for (int s = 0; s < 4; ++s) qf[s] = *(const GAS bf16x8*)(q + 16 * s);
}
__device__ __forceinline__ void attn_store(const f32x16& o0, const f32x16& o1, float inv, bf16* yrow, int hh) {
#pragma unroll
    for (int g = 0; g < 4; ++g) {
        *(GAS v2u*)(yrow + 8 * g + 4 * hh) = (v2u){pk2(o0[4 * g] * inv, o0[4 * g + 1] * inv), pk2(o0[4 * g + 2] * inv, o0[4 * g + 3] * inv)};
        *(GAS v2u*)(yrow + 32 + 8 * g + 4 * hh) = (v2u){pk2(o1[4 * g] * inv, o1[4 * g + 1] * inv), pk2(o1[4 * g + 2] * inv, o1[4 * g + 3] * inv)};
    }
}
__device__ __forceinline__ void build_bias(LAS float* biasT, int hcol, int tid) {
    const int* TB = (const int*)(wsp() + WS_SMALL + SM_TB); const float* pb = inp(3); LAS int* bktT = (LAS int*)(biasT + 2048);
    for (int d = tid; d < 2048; d += NTHR) { const int bk = TB[d]; bktT[d] = bk; biasT[d] = pb[bk * 16 + hcol] * LOG2E; }
}

constexpr int MC_KP = 144, MC_VP = 192, MC_KB = 128 * MC_KP, MC_VB = 128 * MC_VP, MC_K_OFF = 16384, MC_V_OFF = MC_K_OFF + 2 * MC_KB, MC_LDS = MC_V_OFF + 2 * MC_VB;
typedef short v4i16_t __attribute__((ext_vector_type(4)));
__device__ __forceinline__ float pl32_max(float a) { float x = a, y = a;
    asm volatile("s_nop 1\n\tv_permlane32_swap_b32_e32 %0, %1\n\ts_nop 0" : "+v"(x), "+v"(y));
    return fmaxf(x, y); }
template <int MODE> __device__ __forceinline__ void moba_tile(AttnSt& st, const bf16x8 (&qf)[4], const LAS unsigned char* Kt, const LAS unsigned char* Vt, const LAS float* biasT, const LAS int* TB, int dlo, bool sel, int lane, int r32, int hh) {
    bf16x8 kf[4];
#pragma unroll
    for (int s = 0; s < 4; ++s) kf[s] = *(const LAS bf16x8*)(Kt + r32 * MC_KP + 32 * s + 16 * hh);
    v4i16_t vt[2][2][2];
    { const LAS unsigned char* vb = Vt + (4 * hh + ((lane & 15) >> 2)) * MC_VP + (16 * ((lane >> 4) & 1) + 4 * (lane & 3)) * 2;
#pragma unroll
      for (int dh = 0; dh < 2; ++dh)
#pragma unroll
        for (int s2 = 0; s2 < 2; ++s2)
#pragma unroll
            for (int h8 = 0; h8 < 2; ++h8) vt[dh][s2][h8] = __builtin_amdgcn_ds_read_tr16_b64_v4i16((LAS v4i16_t*)(vb + (16 * s2 + 8 * h8) * MC_VP + 64 * dh)); }
    f32x16 sc;
#pragma unroll
    for (int i = 0; i < 16; ++i) sc[i] = 0.f;
#pragma unroll
    for (int s = 0; s < 4; ++s) sc = __builtin_amdgcn_mfma_f32_32x32x16_bf16(kf[s], qf[s], sc, 0, 0, 0);
    const int d0 = dlo + r32 + 31 - 4 * hh;
    const int dmin = dlo < 0 ? 0 : dlo, dmax = dlo + 62;
    const bool uni = __builtin_amdgcn_readfirstlane(TB[dmin]) == __builtin_amdgcn_readfirstlane(TB[dmax]);
    float tmax = -INFINITY;
    if (uni) { const float bu = biasT[dmin];
#pragma unroll
        for (int r = 0; r < 16; ++r) { float v = sc[r] * (0.125f * LOG2E) + bu; if (MODE == 1) { const int dist = d0 - (r & 3) - 8 * (r >> 2); v = dist >= 0 ? v : -INFINITY; } sc[r] = v; tmax = fmaxf(tmax, v); }
    } else {
#pragma unroll
        for (int r = 0; r < 16; ++r) { const int dist = d0 - (r & 3) - 8 * (r >> 2); float v = sc[r] * (0.125f * LOG2E) + biasT[dist < 0 ? 0 : dist]; if (MODE == 1) v = dist >= 0 ? v : -INFINITY; sc[r] = v; tmax = fmaxf(tmax, v); }
    }
    if (MODE == 2) tmax = sel ? tmax : -INFINITY;
    tmax = pl32_max(tmax);
    const float mn = fmaxf(st.m, tmax);
    if (__ballot(mn > st.m) != 0ull) { const float scale = __builtin_amdgcn_exp2f(st.m - mn); st.l *= scale;
#pragma unroll
        for (int i = 0; i < 16; ++i) { st.o0[i] *= scale; st.o1[i] *= scale; } }
    st.m = mn;
    const float msub = (MODE == 2 && !sel) ? INFINITY : mn;
    float ls = 0.f;
#pragma unroll
    for (int r = 0; r < 16; ++r) { sc[r] = __builtin_amdgcn_exp2f(sc[r] - msub); ls += sc[r]; }
    st.l += ls;
    typedef unsigned u32x4_t __attribute__((ext_vector_type(4)));
#pragma unroll
    for (int s2 = 0; s2 < 2; ++s2) {
        u32x4_t pw; pw.x = pg8::cvt_pk_bf16(sc[8 * s2], sc[8 * s2 + 1]); pw.y = pg8::cvt_pk_bf16(sc[8 * s2 + 2], sc[8 * s2 + 3]); pw.z = pg8::cvt_pk_bf16(sc[8 * s2 + 4], sc[8 * s2 + 5]); pw.w = pg8::cvt_pk_bf16(sc[8 * s2 + 6], sc[8 * s2 + 7]);
        const bf16x8 pf = __builtin_bit_cast(bf16x8, pw);
        const bf16x8 a0 = {vt[0][s2][0][0], vt[0][s2][0][1], vt[0][s2][0][2], vt[0][s2][0][3], vt[0][s2][1][0], vt[0][s2][1][1], vt[0][s2][1][2], vt[0][s2][1][3]};
        const bf16x8 a1 = {vt[1][s2][0][0], vt[1][s2][0][1], vt[1][s2][0][2], vt[1][s2][0][3], vt[1][s2][1][0], vt[1][s2][1][1], vt[1][s2][1][2], vt[1][s2][1][3]};
        st.o0 = __builtin_amdgcn_mfma_f32_32x32x16_bf16(a0, pf, st.o0, 0, 0, 0);
        st.o1 = __builtin_amdgcn_mfma_f32_32x32x16_bf16(a1, pf, st.o1, 0, 0, 0);
    }
}
__device__ __forceinline__ void moba_unit(LAS unsigned char* lds, int unit, int tid, int l) {
    const int ob = unit & 7, h = (unit >> 3) & 7, b = unit >> 6, lane = tid & 63, wave = __builtin_amdgcn_readfirstlane(tid >> 6), r32 = lane & 31, hh = lane >> 5;
    LAS float* biasT = (LAS float*)lds;
    build_bias(biasT, 8 + h, tid);
    const bf16* PROJ = (const bf16*)(wsp() + WS_PROJ); const float* KBAR = (const float*)(wsp() + CTL_KBAR) + (size_t)l * 64 * 8 * 64 + ((b * NH + h) * 8) * 64; const LAS int* TB = (const LAS int*)(biasT + 2048);
    const int rowb = b * SEQ, qpos = 256 * ob + 32 * wave + r32;
    bf16x8 qf[4]; attn_loadq(qf, PROJ + CC_Q + 64 * h, rowb + qpos, hh);
    float gate[8];
#pragma unroll
    for (int n = 0; n < 8; ++n) { float s = 0.f;
        if (n < ob) {
#pragma unroll
            for (int s4 = 0; s4 < 4; ++s4) { const f32x4 k0 = *(const GAS f32x4*)(KBAR + n * 64 + 16 * s4 + 8 * hh), k1 = *(const GAS f32x4*)(KBAR + n * 64 + 16 * s4 + 8 * hh + 4);
                const v4u qw = __builtin_bit_cast(v4u, qf[s4]);
                s += bflo(qw.x) * k0.x + bfhi(qw.x) * k0.y + bflo(qw.y) * k0.z + bfhi(qw.y) * k0.w + bflo(qw.z) * k1.x + bfhi(qw.z) * k1.y + bflo(qw.w) * k1.z + bfhi(qw.w) * k1.w; }
            s += __shfl_xor(s, 32); }
        gate[n] = s; }
    unsigned selm = 0u;
#pragma unroll
    for (int n = 0; n < 8; ++n) { int rank = 0;
#pragma unroll
        for (int n2 = 0; n2 < 8; ++n2) rank += (n2 < ob && n2 != n && (gate[n2] > gate[n] || (gate[n2] == gate[n] && n2 < n))) ? 1 : 0;
        if (n < ob && rank < 3) selm |= 1u << n; }
    AttnSt st; attn_init(st);
    const int skey = tid >> 2, spart = tid & 3;
    const bf16* Kg = PROJ + (size_t)rowb * NPROJ_P + CC_K + 64 * h + 16 * spart; const bf16* Vg = PROJ + (size_t)rowb * NPROJ_P + CC_V + 64 * h + 16 * spart;
    bf16x8 gk0, gk1, gv0, gv1;
#define MC_GLOAD(i) do { const size_t ro_ = (size_t)(128 * (i) + skey) * NPROJ_P; gk0 = *(const GAS bf16x8*)(Kg + ro_); gk1 = *(const GAS bf16x8*)(Kg + ro_ + 8); gv0 = *(const GAS bf16x8*)(Vg + ro_); gv1 = *(const GAS bf16x8*)(Vg + ro_ + 8); } while (0)
#define MC_LSTORE(bf) do { LAS unsigned char* kd_ = lds + MC_K_OFF + (bf) * MC_KB + skey * MC_KP + 32 * spart; *(LAS bf16x8*)(kd_) = gk0; *(LAS bf16x8*)(kd_ + 16) = gk1; \
        LAS unsigned char* vd_ = lds + MC_V_OFF + (bf) * MC_VB + skey * MC_VP + 32 * spart; *(LAS bf16x8*)(vd_) = gv0; *(LAS bf16x8*)(vd_ + 16) = gv1; } while (0)
    const int nst = 2 * (ob + 1);
    MC_GLOAD(0); MC_LSTORE(0);
    __syncthreads();
    for (int i = 0; i < nst; ++i) {
        if (i + 1 < nst) MC_GLOAD(i + 1);
        const int n = i >> 1, hf = i & 1; const bool own = n == ob, sel = own || ((selm >> n) & 1u);
        const LAS unsigned char* Kb = lds + MC_K_OFF + (i & 1) * MC_KB; const LAS unsigned char* Vb = lds + MC_V_OFF + (i & 1) * MC_VB;
        if (own) {
#pragma unroll 1
            for (int sub = 0; sub < 4; ++sub) { const int jt = 4 * hf + sub; if (jt > wave) break; const int dlo = 32 * wave - (32 * jt + 31);
                if (jt == wave) moba_tile<1>(st, qf, Kb + sub * 32 * MC_KP, Vb + sub * 32 * MC_VP, biasT, TB, dlo, true, lane, r32, hh);
                else moba_tile<0>(st, qf, Kb + sub * 32 * MC_KP, Vb + sub * 32 * MC_VP, biasT, TB, dlo, true, lane, r32, hh); }
        } else if (__ballot(sel) != 0ull) {
#pragma unroll 1
            for (int sub = 0; sub < 4; ++sub) { const int dlo = 256 * ob + 32 * wave - (256 * n + 128 * hf + 32 * sub + 31);
                moba_tile<2>(st, qf, Kb + sub * 32 * MC_KP, Vb + sub * 32 * MC_VP, biasT, TB, dlo, sel, lane, r32, hh); }
        }
        if (i + 1 < nst) MC_LSTORE((i + 1) & 1);
        __syncthreads();
    }
#undef MC_GLOAD
#undef MC_LSTORE
    const float lt = st.l + __shfl_xor(st.l, 32);
    attn_store(st.o0, st.o1, 1.0f / lt, (bf16*)(wsp() + WS_YCAT) + (size_t)(rowb + qpos) * DM + 2 * GW + 64 * h, hh);
}

constexpr int MA_PITCH = 144, MA_ML_OFF = 512 * MA_PITCH, MA_BIAS_OFF = MA_ML_OFF + 512 * 8, MA_V_OFF = MA_BIAS_OFF + 16384, MA_VW = 32 * MC_VP, MA_LDS = MA_V_OFF + 8 * MA_VW;
template <bool MASKED> __device__ __forceinline__ void dil_tile(AttnSt& st, const bf16x8 (&qf)[4], const bf16x8 (&kf)[4], const LAS unsigned char* Vt, const LAS float* biasT, const LAS int* TB, int dl0, int dstep, int kb, int lane, int r32, int hh) {
    v4i16_t vt[2][2][2];
    { const LAS unsigned char* vb = Vt + (4 * hh + ((lane & 15) >> 2)) * MC_VP + (16 * ((lane >> 4) & 1) + 4 * (lane & 3)) * 2;
#pragma unroll
      for (int dh = 0; dh < 2; ++dh)
#pragma unroll
        for (int s2 = 0; s2 < 2; ++s2)
#pragma unroll
            for (int h8 = 0; h8 < 2; ++h8) vt[dh][s2][h8] = __builtin_amdgcn_ds_read_tr16_b64_v4i16((LAS v4i16_t*)(vb + (16 * s2 + 8 * h8) * MC_VP + 64 * dh)); }
    f32x16 sc;
#pragma unroll
    for (int i = 0; i < 16; ++i) sc[i] = 0.f;
#pragma unroll
    for (int s = 0; s < 4; ++s) sc = __builtin_amdgcn_mfma_f32_32x32x16_bf16(kf[s], qf[s], sc, 0, 0, 0);
    const int e0 = dl0 + r32 - 4 * hh;
    int dmin = (dl0 - 31) * dstep, dmax = (dl0 + 31) * dstep; dmin = dmin < 0 ? 0 : dmin; dmax = dmax > 2047 ? 2047 : dmax;
    const bool uni = __builtin_amdgcn_readfirstlane(TB[dmin]) == __builtin_amdgcn_readfirstlane(TB[dmax]);
    const float bu = biasT[dmin];
    float tmax = -INFINITY;
#pragma unroll
    for (int r = 0; r < 16; ++r) {
        const int kr0 = (r & 3) + 8 * (r >> 2), delta = e0 - kr0;
        float bias = bu;
        if (!uni) { int di = delta * dstep; di = di < 0 ? 0 : (di > 2047 ? 2047 : di); bias = biasT[di]; }
        float v = sc[r] * (0.125f * LOG2E) + bias;
        if (MASKED) { const bool ok = delta >= 0 && delta <= 128 && (kb + (kr0 + 4 * hh) * dstep) >= 0; v = ok ? v : -INFINITY; }
        sc[r] = v; tmax = fmaxf(tmax, v);
    }
    tmax = pl32_max(tmax);
    const float mn = fmaxf(st.m, tmax);
    if (__ballot(mn > st.m) != 0ull) { const float scale = __builtin_amdgcn_exp2f(st.m - mn); st.l *= scale;
#pragma unroll
        for (int i = 0; i < 16; ++i) { st.o0[i] *= scale; st.o1[i] *= scale; } }
    st.m = mn;
    float ls = 0.f;
#pragma unroll
    for (int r = 0; r < 16; ++r) { sc[r] = __builtin_amdgcn_exp2f(sc[r] - mn); ls += sc[r]; }
    st.l += ls;
    typedef unsigned u32x4_t __attribute__((ext_vector_type(4)));
#pragma unroll
    for (int s2 = 0; s2 < 2; ++s2) {
        u32x4_t pw; pw.x = pg8::cvt_pk_bf16(sc[8 * s2], sc[8 * s2 + 1]); pw.y = pg8::cvt_pk_bf16(sc[8 * s2 + 2], sc[8 * s2 + 3]); pw.z = pg8::cvt_pk_bf16(sc[8 * s2 + 4], sc[8 * s2 + 5]); pw.w = pg8::cvt_pk_bf16(sc[8 * s2 + 6], sc[8 * s2 + 7]);
        const bf16x8 pf = __builtin_bit_cast(bf16x8, pw);
        const bf16x8 a0 = {vt[0][s2][0][0], vt[0][s2][0][1], vt[0][s2][0][2], vt[0][s2][0][3], vt[0][s2][1][0], vt[0][s2][1][1], vt[0][s2][1][2], vt[0][s2][1][3]};
        const bf16x8 a1 = {vt[1][s2][0][0], vt[1][s2][0][1], vt[1][s2][0][2], vt[1][s2][0][3], vt[1][s2][1][0], vt[1][s2][1][1], vt[1][s2][1][2], vt[1][s2][1][3]};
        st.o0 = __builtin_amdgcn_mfma_f32_32x32x16_bf16(a0, pf, st.o0, 0, 0, 0);
        st.o1 = __builtin_amdgcn_mfma_f32_32x32x16_bf16(a1, pf, st.o1, 0, 0, 0);
    }
}
__device__ __forceinline__ void dil_unit(LAS unsigned char* lds, int unit, int tid) {
    const int sp = unit & 3, h = (unit >> 2) & 7, b = unit >> 5, lane = tid & 63, wave = __builtin_amdgcn_readfirstlane(tid >> 6), r32 = lane & 31, hh = lane >> 5;
    LAS float* biasT = (LAS float*)(lds + MA_BIAS_OFF);
    build_bias(biasT, h, tid);
    __syncthreads();
    const bf16* PROJ = (const bf16*)(wsp() + WS_PROJ); const LAS int* TB = (const LAS int*)(biasT + 2048); const int rowb = b * SEQ, t0 = 512 * sp;
    const bf16* Qc = PROJ + CA_Q + 64 * h; const bf16* Kc = PROJ + CA_K + 64 * h; const bf16* Vc = PROJ + CA_V + 64 * h;
    LAS unsigned char* Vst = lds + MA_V_OFF + wave * MA_VW;
    const int vkey = lane >> 1, vhalf = lane & 1;
#pragma unroll 1
    for (int p = 0; p < 3; ++p) {
        const int d = p == 0 ? 1 : (p == 1 ? 4 : 16);
#pragma unroll 1
        for (int gi = 0; gi < 2; ++gi) {
            const int g = 2 * wave + gi;
            const int qb = t0 + (p == 0 ? 32 * g : (p == 1 ? 128 * (g >> 2) + (g & 3) : g));
            const int qpos = qb + r32 * d, qi = qpos - t0;
            bf16x8 qf[4]; attn_loadq(qf, Qc, rowb + qpos, hh);
            AttnSt st; attn_init(st);
            int jt = 0; while (qb + (32 * jt - 128 + 31) * d < 0) ++jt;
            bf16x8 kfn[4], vrn[4];
#define MA_GLOAD(JT) do { const int kb_ = qb + (32 * (JT) - 128) * d; int kp_ = kb_ + r32 * d; kp_ = kp_ < 0 ? 0 : kp_; const bf16* kr_ = Kc + (size_t)(rowb + kp_) * NPROJ_P + 8 * hh; \
                _Pragma("unroll") for (int s = 0; s < 4; ++s) kfn[s] = *(const GAS bf16x8*)(kr_ + 16 * s); \
                int vp_ = kb_ + vkey * d; vp_ = vp_ < 0 ? 0 : vp_; const bf16* vr_ = Vc + (size_t)(rowb + vp_) * NPROJ_P + 32 * vhalf; \
                _Pragma("unroll") for (int s = 0; s < 4; ++s) vrn[s] = *(const GAS bf16x8*)(vr_ + 8 * s); } while (0)
            MA_GLOAD(jt);
#pragma unroll 1
            for (; jt < 5; ++jt) {
                bf16x8 kf[4] = {kfn[0], kfn[1], kfn[2], kfn[3]};
                { LAS unsigned char* vd = Vst + vkey * MC_VP + 64 * vhalf;
#pragma unroll
                  for (int s = 0; s < 4; ++s) *(LAS bf16x8*)(vd + 16 * s) = vrn[s]; }
                asm volatile("" ::: "memory");
                if (jt + 1 < 5) MA_GLOAD(jt + 1);
                const int kb = qb + (32 * jt - 128) * d, dl0 = 128 - 32 * jt;
                if (jt == 0 || jt == 4 || kb < 0) dil_tile<true>(st, qf, kf, Vst, biasT, TB, dl0, d, kb, lane, r32, hh);
                else dil_tile<false>(st, qf, kf, Vst, biasT, TB, dl0, d, kb, lane, r32, hh);
            }
#undef MA_GLOAD
            float lt = st.l + __shfl_xor(st.l, 32);
            LAS unsigned char* orow = lds + qi * MA_PITCH; LAS float* ml = (LAS float*)(lds + MA_ML_OFF + qi * 8);
            if (p > 0) {
                const float mo = ml[0], lo = ml[1], mn = fmaxf(mo, st.m), fo = __builtin_amdgcn_exp2f(mo - mn), fc = __builtin_amdgcn_exp2f(st.m - mn);
                lt = lo * fo + lt * fc;
#pragma unroll
                for (int g4 = 0; g4 < 4; ++g4) { const v2u a = *(const LAS v2u*)(orow + 2 * (8 * g4 + 4 * hh)), c = *(const LAS v2u*)(orow + 64 + 2 * (8 * g4 + 4 * hh));
                    const float av[4] = {bflo(a.x), bfhi(a.x), bflo(a.y), bfhi(a.y)}, cv[4] = {bflo(c.x), bfhi(c.x), bflo(c.y), bfhi(c.y)};
#pragma unroll
                    for (int e = 0; e < 4; ++e) { st.o0[4 * g4 + e] = av[e] * fo + st.o0[4 * g4 + e] * fc; st.o1[4 * g4 + e] = cv[e] * fo + st.o1[4 * g4 + e] * fc; } }
                st.m = mn;
            }
            if (p < 2) {
#pragma unroll
                for (int g4 = 0; g4 < 4; ++g4) { *(LAS v2u*)(orow + 2 * (8 * g4 + 4 * hh)) = (v2u){pk2(st.o0[4 * g4], st.o0[4 * g4 + 1]), pk2(st.o0[4 * g4 + 2], st.o0[4 * g4 + 3])};
                    *(LAS v2u*)(orow + 64 + 2 * (8 * g4 + 4 * hh)) = (v2u){pk2(st.o1[4 * g4], st.o1[4 * g4 + 1]), pk2(st.o1[4 * g4 + 2], st.o1[4 * g4 + 3])}; }
                if (hh == 0) { ml[0] = st.m; ml[1] = lt; }
            } else attn_store(st.o0, st.o1, 1.0f / lt, (bf16*)(wsp() + WS_YCAT) + (size_t)(rowb + qpos) * DM + 0 * GW + 64 * h, hh);
        }
        __syncthreads();
    }
}

constexpr int SG_PITCH = 144, SG_WAVE = 128 * SG_PITCH, SG_OP = 272;
static_assert(8 * SG_WAVE <= MISC_OFF && 32 * SG_OP <= SG_WAVE, "SGU LDS");
__device__ __forceinline__ void sgu_unit(LAS unsigned char* lds, int unit, int tid, int l) {
    const int lane = tid & 63, g = __builtin_amdgcn_readfirstlane(tid >> 6), r32 = lane & 31, hh = lane >> 5, m0 = unit * 128;
    const bf16* PROJ = (const bf16*)(wsp() + WS_PROJ); bf16* YC = (bf16*)(wsp() + WS_YCAT); const pg8::fx_t* ST = (const pg8::fx_t*)(wsp() + CTL_STATS) + (size_t)l * M * 2;
    const float* lng = inp(4) + l * GW; const float* sw = inp(5) + ((size_t)l * NH + g) * 128 * 128; const float* sb = inp(6) + (l * NH + g) * 128;
    LAS unsigned char* T = lds + g * SG_WAVE;
    const int tk8 = lane >> 3, part = lane & 7;
    { const f32x4 g0 = *(const GAS f32x4*)(lng + 64 * g + 8 * part), g1 = *(const GAS f32x4*)(lng + 64 * g + 8 * part + 4);
      const float gn[8] = {g0.x, g0.y, g0.z, g0.w, g1.x, g1.y, g1.z, g1.w};
#pragma unroll 4
      for (int i = 0; i < 16; ++i) { const int tkn = tk8 + 8 * i, mm = m0 + tkn;
          const v4u w = *(const GAS v4u*)(PROJ + (size_t)mm * NPROJ_P + CB_V + 64 * g + 8 * part);
          const float mu = pg8::fx_get(ST + 2 * mm) * (1.0f / 512.0f), rs = __builtin_amdgcn_rsqf(fmaxf(pg8::fx_get(ST + 2 * mm + 1) * (1.0f / 512.0f) - mu * mu, 0.f) + 1e-5f);
          float x[8] = {bflo(w.x), bfhi(w.x), bflo(w.y), bfhi(w.y), bflo(w.z), bfhi(w.z), bflo(w.w), bfhi(w.w)};
#pragma unroll
          for (int e = 0; e < 8; ++e) x[e] = (gelu_tanh(x[e]) - mu) * rs * gn[e];
          *(LAS v4u*)(T + tkn * SG_PITCH + 16 * part) = (v4u){pk2(x[0], x[1]), pk2(x[2], x[3]), pk2(x[4], x[5]), pk2(x[6], x[7])}; } }
    asm volatile("" ::: "memory");
    f32x16 acc[4][2];
    const float z_ = zero_v();
#pragma unroll
    for (int tt = 0; tt < 4; ++tt)
#pragma unroll
        for (int ct = 0; ct < 2; ++ct)
#pragma unroll
            for (int i = 0; i < 16; ++i) acc[tt][ct][i] = z_;
    const LAS unsigned char* vb = T + (8 * hh + ((lane & 15) >> 2)) * SG_PITCH + (16 * ((lane >> 4) & 1) + 4 * (lane & 3)) * 2;
#pragma unroll
    for (int k = 0; k < 8; ++k) {
        v4i16_t t00 = __builtin_amdgcn_ds_read_tr16_b64_v4i16((LAS v4i16_t*)(vb + (16 * k) * SG_PITCH)), t01 = __builtin_amdgcn_ds_read_tr16_b64_v4i16((LAS v4i16_t*)(vb + (16 * k + 4) * SG_PITCH));
        v4i16_t t10 = __builtin_amdgcn_ds_read_tr16_b64_v4i16((LAS v4i16_t*)(vb + (16 * k) * SG_PITCH + 64)), t11 = __builtin_amdgcn_ds_read_tr16_b64_v4i16((LAS v4i16_t*)(vb + (16 * k + 4) * SG_PITCH + 64));
        const bf16x8 af0 = {t00[0], t00[1], t00[2], t00[3], t01[0], t01[1], t01[2], t01[3]}, af1 = {t10[0], t10[1], t10[2], t10[3], t11[0], t11[1], t11[2], t11[3]};
#pragma unroll
        for (int tt = 0; tt < 4; ++tt) { if (k < 2 * (tt + 1)) {
                const int t = 32 * tt + r32, s0 = 16 * k + 8 * hh; const float* wrow = sw + (size_t)t * 128 + s0;
                const f32x4 w0 = *(const GAS f32x4*)(wrow), w1 = *(const GAS f32x4*)(wrow + 4);
                float wv[8] = {w0.x, w0.y, w0.z, w0.w, w1.x, w1.y, w1.z, w1.w};
#pragma unroll
                for (int j = 0; j < 8; ++j) wv[j] = (s0 + j <= t) ? wv[j] : 0.f;
                const v4u bw = {pk2(wv[0], wv[1]), pk2(wv[2], wv[3]), pk2(wv[4], wv[5]), pk2(wv[6], wv[7])}; const bf16x8 bfr = __builtin_bit_cast(bf16x8, bw);
                acc[tt][0] = __builtin_amdgcn_mfma_f32_32x32x16_bf16(af0, bfr, acc[tt][0], 0, 0, 0); acc[tt][1] = __builtin_amdgcn_mfma_f32_32x32x16_bf16(af1, bfr, acc[tt][1], 0, 0, 0); } }
    }
    asm volatile("" ::: "memory");
#pragma unroll
    for (int tt = 0; tt < 4; ++tt) {
        const float bias = sb[32 * tt + r32];
#pragma unroll
        for (int ct = 0; ct < 2; ++ct)
#pragma unroll
            for (int g4 = 0; g4 < 4; ++g4) { const f32x16& a = acc[tt][ct];
                *(LAS f32x4*)(T + r32 * SG_OP + 4 * (32 * ct + 8 * g4 + 4 * hh)) = (f32x4){a[4 * g4] + bias, a[4 * g4 + 1] + bias, a[4 * g4 + 2] + bias, a[4 * g4 + 3] + bias}; }
        asm volatile("" ::: "memory");
#pragma unroll
        for (int i = 0; i < 4; ++i) { const int tkn = tk8 + 8 * i, mm = m0 + 32 * tt + tkn;
            const v4u uw = *(const GAS v4u*)(PROJ + (size_t)mm * NPROJ_P + CB_U + 64 * g + 8 * part);
            const f32x4 x0 = *(const LAS f32x4*)(T + tkn * SG_OP + 32 * part), x1 = *(const LAS f32x4*)(T + tkn * SG_OP + 32 * part + 16);
            const float u[8] = {bflo(uw.x), bfhi(uw.x), bflo(uw.y), bfhi(uw.y), bflo(uw.z), bfhi(uw.z), bflo(uw.w), bfhi(uw.w)};
            *(GAS v4u*)(YC + (size_t)mm * DM + GW + 64 * g + 8 * part) = (v4u){pk2(gelu_tanh(u[0]) * x0.x, gelu_tanh(u[1]) * x0.y), pk2(gelu_tanh(u[2]) * x0.z, gelu_tanh(u[3]) * x0.w), pk2(gelu_tanh(u[4]) * x1.x, gelu_tanh(u[5]) * x1.y), pk2(gelu_tanh(u[6]) * x1.z, gelu_tanh(u[7]) * x1.w)}; }
        asm volatile("" ::: "memory");
    }
}

#ifndef SIMPLE_A
#define SIMPLE_A 0
#endif
#ifndef SIMPLE_B
#define SIMPLE_B 0
#endif
#ifndef SIMPLE_C
#define SIMPLE_C 0
#endif
#ifndef SIMPLE_D
#define SIMPLE_D 0
#endif
__device__ __forceinline__ void ph_mixers(LAS unsigned char* L, int l, int phase, int qoff, int mask = 31) {
    Frame F = mkframe(L);
    volatile LAS int* qslot = (volatile LAS int*)(L + MISC_OFF + 64);
    gu32* ctr = ctlp() + CW_Q + 64 * phase + qoff;
    constexpr int I_IN = (DM / 64) * (NPROJ / 32), I_REST = (I8_OUT ? 0 : (DM / 64) * (DM / 32)) + 2 * (DM / 64) * (DFF / 32) + (DFF / 64) * (DM / 32);
    const int n_scan = (SIMPLE_D || !(mask & 1)) ? 0 : 128, n_c = (SIMPLE_C || !(mask & 2)) ? 0 : 512, n_a = (SIMPLE_A || !(mask & 4)) ? 0 : 256, n_b = (SIMPLE_B || !(mask & 8)) ? 0 : 128;
    const int n_cin = ((l + 1 < DEPTH) && (mask & 16)) ? (I8_IN ? NPROJ / 32 + (WINB_ITEMS + 7) / 8 : (I_IN + 7) / 8) : 0, n_crest = (mask & 16) ? (I_REST + 7) / 8 : 0, n_cout = (I8_OUT && (mask & 16)) ? DM / 32 : 0;
    const int e_scan = n_scan, e_a = e_scan + n_a, e_b = e_a + n_b, e_c = e_b + n_c, e_cout = e_c + n_cout, e_cin = e_cout + n_cin, e_crest = e_cin + n_crest;
    for (;;) {
        if (F.tid == 0) *qslot = (int)__hip_atomic_fetch_add(ctr, 1u, RLX_AGENT);
        __syncthreads();
        const int it = __builtin_amdgcn_readfirstlane(*qslot);
        __syncthreads();
        if (it >= e_crest) break;
        int tid = threadIdx.x; asm volatile("" : "+v"(tid));
        if (it < e_scan) scan_unit(L, it, tid);
        else if (it < e_a) dil_unit(L, it - e_scan, tid);
        else if (it < e_b) { sgu_unit(L, it - e_a, tid, l); __syncthreads(); }
        else if (it < e_c) { const int i2 = it - e_b; moba_unit(L, (i2 & 63) * 8 + (7 - (i2 >> 6)), tid, l); }
        else if (it < e_cout) { Frame F2 = mkframe(L); conv_cols_i8(inp(19) + (size_t)l * DM * DM, DM, DM, inp(18) + l * DM, wsp() + WS_WOUT, (float*)(wsp() + WS_SMALL + SM_SWOUT), it - e_c, F2); }
        else if (it < e_cin) { Frame F2 = mkframe(L);
            if (I8_IN) { if (it - e_cout < NPROJ / 32) conv_cols_i8(inp(2) + (size_t)(l + 1) * DM * NPROJ, DM, NPROJ, inp(1) + (l + 1) * DM, wsp() + WS_WIN, (float*)(wsp() + WS_SMALL + SM_SWIN), it - e_cout, F2);
                else conv_winb(F2, l + 1, (it - e_cout - NPROJ / 32) * 8 + F2.wave); }
            else conv_layer_items(F2, l + 1, (it - e_cout) * 8 + F2.wave, 1 << 30, true, false); }
        else { Frame F2 = mkframe(L); conv_layer_items(F2, l, (it - e_cin) * 8 + F2.wave, 1 << 30, false, true); }
    }
    if (!I8_IN && l + 1 < DEPTH) {
        bf16* WIN = (bf16*)(wsp() + WS_WIN);
        Frame F3 = mkframe(L);
        for (int i = F3.gw * 64 + F3.lane; i < 64 * DM / 8; i += F3.ngw * 64) { v4u z = {0u, 0u, 0u, 0u}; asm volatile("" : "+v"(z)); *(GAS v4u*)(WIN + (size_t)NPROJ * DM + (size_t)i * 8) = z; }
    }
    if (SIMPLE_D) mix_d_simple(F);
    if (SIMPLE_A) mix_a_simple(F);
    if (SIMPLE_C) mix_c_simple(F, l);
    if (SIMPLE_B) mix_b_simple(F, l);
}

__device__ __forceinline__ void ph_finalize(Frame& F, int l) {
    bf16* YC = (bf16*)(wsp() + WS_YCAT); const float* YD = (const float*)(wsp() + WS_YD); const bf16* V_ = (const bf16*)outp() + (size_t)3 * M * GW; const bf16* G_ = (const bf16*)(wsp() + WS_G); const float* BC = (const float*)(wsp() + WS_BC);
    const float* lng = inp(16) + l * GW; const float* lnb = inp(17) + l * GW;
    for (int m = F.gw; m < M; m += F.ngw) {
        const int c0 = 8 * F.lane, hd = F.lane >> 3;
        float y[8];
        { const GAS f32x4* yp = (const GAS f32x4*)(YD + (size_t)m * GW + c0); const f32x4 a = yp[0], b = yp[1]; y[0] = a.x; y[1] = a.y; y[2] = a.z; y[3] = a.w; y[4] = b.x; y[5] = b.y; y[6] = b.z; y[7] = b.w; }
        float s = 0.f;
#pragma unroll
        for (int i = 0; i < 8; ++i) s += y[i];
        s += __shfl_xor(s, 1); s += __shfl_xor(s, 2); s += __shfl_xor(s, 4); const float mean = s * (1.0f / 64.0f); float q = 0.f;
#pragma unroll
        for (int i = 0; i < 8; ++i) { const float d = y[i] - mean; q += d * d; }
        q += __shfl_xor(q, 1); q += __shfl_xor(q, 2); q += __shfl_xor(q, 4); const float rstd = 1.0f / sqrtf(q * (1.0f / 64.0f) + 64e-5f);
        const v4u vw = *(const GAS v4u*)(V_ + (size_t)m * GW + c0), gw4 = *(const GAS v4u*)(G_ + (size_t)m * GW + c0); const float bc = BC[(size_t)m * NH + hd];
        float vv[8], gg[8]; UNPACK8(vv, 0, vw); UNPACK8(gg, 0, gw4);
        float ss = 0.f;
#pragma unroll
        for (int i = 0; i < 8; ++i) { y[i] = ((y[i] - mean) * rstd * lng[c0 + i] + lnb[c0 + i] + bc * vv[i]) * gg[i]; ss += y[i] * y[i]; }
        if (I8_OUT) {
            float xn[3][8], mx = 0.f;
            { const float rs = 1.0f / sqrtf(wave_sum(ss) * (1.0f / 512.0f) + NORM_EPS);
#pragma unroll
              for (int i = 0; i < 8; ++i) { y[i] *= rs; mx = fmaxf(mx, fabsf(y[i])); } }
#pragma unroll
            for (int br = 0; br < 3; ++br) {
                const v4u w = *(const GAS v4u*)(YC + (size_t)m * DM + br * GW + c0); UNPACK8(xn[br], 0, w); float s2 = 0.f;
#pragma unroll
                for (int i = 0; i < 8; ++i) s2 += xn[br][i] * xn[br][i];
                const float rs = 1.0f / sqrtf(wave_sum(s2) * (1.0f / 512.0f) + NORM_EPS);
#pragma unroll
                for (int i = 0; i < 8; ++i) { xn[br][i] *= rs; mx = fmaxf(mx, fabsf(xn[br][i])); }
            }
            mx = wave_max(mx); const float inv = mx > 0.f ? 127.0f / mx : 0.f; unsigned char* yq = wsp() + WS_YQ + (size_t)m * DM + c0;
#pragma unroll
            for (int br = 0; br < 3; ++br) *(GAS v2u*)(yq + br * GW) = (v2u){q8pack4(xn[br][0], xn[br][1], xn[br][2], xn[br][3], inv), q8pack4(xn[br][4], xn[br][5], xn[br][6], xn[br][7], inv)};
            *(GAS v2u*)(yq + 3 * GW) = (v2u){q8pack4(y[0], y[1], y[2], y[3], inv), q8pack4(y[4], y[5], y[6], y[7], inv)};
            if (F.lane == 0) ((float*)(wsp() + WS_SMALL + SM_SAY))[m] = mx * (1.0f / 127.0f);
            continue;
        }
        { const float rs = 1.0f / sqrtf(wave_sum(ss) * (1.0f / 512.0f) + NORM_EPS);
          *(GAS v4u*)(YC + (size_t)m * DM + 3 * GW + c0) = (v4u){pk2(y[0] * rs, y[1] * rs), pk2(y[2] * rs, y[3] * rs), pk2(y[4] * rs, y[5] * rs), pk2(y[6] * rs, y[7] * rs)}; }
#pragma unroll
        for (int br = 0; br < 3; ++br) {
            GAS v4u* p = (GAS v4u*)(YC + (size_t)m * DM + br * GW + c0); const v4u w = *p;
            float x[8]; UNPACK8(x, 0, w); float s2 = 0.f;
#pragma unroll
            for (int i = 0; i < 8; ++i) s2 += x[i] * x[i];
            const float rs = 1.0f / sqrtf(wave_sum(s2) * (1.0f / 512.0f) + NORM_EPS);
            *p = (v4u){pk2(x[0] * rs, x[1] * rs), pk2(x[2] * rs, x[3] * rs), pk2(x[4] * rs, x[5] * rs), pk2(x[6] * rs, x[7] * rs)};
        }
    }
}
__device__ __forceinline__ void ph_final(Frame& F) {
    const pg8::fx_t* ssq = (const pg8::fx_t*)(ctlp() + CW_SSQ) + 4 * M; const float* g = inp(24); float* out = outp(); const bf16* XB = (const bf16*)(wsp() + WS_XB);
    for (int m = F.gw; m < M; m += F.ngw) {
        const float rs = 1.0f / sqrtf(pg8::fx_get(ssq + m) * (1.0f / 2048.0f) + NORM_EPS); GAS f32x4* orow = (GAS f32x4*)(out + (size_t)m * DM); const GAS v4u* xr = (const GAS v4u*)(XB + (size_t)m * DM) + F.lane; const GAS f32x4* gp = (const GAS f32x4*)g;
#pragma unroll
        for (int j = 0; j < 4; ++j) { const v4u w = xr[64 * j]; const int c4 = 2 * (F.lane + 64 * j); const f32x4 g0 = gp[c4], g1 = gp[c4 + 1];
            orow[c4] = (f32x4){bflo(w.x) * rs * g0.x, bfhi(w.x) * rs * g0.y, bflo(w.y) * rs * g0.z, bfhi(w.y) * rs * g0.w};
            orow[c4 + 1] = (f32x4){bflo(w.z) * rs * g1.x, bfhi(w.z) * rs * g1.y, bflo(w.w) * rs * g1.z, bfhi(w.w) * rs * g1.w}; }
    }
}

__global__ void __launch_bounds__(NTHR, 2) hy_fwd(Args args) {
    extern __shared__ __attribute__((aligned(16))) unsigned char lds[];
    LAS unsigned char* L = (LAS unsigned char*)lds;
    volatile LAS unsigned* MISC = (volatile LAS unsigned*)(L + MISC_OFF);
    if (threadIdx.x < 64) MISC[threadIdx.x] = 0u;
    __syncthreads();
    XcdBarrier bar; bar.bar = (unsigned*)(ctlp() + CW_BAR); bar.x = 0; bar.st = nullptr;
    if (N_LAUNCH_MODE == 0) bar = xcd_barrier_post((unsigned*)(ctlp() + CW_BAR), MISC + 8);
    const int lo = args.ph_lo, hi = args.ph_hi;
#define IN(k) (lo <= (k) && (k) < hi)
#define SEAM(k) do { if (IN(k) && IN((k) + 1)) xcd_barrier(bar); } while (0)
    if (IN(0)) { Frame F = mkframe(L); ph_prologue(F); if (REPEAT == 1) ph_prologue(F); }
    SEAM(0);
    auto layer = [&](const int l) __attribute__((always_inline)) {
        const int P = 1 + 8 * l;
        if (IN(P)) {
            unsigned char* ws = wsp(); pg8::Gemm g{(const bf16*)(ws + WS_XB), (const bf16*)(ws + WS_WIN), M, NPROJ_P, DM}; pg8::StaticOrder S; S.init(M, NPROJ_P, gridDim.x, (int)blockIdx.x);
            pg8::EpiProj E{(bf16*)(ws + WS_PROJ), NPROJ_P, (const pg8::fx_t*)((gu32*)ws + CW_SSQ) + (size_t)(2 * l) * M, (float*)(ws + CTL_KBAR) + (size_t)l * 64 * 8 * 64, (pg8::fx_t*)(ws + CTL_STATS) + (size_t)l * M * 2,
                           (const float*)(ws + WS_SMALL + SM_SAX), (const float*)(ws + WS_SMALL + SM_SWIN)};
            if (I8_IN) { g.A = (const bf16*)(ws + WS_XQ); pg8::MaskOrder S1; S1.init(M, 0xFFFFFFu & ~BFMASK, gridDim.x, (int)blockIdx.x);
                pg8::gemm_phase<pg8::EpiProj, pg8::MaskOrder, true, PG8_SP2, 1>(L + RING_OFF, g, S1, E);
                if (BFMASK) { pg8::Gemm gb{(const bf16*)(ws + WS_XB), winb_ptr(), M, NPROJ_P, DM}; pg8::MaskOrder S2; S2.init(M, BFMASK, gridDim.x, (int)blockIdx.x);
                    pg8::gemm_phase<pg8::EpiProj, pg8::MaskOrder, true, PG8_SP2>(L + RING_OFF, gb, S2, E); } }
            else pg8::gemm_phase<pg8::EpiProj, pg8::StaticOrder, true, PG8_SP2>(L + RING_OFF, g, S, E);
            if (REPEAT == 2) { if (I8_IN) pg8::gemm_phase<pg8::EpiProj, pg8::StaticOrder, true, PG8_SP2, 1>(L + RING_OFF, g, S, E); else pg8::gemm_phase<pg8::EpiProj, pg8::StaticOrder, true, PG8_SP2>(L + RING_OFF, g, S, E); }
        }
        SEAM(P);
        if (IN(P + 1)) { Frame F = mkframe(L); ph_prep(F, l); if (REPEAT == 3) ph_prep(F, l); }
        SEAM(P + 1);
        if (IN(P + 2)) { ph_mixers(L, l, P + 2, 0); if (REPEAT == 4) ph_mixers(L, l, P + 2, 32); if (REPEAT >= 40 && REPEAT < 50) ph_mixers(L, l, P + 2, 32, REPEAT == 41 ? 1 : (REPEAT == 42 ? 2 : (REPEAT == 43 ? 4 : (REPEAT == 44 ? 8 : 16)))); if (REPEAT >= 430 && REPEAT < 446) ph_mixers(L, l, P + 2, 32, 4); }
        SEAM(P + 2);
        if (IN(P + 3)) { Frame F = mkframe(L); ph_finalize(F, l); if (REPEAT == 5) ph_finalize(F, l); }
        SEAM(P + 3);
        if (IN(P + 4)) {
            unsigned char* ws = wsp(); pg8::Gemm g{(const bf16*)(ws + WS_YCAT), (const bf16*)(ws + WS_WOUT), M, DM, DM}; pg8::StaticOrder S; S.init(M, DM, gridDim.x, (int)blockIdx.x);
            pg8::EpiRes E{(bf16*)(ws + WS_XB), (pg8::fx_t*)((gu32*)ws + CW_SSQ) + (size_t)(2 * l + 1) * M, DM, FFN_FP8 ? (unsigned char*)(ws + WS_SC2) : nullptr, 1.0f, (const float*)(ws + WS_SMALL + SM_SAY), (const float*)(ws + WS_SMALL + SM_SWOUT)};
            if (I8_OUT) { g.A = (const bf16*)(ws + WS_YQ); pg8::gemm_phase<pg8::EpiRes, pg8::StaticOrder, true, PG8_SP2, 1>(L + RING_OFF, g, S, E); }
            else pg8::gemm_phase<pg8::EpiRes, pg8::StaticOrder, true, PG8_SP2>(L + RING_OFF, g, S, E);
        }
        SEAM(P + 4);
        if (IN(P + 5)) {
            unsigned char* ws = wsp(); pg8::Gemm g{(const bf16*)(ws + (FFN_FP8 ? WS_SC2 : WS_XB)), (const bf16*)(ws + WS_WGU), M, 2 * DFF, DM}; pg8::StaticOrder S; S.init(M, 2 * DFF, gridDim.x, (int)blockIdx.x);
            if (FFN_FP8) { pg8::EpiGU8 E{(unsigned char*)(ws + WS_PROJ), DFF, (const pg8::fx_t*)((gu32*)ws + CW_SSQ) + (size_t)(2 * l + 1) * M, 1.0f / 64.0f, 8.0f};
                pg8::gemm_phase_f8<pg8::EpiGU8, pg8::StaticOrder, true, PG8_SP2>(L + RING_OFF, g, S, E);
                if (REPEAT == 6) pg8::gemm_phase_f8<pg8::EpiGU8, pg8::StaticOrder, true, PG8_SP2>(L + RING_OFF, g, S, E);
            } else { pg8::EpiGU E{(bf16*)(ws + WS_PROJ), DFF, (const pg8::fx_t*)((gu32*)ws + CW_SSQ) + (size_t)(2 * l + 1) * M, 1.0f};
                pg8::gemm_phase<pg8::EpiGU, pg8::StaticOrder, true, PG8_SP2>(L + RING_OFF, g, S, E);
                if (REPEAT == 6) pg8::gemm_phase<pg8::EpiGU, pg8::StaticOrder, true, PG8_SP2>(L + RING_OFF, g, S, E); }
        }
        SEAM(P + 5);
        if (IN(P + 6)) {
            unsigned char* ws = wsp(); pg8::Gemm g{(const bf16*)(ws + WS_PROJ), (const bf16*)(ws + WS_WDN), M, DM, DFF}; pg8::StaticOrder S; S.init(M, DM, gridDim.x, (int)blockIdx.x);
            pg8::EpiRes E{(bf16*)(ws + WS_XB), (pg8::fx_t*)((gu32*)ws + CW_SSQ) + (size_t)(2 * l + 2) * M, DM, nullptr, FFN_FP8 ? 1.0f / 512.0f : 1.0f, nullptr, nullptr};
            if (FFN_FP8) pg8::gemm_phase_f8<pg8::EpiRes, pg8::StaticOrder, true, PG8_SP2>(L + RING_OFF, g, S, E);
            else pg8::gemm_phase<pg8::EpiRes, pg8::StaticOrder, true, PG8_SP2>(L + RING_OFF, g, S, E);
        }
        SEAM(P + 6);
        if (l + 1 < DEPTH) { if (I8_IN && IN(P + 7)) { Frame F = mkframe(L); ph_quantx(F); } if (I8_IN) SEAM(P + 7); }
    };
    static_assert(DEPTH == 2, "layers are expanded by hand");
    layer(0); layer(1);
    if (IN(16)) { Frame F = mkframe(L); ph_final(F); }
#undef IN
#undef SEAM
}

extern "C" void kernel_launch(void* const* d_in, const int* in_sizes, int n_in, void* d_out, int out_size, void* d_ws, size_t ws_size, hipStream_t stream) {
    static int grid = 0;
    if (grid == 0) {
        if (n_in != 25 || in_sizes[0] != M * DM || out_size != M * DM || ws_size < WS_END) { fprintf(stderr, "kernel_launch: shape/workspace mismatch: n_in %d in0 %d out %d ws %zu (need %zu)\n", n_in, n_in > 0 ? in_sizes[0] : -1, out_size, ws_size, (size_t)WS_END); grid = -1; return; }
        int dev = 0, cus = 0, per_cu = 0;
        if (hipGetDevice(&dev) != hipSuccess || hipDeviceGetAttribute(&cus, hipDeviceAttributeMultiprocessorCount, dev) != hipSuccess) { grid = -1; return; }
        if (hipFuncSetAttribute((const void*)hy_fwd, hipFuncAttributeMaxDynamicSharedMemorySize, LDS_BYTES) != hipSuccess) { fprintf(stderr, "kernel_launch: hipFuncSetAttribute failed\n"); grid = -1; return; }
        if (hipOccupancyMaxActiveBlocksPerMultiprocessor(&per_cu, (const void*)hy_fwd, NTHR, LDS_BYTES) != hipSuccess || per_cu < 1) fprintf(stderr, "kernel_launch: occupancy query reports %d\n", per_cu);
        (void)hipGetLastError();
        grid = cus;
    }
    if (grid < 0) return;
    if (hipMemsetAsync((char*)d_ws + WS_CTL, 0, CTL_ZERO_BYTES, stream) != hipSuccess) return;
    Args a{};
    for (int i = 0; i < 25; ++i) a.in[i] = (const float*)d_in[i];
    a.out = (float*)d_out; a.ws = (unsigned char*)d_ws;
    if (N_LAUNCH_MODE == 0) { a.ph_lo = 0; a.ph_hi = N_PHASES; hipLaunchKernelGGL(hy_fwd, dim3(grid), dim3(NTHR), LDS_BYTES, stream, a); }
    else for (int p = 0; p < N_PHASES; ++p) { a.ph_lo = p; a.ph_hi = p + 1; hipLaunchKernelGGL(hy_fwd, dim3(grid), dim3(NTHR), LDS_BYTES, stream, a); }
}
```

```cpp
#define N_LAUNCH_MODE 0
#define REPEAT 0
#define PG8_SP2 true
#define FFN_FP8 1
#define GEMM_I8 3
#define STAG 0
#define FFN1_I8 1
#define BFMASK 0x0u
#include <hip/hip_runtime.h>
#include <cstdio>
#include <cstdint>
namespace pg8 {
#define PG8_LAS __attribute__((address_space(3)))
typedef unsigned short bf16_t;
typedef short bf16x8 __attribute__((ext_vector_type(8)));
typedef float f32x4 __attribute__((ext_vector_type(4)));
typedef unsigned u32x4 __attribute__((ext_vector_type(4)));
constexpr int BM = 256, BK = 64, HALF = 128, HTB = HALF * BK * 2  , STAGE_BYTES = 8 * HTB, NXCD = 8, WGM = 8;

__host__ __device__ __forceinline__ int lds_byte(int r, int c) { const int st = (r >> 4) * 2 + (c >> 5), rr = r & 15, cc = c & 31, ob = rr * 64 + cc * 2; return st * 1024 + (ob ^ (((ob >> 9) & 1) << 5)); }
__host__ __device__ __forceinline__ void stage_rc(int b, int& R, int& C) { const int st = b / 1024, sb = b % 1024, swz = sb ^ (((sb >> 9) & 1) << 5); R = (st >> 1) * 16 + swz / 64; C = (st & 1) * 32 + (swz % 64) / 2; }
__host__ __device__ __forceinline__ int perm32(int rho) { const int n = rho >> 4, i = rho & 15; return 8 * (i >> 2) + 4 * n + (i & 3); }

__device__ __forceinline__ int lane_now() { int l; asm volatile("v_mbcnt_lo_u32_b32 %0, -1, 0\n\tv_mbcnt_hi_u32_b32 %0, -1, %0" : "=v"(l)); return l; }
struct Unit { int pm, pn; };
struct Gemm { const bf16_t* A; const bf16_t* Bt; int M, N, K, wv; };

struct StaticOrder {
    int nM, nN, nwg, G, c;
    __host__ __device__ void init(int M, int N, int G_, int c_) { nM = M / BM; nN = N / BM; nwg = nM * nN; G = G_; c = c_; }
    __host__ __device__ bool next(int i, Unit& u) const {
        const long L = (long)i * G + c; if (L >= nwg) return false;
        int wgid = (int)L; { const int q = nwg / NXCD, r = nwg % NXCD, xcd = wgid % NXCD, off = wgid / NXCD; wgid = (xcd < r ? xcd * (q + 1) : r * (q + 1) + (xcd - r) * q) + off; }
        const int nig = WGM * nN, gid = wgid / nig, fm = gid * WGM, gsz = (nM - fm) < WGM ? (nM - fm) : WGM;
        u.pm = fm + ((wgid % nig) % gsz); u.pn = (wgid % nig) / gsz; return true;
    }
    __device__ __forceinline__ void a_ready(const Unit&) const {}
    __device__ __forceinline__ void done(const Unit&) const {}
};

struct MapOrder {
    StaticOrder s; int from, add;
    __device__ __forceinline__ bool next(int i, Unit& u) const { if (!s.next(i, u)) return false; if (u.pn >= from) u.pn += add; return true; }
    __device__ __forceinline__ void a_ready(const Unit&) const {}
    __device__ __forceinline__ void done(const Unit&) const {}
};

struct MaskOrder {
    StaticOrder s; unsigned mask;
    __device__ __forceinline__ void init(int M, unsigned mask_, int G_, int c_) { mask = mask_; s.init(M, BM * __builtin_popcount(mask_), G_, c_); }
    __device__ __forceinline__ bool next(int i, Unit& u) const { if (!s.next(i, u)) return false; unsigned m = mask; for (int j = 0; j < u.pn; ++j) m &= m - 1; u.pn = __builtin_ctz(m); return true; }
    __device__ __forceinline__ void a_ready(const Unit&) const {}
    __device__ __forceinline__ void done(const Unit&) const {}
};

__device__ __forceinline__ unsigned cvt_pk_bf16(float lo, float hi) { unsigned r; asm volatile("v_cvt_pk_bf16_f32 %0, %1, %2" : "=v"(r) : "v"(lo), "v"(hi)); return r; }
typedef float f32x2 __attribute__((ext_vector_type(2)));

typedef unsigned u32x2 __attribute__((ext_vector_type(2)));
typedef unsigned long long fx_t;
__device__ __forceinline__ void fx_add(fx_t* p, float v) { atomicAdd(p, (fx_t)(long long)__float2ll_rn(v * 1073741824.0f)); }
__device__ __forceinline__ float fx_get(const fx_t* p) { return (float)(long long)(*p) * (1.0f / 1073741824.0f); }
__device__ __forceinline__ float epi_gelu(float x) { const float u = 0.7978845608028654f * (x + 0.044715f * x * x * x); const float e2 = __expf(2.0f * u); return 0.5f * x * (2.0f - 2.0f / (e2 + 1.0f)); }
template <int CTRL> __device__ __forceinline__ float epi_dpp_add(float x) { const int y = __builtin_amdgcn_update_dpp(0, __builtin_bit_cast(int, x), CTRL, 0xF, 0xF, false); return x + __builtin_bit_cast(float, y); }
typedef int i32x4_t __attribute__((ext_vector_type(4)));
__device__ __forceinline__ f32x4 acc_f(const f32x4& v) { return v; }
__device__ __forceinline__ f32x4 acc_f(const i32x4_t& v) { return __builtin_convertvector(v, f32x4); }
template <class T> struct AccIsInt { static constexpr bool v = false; };
template <> struct AccIsInt<i32x4_t> { static constexpr bool v = true; };
struct EpiProj {
    static constexpr bool PERM = true, AFTER_DRAIN = false;
    bf16_t* O; int ldc; const fx_t* ssq; float* kbar; fx_t* stats; const float* sa; const float* sw;
    template <class AccT> __device__ __forceinline__ void operator()(const AccT (&acc)[2][2][4][2], const Unit& u, int wr, int wc, int fr, int fq) const {
        constexpr bool Q = AccIsInt<AccT>::v;
        const int row0 = u.pm * BM + wr * 64 + fr, col0 = u.pn * BM + wc * 32 + 8 * fq;
        f32x4 cw[2][2];
        if constexpr (Q) {
#pragma unroll
            for (int bj = 0; bj < 2; ++bj) { cw[bj][0] = *(const f32x4*)(sw + col0 + bj * HALF); cw[bj][1] = *(const f32x4*)(sw + col0 + bj * HALF + 4); } }
        const bool do_k = (u.pn == 12 || u.pn == 13), do_s = (u.pn == 8 || u.pn == 9);
        float cs[2][8];
#pragma unroll
        for (int bj = 0; bj < 2; ++bj)
#pragma unroll
            for (int e = 0; e < 8; ++e) cs[bj][e] = 0.f;
#pragma unroll
        for (int ai = 0; ai < 2; ++ai)
#pragma unroll
            for (int m = 0; m < 4; ++m) { const int row = row0 + ai * HALF + m * 16; float rs = __builtin_amdgcn_rsqf(fx_get(ssq + row) * (1.0f / 2048.0f) + 1e-6f); if constexpr (Q) rs *= sa[row];
                bf16_t* rowp = O + (size_t)row * ldc + col0; float s1 = 0.f, s2 = 0.f;
#pragma unroll
                for (int bj = 0; bj < 2; ++bj) { f32x4 v0 = acc_f(acc[ai][bj][m][0]) * rs, v1 = acc_f(acc[ai][bj][m][1]) * rs; if constexpr (Q) { v0 *= cw[bj][0]; v1 *= cw[bj][1]; }
                    u32x4 w; w.x = cvt_pk_bf16(v0[0], v0[1]); w.y = cvt_pk_bf16(v0[2], v0[3]); w.z = cvt_pk_bf16(v1[0], v1[1]); w.w = cvt_pk_bf16(v1[2], v1[3]);
                    *(u32x4*)(rowp + bj * HALF) = w;
                    if (do_k) {
#pragma unroll
                        for (int e = 0; e < 4; ++e) { cs[bj][e] += v0[e]; cs[bj][4 + e] += v1[e]; } }
                    if (do_s) {
#pragma unroll
                        for (int e = 0; e < 4; ++e) { const float g0 = epi_gelu(v0[e]), g1 = epi_gelu(v1[e]); s1 += g0 + g1; s2 += g0 * g0 + g1 * g1; } } }
                if (do_s) { s1 += __shfl_xor(s1, 16); s1 += __shfl_xor(s1, 32); s2 += __shfl_xor(s2, 16); s2 += __shfl_xor(s2, 32);
                    if (fq == 0) { fx_add(stats + 2 * row, s1); fx_add(stats + 2 * row + 1, s2); } } }
        if (do_k) {
            const int bidx = (u.pm >> 3) * 8, n = u.pm & 7;
#pragma unroll
            for (int bj = 0; bj < 2; ++bj)
#pragma unroll
                for (int e = 0; e < 8; ++e) { float s = cs[bj][e]; s = epi_dpp_add<0xB1>(s); s = epi_dpp_add<0x4E>(s); s = epi_dpp_add<0x141>(s); s = epi_dpp_add<0x140>(s);
                    const int ck = col0 + bj * HALF + e - 3072;
                    if (fr == 0) unsafeAtomicAdd(kbar + ((bidx + (ck >> 6)) * 8 + n) * 64 + (ck & 63), s * (1.0f / 256.0f)); } }
    }
};
struct EpiGU {
    static constexpr bool PERM = true, AFTER_DRAIN = false;
    bf16_t* O; int ldc; const fx_t* ssq; float oscale;
    __device__ __forceinline__ void operator()(const f32x4 (&acc)[2][2][4][2], const Unit& u, int wr, int wc, int fr, int fq) const {
        const int row0 = u.pm * BM + wr * 64 + fr, col0 = u.pn * HALF + wc * 32 + 8 * fq;
#pragma unroll
        for (int ai = 0; ai < 2; ++ai)
#pragma unroll
            for (int m = 0; m < 4; ++m) { const int row = row0 + ai * HALF + m * 16; const float rs = __builtin_amdgcn_rsqf(fx_get(ssq + row) * (1.0f / 2048.0f) + 1e-6f) * oscale;
                float o[8];
#pragma unroll
                for (int n = 0; n < 2; ++n)
#pragma unroll
                    for (int e = 0; e < 4; ++e) { const float g = acc[ai][0][m][n][e] * rs, up = acc[ai][1][m][n][e] * rs;
                        o[n * 4 + e] = g * __builtin_amdgcn_rcpf(1.0f + __builtin_amdgcn_exp2f(-1.4426950408889634f * g)) * up; }
                u32x4 w; w.x = cvt_pk_bf16(o[0], o[1]); w.y = cvt_pk_bf16(o[2], o[3]); w.z = cvt_pk_bf16(o[4], o[5]); w.w = cvt_pk_bf16(o[6], o[7]);
                *(u32x4*)(O + (size_t)row * ldc + col0) = w; }
    }
};
__device__ __forceinline__ float epi_clamp8(float v) { return __builtin_amdgcn_fmed3f(v, -448.0f, 448.0f); }
struct EpiGU8 {
    static constexpr bool PERM = true, AFTER_DRAIN = false;
    unsigned char* O; int ldc; const fx_t* ssq; float oscale, ascale; const float* sa; const float* sw;
    template <class AccT> __device__ __forceinline__ void operator()(const AccT (&acc)[2][2][4][2], const Unit& u, int wr, int wc, int fr, int fq) const {
        constexpr bool Q = AccIsInt<AccT>::v;
        const int row0 = u.pm * BM + wr * 64 + fr, col0 = u.pn * HALF + wc * 32 + 8 * fq;
        f32x4 cw[2][2];
        if constexpr (Q) {
#pragma unroll
            for (int bj = 0; bj < 2; ++bj) { const float* p = sw + u.pn * BM + bj * HALF + wc * 32 + 8 * fq; cw[bj][0] = *(const f32x4*)p; cw[bj][1] = *(const f32x4*)(p + 4); } }
#pragma unroll
        for (int ai = 0; ai < 2; ++ai)
#pragma unroll
            for (int m = 0; m < 4; ++m) { const int row = row0 + ai * HALF + m * 16; float rs = __builtin_amdgcn_rsqf(fx_get(ssq + row) * (1.0f / 2048.0f) + 1e-6f) * oscale; if constexpr (Q) rs *= sa[row];
                float o[8];
#pragma unroll
                for (int n = 0; n < 2; ++n) { f32x4 gv = acc_f(acc[ai][0][m][n]) * rs, uv = acc_f(acc[ai][1][m][n]) * rs; if constexpr (Q) { gv *= cw[0][n]; uv *= cw[1][n]; }
#pragma unroll
                    for (int e = 0; e < 4; ++e) { const float g = gv[e], up = uv[e];
                        o[n * 4 + e] = epi_clamp8(g * __builtin_amdgcn_rcpf(1.0f + __builtin_amdgcn_exp2f(-1.4426950408889634f * g)) * up * ascale); } }
                int f0 = __builtin_bit_cast(int, o[0]), f1 = __builtin_bit_cast(int, o[4]);
                f0 = __builtin_amdgcn_cvt_pk_fp8_f32(o[0], o[1], f0, false); f0 = __builtin_amdgcn_cvt_pk_fp8_f32(o[2], o[3], f0, true);
                f1 = __builtin_amdgcn_cvt_pk_fp8_f32(o[4], o[5], f1, false); f1 = __builtin_amdgcn_cvt_pk_fp8_f32(o[6], o[7], f1, true);
                *(u32x2*)(O + (size_t)row * ldc + col0) = (u32x2){(unsigned)f0, (unsigned)f1}; }
    }
};
struct EpiRes {
    static constexpr bool PERM = true, AFTER_DRAIN = false;
    bf16_t* xb; fx_t* ssq; int ldc; unsigned char* xf; float oscale; const float* sa; const float* sw;
    template <class AccT> __device__ __forceinline__ void operator()(const AccT (&acc)[2][2][4][2], const Unit& u, int wr, int wc, int fr, int fq) const {
        constexpr bool Q = AccIsInt<AccT>::v;
        const int row0 = u.pm * BM + wr * 64 + fr, col0 = u.pn * BM + wc * 32 + 8 * fq;
        f32x4 cw[2][2];
        if constexpr (Q) {
#pragma unroll
            for (int bj = 0; bj < 2; ++bj) { cw[bj][0] = *(const f32x4*)(sw + col0 + bj * HALF); cw[bj][1] = *(const f32x4*)(sw + col0 + bj * HALF + 4); } }
#pragma unroll
        for (int ai = 0; ai < 2; ++ai)
#pragma unroll
            for (int m = 0; m < 4; ++m) { const int row = row0 + ai * HALF + m * 16; bf16_t* rowp = xb + (size_t)row * ldc + col0; float s = 0.f; float osc = oscale; if constexpr (Q) osc = sa[row];
                u32x4 b[2];
#pragma unroll
                for (int bj = 0; bj < 2; ++bj) b[bj] = *(const u32x4*)(rowp + bj * HALF);
#pragma unroll
                for (int bj = 0; bj < 2; ++bj) { float o[8]; f32x4 a2[2] = {acc_f(acc[ai][bj][m][0]), acc_f(acc[ai][bj][m][1])}; if constexpr (Q) { a2[0] *= cw[bj][0]; a2[1] *= cw[bj][1]; }
#pragma unroll
                    for (int q = 0; q < 4; ++q) { o[2 * q] = __builtin_fmaf(a2[q >> 1][2 * (q & 1)], osc, __builtin_bit_cast(float, b[bj][q] << 16)); o[2 * q + 1] = __builtin_fmaf(a2[q >> 1][2 * (q & 1) + 1], osc, __builtin_bit_cast(float, b[bj][q] & 0xffff0000u)); }
                    u32x4 w; w.x = cvt_pk_bf16(o[0], o[1]); w.y = cvt_pk_bf16(o[2], o[3]); w.z = cvt_pk_bf16(o[4], o[5]); w.w = cvt_pk_bf16(o[6], o[7]);
                    *(u32x4*)(rowp + bj * HALF) = w;
                    if (xf) { int f0 = (int)b[bj][0], f1 = (int)b[bj][1]; f0 = __builtin_amdgcn_cvt_pk_fp8_f32(epi_clamp8(o[0]), epi_clamp8(o[1]), f0, false); f0 = __builtin_amdgcn_cvt_pk_fp8_f32(epi_clamp8(o[2]), epi_clamp8(o[3]), f0, true);
                        f1 = __builtin_amdgcn_cvt_pk_fp8_f32(epi_clamp8(o[4]), epi_clamp8(o[5]), f1, false); f1 = __builtin_amdgcn_cvt_pk_fp8_f32(epi_clamp8(o[6]), epi_clamp8(o[7]), f1, true);
                        *(u32x2*)(xf + (size_t)row * ldc + col0 + bj * HALF) = (u32x2){(unsigned)f0, (unsigned)f1}; }
#pragma unroll
                    for (int q = 0; q < 8; ++q) s += o[q] * o[q]; }
                s += __shfl_xor(s, 16); s += __shfl_xor(s, 32);
                if (fq == 0) fx_add(ssq + row, s); }
    }
};
typedef int i32x8_t __attribute__((ext_vector_type(8)));
__device__ __forceinline__ void mma16(f32x4& c, const bf16x8& a, const bf16x8& b) { c = __builtin_amdgcn_mfma_f32_16x16x32_bf16(a, b, c, 0, 0, 0); }
__device__ __forceinline__ void mma16(i32x4_t& c, const bf16x8& a, const bf16x8& b) { c = __builtin_amdgcn_mfma_i32_16x16x64_i8(__builtin_bit_cast(i32x4_t, a), __builtin_bit_cast(i32x4_t, b), c, 0, 0, 0); }
template <int EB> struct AccOf { typedef f32x4 type; };
template <> struct AccOf<1> { typedef i32x4_t type; };
template <class Epi, class Sched, bool ALIGN_EPI = false, bool SP2 = false, int EB = 2>
__device__ __forceinline__ void gemm_phase(PG8_LAS unsigned char* lds, const Gemm g, const Sched& S, const Epi& E) {
    int tid_ = g.wv * 64 + lane_now(); asm volatile("" : "+v"(tid_));
    const int tid = tid_, wid = __builtin_amdgcn_readfirstlane(tid >> 6), lane = tid & 63, wr = wid >> 2, wc = wid & 3, fr = lane & 15, fq = lane >> 4;
    const int K = g.K, nt = K * EB / (2 * BK);
    unsigned voffA[2], voffB[2];
#pragma unroll
    for (int i = 0; i < 2; ++i) { int R, C; stage_rc(tid * 16 + i * 8192, R, C); const int Rb = Epi::PERM ? ((R & ~31) + perm32(R & 31)) : R;
        voffA[i] = (unsigned)(R * K * EB + 2 * C); voffB[i] = (unsigned)(Rb * K * EB + 2 * C); }
    const unsigned kstep = (unsigned)(BK * 2);
    const unsigned hstep = (unsigned)HALF * K * EB;
    const unsigned tstep = 2 * hstep;
    const unsigned ldsw = (unsigned)wid * 1024u;
    const int aoff = lds_byte(wr * 64 + fr, fq * 8), boff = lds_byte(wc * 32 + fr, fq * 8);
#define PG8_SA(b, h) (((b) * 2 + (h)) * HTB)
#define PG8_SB(b, h) ((4 + (b) * 2 + (h)) * HTB)
#define PG8_STAGE(bufoff, rsrc, soff, voff) do { _Pragma("unroll") for (int _i = 0; _i < 2; ++_i) \
        __builtin_amdgcn_raw_ptr_buffer_load_lds(rsrc, (PG8_LAS void*)(lds + (bufoff) + ldsw + _i * 8192), 16, (int)(voff)[_i], (int)(soff), 0, 0); } while (0)
#define PG8_LDA(dst, b, h) do { _Pragma("unroll") for (int m = 0; m < 4; ++m) _Pragma("unroll") for (int k = 0; k < 2; ++k) dst[m][k] = *(const PG8_LAS bf16x8*)(lds + PG8_SA(b, h) + aoff + m * 2048 + k * 1024); } while (0)
#define PG8_LDB(dst, b, h) do { _Pragma("unroll") for (int n = 0; n < 2; ++n) _Pragma("unroll") for (int k = 0; k < 2; ++k) dst[n][k] = *(const PG8_LAS bf16x8*)(lds + PG8_SB(b, h) + boff + n * 2048 + k * 1024); } while (0)
#define PG8_MMA(ai, bj, At, Bt) do { __builtin_amdgcn_s_setprio(1); _Pragma("unroll") for (int m = 0; m < 4; ++m) _Pragma("unroll") for (int n = 0; n < 2; ++n) _Pragma("unroll") for (int k = 0; k < 2; ++k) \
        mma16(acc[ai][bj][m][n], Bt[n][k], At[m][k]); __builtin_amdgcn_s_setprio(0); } while (0)
#define PG8_WAIT_V(n) asm volatile("s_waitcnt vmcnt(" #n ")" ::: "memory")
#define PG8_WAIT_L(n) asm volatile("s_waitcnt lgkmcnt(" #n ")" ::: "memory")
#define PG8_BAR __builtin_amdgcn_s_barrier()
#define PG8_SCHED __builtin_amdgcn_sched_barrier(0)
    Unit cur, nxt; int ui = 0;
    if (!S.next(0, cur)) return;
    typedef typename AccOf<EB>::type acc_t; acc_t acc[2][2][4][2];
#pragma unroll
    for (int a = 0; a < 2; ++a)
#pragma unroll
        for (int b = 0; b < 2; ++b)
#pragma unroll
            for (int m = 0; m < 4; ++m)
#pragma unroll
                for (int n = 0; n < 2; ++n) acc[a][b][m][n] = acc_t{};
    bf16x8 At[4][2], B0[2][2], B1[2][2];
    const __amdgpu_buffer_rsrc_t rA = __builtin_amdgcn_make_buffer_rsrc((void*)g.A, (short)0, -1, 0x00020000), rB = __builtin_amdgcn_make_buffer_rsrc((void*)g.Bt, (short)0, -1, 0x00020000);
    unsigned cA = (unsigned)cur.pm * tstep, cB = (unsigned)cur.pn * tstep;
    S.a_ready(cur);
    if constexpr (SP2) {
        PG8_STAGE(PG8_SB(0, 0), rB, cB, voffB); PG8_STAGE(PG8_SB(0, 1), rB, cB + hstep, voffB); PG8_STAGE(PG8_SA(0, 0), rA, cA, voffA); PG8_STAGE(PG8_SA(0, 1), rA, cA + hstep, voffA);
        if (wr == 1) PG8_BAR;
        PG8_WAIT_V(2); PG8_BAR;
        PG8_STAGE(PG8_SB(1, 0), rB, cB + kstep, voffB); PG8_STAGE(PG8_SA(1, 0), rA, cA + kstep, voffA); PG8_STAGE(PG8_SB(1, 1), rB, cB + hstep + kstep, voffB);
        PG8_WAIT_V(6); PG8_BAR;
    } else {
        PG8_STAGE(PG8_SB(0, 0), rB, cB, voffB); PG8_STAGE(PG8_SA(0, 0), rA, cA, voffA); PG8_STAGE(PG8_SB(0, 1), rB, cB + hstep, voffB); PG8_STAGE(PG8_SA(0, 1), rA, cA + hstep, voffA);
        if (wr == 1) PG8_BAR;
        PG8_WAIT_V(4); PG8_BAR;
        PG8_STAGE(PG8_SB(1, 0), rB, cB + kstep, voffB); PG8_STAGE(PG8_SA(1, 0), rA, cA + kstep, voffA); PG8_STAGE(PG8_SB(1, 1), rB, cB + hstep + kstep, voffB);
        PG8_WAIT_V(6); PG8_BAR;
    }
    for (;;) {
        const bool has_next = S.next(ui + 1, nxt);
        const unsigned nA = has_next ? (unsigned)nxt.pm * tstep : cA, nB = has_next ? (unsigned)nxt.pn * tstep : cB;
        for (int t = 0; t < nt; t += 2) {
            const bool last = (t == nt - 2);
            const unsigned a1 = cA + (unsigned)(t + 1) * kstep;
            const unsigned a2 = last ? nA : cA + (unsigned)(t + 2) * kstep, b2 = last ? nB : cB + (unsigned)(t + 2) * kstep;
            const unsigned a3 = a2 + kstep, b3 = b2 + kstep;
            if (last && has_next) S.a_ready(nxt);
            if constexpr (SP2) {
            PG8_LDB(B0, 0, 0); PG8_LDB(B1, 0, 1); PG8_SCHED; PG8_LDA(At, 0, 0); PG8_STAGE(PG8_SA(1, 1), rA, a1 + hstep, voffA);
            PG8_WAIT_V(8); PG8_WAIT_L(0); PG8_BAR; PG8_MMA(0, 0, At, B0); PG8_MMA(0, 1, At, B1); PG8_BAR; PG8_SCHED;
            PG8_LDA(At, 0, 1); PG8_STAGE(PG8_SB(0, 0), rB, b2, voffB); PG8_STAGE(PG8_SB(0, 1), rB, b2 + hstep, voffB); PG8_STAGE(PG8_SA(0, 0), rA, a2, voffA);
            PG8_WAIT_V(8); PG8_WAIT_L(0); PG8_BAR; PG8_MMA(1, 0, At, B0); PG8_MMA(1, 1, At, B1); PG8_BAR; PG8_SCHED;
            PG8_LDB(B0, 1, 0); PG8_LDB(B1, 1, 1); PG8_SCHED; PG8_LDA(At, 1, 0); PG8_STAGE(PG8_SA(0, 1), rA, a2 + hstep, voffA);
            PG8_WAIT_V(8); PG8_WAIT_L(0); PG8_BAR; PG8_MMA(0, 0, At, B0); PG8_MMA(0, 1, At, B1); PG8_BAR; PG8_SCHED;
            PG8_LDA(At, 1, 1); PG8_STAGE(PG8_SB(1, 0), rB, b3, voffB); PG8_STAGE(PG8_SB(1, 1), rB, b3 + hstep, voffB); PG8_STAGE(PG8_SA(1, 0), rA, a3, voffA);
            PG8_WAIT_V(8); PG8_WAIT_L(0); PG8_BAR; PG8_MMA(1, 0, At, B0); PG8_MMA(1, 1, At, B1); PG8_BAR; PG8_SCHED;
            } else {
            PG8_LDB(B0, 0, 0); PG8_SCHED; PG8_LDA(At, 0, 0); PG8_STAGE(PG8_SA(1, 1), rA, a1 + hstep, voffA);
            PG8_WAIT_L(8); PG8_BAR; PG8_WAIT_L(0); PG8_MMA(0, 0, At, B0); PG8_BAR; PG8_SCHED;
            PG8_LDB(B1, 0, 1); PG8_STAGE(PG8_SB(0, 0), rB, b2, voffB);
            PG8_BAR; PG8_WAIT_L(0); PG8_MMA(0, 1, At, B1); PG8_BAR;
            PG8_LDA(At, 0, 1); PG8_STAGE(PG8_SA(0, 0), rA, a2, voffA);
            PG8_BAR; PG8_WAIT_L(0); PG8_MMA(1, 0, At, B0); PG8_BAR; PG8_SCHED;
            PG8_STAGE(PG8_SB(0, 1), rB, b2 + hstep, voffB);
            PG8_WAIT_V(6); PG8_BAR; PG8_MMA(1, 1, At, B1); PG8_BAR;
            PG8_LDB(B0, 1, 0); PG8_SCHED; PG8_LDA(At, 1, 0); PG8_STAGE(PG8_SA(0, 1), rA, a2 + hstep, voffA);
            PG8_WAIT_L(8); PG8_BAR; PG8_WAIT_L(0); PG8_MMA(0, 0, At, B0); PG8_BAR; PG8_SCHED;
            PG8_LDB(B1, 1, 1); PG8_STAGE(PG8_SB(1, 0), rB, b3, voffB);
            PG8_BAR; PG8_WAIT_L(0); PG8_MMA(0, 1, At, B1); PG8_BAR;
            PG8_LDA(At, 1, 1); PG8_STAGE(PG8_SA(1, 0), rA, a3, voffA);
            PG8_BAR; PG8_WAIT_L(0); PG8_MMA(1, 0, At, B0); PG8_BAR; PG8_SCHED;
            PG8_STAGE(PG8_SB(1, 1), rB, b3 + hstep, voffB);
            PG8_WAIT_V(6); PG8_BAR; PG8_MMA(1, 1, At, B1); PG8_BAR;
            }
        }
        if constexpr (ALIGN_EPI) { if (wr == 0) PG8_BAR; }
        if constexpr (!Epi::AFTER_DRAIN) { int ln_ = (int)__builtin_amdgcn_mbcnt_hi(~0u, __builtin_amdgcn_mbcnt_lo(~0u, 0u)); asm volatile("" : "+v"(ln_));
            E(acc, cur, wr, wc, ln_ & 15, ln_ >> 4); S.done(cur); }
        if (!has_next) break;
#pragma unroll
        for (int a = 0; a < 2; ++a)
#pragma unroll
            for (int b = 0; b < 2; ++b)
#pragma unroll
                for (int m = 0; m < 4; ++m)
#pragma unroll
                    for (int n = 0; n < 2; ++n) acc[a][b][m][n] = acc_t{};
        cur = nxt; cA = nA; cB = nB; ++ui;
        if constexpr (ALIGN_EPI) { if (wr == 1) PG8_BAR; }
    }
    PG8_WAIT_V(0);
    if constexpr (!ALIGN_EPI) { if (wr == 0) PG8_BAR; }
    PG8_BAR;
    if constexpr (Epi::AFTER_DRAIN) { E.fused(acc, cur, wr, wc, fr, fq, lds, wid, lane); S.done(cur); }
#undef PG8_SA
#undef PG8_SB
#undef PG8_STAGE
#undef PG8_LDA
#undef PG8_LDB
#undef PG8_MMA
#undef PG8_WAIT_V
#undef PG8_WAIT_L
#undef PG8_BAR
#undef PG8_SCHED
}
template <class Epi, class Sched, bool ALIGN_EPI = false, bool SP2 = false>
__device__ __forceinline__ void gemm_phase_f8(PG8_LAS unsigned char* lds, const Gemm g, const Sched& S, const Epi& E) {
    int tid_ = g.wv * 64 + lane_now(); asm volatile("" : "+v"(tid_));
    const int tid = tid_, wid = __builtin_amdgcn_readfirstlane(tid >> 6), lane = tid & 63, wr = wid >> 2, wc = wid & 3, fr = lane & 15, fq = lane >> 4;
    const int K = g.K, nt = K / (2 * BK);
    unsigned voffA[2], voffB[2];
#pragma unroll
    for (int i = 0; i < 2; ++i) { int R, C; stage_rc(tid * 16 + i * 8192, R, C); const int Rb = Epi::PERM ? ((R & ~31) + perm32(R & 31)) : R;
        voffA[i] = (unsigned)(R * K + 2 * C); voffB[i] = (unsigned)(Rb * K + 2 * C); }
    const unsigned kstep = (unsigned)(BK * 2);
    const unsigned hstep = (unsigned)HALF * K;
    const unsigned tstep = 2 * hstep;
    const unsigned ldsw = (unsigned)wid * 1024u;
    const int aoff = lds_byte(wr * 64 + fr, fq * 16) ^ ((fq & 1) << 4), boff = lds_byte(wc * 32 + fr, fq * 16) ^ ((fq & 1) << 4), aoff2 = aoff ^ 16, boff2 = boff ^ 16;
#define PG8_SA(b, h) (((b) * 2 + (h)) * HTB)
#define PG8_SB(b, h) ((4 + (b) * 2 + (h)) * HTB)
#define PG8_STAGE(bufoff, rsrc, soff, voff) do { _Pragma("unroll") for (int _i = 0; _i < 2; ++_i) \
        __builtin_amdgcn_raw_ptr_buffer_load_lds(rsrc, (PG8_LAS void*)(lds + (bufoff) + ldsw + _i * 8192), 16, (int)(voff)[_i], (int)(soff), 0, 0); } while (0)
#define PG8_LDA(dst, b, h) do { _Pragma("unroll") for (int m = 0; m < 4; ++m) { const i32x4_t lo_ = *(const PG8_LAS i32x4_t*)(lds + PG8_SA(b, h) + aoff + m * 2048), hi_ = *(const PG8_LAS i32x4_t*)(lds + PG8_SA(b, h) + aoff2 + m * 2048); dst[m] = __builtin_shufflevector(lo_, hi_, 0, 1, 2, 3, 4, 5, 6, 7); } } while (0)
#define PG8_LDB(dst, b, h) do { _Pragma("unroll") for (int n = 0; n < 2; ++n) { const i32x4_t lo_ = *(const PG8_LAS i32x4_t*)(lds + PG8_SB(b, h) + boff + n * 2048), hi_ = *(const PG8_LAS i32x4_t*)(lds + PG8_SB(b, h) + boff2 + n * 2048); dst[n] = __builtin_shufflevector(lo_, hi_, 0, 1, 2, 3, 4, 5, 6, 7); } } while (0)
#define PG8_F8CAT(lo, hi) __builtin_shufflevector(__builtin_bit_cast(i32x4_t, lo), __builtin_bit_cast(i32x4_t, hi), 0, 1, 2, 3, 4, 5, 6, 7)
#define PG8_MMA(ai, bj, At, Bt) do { __builtin_amdgcn_s_setprio(1); _Pragma("unroll") for (int m = 0; m < 4; ++m) _Pragma("unroll") for (int n = 0; n < 2; ++n) \
        acc[ai][bj][m][n] = __builtin_amdgcn_mfma_scale_f32_16x16x128_f8f6f4(Bt[n], At[m], acc[ai][bj][m][n], 0, 0, 0, 0, 0, 0); __builtin_amdgcn_s_setprio(0); } while (0)
#define PG8_WAIT_V(n) asm volatile("s_waitcnt vmcnt(" #n ")" ::: "memory")
#define PG8_WAIT_L(n) asm volatile("s_waitcnt lgkmcnt(" #n ")" ::: "memory")
#define PG8_BAR __builtin_amdgcn_s_barrier()
#define PG8_SCHED __builtin_amdgcn_sched_barrier(0)
    Unit cur, nxt; int ui = 0;
    if (!S.next(0, cur)) return;
    f32x4 acc[2][2][4][2];
#pragma unroll
    for (int a = 0; a < 2; ++a)
#pragma unroll
        for (int b = 0; b < 2; ++b)
#pragma unroll
            for (int m = 0; m < 4; ++m)
#pragma unroll
                for (int n = 0; n < 2; ++n) acc[a][b][m][n] = (f32x4){0.f, 0.f, 0.f, 0.f};
    i32x8_t At[4], B0[2], B1[2];
    const __amdgpu_buffer_rsrc_t rA = __builtin_amdgcn_make_buffer_rsrc((void*)g.A, (short)0, -1, 0x00020000), rB = __builtin_amdgcn_make_buffer_rsrc((void*)g.Bt, (short)0, -1, 0x00020000);
    unsigned cA = (unsigned)cur.pm * tstep, cB = (unsigned)cur.pn * tstep;
    S.a_ready(cur);
    if constexpr (SP2) {
        PG8_STAGE(PG8_SB(0, 0), rB, cB, voffB); PG8_STAGE(PG8_SB(0, 1), rB, cB + hstep, voffB); PG8_STAGE(PG8_SA(0, 0), rA, cA, voffA); PG8_STAGE(PG8_SA(0, 1), rA, cA + hstep, voffA);
        if (wr == 1) PG8_BAR;
        PG8_WAIT_V(2); PG8_BAR;
        PG8_STAGE(PG8_SB(1, 0), rB, cB + kstep, voffB); PG8_STAGE(PG8_SA(1, 0), rA, cA + kstep, voffA); PG8_STAGE(PG8_SB(1, 1), rB, cB + hstep + kstep, voffB);
        PG8_WAIT_V(6); PG8_BAR;
    } else {
        PG8_STAGE(PG8_SB(0, 0), rB, cB, voffB); PG8_STAGE(PG8_SA(0, 0), rA, cA, voffA); PG8_STAGE(PG8_SB(0, 1), rB, cB + hstep, voffB); PG8_STAGE(PG8_SA(0, 1), rA, cA + hstep, voffA);
        if (wr == 1) PG8_BAR;
        PG8_WAIT_V(4); PG8_BAR;
        PG8_STAGE(PG8_SB(1, 0), rB, cB + kstep, voffB); PG8_STAGE(PG8_SA(1, 0), rA, cA + kstep, voffA); PG8_STAGE(PG8_SB(1, 1), rB, cB + hstep + kstep, voffB);
        PG8_WAIT_V(6); PG8_BAR;
    }
    for (;;) {
        const bool has_next = S.next(ui + 1, nxt);
        const unsigned nA = has_next ? (unsigned)nxt.pm * tstep : cA, nB = has_next ? (unsigned)nxt.pn * tstep : cB;
        for (int t = 0; t < nt; t += 2) {
            const bool last = (t == nt - 2);
            const unsigned a1 = cA + (unsigned)(t + 1) * kstep;
            const unsigned a2 = last ? nA : cA + (unsigned)(t + 2) * kstep, b2 = last ? nB : cB + (unsigned)(t + 2) * kstep;
            const unsigned a3 = a2 + kstep, b3 = b2 + kstep;
            if (last && has_next) S.a_ready(nxt);
            if constexpr (SP2) {
            PG8_LDB(B0, 0, 0); PG8_LDB(B1, 0, 1); PG8_SCHED; PG8_LDA(At, 0, 0); PG8_STAGE(PG8_SA(1, 1), rA, a1 + hstep, voffA);
            PG8_WAIT_V(8); PG8_WAIT_L(0); PG8_BAR; PG8_MMA(0, 0, At, B0); PG8_MMA(0, 1, At, B1); PG8_BAR; PG8_SCHED;
            PG8_LDA(At, 0, 1); PG8_STAGE(PG8_SB(0, 0), rB, b2, voffB); PG8_STAGE(PG8_SB(0, 1), rB, b2 + hstep, voffB); PG8_STAGE(PG8_SA(0, 0), rA, a2, voffA);
            PG8_WAIT_V(8); PG8_WAIT_L(0); PG8_BAR; PG8_MMA(1, 0, At, B0); PG8_MMA(1, 1, At, B1); PG8_BAR; PG8_SCHED;
            PG8_LDB(B0, 1, 0); PG8_LDB(B1, 1, 1); PG8_SCHED; PG8_LDA(At, 1, 0); PG8_STAGE(PG8_SA(0, 1), rA, a2 + hstep, voffA);
            PG8_WAIT_V(8); PG8_WAIT_L(0); PG8_BAR; PG8_MMA(0, 0, At, B0); PG8_MMA(0, 1, At, B1); PG8_BAR; PG8_SCHED;
            PG8_LDA(At, 1, 1); PG8_STAGE(PG8_SB(1, 0), rB, b3, voffB); PG8_STAGE(PG8_SB(1, 1), rB, b3 + hstep, voffB); PG8_STAGE(PG8_SA(1, 0), rA, a3, voffA);
            PG8_WAIT_V(8); PG8_WAIT_L(0); PG8_BAR; PG8_MMA(1, 0, At, B0); PG8_MMA(1, 1, At, B1); PG8_BAR; PG8_SCHED;
            } else {
            PG8_LDB(B0, 0, 0); PG8_SCHED; PG8_LDA(At, 0, 0); PG8_STAGE(PG8_SA(1, 1), rA, a1 + hstep, voffA);
            PG8_WAIT_L(8); PG8_BAR; PG8_WAIT_L(0); PG8_MMA(0, 0, At, B0); PG8_BAR; PG8_SCHED;
            PG8_LDB(B1, 0, 1); PG8_STAGE(PG8_SB(0, 0), rB, b2, voffB);
            PG8_BAR; PG8_WAIT_L(0); PG8_MMA(0, 1, At, B1); PG8_BAR;
            PG8_LDA(At, 0, 1); PG8_STAGE(PG8_SA(0, 0), rA, a2, voffA);
            PG8_BAR; PG8_WAIT_L(0); PG8_MMA(1, 0, At, B0); PG8_BAR; PG8_SCHED;
            PG8_STAGE(PG8_SB(0, 1), rB, b2 + hstep, voffB);
            PG8_WAIT_V(6); PG8_BAR; PG8_MMA(1, 1, At, B1); PG8_BAR;
            PG8_LDB(B0, 1, 0); PG8_SCHED; PG8_LDA(At, 1, 0); PG8_STAGE(PG8_SA(0, 1), rA, a2 + hstep, voffA);
            PG8_WAIT_L(8); PG8_BAR; PG8_WAIT_L(0); PG8_MMA(0, 0, At, B0); PG8_BAR; PG8_SCHED;
            PG8_LDB(B1, 1, 1); PG8_STAGE(PG8_SB(1, 0), rB, b3, voffB);
            PG8_BAR; PG8_WAIT_L(0); PG8_MMA(0, 1, At, B1); PG8_BAR;
            PG8_LDA(At, 1, 1); PG8_STAGE(PG8_SA(1, 0), rA, a3, voffA);
            PG8_BAR; PG8_WAIT_L(0); PG8_MMA(1, 0, At, B0); PG8_BAR; PG8_SCHED;
            PG8_STAGE(PG8_SB(1, 1), rB, b3 + hstep, voffB);
            PG8_WAIT_V(6); PG8_BAR; PG8_MMA(1, 1, At, B1); PG8_BAR;
            }
        }
        if constexpr (ALIGN_EPI) { if (wr == 0) PG8_BAR; }
        if constexpr (!Epi::AFTER_DRAIN) { int ln_ = (int)__builtin_amdgcn_mbcnt_hi(~0u, __builtin_amdgcn_mbcnt_lo(~0u, 0u)); asm volatile("" : "+v"(ln_));
            E(acc, cur, wr, wc, ln_ & 15, ln_ >> 4); S.done(cur); }
        if (!has_next) break;
#pragma unroll
        for (int a = 0; a < 2; ++a)
#pragma unroll
            for (int b = 0; b < 2; ++b)
#pragma unroll
                for (int m = 0; m < 4; ++m)
#pragma unroll
                    for (int n = 0; n < 2; ++n) acc[a][b][m][n] = (f32x4){0.f, 0.f, 0.f, 0.f};
        cur = nxt; cA = nA; cB = nB; ++ui;
        if constexpr (ALIGN_EPI) { if (wr == 1) PG8_BAR; }
    }
    PG8_WAIT_V(0);
    if constexpr (!ALIGN_EPI) { if (wr == 0) PG8_BAR; }
    PG8_BAR;
    if constexpr (Epi::AFTER_DRAIN) { E.fused(acc, cur, wr, wc, fr, fq, lds, wid, lane); S.done(cur); }
#undef PG8_SA
#undef PG8_SB
#undef PG8_STAGE
#undef PG8_LDA
#undef PG8_LDB
#undef PG8_MMA
#undef PG8_WAIT_V
#undef PG8_WAIT_L
#undef PG8_BAR
#undef PG8_SCHED
#undef PG8_F8CAT
}
}

constexpr int NWAVES = 8, NTHR = NWAVES * 64;
constexpr int BATCH = 8, SEQ = 2048, DM = 2048, DEPTH = 2, HD = 64, GW = 512, NH = 8;
constexpr int M = BATCH * SEQ;
constexpr int NPROJ = 6080, NPROJ_P = 6144, DFF = 5632;
constexpr int CA_Q = 0, CA_K = 512, CA_V = 1024, CB_U = 1536, CB_V = 2048, CC_Q = 2560, CC_K = 3072, CC_V = 3584, CD = 4096;
constexpr int D_R = 0, D_WD = 512, D_K = 608, D_V = 1120, D_AD = 1632, D_GD = 1728, D_W = 1984;
constexpr float NORM_EPS = 1e-6f;
#ifndef N_LAUNCH_MODE
#define N_LAUNCH_MODE 0
#endif
#ifndef PG8_SP2
#define PG8_SP2 true
#endif
#ifndef FFN_FP8
#define FFN_FP8 1
#endif
#ifndef REPEAT
#define REPEAT 0
#endif
#ifndef GEMM_I8
#define GEMM_I8 3
#endif
#ifndef BFMASK
#define BFMASK 0x003C0Fu
#endif
#ifndef FFN1_I8
#define FFN1_I8 1
#endif
#define I8_IN ((GEMM_I8 & 1) != 0)
#define I8_OUT ((GEMM_I8 & 2) != 0)
constexpr int N_PHASES = 20;

constexpr size_t MiB = 1u << 20;
constexpr size_t WS_CTL = 0, CTL_ZERO_BYTES = 2 * MiB;
constexpr size_t WS_WIN = 2 * MiB, WS_WOUT = 26 * MiB, WS_WGU = 34 * MiB, WS_WDN = 78 * MiB, WS_SMALL = 100 * MiB;
constexpr size_t WS_XB = 104 * MiB, WS_PROJ = 168 * MiB, WS_YCAT = 360 * MiB, WS_SC2 = 424 * MiB, WS_YD = 456 * MiB, WS_G = 488 * MiB, WS_BC = 504 * MiB, WS_END = 506 * MiB;
constexpr size_t WS_XQ = WS_YD, WS_YQ = WS_PROJ;
constexpr size_t SC_ARR = (size_t)M * GW * 2;
constexpr size_t SM_TB = 0;
constexpr size_t SM_KBAR = 64 * 1024;
constexpr size_t SM_STATS = 256 * 1024;
constexpr size_t SM_SAX = 2048 * 1024, SM_SAY = SM_SAX + 64 * 1024;
constexpr size_t SM_SWIN = SM_SAY + 64 * 1024, SM_SWOUT = SM_SWIN + 32 * 1024, SM_SWGU = SM_SWOUT + 16 * 1024;
constexpr size_t SM_WT = 1024 * 1024;
constexpr int CW_BAR = 4096;
constexpr int CW_Q = 8192;
constexpr int CW_SSQ = 65536;
constexpr size_t CTL_KBAR = 1024 * 1024;
constexpr size_t CTL_STATS = 1280 * 1024;
static_assert((size_t)CW_SSQ * 4 + 5 * (size_t)M * 8 <= CTL_KBAR && CTL_STATS + 2 * (size_t)M * 2 * 8 <= CTL_ZERO_BYTES, "CTL");

constexpr int RING_OFF = 0, RING_BYTES = 131072;
constexpr int LDS_BYTES = 163840, MISC_OFF = LDS_BYTES - 256;

#define GAS __attribute__((address_space(1)))
#define LAS __attribute__((address_space(3)))
typedef unsigned short bf16;
typedef unsigned v4u __attribute__((ext_vector_type(4)));
typedef unsigned v2u __attribute__((ext_vector_type(2)));
typedef float f32x4 __attribute__((ext_vector_type(4)));
typedef short bf16x8 __attribute__((ext_vector_type(8)));
typedef float f32x16 __attribute__((ext_vector_type(16)));
typedef GAS unsigned gu32;
#define RLX_AGENT __ATOMIC_RELAXED, __HIP_MEMORY_SCOPE_AGENT
#define LDS_WAIT() asm volatile("s_waitcnt lgkmcnt(0)" ::: "memory")
#define VM_WAIT() asm volatile("s_waitcnt vmcnt(0)" ::: "memory")
__device__ __forceinline__ unsigned f2bf(float f) { unsigned u = __builtin_bit_cast(unsigned, f); return (u + 0x7fffu + ((u >> 16) & 1u)) >> 16; }
__device__ __forceinline__ unsigned pk2(float lo, float hi) { return f2bf(lo) | (f2bf(hi) << 16); }
__device__ __forceinline__ float bf2f(unsigned short h) { return __builtin_bit_cast(float, (unsigned)h << 16); }
__device__ __forceinline__ float bflo(unsigned w) { return __builtin_bit_cast(float, w << 16); }
__device__ __forceinline__ float bfhi(unsigned w) { return __builtin_bit_cast(float, w & 0xffff0000u); }
__device__ __forceinline__ float sigmoidf_(float x) { return 1.0f / (1.0f + __expf(-x)); }
__device__ __forceinline__ float gelu_tanh(float x) { const float u = 0.7978845608028654f * (x + 0.044715f * x * x * x); const float e = __expf(2.0f * u); const float th = 1.0f - 2.0f / (e + 1.0f); return 0.5f * x * (1.0f + th); }
__device__ __forceinline__ float wave_sum(float v) {
#pragma unroll
    for (int o = 1; o < 64; o <<= 1) v += __shfl_xor(v, o);
    return v;
}

__device__ __forceinline__ float zero_v() { float z = 0.f; asm volatile("" : "+v"(z)); return z; }

__device__ __forceinline__ unsigned q8pack4(float a, float b, float c, float d, float inv) {
    const int ia = (int)__builtin_rintf(a * inv), ib = (int)__builtin_rintf(b * inv), ic = (int)__builtin_rintf(c * inv), id = (int)__builtin_rintf(d * inv);
    return ((unsigned)ia & 0xffu) | (((unsigned)ib & 0xffu) << 8) | (((unsigned)ic & 0xffu) << 16) | ((unsigned)id << 24); }
__device__ __forceinline__ float wave_max(float v) {
#pragma unroll
    for (int o = 1; o < 64; o <<= 1) v = fmaxf(v, __shfl_xor(v, o));
    return v;
}
#define UNPACK8(dst, o, W_) do { dst[(o)] = bflo((W_).x); dst[(o) + 1] = bfhi((W_).x); dst[(o) + 2] = bflo((W_).y); dst[(o) + 3] = bfhi((W_).y); dst[(o) + 4] = bflo((W_).z); dst[(o) + 5] = bfhi((W_).z); dst[(o) + 6] = bflo((W_).w); dst[(o) + 7] = bfhi((W_).w); } while (0)
#define XB_TMO      128
#define XB_XCNT(j)  (256  + 64 * (j))
#define XB_XSUB(j)  (1280 + 64 * (j))
#define XB_XGEN(j)  (2304 + 64 * (j))
#define XB_TOP      3328
#define XB_TOPGEN   3392
#define XCD_BAR_WORDS 3456
#define XB_SPIN_CAP (1u << 18)

__device__ __forceinline__ unsigned xb_ld(unsigned* p)              { return __hip_atomic_load(p, __ATOMIC_RELAXED, __HIP_MEMORY_SCOPE_AGENT); }
__device__ __forceinline__ unsigned xb_add(unsigned* p, unsigned v) { return __hip_atomic_fetch_add(p, v, __ATOMIC_RELAXED, __HIP_MEMORY_SCOPE_AGENT); }
__device__ __forceinline__ unsigned xb_xcc_id() { return (unsigned)__builtin_amdgcn_s_getreg((3 << 11) | 20) & 0xFu; }
#define XB_SPIN(cond, bar) do { unsigned _sp = 0; while (cond) { __builtin_amdgcn_s_sleep(1); \
    if ((++_sp & 255u) == 0u) { if (xb_ld(&(bar)[XB_TMO])) break; if (_sp > XB_SPIN_CAP) { atomicAdd(&(bar)[XB_TMO], 1u); break; } } } } while (0)

struct XcdBarrier {
    unsigned* bar; unsigned x; int wv;
    volatile LAS unsigned* st;
};

__device__ __forceinline__ XcdBarrier xcd_barrier_post(unsigned* bar, volatile LAS unsigned* st, int wv) {
    XcdBarrier b; b.bar = bar; b.x = xb_xcc_id(); b.st = st; b.wv = wv;
    if (wv == 0 && pg8::lane_now() == 0) (void)xb_add(&bar[XB_XCNT(b.x)], 1u);
    return b;
}
__device__ __forceinline__ void xcd_barrier_complete(unsigned* bar, unsigned x, unsigned& nloc, unsigned& nx) {
    const unsigned G = gridDim.x * gridDim.y * gridDim.z;
    unsigned sum, cnt, mine, sp = 0u;
    for (;;) {
        sum = 0u; cnt = 0u; mine = 0u;
#pragma unroll
        for (unsigned j = 0; j < 16; ++j) { const unsigned c = xb_ld(&bar[XB_XCNT(j)]); sum += c; cnt += (c > 0u) ? 1u : 0u; mine = (j == x) ? c : mine; }
        if (sum == G) break;
        __builtin_amdgcn_s_sleep(1);
        if ((++sp & 255u) == 0u) { if (xb_ld(&bar[XB_TMO])) break; if (sp > XB_SPIN_CAP) { atomicAdd(&bar[XB_TMO], 1u); break; } }
    }
    nloc = mine > 0u ? mine : 1u; nx = cnt > 0u ? cnt : 1u;
}

__device__ __forceinline__ void xcd_barrier(const XcdBarrier& b) {
    asm volatile("s_waitcnt vmcnt(0)" ::: "memory");
    __syncthreads();
    if (b.wv == 0 && pg8::lane_now() == 0) {
        unsigned* bar = b.bar;
        __builtin_amdgcn_s_waitcnt(0);
        unsigned nloc = b.st[0], nx = b.st[1];
        if (nloc == 0u) { xcd_barrier_complete(bar, b.x, nloc, nx); b.st[0] = nloc; b.st[1] = nx; }
        const unsigned old = xb_add(&bar[XB_XSUB(b.x)], 1u);
        const unsigned gen = old / nloc;
        if (old + 1u == (gen + 1u) * nloc) {
            __builtin_amdgcn_fence(__ATOMIC_RELEASE, "agent");
            asm volatile("s_waitcnt vmcnt(0)" ::: "memory");
            const unsigned og = xb_add(&bar[XB_TOP], 1u);
            const unsigned tg = og / nx;
            if (og + 1u == (tg + 1u) * nx) xb_add(&bar[XB_TOPGEN], 1u);
            else XB_SPIN(xb_ld(&bar[XB_TOPGEN]) == tg, bar);
            __builtin_amdgcn_fence(__ATOMIC_ACQUIRE, "agent");
            xb_add(&bar[XB_XGEN(b.x)], 1u);
            asm volatile("s_waitcnt vmcnt(0)" ::: "memory");
        } else {
            XB_SPIN(xb_ld(&bar[XB_XGEN(b.x)]) == gen, bar);
            __builtin_amdgcn_fence(__ATOMIC_ACQUIRE, "agent");
            asm volatile("s_waitcnt vmcnt(0)" ::: "memory");
        }
    }
    __syncthreads();
}

struct Args { const float* in[25]; float* out; unsigned char* ws; int ph_lo, ph_hi; };
struct Frame {
    LAS unsigned char* lds; int tid, lane, wave, G, vcu, gw, ngw;
};
typedef const __attribute__((address_space(4))) unsigned long long* karg_t;
__device__ __forceinline__ karg_t kargs() { karg_t ka = (karg_t)__builtin_amdgcn_kernarg_segment_ptr(); asm volatile("" : "+s"(ka)); return ka; }
__device__ __forceinline__ const float* inp(int i) { return (const float*)(const GAS float*)kargs()[i]; }
__device__ __forceinline__ float* outp() { return (float*)(GAS float*)kargs()[25]; }
__device__ __forceinline__ unsigned char* wsp() { return (unsigned char*)(GAS unsigned char*)kargs()[26]; }
__device__ __forceinline__ gu32* ctlp() { return (gu32*)(wsp() + WS_CTL); }

__device__ __forceinline__ void conv_item(const float* W, int K, int N, const float* g, bf16* WT, int kind, LAS float* scr, int item, int lane, int ncols = 0) {
    const int nblk = (ncols ? ncols : N) / 32, kb = item / nblk, nb = item % nblk, k0 = 64 * kb, n0 = 32 * nb;
    float ld[32];
    { const float* wp = W + (size_t)(k0 + (lane >> 5)) * N + n0 + (lane & 31);
#pragma unroll
      for (int i = 0; i < 32; ++i) ld[i] = wp[(size_t)(2 * i) * N]; }
    if (g) { const float* gp = g + k0 + (lane >> 5);
#pragma unroll
      for (int i = 0; i < 32; ++i) ld[i] *= gp[2 * i]; }
#pragma unroll
    for (int i = 0; i < 32; ++i) scr[(2 * i + (lane >> 5)) * 33 + (lane & 31)] = ld[i];
    LDS_WAIT(); asm volatile("" ::: "memory");
    const int c = lane & 7;
#pragma unroll
    for (int j = 0; j < 4; ++j) { const int n = (lane >> 3) + 8 * j; const LAS float* s = scr + (8 * c) * 33 + n;
        v4u o; o.x = pk2(s[0 * 33], s[1 * 33]); o.y = pk2(s[2 * 33], s[3 * 33]); o.z = pk2(s[4 * 33], s[5 * 33]); o.w = pk2(s[6 * 33], s[7 * 33]);
        const int nn = n0 + n;
        if (kind >= 3) {
            const int row = kind == 5 ? nn : ((nn >> 7) * 256 + (kind - 3) * 128 + (nn & 127)); int f0 = (int)o.x, f1 = (int)o.y;
            f0 = __builtin_amdgcn_cvt_pk_fp8_f32(64.f * s[0 * 33], 64.f * s[1 * 33], f0, false); f0 = __builtin_amdgcn_cvt_pk_fp8_f32(64.f * s[2 * 33], 64.f * s[3 * 33], f0, true);
            f1 = __builtin_amdgcn_cvt_pk_fp8_f32(64.f * s[4 * 33], 64.f * s[5 * 33], f1, false); f1 = __builtin_amdgcn_cvt_pk_fp8_f32(64.f * s[6 * 33], 64.f * s[7 * 33], f1, true);
            *(GAS v2u*)((unsigned char*)WT + (size_t)row * K + k0 + 8 * c) = (v2u){(unsigned)f0, (unsigned)f1};
        } else {
        const int row = kind == 0 ? nn : ((nn >> 7) * 256 + (kind - 1) * 128 + (nn & 127));
        *(GAS v4u*)(WT + (size_t)row * K + k0 + 8 * c) = o; } }
    LDS_WAIT(); asm volatile("" ::: "memory");
}
__device__ __forceinline__ void conv_cols_i8(const float* W, int K, int N, const float* g, unsigned char* WQ, float* SW, int nb, Frame& F, int orow0 = -1) {
    LAS float* scr = (LAS float*)(F.lds + RING_OFF + F.wave * 16384); LAS float* red = (LAS float*)(F.lds + RING_OFF + 131072);
    const int n0 = 32 * nb, lane = F.lane, nkb = K / 64, o0 = orow0 < 0 ? n0 : orow0;
    const float* wp0 = W + (size_t)(lane >> 5) * N + n0 + (lane & 31);
    float mx = 0.f;
    for (int kb = F.wave; kb < nkb; kb += NWAVES) {
        const float* wp = wp0 + (size_t)(64 * kb) * N; const float* gp = g + 64 * kb + (lane >> 5);
        float ld[32];
#pragma unroll
        for (int i = 0; i < 32; ++i) ld[i] = wp[(size_t)(2 * i) * N];
#pragma unroll
        for (int i = 0; i < 32; ++i) mx = fmaxf(mx, fabsf(ld[i] * gp[2 * i]));
    }
    mx = fmaxf(mx, __shfl_xor(mx, 32));
    if (lane < 32) red[F.wave * 32 + lane] = mx;
    __syncthreads();
    float cm = 0.f;
#pragma unroll
    for (int w = 0; w < NWAVES; ++w) cm = fmaxf(cm, red[w * 32 + (lane & 31)]);
    const float inv = cm > 0.f ? 127.0f / cm : 0.f;
    if (F.wave == 0 && lane < 32) SW[o0 + lane] = cm * (1.0f / 127.0f);
    for (int kb = F.wave; kb < nkb; kb += NWAVES) {
        const float* wp = wp0 + (size_t)(64 * kb) * N; const float* gp = g + 64 * kb + (lane >> 5);
        float ld[32];
#pragma unroll
        for (int i = 0; i < 32; ++i) ld[i] = wp[(size_t)(2 * i) * N];
#pragma unroll
        for (int i = 0; i < 32; ++i) scr[(2 * i + (lane >> 5)) * 33 + (lane & 31)] = ld[i] * gp[2 * i] * inv;
        LDS_WAIT(); asm volatile("" ::: "memory");
        const int c = lane & 7;
#pragma unroll
        for (int j = 0; j < 4; ++j) { const int n = (lane >> 3) + 8 * j; const LAS float* q = scr + (8 * c) * 33 + n;
            *(GAS v2u*)(WQ + (size_t)(o0 + n) * K + 64 * kb + 8 * c) = (v2u){q8pack4(q[0 * 33], q[1 * 33], q[2 * 33], q[3 * 33], 1.0f), q8pack4(q[4 * 33], q[5 * 33], q[6 * 33], q[7 * 33], 1.0f)}; }
        LDS_WAIT(); asm volatile("" ::: "memory");
    }
    __syncthreads();
}
__device__ __forceinline__ void conv_layer_items(Frame& F, int l, int gw, int ngw, bool do_in, bool do_rest) {
    LAS float* scr = (LAS float*)(F.lds + RING_OFF + F.wave * 16384);
    constexpr int I_IN = (DM / 64) * (NPROJ / 32), I_OUT = (DM / 64) * (DM / 32), I_G = (DM / 64) * (DFF / 32), I_D = (DFF / 64) * (DM / 32);
    const float* w_in = inp(2) + (size_t)l * DM * NPROJ; const float* w_out = inp(19) + (size_t)l * DM * DM;
    const float* w_g = inp(21) + (size_t)l * DM * DFF; const float* w_u = inp(22) + (size_t)l * DM * DFF; const float* w_d = inp(23) + (size_t)l * DFF * DM;
    const float* g_mix = inp(1) + l * DM; const float* g_br = inp(18) + l * DM; const float* g_ffn = inp(20) + l * DM;
    bf16* WIN = (bf16*)(wsp() + WS_WIN); bf16* WOUT = (bf16*)(wsp() + WS_WOUT); bf16* WGU = (bf16*)(wsp() + WS_WGU); bf16* WDN = (bf16*)(wsp() + WS_WDN);
    if (do_in) {
        for (int it = gw; it < I_IN; it += ngw) conv_item(w_in, DM, NPROJ, g_mix, WIN, 0, scr, it, F.lane);
    }
    if (do_rest) {
        for (int it = gw; it < (I8_OUT ? 0 : I_OUT) + (FFN1_I8 ? 0 : 2 * I_G) + I_D; it += ngw) {
            int r = it + (I8_OUT ? I_OUT : 0); if (FFN1_I8 && r >= I_OUT) r += 2 * I_G;
            if (r < I_OUT) { conv_item(w_out, DM, DM, g_br, WOUT, 0, scr, r, F.lane); continue; } r -= I_OUT;
            if (r < I_G) { conv_item(w_g, DM, DFF, g_ffn, WGU, FFN_FP8 ? 3 : 1, scr, r, F.lane); continue; } r -= I_G;
            if (r < I_G) { conv_item(w_u, DM, DFF, g_ffn, WGU, FFN_FP8 ? 4 : 2, scr, r, F.lane); continue; } r -= I_G;
            conv_item(w_d, DFF, DM, nullptr, WDN, FFN_FP8 ? 5 : 0, scr, r, F.lane);
        }
    }
}

constexpr int WINB_NB = 8 * __builtin_popcount(BFMASK), WINB_ITEMS = (DM / 64) * WINB_NB;
__device__ __forceinline__ bf16* winb_ptr() { return (bf16*)outp() + (size_t)6 * M * GW; }
__device__ __forceinline__ void conv_winb(Frame& F, int l, int item) {
    if (item >= WINB_ITEMS) return;
    const int kb = item / (WINB_NB ? WINB_NB : 1), r = item % (WINB_NB ? WINB_NB : 1); unsigned m = BFMASK; for (int j = 0; j < (r >> 3); ++j) m &= m - 1;
    conv_item(inp(2) + (size_t)l * DM * NPROJ, DM, NPROJ, inp(1) + l * DM, winb_ptr(), 0, (LAS float*)(F.lds + RING_OFF + F.wave * 16384), kb * (NPROJ / 32) + __builtin_ctz(m) * 8 + (r & 7), F.lane);
}
__device__ __forceinline__ void ph_prologue(Frame& F) {
    if (I8_IN) {
        for (int nb = blockIdx.x; nb < NPROJ / 32; nb += F.G) conv_cols_i8(inp(2), DM, NPROJ, inp(1), wsp() + WS_WIN, (float*)(wsp() + WS_SMALL + SM_SWIN), nb, F);
        unsigned char* WIN = wsp() + WS_WIN; float* SWIN = (float*)(wsp() + WS_SMALL + SM_SWIN);
        for (int i = F.gw * 64 + F.lane; i < 64 * DM / 16; i += F.ngw * 64) *(GAS v4u*)(WIN + (size_t)NPROJ * DM + (size_t)i * 16) = (v4u){0u, 0u, 0u, 0u};
        if (blockIdx.x == 0 && F.tid < NPROJ_P - NPROJ) SWIN[NPROJ + F.tid] = 0.f;
        for (int it = F.gw; it < WINB_ITEMS; it += F.ngw) conv_winb(F, 0, it);
    } else {
    conv_layer_items(F, 0, F.gw, F.ngw, true, false);
    { bf16* WIN = (bf16*)(wsp() + WS_WIN);
      for (int i = F.gw * 64 + F.lane; i < 64 * DM / 8; i += F.ngw * 64) *(GAS v4u*)(WIN + (size_t)NPROJ * DM + (size_t)i * 8) = (v4u){0u, 0u, 0u, 0u}; } }
    if (blockIdx.x == 0) {
        int* TB = (int*)(wsp() + WS_SMALL + SM_TB);
        for (int d = F.tid; d < 2049; d += NTHR) {
            int bkt = d;
            if (d >= 16) bkt = 16 + (d >= 22) + (d >= 30) + (d >= 40) + (d >= 54) + (d >= 73) + (d >= 99) + (d >= 134) + (d >= 182) + (d >= 246) + (d >= 332) + (d >= 450) + (d >= 609) + (d >= 825) + (d >= 1117) + (d >= 1513);
            TB[d] = bkt;
        }
    }
    { bf16* WT = (bf16*)(wsp() + WS_SMALL + SM_WT); const float* w2 = inp(9); const float* a2 = inp(11); const float* g2 = inp(12);
      for (int idx = blockIdx.x * NTHR + F.tid; idx < DEPTH * 448 * GW; idx += F.G * NTHR) {
          const int c = idx % GW, k = (idx / GW) % 448, l = idx / (GW * 448);
          const float v = k < 96 ? w2[((size_t)l * 96 + k) * GW + c] : (k < 192 ? a2[((size_t)l * 96 + (k - 96)) * GW + c] : g2[((size_t)l * 256 + (k - 192)) * GW + c]);
          const int r32_ = c & 31, hct = c >> 5, ks_ = k >> 4, hh_ = (k >> 3) & 1;
          WT[(size_t)l * GW * 448 + (((size_t)hct * 28 + ks_) * 64 + 32 * hh_ + r32_) * 8 + (k & 7)] = (bf16)f2bf(v); } }
    const float* x = inp(0); bf16* XB = (bf16*)(wsp() + WS_XB); pg8::fx_t* ssq = (pg8::fx_t*)(ctlp() + CW_SSQ);
    for (int m = F.gw; m < M; m += F.ngw) {
        const GAS f32x4* xr = (const GAS f32x4*)(x + (size_t)m * DM) + F.lane; GAS v2u* o = (GAS v2u*)(XB + (size_t)m * DM) + F.lane; float s = 0.f;
#pragma unroll
        for (int j = 0; j < 8; ++j) { const f32x4 v = xr[64 * j]; s += (v.x * v.x + v.y * v.y) + (v.z * v.z + v.w * v.w); o[64 * j] = (v2u){pk2(v.x, v.y), pk2(v.z, v.w)}; }
        s = wave_sum(s); if (F.lane == 0) pg8::fx_add(ssq + m, s);
        if (I8_IN) {
            float mx = 0.f;
#pragma unroll
            for (int j = 0; j < 8; ++j) { const f32x4 v = xr[64 * j]; mx = fmaxf(fmaxf(mx, fmaxf(fabsf(v.x), fabsf(v.y))), fmaxf(fabsf(v.z), fabsf(v.w))); }
            mx = wave_max(mx); const float inv = mx > 0.f ? 127.0f / mx : 0.f; GAS unsigned* q = (GAS unsigned*)(wsp() + WS_XQ + (size_t)m * DM) + F.lane;
#pragma unroll
            for (int j = 0; j < 8; ++j) { const f32x4 v = xr[64 * j]; q[64 * j] = q8pack4(v.x, v.y, v.z, v.w, inv); }
            if (F.lane == 0) ((float*)(wsp() + WS_SMALL + SM_SAX))[m] = mx * (1.0f / 127.0f);
        }
    }
}

__device__ __forceinline__ void ph_quantx(Frame& F) {
    const bf16* XB = (const bf16*)(wsp() + WS_XB); unsigned char* XQ = wsp() + WS_XQ; float* SAX = (float*)(wsp() + WS_SMALL + SM_SAX);
    for (int m = F.gw; m < M; m += F.ngw) {
        const GAS v4u* xr = (const GAS v4u*)(XB + (size_t)m * DM) + F.lane; v4u w[4]; float mx = 0.f;
#pragma unroll
        for (int j = 0; j < 4; ++j) w[j] = xr[64 * j];
#pragma unroll
        for (int j = 0; j < 4; ++j) { mx = fmaxf(fmaxf(mx, fmaxf(fabsf(bflo(w[j].x)), fabsf(bfhi(w[j].x)))), fmaxf(fabsf(bflo(w[j].y)), fabsf(bfhi(w[j].y))));
            mx = fmaxf(fmaxf(mx, fmaxf(fabsf(bflo(w[j].z)), fabsf(bfhi(w[j].z)))), fmaxf(fabsf(bflo(w[j].w)), fabsf(bfhi(w[j].w)))); }
        mx = wave_max(mx); const float inv = mx > 0.f ? 127.0f / mx : 0.f; GAS v2u* q = (GAS v2u*)(XQ + (size_t)m * DM) + F.lane;
#pragma unroll
        for (int j = 0; j < 4; ++j) q[64 * j] = (v2u){q8pack4(bflo(w[j].x), bfhi(w[j].x), bflo(w[j].y), bfhi(w[j].y), inv), q8pack4(bflo(w[j].z), bfhi(w[j].z), bflo(w[j].w), bfhi(w[j].w), inv)};
        if (F.lane == 0) SAX[m] = mx * (1.0f / 127.0f);
    }
}

constexpr int PR_PITCH = 912;
constexpr int PR_PRM_OFF = 32768, PR_MUA_OFF = PR_PRM_OFF + 8 * 512 * 4;
__device__ __forceinline__ float fast_tanh(float x) { return 1.0f - 2.0f * __builtin_amdgcn_rcpf(__expf(2.0f * x) + 1.0f); }
__device__ __forceinline__ float fast_sigmoid(float x) { return __builtin_amdgcn_rcpf(1.0f + __expf(-x)); }
constexpr int PR_OT_OFF = 51200, PR_OT_PITCH = 72, PR_OT_TILE = 32 * PR_OT_PITCH, PR_OT_WAVE = 6 * PR_OT_TILE;
static_assert(PR_OT_OFF + 8 * PR_OT_WAVE <= MISC_OFF, "prep LDS");
__device__ __forceinline__ void ph_prep(Frame& F, int l) {
    const bf16* PROJ = (const bf16*)(wsp() + WS_PROJ);
    bf16* R_ = (bf16*)outp();
    bf16* E_ = R_ + (size_t)M * GW; bf16* KP_ = E_ + (size_t)M * GW; bf16* V_ = KP_ + (size_t)M * GW;
    bf16* KK_ = (bf16*)outp() + (size_t)4 * M * GW; bf16* AS_ = KK_ + (size_t)M * GW; bf16* G_ = (bf16*)(wsp() + WS_G); float* BC = (float*)(wsp() + WS_BC);
    const bf16* WT = (const bf16*)(wsp() + WS_SMALL + SM_WT) + (size_t)l * GW * 448;
    LAS unsigned char* actL = F.lds + RING_OFF; LAS float* PRM = (LAS float*)(F.lds + PR_PRM_OFF); LAS float* MUA = (LAS float*)(F.lds + PR_MUA_OFF);
    { const float* mu = inp(7) + l * D_W; const float* w0 = inp(8) + l * GW; const float* a0 = inp(10) + l * GW; const float* k_k = inp(13) + l * GW; const float* k_a = inp(14) + l * GW; const float* r_k = inp(15) + l * GW;
      const int c = F.tid;
      PRM[c] = mu[D_R + c]; PRM[512 + c] = mu[D_K + c]; PRM[1024 + c] = mu[D_V + c]; PRM[1536 + c] = w0[c]; PRM[2048 + c] = a0[c]; PRM[2560 + c] = k_k[c]; PRM[3072 + c] = k_a[c]; PRM[3584 + c] = r_k[c];
      if (c < 448) MUA[c] = mu[c < 96 ? D_WD + c : (c < 192 ? D_AD + (c - 96) : D_GD + (c - 192))]; }
    __syncthreads();
    const int h = F.wave;
    for (int it = blockIdx.x; it < M / 32; it += F.G) {
        const int m0 = it * 32;
        int tid_ = F.wave * 64 + pg8::lane_now(); asm volatile("" : "+v"(tid_));
        const int tid = tid_, r32 = tid & 31, hh = (tid >> 5) & 1, lane = tid & 63;
        LAS unsigned char* OT = F.lds + PR_OT_OFF + h * PR_OT_WAVE;
        { v2u pc[7], pp[7];
#pragma unroll
          for (int i = 0; i < 7; ++i) { const int gi = tid + NTHR * i, t = gi / 112, k = 4 * (gi % 112), m = m0 + t;
              const int col = k < 96 ? D_WD + k : (k < 192 ? D_AD + (k - 96) : D_GD + (k - 192)); const bf16* src = PROJ + (size_t)m * NPROJ_P + CD + col;
              pc[i] = *(const GAS v2u*)src; pp[i] = (v2u){0u, 0u}; if ((m % SEQ) > 0) pp[i] = *(const GAS v2u*)(src - NPROJ_P); }
#pragma unroll
          for (int i = 0; i < 7; ++i) { const int gi = tid + NTHR * i, t = gi / 112, k = 4 * (gi % 112);
              const f32x4 mv = *(const LAS f32x4*)(MUA + k);
              float x[4] = {bflo(pc[i].x), bfhi(pc[i].x), bflo(pc[i].y), bfhi(pc[i].y)}; const float xp[4] = {bflo(pp[i].x), bfhi(pp[i].x), bflo(pp[i].y), bfhi(pp[i].y)};
#pragma unroll
              for (int e = 0; e < 4; ++e) { x[e] += (xp[e] - x[e]) * mv[e]; x[e] = k < 96 ? fast_tanh(x[e]) : (k < 192 ? x[e] : fast_sigmoid(x[e])); }
              *(LAS v2u*)(actL + t * PR_PITCH + 2 * k) = (v2u){pk2(x[0], x[1]), pk2(x[2], x[3])}; } }
        __syncthreads();
        const int m = m0 + r32; const bool has_prev = (m % SEQ) > 0;
        const bf16* pr = PROJ + (size_t)m * NPROJ_P + CD; const bf16* pq = pr - NPROJ_P;
        const LAS unsigned char* bp = actL + r32 * PR_PITCH + 16 * hh;
        float kkv[2][16]; float n2 = 0.f, bcv = 0.f;
#pragma unroll
        for (int ct = 0; ct < 2; ++ct) {
            const int cb = 64 * h + 32 * ct + 4 * hh;
            v4u xc[3][2], xp[3][2];
#pragma unroll
            for (int a = 0; a < 3; ++a)
#pragma unroll
                for (int i = 0; i < 2; ++i) { const int mm = m0 + (lane >> 2) + 16 * i; const bf16* src = PROJ + (size_t)mm * NPROJ_P + CD + (a == 0 ? D_R : (a == 1 ? D_K : D_V)) + 64 * h + 32 * ct + 8 * (lane & 3);
                    xc[a][i] = *(const GAS v4u*)src; xp[a][i] = (v4u){0u, 0u, 0u, 0u}; if ((mm % SEQ) > 0) xp[a][i] = *(const GAS v4u*)(src - NPROJ_P); }
            f32x16 aW, aA, aG;
            { const float z_ = zero_v();
#pragma unroll
            for (int i = 0; i < 16; ++i) { aW[i] = z_; aA[i] = z_; aG[i] = z_; } }
            const bf16* wt0 = WT + ((size_t)(2 * h + ct) * 28 * 64 + lane) * 8;
#pragma unroll
            for (int grp = 0; grp < 4; ++grp) {
                bf16x8 af[7];
#pragma unroll
                for (int q = 0; q < 7; ++q) af[q] = *(const GAS bf16x8*)(wt0 + 512 * (7 * grp + q));
#pragma unroll
                for (int q = 0; q < 7; ++q) { const int ks = 7 * grp + q; const bf16x8 bfr = *(const LAS bf16x8*)(bp + 32 * ks);
                    if (ks < 6) aW = __builtin_amdgcn_mfma_f32_32x32x16_bf16(af[q], bfr, aW, 0, 0, 0);
                    else if (ks < 12) aA = __builtin_amdgcn_mfma_f32_32x32x16_bf16(af[q], bfr, aA, 0, 0, 0);
                    else aG = __builtin_amdgcn_mfma_f32_32x32x16_bf16(af[q], bfr, aG, 0, 0, 0); }
                asm volatile("" ::: "memory");
            }
            LAS unsigned char* IN = OT + 3 * PR_OT_TILE;
#pragma unroll
            for (int a = 0; a < 3; ++a)
#pragma unroll
                for (int i = 0; i < 2; ++i) { const int cch = 64 * h + 32 * ct + 8 * (lane & 3); const f32x4 m0v = *(const LAS f32x4*)(PRM + a * 512 + cch), m1v = *(const LAS f32x4*)(PRM + a * 512 + cch + 4);
                    float xcu[8], xpu[8]; UNPACK8(xcu, 0, xc[a][i]); UNPACK8(xpu, 0, xp[a][i]); const float mw[8] = {m0v.x, m0v.y, m0v.z, m0v.w, m1v.x, m1v.y, m1v.z, m1v.w};
#pragma unroll
                    for (int e = 0; e < 8; ++e) xcu[e] += (xpu[e] - xcu[e]) * mw[e];
                    LAS unsigned char* dstp = IN + a * PR_OT_TILE + ((lane >> 2) + 16 * i) * PR_OT_PITCH + 16 * (lane & 3);
                    *(LAS v2u*)dstp = (v2u){pk2(xcu[0], xcu[1]), pk2(xcu[2], xcu[3])}; *(LAS v2u*)(dstp + 8) = (v2u){pk2(xcu[4], xcu[5]), pk2(xcu[6], xcu[7])}; }
            asm volatile("" ::: "memory");
            v2u oE[4], oK[4], oG[4];
#pragma unroll
            for (int g4 = 0; g4 < 4; ++g4) {
                const int c = cb + 8 * g4;
                const f32x4 w0v = *(const LAS f32x4*)(PRM + 1536 + c),
                            a0v = *(const LAS f32x4*)(PRM + 2048 + c), kkc = *(const LAS f32x4*)(PRM + 2560 + c), kac = *(const LAS f32x4*)(PRM + 3072 + c), rkc = *(const LAS f32x4*)(PRM + 3584 + c);
                const LAS unsigned char* inq = IN + r32 * PR_OT_PITCH + 2 * (8 * g4 + 4 * hh);
                const v2u rq = *(const LAS v2u*)inq, kq = *(const LAS v2u*)(inq + PR_OT_TILE), vq = *(const LAS v2u*)(inq + 2 * PR_OT_TILE);
                const float rsu[4] = {bflo(rq.x), bfhi(rq.x), bflo(rq.y), bfhi(rq.y)}, ksu[4] = {bflo(kq.x), bfhi(kq.x), bflo(kq.y), bfhi(kq.y)}, vsu[4] = {bflo(vq.x), bfhi(vq.x), bflo(vq.y), bfhi(vq.y)};
                float ro[4], eo[4], ko[4], vo[4], ao[4], go[4];
#pragma unroll
                for (int e = 0; e < 4; ++e) {
                    const float r = rsu[e], k = ksu[e], v = vsu[e];
                    const float ee = 0.6065306597126334f * fast_sigmoid(w0v[e] + aW[4 * g4 + e]);
                    const float as = fast_sigmoid(a0v[e] + aA[4 * g4 + e]);
                    const float kv = k * kkc[e]; kkv[ct][4 * g4 + e] = kv; n2 += kv * kv;
                    const float kp = k * (1.0f + (as - 1.0f) * kac[e]);
                    bcv += r * kp * rkc[e];
                    ro[e] = r; eo[e] = ee; ko[e] = kp; vo[e] = v; ao[e] = as; go[e] = aG[4 * g4 + e];
                }
                LAS unsigned char* ot = OT + r32 * PR_OT_PITCH + 2 * (8 * g4 + 4 * hh);
                *(LAS v2u*)(ot) = (v2u){pk2(ro[0], ro[1]), pk2(ro[2], ro[3])}; *(LAS v2u*)(ot + PR_OT_TILE) = (v2u){pk2(vo[0], vo[1]), pk2(vo[2], vo[3])}; *(LAS v2u*)(ot + 2 * PR_OT_TILE) = (v2u){pk2(ao[0], ao[1]), pk2(ao[2], ao[3])};
                oE[g4] = (v2u){pk2(eo[0], eo[1]), pk2(eo[2], eo[3])}; oK[g4] = (v2u){pk2(ko[0], ko[1]), pk2(ko[2], ko[3])}; oG[g4] = (v2u){pk2(go[0], go[1]), pk2(go[2], go[3])};
            }
            asm volatile("" ::: "memory");
#pragma unroll
            for (int batch = 0; batch < 2; ++batch) {
                bf16* const dst[3] = {batch == 0 ? R_ : E_, batch == 0 ? V_ : KP_, batch == 0 ? AS_ : G_};
                if (batch == 1) {
#pragma unroll
                    for (int g4 = 0; g4 < 4; ++g4) { LAS unsigned char* ot = OT + r32 * PR_OT_PITCH + 2 * (8 * g4 + 4 * hh); *(LAS v2u*)(ot) = oE[g4]; *(LAS v2u*)(ot + PR_OT_TILE) = oK[g4]; *(LAS v2u*)(ot + 2 * PR_OT_TILE) = oG[g4]; }
                    asm volatile("" ::: "memory"); }
#pragma unroll
                for (int a = 0; a < 3; ++a)
#pragma unroll
                    for (int i = 0; i < 2; ++i) { const int tk = (lane >> 2) + 16 * i, part = lane & 3; const LAS unsigned char* src = OT + a * PR_OT_TILE + tk * PR_OT_PITCH + 16 * part;
                        const v2u lo = *(const LAS v2u*)src, hi = *(const LAS v2u*)(src + 8);
                        *(GAS v4u*)(dst[a] + (size_t)(m0 + tk) * GW + 64 * h + 32 * ct + 8 * part) = (v4u){lo.x, lo.y, hi.x, hi.y}; }
                asm volatile("" ::: "memory");
            }
        }
        n2 += __shfl_xor(n2, 32); bcv += __shfl_xor(bcv, 32);
        const float inv = 1.0f / fmaxf(sqrtf(n2), 1e-12f);
#pragma unroll
        for (int ct = 0; ct < 2; ++ct)
#pragma unroll
            for (int g4 = 0; g4 < 4; ++g4) *(LAS v2u*)(OT + ct * PR_OT_TILE + r32 * PR_OT_PITCH + 2 * (8 * g4 + 4 * hh)) = (v2u){pk2(kkv[ct][4 * g4] * inv, kkv[ct][4 * g4 + 1] * inv), pk2(kkv[ct][4 * g4 + 2] * inv, kkv[ct][4 * g4 + 3] * inv)};
        asm volatile("" ::: "memory");
#pragma unroll
        for (int ct = 0; ct < 2; ++ct)
#pragma unroll
            for (int i = 0; i < 2; ++i) { const int tk = (lane >> 2) + 16 * i, part = lane & 3; const LAS unsigned char* src = OT + ct * PR_OT_TILE + tk * PR_OT_PITCH + 16 * part;
                const v2u lo = *(const LAS v2u*)src, hi = *(const LAS v2u*)(src + 8);
                *(GAS v4u*)(KK_ + (size_t)(m0 + tk) * GW + 64 * h + 32 * ct + 8 * part) = (v4u){lo.x, lo.y, hi.x, hi.y}; }
        asm volatile("" ::: "memory");
        if (hh == 0) BC[(size_t)m * NH + h] = bcv;
        __syncthreads();
    }
}

__device__ __forceinline__ Frame mkframe(LAS unsigned char* lds, int wv) {
    Frame F; F.lds = lds; { int t_ = wv * 64 + pg8::lane_now(); asm volatile("" : "+v"(t_)); F.tid = t_; } F.lane = F.tid & 63; F.wave = wv;
    F.G = gridDim.x; { const int bx = blockIdx.x; F.vcu = (F.G % 8 == 0) ? (bx % 8) * (F.G / 8) + bx / 8 : bx; }
    F.gw = blockIdx.x * NWAVES + F.wave; F.ngw = F.G * NWAVES; return F;
}

#ifndef UNPACK8
#define UNPACK8(dst, o, W_) do { dst[(o)] = bflo((W_).x); dst[(o) + 1] = bfhi((W_).x); dst[(o) + 2] = bflo((W_).y); dst[(o) + 3] = bfhi((W_).y); dst[(o) + 4] = bflo((W_).z); dst[(o) + 5] = bfhi((W_).z); dst[(o) + 6] = bflo((W_).w); dst[(o) + 7] = bfhi((W_).w); } while (0)
#endif
#define DOT8(q, o, W_) ((q)[(o)] * bflo((W_).x) + (q)[(o) + 1] * bfhi((W_).x) + (q)[(o) + 2] * bflo((W_).y) + (q)[(o) + 3] * bfhi((W_).y) + (q)[(o) + 4] * bflo((W_).z) + (q)[(o) + 5] * bfhi((W_).z) + (q)[(o) + 6] * bflo((W_).w) + (q)[(o) + 7] * bfhi((W_).w))
#define AXPY8(acc, o, sc, pe, W_) do { acc[(o)] = acc[(o)] * (sc) + (pe) * bflo((W_).x); acc[(o) + 1] = acc[(o) + 1] * (sc) + (pe) * bfhi((W_).x); acc[(o) + 2] = acc[(o) + 2] * (sc) + (pe) * bflo((W_).y); acc[(o) + 3] = acc[(o) + 3] * (sc) + (pe) * bfhi((W_).y); \
    acc[(o) + 4] = acc[(o) + 4] * (sc) + (pe) * bflo((W_).z); acc[(o) + 5] = acc[(o) + 5] * (sc) + (pe) * bfhi((W_).z); acc[(o) + 6] = acc[(o) + 6] * (sc) + (pe) * bflo((W_).w); acc[(o) + 7] = acc[(o) + 7] * (sc) + (pe) * bfhi((W_).w); } while (0)
__device__ __forceinline__ void mix_a_simple(Frame& F) {
    const bf16* PROJ = (const bf16*)(wsp() + WS_PROJ); bf16* YC = (bf16*)(wsp() + WS_YCAT); const int* TB = (const int*)(wsp() + WS_SMALL + SM_TB); const float* pb = inp(3);
    const int nthr = F.G * NTHR;
    for (int idx = blockIdx.x * NTHR + F.tid; idx < M * NH; idx += nthr) {
        const int m = idx >> 3, h = idx & 7, t = m % SEQ;
        float q[64], acc[64];
        { const GAS v4u* qp = (const GAS v4u*)(PROJ + (size_t)m * NPROJ_P + CA_Q + 64 * h);
#pragma unroll
          for (int i = 0; i < 8; ++i) { const v4u w = qp[i]; UNPACK8(q, 8 * i, w); } }
#pragma unroll
        for (int i = 0; i < 64; ++i) acc[i] = 0.f;
        float mx = -1e30f, l = 0.f;
        for (int p = 0; p < 3; ++p) { const int d = p == 0 ? 1 : (p == 1 ? 4 : 16);
            for (int j = 0; j <= 128; ++j) { const int kp = t - j * d; if (kp < 0) break;
                const bf16* row = PROJ + (size_t)(m - j * d) * NPROJ_P; const GAS v4u* kq = (const GAS v4u*)(row + CA_K + 64 * h); const GAS v4u* vq = (const GAS v4u*)(row + CA_V + 64 * h);
                float s = 0.f;
#pragma unroll
                for (int i = 0; i < 8; ++i) { const v4u w = kq[i]; s += DOT8(q, 8 * i, w); }
                s = s * 0.125f + pb[TB[j * d] * 16 + h];
                const float mn = fmaxf(mx, s), sc = __expf(mx - mn), pe = __expf(s - mn); mx = mn; l = l * sc + pe;
#pragma unroll
                for (int i = 0; i < 8; ++i) { const v4u w = vq[i]; AXPY8(acc, 8 * i, sc, pe, w); }
            } }
        const float inv = 1.0f / l; GAS v4u* op = (GAS v4u*)(YC + (size_t)m * DM + 0 * GW + 64 * h);
#pragma unroll
        for (int i = 0; i < 8; ++i) op[i] = (v4u){pk2(acc[8 * i] * inv, acc[8 * i + 1] * inv), pk2(acc[8 * i + 2] * inv, acc[8 * i + 3] * inv), pk2(acc[8 * i + 4] * inv, acc[8 * i + 5] * inv), pk2(acc[8 * i + 6] * inv, acc[8 * i + 7] * inv)};
    }
}
__device__ __forceinline__ void mix_c_simple(Frame& F, int l = 0) {
    const bf16* PROJ = (const bf16*)(wsp() + WS_PROJ); bf16* YC = (bf16*)(wsp() + WS_YCAT); const int* TB = (const int*)(wsp() + WS_SMALL + SM_TB); const float* pb = inp(3);
    const float* KBAR = (const float*)(wsp() + CTL_KBAR) + (size_t)l * 64 * 8 * 64;
    const int nthr = F.G * NTHR;
    for (int idx = blockIdx.x * NTHR + F.tid; idx < M * NH; idx += nthr) {
        const int m = idx >> 3, h = idx & 7, t = m % SEQ, b = m / SEQ, ob = t >> 8;
        float q[64], acc[64];
        { const GAS v4u* qp = (const GAS v4u*)(PROJ + (size_t)m * NPROJ_P + CC_Q + 64 * h);
#pragma unroll
          for (int i = 0; i < 8; ++i) { const v4u w = qp[i]; UNPACK8(q, 8 * i, w); } }
        float gate[8];
#pragma unroll
        for (int n = 0; n < 8; ++n) { float s = 0.f; if (n < ob) { const float* kb = KBAR + ((b * NH + h) * 8 + n) * 64;
#pragma unroll
                for (int i = 0; i < 64; ++i) s += q[i] * kb[i]; } gate[n] = s; }
        unsigned sel = 0u;
#pragma unroll
        for (int n = 0; n < 8; ++n) { int rank = 0;
#pragma unroll
            for (int n2 = 0; n2 < 8; ++n2) rank += (n2 < ob && n2 != n && (gate[n2] > gate[n] || (gate[n2] == gate[n] && n2 < n))) ? 1 : 0;
            if (n < ob && rank < 3) sel |= 1u << n; }
        sel |= 1u << ob;
#pragma unroll
        for (int i = 0; i < 64; ++i) acc[i] = 0.f;
        float mx = -1e30f, l = 0.f;
        for (int n = 0; n <= ob; ++n) { if (!((sel >> n) & 1u)) continue; const int kmax = n == ob ? (t & 255) : 255;
            for (int i2 = 0; i2 <= kmax; ++i2) { const int kp = 256 * n + i2;
                const bf16* row = PROJ + ((size_t)b * SEQ + kp) * NPROJ_P; const GAS v4u* kq = (const GAS v4u*)(row + CC_K + 64 * h); const GAS v4u* vq = (const GAS v4u*)(row + CC_V + 64 * h);
                float s = 0.f;
#pragma unroll
                for (int i = 0; i < 8; ++i) { const v4u w = kq[i]; s += DOT8(q, 8 * i, w); }
                s = s * 0.125f + pb[TB[t - kp] * 16 + 8 + h];
                const float mn = fmaxf(mx, s), sc = __expf(mx - mn), pe = __expf(s - mn); mx = mn; l = l * sc + pe;
#pragma unroll
                for (int i = 0; i < 8; ++i) { const v4u w = vq[i]; AXPY8(acc, 8 * i, sc, pe, w); }
            } }
        const float inv = 1.0f / l; GAS v4u* op = (GAS v4u*)(YC + (size_t)m * DM + 2 * GW + 64 * h);
#pragma unroll
        for (int i = 0; i < 8; ++i) op[i] = (v4u){pk2(acc[8 * i] * inv, acc[8 * i + 1] * inv), pk2(acc[8 * i + 2] * inv, acc[8 * i + 3] * inv), pk2(acc[8 * i + 4] * inv, acc[8 * i + 5] * inv), pk2(acc[8 * i + 6] * inv, acc[8 * i + 7] * inv)};
    }
}
__device__ __forceinline__ void mix_b_simple(Frame& F, int l) {
    const bf16* PROJ = (const bf16*)(wsp() + WS_PROJ); bf16* YC = (bf16*)(wsp() + WS_YCAT); const pg8::fx_t* ST = (const pg8::fx_t*)(wsp() + CTL_STATS) + (size_t)l * M * 2;
    const float* lng = inp(4) + l * GW; const float* sw = inp(5) + (size_t)l * NH * 128 * 128; const float* sb = inp(6) + l * NH * 128;
    const int nthr = F.G * NTHR;
    for (int idx = blockIdx.x * NTHR + F.tid; idx < M * GW; idx += nthr) {
        const int m = idx >> 9, c = idx & 511, g = c >> 6, tt = m & 127, m0 = m - tt;
        const float* wrow = sw + ((size_t)g * 128 + tt) * 128; const float gn = lng[c]; float s = 0.f;
        for (int s2 = 0; s2 <= tt; ++s2) { const int ms = m0 + s2; const float mu_ = pg8::fx_get(ST + 2 * ms) * (1.0f / 512.0f), rs_ = 1.0f / sqrtf(fmaxf(pg8::fx_get(ST + 2 * ms + 1) * (1.0f / 512.0f) - mu_ * mu_, 0.f) + 1e-5f); const float vv = (gelu_tanh(bf2f(PROJ[(size_t)ms * NPROJ_P + CB_V + c])) - mu_) * rs_ * gn; s += wrow[s2] * vv; }
        const float u = gelu_tanh(bf2f(PROJ[(size_t)m * NPROJ_P + CB_U + c]));
        YC[(size_t)m * DM + GW + c] = (bf16)f2bf(u * (s + sb[g * 128 + tt]));
    }
}
__device__ __forceinline__ float rdl(float v, int k) { return __builtin_bit_cast(float, __builtin_amdgcn_readlane(__builtin_bit_cast(int, v), k)); }
__device__ __forceinline__ void mix_d_simple(Frame& F) {
    const bf16* R_ = (const bf16*)outp();
    const bf16* E_ = R_ + (size_t)M * GW; const bf16* KP_ = E_ + (size_t)M * GW; const bf16* V_ = KP_ + (size_t)M * GW;
    const bf16* KK_ = (const bf16*)outp() + (size_t)4 * M * GW; const bf16* AS_ = KK_ + (size_t)M * GW; float* YD = (float*)(wsp() + WS_YD);
    for (int it = F.gw; it < BATCH * NH; it += F.ngw) {
        const int b = it >> 3, h = it & 7; float s[64];
#pragma unroll
        for (int k = 0; k < 64; ++k) s[k] = 0.f;
        for (int t = 0; t < SEQ; ++t) {
            const size_t o = ((size_t)b * SEQ + t) * GW + 64 * h + F.lane;
            const float r = bf2f(R_[o]), w = __expf(-bf2f(E_[o])), kp = bf2f(KP_[o]), v = bf2f(V_[o]), kk = bf2f(KK_[o]), as = bf2f(AS_[o]);
            const float a = -kk, bb = kk * as;
            float sa = 0.f;
#pragma unroll
            for (int k = 0; k < 64; ++k) sa += s[k] * rdl(a, k);
            float y = 0.f;
#pragma unroll
            for (int k = 0; k < 64; ++k) { s[k] = s[k] * rdl(w, k) + sa * rdl(bb, k) + v * rdl(kp, k); y += s[k] * rdl(r, k); }
            YD[o] = y;
        }
    }
}

constexpr float LOG2E = 1.4426950408889634f;

constexpr int SC_T = 32, SC_TOK = (5 * 64 + 32) * 4, SC_BUF = SC_T * SC_TOK, SC_YB = SC_T * 32 * 4, SC_LDS = 2 * SC_BUF + 2 * SC_YB;
template <int CTRL> __device__ __forceinline__ float dpp_add(float x) {
    const int y = __builtin_amdgcn_update_dpp(0, __builtin_bit_cast(int, x), CTRL, 0xF, 0xF, false);
    return x + __builtin_bit_cast(float, y);
}
__device__ __forceinline__ float red8(float x) { x = dpp_add<0xB1>(x); x = dpp_add<0x4E>(x); x = dpp_add<0x141>(x); return x; }
__device__ __forceinline__ void scan_unit(LAS unsigned char* lds, int unit, int tid) {
    const int half = unit & 1, h = (unit >> 1) & 7, b = unit >> 4;
    const bf16* R_ = (const bf16*)outp();
    const bf16* E_ = R_ + (size_t)M * GW; const bf16* KP_ = E_ + (size_t)M * GW; const bf16* V_ = KP_ + (size_t)M * GW;
    const bf16* KK_ = (const bf16*)outp() + (size_t)4 * M * GW; const bf16* AS_ = KK_ + (size_t)M * GW; float* YD = (float*)(wsp() + WS_YD);
    const int lane = tid & 63, wave = __builtin_amdgcn_readfirstlane(tid >> 6);
    const bool scanner = wave < 4;
    const int j = lane & 7, rowl = (wave & 3) * 8 + (lane >> 3);
    const int st = tid & 255, tt = st >> 3, cg = st & 7;
    const size_t gbase = ((size_t)b * SEQ) * GW + 64 * h + 8 * cg;
#define SC_STAGE(c, buf) do { const size_t o_ = gbase + (size_t)((c) * SC_T + tt) * GW; \
        const v4u g_r = *(const GAS v4u*)(R_ + o_), g_e = *(const GAS v4u*)(E_ + o_), g_k = *(const GAS v4u*)(KP_ + o_), g_v = *(const GAS v4u*)(V_ + o_), g_kk = *(const GAS v4u*)(KK_ + o_), g_as = *(const GAS v4u*)(AS_ + o_); \
        LAS float* p_ = (LAS float*)(lds + (buf) * SC_BUF + tt * SC_TOK) + 8 * cg; float kk_[8], x_[8], y_[8]; \
        UNPACK8(kk_, 0, g_kk); \
        *(LAS f32x4*)(p_) = (f32x4){-kk_[0], -kk_[1], -kk_[2], -kk_[3]}; *(LAS f32x4*)(p_ + 4) = (f32x4){-kk_[4], -kk_[5], -kk_[6], -kk_[7]}; \
        UNPACK8(x_, 0, g_e); *(LAS f32x4*)(p_ + 64) = (f32x4){__expf(-x_[0]), __expf(-x_[1]), __expf(-x_[2]), __expf(-x_[3])}; *(LAS f32x4*)(p_ + 68) = (f32x4){__expf(-x_[4]), __expf(-x_[5]), __expf(-x_[6]), __expf(-x_[7])}; \
        UNPACK8(y_, 0, g_as); *(LAS f32x4*)(p_ + 128) = (f32x4){kk_[0] * y_[0], kk_[1] * y_[1], kk_[2] * y_[2], kk_[3] * y_[3]}; *(LAS f32x4*)(p_ + 132) = (f32x4){kk_[4] * y_[4], kk_[5] * y_[5], kk_[6] * y_[6], kk_[7] * y_[7]}; \
        UNPACK8(x_, 0, g_k); *(LAS f32x4*)(p_ + 192) = (f32x4){x_[0], x_[1], x_[2], x_[3]}; *(LAS f32x4*)(p_ + 196) = (f32x4){x_[4], x_[5], x_[6], x_[7]}; \
        UNPACK8(x_, 0, g_r); *(LAS f32x4*)(p_ + 256) = (f32x4){x_[0], x_[1], x_[2], x_[3]}; *(LAS f32x4*)(p_ + 260) = (f32x4){x_[4], x_[5], x_[6], x_[7]}; \
        if ((cg >> 2) == half) { UNPACK8(x_, 0, g_v); LAS float* v_ = (LAS float*)(lds + (buf) * SC_BUF + tt * SC_TOK) + 320 + 8 * (cg & 3); \
            *(LAS f32x4*)(v_) = (f32x4){x_[0], x_[1], x_[2], x_[3]}; *(LAS f32x4*)(v_ + 4) = (f32x4){x_[4], x_[5], x_[6], x_[7]}; } } while (0)
    if (!scanner) SC_STAGE(0, 0);
    __syncthreads();
    f32x4 s0 = {0.f, 0.f, 0.f, 0.f}, s1 = {0.f, 0.f, 0.f, 0.f};
    float ykeep = 0.f;
    for (int c = 0; c < SEQ / SC_T; ++c) {
        const int cur = c & 1;
        LAS float* yb = (LAS float*)(lds + 2 * SC_BUF + cur * SC_YB);
        if (scanner) {
            const LAS float* base = (const LAS float*)(lds + cur * SC_BUF) + 8 * j;
            const LAS float* vbase = (const LAS float*)(lds + cur * SC_BUF) + 320 + rowl;
            f32x4 a0 = *(const LAS f32x4*)(base), a1 = *(const LAS f32x4*)(base + 4), w0 = *(const LAS f32x4*)(base + 64), w1 = *(const LAS f32x4*)(base + 68), b0 = *(const LAS f32x4*)(base + 128), b1 = *(const LAS f32x4*)(base + 132),
                  k0 = *(const LAS f32x4*)(base + 192), k1 = *(const LAS f32x4*)(base + 196), r0 = *(const LAS f32x4*)(base + 256), r1 = *(const LAS f32x4*)(base + 260);
            float vv = *vbase;
#pragma unroll
            for (int t = 0; t < SC_T; ++t) {
                f32x4 na0 = a0, na1 = a1, nw0 = w0, nw1 = w1, nb0 = b0, nb1 = b1, nk0 = k0, nk1 = k1, nr0 = r0, nr1 = r1; float nv = vv;
                if (t + 1 < SC_T) { const LAS float* p = base + (t + 1) * (SC_TOK / 4);
                    na0 = *(const LAS f32x4*)(p); na1 = *(const LAS f32x4*)(p + 4); nw0 = *(const LAS f32x4*)(p + 64); nw1 = *(const LAS f32x4*)(p + 68); nb0 = *(const LAS f32x4*)(p + 128); nb1 = *(const LAS f32x4*)(p + 132);
                    nk0 = *(const LAS f32x4*)(p + 192); nk1 = *(const LAS f32x4*)(p + 196); nr0 = *(const LAS f32x4*)(p + 256); nr1 = *(const LAS f32x4*)(p + 260);
                    nv = vbase[(t + 1) * (SC_TOK / 4)]; }
                const f32x4 pa = s0 * a0 + s1 * a1;
                float sa = (pa.x + pa.y) + (pa.z + pa.w);
                const f32x4 sw0 = s0 * w0 + vv * k0, sw1 = s1 * w1 + vv * k1;
                sa = red8(sa);
                s0 = sa * b0 + sw0; s1 = sa * b1 + sw1;
                const f32x4 py = s0 * r0 + s1 * r1;
                float y = (py.x + py.y) + (py.z + py.w);
                y = red8(y);
                ykeep = (j == (t & 7)) ? y : ykeep;
                if ((t & 7) == 7) yb[((t & ~7) + j) * 32 + rowl] = ykeep;
                a0 = na0; a1 = na1; w0 = nw0; w1 = nw1; b0 = nb0; b1 = nb1; k0 = nk0; k1 = nk1; r0 = nr0; r1 = nr1; vv = nv;
            }
        } else {
            if (c > 0) {
                const LAS float* ybp = (const LAS float*)(lds + 2 * SC_BUF + (cur ^ 1) * SC_YB); const int t2 = st >> 3, q4 = st & 7; const f32x4 v = *(const LAS f32x4*)(ybp + t2 * 32 + 4 * q4);
                *(GAS f32x4*)(YD + ((size_t)b * SEQ + (c - 1) * SC_T + t2) * GW + 64 * h + 32 * half + 4 * q4) = v; }
            if (c + 1 < SEQ / SC_T) SC_STAGE(c + 1, cur ^ 1);
        }
        __syncthreads();
    }
    if (!scanner) { const LAS float* ybp = (const LAS float*)(lds + 2 * SC_BUF + 1 * SC_YB); const int t2 = st >> 3, q4 = st & 7; const f32x4 v = *(const LAS f32x4*)(ybp + t2 * 32 + 4 * q4);
        *(GAS f32x4*)(YD + ((size_t)b * SEQ + (SEQ / SC_T - 1) * SC_T + t2) * GW + 64 * h + 32 * half + 4 * q4) = v; }
#undef SC_STAGE
    __syncthreads();
}

struct AttnSt { f32x16 o0, o1; float m, l; };
__device__ __forceinline__ void attn_init(AttnSt& st) {
    const float z_ = zero_v();
#pragma unroll
    for (int i = 0; i < 16; ++i) { st.o0[i] = z_; st.o1[i] = z_; }
    st.m = -1e30f; st.l = 0.f;
}
__device__ __forceinline__ void attn_tile(AttnSt& st, const bf16x8 (&qf)[4], const bf16* Kcol, const bf16* Vcol, int rowb, int kb, int ks, int qpos, int maxd, bool sel, const LAS float* biasT, int r32, int hh) {
    int kp_l = kb + r32 * ks; kp_l = kp_l < 0 ? 0 : kp_l;
    const bf16* kr_ = Kcol + (size_t)(rowb + kp_l) * NPROJ_P + 8 * hh;
    bf16x8 kf[4];
#pragma unroll
    for (int s = 0; s < 4; ++s) kf[s] = *(const GAS bf16x8*)(kr_ + 16 * s);
    f32x16 sc;
#pragma unroll
    for (int i = 0; i < 16; ++i) sc[i] = 0.f;
#pragma unroll
    for (int s = 0; s < 4; ++s) sc = __builtin_amdgcn_mfma_f32_32x32x16_bf16(kf[s], qf[s], sc, 0, 0, 0);
    unsigned vf[2][2][4];
#pragma unroll
    for (int s2 = 0; s2 < 2; ++s2)
#pragma unroll
        for (int jp = 0; jp < 4; ++jp) {
            const int j0 = 2 * jp, key0 = 16 * s2 + 8 * (j0 >> 2) + 4 * hh + (j0 & 3);
            int kp0 = kb + key0 * ks, kp1 = kp0 + ks; kp0 = kp0 < 0 ? 0 : kp0; kp1 = kp1 < 0 ? 0 : kp1;
            const bf16* v0 = Vcol + (size_t)(rowb + kp0) * NPROJ_P + r32; const bf16* v1 = Vcol + (size_t)(rowb + kp1) * NPROJ_P + r32;
            vf[0][s2][jp] = (unsigned)v0[0] | ((unsigned)v1[0] << 16); vf[1][s2][jp] = (unsigned)v0[32] | ((unsigned)v1[32] << 16);
        }
    float tmax = -INFINITY;
#pragma unroll
    for (int r = 0; r < 16; ++r) {
        const int kr = (r & 3) + 8 * (r >> 2) + 4 * hh, kp = kb + kr * ks, dist = qpos - kp;
        const bool ok = sel && dist >= 0 && dist <= maxd && kp >= 0;
        const float v = sc[r] * (0.125f * LOG2E) + biasT[ok ? dist : 0];
        sc[r] = ok ? v : -INFINITY; tmax = fmaxf(tmax, sc[r]);
    }
    tmax = fmaxf(tmax, __shfl_xor(tmax, 32));
    const float mn = fmaxf(st.m, tmax), scale = __builtin_amdgcn_exp2f(st.m - mn); st.m = mn;
    float ls = 0.f;
#pragma unroll
    for (int r = 0; r < 16; ++r) { sc[r] = __builtin_amdgcn_exp2f(sc[r] - mn); ls += sc[r]; }
    st.l = st.l * scale + ls;
#pragma unroll
    for (int i = 0; i < 16; ++i) { st.o0[i] *= scale; st.o1[i] *= scale; }
    typedef unsigned u32x4_t __attribute__((ext_vector_type(4)));
#pragma unroll
    for (int s2 = 0; s2 < 2; ++s2) {
        u32x4_t pw; pw.x = pg8::cvt_pk_bf16(sc[8 * s2], sc[8 * s2 + 1]); pw.y = pg8::cvt_pk_bf16(sc[8 * s2 + 2], sc[8 * s2 + 3]); pw.z = pg8::cvt_pk_bf16(sc[8 * s2 + 4], sc[8 * s2 + 5]); pw.w = pg8::cvt_pk_bf16(sc[8 * s2 + 6], sc[8 * s2 + 7]);
        const bf16x8 pf = __builtin_bit_cast(bf16x8, pw);
        u32x4_t a0 = {vf[0][s2][0], vf[0][s2][1], vf[0][s2][2], vf[0][s2][3]}, a1 = {vf[1][s2][0], vf[1][s2][1], vf[1][s2][2], vf[1][s2][3]};
        st.o0 = __builtin_amdgcn_mfma_f32_32x32x16_bf16(__builtin_bit_cast(bf16x8, a0), pf, st.o0, 0, 0, 0);
        st.o1 = __builtin_amdgcn_mfma_f32_32x32x16_bf16(__builtin_bit_cast(bf16x8, a1), pf, st.o1, 0, 0, 0);
    }
}
__device__ __forceinline__ void attn_loadq(bf16x8 (&qf)[4], const bf16* Qcol, int row, int hh) {
    const bf16* q = Qcol + (size_t)row * NPROJ_P + 8 * hh;
#pragma unroll
    for (int s = 0; s < 4; ++s) qf[s] = *(const GAS bf16x8*)(q + 16 * s);
}
__device__ __forceinline__ void attn_store(const f32x16& o0, const f32x16& o1, float inv, bf16* yrow, int hh) {
#pragma unroll
    for (int g = 0; g < 4; ++g) {
        *(GAS v2u*)(yrow + 8 * g + 4 * hh) = (v2u){pk2(o0[4 * g] * inv, o0[4 * g + 1] * inv), pk2(o0[4 * g + 2] * inv, o0[4 * g + 3] * inv)};
        *(GAS v2u*)(yrow + 32 + 8 * g + 4 * hh) = (v2u){pk2(o1[4 * g] * inv, o1[4 * g + 1] * inv), pk2(o1[4 * g + 2] * inv, o1[4 * g + 3] * inv)};
    }
}
__device__ __forceinline__ void build_bias(LAS float* biasT, int hcol, int tid) {
    const int* TB = (const int*)(wsp() + WS_SMALL + SM_TB); const float* pb = inp(3); LAS int* bktT = (LAS int*)(biasT + 2048);
    for (int d = tid; d < 2048; d += NTHR) { const int bk = TB[d]; bktT[d] = bk; biasT[d] = pb[bk * 16 + hcol] * LOG2E; }
}

constexpr int MC_KP = 144, MC_VP = 192, MC_KB = 128 * MC_KP, MC_VB = 128 * MC_VP, MC_K_OFF = 16384, MC_V_OFF = MC_K_OFF + 2 * MC_KB, MC_LDS = MC_V_OFF + 2 * MC_VB;
typedef short v4i16_t __attribute__((ext_vector_type(4)));
__device__ __forceinline__ float pl32_max(float a) { float x = a, y = a;
    asm volatile("s_nop 1\n\tv_permlane32_swap_b32_e32 %0, %1\n\ts_nop 0" : "+v"(x), "+v"(y));
    return fmaxf(x, y); }
template <int MODE> __device__ __forceinline__ void moba_tile(AttnSt& st, const bf16x8 (&qf)[4], const LAS unsigned char* Kt, const LAS unsigned char* Vt, const LAS float* biasT, const LAS int* TB, int dlo, bool sel, int lane, int r32, int hh) {
    bf16x8 kf[4];
#pragma unroll
    for (int s = 0; s < 4; ++s) kf[s] = *(const LAS bf16x8*)(Kt + r32 * MC_KP + 32 * s + 16 * hh);
    v4i16_t vt[2][2][2];
    { const LAS unsigned char* vb = Vt + (4 * hh + ((lane & 15) >> 2)) * MC_VP + (16 * ((lane >> 4) & 1) + 4 * (lane & 3)) * 2;
#pragma unroll
      for (int dh = 0; dh < 2; ++dh)
#pragma unroll
        for (int s2 = 0; s2 < 2; ++s2)
#pragma unroll
            for (int h8 = 0; h8 < 2; ++h8) vt[dh][s2][h8] = __builtin_amdgcn_ds_read_tr16_b64_v4i16((LAS v4i16_t*)(vb + (16 * s2 + 8 * h8) * MC_VP + 64 * dh)); }
    f32x16 sc;
#pragma unroll
    for (int i = 0; i < 16; ++i) sc[i] = 0.f;
#pragma unroll
    for (int s = 0; s < 4; ++s) sc = __builtin_amdgcn_mfma_f32_32x32x16_bf16(kf[s], qf[s], sc, 0, 0, 0);
    const int d0 = dlo + r32 + 31 - 4 * hh;
    const int dmin = dlo < 0 ? 0 : dlo, dmax = dlo + 62;
    const bool uni = __builtin_amdgcn_readfirstlane(TB[dmin]) == __builtin_amdgcn_readfirstlane(TB[dmax]);
    float tmax = -INFINITY;
    if (uni) { const float bu = biasT[dmin];
#pragma unroll
        for (int r = 0; r < 16; ++r) { float v = sc[r] * (0.125f * LOG2E) + bu; if (MODE == 1) { const int dist = d0 - (r & 3) - 8 * (r >> 2); v = dist >= 0 ? v : -INFINITY; } sc[r] = v; tmax = fmaxf(tmax, v); }
    } else {
#pragma unroll
        for (int r = 0; r < 16; ++r) { const int dist = d0 - (r & 3) - 8 * (r >> 2); float v = sc[r] * (0.125f * LOG2E) + biasT[dist < 0 ? 0 : dist]; if (MODE == 1) v = dist >= 0 ? v : -INFINITY; sc[r] = v; tmax = fmaxf(tmax, v); }
    }
    if (MODE == 2) tmax = sel ? tmax : -INFINITY;
    tmax = pl32_max(tmax);
    const float mn = fmaxf(st.m, tmax);
    if (__ballot(mn > st.m) != 0ull) { const float scale = __builtin_amdgcn_exp2f(st.m - mn); st.l *= scale;
#pragma unroll
        for (int i = 0; i < 16; ++i) { st.o0[i] *= scale; st.o1[i] *= scale; } }
    st.m = mn;
    const float msub = (MODE == 2 && !sel) ? INFINITY : mn;
    float ls = 0.f;
#pragma unroll
    for (int r = 0; r < 16; ++r) { sc[r] = __builtin_amdgcn_exp2f(sc[r] - msub); ls += sc[r]; }
    st.l += ls;
    typedef unsigned u32x4_t __attribute__((ext_vector_type(4)));
#pragma unroll
    for (int s2 = 0; s2 < 2; ++s2) {
        u32x4_t pw; pw.x = pg8::cvt_pk_bf16(sc[8 * s2], sc[8 * s2 + 1]); pw.y = pg8::cvt_pk_bf16(sc[8 * s2 + 2], sc[8 * s2 + 3]); pw.z = pg8::cvt_pk_bf16(sc[8 * s2 + 4], sc[8 * s2 + 5]); pw.w = pg8::cvt_pk_bf16(sc[8 * s2 + 6], sc[8 * s2 + 7]);
        const bf16x8 pf = __builtin_bit_cast(bf16x8, pw);
        const bf16x8 a0 = {vt[0][s2][0][0], vt[0][s2][0][1], vt[0][s2][0][2], vt[0][s2][0][3], vt[0][s2][1][0], vt[0][s2][1][1], vt[0][s2][1][2], vt[0][s2][1][3]};
        const bf16x8 a1 = {vt[1][s2][0][0], vt[1][s2][0][1], vt[1][s2][0][2], vt[1][s2][0][3], vt[1][s2][1][0], vt[1][s2][1][1], vt[1][s2][1][2], vt[1][s2][1][3]};
        st.o0 = __builtin_amdgcn_mfma_f32_32x32x16_bf16(a0, pf, st.o0, 0, 0, 0);
        st.o1 = __builtin_amdgcn_mfma_f32_32x32x16_bf16(a1, pf, st.o1, 0, 0, 0);
    }
}
__device__ __forceinline__ void moba_unit(LAS unsigned char* lds, int unit, int tid, int l) {
    const int ob = unit & 7, h = (unit >> 3) & 7, b = unit >> 6, lane = tid & 63, wave = __builtin_amdgcn_readfirstlane(tid >> 6), r32 = lane & 31, hh = lane >> 5;
    LAS float* biasT = (LAS float*)lds;
    build_bias(biasT, 8 + h, tid);
    const bf16* PROJ = (const bf16*)(wsp() + WS_PROJ); const float* KBAR = (const float*)(wsp() + CTL_KBAR) + (size_t)l * 64 * 8 * 64 + ((b * NH + h) * 8) * 64; const LAS int* TB = (const LAS int*)(biasT + 2048);
    const int rowb = b * SEQ, qpos = 256 * ob + 32 * wave + r32;
    bf16x8 qf[4]; attn_loadq(qf, PROJ + CC_Q + 64 * h, rowb + qpos, hh);
    float gate[8];
#pragma unroll
    for (int n = 0; n < 8; ++n) { float s = 0.f;
        if (n < ob) {
#pragma unroll
            for (int s4 = 0; s4 < 4; ++s4) { const f32x4 k0 = *(const GAS f32x4*)(KBAR + n * 64 + 16 * s4 + 8 * hh), k1 = *(const GAS f32x4*)(KBAR + n * 64 + 16 * s4 + 8 * hh + 4);
                const v4u qw = __builtin_bit_cast(v4u, qf[s4]);
                s += bflo(qw.x) * k0.x + bfhi(qw.x) * k0.y + bflo(qw.y) * k0.z + bfhi(qw.y) * k0.w + bflo(qw.z) * k1.x + bfhi(qw.z) * k1.y + bflo(qw.w) * k1.z + bfhi(qw.w) * k1.w; }
            s += __shfl_xor(s, 32); }
        gate[n] = s; }
    unsigned selm = 0u;
#pragma unroll
    for (int n = 0; n < 8; ++n) { int rank = 0;
#pragma unroll
        for (int n2 = 0; n2 < 8; ++n2) rank += (n2 < ob && n2 != n && (gate[n2] > gate[n] || (gate[n2] == gate[n] && n2 < n))) ? 1 : 0;
        if (n < ob && rank < 3) selm |= 1u << n; }
    AttnSt st; attn_init(st);
    const int skey = tid >> 2, spart = tid & 3;
    const bf16* Kg = PROJ + (size_t)rowb * NPROJ_P + CC_K + 64 * h + 16 * spart; const bf16* Vg = PROJ + (size_t)rowb * NPROJ_P + CC_V + 64 * h + 16 * spart;
    bf16x8 gk0, gk1, gv0, gv1;
#define MC_GLOAD(i) do { const size_t ro_ = (size_t)(128 * (i) + skey) * NPROJ_P; gk0 = *(const GAS bf16x8*)(Kg + ro_); gk1 = *(const GAS bf16x8*)(Kg + ro_ + 8); gv0 = *(const GAS bf16x8*)(Vg + ro_); gv1 = *(const GAS bf16x8*)(Vg + ro_ + 8); } while (0)
#define MC_LSTORE(bf) do { LAS unsigned char* kd_ = lds + MC_K_OFF + (bf) * MC_KB + skey * MC_KP + 32 * spart; *(LAS bf16x8*)(kd_) = gk0; *(LAS bf16x8*)(kd_ + 16) = gk1; \
        LAS unsigned char* vd_ = lds + MC_V_OFF + (bf) * MC_VB + skey * MC_VP + 32 * spart; *(LAS bf16x8*)(vd_) = gv0; *(LAS bf16x8*)(vd_ + 16) = gv1; } while (0)
    const int nst = 2 * (ob + 1);
    MC_GLOAD(0); MC_LSTORE(0);
    __syncthreads();
    for (int i = 0; i < nst; ++i) {
        if (i + 1 < nst) MC_GLOAD(i + 1);
        const int n = i >> 1, hf = i & 1; const bool own = n == ob, sel = own || ((selm >> n) & 1u);
        const LAS unsigned char* Kb = lds + MC_K_OFF + (i & 1) * MC_KB; const LAS unsigned char* Vb = lds + MC_V_OFF + (i & 1) * MC_VB;
        if (own) {
#pragma unroll 1
            for (int sub = 0; sub < 4; ++sub) { const int jt = 4 * hf + sub; if (jt > wave) break; const int dlo = 32 * wave - (32 * jt + 31);
                if (jt == wave) moba_tile<1>(st, qf, Kb + sub * 32 * MC_KP, Vb + sub * 32 * MC_VP, biasT, TB, dlo, true, lane, r32, hh);
                else moba_tile<0>(st, qf, Kb + sub * 32 * MC_KP, Vb + sub * 32 * MC_VP, biasT, TB, dlo, true, lane, r32, hh); }
        } else if (__ballot(sel) != 0ull) {
#pragma unroll 1
            for (int sub = 0; sub < 4; ++sub) { const int dlo = 256 * ob + 32 * wave - (256 * n + 128 * hf + 32 * sub + 31);
                moba_tile<2>(st, qf, Kb + sub * 32 * MC_KP, Vb + sub * 32 * MC_VP, biasT, TB, dlo, sel, lane, r32, hh); }
        }
        if (i + 1 < nst) MC_LSTORE((i + 1) & 1);
        __syncthreads();
    }
#undef MC_GLOAD
#undef MC_LSTORE
    const float lt = st.l + __shfl_xor(st.l, 32);
    attn_store(st.o0, st.o1, 1.0f / lt, (bf16*)(wsp() + WS_YCAT) + (size_t)(rowb + qpos) * DM + 2 * GW + 64 * h, hh);
}

constexpr int MA_PITCH = 144, MA_ML_OFF = 512 * MA_PITCH, MA_BIAS_OFF = MA_ML_OFF + 512 * 8, MA_V_OFF = MA_BIAS_OFF + 16384, MA_VW = 32 * MC_VP, MA_LDS = MA_V_OFF + 8 * MA_VW;
template <bool MASKED> __device__ __forceinline__ void dil_tile(AttnSt& st, const bf16x8 (&qf)[4], const bf16x8 (&kf)[4], const LAS unsigned char* Vt, const LAS float* biasT, const LAS int* TB, int dl0, int dstep, int kb, int lane, int r32, int hh) {
    v4i16_t vt[2][2][2];
    { const LAS unsigned char* vb = Vt + (4 * hh + ((lane & 15) >> 2)) * MC_VP + (16 * ((lane >> 4) & 1) + 4 * (lane & 3)) * 2;
#pragma unroll
      for (int dh = 0; dh < 2; ++dh)
#pragma unroll
        for (int s2 = 0; s2 < 2; ++s2)
#pragma unroll
            for (int h8 = 0; h8 < 2; ++h8) vt[dh][s2][h8] = __builtin_amdgcn_ds_read_tr16_b64_v4i16((LAS v4i16_t*)(vb + (16 * s2 + 8 * h8) * MC_VP + 64 * dh)); }
    f32x16 sc;
#pragma unroll
    for (int i = 0; i < 16; ++i) sc[i] = 0.f;
#pragma unroll
    for (int s = 0; s < 4; ++s) sc = __builtin_amdgcn_mfma_f32_32x32x16_bf16(kf[s], qf[s], sc, 0, 0, 0);
    const int e0 = dl0 + r32 - 4 * hh;
    int dmin = (dl0 - 31) * dstep, dmax = (dl0 + 31) * dstep; dmin = dmin < 0 ? 0 : dmin; dmax = dmax > 2047 ? 2047 : dmax;
    const bool uni = __builtin_amdgcn_readfirstlane(TB[dmin]) == __builtin_amdgcn_readfirstlane(TB[dmax]);
    const float bu = biasT[dmin];
    float tmax = -INFINITY;
#pragma unroll
    for (int r = 0; r < 16; ++r) {
        const int kr0 = (r & 3) + 8 * (r >> 2), delta = e0 - kr0;
        float bias = bu;
        if (!uni) { int di = delta * dstep; di = di < 0 ? 0 : (di > 2047 ? 2047 : di); bias = biasT[di]; }
        float v = sc[r] * (0.125f * LOG2E) + bias;
        if (MASKED) { const bool ok = delta >= 0 && delta <= 128 && (kb + (kr0 + 4 * hh) * dstep) >= 0; v = ok ? v : -INFINITY; }
        sc[r] = v; tmax = fmaxf(tmax, v);
    }
    tmax = pl32_max(tmax);
    const float mn = fmaxf(st.m, tmax);
    if (__ballot(mn > st.m) != 0ull) { const float scale = __builtin_amdgcn_exp2f(st.m - mn); st.l *= scale;
#pragma unroll
        for (int i = 0; i < 16; ++i) { st.o0[i] *= scale; st.o1[i] *= scale; } }
    st.m = mn;
    float ls = 0.f;
#pragma unroll
    for (int r = 0; r < 16; ++r) { sc[r] = __builtin_amdgcn_exp2f(sc[r] - mn); ls += sc[r]; }
    st.l += ls;
    typedef unsigned u32x4_t __attribute__((ext_vector_type(4)));
#pragma unroll
    for (int s2 = 0; s2 < 2; ++s2) {
        u32x4_t pw; pw.x = pg8::cvt_pk_bf16(sc[8 * s2], sc[8 * s2 + 1]); pw.y = pg8::cvt_pk_bf16(sc[8 * s2 + 2], sc[8 * s2 + 3]); pw.z = pg8::cvt_pk_bf16(sc[8 * s2 + 4], sc[8 * s2 + 5]); pw.w = pg8::cvt_pk_bf16(sc[8 * s2 + 6], sc[8 * s2 + 7]);
        const bf16x8 pf = __builtin_bit_cast(bf16x8, pw);
        const bf16x8 a0 = {vt[0][s2][0][0], vt[0][s2][0][1], vt[0][s2][0][2], vt[0][s2][0][3], vt[0][s2][1][0], vt[0][s2][1][1], vt[0][s2][1][2], vt[0][s2][1][3]};
        const bf16x8 a1 = {vt[1][s2][0][0], vt[1][s2][0][1], vt[1][s2][0][2], vt[1][s2][0][3], vt[1][s2][1][0], vt[1][s2][1][1], vt[1][s2][1][2], vt[1][s2][1][3]};
        st.o0 = __builtin_amdgcn_mfma_f32_32x32x16_bf16(a0, pf, st.o0, 0, 0, 0);
        st.o1 = __builtin_amdgcn_mfma_f32_32x32x16_bf16(a1, pf, st.o1, 0, 0, 0);
    }
}
__device__ __forceinline__ void dil_unit(LAS unsigned char* lds, int unit, int tid) {
    const int sp = unit & 3, h = (unit >> 2) & 7, b = unit >> 5, lane = tid & 63, wave = __builtin_amdgcn_readfirstlane(tid >> 6), r32 = lane & 31, hh = lane >> 5;
    LAS float* biasT = (LAS float*)(lds + MA_BIAS_OFF);
    build_bias(biasT, h, tid);
    __syncthreads();
    const bf16* PROJ = (const bf16*)(wsp() + WS_PROJ); const LAS int* TB = (const LAS int*)(biasT + 2048); const int rowb = b * SEQ, t0 = 512 * sp;
    const bf16* Qc = PROJ + CA_Q + 64 * h; const bf16* Kc = PROJ + CA_K + 64 * h; const bf16* Vc = PROJ + CA_V + 64 * h;
    LAS unsigned char* Vst = lds + MA_V_OFF + wave * MA_VW;
    const int vkey = lane >> 1, vhalf = lane & 1;
#pragma unroll 1
    for (int p = 0; p < 3; ++p) {
        const int d = p == 0 ? 1 : (p == 1 ? 4 : 16);
#pragma unroll 1
        for (int gi = 0; gi < 2; ++gi) {
            const int g = 2 * wave + gi;
            const int qb = t0 + (p == 0 ? 32 * g : (p == 1 ? 128 * (g >> 2) + (g & 3) : g));
            const int qpos = qb + r32 * d, qi = qpos - t0;
            bf16x8 qf[4]; attn_loadq(qf, Qc, rowb + qpos, hh);
            AttnSt st; attn_init(st);
            int jt = 0; while (qb + (32 * jt - 128 + 31) * d < 0) ++jt;
            bf16x8 kfn[4], vrn[4];
#define MA_GLOAD(JT) do { const int kb_ = qb + (32 * (JT) - 128) * d; int kp_ = kb_ + r32 * d; kp_ = kp_ < 0 ? 0 : kp_; const bf16* kr_ = Kc + (size_t)(rowb + kp_) * NPROJ_P + 8 * hh; \
                _Pragma("unroll") for (int s = 0; s < 4; ++s) kfn[s] = *(const GAS bf16x8*)(kr_ + 16 * s); \
                int vp_ = kb_ + vkey * d; vp_ = vp_ < 0 ? 0 : vp_; const bf16* vr_ = Vc + (size_t)(rowb + vp_) * NPROJ_P + 32 * vhalf; \
                _Pragma("unroll") for (int s = 0; s < 4; ++s) vrn[s] = *(const GAS bf16x8*)(vr_ + 8 * s); } while (0)
            MA_GLOAD(jt);
#pragma unroll 1
            for (; jt < 5; ++jt) {
                bf16x8 kf[4] = {kfn[0], kfn[1], kfn[2], kfn[3]};
                { LAS unsigned char* vd = Vst + vkey * MC_VP + 64 * vhalf;
#pragma unroll
                  for (int s = 0; s < 4; ++s) *(LAS bf16x8*)(vd + 16 * s) = vrn[s]; }
                asm volatile("" ::: "memory");
                if (jt + 1 < 5) MA_GLOAD(jt + 1);
                const int kb = qb + (32 * jt - 128) * d, dl0 = 128 - 32 * jt;
                if (jt == 0 || jt == 4 || kb < 0) dil_tile<true>(st, qf, kf, Vst, biasT, TB, dl0, d, kb, lane, r32, hh);
                else dil_tile<false>(st, qf, kf, Vst, biasT, TB, dl0, d, kb, lane, r32, hh);
            }
#undef MA_GLOAD
            float lt = st.l + __shfl_xor(st.l, 32);
            LAS unsigned char* orow = lds + qi * MA_PITCH; LAS float* ml = (LAS float*)(lds + MA_ML_OFF + qi * 8);
            if (p > 0) {
                const float mo = ml[0], lo = ml[1], mn = fmaxf(mo, st.m), fo = __builtin_amdgcn_exp2f(mo - mn), fc = __builtin_amdgcn_exp2f(st.m - mn);
                lt = lo * fo + lt * fc;
#pragma unroll
                for (int g4 = 0; g4 < 4; ++g4) { const v2u a = *(const LAS v2u*)(orow + 2 * (8 * g4 + 4 * hh)), c = *(const LAS v2u*)(orow + 64 + 2 * (8 * g4 + 4 * hh));
                    const float av[4] = {bflo(a.x), bfhi(a.x), bflo(a.y), bfhi(a.y)}, cv[4] = {bflo(c.x), bfhi(c.x), bflo(c.y), bfhi(c.y)};
#pragma unroll
                    for (int e = 0; e < 4; ++e) { st.o0[4 * g4 + e] = av[e] * fo + st.o0[4 * g4 + e] * fc; st.o1[4 * g4 + e] = cv[e] * fo + st.o1[4 * g4 + e] * fc; } }
                st.m = mn;
            }
            if (p < 2) {
#pragma unroll
                for (int g4 = 0; g4 < 4; ++g4) { *(LAS v2u*)(orow + 2 * (8 * g4 + 4 * hh)) = (v2u){pk2(st.o0[4 * g4], st.o0[4 * g4 + 1]), pk2(st.o0[4 * g4 + 2], st.o0[4 * g4 + 3])};
                    *(LAS v2u*)(orow + 64 + 2 * (8 * g4 + 4 * hh)) = (v2u){pk2(st.o1[4 * g4], st.o1[4 * g4 + 1]), pk2(st.o1[4 * g4 + 2], st.o1[4 * g4 + 3])}; }
                if (hh == 0) { ml[0] = st.m; ml[1] = lt; }
            } else attn_store(st.o0, st.o1, 1.0f / lt, (bf16*)(wsp() + WS_YCAT) + (size_t)(rowb + qpos) * DM + 0 * GW + 64 * h, hh);
        }
        __syncthreads();
    }
}

constexpr int SG_PITCH = 144, SG_WAVE = 128 * SG_PITCH, SG_OP = 272;
static_assert(8 * SG_WAVE <= MISC_OFF && 32 * SG_OP <= SG_WAVE, "SGU LDS");
__device__ __forceinline__ void sgu_unit(LAS unsigned char* lds, int unit, int tid, int l) {
    const int lane = tid & 63, g = __builtin_amdgcn_readfirstlane(tid >> 6), r32 = lane & 31, hh = lane >> 5, m0 = unit * 128;
    const bf16* PROJ = (const bf16*)(wsp() + WS_PROJ); bf16* YC = (bf16*)(wsp() + WS_YCAT); const pg8::fx_t* ST = (const pg8::fx_t*)(wsp() + CTL_STATS) + (size_t)l * M * 2;
    const float* lng = inp(4) + l * GW; const float* sw = inp(5) + ((size_t)l * NH + g) * 128 * 128; const float* sb = inp(6) + (l * NH + g) * 128;
    LAS unsigned char* T = lds + g * SG_WAVE;
    const int tk8 = lane >> 3, part = lane & 7;
    { const f32x4 g0 = *(const GAS f32x4*)(lng + 64 * g + 8 * part), g1 = *(const GAS f32x4*)(lng + 64 * g + 8 * part + 4);
      const float gn[8] = {g0.x, g0.y, g0.z, g0.w, g1.x, g1.y, g1.z, g1.w};
#pragma unroll 4
      for (int i = 0; i < 16; ++i) { const int tkn = tk8 + 8 * i, mm = m0 + tkn;
          const v4u w = *(const GAS v4u*)(PROJ + (size_t)mm * NPROJ_P + CB_V + 64 * g + 8 * part);
          const float mu = pg8::fx_get(ST + 2 * mm) * (1.0f / 512.0f), rs = __builtin_amdgcn_rsqf(fmaxf(pg8::fx_get(ST + 2 * mm + 1) * (1.0f / 512.0f) - mu * mu, 0.f) + 1e-5f);
          float x[8] = {bflo(w.x), bfhi(w.x), bflo(w.y), bfhi(w.y), bflo(w.z), bfhi(w.z), bflo(w.w), bfhi(w.w)};
#pragma unroll
          for (int e = 0; e < 8; ++e) x[e] = (gelu_tanh(x[e]) - mu) * rs * gn[e];
          *(LAS v4u*)(T + tkn * SG_PITCH + 16 * part) = (v4u){pk2(x[0], x[1]), pk2(x[2], x[3]), pk2(x[4], x[5]), pk2(x[6], x[7])}; } }
    asm volatile("" ::: "memory");
    f32x16 acc[4][2];
    const float z_ = zero_v();
#pragma unroll
    for (int tt = 0; tt < 4; ++tt)
#pragma unroll
        for (int ct = 0; ct < 2; ++ct)
#pragma unroll
            for (int i = 0; i < 16; ++i) acc[tt][ct][i] = z_;
    const LAS unsigned char* vb = T + (8 * hh + ((lane & 15) >> 2)) * SG_PITCH + (16 * ((lane >> 4) & 1) + 4 * (lane & 3)) * 2;
#pragma unroll
    for (int k = 0; k < 8; ++k) {
        v4i16_t t00 = __builtin_amdgcn_ds_read_tr16_b64_v4i16((LAS v4i16_t*)(vb + (16 * k) * SG_PITCH)), t01 = __builtin_amdgcn_ds_read_tr16_b64_v4i16((LAS v4i16_t*)(vb + (16 * k + 4) * SG_PITCH));
        v4i16_t t10 = __builtin_amdgcn_ds_read_tr16_b64_v4i16((LAS v4i16_t*)(vb + (16 * k) * SG_PITCH + 64)), t11 = __builtin_amdgcn_ds_read_tr16_b64_v4i16((LAS v4i16_t*)(vb + (16 * k + 4) * SG_PITCH + 64));
        const bf16x8 af0 = {t00[0], t00[1], t00[2], t00[3], t01[0], t01[1], t01[2], t01[3]}, af1 = {t10[0], t10[1], t10[2], t10[3], t11[0], t11[1], t11[2], t11[3]};
#pragma unroll
        for (int tt = 0; tt < 4; ++tt) { if (k < 2 * (tt + 1)) {
                const int t = 32 * tt + r32, s0 = 16 * k + 8 * hh; const float* wrow = sw + (size_t)t * 128 + s0;
                const f32x4 w0 = *(const GAS f32x4*)(wrow), w1 = *(const GAS f32x4*)(wrow + 4);
                float wv[8] = {w0.x, w0.y, w0.z, w0.w, w1.x, w1.y, w1.z, w1.w};
#pragma unroll
                for (int j = 0; j < 8; ++j) wv[j] = (s0 + j <= t) ? wv[j] : 0.f;
                const v4u bw = {pk2(wv[0], wv[1]), pk2(wv[2], wv[3]), pk2(wv[4], wv[5]), pk2(wv[6], wv[7])}; const bf16x8 bfr = __builtin_bit_cast(bf16x8, bw);
                acc[tt][0] = __builtin_amdgcn_mfma_f32_32x32x16_bf16(af0, bfr, acc[tt][0], 0, 0, 0); acc[tt][1] = __builtin_amdgcn_mfma_f32_32x32x16_bf16(af1, bfr, acc[tt][1], 0, 0, 0); } }
    }
    asm volatile("" ::: "memory");
#pragma unroll
    for (int tt = 0; tt < 4; ++tt) {
        const float bias = sb[32 * tt + r32];
#pragma unroll
        for (int ct = 0; ct < 2; ++ct)
#pragma unroll
            for (int g4 = 0; g4 < 4; ++g4) { const f32x16& a = acc[tt][ct];
                *(LAS f32x4*)(T + r32 * SG_OP + 4 * (32 * ct + 8 * g4 + 4 * hh)) = (f32x4){a[4 * g4] + bias, a[4 * g4 + 1] + bias, a[4 * g4 + 2] + bias, a[4 * g4 + 3] + bias}; }
        asm volatile("" ::: "memory");
#pragma unroll
        for (int i = 0; i < 4; ++i) { const int tkn = tk8 + 8 * i, mm = m0 + 32 * tt + tkn;
            const v4u uw = *(const GAS v4u*)(PROJ + (size_t)mm * NPROJ_P + CB_U + 64 * g + 8 * part);
            const f32x4 x0 = *(const LAS f32x4*)(T + tkn * SG_OP + 32 * part), x1 = *(const LAS f32x4*)(T + tkn * SG_OP + 32 * part + 16);
            const float u[8] = {bflo(uw.x), bfhi(uw.x), bflo(uw.y), bfhi(uw.y), bflo(uw.z), bfhi(uw.z), bflo(uw.w), bfhi(uw.w)};
            *(GAS v4u*)(YC + (size_t)mm * DM + GW + 64 * g + 8 * part) = (v4u){pk2(gelu_tanh(u[0]) * x0.x, gelu_tanh(u[1]) * x0.y), pk2(gelu_tanh(u[2]) * x0.z, gelu_tanh(u[3]) * x0.w), pk2(gelu_tanh(u[4]) * x1.x, gelu_tanh(u[5]) * x1.y), pk2(gelu_tanh(u[6]) * x1.z, gelu_tanh(u[7]) * x1.w)}; }
        asm volatile("" ::: "memory");
    }
}

#ifndef SIMPLE_A
#define SIMPLE_A 0
#endif
#ifndef SIMPLE_B
#define SIMPLE_B 0
#endif
#ifndef SIMPLE_C
#define SIMPLE_C 0
#endif
#ifndef SIMPLE_D
#define SIMPLE_D 0
#endif
__device__ __forceinline__ void ph_mixers(LAS unsigned char* L, int l, int phase, int qoff, int wv, int mask = 31) {
    Frame F = mkframe(L, wv);
    volatile LAS int* qslot = (volatile LAS int*)(L + MISC_OFF + 64);
    gu32* ctr = ctlp() + CW_Q + 64 * phase + qoff;
    constexpr int I_IN = (DM / 64) * (NPROJ / 32), I_REST = (I8_OUT ? 0 : (DM / 64) * (DM / 32)) + (FFN1_I8 ? 0 : 2 * (DM / 64) * (DFF / 32)) + (DFF / 64) * (DM / 32);
    const int n_scan = (SIMPLE_D || !(mask & 1)) ? 0 : 128, n_c = (SIMPLE_C || !(mask & 2)) ? 0 : 512, n_a = (SIMPLE_A || !(mask & 4)) ? 0 : 256, n_b = (SIMPLE_B || !(mask & 8)) ? 0 : 128;
    const int n_cin = ((l + 1 < DEPTH) && (mask & 16)) ? (I8_IN ? NPROJ / 32 + (WINB_ITEMS + 7) / 8 : (I_IN + 7) / 8) : 0, n_crest = (mask & 16) ? (I_REST + 7) / 8 : 0, n_cout = ((I8_OUT && (mask & 16)) ? DM / 32 : 0) + ((FFN1_I8 && (mask & 16)) ? 2 * (DFF / 32) : 0);
    const int e_scan = n_scan, e_a = e_scan + n_a, e_b = e_a + n_b, e_c = e_b + n_c, e_cout = e_c + n_cout, e_cin = e_cout + n_cin, e_crest = e_cin + n_crest;
    for (;;) {
        if (F.tid == 0) *qslot = (int)__hip_atomic_fetch_add(ctr, 1u, RLX_AGENT);
        __syncthreads();
        const int it = __builtin_amdgcn_readfirstlane(*qslot);
        __syncthreads();
        if (it >= e_crest) break;
        int tid = wv * 64 + pg8::lane_now(); asm volatile("" : "+v"(tid));
        if (it < e_scan) scan_unit(L, it, tid);
        else if (it < e_a) dil_unit(L, it - e_scan, tid);
        else if (it < e_b) { sgu_unit(L, it - e_a, tid, l); __syncthreads(); }
        else if (it < e_c) { const int i2 = it - e_b; moba_unit(L, (i2 & 63) * 8 + (7 - (i2 >> 6)), tid, l); }
        else if (it < e_cout) { Frame F2 = mkframe(L, wv); int r = it - e_c;
            if (I8_OUT && r < DM / 32) conv_cols_i8(inp(19) + (size_t)l * DM * DM, DM, DM, inp(18) + l * DM, wsp() + WS_WOUT, (float*)(wsp() + WS_SMALL + SM_SWOUT), r, F2);
            else { r -= I8_OUT ? DM / 32 : 0; const int up = r >= DFF / 32 ? 1 : 0, nb = r - up * (DFF / 32), n0 = 32 * nb;
                conv_cols_i8(inp(up ? 22 : 21) + (size_t)l * DM * DFF, DM, DFF, inp(20) + l * DM, wsp() + WS_WGU, (float*)(wsp() + WS_SMALL + SM_SWGU), nb, F2, (n0 >> 7) * 256 + up * 128 + (n0 & 127)); } }
        else if (it < e_cin) { Frame F2 = mkframe(L, wv);
            if (I8_IN) { if (it - e_cout < NPROJ / 32) conv_cols_i8(inp(2) + (size_t)(l + 1) * DM * NPROJ, DM, NPROJ, inp(1) + (l + 1) * DM, wsp() + WS_WIN, (float*)(wsp() + WS_SMALL + SM_SWIN), it - e_cout, F2);
                else conv_winb(F2, l + 1, (it - e_cout - NPROJ / 32) * 8 + F2.wave); }
            else conv_layer_items(F2, l + 1, (it - e_cout) * 8 + F2.wave, 1 << 30, true, false); }
        else { Frame F2 = mkframe(L, wv); conv_layer_items(F2, l, (it - e_cin) * 8 + F2.wave, 1 << 30, false, true); }
    }
    if (!I8_IN && l + 1 < DEPTH) {
        bf16* WIN = (bf16*)(wsp() + WS_WIN);
        Frame F3 = mkframe(L, wv);
        for (int i = F3.gw * 64 + F3.lane; i < 64 * DM / 8; i += F3.ngw * 64) { v4u z = {0u, 0u, 0u, 0u}; asm volatile("" : "+v"(z)); *(GAS v4u*)(WIN + (size_t)NPROJ * DM + (size_t)i * 8) = z; }
    }
    if (SIMPLE_D) mix_d_simple(F);
    if (SIMPLE_A) mix_a_simple(F);
    if (SIMPLE_C) mix_c_simple(F, l);
    if (SIMPLE_B) mix_b_simple(F, l);
}

__device__ __forceinline__ void ph_finalize(Frame& F, int l) {
    bf16* YC = (bf16*)(wsp() + WS_YCAT); const float* YD = (const float*)(wsp() + WS_YD); const bf16* V_ = (const bf16*)outp() + (size_t)3 * M * GW; const bf16* G_ = (const bf16*)(wsp() + WS_G); const float* BC = (const float*)(wsp() + WS_BC);
    const float* lng = inp(16) + l * GW; const float* lnb = inp(17) + l * GW;
    for (int m = F.gw; m < M; m += F.ngw) {
        const int c0 = 8 * F.lane, hd = F.lane >> 3;
        float y[8];
        { const GAS f32x4* yp = (const GAS f32x4*)(YD + (size_t)m * GW + c0); const f32x4 a = yp[0], b = yp[1]; y[0] = a.x; y[1] = a.y; y[2] = a.z; y[3] = a.w; y[4] = b.x; y[5] = b.y; y[6] = b.z; y[7] = b.w; }
        float s = 0.f;
#pragma unroll
        for (int i = 0; i < 8; ++i) s += y[i];
        s += __shfl_xor(s, 1); s += __shfl_xor(s, 2); s += __shfl_xor(s, 4); const float mean = s * (1.0f / 64.0f); float q = 0.f;
#pragma unroll
        for (int i = 0; i < 8; ++i) { const float d = y[i] - mean; q += d * d; }
        q += __shfl_xor(q, 1); q += __shfl_xor(q, 2); q += __shfl_xor(q, 4); const float rstd = 1.0f / sqrtf(q * (1.0f / 64.0f) + 64e-5f);
        const v4u vw = *(const GAS v4u*)(V_ + (size_t)m * GW + c0), gw4 = *(const GAS v4u*)(G_ + (size_t)m * GW + c0); const float bc = BC[(size_t)m * NH + hd];
        float vv[8], gg[8]; UNPACK8(vv, 0, vw); UNPACK8(gg, 0, gw4);
        float ss = 0.f;
#pragma unroll
        for (int i = 0; i < 8; ++i) { y[i] = ((y[i] - mean) * rstd * lng[c0 + i] + lnb[c0 + i] + bc * vv[i]) * gg[i]; ss += y[i] * y[i]; }
        if (I8_OUT) {
            float xn[3][8], mx = 0.f;
            { const float rs = 1.0f / sqrtf(wave_sum(ss) * (1.0f / 512.0f) + NORM_EPS);
#pragma unroll
              for (int i = 0; i < 8; ++i) { y[i] *= rs; mx = fmaxf(mx, fabsf(y[i])); } }
#pragma unroll
            for (int br = 0; br < 3; ++br) {
                const v4u w = *(const GAS v4u*)(YC + (size_t)m * DM + br * GW + c0); UNPACK8(xn[br], 0, w); float s2 = 0.f;
#pragma unroll
                for (int i = 0; i < 8; ++i) s2 += xn[br][i] * xn[br][i];
                const float rs = 1.0f / sqrtf(wave_sum(s2) * (1.0f / 512.0f) + NORM_EPS);
#pragma unroll
                for (int i = 0; i < 8; ++i) { xn[br][i] *= rs; mx = fmaxf(mx, fabsf(xn[br][i])); }
            }
            mx = wave_max(mx); const float inv = mx > 0.f ? 127.0f / mx : 0.f; unsigned char* yq = wsp() + WS_YQ + (size_t)m * DM + c0;
#pragma unroll
            for (int br = 0; br < 3; ++br) *(GAS v2u*)(yq + br * GW) = (v2u){q8pack4(xn[br][0], xn[br][1], xn[br][2], xn[br][3], inv), q8pack4(xn[br][4], xn[br][5], xn[br][6], xn[br][7], inv)};
            *(GAS v2u*)(yq + 3 * GW) = (v2u){q8pack4(y[0], y[1], y[2], y[3], inv), q8pack4(y[4], y[5], y[6], y[7], inv)};
            if (F.lane == 0) ((float*)(wsp() + WS_SMALL + SM_SAY))[m] = mx * (1.0f / 127.0f);
            continue;
        }
        { const float rs = 1.0f / sqrtf(wave_sum(ss) * (1.0f / 512.0f) + NORM_EPS);
          *(GAS v4u*)(YC + (size_t)m * DM + 3 * GW + c0) = (v4u){pk2(y[0] * rs, y[1] * rs), pk2(y[2] * rs, y[3] * rs), pk2(y[4] * rs, y[5] * rs), pk2(y[6] * rs, y[7] * rs)}; }
#pragma unroll
        for (int br = 0; br < 3; ++br) {
            GAS v4u* p = (GAS v4u*)(YC + (size_t)m * DM + br * GW + c0); const v4u w = *p;
            float x[8]; UNPACK8(x, 0, w); float s2 = 0.f;
#pragma unroll
            for (int i = 0; i < 8; ++i) s2 += x[i] * x[i];
            const float rs = 1.0f / sqrtf(wave_sum(s2) * (1.0f / 512.0f) + NORM_EPS);
            *p = (v4u){pk2(x[0] * rs, x[1] * rs), pk2(x[2] * rs, x[3] * rs), pk2(x[4] * rs, x[5] * rs), pk2(x[6] * rs, x[7] * rs)};
        }
    }
}
__device__ __forceinline__ void ph_final(Frame& F) {
    const pg8::fx_t* ssq = (const pg8::fx_t*)(ctlp() + CW_SSQ) + 4 * M; const float* g = inp(24); float* out = outp(); const bf16* XB = (const bf16*)(wsp() + WS_XB);
    for (int m = F.gw; m < M; m += F.ngw) {
        const float rs = 1.0f / sqrtf(pg8::fx_get(ssq + m) * (1.0f / 2048.0f) + NORM_EPS); GAS f32x4* orow = (GAS f32x4*)(out + (size_t)m * DM); const GAS v4u* xr = (const GAS v4u*)(XB + (size_t)m * DM) + F.lane; const GAS f32x4* gp = (const GAS f32x4*)g;
#pragma unroll
        for (int j = 0; j < 4; ++j) { const v4u w = xr[64 * j]; const int c4 = 2 * (F.lane + 64 * j); const f32x4 g0 = gp[c4], g1 = gp[c4 + 1];
            orow[c4] = (f32x4){bflo(w.x) * rs * g0.x, bfhi(w.x) * rs * g0.y, bflo(w.y) * rs * g0.z, bfhi(w.y) * rs * g0.w};
            orow[c4 + 1] = (f32x4){bflo(w.z) * rs * g1.x, bfhi(w.z) * rs * g1.y, bflo(w.w) * rs * g1.z, bfhi(w.w) * rs * g1.w}; }
    }
}

#ifndef STAG
#define STAG 500
#endif
__device__ __forceinline__ void phase_stagger(int ticks) {
    const int grp = ((int)blockIdx.x >> 3) & 3;
    if (ticks > 0 && grp > 0) { const unsigned long long t0 = __builtin_amdgcn_s_memrealtime(); while ((long long)(__builtin_amdgcn_s_memrealtime() - t0) < (long long)grp * ticks) __builtin_amdgcn_s_sleep(32); }
}
__global__ void __launch_bounds__(NTHR, 2) hy_fwd(Args args) {
    extern __shared__ __attribute__((aligned(16))) unsigned char lds[];
    LAS unsigned char* L = (LAS unsigned char*)lds;
    volatile LAS unsigned* MISC = (volatile LAS unsigned*)(L + MISC_OFF);
    const int wv = __builtin_amdgcn_readfirstlane((int)threadIdx.x >> 6);
    if (wv == 0) MISC[pg8::lane_now()] = 0u;
    __syncthreads();
    XcdBarrier bar; bar.bar = (unsigned*)(ctlp() + CW_BAR); bar.x = 0; bar.st = nullptr; bar.wv = wv;
    if (N_LAUNCH_MODE == 0) bar = xcd_barrier_post((unsigned*)(ctlp() + CW_BAR), MISC + 8, wv);
    const int lo = args.ph_lo, hi = args.ph_hi;
#define IN(k) (lo <= (k) && (k) < hi)
#define SEAM(k) do { if (IN(k) && IN((k) + 1)) xcd_barrier(bar); } while (0)
    if (IN(0)) { Frame F = mkframe(L, wv); ph_prologue(F); if (REPEAT == 1) ph_prologue(F); }
    SEAM(0);
    auto layer = [&](const int l) __attribute__((always_inline)) {
        const int P = 1 + 9 * l;
        if (IN(P)) { phase_stagger(STAG);
            unsigned char* ws = wsp(); pg8::Gemm g{(const bf16*)(ws + WS_XB), (const bf16*)(ws + WS_WIN), M, NPROJ_P, DM, wv}; pg8::StaticOrder S; S.init(M, NPROJ_P, gridDim.x, (int)blockIdx.x);
            pg8::EpiProj E{(bf16*)(ws + WS_PROJ), NPROJ_P, (const pg8::fx_t*)((gu32*)ws + CW_SSQ) + (size_t)(2 * l) * M, (float*)(ws + CTL_KBAR) + (size_t)l * 64 * 8 * 64, (pg8::fx_t*)(ws + CTL_STATS) + (size_t)l * M * 2,
                           (const float*)(ws + WS_SMALL + SM_SAX), (const float*)(ws + WS_SMALL + SM_SWIN)};
            if (I8_IN) { g.A = (const bf16*)(ws + WS_XQ); pg8::MaskOrder S1; S1.init(M, 0xFFFFFFu & ~BFMASK, gridDim.x, (int)blockIdx.x);
                pg8::gemm_phase<pg8::EpiProj, pg8::MaskOrder, true, PG8_SP2, 1>(L + RING_OFF, g, S1, E);
                if (BFMASK) { pg8::Gemm gb{(const bf16*)(ws + WS_XB), winb_ptr(), M, NPROJ_P, DM, wv}; pg8::MaskOrder S2; S2.init(M, BFMASK, gridDim.x, (int)blockIdx.x);
                    pg8::gemm_phase<pg8::EpiProj, pg8::MaskOrder, true, PG8_SP2>(L + RING_OFF, gb, S2, E); } }
            else pg8::gemm_phase<pg8::EpiProj, pg8::StaticOrder, true, PG8_SP2>(L + RING_OFF, g, S, E);
            if (REPEAT == 2) { pg8::EpiProj E2 = E; E2.kbar = (float*)(ws + WS_YCAT); E2.stats = (pg8::fx_t*)(ws + WS_YCAT + 8 * MiB);
                if (I8_IN) { pg8::MaskOrder S1; S1.init(M, 0xFFFFFFu & ~BFMASK, gridDim.x, (int)blockIdx.x); pg8::gemm_phase<pg8::EpiProj, pg8::MaskOrder, true, PG8_SP2, 1>(L + RING_OFF, g, S1, E2);
                    if (BFMASK) { pg8::Gemm gb{(const bf16*)(ws + WS_XB), winb_ptr(), M, NPROJ_P, DM, wv}; pg8::MaskOrder S2; S2.init(M, BFMASK, gridDim.x, (int)blockIdx.x); pg8::gemm_phase<pg8::EpiProj, pg8::MaskOrder, true, PG8_SP2>(L + RING_OFF, gb, S2, E2); } }
                else pg8::gemm_phase<pg8::EpiProj, pg8::StaticOrder, true, PG8_SP2>(L + RING_OFF, g, S, E2); }
        }
        SEAM(P);
        if (IN(P + 1)) { Frame F = mkframe(L, wv); ph_prep(F, l); if (REPEAT == 3) ph_prep(F, l); }
        SEAM(P + 1);
        if (IN(P + 2)) { ph_mixers(L, l, P + 2, 0, wv); if (REPEAT == 4) ph_mixers(L, l, P + 2, 32, wv); if (REPEAT >= 40 && REPEAT < 50) ph_mixers(L, l, P + 2, 32, wv, REPEAT == 41 ? 1 : (REPEAT == 42 ? 2 : (REPEAT == 43 ? 4 : (REPEAT == 44 ? 8 : 16)))); if (REPEAT >= 430 && REPEAT < 446) ph_mixers(L, l, P + 2, 32, wv, 4); }
        SEAM(P + 2);
        if (IN(P + 3)) { Frame F = mkframe(L, wv); ph_finalize(F, l); if (REPEAT == 5) ph_finalize(F, l); }
        SEAM(P + 3);
        if (IN(P + 4)) { phase_stagger(STAG);
            unsigned char* ws = wsp(); pg8::Gemm g{(const bf16*)(ws + WS_YCAT), (const bf16*)(ws + WS_WOUT), M, DM, DM, wv}; pg8::StaticOrder S; S.init(M, DM, gridDim.x, (int)blockIdx.x);
            pg8::EpiRes E{(bf16*)(ws + WS_XB), (pg8::fx_t*)((gu32*)ws + CW_SSQ) + (size_t)(2 * l + 1) * M, DM, (FFN_FP8 && !FFN1_I8) ? (unsigned char*)(ws + WS_SC2) : nullptr, 1.0f, (const float*)(ws + WS_SMALL + SM_SAY), (const float*)(ws + WS_SMALL + SM_SWOUT)};
            if (I8_OUT) { g.A = (const bf16*)(ws + WS_YQ); pg8::gemm_phase<pg8::EpiRes, pg8::StaticOrder, true, PG8_SP2, 1>(L + RING_OFF, g, S, E); }
            else pg8::gemm_phase<pg8::EpiRes, pg8::StaticOrder, true, PG8_SP2>(L + RING_OFF, g, S, E);
            if (REPEAT == 7) { pg8::EpiRes E2 = E; E2.xb = (bf16*)(ws + WS_YCAT); E2.ssq = (pg8::fx_t*)(ws + WS_G); E2.xf = (unsigned char*)(ws + WS_YD);
                if (I8_OUT) pg8::gemm_phase<pg8::EpiRes, pg8::StaticOrder, true, PG8_SP2, 1>(L + RING_OFF, g, S, E2); else pg8::gemm_phase<pg8::EpiRes, pg8::StaticOrder, true, PG8_SP2>(L + RING_OFF, g, S, E2); }
        }
        SEAM(P + 4);
        if (FFN1_I8) { if (IN(P + 5)) { Frame F = mkframe(L, wv); ph_quantx(F); } SEAM(P + 5); }
        if (IN(P + 6)) {
            unsigned char* ws = wsp(); pg8::Gemm g{(const bf16*)(ws + (FFN1_I8 ? WS_XQ : (FFN_FP8 ? WS_SC2 : WS_XB))), (const bf16*)(ws + WS_WGU), M, 2 * DFF, DM, wv}; pg8::StaticOrder S; S.init(M, 2 * DFF, gridDim.x, (int)blockIdx.x);
            if (FFN_FP8) { pg8::EpiGU8 E{(unsigned char*)(ws + WS_PROJ), DFF, (const pg8::fx_t*)((gu32*)ws + CW_SSQ) + (size_t)(2 * l + 1) * M, FFN1_I8 ? 1.0f : 1.0f / 64.0f, 8.0f, (const float*)(ws + WS_SMALL + SM_SAX), (const float*)(ws + WS_SMALL + SM_SWGU)};
                if (FFN1_I8) pg8::gemm_phase<pg8::EpiGU8, pg8::StaticOrder, true, PG8_SP2, 1>(L + RING_OFF, g, S, E);
                else pg8::gemm_phase_f8<pg8::EpiGU8, pg8::StaticOrder, true, PG8_SP2>(L + RING_OFF, g, S, E);
                if (REPEAT == 6) { if (FFN1_I8) pg8::gemm_phase<pg8::EpiGU8, pg8::StaticOrder, true, PG8_SP2, 1>(L + RING_OFF, g, S, E); else pg8::gemm_phase_f8<pg8::EpiGU8, pg8::StaticOrder, true, PG8_SP2>(L + RING_OFF, g, S, E); }
            } else { pg8::EpiGU E{(bf16*)(ws + WS_PROJ), DFF, (const pg8::fx_t*)((gu32*)ws + CW_SSQ) + (size_t)(2 * l + 1) * M, 1.0f};
                pg8::gemm_phase<pg8::EpiGU, pg8::StaticOrder, true, PG8_SP2>(L + RING_OFF, g, S, E);
                if (REPEAT == 6) pg8::gemm_phase<pg8::EpiGU, pg8::StaticOrder, true, PG8_SP2>(L + RING_OFF, g, S, E); }
        }
        SEAM(P + 6);
        if (IN(P + 7)) { phase_stagger(STAG);
            unsigned char* ws = wsp(); pg8::Gemm g{(const bf16*)(ws + WS_PROJ), (const bf16*)(ws + WS_WDN), M, DM, DFF, wv}; pg8::StaticOrder S; S.init(M, DM, gridDim.x, (int)blockIdx.x);
            pg8::EpiRes E{(bf16*)(ws + WS_XB), (pg8::fx_t*)((gu32*)ws + CW_SSQ) + (size_t)(2 * l + 2) * M, DM, nullptr, FFN_FP8 ? 1.0f / 512.0f : 1.0f, nullptr, nullptr};
            if (FFN_FP8) pg8::gemm_phase_f8<pg8::EpiRes, pg8::StaticOrder, true, PG8_SP2>(L + RING_OFF, g, S, E);
            else pg8::gemm_phase<pg8::EpiRes, pg8::StaticOrder, true, PG8_SP2>(L + RING_OFF, g, S, E);
            if (REPEAT == 8) { pg8::EpiRes E2 = E; E2.xb = (bf16*)(ws + WS_YCAT); E2.ssq = (pg8::fx_t*)(ws + WS_G);
                if (FFN_FP8) pg8::gemm_phase_f8<pg8::EpiRes, pg8::StaticOrder, true, PG8_SP2>(L + RING_OFF, g, S, E2); else pg8::gemm_phase<pg8::EpiRes, pg8::StaticOrder, true, PG8_SP2>(L + RING_OFF, g, S, E2); }
        }
        SEAM(P + 7);
        if (l + 1 < DEPTH) { if (I8_IN && IN(P + 8)) { Frame F = mkframe(L, wv); ph_quantx(F); } if (I8_IN) SEAM(P + 8); }
    };
    static_assert(DEPTH == 2, "layers are expanded by hand");
    layer(0); layer(1);
    if (IN(19)) { Frame F = mkframe(L, wv); ph_final(F); }
#undef IN
#undef SEAM
}

extern "C" void kernel_launch(void* const* d_in, const int* in_sizes, int n_in, void* d_out, int out_size, void* d_ws, size_t ws_size, hipStream_t stream) {
    static int grid = 0;
    if (grid == 0) {
        if (n_in != 25 || in_sizes[0] != M * DM || out_size != M * DM || ws_size < WS_END) { fprintf(stderr, "kernel_launch: shape/workspace mismatch: n_in %d in0 %d out %d ws %zu (need %zu)\n", n_in, n_in > 0 ? in_sizes[0] : -1, out_size, ws_size, (size_t)WS_END); grid = -1; return; }
        int dev = 0, cus = 0, per_cu = 0;
        if (hipGetDevice(&dev) != hipSuccess || hipDeviceGetAttribute(&cus, hipDeviceAttributeMultiprocessorCount, dev) != hipSuccess) { grid = -1; return; }
        if (hipFuncSetAttribute((const void*)hy_fwd, hipFuncAttributeMaxDynamicSharedMemorySize, LDS_BYTES) != hipSuccess) { fprintf(stderr, "kernel_launch: hipFuncSetAttribute failed\n"); grid = -1; return; }
        if (hipOccupancyMaxActiveBlocksPerMultiprocessor(&per_cu, (const void*)hy_fwd, NTHR, LDS_BYTES) != hipSuccess || per_cu < 1) fprintf(stderr, "kernel_launch: occupancy query reports %d\n", per_cu);
        (void)hipGetLastError();
        grid = cus;
    }
    if (grid < 0) return;
    if (hipMemsetAsync((char*)d_ws + WS_CTL, 0, CTL_ZERO_BYTES, stream) != hipSuccess) return;
    Args a{};
    for (int i = 0; i < 25; ++i) a.in[i] = (const float*)d_in[i];
    a.out = (float*)d_out; a.ws = (unsigned char*)d_ws;
    if (N_LAUNCH_MODE == 0) { a.ph_lo = 0; a.ph_hi = N_PHASES; hipLaunchKernelGGL(hy_fwd, dim3(grid), dim3(NTHR), LDS_BYTES, stream, a); }
    else for (int p = 0; p < N_PHASES; ++p) { a.ph_lo = p; a.ph_hi = p + 1; hipLaunchKernelGGL(hy_fwd, dim3(grid), dim3(NTHR), LDS_BYTES, stream, a); }
}
```

```cpp
#define N_LAUNCH_MODE 0
#define REPEAT 0
#define PG8_SP2 true
#define FFN_FP8 1
#define GEMM_I8 3
#define STAG 0
#define FFN1_I8 1
#define BFMASK 0x0u
#include <hip/hip_runtime.h>
#include <cstdio>
#include <cstdint>
namespace pg8 {
#define PG8_LAS __attribute__((address_space(3)))
typedef unsigned short bf16_t;
typedef short bf16x8 __attribute__((ext_vector_type(8)));
typedef float f32x4 __attribute__((ext_vector_type(4)));
typedef unsigned u32x4 __attribute__((ext_vector_type(4)));
constexpr int BM = 256, BK = 64, HALF = 128, HTB = HALF * BK * 2  , STAGE_BYTES = 8 * HTB, NXCD = 8, WGM = 8;

__host__ __device__ __forceinline__ int lds_byte(int r, int c) { const int st = (r >> 4) * 2 + (c >> 5), rr = r & 15, cc = c & 31, ob = rr * 64 + cc * 2; return st * 1024 + (ob ^ (((ob >> 9) & 1) << 5)); }
__host__ __device__ __forceinline__ void stage_rc(int b, int& R, int& C) { const int st = b / 1024, sb = b % 1024, swz = sb ^ (((sb >> 9) & 1) << 5); R = (st >> 1) * 16 + swz / 64; C = (st & 1) * 32 + (swz % 64) / 2; }
__host__ __device__ __forceinline__ int perm32(int rho) { const int n = rho >> 4, i = rho & 15; return 8 * (i >> 2) + 4 * n + (i & 3); }

__device__ __forceinline__ int lane_now() { int l; asm volatile("v_mbcnt_lo_u32_b32 %0, -1, 0\n\tv_mbcnt_hi_u32_b32 %0, -1, %0" : "=v"(l)); return l; }
struct Unit { int pm, pn; };
struct Gemm { const bf16_t* A; const bf16_t* Bt; int M, N, K, wv; };

struct StaticOrder {
    int nM, nN, nwg, G, c;
    __host__ __device__ void init(int M, int N, int G_, int c_) { nM = M / BM; nN = N / BM; nwg = nM * nN; G = G_; c = c_; }
    __host__ __device__ bool next(int i, Unit& u) const {
        const long L = (long)i * G + c; if (L >= nwg) return false;
        int wgid = (int)L; { const int q = nwg / NXCD, r = nwg % NXCD, xcd = wgid % NXCD, off = wgid / NXCD; wgid = (xcd < r ? xcd * (q + 1) : r * (q + 1) + (xcd - r) * q) + off; }
        const int nig = WGM * nN, gid = wgid / nig, fm = gid * WGM, gsz = (nM - fm) < WGM ? (nM - fm) : WGM;
        u.pm = fm + ((wgid % nig) % gsz); u.pn = (wgid % nig) / gsz; return true;
    }
    __device__ __forceinline__ void a_ready(const Unit&) const {}
    __device__ __forceinline__ void done(const Unit&) const {}
};

struct MapOrder {
    StaticOrder s; int from, add;
    __device__ __forceinline__ bool next(int i, Unit& u) const { if (!s.next(i, u)) return false; if (u.pn >= from) u.pn += add; return true; }
    __device__ __forceinline__ void a_ready(const Unit&) const {}
    __device__ __forceinline__ void done(const Unit&) const {}
};

struct MaskOrder {
    StaticOrder s; unsigned mask;
    __device__ __forceinline__ void init(int M, unsigned mask_, int G_, int c_) { mask = mask_; s.init(M, BM * __builtin_popcount(mask_), G_, c_); }
    __device__ __forceinline__ bool next(int i, Unit& u) const { if (!s.next(i, u)) return false; unsigned m = mask; for (int j = 0; j < u.pn; ++j) m &= m - 1; u.pn = __builtin_ctz(m); return true; }
    __device__ __forceinline__ void a_ready(const Unit&) const {}
    __device__ __forceinline__ void done(const Unit&) const {}
};

__device__ __forceinline__ unsigned cvt_pk_bf16(float lo, float hi) { unsigned r; asm volatile("v_cvt_pk_bf16_f32 %0, %1, %2" : "=v"(r) : "v"(lo), "v"(hi)); return r; }
typedef float f32x2 __attribute__((ext_vector_type(2)));

typedef unsigned u32x2 __attribute__((ext_vector_type(2)));
typedef unsigned long long fx_t;
__device__ __forceinline__ void fx_add(fx_t* p, float v) { atomicAdd(p, (fx_t)(long long)__float2ll_rn(v * 1073741824.0f)); }
__device__ __forceinline__ float fx_get(const fx_t* p) { return (float)(long long)(*p) * (1.0f / 1073741824.0f); }
__device__ __forceinline__ float epi_gelu(float x) { const float u = 0.7978845608028654f * (x + 0.044715f * x * x * x); const float e2 = __expf(2.0f * u); return 0.5f * x * (2.0f - 2.0f / (e2 + 1.0f)); }
template <int CTRL> __device__ __forceinline__ float epi_dpp_add(float x) { const int y = __builtin_amdgcn_update_dpp(0, __builtin_bit_cast(int, x), CTRL, 0xF, 0xF, false); return x + __builtin_bit_cast(float, y); }
typedef int i32x4_t __attribute__((ext_vector_type(4)));
__device__ __forceinline__ f32x4 acc_f(const f32x4& v) { return v; }
__device__ __forceinline__ f32x4 acc_f(const i32x4_t& v) { return __builtin_convertvector(v, f32x4); }
template <class T> struct AccIsInt { static constexpr bool v = false; };
template <> struct AccIsInt<i32x4_t> { static constexpr bool v = true; };
__device__ __forceinline__ void epi_prefetch(const fx_t* ssq_rows, const float* sa_rows, const float* sw_cols, PG8_LAS unsigned char* slot, int wid) {
    const int ln = lane_now();
    __builtin_amdgcn_global_load_lds((const __attribute__((address_space(1))) unsigned*)((const unsigned*)ssq_rows + wid * 64 + ln), (PG8_LAS unsigned*)(slot + wid * 256), 4, 0, 0);
    if (sa_rows) { const float* src = wid < 4 ? sa_rows + wid * 64 : sw_cols + (wid - 4) * 64;
        __builtin_amdgcn_global_load_lds((const __attribute__((address_space(1))) unsigned*)((const unsigned*)src + ln), (PG8_LAS unsigned*)(slot + 2048 + wid * 256), 4, 0, 0); }
}
__device__ __forceinline__ float fx_getl(const PG8_LAS unsigned char* slot, int rloc) { return (float)(long long)(*(const PG8_LAS fx_t*)(slot + 8 * rloc)) * (1.0f / 1073741824.0f); }
struct EpiProj {
    static constexpr bool PERM = true, AFTER_DRAIN = false, PREFETCH = true;
    bf16_t* O; int ldc; const fx_t* ssq; float* kbar; fx_t* stats; const float* sa; const float* sw;
    __device__ __forceinline__ void prefetch(const Unit& u, PG8_LAS unsigned char* slot, int wid) const { epi_prefetch(ssq + u.pm * BM, sa ? sa + u.pm * BM : nullptr, sw + u.pn * BM, slot, wid); }
    template <class AccT> __device__ __forceinline__ void operator()(const AccT (&acc)[2][2][4][2], const Unit& u, int wr, int wc, int fr, int fq, const PG8_LAS unsigned char* slot) const {
        constexpr bool Q = AccIsInt<AccT>::v;
        const int row0 = u.pm * BM + wr * 64 + fr, col0 = u.pn * BM + wc * 32 + 8 * fq;
        f32x4 cw[2][2];
        if constexpr (Q) {
#pragma unroll
            for (int bj = 0; bj < 2; ++bj) { const PG8_LAS float* p = (const PG8_LAS float*)(slot + 3072) + bj * HALF + wc * 32 + 8 * fq; cw[bj][0] = *(const PG8_LAS f32x4*)p; cw[bj][1] = *(const PG8_LAS f32x4*)(p + 4); } }
        const bool do_k = (u.pn == 12 || u.pn == 13), do_s = (u.pn == 8 || u.pn == 9);
        float cs[2][8];
#pragma unroll
        for (int bj = 0; bj < 2; ++bj)
#pragma unroll
            for (int e = 0; e < 8; ++e) cs[bj][e] = 0.f;
#pragma unroll
        for (int ai = 0; ai < 2; ++ai)
#pragma unroll
            for (int m = 0; m < 4; ++m) { const int row = row0 + ai * HALF + m * 16; const int rloc = ai * HALF + wr * 64 + m * 16 + fr; float rs = __builtin_amdgcn_rsqf(fx_getl(slot, rloc) * (1.0f / 2048.0f) + 1e-6f); if constexpr (Q) rs *= *(const PG8_LAS float*)(slot + 2048 + 4 * rloc);
                bf16_t* rowp = O + (size_t)row * ldc + col0; float s1 = 0.f, s2 = 0.f;
#pragma unroll
                for (int bj = 0; bj < 2; ++bj) { f32x4 v0 = acc_f(acc[ai][bj][m][0]) * rs, v1 = acc_f(acc[ai][bj][m][1]) * rs; if constexpr (Q) { v0 *= cw[bj][0]; v1 *= cw[bj][1]; }
                    u32x4 w; w.x = cvt_pk_bf16(v0[0], v0[1]); w.y = cvt_pk_bf16(v0[2], v0[3]); w.z = cvt_pk_bf16(v1[0], v1[1]); w.w = cvt_pk_bf16(v1[2], v1[3]);
                    *(u32x4*)(rowp + bj * HALF) = w;
                    if (do_k) {
#pragma unroll
                        for (int e = 0; e < 4; ++e) { cs[bj][e] += v0[e]; cs[bj][4 + e] += v1[e]; } }
                    if (do_s) {
#pragma unroll
                        for (int e = 0; e < 4; ++e) { const float g0 = epi_gelu(v0[e]), g1 = epi_gelu(v1[e]); s1 += g0 + g1; s2 += g0 * g0 + g1 * g1; } } }
                if (do_s) { s1 += __shfl_xor(s1, 16); s1 += __shfl_xor(s1, 32); s2 += __shfl_xor(s2, 16); s2 += __shfl_xor(s2, 32);
                    if (fq == 0) { fx_add(stats + 2 * row, s1); fx_add(stats + 2 * row + 1, s2); } } }
        if (do_k) {
            const int bidx = (u.pm >> 3) * 8, n = u.pm & 7;
#pragma unroll
            for (int bj = 0; bj < 2; ++bj)
#pragma unroll
                for (int e = 0; e < 8; ++e) { float s = cs[bj][e]; s = epi_dpp_add<0xB1>(s); s = epi_dpp_add<0x4E>(s); s = epi_dpp_add<0x141>(s); s = epi_dpp_add<0x140>(s);
                    const int ck = col0 + bj * HALF + e - 3072;
                    if (fr == 0) unsafeAtomicAdd(kbar + ((bidx + (ck >> 6)) * 8 + n) * 64 + (ck & 63), s * (1.0f / 256.0f)); } }
    }
};
struct EpiGU {
    static constexpr bool PERM = true, AFTER_DRAIN = false, PREFETCH = false;
    bf16_t* O; int ldc; const fx_t* ssq; float oscale;
    __device__ __forceinline__ void operator()(const f32x4 (&acc)[2][2][4][2], const Unit& u, int wr, int wc, int fr, int fq, const PG8_LAS unsigned char* slot) const {
        const int row0 = u.pm * BM + wr * 64 + fr, col0 = u.pn * HALF + wc * 32 + 8 * fq;
#pragma unroll
        for (int ai = 0; ai < 2; ++ai)
#pragma unroll
            for (int m = 0; m < 4; ++m) { const int row = row0 + ai * HALF + m * 16; const float rs = __builtin_amdgcn_rsqf(fx_get(ssq + row) * (1.0f / 2048.0f) + 1e-6f) * oscale;
                float o[8];
#pragma unroll
                for (int n = 0; n < 2; ++n)
#pragma unroll
                    for (int e = 0; e < 4; ++e) { const float g = acc[ai][0][m][n][e] * rs, up = acc[ai][1][m][n][e] * rs;
                        o[n * 4 + e] = g * __builtin_amdgcn_rcpf(1.0f + __builtin_amdgcn_exp2f(-1.4426950408889634f * g)) * up; }
                u32x4 w; w.x = cvt_pk_bf16(o[0], o[1]); w.y = cvt_pk_bf16(o[2], o[3]); w.z = cvt_pk_bf16(o[4], o[5]); w.w = cvt_pk_bf16(o[6], o[7]);
                *(u32x4*)(O + (size_t)row * ldc + col0) = w; }
    }
};
__device__ __forceinline__ float epi_clamp8(float v) { return __builtin_amdgcn_fmed3f(v, -448.0f, 448.0f); }
struct EpiGU8 {
    static constexpr bool PERM = true, AFTER_DRAIN = false, PREFETCH = true;
    __device__ __forceinline__ void prefetch(const Unit& u, PG8_LAS unsigned char* slot, int wid) const { epi_prefetch(ssq + u.pm * BM, sa ? sa + u.pm * BM : nullptr, sw + u.pn * BM, slot, wid); }
    unsigned char* O; int ldc; const fx_t* ssq; float oscale, ascale; const float* sa; const float* sw;
    template <class AccT> __device__ __forceinline__ void operator()(const AccT (&acc)[2][2][4][2], const Unit& u, int wr, int wc, int fr, int fq, const PG8_LAS unsigned char* slot) const {
        constexpr bool Q = AccIsInt<AccT>::v;
        const int row0 = u.pm * BM + wr * 64 + fr, col0 = u.pn * HALF + wc * 32 + 8 * fq;
        f32x4 cw[2][2];
        if constexpr (Q) {
#pragma unroll
            for (int bj = 0; bj < 2; ++bj) { const PG8_LAS float* p = (const PG8_LAS float*)(slot + 3072) + bj * HALF + wc * 32 + 8 * fq; cw[bj][0] = *(const PG8_LAS f32x4*)p; cw[bj][1] = *(const PG8_LAS f32x4*)(p + 4); } }
#pragma unroll
        for (int ai = 0; ai < 2; ++ai)
#pragma unroll
            for (int m = 0; m < 4; ++m) { const int row = row0 + ai * HALF + m * 16; const int rloc = ai * HALF + wr * 64 + m * 16 + fr; float rs = __builtin_amdgcn_rsqf(fx_getl(slot, rloc) * (1.0f / 2048.0f) + 1e-6f) * oscale; if constexpr (Q) rs *= *(const PG8_LAS float*)(slot + 2048 + 4 * rloc);
                float o[8];
#pragma unroll
                for (int n = 0; n < 2; ++n) { f32x4 gv = acc_f(acc[ai][0][m][n]) * rs, uv = acc_f(acc[ai][1][m][n]) * rs; if constexpr (Q) { gv *= cw[0][n]; uv *= cw[1][n]; }
#pragma unroll
                    for (int e = 0; e < 4; ++e) { const float g = gv[e], up = uv[e];
                        o[n * 4 + e] = epi_clamp8(g * __builtin_amdgcn_rcpf(1.0f + __builtin_amdgcn_exp2f(-1.4426950408889634f * g)) * up * ascale); } }
                int f0 = __builtin_bit_cast(int, o[0]), f1 = __builtin_bit_cast(int, o[4]);
                f0 = __builtin_amdgcn_cvt_pk_fp8_f32(o[0], o[1], f0, false); f0 = __builtin_amdgcn_cvt_pk_fp8_f32(o[2], o[3], f0, true);
                f1 = __builtin_amdgcn_cvt_pk_fp8_f32(o[4], o[5], f1, false); f1 = __builtin_amdgcn_cvt_pk_fp8_f32(o[6], o[7], f1, true);
                *(u32x2*)(O + (size_t)row * ldc + col0) = (u32x2){(unsigned)f0, (unsigned)f1}; }
    }
};
struct EpiRes {
    static constexpr bool PERM = true, AFTER_DRAIN = false, PREFETCH = false;
    bf16_t* xb; fx_t* ssq; int ldc; unsigned char* xf; float oscale; const float* sa; const float* sw;
    template <class AccT> __device__ __forceinline__ void operator()(const AccT (&acc)[2][2][4][2], const Unit& u, int wr, int wc, int fr, int fq, const PG8_LAS unsigned char* slot) const {
        constexpr bool Q = AccIsInt<AccT>::v;
        const int row0 = u.pm * BM + wr * 64 + fr, col0 = u.pn * BM + wc * 32 + 8 * fq;
        f32x4 cw[2][2];
        if constexpr (Q) {
#pragma unroll
            for (int bj = 0; bj < 2; ++bj) { cw[bj][0] = *(const f32x4*)(sw + col0 + bj * HALF); cw[bj][1] = *(const f32x4*)(sw + col0 + bj * HALF + 4); } }
#pragma unroll
        for (int ai = 0; ai < 2; ++ai)
#pragma unroll
            for (int m = 0; m < 4; ++m) { const int row = row0 + ai * HALF + m * 16; bf16_t* rowp = xb + (size_t)row * ldc + col0; float s = 0.f; float osc = oscale; if constexpr (Q) osc = sa[row];
                u32x4 b[2];
#pragma unroll
                for (int bj = 0; bj < 2; ++bj) b[bj] = *(const u32x4*)(rowp + bj * HALF);
#pragma unroll
                for (int bj = 0; bj < 2; ++bj) { float o[8]; f32x4 a2[2] = {acc_f(acc[ai][bj][m][0]), acc_f(acc[ai][bj][m][1])}; if constexpr (Q) { a2[0] *= cw[bj][0]; a2[1] *= cw[bj][1]; }
#pragma unroll
                    for (int q = 0; q < 4; ++q) { o[2 * q] = __builtin_fmaf(a2[q >> 1][2 * (q & 1)], osc, __builtin_bit_cast(float, b[bj][q] << 16)); o[2 * q + 1] = __builtin_fmaf(a2[q >> 1][2 * (q & 1) + 1], osc, __builtin_bit_cast(float, b[bj][q] & 0xffff0000u)); }
                    u32x4 w; w.x = cvt_pk_bf16(o[0], o[1]); w.y = cvt_pk_bf16(o[2], o[3]); w.z = cvt_pk_bf16(o[4], o[5]); w.w = cvt_pk_bf16(o[6], o[7]);
                    *(u32x4*)(rowp + bj * HALF) = w;
                    if (xf) { int f0 = (int)b[bj][0], f1 = (int)b[bj][1]; f0 = __builtin_amdgcn_cvt_pk_fp8_f32(epi_clamp8(o[0]), epi_clamp8(o[1]), f0, false); f0 = __builtin_amdgcn_cvt_pk_fp8_f32(epi_clamp8(o[2]), epi_clamp8(o[3]), f0, true);
                        f1 = __builtin_amdgcn_cvt_pk_fp8_f32(epi_clamp8(o[4]), epi_clamp8(o[5]), f1, false); f1 = __builtin_amdgcn_cvt_pk_fp8_f32(epi_clamp8(o[6]), epi_clamp8(o[7]), f1, true);
                        *(u32x2*)(xf + (size_t)row * ldc + col0 + bj * HALF) = (u32x2){(unsigned)f0, (unsigned)f1}; }
#pragma unroll
                    for (int q = 0; q < 8; ++q) s += o[q] * o[q]; }
                s += __shfl_xor(s, 16); s += __shfl_xor(s, 32);
                if (fq == 0) fx_add(ssq + row, s); }
    }
};

struct EpiNull {
    static constexpr bool PERM = true, AFTER_DRAIN = false, PREFETCH = false;
    float* sink;
    template <class AccT> __device__ __forceinline__ void operator()(const AccT (&acc)[2][2][4][2], const Unit& u, int wr, int wc, int fr, int fq, const PG8_LAS unsigned char* slot) const {
        f32x4 s = {0.f, 0.f, 0.f, 0.f};
#pragma unroll
        for (int ai = 0; ai < 2; ++ai)
#pragma unroll
            for (int bj = 0; bj < 2; ++bj)
#pragma unroll
                for (int m = 0; m < 4; ++m)
#pragma unroll
                    for (int n = 0; n < 2; ++n) s += acc_f(acc[ai][bj][m][n]);
        if (s[0] + s[1] + s[2] + s[3] == 1.2345e30f) sink[0] = s[0];
    }
};

struct EpiProjDense {
    static constexpr bool PERM = true, AFTER_DRAIN = false, PREFETCH = false;
    bf16_t* O; const fx_t* ssq; const float* sa; const float* sw;
    template <class AccT> __device__ __forceinline__ void operator()(const AccT (&acc)[2][2][4][2], const Unit& u, int wr, int wc, int fr, int fq, const PG8_LAS unsigned char* slot) const {
        const int row0 = u.pm * BM + wr * 64 + fr, col0 = u.pn * BM + wc * 32 + 8 * fq;
        f32x4 cw[2][2];
#pragma unroll
        for (int bj = 0; bj < 2; ++bj) { cw[bj][0] = *(const f32x4*)(sw + col0 + bj * HALF); cw[bj][1] = *(const f32x4*)(sw + col0 + bj * HALF + 4); }
        bf16_t* base = O + ((size_t)(((u.pm * 24 + u.pn) & 255) * 8 + wr * 4 + wc) * 16) * 512 + (fq * 16 + fr) * 8;
#pragma unroll
        for (int ai = 0; ai < 2; ++ai)
#pragma unroll
            for (int m = 0; m < 4; ++m) { const int row = row0 + ai * HALF + m * 16; float rs = __builtin_amdgcn_rsqf(fx_get(ssq + row) * (1.0f / 2048.0f) + 1e-6f) * sa[row];
#pragma unroll
                for (int bj = 0; bj < 2; ++bj) { f32x4 v0 = acc_f(acc[ai][bj][m][0]) * rs * cw[bj][0], v1 = acc_f(acc[ai][bj][m][1]) * rs * cw[bj][1];
                    u32x4 w; w.x = cvt_pk_bf16(v0[0], v0[1]); w.y = cvt_pk_bf16(v0[2], v0[3]); w.z = cvt_pk_bf16(v1[0], v1[1]); w.w = cvt_pk_bf16(v1[2], v1[3]);
                    *(u32x4*)(base + ((ai * 4 + m) * 2 + bj) * 512) = w; } }
    }
};
typedef int i32x8_t __attribute__((ext_vector_type(8)));
constexpr int PG8_PRM_OFF = STAGE_BYTES + 1024;
__device__ __forceinline__ void mma16(f32x4& c, const bf16x8& a, const bf16x8& b) { c = __builtin_amdgcn_mfma_f32_16x16x32_bf16(a, b, c, 0, 0, 0); }
__device__ __forceinline__ void mma16(i32x4_t& c, const bf16x8& a, const bf16x8& b) { c = __builtin_amdgcn_mfma_i32_16x16x64_i8(__builtin_bit_cast(i32x4_t, a), __builtin_bit_cast(i32x4_t, b), c, 0, 0, 0); }
template <int EB> struct AccOf { typedef f32x4 type; };
template <> struct AccOf<1> { typedef i32x4_t type; };
template <class Epi, class Sched, bool ALIGN_EPI = false, bool SP2 = false, int EB = 2>
__device__ __forceinline__ void gemm_phase(PG8_LAS unsigned char* lds, const Gemm g, const Sched& S, const Epi& E) {
    int tid_ = g.wv * 64 + lane_now(); asm volatile("" : "+v"(tid_));
    const int tid = tid_, wid = __builtin_amdgcn_readfirstlane(tid >> 6), lane = tid & 63, wr = wid >> 2, wc = wid & 3, fr = lane & 15, fq = lane >> 4;
    const int K = g.K, nt = K * EB / (2 * BK);
    unsigned voffA[2], voffB[2];
#pragma unroll
    for (int i = 0; i < 2; ++i) { int R, C; stage_rc(tid * 16 + i * 8192, R, C); const int Rb = Epi::PERM ? ((R & ~31) + perm32(R & 31)) : R;
        voffA[i] = (unsigned)(R * K * EB + 2 * C); voffB[i] = (unsigned)(Rb * K * EB + 2 * C); }
    const unsigned kstep = (unsigned)(BK * 2);
    const unsigned hstep = (unsigned)HALF * K * EB;
    const unsigned tstep = 2 * hstep;
    const unsigned ldsw = (unsigned)wid * 1024u;
    const int aoff = lds_byte(wr * 64 + fr, fq * 8), boff = lds_byte(wc * 32 + fr, fq * 8);
#define PG8_SA(b, h) (((b) * 2 + (h)) * HTB)
#define PG8_SB(b, h) ((4 + (b) * 2 + (h)) * HTB)
#define PG8_STAGE(bufoff, rsrc, soff, voff) do { _Pragma("unroll") for (int _i = 0; _i < 2; ++_i) \
        __builtin_amdgcn_raw_ptr_buffer_load_lds(rsrc, (PG8_LAS void*)(lds + (bufoff) + ldsw + _i * 8192), 16, (int)(voff)[_i], (int)(soff), 0, 0); } while (0)
#define PG8_LDA(dst, b, h) do { _Pragma("unroll") for (int m = 0; m < 4; ++m) _Pragma("unroll") for (int k = 0; k < 2; ++k) dst[m][k] = *(const PG8_LAS bf16x8*)(lds + PG8_SA(b, h) + aoff + m * 2048 + k * 1024); } while (0)
#define PG8_LDB(dst, b, h) do { _Pragma("unroll") for (int n = 0; n < 2; ++n) _Pragma("unroll") for (int k = 0; k < 2; ++k) dst[n][k] = *(const PG8_LAS bf16x8*)(lds + PG8_SB(b, h) + boff + n * 2048 + k * 1024); } while (0)
#define PG8_MMA(ai, bj, At, Bt) do { __builtin_amdgcn_s_setprio(1); _Pragma("unroll") for (int m = 0; m < 4; ++m) _Pragma("unroll") for (int n = 0; n < 2; ++n) _Pragma("unroll") for (int k = 0; k < 2; ++k) \
        mma16(acc[ai][bj][m][n], Bt[n][k], At[m][k]); __builtin_amdgcn_s_setprio(0); } while (0)
#define PG8_WAIT_V(n) asm volatile("s_waitcnt vmcnt(" #n ")" ::: "memory")
#define PG8_WAIT_L(n) asm volatile("s_waitcnt lgkmcnt(" #n ")" ::: "memory")
#define PG8_BAR __builtin_amdgcn_s_barrier()
#define PG8_SCHED __builtin_amdgcn_sched_barrier(0)
    Unit cur, nxt; int ui = 0;
    if (!S.next(0, cur)) return;
    typedef typename AccOf<EB>::type acc_t; acc_t acc[2][2][4][2];
#pragma unroll
    for (int a = 0; a < 2; ++a)
#pragma unroll
        for (int b = 0; b < 2; ++b)
#pragma unroll
            for (int m = 0; m < 4; ++m)
#pragma unroll
                for (int n = 0; n < 2; ++n) acc[a][b][m][n] = acc_t{};
    bf16x8 At[4][2], B0[2][2], B1[2][2];
    const __amdgpu_buffer_rsrc_t rA = __builtin_amdgcn_make_buffer_rsrc((void*)g.A, (short)0, -1, 0x00020000), rB = __builtin_amdgcn_make_buffer_rsrc((void*)g.Bt, (short)0, -1, 0x00020000);
    unsigned cA = (unsigned)cur.pm * tstep, cB = (unsigned)cur.pn * tstep;
    S.a_ready(cur);
    if constexpr (SP2) {
        PG8_STAGE(PG8_SB(0, 0), rB, cB, voffB); PG8_STAGE(PG8_SB(0, 1), rB, cB + hstep, voffB); PG8_STAGE(PG8_SA(0, 0), rA, cA, voffA); PG8_STAGE(PG8_SA(0, 1), rA, cA + hstep, voffA);
        if (wr == 1) PG8_BAR;
        PG8_WAIT_V(2); PG8_BAR;
        PG8_STAGE(PG8_SB(1, 0), rB, cB + kstep, voffB); PG8_STAGE(PG8_SA(1, 0), rA, cA + kstep, voffA); PG8_STAGE(PG8_SB(1, 1), rB, cB + hstep + kstep, voffB);
        PG8_WAIT_V(6); PG8_BAR;
    } else {
        PG8_STAGE(PG8_SB(0, 0), rB, cB, voffB); PG8_STAGE(PG8_SA(0, 0), rA, cA, voffA); PG8_STAGE(PG8_SB(0, 1), rB, cB + hstep, voffB); PG8_STAGE(PG8_SA(0, 1), rA, cA + hstep, voffA);
        if (wr == 1) PG8_BAR;
        PG8_WAIT_V(4); PG8_BAR;
        PG8_STAGE(PG8_SB(1, 0), rB, cB + kstep, voffB); PG8_STAGE(PG8_SA(1, 0), rA, cA + kstep, voffA); PG8_STAGE(PG8_SB(1, 1), rB, cB + hstep + kstep, voffB);
        PG8_WAIT_V(6); PG8_BAR;
    }
    for (;;) {
        const bool has_next = S.next(ui + 1, nxt);
        const unsigned nA = has_next ? (unsigned)nxt.pm * tstep : cA, nB = has_next ? (unsigned)nxt.pn * tstep : cB;
        for (int t = 0; t < nt; t += 2) {
            const bool last = (t == nt - 2);
            const unsigned a1 = cA + (unsigned)(t + 1) * kstep;
            const unsigned a2 = last ? nA : cA + (unsigned)(t + 2) * kstep, b2 = last ? nB : cB + (unsigned)(t + 2) * kstep;
            const unsigned a3 = a2 + kstep, b3 = b2 + kstep;
            if (last && has_next) S.a_ready(nxt);
            if constexpr (Epi::PREFETCH) { if (t == 0) E.prefetch(cur, lds + PG8_PRM_OFF + (ui & 1) * 4096, wid); }
            if constexpr (SP2) {
            PG8_LDB(B0, 0, 0); PG8_LDB(B1, 0, 1); PG8_SCHED; PG8_LDA(At, 0, 0); PG8_STAGE(PG8_SA(1, 1), rA, a1 + hstep, voffA);
            PG8_WAIT_V(8); PG8_WAIT_L(0); PG8_BAR; PG8_MMA(0, 0, At, B0); PG8_MMA(0, 1, At, B1); PG8_BAR; PG8_SCHED;
            PG8_LDA(At, 0, 1); PG8_STAGE(PG8_SB(0, 0), rB, b2, voffB); PG8_STAGE(PG8_SB(0, 1), rB, b2 + hstep, voffB); PG8_STAGE(PG8_SA(0, 0), rA, a2, voffA);
            PG8_WAIT_V(8); PG8_WAIT_L(0); PG8_BAR; PG8_MMA(1, 0, At, B0); PG8_MMA(1, 1, At, B1); PG8_BAR; PG8_SCHED;
            PG8_LDB(B0, 1, 0); PG8_LDB(B1, 1, 1); PG8_SCHED; PG8_LDA(At, 1, 0); PG8_STAGE(PG8_SA(0, 1), rA, a2 + hstep, voffA);
            PG8_WAIT_V(8); PG8_WAIT_L(0); PG8_BAR; PG8_MMA(0, 0, At, B0); PG8_MMA(0, 1, At, B1); PG8_BAR; PG8_SCHED;
            PG8_LDA(At, 1, 1); PG8_STAGE(PG8_SB(1, 0), rB, b3, voffB); PG8_STAGE(PG8_SB(1, 1), rB, b3 + hstep, voffB); PG8_STAGE(PG8_SA(1, 0), rA, a3, voffA);
            PG8_WAIT_V(8); PG8_WAIT_L(0); PG8_BAR; PG8_MMA(1, 0, At, B0); PG8_MMA(1, 1, At, B1); PG8_BAR; PG8_SCHED;
            } else {
            PG8_LDB(B0, 0, 0); PG8_SCHED; PG8_LDA(At, 0, 0); PG8_STAGE(PG8_SA(1, 1), rA, a1 + hstep, voffA);
            PG8_WAIT_L(8); PG8_BAR; PG8_WAIT_L(0); PG8_MMA(0, 0, At, B0); PG8_BAR; PG8_SCHED;
            PG8_LDB(B1, 0, 1); PG8_STAGE(PG8_SB(0, 0), rB, b2, voffB);
            PG8_BAR; PG8_WAIT_L(0); PG8_MMA(0, 1, At, B1); PG8_BAR;
            PG8_LDA(At, 0, 1); PG8_STAGE(PG8_SA(0, 0), rA, a2, voffA);
            PG8_BAR; PG8_WAIT_L(0); PG8_MMA(1, 0, At, B0); PG8_BAR; PG8_SCHED;
            PG8_STAGE(PG8_SB(0, 1), rB, b2 + hstep, voffB);
            PG8_WAIT_V(6); PG8_BAR; PG8_MMA(1, 1, At, B1); PG8_BAR;
            PG8_LDB(B0, 1, 0); PG8_SCHED; PG8_LDA(At, 1, 0); PG8_STAGE(PG8_SA(0, 1), rA, a2 + hstep, voffA);
            PG8_WAIT_L(8); PG8_BAR; PG8_WAIT_L(0); PG8_MMA(0, 0, At, B0); PG8_BAR; PG8_SCHED;
            PG8_LDB(B1, 1, 1); PG8_STAGE(PG8_SB(1, 0), rB, b3, voffB);
            PG8_BAR; PG8_WAIT_L(0); PG8_MMA(0, 1, At, B1); PG8_BAR;
            PG8_LDA(At, 1, 1); PG8_STAGE(PG8_SA(1, 0), rA, a3, voffA);
            PG8_BAR; PG8_WAIT_L(0); PG8_MMA(1, 0, At, B0); PG8_BAR; PG8_SCHED;
            PG8_STAGE(PG8_SB(1, 1), rB, b3 + hstep, voffB);
            PG8_WAIT_V(6); PG8_BAR; PG8_MMA(1, 1, At, B1); PG8_BAR;
            }
        }
        if constexpr (ALIGN_EPI) { if (wr == 0) PG8_BAR; }
        if constexpr (!Epi::AFTER_DRAIN) { int ln_ = (int)__builtin_amdgcn_mbcnt_hi(~0u, __builtin_amdgcn_mbcnt_lo(~0u, 0u)); asm volatile("" : "+v"(ln_));
            E(acc, cur, wr, wc, ln_ & 15, ln_ >> 4, lds + PG8_PRM_OFF + (ui & 1) * 4096); S.done(cur); }
        if (!has_next) break;
#pragma unroll
        for (int a = 0; a < 2; ++a)
#pragma unroll
            for (int b = 0; b < 2; ++b)
#pragma unroll
                for (int m = 0; m < 4; ++m)
#pragma unroll
                    for (int n = 0; n < 2; ++n) acc[a][b][m][n] = acc_t{};
        cur = nxt; cA = nA; cB = nB; ++ui;
        if constexpr (ALIGN_EPI) { if (wr == 1) PG8_BAR; }
    }
    PG8_WAIT_V(0);
    if constexpr (!ALIGN_EPI) { if (wr == 0) PG8_BAR; }
    PG8_BAR;
    if constexpr (Epi::AFTER_DRAIN) { E.fused(acc, cur, wr, wc, fr, fq, lds, wid, lane); S.done(cur); }
#undef PG8_SA
#undef PG8_SB
#undef PG8_STAGE
#undef PG8_LDA
#undef PG8_LDB
#undef PG8_MMA
#undef PG8_WAIT_V
#undef PG8_WAIT_L
#undef PG8_BAR
#undef PG8_SCHED
}
template <class Epi, class Sched, bool ALIGN_EPI = false, bool SP2 = false>
__device__ __forceinline__ void gemm_phase_f8(PG8_LAS unsigned char* lds, const Gemm g, const Sched& S, const Epi& E) {
    int tid_ = g.wv * 64 + lane_now(); asm volatile("" : "+v"(tid_));
    const int tid = tid_, wid = __builtin_amdgcn_readfirstlane(tid >> 6), lane = tid & 63, wr = wid >> 2, wc = wid & 3, fr = lane & 15, fq = lane >> 4;
    const int K = g.K, nt = K / (2 * BK);
    unsigned voffA[2], voffB[2];
#pragma unroll
    for (int i = 0; i < 2; ++i) { int R, C; stage_rc(tid * 16 + i * 8192, R, C); const int Rb = Epi::PERM ? ((R & ~31) + perm32(R & 31)) : R;
        voffA[i] = (unsigned)(R * K + 2 * C); voffB[i] = (unsigned)(Rb * K + 2 * C); }
    const unsigned kstep = (unsigned)(BK * 2);
    const unsigned hstep = (unsigned)HALF * K;
    const unsigned tstep = 2 * hstep;
    const unsigned ldsw = (unsigned)wid * 1024u;
    const int aoff = lds_byte(wr * 64 + fr, fq * 16) ^ ((fq & 1) << 4), boff = lds_byte(wc * 32 + fr, fq * 16) ^ ((fq & 1) << 4), aoff2 = aoff ^ 16, boff2 = boff ^ 16;
#define PG8_SA(b, h) (((b) * 2 + (h)) * HTB)
#define PG8_SB(b, h) ((4 + (b) * 2 + (h)) * HTB)
#define PG8_STAGE(bufoff, rsrc, soff, voff) do { _Pragma("unroll") for (int _i = 0; _i < 2; ++_i) \
        __builtin_amdgcn_raw_ptr_buffer_load_lds(rsrc, (PG8_LAS void*)(lds + (bufoff) + ldsw + _i * 8192), 16, (int)(voff)[_i], (int)(soff), 0, 0); } while (0)
#define PG8_LDA(dst, b, h) do { _Pragma("unroll") for (int m = 0; m < 4; ++m) { const i32x4_t lo_ = *(const PG8_LAS i32x4_t*)(lds + PG8_SA(b, h) + aoff + m * 2048), hi_ = *(const PG8_LAS i32x4_t*)(lds + PG8_SA(b, h) + aoff2 + m * 2048); dst[m] = __builtin_shufflevector(lo_, hi_, 0, 1, 2, 3, 4, 5, 6, 7); } } while (0)
#define PG8_LDB(dst, b, h) do { _Pragma("unroll") for (int n = 0; n < 2; ++n) { const i32x4_t lo_ = *(const PG8_LAS i32x4_t*)(lds + PG8_SB(b, h) + boff + n * 2048), hi_ = *(const PG8_LAS i32x4_t*)(lds + PG8_SB(b, h) + boff2 + n * 2048); dst[n] = __builtin_shufflevector(lo_, hi_, 0, 1, 2, 3, 4, 5, 6, 7); } } while (0)
#define PG8_F8CAT(lo, hi) __builtin_shufflevector(__builtin_bit_cast(i32x4_t, lo), __builtin_bit_cast(i32x4_t, hi), 0, 1, 2, 3, 4, 5, 6, 7)
#define PG8_MMA(ai, bj, At, Bt) do { __builtin_amdgcn_s_setprio(1); _Pragma("unroll") for (int m = 0; m < 4; ++m) _Pragma("unroll") for (int n = 0; n < 2; ++n) \
        acc[ai][bj][m][n] = __builtin_amdgcn_mfma_scale_f32_16x16x128_f8f6f4(Bt[n], At[m], acc[ai][bj][m][n], 0, 0, 0, 0, 0, 0); __builtin_amdgcn_s_setprio(0); } while (0)
#define PG8_WAIT_V(n) asm volatile("s_waitcnt vmcnt(" #n ")" ::: "memory")
#define PG8_WAIT_L(n) asm volatile("s_waitcnt lgkmcnt(" #n ")" ::: "memory")
#define PG8_BAR __builtin_amdgcn_s_barrier()
#define PG8_SCHED __builtin_amdgcn_sched_barrier(0)
    Unit cur, nxt; int ui = 0;
    if (!S.next(0, cur)) return;
    f32x4 acc[2][2][4][2];
#pragma unroll
    for (int a = 0; a < 2; ++a)
#pragma unroll
        for (int b = 0; b < 2; ++b)
#pragma unroll
            for (int m = 0; m < 4; ++m)
#pragma unroll
                for (int n = 0; n < 2; ++n) acc[a][b][m][n] = (f32x4){0.f, 0.f, 0.f, 0.f};
    i32x8_t At[4], B0[2], B1[2];
    const __amdgpu_buffer_rsrc_t rA = __builtin_amdgcn_make_buffer_rsrc((void*)g.A, (short)0, -1, 0x00020000), rB = __builtin_amdgcn_make_buffer_rsrc((void*)g.Bt, (short)0, -1, 0x00020000);
    unsigned cA = (unsigned)cur.pm * tstep, cB = (unsigned)cur.pn * tstep;
    S.a_ready(cur);
    if constexpr (SP2) {
        PG8_STAGE(PG8_SB(0, 0), rB, cB, voffB); PG8_STAGE(PG8_SB(0, 1), rB, cB + hstep, voffB); PG8_STAGE(PG8_SA(0, 0), rA, cA, voffA); PG8_STAGE(PG8_SA(0, 1), rA, cA + hstep, voffA);
        if (wr == 1) PG8_BAR;
        PG8_WAIT_V(2); PG8_BAR;
        PG8_STAGE(PG8_SB(1, 0), rB, cB + kstep, voffB); PG8_STAGE(PG8_SA(1, 0), rA, cA + kstep, voffA); PG8_STAGE(PG8_SB(1, 1), rB, cB + hstep + kstep, voffB);
        PG8_WAIT_V(6); PG8_BAR;
    } else {
        PG8_STAGE(PG8_SB(0, 0), rB, cB, voffB); PG8_STAGE(PG8_SA(0, 0), rA, cA, voffA); PG8_STAGE(PG8_SB(0, 1), rB, cB + hstep, voffB); PG8_STAGE(PG8_SA(0, 1), rA, cA + hstep, voffA);
        if (wr == 1) PG8_BAR;
        PG8_WAIT_V(4); PG8_BAR;
        PG8_STAGE(PG8_SB(1, 0), rB, cB + kstep, voffB); PG8_STAGE(PG8_SA(1, 0), rA, cA + kstep, voffA); PG8_STAGE(PG8_SB(1, 1), rB, cB + hstep + kstep, voffB);
        PG8_WAIT_V(6); PG8_BAR;
    }
    for (;;) {
        const bool has_next = S.next(ui + 1, nxt);
        const unsigned nA = has_next ? (unsigned)nxt.pm * tstep : cA, nB = has_next ? (unsigned)nxt.pn * tstep : cB;
        for (int t = 0; t < nt; t += 2) {
            const bool last = (t == nt - 2);
            const unsigned a1 = cA + (unsigned)(t + 1) * kstep;
            const unsigned a2 = last ? nA : cA + (unsigned)(t + 2) * kstep, b2 = last ? nB : cB + (unsigned)(t + 2) * kstep;
            const unsigned a3 = a2 + kstep, b3 = b2 + kstep;
            if (last && has_next) S.a_ready(nxt);
            if constexpr (Epi::PREFETCH) { if (t == 0) E.prefetch(cur, lds + PG8_PRM_OFF + (ui & 1) * 4096, wid); }
            if constexpr (SP2) {
            PG8_LDB(B0, 0, 0); PG8_LDB(B1, 0, 1); PG8_SCHED; PG8_LDA(At, 0, 0); PG8_STAGE(PG8_SA(1, 1), rA, a1 + hstep, voffA);
            PG8_WAIT_V(8); PG8_WAIT_L(0); PG8_BAR; PG8_MMA(0, 0, At, B0); PG8_MMA(0, 1, At, B1); PG8_BAR; PG8_SCHED;
            PG8_LDA(At, 0, 1); PG8_STAGE(PG8_SB(0, 0), rB, b2, voffB); PG8_STAGE(PG8_SB(0, 1), rB, b2 + hstep, voffB); PG8_STAGE(PG8_SA(0, 0), rA, a2, voffA);
            PG8_WAIT_V(8); PG8_WAIT_L(0); PG8_BAR; PG8_MMA(1, 0, At, B0); PG8_MMA(1, 1, At, B1); PG8_BAR; PG8_SCHED;
            PG8_LDB(B0, 1, 0); PG8_LDB(B1, 1, 1); PG8_SCHED; PG8_LDA(At, 1, 0); PG8_STAGE(PG8_SA(0, 1), rA, a2 + hstep, voffA);
            PG8_WAIT_V(8); PG8_WAIT_L(0); PG8_BAR; PG8_MMA(0, 0, At, B0); PG8_MMA(0, 1, At, B1); PG8_BAR; PG8_SCHED;
            PG8_LDA(At, 1, 1); PG8_STAGE(PG8_SB(1, 0), rB, b3, voffB); PG8_STAGE(PG8_SB(1, 1), rB, b3 + hstep, voffB); PG8_STAGE(PG8_SA(1, 0), rA, a3, voffA);
            PG8_WAIT_V(8); PG8_WAIT_L(0); PG8_BAR; PG8_MMA(1, 0, At, B0); PG8_MMA(1, 1, At, B1); PG8_BAR; PG8_SCHED;
            } else {
            PG8_LDB(B0, 0, 0); PG8_SCHED; PG8_LDA(At, 0, 0); PG8_STAGE(PG8_SA(1, 1), rA, a1 + hstep, voffA);
            PG8_WAIT_L(8); PG8_BAR; PG8_WAIT_L(0); PG8_MMA(0, 0, At, B0); PG8_BAR; PG8_SCHED;
            PG8_LDB(B1, 0, 1); PG8_STAGE(PG8_SB(0, 0), rB, b2, voffB);
            PG8_BAR; PG8_WAIT_L(0); PG8_MMA(0, 1, At, B1); PG8_BAR;
            PG8_LDA(At, 0, 1); PG8_STAGE(PG8_SA(0, 0), rA, a2, voffA);
            PG8_BAR; PG8_WAIT_L(0); PG8_MMA(1, 0, At, B0); PG8_BAR; PG8_SCHED;
            PG8_STAGE(PG8_SB(0, 1), rB, b2 + hstep, voffB);
            PG8_WAIT_V(6); PG8_BAR; PG8_MMA(1, 1, At, B1); PG8_BAR;
            PG8_LDB(B0, 1, 0); PG8_SCHED; PG8_LDA(At, 1, 0); PG8_STAGE(PG8_SA(0, 1), rA, a2 + hstep, voffA);
            PG8_WAIT_L(8); PG8_BAR; PG8_WAIT_L(0); PG8_MMA(0, 0, At, B0); PG8_BAR; PG8_SCHED;
            PG8_LDB(B1, 1, 1); PG8_STAGE(PG8_SB(1, 0), rB, b3, voffB);
            PG8_BAR; PG8_WAIT_L(0); PG8_MMA(0, 1, At, B1); PG8_BAR;
            PG8_LDA(At, 1, 1); PG8_STAGE(PG8_SA(1, 0), rA, a3, voffA);
            PG8_BAR; PG8_WAIT_L(0); PG8_MMA(1, 0, At, B0); PG8_BAR; PG8_SCHED;
            PG8_STAGE(PG8_SB(1, 1), rB, b3 + hstep, voffB);
            PG8_WAIT_V(6); PG8_BAR; PG8_MMA(1, 1, At, B1); PG8_BAR;
            }
        }
        if constexpr (ALIGN_EPI) { if (wr == 0) PG8_BAR; }
        if constexpr (!Epi::AFTER_DRAIN) { int ln_ = (int)__builtin_amdgcn_mbcnt_hi(~0u, __builtin_amdgcn_mbcnt_lo(~0u, 0u)); asm volatile("" : "+v"(ln_));
            E(acc, cur, wr, wc, ln_ & 15, ln_ >> 4, lds + PG8_PRM_OFF + (ui & 1) * 4096); S.done(cur); }
        if (!has_next) break;
#pragma unroll
        for (int a = 0; a < 2; ++a)
#pragma unroll
            for (int b = 0; b < 2; ++b)
#pragma unroll
                for (int m = 0; m < 4; ++m)
#pragma unroll
                    for (int n = 0; n < 2; ++n) acc[a][b][m][n] = (f32x4){0.f, 0.f, 0.f, 0.f};
        cur = nxt; cA = nA; cB = nB; ++ui;
        if constexpr (ALIGN_EPI) { if (wr == 1) PG8_BAR; }
    }
    PG8_WAIT_V(0);
    if constexpr (!ALIGN_EPI) { if (wr == 0) PG8_BAR; }
    PG8_BAR;
    if constexpr (Epi::AFTER_DRAIN) { E.fused(acc, cur, wr, wc, fr, fq, lds, wid, lane); S.done(cur); }
#undef PG8_SA
#undef PG8_SB
#undef PG8_STAGE
#undef PG8_LDA
#undef PG8_LDB
#undef PG8_MMA
#undef PG8_WAIT_V
#undef PG8_WAIT_L
#undef PG8_BAR
#undef PG8_SCHED
#undef PG8_F8CAT
}
}

constexpr int NWAVES = 8, NTHR = NWAVES * 64;
constexpr int BATCH = 8, SEQ = 2048, DM = 2048, DEPTH = 2, HD = 64, GW = 512, NH = 8;
constexpr int M = BATCH * SEQ;
constexpr int NPROJ = 6080, NPROJ_P = 6144, DFF = 5632;
constexpr int CA_Q = 0, CA_K = 512, CA_V = 1024, CB_U = 1536, CB_V = 2048, CC_Q = 2560, CC_K = 3072, CC_V = 3584, CD = 4096;
constexpr int D_R = 0, D_WD = 512, D_K = 608, D_V = 1120, D_AD = 1632, D_GD = 1728, D_W = 1984;
constexpr float NORM_EPS = 1e-6f;
#ifndef N_LAUNCH_MODE
#define N_LAUNCH_MODE 0
#endif
#ifndef PG8_SP2
#define PG8_SP2 true
#endif
#ifndef FFN_FP8
#define FFN_FP8 1
#endif
#ifndef REPEAT
#define REPEAT 0
#endif
#ifndef GEMM_I8
#define GEMM_I8 3
#endif
#ifndef BFMASK
#define BFMASK 0x003C0Fu
#endif
#ifndef FFN1_I8
#define FFN1_I8 1
#endif
#define I8_IN ((GEMM_I8 & 1) != 0)
#define I8_OUT ((GEMM_I8 & 2) != 0)
constexpr int N_PHASES = 20;

constexpr size_t MiB = 1u << 20;
constexpr size_t WS_CTL = 0, CTL_ZERO_BYTES = 2 * MiB;
constexpr size_t WS_WIN = 2 * MiB, WS_WOUT = 26 * MiB, WS_WGU = 34 * MiB, WS_WDN = 78 * MiB, WS_SMALL = 100 * MiB;
constexpr size_t WS_XB = 104 * MiB, WS_PROJ = 168 * MiB, WS_YCAT = 360 * MiB, WS_SC2 = 424 * MiB, WS_YD = 456 * MiB, WS_G = 488 * MiB, WS_BC = 504 * MiB, WS_END = 506 * MiB;
constexpr size_t WS_XQ = WS_YD, WS_YQ = WS_PROJ;
constexpr size_t SC_ARR = (size_t)M * GW * 2;
constexpr size_t SM_TB = 0;
constexpr size_t SM_KBAR = 64 * 1024;
constexpr size_t SM_STATS = 256 * 1024;
constexpr size_t SM_SAX = 2048 * 1024, SM_SAY = SM_SAX + 64 * 1024;
constexpr size_t SM_SWIN = SM_SAY + 64 * 1024, SM_SWOUT = SM_SWIN + 32 * 1024, SM_SWGU = SM_SWOUT + 16 * 1024;
constexpr size_t SM_WT = 1024 * 1024;
constexpr int CW_BAR = 4096;
constexpr int CW_Q = 8192;
constexpr int CW_SSQ = 65536;
constexpr size_t CTL_KBAR = 1024 * 1024;
constexpr size_t CTL_STATS = 1280 * 1024;
static_assert((size_t)CW_SSQ * 4 + 5 * (size_t)M * 8 <= CTL_KBAR && CTL_STATS + 2 * (size_t)M * 2 * 8 <= CTL_ZERO_BYTES, "CTL");

constexpr int RING_OFF = 0, RING_BYTES = 131072;
constexpr int LDS_BYTES = 163840, MISC_OFF = LDS_BYTES - 256;

#define GAS __attribute__((address_space(1)))
#define LAS __attribute__((address_space(3)))
typedef unsigned short bf16;
typedef unsigned v4u __attribute__((ext_vector_type(4)));
typedef unsigned v2u __attribute__((ext_vector_type(2)));
typedef float f32x4 __attribute__((ext_vector_type(4)));
typedef short bf16x8 __attribute__((ext_vector_type(8)));
typedef float f32x16 __attribute__((ext_vector_type(16)));
typedef GAS unsigned gu32;
#define RLX_AGENT __ATOMIC_RELAXED, __HIP_MEMORY_SCOPE_AGENT
#define LDS_WAIT() asm volatile("s_waitcnt lgkmcnt(0)" ::: "memory")
#define VM_WAIT() asm volatile("s_waitcnt vmcnt(0)" ::: "memory")
__device__ __forceinline__ unsigned f2bf(float f) { unsigned u = __builtin_bit_cast(unsigned, f); return (u + 0x7fffu + ((u >> 16) & 1u)) >> 16; }
__device__ __forceinline__ unsigned pk2(float lo, float hi) { return f2bf(lo) | (f2bf(hi) << 16); }
__device__ __forceinline__ float bf2f(unsigned short h) { return __builtin_bit_cast(float, (unsigned)h << 16); }
__device__ __forceinline__ float bflo(unsigned w) { return __builtin_bit_cast(float, w << 16); }
__device__ __forceinline__ float bfhi(unsigned w) { return __builtin_bit_cast(float, w & 0xffff0000u); }
__device__ __forceinline__ float sigmoidf_(float x) { return 1.0f / (1.0f + __expf(-x)); }
__device__ __forceinline__ float gelu_tanh(float x) { const float u = 0.7978845608028654f * (x + 0.044715f * x * x * x); const float e = __expf(2.0f * u); const float th = 1.0f - 2.0f / (e + 1.0f); return 0.5f * x * (1.0f + th); }
__device__ __forceinline__ float wave_sum(float v) {
#pragma unroll
    for (int o = 1; o < 64; o <<= 1) v += __shfl_xor(v, o);
    return v;
}

__device__ __forceinline__ float zero_v() { float z = 0.f; asm volatile("" : "+v"(z)); return z; }

__device__ __forceinline__ unsigned q8pack4(float a, float b, float c, float d, float inv) {
    const int ia = (int)__builtin_rintf(a * inv), ib = (int)__builtin_rintf(b * inv), ic = (int)__builtin_rintf(c * inv), id = (int)__builtin_rintf(d * inv);
    return ((unsigned)ia & 0xffu) | (((unsigned)ib & 0xffu) << 8) | (((unsigned)ic & 0xffu) << 16) | ((unsigned)id << 24); }
__device__ __forceinline__ float wave_max(float v) {
#pragma unroll
    for (int o = 1; o < 64; o <<= 1) v = fmaxf(v, __shfl_xor(v, o));
    return v;
}
#define UNPACK8(dst, o, W_) do { dst[(o)] = bflo((W_).x); dst[(o) + 1] = bfhi((W_).x); dst[(o) + 2] = bflo((W_).y); dst[(o) + 3] = bfhi((W_).y); dst[(o) + 4] = bflo((W_).z); dst[(o) + 5] = bfhi((W_).z); dst[(o) + 6] = bflo((W_).w); dst[(o) + 7] = bfhi((W_).w); } while (0)
#define XB_TMO      128
#define XB_XCNT(j)  (256  + 64 * (j))
#define XB_XSUB(j)  (1280 + 64 * (j))
#define XB_XGEN(j)  (2304 + 64 * (j))
#define XB_TOP      3328
#define XB_TOPGEN   3392
#define XCD_BAR_WORDS 3456
#define XB_SPIN_CAP (1u << 18)

__device__ __forceinline__ unsigned xb_ld(unsigned* p)              { return __hip_atomic_load(p, __ATOMIC_RELAXED, __HIP_MEMORY_SCOPE_AGENT); }
__device__ __forceinline__ unsigned xb_add(unsigned* p, unsigned v) { return __hip_atomic_fetch_add(p, v, __ATOMIC_RELAXED, __HIP_MEMORY_SCOPE_AGENT); }
__device__ __forceinline__ unsigned xb_xcc_id() { return (unsigned)__builtin_amdgcn_s_getreg((3 << 11) | 20) & 0xFu; }
#define XB_SPIN(cond, bar) do { unsigned _sp = 0; while (cond) { __builtin_amdgcn_s_sleep(1); \
    if ((++_sp & 255u) == 0u) { if (xb_ld(&(bar)[XB_TMO])) break; if (_sp > XB_SPIN_CAP) { atomicAdd(&(bar)[XB_TMO], 1u); break; } } } } while (0)

struct XcdBarrier {
    unsigned* bar; unsigned x; int wv;
    volatile LAS unsigned* st;
};

__device__ __forceinline__ XcdBarrier xcd_barrier_post(unsigned* bar, volatile LAS unsigned* st, int wv) {
    XcdBarrier b; b.bar = bar; b.x = xb_xcc_id(); b.st = st; b.wv = wv;
    if (wv == 0 && pg8::lane_now() == 0) (void)xb_add(&bar[XB_XCNT(b.x)], 1u);
    return b;
}
__device__ __forceinline__ void xcd_barrier_complete(unsigned* bar, unsigned x, unsigned& nloc, unsigned& nx) {
    const unsigned G = gridDim.x * gridDim.y * gridDim.z;
    unsigned sum, cnt, mine, sp = 0u;
    for (;;) {
        sum = 0u; cnt = 0u; mine = 0u;
#pragma unroll
        for (unsigned j = 0; j < 16; ++j) { const unsigned c = xb_ld(&bar[XB_XCNT(j)]); sum += c; cnt += (c > 0u) ? 1u : 0u; mine = (j == x) ? c : mine; }
        if (sum == G) break;
        __builtin_amdgcn_s_sleep(1);
        if ((++sp & 255u) == 0u) { if (xb_ld(&bar[XB_TMO])) break; if (sp > XB_SPIN_CAP) { atomicAdd(&bar[XB_TMO], 1u); break; } }
    }
    nloc = mine > 0u ? mine : 1u; nx = cnt > 0u ? cnt : 1u;
}

__device__ __forceinline__ void xcd_barrier(const XcdBarrier& b) {
    asm volatile("s_waitcnt vmcnt(0)" ::: "memory");
    __syncthreads();
    if (b.wv == 0 && pg8::lane_now() == 0) {
        unsigned* bar = b.bar;
        __builtin_amdgcn_s_waitcnt(0);
        unsigned nloc = b.st[0], nx = b.st[1];
        if (nloc == 0u) { xcd_barrier_complete(bar, b.x, nloc, nx); b.st[0] = nloc; b.st[1] = nx; }
        const unsigned old = xb_add(&bar[XB_XSUB(b.x)], 1u);
        const unsigned gen = old / nloc;
        if (old + 1u == (gen + 1u) * nloc) {
            __builtin_amdgcn_fence(__ATOMIC_RELEASE, "agent");
            asm volatile("s_waitcnt vmcnt(0)" ::: "memory");
            const unsigned og = xb_add(&bar[XB_TOP], 1u);
            const unsigned tg = og / nx;
            if (og + 1u == (tg + 1u) * nx) xb_add(&bar[XB_TOPGEN], 1u);
            else XB_SPIN(xb_ld(&bar[XB_TOPGEN]) == tg, bar);
            __builtin_amdgcn_fence(__ATOMIC_ACQUIRE, "agent");
            xb_add(&bar[XB_XGEN(b.x)], 1u);
            asm volatile("s_waitcnt vmcnt(0)" ::: "memory");
        } else {
            XB_SPIN(xb_ld(&bar[XB_XGEN(b.x)]) == gen, bar);
            __builtin_amdgcn_fence(__ATOMIC_ACQUIRE, "agent");
            asm volatile("s_waitcnt vmcnt(0)" ::: "memory");
        }
    }
    __syncthreads();
}

struct Args { const float* in[25]; float* out; unsigned char* ws; int ph_lo, ph_hi; };
struct Frame {
    LAS unsigned char* lds; int tid, lane, wave, G, vcu, gw, ngw;
};
typedef const __attribute__((address_space(4))) unsigned long long* karg_t;
__device__ __forceinline__ karg_t kargs() { karg_t ka = (karg_t)__builtin_amdgcn_kernarg_segment_ptr(); asm volatile("" : "+s"(ka)); return ka; }
__device__ __forceinline__ const float* inp(int i) { return (const float*)(const GAS float*)kargs()[i]; }
__device__ __forceinline__ float* outp() { return (float*)(GAS float*)kargs()[25]; }
__device__ __forceinline__ unsigned char* wsp() { return (unsigned char*)(GAS unsigned char*)kargs()[26]; }
__device__ __forceinline__ gu32* ctlp() { return (gu32*)(wsp() + WS_CTL); }

__device__ __forceinline__ void conv_item(const float* W, int K, int N, const float* g, bf16* WT, int kind, LAS float* scr, int item, int lane, int ncols = 0) {
    const int nblk = (ncols ? ncols : N) / 32, kb = item / nblk, nb = item % nblk, k0 = 64 * kb, n0 = 32 * nb;
    float ld[32];
    { const float* wp = W + (size_t)(k0 + (lane >> 5)) * N + n0 + (lane & 31);
#pragma unroll
      for (int i = 0; i < 32; ++i) ld[i] = wp[(size_t)(2 * i) * N]; }
    if (g) { const float* gp = g + k0 + (lane >> 5);
#pragma unroll
      for (int i = 0; i < 32; ++i) ld[i] *= gp[2 * i]; }
#pragma unroll
    for (int i = 0; i < 32; ++i) scr[(2 * i + (lane >> 5)) * 33 + (lane & 31)] = ld[i];
    LDS_WAIT(); asm volatile("" ::: "memory");
    const int c = lane & 7;
#pragma unroll
    for (int j = 0; j < 4; ++j) { const int n = (lane >> 3) + 8 * j; const LAS float* s = scr + (8 * c) * 33 + n;
        v4u o; o.x = pk2(s[0 * 33], s[1 * 33]); o.y = pk2(s[2 * 33], s[3 * 33]); o.z = pk2(s[4 * 33], s[5 * 33]); o.w = pk2(s[6 * 33], s[7 * 33]);
        const int nn = n0 + n;
        if (kind >= 3) {
            const int row = kind == 5 ? nn : ((nn >> 7) * 256 + (kind - 3) * 128 + (nn & 127)); int f0 = (int)o.x, f1 = (int)o.y;
            f0 = __builtin_amdgcn_cvt_pk_fp8_f32(64.f * s[0 * 33], 64.f * s[1 * 33], f0, false); f0 = __builtin_amdgcn_cvt_pk_fp8_f32(64.f * s[2 * 33], 64.f * s[3 * 33], f0, true);
            f1 = __builtin_amdgcn_cvt_pk_fp8_f32(64.f * s[4 * 33], 64.f * s[5 * 33], f1, false); f1 = __builtin_amdgcn_cvt_pk_fp8_f32(64.f * s[6 * 33], 64.f * s[7 * 33], f1, true);
            *(GAS v2u*)((unsigned char*)WT + (size_t)row * K + k0 + 8 * c) = (v2u){(unsigned)f0, (unsigned)f1};
        } else {
        const int row = kind == 0 ? nn : ((nn >> 7) * 256 + (kind - 1) * 128 + (nn & 127));
        *(GAS v4u*)(WT + (size_t)row * K + k0 + 8 * c) = o; } }
    LDS_WAIT(); asm volatile("" ::: "memory");
}
__device__ __forceinline__ void conv_cols_i8(const float* W, int K, int N, const float* g, unsigned char* WQ, float* SW, int nb, Frame& F, int orow0 = -1) {
    LAS float* scr = (LAS float*)(F.lds + RING_OFF + F.wave * 16384); LAS float* red = (LAS float*)(F.lds + RING_OFF + 131072);
    const int n0 = 32 * nb, lane = F.lane, nkb = K / 64, o0 = orow0 < 0 ? n0 : orow0;
    const float* wp0 = W + (size_t)(lane >> 5) * N + n0 + (lane & 31);
    float mx = 0.f;
    for (int kb = F.wave; kb < nkb; kb += NWAVES) {
        const float* wp = wp0 + (size_t)(64 * kb) * N; const float* gp = g + 64 * kb + (lane >> 5);
        float ld[32];
#pragma unroll
        for (int i = 0; i < 32; ++i) ld[i] = wp[(size_t)(2 * i) * N];
#pragma unroll
        for (int i = 0; i < 32; ++i) mx = fmaxf(mx, fabsf(ld[i] * gp[2 * i]));
    }
    mx = fmaxf(mx, __shfl_xor(mx, 32));
    if (lane < 32) red[F.wave * 32 + lane] = mx;
    __syncthreads();
    float cm = 0.f;
#pragma unroll
    for (int w = 0; w < NWAVES; ++w) cm = fmaxf(cm, red[w * 32 + (lane & 31)]);
    const float inv = cm > 0.f ? 127.0f / cm : 0.f;
    if (F.wave == 0 && lane < 32) SW[o0 + lane] = cm * (1.0f / 127.0f);
    for (int kb = F.wave; kb < nkb; kb += NWAVES) {
        const float* wp = wp0 + (size_t)(64 * kb) * N; const float* gp = g + 64 * kb + (lane >> 5);
        float ld[32];
#pragma unroll
        for (int i = 0; i < 32; ++i) ld[i] = wp[(size_t)(2 * i) * N];
#pragma unroll
        for (int i = 0; i < 32; ++i) scr[(2 * i + (lane >> 5)) * 33 + (lane & 31)] = ld[i] * gp[2 * i] * inv;
        LDS_WAIT(); asm volatile("" ::: "memory");
        const int c = lane & 7;
#pragma unroll
        for (int j = 0; j < 4; ++j) { const int n = (lane >> 3) + 8 * j; const LAS float* q = scr + (8 * c) * 33 + n;
            *(GAS v2u*)(WQ + (size_t)(o0 + n) * K + 64 * kb + 8 * c) = (v2u){q8pack4(q[0 * 33], q[1 * 33], q[2 * 33], q[3 * 33], 1.0f), q8pack4(q[4 * 33], q[5 * 33], q[6 * 33], q[7 * 33], 1.0f)}; }
        LDS_WAIT(); asm volatile("" ::: "memory");
    }
    __syncthreads();
}
__device__ __forceinline__ void conv_layer_items(Frame& F, int l, int gw, int ngw, bool do_in, bool do_rest) {
    LAS float* scr = (LAS float*)(F.lds + RING_OFF + F.wave * 16384);
    constexpr int I_IN = (DM / 64) * (NPROJ / 32), I_OUT = (DM / 64) * (DM / 32), I_G = (DM / 64) * (DFF / 32), I_D = (DFF / 64) * (DM / 32);
    const float* w_in = inp(2) + (size_t)l * DM * NPROJ; const float* w_out = inp(19) + (size_t)l * DM * DM;
    const float* w_g = inp(21) + (size_t)l * DM * DFF; const float* w_u = inp(22) + (size_t)l * DM * DFF; const float* w_d = inp(23) + (size_t)l * DFF * DM;
    const float* g_mix = inp(1) + l * DM; const float* g_br = inp(18) + l * DM; const float* g_ffn = inp(20) + l * DM;
    bf16* WIN = (bf16*)(wsp() + WS_WIN); bf16* WOUT = (bf16*)(wsp() + WS_WOUT); bf16* WGU = (bf16*)(wsp() + WS_WGU); bf16* WDN = (bf16*)(wsp() + WS_WDN);
    if (do_in) {
        for (int it = gw; it < I_IN; it += ngw) conv_item(w_in, DM, NPROJ, g_mix, WIN, 0, scr, it, F.lane);
    }
    if (do_rest) {
        for (int it = gw; it < (I8_OUT ? 0 : I_OUT) + (FFN1_I8 ? 0 : 2 * I_G) + I_D; it += ngw) {
            int r = it + (I8_OUT ? I_OUT : 0); if (FFN1_I8 && r >= I_OUT) r += 2 * I_G;
            if (r < I_OUT) { conv_item(w_out, DM, DM, g_br, WOUT, 0, scr, r, F.lane); continue; } r -= I_OUT;
            if (r < I_G) { conv_item(w_g, DM, DFF, g_ffn, WGU, FFN_FP8 ? 3 : 1, scr, r, F.lane); continue; } r -= I_G;
            if (r < I_G) { conv_item(w_u, DM, DFF, g_ffn, WGU, FFN_FP8 ? 4 : 2, scr, r, F.lane); continue; } r -= I_G;
            conv_item(w_d, DFF, DM, nullptr, WDN, FFN_FP8 ? 5 : 0, scr, r, F.lane);
        }
    }
}

constexpr int WINB_NB = 8 * __builtin_popcount(BFMASK), WINB_ITEMS = (DM / 64) * WINB_NB;
__device__ __forceinline__ bf16* winb_ptr() { return (bf16*)outp() + (size_t)6 * M * GW; }
__device__ __forceinline__ void conv_winb(Frame& F, int l, int item) {
    if (item >= WINB_ITEMS) return;
    const int kb = item / (WINB_NB ? WINB_NB : 1), r = item % (WINB_NB ? WINB_NB : 1); unsigned m = BFMASK; for (int j = 0; j < (r >> 3); ++j) m &= m - 1;
    conv_item(inp(2) + (size_t)l * DM * NPROJ, DM, NPROJ, inp(1) + l * DM, winb_ptr(), 0, (LAS float*)(F.lds + RING_OFF + F.wave * 16384), kb * (NPROJ / 32) + __builtin_ctz(m) * 8 + (r & 7), F.lane);
}
__device__ __forceinline__ void ph_prologue(Frame& F) {
    if (I8_IN) {
        for (int nb = blockIdx.x; nb < NPROJ / 32; nb += F.G) conv_cols_i8(inp(2), DM, NPROJ, inp(1), wsp() + WS_WIN, (float*)(wsp() + WS_SMALL + SM_SWIN), nb, F);
        unsigned char* WIN = wsp() + WS_WIN; float* SWIN = (float*)(wsp() + WS_SMALL + SM_SWIN);
        for (int i = F.gw * 64 + F.lane; i < 64 * DM / 16; i += F.ngw * 64) *(GAS v4u*)(WIN + (size_t)NPROJ * DM + (size_t)i * 16) = (v4u){0u, 0u, 0u, 0u};
        if (blockIdx.x == 0 && F.tid < NPROJ_P - NPROJ) SWIN[NPROJ + F.tid] = 0.f;
        for (int it = F.gw; it < WINB_ITEMS; it += F.ngw) conv_winb(F, 0, it);
    } else {
    conv_layer_items(F, 0, F.gw, F.ngw, true, false);
    { bf16* WIN = (bf16*)(wsp() + WS_WIN);
      for (int i = F.gw * 64 + F.lane; i < 64 * DM / 8; i += F.ngw * 64) *(GAS v4u*)(WIN + (size_t)NPROJ * DM + (size_t)i * 8) = (v4u){0u, 0u, 0u, 0u}; } }
    if (blockIdx.x == 0) {
        int* TB = (int*)(wsp() + WS_SMALL + SM_TB);
        for (int d = F.tid; d < 2049; d += NTHR) {
            int bkt = d;
            if (d >= 16) bkt = 16 + (d >= 22) + (d >= 30) + (d >= 40) + (d >= 54) + (d >= 73) + (d >= 99) + (d >= 134) + (d >= 182) + (d >= 246) + (d >= 332) + (d >= 450) + (d >= 609) + (d >= 825) + (d >= 1117) + (d >= 1513);
            TB[d] = bkt;
        }
    }
    { bf16* WT = (bf16*)(wsp() + WS_SMALL + SM_WT); const float* w2 = inp(9); const float* a2 = inp(11); const float* g2 = inp(12);
      for (int idx = blockIdx.x * NTHR + F.tid; idx < DEPTH * 448 * GW; idx += F.G * NTHR) {
          const int c = idx % GW, k = (idx / GW) % 448, l = idx / (GW * 448);
          const float v = k < 96 ? w2[((size_t)l * 96 + k) * GW + c] : (k < 192 ? a2[((size_t)l * 96 + (k - 96)) * GW + c] : g2[((size_t)l * 256 + (k - 192)) * GW + c]);
          const int r32_ = c & 31, hct = c >> 5, ks_ = k >> 4, hh_ = (k >> 3) & 1;
          WT[(size_t)l * GW * 448 + (((size_t)hct * 28 + ks_) * 64 + 32 * hh_ + r32_) * 8 + (k & 7)] = (bf16)f2bf(v); } }
    const float* x = inp(0); bf16* XB = (bf16*)(wsp() + WS_XB); pg8::fx_t* ssq = (pg8::fx_t*)(ctlp() + CW_SSQ);
    for (int m = F.gw; m < M; m += F.ngw) {
        const GAS f32x4* xr = (const GAS f32x4*)(x + (size_t)m * DM) + F.lane; GAS v2u* o = (GAS v2u*)(XB + (size_t)m * DM) + F.lane; float s = 0.f;
#pragma unroll
        for (int j = 0; j < 8; ++j) { const f32x4 v = xr[64 * j]; s += (v.x * v.x + v.y * v.y) + (v.z * v.z + v.w * v.w); o[64 * j] = (v2u){pk2(v.x, v.y), pk2(v.z, v.w)}; }
        s = wave_sum(s); if (F.lane == 0) pg8::fx_add(ssq + m, s);
        if (I8_IN) {
            float mx = 0.f;
#pragma unroll
            for (int j = 0; j < 8; ++j) { const f32x4 v = xr[64 * j]; mx = fmaxf(fmaxf(mx, fmaxf(fabsf(v.x), fabsf(v.y))), fmaxf(fabsf(v.z), fabsf(v.w))); }
            mx = wave_max(mx); const float inv = mx > 0.f ? 127.0f / mx : 0.f; GAS unsigned* q = (GAS unsigned*)(wsp() + WS_XQ + (size_t)m * DM) + F.lane;
#pragma unroll
            for (int j = 0; j < 8; ++j) { const f32x4 v = xr[64 * j]; q[64 * j] = q8pack4(v.x, v.y, v.z, v.w, inv); }
            if (F.lane == 0) ((float*)(wsp() + WS_SMALL + SM_SAX))[m] = mx * (1.0f / 127.0f);
        }
    }
}

__device__ __forceinline__ void ph_quantx(Frame& F) {
    const bf16* XB = (const bf16*)(wsp() + WS_XB); unsigned char* XQ = wsp() + WS_XQ; float* SAX = (float*)(wsp() + WS_SMALL + SM_SAX);
    for (int m = F.gw; m < M; m += F.ngw) {
        const GAS v4u* xr = (const GAS v4u*)(XB + (size_t)m * DM) + F.lane; v4u w[4]; float mx = 0.f;
#pragma unroll
        for (int j = 0; j < 4; ++j) w[j] = xr[64 * j];
#pragma unroll
        for (int j = 0; j < 4; ++j) { mx = fmaxf(fmaxf(mx, fmaxf(fabsf(bflo(w[j].x)), fabsf(bfhi(w[j].x)))), fmaxf(fabsf(bflo(w[j].y)), fabsf(bfhi(w[j].y))));
            mx = fmaxf(fmaxf(mx, fmaxf(fabsf(bflo(w[j].z)), fabsf(bfhi(w[j].z)))), fmaxf(fabsf(bflo(w[j].w)), fabsf(bfhi(w[j].w)))); }
        mx = wave_max(mx); const float inv = mx > 0.f ? 127.0f / mx : 0.f; GAS v2u* q = (GAS v2u*)(XQ + (size_t)m * DM) + F.lane;
#pragma unroll
        for (int j = 0; j < 4; ++j) q[64 * j] = (v2u){q8pack4(bflo(w[j].x), bfhi(w[j].x), bflo(w[j].y), bfhi(w[j].y), inv), q8pack4(bflo(w[j].z), bfhi(w[j].z), bflo(w[j].w), bfhi(w[j].w), inv)};
        if (F.lane == 0) SAX[m] = mx * (1.0f / 127.0f);
    }
}

constexpr int PR_PITCH = 912;
constexpr int PR_PRM_OFF = 32768, PR_MUA_OFF = PR_PRM_OFF + 8 * 512 * 4;
__device__ __forceinline__ float fast_tanh(float x) { return 1.0f - 2.0f * __builtin_amdgcn_rcpf(__expf(2.0f * x) + 1.0f); }
__device__ __forceinline__ float fast_sigmoid(float x) { return __builtin_amdgcn_rcpf(1.0f + __expf(-x)); }
constexpr int PR_OT_OFF = 51200, PR_OT_PITCH = 72, PR_OT_TILE = 32 * PR_OT_PITCH, PR_OT_WAVE = 6 * PR_OT_TILE;
static_assert(PR_OT_OFF + 8 * PR_OT_WAVE <= MISC_OFF, "prep LDS");
__device__ __forceinline__ void ph_prep(Frame& F, int l) {
    const bf16* PROJ = (const bf16*)(wsp() + WS_PROJ);
    bf16* R_ = (bf16*)outp();
    bf16* E_ = R_ + (size_t)M * GW; bf16* KP_ = E_ + (size_t)M * GW; bf16* V_ = KP_ + (size_t)M * GW;
    bf16* KK_ = (bf16*)outp() + (size_t)4 * M * GW; bf16* AS_ = KK_ + (size_t)M * GW; bf16* G_ = (bf16*)(wsp() + WS_G); float* BC = (float*)(wsp() + WS_BC);
    const bf16* WT = (const bf16*)(wsp() + WS_SMALL + SM_WT) + (size_t)l * GW * 448;
    LAS unsigned char* actL = F.lds + RING_OFF; LAS float* PRM = (LAS float*)(F.lds + PR_PRM_OFF); LAS float* MUA = (LAS float*)(F.lds + PR_MUA_OFF);
    { const float* mu = inp(7) + l * D_W; const float* w0 = inp(8) + l * GW; const float* a0 = inp(10) + l * GW; const float* k_k = inp(13) + l * GW; const float* k_a = inp(14) + l * GW; const float* r_k = inp(15) + l * GW;
      const int c = F.tid;
      PRM[c] = mu[D_R + c]; PRM[512 + c] = mu[D_K + c]; PRM[1024 + c] = mu[D_V + c]; PRM[1536 + c] = w0[c]; PRM[2048 + c] = a0[c]; PRM[2560 + c] = k_k[c]; PRM[3072 + c] = k_a[c]; PRM[3584 + c] = r_k[c];
      if (c < 448) MUA[c] = mu[c < 96 ? D_WD + c : (c < 192 ? D_AD + (c - 96) : D_GD + (c - 192))]; }
    __syncthreads();
    const int h = F.wave;
    for (int it = blockIdx.x; it < M / 32; it += F.G) {
        const int m0 = it * 32;
        int tid_ = F.wave * 64 + pg8::lane_now(); asm volatile("" : "+v"(tid_));
        const int tid = tid_, r32 = tid & 31, hh = (tid >> 5) & 1, lane = tid & 63;
        LAS unsigned char* OT = F.lds + PR_OT_OFF + h * PR_OT_WAVE;
        { v2u pc[7], pp[7];
#pragma unroll
          for (int i = 0; i < 7; ++i) { const int gi = tid + NTHR * i, t = gi / 112, k = 4 * (gi % 112), m = m0 + t;
              const int col = k < 96 ? D_WD + k : (k < 192 ? D_AD + (k - 96) : D_GD + (k - 192)); const bf16* src = PROJ + (size_t)m * NPROJ_P + CD + col;
              pc[i] = *(const GAS v2u*)src; pp[i] = (v2u){0u, 0u}; if ((m % SEQ) > 0) pp[i] = *(const GAS v2u*)(src - NPROJ_P); }
#pragma unroll
          for (int i = 0; i < 7; ++i) { const int gi = tid + NTHR * i, t = gi / 112, k = 4 * (gi % 112);
              const f32x4 mv = *(const LAS f32x4*)(MUA + k);
              float x[4] = {bflo(pc[i].x), bfhi(pc[i].x), bflo(pc[i].y), bfhi(pc[i].y)}; const float xp[4] = {bflo(pp[i].x), bfhi(pp[i].x), bflo(pp[i].y), bfhi(pp[i].y)};
#pragma unroll
              for (int e = 0; e < 4; ++e) { x[e] += (xp[e] - x[e]) * mv[e]; x[e] = k < 96 ? fast_tanh(x[e]) : (k < 192 ? x[e] : fast_sigmoid(x[e])); }
              *(LAS v2u*)(actL + t * PR_PITCH + 2 * k) = (v2u){pk2(x[0], x[1]), pk2(x[2], x[3])}; } }
        __syncthreads();
        const int m = m0 + r32; const bool has_prev = (m % SEQ) > 0;
        const bf16* pr = PROJ + (size_t)m * NPROJ_P + CD; const bf16* pq = pr - NPROJ_P;
        const LAS unsigned char* bp = actL + r32 * PR_PITCH + 16 * hh;
        float kkv[2][16]; float n2 = 0.f, bcv = 0.f;
#pragma unroll
        for (int ct = 0; ct < 2; ++ct) {
            const int cb = 64 * h + 32 * ct + 4 * hh;
            v4u xc[3][2], xp[3][2];
#pragma unroll
            for (int a = 0; a < 3; ++a)
#pragma unroll
                for (int i = 0; i < 2; ++i) { const int mm = m0 + (lane >> 2) + 16 * i; const bf16* src = PROJ + (size_t)mm * NPROJ_P + CD + (a == 0 ? D_R : (a == 1 ? D_K : D_V)) + 64 * h + 32 * ct + 8 * (lane & 3);
                    xc[a][i] = *(const GAS v4u*)src; xp[a][i] = (v4u){0u, 0u, 0u, 0u}; if ((mm % SEQ) > 0) xp[a][i] = *(const GAS v4u*)(src - NPROJ_P); }
            f32x16 aW, aA, aG;
            { const float z_ = zero_v();
#pragma unroll
            for (int i = 0; i < 16; ++i) { aW[i] = z_; aA[i] = z_; aG[i] = z_; } }
            const bf16* wt0 = WT + ((size_t)(2 * h + ct) * 28 * 64 + lane) * 8;
#pragma unroll
            for (int grp = 0; grp < 4; ++grp) {
                bf16x8 af[7];
#pragma unroll
                for (int q = 0; q < 7; ++q) af[q] = *(const GAS bf16x8*)(wt0 + 512 * (7 * grp + q));
#pragma unroll
                for (int q = 0; q < 7; ++q) { const int ks = 7 * grp + q; const bf16x8 bfr = *(const LAS bf16x8*)(bp + 32 * ks);
                    if (ks < 6) aW = __builtin_amdgcn_mfma_f32_32x32x16_bf16(af[q], bfr, aW, 0, 0, 0);
                    else if (ks < 12) aA = __builtin_amdgcn_mfma_f32_32x32x16_bf16(af[q], bfr, aA, 0, 0, 0);
                    else aG = __builtin_amdgcn_mfma_f32_32x32x16_bf16(af[q], bfr, aG, 0, 0, 0); }
                asm volatile("" ::: "memory");
            }
            LAS unsigned char* IN = OT + 3 * PR_OT_TILE;
#pragma unroll
            for (int a = 0; a < 3; ++a)
#pragma unroll
                for (int i = 0; i < 2; ++i) { const int cch = 64 * h + 32 * ct + 8 * (lane & 3); const f32x4 m0v = *(const LAS f32x4*)(PRM + a * 512 + cch), m1v = *(const LAS f32x4*)(PRM + a * 512 + cch + 4);
                    float xcu[8], xpu[8]; UNPACK8(xcu, 0, xc[a][i]); UNPACK8(xpu, 0, xp[a][i]); const float mw[8] = {m0v.x, m0v.y, m0v.z, m0v.w, m1v.x, m1v.y, m1v.z, m1v.w};
#pragma unroll
                    for (int e = 0; e < 8; ++e) xcu[e] += (xpu[e] - xcu[e]) * mw[e];
                    LAS unsigned char* dstp = IN + a * PR_OT_TILE + ((lane >> 2) + 16 * i) * PR_OT_PITCH + 16 * (lane & 3);
                    *(LAS v2u*)dstp = (v2u){pk2(xcu[0], xcu[1]), pk2(xcu[2], xcu[3])}; *(LAS v2u*)(dstp + 8) = (v2u){pk2(xcu[4], xcu[5]), pk2(xcu[6], xcu[7])}; }
            asm volatile("" ::: "memory");
            v2u oE[4], oK[4], oG[4];
#pragma unroll
            for (int g4 = 0; g4 < 4; ++g4) {
                const int c = cb + 8 * g4;
                const f32x4 w0v = *(const LAS f32x4*)(PRM + 1536 + c),
                            a0v = *(const LAS f32x4*)(PRM + 2048 + c), kkc = *(const LAS f32x4*)(PRM + 2560 + c), kac = *(const LAS f32x4*)(PRM + 3072 + c), rkc = *(const LAS f32x4*)(PRM + 3584 + c);
                const LAS unsigned char* inq = IN + r32 * PR_OT_PITCH + 2 * (8 * g4 + 4 * hh);
                const v2u rq = *(const LAS v2u*)inq, kq = *(const LAS v2u*)(inq + PR_OT_TILE), vq = *(const LAS v2u*)(inq + 2 * PR_OT_TILE);
                const float rsu[4] = {bflo(rq.x), bfhi(rq.x), bflo(rq.y), bfhi(rq.y)}, ksu[4] = {bflo(kq.x), bfhi(kq.x), bflo(kq.y), bfhi(kq.y)}, vsu[4] = {bflo(vq.x), bfhi(vq.x), bflo(vq.y), bfhi(vq.y)};
                float ro[4], eo[4], ko[4], vo[4], ao[4], go[4];
#pragma unroll
                for (int e = 0; e < 4; ++e) {
                    const float r = rsu[e], k = ksu[e], v = vsu[e];
                    const float ee = 0.6065306597126334f * fast_sigmoid(w0v[e] + aW[4 * g4 + e]);
                    const float as = fast_sigmoid(a0v[e] + aA[4 * g4 + e]);
                    const float kv = k * kkc[e]; kkv[ct][4 * g4 + e] = kv; n2 += kv * kv;
                    const float kp = k * (1.0f + (as - 1.0f) * kac[e]);
                    bcv += r * kp * rkc[e];
                    ro[e] = r; eo[e] = ee; ko[e] = kp; vo[e] = v; ao[e] = as; go[e] = aG[4 * g4 + e];
                }
                LAS unsigned char* ot = OT + r32 * PR_OT_PITCH + 2 * (8 * g4 + 4 * hh);
                *(LAS v2u*)(ot) = (v2u){pk2(ro[0], ro[1]), pk2(ro[2], ro[3])}; *(LAS v2u*)(ot + PR_OT_TILE) = (v2u){pk2(vo[0], vo[1]), pk2(vo[2], vo[3])}; *(LAS v2u*)(ot + 2 * PR_OT_TILE) = (v2u){pk2(ao[0], ao[1]), pk2(ao[2], ao[3])};
                oE[g4] = (v2u){pk2(eo[0], eo[1]), pk2(eo[2], eo[3])}; oK[g4] = (v2u){pk2(ko[0], ko[1]), pk2(ko[2], ko[3])}; oG[g4] = (v2u){pk2(go[0], go[1]), pk2(go[2], go[3])};
            }
            asm volatile("" ::: "memory");
#pragma unroll
            for (int batch = 0; batch < 2; ++batch) {
                bf16* const dst[3] = {batch == 0 ? R_ : E_, batch == 0 ? V_ : KP_, batch == 0 ? AS_ : G_};
                if (batch == 1) {
#pragma unroll
                    for (int g4 = 0; g4 < 4; ++g4) { LAS unsigned char* ot = OT + r32 * PR_OT_PITCH + 2 * (8 * g4 + 4 * hh); *(LAS v2u*)(ot) = oE[g4]; *(LAS v2u*)(ot + PR_OT_TILE) = oK[g4]; *(LAS v2u*)(ot + 2 * PR_OT_TILE) = oG[g4]; }
                    asm volatile("" ::: "memory"); }
#pragma unroll
                for (int a = 0; a < 3; ++a)
#pragma unroll
                    for (int i = 0; i < 2; ++i) { const int tk = (lane >> 2) + 16 * i, part = lane & 3; const LAS unsigned char* src = OT + a * PR_OT_TILE + tk * PR_OT_PITCH + 16 * part;
                        const v2u lo = *(const LAS v2u*)src, hi = *(const LAS v2u*)(src + 8);
                        *(GAS v4u*)(dst[a] + (size_t)(m0 + tk) * GW + 64 * h + 32 * ct + 8 * part) = (v4u){lo.x, lo.y, hi.x, hi.y}; }
                asm volatile("" ::: "memory");
            }
        }
        n2 += __shfl_xor(n2, 32); bcv += __shfl_xor(bcv, 32);
        const float inv = 1.0f / fmaxf(sqrtf(n2), 1e-12f);
#pragma unroll
        for (int ct = 0; ct < 2; ++ct)
#pragma unroll
            for (int g4 = 0; g4 < 4; ++g4) *(LAS v2u*)(OT + ct * PR_OT_TILE + r32 * PR_OT_PITCH + 2 * (8 * g4 + 4 * hh)) = (v2u){pk2(kkv[ct][4 * g4] * inv, kkv[ct][4 * g4 + 1] * inv), pk2(kkv[ct][4 * g4 + 2] * inv, kkv[ct][4 * g4 + 3] * inv)};
        asm volatile("" ::: "memory");
#pragma unroll
        for (int ct = 0; ct < 2; ++ct)
#pragma unroll
            for (int i = 0; i < 2; ++i) { const int tk = (lane >> 2) + 16 * i, part = lane & 3; const LAS unsigned char* src = OT + ct * PR_OT_TILE + tk * PR_OT_PITCH + 16 * part;
                const v2u lo = *(const LAS v2u*)src, hi = *(const LAS v2u*)(src + 8);
                *(GAS v4u*)(KK_ + (size_t)(m0 + tk) * GW + 64 * h + 32 * ct + 8 * part) = (v4u){lo.x, lo.y, hi.x, hi.y}; }
        asm volatile("" ::: "memory");
        if (hh == 0) BC[(size_t)m * NH + h] = bcv;
        __syncthreads();
    }
}

__device__ __forceinline__ Frame mkframe(LAS unsigned char* lds, int wv) {
    Frame F; F.lds = lds; { int t_ = wv * 64 + pg8::lane_now(); asm volatile("" : "+v"(t_)); F.tid = t_; } F.lane = F.tid & 63; F.wave = wv;
    F.G = gridDim.x; { const int bx = blockIdx.x; F.vcu = (F.G % 8 == 0) ? (bx % 8) * (F.G / 8) + bx / 8 : bx; }
    F.gw = blockIdx.x * NWAVES + F.wave; F.ngw = F.G * NWAVES; return F;
}

#ifndef UNPACK8
#define UNPACK8(dst, o, W_) do { dst[(o)] = bflo((W_).x); dst[(o) + 1] = bfhi((W_).x); dst[(o) + 2] = bflo((W_).y); dst[(o) + 3] = bfhi((W_).y); dst[(o) + 4] = bflo((W_).z); dst[(o) + 5] = bfhi((W_).z); dst[(o) + 6] = bflo((W_).w); dst[(o) + 7] = bfhi((W_).w); } while (0)
#endif
#define DOT8(q, o, W_) ((q)[(o)] * bflo((W_).x) + (q)[(o) + 1] * bfhi((W_).x) + (q)[(o) + 2] * bflo((W_).y) + (q)[(o) + 3] * bfhi((W_).y) + (q)[(o) + 4] * bflo((W_).z) + (q)[(o) + 5] * bfhi((W_).z) + (q)[(o) + 6] * bflo((W_).w) + (q)[(o) + 7] * bfhi((W_).w))
#define AXPY8(acc, o, sc, pe, W_) do { acc[(o)] = acc[(o)] * (sc) + (pe) * bflo((W_).x); acc[(o) + 1] = acc[(o) + 1] * (sc) + (pe) * bfhi((W_).x); acc[(o) + 2] = acc[(o) + 2] * (sc) + (pe) * bflo((W_).y); acc[(o) + 3] = acc[(o) + 3] * (sc) + (pe) * bfhi((W_).y); \
    acc[(o) + 4] = acc[(o) + 4] * (sc) + (pe) * bflo((W_).z); acc[(o) + 5] = acc[(o) + 5] * (sc) + (pe) * bfhi((W_).z); acc[(o) + 6] = acc[(o) + 6] * (sc) + (pe) * bflo((W_).w); acc[(o) + 7] = acc[(o) + 7] * (sc) + (pe) * bfhi((W_).w); } while (0)
__device__ __forceinline__ void mix_a_simple(Frame& F) {
    const bf16* PROJ = (const bf16*)(wsp() + WS_PROJ); bf16* YC = (bf16*)(wsp() + WS_YCAT); const int* TB = (const int*)(wsp() + WS_SMALL + SM_TB); const float* pb = inp(3);
    const int nthr = F.G * NTHR;
    for (int idx = blockIdx.x * NTHR + F.tid; idx < M * NH; idx += nthr) {
        const int m = idx >> 3, h = idx & 7, t = m % SEQ;
        float q[64], acc[64];
        { const GAS v4u* qp = (const GAS v4u*)(PROJ + (size_t)m * NPROJ_P + CA_Q + 64 * h);
#pragma unroll
          for (int i = 0; i < 8; ++i) { const v4u w = qp[i]; UNPACK8(q, 8 * i, w); } }
#pragma unroll
        for (int i = 0; i < 64; ++i) acc[i] = 0.f;
        float mx = -1e30f, l = 0.f;
        for (int p = 0; p < 3; ++p) { const int d = p == 0 ? 1 : (p == 1 ? 4 : 16);
            for (int j = 0; j <= 128; ++j) { const int kp = t - j * d; if (kp < 0) break;
                const bf16* row = PROJ + (size_t)(m - j * d) * NPROJ_P; const GAS v4u* kq = (const GAS v4u*)(row + CA_K + 64 * h); const GAS v4u* vq = (const GAS v4u*)(row + CA_V + 64 * h);
                float s = 0.f;
#pragma unroll
                for (int i = 0; i < 8; ++i) { const v4u w = kq[i]; s += DOT8(q, 8 * i, w); }
                s = s * 0.125f + pb[TB[j * d] * 16 + h];
                const float mn = fmaxf(mx, s), sc = __expf(mx - mn), pe = __expf(s - mn); mx = mn; l = l * sc + pe;
#pragma unroll
                for (int i = 0; i < 8; ++i) { const v4u w = vq[i]; AXPY8(acc, 8 * i, sc, pe, w); }
            } }
        const float inv = 1.0f / l; GAS v4u* op = (GAS v4u*)(YC + (size_t)m * DM + 0 * GW + 64 * h);
#pragma unroll
        for (int i = 0; i < 8; ++i) op[i] = (v4u){pk2(acc[8 * i] * inv, acc[8 * i + 1] * inv), pk2(acc[8 * i + 2] * inv, acc[8 * i + 3] * inv), pk2(acc[8 * i + 4] * inv, acc[8 * i + 5] * inv), pk2(acc[8 * i + 6] * inv, acc[8 * i + 7] * inv)};
    }
}
__device__ __forceinline__ void mix_c_simple(Frame& F, int l = 0) {
    const bf16* PROJ = (const bf16*)(wsp() + WS_PROJ); bf16* YC = (bf16*)(wsp() + WS_YCAT); const int* TB = (const int*)(wsp() + WS_SMALL + SM_TB); const float* pb = inp(3);
    const float* KBAR = (const float*)(wsp() + CTL_KBAR) + (size_t)l * 64 * 8 * 64;
    const int nthr = F.G * NTHR;
    for (int idx = blockIdx.x * NTHR + F.tid; idx < M * NH; idx += nthr) {
        const int m = idx >> 3, h = idx & 7, t = m % SEQ, b = m / SEQ, ob = t >> 8;
        float q[64], acc[64];
        { const GAS v4u* qp = (const GAS v4u*)(PROJ + (size_t)m * NPROJ_P + CC_Q + 64 * h);
#pragma unroll
          for (int i = 0; i < 8; ++i) { const v4u w = qp[i]; UNPACK8(q, 8 * i, w); } }
        float gate[8];
#pragma unroll
        for (int n = 0; n < 8; ++n) { float s = 0.f; if (n < ob) { const float* kb = KBAR + ((b * NH + h) * 8 + n) * 64;
#pragma unroll
                for (int i = 0; i < 64; ++i) s += q[i] * kb[i]; } gate[n] = s; }
        unsigned sel = 0u;
#pragma unroll
        for (int n = 0; n < 8; ++n) { int rank = 0;
#pragma unroll
            for (int n2 = 0; n2 < 8; ++n2) rank += (n2 < ob && n2 != n && (gate[n2] > gate[n] || (gate[n2] == gate[n] && n2 < n))) ? 1 : 0;
            if (n < ob && rank < 3) sel |= 1u << n; }
        sel |= 1u << ob;
#pragma unroll
        for (int i = 0; i < 64; ++i) acc[i] = 0.f;
        float mx = -1e30f, l = 0.f;
        for (int n = 0; n <= ob; ++n) { if (!((sel >> n) & 1u)) continue; const int kmax = n == ob ? (t & 255) : 255;
            for (int i2 = 0; i2 <= kmax; ++i2) { const int kp = 256 * n + i2;
                const bf16* row = PROJ + ((size_t)b * SEQ + kp) * NPROJ_P; const GAS v4u* kq = (const GAS v4u*)(row + CC_K + 64 * h); const GAS v4u* vq = (const GAS v4u*)(row + CC_V + 64 * h);
                float s = 0.f;
#pragma unroll
                for (int i = 0; i < 8; ++i) { const v4u w = kq[i]; s += DOT8(q, 8 * i, w); }
                s = s * 0.125f + pb[TB[t - kp] * 16 + 8 + h];
                const float mn = fmaxf(mx, s), sc = __expf(mx - mn), pe = __expf(s - mn); mx = mn; l = l * sc + pe;
#pragma unroll
                for (int i = 0; i < 8; ++i) { const v4u w = vq[i]; AXPY8(acc, 8 * i, sc, pe, w); }
            } }
        const float inv = 1.0f / l; GAS v4u* op = (GAS v4u*)(YC + (size_t)m * DM + 2 * GW + 64 * h);
#pragma unroll
        for (int i = 0; i < 8; ++i) op[i] = (v4u){pk2(acc[8 * i] * inv, acc[8 * i + 1] * inv), pk2(acc[8 * i + 2] * inv, acc[8 * i + 3] * inv), pk2(acc[8 * i + 4] * inv, acc[8 * i + 5] * inv), pk2(acc[8 * i + 6] * inv, acc[8 * i + 7] * inv)};
    }
}
__device__ __forceinline__ void mix_b_simple(Frame& F, int l) {
    const bf16* PROJ = (const bf16*)(wsp() + WS_PROJ); bf16* YC = (bf16*)(wsp() + WS_YCAT); const pg8::fx_t* ST = (const pg8::fx_t*)(wsp() + CTL_STATS) + (size_t)l * M * 2;
    const float* lng = inp(4) + l * GW; const float* sw = inp(5) + (size_t)l * NH * 128 * 128; const float* sb = inp(6) + l * NH * 128;
    const int nthr = F.G * NTHR;
    for (int idx = blockIdx.x * NTHR + F.tid; idx < M * GW; idx += nthr) {
        const int m = idx >> 9, c = idx & 511, g = c >> 6, tt = m & 127, m0 = m - tt;
        const float* wrow = sw + ((size_t)g * 128 + tt) * 128; const float gn = lng[c]; float s = 0.f;
        for (int s2 = 0; s2 <= tt; ++s2) { const int ms = m0 + s2; const float mu_ = pg8::fx_get(ST + 2 * ms) * (1.0f / 512.0f), rs_ = 1.0f / sqrtf(fmaxf(pg8::fx_get(ST + 2 * ms + 1) * (1.0f / 512.0f) - mu_ * mu_, 0.f) + 1e-5f); const float vv = (gelu_tanh(bf2f(PROJ[(size_t)ms * NPROJ_P + CB_V + c])) - mu_) * rs_ * gn; s += wrow[s2] * vv; }
        const float u = gelu_tanh(bf2f(PROJ[(size_t)m * NPROJ_P + CB_U + c]));
        YC[(size_t)m * DM + GW + c] = (bf16)f2bf(u * (s + sb[g * 128 + tt]));
    }
}
__device__ __forceinline__ float rdl(float v, int k) { return __builtin_bit_cast(float, __builtin_amdgcn_readlane(__builtin_bit_cast(int, v), k)); }
__device__ __forceinline__ void mix_d_simple(Frame& F) {
    const bf16* R_ = (const bf16*)outp();
    const bf16* E_ = R_ + (size_t)M * GW; const bf16* KP_ = E_ + (size_t)M * GW; const bf16* V_ = KP_ + (size_t)M * GW;
    const bf16* KK_ = (const bf16*)outp() + (size_t)4 * M * GW; const bf16* AS_ = KK_ + (size_t)M * GW; float* YD = (float*)(wsp() + WS_YD);
    for (int it = F.gw; it < BATCH * NH; it += F.ngw) {
        const int b = it >> 3, h = it & 7; float s[64];
#pragma unroll
        for (int k = 0; k < 64; ++k) s[k] = 0.f;
        for (int t = 0; t < SEQ; ++t) {
            const size_t o = ((size_t)b * SEQ + t) * GW + 64 * h + F.lane;
            const float r = bf2f(R_[o]), w = __expf(-bf2f(E_[o])), kp = bf2f(KP_[o]), v = bf2f(V_[o]), kk = bf2f(KK_[o]), as = bf2f(AS_[o]);
            const float a = -kk, bb = kk * as;
            float sa = 0.f;
#pragma unroll
            for (int k = 0; k < 64; ++k) sa += s[k] * rdl(a, k);
            float y = 0.f;
#pragma unroll
            for (int k = 0; k < 64; ++k) { s[k] = s[k] * rdl(w, k) + sa * rdl(bb, k) + v * rdl(kp, k); y += s[k] * rdl(r, k); }
            YD[o] = y;
        }
    }
}

constexpr float LOG2E = 1.4426950408889634f;

constexpr int SC_T = 32, SC_TOK = (5 * 64 + 32) * 4, SC_BUF = SC_T * SC_TOK, SC_YB = SC_T * 32 * 4, SC_LDS = 2 * SC_BUF + 2 * SC_YB;
template <int CTRL> __device__ __forceinline__ float dpp_add(float x) {
    const int y = __builtin_amdgcn_update_dpp(0, __builtin_bit_cast(int, x), CTRL, 0xF, 0xF, false);
    return x + __builtin_bit_cast(float, y);
}
__device__ __forceinline__ float red8(float x) { x = dpp_add<0xB1>(x); x = dpp_add<0x4E>(x); x = dpp_add<0x141>(x); return x; }
__device__ __forceinline__ void scan_unit(LAS unsigned char* lds, int unit, int tid) {
    const int half = unit & 1, h = (unit >> 1) & 7, b = unit >> 4;
    const bf16* R_ = (const bf16*)outp();
    const bf16* E_ = R_ + (size_t)M * GW; const bf16* KP_ = E_ + (size_t)M * GW; const bf16* V_ = KP_ + (size_t)M * GW;
    const bf16* KK_ = (const bf16*)outp() + (size_t)4 * M * GW; const bf16* AS_ = KK_ + (size_t)M * GW; float* YD = (float*)(wsp() + WS_YD);
    const int lane = tid & 63, wave = __builtin_amdgcn_readfirstlane(tid >> 6);
    const bool scanner = wave < 4;
    const int j = lane & 7, rowl = (wave & 3) * 8 + (lane >> 3);
    const int st = tid & 255, tt = st >> 3, cg = st & 7;
    const size_t gbase = ((size_t)b * SEQ) * GW + 64 * h + 8 * cg;
#define SC_STAGE(c, buf) do { const size_t o_ = gbase + (size_t)((c) * SC_T + tt) * GW; \
        const v4u g_r = *(const GAS v4u*)(R_ + o_), g_e = *(const GAS v4u*)(E_ + o_), g_k = *(const GAS v4u*)(KP_ + o_), g_v = *(const GAS v4u*)(V_ + o_), g_kk = *(const GAS v4u*)(KK_ + o_), g_as = *(const GAS v4u*)(AS_ + o_); \
        LAS float* p_ = (LAS float*)(lds + (buf) * SC_BUF + tt * SC_TOK) + 8 * cg; float kk_[8], x_[8], y_[8]; \
        UNPACK8(kk_, 0, g_kk); \
        *(LAS f32x4*)(p_) = (f32x4){-kk_[0], -kk_[1], -kk_[2], -kk_[3]}; *(LAS f32x4*)(p_ + 4) = (f32x4){-kk_[4], -kk_[5], -kk_[6], -kk_[7]}; \
        UNPACK8(x_, 0, g_e); *(LAS f32x4*)(p_ + 64) = (f32x4){__expf(-x_[0]), __expf(-x_[1]), __expf(-x_[2]), __expf(-x_[3])}; *(LAS f32x4*)(p_ + 68) = (f32x4){__expf(-x_[4]), __expf(-x_[5]), __expf(-x_[6]), __expf(-x_[7])}; \
        UNPACK8(y_, 0, g_as); *(LAS f32x4*)(p_ + 128) = (f32x4){kk_[0] * y_[0], kk_[1] * y_[1], kk_[2] * y_[2], kk_[3] * y_[3]}; *(LAS f32x4*)(p_ + 132) = (f32x4){kk_[4] * y_[4], kk_[5] * y_[5], kk_[6] * y_[6], kk_[7] * y_[7]}; \
        UNPACK8(x_, 0, g_k); *(LAS f32x4*)(p_ + 192) = (f32x4){x_[0], x_[1], x_[2], x_[3]}; *(LAS f32x4*)(p_ + 196) = (f32x4){x_[4], x_[5], x_[6], x_[7]}; \
        UNPACK8(x_, 0, g_r); *(LAS f32x4*)(p_ + 256) = (f32x4){x_[0], x_[1], x_[2], x_[3]}; *(LAS f32x4*)(p_ + 260) = (f32x4){x_[4], x_[5], x_[6], x_[7]}; \
        if ((cg >> 2) == half) { UNPACK8(x_, 0, g_v); LAS float* v_ = (LAS float*)(lds + (buf) * SC_BUF + tt * SC_TOK) + 320 + 8 * (cg & 3); \
            *(LAS f32x4*)(v_) = (f32x4){x_[0], x_[1], x_[2], x_[3]}; *(LAS f32x4*)(v_ + 4) = (f32x4){x_[4], x_[5], x_[6], x_[7]}; } } while (0)
    if (!scanner) SC_STAGE(0, 0);
    __syncthreads();
    f32x4 s0 = {0.f, 0.f, 0.f, 0.f}, s1 = {0.f, 0.f, 0.f, 0.f};
    float ykeep = 0.f;
    for (int c = 0; c < SEQ / SC_T; ++c) {
        const int cur = c & 1;
        LAS float* yb = (LAS float*)(lds + 2 * SC_BUF + cur * SC_YB);
        if (scanner) {
            const LAS float* base = (const LAS float*)(lds + cur * SC_BUF) + 8 * j;
            const LAS float* vbase = (const LAS float*)(lds + cur * SC_BUF) + 320 + rowl;
            f32x4 a0 = *(const LAS f32x4*)(base), a1 = *(const LAS f32x4*)(base + 4), w0 = *(const LAS f32x4*)(base + 64), w1 = *(const LAS f32x4*)(base + 68), b0 = *(const LAS f32x4*)(base + 128), b1 = *(const LAS f32x4*)(base + 132),
                  k0 = *(const LAS f32x4*)(base + 192), k1 = *(const LAS f32x4*)(base + 196), r0 = *(const LAS f32x4*)(base + 256), r1 = *(const LAS f32x4*)(base + 260);
            float vv = *vbase;
#pragma unroll
            for (int t = 0; t < SC_T; ++t) {
                f32x4 na0 = a0, na1 = a1, nw0 = w0, nw1 = w1, nb0 = b0, nb1 = b1, nk0 = k0, nk1 = k1, nr0 = r0, nr1 = r1; float nv = vv;
                if (t + 1 < SC_T) { const LAS float* p = base + (t + 1) * (SC_TOK / 4);
                    na0 = *(const LAS f32x4*)(p); na1 = *(const LAS f32x4*)(p + 4); nw0 = *(const LAS f32x4*)(p + 64); nw1 = *(const LAS f32x4*)(p + 68); nb0 = *(const LAS f32x4*)(p + 128); nb1 = *(const LAS f32x4*)(p + 132);
                    nk0 = *(const LAS f32x4*)(p + 192); nk1 = *(const LAS f32x4*)(p + 196); nr0 = *(const LAS f32x4*)(p + 256); nr1 = *(const LAS f32x4*)(p + 260);
                    nv = vbase[(t + 1) * (SC_TOK / 4)]; }
                const f32x4 pa = s0 * a0 + s1 * a1;
                float sa = (pa.x + pa.y) + (pa.z + pa.w);
                const f32x4 sw0 = s0 * w0 + vv * k0, sw1 = s1 * w1 + vv * k1;
                sa = red8(sa);
                s0 = sa * b0 + sw0; s1 = sa * b1 + sw1;
                const f32x4 py = s0 * r0 + s1 * r1;
                float y = (py.x + py.y) + (py.z + py.w);
                y = red8(y);
                ykeep = (j == (t & 7)) ? y : ykeep;
                if ((t & 7) == 7) yb[((t & ~7) + j) * 32 + rowl] = ykeep;
                a0 = na0; a1 = na1; w0 = nw0; w1 = nw1; b0 = nb0; b1 = nb1; k0 = nk0; k1 = nk1; r0 = nr0; r1 = nr1; vv = nv;
            }
        } else {
            if (c > 0) {
                const LAS float* ybp = (const LAS float*)(lds + 2 * SC_BUF + (cur ^ 1) * SC_YB); const int t2 = st >> 3, q4 = st & 7; const f32x4 v = *(const LAS f32x4*)(ybp + t2 * 32 + 4 * q4);
                *(GAS f32x4*)(YD + ((size_t)b * SEQ + (c - 1) * SC_T + t2) * GW + 64 * h + 32 * half + 4 * q4) = v; }
            if (c + 1 < SEQ / SC_T) SC_STAGE(c + 1, cur ^ 1);
        }
        __syncthreads();
    }
    if (!scanner) { const LAS float* ybp = (const LAS float*)(lds + 2 * SC_BUF + 1 * SC_YB); const int t2 = st >> 3, q4 = st & 7; const f32x4 v = *(const LAS f32x4*)(ybp + t2 * 32 + 4 * q4);
        *(GAS f32x4*)(YD + ((size_t)b * SEQ + (SEQ / SC_T - 1) * SC_T + t2) * GW + 64 * h + 32 * half + 4 * q4) = v; }
#undef SC_STAGE
    __syncthreads();
}

struct AttnSt { f32x16 o0, o1; float m, l; };
__device__ __forceinline__ void attn_init(AttnSt& st) {
    const float z_ = zero_v();
#pragma unroll
    for (int i = 0; i < 16; ++i) { st.o0[i] = z_; st.o1[i] = z_; }
    st.m = -1e30f; st.l = 0.f;
}
__device__ __forceinline__ void attn_tile(AttnSt& st, const bf16x8 (&qf)[4], const bf16* Kcol, const bf16* Vcol, int rowb, int kb, int ks, int qpos, int maxd, bool sel, const LAS float* biasT, int r32, int hh) {
    int kp_l = kb + r32 * ks; kp_l = kp_l < 0 ? 0 : kp_l;
    const bf16* kr_ = Kcol + (size_t)(rowb + kp_l) * NPROJ_P + 8 * hh;
    bf16x8 kf[4];
#pragma unroll
    for (int s = 0; s < 4; ++s) kf[s] = *(const GAS bf16x8*)(kr_ + 16 * s);
    f32x16 sc;
#pragma unroll
    for (int i = 0; i < 16; ++i) sc[i] = 0.f;
#pragma unroll
    for (int s = 0; s < 4; ++s) sc = __builtin_amdgcn_mfma_f32_32x32x16_bf16(kf[s], qf[s], sc, 0, 0, 0);
    unsigned vf[2][2][4];
#pragma unroll
    for (int s2 = 0; s2 < 2; ++s2)
#pragma unroll
        for (int jp = 0; jp < 4; ++jp) {
            const int j0 = 2 * jp, key0 = 16 * s2 + 8 * (j0 >> 2) + 4 * hh + (j0 & 3);
            int kp0 = kb + key0 * ks, kp1 = kp0 + ks; kp0 = kp0 < 0 ? 0 : kp0; kp1 = kp1 < 0 ? 0 : kp1;
            const bf16* v0 = Vcol + (size_t)(rowb + kp0) * NPROJ_P + r32; const bf16* v1 = Vcol + (size_t)(rowb + kp1) * NPROJ_P + r32;
            vf[0][s2][jp] = (unsigned)v0[0] | ((unsigned)v1[0] << 16); vf[1][s2][jp] = (unsigned)v0[32] | ((unsigned)v1[32] << 16);
        }
    float tmax = -INFINITY;
#pragma unroll
    for (int r = 0; r < 16; ++r) {
        const int kr = (r & 3) + 8 * (r >> 2) + 4 * hh, kp = kb + kr * ks, dist = qpos - kp;
        const bool ok = sel && dist >= 0 && dist <= maxd && kp >= 0;
        const float v = sc[r] * (0.125f * LOG2E) + biasT[ok ? dist : 0];
        sc[r] = ok ? v : -INFINITY; tmax = fmaxf(tmax, sc[r]);
    }
    tmax = fmaxf(tmax, __shfl_xor(tmax, 32));
    const float mn = fmaxf(st.m, tmax), scale = __builtin_amdgcn_exp2f(st.m - mn); st.m = mn;
    float ls = 0.f;
#pragma unroll
    for (int r = 0; r < 16; ++r) { sc[r] = __builtin_amdgcn_exp2f(sc[r] - mn); ls += sc[r]; }
    st.l = st.l * scale + ls;
#pragma unroll
    for (int i = 0; i < 16; ++i) { st.o0[i] *= scale; st.o1[i] *= scale; }
    typedef unsigned u32x4_t __attribute__((ext_vector_type(4)));
#pragma unroll
    for (int s2 = 0; s2 < 2; ++s2) {
        u32x4_t pw; pw.x = pg8::cvt_pk_bf16(sc[8 * s2], sc[8 * s2 + 1]); pw.y = pg8::cvt_pk_bf16(sc[8 * s2 + 2], sc[8 * s2 + 3]); pw.z = pg8::cvt_pk_bf16(sc[8 * s2 + 4], sc[8 * s2 + 5]); pw.w = pg8::cvt_pk_bf16(sc[8 * s2 + 6], sc[8 * s2 + 7]);
        const bf16x8 pf = __builtin_bit_cast(bf16x8, pw);
        u32x4_t a0 = {vf[0][s2][0], vf[0][s2][1], vf[0][s2][2], vf[0][s2][3]}, a1 = {vf[1][s2][0], vf[1][s2][1], vf[1][s2][2], vf[1][s2][3]};
        st.o0 = __builtin_amdgcn_mfma_f32_32x32x16_bf16(__builtin_bit_cast(bf16x8, a0), pf, st.o0, 0, 0, 0);
        st.o1 = __builtin_amdgcn_mfma_f32_32x32x16_bf16(__builtin_bit_cast(bf16x8, a1), pf, st.o1, 0, 0, 0);
    }
}
__device__ __forceinline__ void attn_loadq(bf16x8 (&qf)[4], const bf16* Qcol, int row, int hh) {
    const bf16* q = Qcol + (size_t)row * NPROJ_P + 8 * hh;
#pragma unroll
    for (int s = 0; s < 4; ++s) qf[s] = *(const GAS bf16x8*)(q + 16 * s);
}
__device__ __forceinline__ void attn_store(const f32x16& o0, const f32x16& o1, float inv, bf16* yrow, int hh) {
#pragma unroll
    for (int g = 0; g < 4; ++g) {
        *(GAS v2u*)(yrow + 8 * g + 4 * hh) = (v2u){pk2(o0[4 * g] * inv, o0[4 * g + 1] * inv), pk2(o0[4 * g + 2] * inv, o0[4 * g + 3] * inv)};
        *(GAS v2u*)(yrow + 32 + 8 * g + 4 * hh) = (v2u){pk2(o1[4 * g] * inv, o1[4 * g + 1] * inv), pk2(o1[4 * g + 2] * inv, o1[4 * g + 3] * inv)};
    }
}
__device__ __forceinline__ void build_bias(LAS float* biasT, int hcol, int tid) {
    const int* TB = (const int*)(wsp() + WS_SMALL + SM_TB); const float* pb = inp(3); LAS int* bktT = (LAS int*)(biasT + 2048);
    for (int d = tid; d < 2048; d += NTHR) { const int bk = TB[d]; bktT[d] = bk; biasT[d] = pb[bk * 16 + hcol] * LOG2E; }
}

constexpr int MC_KP = 144, MC_VP = 192, MC_KB = 128 * MC_KP, MC_VB = 128 * MC_VP, MC_K_OFF = 16384, MC_V_OFF = MC_K_OFF + 2 * MC_KB, MC_LDS = MC_V_OFF + 2 * MC_VB;
typedef short v4i16_t __attribute__((ext_vector_type(4)));
__device__ __forceinline__ float pl32_max(float a) { float x = a, y = a;
    asm volatile("s_nop 1\n\tv_permlane32_swap_b32_e32 %0, %1\n\ts_nop 0" : "+v"(x), "+v"(y));
    return fmaxf(x, y); }
template <int MODE> __device__ __forceinline__ void moba_tile(AttnSt& st, const bf16x8 (&qf)[4], const LAS unsigned char* Kt, const LAS unsigned char* Vt, const LAS float* biasT, const LAS int* TB, int dlo, bool sel, int lane, int r32, int hh) {
    bf16x8 kf[4];
#pragma unroll
    for (int s = 0; s < 4; ++s) kf[s] = *(const LAS bf16x8*)(Kt + r32 * MC_KP + 32 * s + 16 * hh);
    v4i16_t vt[2][2][2];
    { const LAS unsigned char* vb = Vt + (4 * hh + ((lane & 15) >> 2)) * MC_VP + (16 * ((lane >> 4) & 1) + 4 * (lane & 3)) * 2;
#pragma unroll
      for (int dh = 0; dh < 2; ++dh)
#pragma unroll
        for (int s2 = 0; s2 < 2; ++s2)
#pragma unroll
            for (int h8 = 0; h8 < 2; ++h8) vt[dh][s2][h8] = __builtin_amdgcn_ds_read_tr16_b64_v4i16((LAS v4i16_t*)(vb + (16 * s2 + 8 * h8) * MC_VP + 64 * dh)); }
    f32x16 sc;
#pragma unroll
    for (int i = 0; i < 16; ++i) sc[i] = 0.f;
#pragma unroll
    for (int s = 0; s < 4; ++s) sc = __builtin_amdgcn_mfma_f32_32x32x16_bf16(kf[s], qf[s], sc, 0, 0, 0);
    const int d0 = dlo + r32 + 31 - 4 * hh;
    const int dmin = dlo < 0 ? 0 : dlo, dmax = dlo + 62;
    const bool uni = __builtin_amdgcn_readfirstlane(TB[dmin]) == __builtin_amdgcn_readfirstlane(TB[dmax]);
    float tmax = -INFINITY;
    if (uni) { const float bu = biasT[dmin];
#pragma unroll
        for (int r = 0; r < 16; ++r) { float v = sc[r] * (0.125f * LOG2E) + bu; if (MODE == 1) { const int dist = d0 - (r & 3) - 8 * (r >> 2); v = dist >= 0 ? v : -INFINITY; } sc[r] = v; tmax = fmaxf(tmax, v); }
    } else {
#pragma unroll
        for (int r = 0; r < 16; ++r) { const int dist = d0 - (r & 3) - 8 * (r >> 2); float v = sc[r] * (0.125f * LOG2E) + biasT[dist < 0 ? 0 : dist]; if (MODE == 1) v = dist >= 0 ? v : -INFINITY; sc[r] = v; tmax = fmaxf(tmax, v); }
    }
    if (MODE == 2) tmax = sel ? tmax : -INFINITY;
    tmax = pl32_max(tmax);
    const float mn = fmaxf(st.m, tmax);
    if (__ballot(mn > st.m) != 0ull) { const float scale = __builtin_amdgcn_exp2f(st.m - mn); st.l *= scale;
#pragma unroll
        for (int i = 0; i < 16; ++i) { st.o0[i] *= scale; st.o1[i] *= scale; } }
    st.m = mn;
    const float msub = (MODE == 2 && !sel) ? INFINITY : mn;
    float ls = 0.f;
#pragma unroll
    for (int r = 0; r < 16; ++r) { sc[r] = __builtin_amdgcn_exp2f(sc[r] - msub); ls += sc[r]; }
    st.l += ls;
    typedef unsigned u32x4_t __attribute__((ext_vector_type(4)));
#pragma unroll
    for (int s2 = 0; s2 < 2; ++s2) {
        u32x4_t pw; pw.x = pg8::cvt_pk_bf16(sc[8 * s2], sc[8 * s2 + 1]); pw.y = pg8::cvt_pk_bf16(sc[8 * s2 + 2], sc[8 * s2 + 3]); pw.z = pg8::cvt_pk_bf16(sc[8 * s2 + 4], sc[8 * s2 + 5]); pw.w = pg8::cvt_pk_bf16(sc[8 * s2 + 6], sc[8 * s2 + 7]);
        const bf16x8 pf = __builtin_bit_cast(bf16x8, pw);
        const bf16x8 a0 = {vt[0][s2][0][0], vt[0][s2][0][1], vt[0][s2][0][2], vt[0][s2][0][3], vt[0][s2][1][0], vt[0][s2][1][1], vt[0][s2][1][2], vt[0][s2][1][3]};
        const bf16x8 a1 = {vt[1][s2][0][0], vt[1][s2][0][1], vt[1][s2][0][2], vt[1][s2][0][3], vt[1][s2][1][0], vt[1][s2][1][1], vt[1][s2][1][2], vt[1][s2][1][3]};
        st.o0 = __builtin_amdgcn_mfma_f32_32x32x16_bf16(a0, pf, st.o0, 0, 0, 0);
        st.o1 = __builtin_amdgcn_mfma_f32_32x32x16_bf16(a1, pf, st.o1, 0, 0, 0);
    }
}
__device__ __forceinline__ void moba_unit(LAS unsigned char* lds, int unit, int tid, int l) {
    const int ob = unit & 7, h = (unit >> 3) & 7, b = unit >> 6, lane = tid & 63, wave = __builtin_amdgcn_readfirstlane(tid >> 6), r32 = lane & 31, hh = lane >> 5;
    LAS float* biasT = (LAS float*)lds;
    build_bias(biasT, 8 + h, tid);
    const bf16* PROJ = (const bf16*)(wsp() + WS_PROJ); const float* KBAR = (const float*)(wsp() + CTL_KBAR) + (size_t)l * 64 * 8 * 64 + ((b * NH + h) * 8) * 64; const LAS int* TB = (const LAS int*)(biasT + 2048);
    const int rowb = b * SEQ, qpos = 256 * ob + 32 * wave + r32;
    bf16x8 qf[4]; attn_loadq(qf, PROJ + CC_Q + 64 * h, rowb + qpos, hh);
    float gate[8];
#pragma unroll
    for (int n = 0; n < 8; ++n) { float s = 0.f;
        if (n < ob) {
#pragma unroll
            for (int s4 = 0; s4 < 4; ++s4) { const f32x4 k0 = *(const GAS f32x4*)(KBAR + n * 64 + 16 * s4 + 8 * hh), k1 = *(const GAS f32x4*)(KBAR + n * 64 + 16 * s4 + 8 * hh + 4);
                const v4u qw = __builtin_bit_cast(v4u, qf[s4]);
                s += bflo(qw.x) * k0.x + bfhi(qw.x) * k0.y + bflo(qw.y) * k0.z + bfhi(qw.y) * k0.w + bflo(qw.z) * k1.x + bfhi(qw.z) * k1.y + bflo(qw.w) * k1.z + bfhi(qw.w) * k1.w; }
            s += __shfl_xor(s, 32); }
        gate[n] = s; }
    unsigned selm = 0u;
#pragma unroll
    for (int n = 0; n < 8; ++n) { int rank = 0;
#pragma unroll
        for (int n2 = 0; n2 < 8; ++n2) rank += (n2 < ob && n2 != n && (gate[n2] > gate[n] || (gate[n2] == gate[n] && n2 < n))) ? 1 : 0;
        if (n < ob && rank < 3) selm |= 1u << n; }
    AttnSt st; attn_init(st);
    const int skey = tid >> 2, spart = tid & 3;
    const bf16* Kg = PROJ + (size_t)rowb * NPROJ_P + CC_K + 64 * h + 16 * spart; const bf16* Vg = PROJ + (size_t)rowb * NPROJ_P + CC_V + 64 * h + 16 * spart;
    bf16x8 gk0, gk1, gv0, gv1;
#define MC_GLOAD(i) do { const size_t ro_ = (size_t)(128 * (i) + skey) * NPROJ_P; gk0 = *(const GAS bf16x8*)(Kg + ro_); gk1 = *(const GAS bf16x8*)(Kg + ro_ + 8); gv0 = *(const GAS bf16x8*)(Vg + ro_); gv1 = *(const GAS bf16x8*)(Vg + ro_ + 8); } while (0)
#define MC_LSTORE(bf) do { LAS unsigned char* kd_ = lds + MC_K_OFF + (bf) * MC_KB + skey * MC_KP + 32 * spart; *(LAS bf16x8*)(kd_) = gk0; *(LAS bf16x8*)(kd_ + 16) = gk1; \
        LAS unsigned char* vd_ = lds + MC_V_OFF + (bf) * MC_VB + skey * MC_VP + 32 * spart; *(LAS bf16x8*)(vd_) = gv0; *(LAS bf16x8*)(vd_ + 16) = gv1; } while (0)
    const int nst = 2 * (ob + 1);
    MC_GLOAD(0); MC_LSTORE(0);
    __syncthreads();
    for (int i = 0; i < nst; ++i) {
        if (i + 1 < nst) MC_GLOAD(i + 1);
        const int n = i >> 1, hf = i & 1; const bool own = n == ob, sel = own || ((selm >> n) & 1u);
        const LAS unsigned char* Kb = lds + MC_K_OFF + (i & 1) * MC_KB; const LAS unsigned char* Vb = lds + MC_V_OFF + (i & 1) * MC_VB;
        if (own) {
#pragma unroll 1
            for (int sub = 0; sub < 4; ++sub) { const int jt = 4 * hf + sub; if (jt > wave) break; const int dlo = 32 * wave - (32 * jt + 31);
                if (jt == wave) moba_tile<1>(st, qf, Kb + sub * 32 * MC_KP, Vb + sub * 32 * MC_VP, biasT, TB, dlo, true, lane, r32, hh);
                else moba_tile<0>(st, qf, Kb + sub * 32 * MC_KP, Vb + sub * 32 * MC_VP, biasT, TB, dlo, true, lane, r32, hh); }
        } else if (__ballot(sel) != 0ull) {
#pragma unroll 1
            for (int sub = 0; sub < 4; ++sub) { const int dlo = 256 * ob + 32 * wave - (256 * n + 128 * hf + 32 * sub + 31);
                moba_tile<2>(st, qf, Kb + sub * 32 * MC_KP, Vb + sub * 32 * MC_VP, biasT, TB, dlo, sel, lane, r32, hh); }
        }
        if (i + 1 < nst) MC_LSTORE((i + 1) & 1);
        __syncthreads();
    }
#undef MC_GLOAD
#undef MC_LSTORE
    const float lt = st.l + __shfl_xor(st.l, 32);
    attn_store(st.o0, st.o1, 1.0f / lt, (bf16*)(wsp() + WS_YCAT) + (size_t)(rowb + qpos) * DM + 2 * GW + 64 * h, hh);
}

constexpr int MA_PITCH = 144, MA_ML_OFF = 512 * MA_PITCH, MA_BIAS_OFF = MA_ML_OFF + 512 * 8, MA_V_OFF = MA_BIAS_OFF + 16384, MA_VW = 32 * MC_VP, MA_LDS = MA_V_OFF + 8 * MA_VW;
template <bool MASKED> __device__ __forceinline__ void dil_tile(AttnSt& st, const bf16x8 (&qf)[4], const bf16x8 (&kf)[4], const LAS unsigned char* Vt, const LAS float* biasT, const LAS int* TB, int dl0, int dstep, int kb, int lane, int r32, int hh) {
    v4i16_t vt[2][2][2];
    { const LAS unsigned char* vb = Vt + (4 * hh + ((lane & 15) >> 2)) * MC_VP + (16 * ((lane >> 4) & 1) + 4 * (lane & 3)) * 2;
#pragma unroll
      for (int dh = 0; dh < 2; ++dh)
#pragma unroll
        for (int s2 = 0; s2 < 2; ++s2)
#pragma unroll
            for (int h8 = 0; h8 < 2; ++h8) vt[dh][s2][h8] = __builtin_amdgcn_ds_read_tr16_b64_v4i16((LAS v4i16_t*)(vb + (16 * s2 + 8 * h8) * MC_VP + 64 * dh)); }
    f32x16 sc;
#pragma unroll
    for (int i = 0; i < 16; ++i) sc[i] = 0.f;
#pragma unroll
    for (int s = 0; s < 4; ++s) sc = __builtin_amdgcn_mfma_f32_32x32x16_bf16(kf[s], qf[s], sc, 0, 0, 0);
    const int e0 = dl0 + r32 - 4 * hh;
    int dmin = (dl0 - 31) * dstep, dmax = (dl0 + 31) * dstep; dmin = dmin < 0 ? 0 : dmin; dmax = dmax > 2047 ? 2047 : dmax;
    const bool uni = __builtin_amdgcn_readfirstlane(TB[dmin]) == __builtin_amdgcn_readfirstlane(TB[dmax]);
    const float bu = biasT[dmin];
    float tmax = -INFINITY;
#pragma unroll
    for (int r = 0; r < 16; ++r) {
        const int kr0 = (r & 3) + 8 * (r >> 2), delta = e0 - kr0;
        float bias = bu;
        if (!uni) { int di = delta * dstep; di = di < 0 ? 0 : (di > 2047 ? 2047 : di); bias = biasT[di]; }
        float v = sc[r] * (0.125f * LOG2E) + bias;
        if (MASKED) { const bool ok = delta >= 0 && delta <= 128 && (kb + (kr0 + 4 * hh) * dstep) >= 0; v = ok ? v : -INFINITY; }
        sc[r] = v; tmax = fmaxf(tmax, v);
    }
    tmax = pl32_max(tmax);
    const float mn = fmaxf(st.m, tmax);
    if (__ballot(mn > st.m) != 0ull) { const float scale = __builtin_amdgcn_exp2f(st.m - mn); st.l *= scale;
#pragma unroll
        for (int i = 0; i < 16; ++i) { st.o0[i] *= scale; st.o1[i] *= scale; } }
    st.m = mn;
    float ls = 0.f;
#pragma unroll
    for (int r = 0; r < 16; ++r) { sc[r] = __builtin_amdgcn_exp2f(sc[r] - mn); ls += sc[r]; }
    st.l += ls;
    typedef unsigned u32x4_t __attribute__((ext_vector_type(4)));
#pragma unroll
    for (int s2 = 0; s2 < 2; ++s2) {
        u32x4_t pw; pw.x = pg8::cvt_pk_bf16(sc[8 * s2], sc[8 * s2 + 1]); pw.y = pg8::cvt_pk_bf16(sc[8 * s2 + 2], sc[8 * s2 + 3]); pw.z = pg8::cvt_pk_bf16(sc[8 * s2 + 4], sc[8 * s2 + 5]); pw.w = pg8::cvt_pk_bf16(sc[8 * s2 + 6], sc[8 * s2 + 7]);
        const bf16x8 pf = __builtin_bit_cast(bf16x8, pw);
        const bf16x8 a0 = {vt[0][s2][0][0], vt[0][s2][0][1], vt[0][s2][0][2], vt[0][s2][0][3], vt[0][s2][1][0], vt[0][s2][1][1], vt[0][s2][1][2], vt[0][s2][1][3]};
        const bf16x8 a1 = {vt[1][s2][0][0], vt[1][s2][0][1], vt[1][s2][0][2], vt[1][s2][0][3], vt[1][s2][1][0], vt[1][s2][1][1], vt[1][s2][1][2], vt[1][s2][1][3]};
        st.o0 = __builtin_amdgcn_mfma_f32_32x32x16_bf16(a0, pf, st.o0, 0, 0, 0);
        st.o1 = __builtin_amdgcn_mfma_f32_32x32x16_bf16(a1, pf, st.o1, 0, 0, 0);
    }
}
__device__ __forceinline__ void dil_unit(LAS unsigned char* lds, int unit, int tid) {
    const int sp = unit & 3, h = (unit >> 2) & 7, b = unit >> 5, lane = tid & 63, wave = __builtin_amdgcn_readfirstlane(tid >> 6), r32 = lane & 31, hh = lane >> 5;
    LAS float* biasT = (LAS float*)(lds + MA_BIAS_OFF);
    build_bias(biasT, h, tid);
    __syncthreads();
    const bf16* PROJ = (const bf16*)(wsp() + WS_PROJ); const LAS int* TB = (const LAS int*)(biasT + 2048); const int rowb = b * SEQ, t0 = 512 * sp;
    const bf16* Qc = PROJ + CA_Q + 64 * h; const bf16* Kc = PROJ + CA_K + 64 * h; const bf16* Vc = PROJ + CA_V + 64 * h;
    LAS unsigned char* Vst = lds + MA_V_OFF + wave * MA_VW;
    const int vkey = lane >> 1, vhalf = lane & 1;
#pragma unroll 1
    for (int p = 0; p < 3; ++p) {
        const int d = p == 0 ? 1 : (p == 1 ? 4 : 16);
#pragma unroll 1
        for (int gi = 0; gi < 2; ++gi) {
            const int g = 2 * wave + gi;
            const int qb = t0 + (p == 0 ? 32 * g : (p == 1 ? 128 * (g >> 2) + (g & 3) : g));
            const int qpos = qb + r32 * d, qi = qpos - t0;
            bf16x8 qf[4]; attn_loadq(qf, Qc, rowb + qpos, hh);
            AttnSt st; attn_init(st);
            int jt = 0; while (qb + (32 * jt - 128 + 31) * d < 0) ++jt;
            bf16x8 kfn[4], vrn[4];
#define MA_GLOAD(JT) do { const int kb_ = qb + (32 * (JT) - 128) * d; int kp_ = kb_ + r32 * d; kp_ = kp_ < 0 ? 0 : kp_; const bf16* kr_ = Kc + (size_t)(rowb + kp_) * NPROJ_P + 8 * hh; \
                _Pragma("unroll") for (int s = 0; s < 4; ++s) kfn[s] = *(const GAS bf16x8*)(kr_ + 16 * s); \
                int vp_ = kb_ + vkey * d; vp_ = vp_ < 0 ? 0 : vp_; const bf16* vr_ = Vc + (size_t)(rowb + vp_) * NPROJ_P + 32 * vhalf; \
                _Pragma("unroll") for (int s = 0; s < 4; ++s) vrn[s] = *(const GAS bf16x8*)(vr_ + 8 * s); } while (0)
            MA_GLOAD(jt);
#pragma unroll 1
            for (; jt < 5; ++jt) {
                bf16x8 kf[4] = {kfn[0], kfn[1], kfn[2], kfn[3]};
                { LAS unsigned char* vd = Vst + vkey * MC_VP + 64 * vhalf;
#pragma unroll
                  for (int s = 0; s < 4; ++s) *(LAS bf16x8*)(vd + 16 * s) = vrn[s]; }
                asm volatile("" ::: "memory");
                if (jt + 1 < 5) MA_GLOAD(jt + 1);
                const int kb = qb + (32 * jt - 128) * d, dl0 = 128 - 32 * jt;
                if (jt == 0 || jt == 4 || kb < 0) dil_tile<true>(st, qf, kf, Vst, biasT, TB, dl0, d, kb, lane, r32, hh);
                else dil_tile<false>(st, qf, kf, Vst, biasT, TB, dl0, d, kb, lane, r32, hh);
            }
#undef MA_GLOAD
            float lt = st.l + __shfl_xor(st.l, 32);
            LAS unsigned char* orow = lds + qi * MA_PITCH; LAS float* ml = (LAS float*)(lds + MA_ML_OFF + qi * 8);
            if (p > 0) {
                const float mo = ml[0], lo = ml[1], mn = fmaxf(mo, st.m), fo = __builtin_amdgcn_exp2f(mo - mn), fc = __builtin_amdgcn_exp2f(st.m - mn);
                lt = lo * fo + lt * fc;
#pragma unroll
                for (int g4 = 0; g4 < 4; ++g4) { const v2u a = *(const LAS v2u*)(orow + 2 * (8 * g4 + 4 * hh)), c = *(const LAS v2u*)(orow + 64 + 2 * (8 * g4 + 4 * hh));
                    const float av[4] = {bflo(a.x), bfhi(a.x), bflo(a.y), bfhi(a.y)}, cv[4] = {bflo(c.x), bfhi(c.x), bflo(c.y), bfhi(c.y)};
#pragma unroll
                    for (int e = 0; e < 4; ++e) { st.o0[4 * g4 + e] = av[e] * fo + st.o0[4 * g4 + e] * fc; st.o1[4 * g4 + e] = cv[e] * fo + st.o1[4 * g4 + e] * fc; } }
                st.m = mn;
            }
            if (p < 2) {
#pragma unroll
                for (int g4 = 0; g4 < 4; ++g4) { *(LAS v2u*)(orow + 2 * (8 * g4 + 4 * hh)) = (v2u){pk2(st.o0[4 * g4], st.o0[4 * g4 + 1]), pk2(st.o0[4 * g4 + 2], st.o0[4 * g4 + 3])};
                    *(LAS v2u*)(orow + 64 + 2 * (8 * g4 + 4 * hh)) = (v2u){pk2(st.o1[4 * g4], st.o1[4 * g4 + 1]), pk2(st.o1[4 * g4 + 2], st.o1[4 * g4 + 3])}; }
                if (hh == 0) { ml[0] = st.m; ml[1] = lt; }
            } else attn_store(st.o0, st.o1, 1.0f / lt, (bf16*)(wsp() + WS_YCAT) + (size_t)(rowb + qpos) * DM + 0 * GW + 64 * h, hh);
        }
        __syncthreads();
    }
}

constexpr int SG_PITCH = 144, SG_WAVE = 128 * SG_PITCH, SG_OP = 272;
static_assert(8 * SG_WAVE <= MISC_OFF && 32 * SG_OP <= SG_WAVE, "SGU LDS");
__device__ __forceinline__ void sgu_unit(LAS unsigned char* lds, int unit, int tid, int l) {
    const int lane = tid & 63, g = __builtin_amdgcn_readfirstlane(tid >> 6), r32 = lane & 31, hh = lane >> 5, m0 = unit * 128;
    const bf16* PROJ = (const bf16*)(wsp() + WS_PROJ); bf16* YC = (bf16*)(wsp() + WS_YCAT); const pg8::fx_t* ST = (const pg8::fx_t*)(wsp() + CTL_STATS) + (size_t)l * M * 2;
    const float* lng = inp(4) + l * GW; const float* sw = inp(5) + ((size_t)l * NH + g) * 128 * 128; const float* sb = inp(6) + (l * NH + g) * 128;
    LAS unsigned char* T = lds + g * SG_WAVE;
    const int tk8 = lane >> 3, part = lane & 7;
    { const f32x4 g0 = *(const GAS f32x4*)(lng + 64 * g + 8 * part), g1 = *(const GAS f32x4*)(lng + 64 * g + 8 * part + 4);
      const float gn[8] = {g0.x, g0.y, g0.z, g0.w, g1.x, g1.y, g1.z, g1.w};
#pragma unroll 4
      for (int i = 0; i < 16; ++i) { const int tkn = tk8 + 8 * i, mm = m0 + tkn;
          const v4u w = *(const GAS v4u*)(PROJ + (size_t)mm * NPROJ_P + CB_V + 64 * g + 8 * part);
          const float mu = pg8::fx_get(ST + 2 * mm) * (1.0f / 512.0f), rs = __builtin_amdgcn_rsqf(fmaxf(pg8::fx_get(ST + 2 * mm + 1) * (1.0f / 512.0f) - mu * mu, 0.f) + 1e-5f);
          float x[8] = {bflo(w.x), bfhi(w.x), bflo(w.y), bfhi(w.y), bflo(w.z), bfhi(w.z), bflo(w.w), bfhi(w.w)};
#pragma unroll
          for (int e = 0; e < 8; ++e) x[e] = (gelu_tanh(x[e]) - mu) * rs * gn[e];
          *(LAS v4u*)(T + tkn * SG_PITCH + 16 * part) = (v4u){pk2(x[0], x[1]), pk2(x[2], x[3]), pk2(x[4], x[5]), pk2(x[6], x[7])}; } }
    asm volatile("" ::: "memory");
    f32x16 acc[4][2];
    const float z_ = zero_v();
#pragma unroll
    for (int tt = 0; tt < 4; ++tt)
#pragma unroll
        for (int ct = 0; ct < 2; ++ct)
#pragma unroll
            for (int i = 0; i < 16; ++i) acc[tt][ct][i] = z_;
    const LAS unsigned char* vb = T + (8 * hh + ((lane & 15) >> 2)) * SG_PITCH + (16 * ((lane >> 4) & 1) + 4 * (lane & 3)) * 2;
#pragma unroll
    for (int k = 0; k < 8; ++k) {
        v4i16_t t00 = __builtin_amdgcn_ds_read_tr16_b64_v4i16((LAS v4i16_t*)(vb + (16 * k) * SG_PITCH)), t01 = __builtin_amdgcn_ds_read_tr16_b64_v4i16((LAS v4i16_t*)(vb + (16 * k + 4) * SG_PITCH));
        v4i16_t t10 = __builtin_amdgcn_ds_read_tr16_b64_v4i16((LAS v4i16_t*)(vb + (16 * k) * SG_PITCH + 64)), t11 = __builtin_amdgcn_ds_read_tr16_b64_v4i16((LAS v4i16_t*)(vb + (16 * k + 4) * SG_PITCH + 64));
        const bf16x8 af0 = {t00[0], t00[1], t00[2], t00[3], t01[0], t01[1], t01[2], t01[3]}, af1 = {t10[0], t10[1], t10[2], t10[3], t11[0], t11[1], t11[2], t11[3]};
#pragma unroll
        for (int tt = 0; tt < 4; ++tt) { if (k < 2 * (tt + 1)) {
                const int t = 32 * tt + r32, s0 = 16 * k + 8 * hh; const float* wrow = sw + (size_t)t * 128 + s0;
                const f32x4 w0 = *(const GAS f32x4*)(wrow), w1 = *(const GAS f32x4*)(wrow + 4);
                float wv[8] = {w0.x, w0.y, w0.z, w0.w, w1.x, w1.y, w1.z, w1.w};
#pragma unroll
                for (int j = 0; j < 8; ++j) wv[j] = (s0 + j <= t) ? wv[j] : 0.f;
                const v4u bw = {pk2(wv[0], wv[1]), pk2(wv[2], wv[3]), pk2(wv[4], wv[5]), pk2(wv[6], wv[7])}; const bf16x8 bfr = __builtin_bit_cast(bf16x8, bw);
                acc[tt][0] = __builtin_amdgcn_mfma_f32_32x32x16_bf16(af0, bfr, acc[tt][0], 0, 0, 0); acc[tt][1] = __builtin_amdgcn_mfma_f32_32x32x16_bf16(af1, bfr, acc[tt][1], 0, 0, 0); } }
    }
    asm volatile("" ::: "memory");
#pragma unroll
    for (int tt = 0; tt < 4; ++tt) {
        const float bias = sb[32 * tt + r32];
#pragma unroll
        for (int ct = 0; ct < 2; ++ct)
#pragma unroll
            for (int g4 = 0; g4 < 4; ++g4) { const f32x16& a = acc[tt][ct];
                *(LAS f32x4*)(T + r32 * SG_OP + 4 * (32 * ct + 8 * g4 + 4 * hh)) = (f32x4){a[4 * g4] + bias, a[4 * g4 + 1] + bias, a[4 * g4 + 2] + bias, a[4 * g4 + 3] + bias}; }
        asm volatile("" ::: "memory");
#pragma unroll
        for (int i = 0; i < 4; ++i) { const int tkn = tk8 + 8 * i, mm = m0 + 32 * tt + tkn;
            const v4u uw = *(const GAS v4u*)(PROJ + (size_t)mm * NPROJ_P + CB_U + 64 * g + 8 * part);
            const f32x4 x0 = *(const LAS f32x4*)(T + tkn * SG_OP + 32 * part), x1 = *(const LAS f32x4*)(T + tkn * SG_OP + 32 * part + 16);
            const float u[8] = {bflo(uw.x), bfhi(uw.x), bflo(uw.y), bfhi(uw.y), bflo(uw.z), bfhi(uw.z), bflo(uw.w), bfhi(uw.w)};
            *(GAS v4u*)(YC + (size_t)mm * DM + GW + 64 * g + 8 * part) = (v4u){pk2(gelu_tanh(u[0]) * x0.x, gelu_tanh(u[1]) * x0.y), pk2(gelu_tanh(u[2]) * x0.z, gelu_tanh(u[3]) * x0.w), pk2(gelu_tanh(u[4]) * x1.x, gelu_tanh(u[5]) * x1.y), pk2(gelu_tanh(u[6]) * x1.z, gelu_tanh(u[7]) * x1.w)}; }
        asm volatile("" ::: "memory");
    }
}

#ifndef SIMPLE_A
#define SIMPLE_A 0
#endif
#ifndef SIMPLE_B
#define SIMPLE_B 0
#endif
#ifndef SIMPLE_C
#define SIMPLE_C 0
#endif
#ifndef SIMPLE_D
#define SIMPLE_D 0
#endif
__device__ __forceinline__ void ph_mixers(LAS unsigned char* L, int l, int phase, int qoff, int wv, int mask = 31) {
    Frame F = mkframe(L, wv);
    volatile LAS int* qslot = (volatile LAS int*)(L + MISC_OFF + 64);
    gu32* ctr = ctlp() + CW_Q + 64 * phase + qoff;
    constexpr int I_IN = (DM / 64) * (NPROJ / 32), I_REST = (I8_OUT ? 0 : (DM / 64) * (DM / 32)) + (FFN1_I8 ? 0 : 2 * (DM / 64) * (DFF / 32)) + (DFF / 64) * (DM / 32);
    const int n_scan = (SIMPLE_D || !(mask & 1)) ? 0 : 128, n_c = (SIMPLE_C || !(mask & 2)) ? 0 : 512, n_a = (SIMPLE_A || !(mask & 4)) ? 0 : 256, n_b = (SIMPLE_B || !(mask & 8)) ? 0 : 128;
    const int n_cin = ((l + 1 < DEPTH) && (mask & 16)) ? (I8_IN ? NPROJ / 32 + (WINB_ITEMS + 7) / 8 : (I_IN + 7) / 8) : 0, n_crest = (mask & 16) ? (I_REST + 7) / 8 : 0, n_cout = ((I8_OUT && (mask & 16)) ? DM / 32 : 0) + ((FFN1_I8 && (mask & 16)) ? 2 * (DFF / 32) : 0);
    const int e_scan = n_scan, e_a = e_scan + n_a, e_b = e_a + n_b, e_c = e_b + n_c, e_cout = e_c + n_cout, e_cin = e_cout + n_cin, e_crest = e_cin + n_crest;
    for (;;) {
        if (F.tid == 0) *qslot = (int)__hip_atomic_fetch_add(ctr, 1u, RLX_AGENT);
        __syncthreads();
        const int it = __builtin_amdgcn_readfirstlane(*qslot);
        __syncthreads();
        if (it >= e_crest) break;
        int tid = wv * 64 + pg8::lane_now(); asm volatile("" : "+v"(tid));
        if (it < e_scan) scan_unit(L, it, tid);
        else if (it < e_a) dil_unit(L, it - e_scan, tid);
        else if (it < e_b) { sgu_unit(L, it - e_a, tid, l); __syncthreads(); }
        else if (it < e_c) { const int i2 = it - e_b; moba_unit(L, (i2 & 63) * 8 + (7 - (i2 >> 6)), tid, l); }
        else if (it < e_cout) { Frame F2 = mkframe(L, wv); int r = it - e_c;
            if (I8_OUT && r < DM / 32) conv_cols_i8(inp(19) + (size_t)l * DM * DM, DM, DM, inp(18) + l * DM, wsp() + WS_WOUT, (float*)(wsp() + WS_SMALL + SM_SWOUT), r, F2);
            else { r -= I8_OUT ? DM / 32 : 0; const int up = r >= DFF / 32 ? 1 : 0, nb = r - up * (DFF / 32), n0 = 32 * nb;
                conv_cols_i8(inp(up ? 22 : 21) + (size_t)l * DM * DFF, DM, DFF, inp(20) + l * DM, wsp() + WS_WGU, (float*)(wsp() + WS_SMALL + SM_SWGU), nb, F2, (n0 >> 7) * 256 + up * 128 + (n0 & 127)); } }
        else if (it < e_cin) { Frame F2 = mkframe(L, wv);
            if (I8_IN) { if (it - e_cout < NPROJ / 32) conv_cols_i8(inp(2) + (size_t)(l + 1) * DM * NPROJ, DM, NPROJ, inp(1) + (l + 1) * DM, wsp() + WS_WIN, (float*)(wsp() + WS_SMALL + SM_SWIN), it - e_cout, F2);
                else conv_winb(F2, l + 1, (it - e_cout - NPROJ / 32) * 8 + F2.wave); }
            else conv_layer_items(F2, l + 1, (it - e_cout) * 8 + F2.wave, 1 << 30, true, false); }
        else { Frame F2 = mkframe(L, wv); conv_layer_items(F2, l, (it - e_cin) * 8 + F2.wave, 1 << 30, false, true); }
    }
    if (!I8_IN && l + 1 < DEPTH) {
        bf16* WIN = (bf16*)(wsp() + WS_WIN);
        Frame F3 = mkframe(L, wv);
        for (int i = F3.gw * 64 + F3.lane; i < 64 * DM / 8; i += F3.ngw * 64) { v4u z = {0u, 0u, 0u, 0u}; asm volatile("" : "+v"(z)); *(GAS v4u*)(WIN + (size_t)NPROJ * DM + (size_t)i * 8) = z; }
    }
    if (SIMPLE_D) mix_d_simple(F);
    if (SIMPLE_A) mix_a_simple(F);
    if (SIMPLE_C) mix_c_simple(F, l);
    if (SIMPLE_B) mix_b_simple(F, l);
}

__device__ __forceinline__ void ph_finalize(Frame& F, int l) {
    bf16* YC = (bf16*)(wsp() + WS_YCAT); const float* YD = (const float*)(wsp() + WS_YD); const bf16* V_ = (const bf16*)outp() + (size_t)3 * M * GW; const bf16* G_ = (const bf16*)(wsp() + WS_G); const float* BC = (const float*)(wsp() + WS_BC);
    const float* lng = inp(16) + l * GW; const float* lnb = inp(17) + l * GW;
    for (int m = F.gw; m < M; m += F.ngw) {
        const int c0 = 8 * F.lane, hd = F.lane >> 3;
        float y[8];
        { const GAS f32x4* yp = (const GAS f32x4*)(YD + (size_t)m * GW + c0); const f32x4 a = yp[0], b = yp[1]; y[0] = a.x; y[1] = a.y; y[2] = a.z; y[3] = a.w; y[4] = b.x; y[5] = b.y; y[6] = b.z; y[7] = b.w; }
        float s = 0.f;
#pragma unroll
        for (int i = 0; i < 8; ++i) s += y[i];
        s += __shfl_xor(s, 1); s += __shfl_xor(s, 2); s += __shfl_xor(s, 4); const float mean = s * (1.0f / 64.0f); float q = 0.f;
#pragma unroll
        for (int i = 0; i < 8; ++i) { const float d = y[i] - mean; q += d * d; }
        q += __shfl_xor(q, 1); q += __shfl_xor(q, 2); q += __shfl_xor(q, 4); const float rstd = 1.0f / sqrtf(q * (1.0f / 64.0f) + 64e-5f);
        const v4u vw = *(const GAS v4u*)(V_ + (size_t)m * GW + c0), gw4 = *(const GAS v4u*)(G_ + (size_t)m * GW + c0); const float bc = BC[(size_t)m * NH + hd];
        float vv[8], gg[8]; UNPACK8(vv, 0, vw); UNPACK8(gg, 0, gw4);
        float ss = 0.f;
#pragma unroll
        for (int i = 0; i < 8; ++i) { y[i] = ((y[i] - mean) * rstd * lng[c0 + i] + lnb[c0 + i] + bc * vv[i]) * gg[i]; ss += y[i] * y[i]; }
        if (I8_OUT) {
            float xn[3][8], mx = 0.f;
            { const float rs = 1.0f / sqrtf(wave_sum(ss) * (1.0f / 512.0f) + NORM_EPS);
#pragma unroll
              for (int i = 0; i < 8; ++i) { y[i] *= rs; mx = fmaxf(mx, fabsf(y[i])); } }
#pragma unroll
            for (int br = 0; br < 3; ++br) {
                const v4u w = *(const GAS v4u*)(YC + (size_t)m * DM + br * GW + c0); UNPACK8(xn[br], 0, w); float s2 = 0.f;
#pragma unroll
                for (int i = 0; i < 8; ++i) s2 += xn[br][i] * xn[br][i];
                const float rs = 1.0f / sqrtf(wave_sum(s2) * (1.0f / 512.0f) + NORM_EPS);
#pragma unroll
                for (int i = 0; i < 8; ++i) { xn[br][i] *= rs; mx = fmaxf(mx, fabsf(xn[br][i])); }
            }
            mx = wave_max(mx); const float inv = mx > 0.f ? 127.0f / mx : 0.f; unsigned char* yq = wsp() + WS_YQ + (size_t)m * DM + c0;
#pragma unroll
            for (int br = 0; br < 3; ++br) *(GAS v2u*)(yq + br * GW) = (v2u){q8pack4(xn[br][0], xn[br][1], xn[br][2], xn[br][3], inv), q8pack4(xn[br][4], xn[br][5], xn[br][6], xn[br][7], inv)};
            *(GAS v2u*)(yq + 3 * GW) = (v2u){q8pack4(y[0], y[1], y[2], y[3], inv), q8pack4(y[4], y[5], y[6], y[7], inv)};
            if (F.lane == 0) ((float*)(wsp() + WS_SMALL + SM_SAY))[m] = mx * (1.0f / 127.0f);
            continue;
        }
        { const float rs = 1.0f / sqrtf(wave_sum(ss) * (1.0f / 512.0f) + NORM_EPS);
          *(GAS v4u*)(YC + (size_t)m * DM + 3 * GW + c0) = (v4u){pk2(y[0] * rs, y[1] * rs), pk2(y[2] * rs, y[3] * rs), pk2(y[4] * rs, y[5] * rs), pk2(y[6] * rs, y[7] * rs)}; }
#pragma unroll
        for (int br = 0; br < 3; ++br) {
            GAS v4u* p = (GAS v4u*)(YC + (size_t)m * DM + br * GW + c0); const v4u w = *p;
            float x[8]; UNPACK8(x, 0, w); float s2 = 0.f;
#pragma unroll
            for (int i = 0; i < 8; ++i) s2 += x[i] * x[i];
            const float rs = 1.0f / sqrtf(wave_sum(s2) * (1.0f / 512.0f) + NORM_EPS);
            *p = (v4u){pk2(x[0] * rs, x[1] * rs), pk2(x[2] * rs, x[3] * rs), pk2(x[4] * rs, x[5] * rs), pk2(x[6] * rs, x[7] * rs)};
        }
    }
}
__device__ __forceinline__ void ph_final(Frame& F) {
    const pg8::fx_t* ssq = (const pg8::fx_t*)(ctlp() + CW_SSQ) + 4 * M; const float* g = inp(24); float* out = outp(); const bf16* XB = (const bf16*)(wsp() + WS_XB);
    for (int m = F.gw; m < M; m += F.ngw) {
        const float rs = 1.0f / sqrtf(pg8::fx_get(ssq + m) * (1.0f / 2048.0f) + NORM_EPS); GAS f32x4* orow = (GAS f32x4*)(out + (size_t)m * DM); const GAS v4u* xr = (const GAS v4u*)(XB + (size_t)m * DM) + F.lane; const GAS f32x4* gp = (const GAS f32x4*)g;
#pragma unroll
        for (int j = 0; j < 4; ++j) { const v4u w = xr[64 * j]; const int c4 = 2 * (F.lane + 64 * j); const f32x4 g0 = gp[c4], g1 = gp[c4 + 1];
            orow[c4] = (f32x4){bflo(w.x) * rs * g0.x, bfhi(w.x) * rs * g0.y, bflo(w.y) * rs * g0.z, bfhi(w.y) * rs * g0.w};
            orow[c4 + 1] = (f32x4){bflo(w.z) * rs * g1.x, bfhi(w.z) * rs * g1.y, bflo(w.w) * rs * g1.z, bfhi(w.w) * rs * g1.w}; }
    }
}

#ifndef STAG
#define STAG 500
#endif
__device__ __forceinline__ void phase_stagger(int ticks) {
    const int grp = ((int)blockIdx.x >> 3) & 3;
    if (ticks > 0 && grp > 0) { const unsigned long long t0 = __builtin_amdgcn_s_memrealtime(); while ((long long)(__builtin_amdgcn_s_memrealtime() - t0) < (long long)grp * ticks) __builtin_amdgcn_s_sleep(32); }
}
__global__ void __launch_bounds__(NTHR, 2) hy_fwd(Args args) {
    extern __shared__ __attribute__((aligned(16))) unsigned char lds[];
    LAS unsigned char* L = (LAS unsigned char*)lds;
    volatile LAS unsigned* MISC = (volatile LAS unsigned*)(L + MISC_OFF);
    const int wv = __builtin_amdgcn_readfirstlane((int)threadIdx.x >> 6);
    if (wv == 0) MISC[pg8::lane_now()] = 0u;
    __syncthreads();
    XcdBarrier bar; bar.bar = (unsigned*)(ctlp() + CW_BAR); bar.x = 0; bar.st = nullptr; bar.wv = wv;
    if (N_LAUNCH_MODE == 0) bar = xcd_barrier_post((unsigned*)(ctlp() + CW_BAR), MISC + 8, wv);
    const int lo = args.ph_lo, hi = args.ph_hi;
#define IN(k) (lo <= (k) && (k) < hi)
#define SEAM(k) do { if (IN(k) && IN((k) + 1)) xcd_barrier(bar); } while (0)
    if (IN(0)) { Frame F = mkframe(L, wv); ph_prologue(F); if (REPEAT == 1) ph_prologue(F); }
    SEAM(0);
    auto layer = [&](const int l) __attribute__((always_inline)) {
        const int P = 1 + 9 * l;
        if (IN(P)) { phase_stagger(STAG);
            unsigned char* ws = wsp(); pg8::Gemm g{(const bf16*)(ws + WS_XB), (const bf16*)(ws + WS_WIN), M, NPROJ_P, DM, wv}; pg8::StaticOrder S; S.init(M, NPROJ_P, gridDim.x, (int)blockIdx.x);
            pg8::EpiProj E{(bf16*)(ws + WS_PROJ), NPROJ_P, (const pg8::fx_t*)((gu32*)ws + CW_SSQ) + (size_t)(2 * l) * M, (float*)(ws + CTL_KBAR) + (size_t)l * 64 * 8 * 64, (pg8::fx_t*)(ws + CTL_STATS) + (size_t)l * M * 2,
                           (const float*)(ws + WS_SMALL + SM_SAX), (const float*)(ws + WS_SMALL + SM_SWIN)};
            if (I8_IN) { g.A = (const bf16*)(ws + WS_XQ); pg8::MaskOrder S1; S1.init(M, 0xFFFFFFu & ~BFMASK, gridDim.x, (int)blockIdx.x);
                pg8::gemm_phase<pg8::EpiProj, pg8::MaskOrder, true, PG8_SP2, 1>(L + RING_OFF, g, S1, E);
                if (BFMASK) { pg8::Gemm gb{(const bf16*)(ws + WS_XB), winb_ptr(), M, NPROJ_P, DM, wv}; pg8::MaskOrder S2; S2.init(M, BFMASK, gridDim.x, (int)blockIdx.x);
                    pg8::gemm_phase<pg8::EpiProj, pg8::MaskOrder, true, PG8_SP2>(L + RING_OFF, gb, S2, E); } }
            else pg8::gemm_phase<pg8::EpiProj, pg8::StaticOrder, true, PG8_SP2>(L + RING_OFF, g, S, E);
            if (REPEAT == 21) { pg8::EpiNull E0{(float*)(ws + WS_YCAT)}; pg8::MaskOrder S1; S1.init(M, 0xFFFFFFu, gridDim.x, (int)blockIdx.x); pg8::gemm_phase<pg8::EpiNull, pg8::MaskOrder, true, PG8_SP2, 1>(L + RING_OFF, g, S1, E0); }
            if (REPEAT == 23) { pg8::EpiProjDense E3{(bf16*)(ws + WS_YCAT), E.ssq, E.sa, E.sw}; pg8::MaskOrder S1; S1.init(M, 0xFFFFFFu, gridDim.x, (int)blockIdx.x); pg8::gemm_phase<pg8::EpiProjDense, pg8::MaskOrder, true, PG8_SP2, 1>(L + RING_OFF, g, S1, E3); }
            if (REPEAT == 22) { pg8::EpiProj E2 = E; E2.kbar = (float*)(ws + WS_YCAT + 32 * MiB); E2.stats = (pg8::fx_t*)(ws + WS_YCAT + 40 * MiB); E2.O = (bf16*)(ws + WS_YCAT); E2.ldc = 256;
                pg8::MaskOrder S1; S1.init(M, 0xFFFFFFu, gridDim.x, (int)blockIdx.x); pg8::gemm_phase<pg8::EpiProj, pg8::MaskOrder, true, PG8_SP2, 1>(L + RING_OFF, g, S1, E2); }
            if (REPEAT == 2) { pg8::EpiProj E2 = E; E2.kbar = (float*)(ws + WS_YCAT); E2.stats = (pg8::fx_t*)(ws + WS_YCAT + 8 * MiB);
                if (I8_IN) { pg8::MaskOrder S1; S1.init(M, 0xFFFFFFu & ~BFMASK, gridDim.x, (int)blockIdx.x); pg8::gemm_phase<pg8::EpiProj, pg8::MaskOrder, true, PG8_SP2, 1>(L + RING_OFF, g, S1, E2);
                    if (BFMASK) { pg8::Gemm gb{(const bf16*)(ws + WS_XB), winb_ptr(), M, NPROJ_P, DM, wv}; pg8::MaskOrder S2; S2.init(M, BFMASK, gridDim.x, (int)blockIdx.x); pg8::gemm_phase<pg8::EpiProj, pg8::MaskOrder, true, PG8_SP2>(L + RING_OFF, gb, S2, E2); } }
                else pg8::gemm_phase<pg8::EpiProj, pg8::StaticOrder, true, PG8_SP2>(L + RING_OFF, g, S, E2); }
        }
        SEAM(P);
        if (IN(P + 1)) { Frame F = mkframe(L, wv); ph_prep(F, l); if (REPEAT == 3) ph_prep(F, l); }
        SEAM(P + 1);
        if (IN(P + 2)) { ph_mixers(L, l, P + 2, 0, wv); if (REPEAT == 4) ph_mixers(L, l, P + 2, 32, wv); if (REPEAT >= 40 && REPEAT < 50) ph_mixers(L, l, P + 2, 32, wv, REPEAT == 41 ? 1 : (REPEAT == 42 ? 2 : (REPEAT == 43 ? 4 : (REPEAT == 44 ? 8 : 16)))); if (REPEAT >= 430 && REPEAT < 446) ph_mixers(L, l, P + 2, 32, wv, 4); }
        SEAM(P + 2);
        if (IN(P + 3)) { Frame F = mkframe(L, wv); ph_finalize(F, l); if (REPEAT == 5) ph_finalize(F, l); }
        SEAM(P + 3);
        if (IN(P + 4)) { phase_stagger(STAG);
            unsigned char* ws = wsp(); pg8::Gemm g{(const bf16*)(ws + WS_YCAT), (const bf16*)(ws + WS_WOUT), M, DM, DM, wv}; pg8::StaticOrder S; S.init(M, DM, gridDim.x, (int)blockIdx.x);
            pg8::EpiRes E{(bf16*)(ws + WS_XB), (pg8::fx_t*)((gu32*)ws + CW_SSQ) + (size_t)(2 * l + 1) * M, DM, (FFN_FP8 && !FFN1_I8) ? (unsigned char*)(ws + WS_SC2) : nullptr, 1.0f, (const float*)(ws + WS_SMALL + SM_SAY), (const float*)(ws + WS_SMALL + SM_SWOUT)};
            if (I8_OUT) { g.A = (const bf16*)(ws + WS_YQ); pg8::gemm_phase<pg8::EpiRes, pg8::StaticOrder, true, PG8_SP2, 1>(L + RING_OFF, g, S, E); }
            else pg8::gemm_phase<pg8::EpiRes, pg8::StaticOrder, true, PG8_SP2>(L + RING_OFF, g, S, E);
            if (REPEAT == 7) { pg8::EpiRes E2 = E; E2.xb = (bf16*)(ws + WS_YCAT); E2.ssq = (pg8::fx_t*)(ws + WS_G); E2.xf = (unsigned char*)(ws + WS_YD);
                if (I8_OUT) pg8::gemm_phase<pg8::EpiRes, pg8::StaticOrder, true, PG8_SP2, 1>(L + RING_OFF, g, S, E2); else pg8::gemm_phase<pg8::EpiRes, pg8::StaticOrder, true, PG8_SP2>(L + RING_OFF, g, S, E2); }
        }
        SEAM(P + 4);
        if (FFN1_I8) { if (IN(P + 5)) { Frame F = mkframe(L, wv); ph_quantx(F); } SEAM(P + 5); }
        if (IN(P + 6)) {
            unsigned char* ws = wsp(); pg8::Gemm g{(const bf16*)(ws + (FFN1_I8 ? WS_XQ : (FFN_FP8 ? WS_SC2 : WS_XB))), (const bf16*)(ws + WS_WGU), M, 2 * DFF, DM, wv}; pg8::StaticOrder S; S.init(M, 2 * DFF, gridDim.x, (int)blockIdx.x);
            if (FFN_FP8) { pg8::EpiGU8 E{(unsigned char*)(ws + WS_PROJ), DFF, (const pg8::fx_t*)((gu32*)ws + CW_SSQ) + (size_t)(2 * l + 1) * M, FFN1_I8 ? 1.0f : 1.0f / 64.0f, 8.0f, (const float*)(ws + WS_SMALL + SM_SAX), (const float*)(ws + WS_SMALL + SM_SWGU)};
                if (FFN1_I8) pg8::gemm_phase<pg8::EpiGU8, pg8::StaticOrder, true, PG8_SP2, 1>(L + RING_OFF, g, S, E);
                else pg8::gemm_phase_f8<pg8::EpiGU8, pg8::StaticOrder, true, PG8_SP2>(L + RING_OFF, g, S, E);
                if (REPEAT == 6) { if (FFN1_I8) pg8::gemm_phase<pg8::EpiGU8, pg8::StaticOrder, true, PG8_SP2, 1>(L + RING_OFF, g, S, E); else pg8::gemm_phase_f8<pg8::EpiGU8, pg8::StaticOrder, true, PG8_SP2>(L + RING_OFF, g, S, E); }
            } else { pg8::EpiGU E{(bf16*)(ws + WS_PROJ), DFF, (const pg8::fx_t*)((gu32*)ws + CW_SSQ) + (size_t)(2 * l + 1) * M, 1.0f};
                pg8::gemm_phase<pg8::EpiGU, pg8::StaticOrder, true, PG8_SP2>(L + RING_OFF, g, S, E);
                if (REPEAT == 6) pg8::gemm_phase<pg8::EpiGU, pg8::StaticOrder, true, PG8_SP2>(L + RING_OFF, g, S, E); }
        }
        SEAM(P + 6);
        if (IN(P + 7)) { phase_stagger(STAG);
            unsigned char* ws = wsp(); pg8::Gemm g{(const bf16*)(ws + WS_PROJ), (const bf16*)(ws + WS_WDN), M, DM, DFF, wv}; pg8::StaticOrder S; S.init(M, DM, gridDim.x, (int)blockIdx.x);
            pg8::EpiRes E{(bf16*)(ws + WS_XB), (pg8::fx_t*)((gu32*)ws + CW_SSQ) + (size_t)(2 * l + 2) * M, DM, nullptr, FFN_FP8 ? 1.0f / 512.0f : 1.0f, nullptr, nullptr};
            if (FFN_FP8) pg8::gemm_phase_f8<pg8::EpiRes, pg8::StaticOrder, true, PG8_SP2>(L + RING_OFF, g, S, E);
            else pg8::gemm_phase<pg8::EpiRes, pg8::StaticOrder, true, PG8_SP2>(L + RING_OFF, g, S, E);
            if (REPEAT == 8) { pg8::EpiRes E2 = E; E2.xb = (bf16*)(ws + WS_YCAT); E2.ssq = (pg8::fx_t*)(ws + WS_G);
                if (FFN_FP8) pg8::gemm_phase_f8<pg8::EpiRes, pg8::StaticOrder, true, PG8_SP2>(L + RING_OFF, g, S, E2); else pg8::gemm_phase<pg8::EpiRes, pg8::StaticOrder, true, PG8_SP2>(L + RING_OFF, g, S, E2); }
        }
        SEAM(P + 7);
        if (l + 1 < DEPTH) { if (I8_IN && IN(P + 8)) { Frame F = mkframe(L, wv); ph_quantx(F); } if (I8_IN) SEAM(P + 8); }
    };
    static_assert(DEPTH == 2, "layers are expanded by hand");
    layer(0); layer(1);
    if (IN(19)) { Frame F = mkframe(L, wv); ph_final(F); }
#undef IN
#undef SEAM
}

extern "C" void kernel_launch(void* const* d_in, const int* in_sizes, int n_in, void* d_out, int out_size, void* d_ws, size_t ws_size, hipStream_t stream) {
    static int grid = 0;
    if (grid == 0) {
        if (n_in != 25 || in_sizes[0] != M * DM || out_size != M * DM || ws_size < WS_END) { fprintf(stderr, "kernel_launch: shape/workspace mismatch: n_in %d in0 %d out %d ws %zu (need %zu)\n", n_in, n_in > 0 ? in_sizes[0] : -1, out_size, ws_size, (size_t)WS_END); grid = -1; return; }
        int dev = 0, cus = 0, per_cu = 0;
        if (hipGetDevice(&dev) != hipSuccess || hipDeviceGetAttribute(&cus, hipDeviceAttributeMultiprocessorCount, dev) != hipSuccess) { grid = -1; return; }
        if (hipFuncSetAttribute((const void*)hy_fwd, hipFuncAttributeMaxDynamicSharedMemorySize, LDS_BYTES) != hipSuccess) { fprintf(stderr, "kernel_launch: hipFuncSetAttribute failed\n"); grid = -1; return; }
        if (hipOccupancyMaxActiveBlocksPerMultiprocessor(&per_cu, (const void*)hy_fwd, NTHR, LDS_BYTES) != hipSuccess || per_cu < 1) fprintf(stderr, "kernel_launch: occupancy query reports %d\n", per_cu);
        (void)hipGetLastError();
        grid = cus;
    }
    if (grid < 0) return;
    if (hipMemsetAsync((char*)d_ws + WS_CTL, 0, CTL_ZERO_BYTES, stream) != hipSuccess) return;
    Args a{};
    for (int i = 0; i < 25; ++i) a.in[i] = (const float*)d_in[i];
    a.out = (float*)d_out; a.ws = (unsigned char*)d_ws;
    if (N_LAUNCH_MODE == 0) { a.ph_lo = 0; a.ph_hi = N_PHASES; hipLaunchKernelGGL(hy_fwd, dim3(grid), dim3(NTHR), LDS_BYTES, stream, a); }
    else for (int p = 0; p < N_PHASES; ++p) { a.ph_lo = p; a.ph_hi = p + 1; hipLaunchKernelGGL(hy_fwd, dim3(grid), dim3(NTHR), LDS_BYTES, stream, a); }
}
```

```cpp
#define N_LAUNCH_MODE 0
#define REPEAT 0
#define PG8_SP2 true
#define FFN_FP8 1
#define GEMM_I8 3
#define STAG 0
#define FFN1_I8 1
#define BFMASK 0x0u
#include <hip/hip_runtime.h>
#include <cstdio>
#include <cstdint>
namespace pg8 {
#define PG8_LAS __attribute__((address_space(3)))
typedef unsigned short bf16_t;
typedef short bf16x8 __attribute__((ext_vector_type(8)));
typedef float f32x4 __attribute__((ext_vector_type(4)));
typedef unsigned u32x4 __attribute__((ext_vector_type(4)));
constexpr int BM = 256, BK = 64, HALF = 128, HTB = HALF * BK * 2  , STAGE_BYTES = 8 * HTB, NXCD = 8, WGM = 8;

__host__ __device__ __forceinline__ int lds_byte(int r, int c) { const int st = (r >> 4) * 2 + (c >> 5), rr = r & 15, cc = c & 31, ob = rr * 64 + cc * 2; return st * 1024 + (ob ^ (((ob >> 9) & 1) << 5)); }
__host__ __device__ __forceinline__ void stage_rc(int b, int& R, int& C) { const int st = b / 1024, sb = b % 1024, swz = sb ^ (((sb >> 9) & 1) << 5); R = (st >> 1) * 16 + swz / 64; C = (st & 1) * 32 + (swz % 64) / 2; }
__host__ __device__ __forceinline__ int perm32(int rho) { const int n = rho >> 4, i = rho & 15; return 8 * (i >> 2) + 4 * n + (i & 3); }

__device__ __forceinline__ int lane_now() { int l; asm volatile("v_mbcnt_lo_u32_b32 %0, -1, 0\n\tv_mbcnt_hi_u32_b32 %0, -1, %0" : "=v"(l)); return l; }
struct Unit { int pm, pn; };
struct Gemm { const bf16_t* A; const bf16_t* Bt; int M, N, K, wv; };

struct StaticOrder {
    int nM, nN, nwg, G, c;
    __host__ __device__ void init(int M, int N, int G_, int c_) { nM = M / BM; nN = N / BM; nwg = nM * nN; G = G_; c = c_; }
    __host__ __device__ bool next(int i, Unit& u) const {
        const long L = (long)i * G + c; if (L >= nwg) return false;
        int wgid = (int)L; { const int q = nwg / NXCD, r = nwg % NXCD, xcd = wgid % NXCD, off = wgid / NXCD; wgid = (xcd < r ? xcd * (q + 1) : r * (q + 1) + (xcd - r) * q) + off; }
        const int nig = WGM * nN, gid = wgid / nig, fm = gid * WGM, gsz = (nM - fm) < WGM ? (nM - fm) : WGM;
        u.pm = fm + ((wgid % nig) % gsz); u.pn = (wgid % nig) / gsz; return true;
    }
    __device__ __forceinline__ void a_ready(const Unit&) const {}
    __device__ __forceinline__ void done(const Unit&) const {}
};

struct MapOrder {
    StaticOrder s; int from, add;
    __device__ __forceinline__ bool next(int i, Unit& u) const { if (!s.next(i, u)) return false; if (u.pn >= from) u.pn += add; return true; }
    __device__ __forceinline__ void a_ready(const Unit&) const {}
    __device__ __forceinline__ void done(const Unit&) const {}
};

struct MaskOrder {
    StaticOrder s; unsigned mask;
    __device__ __forceinline__ void init(int M, unsigned mask_, int G_, int c_) { mask = mask_; s.init(M, BM * __builtin_popcount(mask_), G_, c_); }
    __device__ __forceinline__ bool next(int i, Unit& u) const { if (!s.next(i, u)) return false; unsigned m = mask; for (int j = 0; j < u.pn; ++j) m &= m - 1; u.pn = __builtin_ctz(m); return true; }
    __device__ __forceinline__ void a_ready(const Unit&) const {}
    __device__ __forceinline__ void done(const Unit&) const {}
};

__device__ __forceinline__ unsigned cvt_pk_bf16(float lo, float hi) { unsigned r; asm volatile("v_cvt_pk_bf16_f32 %0, %1, %2" : "=v"(r) : "v"(lo), "v"(hi)); return r; }
typedef float f32x2 __attribute__((ext_vector_type(2)));

typedef unsigned u32x2 __attribute__((ext_vector_type(2)));
typedef unsigned long long fx_t;
__device__ __forceinline__ void fx_add(fx_t* p, float v) { atomicAdd(p, (fx_t)(long long)__float2ll_rn(v * 1073741824.0f)); }
__device__ __forceinline__ float fx_get(const fx_t* p) { return (float)(long long)(*p) * (1.0f / 1073741824.0f); }
__device__ __forceinline__ float epi_gelu(float x) { const float u = 0.7978845608028654f * (x + 0.044715f * x * x * x); const float e2 = __expf(2.0f * u); return 0.5f * x * (2.0f - 2.0f / (e2 + 1.0f)); }
template <int CTRL> __device__ __forceinline__ float epi_dpp_add(float x) { const int y = __builtin_amdgcn_update_dpp(0, __builtin_bit_cast(int, x), CTRL, 0xF, 0xF, false); return x + __builtin_bit_cast(float, y); }
typedef int i32x4_t __attribute__((ext_vector_type(4)));
__device__ __forceinline__ f32x4 acc_f(const f32x4& v) { return v; }
__device__ __forceinline__ f32x4 acc_f(const i32x4_t& v) { return __builtin_convertvector(v, f32x4); }
template <class T> struct AccIsInt { static constexpr bool v = false; };
template <> struct AccIsInt<i32x4_t> { static constexpr bool v = true; };
__device__ __forceinline__ void epi_prefetch(const fx_t* ssq_rows, const float* sa_rows, const float* sw_cols, PG8_LAS unsigned char* slot, int wid) {
    const int ln = lane_now();
    __builtin_amdgcn_global_load_lds((const __attribute__((address_space(1))) unsigned*)((const unsigned*)ssq_rows + wid * 64 + ln), (PG8_LAS unsigned*)(slot + wid * 256), 4, 0, 0);
    if (sa_rows) { const float* src = wid < 4 ? sa_rows + wid * 64 : sw_cols + (wid - 4) * 64;
        __builtin_amdgcn_global_load_lds((const __attribute__((address_space(1))) unsigned*)((const unsigned*)src + ln), (PG8_LAS unsigned*)(slot + 2048 + wid * 256), 4, 0, 0); }
}
__device__ __forceinline__ float fx_getl(const PG8_LAS unsigned char* slot, int rloc) { return (float)(long long)(*(const PG8_LAS fx_t*)(slot + 8 * rloc)) * (1.0f / 1073741824.0f); }
struct EpiProj {
    static constexpr bool PERM = true, AFTER_DRAIN = false, PREFETCH = true;
    bf16_t* O; int ldc; const fx_t* ssq; float* kbar; fx_t* stats; const float* sa; const float* sw;
    __device__ __forceinline__ void prefetch(const Unit& u, PG8_LAS unsigned char* slot, int wid) const { epi_prefetch(ssq + u.pm * BM, sa ? sa + u.pm * BM : nullptr, sw + u.pn * BM, slot, wid); }
    template <class AccT> __device__ __forceinline__ void operator()(const AccT (&acc)[2][2][4][2], const Unit& u, int wr, int wc, int fr, int fq, const PG8_LAS unsigned char* slot) const {
        constexpr bool Q = AccIsInt<AccT>::v;
        const int row0 = u.pm * BM + wr * 64 + fr, col0 = u.pn * BM + wc * 32 + 8 * fq;
        f32x4 cw[2][2];
        if constexpr (Q) {
#pragma unroll
            for (int bj = 0; bj < 2; ++bj) { const PG8_LAS float* p = (const PG8_LAS float*)(slot + 3072) + bj * HALF + wc * 32 + 8 * fq; cw[bj][0] = *(const PG8_LAS f32x4*)p; cw[bj][1] = *(const PG8_LAS f32x4*)(p + 4); } }
        const bool do_k = (u.pn == 12 || u.pn == 13), do_s = (u.pn == 8 || u.pn == 9);
        float cs[2][8];
#pragma unroll
        for (int bj = 0; bj < 2; ++bj)
#pragma unroll
            for (int e = 0; e < 8; ++e) cs[bj][e] = 0.f;
#pragma unroll
        for (int ai = 0; ai < 2; ++ai)
#pragma unroll
            for (int m = 0; m < 4; ++m) { const int row = row0 + ai * HALF + m * 16; const int rloc = ai * HALF + wr * 64 + m * 16 + fr; float rs = __builtin_amdgcn_rsqf(fx_getl(slot, rloc) * (1.0f / 2048.0f) + 1e-6f); if constexpr (Q) rs *= *(const PG8_LAS float*)(slot + 2048 + 4 * rloc);
                bf16_t* rowp = O + (size_t)row * ldc + col0; float s1 = 0.f, s2 = 0.f;
#pragma unroll
                for (int bj = 0; bj < 2; ++bj) { f32x4 v0 = acc_f(acc[ai][bj][m][0]) * rs, v1 = acc_f(acc[ai][bj][m][1]) * rs; if constexpr (Q) { v0 *= cw[bj][0]; v1 *= cw[bj][1]; }
                    u32x4 w; w.x = cvt_pk_bf16(v0[0], v0[1]); w.y = cvt_pk_bf16(v0[2], v0[3]); w.z = cvt_pk_bf16(v1[0], v1[1]); w.w = cvt_pk_bf16(v1[2], v1[3]);
                    *(u32x4*)(rowp + bj * HALF) = w;
                    if (do_k) {
#pragma unroll
                        for (int e = 0; e < 4; ++e) { cs[bj][e] += v0[e]; cs[bj][4 + e] += v1[e]; } }
                    if (do_s) {
#pragma unroll
                        for (int e = 0; e < 4; ++e) { const float g0 = epi_gelu(v0[e]), g1 = epi_gelu(v1[e]); s1 += g0 + g1; s2 += g0 * g0 + g1 * g1; } } }
                if (do_s) { s1 += __shfl_xor(s1, 16); s1 += __shfl_xor(s1, 32); s2 += __shfl_xor(s2, 16); s2 += __shfl_xor(s2, 32);
                    if (fq == 0) { fx_add(stats + 2 * row, s1); fx_add(stats + 2 * row + 1, s2); } } }
        if (do_k) {
            const int bidx = (u.pm >> 3) * 8, n = u.pm & 7;
#pragma unroll
            for (int bj = 0; bj < 2; ++bj)
#pragma unroll
                for (int e = 0; e < 8; ++e) { float s = cs[bj][e]; s = epi_dpp_add<0xB1>(s); s = epi_dpp_add<0x4E>(s); s = epi_dpp_add<0x141>(s); s = epi_dpp_add<0x140>(s);
                    const int ck = col0 + bj * HALF + e - 3072;
                    if (fr == 0) unsafeAtomicAdd(kbar + ((bidx + (ck >> 6)) * 8 + n) * 64 + (ck & 63), s * (1.0f / 256.0f)); } }
    }
};
struct EpiGU {
    static constexpr bool PERM = true, AFTER_DRAIN = false, PREFETCH = false;
    bf16_t* O; int ldc; const fx_t* ssq; float oscale;
    __device__ __forceinline__ void operator()(const f32x4 (&acc)[2][2][4][2], const Unit& u, int wr, int wc, int fr, int fq, const PG8_LAS unsigned char* slot) const {
        const int row0 = u.pm * BM + wr * 64 + fr, col0 = u.pn * HALF + wc * 32 + 8 * fq;
#pragma unroll
        for (int ai = 0; ai < 2; ++ai)
#pragma unroll
            for (int m = 0; m < 4; ++m) { const int row = row0 + ai * HALF + m * 16; const float rs = __builtin_amdgcn_rsqf(fx_get(ssq + row) * (1.0f / 2048.0f) + 1e-6f) * oscale;
                float o[8];
#pragma unroll
                for (int n = 0; n < 2; ++n)
#pragma unroll
                    for (int e = 0; e < 4; ++e) { const float g = acc[ai][0][m][n][e] * rs, up = acc[ai][1][m][n][e] * rs;
                        o[n * 4 + e] = g * __builtin_amdgcn_rcpf(1.0f + __builtin_amdgcn_exp2f(-1.4426950408889634f * g)) * up; }
                u32x4 w; w.x = cvt_pk_bf16(o[0], o[1]); w.y = cvt_pk_bf16(o[2], o[3]); w.z = cvt_pk_bf16(o[4], o[5]); w.w = cvt_pk_bf16(o[6], o[7]);
                *(u32x4*)(O + (size_t)row * ldc + col0) = w; }
    }
};
__device__ __forceinline__ float epi_clamp8(float v) { return __builtin_amdgcn_fmed3f(v, -448.0f, 448.0f); }
struct EpiGU8 {
    static constexpr bool PERM = true, AFTER_DRAIN = false, PREFETCH = true;
    __device__ __forceinline__ void prefetch(const Unit& u, PG8_LAS unsigned char* slot, int wid) const { epi_prefetch(ssq + u.pm * BM, sa ? sa + u.pm * BM : nullptr, sw + u.pn * BM, slot, wid); }
    unsigned char* O; int ldc; const fx_t* ssq; float oscale, ascale; const float* sa; const float* sw;
    template <class AccT> __device__ __forceinline__ void operator()(const AccT (&acc)[2][2][4][2], const Unit& u, int wr, int wc, int fr, int fq, const PG8_LAS unsigned char* slot) const {
        constexpr bool Q = AccIsInt<AccT>::v;
        const int row0 = u.pm * BM + wr * 64 + fr, col0 = u.pn * HALF + wc * 32 + 8 * fq;
        f32x4 cw[2][2];
        if constexpr (Q) {
#pragma unroll
            for (int bj = 0; bj < 2; ++bj) { const PG8_LAS float* p = (const PG8_LAS float*)(slot + 3072) + bj * HALF + wc * 32 + 8 * fq; cw[bj][0] = *(const PG8_LAS f32x4*)p; cw[bj][1] = *(const PG8_LAS f32x4*)(p + 4); } }
#pragma unroll
        for (int ai = 0; ai < 2; ++ai)
#pragma unroll
            for (int m = 0; m < 4; ++m) { const int row = row0 + ai * HALF + m * 16; const int rloc = ai * HALF + wr * 64 + m * 16 + fr; float rs = __builtin_amdgcn_rsqf(fx_getl(slot, rloc) * (1.0f / 2048.0f) + 1e-6f) * oscale; if constexpr (Q) rs *= *(const PG8_LAS float*)(slot + 2048 + 4 * rloc);
                float o[8];
#pragma unroll
                for (int n = 0; n < 2; ++n) { f32x4 gv = acc_f(acc[ai][0][m][n]) * rs, uv = acc_f(acc[ai][1][m][n]) * rs; if constexpr (Q) { gv *= cw[0][n]; uv *= cw[1][n]; }
#pragma unroll
                    for (int e = 0; e < 4; ++e) { const float g = gv[e], up = uv[e];
                        o[n * 4 + e] = epi_clamp8(g * __builtin_amdgcn_rcpf(1.0f + __builtin_amdgcn_exp2f(-1.4426950408889634f * g)) * up * ascale); } }
                int f0 = __builtin_bit_cast(int, o[0]), f1 = __builtin_bit_cast(int, o[4]);
                f0 = __builtin_amdgcn_cvt_pk_fp8_f32(o[0], o[1], f0, false); f0 = __builtin_amdgcn_cvt_pk_fp8_f32(o[2], o[3], f0, true);
                f1 = __builtin_amdgcn_cvt_pk_fp8_f32(o[4], o[5], f1, false); f1 = __builtin_amdgcn_cvt_pk_fp8_f32(o[6], o[7], f1, true);
                *(u32x2*)(O + (size_t)row * ldc + col0) = (u32x2){(unsigned)f0, (unsigned)f1}; }
    }
};
struct EpiRes {
    static constexpr bool PERM = true, AFTER_DRAIN = false, PREFETCH = false;
    bf16_t* xb; fx_t* ssq; int ldc; unsigned char* xf; float oscale; const float* sa; const float* sw;
    template <class AccT> __device__ __forceinline__ void operator()(const AccT (&acc)[2][2][4][2], const Unit& u, int wr, int wc, int fr, int fq, const PG8_LAS unsigned char* slot) const {
        constexpr bool Q = AccIsInt<AccT>::v;
        const int row0 = u.pm * BM + wr * 64 + fr, col0 = u.pn * BM + wc * 32 + 8 * fq;
        f32x4 cw[2][2];
        if constexpr (Q) {
#pragma unroll
            for (int bj = 0; bj < 2; ++bj) { cw[bj][0] = *(const f32x4*)(sw + col0 + bj * HALF); cw[bj][1] = *(const f32x4*)(sw + col0 + bj * HALF + 4); } }
#pragma unroll
        for (int ai = 0; ai < 2; ++ai)
#pragma unroll
            for (int m = 0; m < 4; ++m) { const int row = row0 + ai * HALF + m * 16; bf16_t* rowp = xb + (size_t)row * ldc + col0; float s = 0.f; float osc = oscale; if constexpr (Q) osc = sa[row];
                u32x4 b[2];
#pragma unroll
                for (int bj = 0; bj < 2; ++bj) b[bj] = *(const u32x4*)(rowp + bj * HALF);
#pragma unroll
                for (int bj = 0; bj < 2; ++bj) { float o[8]; f32x4 a2[2] = {acc_f(acc[ai][bj][m][0]), acc_f(acc[ai][bj][m][1])}; if constexpr (Q) { a2[0] *= cw[bj][0]; a2[1] *= cw[bj][1]; }
#pragma unroll
                    for (int q = 0; q < 4; ++q) { o[2 * q] = __builtin_fmaf(a2[q >> 1][2 * (q & 1)], osc, __builtin_bit_cast(float, b[bj][q] << 16)); o[2 * q + 1] = __builtin_fmaf(a2[q >> 1][2 * (q & 1) + 1], osc, __builtin_bit_cast(float, b[bj][q] & 0xffff0000u)); }
                    u32x4 w; w.x = cvt_pk_bf16(o[0], o[1]); w.y = cvt_pk_bf16(o[2], o[3]); w.z = cvt_pk_bf16(o[4], o[5]); w.w = cvt_pk_bf16(o[6], o[7]);
                    *(u32x4*)(rowp + bj * HALF) = w;
                    if (xf) { int f0 = (int)b[bj][0], f1 = (int)b[bj][1]; f0 = __builtin_amdgcn_cvt_pk_fp8_f32(epi_clamp8(o[0]), epi_clamp8(o[1]), f0, false); f0 = __builtin_amdgcn_cvt_pk_fp8_f32(epi_clamp8(o[2]), epi_clamp8(o[3]), f0, true);
                        f1 = __builtin_amdgcn_cvt_pk_fp8_f32(epi_clamp8(o[4]), epi_clamp8(o[5]), f1, false); f1 = __builtin_amdgcn_cvt_pk_fp8_f32(epi_clamp8(o[6]), epi_clamp8(o[7]), f1, true);
                        *(u32x2*)(xf + (size_t)row * ldc + col0 + bj * HALF) = (u32x2){(unsigned)f0, (unsigned)f1}; }
#pragma unroll
                    for (int q = 0; q < 8; ++q) s += o[q] * o[q]; }
                s += __shfl_xor(s, 16); s += __shfl_xor(s, 32);
                if (fq == 0) fx_add(ssq + row, s); }
    }
};

struct EpiNull {
    static constexpr bool PERM = true, AFTER_DRAIN = false, PREFETCH = false;
    float* sink;
    template <class AccT> __device__ __forceinline__ void operator()(const AccT (&acc)[2][2][4][2], const Unit& u, int wr, int wc, int fr, int fq, const PG8_LAS unsigned char* slot) const {
        f32x4 s = {0.f, 0.f, 0.f, 0.f};
#pragma unroll
        for (int ai = 0; ai < 2; ++ai)
#pragma unroll
            for (int bj = 0; bj < 2; ++bj)
#pragma unroll
                for (int m = 0; m < 4; ++m)
#pragma unroll
                    for (int n = 0; n < 2; ++n) s += acc_f(acc[ai][bj][m][n]);
        if (s[0] + s[1] + s[2] + s[3] == 1.2345e30f) sink[0] = s[0];
    }
};

struct EpiProjDense {
    static constexpr bool PERM = true, AFTER_DRAIN = false, PREFETCH = false;
    bf16_t* O; const fx_t* ssq; const float* sa; const float* sw;
    template <class AccT> __device__ __forceinline__ void operator()(const AccT (&acc)[2][2][4][2], const Unit& u, int wr, int wc, int fr, int fq, const PG8_LAS unsigned char* slot) const {
        const int row0 = u.pm * BM + wr * 64 + fr, col0 = u.pn * BM + wc * 32 + 8 * fq;
        f32x4 cw[2][2];
#pragma unroll
        for (int bj = 0; bj < 2; ++bj) { cw[bj][0] = *(const f32x4*)(sw + col0 + bj * HALF); cw[bj][1] = *(const f32x4*)(sw + col0 + bj * HALF + 4); }
        bf16_t* base = O + ((size_t)(((u.pm * 24 + u.pn) & 255) * 8 + wr * 4 + wc) * 16) * 512 + (fq * 16 + fr) * 8;
#pragma unroll
        for (int ai = 0; ai < 2; ++ai)
#pragma unroll
            for (int m = 0; m < 4; ++m) { const int row = row0 + ai * HALF + m * 16; float rs = __builtin_amdgcn_rsqf(fx_get(ssq + row) * (1.0f / 2048.0f) + 1e-6f) * sa[row];
#pragma unroll
                for (int bj = 0; bj < 2; ++bj) { f32x4 v0 = acc_f(acc[ai][bj][m][0]) * rs * cw[bj][0], v1 = acc_f(acc[ai][bj][m][1]) * rs * cw[bj][1];
                    u32x4 w; w.x = cvt_pk_bf16(v0[0], v0[1]); w.y = cvt_pk_bf16(v0[2], v0[3]); w.z = cvt_pk_bf16(v1[0], v1[1]); w.w = cvt_pk_bf16(v1[2], v1[3]);
                    *(u32x4*)(base + ((ai * 4 + m) * 2 + bj) * 512) = w; } }
    }
};
typedef int i32x8_t __attribute__((ext_vector_type(8)));
constexpr int PG8_PRM_OFF = STAGE_BYTES + 1024;
__device__ __forceinline__ void mma16(f32x4& c, const bf16x8& a, const bf16x8& b) { c = __builtin_amdgcn_mfma_f32_16x16x32_bf16(a, b, c, 0, 0, 0); }
__device__ __forceinline__ void mma16(i32x4_t& c, const bf16x8& a, const bf16x8& b) { c = __builtin_amdgcn_mfma_i32_16x16x64_i8(__builtin_bit_cast(i32x4_t, a), __builtin_bit_cast(i32x4_t, b), c, 0, 0, 0); }
template <int EB> struct AccOf { typedef f32x4 type; };
template <> struct AccOf<1> { typedef i32x4_t type; };
template <class Epi, class Sched, bool ALIGN_EPI = false, bool SP2 = false, int EB = 2>
__device__ __forceinline__ void gemm_phase(PG8_LAS unsigned char* lds, const Gemm g, const Sched& S, const Epi& E) {
    int tid_ = g.wv * 64 + lane_now(); asm volatile("" : "+v"(tid_));
    const int tid = tid_, wid = __builtin_amdgcn_readfirstlane(tid >> 6), lane = tid & 63, wr = wid >> 2, wc = wid & 3, fr = lane & 15, fq = lane >> 4;
    const int K = g.K, nt = K * EB / (2 * BK);
    unsigned voffA[2], voffB[2];
#pragma unroll
    for (int i = 0; i < 2; ++i) { int R, C; stage_rc(tid * 16 + i * 8192, R, C); const int Rb = Epi::PERM ? ((R & ~31) + perm32(R & 31)) : R;
        voffA[i] = (unsigned)(R * K * EB + 2 * C); voffB[i] = (unsigned)(Rb * K * EB + 2 * C); }
    const unsigned kstep = (unsigned)(BK * 2);
    const unsigned hstep = (unsigned)HALF * K * EB;
    const unsigned tstep = 2 * hstep;
    const unsigned ldsw = (unsigned)wid * 1024u;
    const int aoff = lds_byte(wr * 64 + fr, fq * 8), boff = lds_byte(wc * 32 + fr, fq * 8);
#define PG8_SA(b, h) (((b) * 2 + (h)) * HTB)
#define PG8_SB(b, h) ((4 + (b) * 2 + (h)) * HTB)
#define PG8_STAGE(bufoff, rsrc, soff, voff) do { _Pragma("unroll") for (int _i = 0; _i < 2; ++_i) \
        __builtin_amdgcn_raw_ptr_buffer_load_lds(rsrc, (PG8_LAS void*)(lds + (bufoff) + ldsw + _i * 8192), 16, (int)(voff)[_i], (int)(soff), 0, 0); } while (0)
#define PG8_LDA(dst, b, h) do { _Pragma("unroll") for (int m = 0; m < 4; ++m) _Pragma("unroll") for (int k = 0; k < 2; ++k) dst[m][k] = *(const PG8_LAS bf16x8*)(lds + PG8_SA(b, h) + aoff + m * 2048 + k * 1024); } while (0)
#define PG8_LDB(dst, b, h) do { _Pragma("unroll") for (int n = 0; n < 2; ++n) _Pragma("unroll") for (int k = 0; k < 2; ++k) dst[n][k] = *(const PG8_LAS bf16x8*)(lds + PG8_SB(b, h) + boff + n * 2048 + k * 1024); } while (0)
#define PG8_MMA(ai, bj, At, Bt) do { __builtin_amdgcn_s_setprio(1); _Pragma("unroll") for (int m = 0; m < 4; ++m) _Pragma("unroll") for (int n = 0; n < 2; ++n) _Pragma("unroll") for (int k = 0; k < 2; ++k) \
        mma16(acc[ai][bj][m][n], Bt[n][k], At[m][k]); __builtin_amdgcn_s_setprio(0); } while (0)
#define PG8_WAIT_V(n) asm volatile("s_waitcnt vmcnt(" #n ")" ::: "memory")
#define PG8_WAIT_L(n) asm volatile("s_waitcnt lgkmcnt(" #n ")" ::: "memory")
#define PG8_BAR __builtin_amdgcn_s_barrier()
#define PG8_SCHED __builtin_amdgcn_sched_barrier(0)
    Unit cur, nxt; int ui = 0;
    if (!S.next(0, cur)) return;
    typedef typename AccOf<EB>::type acc_t; acc_t acc[2][2][4][2];
#pragma unroll
    for (int a = 0; a < 2; ++a)
#pragma unroll
        for (int b = 0; b < 2; ++b)
#pragma unroll
            for (int m = 0; m < 4; ++m)
#pragma unroll
                for (int n = 0; n < 2; ++n) acc[a][b][m][n] = acc_t{};
    bf16x8 At[4][2], B0[2][2], B1[2][2];
    const __amdgpu_buffer_rsrc_t rA = __builtin_amdgcn_make_buffer_rsrc((void*)g.A, (short)0, -1, 0x00020000), rB = __builtin_amdgcn_make_buffer_rsrc((void*)g.Bt, (short)0, -1, 0x00020000);
    unsigned cA = (unsigned)cur.pm * tstep, cB = (unsigned)cur.pn * tstep;
    S.a_ready(cur);
    if constexpr (SP2) {
        PG8_STAGE(PG8_SB(0, 0), rB, cB, voffB); PG8_STAGE(PG8_SB(0, 1), rB, cB + hstep, voffB); PG8_STAGE(PG8_SA(0, 0), rA, cA, voffA); PG8_STAGE(PG8_SA(0, 1), rA, cA + hstep, voffA);
        if (wr == 1) PG8_BAR;
        PG8_WAIT_V(2); PG8_BAR;
        PG8_STAGE(PG8_SB(1, 0), rB, cB + kstep, voffB); PG8_STAGE(PG8_SA(1, 0), rA, cA + kstep, voffA); PG8_STAGE(PG8_SB(1, 1), rB, cB + hstep + kstep, voffB);
        PG8_WAIT_V(6); PG8_BAR;
    } else {
        PG8_STAGE(PG8_SB(0, 0), rB, cB, voffB); PG8_STAGE(PG8_SA(0, 0), rA, cA, voffA); PG8_STAGE(PG8_SB(0, 1), rB, cB + hstep, voffB); PG8_STAGE(PG8_SA(0, 1), rA, cA + hstep, voffA);
        if (wr == 1) PG8_BAR;
        PG8_WAIT_V(4); PG8_BAR;
        PG8_STAGE(PG8_SB(1, 0), rB, cB + kstep, voffB); PG8_STAGE(PG8_SA(1, 0), rA, cA + kstep, voffA); PG8_STAGE(PG8_SB(1, 1), rB, cB + hstep + kstep, voffB);
        PG8_WAIT_V(6); PG8_BAR;
    }
    for (;;) {
        const bool has_next = S.next(ui + 1, nxt);
        const unsigned nA = has_next ? (unsigned)nxt.pm * tstep : cA, nB = has_next ? (unsigned)nxt.pn * tstep : cB;
        for (int t = 0; t < nt; t += 2) {
            const bool last = (t == nt - 2);
            const unsigned a1 = cA + (unsigned)(t + 1) * kstep;
            const unsigned a2 = last ? nA : cA + (unsigned)(t + 2) * kstep, b2 = last ? nB : cB + (unsigned)(t + 2) * kstep;
            const unsigned a3 = a2 + kstep, b3 = b2 + kstep;
            if (last && has_next) S.a_ready(nxt);
            if constexpr (Epi::PREFETCH) { if (t == 0) E.prefetch(cur, lds + PG8_PRM_OFF + (ui & 1) * 4096, wid); }
            if constexpr (SP2) {
            PG8_LDB(B0, 0, 0); PG8_LDB(B1, 0, 1); PG8_SCHED; PG8_LDA(At, 0, 0); PG8_STAGE(PG8_SA(1, 1), rA, a1 + hstep, voffA);
            PG8_WAIT_V(8); PG8_WAIT_L(0); PG8_BAR; PG8_MMA(0, 0, At, B0); PG8_MMA(0, 1, At, B1); PG8_BAR; PG8_SCHED;
            PG8_LDA(At, 0, 1); PG8_STAGE(PG8_SB(0, 0), rB, b2, voffB); PG8_STAGE(PG8_SB(0, 1), rB, b2 + hstep, voffB); PG8_STAGE(PG8_SA(0, 0), rA, a2, voffA);
            PG8_WAIT_V(8); PG8_WAIT_L(0); PG8_BAR; PG8_MMA(1, 0, At, B0); PG8_MMA(1, 1, At, B1); PG8_BAR; PG8_SCHED;
            PG8_LDB(B0, 1, 0); PG8_LDB(B1, 1, 1); PG8_SCHED; PG8_LDA(At, 1, 0); PG8_STAGE(PG8_SA(0, 1), rA, a2 + hstep, voffA);
            PG8_WAIT_V(8); PG8_WAIT_L(0); PG8_BAR; PG8_MMA(0, 0, At, B0); PG8_MMA(0, 1, At, B1); PG8_BAR; PG8_SCHED;
            PG8_LDA(At, 1, 1); PG8_STAGE(PG8_SB(1, 0), rB, b3, voffB); PG8_STAGE(PG8_SB(1, 1), rB, b3 + hstep, voffB); PG8_STAGE(PG8_SA(1, 0), rA, a3, voffA);
            PG8_WAIT_V(8); PG8_WAIT_L(0); PG8_BAR; PG8_MMA(1, 0, At, B0); PG8_MMA(1, 1, At, B1); PG8_BAR; PG8_SCHED;
            } else {
            PG8_LDB(B0, 0, 0); PG8_SCHED; PG8_LDA(At, 0, 0); PG8_STAGE(PG8_SA(1, 1), rA, a1 + hstep, voffA);
            PG8_WAIT_L(8); PG8_BAR; PG8_WAIT_L(0); PG8_MMA(0, 0, At, B0); PG8_BAR; PG8_SCHED;
            PG8_LDB(B1, 0, 1); PG8_STAGE(PG8_SB(0, 0), rB, b2, voffB);
            PG8_BAR; PG8_WAIT_L(0); PG8_MMA(0, 1, At, B1); PG8_BAR;
            PG8_LDA(At, 0, 1); PG8_STAGE(PG8_SA(0, 0), rA, a2, voffA);
            PG8_BAR; PG8_WAIT_L(0); PG8_MMA(1, 0, At, B0); PG8_BAR; PG8_SCHED;
            PG8_STAGE(PG8_SB(0, 1), rB, b2 + hstep, voffB);
            PG8_WAIT_V(6); PG8_BAR; PG8_MMA(1, 1, At, B1); PG8_BAR;
            PG8_LDB(B0, 1, 0); PG8_SCHED; PG8_LDA(At, 1, 0); PG8_STAGE(PG8_SA(0, 1), rA, a2 + hstep, voffA);
            PG8_WAIT_L(8); PG8_BAR; PG8_WAIT_L(0); PG8_MMA(0, 0, At, B0); PG8_BAR; PG8_SCHED;
            PG8_LDB(B1, 1, 1); PG8_STAGE(PG8_SB(1, 0), rB, b3, voffB);
            PG8_BAR; PG8_WAIT_L(0); PG8_MMA(0, 1, At, B1); PG8_BAR;
            PG8_LDA(At, 1, 1); PG8_STAGE(PG8_SA(1, 0), rA, a3, voffA);
            PG8_BAR; PG8_WAIT_L(0); PG8_MMA(1, 0, At, B0); PG8_BAR; PG8_SCHED;
            PG8_STAGE(PG8_SB(1, 1), rB, b3 + hstep, voffB);
            PG8_WAIT_V(6); PG8_BAR; PG8_MMA(1, 1, At, B1); PG8_BAR;
            }
        }
        if constexpr (ALIGN_EPI) { if (wr == 0) PG8_BAR; }
        if constexpr (!Epi::AFTER_DRAIN) { int ln_ = (int)__builtin_amdgcn_mbcnt_hi(~0u, __builtin_amdgcn_mbcnt_lo(~0u, 0u)); asm volatile("" : "+v"(ln_));
            E(acc, cur, wr, wc, ln_ & 15, ln_ >> 4, lds + PG8_PRM_OFF + (ui & 1) * 4096); S.done(cur); }
        if (!has_next) break;
#pragma unroll
        for (int a = 0; a < 2; ++a)
#pragma unroll
            for (int b = 0; b < 2; ++b)
#pragma unroll
                for (int m = 0; m < 4; ++m)
#pragma unroll
                    for (int n = 0; n < 2; ++n) acc[a][b][m][n] = acc_t{};
        cur = nxt; cA = nA; cB = nB; ++ui;
        if constexpr (ALIGN_EPI) { if (wr == 1) PG8_BAR; }
    }
    PG8_WAIT_V(0);
    if constexpr (!ALIGN_EPI) { if (wr == 0) PG8_BAR; }
    PG8_BAR;
    if constexpr (Epi::AFTER_DRAIN) { E.fused(acc, cur, wr, wc, fr, fq, lds, wid, lane); S.done(cur); }
#undef PG8_SA
#undef PG8_SB
#undef PG8_STAGE
#undef PG8_LDA
#undef PG8_LDB
#undef PG8_MMA
#undef PG8_WAIT_V
#undef PG8_WAIT_L
#undef PG8_BAR
#undef PG8_SCHED
}
template <class Epi, class Sched, bool ALIGN_EPI = false, bool SP2 = false>
__device__ __forceinline__ void gemm_phase_f8(PG8_LAS unsigned char* lds, const Gemm g, const Sched& S, const Epi& E) {
    int tid_ = g.wv * 64 + lane_now(); asm volatile("" : "+v"(tid_));
    const int tid = tid_, wid = __builtin_amdgcn_readfirstlane(tid >> 6), lane = tid & 63, wr = wid >> 2, wc = wid & 3, fr = lane & 15, fq = lane >> 4;
    const int K = g.K, nt = K / (2 * BK);
    unsigned voffA[2], voffB[2];
#pragma unroll
    for (int i = 0; i < 2; ++i) { int R, C; stage_rc(tid * 16 + i * 8192, R, C); const int Rb = Epi::PERM ? ((R & ~31) + perm32(R & 31)) : R;
        voffA[i] = (unsigned)(R * K + 2 * C); voffB[i] = (unsigned)(Rb * K + 2 * C); }
    const unsigned kstep = (unsigned)(BK * 2);
    const unsigned hstep = (unsigned)HALF * K;
    const unsigned tstep = 2 * hstep;
    const unsigned ldsw = (unsigned)wid * 1024u;
    const int aoff = lds_byte(wr * 64 + fr, fq * 16) ^ ((fq & 1) << 4), boff = lds_byte(wc * 32 + fr, fq * 16) ^ ((fq & 1) << 4), aoff2 = aoff ^ 16, boff2 = boff ^ 16;
#define PG8_SA(b, h) (((b) * 2 + (h)) * HTB)
#define PG8_SB(b, h) ((4 + (b) * 2 + (h)) * HTB)
#define PG8_STAGE(bufoff, rsrc, soff, voff) do { _Pragma("unroll") for (int _i = 0; _i < 2; ++_i) \
        __builtin_amdgcn_raw_ptr_buffer_load_lds(rsrc, (PG8_LAS void*)(lds + (bufoff) + ldsw + _i * 8192), 16, (int)(voff)[_i], (int)(soff), 0, 0); } while (0)
#define PG8_LDA(dst, b, h) do { _Pragma("unroll") for (int m = 0; m < 4; ++m) { const i32x4_t lo_ = *(const PG8_LAS i32x4_t*)(lds + PG8_SA(b, h) + aoff + m * 2048), hi_ = *(const PG8_LAS i32x4_t*)(lds + PG8_SA(b, h) + aoff2 + m * 2048); dst[m] = __builtin_shufflevector(lo_, hi_, 0, 1, 2, 3, 4, 5, 6, 7); } } while (0)
#define PG8_LDB(dst, b, h) do { _Pragma("unroll") for (int n = 0; n < 2; ++n) { const i32x4_t lo_ = *(const PG8_LAS i32x4_t*)(lds + PG8_SB(b, h) + boff + n * 2048), hi_ = *(const PG8_LAS i32x4_t*)(lds + PG8_SB(b, h) + boff2 + n * 2048); dst[n] = __builtin_shufflevector(lo_, hi_, 0, 1, 2, 3, 4, 5, 6, 7); } } while (0)
#define PG8_F8CAT(lo, hi) __builtin_shufflevector(__builtin_bit_cast(i32x4_t, lo), __builtin_bit_cast(i32x4_t, hi), 0, 1, 2, 3, 4, 5, 6, 7)
#define PG8_MMA(ai, bj, At, Bt) do { __builtin_amdgcn_s_setprio(1); _Pragma("unroll") for (int m = 0; m < 4; ++m) _Pragma("unroll") for (int n = 0; n < 2; ++n) \
        acc[ai][bj][m][n] = __builtin_amdgcn_mfma_scale_f32_16x16x128_f8f6f4(Bt[n], At[m], acc[ai][bj][m][n], 0, 0, 0, 0, 0, 0); __builtin_amdgcn_s_setprio(0); } while (0)
#define PG8_WAIT_V(n) asm volatile("s_waitcnt vmcnt(" #n ")" ::: "memory")
#define PG8_WAIT_L(n) asm volatile("s_waitcnt lgkmcnt(" #n ")" ::: "memory")
#define PG8_BAR __builtin_amdgcn_s_barrier()
#define PG8_SCHED __builtin_amdgcn_sched_barrier(0)
    Unit cur, nxt; int ui = 0;
    if (!S.next(0, cur)) return;
    f32x4 acc[2][2][4][2];
#pragma unroll
    for (int a = 0; a < 2; ++a)
#pragma unroll
        for (int b = 0; b < 2; ++b)
#pragma unroll
            for (int m = 0; m < 4; ++m)
#pragma unroll
                for (int n = 0; n < 2; ++n) acc[a][b][m][n] = (f32x4){0.f, 0.f, 0.f, 0.f};
    i32x8_t At[4], B0[2], B1[2];
    const __amdgpu_buffer_rsrc_t rA = __builtin_amdgcn_make_buffer_rsrc((void*)g.A, (short)0, -1, 0x00020000), rB = __builtin_amdgcn_make_buffer_rsrc((void*)g.Bt, (short)0, -1, 0x00020000);
    unsigned cA = (unsigned)cur.pm * tstep, cB = (unsigned)cur.pn * tstep;
    S.a_ready(cur);
    if constexpr (SP2) {
        PG8_STAGE(PG8_SB(0, 0), rB, cB, voffB); PG8_STAGE(PG8_SB(0, 1), rB, cB + hstep, voffB); PG8_STAGE(PG8_SA(0, 0), rA, cA, voffA); PG8_STAGE(PG8_SA(0, 1), rA, cA + hstep, voffA);
        if (wr == 1) PG8_BAR;
        PG8_WAIT_V(2); PG8_BAR;
        PG8_STAGE(PG8_SB(1, 0), rB, cB + kstep, voffB); PG8_STAGE(PG8_SA(1, 0), rA, cA + kstep, voffA); PG8_STAGE(PG8_SB(1, 1), rB, cB + hstep + kstep, voffB);
        PG8_WAIT_V(6); PG8_BAR;
    } else {
        PG8_STAGE(PG8_SB(0, 0), rB, cB, voffB); PG8_STAGE(PG8_SA(0, 0), rA, cA, voffA); PG8_STAGE(PG8_SB(0, 1), rB, cB + hstep, voffB); PG8_STAGE(PG8_SA(0, 1), rA, cA + hstep, voffA);
        if (wr == 1) PG8_BAR;
        PG8_WAIT_V(4); PG8_BAR;
        PG8_STAGE(PG8_SB(1, 0), rB, cB + kstep, voffB); PG8_STAGE(PG8_SA(1, 0), rA, cA + kstep, voffA); PG8_STAGE(PG8_SB(1, 1), rB, cB + hstep + kstep, voffB);
        PG8_WAIT_V(6); PG8_BAR;
    }
    for (;;) {
        const bool has_next = S.next(ui + 1, nxt);
        const unsigned nA = has_next ? (unsigned)nxt.pm * tstep : cA, nB = has_next ? (unsigned)nxt.pn * tstep : cB;
        for (int t = 0; t < nt; t += 2) {
            const bool last = (t == nt - 2);
            const unsigned a1 = cA + (unsigned)(t + 1) * kstep;
            const unsigned a2 = last ? nA : cA + (unsigned)(t + 2) * kstep, b2 = last ? nB : cB + (unsigned)(t + 2) * kstep;
            const unsigned a3 = a2 + kstep, b3 = b2 + kstep;
            if (last && has_next) S.a_ready(nxt);
            if constexpr (Epi::PREFETCH) { if (t == 0) E.prefetch(cur, lds + PG8_PRM_OFF + (ui & 1) * 4096, wid); }
            if constexpr (SP2) {
            PG8_LDB(B0, 0, 0); PG8_LDB(B1, 0, 1); PG8_SCHED; PG8_LDA(At, 0, 0); PG8_STAGE(PG8_SA(1, 1), rA, a1 + hstep, voffA);
            PG8_WAIT_V(8); PG8_WAIT_L(0); PG8_BAR; PG8_MMA(0, 0, At, B0); PG8_MMA(0, 1, At, B1); PG8_BAR; PG8_SCHED;
            PG8_LDA(At, 0, 1); PG8_STAGE(PG8_SB(0, 0), rB, b2, voffB); PG8_STAGE(PG8_SB(0, 1), rB, b2 + hstep, voffB); PG8_STAGE(PG8_SA(0, 0), rA, a2, voffA);
            PG8_WAIT_V(8); PG8_WAIT_L(0); PG8_BAR; PG8_MMA(1, 0, At, B0); PG8_MMA(1, 1, At, B1); PG8_BAR; PG8_SCHED;
            PG8_LDB(B0, 1, 0); PG8_LDB(B1, 1, 1); PG8_SCHED; PG8_LDA(At, 1, 0); PG8_STAGE(PG8_SA(0, 1), rA, a2 + hstep, voffA);
            PG8_WAIT_V(8); PG8_WAIT_L(0); PG8_BAR; PG8_MMA(0, 0, At, B0); PG8_MMA(0, 1, At, B1); PG8_BAR; PG8_SCHED;
            PG8_LDA(At, 1, 1); PG8_STAGE(PG8_SB(1, 0), rB, b3, voffB); PG8_STAGE(PG8_SB(1, 1), rB, b3 + hstep, voffB); PG8_STAGE(PG8_SA(1, 0), rA, a3, voffA);
            PG8_WAIT_V(8); PG8_WAIT_L(0); PG8_BAR; PG8_MMA(1, 0, At, B0); PG8_MMA(1, 1, At, B1); PG8_BAR; PG8_SCHED;
            } else {
            PG8_LDB(B0, 0, 0); PG8_SCHED; PG8_LDA(At, 0, 0); PG8_STAGE(PG8_SA(1, 1), rA, a1 + hstep, voffA);
            PG8_WAIT_L(8); PG8_BAR; PG8_WAIT_L(0); PG8_MMA(0, 0, At, B0); PG8_BAR; PG8_SCHED;
            PG8_LDB(B1, 0, 1); PG8_STAGE(PG8_SB(0, 0), rB, b2, voffB);
            PG8_BAR; PG8_WAIT_L(0); PG8_MMA(0, 1, At, B1); PG8_BAR;
            PG8_LDA(At, 0, 1); PG8_STAGE(PG8_SA(0, 0), rA, a2, voffA);
            PG8_BAR; PG8_WAIT_L(0); PG8_MMA(1, 0, At, B0); PG8_BAR; PG8_SCHED;
            PG8_STAGE(PG8_SB(0, 1), rB, b2 + hstep, voffB);
            PG8_WAIT_V(6); PG8_BAR; PG8_MMA(1, 1, At, B1); PG8_BAR;
            PG8_LDB(B0, 1, 0); PG8_SCHED; PG8_LDA(At, 1, 0); PG8_STAGE(PG8_SA(0, 1), rA, a2 + hstep, voffA);
            PG8_WAIT_L(8); PG8_BAR; PG8_WAIT_L(0); PG8_MMA(0, 0, At, B0); PG8_BAR; PG8_SCHED;
            PG8_LDB(B1, 1, 1); PG8_STAGE(PG8_SB(1, 0), rB, b3, voffB);
            PG8_BAR; PG8_WAIT_L(0); PG8_MMA(0, 1, At, B1); PG8_BAR;
            PG8_LDA(At, 1, 1); PG8_STAGE(PG8_SA(1, 0), rA, a3, voffA);
            PG8_BAR; PG8_WAIT_L(0); PG8_MMA(1, 0, At, B0); PG8_BAR; PG8_SCHED;
            PG8_STAGE(PG8_SB(1, 1), rB, b3 + hstep, voffB);
            PG8_WAIT_V(6); PG8_BAR; PG8_MMA(1, 1, At, B1); PG8_BAR;
            }
        }
        if constexpr (ALIGN_EPI) { if (wr == 0) PG8_BAR; }
        if constexpr (!Epi::AFTER_DRAIN) { int ln_ = (int)__builtin_amdgcn_mbcnt_hi(~0u, __builtin_amdgcn_mbcnt_lo(~0u, 0u)); asm volatile("" : "+v"(ln_));
            E(acc, cur, wr, wc, ln_ & 15, ln_ >> 4, lds + PG8_PRM_OFF + (ui & 1) * 4096); S.done(cur); }
        if (!has_next) break;
#pragma unroll
        for (int a = 0; a < 2; ++a)
#pragma unroll
            for (int b = 0; b < 2; ++b)
#pragma unroll
                for (int m = 0; m < 4; ++m)
#pragma unroll
                    for (int n = 0; n < 2; ++n) acc[a][b][m][n] = (f32x4){0.f, 0.f, 0.f, 0.f};
        cur = nxt; cA = nA; cB = nB; ++ui;
        if constexpr (ALIGN_EPI) { if (wr == 1) PG8_BAR; }
    }
    PG8_WAIT_V(0);
    if constexpr (!ALIGN_EPI) { if (wr == 0) PG8_BAR; }
    PG8_BAR;
    if constexpr (Epi::AFTER_DRAIN) { E.fused(acc, cur, wr, wc, fr, fq, lds, wid, lane); S.done(cur); }
#undef PG8_SA
#undef PG8_SB
#undef PG8_STAGE
#undef PG8_LDA
#undef PG8_LDB
#undef PG8_MMA
#undef PG8_WAIT_V
#undef PG8_WAIT_L
#undef PG8_BAR
#undef PG8_SCHED
#undef PG8_F8CAT
}
}

constexpr int NWAVES = 8, NTHR = NWAVES * 64;
constexpr int BATCH = 8, SEQ = 2048, DM = 2048, DEPTH = 2, HD = 64, GW = 512, NH = 8;
constexpr int M = BATCH * SEQ;
constexpr int NPROJ = 6080, NPROJ_P = 6144, DFF = 5632;
constexpr int CA_Q = 0, CA_K = 512, CA_V = 1024, CB_U = 1536, CB_V = 2048, CC_Q = 2560, CC_K = 3072, CC_V = 3584, CD = 4096;
constexpr int D_R = 0, D_WD = 512, D_K = 608, D_V = 1120, D_AD = 1632, D_GD = 1728, D_W = 1984;
constexpr float NORM_EPS = 1e-6f;
#ifndef N_LAUNCH_MODE
#define N_LAUNCH_MODE 0
#endif
#ifndef PG8_SP2
#define PG8_SP2 true
#endif
#ifndef FFN_FP8
#define FFN_FP8 1
#endif
#ifndef REPEAT
#define REPEAT 0
#endif
#ifndef GEMM_I8
#define GEMM_I8 3
#endif
#ifndef BFMASK
#define BFMASK 0x003C0Fu
#endif
#ifndef FFN1_I8
#define FFN1_I8 1
#endif
#define I8_IN ((GEMM_I8 & 1) != 0)
#define I8_OUT ((GEMM_I8 & 2) != 0)
constexpr int N_PHASES = 20;

constexpr size_t MiB = 1u << 20;
constexpr size_t WS_CTL = 0, CTL_ZERO_BYTES = 2 * MiB;
constexpr size_t WS_WIN = 2 * MiB, WS_WOUT = 26 * MiB, WS_WGU = 34 * MiB, WS_WDN = 78 * MiB, WS_SMALL = 100 * MiB;
constexpr size_t WS_XB = 104 * MiB, WS_PROJ = 168 * MiB, WS_YCAT = 360 * MiB, WS_SC2 = 424 * MiB, WS_YD = 456 * MiB, WS_G = 488 * MiB, WS_BC = 504 * MiB, WS_END = 506 * MiB;
constexpr size_t WS_XQ = WS_YD, WS_YQ = WS_PROJ;
constexpr size_t SC_ARR = (size_t)M * GW * 2;
constexpr size_t SM_TB = 0;
constexpr size_t SM_KBAR = 64 * 1024;
constexpr size_t SM_STATS = 256 * 1024;
constexpr size_t SM_SAX = 2048 * 1024, SM_SAY = SM_SAX + 64 * 1024;
constexpr size_t SM_SWIN = SM_SAY + 64 * 1024, SM_SWOUT = SM_SWIN + 32 * 1024, SM_SWGU = SM_SWOUT + 16 * 1024;
constexpr size_t SM_BIAS = 3072 * 1024;
constexpr size_t SM_WT = 1024 * 1024;
constexpr int CW_BAR = 4096;
constexpr int CW_Q = 8192;
constexpr int CW_SSQ = 65536;
constexpr size_t CTL_KBAR = 1024 * 1024;
constexpr size_t CTL_STATS = 1280 * 1024;
static_assert((size_t)CW_SSQ * 4 + 5 * (size_t)M * 8 <= CTL_KBAR && CTL_STATS + 2 * (size_t)M * 2 * 8 <= CTL_ZERO_BYTES, "CTL");

constexpr int RING_OFF = 0, RING_BYTES = 131072;
constexpr int LDS_BYTES = 163840, MISC_OFF = LDS_BYTES - 256;

#define GAS __attribute__((address_space(1)))
#define LAS __attribute__((address_space(3)))
typedef unsigned short bf16;
typedef unsigned v4u __attribute__((ext_vector_type(4)));
typedef unsigned v2u __attribute__((ext_vector_type(2)));
typedef float f32x4 __attribute__((ext_vector_type(4)));
typedef short bf16x8 __attribute__((ext_vector_type(8)));
typedef float f32x16 __attribute__((ext_vector_type(16)));
typedef GAS unsigned gu32;
#define RLX_AGENT __ATOMIC_RELAXED, __HIP_MEMORY_SCOPE_AGENT
#define LDS_WAIT() asm volatile("s_waitcnt lgkmcnt(0)" ::: "memory")
#define VM_WAIT() asm volatile("s_waitcnt vmcnt(0)" ::: "memory")
__device__ __forceinline__ unsigned f2bf(float f) { unsigned u = __builtin_bit_cast(unsigned, f); return (u + 0x7fffu + ((u >> 16) & 1u)) >> 16; }
__device__ __forceinline__ unsigned pk2(float lo, float hi) { return f2bf(lo) | (f2bf(hi) << 16); }
__device__ __forceinline__ float bf2f(unsigned short h) { return __builtin_bit_cast(float, (unsigned)h << 16); }
__device__ __forceinline__ float bflo(unsigned w) { return __builtin_bit_cast(float, w << 16); }
__device__ __forceinline__ float bfhi(unsigned w) { return __builtin_bit_cast(float, w & 0xffff0000u); }
__device__ __forceinline__ float sigmoidf_(float x) { return 1.0f / (1.0f + __expf(-x)); }
__device__ __forceinline__ float gelu_tanh(float x) { const float u = 0.7978845608028654f * (x + 0.044715f * x * x * x); const float e = __expf(2.0f * u); const float th = 1.0f - 2.0f / (e + 1.0f); return 0.5f * x * (1.0f + th); }
__device__ __forceinline__ float wave_sum(float v) {
#pragma unroll
    for (int o = 1; o < 64; o <<= 1) v += __shfl_xor(v, o);
    return v;
}

__device__ __forceinline__ float zero_v() { float z = 0.f; asm volatile("" : "+v"(z)); return z; }

__device__ __forceinline__ unsigned q8pack4(float a, float b, float c, float d, float inv) {
    const int ia = (int)__builtin_rintf(a * inv), ib = (int)__builtin_rintf(b * inv), ic = (int)__builtin_rintf(c * inv), id = (int)__builtin_rintf(d * inv);
    return ((unsigned)ia & 0xffu) | (((unsigned)ib & 0xffu) << 8) | (((unsigned)ic & 0xffu) << 16) | ((unsigned)id << 24); }
__device__ __forceinline__ float wave_max(float v) {
#pragma unroll
    for (int o = 1; o < 64; o <<= 1) v = fmaxf(v, __shfl_xor(v, o));
    return v;
}
#define UNPACK8(dst, o, W_) do { dst[(o)] = bflo((W_).x); dst[(o) + 1] = bfhi((W_).x); dst[(o) + 2] = bflo((W_).y); dst[(o) + 3] = bfhi((W_).y); dst[(o) + 4] = bflo((W_).z); dst[(o) + 5] = bfhi((W_).z); dst[(o) + 6] = bflo((W_).w); dst[(o) + 7] = bfhi((W_).w); } while (0)
#define XB_TMO      128
#define XB_XCNT(j)  (256  + 64 * (j))
#define XB_XSUB(j)  (1280 + 64 * (j))
#define XB_XGEN(j)  (2304 + 64 * (j))
#define XB_TOP      3328
#define XB_TOPGEN   3392
#define XCD_BAR_WORDS 3456
#define XB_SPIN_CAP (1u << 18)

__device__ __forceinline__ unsigned xb_ld(unsigned* p)              { return __hip_atomic_load(p, __ATOMIC_RELAXED, __HIP_MEMORY_SCOPE_AGENT); }
__device__ __forceinline__ unsigned xb_add(unsigned* p, unsigned v) { return __hip_atomic_fetch_add(p, v, __ATOMIC_RELAXED, __HIP_MEMORY_SCOPE_AGENT); }
__device__ __forceinline__ unsigned xb_xcc_id() { return (unsigned)__builtin_amdgcn_s_getreg((3 << 11) | 20) & 0xFu; }
#define XB_SPIN(cond, bar) do { unsigned _sp = 0; while (cond) { __builtin_amdgcn_s_sleep(1); \
    if ((++_sp & 255u) == 0u) { if (xb_ld(&(bar)[XB_TMO])) break; if (_sp > XB_SPIN_CAP) { atomicAdd(&(bar)[XB_TMO], 1u); break; } } } } while (0)

struct XcdBarrier {
    unsigned* bar; unsigned x; int wv;
    volatile LAS unsigned* st;
};

__device__ __forceinline__ XcdBarrier xcd_barrier_post(unsigned* bar, volatile LAS unsigned* st, int wv) {
    XcdBarrier b; b.bar = bar; b.x = xb_xcc_id(); b.st = st; b.wv = wv;
    if (wv == 0 && pg8::lane_now() == 0) (void)xb_add(&bar[XB_XCNT(b.x)], 1u);
    return b;
}
__device__ __forceinline__ void xcd_barrier_complete(unsigned* bar, unsigned x, unsigned& nloc, unsigned& nx) {
    const unsigned G = gridDim.x * gridDim.y * gridDim.z;
    unsigned sum, cnt, mine, sp = 0u;
    for (;;) {
        sum = 0u; cnt = 0u; mine = 0u;
#pragma unroll
        for (unsigned j = 0; j < 16; ++j) { const unsigned c = xb_ld(&bar[XB_XCNT(j)]); sum += c; cnt += (c > 0u) ? 1u : 0u; mine = (j == x) ? c : mine; }
        if (sum == G) break;
        __builtin_amdgcn_s_sleep(1);
        if ((++sp & 255u) == 0u) { if (xb_ld(&bar[XB_TMO])) break; if (sp > XB_SPIN_CAP) { atomicAdd(&bar[XB_TMO], 1u); break; } }
    }
    nloc = mine > 0u ? mine : 1u; nx = cnt > 0u ? cnt : 1u;
}

__device__ __forceinline__ void xcd_barrier(const XcdBarrier& b) {
    asm volatile("s_waitcnt vmcnt(0)" ::: "memory");
    __syncthreads();
    if (b.wv == 0 && pg8::lane_now() == 0) {
        unsigned* bar = b.bar;
        __builtin_amdgcn_s_waitcnt(0);
        unsigned nloc = b.st[0], nx = b.st[1];
        if (nloc == 0u) { xcd_barrier_complete(bar, b.x, nloc, nx); b.st[0] = nloc; b.st[1] = nx; }
        const unsigned old = xb_add(&bar[XB_XSUB(b.x)], 1u);
        const unsigned gen = old / nloc;
        if (old + 1u == (gen + 1u) * nloc) {
            __builtin_amdgcn_fence(__ATOMIC_RELEASE, "agent");
            asm volatile("s_waitcnt vmcnt(0)" ::: "memory");
            const unsigned og = xb_add(&bar[XB_TOP], 1u);
            const unsigned tg = og / nx;
            if (og + 1u == (tg + 1u) * nx) xb_add(&bar[XB_TOPGEN], 1u);
            else XB_SPIN(xb_ld(&bar[XB_TOPGEN]) == tg, bar);
            __builtin_amdgcn_fence(__ATOMIC_ACQUIRE, "agent");
            xb_add(&bar[XB_XGEN(b.x)], 1u);
            asm volatile("s_waitcnt vmcnt(0)" ::: "memory");
        } else {
            XB_SPIN(xb_ld(&bar[XB_XGEN(b.x)]) == gen, bar);
            __builtin_amdgcn_fence(__ATOMIC_ACQUIRE, "agent");
            asm volatile("s_waitcnt vmcnt(0)" ::: "memory");
        }
    }
    __syncthreads();
}

struct Args { const float* in[25]; float* out; unsigned char* ws; int ph_lo, ph_hi; };
struct Frame {
    LAS unsigned char* lds; int tid, lane, wave, G, vcu, gw, ngw;
};
typedef const __attribute__((address_space(4))) unsigned long long* karg_t;
__device__ __forceinline__ karg_t kargs() { karg_t ka = (karg_t)__builtin_amdgcn_kernarg_segment_ptr(); asm volatile("" : "+s"(ka)); return ka; }
__device__ __forceinline__ const float* inp(int i) { return (const float*)(const GAS float*)kargs()[i]; }
__device__ __forceinline__ float* outp() { return (float*)(GAS float*)kargs()[25]; }
__device__ __forceinline__ unsigned char* wsp() { return (unsigned char*)(GAS unsigned char*)kargs()[26]; }
__device__ __forceinline__ gu32* ctlp() { return (gu32*)(wsp() + WS_CTL); }

__device__ __forceinline__ void conv_item(const float* W, int K, int N, const float* g, bf16* WT, int kind, LAS float* scr, int item, int lane, int ncols = 0) {
    const int nblk = (ncols ? ncols : N) / 32, kb = item / nblk, nb = item % nblk, k0 = 64 * kb, n0 = 32 * nb;
    float ld[32];
    { const float* wp = W + (size_t)(k0 + (lane >> 5)) * N + n0 + (lane & 31);
#pragma unroll
      for (int i = 0; i < 32; ++i) ld[i] = wp[(size_t)(2 * i) * N]; }
    if (g) { const float* gp = g + k0 + (lane >> 5);
#pragma unroll
      for (int i = 0; i < 32; ++i) ld[i] *= gp[2 * i]; }
#pragma unroll
    for (int i = 0; i < 32; ++i) scr[(2 * i + (lane >> 5)) * 33 + (lane & 31)] = ld[i];
    LDS_WAIT(); asm volatile("" ::: "memory");
    const int c = lane & 7;
#pragma unroll
    for (int j = 0; j < 4; ++j) { const int n = (lane >> 3) + 8 * j; const LAS float* s = scr + (8 * c) * 33 + n;
        v4u o; o.x = pk2(s[0 * 33], s[1 * 33]); o.y = pk2(s[2 * 33], s[3 * 33]); o.z = pk2(s[4 * 33], s[5 * 33]); o.w = pk2(s[6 * 33], s[7 * 33]);
        const int nn = n0 + n;
        if (kind >= 3) {
            const int row = kind == 5 ? nn : ((nn >> 7) * 256 + (kind - 3) * 128 + (nn & 127)); int f0 = (int)o.x, f1 = (int)o.y;
            f0 = __builtin_amdgcn_cvt_pk_fp8_f32(64.f * s[0 * 33], 64.f * s[1 * 33], f0, false); f0 = __builtin_amdgcn_cvt_pk_fp8_f32(64.f * s[2 * 33], 64.f * s[3 * 33], f0, true);
            f1 = __builtin_amdgcn_cvt_pk_fp8_f32(64.f * s[4 * 33], 64.f * s[5 * 33], f1, false); f1 = __builtin_amdgcn_cvt_pk_fp8_f32(64.f * s[6 * 33], 64.f * s[7 * 33], f1, true);
            *(GAS v2u*)((unsigned char*)WT + (size_t)row * K + k0 + 8 * c) = (v2u){(unsigned)f0, (unsigned)f1};
        } else {
        const int row = kind == 0 ? nn : ((nn >> 7) * 256 + (kind - 1) * 128 + (nn & 127));
        *(GAS v4u*)(WT + (size_t)row * K + k0 + 8 * c) = o; } }
    LDS_WAIT(); asm volatile("" ::: "memory");
}
__device__ __forceinline__ void conv_cols_i8(const float* W, int K, int N, const float* g, unsigned char* WQ, float* SW, int nb, Frame& F, int orow0 = -1) {
    LAS float* scr = (LAS float*)(F.lds + RING_OFF + F.wave * 16384); LAS float* red = (LAS float*)(F.lds + RING_OFF + 131072);
    const int n0 = 32 * nb, lane = F.lane, nkb = K / 64, o0 = orow0 < 0 ? n0 : orow0;
    const float* wp0 = W + (size_t)(lane >> 5) * N + n0 + (lane & 31);
    float mx = 0.f;
    for (int kb = F.wave; kb < nkb; kb += NWAVES) {
        const float* wp = wp0 + (size_t)(64 * kb) * N; const float* gp = g + 64 * kb + (lane >> 5);
        float ld[32];
#pragma unroll
        for (int i = 0; i < 32; ++i) ld[i] = wp[(size_t)(2 * i) * N];
#pragma unroll
        for (int i = 0; i < 32; ++i) mx = fmaxf(mx, fabsf(ld[i] * gp[2 * i]));
    }
    mx = fmaxf(mx, __shfl_xor(mx, 32));
    if (lane < 32) red[F.wave * 32 + lane] = mx;
    __syncthreads();
    float cm = 0.f;
#pragma unroll
    for (int w = 0; w < NWAVES; ++w) cm = fmaxf(cm, red[w * 32 + (lane & 31)]);
    const float inv = cm > 0.f ? 127.0f / cm : 0.f;
    if (F.wave == 0 && lane < 32) SW[o0 + lane] = cm * (1.0f / 127.0f);
    for (int kb = F.wave; kb < nkb; kb += NWAVES) {
        const float* wp = wp0 + (size_t)(64 * kb) * N; const float* gp = g + 64 * kb + (lane >> 5);
        float ld[32];
#pragma unroll
        for (int i = 0; i < 32; ++i) ld[i] = wp[(size_t)(2 * i) * N];
#pragma unroll
        for (int i = 0; i < 32; ++i) scr[(2 * i + (lane >> 5)) * 33 + (lane & 31)] = ld[i] * gp[2 * i] * inv;
        LDS_WAIT(); asm volatile("" ::: "memory");
        const int c = lane & 7;
#pragma unroll
        for (int j = 0; j < 4; ++j) { const int n = (lane >> 3) + 8 * j; const LAS float* q = scr + (8 * c) * 33 + n;
            *(GAS v2u*)(WQ + (size_t)(o0 + n) * K + 64 * kb + 8 * c) = (v2u){q8pack4(q[0 * 33], q[1 * 33], q[2 * 33], q[3 * 33], 1.0f), q8pack4(q[4 * 33], q[5 * 33], q[6 * 33], q[7 * 33], 1.0f)}; }
        LDS_WAIT(); asm volatile("" ::: "memory");
    }
    __syncthreads();
}
__device__ __forceinline__ void conv_layer_items(Frame& F, int l, int gw, int ngw, bool do_in, bool do_rest) {
    LAS float* scr = (LAS float*)(F.lds + RING_OFF + F.wave * 16384);
    constexpr int I_IN = (DM / 64) * (NPROJ / 32), I_OUT = (DM / 64) * (DM / 32), I_G = (DM / 64) * (DFF / 32), I_D = (DFF / 64) * (DM / 32);
    const float* w_in = inp(2) + (size_t)l * DM * NPROJ; const float* w_out = inp(19) + (size_t)l * DM * DM;
    const float* w_g = inp(21) + (size_t)l * DM * DFF; const float* w_u = inp(22) + (size_t)l * DM * DFF; const float* w_d = inp(23) + (size_t)l * DFF * DM;
    const float* g_mix = inp(1) + l * DM; const float* g_br = inp(18) + l * DM; const float* g_ffn = inp(20) + l * DM;
    bf16* WIN = (bf16*)(wsp() + WS_WIN); bf16* WOUT = (bf16*)(wsp() + WS_WOUT); bf16* WGU = (bf16*)(wsp() + WS_WGU); bf16* WDN = (bf16*)(wsp() + WS_WDN);
    if (do_in) {
        for (int it = gw; it < I_IN; it += ngw) conv_item(w_in, DM, NPROJ, g_mix, WIN, 0, scr, it, F.lane);
    }
    if (do_rest) {
        for (int it = gw; it < (I8_OUT ? 0 : I_OUT) + (FFN1_I8 ? 0 : 2 * I_G) + I_D; it += ngw) {
            int r = it + (I8_OUT ? I_OUT : 0); if (FFN1_I8 && r >= I_OUT) r += 2 * I_G;
            if (r < I_OUT) { conv_item(w_out, DM, DM, g_br, WOUT, 0, scr, r, F.lane); continue; } r -= I_OUT;
            if (r < I_G) { conv_item(w_g, DM, DFF, g_ffn, WGU, FFN_FP8 ? 3 : 1, scr, r, F.lane); continue; } r -= I_G;
            if (r < I_G) { conv_item(w_u, DM, DFF, g_ffn, WGU, FFN_FP8 ? 4 : 2, scr, r, F.lane); continue; } r -= I_G;
            conv_item(w_d, DFF, DM, nullptr, WDN, FFN_FP8 ? 5 : 0, scr, r, F.lane);
        }
    }
}

constexpr int WINB_NB = 8 * __builtin_popcount(BFMASK), WINB_ITEMS = (DM / 64) * WINB_NB;
__device__ __forceinline__ bf16* winb_ptr() { return (bf16*)outp() + (size_t)6 * M * GW; }
__device__ __forceinline__ void conv_winb(Frame& F, int l, int item) {
    if (item >= WINB_ITEMS) return;
    const int kb = item / (WINB_NB ? WINB_NB : 1), r = item % (WINB_NB ? WINB_NB : 1); unsigned m = BFMASK; for (int j = 0; j < (r >> 3); ++j) m &= m - 1;
    conv_item(inp(2) + (size_t)l * DM * NPROJ, DM, NPROJ, inp(1) + l * DM, winb_ptr(), 0, (LAS float*)(F.lds + RING_OFF + F.wave * 16384), kb * (NPROJ / 32) + __builtin_ctz(m) * 8 + (r & 7), F.lane);
}
__device__ __forceinline__ void ph_prologue(Frame& F) {
    if (I8_IN) {
        for (int nb = blockIdx.x; nb < NPROJ / 32; nb += F.G) conv_cols_i8(inp(2), DM, NPROJ, inp(1), wsp() + WS_WIN, (float*)(wsp() + WS_SMALL + SM_SWIN), nb, F);
        unsigned char* WIN = wsp() + WS_WIN; float* SWIN = (float*)(wsp() + WS_SMALL + SM_SWIN);
        for (int i = F.gw * 64 + F.lane; i < 64 * DM / 16; i += F.ngw * 64) *(GAS v4u*)(WIN + (size_t)NPROJ * DM + (size_t)i * 16) = (v4u){0u, 0u, 0u, 0u};
        if (blockIdx.x == 0 && F.tid < NPROJ_P - NPROJ) SWIN[NPROJ + F.tid] = 0.f;
        for (int it = F.gw; it < WINB_ITEMS; it += F.ngw) conv_winb(F, 0, it);
    } else {
    conv_layer_items(F, 0, F.gw, F.ngw, true, false);
    { bf16* WIN = (bf16*)(wsp() + WS_WIN);
      for (int i = F.gw * 64 + F.lane; i < 64 * DM / 8; i += F.ngw * 64) *(GAS v4u*)(WIN + (size_t)NPROJ * DM + (size_t)i * 8) = (v4u){0u, 0u, 0u, 0u}; } }
    if (blockIdx.x == 0) {
        int* TB = (int*)(wsp() + WS_SMALL + SM_TB);
        for (int d = F.tid; d < 2049; d += NTHR) {
            int bkt = d;
            if (d >= 16) bkt = 16 + (d >= 22) + (d >= 30) + (d >= 40) + (d >= 54) + (d >= 73) + (d >= 99) + (d >= 134) + (d >= 182) + (d >= 246) + (d >= 332) + (d >= 450) + (d >= 609) + (d >= 825) + (d >= 1117) + (d >= 1513);
            TB[d] = bkt;
        }
    }
    if (blockIdx.x >= 1 && blockIdx.x <= 16) {
        const int hcol = blockIdx.x - 1; float* BT = (float*)(wsp() + WS_SMALL + SM_BIAS) + hcol * 2048; const float* pb = inp(3);
        for (int d = F.tid; d < 2048; d += NTHR) {
            int bkt = d;
            if (d >= 16) bkt = 16 + (d >= 22) + (d >= 30) + (d >= 40) + (d >= 54) + (d >= 73) + (d >= 99) + (d >= 134) + (d >= 182) + (d >= 246) + (d >= 332) + (d >= 450) + (d >= 609) + (d >= 825) + (d >= 1117) + (d >= 1513);
            BT[d] = pb[bkt * 16 + hcol] * 1.4426950408889634f;
        }
    }
    { bf16* WT = (bf16*)(wsp() + WS_SMALL + SM_WT); const float* w2 = inp(9); const float* a2 = inp(11); const float* g2 = inp(12);
      for (int idx = blockIdx.x * NTHR + F.tid; idx < DEPTH * 448 * GW; idx += F.G * NTHR) {
          const int c = idx % GW, k = (idx / GW) % 448, l = idx / (GW * 448);
          const float v = k < 96 ? w2[((size_t)l * 96 + k) * GW + c] : (k < 192 ? a2[((size_t)l * 96 + (k - 96)) * GW + c] : g2[((size_t)l * 256 + (k - 192)) * GW + c]);
          const int r32_ = c & 31, hct = c >> 5, ks_ = k >> 4, hh_ = (k >> 3) & 1;
          WT[(size_t)l * GW * 448 + (((size_t)hct * 28 + ks_) * 64 + 32 * hh_ + r32_) * 8 + (k & 7)] = (bf16)f2bf(v); } }
    const float* x = inp(0); bf16* XB = (bf16*)(wsp() + WS_XB); pg8::fx_t* ssq = (pg8::fx_t*)(ctlp() + CW_SSQ);
    for (int m = F.gw; m < M; m += F.ngw) {
        const GAS f32x4* xr = (const GAS f32x4*)(x + (size_t)m * DM) + F.lane; GAS v2u* o = (GAS v2u*)(XB + (size_t)m * DM) + F.lane; float s = 0.f;
#pragma unroll
        for (int j = 0; j < 8; ++j) { const f32x4 v = xr[64 * j]; s += (v.x * v.x + v.y * v.y) + (v.z * v.z + v.w * v.w); o[64 * j] = (v2u){pk2(v.x, v.y), pk2(v.z, v.w)}; }
        s = wave_sum(s); if (F.lane == 0) pg8::fx_add(ssq + m, s);
        if (I8_IN) {
            float mx = 0.f;
#pragma unroll
            for (int j = 0; j < 8; ++j) { const f32x4 v = xr[64 * j]; mx = fmaxf(fmaxf(mx, fmaxf(fabsf(v.x), fabsf(v.y))), fmaxf(fabsf(v.z), fabsf(v.w))); }
            mx = wave_max(mx); const float inv = mx > 0.f ? 127.0f / mx : 0.f; GAS unsigned* q = (GAS unsigned*)(wsp() + WS_XQ + (size_t)m * DM) + F.lane;
#pragma unroll
            for (int j = 0; j < 8; ++j) { const f32x4 v = xr[64 * j]; q[64 * j] = q8pack4(v.x, v.y, v.z, v.w, inv); }
            if (F.lane == 0) ((float*)(wsp() + WS_SMALL + SM_SAX))[m] = mx * (1.0f / 127.0f);
        }
    }
}

__device__ __forceinline__ void ph_quantx(Frame& F) {
    const bf16* XB = (const bf16*)(wsp() + WS_XB); unsigned char* XQ = wsp() + WS_XQ; float* SAX = (float*)(wsp() + WS_SMALL + SM_SAX);
    for (int m = F.gw; m < M; m += F.ngw) {
        const GAS v4u* xr = (const GAS v4u*)(XB + (size_t)m * DM) + F.lane; v4u w[4]; float mx = 0.f;
#pragma unroll
        for (int j = 0; j < 4; ++j) w[j] = xr[64 * j];
#pragma unroll
        for (int j = 0; j < 4; ++j) { mx = fmaxf(fmaxf(mx, fmaxf(fabsf(bflo(w[j].x)), fabsf(bfhi(w[j].x)))), fmaxf(fabsf(bflo(w[j].y)), fabsf(bfhi(w[j].y))));
            mx = fmaxf(fmaxf(mx, fmaxf(fabsf(bflo(w[j].z)), fabsf(bfhi(w[j].z)))), fmaxf(fabsf(bflo(w[j].w)), fabsf(bfhi(w[j].w)))); }
        mx = wave_max(mx); const float inv = mx > 0.f ? 127.0f / mx : 0.f; GAS v2u* q = (GAS v2u*)(XQ + (size_t)m * DM) + F.lane;
#pragma unroll
        for (int j = 0; j < 4; ++j) q[64 * j] = (v2u){q8pack4(bflo(w[j].x), bfhi(w[j].x), bflo(w[j].y), bfhi(w[j].y), inv), q8pack4(bflo(w[j].z), bfhi(w[j].z), bflo(w[j].w), bfhi(w[j].w), inv)};
        if (F.lane == 0) SAX[m] = mx * (1.0f / 127.0f);
    }
}

constexpr int PR_PITCH = 912;
constexpr int PR_PRM_OFF = 32768, PR_MUA_OFF = PR_PRM_OFF + 8 * 512 * 4;
__device__ __forceinline__ float fast_tanh(float x) { return 1.0f - 2.0f * __builtin_amdgcn_rcpf(__expf(2.0f * x) + 1.0f); }
__device__ __forceinline__ float fast_sigmoid(float x) { return __builtin_amdgcn_rcpf(1.0f + __expf(-x)); }
constexpr int PR_OT_OFF = 51200, PR_OT_PITCH = 72, PR_OT_TILE = 32 * PR_OT_PITCH, PR_OT_WAVE = 6 * PR_OT_TILE;
static_assert(PR_OT_OFF + 8 * PR_OT_WAVE <= MISC_OFF, "prep LDS");
__device__ __forceinline__ void ph_prep(Frame& F, int l) {
    const bf16* PROJ = (const bf16*)(wsp() + WS_PROJ);
    bf16* R_ = (bf16*)outp();
    bf16* E_ = R_ + (size_t)M * GW; bf16* KP_ = E_ + (size_t)M * GW; bf16* V_ = KP_ + (size_t)M * GW;
    bf16* KK_ = (bf16*)outp() + (size_t)4 * M * GW; bf16* AS_ = KK_ + (size_t)M * GW; bf16* G_ = (bf16*)(wsp() + WS_G); float* BC = (float*)(wsp() + WS_BC);
    const bf16* WT = (const bf16*)(wsp() + WS_SMALL + SM_WT) + (size_t)l * GW * 448;
    LAS unsigned char* actL = F.lds + RING_OFF; LAS float* PRM = (LAS float*)(F.lds + PR_PRM_OFF); LAS float* MUA = (LAS float*)(F.lds + PR_MUA_OFF);
    { const float* mu = inp(7) + l * D_W; const float* w0 = inp(8) + l * GW; const float* a0 = inp(10) + l * GW; const float* k_k = inp(13) + l * GW; const float* k_a = inp(14) + l * GW; const float* r_k = inp(15) + l * GW;
      const int c = F.tid;
      PRM[c] = mu[D_R + c]; PRM[512 + c] = mu[D_K + c]; PRM[1024 + c] = mu[D_V + c]; PRM[1536 + c] = w0[c]; PRM[2048 + c] = a0[c]; PRM[2560 + c] = k_k[c]; PRM[3072 + c] = k_a[c]; PRM[3584 + c] = r_k[c];
      if (c < 448) MUA[c] = mu[c < 96 ? D_WD + c : (c < 192 ? D_AD + (c - 96) : D_GD + (c - 192))]; }
    __syncthreads();
    const int h = F.wave;
    for (int it = blockIdx.x; it < M / 32; it += F.G) {
        const int m0 = it * 32;
        int tid_ = F.wave * 64 + pg8::lane_now(); asm volatile("" : "+v"(tid_));
        const int tid = tid_, r32 = tid & 31, hh = (tid >> 5) & 1, lane = tid & 63;
        LAS unsigned char* OT = F.lds + PR_OT_OFF + h * PR_OT_WAVE;
        { v2u pc[7], pp[7];
#pragma unroll
          for (int i = 0; i < 7; ++i) { const int gi = tid + NTHR * i, t = gi / 112, k = 4 * (gi % 112), m = m0 + t;
              const int col = k < 96 ? D_WD + k : (k < 192 ? D_AD + (k - 96) : D_GD + (k - 192)); const bf16* src = PROJ + (size_t)m * NPROJ_P + CD + col;
              pc[i] = *(const GAS v2u*)src; pp[i] = (v2u){0u, 0u}; if ((m % SEQ) > 0) pp[i] = *(const GAS v2u*)(src - NPROJ_P); }
#pragma unroll
          for (int i = 0; i < 7; ++i) { const int gi = tid + NTHR * i, t = gi / 112, k = 4 * (gi % 112);
              const f32x4 mv = *(const LAS f32x4*)(MUA + k);
              float x[4] = {bflo(pc[i].x), bfhi(pc[i].x), bflo(pc[i].y), bfhi(pc[i].y)}; const float xp[4] = {bflo(pp[i].x), bfhi(pp[i].x), bflo(pp[i].y), bfhi(pp[i].y)};
#pragma unroll
              for (int e = 0; e < 4; ++e) { x[e] += (xp[e] - x[e]) * mv[e]; x[e] = k < 96 ? fast_tanh(x[e]) : (k < 192 ? x[e] : fast_sigmoid(x[e])); }
              *(LAS v2u*)(actL + t * PR_PITCH + 2 * k) = (v2u){pk2(x[0], x[1]), pk2(x[2], x[3])}; } }
        __syncthreads();
        const int m = m0 + r32; const bool has_prev = (m % SEQ) > 0;
        const bf16* pr = PROJ + (size_t)m * NPROJ_P + CD; const bf16* pq = pr - NPROJ_P;
        const LAS unsigned char* bp = actL + r32 * PR_PITCH + 16 * hh;
        float kkv[2][16]; float n2 = 0.f, bcv = 0.f;
#pragma unroll
        for (int ct = 0; ct < 2; ++ct) {
            const int cb = 64 * h + 32 * ct + 4 * hh;
            v4u xc[3][2], xp[3][2];
#pragma unroll
            for (int a = 0; a < 3; ++a)
#pragma unroll
                for (int i = 0; i < 2; ++i) { const int mm = m0 + (lane >> 2) + 16 * i; const bf16* src = PROJ + (size_t)mm * NPROJ_P + CD + (a == 0 ? D_R : (a == 1 ? D_K : D_V)) + 64 * h + 32 * ct + 8 * (lane & 3);
                    xc[a][i] = *(const GAS v4u*)src; xp[a][i] = (v4u){0u, 0u, 0u, 0u}; if ((mm % SEQ) > 0) xp[a][i] = *(const GAS v4u*)(src - NPROJ_P); }
            f32x16 aW, aA, aG;
            { const float z_ = zero_v();
#pragma unroll
            for (int i = 0; i < 16; ++i) { aW[i] = z_; aA[i] = z_; aG[i] = z_; } }
            const bf16* wt0 = WT + ((size_t)(2 * h + ct) * 28 * 64 + lane) * 8;
#pragma unroll
            for (int grp = 0; grp < 4; ++grp) {
                bf16x8 af[7];
#pragma unroll
                for (int q = 0; q < 7; ++q) af[q] = *(const GAS bf16x8*)(wt0 + 512 * (7 * grp + q));
#pragma unroll
                for (int q = 0; q < 7; ++q) { const int ks = 7 * grp + q; const bf16x8 bfr = *(const LAS bf16x8*)(bp + 32 * ks);
                    if (ks < 6) aW = __builtin_amdgcn_mfma_f32_32x32x16_bf16(af[q], bfr, aW, 0, 0, 0);
                    else if (ks < 12) aA = __builtin_amdgcn_mfma_f32_32x32x16_bf16(af[q], bfr, aA, 0, 0, 0);
                    else aG = __builtin_amdgcn_mfma_f32_32x32x16_bf16(af[q], bfr, aG, 0, 0, 0); }
                asm volatile("" ::: "memory");
            }
            LAS unsigned char* IN = OT + 3 * PR_OT_TILE;
#pragma unroll
            for (int a = 0; a < 3; ++a)
#pragma unroll
                for (int i = 0; i < 2; ++i) { const int cch = 64 * h + 32 * ct + 8 * (lane & 3); const f32x4 m0v = *(const LAS f32x4*)(PRM + a * 512 + cch), m1v = *(const LAS f32x4*)(PRM + a * 512 + cch + 4);
                    float xcu[8], xpu[8]; UNPACK8(xcu, 0, xc[a][i]); UNPACK8(xpu, 0, xp[a][i]); const float mw[8] = {m0v.x, m0v.y, m0v.z, m0v.w, m1v.x, m1v.y, m1v.z, m1v.w};
#pragma unroll
                    for (int e = 0; e < 8; ++e) xcu[e] += (xpu[e] - xcu[e]) * mw[e];
                    LAS unsigned char* dstp = IN + a * PR_OT_TILE + ((lane >> 2) + 16 * i) * PR_OT_PITCH + 16 * (lane & 3);
                    *(LAS v2u*)dstp = (v2u){pk2(xcu[0], xcu[1]), pk2(xcu[2], xcu[3])}; *(LAS v2u*)(dstp + 8) = (v2u){pk2(xcu[4], xcu[5]), pk2(xcu[6], xcu[7])}; }
            asm volatile("" ::: "memory");
            v2u oE[4], oK[4], oG[4];
#pragma unroll
            for (int g4 = 0; g4 < 4; ++g4) {
                const int c = cb + 8 * g4;
                const f32x4 w0v = *(const LAS f32x4*)(PRM + 1536 + c),
                            a0v = *(const LAS f32x4*)(PRM + 2048 + c), kkc = *(const LAS f32x4*)(PRM + 2560 + c), kac = *(const LAS f32x4*)(PRM + 3072 + c), rkc = *(const LAS f32x4*)(PRM + 3584 + c);
                const LAS unsigned char* inq = IN + r32 * PR_OT_PITCH + 2 * (8 * g4 + 4 * hh);
                const v2u rq = *(const LAS v2u*)inq, kq = *(const LAS v2u*)(inq + PR_OT_TILE), vq = *(const LAS v2u*)(inq + 2 * PR_OT_TILE);
                const float rsu[4] = {bflo(rq.x), bfhi(rq.x), bflo(rq.y), bfhi(rq.y)}, ksu[4] = {bflo(kq.x), bfhi(kq.x), bflo(kq.y), bfhi(kq.y)}, vsu[4] = {bflo(vq.x), bfhi(vq.x), bflo(vq.y), bfhi(vq.y)};
                float ro[4], eo[4], ko[4], vo[4], ao[4], go[4];
#pragma unroll
                for (int e = 0; e < 4; ++e) {
                    const float r = rsu[e], k = ksu[e], v = vsu[e];
                    const float ee = 0.6065306597126334f * fast_sigmoid(w0v[e] + aW[4 * g4 + e]);
                    const float as = fast_sigmoid(a0v[e] + aA[4 * g4 + e]);
                    const float kv = k * kkc[e]; kkv[ct][4 * g4 + e] = kv; n2 += kv * kv;
                    const float kp = k * (1.0f + (as - 1.0f) * kac[e]);
                    bcv += r * kp * rkc[e];
                    ro[e] = r; eo[e] = ee; ko[e] = kp; vo[e] = v; ao[e] = as; go[e] = aG[4 * g4 + e];
                }
                LAS unsigned char* ot = OT + r32 * PR_OT_PITCH + 2 * (8 * g4 + 4 * hh);
                *(LAS v2u*)(ot) = (v2u){pk2(ro[0], ro[1]), pk2(ro[2], ro[3])}; *(LAS v2u*)(ot + PR_OT_TILE) = (v2u){pk2(vo[0], vo[1]), pk2(vo[2], vo[3])}; *(LAS v2u*)(ot + 2 * PR_OT_TILE) = (v2u){pk2(ao[0], ao[1]), pk2(ao[2], ao[3])};
                oE[g4] = (v2u){pk2(eo[0], eo[1]), pk2(eo[2], eo[3])}; oK[g4] = (v2u){pk2(ko[0], ko[1]), pk2(ko[2], ko[3])}; oG[g4] = (v2u){pk2(go[0], go[1]), pk2(go[2], go[3])};
            }
            asm volatile("" ::: "memory");
#pragma unroll
            for (int batch = 0; batch < 2; ++batch) {
                bf16* const dst[3] = {batch == 0 ? R_ : E_, batch == 0 ? V_ : KP_, batch == 0 ? AS_ : G_};
                if (batch == 1) {
#pragma unroll
                    for (int g4 = 0; g4 < 4; ++g4) { LAS unsigned char* ot = OT + r32 * PR_OT_PITCH + 2 * (8 * g4 + 4 * hh); *(LAS v2u*)(ot) = oE[g4]; *(LAS v2u*)(ot + PR_OT_TILE) = oK[g4]; *(LAS v2u*)(ot + 2 * PR_OT_TILE) = oG[g4]; }
                    asm volatile("" ::: "memory"); }
#pragma unroll
                for (int a = 0; a < 3; ++a)
#pragma unroll
                    for (int i = 0; i < 2; ++i) { const int tk = (lane >> 2) + 16 * i, part = lane & 3; const LAS unsigned char* src = OT + a * PR_OT_TILE + tk * PR_OT_PITCH + 16 * part;
                        const v2u lo = *(const LAS v2u*)src, hi = *(const LAS v2u*)(src + 8);
                        *(GAS v4u*)(dst[a] + (size_t)(m0 + tk) * GW + 64 * h + 32 * ct + 8 * part) = (v4u){lo.x, lo.y, hi.x, hi.y}; }
                asm volatile("" ::: "memory");
            }
        }
        n2 += __shfl_xor(n2, 32); bcv += __shfl_xor(bcv, 32);
        const float inv = 1.0f / fmaxf(sqrtf(n2), 1e-12f);
#pragma unroll
        for (int ct = 0; ct < 2; ++ct)
#pragma unroll
            for (int g4 = 0; g4 < 4; ++g4) *(LAS v2u*)(OT + ct * PR_OT_TILE + r32 * PR_OT_PITCH + 2 * (8 * g4 + 4 * hh)) = (v2u){pk2(kkv[ct][4 * g4] * inv, kkv[ct][4 * g4 + 1] * inv), pk2(kkv[ct][4 * g4 + 2] * inv, kkv[ct][4 * g4 + 3] * inv)};
        asm volatile("" ::: "memory");
#pragma unroll
        for (int ct = 0; ct < 2; ++ct)
#pragma unroll
            for (int i = 0; i < 2; ++i) { const int tk = (lane >> 2) + 16 * i, part = lane & 3; const LAS unsigned char* src = OT + ct * PR_OT_TILE + tk * PR_OT_PITCH + 16 * part;
                const v2u lo = *(const LAS v2u*)src, hi = *(const LAS v2u*)(src + 8);
                *(GAS v4u*)(KK_ + (size_t)(m0 + tk) * GW + 64 * h + 32 * ct + 8 * part) = (v4u){lo.x, lo.y, hi.x, hi.y}; }
        asm volatile("" ::: "memory");
        if (hh == 0) BC[(size_t)m * NH + h] = bcv;
        __syncthreads();
    }
}

__device__ __forceinline__ Frame mkframe(LAS unsigned char* lds, int wv) {
    Frame F; F.lds = lds; { int t_ = wv * 64 + pg8::lane_now(); asm volatile("" : "+v"(t_)); F.tid = t_; } F.lane = F.tid & 63; F.wave = wv;
    F.G = gridDim.x; { const int bx = blockIdx.x; F.vcu = (F.G % 8 == 0) ? (bx % 8) * (F.G / 8) + bx / 8 : bx; }
    F.gw = blockIdx.x * NWAVES + F.wave; F.ngw = F.G * NWAVES; return F;
}

#ifndef UNPACK8
#define UNPACK8(dst, o, W_) do { dst[(o)] = bflo((W_).x); dst[(o) + 1] = bfhi((W_).x); dst[(o) + 2] = bflo((W_).y); dst[(o) + 3] = bfhi((W_).y); dst[(o) + 4] = bflo((W_).z); dst[(o) + 5] = bfhi((W_).z); dst[(o) + 6] = bflo((W_).w); dst[(o) + 7] = bfhi((W_).w); } while (0)
#endif
#define DOT8(q, o, W_) ((q)[(o)] * bflo((W_).x) + (q)[(o) + 1] * bfhi((W_).x) + (q)[(o) + 2] * bflo((W_).y) + (q)[(o) + 3] * bfhi((W_).y) + (q)[(o) + 4] * bflo((W_).z) + (q)[(o) + 5] * bfhi((W_).z) + (q)[(o) + 6] * bflo((W_).w) + (q)[(o) + 7] * bfhi((W_).w))
#define AXPY8(acc, o, sc, pe, W_) do { acc[(o)] = acc[(o)] * (sc) + (pe) * bflo((W_).x); acc[(o) + 1] = acc[(o) + 1] * (sc) + (pe) * bfhi((W_).x); acc[(o) + 2] = acc[(o) + 2] * (sc) + (pe) * bflo((W_).y); acc[(o) + 3] = acc[(o) + 3] * (sc) + (pe) * bfhi((W_).y); \
    acc[(o) + 4] = acc[(o) + 4] * (sc) + (pe) * bflo((W_).z); acc[(o) + 5] = acc[(o) + 5] * (sc) + (pe) * bfhi((W_).z); acc[(o) + 6] = acc[(o) + 6] * (sc) + (pe) * bflo((W_).w); acc[(o) + 7] = acc[(o) + 7] * (sc) + (pe) * bfhi((W_).w); } while (0)
__device__ __forceinline__ void mix_a_simple(Frame& F) {
    const bf16* PROJ = (const bf16*)(wsp() + WS_PROJ); bf16* YC = (bf16*)(wsp() + WS_YCAT); const int* TB = (const int*)(wsp() + WS_SMALL + SM_TB); const float* pb = inp(3);
    const int nthr = F.G * NTHR;
    for (int idx = blockIdx.x * NTHR + F.tid; idx < M * NH; idx += nthr) {
        const int m = idx >> 3, h = idx & 7, t = m % SEQ;
        float q[64], acc[64];
        { const GAS v4u* qp = (const GAS v4u*)(PROJ + (size_t)m * NPROJ_P + CA_Q + 64 * h);
#pragma unroll
          for (int i = 0; i < 8; ++i) { const v4u w = qp[i]; UNPACK8(q, 8 * i, w); } }
#pragma unroll
        for (int i = 0; i < 64; ++i) acc[i] = 0.f;
        float mx = -1e30f, l = 0.f;
        for (int p = 0; p < 3; ++p) { const int d = p == 0 ? 1 : (p == 1 ? 4 : 16);
            for (int j = 0; j <= 128; ++j) { const int kp = t - j * d; if (kp < 0) break;
                const bf16* row = PROJ + (size_t)(m - j * d) * NPROJ_P; const GAS v4u* kq = (const GAS v4u*)(row + CA_K + 64 * h); const GAS v4u* vq = (const GAS v4u*)(row + CA_V + 64 * h);
                float s = 0.f;
#pragma unroll
                for (int i = 0; i < 8; ++i) { const v4u w = kq[i]; s += DOT8(q, 8 * i, w); }
                s = s * 0.125f + pb[TB[j * d] * 16 + h];
                const float mn = fmaxf(mx, s), sc = __expf(mx - mn), pe = __expf(s - mn); mx = mn; l = l * sc + pe;
#pragma unroll
                for (int i = 0; i < 8; ++i) { const v4u w = vq[i]; AXPY8(acc, 8 * i, sc, pe, w); }
            } }
        const float inv = 1.0f / l; GAS v4u* op = (GAS v4u*)(YC + (size_t)m * DM + 0 * GW + 64 * h);
#pragma unroll
        for (int i = 0; i < 8; ++i) op[i] = (v4u){pk2(acc[8 * i] * inv, acc[8 * i + 1] * inv), pk2(acc[8 * i + 2] * inv, acc[8 * i + 3] * inv), pk2(acc[8 * i + 4] * inv, acc[8 * i + 5] * inv), pk2(acc[8 * i + 6] * inv, acc[8 * i + 7] * inv)};
    }
}
__device__ __forceinline__ void mix_c_simple(Frame& F, int l = 0) {
    const bf16* PROJ = (const bf16*)(wsp() + WS_PROJ); bf16* YC = (bf16*)(wsp() + WS_YCAT); const int* TB = (const int*)(wsp() + WS_SMALL + SM_TB); const float* pb = inp(3);
    const float* KBAR = (const float*)(wsp() + CTL_KBAR) + (size_t)l * 64 * 8 * 64;
    const int nthr = F.G * NTHR;
    for (int idx = blockIdx.x * NTHR + F.tid; idx < M * NH; idx += nthr) {
        const int m = idx >> 3, h = idx & 7, t = m % SEQ, b = m / SEQ, ob = t >> 8;
        float q[64], acc[64];
        { const GAS v4u* qp = (const GAS v4u*)(PROJ + (size_t)m * NPROJ_P + CC_Q + 64 * h);
#pragma unroll
          for (int i = 0; i < 8; ++i) { const v4u w = qp[i]; UNPACK8(q, 8 * i, w); } }
        float gate[8];
#pragma unroll
        for (int n = 0; n < 8; ++n) { float s = 0.f; if (n < ob) { const float* kb = KBAR + ((b * NH + h) * 8 + n) * 64;
#pragma unroll
                for (int i = 0; i < 64; ++i) s += q[i] * kb[i]; } gate[n] = s; }
        unsigned sel = 0u;
#pragma unroll
        for (int n = 0; n < 8; ++n) { int rank = 0;
#pragma unroll
            for (int n2 = 0; n2 < 8; ++n2) rank += (n2 < ob && n2 != n && (gate[n2] > gate[n] || (gate[n2] == gate[n] && n2 < n))) ? 1 : 0;
            if (n < ob && rank < 3) sel |= 1u << n; }
        sel |= 1u << ob;
#pragma unroll
        for (int i = 0; i < 64; ++i) acc[i] = 0.f;
        float mx = -1e30f, l = 0.f;
        for (int n = 0; n <= ob; ++n) { if (!((sel >> n) & 1u)) continue; const int kmax = n == ob ? (t & 255) : 255;
            for (int i2 = 0; i2 <= kmax; ++i2) { const int kp = 256 * n + i2;
                const bf16* row = PROJ + ((size_t)b * SEQ + kp) * NPROJ_P; const GAS v4u* kq = (const GAS v4u*)(row + CC_K + 64 * h); const GAS v4u* vq = (const GAS v4u*)(row + CC_V + 64 * h);
                float s = 0.f;
#pragma unroll
                for (int i = 0; i < 8; ++i) { const v4u w = kq[i]; s += DOT8(q, 8 * i, w); }
                s = s * 0.125f + pb[TB[t - kp] * 16 + 8 + h];
                const float mn = fmaxf(mx, s), sc = __expf(mx - mn), pe = __expf(s - mn); mx = mn; l = l * sc + pe;
#pragma unroll
                for (int i = 0; i < 8; ++i) { const v4u w = vq[i]; AXPY8(acc, 8 * i, sc, pe, w); }
            } }
        const float inv = 1.0f / l; GAS v4u* op = (GAS v4u*)(YC + (size_t)m * DM + 2 * GW + 64 * h);
#pragma unroll
        for (int i = 0; i < 8; ++i) op[i] = (v4u){pk2(acc[8 * i] * inv, acc[8 * i + 1] * inv), pk2(acc[8 * i + 2] * inv, acc[8 * i + 3] * inv), pk2(acc[8 * i + 4] * inv, acc[8 * i + 5] * inv), pk2(acc[8 * i + 6] * inv, acc[8 * i + 7] * inv)};
    }
}
__device__ __forceinline__ void mix_b_simple(Frame& F, int l) {
    const bf16* PROJ = (const bf16*)(wsp() + WS_PROJ); bf16* YC = (bf16*)(wsp() + WS_YCAT); const pg8::fx_t* ST = (const pg8::fx_t*)(wsp() + CTL_STATS) + (size_t)l * M * 2;
    const float* lng = inp(4) + l * GW; const float* sw = inp(5) + (size_t)l * NH * 128 * 128; const float* sb = inp(6) + l * NH * 128;
    const int nthr = F.G * NTHR;
    for (int idx = blockIdx.x * NTHR + F.tid; idx < M * GW; idx += nthr) {
        const int m = idx >> 9, c = idx & 511, g = c >> 6, tt = m & 127, m0 = m - tt;
        const float* wrow = sw + ((size_t)g * 128 + tt) * 128; const float gn = lng[c]; float s = 0.f;
        for (int s2 = 0; s2 <= tt; ++s2) { const int ms = m0 + s2; const float mu_ = pg8::fx_get(ST + 2 * ms) * (1.0f / 512.0f), rs_ = 1.0f / sqrtf(fmaxf(pg8::fx_get(ST + 2 * ms + 1) * (1.0f / 512.0f) - mu_ * mu_, 0.f) + 1e-5f); const float vv = (gelu_tanh(bf2f(PROJ[(size_t)ms * NPROJ_P + CB_V + c])) - mu_) * rs_ * gn; s += wrow[s2] * vv; }
        const float u = gelu_tanh(bf2f(PROJ[(size_t)m * NPROJ_P + CB_U + c]));
        YC[(size_t)m * DM + GW + c] = (bf16)f2bf(u * (s + sb[g * 128 + tt]));
    }
}
__device__ __forceinline__ float rdl(float v, int k) { return __builtin_bit_cast(float, __builtin_amdgcn_readlane(__builtin_bit_cast(int, v), k)); }
__device__ __forceinline__ void mix_d_simple(Frame& F) {
    const bf16* R_ = (const bf16*)outp();
    const bf16* E_ = R_ + (size_t)M * GW; const bf16* KP_ = E_ + (size_t)M * GW; const bf16* V_ = KP_ + (size_t)M * GW;
    const bf16* KK_ = (const bf16*)outp() + (size_t)4 * M * GW; const bf16* AS_ = KK_ + (size_t)M * GW; float* YD = (float*)(wsp() + WS_YD);
    for (int it = F.gw; it < BATCH * NH; it += F.ngw) {
        const int b = it >> 3, h = it & 7; float s[64];
#pragma unroll
        for (int k = 0; k < 64; ++k) s[k] = 0.f;
        for (int t = 0; t < SEQ; ++t) {
            const size_t o = ((size_t)b * SEQ + t) * GW + 64 * h + F.lane;
            const float r = bf2f(R_[o]), w = __expf(-bf2f(E_[o])), kp = bf2f(KP_[o]), v = bf2f(V_[o]), kk = bf2f(KK_[o]), as = bf2f(AS_[o]);
            const float a = -kk, bb = kk * as;
            float sa = 0.f;
#pragma unroll
            for (int k = 0; k < 64; ++k) sa += s[k] * rdl(a, k);
            float y = 0.f;
#pragma unroll
            for (int k = 0; k < 64; ++k) { s[k] = s[k] * rdl(w, k) + sa * rdl(bb, k) + v * rdl(kp, k); y += s[k] * rdl(r, k); }
            YD[o] = y;
        }
    }
}

constexpr float LOG2E = 1.4426950408889634f;

constexpr int SC_T = 32, SC_TOK = (5 * 64 + 32) * 4, SC_BUF = SC_T * SC_TOK, SC_YB = SC_T * 32 * 4, SC_LDS = 2 * SC_BUF + 2 * SC_YB;
template <int CTRL> __device__ __forceinline__ float dpp_add(float x) {
    const int y = __builtin_amdgcn_update_dpp(0, __builtin_bit_cast(int, x), CTRL, 0xF, 0xF, false);
    return x + __builtin_bit_cast(float, y);
}
__device__ __forceinline__ float red8(float x) { x = dpp_add<0xB1>(x); x = dpp_add<0x4E>(x); x = dpp_add<0x141>(x); return x; }
__device__ __forceinline__ void scan_unit(LAS unsigned char* lds, int unit, int tid) {
    const int half = unit & 1, h = (unit >> 1) & 7, b = unit >> 4;
    const bf16* R_ = (const bf16*)outp();
    const bf16* E_ = R_ + (size_t)M * GW; const bf16* KP_ = E_ + (size_t)M * GW; const bf16* V_ = KP_ + (size_t)M * GW;
    const bf16* KK_ = (const bf16*)outp() + (size_t)4 * M * GW; const bf16* AS_ = KK_ + (size_t)M * GW; float* YD = (float*)(wsp() + WS_YD);
    const int lane = tid & 63, wave = __builtin_amdgcn_readfirstlane(tid >> 6);
    const bool scanner = wave < 4;
    const int j = lane & 7, rowl = (wave & 3) * 8 + (lane >> 3);
    const int st = tid & 255, tt = st >> 3, cg = st & 7;
    const size_t gbase = ((size_t)b * SEQ) * GW + 64 * h + 8 * cg;
#define SC_STAGE(c, buf) do { const size_t o_ = gbase + (size_t)((c) * SC_T + tt) * GW; \
        const v4u g_r = *(const GAS v4u*)(R_ + o_), g_e = *(const GAS v4u*)(E_ + o_), g_k = *(const GAS v4u*)(KP_ + o_), g_v = *(const GAS v4u*)(V_ + o_), g_kk = *(const GAS v4u*)(KK_ + o_), g_as = *(const GAS v4u*)(AS_ + o_); \
        LAS float* p_ = (LAS float*)(lds + (buf) * SC_BUF + tt * SC_TOK) + 8 * cg; float kk_[8], x_[8], y_[8]; \
        UNPACK8(kk_, 0, g_kk); \
        *(LAS f32x4*)(p_) = (f32x4){-kk_[0], -kk_[1], -kk_[2], -kk_[3]}; *(LAS f32x4*)(p_ + 4) = (f32x4){-kk_[4], -kk_[5], -kk_[6], -kk_[7]}; \
        UNPACK8(x_, 0, g_e); *(LAS f32x4*)(p_ + 64) = (f32x4){__expf(-x_[0]), __expf(-x_[1]), __expf(-x_[2]), __expf(-x_[3])}; *(LAS f32x4*)(p_ + 68) = (f32x4){__expf(-x_[4]), __expf(-x_[5]), __expf(-x_[6]), __expf(-x_[7])}; \
        UNPACK8(y_, 0, g_as); *(LAS f32x4*)(p_ + 128) = (f32x4){kk_[0] * y_[0], kk_[1] * y_[1], kk_[2] * y_[2], kk_[3] * y_[3]}; *(LAS f32x4*)(p_ + 132) = (f32x4){kk_[4] * y_[4], kk_[5] * y_[5], kk_[6] * y_[6], kk_[7] * y_[7]}; \
        UNPACK8(x_, 0, g_k); *(LAS f32x4*)(p_ + 192) = (f32x4){x_[0], x_[1], x_[2], x_[3]}; *(LAS f32x4*)(p_ + 196) = (f32x4){x_[4], x_[5], x_[6], x_[7]}; \
        UNPACK8(x_, 0, g_r); *(LAS f32x4*)(p_ + 256) = (f32x4){x_[0], x_[1], x_[2], x_[3]}; *(LAS f32x4*)(p_ + 260) = (f32x4){x_[4], x_[5], x_[6], x_[7]}; \
        if ((cg >> 2) == half) { UNPACK8(x_, 0, g_v); LAS float* v_ = (LAS float*)(lds + (buf) * SC_BUF + tt * SC_TOK) + 320 + 8 * (cg & 3); \
            *(LAS f32x4*)(v_) = (f32x4){x_[0], x_[1], x_[2], x_[3]}; *(LAS f32x4*)(v_ + 4) = (f32x4){x_[4], x_[5], x_[6], x_[7]}; } } while (0)
    if (!scanner) SC_STAGE(0, 0);
    __syncthreads();
    f32x4 s0 = {0.f, 0.f, 0.f, 0.f}, s1 = {0.f, 0.f, 0.f, 0.f};
    float ykeep = 0.f;
    for (int c = 0; c < SEQ / SC_T; ++c) {
        const int cur = c & 1;
        LAS float* yb = (LAS float*)(lds + 2 * SC_BUF + cur * SC_YB);
        if (scanner) {
            const LAS float* base = (const LAS float*)(lds + cur * SC_BUF) + 8 * j;
            const LAS float* vbase = (const LAS float*)(lds + cur * SC_BUF) + 320 + rowl;
            f32x4 a0 = *(const LAS f32x4*)(base), a1 = *(const LAS f32x4*)(base + 4), w0 = *(const LAS f32x4*)(base + 64), w1 = *(const LAS f32x4*)(base + 68), b0 = *(const LAS f32x4*)(base + 128), b1 = *(const LAS f32x4*)(base + 132),
                  k0 = *(const LAS f32x4*)(base + 192), k1 = *(const LAS f32x4*)(base + 196), r0 = *(const LAS f32x4*)(base + 256), r1 = *(const LAS f32x4*)(base + 260);
            float vv = *vbase;
#pragma unroll
            for (int t = 0; t < SC_T; ++t) {
                f32x4 na0 = a0, na1 = a1, nw0 = w0, nw1 = w1, nb0 = b0, nb1 = b1, nk0 = k0, nk1 = k1, nr0 = r0, nr1 = r1; float nv = vv;
                if (t + 1 < SC_T) { const LAS float* p = base + (t + 1) * (SC_TOK / 4);
                    na0 = *(const LAS f32x4*)(p); na1 = *(const LAS f32x4*)(p + 4); nw0 = *(const LAS f32x4*)(p + 64); nw1 = *(const LAS f32x4*)(p + 68); nb0 = *(const LAS f32x4*)(p + 128); nb1 = *(const LAS f32x4*)(p + 132);
                    nk0 = *(const LAS f32x4*)(p + 192); nk1 = *(const LAS f32x4*)(p + 196); nr0 = *(const LAS f32x4*)(p + 256); nr1 = *(const LAS f32x4*)(p + 260);
                    nv = vbase[(t + 1) * (SC_TOK / 4)]; }
                const f32x4 pa = s0 * a0 + s1 * a1;
                float sa = (pa.x + pa.y) + (pa.z + pa.w);
                const f32x4 sw0 = s0 * w0 + vv * k0, sw1 = s1 * w1 + vv * k1;
                sa = red8(sa);
                s0 = sa * b0 + sw0; s1 = sa * b1 + sw1;
                const f32x4 py = s0 * r0 + s1 * r1;
                float y = (py.x + py.y) + (py.z + py.w);
                y = red8(y);
                ykeep = (j == (t & 7)) ? y : ykeep;
                if ((t & 7) == 7) yb[((t & ~7) + j) * 32 + rowl] = ykeep;
                a0 = na0; a1 = na1; w0 = nw0; w1 = nw1; b0 = nb0; b1 = nb1; k0 = nk0; k1 = nk1; r0 = nr0; r1 = nr1; vv = nv;
            }
        } else {
            if (c > 0) {
                const LAS float* ybp = (const LAS float*)(lds + 2 * SC_BUF + (cur ^ 1) * SC_YB); const int t2 = st >> 3, q4 = st & 7; const f32x4 v = *(const LAS f32x4*)(ybp + t2 * 32 + 4 * q4);
                *(GAS f32x4*)(YD + ((size_t)b * SEQ + (c - 1) * SC_T + t2) * GW + 64 * h + 32 * half + 4 * q4) = v; }
            if (c + 1 < SEQ / SC_T) SC_STAGE(c + 1, cur ^ 1);
        }
        __syncthreads();
    }
    if (!scanner) { const LAS float* ybp = (const LAS float*)(lds + 2 * SC_BUF + 1 * SC_YB); const int t2 = st >> 3, q4 = st & 7; const f32x4 v = *(const LAS f32x4*)(ybp + t2 * 32 + 4 * q4);
        *(GAS f32x4*)(YD + ((size_t)b * SEQ + (SEQ / SC_T - 1) * SC_T + t2) * GW + 64 * h + 32 * half + 4 * q4) = v; }
#undef SC_STAGE
    __syncthreads();
}

struct AttnSt { f32x16 o0, o1; float m, l; };
__device__ __forceinline__ void attn_init(AttnSt& st) {
    const float z_ = zero_v();
#pragma unroll
    for (int i = 0; i < 16; ++i) { st.o0[i] = z_; st.o1[i] = z_; }
    st.m = -1e30f; st.l = 0.f;
}
__device__ __forceinline__ void attn_tile(AttnSt& st, const bf16x8 (&qf)[4], const bf16* Kcol, const bf16* Vcol, int rowb, int kb, int ks, int qpos, int maxd, bool sel, const LAS float* biasT, int r32, int hh) {
    int kp_l = kb + r32 * ks; kp_l = kp_l < 0 ? 0 : kp_l;
    const bf16* kr_ = Kcol + (size_t)(rowb + kp_l) * NPROJ_P + 8 * hh;
    bf16x8 kf[4];
#pragma unroll
    for (int s = 0; s < 4; ++s) kf[s] = *(const GAS bf16x8*)(kr_ + 16 * s);
    f32x16 sc;
#pragma unroll
    for (int i = 0; i < 16; ++i) sc[i] = 0.f;
#pragma unroll
    for (int s = 0; s < 4; ++s) sc = __builtin_amdgcn_mfma_f32_32x32x16_bf16(kf[s], qf[s], sc, 0, 0, 0);
    unsigned vf[2][2][4];
#pragma unroll
    for (int s2 = 0; s2 < 2; ++s2)
#pragma unroll
        for (int jp = 0; jp < 4; ++jp) {
            const int j0 = 2 * jp, key0 = 16 * s2 + 8 * (j0 >> 2) + 4 * hh + (j0 & 3);
            int kp0 = kb + key0 * ks, kp1 = kp0 + ks; kp0 = kp0 < 0 ? 0 : kp0; kp1 = kp1 < 0 ? 0 : kp1;
            const bf16* v0 = Vcol + (size_t)(rowb + kp0) * NPROJ_P + r32; const bf16* v1 = Vcol + (size_t)(rowb + kp1) * NPROJ_P + r32;
            vf[0][s2][jp] = (unsigned)v0[0] | ((unsigned)v1[0] << 16); vf[1][s2][jp] = (unsigned)v0[32] | ((unsigned)v1[32] << 16);
        }
    float tmax = -INFINITY;
#pragma unroll
    for (int r = 0; r < 16; ++r) {
        const int kr = (r & 3) + 8 * (r >> 2) + 4 * hh, kp = kb + kr * ks, dist = qpos - kp;
        const bool ok = sel && dist >= 0 && dist <= maxd && kp >= 0;
        const float v = sc[r] * (0.125f * LOG2E) + biasT[ok ? dist : 0];
        sc[r] = ok ? v : -INFINITY; tmax = fmaxf(tmax, sc[r]);
    }
    tmax = fmaxf(tmax, __shfl_xor(tmax, 32));
    const float mn = fmaxf(st.m, tmax), scale = __builtin_amdgcn_exp2f(st.m - mn); st.m = mn;
    float ls = 0.f;
#pragma unroll
    for (int r = 0; r < 16; ++r) { sc[r] = __builtin_amdgcn_exp2f(sc[r] - mn); ls += sc[r]; }
    st.l = st.l * scale + ls;
#pragma unroll
    for (int i = 0; i < 16; ++i) { st.o0[i] *= scale; st.o1[i] *= scale; }
    typedef unsigned u32x4_t __attribute__((ext_vector_type(4)));
#pragma unroll
    for (int s2 = 0; s2 < 2; ++s2) {
        u32x4_t pw; pw.x = pg8::cvt_pk_bf16(sc[8 * s2], sc[8 * s2 + 1]); pw.y = pg8::cvt_pk_bf16(sc[8 * s2 + 2], sc[8 * s2 + 3]); pw.z = pg8::cvt_pk_bf16(sc[8 * s2 + 4], sc[8 * s2 + 5]); pw.w = pg8::cvt_pk_bf16(sc[8 * s2 + 6], sc[8 * s2 + 7]);
        const bf16x8 pf = __builtin_bit_cast(bf16x8, pw);
        u32x4_t a0 = {vf[0][s2][0], vf[0][s2][1], vf[0][s2][2], vf[0][s2][3]}, a1 = {vf[1][s2][0], vf[1][s2][1], vf[1][s2][2], vf[1][s2][3]};
        st.o0 = __builtin_amdgcn_mfma_f32_32x32x16_bf16(__builtin_bit_cast(bf16x8, a0), pf, st.o0, 0, 0, 0);
        st.o1 = __builtin_amdgcn_mfma_f32_32x32x16_bf16(__builtin_bit_cast(bf16x8, a1), pf, st.o1, 0, 0, 0);
    }
}
__device__ __forceinline__ void attn_loadq(bf16x8 (&qf)[4], const bf16* Qcol, int row, int hh) {
    const bf16* q = Qcol + (size_t)row * NPROJ_P + 8 * hh;
#pragma unroll
    for (int s = 0; s < 4; ++s) qf[s] = *(const GAS bf16x8*)(q + 16 * s);
}
__device__ __forceinline__ void attn_store(const f32x16& o0, const f32x16& o1, float inv, bf16* yrow, int hh) {
#pragma unroll
    for (int g = 0; g < 4; ++g) {
        *(GAS v2u*)(yrow + 8 * g + 4 * hh) = (v2u){pk2(o0[4 * g] * inv, o0[4 * g + 1] * inv), pk2(o0[4 * g + 2] * inv, o0[4 * g + 3] * inv)};
        *(GAS v2u*)(yrow + 32 + 8 * g + 4 * hh) = (v2u){pk2(o1[4 * g] * inv, o1[4 * g + 1] * inv), pk2(o1[4 * g + 2] * inv, o1[4 * g + 3] * inv)};
    }
}
__device__ __forceinline__ void build_bias(LAS float* biasT, int hcol, int tid) {
    const f32x4 bv = *(const GAS f32x4*)((const float*)(wsp() + WS_SMALL + SM_BIAS) + hcol * 2048 + 4 * tid); const v4u tv = *(const GAS v4u*)((const unsigned*)(wsp() + WS_SMALL + SM_TB) + 4 * tid);
    *(LAS f32x4*)(biasT + 4 * tid) = bv; *(LAS v4u*)((LAS unsigned*)(biasT + 2048) + 4 * tid) = tv;
}

constexpr int MC_KP = 144, MC_VP = 192, MC_KB = 128 * MC_KP, MC_VB = 128 * MC_VP, MC_K_OFF = 16384, MC_V_OFF = MC_K_OFF + 2 * MC_KB, MC_LDS = MC_V_OFF + 2 * MC_VB;
typedef short v4i16_t __attribute__((ext_vector_type(4)));
__device__ __forceinline__ float pl32_max(float a) { float x = a, y = a;
    asm volatile("s_nop 1\n\tv_permlane32_swap_b32_e32 %0, %1\n\ts_nop 0" : "+v"(x), "+v"(y));
    return fmaxf(x, y); }
template <int MODE> __device__ __forceinline__ void moba_tile(AttnSt& st, const bf16x8 (&qf)[4], const LAS unsigned char* Kt, const LAS unsigned char* Vt, const LAS float* biasT, const LAS int* TB, int dlo, bool sel, int lane, int r32, int hh) {
    bf16x8 kf[4];
#pragma unroll
    for (int s = 0; s < 4; ++s) kf[s] = *(const LAS bf16x8*)(Kt + r32 * MC_KP + 32 * s + 16 * hh);
    v4i16_t vt[2][2][2];
    { const LAS unsigned char* vb = Vt + (4 * hh + ((lane & 15) >> 2)) * MC_VP + (16 * ((lane >> 4) & 1) + 4 * (lane & 3)) * 2;
#pragma unroll
      for (int dh = 0; dh < 2; ++dh)
#pragma unroll
        for (int s2 = 0; s2 < 2; ++s2)
#pragma unroll
            for (int h8 = 0; h8 < 2; ++h8) vt[dh][s2][h8] = __builtin_amdgcn_ds_read_tr16_b64_v4i16((LAS v4i16_t*)(vb + (16 * s2 + 8 * h8) * MC_VP + 64 * dh)); }
    f32x16 sc;
#pragma unroll
    for (int i = 0; i < 16; ++i) sc[i] = 0.f;
#pragma unroll
    for (int s = 0; s < 4; ++s) sc = __builtin_amdgcn_mfma_f32_32x32x16_bf16(kf[s], qf[s], sc, 0, 0, 0);
    const int d0 = dlo + r32 + 31 - 4 * hh;
    const int dmin = dlo < 0 ? 0 : dlo, dmax = dlo + 62;
    const bool uni = __builtin_amdgcn_readfirstlane(TB[dmin]) == __builtin_amdgcn_readfirstlane(TB[dmax]);
    float tmax = -INFINITY;
    if (uni) { const float bu = biasT[dmin];
#pragma unroll
        for (int r = 0; r < 16; ++r) { float v = sc[r] * (0.125f * LOG2E) + bu; if (MODE == 1) { const int dist = d0 - (r & 3) - 8 * (r >> 2); v = dist >= 0 ? v : -INFINITY; } sc[r] = v; tmax = fmaxf(tmax, v); }
    } else {
#pragma unroll
        for (int r = 0; r < 16; ++r) { const int dist = d0 - (r & 3) - 8 * (r >> 2); float v = sc[r] * (0.125f * LOG2E) + biasT[dist < 0 ? 0 : dist]; if (MODE == 1) v = dist >= 0 ? v : -INFINITY; sc[r] = v; tmax = fmaxf(tmax, v); }
    }
    if (MODE == 2) tmax = sel ? tmax : -INFINITY;
    tmax = pl32_max(tmax);
    const float mn = fmaxf(st.m, tmax);
    if (__ballot(mn > st.m) != 0ull) { const float scale = __builtin_amdgcn_exp2f(st.m - mn); st.l *= scale;
#pragma unroll
        for (int i = 0; i < 16; ++i) { st.o0[i] *= scale; st.o1[i] *= scale; } }
    st.m = mn;
    const float msub = (MODE == 2 && !sel) ? INFINITY : mn;
    float ls = 0.f;
#pragma unroll
    for (int r = 0; r < 16; ++r) { sc[r] = __builtin_amdgcn_exp2f(sc[r] - msub); ls += sc[r]; }
    st.l += ls;
    typedef unsigned u32x4_t __attribute__((ext_vector_type(4)));
#pragma unroll
    for (int s2 = 0; s2 < 2; ++s2) {
        u32x4_t pw; pw.x = pg8::cvt_pk_bf16(sc[8 * s2], sc[8 * s2 + 1]); pw.y = pg8::cvt_pk_bf16(sc[8 * s2 + 2], sc[8 * s2 + 3]); pw.z = pg8::cvt_pk_bf16(sc[8 * s2 + 4], sc[8 * s2 + 5]); pw.w = pg8::cvt_pk_bf16(sc[8 * s2 + 6], sc[8 * s2 + 7]);
        const bf16x8 pf = __builtin_bit_cast(bf16x8, pw);
        const bf16x8 a0 = {vt[0][s2][0][0], vt[0][s2][0][1], vt[0][s2][0][2], vt[0][s2][0][3], vt[0][s2][1][0], vt[0][s2][1][1], vt[0][s2][1][2], vt[0][s2][1][3]};
        const bf16x8 a1 = {vt[1][s2][0][0], vt[1][s2][0][1], vt[1][s2][0][2], vt[1][s2][0][3], vt[1][s2][1][0], vt[1][s2][1][1], vt[1][s2][1][2], vt[1][s2][1][3]};
        st.o0 = __builtin_amdgcn_mfma_f32_32x32x16_bf16(a0, pf, st.o0, 0, 0, 0);
        st.o1 = __builtin_amdgcn_mfma_f32_32x32x16_bf16(a1, pf, st.o1, 0, 0, 0);
    }
}
__device__ __forceinline__ void moba_unit(LAS unsigned char* lds, int unit, int tid, int l) {
    const int ob = unit & 7, h = (unit >> 3) & 7, b = unit >> 6, lane = tid & 63, wave = __builtin_amdgcn_readfirstlane(tid >> 6), r32 = lane & 31, hh = lane >> 5;
    LAS float* biasT = (LAS float*)lds;
    build_bias(biasT, 8 + h, tid);
    const bf16* PROJ = (const bf16*)(wsp() + WS_PROJ); const float* KBAR = (const float*)(wsp() + CTL_KBAR) + (size_t)l * 64 * 8 * 64 + ((b * NH + h) * 8) * 64; const LAS int* TB = (const LAS int*)(biasT + 2048);
    const int rowb = b * SEQ, qpos = 256 * ob + 32 * wave + r32;
    bf16x8 qf[4]; attn_loadq(qf, PROJ + CC_Q + 64 * h, rowb + qpos, hh);
    float gate[8];
#pragma unroll
    for (int n = 0; n < 8; ++n) { float s = 0.f;
        if (n < ob) {
#pragma unroll
            for (int s4 = 0; s4 < 4; ++s4) { const f32x4 k0 = *(const GAS f32x4*)(KBAR + n * 64 + 16 * s4 + 8 * hh), k1 = *(const GAS f32x4*)(KBAR + n * 64 + 16 * s4 + 8 * hh + 4);
                const v4u qw = __builtin_bit_cast(v4u, qf[s4]);
                s += bflo(qw.x) * k0.x + bfhi(qw.x) * k0.y + bflo(qw.y) * k0.z + bfhi(qw.y) * k0.w + bflo(qw.z) * k1.x + bfhi(qw.z) * k1.y + bflo(qw.w) * k1.z + bfhi(qw.w) * k1.w; }
            s += __shfl_xor(s, 32); }
        gate[n] = s; }
    unsigned selm = 0u;
#pragma unroll
    for (int n = 0; n < 8; ++n) { int rank = 0;
#pragma unroll
        for (int n2 = 0; n2 < 8; ++n2) rank += (n2 < ob && n2 != n && (gate[n2] > gate[n] || (gate[n2] == gate[n] && n2 < n))) ? 1 : 0;
        if (n < ob && rank < 3) selm |= 1u << n; }
    AttnSt st; attn_init(st);
    const int skey = tid >> 2, spart = tid & 3;
    const bf16* Kg = PROJ + (size_t)rowb * NPROJ_P + CC_K + 64 * h + 16 * spart; const bf16* Vg = PROJ + (size_t)rowb * NPROJ_P + CC_V + 64 * h + 16 * spart;
    bf16x8 gk0, gk1, gv0, gv1;
#define MC_GLOAD(i) do { const size_t ro_ = (size_t)(128 * (i) + skey) * NPROJ_P; gk0 = *(const GAS bf16x8*)(Kg + ro_); gk1 = *(const GAS bf16x8*)(Kg + ro_ + 8); gv0 = *(const GAS bf16x8*)(Vg + ro_); gv1 = *(const GAS bf16x8*)(Vg + ro_ + 8); } while (0)
#define MC_LSTORE(bf) do { LAS unsigned char* kd_ = lds + MC_K_OFF + (bf) * MC_KB + skey * MC_KP + 32 * spart; *(LAS bf16x8*)(kd_) = gk0; *(LAS bf16x8*)(kd_ + 16) = gk1; \
        LAS unsigned char* vd_ = lds + MC_V_OFF + (bf) * MC_VB + skey * MC_VP + 32 * spart; *(LAS bf16x8*)(vd_) = gv0; *(LAS bf16x8*)(vd_ + 16) = gv1; } while (0)
    const int nst = 2 * (ob + 1);
    MC_GLOAD(0); MC_LSTORE(0);
    __syncthreads();
    for (int i = 0; i < nst; ++i) {
        if (i + 1 < nst) MC_GLOAD(i + 1);
        const int n = i >> 1, hf = i & 1; const bool own = n == ob, sel = own || ((selm >> n) & 1u);
        const LAS unsigned char* Kb = lds + MC_K_OFF + (i & 1) * MC_KB; const LAS unsigned char* Vb = lds + MC_V_OFF + (i & 1) * MC_VB;
        if (own) {
#pragma unroll 1
            for (int sub = 0; sub < 4; ++sub) { const int jt = 4 * hf + sub; if (jt > wave) break; const int dlo = 32 * wave - (32 * jt + 31);
                if (jt == wave) moba_tile<1>(st, qf, Kb + sub * 32 * MC_KP, Vb + sub * 32 * MC_VP, biasT, TB, dlo, true, lane, r32, hh);
                else moba_tile<0>(st, qf, Kb + sub * 32 * MC_KP, Vb + sub * 32 * MC_VP, biasT, TB, dlo, true, lane, r32, hh); }
        } else if (__ballot(sel) != 0ull) {
#pragma unroll 1
            for (int sub = 0; sub < 4; ++sub) { const int dlo = 256 * ob + 32 * wave - (256 * n + 128 * hf + 32 * sub + 31);
                moba_tile<2>(st, qf, Kb + sub * 32 * MC_KP, Vb + sub * 32 * MC_VP, biasT, TB, dlo, sel, lane, r32, hh); }
        }
        if (i + 1 < nst) MC_LSTORE((i + 1) & 1);
        __syncthreads();
    }
#undef MC_GLOAD
#undef MC_LSTORE
    const float lt = st.l + __shfl_xor(st.l, 32);
    attn_store(st.o0, st.o1, 1.0f / lt, (bf16*)(wsp() + WS_YCAT) + (size_t)(rowb + qpos) * DM + 2 * GW + 64 * h, hh);
}

constexpr int MA_PITCH = 144, MA_ML_OFF = 512 * MA_PITCH, MA_BIAS_OFF = MA_ML_OFF + 512 * 8, MA_V_OFF = MA_BIAS_OFF + 16384, MA_VW = 32 * MC_VP, MA_LDS = MA_V_OFF + 8 * MA_VW;
template <bool MASKED> __device__ __forceinline__ void dil_tile(AttnSt& st, const bf16x8 (&qf)[4], const bf16x8 (&kf)[4], const LAS unsigned char* Vt, const LAS float* biasT, const LAS int* TB, int dl0, int dstep, int kb, int lane, int r32, int hh) {
    v4i16_t vt[2][2][2];
    { const LAS unsigned char* vb = Vt + (4 * hh + ((lane & 15) >> 2)) * MC_VP + (16 * ((lane >> 4) & 1) + 4 * (lane & 3)) * 2;
#pragma unroll
      for (int dh = 0; dh < 2; ++dh)
#pragma unroll
        for (int s2 = 0; s2 < 2; ++s2)
#pragma unroll
            for (int h8 = 0; h8 < 2; ++h8) vt[dh][s2][h8] = __builtin_amdgcn_ds_read_tr16_b64_v4i16((LAS v4i16_t*)(vb + (16 * s2 + 8 * h8) * MC_VP + 64 * dh)); }
    f32x16 sc;
#pragma unroll
    for (int i = 0; i < 16; ++i) sc[i] = 0.f;
#pragma unroll
    for (int s = 0; s < 4; ++s) sc = __builtin_amdgcn_mfma_f32_32x32x16_bf16(kf[s], qf[s], sc, 0, 0, 0);
    const int e0 = dl0 + r32 - 4 * hh;
    int dmin = (dl0 - 31) * dstep, dmax = (dl0 + 31) * dstep; dmin = dmin < 0 ? 0 : dmin; dmax = dmax > 2047 ? 2047 : dmax;
    const bool uni = __builtin_amdgcn_readfirstlane(TB[dmin]) == __builtin_amdgcn_readfirstlane(TB[dmax]);
    const float bu = biasT[dmin];
    float tmax = -INFINITY;
#pragma unroll
    for (int r = 0; r < 16; ++r) {
        const int kr0 = (r & 3) + 8 * (r >> 2), delta = e0 - kr0;
        float bias = bu;
        if (!uni) { int di = delta * dstep; di = di < 0 ? 0 : (di > 2047 ? 2047 : di); bias = biasT[di]; }
        float v = sc[r] * (0.125f * LOG2E) + bias;
        if (MASKED) { const bool ok = delta >= 0 && delta <= 128 && (kb + (kr0 + 4 * hh) * dstep) >= 0; v = ok ? v : -INFINITY; }
        sc[r] = v; tmax = fmaxf(tmax, v);
    }
    tmax = pl32_max(tmax);
    const float mn = fmaxf(st.m, tmax);
    if (__ballot(mn > st.m) != 0ull) { const float scale = __builtin_amdgcn_exp2f(st.m - mn); st.l *= scale;
#pragma unroll
        for (int i = 0; i < 16; ++i) { st.o0[i] *= scale; st.o1[i] *= scale; } }
    st.m = mn;
    float ls = 0.f;
#pragma unroll
    for (int r = 0; r < 16; ++r) { sc[r] = __builtin_amdgcn_exp2f(sc[r] - mn); ls += sc[r]; }
    st.l += ls;
    typedef unsigned u32x4_t __attribute__((ext_vector_type(4)));
#pragma unroll
    for (int s2 = 0; s2 < 2; ++s2) {
        u32x4_t pw; pw.x = pg8::cvt_pk_bf16(sc[8 * s2], sc[8 * s2 + 1]); pw.y = pg8::cvt_pk_bf16(sc[8 * s2 + 2], sc[8 * s2 + 3]); pw.z = pg8::cvt_pk_bf16(sc[8 * s2 + 4], sc[8 * s2 + 5]); pw.w = pg8::cvt_pk_bf16(sc[8 * s2 + 6], sc[8 * s2 + 7]);
        const bf16x8 pf = __builtin_bit_cast(bf16x8, pw);
        const bf16x8 a0 = {vt[0][s2][0][0], vt[0][s2][0][1], vt[0][s2][0][2], vt[0][s2][0][3], vt[0][s2][1][0], vt[0][s2][1][1], vt[0][s2][1][2], vt[0][s2][1][3]};
        const bf16x8 a1 = {vt[1][s2][0][0], vt[1][s2][0][1], vt[1][s2][0][2], vt[1][s2][0][3], vt[1][s2][1][0], vt[1][s2][1][1], vt[1][s2][1][2], vt[1][s2][1][3]};
        st.o0 = __builtin_amdgcn_mfma_f32_32x32x16_bf16(a0, pf, st.o0, 0, 0, 0);
        st.o1 = __builtin_amdgcn_mfma_f32_32x32x16_bf16(a1, pf, st.o1, 0, 0, 0);
    }
}
__device__ __forceinline__ void dil_unit(LAS unsigned char* lds, int unit, int tid) {
    const int sp = unit & 3, h = (unit >> 2) & 7, b = unit >> 5, lane = tid & 63, wave = __builtin_amdgcn_readfirstlane(tid >> 6), r32 = lane & 31, hh = lane >> 5;
    LAS float* biasT = (LAS float*)(lds + MA_BIAS_OFF);
    build_bias(biasT, h, tid);
    __syncthreads();
    const bf16* PROJ = (const bf16*)(wsp() + WS_PROJ); const LAS int* TB = (const LAS int*)(biasT + 2048); const int rowb = b * SEQ, t0 = 512 * sp;
    const bf16* Qc = PROJ + CA_Q + 64 * h; const bf16* Kc = PROJ + CA_K + 64 * h; const bf16* Vc = PROJ + CA_V + 64 * h;
    LAS unsigned char* Vst = lds + MA_V_OFF + wave * MA_VW;
    const int vkey = lane >> 1, vhalf = lane & 1;
#pragma unroll 1
    for (int p = 0; p < 3; ++p) {
        const int d = p == 0 ? 1 : (p == 1 ? 4 : 16);
#pragma unroll 1
        for (int gi = 0; gi < 2; ++gi) {
            const int g = 2 * wave + gi;
            const int qb = t0 + (p == 0 ? 32 * g : (p == 1 ? 128 * (g >> 2) + (g & 3) : g));
            const int qpos = qb + r32 * d, qi = qpos - t0;
            bf16x8 qf[4]; attn_loadq(qf, Qc, rowb + qpos, hh);
            AttnSt st; attn_init(st);
            int jt = 0; while (qb + (32 * jt - 128 + 31) * d < 0) ++jt;
            bf16x8 kfn[4], vrn[4];
#define MA_GLOAD(JT) do { const int kb_ = qb + (32 * (JT) - 128) * d; int kp_ = kb_ + r32 * d; kp_ = kp_ < 0 ? 0 : kp_; const bf16* kr_ = Kc + (size_t)(rowb + kp_) * NPROJ_P + 8 * hh; \
                _Pragma("unroll") for (int s = 0; s < 4; ++s) kfn[s] = *(const GAS bf16x8*)(kr_ + 16 * s); \
                int vp_ = kb_ + vkey * d; vp_ = vp_ < 0 ? 0 : vp_; const bf16* vr_ = Vc + (size_t)(rowb + vp_) * NPROJ_P + 32 * vhalf; \
                _Pragma("unroll") for (int s = 0; s < 4; ++s) vrn[s] = *(const GAS bf16x8*)(vr_ + 8 * s); } while (0)
            MA_GLOAD(jt);
#pragma unroll 1
            for (; jt < 5; ++jt) {
                bf16x8 kf[4] = {kfn[0], kfn[1], kfn[2], kfn[3]};
                { LAS unsigned char* vd = Vst + vkey * MC_VP + 64 * vhalf;
#pragma unroll
                  for (int s = 0; s < 4; ++s) *(LAS bf16x8*)(vd + 16 * s) = vrn[s]; }
                asm volatile("" ::: "memory");
                if (jt + 1 < 5) MA_GLOAD(jt + 1);
                const int kb = qb + (32 * jt - 128) * d, dl0 = 128 - 32 * jt;
                if (jt == 0 || jt == 4 || kb < 0) dil_tile<true>(st, qf, kf, Vst, biasT, TB, dl0, d, kb, lane, r32, hh);
                else dil_tile<false>(st, qf, kf, Vst, biasT, TB, dl0, d, kb, lane, r32, hh);
            }
#undef MA_GLOAD
            float lt = st.l + __shfl_xor(st.l, 32);
            LAS unsigned char* orow = lds + qi * MA_PITCH; LAS float* ml = (LAS float*)(lds + MA_ML_OFF + qi * 8);
            if (p > 0) {
                const float mo = ml[0], lo = ml[1], mn = fmaxf(mo, st.m), fo = __builtin_amdgcn_exp2f(mo - mn), fc = __builtin_amdgcn_exp2f(st.m - mn);
                lt = lo * fo + lt * fc;
#pragma unroll
                for (int g4 = 0; g4 < 4; ++g4) { const v2u a = *(const LAS v2u*)(orow + 2 * (8 * g4 + 4 * hh)), c = *(const LAS v2u*)(orow + 64 + 2 * (8 * g4 + 4 * hh));
                    const float av[4] = {bflo(a.x), bfhi(a.x), bflo(a.y), bfhi(a.y)}, cv[4] = {bflo(c.x), bfhi(c.x), bflo(c.y), bfhi(c.y)};
#pragma unroll
                    for (int e = 0; e < 4; ++e) { st.o0[4 * g4 + e] = av[e] * fo + st.o0[4 * g4 + e] * fc; st.o1[4 * g4 + e] = cv[e] * fo + st.o1[4 * g4 + e] * fc; } }
                st.m = mn;
            }
            if (p < 2) {
#pragma unroll
                for (int g4 = 0; g4 < 4; ++g4) { *(LAS v2u*)(orow + 2 * (8 * g4 + 4 * hh)) = (v2u){pk2(st.o0[4 * g4], st.o0[4 * g4 + 1]), pk2(st.o0[4 * g4 + 2], st.o0[4 * g4 + 3])};
                    *(LAS v2u*)(orow + 64 + 2 * (8 * g4 + 4 * hh)) = (v2u){pk2(st.o1[4 * g4], st.o1[4 * g4 + 1]), pk2(st.o1[4 * g4 + 2], st.o1[4 * g4 + 3])}; }
                if (hh == 0) { ml[0] = st.m; ml[1] = lt; }
            } else attn_store(st.o0, st.o1, 1.0f / lt, (bf16*)(wsp() + WS_YCAT) + (size_t)(rowb + qpos) * DM + 0 * GW + 64 * h, hh);
        }
        __syncthreads();
    }
}

constexpr int SG_PITCH = 144, SG_WAVE = 128 * SG_PITCH, SG_OP = 272;
static_assert(8 * SG_WAVE <= MISC_OFF && 32 * SG_OP <= SG_WAVE, "SGU LDS");
__device__ __forceinline__ void sgu_unit(LAS unsigned char* lds, int unit, int tid, int l) {
    const int lane = tid & 63, g = __builtin_amdgcn_readfirstlane(tid >> 6), r32 = lane & 31, hh = lane >> 5, m0 = unit * 128;
    const bf16* PROJ = (const bf16*)(wsp() + WS_PROJ); bf16* YC = (bf16*)(wsp() + WS_YCAT); const pg8::fx_t* ST = (const pg8::fx_t*)(wsp() + CTL_STATS) + (size_t)l * M * 2;
    const float* lng = inp(4) + l * GW; const float* sw = inp(5) + ((size_t)l * NH + g) * 128 * 128; const float* sb = inp(6) + (l * NH + g) * 128;
    LAS unsigned char* T = lds + g * SG_WAVE;
    const int tk8 = lane >> 3, part = lane & 7;
    { const f32x4 g0 = *(const GAS f32x4*)(lng + 64 * g + 8 * part), g1 = *(const GAS f32x4*)(lng + 64 * g + 8 * part + 4);
      const float gn[8] = {g0.x, g0.y, g0.z, g0.w, g1.x, g1.y, g1.z, g1.w};
#pragma unroll 4
      for (int i = 0; i < 16; ++i) { const int tkn = tk8 + 8 * i, mm = m0 + tkn;
          const v4u w = *(const GAS v4u*)(PROJ + (size_t)mm * NPROJ_P + CB_V + 64 * g + 8 * part);
          const float mu = pg8::fx_get(ST + 2 * mm) * (1.0f / 512.0f), rs = __builtin_amdgcn_rsqf(fmaxf(pg8::fx_get(ST + 2 * mm + 1) * (1.0f / 512.0f) - mu * mu, 0.f) + 1e-5f);
          float x[8] = {bflo(w.x), bfhi(w.x), bflo(w.y), bfhi(w.y), bflo(w.z), bfhi(w.z), bflo(w.w), bfhi(w.w)};
#pragma unroll
          for (int e = 0; e < 8; ++e) x[e] = (gelu_tanh(x[e]) - mu) * rs * gn[e];
          *(LAS v4u*)(T + tkn * SG_PITCH + 16 * part) = (v4u){pk2(x[0], x[1]), pk2(x[2], x[3]), pk2(x[4], x[5]), pk2(x[6], x[7])}; } }
    asm volatile("" ::: "memory");
    f32x16 acc[4][2];
    const float z_ = zero_v();
#pragma unroll
    for (int tt = 0; tt < 4; ++tt)
#pragma unroll
        for (int ct = 0; ct < 2; ++ct)
#pragma unroll
            for (int i = 0; i < 16; ++i) acc[tt][ct][i] = z_;
    const LAS unsigned char* vb = T + (8 * hh + ((lane & 15) >> 2)) * SG_PITCH + (16 * ((lane >> 4) & 1) + 4 * (lane & 3)) * 2;
#pragma unroll
    for (int k = 0; k < 8; ++k) {
        v4i16_t t00 = __builtin_amdgcn_ds_read_tr16_b64_v4i16((LAS v4i16_t*)(vb + (16 * k) * SG_PITCH)), t01 = __builtin_amdgcn_ds_read_tr16_b64_v4i16((LAS v4i16_t*)(vb + (16 * k + 4) * SG_PITCH));
        v4i16_t t10 = __builtin_amdgcn_ds_read_tr16_b64_v4i16((LAS v4i16_t*)(vb + (16 * k) * SG_PITCH + 64)), t11 = __builtin_amdgcn_ds_read_tr16_b64_v4i16((LAS v4i16_t*)(vb + (16 * k + 4) * SG_PITCH + 64));
        const bf16x8 af0 = {t00[0], t00[1], t00[2], t00[3], t01[0], t01[1], t01[2], t01[3]}, af1 = {t10[0], t10[1], t10[2], t10[3], t11[0], t11[1], t11[2], t11[3]};
#pragma unroll
        for (int tt = 0; tt < 4; ++tt) { if (k < 2 * (tt + 1)) {
                const int t = 32 * tt + r32, s0 = 16 * k + 8 * hh; const float* wrow = sw + (size_t)t * 128 + s0;
                const f32x4 w0 = *(const GAS f32x4*)(wrow), w1 = *(const GAS f32x4*)(wrow + 4);
                float wv[8] = {w0.x, w0.y, w0.z, w0.w, w1.x, w1.y, w1.z, w1.w};
#pragma unroll
                for (int j = 0; j < 8; ++j) wv[j] = (s0 + j <= t) ? wv[j] : 0.f;
                const v4u bw = {pk2(wv[0], wv[1]), pk2(wv[2], wv[3]), pk2(wv[4], wv[5]), pk2(wv[6], wv[7])}; const bf16x8 bfr = __builtin_bit_cast(bf16x8, bw);
                acc[tt][0] = __builtin_amdgcn_mfma_f32_32x32x16_bf16(af0, bfr, acc[tt][0], 0, 0, 0); acc[tt][1] = __builtin_amdgcn_mfma_f32_32x32x16_bf16(af1, bfr, acc[tt][1], 0, 0, 0); } }
    }
    asm volatile("" ::: "memory");
#pragma unroll
    for (int tt = 0; tt < 4; ++tt) {
        const float bias = sb[32 * tt + r32];
#pragma unroll
        for (int ct = 0; ct < 2; ++ct)
#pragma unroll
            for (int g4 = 0; g4 < 4; ++g4) { const f32x16& a = acc[tt][ct];
                *(LAS f32x4*)(T + r32 * SG_OP + 4 * (32 * ct + 8 * g4 + 4 * hh)) = (f32x4){a[4 * g4] + bias, a[4 * g4 + 1] + bias, a[4 * g4 + 2] + bias, a[4 * g4 + 3] + bias}; }
        asm volatile("" ::: "memory");
#pragma unroll
        for (int i = 0; i < 4; ++i) { const int tkn = tk8 + 8 * i, mm = m0 + 32 * tt + tkn;
            const v4u uw = *(const GAS v4u*)(PROJ + (size_t)mm * NPROJ_P + CB_U + 64 * g + 8 * part);
            const f32x4 x0 = *(const LAS f32x4*)(T + tkn * SG_OP + 32 * part), x1 = *(const LAS f32x4*)(T + tkn * SG_OP + 32 * part + 16);
            const float u[8] = {bflo(uw.x), bfhi(uw.x), bflo(uw.y), bfhi(uw.y), bflo(uw.z), bfhi(uw.z), bflo(uw.w), bfhi(uw.w)};
            *(GAS v4u*)(YC + (size_t)mm * DM + GW + 64 * g + 8 * part) = (v4u){pk2(gelu_tanh(u[0]) * x0.x, gelu_tanh(u[1]) * x0.y), pk2(gelu_tanh(u[2]) * x0.z, gelu_tanh(u[3]) * x0.w), pk2(gelu_tanh(u[4]) * x1.x, gelu_tanh(u[5]) * x1.y), pk2(gelu_tanh(u[6]) * x1.z, gelu_tanh(u[7]) * x1.w)}; }
        asm volatile("" ::: "memory");
    }
}

#ifndef SIMPLE_A
#define SIMPLE_A 0
#endif
#ifndef SIMPLE_B
#define SIMPLE_B 0
#endif
#ifndef SIMPLE_C
#define SIMPLE_C 0
#endif
#ifndef SIMPLE_D
#define SIMPLE_D 0
#endif
__device__ __forceinline__ void ph_mixers(LAS unsigned char* L, int l, int phase, int qoff, int wv, int mask = 31) {
    Frame F = mkframe(L, wv);
    volatile LAS int* qslot = (volatile LAS int*)(L + MISC_OFF + 64);
    gu32* ctr = ctlp() + CW_Q + 64 * phase + qoff;
    constexpr int I_IN = (DM / 64) * (NPROJ / 32), I_REST = (I8_OUT ? 0 : (DM / 64) * (DM / 32)) + (FFN1_I8 ? 0 : 2 * (DM / 64) * (DFF / 32)) + (DFF / 64) * (DM / 32);
    const int n_scan = (SIMPLE_D || !(mask & 1)) ? 0 : 128, n_c = (SIMPLE_C || !(mask & 2)) ? 0 : 512, n_a = (SIMPLE_A || !(mask & 4)) ? 0 : 256, n_b = (SIMPLE_B || !(mask & 8)) ? 0 : 128;
    const int n_cin = ((l + 1 < DEPTH) && (mask & 16)) ? (I8_IN ? NPROJ / 32 + (WINB_ITEMS + 7) / 8 : (I_IN + 7) / 8) : 0, n_crest = (mask & 16) ? (I_REST + 7) / 8 : 0, n_cout = ((I8_OUT && (mask & 16)) ? DM / 32 : 0) + ((FFN1_I8 && (mask & 16)) ? 2 * (DFF / 32) : 0);
    const int e_scan = n_scan, e_a = e_scan + n_a, e_b = e_a + n_b, e_c = e_b + n_c, e_cout = e_c + n_cout, e_cin = e_cout + n_cin, e_crest = e_cin + n_crest;
    for (;;) {
        if (F.tid == 0) *qslot = (int)__hip_atomic_fetch_add(ctr, 1u, RLX_AGENT);
        __syncthreads();
        const int it = __builtin_amdgcn_readfirstlane(*qslot);
        __syncthreads();
        if (it >= e_crest) break;
        int tid = wv * 64 + pg8::lane_now(); asm volatile("" : "+v"(tid));
        if (it < e_scan) scan_unit(L, it, tid);
        else if (it < e_a) dil_unit(L, it - e_scan, tid);
        else if (it < e_b) { sgu_unit(L, it - e_a, tid, l); __syncthreads(); }
        else if (it < e_c) { const int i2 = it - e_b; moba_unit(L, (i2 & 63) * 8 + (7 - (i2 >> 6)), tid, l); }
        else if (it < e_cout) { Frame F2 = mkframe(L, wv); int r = it - e_c;
            if (I8_OUT && r < DM / 32) conv_cols_i8(inp(19) + (size_t)l * DM * DM, DM, DM, inp(18) + l * DM, wsp() + WS_WOUT, (float*)(wsp() + WS_SMALL + SM_SWOUT), r, F2);
            else { r -= I8_OUT ? DM / 32 : 0; const int up = r >= DFF / 32 ? 1 : 0, nb = r - up * (DFF / 32), n0 = 32 * nb;
                conv_cols_i8(inp(up ? 22 : 21) + (size_t)l * DM * DFF, DM, DFF, inp(20) + l * DM, wsp() + WS_WGU, (float*)(wsp() + WS_SMALL + SM_SWGU), nb, F2, (n0 >> 7) * 256 + up * 128 + (n0 & 127)); } }
        else if (it < e_cin) { Frame F2 = mkframe(L, wv);
            if (I8_IN) { if (it - e_cout < NPROJ / 32) conv_cols_i8(inp(2) + (size_t)(l + 1) * DM * NPROJ, DM, NPROJ, inp(1) + (l + 1) * DM, wsp() + WS_WIN, (float*)(wsp() + WS_SMALL + SM_SWIN), it - e_cout, F2);
                else conv_winb(F2, l + 1, (it - e_cout - NPROJ / 32) * 8 + F2.wave); }
            else conv_layer_items(F2, l + 1, (it - e_cout) * 8 + F2.wave, 1 << 30, true, false); }
        else { Frame F2 = mkframe(L, wv); conv_layer_items(F2, l, (it - e_cin) * 8 + F2.wave, 1 << 30, false, true); }
    }
    if (!I8_IN && l + 1 < DEPTH) {
        bf16* WIN = (bf16*)(wsp() + WS_WIN);
        Frame F3 = mkframe(L, wv);
        for (int i = F3.gw * 64 + F3.lane; i < 64 * DM / 8; i += F3.ngw * 64) { v4u z = {0u, 0u, 0u, 0u}; asm volatile("" : "+v"(z)); *(GAS v4u*)(WIN + (size_t)NPROJ * DM + (size_t)i * 8) = z; }
    }
    if (SIMPLE_D) mix_d_simple(F);
    if (SIMPLE_A) mix_a_simple(F);
    if (SIMPLE_C) mix_c_simple(F, l);
    if (SIMPLE_B) mix_b_simple(F, l);
}

__device__ __forceinline__ void ph_finalize(Frame& F, int l) {
    bf16* YC = (bf16*)(wsp() + WS_YCAT); const float* YD = (const float*)(wsp() + WS_YD); const bf16* V_ = (const bf16*)outp() + (size_t)3 * M * GW; const bf16* G_ = (const bf16*)(wsp() + WS_G); const float* BC = (const float*)(wsp() + WS_BC);
    const float* lng = inp(16) + l * GW; const float* lnb = inp(17) + l * GW;
    for (int m = F.gw; m < M; m += F.ngw) {
        const int c0 = 8 * F.lane, hd = F.lane >> 3;
        float y[8];
        { const GAS f32x4* yp = (const GAS f32x4*)(YD + (size_t)m * GW + c0); const f32x4 a = yp[0], b = yp[1]; y[0] = a.x; y[1] = a.y; y[2] = a.z; y[3] = a.w; y[4] = b.x; y[5] = b.y; y[6] = b.z; y[7] = b.w; }
        float s = 0.f;
#pragma unroll
        for (int i = 0; i < 8; ++i) s += y[i];
        s += __shfl_xor(s, 1); s += __shfl_xor(s, 2); s += __shfl_xor(s, 4); const float mean = s * (1.0f / 64.0f); float q = 0.f;
#pragma unroll
        for (int i = 0; i < 8; ++i) { const float d = y[i] - mean; q += d * d; }
        q += __shfl_xor(q, 1); q += __shfl_xor(q, 2); q += __shfl_xor(q, 4); const float rstd = 1.0f / sqrtf(q * (1.0f / 64.0f) + 64e-5f);
        const v4u vw = *(const GAS v4u*)(V_ + (size_t)m * GW + c0), gw4 = *(const GAS v4u*)(G_ + (size_t)m * GW + c0); const float bc = BC[(size_t)m * NH + hd];
        float vv[8], gg[8]; UNPACK8(vv, 0, vw); UNPACK8(gg, 0, gw4);
        float ss = 0.f;
#pragma unroll
        for (int i = 0; i < 8; ++i) { y[i] = ((y[i] - mean) * rstd * lng[c0 + i] + lnb[c0 + i] + bc * vv[i]) * gg[i]; ss += y[i] * y[i]; }
        if (I8_OUT) {
            float xn[3][8], mx = 0.f;
            { const float rs = 1.0f / sqrtf(wave_sum(ss) * (1.0f / 512.0f) + NORM_EPS);
#pragma unroll
              for (int i = 0; i < 8; ++i) { y[i] *= rs; mx = fmaxf(mx, fabsf(y[i])); } }
#pragma unroll
            for (int br = 0; br < 3; ++br) {
                const v4u w = *(const GAS v4u*)(YC + (size_t)m * DM + br * GW + c0); UNPACK8(xn[br], 0, w); float s2 = 0.f;
#pragma unroll
                for (int i = 0; i < 8; ++i) s2 += xn[br][i] * xn[br][i];
                const float rs = 1.0f / sqrtf(wave_sum(s2) * (1.0f / 512.0f) + NORM_EPS);
#pragma unroll
                for (int i = 0; i < 8; ++i) { xn[br][i] *= rs; mx = fmaxf(mx, fabsf(xn[br][i])); }
            }
            mx = wave_max(mx); const float inv = mx > 0.f ? 127.0f / mx : 0.f; unsigned char* yq = wsp() + WS_YQ + (size_t)m * DM + c0;
#pragma unroll
            for (int br = 0; br < 3; ++br) *(GAS v2u*)(yq + br * GW) = (v2u){q8pack4(xn[br][0], xn[br][1], xn[br][2], xn[br][3], inv), q8pack4(xn[br][4], xn[br][5], xn[br][6], xn[br][7], inv)};
            *(GAS v2u*)(yq + 3 * GW) = (v2u){q8pack4(y[0], y[1], y[2], y[3], inv), q8pack4(y[4], y[5], y[6], y[7], inv)};
            if (F.lane == 0) ((float*)(wsp() + WS_SMALL + SM_SAY))[m] = mx * (1.0f / 127.0f);
            continue;
        }
        { const float rs = 1.0f / sqrtf(wave_sum(ss) * (1.0f / 512.0f) + NORM_EPS);
          *(GAS v4u*)(YC + (size_t)m * DM + 3 * GW + c0) = (v4u){pk2(y[0] * rs, y[1] * rs), pk2(y[2] * rs, y[3] * rs), pk2(y[4] * rs, y[5] * rs), pk2(y[6] * rs, y[7] * rs)}; }
#pragma unroll
        for (int br = 0; br < 3; ++br) {
            GAS v4u* p = (GAS v4u*)(YC + (size_t)m * DM + br * GW + c0); const v4u w = *p;
            float x[8]; UNPACK8(x, 0, w); float s2 = 0.f;
#pragma unroll
            for (int i = 0; i < 8; ++i) s2 += x[i] * x[i];
            const float rs = 1.0f / sqrtf(wave_sum(s2) * (1.0f / 512.0f) + NORM_EPS);
            *p = (v4u){pk2(x[0] * rs, x[1] * rs), pk2(x[2] * rs, x[3] * rs), pk2(x[4] * rs, x[5] * rs), pk2(x[6] * rs, x[7] * rs)};
        }
    }
}
__device__ __forceinline__ void ph_final(Frame& F) {
    const pg8::fx_t* ssq = (const pg8::fx_t*)(ctlp() + CW_SSQ) + 4 * M; const float* g = inp(24); float* out = outp(); const bf16* XB = (const bf16*)(wsp() + WS_XB);
    for (int m = F.gw; m < M; m += F.ngw) {
        const float rs = 1.0f / sqrtf(pg8::fx_get(ssq + m) * (1.0f / 2048.0f) + NORM_EPS); GAS f32x4* orow = (GAS f32x4*)(out + (size_t)m * DM); const GAS v4u* xr = (const GAS v4u*)(XB + (size_t)m * DM) + F.lane; const GAS f32x4* gp = (const GAS f32x4*)g;
#pragma unroll
        for (int j = 0; j < 4; ++j) { const v4u w = xr[64 * j]; const int c4 = 2 * (F.lane + 64 * j); const f32x4 g0 = gp[c4], g1 = gp[c4 + 1];
            orow[c4] = (f32x4){bflo(w.x) * rs * g0.x, bfhi(w.x) * rs * g0.y, bflo(w.y) * rs * g0.z, bfhi(w.y) * rs * g0.w};
            orow[c4 + 1] = (f32x4){bflo(w.z) * rs * g1.x, bfhi(w.z) * rs * g1.y, bflo(w.w) * rs * g1.z, bfhi(w.w) * rs * g1.w}; }
    }
}

#ifndef STAG
#define STAG 500
#endif
__device__ __forceinline__ void phase_stagger(int ticks) {
    const int grp = ((int)blockIdx.x >> 3) & 3;
    if (ticks > 0 && grp > 0) { const unsigned long long t0 = __builtin_amdgcn_s_memrealtime(); while ((long long)(__builtin_amdgcn_s_memrealtime() - t0) < (long long)grp * ticks) __builtin_amdgcn_s_sleep(32); }
}
__global__ void __launch_bounds__(NTHR, 2) hy_fwd(Args args) {
    extern __shared__ __attribute__((aligned(16))) unsigned char lds[];
    LAS unsigned char* L = (LAS unsigned char*)lds;
    volatile LAS unsigned* MISC = (volatile LAS unsigned*)(L + MISC_OFF);
    const int wv = __builtin_amdgcn_readfirstlane((int)threadIdx.x >> 6);
    if (wv == 0) MISC[pg8::lane_now()] = 0u;
    __syncthreads();
    XcdBarrier bar; bar.bar = (unsigned*)(ctlp() + CW_BAR); bar.x = 0; bar.st = nullptr; bar.wv = wv;
    if (N_LAUNCH_MODE == 0) bar = xcd_barrier_post((unsigned*)(ctlp() + CW_BAR), MISC + 8, wv);
    const int lo = args.ph_lo, hi = args.ph_hi;
#define IN(k) (lo <= (k) && (k) < hi)
#define SEAM(k) do { if (IN(k) && IN((k) + 1)) xcd_barrier(bar); } while (0)
    if (IN(0)) { Frame F = mkframe(L, wv); ph_prologue(F); if (REPEAT == 1) ph_prologue(F); }
    SEAM(0);
    auto layer = [&](const int l) __attribute__((always_inline)) {
        const int P = 1 + 9 * l;
        if (IN(P)) { phase_stagger(STAG);
            unsigned char* ws = wsp(); pg8::Gemm g{(const bf16*)(ws + WS_XB), (const bf16*)(ws + WS_WIN), M, NPROJ_P, DM, wv}; pg8::StaticOrder S; S.init(M, NPROJ_P, gridDim.x, (int)blockIdx.x);
            pg8::EpiProj E{(bf16*)(ws + WS_PROJ), NPROJ_P, (const pg8::fx_t*)((gu32*)ws + CW_SSQ) + (size_t)(2 * l) * M, (float*)(ws + CTL_KBAR) + (size_t)l * 64 * 8 * 64, (pg8::fx_t*)(ws + CTL_STATS) + (size_t)l * M * 2,
                           (const float*)(ws + WS_SMALL + SM_SAX), (const float*)(ws + WS_SMALL + SM_SWIN)};
            if (I8_IN) { g.A = (const bf16*)(ws + WS_XQ); pg8::MaskOrder S1; S1.init(M, 0xFFFFFFu & ~BFMASK, gridDim.x, (int)blockIdx.x);
                pg8::gemm_phase<pg8::EpiProj, pg8::MaskOrder, true, PG8_SP2, 1>(L + RING_OFF, g, S1, E);
                if (BFMASK) { pg8::Gemm gb{(const bf16*)(ws + WS_XB), winb_ptr(), M, NPROJ_P, DM, wv}; pg8::MaskOrder S2; S2.init(M, BFMASK, gridDim.x, (int)blockIdx.x);
                    pg8::gemm_phase<pg8::EpiProj, pg8::MaskOrder, true, PG8_SP2>(L + RING_OFF, gb, S2, E); } }
            else pg8::gemm_phase<pg8::EpiProj, pg8::StaticOrder, true, PG8_SP2>(L + RING_OFF, g, S, E);
            if (REPEAT == 21) { pg8::EpiNull E0{(float*)(ws + WS_YCAT)}; pg8::MaskOrder S1; S1.init(M, 0xFFFFFFu, gridDim.x, (int)blockIdx.x); pg8::gemm_phase<pg8::EpiNull, pg8::MaskOrder, true, PG8_SP2, 1>(L + RING_OFF, g, S1, E0); }
            if (REPEAT == 23) { pg8::EpiProjDense E3{(bf16*)(ws + WS_YCAT), E.ssq, E.sa, E.sw}; pg8::MaskOrder S1; S1.init(M, 0xFFFFFFu, gridDim.x, (int)blockIdx.x); pg8::gemm_phase<pg8::EpiProjDense, pg8::MaskOrder, true, PG8_SP2, 1>(L + RING_OFF, g, S1, E3); }
            if (REPEAT == 22) { pg8::EpiProj E2 = E; E2.kbar = (float*)(ws + WS_YCAT + 32 * MiB); E2.stats = (pg8::fx_t*)(ws + WS_YCAT + 40 * MiB); E2.O = (bf16*)(ws + WS_YCAT); E2.ldc = 256;
                pg8::MaskOrder S1; S1.init(M, 0xFFFFFFu, gridDim.x, (int)blockIdx.x); pg8::gemm_phase<pg8::EpiProj, pg8::MaskOrder, true, PG8_SP2, 1>(L + RING_OFF, g, S1, E2); }
            if (REPEAT == 2) { pg8::EpiProj E2 = E; E2.kbar = (float*)(ws + WS_YCAT); E2.stats = (pg8::fx_t*)(ws + WS_YCAT + 8 * MiB);
                if (I8_IN) { pg8::MaskOrder S1; S1.init(M, 0xFFFFFFu & ~BFMASK, gridDim.x, (int)blockIdx.x); pg8::gemm_phase<pg8::EpiProj, pg8::MaskOrder, true, PG8_SP2, 1>(L + RING_OFF, g, S1, E2);
                    if (BFMASK) { pg8::Gemm gb{(const bf16*)(ws + WS_XB), winb_ptr(), M, NPROJ_P, DM, wv}; pg8::MaskOrder S2; S2.init(M, BFMASK, gridDim.x, (int)blockIdx.x); pg8::gemm_phase<pg8::EpiProj, pg8::MaskOrder, true, PG8_SP2>(L + RING_OFF, gb, S2, E2); } }
                else pg8::gemm_phase<pg8::EpiProj, pg8::StaticOrder, true, PG8_SP2>(L + RING_OFF, g, S, E2); }
        }
        SEAM(P);
        if (IN(P + 1)) { Frame F = mkframe(L, wv); ph_prep(F, l); if (REPEAT == 3) ph_prep(F, l); }
        SEAM(P + 1);
        if (IN(P + 2)) { ph_mixers(L, l, P + 2, 0, wv); if (REPEAT == 4) ph_mixers(L, l, P + 2, 32, wv); if (REPEAT >= 40 && REPEAT < 50) ph_mixers(L, l, P + 2, 32, wv, REPEAT == 41 ? 1 : (REPEAT == 42 ? 2 : (REPEAT == 43 ? 4 : (REPEAT == 44 ? 8 : 16)))); if (REPEAT >= 430 && REPEAT < 446) ph_mixers(L, l, P + 2, 32, wv, 4); }
        SEAM(P + 2);
        if (IN(P + 3)) { Frame F = mkframe(L, wv); ph_finalize(F, l); if (REPEAT == 5) ph_finalize(F, l); }
        SEAM(P + 3);
        if (IN(P + 4)) { phase_stagger(STAG);
            unsigned char* ws = wsp(); pg8::Gemm g{(const bf16*)(ws + WS_YCAT), (const bf16*)(ws + WS_WOUT), M, DM, DM, wv}; pg8::StaticOrder S; S.init(M, DM, gridDim.x, (int)blockIdx.x);
            pg8::EpiRes E{(bf16*)(ws + WS_XB), (pg8::fx_t*)((gu32*)ws + CW_SSQ) + (size_t)(2 * l + 1) * M, DM, (FFN_FP8 && !FFN1_I8) ? (unsigned char*)(ws + WS_SC2) : nullptr, 1.0f, (const float*)(ws + WS_SMALL + SM_SAY), (const float*)(ws + WS_SMALL + SM_SWOUT)};
            if (I8_OUT) { g.A = (const bf16*)(ws + WS_YQ); pg8::gemm_phase<pg8::EpiRes, pg8::StaticOrder, true, PG8_SP2, 1>(L + RING_OFF, g, S, E); }
            else pg8::gemm_phase<pg8::EpiRes, pg8::StaticOrder, true, PG8_SP2>(L + RING_OFF, g, S, E);
            if (REPEAT == 7) { pg8::EpiRes E2 = E; E2.xb = (bf16*)(ws + WS_YCAT); E2.ssq = (pg8::fx_t*)(ws + WS_G); E2.xf = (unsigned char*)(ws + WS_YD);
                if (I8_OUT) pg8::gemm_phase<pg8::EpiRes, pg8::StaticOrder, true, PG8_SP2, 1>(L + RING_OFF, g, S, E2); else pg8::gemm_phase<pg8::EpiRes, pg8::StaticOrder, true, PG8_SP2>(L + RING_OFF, g, S, E2); }
        }
        SEAM(P + 4);
        if (FFN1_I8) { if (IN(P + 5)) { Frame F = mkframe(L, wv); ph_quantx(F); } SEAM(P + 5); }
        if (IN(P + 6)) {
            unsigned char* ws = wsp(); pg8::Gemm g{(const bf16*)(ws + (FFN1_I8 ? WS_XQ : (FFN_FP8 ? WS_SC2 : WS_XB))), (const bf16*)(ws + WS_WGU), M, 2 * DFF, DM, wv}; pg8::StaticOrder S; S.init(M, 2 * DFF, gridDim.x, (int)blockIdx.x);
            if (FFN_FP8) { pg8::EpiGU8 E{(unsigned char*)(ws + WS_PROJ), DFF, (const pg8::fx_t*)((gu32*)ws + CW_SSQ) + (size_t)(2 * l + 1) * M, FFN1_I8 ? 1.0f : 1.0f / 64.0f, 8.0f, (const float*)(ws + WS_SMALL + SM_SAX), (const float*)(ws + WS_SMALL + SM_SWGU)};
                if (FFN1_I8) pg8::gemm_phase<pg8::EpiGU8, pg8::StaticOrder, true, PG8_SP2, 1>(L + RING_OFF, g, S, E);
                else pg8::gemm_phase_f8<pg8::EpiGU8, pg8::StaticOrder, true, PG8_SP2>(L + RING_OFF, g, S, E);
                if (REPEAT == 6) { if (FFN1_I8) pg8::gemm_phase<pg8::EpiGU8, pg8::StaticOrder, true, PG8_SP2, 1>(L + RING_OFF, g, S, E); else pg8::gemm_phase_f8<pg8::EpiGU8, pg8::StaticOrder, true, PG8_SP2>(L + RING_OFF, g, S, E); }
            } else { pg8::EpiGU E{(bf16*)(ws + WS_PROJ), DFF, (const pg8::fx_t*)((gu32*)ws + CW_SSQ) + (size_t)(2 * l + 1) * M, 1.0f};
                pg8::gemm_phase<pg8::EpiGU, pg8::StaticOrder, true, PG8_SP2>(L + RING_OFF, g, S, E);
                if (REPEAT == 6) pg8::gemm_phase<pg8::EpiGU, pg8::StaticOrder, true, PG8_SP2>(L + RING_OFF, g, S, E); }
        }
        SEAM(P + 6);
        if (IN(P + 7)) { phase_stagger(STAG);
            unsigned char* ws = wsp(); pg8::Gemm g{(const bf16*)(ws + WS_PROJ), (const bf16*)(ws + WS_WDN), M, DM, DFF, wv}; pg8::StaticOrder S; S.init(M, DM, gridDim.x, (int)blockIdx.x);
            pg8::EpiRes E{(bf16*)(ws + WS_XB), (pg8::fx_t*)((gu32*)ws + CW_SSQ) + (size_t)(2 * l + 2) * M, DM, nullptr, FFN_FP8 ? 1.0f / 512.0f : 1.0f, nullptr, nullptr};
            if (FFN_FP8) pg8::gemm_phase_f8<pg8::EpiRes, pg8::StaticOrder, true, PG8_SP2>(L + RING_OFF, g, S, E);
            else pg8::gemm_phase<pg8::EpiRes, pg8::StaticOrder, true, PG8_SP2>(L + RING_OFF, g, S, E);
            if (REPEAT == 8) { pg8::EpiRes E2 = E; E2.xb = (bf16*)(ws + WS_YCAT); E2.ssq = (pg8::fx_t*)(ws + WS_G);
                if (FFN_FP8) pg8::gemm_phase_f8<pg8::EpiRes, pg8::StaticOrder, true, PG8_SP2>(L + RING_OFF, g, S, E2); else pg8::gemm_phase<pg8::EpiRes, pg8::StaticOrder, true, PG8_SP2>(L + RING_OFF, g, S, E2); }
        }
        SEAM(P + 7);
        if (l + 1 < DEPTH) { if (I8_IN && IN(P + 8)) { Frame F = mkframe(L, wv); ph_quantx(F); } if (I8_IN) SEAM(P + 8); }
    };
    static_assert(DEPTH == 2, "layers are expanded by hand");
    layer(0); layer(1);
    if (IN(19)) { Frame F = mkframe(L, wv); ph_final(F); }
#undef IN
#undef SEAM
}

extern "C" void kernel_launch(void* const* d_in, const int* in_sizes, int n_in, void* d_out, int out_size, void* d_ws, size_t ws_size, hipStream_t stream) {
    static int grid = 0;
    if (grid == 0) {
        if (n_in != 25 || in_sizes[0] != M * DM || out_size != M * DM || ws_size < WS_END) { fprintf(stderr, "kernel_launch: shape/workspace mismatch: n_in %d in0 %d out %d ws %zu (need %zu)\n", n_in, n_in > 0 ? in_sizes[0] : -1, out_size, ws_size, (size_t)WS_END); grid = -1; return; }
        int dev = 0, cus = 0, per_cu = 0;
        if (hipGetDevice(&dev) != hipSuccess || hipDeviceGetAttribute(&cus, hipDeviceAttributeMultiprocessorCount, dev) != hipSuccess) { grid = -1; return; }
        if (hipFuncSetAttribute((const void*)hy_fwd, hipFuncAttributeMaxDynamicSharedMemorySize, LDS_BYTES) != hipSuccess) { fprintf(stderr, "kernel_launch: hipFuncSetAttribute failed\n"); grid = -1; return; }
        if (hipOccupancyMaxActiveBlocksPerMultiprocessor(&per_cu, (const void*)hy_fwd, NTHR, LDS_BYTES) != hipSuccess || per_cu < 1) fprintf(stderr, "kernel_launch: occupancy query reports %d\n", per_cu);
        (void)hipGetLastError();
        grid = cus;
    }
    if (grid < 0) return;
    if (hipMemsetAsync((char*)d_ws + WS_CTL, 0, CTL_ZERO_BYTES, stream) != hipSuccess) return;
    Args a{};
    for (int i = 0; i < 25; ++i) a.in[i] = (const float*)d_in[i];
    a.out = (float*)d_out; a.ws = (unsigned char*)d_ws;
    if (N_LAUNCH_MODE == 0) { a.ph_lo = 0; a.ph_hi = N_PHASES; hipLaunchKernelGGL(hy_fwd, dim3(grid), dim3(NTHR), LDS_BYTES, stream, a); }
    else for (int p = 0; p < N_PHASES; ++p) { a.ph_lo = p; a.ph_hi = p + 1; hipLaunchKernelGGL(hy_fwd, dim3(grid), dim3(NTHR), LDS_BYTES, stream, a); }
}
```

```cpp
#define N_LAUNCH_MODE 0
#define REPEAT 0
#define PG8_SP2 true
#define FFN_FP8 1
#define GEMM_I8 3
#define STAG 0
#define FFN1_I8 1
#define BFMASK 0x0u
#include <hip/hip_runtime.h>
#include <cstdio>
#include <cstdint>
namespace pg8 {
#define PG8_LAS __attribute__((address_space(3)))
typedef unsigned short bf16_t;
typedef short bf16x8 __attribute__((ext_vector_type(8)));
typedef float f32x4 __attribute__((ext_vector_type(4)));
typedef unsigned u32x4 __attribute__((ext_vector_type(4)));
constexpr int BM = 256, BK = 64, HALF = 128, HTB = HALF * BK * 2  , STAGE_BYTES = 8 * HTB, NXCD = 8, WGM = 8;

__host__ __device__ __forceinline__ int lds_byte(int r, int c) { const int st = (r >> 4) * 2 + (c >> 5), rr = r & 15, cc = c & 31, ob = rr * 64 + cc * 2; return st * 1024 + (ob ^ (((ob >> 9) & 1) << 5)); }
__host__ __device__ __forceinline__ void stage_rc(int b, int& R, int& C) { const int st = b / 1024, sb = b % 1024, swz = sb ^ (((sb >> 9) & 1) << 5); R = (st >> 1) * 16 + swz / 64; C = (st & 1) * 32 + (swz % 64) / 2; }
__host__ __device__ __forceinline__ int perm32(int rho) { const int n = rho >> 4, i = rho & 15; return 8 * (i >> 2) + 4 * n + (i & 3); }

__device__ __forceinline__ int lane_now() { int l; asm volatile("v_mbcnt_lo_u32_b32 %0, -1, 0\n\tv_mbcnt_hi_u32_b32 %0, -1, %0" : "=v"(l)); return l; }
struct Unit { int pm, pn; };
struct Gemm { const bf16_t* A; const bf16_t* Bt; int M, N, K, wv; };

struct StaticOrder {
    int nM, nN, nwg, G, c;
    __host__ __device__ void init(int M, int N, int G_, int c_) { nM = M / BM; nN = N / BM; nwg = nM * nN; G = G_; c = c_; }
    __host__ __device__ bool next(int i, Unit& u) const {
        const long L = (long)i * G + c; if (L >= nwg) return false;
        int wgid = (int)L; { const int q = nwg / NXCD, r = nwg % NXCD, xcd = wgid % NXCD, off = wgid / NXCD; wgid = (xcd < r ? xcd * (q + 1) : r * (q + 1) + (xcd - r) * q) + off; }
        const int nig = WGM * nN, gid = wgid / nig, fm = gid * WGM, gsz = (nM - fm) < WGM ? (nM - fm) : WGM;
        u.pm = fm + ((wgid % nig) % gsz); u.pn = (wgid % nig) / gsz; return true;
    }
    __device__ __forceinline__ void a_ready(const Unit&) const {}
    __device__ __forceinline__ void done(const Unit&) const {}
};

struct MapOrder {
    StaticOrder s; int from, add;
    __device__ __forceinline__ bool next(int i, Unit& u) const { if (!s.next(i, u)) return false; if (u.pn >= from) u.pn += add; return true; }
    __device__ __forceinline__ void a_ready(const Unit&) const {}
    __device__ __forceinline__ void done(const Unit&) const {}
};

struct MaskOrder {
    StaticOrder s; unsigned mask;
    __device__ __forceinline__ void init(int M, unsigned mask_, int G_, int c_) { mask = mask_; s.init(M, BM * __builtin_popcount(mask_), G_, c_); }
    __device__ __forceinline__ bool next(int i, Unit& u) const { if (!s.next(i, u)) return false; unsigned m = mask; for (int j = 0; j < u.pn; ++j) m &= m - 1; u.pn = __builtin_ctz(m); return true; }
    __device__ __forceinline__ void a_ready(const Unit&) const {}
    __device__ __forceinline__ void done(const Unit&) const {}
};

__device__ __forceinline__ unsigned cvt_pk_bf16(float lo, float hi) { unsigned r; asm volatile("v_cvt_pk_bf16_f32 %0, %1, %2" : "=v"(r) : "v"(lo), "v"(hi)); return r; }
typedef float f32x2 __attribute__((ext_vector_type(2)));

typedef unsigned u32x2 __attribute__((ext_vector_type(2)));
typedef unsigned long long fx_t;
__device__ __forceinline__ void fx_add(fx_t* p, float v) { atomicAdd(p, (fx_t)(long long)__float2ll_rn(v * 1073741824.0f)); }
__device__ __forceinline__ float fx_get(const fx_t* p) { return (float)(long long)(*p) * (1.0f / 1073741824.0f); }
__device__ __forceinline__ float epi_gelu(float x) { const float u = 0.7978845608028654f * (x + 0.044715f * x * x * x); const float e2 = __expf(2.0f * u); return 0.5f * x * (2.0f - 2.0f / (e2 + 1.0f)); }
template <int CTRL> __device__ __forceinline__ float epi_dpp_add(float x) { const int y = __builtin_amdgcn_update_dpp(0, __builtin_bit_cast(int, x), CTRL, 0xF, 0xF, false); return x + __builtin_bit_cast(float, y); }
typedef int i32x4_t __attribute__((ext_vector_type(4)));
__device__ __forceinline__ f32x4 acc_f(const f32x4& v) { return v; }
__device__ __forceinline__ f32x4 acc_f(const i32x4_t& v) { return __builtin_convertvector(v, f32x4); }
template <class T> struct AccIsInt { static constexpr bool v = false; };
template <> struct AccIsInt<i32x4_t> { static constexpr bool v = true; };
__device__ __forceinline__ void epi_prefetch(const fx_t* ssq_rows, const float* sa_rows, const float* sw_cols, PG8_LAS unsigned char* slot, int wid) {
    const int ln = lane_now();
    __builtin_amdgcn_global_load_lds((const __attribute__((address_space(1))) unsigned*)((const unsigned*)ssq_rows + wid * 64 + ln), (PG8_LAS unsigned*)(slot + wid * 256), 4, 0, 0);
    if (sa_rows) { const float* src = wid < 4 ? sa_rows + wid * 64 : sw_cols + (wid - 4) * 64;
        __builtin_amdgcn_global_load_lds((const __attribute__((address_space(1))) unsigned*)((const unsigned*)src + ln), (PG8_LAS unsigned*)(slot + 2048 + wid * 256), 4, 0, 0); }
}
__device__ __forceinline__ float fx_getl(const PG8_LAS unsigned char* slot, int rloc) { return (float)(long long)(*(const PG8_LAS fx_t*)(slot + 8 * rloc)) * (1.0f / 1073741824.0f); }
struct EpiProj {
    static constexpr bool PERM = true, AFTER_DRAIN = false, PREFETCH = true;
    bf16_t* O; int ldc; const fx_t* ssq; float* kbar; fx_t* stats; const float* sa; const float* sw;
    __device__ __forceinline__ void prefetch(const Unit& u, PG8_LAS unsigned char* slot, int wid) const { epi_prefetch(ssq + u.pm * BM, sa ? sa + u.pm * BM : nullptr, sw + u.pn * BM, slot, wid); }
    template <class AccT> __device__ __forceinline__ void operator()(const AccT (&acc)[2][2][4][2], const Unit& u, int wr, int wc, int fr, int fq, const PG8_LAS unsigned char* slot) const {
        constexpr bool Q = AccIsInt<AccT>::v;
        const int row0 = u.pm * BM + wr * 64 + fr, col0 = u.pn * BM + wc * 32 + 8 * fq;
        f32x4 cw[2][2];
        if constexpr (Q) {
#pragma unroll
            for (int bj = 0; bj < 2; ++bj) { const PG8_LAS float* p = (const PG8_LAS float*)(slot + 3072) + bj * HALF + wc * 32 + 8 * fq; cw[bj][0] = *(const PG8_LAS f32x4*)p; cw[bj][1] = *(const PG8_LAS f32x4*)(p + 4); } }
        const bool do_k = (u.pn == 12 || u.pn == 13), do_s = (u.pn == 8 || u.pn == 9);
        float cs[2][8];
#pragma unroll
        for (int bj = 0; bj < 2; ++bj)
#pragma unroll
            for (int e = 0; e < 8; ++e) cs[bj][e] = 0.f;
#pragma unroll
        for (int ai = 0; ai < 2; ++ai)
#pragma unroll
            for (int m = 0; m < 4; ++m) { const int row = row0 + ai * HALF + m * 16; const int rloc = ai * HALF + wr * 64 + m * 16 + fr; float rs = __builtin_amdgcn_rsqf(fx_getl(slot, rloc) * (1.0f / 2048.0f) + 1e-6f); if constexpr (Q) rs *= *(const PG8_LAS float*)(slot + 2048 + 4 * rloc);
                bf16_t* rowp = O + (size_t)row * ldc + col0; float s1 = 0.f, s2 = 0.f;
#pragma unroll
                for (int bj = 0; bj < 2; ++bj) { f32x4 v0 = acc_f(acc[ai][bj][m][0]) * rs, v1 = acc_f(acc[ai][bj][m][1]) * rs; if constexpr (Q) { v0 *= cw[bj][0]; v1 *= cw[bj][1]; }
                    u32x4 w; w.x = cvt_pk_bf16(v0[0], v0[1]); w.y = cvt_pk_bf16(v0[2], v0[3]); w.z = cvt_pk_bf16(v1[0], v1[1]); w.w = cvt_pk_bf16(v1[2], v1[3]);
                    *(u32x4*)(rowp + bj * HALF) = w;
                    if (do_k) {
#pragma unroll
                        for (int e = 0; e < 4; ++e) { cs[bj][e] += v0[e]; cs[bj][4 + e] += v1[e]; } }
                    if (do_s) {
#pragma unroll
                        for (int e = 0; e < 4; ++e) { const float g0 = epi_gelu(v0[e]), g1 = epi_gelu(v1[e]); s1 += g0 + g1; s2 += g0 * g0 + g1 * g1; } } }
                if (do_s) { s1 += __shfl_xor(s1, 16); s1 += __shfl_xor(s1, 32); s2 += __shfl_xor(s2, 16); s2 += __shfl_xor(s2, 32);
                    if (fq == 0) { fx_add(stats + 2 * row, s1); fx_add(stats + 2 * row + 1, s2); } } }
        if (do_k) {
            const int bidx = (u.pm >> 3) * 8, n = u.pm & 7;
#pragma unroll
            for (int bj = 0; bj < 2; ++bj)
#pragma unroll
                for (int e = 0; e < 8; ++e) { float s = cs[bj][e]; s = epi_dpp_add<0xB1>(s); s = epi_dpp_add<0x4E>(s); s = epi_dpp_add<0x141>(s); s = epi_dpp_add<0x140>(s);
                    const int ck = col0 + bj * HALF + e - 3072;
                    if (fr == 0) unsafeAtomicAdd(kbar + ((bidx + (ck >> 6)) * 8 + n) * 64 + (ck & 63), s * (1.0f / 256.0f)); } }
    }
};
struct EpiGU {
    static constexpr bool PERM = true, AFTER_DRAIN = false, PREFETCH = false;
    bf16_t* O; int ldc; const fx_t* ssq; float oscale;
    __device__ __forceinline__ void operator()(const f32x4 (&acc)[2][2][4][2], const Unit& u, int wr, int wc, int fr, int fq, const PG8_LAS unsigned char* slot) const {
        const int row0 = u.pm * BM + wr * 64 + fr, col0 = u.pn * HALF + wc * 32 + 8 * fq;
#pragma unroll
        for (int ai = 0; ai < 2; ++ai)
#pragma unroll
            for (int m = 0; m < 4; ++m) { const int row = row0 + ai * HALF + m * 16; const float rs = __builtin_amdgcn_rsqf(fx_get(ssq + row) * (1.0f / 2048.0f) + 1e-6f) * oscale;
                float o[8];
#pragma unroll
                for (int n = 0; n < 2; ++n)
#pragma unroll
                    for (int e = 0; e < 4; ++e) { const float g = acc[ai][0][m][n][e] * rs, up = acc[ai][1][m][n][e] * rs;
                        o[n * 4 + e] = g * __builtin_amdgcn_rcpf(1.0f + __builtin_amdgcn_exp2f(-1.4426950408889634f * g)) * up; }
                u32x4 w; w.x = cvt_pk_bf16(o[0], o[1]); w.y = cvt_pk_bf16(o[2], o[3]); w.z = cvt_pk_bf16(o[4], o[5]); w.w = cvt_pk_bf16(o[6], o[7]);
                *(u32x4*)(O + (size_t)row * ldc + col0) = w; }
    }
};
__device__ __forceinline__ float epi_clamp8(float v) { return __builtin_amdgcn_fmed3f(v, -448.0f, 448.0f); }
struct EpiGU8 {
    static constexpr bool PERM = true, AFTER_DRAIN = false, PREFETCH = true;
    __device__ __forceinline__ void prefetch(const Unit& u, PG8_LAS unsigned char* slot, int wid) const { epi_prefetch(ssq + u.pm * BM, sa ? sa + u.pm * BM : nullptr, sw + u.pn * BM, slot, wid); }
    unsigned char* O; int ldc; const fx_t* ssq; float oscale, ascale; const float* sa; const float* sw;
    template <class AccT> __device__ __forceinline__ void operator()(const AccT (&acc)[2][2][4][2], const Unit& u, int wr, int wc, int fr, int fq, const PG8_LAS unsigned char* slot) const {
        constexpr bool Q = AccIsInt<AccT>::v;
        const int row0 = u.pm * BM + wr * 64 + fr, col0 = u.pn * HALF + wc * 32 + 8 * fq;
        f32x4 cw[2][2];
        if constexpr (Q) {
#pragma unroll
            for (int bj = 0; bj < 2; ++bj) { const PG8_LAS float* p = (const PG8_LAS float*)(slot + 3072) + bj * HALF + wc * 32 + 8 * fq; cw[bj][0] = *(const PG8_LAS f32x4*)p; cw[bj][1] = *(const PG8_LAS f32x4*)(p + 4); } }
#pragma unroll
        for (int ai = 0; ai < 2; ++ai)
#pragma unroll
            for (int m = 0; m < 4; ++m) { const int row = row0 + ai * HALF + m * 16; const int rloc = ai * HALF + wr * 64 + m * 16 + fr; float rs = __builtin_amdgcn_rsqf(fx_getl(slot, rloc) * (1.0f / 2048.0f) + 1e-6f) * oscale; if constexpr (Q) rs *= *(const PG8_LAS float*)(slot + 2048 + 4 * rloc);
                float o[8];
#pragma unroll
                for (int n = 0; n < 2; ++n) { f32x4 gv = acc_f(acc[ai][0][m][n]) * rs, uv = acc_f(acc[ai][1][m][n]) * rs; if constexpr (Q) { gv *= cw[0][n]; uv *= cw[1][n]; }
#pragma unroll
                    for (int e = 0; e < 4; ++e) { const float g = gv[e], up = uv[e];
                        o[n * 4 + e] = epi_clamp8(g * __builtin_amdgcn_rcpf(1.0f + __builtin_amdgcn_exp2f(-1.4426950408889634f * g)) * up * ascale); } }
                int f0 = __builtin_bit_cast(int, o[0]), f1 = __builtin_bit_cast(int, o[4]);
                f0 = __builtin_amdgcn_cvt_pk_fp8_f32(o[0], o[1], f0, false); f0 = __builtin_amdgcn_cvt_pk_fp8_f32(o[2], o[3], f0, true);
                f1 = __builtin_amdgcn_cvt_pk_fp8_f32(o[4], o[5], f1, false); f1 = __builtin_amdgcn_cvt_pk_fp8_f32(o[6], o[7], f1, true);
                *(u32x2*)(O + (size_t)row * ldc + col0) = (u32x2){(unsigned)f0, (unsigned)f1}; }
    }
};
struct EpiRes {
    static constexpr bool PERM = true, AFTER_DRAIN = false, PREFETCH = false;
    bf16_t* xb; fx_t* ssq; int ldc; unsigned char* xf; float oscale; const float* sa; const float* sw;
    template <class AccT> __device__ __forceinline__ void operator()(const AccT (&acc)[2][2][4][2], const Unit& u, int wr, int wc, int fr, int fq, const PG8_LAS unsigned char* slot) const {
        constexpr bool Q = AccIsInt<AccT>::v;
        const int row0 = u.pm * BM + wr * 64 + fr, col0 = u.pn * BM + wc * 32 + 8 * fq;
        f32x4 cw[2][2];
        if constexpr (Q) {
#pragma unroll
            for (int bj = 0; bj < 2; ++bj) { cw[bj][0] = *(const f32x4*)(sw + col0 + bj * HALF); cw[bj][1] = *(const f32x4*)(sw + col0 + bj * HALF + 4); } }
#pragma unroll
        for (int ai = 0; ai < 2; ++ai)
#pragma unroll
            for (int m = 0; m < 4; ++m) { const int row = row0 + ai * HALF + m * 16; bf16_t* rowp = xb + (size_t)row * ldc + col0; float s = 0.f; float osc = oscale; if constexpr (Q) osc = sa[row];
                u32x4 b[2];
#pragma unroll
                for (int bj = 0; bj < 2; ++bj) b[bj] = *(const u32x4*)(rowp + bj * HALF);
#pragma unroll
                for (int bj = 0; bj < 2; ++bj) { float o[8]; f32x4 a2[2] = {acc_f(acc[ai][bj][m][0]), acc_f(acc[ai][bj][m][1])}; if constexpr (Q) { a2[0] *= cw[bj][0]; a2[1] *= cw[bj][1]; }
#pragma unroll
                    for (int q = 0; q < 4; ++q) { o[2 * q] = __builtin_fmaf(a2[q >> 1][2 * (q & 1)], osc, __builtin_bit_cast(float, b[bj][q] << 16)); o[2 * q + 1] = __builtin_fmaf(a2[q >> 1][2 * (q & 1) + 1], osc, __builtin_bit_cast(float, b[bj][q] & 0xffff0000u)); }
                    u32x4 w; w.x = cvt_pk_bf16(o[0], o[1]); w.y = cvt_pk_bf16(o[2], o[3]); w.z = cvt_pk_bf16(o[4], o[5]); w.w = cvt_pk_bf16(o[6], o[7]);
                    *(u32x4*)(rowp + bj * HALF) = w;
                    if (xf) { int f0 = (int)b[bj][0], f1 = (int)b[bj][1]; f0 = __builtin_amdgcn_cvt_pk_fp8_f32(epi_clamp8(o[0]), epi_clamp8(o[1]), f0, false); f0 = __builtin_amdgcn_cvt_pk_fp8_f32(epi_clamp8(o[2]), epi_clamp8(o[3]), f0, true);
                        f1 = __builtin_amdgcn_cvt_pk_fp8_f32(epi_clamp8(o[4]), epi_clamp8(o[5]), f1, false); f1 = __builtin_amdgcn_cvt_pk_fp8_f32(epi_clamp8(o[6]), epi_clamp8(o[7]), f1, true);
                        *(u32x2*)(xf + (size_t)row * ldc + col0 + bj * HALF) = (u32x2){(unsigned)f0, (unsigned)f1}; }
#pragma unroll
                    for (int q = 0; q < 8; ++q) s += o[q] * o[q]; }
                s += __shfl_xor(s, 16); s += __shfl_xor(s, 32);
                if (fq == 0) fx_add(ssq + row, s); }
    }
};

struct EpiNull {
    static constexpr bool PERM = true, AFTER_DRAIN = false, PREFETCH = false;
    float* sink;
    template <class AccT> __device__ __forceinline__ void operator()(const AccT (&acc)[2][2][4][2], const Unit& u, int wr, int wc, int fr, int fq, const PG8_LAS unsigned char* slot) const {
        f32x4 s = {0.f, 0.f, 0.f, 0.f};
#pragma unroll
        for (int ai = 0; ai < 2; ++ai)
#pragma unroll
            for (int bj = 0; bj < 2; ++bj)
#pragma unroll
                for (int m = 0; m < 4; ++m)
#pragma unroll
                    for (int n = 0; n < 2; ++n) s += acc_f(acc[ai][bj][m][n]);
        if (s[0] + s[1] + s[2] + s[3] == 1.2345e30f) sink[0] = s[0];
    }
};

struct EpiProjDense {
    static constexpr bool PERM = true, AFTER_DRAIN = false, PREFETCH = false;
    bf16_t* O; const fx_t* ssq; const float* sa; const float* sw;
    template <class AccT> __device__ __forceinline__ void operator()(const AccT (&acc)[2][2][4][2], const Unit& u, int wr, int wc, int fr, int fq, const PG8_LAS unsigned char* slot) const {
        const int row0 = u.pm * BM + wr * 64 + fr, col0 = u.pn * BM + wc * 32 + 8 * fq;
        f32x4 cw[2][2];
#pragma unroll
        for (int bj = 0; bj < 2; ++bj) { cw[bj][0] = *(const f32x4*)(sw + col0 + bj * HALF); cw[bj][1] = *(const f32x4*)(sw + col0 + bj * HALF + 4); }
        bf16_t* base = O + ((size_t)(((u.pm * 24 + u.pn) & 255) * 8 + wr * 4 + wc) * 16) * 512 + (fq * 16 + fr) * 8;
#pragma unroll
        for (int ai = 0; ai < 2; ++ai)
#pragma unroll
            for (int m = 0; m < 4; ++m) { const int row = row0 + ai * HALF + m * 16; float rs = __builtin_amdgcn_rsqf(fx_get(ssq + row) * (1.0f / 2048.0f) + 1e-6f) * sa[row];
#pragma unroll
                for (int bj = 0; bj < 2; ++bj) { f32x4 v0 = acc_f(acc[ai][bj][m][0]) * rs * cw[bj][0], v1 = acc_f(acc[ai][bj][m][1]) * rs * cw[bj][1];
                    u32x4 w; w.x = cvt_pk_bf16(v0[0], v0[1]); w.y = cvt_pk_bf16(v0[2], v0[3]); w.z = cvt_pk_bf16(v1[0], v1[1]); w.w = cvt_pk_bf16(v1[2], v1[3]);
                    *(u32x4*)(base + ((ai * 4 + m) * 2 + bj) * 512) = w; } }
    }
};
typedef int i32x8_t __attribute__((ext_vector_type(8)));
constexpr int PG8_PRM_OFF = STAGE_BYTES + 1024;
__device__ __forceinline__ void mma16(f32x4& c, const bf16x8& a, const bf16x8& b) { c = __builtin_amdgcn_mfma_f32_16x16x32_bf16(a, b, c, 0, 0, 0); }
__device__ __forceinline__ void mma16(i32x4_t& c, const bf16x8& a, const bf16x8& b) { c = __builtin_amdgcn_mfma_i32_16x16x64_i8(__builtin_bit_cast(i32x4_t, a), __builtin_bit_cast(i32x4_t, b), c, 0, 0, 0); }
template <int EB> struct AccOf { typedef f32x4 type; };
template <> struct AccOf<1> { typedef i32x4_t type; };
template <class Epi, class Sched, bool ALIGN_EPI = false, bool SP2 = false, int EB = 2>
__device__ __forceinline__ void gemm_phase(PG8_LAS unsigned char* lds, const Gemm g, const Sched& S, const Epi& E) {
    int tid_ = g.wv * 64 + lane_now(); asm volatile("" : "+v"(tid_));
    const int tid = tid_, wid = __builtin_amdgcn_readfirstlane(tid >> 6), lane = tid & 63, wr = wid >> 2, wc = wid & 3, fr = lane & 15, fq = lane >> 4;
    const int K = g.K, nt = K * EB / (2 * BK);
    unsigned voffA[2], voffB[2];
#pragma unroll
    for (int i = 0; i < 2; ++i) { int R, C; stage_rc(tid * 16 + i * 8192, R, C); const int Rb = Epi::PERM ? ((R & ~31) + perm32(R & 31)) : R;
        voffA[i] = (unsigned)(R * K * EB + 2 * C); voffB[i] = (unsigned)(Rb * K * EB + 2 * C); }
    const unsigned kstep = (unsigned)(BK * 2);
    const unsigned hstep = (unsigned)HALF * K * EB;
    const unsigned tstep = 2 * hstep;
    const unsigned ldsw = (unsigned)wid * 1024u;
    const int aoff = lds_byte(wr * 64 + fr, fq * 8), boff = lds_byte(wc * 32 + fr, fq * 8);
#define PG8_SA(b, h) (((b) * 2 + (h)) * HTB)
#define PG8_SB(b, h) ((4 + (b) * 2 + (h)) * HTB)
#define PG8_STAGE(bufoff, rsrc, soff, voff) do { _Pragma("unroll") for (int _i = 0; _i < 2; ++_i) \
        __builtin_amdgcn_raw_ptr_buffer_load_lds(rsrc, (PG8_LAS void*)(lds + (bufoff) + ldsw + _i * 8192), 16, (int)(voff)[_i], (int)(soff), 0, 0); } while (0)
#define PG8_LDA(dst, b, h) do { _Pragma("unroll") for (int m = 0; m < 4; ++m) _Pragma("unroll") for (int k = 0; k < 2; ++k) dst[m][k] = *(const PG8_LAS bf16x8*)(lds + PG8_SA(b, h) + aoff + m * 2048 + k * 1024); } while (0)
#define PG8_LDB(dst, b, h) do { _Pragma("unroll") for (int n = 0; n < 2; ++n) _Pragma("unroll") for (int k = 0; k < 2; ++k) dst[n][k] = *(const PG8_LAS bf16x8*)(lds + PG8_SB(b, h) + boff + n * 2048 + k * 1024); } while (0)
#define PG8_MMA(ai, bj, At, Bt) do { __builtin_amdgcn_s_setprio(1); _Pragma("unroll") for (int m = 0; m < 4; ++m) _Pragma("unroll") for (int n = 0; n < 2; ++n) _Pragma("unroll") for (int k = 0; k < 2; ++k) \
        mma16(acc[ai][bj][m][n], Bt[n][k], At[m][k]); __builtin_amdgcn_s_setprio(0); } while (0)
#define PG8_WAIT_V(n) asm volatile("s_waitcnt vmcnt(" #n ")" ::: "memory")
#define PG8_WAIT_L(n) asm volatile("s_waitcnt lgkmcnt(" #n ")" ::: "memory")
#define PG8_BAR __builtin_amdgcn_s_barrier()
#define PG8_SCHED __builtin_amdgcn_sched_barrier(0)
    Unit cur, nxt; int ui = 0;
    if (!S.next(0, cur)) return;
    typedef typename AccOf<EB>::type acc_t; acc_t acc[2][2][4][2];
#pragma unroll
    for (int a = 0; a < 2; ++a)
#pragma unroll
        for (int b = 0; b < 2; ++b)
#pragma unroll
            for (int m = 0; m < 4; ++m)
#pragma unroll
                for (int n = 0; n < 2; ++n) acc[a][b][m][n] = acc_t{};
    bf16x8 At[4][2], B0[2][2], B1[2][2];
    const __amdgpu_buffer_rsrc_t rA = __builtin_amdgcn_make_buffer_rsrc((void*)g.A, (short)0, -1, 0x00020000), rB = __builtin_amdgcn_make_buffer_rsrc((void*)g.Bt, (short)0, -1, 0x00020000);
    unsigned cA = (unsigned)cur.pm * tstep, cB = (unsigned)cur.pn * tstep;
    S.a_ready(cur);
    if constexpr (SP2) {
        PG8_STAGE(PG8_SB(0, 0), rB, cB, voffB); PG8_STAGE(PG8_SB(0, 1), rB, cB + hstep, voffB); PG8_STAGE(PG8_SA(0, 0), rA, cA, voffA); PG8_STAGE(PG8_SA(0, 1), rA, cA + hstep, voffA);
        if (wr == 1) PG8_BAR;
        PG8_WAIT_V(2); PG8_BAR;
        PG8_STAGE(PG8_SB(1, 0), rB, cB + kstep, voffB); PG8_STAGE(PG8_SA(1, 0), rA, cA + kstep, voffA); PG8_STAGE(PG8_SB(1, 1), rB, cB + hstep + kstep, voffB);
        PG8_WAIT_V(6); PG8_BAR;
    } else {
        PG8_STAGE(PG8_SB(0, 0), rB, cB, voffB); PG8_STAGE(PG8_SA(0, 0), rA, cA, voffA); PG8_STAGE(PG8_SB(0, 1), rB, cB + hstep, voffB); PG8_STAGE(PG8_SA(0, 1), rA, cA + hstep, voffA);
        if (wr == 1) PG8_BAR;
        PG8_WAIT_V(4); PG8_BAR;
        PG8_STAGE(PG8_SB(1, 0), rB, cB + kstep, voffB); PG8_STAGE(PG8_SA(1, 0), rA, cA + kstep, voffA); PG8_STAGE(PG8_SB(1, 1), rB, cB + hstep + kstep, voffB);
        PG8_WAIT_V(6); PG8_BAR;
    }
    for (;;) {
        const bool has_next = S.next(ui + 1, nxt);
        const unsigned nA = has_next ? (unsigned)nxt.pm * tstep : cA, nB = has_next ? (unsigned)nxt.pn * tstep : cB;
        for (int t = 0; t < nt; t += 2) {
            const bool last = (t == nt - 2);
            const unsigned a1 = cA + (unsigned)(t + 1) * kstep;
            const unsigned a2 = last ? nA : cA + (unsigned)(t + 2) * kstep, b2 = last ? nB : cB + (unsigned)(t + 2) * kstep;
            const unsigned a3 = a2 + kstep, b3 = b2 + kstep;
            if (last && has_next) S.a_ready(nxt);
            if constexpr (Epi::PREFETCH) { if (t == 0) E.prefetch(cur, lds + PG8_PRM_OFF + (ui & 1) * 4096, wid); }
            if constexpr (SP2) {
            PG8_LDB(B0, 0, 0); PG8_LDB(B1, 0, 1); PG8_SCHED; PG8_LDA(At, 0, 0); PG8_STAGE(PG8_SA(1, 1), rA, a1 + hstep, voffA);
            PG8_WAIT_V(8); PG8_WAIT_L(0); PG8_BAR; PG8_MMA(0, 0, At, B0); PG8_MMA(0, 1, At, B1); PG8_BAR; PG8_SCHED;
            PG8_LDA(At, 0, 1); PG8_STAGE(PG8_SB(0, 0), rB, b2, voffB); PG8_STAGE(PG8_SB(0, 1), rB, b2 + hstep, voffB); PG8_STAGE(PG8_SA(0, 0), rA, a2, voffA);
            PG8_WAIT_V(8); PG8_WAIT_L(0); PG8_BAR; PG8_MMA(1, 0, At, B0); PG8_MMA(1, 1, At, B1); PG8_BAR; PG8_SCHED;
            PG8_LDB(B0, 1, 0); PG8_LDB(B1, 1, 1); PG8_SCHED; PG8_LDA(At, 1, 0); PG8_STAGE(PG8_SA(0, 1), rA, a2 + hstep, voffA);
            PG8_WAIT_V(8); PG8_WAIT_L(0); PG8_BAR; PG8_MMA(0, 0, At, B0); PG8_MMA(0, 1, At, B1); PG8_BAR; PG8_SCHED;
            PG8_LDA(At, 1, 1); PG8_STAGE(PG8_SB(1, 0), rB, b3, voffB); PG8_STAGE(PG8_SB(1, 1), rB, b3 + hstep, voffB); PG8_STAGE(PG8_SA(1, 0), rA, a3, voffA);
            PG8_WAIT_V(8); PG8_WAIT_L(0); PG8_BAR; PG8_MMA(1, 0, At, B0); PG8_MMA(1, 1, At, B1); PG8_BAR; PG8_SCHED;
            } else {
            PG8_LDB(B0, 0, 0); PG8_SCHED; PG8_LDA(At, 0, 0); PG8_STAGE(PG8_SA(1, 1), rA, a1 + hstep, voffA);
            PG8_WAIT_L(8); PG8_BAR; PG8_WAIT_L(0); PG8_MMA(0, 0, At, B0); PG8_BAR; PG8_SCHED;
            PG8_LDB(B1, 0, 1); PG8_STAGE(PG8_SB(0, 0), rB, b2, voffB);
            PG8_BAR; PG8_WAIT_L(0); PG8_MMA(0, 1, At, B1); PG8_BAR;
            PG8_LDA(At, 0, 1); PG8_STAGE(PG8_SA(0, 0), rA, a2, voffA);
            PG8_BAR; PG8_WAIT_L(0); PG8_MMA(1, 0, At, B0); PG8_BAR; PG8_SCHED;
            PG8_STAGE(PG8_SB(0, 1), rB, b2 + hstep, voffB);
            PG8_WAIT_V(6); PG8_BAR; PG8_MMA(1, 1, At, B1); PG8_BAR;
            PG8_LDB(B0, 1, 0); PG8_SCHED; PG8_LDA(At, 1, 0); PG8_STAGE(PG8_SA(0, 1), rA, a2 + hstep, voffA);
            PG8_WAIT_L(8); PG8_BAR; PG8_WAIT_L(0); PG8_MMA(0, 0, At, B0); PG8_BAR; PG8_SCHED;
            PG8_LDB(B1, 1, 1); PG8_STAGE(PG8_SB(1, 0), rB, b3, voffB);
            PG8_BAR; PG8_WAIT_L(0); PG8_MMA(0, 1, At, B1); PG8_BAR;
            PG8_LDA(At, 1, 1); PG8_STAGE(PG8_SA(1, 0), rA, a3, voffA);
            PG8_BAR; PG8_WAIT_L(0); PG8_MMA(1, 0, At, B0); PG8_BAR; PG8_SCHED;
            PG8_STAGE(PG8_SB(1, 1), rB, b3 + hstep, voffB);
            PG8_WAIT_V(6); PG8_BAR; PG8_MMA(1, 1, At, B1); PG8_BAR;
            }
        }
        if constexpr (ALIGN_EPI) { if (wr == 0) PG8_BAR; }
        if constexpr (!Epi::AFTER_DRAIN) { int ln_ = (int)__builtin_amdgcn_mbcnt_hi(~0u, __builtin_amdgcn_mbcnt_lo(~0u, 0u)); asm volatile("" : "+v"(ln_));
            E(acc, cur, wr, wc, ln_ & 15, ln_ >> 4, lds + PG8_PRM_OFF + (ui & 1) * 4096); S.done(cur); }
        if (!has_next) break;
#pragma unroll
        for (int a = 0; a < 2; ++a)
#pragma unroll
            for (int b = 0; b < 2; ++b)
#pragma unroll
                for (int m = 0; m < 4; ++m)
#pragma unroll
                    for (int n = 0; n < 2; ++n) acc[a][b][m][n] = acc_t{};
        cur = nxt; cA = nA; cB = nB; ++ui;
        if constexpr (ALIGN_EPI) { if (wr == 1) PG8_BAR; }
    }
    PG8_WAIT_V(0);
    if constexpr (!ALIGN_EPI) { if (wr == 0) PG8_BAR; }
    PG8_BAR;
    if constexpr (Epi::AFTER_DRAIN) { E.fused(acc, cur, wr, wc, fr, fq, lds, wid, lane); S.done(cur); }
#undef PG8_SA
#undef PG8_SB
#undef PG8_STAGE
#undef PG8_LDA
#undef PG8_LDB
#undef PG8_MMA
#undef PG8_WAIT_V
#undef PG8_WAIT_L
#undef PG8_BAR
#undef PG8_SCHED
}
template <class Epi, class Sched, bool ALIGN_EPI = false, bool SP2 = false>
__device__ __forceinline__ void gemm_phase_f8(PG8_LAS unsigned char* lds, const Gemm g, const Sched& S, const Epi& E) {
    int tid_ = g.wv * 64 + lane_now(); asm volatile("" : "+v"(tid_));
    const int tid = tid_, wid = __builtin_amdgcn_readfirstlane(tid >> 6), lane = tid & 63, wr = wid >> 2, wc = wid & 3, fr = lane & 15, fq = lane >> 4;
    const int K = g.K, nt = K / (2 * BK);
    unsigned voffA[2], voffB[2];
#pragma unroll
    for (int i = 0; i < 2; ++i) { int R, C; stage_rc(tid * 16 + i * 8192, R, C); const int Rb = Epi::PERM ? ((R & ~31) + perm32(R & 31)) : R;
        voffA[i] = (unsigned)(R * K + 2 * C); voffB[i] = (unsigned)(Rb * K + 2 * C); }
    const unsigned kstep = (unsigned)(BK * 2);
    const unsigned hstep = (unsigned)HALF * K;
    const unsigned tstep = 2 * hstep;
    const unsigned ldsw = (unsigned)wid * 1024u;
    const int aoff = lds_byte(wr * 64 + fr, fq * 16) ^ ((fq & 1) << 4), boff = lds_byte(wc * 32 + fr, fq * 16) ^ ((fq & 1) << 4), aoff2 = aoff ^ 16, boff2 = boff ^ 16;
#define PG8_SA(b, h) (((b) * 2 + (h)) * HTB)
#define PG8_SB(b, h) ((4 + (b) * 2 + (h)) * HTB)
#define PG8_STAGE(bufoff, rsrc, soff, voff) do { _Pragma("unroll") for (int _i = 0; _i < 2; ++_i) \
        __builtin_amdgcn_raw_ptr_buffer_load_lds(rsrc, (PG8_LAS void*)(lds + (bufoff) + ldsw + _i * 8192), 16, (int)(voff)[_i], (int)(soff), 0, 0); } while (0)
#define PG8_LDA(dst, b, h) do { _Pragma("unroll") for (int m = 0; m < 4; ++m) { const i32x4_t lo_ = *(const PG8_LAS i32x4_t*)(lds + PG8_SA(b, h) + aoff + m * 2048), hi_ = *(const PG8_LAS i32x4_t*)(lds + PG8_SA(b, h) + aoff2 + m * 2048); dst[m] = __builtin_shufflevector(lo_, hi_, 0, 1, 2, 3, 4, 5, 6, 7); } } while (0)
#define PG8_LDB(dst, b, h) do { _Pragma("unroll") for (int n = 0; n < 2; ++n) { const i32x4_t lo_ = *(const PG8_LAS i32x4_t*)(lds + PG8_SB(b, h) + boff + n * 2048), hi_ = *(const PG8_LAS i32x4_t*)(lds + PG8_SB(b, h) + boff2 + n * 2048); dst[n] = __builtin_shufflevector(lo_, hi_, 0, 1, 2, 3, 4, 5, 6, 7); } } while (0)
#define PG8_F8CAT(lo, hi) __builtin_shufflevector(__builtin_bit_cast(i32x4_t, lo), __builtin_bit_cast(i32x4_t, hi), 0, 1, 2, 3, 4, 5, 6, 7)
#define PG8_MMA(ai, bj, At, Bt) do { __builtin_amdgcn_s_setprio(1); _Pragma("unroll") for (int m = 0; m < 4; ++m) _Pragma("unroll") for (int n = 0; n < 2; ++n) \
        acc[ai][bj][m][n] = __builtin_amdgcn_mfma_scale_f32_16x16x128_f8f6f4(Bt[n], At[m], acc[ai][bj][m][n], 0, 0, 0, 0, 0, 0); __builtin_amdgcn_s_setprio(0); } while (0)
#define PG8_WAIT_V(n) asm volatile("s_waitcnt vmcnt(" #n ")" ::: "memory")
#define PG8_WAIT_L(n) asm volatile("s_waitcnt lgkmcnt(" #n ")" ::: "memory")
#define PG8_BAR __builtin_amdgcn_s_barrier()
#define PG8_SCHED __builtin_amdgcn_sched_barrier(0)
    Unit cur, nxt; int ui = 0;
    if (!S.next(0, cur)) return;
    f32x4 acc[2][2][4][2];
#pragma unroll
    for (int a = 0; a < 2; ++a)
#pragma unroll
        for (int b = 0; b < 2; ++b)
#pragma unroll
            for (int m = 0; m < 4; ++m)
#pragma unroll
                for (int n = 0; n < 2; ++n) acc[a][b][m][n] = (f32x4){0.f, 0.f, 0.f, 0.f};
    i32x8_t At[4], B0[2], B1[2];
    const __amdgpu_buffer_rsrc_t rA = __builtin_amdgcn_make_buffer_rsrc((void*)g.A, (short)0, -1, 0x00020000), rB = __builtin_amdgcn_make_buffer_rsrc((void*)g.Bt, (short)0, -1, 0x00020000);
    unsigned cA = (unsigned)cur.pm * tstep, cB = (unsigned)cur.pn * tstep;
    S.a_ready(cur);
    if constexpr (SP2) {
        PG8_STAGE(PG8_SB(0, 0), rB, cB, voffB); PG8_STAGE(PG8_SB(0, 1), rB, cB + hstep, voffB); PG8_STAGE(PG8_SA(0, 0), rA, cA, voffA); PG8_STAGE(PG8_SA(0, 1), rA, cA + hstep, voffA);
        if (wr == 1) PG8_BAR;
        PG8_WAIT_V(2); PG8_BAR;
        PG8_STAGE(PG8_SB(1, 0), rB, cB + kstep, voffB); PG8_STAGE(PG8_SA(1, 0), rA, cA + kstep, voffA); PG8_STAGE(PG8_SB(1, 1), rB, cB + hstep + kstep, voffB);
        PG8_WAIT_V(6); PG8_BAR;
    } else {
        PG8_STAGE(PG8_SB(0, 0), rB, cB, voffB); PG8_STAGE(PG8_SA(0, 0), rA, cA, voffA); PG8_STAGE(PG8_SB(0, 1), rB, cB + hstep, voffB); PG8_STAGE(PG8_SA(0, 1), rA, cA + hstep, voffA);
        if (wr == 1) PG8_BAR;
        PG8_WAIT_V(4); PG8_BAR;
        PG8_STAGE(PG8_SB(1, 0), rB, cB + kstep, voffB); PG8_STAGE(PG8_SA(1, 0), rA, cA + kstep, voffA); PG8_STAGE(PG8_SB(1, 1), rB, cB + hstep + kstep, voffB);
        PG8_WAIT_V(6); PG8_BAR;
    }
    for (;;) {
        const bool has_next = S.next(ui + 1, nxt);
        const unsigned nA = has_next ? (unsigned)nxt.pm * tstep : cA, nB = has_next ? (unsigned)nxt.pn * tstep : cB;
        for (int t = 0; t < nt; t += 2) {
            const bool last = (t == nt - 2);
            const unsigned a1 = cA + (unsigned)(t + 1) * kstep;
            const unsigned a2 = last ? nA : cA + (unsigned)(t + 2) * kstep, b2 = last ? nB : cB + (unsigned)(t + 2) * kstep;
            const unsigned a3 = a2 + kstep, b3 = b2 + kstep;
            if (last && has_next) S.a_ready(nxt);
            if constexpr (Epi::PREFETCH) { if (t == 0) E.prefetch(cur, lds + PG8_PRM_OFF + (ui & 1) * 4096, wid); }
            if constexpr (SP2) {
            PG8_LDB(B0, 0, 0); PG8_LDB(B1, 0, 1); PG8_SCHED; PG8_LDA(At, 0, 0); PG8_STAGE(PG8_SA(1, 1), rA, a1 + hstep, voffA);
            PG8_WAIT_V(8); PG8_WAIT_L(0); PG8_BAR; PG8_MMA(0, 0, At, B0); PG8_MMA(0, 1, At, B1); PG8_BAR; PG8_SCHED;
            PG8_LDA(At, 0, 1); PG8_STAGE(PG8_SB(0, 0), rB, b2, voffB); PG8_STAGE(PG8_SB(0, 1), rB, b2 + hstep, voffB); PG8_STAGE(PG8_SA(0, 0), rA, a2, voffA);
            PG8_WAIT_V(8); PG8_WAIT_L(0); PG8_BAR; PG8_MMA(1, 0, At, B0); PG8_MMA(1, 1, At, B1); PG8_BAR; PG8_SCHED;
            PG8_LDB(B0, 1, 0); PG8_LDB(B1, 1, 1); PG8_SCHED; PG8_LDA(At, 1, 0); PG8_STAGE(PG8_SA(0, 1), rA, a2 + hstep, voffA);
            PG8_WAIT_V(8); PG8_WAIT_L(0); PG8_BAR; PG8_MMA(0, 0, At, B0); PG8_MMA(0, 1, At, B1); PG8_BAR; PG8_SCHED;
            PG8_LDA(At, 1, 1); PG8_STAGE(PG8_SB(1, 0), rB, b3, voffB); PG8_STAGE(PG8_SB(1, 1), rB, b3 + hstep, voffB); PG8_STAGE(PG8_SA(1, 0), rA, a3, voffA);
            PG8_WAIT_V(8); PG8_WAIT_L(0); PG8_BAR; PG8_MMA(1, 0, At, B0); PG8_MMA(1, 1, At, B1); PG8_BAR; PG8_SCHED;
            } else {
            PG8_LDB(B0, 0, 0); PG8_SCHED; PG8_LDA(At, 0, 0); PG8_STAGE(PG8_SA(1, 1), rA, a1 + hstep, voffA);
            PG8_WAIT_L(8); PG8_BAR; PG8_WAIT_L(0); PG8_MMA(0, 0, At, B0); PG8_BAR; PG8_SCHED;
            PG8_LDB(B1, 0, 1); PG8_STAGE(PG8_SB(0, 0), rB, b2, voffB);
            PG8_BAR; PG8_WAIT_L(0); PG8_MMA(0, 1, At, B1); PG8_BAR;
            PG8_LDA(At, 0, 1); PG8_STAGE(PG8_SA(0, 0), rA, a2, voffA);
            PG8_BAR; PG8_WAIT_L(0); PG8_MMA(1, 0, At, B0); PG8_BAR; PG8_SCHED;
            PG8_STAGE(PG8_SB(0, 1), rB, b2 + hstep, voffB);
            PG8_WAIT_V(6); PG8_BAR; PG8_MMA(1, 1, At, B1); PG8_BAR;
            PG8_LDB(B0, 1, 0); PG8_SCHED; PG8_LDA(At, 1, 0); PG8_STAGE(PG8_SA(0, 1), rA, a2 + hstep, voffA);
            PG8_WAIT_L(8); PG8_BAR; PG8_WAIT_L(0); PG8_MMA(0, 0, At, B0); PG8_BAR; PG8_SCHED;
            PG8_LDB(B1, 1, 1); PG8_STAGE(PG8_SB(1, 0), rB, b3, voffB);
            PG8_BAR; PG8_WAIT_L(0); PG8_MMA(0, 1, At, B1); PG8_BAR;
            PG8_LDA(At, 1, 1); PG8_STAGE(PG8_SA(1, 0), rA, a3, voffA);
            PG8_BAR; PG8_WAIT_L(0); PG8_MMA(1, 0, At, B0); PG8_BAR; PG8_SCHED;
            PG8_STAGE(PG8_SB(1, 1), rB, b3 + hstep, voffB);
            PG8_WAIT_V(6); PG8_BAR; PG8_MMA(1, 1, At, B1); PG8_BAR;
            }
        }
        if constexpr (ALIGN_EPI) { if (wr == 0) PG8_BAR; }
        if constexpr (!Epi::AFTER_DRAIN) { int ln_ = (int)__builtin_amdgcn_mbcnt_hi(~0u, __builtin_amdgcn_mbcnt_lo(~0u, 0u)); asm volatile("" : "+v"(ln_));
            E(acc, cur, wr, wc, ln_ & 15, ln_ >> 4, lds + PG8_PRM_OFF + (ui & 1) * 4096); S.done(cur); }
        if (!has_next) break;
#pragma unroll
        for (int a = 0; a < 2; ++a)
#pragma unroll
            for (int b = 0; b < 2; ++b)
#pragma unroll
                for (int m = 0; m < 4; ++m)
#pragma unroll
                    for (int n = 0; n < 2; ++n) acc[a][b][m][n] = (f32x4){0.f, 0.f, 0.f, 0.f};
        cur = nxt; cA = nA; cB = nB; ++ui;
        if constexpr (ALIGN_EPI) { if (wr == 1) PG8_BAR; }
    }
    PG8_WAIT_V(0);
    if constexpr (!ALIGN_EPI) { if (wr == 0) PG8_BAR; }
    PG8_BAR;
    if constexpr (Epi::AFTER_DRAIN) { E.fused(acc, cur, wr, wc, fr, fq, lds, wid, lane); S.done(cur); }
#undef PG8_SA
#undef PG8_SB
#undef PG8_STAGE
#undef PG8_LDA
#undef PG8_LDB
#undef PG8_MMA
#undef PG8_WAIT_V
#undef PG8_WAIT_L
#undef PG8_BAR
#undef PG8_SCHED
#undef PG8_F8CAT
}
}

constexpr int NWAVES = 8, NTHR = NWAVES * 64;
constexpr int BATCH = 8, SEQ = 2048, DM = 2048, DEPTH = 2, HD = 64, GW = 512, NH = 8;
constexpr int M = BATCH * SEQ;
constexpr int NPROJ = 6080, NPROJ_P = 6144, DFF = 5632;
constexpr int CA_Q = 0, CA_K = 512, CA_V = 1024, CB_U = 1536, CB_V = 2048, CC_Q = 2560, CC_K = 3072, CC_V = 3584, CD = 4096;
constexpr int D_R = 0, D_WD = 512, D_K = 608, D_V = 1120, D_AD = 1632, D_GD = 1728, D_W = 1984;
constexpr float NORM_EPS = 1e-6f;
#ifndef N_LAUNCH_MODE
#define N_LAUNCH_MODE 0
#endif
#ifndef PG8_SP2
#define PG8_SP2 true
#endif
#ifndef FFN_FP8
#define FFN_FP8 1
#endif
#ifndef REPEAT
#define REPEAT 0
#endif
#ifndef GEMM_I8
#define GEMM_I8 3
#endif
#ifndef BFMASK
#define BFMASK 0x003C0Fu
#endif
#ifndef FFN1_I8
#define FFN1_I8 1
#endif
#define I8_IN ((GEMM_I8 & 1) != 0)
#define I8_OUT ((GEMM_I8 & 2) != 0)
constexpr int N_PHASES = 20;

constexpr size_t MiB = 1u << 20;
constexpr size_t WS_CTL = 0, CTL_ZERO_BYTES = 2 * MiB;
constexpr size_t WS_WIN = 2 * MiB, WS_WOUT = 26 * MiB, WS_WGU = 34 * MiB, WS_WDN = 78 * MiB, WS_SMALL = 100 * MiB;
constexpr size_t WS_XB = 104 * MiB, WS_PROJ = 168 * MiB, WS_YCAT = 360 * MiB, WS_SC2 = 424 * MiB, WS_YD = 456 * MiB, WS_G = 488 * MiB, WS_BC = 504 * MiB, WS_END = 506 * MiB;
constexpr size_t WS_XQ = WS_YD, WS_YQ = WS_PROJ;
constexpr size_t SC_ARR = (size_t)M * GW * 2;
constexpr size_t SM_TB = 0;
constexpr size_t SM_KBAR = 64 * 1024;
constexpr size_t SM_STATS = 256 * 1024;
constexpr size_t SM_SAX = 2048 * 1024, SM_SAY = SM_SAX + 64 * 1024;
constexpr size_t SM_SWIN = SM_SAY + 64 * 1024, SM_SWOUT = SM_SWIN + 32 * 1024, SM_SWGU = SM_SWOUT + 16 * 1024;
constexpr size_t SM_BIAS = 3072 * 1024;
constexpr size_t SM_WT = 1024 * 1024;
constexpr int CW_BAR = 4096;
constexpr int CW_Q = 8192;
constexpr int CW_SSQ = 65536;
constexpr size_t CTL_KBAR = 1024 * 1024;
constexpr size_t CTL_STATS = 1280 * 1024;
static_assert((size_t)CW_SSQ * 4 + 5 * (size_t)M * 8 <= CTL_KBAR && CTL_STATS + 2 * (size_t)M * 2 * 8 <= CTL_ZERO_BYTES, "CTL");

constexpr int RING_OFF = 0, RING_BYTES = 131072;
constexpr int LDS_BYTES = 163840, MISC_OFF = LDS_BYTES - 256;

#define GAS __attribute__((address_space(1)))
#define LAS __attribute__((address_space(3)))
typedef unsigned short bf16;
typedef unsigned v4u __attribute__((ext_vector_type(4)));
typedef unsigned v2u __attribute__((ext_vector_type(2)));
typedef float f32x4 __attribute__((ext_vector_type(4)));
typedef short bf16x8 __attribute__((ext_vector_type(8)));
typedef float f32x16 __attribute__((ext_vector_type(16)));
typedef GAS unsigned gu32;
#define RLX_AGENT __ATOMIC_RELAXED, __HIP_MEMORY_SCOPE_AGENT
#define LDS_WAIT() asm volatile("s_waitcnt lgkmcnt(0)" ::: "memory")
#define VM_WAIT() asm volatile("s_waitcnt vmcnt(0)" ::: "memory")
__device__ __forceinline__ unsigned f2bf(float f) { unsigned u = __builtin_bit_cast(unsigned, f); return (u + 0x7fffu + ((u >> 16) & 1u)) >> 16; }
__device__ __forceinline__ unsigned pk2(float lo, float hi) { return f2bf(lo) | (f2bf(hi) << 16); }
__device__ __forceinline__ float bf2f(unsigned short h) { return __builtin_bit_cast(float, (unsigned)h << 16); }
__device__ __forceinline__ float bflo(unsigned w) { return __builtin_bit_cast(float, w << 16); }
__device__ __forceinline__ float bfhi(unsigned w) { return __builtin_bit_cast(float, w & 0xffff0000u); }
__device__ __forceinline__ float sigmoidf_(float x) { return 1.0f / (1.0f + __expf(-x)); }
__device__ __forceinline__ float gelu_tanh(float x) { const float u = 0.7978845608028654f * (x + 0.044715f * x * x * x); const float e = __expf(2.0f * u); const float th = 1.0f - 2.0f / (e + 1.0f); return 0.5f * x * (1.0f + th); }
__device__ __forceinline__ float wave_sum(float v) {
#pragma unroll
    for (int o = 1; o < 64; o <<= 1) v += __shfl_xor(v, o);
    return v;
}

__device__ __forceinline__ float zero_v() { float z = 0.f; asm volatile("" : "+v"(z)); return z; }

__device__ __forceinline__ unsigned q8pack4(float a, float b, float c, float d, float inv) {
    const int ia = (int)__builtin_rintf(a * inv), ib = (int)__builtin_rintf(b * inv), ic = (int)__builtin_rintf(c * inv), id = (int)__builtin_rintf(d * inv);
    return ((unsigned)ia & 0xffu) | (((unsigned)ib & 0xffu) << 8) | (((unsigned)ic & 0xffu) << 16) | ((unsigned)id << 24); }
__device__ __forceinline__ float wave_max(float v) {
#pragma unroll
    for (int o = 1; o < 64; o <<= 1) v = fmaxf(v, __shfl_xor(v, o));
    return v;
}
#define UNPACK8(dst, o, W_) do { dst[(o)] = bflo((W_).x); dst[(o) + 1] = bfhi((W_).x); dst[(o) + 2] = bflo((W_).y); dst[(o) + 3] = bfhi((W_).y); dst[(o) + 4] = bflo((W_).z); dst[(o) + 5] = bfhi((W_).z); dst[(o) + 6] = bflo((W_).w); dst[(o) + 7] = bfhi((W_).w); } while (0)
#define XB_TMO      128
#define XB_XCNT(j)  (256  + 64 * (j))
#define XB_XSUB(j)  (1280 + 64 * (j))
#define XB_XGEN(j)  (2304 + 64 * (j))
#define XB_TOP      3328
#define XB_TOPGEN   3392
#define XCD_BAR_WORDS 3456
#define XB_SPIN_CAP (1u << 18)

__device__ __forceinline__ unsigned xb_ld(unsigned* p)              { return __hip_atomic_load(p, __ATOMIC_RELAXED, __HIP_MEMORY_SCOPE_AGENT); }
__device__ __forceinline__ unsigned xb_add(unsigned* p, unsigned v) { return __hip_atomic_fetch_add(p, v, __ATOMIC_RELAXED, __HIP_MEMORY_SCOPE_AGENT); }
__device__ __forceinline__ unsigned xb_xcc_id() { return (unsigned)__builtin_amdgcn_s_getreg((3 << 11) | 20) & 0xFu; }
#define XB_SPIN(cond, bar) do { unsigned _sp = 0; while (cond) { __builtin_amdgcn_s_sleep(1); \
    if ((++_sp & 255u) == 0u) { if (xb_ld(&(bar)[XB_TMO])) break; if (_sp > XB_SPIN_CAP) { atomicAdd(&(bar)[XB_TMO], 1u); break; } } } } while (0)

struct XcdBarrier {
    unsigned* bar; unsigned x; int wv;
    volatile LAS unsigned* st;
};

__device__ __forceinline__ XcdBarrier xcd_barrier_post(unsigned* bar, volatile LAS unsigned* st, int wv) {
    XcdBarrier b; b.bar = bar; b.x = xb_xcc_id(); b.st = st; b.wv = wv;
    if (wv == 0 && pg8::lane_now() == 0) (void)xb_add(&bar[XB_XCNT(b.x)], 1u);
    return b;
}
__device__ __forceinline__ void xcd_barrier_complete(unsigned* bar, unsigned x, unsigned& nloc, unsigned& nx) {
    const unsigned G = gridDim.x * gridDim.y * gridDim.z;
    unsigned sum, cnt, mine, sp = 0u;
    for (;;) {
        sum = 0u; cnt = 0u; mine = 0u;
#pragma unroll
        for (unsigned j = 0; j < 16; ++j) { const unsigned c = xb_ld(&bar[XB_XCNT(j)]); sum += c; cnt += (c > 0u) ? 1u : 0u; mine = (j == x) ? c : mine; }
        if (sum == G) break;
        __builtin_amdgcn_s_sleep(1);
        if ((++sp & 255u) == 0u) { if (xb_ld(&bar[XB_TMO])) break; if (sp > XB_SPIN_CAP) { atomicAdd(&bar[XB_TMO], 1u); break; } }
    }
    nloc = mine > 0u ? mine : 1u; nx = cnt > 0u ? cnt : 1u;
}

__device__ __forceinline__ void xcd_barrier(const XcdBarrier& b) {
    asm volatile("s_waitcnt vmcnt(0)" ::: "memory");
    __syncthreads();
    if (b.wv == 0 && pg8::lane_now() == 0) {
        unsigned* bar = b.bar;
        __builtin_amdgcn_s_waitcnt(0);
        unsigned nloc = b.st[0], nx = b.st[1];
        if (nloc == 0u) { xcd_barrier_complete(bar, b.x, nloc, nx); b.st[0] = nloc; b.st[1] = nx; }
        const unsigned old = xb_add(&bar[XB_XSUB(b.x)], 1u);
        const unsigned gen = old / nloc;
        if (old + 1u == (gen + 1u) * nloc) {
            __builtin_amdgcn_fence(__ATOMIC_RELEASE, "agent");
            asm volatile("s_waitcnt vmcnt(0)" ::: "memory");
            const unsigned og = xb_add(&bar[XB_TOP], 1u);
            const unsigned tg = og / nx;
            if (og + 1u == (tg + 1u) * nx) xb_add(&bar[XB_TOPGEN], 1u);
            else XB_SPIN(xb_ld(&bar[XB_TOPGEN]) == tg, bar);
            __builtin_amdgcn_fence(__ATOMIC_ACQUIRE, "agent");
            xb_add(&bar[XB_XGEN(b.x)], 1u);
            asm volatile("s_waitcnt vmcnt(0)" ::: "memory");
        } else {
            XB_SPIN(xb_ld(&bar[XB_XGEN(b.x)]) == gen, bar);
            __builtin_amdgcn_fence(__ATOMIC_ACQUIRE, "agent");
            asm volatile("s_waitcnt vmcnt(0)" ::: "memory");
        }
    }
    __syncthreads();
}

struct Args { const float* in[25]; float* out; unsigned char* ws; int ph_lo, ph_hi; };
struct Frame {
    LAS unsigned char* lds; int tid, lane, wave, G, vcu, gw, ngw;
};
typedef const __attribute__((address_space(4))) unsigned long long* karg_t;
__device__ __forceinline__ karg_t kargs() { karg_t ka = (karg_t)__builtin_amdgcn_kernarg_segment_ptr(); asm volatile("" : "+s"(ka)); return ka; }
__device__ __forceinline__ const float* inp(int i) { return (const float*)(const GAS float*)kargs()[i]; }
__device__ __forceinline__ float* outp() { return (float*)(GAS float*)kargs()[25]; }
__device__ __forceinline__ unsigned char* wsp() { return (unsigned char*)(GAS unsigned char*)kargs()[26]; }
__device__ __forceinline__ gu32* ctlp() { return (gu32*)(wsp() + WS_CTL); }

__device__ __forceinline__ void conv_item(const float* W, int K, int N, const float* g, bf16* WT, int kind, LAS float* scr, int item, int lane, int ncols = 0) {
    const int nblk = (ncols ? ncols : N) / 32, kb = item / nblk, nb = item % nblk, k0 = 64 * kb, n0 = 32 * nb;
    float ld[32];
    { const float* wp = W + (size_t)(k0 + (lane >> 5)) * N + n0 + (lane & 31);
#pragma unroll
      for (int i = 0; i < 32; ++i) ld[i] = wp[(size_t)(2 * i) * N]; }
    if (g) { const float* gp = g + k0 + (lane >> 5);
#pragma unroll
      for (int i = 0; i < 32; ++i) ld[i] *= gp[2 * i]; }
#pragma unroll
    for (int i = 0; i < 32; ++i) scr[(2 * i + (lane >> 5)) * 33 + (lane & 31)] = ld[i];
    LDS_WAIT(); asm volatile("" ::: "memory");
    const int c = lane & 7;
#pragma unroll
    for (int j = 0; j < 4; ++j) { const int n = (lane >> 3) + 8 * j; const LAS float* s = scr + (8 * c) * 33 + n;
        v4u o; o.x = pk2(s[0 * 33], s[1 * 33]); o.y = pk2(s[2 * 33], s[3 * 33]); o.z = pk2(s[4 * 33], s[5 * 33]); o.w = pk2(s[6 * 33], s[7 * 33]);
        const int nn = n0 + n;
        if (kind >= 3) {
            const int row = kind == 5 ? nn : ((nn >> 7) * 256 + (kind - 3) * 128 + (nn & 127)); int f0 = (int)o.x, f1 = (int)o.y;
            f0 = __builtin_amdgcn_cvt_pk_fp8_f32(64.f * s[0 * 33], 64.f * s[1 * 33], f0, false); f0 = __builtin_amdgcn_cvt_pk_fp8_f32(64.f * s[2 * 33], 64.f * s[3 * 33], f0, true);
            f1 = __builtin_amdgcn_cvt_pk_fp8_f32(64.f * s[4 * 33], 64.f * s[5 * 33], f1, false); f1 = __builtin_amdgcn_cvt_pk_fp8_f32(64.f * s[6 * 33], 64.f * s[7 * 33], f1, true);
            *(GAS v2u*)((unsigned char*)WT + (size_t)row * K + k0 + 8 * c) = (v2u){(unsigned)f0, (unsigned)f1};
        } else {
        const int row = kind == 0 ? nn : ((nn >> 7) * 256 + (kind - 1) * 128 + (nn & 127));
        *(GAS v4u*)(WT + (size_t)row * K + k0 + 8 * c) = o; } }
    LDS_WAIT(); asm volatile("" ::: "memory");
}
__device__ __forceinline__ void conv_cols_i8(const float* W, int K, int N, const float* g, unsigned char* WQ, float* SW, int nb, Frame& F, int orow0 = -1) {
    constexpr int CC_PITCH = 2 * DM + 16;
    LAS unsigned char* T = F.lds + RING_OFF; LAS float* red = (LAS float*)(F.lds + RING_OFF + 32 * CC_PITCH);
    static_assert(32 * CC_PITCH + 1024 <= MISC_OFF, "conv LDS");
    const int n0 = 32 * nb, lane = F.lane, nkb = K / 64, o0 = orow0 < 0 ? n0 : orow0;
    const float* wp0 = W + (size_t)(lane >> 5) * N + n0 + (lane & 31);
    float mx = 0.f;
    for (int kb = F.wave; kb < nkb; kb += NWAVES) {
        const float* wp = wp0 + (size_t)(64 * kb) * N; const float* gp = g + 64 * kb + (lane >> 5);
        float ld[32];
#pragma unroll
        for (int i = 0; i < 32; ++i) ld[i] = wp[(size_t)(2 * i) * N];
        LAS unsigned char* tp = T + (lane & 31) * CC_PITCH + 2 * (64 * kb + (lane >> 5));
#pragma unroll
        for (int i = 0; i < 32; ++i) { const unsigned h = f2bf(ld[i] * gp[2 * i]); mx = fmaxf(mx, fabsf(__builtin_bit_cast(float, h << 16))); *(LAS unsigned short*)(tp + 4 * i) = (unsigned short)h; }
    }
    mx = fmaxf(mx, __shfl_xor(mx, 32));
    if (lane < 32) red[F.wave * 32 + lane] = mx;
    __syncthreads();
#pragma unroll
    for (int j = 0; j < 4; ++j) { const int n = 4 * F.wave + j;
        float cm = 0.f;
#pragma unroll
        for (int w = 0; w < NWAVES; ++w) cm = fmaxf(cm, red[w * 32 + n]);
        const float inv = cm > 0.f ? 127.0f / cm : 0.f;
        if (lane == 0) SW[o0 + n] = cm * (1.0f / 127.0f);
        const LAS unsigned char* tr = T + n * CC_PITCH + 16 * lane; unsigned char* wq = WQ + (size_t)(o0 + n) * K + 8 * lane;
#pragma unroll
        for (int it = 0; it < 4; ++it) { const v4u w = *(const LAS v4u*)(tr + 1024 * it);
            *(GAS v2u*)(wq + 512 * it) = (v2u){q8pack4(bflo(w.x), bfhi(w.x), bflo(w.y), bfhi(w.y), inv), q8pack4(bflo(w.z), bfhi(w.z), bflo(w.w), bfhi(w.w), inv)}; }
    }
    __syncthreads();
}
__device__ __forceinline__ void conv_layer_items(Frame& F, int l, int gw, int ngw, bool do_in, bool do_rest) {
    LAS float* scr = (LAS float*)(F.lds + RING_OFF + F.wave * 16384);
    constexpr int I_IN = (DM / 64) * (NPROJ / 32), I_OUT = (DM / 64) * (DM / 32), I_G = (DM / 64) * (DFF / 32), I_D = (DFF / 64) * (DM / 32);
    const float* w_in = inp(2) + (size_t)l * DM * NPROJ; const float* w_out = inp(19) + (size_t)l * DM * DM;
    const float* w_g = inp(21) + (size_t)l * DM * DFF; const float* w_u = inp(22) + (size_t)l * DM * DFF; const float* w_d = inp(23) + (size_t)l * DFF * DM;
    const float* g_mix = inp(1) + l * DM; const float* g_br = inp(18) + l * DM; const float* g_ffn = inp(20) + l * DM;
    bf16* WIN = (bf16*)(wsp() + WS_WIN); bf16* WOUT = (bf16*)(wsp() + WS_WOUT); bf16* WGU = (bf16*)(wsp() + WS_WGU); bf16* WDN = (bf16*)(wsp() + WS_WDN);
    if (do_in) {
        for (int it = gw; it < I_IN; it += ngw) conv_item(w_in, DM, NPROJ, g_mix, WIN, 0, scr, it, F.lane);
    }
    if (do_rest) {
        for (int it = gw; it < (I8_OUT ? 0 : I_OUT) + (FFN1_I8 ? 0 : 2 * I_G) + I_D; it += ngw) {
            int r = it + (I8_OUT ? I_OUT : 0); if (FFN1_I8 && r >= I_OUT) r += 2 * I_G;
            if (r < I_OUT) { conv_item(w_out, DM, DM, g_br, WOUT, 0, scr, r, F.lane); continue; } r -= I_OUT;
            if (r < I_G) { conv_item(w_g, DM, DFF, g_ffn, WGU, FFN_FP8 ? 3 : 1, scr, r, F.lane); continue; } r -= I_G;
            if (r < I_G) { conv_item(w_u, DM, DFF, g_ffn, WGU, FFN_FP8 ? 4 : 2, scr, r, F.lane); continue; } r -= I_G;
            conv_item(w_d, DFF, DM, nullptr, WDN, FFN_FP8 ? 5 : 0, scr, r, F.lane);
        }
    }
}

constexpr int WINB_NB = 8 * __builtin_popcount(BFMASK), WINB_ITEMS = (DM / 64) * WINB_NB;
__device__ __forceinline__ bf16* winb_ptr() { return (bf16*)outp() + (size_t)6 * M * GW; }
__device__ __forceinline__ void conv_winb(Frame& F, int l, int item) {
    if (item >= WINB_ITEMS) return;
    const int kb = item / (WINB_NB ? WINB_NB : 1), r = item % (WINB_NB ? WINB_NB : 1); unsigned m = BFMASK; for (int j = 0; j < (r >> 3); ++j) m &= m - 1;
    conv_item(inp(2) + (size_t)l * DM * NPROJ, DM, NPROJ, inp(1) + l * DM, winb_ptr(), 0, (LAS float*)(F.lds + RING_OFF + F.wave * 16384), kb * (NPROJ / 32) + __builtin_ctz(m) * 8 + (r & 7), F.lane);
}
__device__ __forceinline__ void ph_prologue(Frame& F) {
    if (I8_IN) {
        for (int nb = blockIdx.x; nb < NPROJ / 32; nb += F.G) conv_cols_i8(inp(2), DM, NPROJ, inp(1), wsp() + WS_WIN, (float*)(wsp() + WS_SMALL + SM_SWIN), nb, F);
        unsigned char* WIN = wsp() + WS_WIN; float* SWIN = (float*)(wsp() + WS_SMALL + SM_SWIN);
        for (int i = F.gw * 64 + F.lane; i < 64 * DM / 16; i += F.ngw * 64) *(GAS v4u*)(WIN + (size_t)NPROJ * DM + (size_t)i * 16) = (v4u){0u, 0u, 0u, 0u};
        if (blockIdx.x == 0 && F.tid < NPROJ_P - NPROJ) SWIN[NPROJ + F.tid] = 0.f;
        for (int it = F.gw; it < WINB_ITEMS; it += F.ngw) conv_winb(F, 0, it);
    } else {
    conv_layer_items(F, 0, F.gw, F.ngw, true, false);
    { bf16* WIN = (bf16*)(wsp() + WS_WIN);
      for (int i = F.gw * 64 + F.lane; i < 64 * DM / 8; i += F.ngw * 64) *(GAS v4u*)(WIN + (size_t)NPROJ * DM + (size_t)i * 8) = (v4u){0u, 0u, 0u, 0u}; } }
    if (blockIdx.x == 0) {
        int* TB = (int*)(wsp() + WS_SMALL + SM_TB);
        for (int d = F.tid; d < 2049; d += NTHR) {
            int bkt = d;
            if (d >= 16) bkt = 16 + (d >= 22) + (d >= 30) + (d >= 40) + (d >= 54) + (d >= 73) + (d >= 99) + (d >= 134) + (d >= 182) + (d >= 246) + (d >= 332) + (d >= 450) + (d >= 609) + (d >= 825) + (d >= 1117) + (d >= 1513);
            TB[d] = bkt;
        }
    }
    if (blockIdx.x >= 1 && blockIdx.x <= 16) {
        const int hcol = blockIdx.x - 1; float* BT = (float*)(wsp() + WS_SMALL + SM_BIAS) + hcol * 2048; const float* pb = inp(3);
        for (int d = F.tid; d < 2048; d += NTHR) {
            int bkt = d;
            if (d >= 16) bkt = 16 + (d >= 22) + (d >= 30) + (d >= 40) + (d >= 54) + (d >= 73) + (d >= 99) + (d >= 134) + (d >= 182) + (d >= 246) + (d >= 332) + (d >= 450) + (d >= 609) + (d >= 825) + (d >= 1117) + (d >= 1513);
            BT[d] = pb[bkt * 16 + hcol] * 1.4426950408889634f;
        }
    }
    { bf16* WT = (bf16*)(wsp() + WS_SMALL + SM_WT); const float* w2 = inp(9); const float* a2 = inp(11); const float* g2 = inp(12);
      for (int idx = blockIdx.x * NTHR + F.tid; idx < DEPTH * 448 * GW; idx += F.G * NTHR) {
          const int c = idx % GW, k = (idx / GW) % 448, l = idx / (GW * 448);
          const float v = k < 96 ? w2[((size_t)l * 96 + k) * GW + c] : (k < 192 ? a2[((size_t)l * 96 + (k - 96)) * GW + c] : g2[((size_t)l * 256 + (k - 192)) * GW + c]);
          const int r32_ = c & 31, hct = c >> 5, ks_ = k >> 4, hh_ = (k >> 3) & 1;
          WT[(size_t)l * GW * 448 + (((size_t)hct * 28 + ks_) * 64 + 32 * hh_ + r32_) * 8 + (k & 7)] = (bf16)f2bf(v); } }
    const float* x = inp(0); bf16* XB = (bf16*)(wsp() + WS_XB); pg8::fx_t* ssq = (pg8::fx_t*)(ctlp() + CW_SSQ);
    for (int m = F.gw; m < M; m += F.ngw) {
        const GAS f32x4* xr = (const GAS f32x4*)(x + (size_t)m * DM) + F.lane; GAS v2u* o = (GAS v2u*)(XB + (size_t)m * DM) + F.lane; float s = 0.f;
#pragma unroll
        for (int j = 0; j < 8; ++j) { const f32x4 v = xr[64 * j]; s += (v.x * v.x + v.y * v.y) + (v.z * v.z + v.w * v.w); o[64 * j] = (v2u){pk2(v.x, v.y), pk2(v.z, v.w)}; }
        s = wave_sum(s); if (F.lane == 0) pg8::fx_add(ssq + m, s);
        if (I8_IN) {
            float mx = 0.f;
#pragma unroll
            for (int j = 0; j < 8; ++j) { const f32x4 v = xr[64 * j]; mx = fmaxf(fmaxf(mx, fmaxf(fabsf(v.x), fabsf(v.y))), fmaxf(fabsf(v.z), fabsf(v.w))); }
            mx = wave_max(mx); const float inv = mx > 0.f ? 127.0f / mx : 0.f; GAS unsigned* q = (GAS unsigned*)(wsp() + WS_XQ + (size_t)m * DM) + F.lane;
#pragma unroll
            for (int j = 0; j < 8; ++j) { const f32x4 v = xr[64 * j]; q[64 * j] = q8pack4(v.x, v.y, v.z, v.w, inv); }
            if (F.lane == 0) ((float*)(wsp() + WS_SMALL + SM_SAX))[m] = mx * (1.0f / 127.0f);
        }
    }
}

__device__ __forceinline__ void ph_quantx(Frame& F) {
    const bf16* XB = (const bf16*)(wsp() + WS_XB); unsigned char* XQ = wsp() + WS_XQ; float* SAX = (float*)(wsp() + WS_SMALL + SM_SAX);
    for (int m = F.gw; m < M; m += F.ngw) {
        const GAS v4u* xr = (const GAS v4u*)(XB + (size_t)m * DM) + F.lane; v4u w[4]; float mx = 0.f;
#pragma unroll
        for (int j = 0; j < 4; ++j) w[j] = xr[64 * j];
#pragma unroll
        for (int j = 0; j < 4; ++j) { mx = fmaxf(fmaxf(mx, fmaxf(fabsf(bflo(w[j].x)), fabsf(bfhi(w[j].x)))), fmaxf(fabsf(bflo(w[j].y)), fabsf(bfhi(w[j].y))));
            mx = fmaxf(fmaxf(mx, fmaxf(fabsf(bflo(w[j].z)), fabsf(bfhi(w[j].z)))), fmaxf(fabsf(bflo(w[j].w)), fabsf(bfhi(w[j].w)))); }
        mx = wave_max(mx); const float inv = mx > 0.f ? 127.0f / mx : 0.f; GAS v2u* q = (GAS v2u*)(XQ + (size_t)m * DM) + F.lane;
#pragma unroll
        for (int j = 0; j < 4; ++j) q[64 * j] = (v2u){q8pack4(bflo(w[j].x), bfhi(w[j].x), bflo(w[j].y), bfhi(w[j].y), inv), q8pack4(bflo(w[j].z), bfhi(w[j].z), bflo(w[j].w), bfhi(w[j].w), inv)};
        if (F.lane == 0) SAX[m] = mx * (1.0f / 127.0f);
    }
}

constexpr int PR_PITCH = 912;
constexpr int PR_PRM_OFF = 32768, PR_MUA_OFF = PR_PRM_OFF + 8 * 512 * 4;
__device__ __forceinline__ float fast_tanh(float x) { return 1.0f - 2.0f * __builtin_amdgcn_rcpf(__expf(2.0f * x) + 1.0f); }
__device__ __forceinline__ float fast_sigmoid(float x) { return __builtin_amdgcn_rcpf(1.0f + __expf(-x)); }
constexpr int PR_OT_OFF = 51200, PR_OT_PITCH = 72, PR_OT_TILE = 32 * PR_OT_PITCH, PR_OT_WAVE = 6 * PR_OT_TILE;
static_assert(PR_OT_OFF + 8 * PR_OT_WAVE <= MISC_OFF, "prep LDS");
__device__ __forceinline__ void ph_prep(Frame& F, int l) {
    const bf16* PROJ = (const bf16*)(wsp() + WS_PROJ);
    bf16* R_ = (bf16*)outp();
    bf16* E_ = R_ + (size_t)M * GW; bf16* KP_ = E_ + (size_t)M * GW; bf16* V_ = KP_ + (size_t)M * GW;
    bf16* KK_ = (bf16*)outp() + (size_t)4 * M * GW; bf16* AS_ = KK_ + (size_t)M * GW; bf16* G_ = (bf16*)(wsp() + WS_G); float* BC = (float*)(wsp() + WS_BC);
    const bf16* WT = (const bf16*)(wsp() + WS_SMALL + SM_WT) + (size_t)l * GW * 448;
    LAS unsigned char* actL = F.lds + RING_OFF; LAS float* PRM = (LAS float*)(F.lds + PR_PRM_OFF); LAS float* MUA = (LAS float*)(F.lds + PR_MUA_OFF);
    { const float* mu = inp(7) + l * D_W; const float* w0 = inp(8) + l * GW; const float* a0 = inp(10) + l * GW; const float* k_k = inp(13) + l * GW; const float* k_a = inp(14) + l * GW; const float* r_k = inp(15) + l * GW;
      const int c = F.tid;
      PRM[c] = mu[D_R + c]; PRM[512 + c] = mu[D_K + c]; PRM[1024 + c] = mu[D_V + c]; PRM[1536 + c] = w0[c]; PRM[2048 + c] = a0[c]; PRM[2560 + c] = k_k[c]; PRM[3072 + c] = k_a[c]; PRM[3584 + c] = r_k[c];
      if (c < 448) MUA[c] = mu[c < 96 ? D_WD + c : (c < 192 ? D_AD + (c - 96) : D_GD + (c - 192))]; }
    __syncthreads();
    const int h = F.wave;
    for (int it = blockIdx.x; it < M / 32; it += F.G) {
        const int m0 = it * 32;
        int tid_ = F.wave * 64 + pg8::lane_now(); asm volatile("" : "+v"(tid_));
        const int tid = tid_, r32 = tid & 31, hh = (tid >> 5) & 1, lane = tid & 63;
        LAS unsigned char* OT = F.lds + PR_OT_OFF + h * PR_OT_WAVE;
        { v2u pc[7], pp[7];
#pragma unroll
          for (int i = 0; i < 7; ++i) { const int gi = tid + NTHR * i, t = gi / 112, k = 4 * (gi % 112), m = m0 + t;
              const int col = k < 96 ? D_WD + k : (k < 192 ? D_AD + (k - 96) : D_GD + (k - 192)); const bf16* src = PROJ + (size_t)m * NPROJ_P + CD + col;
              pc[i] = *(const GAS v2u*)src; pp[i] = (v2u){0u, 0u}; if ((m % SEQ) > 0) pp[i] = *(const GAS v2u*)(src - NPROJ_P); }
#pragma unroll
          for (int i = 0; i < 7; ++i) { const int gi = tid + NTHR * i, t = gi / 112, k = 4 * (gi % 112);
              const f32x4 mv = *(const LAS f32x4*)(MUA + k);
              float x[4] = {bflo(pc[i].x), bfhi(pc[i].x), bflo(pc[i].y), bfhi(pc[i].y)}; const float xp[4] = {bflo(pp[i].x), bfhi(pp[i].x), bflo(pp[i].y), bfhi(pp[i].y)};
#pragma unroll
              for (int e = 0; e < 4; ++e) { x[e] += (xp[e] - x[e]) * mv[e]; x[e] = k < 96 ? fast_tanh(x[e]) : (k < 192 ? x[e] : fast_sigmoid(x[e])); }
              *(LAS v2u*)(actL + t * PR_PITCH + 2 * k) = (v2u){pk2(x[0], x[1]), pk2(x[2], x[3])}; } }
        __syncthreads();
        const int m = m0 + r32; const bool has_prev = (m % SEQ) > 0;
        const bf16* pr = PROJ + (size_t)m * NPROJ_P + CD; const bf16* pq = pr - NPROJ_P;
        const LAS unsigned char* bp = actL + r32 * PR_PITCH + 16 * hh;
        float kkv[2][16]; float n2 = 0.f, bcv = 0.f;
#pragma unroll
        for (int ct = 0; ct < 2; ++ct) {
            const int cb = 64 * h + 32 * ct + 4 * hh;
            v4u xc[3][2], xp[3][2];
#pragma unroll
            for (int a = 0; a < 3; ++a)
#pragma unroll
                for (int i = 0; i < 2; ++i) { const int mm = m0 + (lane >> 2) + 16 * i; const bf16* src = PROJ + (size_t)mm * NPROJ_P + CD + (a == 0 ? D_R : (a == 1 ? D_K : D_V)) + 64 * h + 32 * ct + 8 * (lane & 3);
                    xc[a][i] = *(const GAS v4u*)src; xp[a][i] = (v4u){0u, 0u, 0u, 0u}; if ((mm % SEQ) > 0) xp[a][i] = *(const GAS v4u*)(src - NPROJ_P); }
            f32x16 aW, aA, aG;
            { const float z_ = zero_v();
#pragma unroll
            for (int i = 0; i < 16; ++i) { aW[i] = z_; aA[i] = z_; aG[i] = z_; } }
            const bf16* wt0 = WT + ((size_t)(2 * h + ct) * 28 * 64 + lane) * 8;
#pragma unroll
            for (int grp = 0; grp < 4; ++grp) {
                bf16x8 af[7];
#pragma unroll
                for (int q = 0; q < 7; ++q) af[q] = *(const GAS bf16x8*)(wt0 + 512 * (7 * grp + q));
#pragma unroll
                for (int q = 0; q < 7; ++q) { const int ks = 7 * grp + q; const bf16x8 bfr = *(const LAS bf16x8*)(bp + 32 * ks);
                    if (ks < 6) aW = __builtin_amdgcn_mfma_f32_32x32x16_bf16(af[q], bfr, aW, 0, 0, 0);
                    else if (ks < 12) aA = __builtin_amdgcn_mfma_f32_32x32x16_bf16(af[q], bfr, aA, 0, 0, 0);
                    else aG = __builtin_amdgcn_mfma_f32_32x32x16_bf16(af[q], bfr, aG, 0, 0, 0); }
                asm volatile("" ::: "memory");
            }
            LAS unsigned char* IN = OT + 3 * PR_OT_TILE;
#pragma unroll
            for (int a = 0; a < 3; ++a)
#pragma unroll
                for (int i = 0; i < 2; ++i) { const int cch = 64 * h + 32 * ct + 8 * (lane & 3); const f32x4 m0v = *(const LAS f32x4*)(PRM + a * 512 + cch), m1v = *(const LAS f32x4*)(PRM + a * 512 + cch + 4);
                    float xcu[8], xpu[8]; UNPACK8(xcu, 0, xc[a][i]); UNPACK8(xpu, 0, xp[a][i]); const float mw[8] = {m0v.x, m0v.y, m0v.z, m0v.w, m1v.x, m1v.y, m1v.z, m1v.w};
#pragma unroll
                    for (int e = 0; e < 8; ++e) xcu[e] += (xpu[e] - xcu[e]) * mw[e];
                    LAS unsigned char* dstp = IN + a * PR_OT_TILE + ((lane >> 2) + 16 * i) * PR_OT_PITCH + 16 * (lane & 3);
                    *(LAS v2u*)dstp = (v2u){pk2(xcu[0], xcu[1]), pk2(xcu[2], xcu[3])}; *(LAS v2u*)(dstp + 8) = (v2u){pk2(xcu[4], xcu[5]), pk2(xcu[6], xcu[7])}; }
            asm volatile("" ::: "memory");
            v2u oE[4], oK[4], oG[4];
#pragma unroll
            for (int g4 = 0; g4 < 4; ++g4) {
                const int c = cb + 8 * g4;
                const f32x4 w0v = *(const LAS f32x4*)(PRM + 1536 + c),
                            a0v = *(const LAS f32x4*)(PRM + 2048 + c), kkc = *(const LAS f32x4*)(PRM + 2560 + c), kac = *(const LAS f32x4*)(PRM + 3072 + c), rkc = *(const LAS f32x4*)(PRM + 3584 + c);
                const LAS unsigned char* inq = IN + r32 * PR_OT_PITCH + 2 * (8 * g4 + 4 * hh);
                const v2u rq = *(const LAS v2u*)inq, kq = *(const LAS v2u*)(inq + PR_OT_TILE), vq = *(const LAS v2u*)(inq + 2 * PR_OT_TILE);
                const float rsu[4] = {bflo(rq.x), bfhi(rq.x), bflo(rq.y), bfhi(rq.y)}, ksu[4] = {bflo(kq.x), bfhi(kq.x), bflo(kq.y), bfhi(kq.y)}, vsu[4] = {bflo(vq.x), bfhi(vq.x), bflo(vq.y), bfhi(vq.y)};
                float ro[4], eo[4], ko[4], vo[4], ao[4], go[4];
#pragma unroll
                for (int e = 0; e < 4; ++e) {
                    const float r = rsu[e], k = ksu[e], v = vsu[e];
                    const float ee = 0.6065306597126334f * fast_sigmoid(w0v[e] + aW[4 * g4 + e]);
                    const float as = fast_sigmoid(a0v[e] + aA[4 * g4 + e]);
                    const float kv = k * kkc[e]; kkv[ct][4 * g4 + e] = kv; n2 += kv * kv;
                    const float kp = k * (1.0f + (as - 1.0f) * kac[e]);
                    bcv += r * kp * rkc[e];
                    ro[e] = r; eo[e] = ee; ko[e] = kp; vo[e] = v; ao[e] = as; go[e] = aG[4 * g4 + e];
                }
                LAS unsigned char* ot = OT + r32 * PR_OT_PITCH + 2 * (8 * g4 + 4 * hh);
                *(LAS v2u*)(ot) = (v2u){pk2(ro[0], ro[1]), pk2(ro[2], ro[3])}; *(LAS v2u*)(ot + PR_OT_TILE) = (v2u){pk2(vo[0], vo[1]), pk2(vo[2], vo[3])}; *(LAS v2u*)(ot + 2 * PR_OT_TILE) = (v2u){pk2(ao[0], ao[1]), pk2(ao[2], ao[3])};
                oE[g4] = (v2u){pk2(eo[0], eo[1]), pk2(eo[2], eo[3])}; oK[g4] = (v2u){pk2(ko[0], ko[1]), pk2(ko[2], ko[3])}; oG[g4] = (v2u){pk2(go[0], go[1]), pk2(go[2], go[3])};
            }
            asm volatile("" ::: "memory");
#pragma unroll
            for (int batch = 0; batch < 2; ++batch) {
                bf16* const dst[3] = {batch == 0 ? R_ : E_, batch == 0 ? V_ : KP_, batch == 0 ? AS_ : G_};
                if (batch == 1) {
#pragma unroll
                    for (int g4 = 0; g4 < 4; ++g4) { LAS unsigned char* ot = OT + r32 * PR_OT_PITCH + 2 * (8 * g4 + 4 * hh); *(LAS v2u*)(ot) = oE[g4]; *(LAS v2u*)(ot + PR_OT_TILE) = oK[g4]; *(LAS v2u*)(ot + 2 * PR_OT_TILE) = oG[g4]; }
                    asm volatile("" ::: "memory"); }
#pragma unroll
                for (int a = 0; a < 3; ++a)
#pragma unroll
                    for (int i = 0; i < 2; ++i) { const int tk = (lane >> 2) + 16 * i, part = lane & 3; const LAS unsigned char* src = OT + a * PR_OT_TILE + tk * PR_OT_PITCH + 16 * part;
                        const v2u lo = *(const LAS v2u*)src, hi = *(const LAS v2u*)(src + 8);
                        *(GAS v4u*)(dst[a] + (size_t)(m0 + tk) * GW + 64 * h + 32 * ct + 8 * part) = (v4u){lo.x, lo.y, hi.x, hi.y}; }
                asm volatile("" ::: "memory");
            }
        }
        n2 += __shfl_xor(n2, 32); bcv += __shfl_xor(bcv, 32);
        const float inv = 1.0f / fmaxf(sqrtf(n2), 1e-12f);
#pragma unroll
        for (int ct = 0; ct < 2; ++ct)
#pragma unroll
            for (int g4 = 0; g4 < 4; ++g4) *(LAS v2u*)(OT + ct * PR_OT_TILE + r32 * PR_OT_PITCH + 2 * (8 * g4 + 4 * hh)) = (v2u){pk2(kkv[ct][4 * g4] * inv, kkv[ct][4 * g4 + 1] * inv), pk2(kkv[ct][4 * g4 + 2] * inv, kkv[ct][4 * g4 + 3] * inv)};
        asm volatile("" ::: "memory");
#pragma unroll
        for (int ct = 0; ct < 2; ++ct)
#pragma unroll
            for (int i = 0; i < 2; ++i) { const int tk = (lane >> 2) + 16 * i, part = lane & 3; const LAS unsigned char* src = OT + ct * PR_OT_TILE + tk * PR_OT_PITCH + 16 * part;
                const v2u lo = *(const LAS v2u*)src, hi = *(const LAS v2u*)(src + 8);
                *(GAS v4u*)(KK_ + (size_t)(m0 + tk) * GW + 64 * h + 32 * ct + 8 * part) = (v4u){lo.x, lo.y, hi.x, hi.y}; }
        asm volatile("" ::: "memory");
        if (hh == 0) BC[(size_t)m * NH + h] = bcv;
        __syncthreads();
    }
}

__device__ __forceinline__ Frame mkframe(LAS unsigned char* lds, int wv) {
    Frame F; F.lds = lds; { int t_ = wv * 64 + pg8::lane_now(); asm volatile("" : "+v"(t_)); F.tid = t_; } F.lane = F.tid & 63; F.wave = wv;
    F.G = gridDim.x; { const int bx = blockIdx.x; F.vcu = (F.G % 8 == 0) ? (bx % 8) * (F.G / 8) + bx / 8 : bx; }
    F.gw = blockIdx.x * NWAVES + F.wave; F.ngw = F.G * NWAVES; return F;
}

#ifndef UNPACK8
#define UNPACK8(dst, o, W_) do { dst[(o)] = bflo((W_).x); dst[(o) + 1] = bfhi((W_).x); dst[(o) + 2] = bflo((W_).y); dst[(o) + 3] = bfhi((W_).y); dst[(o) + 4] = bflo((W_).z); dst[(o) + 5] = bfhi((W_).z); dst[(o) + 6] = bflo((W_).w); dst[(o) + 7] = bfhi((W_).w); } while (0)
#endif
#define DOT8(q, o, W_) ((q)[(o)] * bflo((W_).x) + (q)[(o) + 1] * bfhi((W_).x) + (q)[(o) + 2] * bflo((W_).y) + (q)[(o) + 3] * bfhi((W_).y) + (q)[(o) + 4] * bflo((W_).z) + (q)[(o) + 5] * bfhi((W_).z) + (q)[(o) + 6] * bflo((W_).w) + (q)[(o) + 7] * bfhi((W_).w))
#define AXPY8(acc, o, sc, pe, W_) do { acc[(o)] = acc[(o)] * (sc) + (pe) * bflo((W_).x); acc[(o) + 1] = acc[(o) + 1] * (sc) + (pe) * bfhi((W_).x); acc[(o) + 2] = acc[(o) + 2] * (sc) + (pe) * bflo((W_).y); acc[(o) + 3] = acc[(o) + 3] * (sc) + (pe) * bfhi((W_).y); \
    acc[(o) + 4] = acc[(o) + 4] * (sc) + (pe) * bflo((W_).z); acc[(o) + 5] = acc[(o) + 5] * (sc) + (pe) * bfhi((W_).z); acc[(o) + 6] = acc[(o) + 6] * (sc) + (pe) * bflo((W_).w); acc[(o) + 7] = acc[(o) + 7] * (sc) + (pe) * bfhi((W_).w); } while (0)
__device__ __forceinline__ void mix_a_simple(Frame& F) {
    const bf16* PROJ = (const bf16*)(wsp() + WS_PROJ); bf16* YC = (bf16*)(wsp() + WS_YCAT); const int* TB = (const int*)(wsp() + WS_SMALL + SM_TB); const float* pb = inp(3);
    const int nthr = F.G * NTHR;
    for (int idx = blockIdx.x * NTHR + F.tid; idx < M * NH; idx += nthr) {
        const int m = idx >> 3, h = idx & 7, t = m % SEQ;
        float q[64], acc[64];
        { const GAS v4u* qp = (const GAS v4u*)(PROJ + (size_t)m * NPROJ_P + CA_Q + 64 * h);
#pragma unroll
          for (int i = 0; i < 8; ++i) { const v4u w = qp[i]; UNPACK8(q, 8 * i, w); } }
#pragma unroll
        for (int i = 0; i < 64; ++i) acc[i] = 0.f;
        float mx = -1e30f, l = 0.f;
        for (int p = 0; p < 3; ++p) { const int d = p == 0 ? 1 : (p == 1 ? 4 : 16);
            for (int j = 0; j <= 128; ++j) { const int kp = t - j * d; if (kp < 0) break;
                const bf16* row = PROJ + (size_t)(m - j * d) * NPROJ_P; const GAS v4u* kq = (const GAS v4u*)(row + CA_K + 64 * h); const GAS v4u* vq = (const GAS v4u*)(row + CA_V + 64 * h);
                float s = 0.f;
#pragma unroll
                for (int i = 0; i < 8; ++i) { const v4u w = kq[i]; s += DOT8(q, 8 * i, w); }
                s = s * 0.125f + pb[TB[j * d] * 16 + h];
                const float mn = fmaxf(mx, s), sc = __expf(mx - mn), pe = __expf(s - mn); mx = mn; l = l * sc + pe;
#pragma unroll
                for (int i = 0; i < 8; ++i) { const v4u w = vq[i]; AXPY8(acc, 8 * i, sc, pe, w); }
            } }
        const float inv = 1.0f / l; GAS v4u* op = (GAS v4u*)(YC + (size_t)m * DM + 0 * GW + 64 * h);
#pragma unroll
        for (int i = 0; i < 8; ++i) op[i] = (v4u){pk2(acc[8 * i] * inv, acc[8 * i + 1] * inv), pk2(acc[8 * i + 2] * inv, acc[8 * i + 3] * inv), pk2(acc[8 * i + 4] * inv, acc[8 * i + 5] * inv), pk2(acc[8 * i + 6] * inv, acc[8 * i + 7] * inv)};
    }
}
__device__ __forceinline__ void mix_c_simple(Frame& F, int l = 0) {
    const bf16* PROJ = (const bf16*)(wsp() + WS_PROJ); bf16* YC = (bf16*)(wsp() + WS_YCAT); const int* TB = (const int*)(wsp() + WS_SMALL + SM_TB); const float* pb = inp(3);
    const float* KBAR = (const float*)(wsp() + CTL_KBAR) + (size_t)l * 64 * 8 * 64;
    const int nthr = F.G * NTHR;
    for (int idx = blockIdx.x * NTHR + F.tid; idx < M * NH; idx += nthr) {
        const int m = idx >> 3, h = idx & 7, t = m % SEQ, b = m / SEQ, ob = t >> 8;
        float q[64], acc[64];
        { const GAS v4u* qp = (const GAS v4u*)(PROJ + (size_t)m * NPROJ_P + CC_Q + 64 * h);
#pragma unroll
          for (int i = 0; i < 8; ++i) { const v4u w = qp[i]; UNPACK8(q, 8 * i, w); } }
        float gate[8];
#pragma unroll
        for (int n = 0; n < 8; ++n) { float s = 0.f; if (n < ob) { const float* kb = KBAR + ((b * NH + h) * 8 + n) * 64;
#pragma unroll
                for (int i = 0; i < 64; ++i) s += q[i] * kb[i]; } gate[n] = s; }
        unsigned sel = 0u;
#pragma unroll
        for (int n = 0; n < 8; ++n) { int rank = 0;
#pragma unroll
            for (int n2 = 0; n2 < 8; ++n2) rank += (n2 < ob && n2 != n && (gate[n2] > gate[n] || (gate[n2] == gate[n] && n2 < n))) ? 1 : 0;
            if (n < ob && rank < 3) sel |= 1u << n; }
        sel |= 1u << ob;
#pragma unroll
        for (int i = 0; i < 64; ++i) acc[i] = 0.f;
        float mx = -1e30f, l = 0.f;
        for (int n = 0; n <= ob; ++n) { if (!((sel >> n) & 1u)) continue; const int kmax = n == ob ? (t & 255) : 255;
            for (int i2 = 0; i2 <= kmax; ++i2) { const int kp = 256 * n + i2;
                const bf16* row = PROJ + ((size_t)b * SEQ + kp) * NPROJ_P; const GAS v4u* kq = (const GAS v4u*)(row + CC_K + 64 * h); const GAS v4u* vq = (const GAS v4u*)(row + CC_V + 64 * h);
                float s = 0.f;
#pragma unroll
                for (int i = 0; i < 8; ++i) { const v4u w = kq[i]; s += DOT8(q, 8 * i, w); }
                s = s * 0.125f + pb[TB[t - kp] * 16 + 8 + h];
                const float mn = fmaxf(mx, s), sc = __expf(mx - mn), pe = __expf(s - mn); mx = mn; l = l * sc + pe;
#pragma unroll
                for (int i = 0; i < 8; ++i) { const v4u w = vq[i]; AXPY8(acc, 8 * i, sc, pe, w); }
            } }
        const float inv = 1.0f / l; GAS v4u* op = (GAS v4u*)(YC + (size_t)m * DM + 2 * GW + 64 * h);
#pragma unroll
        for (int i = 0; i < 8; ++i) op[i] = (v4u){pk2(acc[8 * i] * inv, acc[8 * i + 1] * inv), pk2(acc[8 * i + 2] * inv, acc[8 * i + 3] * inv), pk2(acc[8 * i + 4] * inv, acc[8 * i + 5] * inv), pk2(acc[8 * i + 6] * inv, acc[8 * i + 7] * inv)};
    }
}
__device__ __forceinline__ void mix_b_simple(Frame& F, int l) {
    const bf16* PROJ = (const bf16*)(wsp() + WS_PROJ); bf16* YC = (bf16*)(wsp() + WS_YCAT); const pg8::fx_t* ST = (const pg8::fx_t*)(wsp() + CTL_STATS) + (size_t)l * M * 2;
    const float* lng = inp(4) + l * GW; const float* sw = inp(5) + (size_t)l * NH * 128 * 128; const float* sb = inp(6) + l * NH * 128;
    const int nthr = F.G * NTHR;
    for (int idx = blockIdx.x * NTHR + F.tid; idx < M * GW; idx += nthr) {
        const int m = idx >> 9, c = idx & 511, g = c >> 6, tt = m & 127, m0 = m - tt;
        const float* wrow = sw + ((size_t)g * 128 + tt) * 128; const float gn = lng[c]; float s = 0.f;
        for (int s2 = 0; s2 <= tt; ++s2) { const int ms = m0 + s2; const float mu_ = pg8::fx_get(ST + 2 * ms) * (1.0f / 512.0f), rs_ = 1.0f / sqrtf(fmaxf(pg8::fx_get(ST + 2 * ms + 1) * (1.0f / 512.0f) - mu_ * mu_, 0.f) + 1e-5f); const float vv = (gelu_tanh(bf2f(PROJ[(size_t)ms * NPROJ_P + CB_V + c])) - mu_) * rs_ * gn; s += wrow[s2] * vv; }
        const float u = gelu_tanh(bf2f(PROJ[(size_t)m * NPROJ_P + CB_U + c]));
        YC[(size_t)m * DM + GW + c] = (bf16)f2bf(u * (s + sb[g * 128 + tt]));
    }
}
__device__ __forceinline__ float rdl(float v, int k) { return __builtin_bit_cast(float, __builtin_amdgcn_readlane(__builtin_bit_cast(int, v), k)); }
__device__ __forceinline__ void mix_d_simple(Frame& F) {
    const bf16* R_ = (const bf16*)outp();
    const bf16* E_ = R_ + (size_t)M * GW; const bf16* KP_ = E_ + (size_t)M * GW; const bf16* V_ = KP_ + (size_t)M * GW;
    const bf16* KK_ = (const bf16*)outp() + (size_t)4 * M * GW; const bf16* AS_ = KK_ + (size_t)M * GW; float* YD = (float*)(wsp() + WS_YD);
    for (int it = F.gw; it < BATCH * NH; it += F.ngw) {
        const int b = it >> 3, h = it & 7; float s[64];
#pragma unroll
        for (int k = 0; k < 64; ++k) s[k] = 0.f;
        for (int t = 0; t < SEQ; ++t) {
            const size_t o = ((size_t)b * SEQ + t) * GW + 64 * h + F.lane;
            const float r = bf2f(R_[o]), w = __expf(-bf2f(E_[o])), kp = bf2f(KP_[o]), v = bf2f(V_[o]), kk = bf2f(KK_[o]), as = bf2f(AS_[o]);
            const float a = -kk, bb = kk * as;
            float sa = 0.f;
#pragma unroll
            for (int k = 0; k < 64; ++k) sa += s[k] * rdl(a, k);
            float y = 0.f;
#pragma unroll
            for (int k = 0; k < 64; ++k) { s[k] = s[k] * rdl(w, k) + sa * rdl(bb, k) + v * rdl(kp, k); y += s[k] * rdl(r, k); }
            YD[o] = y;
        }
    }
}

constexpr float LOG2E = 1.4426950408889634f;

constexpr int SC_T = 32, SC_TOK = (5 * 64 + 32) * 4, SC_BUF = SC_T * SC_TOK, SC_YB = SC_T * 32 * 4, SC_LDS = 2 * SC_BUF + 2 * SC_YB;
template <int CTRL> __device__ __forceinline__ float dpp_add(float x) {
    const int y = __builtin_amdgcn_update_dpp(0, __builtin_bit_cast(int, x), CTRL, 0xF, 0xF, false);
    return x + __builtin_bit_cast(float, y);
}
__device__ __forceinline__ float red8(float x) { x = dpp_add<0xB1>(x); x = dpp_add<0x4E>(x); x = dpp_add<0x141>(x); return x; }
__device__ __forceinline__ void scan_unit(LAS unsigned char* lds, int unit, int tid) {
    const int half = unit & 1, h = (unit >> 1) & 7, b = unit >> 4;
    const bf16* R_ = (const bf16*)outp();
    const bf16* E_ = R_ + (size_t)M * GW; const bf16* KP_ = E_ + (size_t)M * GW; const bf16* V_ = KP_ + (size_t)M * GW;
    const bf16* KK_ = (const bf16*)outp() + (size_t)4 * M * GW; const bf16* AS_ = KK_ + (size_t)M * GW; float* YD = (float*)(wsp() + WS_YD);
    const int lane = tid & 63, wave = __builtin_amdgcn_readfirstlane(tid >> 6);
    const bool scanner = wave < 4;
    const int j = lane & 7, rowl = (wave & 3) * 8 + (lane >> 3);
    const int st = tid & 255, tt = st >> 3, cg = st & 7;
    const size_t gbase = ((size_t)b * SEQ) * GW + 64 * h + 8 * cg;
#define SC_STAGE(c, buf) do { const size_t o_ = gbase + (size_t)((c) * SC_T + tt) * GW; \
        const v4u g_r = *(const GAS v4u*)(R_ + o_), g_e = *(const GAS v4u*)(E_ + o_), g_k = *(const GAS v4u*)(KP_ + o_), g_v = *(const GAS v4u*)(V_ + o_), g_kk = *(const GAS v4u*)(KK_ + o_), g_as = *(const GAS v4u*)(AS_ + o_); \
        LAS float* p_ = (LAS float*)(lds + (buf) * SC_BUF + tt * SC_TOK) + 8 * cg; float kk_[8], x_[8], y_[8]; \
        UNPACK8(kk_, 0, g_kk); \
        *(LAS f32x4*)(p_) = (f32x4){-kk_[0], -kk_[1], -kk_[2], -kk_[3]}; *(LAS f32x4*)(p_ + 4) = (f32x4){-kk_[4], -kk_[5], -kk_[6], -kk_[7]}; \
        UNPACK8(x_, 0, g_e); *(LAS f32x4*)(p_ + 64) = (f32x4){__expf(-x_[0]), __expf(-x_[1]), __expf(-x_[2]), __expf(-x_[3])}; *(LAS f32x4*)(p_ + 68) = (f32x4){__expf(-x_[4]), __expf(-x_[5]), __expf(-x_[6]), __expf(-x_[7])}; \
        UNPACK8(y_, 0, g_as); *(LAS f32x4*)(p_ + 128) = (f32x4){kk_[0] * y_[0], kk_[1] * y_[1], kk_[2] * y_[2], kk_[3] * y_[3]}; *(LAS f32x4*)(p_ + 132) = (f32x4){kk_[4] * y_[4], kk_[5] * y_[5], kk_[6] * y_[6], kk_[7] * y_[7]}; \
        UNPACK8(x_, 0, g_k); *(LAS f32x4*)(p_ + 192) = (f32x4){x_[0], x_[1], x_[2], x_[3]}; *(LAS f32x4*)(p_ + 196) = (f32x4){x_[4], x_[5], x_[6], x_[7]}; \
        UNPACK8(x_, 0, g_r); *(LAS f32x4*)(p_ + 256) = (f32x4){x_[0], x_[1], x_[2], x_[3]}; *(LAS f32x4*)(p_ + 260) = (f32x4){x_[4], x_[5], x_[6], x_[7]}; \
        if ((cg >> 2) == half) { UNPACK8(x_, 0, g_v); LAS float* v_ = (LAS float*)(lds + (buf) * SC_BUF + tt * SC_TOK) + 320 + 8 * (cg & 3); \
            *(LAS f32x4*)(v_) = (f32x4){x_[0], x_[1], x_[2], x_[3]}; *(LAS f32x4*)(v_ + 4) = (f32x4){x_[4], x_[5], x_[6], x_[7]}; } } while (0)
    if (!scanner) SC_STAGE(0, 0);
    __syncthreads();
    f32x4 s0 = {0.f, 0.f, 0.f, 0.f}, s1 = {0.f, 0.f, 0.f, 0.f};
    float ykeep = 0.f;
    for (int c = 0; c < SEQ / SC_T; ++c) {
        const int cur = c & 1;
        LAS float* yb = (LAS float*)(lds + 2 * SC_BUF + cur * SC_YB);
        if (scanner) {
            const LAS float* base = (const LAS float*)(lds + cur * SC_BUF) + 8 * j;
            const LAS float* vbase = (const LAS float*)(lds + cur * SC_BUF) + 320 + rowl;
            f32x4 a0 = *(const LAS f32x4*)(base), a1 = *(const LAS f32x4*)(base + 4), w0 = *(const LAS f32x4*)(base + 64), w1 = *(const LAS f32x4*)(base + 68), b0 = *(const LAS f32x4*)(base + 128), b1 = *(const LAS f32x4*)(base + 132),
                  k0 = *(const LAS f32x4*)(base + 192), k1 = *(const LAS f32x4*)(base + 196), r0 = *(const LAS f32x4*)(base + 256), r1 = *(const LAS f32x4*)(base + 260);
            float vv = *vbase;
#pragma unroll
            for (int t = 0; t < SC_T; ++t) {
                f32x4 na0 = a0, na1 = a1, nw0 = w0, nw1 = w1, nb0 = b0, nb1 = b1, nk0 = k0, nk1 = k1, nr0 = r0, nr1 = r1; float nv = vv;
                if (t + 1 < SC_T) { const LAS float* p = base + (t + 1) * (SC_TOK / 4);
                    na0 = *(const LAS f32x4*)(p); na1 = *(const LAS f32x4*)(p + 4); nw0 = *(const LAS f32x4*)(p + 64); nw1 = *(const LAS f32x4*)(p + 68); nb0 = *(const LAS f32x4*)(p + 128); nb1 = *(const LAS f32x4*)(p + 132);
                    nk0 = *(const LAS f32x4*)(p + 192); nk1 = *(const LAS f32x4*)(p + 196); nr0 = *(const LAS f32x4*)(p + 256); nr1 = *(const LAS f32x4*)(p + 260);
                    nv = vbase[(t + 1) * (SC_TOK / 4)]; }
                const f32x4 pa = s0 * a0 + s1 * a1;
                float sa = (pa.x + pa.y) + (pa.z + pa.w);
                const f32x4 sw0 = s0 * w0 + vv * k0, sw1 = s1 * w1 + vv * k1;
                sa = red8(sa);
                s0 = sa * b0 + sw0; s1 = sa * b1 + sw1;
                const f32x4 py = s0 * r0 + s1 * r1;
                float y = (py.x + py.y) + (py.z + py.w);
                y = red8(y);
                ykeep = (j == (t & 7)) ? y : ykeep;
                if ((t & 7) == 7) yb[((t & ~7) + j) * 32 + rowl] = ykeep;
                a0 = na0; a1 = na1; w0 = nw0; w1 = nw1; b0 = nb0; b1 = nb1; k0 = nk0; k1 = nk1; r0 = nr0; r1 = nr1; vv = nv;
            }
        } else {
            if (c > 0) {
                const LAS float* ybp = (const LAS float*)(lds + 2 * SC_BUF + (cur ^ 1) * SC_YB); const int t2 = st >> 3, q4 = st & 7; const f32x4 v = *(const LAS f32x4*)(ybp + t2 * 32 + 4 * q4);
                *(GAS f32x4*)(YD + ((size_t)b * SEQ + (c - 1) * SC_T + t2) * GW + 64 * h + 32 * half + 4 * q4) = v; }
            if (c + 1 < SEQ / SC_T) SC_STAGE(c + 1, cur ^ 1);
        }
        __syncthreads();
    }
    if (!scanner) { const LAS float* ybp = (const LAS float*)(lds + 2 * SC_BUF + 1 * SC_YB); const int t2 = st >> 3, q4 = st & 7; const f32x4 v = *(const LAS f32x4*)(ybp + t2 * 32 + 4 * q4);
        *(GAS f32x4*)(YD + ((size_t)b * SEQ + (SEQ / SC_T - 1) * SC_T + t2) * GW + 64 * h + 32 * half + 4 * q4) = v; }
#undef SC_STAGE
    __syncthreads();
}

struct AttnSt { f32x16 o0, o1; float m, l; };
__device__ __forceinline__ void attn_init(AttnSt& st) {
    const float z_ = zero_v();
#pragma unroll
    for (int i = 0; i < 16; ++i) { st.o0[i] = z_; st.o1[i] = z_; }
    st.m = -1e30f; st.l = 0.f;
}
__device__ __forceinline__ void attn_tile(AttnSt& st, const bf16x8 (&qf)[4], const bf16* Kcol, const bf16* Vcol, int rowb, int kb, int ks, int qpos, int maxd, bool sel, const LAS float* biasT, int r32, int hh) {
    int kp_l = kb + r32 * ks; kp_l = kp_l < 0 ? 0 : kp_l;
    const bf16* kr_ = Kcol + (size_t)(rowb + kp_l) * NPROJ_P + 8 * hh;
    bf16x8 kf[4];
#pragma unroll
    for (int s = 0; s < 4; ++s) kf[s] = *(const GAS bf16x8*)(kr_ + 16 * s);
    f32x16 sc;
#pragma unroll
    for (int i = 0; i < 16; ++i) sc[i] = 0.f;
#pragma unroll
    for (int s = 0; s < 4; ++s) sc = __builtin_amdgcn_mfma_f32_32x32x16_bf16(kf[s], qf[s], sc, 0, 0, 0);
    unsigned vf[2][2][4];
#pragma unroll
    for (int s2 = 0; s2 < 2; ++s2)
#pragma unroll
        for (int jp = 0; jp < 4; ++jp) {
            const int j0 = 2 * jp, key0 = 16 * s2 + 8 * (j0 >> 2) + 4 * hh + (j0 & 3);
            int kp0 = kb + key0 * ks, kp1 = kp0 + ks; kp0 = kp0 < 0 ? 0 : kp0; kp1 = kp1 < 0 ? 0 : kp1;
            const bf16* v0 = Vcol + (size_t)(rowb + kp0) * NPROJ_P + r32; const bf16* v1 = Vcol + (size_t)(rowb + kp1) * NPROJ_P + r32;
            vf[0][s2][jp] = (unsigned)v0[0] | ((unsigned)v1[0] << 16); vf[1][s2][jp] = (unsigned)v0[32] | ((unsigned)v1[32] << 16);
        }
    float tmax = -INFINITY;
#pragma unroll
    for (int r = 0; r < 16; ++r) {
        const int kr = (r & 3) + 8 * (r >> 2) + 4 * hh, kp = kb + kr * ks, dist = qpos - kp;
        const bool ok = sel && dist >= 0 && dist <= maxd && kp >= 0;
        const float v = sc[r] * (0.125f * LOG2E) + biasT[ok ? dist : 0];
        sc[r] = ok ? v : -INFINITY; tmax = fmaxf(tmax, sc[r]);
    }
    tmax = fmaxf(tmax, __shfl_xor(tmax, 32));
    const float mn = fmaxf(st.m, tmax), scale = __builtin_amdgcn_exp2f(st.m - mn); st.m = mn;
    float ls = 0.f;
#pragma unroll
    for (int r = 0; r < 16; ++r) { sc[r] = __builtin_amdgcn_exp2f(sc[r] - mn); ls += sc[r]; }
    st.l = st.l * scale + ls;
#pragma unroll
    for (int i = 0; i < 16; ++i) { st.o0[i] *= scale; st.o1[i] *= scale; }
    typedef unsigned u32x4_t __attribute__((ext_vector_type(4)));
#pragma unroll
    for (int s2 = 0; s2 < 2; ++s2) {
        u32x4_t pw; pw.x = pg8::cvt_pk_bf16(sc[8 * s2], sc[8 * s2 + 1]); pw.y = pg8::cvt_pk_bf16(sc[8 * s2 + 2], sc[8 * s2 + 3]); pw.z = pg8::cvt_pk_bf16(sc[8 * s2 + 4], sc[8 * s2 + 5]); pw.w = pg8::cvt_pk_bf16(sc[8 * s2 + 6], sc[8 * s2 + 7]);
        const bf16x8 pf = __builtin_bit_cast(bf16x8, pw);
        u32x4_t a0 = {vf[0][s2][0], vf[0][s2][1], vf[0][s2][2], vf[0][s2][3]}, a1 = {vf[1][s2][0], vf[1][s2][1], vf[1][s2][2], vf[1][s2][3]};
        st.o0 = __builtin_amdgcn_mfma_f32_32x32x16_bf16(__builtin_bit_cast(bf16x8, a0), pf, st.o0, 0, 0, 0);
        st.o1 = __builtin_amdgcn_mfma_f32_32x32x16_bf16(__builtin_bit_cast(bf16x8, a1), pf, st.o1, 0, 0, 0);
    }
}
__device__ __forceinline__ void attn_loadq(bf16x8 (&qf)[4], const bf16* Qcol, int row, int hh) {
    const bf16* q = Qcol + (size_t)row * NPROJ_P + 8 * hh;
#pragma unroll
    for (int s = 0; s < 4; ++s) qf[s] = *(const GAS bf16x8*)(q + 16 * s);
}
__device__ __forceinline__ void attn_store(const f32x16& o0, const f32x16& o1, float inv, bf16* yrow, int hh) {
#pragma unroll
    for (int g = 0; g < 4; ++g) {
        *(GAS v2u*)(yrow + 8 * g + 4 * hh) = (v2u){pk2(o0[4 * g] * inv, o0[4 * g + 1] * inv), pk2(o0[4 * g + 2] * inv, o0[4 * g + 3] * inv)};
        *(GAS v2u*)(yrow + 32 + 8 * g + 4 * hh) = (v2u){pk2(o1[4 * g] * inv, o1[4 * g + 1] * inv), pk2(o1[4 * g + 2] * inv, o1[4 * g + 3] * inv)};
    }
}
__device__ __forceinline__ void build_bias(LAS float* biasT, int hcol, int tid) {
    const f32x4 bv = *(const GAS f32x4*)((const float*)(wsp() + WS_SMALL + SM_BIAS) + hcol * 2048 + 4 * tid); const v4u tv = *(const GAS v4u*)((const unsigned*)(wsp() + WS_SMALL + SM_TB) + 4 * tid);
    *(LAS f32x4*)(biasT + 4 * tid) = bv; *(LAS v4u*)((LAS unsigned*)(biasT + 2048) + 4 * tid) = tv;
}

constexpr int MC_KP = 144, MC_VP = 192, MC_KB = 128 * MC_KP, MC_VB = 128 * MC_VP, MC_K_OFF = 16384, MC_V_OFF = MC_K_OFF + 2 * MC_KB, MC_LDS = MC_V_OFF + 2 * MC_VB;
typedef short v4i16_t __attribute__((ext_vector_type(4)));
__device__ __forceinline__ float pl32_max(float a) { float x = a, y = a;
    asm volatile("s_nop 1\n\tv_permlane32_swap_b32_e32 %0, %1\n\ts_nop 0" : "+v"(x), "+v"(y));
    return fmaxf(x, y); }
template <int MODE> __device__ __forceinline__ void moba_tile(AttnSt& st, const bf16x8 (&qf)[4], const LAS unsigned char* Kt, const LAS unsigned char* Vt, const LAS float* biasT, const LAS int* TB, int dlo, bool sel, int lane, int r32, int hh) {
    bf16x8 kf[4];
#pragma unroll
    for (int s = 0; s < 4; ++s) kf[s] = *(const LAS bf16x8*)(Kt + r32 * MC_KP + 32 * s + 16 * hh);
    v4i16_t vt[2][2][2];
    { const LAS unsigned char* vb = Vt + (4 * hh + ((lane & 15) >> 2)) * MC_VP + (16 * ((lane >> 4) & 1) + 4 * (lane & 3)) * 2;
#pragma unroll
      for (int dh = 0; dh < 2; ++dh)
#pragma unroll
        for (int s2 = 0; s2 < 2; ++s2)
#pragma unroll
            for (int h8 = 0; h8 < 2; ++h8) vt[dh][s2][h8] = __builtin_amdgcn_ds_read_tr16_b64_v4i16((LAS v4i16_t*)(vb + (16 * s2 + 8 * h8) * MC_VP + 64 * dh)); }
    f32x16 sc;
#pragma unroll
    for (int i = 0; i < 16; ++i) sc[i] = 0.f;
#pragma unroll
    for (int s = 0; s < 4; ++s) sc = __builtin_amdgcn_mfma_f32_32x32x16_bf16(kf[s], qf[s], sc, 0, 0, 0);
    const int d0 = dlo + r32 + 31 - 4 * hh;
    const int dmin = dlo < 0 ? 0 : dlo, dmax = dlo + 62;
    const bool uni = __builtin_amdgcn_readfirstlane(TB[dmin]) == __builtin_amdgcn_readfirstlane(TB[dmax]);
    float tmax = -INFINITY;
    if (uni) { const float bu = biasT[dmin];
#pragma unroll
        for (int r = 0; r < 16; ++r) { float v = sc[r] * (0.125f * LOG2E) + bu; if (MODE == 1) { const int dist = d0 - (r & 3) - 8 * (r >> 2); v = dist >= 0 ? v : -INFINITY; } sc[r] = v; tmax = fmaxf(tmax, v); }
    } else {
#pragma unroll
        for (int r = 0; r < 16; ++r) { const int dist = d0 - (r & 3) - 8 * (r >> 2); float v = sc[r] * (0.125f * LOG2E) + biasT[dist < 0 ? 0 : dist]; if (MODE == 1) v = dist >= 0 ? v : -INFINITY; sc[r] = v; tmax = fmaxf(tmax, v); }
    }
    if (MODE == 2) tmax = sel ? tmax : -INFINITY;
    tmax = pl32_max(tmax);
    const float mn = fmaxf(st.m, tmax);
    if (__ballot(mn > st.m) != 0ull) { const float scale = __builtin_amdgcn_exp2f(st.m - mn); st.l *= scale;
#pragma unroll
        for (int i = 0; i < 16; ++i) { st.o0[i] *= scale; st.o1[i] *= scale; } }
    st.m = mn;
    const float msub = (MODE == 2 && !sel) ? INFINITY : mn;
    float ls = 0.f;
#pragma unroll
    for (int r = 0; r < 16; ++r) { sc[r] = __builtin_amdgcn_exp2f(sc[r] - msub); ls += sc[r]; }
    st.l += ls;
    typedef unsigned u32x4_t __attribute__((ext_vector_type(4)));
#pragma unroll
    for (int s2 = 0; s2 < 2; ++s2) {
        u32x4_t pw; pw.x = pg8::cvt_pk_bf16(sc[8 * s2], sc[8 * s2 + 1]); pw.y = pg8::cvt_pk_bf16(sc[8 * s2 + 2], sc[8 * s2 + 3]); pw.z = pg8::cvt_pk_bf16(sc[8 * s2 + 4], sc[8 * s2 + 5]); pw.w = pg8::cvt_pk_bf16(sc[8 * s2 + 6], sc[8 * s2 + 7]);
        const bf16x8 pf = __builtin_bit_cast(bf16x8, pw);
        const bf16x8 a0 = {vt[0][s2][0][0], vt[0][s2][0][1], vt[0][s2][0][2], vt[0][s2][0][3], vt[0][s2][1][0], vt[0][s2][1][1], vt[0][s2][1][2], vt[0][s2][1][3]};
        const bf16x8 a1 = {vt[1][s2][0][0], vt[1][s2][0][1], vt[1][s2][0][2], vt[1][s2][0][3], vt[1][s2][1][0], vt[1][s2][1][1], vt[1][s2][1][2], vt[1][s2][1][3]};
        st.o0 = __builtin_amdgcn_mfma_f32_32x32x16_bf16(a0, pf, st.o0, 0, 0, 0);
        st.o1 = __builtin_amdgcn_mfma_f32_32x32x16_bf16(a1, pf, st.o1, 0, 0, 0);
    }
}
__device__ __forceinline__ void moba_unit(LAS unsigned char* lds, int unit, int tid, int l) {
    const int ob = unit & 7, h = (unit >> 3) & 7, b = unit >> 6, lane = tid & 63, wave = __builtin_amdgcn_readfirstlane(tid >> 6), r32 = lane & 31, hh = lane >> 5;
    LAS float* biasT = (LAS float*)lds;
    build_bias(biasT, 8 + h, tid);
    const bf16* PROJ = (const bf16*)(wsp() + WS_PROJ); const float* KBAR = (const float*)(wsp() + CTL_KBAR) + (size_t)l * 64 * 8 * 64 + ((b * NH + h) * 8) * 64; const LAS int* TB = (const LAS int*)(biasT + 2048);
    const int rowb = b * SEQ, qpos = 256 * ob + 32 * wave + r32;
    bf16x8 qf[4]; attn_loadq(qf, PROJ + CC_Q + 64 * h, rowb + qpos, hh);
    float gate[8];
#pragma unroll
    for (int n = 0; n < 8; ++n) { float s = 0.f;
        if (n < ob) {
#pragma unroll
            for (int s4 = 0; s4 < 4; ++s4) { const f32x4 k0 = *(const GAS f32x4*)(KBAR + n * 64 + 16 * s4 + 8 * hh), k1 = *(const GAS f32x4*)(KBAR + n * 64 + 16 * s4 + 8 * hh + 4);
                const v4u qw = __builtin_bit_cast(v4u, qf[s4]);
                s += bflo(qw.x) * k0.x + bfhi(qw.x) * k0.y + bflo(qw.y) * k0.z + bfhi(qw.y) * k0.w + bflo(qw.z) * k1.x + bfhi(qw.z) * k1.y + bflo(qw.w) * k1.z + bfhi(qw.w) * k1.w; }
            s += __shfl_xor(s, 32); }
        gate[n] = s; }
    unsigned selm = 0u;
#pragma unroll
    for (int n = 0; n < 8; ++n) { int rank = 0;
#pragma unroll
        for (int n2 = 0; n2 < 8; ++n2) rank += (n2 < ob && n2 != n && (gate[n2] > gate[n] || (gate[n2] == gate[n] && n2 < n))) ? 1 : 0;
        if (n < ob && rank < 3) selm |= 1u << n; }
    AttnSt st; attn_init(st);
    const int skey = tid >> 2, spart = tid & 3;
    const bf16* Kg = PROJ + (size_t)rowb * NPROJ_P + CC_K + 64 * h + 16 * spart; const bf16* Vg = PROJ + (size_t)rowb * NPROJ_P + CC_V + 64 * h + 16 * spart;
    bf16x8 gk0, gk1, gv0, gv1;
#define MC_GLOAD(i) do { const size_t ro_ = (size_t)(128 * (i) + skey) * NPROJ_P; gk0 = *(const GAS bf16x8*)(Kg + ro_); gk1 = *(const GAS bf16x8*)(Kg + ro_ + 8); gv0 = *(const GAS bf16x8*)(Vg + ro_); gv1 = *(const GAS bf16x8*)(Vg + ro_ + 8); } while (0)
#define MC_LSTORE(bf) do { LAS unsigned char* kd_ = lds + MC_K_OFF + (bf) * MC_KB + skey * MC_KP + 32 * spart; *(LAS bf16x8*)(kd_) = gk0; *(LAS bf16x8*)(kd_ + 16) = gk1; \
        LAS unsigned char* vd_ = lds + MC_V_OFF + (bf) * MC_VB + skey * MC_VP + 32 * spart; *(LAS bf16x8*)(vd_) = gv0; *(LAS bf16x8*)(vd_ + 16) = gv1; } while (0)
    const int nst = 2 * (ob + 1);
    MC_GLOAD(0); MC_LSTORE(0);
    __syncthreads();
    for (int i = 0; i < nst; ++i) {
        if (i + 1 < nst) MC_GLOAD(i + 1);
        const int n = i >> 1, hf = i & 1; const bool own = n == ob, sel = own || ((selm >> n) & 1u);
        const LAS unsigned char* Kb = lds + MC_K_OFF + (i & 1) * MC_KB; const LAS unsigned char* Vb = lds + MC_V_OFF + (i & 1) * MC_VB;
        if (own) {
#pragma unroll 1
            for (int sub = 0; sub < 4; ++sub) { const int jt = 4 * hf + sub; if (jt > wave) break; const int dlo = 32 * wave - (32 * jt + 31);
                if (jt == wave) moba_tile<1>(st, qf, Kb + sub * 32 * MC_KP, Vb + sub * 32 * MC_VP, biasT, TB, dlo, true, lane, r32, hh);
                else moba_tile<0>(st, qf, Kb + sub * 32 * MC_KP, Vb + sub * 32 * MC_VP, biasT, TB, dlo, true, lane, r32, hh); }
        } else if (__ballot(sel) != 0ull) {
#pragma unroll 1
            for (int sub = 0; sub < 4; ++sub) { const int dlo = 256 * ob + 32 * wave - (256 * n + 128 * hf + 32 * sub + 31);
                moba_tile<2>(st, qf, Kb + sub * 32 * MC_KP, Vb + sub * 32 * MC_VP, biasT, TB, dlo, sel, lane, r32, hh); }
        }
        if (i + 1 < nst) MC_LSTORE((i + 1) & 1);
        __syncthreads();
    }
#undef MC_GLOAD
#undef MC_LSTORE
    const float lt = st.l + __shfl_xor(st.l, 32);
    attn_store(st.o0, st.o1, 1.0f / lt, (bf16*)(wsp() + WS_YCAT) + (size_t)(rowb + qpos) * DM + 2 * GW + 64 * h, hh);
}

constexpr int MA_PITCH = 144, MA_ML_OFF = 512 * MA_PITCH, MA_BIAS_OFF = MA_ML_OFF + 512 * 8, MA_V_OFF = MA_BIAS_OFF + 16384, MA_VW = 32 * MC_VP, MA_LDS = MA_V_OFF + 8 * MA_VW;
template <bool MASKED> __device__ __forceinline__ void dil_tile(AttnSt& st, const bf16x8 (&qf)[4], const bf16x8 (&kf)[4], const LAS unsigned char* Vt, const LAS float* biasT, const LAS int* TB, int dl0, int dstep, int kb, int lane, int r32, int hh) {
    v4i16_t vt[2][2][2];
    { const LAS unsigned char* vb = Vt + (4 * hh + ((lane & 15) >> 2)) * MC_VP + (16 * ((lane >> 4) & 1) + 4 * (lane & 3)) * 2;
#pragma unroll
      for (int dh = 0; dh < 2; ++dh)
#pragma unroll
        for (int s2 = 0; s2 < 2; ++s2)
#pragma unroll
            for (int h8 = 0; h8 < 2; ++h8) vt[dh][s2][h8] = __builtin_amdgcn_ds_read_tr16_b64_v4i16((LAS v4i16_t*)(vb + (16 * s2 + 8 * h8) * MC_VP + 64 * dh)); }
    f32x16 sc;
#pragma unroll
    for (int i = 0; i < 16; ++i) sc[i] = 0.f;
#pragma unroll
    for (int s = 0; s < 4; ++s) sc = __builtin_amdgcn_mfma_f32_32x32x16_bf16(kf[s], qf[s], sc, 0, 0, 0);
    const int e0 = dl0 + r32 - 4 * hh;
    int dmin = (dl0 - 31) * dstep, dmax = (dl0 + 31) * dstep; dmin = dmin < 0 ? 0 : dmin; dmax = dmax > 2047 ? 2047 : dmax;
    const bool uni = __builtin_amdgcn_readfirstlane(TB[dmin]) == __builtin_amdgcn_readfirstlane(TB[dmax]);
    const float bu = biasT[dmin];
    float tmax = -INFINITY;
#pragma unroll
    for (int r = 0; r < 16; ++r) {
        const int kr0 = (r & 3) + 8 * (r >> 2), delta = e0 - kr0;
        float bias = bu;
        if (!uni) { int di = delta * dstep; di = di < 0 ? 0 : (di > 2047 ? 2047 : di); bias = biasT[di]; }
        float v = sc[r] * (0.125f * LOG2E) + bias;
        if (MASKED) { const bool ok = delta >= 0 && delta <= 128 && (kb + (kr0 + 4 * hh) * dstep) >= 0; v = ok ? v : -INFINITY; }
        sc[r] = v; tmax = fmaxf(tmax, v);
    }
    tmax = pl32_max(tmax);
    const float mn = fmaxf(st.m, tmax);
    if (__ballot(mn > st.m) != 0ull) { const float scale = __builtin_amdgcn_exp2f(st.m - mn); st.l *= scale;
#pragma unroll
        for (int i = 0; i < 16; ++i) { st.o0[i] *= scale; st.o1[i] *= scale; } }
    st.m = mn;
    float ls = 0.f;
#pragma unroll
    for (int r = 0; r < 16; ++r) { sc[r] = __builtin_amdgcn_exp2f(sc[r] - mn); ls += sc[r]; }
    st.l += ls;
    typedef unsigned u32x4_t __attribute__((ext_vector_type(4)));
#pragma unroll
    for (int s2 = 0; s2 < 2; ++s2) {
        u32x4_t pw; pw.x = pg8::cvt_pk_bf16(sc[8 * s2], sc[8 * s2 + 1]); pw.y = pg8::cvt_pk_bf16(sc[8 * s2 + 2], sc[8 * s2 + 3]); pw.z = pg8::cvt_pk_bf16(sc[8 * s2 + 4], sc[8 * s2 + 5]); pw.w = pg8::cvt_pk_bf16(sc[8 * s2 + 6], sc[8 * s2 + 7]);
        const bf16x8 pf = __builtin_bit_cast(bf16x8, pw);
        const bf16x8 a0 = {vt[0][s2][0][0], vt[0][s2][0][1], vt[0][s2][0][2], vt[0][s2][0][3], vt[0][s2][1][0], vt[0][s2][1][1], vt[0][s2][1][2], vt[0][s2][1][3]};
        const bf16x8 a1 = {vt[1][s2][0][0], vt[1][s2][0][1], vt[1][s2][0][2], vt[1][s2][0][3], vt[1][s2][1][0], vt[1][s2][1][1], vt[1][s2][1][2], vt[1][s2][1][3]};
        st.o0 = __builtin_amdgcn_mfma_f32_32x32x16_bf16(a0, pf, st.o0, 0, 0, 0);
        st.o1 = __builtin_amdgcn_mfma_f32_32x32x16_bf16(a1, pf, st.o1, 0, 0, 0);
    }
}
__device__ __forceinline__ void dil_unit(LAS unsigned char* lds, int unit, int tid) {
    const int sp = unit & 3, h = (unit >> 2) & 7, b = unit >> 5, lane = tid & 63, wave = __builtin_amdgcn_readfirstlane(tid >> 6), r32 = lane & 31, hh = lane >> 5;
    LAS float* biasT = (LAS float*)(lds + MA_BIAS_OFF);
    build_bias(biasT, h, tid);
    __syncthreads();
    const bf16* PROJ = (const bf16*)(wsp() + WS_PROJ); const LAS int* TB = (const LAS int*)(biasT + 2048); const int rowb = b * SEQ, t0 = 512 * sp;
    const bf16* Qc = PROJ + CA_Q + 64 * h; const bf16* Kc = PROJ + CA_K + 64 * h; const bf16* Vc = PROJ + CA_V + 64 * h;
    LAS unsigned char* Vst = lds + MA_V_OFF + wave * MA_VW;
    const int vkey = lane >> 1, vhalf = lane & 1;
#pragma unroll 1
    for (int p = 0; p < 3; ++p) {
        const int d = p == 0 ? 1 : (p == 1 ? 4 : 16);
#pragma unroll 1
        for (int gi = 0; gi < 2; ++gi) {
            const int g = 2 * wave + gi;
            const int qb = t0 + (p == 0 ? 32 * g : (p == 1 ? 128 * (g >> 2) + (g & 3) : g));
            const int qpos = qb + r32 * d, qi = qpos - t0;
            bf16x8 qf[4]; attn_loadq(qf, Qc, rowb + qpos, hh);
            AttnSt st; attn_init(st);
            int jt = 0; while (qb + (32 * jt - 128 + 31) * d < 0) ++jt;
            bf16x8 kfn[4], vrn[4];
#define MA_GLOAD(JT) do { const int kb_ = qb + (32 * (JT) - 128) * d; int kp_ = kb_ + r32 * d; kp_ = kp_ < 0 ? 0 : kp_; const bf16* kr_ = Kc + (size_t)(rowb + kp_) * NPROJ_P + 8 * hh; \
                _Pragma("unroll") for (int s = 0; s < 4; ++s) kfn[s] = *(const GAS bf16x8*)(kr_ + 16 * s); \
                int vp_ = kb_ + vkey * d; vp_ = vp_ < 0 ? 0 : vp_; const bf16* vr_ = Vc + (size_t)(rowb + vp_) * NPROJ_P + 32 * vhalf; \
                _Pragma("unroll") for (int s = 0; s < 4; ++s) vrn[s] = *(const GAS bf16x8*)(vr_ + 8 * s); } while (0)
            MA_GLOAD(jt);
#pragma unroll 1
            for (; jt < 5; ++jt) {
                bf16x8 kf[4] = {kfn[0], kfn[1], kfn[2], kfn[3]};
                { LAS unsigned char* vd = Vst + vkey * MC_VP + 64 * vhalf;
#pragma unroll
                  for (int s = 0; s < 4; ++s) *(LAS bf16x8*)(vd + 16 * s) = vrn[s]; }
                asm volatile("" ::: "memory");
                if (jt + 1 < 5) MA_GLOAD(jt + 1);
                const int kb = qb + (32 * jt - 128) * d, dl0 = 128 - 32 * jt;
                if (jt == 0 || jt == 4 || kb < 0) dil_tile<true>(st, qf, kf, Vst, biasT, TB, dl0, d, kb, lane, r32, hh);
                else dil_tile<false>(st, qf, kf, Vst, biasT, TB, dl0, d, kb, lane, r32, hh);
            }
#undef MA_GLOAD
            float lt = st.l + __shfl_xor(st.l, 32);
            LAS unsigned char* orow = lds + qi * MA_PITCH; LAS float* ml = (LAS float*)(lds + MA_ML_OFF + qi * 8);
            if (p > 0) {
                const float mo = ml[0], lo = ml[1], mn = fmaxf(mo, st.m), fo = __builtin_amdgcn_exp2f(mo - mn), fc = __builtin_amdgcn_exp2f(st.m - mn);
                lt = lo * fo + lt * fc;
#pragma unroll
                for (int g4 = 0; g4 < 4; ++g4) { const v2u a = *(const LAS v2u*)(orow + 2 * (8 * g4 + 4 * hh)), c = *(const LAS v2u*)(orow + 64 + 2 * (8 * g4 + 4 * hh));
                    const float av[4] = {bflo(a.x), bfhi(a.x), bflo(a.y), bfhi(a.y)}, cv[4] = {bflo(c.x), bfhi(c.x), bflo(c.y), bfhi(c.y)};
#pragma unroll
                    for (int e = 0; e < 4; ++e) { st.o0[4 * g4 + e] = av[e] * fo + st.o0[4 * g4 + e] * fc; st.o1[4 * g4 + e] = cv[e] * fo + st.o1[4 * g4 + e] * fc; } }
                st.m = mn;
            }
            if (p < 2) {
#pragma unroll
                for (int g4 = 0; g4 < 4; ++g4) { *(LAS v2u*)(orow + 2 * (8 * g4 + 4 * hh)) = (v2u){pk2(st.o0[4 * g4], st.o0[4 * g4 + 1]), pk2(st.o0[4 * g4 + 2], st.o0[4 * g4 + 3])};
                    *(LAS v2u*)(orow + 64 + 2 * (8 * g4 + 4 * hh)) = (v2u){pk2(st.o1[4 * g4], st.o1[4 * g4 + 1]), pk2(st.o1[4 * g4 + 2], st.o1[4 * g4 + 3])}; }
                if (hh == 0) { ml[0] = st.m; ml[1] = lt; }
            } else attn_store(st.o0, st.o1, 1.0f / lt, (bf16*)(wsp() + WS_YCAT) + (size_t)(rowb + qpos) * DM + 0 * GW + 64 * h, hh);
        }
        __syncthreads();
    }
}

constexpr int SG_PITCH = 144, SG_WAVE = 128 * SG_PITCH, SG_OP = 272;
static_assert(8 * SG_WAVE <= MISC_OFF && 32 * SG_OP <= SG_WAVE, "SGU LDS");
__device__ __forceinline__ void sgu_unit(LAS unsigned char* lds, int unit, int tid, int l) {
    const int lane = tid & 63, g = __builtin_amdgcn_readfirstlane(tid >> 6), r32 = lane & 31, hh = lane >> 5, m0 = unit * 128;
    const bf16* PROJ = (const bf16*)(wsp() + WS_PROJ); bf16* YC = (bf16*)(wsp() + WS_YCAT); const pg8::fx_t* ST = (const pg8::fx_t*)(wsp() + CTL_STATS) + (size_t)l * M * 2;
    const float* lng = inp(4) + l * GW; const float* sw = inp(5) + ((size_t)l * NH + g) * 128 * 128; const float* sb = inp(6) + (l * NH + g) * 128;
    LAS unsigned char* T = lds + g * SG_WAVE;
    const int tk8 = lane >> 3, part = lane & 7;
    { const f32x4 g0 = *(const GAS f32x4*)(lng + 64 * g + 8 * part), g1 = *(const GAS f32x4*)(lng + 64 * g + 8 * part + 4);
      const float gn[8] = {g0.x, g0.y, g0.z, g0.w, g1.x, g1.y, g1.z, g1.w};
#pragma unroll 4
      for (int i = 0; i < 16; ++i) { const int tkn = tk8 + 8 * i, mm = m0 + tkn;
          const v4u w = *(const GAS v4u*)(PROJ + (size_t)mm * NPROJ_P + CB_V + 64 * g + 8 * part);
          const float mu = pg8::fx_get(ST + 2 * mm) * (1.0f / 512.0f), rs = __builtin_amdgcn_rsqf(fmaxf(pg8::fx_get(ST + 2 * mm + 1) * (1.0f / 512.0f) - mu * mu, 0.f) + 1e-5f);
          float x[8] = {bflo(w.x), bfhi(w.x), bflo(w.y), bfhi(w.y), bflo(w.z), bfhi(w.z), bflo(w.w), bfhi(w.w)};
#pragma unroll
          for (int e = 0; e < 8; ++e) x[e] = (gelu_tanh(x[e]) - mu) * rs * gn[e];
          *(LAS v4u*)(T + tkn * SG_PITCH + 16 * part) = (v4u){pk2(x[0], x[1]), pk2(x[2], x[3]), pk2(x[4], x[5]), pk2(x[6], x[7])}; } }
    asm volatile("" ::: "memory");
    f32x16 acc[4][2];
    const float z_ = zero_v();
#pragma unroll
    for (int tt = 0; tt < 4; ++tt)
#pragma unroll
        for (int ct = 0; ct < 2; ++ct)
#pragma unroll
            for (int i = 0; i < 16; ++i) acc[tt][ct][i] = z_;
    const LAS unsigned char* vb = T + (8 * hh + ((lane & 15) >> 2)) * SG_PITCH + (16 * ((lane >> 4) & 1) + 4 * (lane & 3)) * 2;
#pragma unroll
    for (int k = 0; k < 8; ++k) {
        v4i16_t t00 = __builtin_amdgcn_ds_read_tr16_b64_v4i16((LAS v4i16_t*)(vb + (16 * k) * SG_PITCH)), t01 = __builtin_amdgcn_ds_read_tr16_b64_v4i16((LAS v4i16_t*)(vb + (16 * k + 4) * SG_PITCH));
        v4i16_t t10 = __builtin_amdgcn_ds_read_tr16_b64_v4i16((LAS v4i16_t*)(vb + (16 * k) * SG_PITCH + 64)), t11 = __builtin_amdgcn_ds_read_tr16_b64_v4i16((LAS v4i16_t*)(vb + (16 * k + 4) * SG_PITCH + 64));
        const bf16x8 af0 = {t00[0], t00[1], t00[2], t00[3], t01[0], t01[1], t01[2], t01[3]}, af1 = {t10[0], t10[1], t10[2], t10[3], t11[0], t11[1], t11[2], t11[3]};
#pragma unroll
        for (int tt = 0; tt < 4; ++tt) { if (k < 2 * (tt + 1)) {
                const int t = 32 * tt + r32, s0 = 16 * k + 8 * hh; const float* wrow = sw + (size_t)t * 128 + s0;
                const f32x4 w0 = *(const GAS f32x4*)(wrow), w1 = *(const GAS f32x4*)(wrow + 4);
                float wv[8] = {w0.x, w0.y, w0.z, w0.w, w1.x, w1.y, w1.z, w1.w};
#pragma unroll
                for (int j = 0; j < 8; ++j) wv[j] = (s0 + j <= t) ? wv[j] : 0.f;
                const v4u bw = {pk2(wv[0], wv[1]), pk2(wv[2], wv[3]), pk2(wv[4], wv[5]), pk2(wv[6], wv[7])}; const bf16x8 bfr = __builtin_bit_cast(bf16x8, bw);
                acc[tt][0] = __builtin_amdgcn_mfma_f32_32x32x16_bf16(af0, bfr, acc[tt][0], 0, 0, 0); acc[tt][1] = __builtin_amdgcn_mfma_f32_32x32x16_bf16(af1, bfr, acc[tt][1], 0, 0, 0); } }
    }
    asm volatile("" ::: "memory");
#pragma unroll
    for (int tt = 0; tt < 4; ++tt) {
        const float bias = sb[32 * tt + r32];
#pragma unroll
        for (int ct = 0; ct < 2; ++ct)
#pragma unroll
            for (int g4 = 0; g4 < 4; ++g4) { const f32x16& a = acc[tt][ct];
                *(LAS f32x4*)(T + r32 * SG_OP + 4 * (32 * ct + 8 * g4 + 4 * hh)) = (f32x4){a[4 * g4] + bias, a[4 * g4 + 1] + bias, a[4 * g4 + 2] + bias, a[4 * g4 + 3] + bias}; }
        asm volatile("" ::: "memory");
#pragma unroll
        for (int i = 0; i < 4; ++i) { const int tkn = tk8 + 8 * i, mm = m0 + 32 * tt + tkn;
            const v4u uw = *(const GAS v4u*)(PROJ + (size_t)mm * NPROJ_P + CB_U + 64 * g + 8 * part);
            const f32x4 x0 = *(const LAS f32x4*)(T + tkn * SG_OP + 32 * part), x1 = *(const LAS f32x4*)(T + tkn * SG_OP + 32 * part + 16);
            const float u[8] = {bflo(uw.x), bfhi(uw.x), bflo(uw.y), bfhi(uw.y), bflo(uw.z), bfhi(uw.z), bflo(uw.w), bfhi(uw.w)};
            *(GAS v4u*)(YC + (size_t)mm * DM + GW + 64 * g + 8 * part) = (v4u){pk2(gelu_tanh(u[0]) * x0.x, gelu_tanh(u[1]) * x0.y), pk2(gelu_tanh(u[2]) * x0.z, gelu_tanh(u[3]) * x0.w), pk2(gelu_tanh(u[4]) * x1.x, gelu_tanh(u[5]) * x1.y), pk2(gelu_tanh(u[6]) * x1.z, gelu_tanh(u[7]) * x1.w)}; }
        asm volatile("" ::: "memory");
    }
}

#ifndef SIMPLE_A
#define SIMPLE_A 0
#endif
#ifndef SIMPLE_B
#define SIMPLE_B 0
#endif
#ifndef SIMPLE_C
#define SIMPLE_C 0
#endif
#ifndef SIMPLE_D
#define SIMPLE_D 0
#endif
__device__ __forceinline__ void ph_mixers(LAS unsigned char* L, int l, int phase, int qoff, int wv, int mask = 31) {
    Frame F = mkframe(L, wv);
    volatile LAS int* qslot = (volatile LAS int*)(L + MISC_OFF + 64);
    gu32* ctr = ctlp() + CW_Q + 64 * phase + qoff;
    constexpr int I_IN = (DM / 64) * (NPROJ / 32), I_REST = (I8_OUT ? 0 : (DM / 64) * (DM / 32)) + (FFN1_I8 ? 0 : 2 * (DM / 64) * (DFF / 32)) + (DFF / 64) * (DM / 32);
    const int n_scan = (SIMPLE_D || !(mask & 1)) ? 0 : 128, n_c = (SIMPLE_C || !(mask & 2)) ? 0 : 512, n_a = (SIMPLE_A || !(mask & 4)) ? 0 : 256, n_b = (SIMPLE_B || !(mask & 8)) ? 0 : 128;
    const int n_cin = ((l + 1 < DEPTH) && (mask & 16)) ? (I8_IN ? NPROJ / 32 + (WINB_ITEMS + 7) / 8 : (I_IN + 7) / 8) : 0, n_crest = (mask & 16) ? (I_REST + 7) / 8 : 0, n_cout = ((I8_OUT && (mask & 16)) ? DM / 32 : 0) + ((FFN1_I8 && (mask & 16)) ? 2 * (DFF / 32) : 0);
    const int e_scan = n_scan, e_a = e_scan + n_a, e_b = e_a + n_b, e_c = e_b + n_c, e_cout = e_c + n_cout, e_cin = e_cout + n_cin, e_crest = e_cin + n_crest;
    for (;;) {
        if (F.tid == 0) *qslot = (int)__hip_atomic_fetch_add(ctr, 1u, RLX_AGENT);
        __syncthreads();
        const int it = __builtin_amdgcn_readfirstlane(*qslot);
        __syncthreads();
        if (it >= e_crest) break;
        int tid = wv * 64 + pg8::lane_now(); asm volatile("" : "+v"(tid));
        if (it < e_scan) scan_unit(L, it, tid);
        else if (it < e_a) dil_unit(L, it - e_scan, tid);
        else if (it < e_b) { sgu_unit(L, it - e_a, tid, l); __syncthreads(); }
        else if (it < e_c) { const int i2 = it - e_b; moba_unit(L, (i2 & 63) * 8 + (7 - (i2 >> 6)), tid, l); }
        else if (it < e_cout) { Frame F2 = mkframe(L, wv); int r = it - e_c;
            if (I8_OUT && r < DM / 32) conv_cols_i8(inp(19) + (size_t)l * DM * DM, DM, DM, inp(18) + l * DM, wsp() + WS_WOUT, (float*)(wsp() + WS_SMALL + SM_SWOUT), r, F2);
            else { r -= I8_OUT ? DM / 32 : 0; const int up = r >= DFF / 32 ? 1 : 0, nb = r - up * (DFF / 32), n0 = 32 * nb;
                conv_cols_i8(inp(up ? 22 : 21) + (size_t)l * DM * DFF, DM, DFF, inp(20) + l * DM, wsp() + WS_WGU, (float*)(wsp() + WS_SMALL + SM_SWGU), nb, F2, (n0 >> 7) * 256 + up * 128 + (n0 & 127)); } }
        else if (it < e_cin) { Frame F2 = mkframe(L, wv);
            if (I8_IN) { if (it - e_cout < NPROJ / 32) conv_cols_i8(inp(2) + (size_t)(l + 1) * DM * NPROJ, DM, NPROJ, inp(1) + (l + 1) * DM, wsp() + WS_WIN, (float*)(wsp() + WS_SMALL + SM_SWIN), it - e_cout, F2);
                else conv_winb(F2, l + 1, (it - e_cout - NPROJ / 32) * 8 + F2.wave); }
            else conv_layer_items(F2, l + 1, (it - e_cout) * 8 + F2.wave, 1 << 30, true, false); }
        else { Frame F2 = mkframe(L, wv); conv_layer_items(F2, l, (it - e_cin) * 8 + F2.wave, 1 << 30, false, true); }
    }
    if (!I8_IN && l + 1 < DEPTH) {
        bf16* WIN = (bf16*)(wsp() + WS_WIN);
        Frame F3 = mkframe(L, wv);
        for (int i = F3.gw * 64 + F3.lane; i < 64 * DM / 8; i += F3.ngw * 64) { v4u z = {0u, 0u, 0u, 0u}; asm volatile("" : "+v"(z)); *(GAS v4u*)(WIN + (size_t)NPROJ * DM + (size_t)i * 8) = z; }
    }
    if (SIMPLE_D) mix_d_simple(F);
    if (SIMPLE_A) mix_a_simple(F);
    if (SIMPLE_C) mix_c_simple(F, l);
    if (SIMPLE_B) mix_b_simple(F, l);
}

__device__ __forceinline__ void ph_finalize(Frame& F, int l) {
    bf16* YC = (bf16*)(wsp() + WS_YCAT); const float* YD = (const float*)(wsp() + WS_YD); const bf16* V_ = (const bf16*)outp() + (size_t)3 * M * GW; const bf16* G_ = (const bf16*)(wsp() + WS_G); const float* BC = (const float*)(wsp() + WS_BC);
    const float* lng = inp(16) + l * GW; const float* lnb = inp(17) + l * GW;
    for (int m = F.gw; m < M; m += F.ngw) {
        const int c0 = 8 * F.lane, hd = F.lane >> 3;
        float y[8];
        { const GAS f32x4* yp = (const GAS f32x4*)(YD + (size_t)m * GW + c0); const f32x4 a = yp[0], b = yp[1]; y[0] = a.x; y[1] = a.y; y[2] = a.z; y[3] = a.w; y[4] = b.x; y[5] = b.y; y[6] = b.z; y[7] = b.w; }
        float s = 0.f;
#pragma unroll
        for (int i = 0; i < 8; ++i) s += y[i];
        s += __shfl_xor(s, 1); s += __shfl_xor(s, 2); s += __shfl_xor(s, 4); const float mean = s * (1.0f / 64.0f); float q = 0.f;
#pragma unroll
        for (int i = 0; i < 8; ++i) { const float d = y[i] - mean; q += d * d; }
        q += __shfl_xor(q, 1); q += __shfl_xor(q, 2); q += __shfl_xor(q, 4); const float rstd = 1.0f / sqrtf(q * (1.0f / 64.0f) + 64e-5f);
        const v4u vw = *(const GAS v4u*)(V_ + (size_t)m * GW + c0), gw4 = *(const GAS v4u*)(G_ + (size_t)m * GW + c0); const float bc = BC[(size_t)m * NH + hd];
        float vv[8], gg[8]; UNPACK8(vv, 0, vw); UNPACK8(gg, 0, gw4);
        float ss = 0.f;
#pragma unroll
        for (int i = 0; i < 8; ++i) { y[i] = ((y[i] - mean) * rstd * lng[c0 + i] + lnb[c0 + i] + bc * vv[i]) * gg[i]; ss += y[i] * y[i]; }
        if (I8_OUT) {
            float xn[3][8], mx = 0.f;
            { const float rs = 1.0f / sqrtf(wave_sum(ss) * (1.0f / 512.0f) + NORM_EPS);
#pragma unroll
              for (int i = 0; i < 8; ++i) { y[i] *= rs; mx = fmaxf(mx, fabsf(y[i])); } }
#pragma unroll
            for (int br = 0; br < 3; ++br) {
                const v4u w = *(const GAS v4u*)(YC + (size_t)m * DM + br * GW + c0); UNPACK8(xn[br], 0, w); float s2 = 0.f;
#pragma unroll
                for (int i = 0; i < 8; ++i) s2 += xn[br][i] * xn[br][i];
                const float rs = 1.0f / sqrtf(wave_sum(s2) * (1.0f / 512.0f) + NORM_EPS);
#pragma unroll
                for (int i = 0; i < 8; ++i) { xn[br][i] *= rs; mx = fmaxf(mx, fabsf(xn[br][i])); }
            }
            mx = wave_max(mx); const float inv = mx > 0.f ? 127.0f / mx : 0.f; unsigned char* yq = wsp() + WS_YQ + (size_t)m * DM + c0;
#pragma unroll
            for (int br = 0; br < 3; ++br) *(GAS v2u*)(yq + br * GW) = (v2u){q8pack4(xn[br][0], xn[br][1], xn[br][2], xn[br][3], inv), q8pack4(xn[br][4], xn[br][5], xn[br][6], xn[br][7], inv)};
            *(GAS v2u*)(yq + 3 * GW) = (v2u){q8pack4(y[0], y[1], y[2], y[3], inv), q8pack4(y[4], y[5], y[6], y[7], inv)};
            if (F.lane == 0) ((float*)(wsp() + WS_SMALL + SM_SAY))[m] = mx * (1.0f / 127.0f);
            continue;
        }
        { const float rs = 1.0f / sqrtf(wave_sum(ss) * (1.0f / 512.0f) + NORM_EPS);
          *(GAS v4u*)(YC + (size_t)m * DM + 3 * GW + c0) = (v4u){pk2(y[0] * rs, y[1] * rs), pk2(y[2] * rs, y[3] * rs), pk2(y[4] * rs, y[5] * rs), pk2(y[6] * rs, y[7] * rs)}; }
#pragma unroll
        for (int br = 0; br < 3; ++br) {
            GAS v4u* p = (GAS v4u*)(YC + (size_t)m * DM + br * GW + c0); const v4u w = *p;
            float x[8]; UNPACK8(x, 0, w); float s2 = 0.f;
#pragma unroll
            for (int i = 0; i < 8; ++i) s2 += x[i] * x[i];
            const float rs = 1.0f / sqrtf(wave_sum(s2) * (1.0f / 512.0f) + NORM_EPS);
            *p = (v4u){pk2(x[0] * rs, x[1] * rs), pk2(x[2] * rs, x[3] * rs), pk2(x[4] * rs, x[5] * rs), pk2(x[6] * rs, x[7] * rs)};
        }
    }
}
__device__ __forceinline__ void ph_final(Frame& F) {
    const pg8::fx_t* ssq = (const pg8::fx_t*)(ctlp() + CW_SSQ) + 4 * M; const float* g = inp(24); float* out = outp(); const bf16* XB = (const bf16*)(wsp() + WS_XB);
    for (int m = F.gw; m < M; m += F.ngw) {
        const float rs = 1.0f / sqrtf(pg8::fx_get(ssq + m) * (1.0f / 2048.0f) + NORM_EPS); GAS f32x4* orow = (GAS f32x4*)(out + (size_t)m * DM); const GAS v4u* xr = (const GAS v4u*)(XB + (size_t)m * DM) + F.lane; const GAS f32x4* gp = (const GAS f32x4*)g;
#pragma unroll
        for (int j = 0; j < 4; ++j) { const v4u w = xr[64 * j]; const int c4 = 2 * (F.lane + 64 * j); const f32x4 g0 = gp[c4], g1 = gp[c4 + 1];
            orow[c4] = (f32x4){bflo(w.x) * rs * g0.x, bfhi(w.x) * rs * g0.y, bflo(w.y) * rs * g0.z, bfhi(w.y) * rs * g0.w};
            orow[c4 + 1] = (f32x4){bflo(w.z) * rs * g1.x, bfhi(w.z) * rs * g1.y, bflo(w.w) * rs * g1.z, bfhi(w.w) * rs * g1.w}; }
    }
}

#ifndef STAG
#define STAG 500
#endif
__device__ __forceinline__ void phase_stagger(int ticks) {
    const int grp = ((int)blockIdx.x >> 3) & 3;
    if (ticks > 0 && grp > 0) { const unsigned long long t0 = __builtin_amdgcn_s_memrealtime(); while ((long long)(__builtin_amdgcn_s_memrealtime() - t0) < (long long)grp * ticks) __builtin_amdgcn_s_sleep(32); }
}
__global__ void __launch_bounds__(NTHR, 2) hy_fwd(Args args) {
    extern __shared__ __attribute__((aligned(16))) unsigned char lds[];
    LAS unsigned char* L = (LAS unsigned char*)lds;
    volatile LAS unsigned* MISC = (volatile LAS unsigned*)(L + MISC_OFF);
    const int wv = __builtin_amdgcn_readfirstlane((int)threadIdx.x >> 6);
    if (wv == 0) MISC[pg8::lane_now()] = 0u;
    __syncthreads();
    XcdBarrier bar; bar.bar = (unsigned*)(ctlp() + CW_BAR); bar.x = 0; bar.st = nullptr; bar.wv = wv;
    if (N_LAUNCH_MODE == 0) bar = xcd_barrier_post((unsigned*)(ctlp() + CW_BAR), MISC + 8, wv);
    const int lo = args.ph_lo, hi = args.ph_hi;
#define IN(k) (lo <= (k) && (k) < hi)
#define SEAM(k) do { if (IN(k) && IN((k) + 1)) xcd_barrier(bar); } while (0)
    if (IN(0)) { Frame F = mkframe(L, wv); ph_prologue(F); if (REPEAT == 1) ph_prologue(F); }
    SEAM(0);
    auto layer = [&](const int l) __attribute__((always_inline)) {
        const int P = 1 + 9 * l;
        if (IN(P)) { phase_stagger(STAG);
            unsigned char* ws = wsp(); pg8::Gemm g{(const bf16*)(ws + WS_XB), (const bf16*)(ws + WS_WIN), M, NPROJ_P, DM, wv}; pg8::StaticOrder S; S.init(M, NPROJ_P, gridDim.x, (int)blockIdx.x);
            pg8::EpiProj E{(bf16*)(ws + WS_PROJ), NPROJ_P, (const pg8::fx_t*)((gu32*)ws + CW_SSQ) + (size_t)(2 * l) * M, (float*)(ws + CTL_KBAR) + (size_t)l * 64 * 8 * 64, (pg8::fx_t*)(ws + CTL_STATS) + (size_t)l * M * 2,
                           (const float*)(ws + WS_SMALL + SM_SAX), (const float*)(ws + WS_SMALL + SM_SWIN)};
            if (I8_IN) { g.A = (const bf16*)(ws + WS_XQ); pg8::MaskOrder S1; S1.init(M, 0xFFFFFFu & ~BFMASK, gridDim.x, (int)blockIdx.x);
                pg8::gemm_phase<pg8::EpiProj, pg8::MaskOrder, true, PG8_SP2, 1>(L + RING_OFF, g, S1, E);
                if (BFMASK) { pg8::Gemm gb{(const bf16*)(ws + WS_XB), winb_ptr(), M, NPROJ_P, DM, wv}; pg8::MaskOrder S2; S2.init(M, BFMASK, gridDim.x, (int)blockIdx.x);
                    pg8::gemm_phase<pg8::EpiProj, pg8::MaskOrder, true, PG8_SP2>(L + RING_OFF, gb, S2, E); } }
            else pg8::gemm_phase<pg8::EpiProj, pg8::StaticOrder, true, PG8_SP2>(L + RING_OFF, g, S, E);
            if (REPEAT == 21) { pg8::EpiNull E0{(float*)(ws + WS_YCAT)}; pg8::MaskOrder S1; S1.init(M, 0xFFFFFFu, gridDim.x, (int)blockIdx.x); pg8::gemm_phase<pg8::EpiNull, pg8::MaskOrder, true, PG8_SP2, 1>(L + RING_OFF, g, S1, E0); }
            if (REPEAT == 23) { pg8::EpiProjDense E3{(bf16*)(ws + WS_YCAT), E.ssq, E.sa, E.sw}; pg8::MaskOrder S1; S1.init(M, 0xFFFFFFu, gridDim.x, (int)blockIdx.x); pg8::gemm_phase<pg8::EpiProjDense, pg8::MaskOrder, true, PG8_SP2, 1>(L + RING_OFF, g, S1, E3); }
            if (REPEAT == 22) { pg8::EpiProj E2 = E; E2.kbar = (float*)(ws + WS_YCAT + 32 * MiB); E2.stats = (pg8::fx_t*)(ws + WS_YCAT + 40 * MiB); E2.O = (bf16*)(ws + WS_YCAT); E2.ldc = 256;
                pg8::MaskOrder S1; S1.init(M, 0xFFFFFFu, gridDim.x, (int)blockIdx.x); pg8::gemm_phase<pg8::EpiProj, pg8::MaskOrder, true, PG8_SP2, 1>(L + RING_OFF, g, S1, E2); }
            if (REPEAT == 2) { pg8::EpiProj E2 = E; E2.kbar = (float*)(ws + WS_YCAT); E2.stats = (pg8::fx_t*)(ws + WS_YCAT + 8 * MiB);
                if (I8_IN) { pg8::MaskOrder S1; S1.init(M, 0xFFFFFFu & ~BFMASK, gridDim.x, (int)blockIdx.x); pg8::gemm_phase<pg8::EpiProj, pg8::MaskOrder, true, PG8_SP2, 1>(L + RING_OFF, g, S1, E2);
                    if (BFMASK) { pg8::Gemm gb{(const bf16*)(ws + WS_XB), winb_ptr(), M, NPROJ_P, DM, wv}; pg8::MaskOrder S2; S2.init(M, BFMASK, gridDim.x, (int)blockIdx.x); pg8::gemm_phase<pg8::EpiProj, pg8::MaskOrder, true, PG8_SP2>(L + RING_OFF, gb, S2, E2); } }
                else pg8::gemm_phase<pg8::EpiProj, pg8::StaticOrder, true, PG8_SP2>(L + RING_OFF, g, S, E2); }
        }
        SEAM(P);
        if (IN(P + 1)) { Frame F = mkframe(L, wv); ph_prep(F, l); if (REPEAT == 3) ph_prep(F, l); }
        SEAM(P + 1);
        if (IN(P + 2)) { ph_mixers(L, l, P + 2, 0, wv); if (REPEAT == 4) ph_mixers(L, l, P + 2, 32, wv); if (REPEAT >= 40 && REPEAT < 50) ph_mixers(L, l, P + 2, 32, wv, REPEAT == 41 ? 1 : (REPEAT == 42 ? 2 : (REPEAT == 43 ? 4 : (REPEAT == 44 ? 8 : 16)))); if (REPEAT >= 430 && REPEAT < 446) ph_mixers(L, l, P + 2, 32, wv, 4); }
        SEAM(P + 2);
        if (IN(P + 3)) { Frame F = mkframe(L, wv); ph_finalize(F, l); if (REPEAT == 5) ph_finalize(F, l); }
        SEAM(P + 3);
        if (IN(P + 4)) { phase_stagger(STAG);
            unsigned char* ws = wsp(); pg8::Gemm g{(const bf16*)(ws + WS_YCAT), (const bf16*)(ws + WS_WOUT), M, DM, DM, wv}; pg8::StaticOrder S; S.init(M, DM, gridDim.x, (int)blockIdx.x);
            pg8::EpiRes E{(bf16*)(ws + WS_XB), (pg8::fx_t*)((gu32*)ws + CW_SSQ) + (size_t)(2 * l + 1) * M, DM, (FFN_FP8 && !FFN1_I8) ? (unsigned char*)(ws + WS_SC2) : nullptr, 1.0f, (const float*)(ws + WS_SMALL + SM_SAY), (const float*)(ws + WS_SMALL + SM_SWOUT)};
            if (I8_OUT) { g.A = (const bf16*)(ws + WS_YQ); pg8::gemm_phase<pg8::EpiRes, pg8::StaticOrder, true, PG8_SP2, 1>(L + RING_OFF, g, S, E); }
            else pg8::gemm_phase<pg8::EpiRes, pg8::StaticOrder, true, PG8_SP2>(L + RING_OFF, g, S, E);
            if (REPEAT == 7) { pg8::EpiRes E2 = E; E2.xb = (bf16*)(ws + WS_YCAT); E2.ssq = (pg8::fx_t*)(ws + WS_G); E2.xf = (unsigned char*)(ws + WS_YD);
                if (I8_OUT) pg8::gemm_phase<pg8::EpiRes, pg8::StaticOrder, true, PG8_SP2, 1>(L + RING_OFF, g, S, E2); else pg8::gemm_phase<pg8::EpiRes, pg8::StaticOrder, true, PG8_SP2>(L + RING_OFF, g, S, E2); }
        }
        SEAM(P + 4);
        if (FFN1_I8) { if (IN(P + 5)) { Frame F = mkframe(L, wv); ph_quantx(F); } SEAM(P + 5); }
        if (IN(P + 6)) {
            unsigned char* ws = wsp(); pg8::Gemm g{(const bf16*)(ws + (FFN1_I8 ? WS_XQ : (FFN_FP8 ? WS_SC2 : WS_XB))), (const bf16*)(ws + WS_WGU), M, 2 * DFF, DM, wv}; pg8::StaticOrder S; S.init(M, 2 * DFF, gridDim.x, (int)blockIdx.x);
            if (FFN_FP8) { pg8::EpiGU8 E{(unsigned char*)(ws + WS_PROJ), DFF, (const pg8::fx_t*)((gu32*)ws + CW_SSQ) + (size_t)(2 * l + 1) * M, FFN1_I8 ? 1.0f : 1.0f / 64.0f, 8.0f, (const float*)(ws + WS_SMALL + SM_SAX), (const float*)(ws + WS_SMALL + SM_SWGU)};
                if (FFN1_I8) pg8::gemm_phase<pg8::EpiGU8, pg8::StaticOrder, true, PG8_SP2, 1>(L + RING_OFF, g, S, E);
                else pg8::gemm_phase_f8<pg8::EpiGU8, pg8::StaticOrder, true, PG8_SP2>(L + RING_OFF, g, S, E);
                if (REPEAT == 6) { if (FFN1_I8) pg8::gemm_phase<pg8::EpiGU8, pg8::StaticOrder, true, PG8_SP2, 1>(L + RING_OFF, g, S, E); else pg8::gemm_phase_f8<pg8::EpiGU8, pg8::StaticOrder, true, PG8_SP2>(L + RING_OFF, g, S, E); }
            } else { pg8::EpiGU E{(bf16*)(ws + WS_PROJ), DFF, (const pg8::fx_t*)((gu32*)ws + CW_SSQ) + (size_t)(2 * l + 1) * M, 1.0f};
                pg8::gemm_phase<pg8::EpiGU, pg8::StaticOrder, true, PG8_SP2>(L + RING_OFF, g, S, E);
                if (REPEAT == 6) pg8::gemm_phase<pg8::EpiGU, pg8::StaticOrder, true, PG8_SP2>(L + RING_OFF, g, S, E); }
        }
        SEAM(P + 6);
        if (IN(P + 7)) { phase_stagger(STAG);
            unsigned char* ws = wsp(); pg8::Gemm g{(const bf16*)(ws + WS_PROJ), (const bf16*)(ws + WS_WDN), M, DM, DFF, wv}; pg8::StaticOrder S; S.init(M, DM, gridDim.x, (int)blockIdx.x);
            pg8::EpiRes E{(bf16*)(ws + WS_XB), (pg8::fx_t*)((gu32*)ws + CW_SSQ) + (size_t)(2 * l + 2) * M, DM, nullptr, FFN_FP8 ? 1.0f / 512.0f : 1.0f, nullptr, nullptr};
            if (FFN_FP8) pg8::gemm_phase_f8<pg8::EpiRes, pg8::StaticOrder, true, PG8_SP2>(L + RING_OFF, g, S, E);
            else pg8::gemm_phase<pg8::EpiRes, pg8::StaticOrder, true, PG8_SP2>(L + RING_OFF, g, S, E);
            if (REPEAT == 8) { pg8::EpiRes E2 = E; E2.xb = (bf16*)(ws + WS_YCAT); E2.ssq = (pg8::fx_t*)(ws + WS_G);
                if (FFN_FP8) pg8::gemm_phase_f8<pg8::EpiRes, pg8::StaticOrder, true, PG8_SP2>(L + RING_OFF, g, S, E2); else pg8::gemm_phase<pg8::EpiRes, pg8::StaticOrder, true, PG8_SP2>(L + RING_OFF, g, S, E2); }
        }
        SEAM(P + 7);
        if (l + 1 < DEPTH) { if (I8_IN && IN(P + 8)) { Frame F = mkframe(L, wv); ph_quantx(F); } if (I8_IN) SEAM(P + 8); }
    };
    static_assert(DEPTH == 2, "layers are expanded by hand");
    layer(0); layer(1);
    if (IN(19)) { Frame F = mkframe(L, wv); ph_final(F); }
#undef IN
#undef SEAM
}

extern "C" void kernel_launch(void* const* d_in, const int* in_sizes, int n_in, void* d_out, int out_size, void* d_ws, size_t ws_size, hipStream_t stream) {
    static int grid = 0;
    if (grid == 0) {
        if (n_in != 25 || in_sizes[0] != M * DM || out_size != M * DM || ws_size < WS_END) { fprintf(stderr, "kernel_launch: shape/workspace mismatch: n_in %d in0 %d out %d ws %zu (need %zu)\n", n_in, n_in > 0 ? in_sizes[0] : -1, out_size, ws_size, (size_t)WS_END); grid = -1; return; }
        int dev = 0, cus = 0, per_cu = 0;
        if (hipGetDevice(&dev) != hipSuccess || hipDeviceGetAttribute(&cus, hipDeviceAttributeMultiprocessorCount, dev) != hipSuccess) { grid = -1; return; }
        if (hipFuncSetAttribute((const void*)hy_fwd, hipFuncAttributeMaxDynamicSharedMemorySize, LDS_BYTES) != hipSuccess) { fprintf(stderr, "kernel_launch: hipFuncSetAttribute failed\n"); grid = -1; return; }
        if (hipOccupancyMaxActiveBlocksPerMultiprocessor(&per_cu, (const void*)hy_fwd, NTHR, LDS_BYTES) != hipSuccess || per_cu < 1) fprintf(stderr, "kernel_launch: occupancy query reports %d\n", per_cu);
        (void)hipGetLastError();
        grid = cus;
    }
    if (grid < 0) return;
    if (hipMemsetAsync((char*)d_ws + WS_CTL, 0, CTL_ZERO_BYTES, stream) != hipSuccess) return;
    Args a{};
    for (int i = 0; i < 25; ++i) a.in[i] = (const float*)d_in[i];
    a.out = (float*)d_out; a.ws = (unsigned char*)d_ws;
    if (N_LAUNCH_MODE == 0) { a.ph_lo = 0; a.ph_hi = N_PHASES; hipLaunchKernelGGL(hy_fwd, dim3(grid), dim3(NTHR), LDS_BYTES, stream, a); }
    else for (int p = 0; p < N_PHASES; ++p) { a.ph_lo = p; a.ph_hi = p + 1; hipLaunchKernelGGL(hy_fwd, dim3(grid), dim3(NTHR), LDS_BYTES, stream, a); }
}
```

```cpp
#define N_LAUNCH_MODE 0
#define REPEAT 0
#define PG8_SP2 true
#define FFN_FP8 1
#define GEMM_I8 3
#define STAG 0
#define FFN1_I8 1
#define BFMASK 0x0u
#include <hip/hip_runtime.h>
#include <cstdio>
#include <cstdint>
namespace pg8 {
#define PG8_LAS __attribute__((address_space(3)))
typedef unsigned short bf16_t;
typedef short bf16x8 __attribute__((ext_vector_type(8)));
typedef float f32x4 __attribute__((ext_vector_type(4)));
typedef unsigned u32x4 __attribute__((ext_vector_type(4)));
constexpr int BM = 256, BK = 64, HALF = 128, HTB = HALF * BK * 2  , STAGE_BYTES = 8 * HTB, NXCD = 8, WGM = 8;

__host__ __device__ __forceinline__ int lds_byte(int r, int c) { const int st = (r >> 4) * 2 + (c >> 5), rr = r & 15, cc = c & 31, ob = rr * 64 + cc * 2; return st * 1024 + (ob ^ (((ob >> 9) & 1) << 5)); }
__host__ __device__ __forceinline__ void stage_rc(int b, int& R, int& C) { const int st = b / 1024, sb = b % 1024, swz = sb ^ (((sb >> 9) & 1) << 5); R = (st >> 1) * 16 + swz / 64; C = (st & 1) * 32 + (swz % 64) / 2; }
__host__ __device__ __forceinline__ int perm32(int rho) { const int n = rho >> 4, i = rho & 15; return 8 * (i >> 2) + 4 * n + (i & 3); }

__device__ __forceinline__ int lane_now() { int l; asm volatile("v_mbcnt_lo_u32_b32 %0, -1, 0\n\tv_mbcnt_hi_u32_b32 %0, -1, %0" : "=v"(l)); return l; }
struct Unit { int pm, pn; };
struct Gemm { const bf16_t* A; const bf16_t* Bt; int M, N, K, wv; int same = 0; };

struct StaticOrder {
    int nM, nN, nwg, G, c;
    __host__ __device__ void init(int M, int N, int G_, int c_) { nM = M / BM; nN = N / BM; nwg = nM * nN; G = G_; c = c_; }
    __host__ __device__ bool next(int i, Unit& u) const {
        const long L = (long)i * G + c; if (L >= nwg) return false;
        int wgid = (int)L; { const int q = nwg / NXCD, r = nwg % NXCD, xcd = wgid % NXCD, off = wgid / NXCD; wgid = (xcd < r ? xcd * (q + 1) : r * (q + 1) + (xcd - r) * q) + off; }
        const int nig = WGM * nN, gid = wgid / nig, fm = gid * WGM, gsz = (nM - fm) < WGM ? (nM - fm) : WGM;
        u.pm = fm + ((wgid % nig) % gsz); u.pn = (wgid % nig) / gsz; return true;
    }
    __device__ __forceinline__ void a_ready(const Unit&) const {}
    __device__ __forceinline__ void done(const Unit&) const {}
};

struct MapOrder {
    StaticOrder s; int from, add;
    __device__ __forceinline__ bool next(int i, Unit& u) const { if (!s.next(i, u)) return false; if (u.pn >= from) u.pn += add; return true; }
    __device__ __forceinline__ void a_ready(const Unit&) const {}
    __device__ __forceinline__ void done(const Unit&) const {}
};

struct MaskOrder {
    StaticOrder s; unsigned mask;
    __device__ __forceinline__ void init(int M, unsigned mask_, int G_, int c_) { mask = mask_; s.init(M, BM * __builtin_popcount(mask_), G_, c_); }
    __device__ __forceinline__ bool next(int i, Unit& u) const { if (!s.next(i, u)) return false; unsigned m = mask; for (int j = 0; j < u.pn; ++j) m &= m - 1; u.pn = __builtin_ctz(m); return true; }
    __device__ __forceinline__ void a_ready(const Unit&) const {}
    __device__ __forceinline__ void done(const Unit&) const {}
};

__device__ __forceinline__ unsigned cvt_pk_bf16(float lo, float hi) { unsigned r; asm volatile("v_cvt_pk_bf16_f32 %0, %1, %2" : "=v"(r) : "v"(lo), "v"(hi)); return r; }
typedef float f32x2 __attribute__((ext_vector_type(2)));

typedef unsigned u32x2 __attribute__((ext_vector_type(2)));
typedef unsigned long long fx_t;
__device__ __forceinline__ void fx_add(fx_t* p, float v) { atomicAdd(p, (fx_t)(long long)__float2ll_rn(v * 1073741824.0f)); }
__device__ __forceinline__ float fx_get(const fx_t* p) { return (float)(long long)(*p) * (1.0f / 1073741824.0f); }
__device__ __forceinline__ float epi_gelu(float x) { const float u = 0.7978845608028654f * (x + 0.044715f * x * x * x); const float e2 = __expf(2.0f * u); return 0.5f * x * (2.0f - 2.0f / (e2 + 1.0f)); }
template <int CTRL> __device__ __forceinline__ float epi_dpp_add(float x) { const int y = __builtin_amdgcn_update_dpp(0, __builtin_bit_cast(int, x), CTRL, 0xF, 0xF, false); return x + __builtin_bit_cast(float, y); }
typedef int i32x4_t __attribute__((ext_vector_type(4)));
__device__ __forceinline__ f32x4 acc_f(const f32x4& v) { return v; }
__device__ __forceinline__ f32x4 acc_f(const i32x4_t& v) { return __builtin_convertvector(v, f32x4); }
template <class T> struct AccIsInt { static constexpr bool v = false; };
template <> struct AccIsInt<i32x4_t> { static constexpr bool v = true; };
__device__ __forceinline__ void epi_prefetch(const fx_t* ssq_rows, const float* sa_rows, const float* sw_cols, PG8_LAS unsigned char* slot, int wid) {
    const int ln = lane_now();
    __builtin_amdgcn_global_load_lds((const __attribute__((address_space(1))) unsigned*)((const unsigned*)ssq_rows + wid * 64 + ln), (PG8_LAS unsigned*)(slot + wid * 256), 4, 0, 0);
    if (sa_rows) { const float* src = wid < 4 ? sa_rows + wid * 64 : sw_cols + (wid - 4) * 64;
        __builtin_amdgcn_global_load_lds((const __attribute__((address_space(1))) unsigned*)((const unsigned*)src + ln), (PG8_LAS unsigned*)(slot + 2048 + wid * 256), 4, 0, 0); }
}
__device__ __forceinline__ float fx_getl(const PG8_LAS unsigned char* slot, int rloc) { return (float)(long long)(*(const PG8_LAS fx_t*)(slot + 8 * rloc)) * (1.0f / 1073741824.0f); }
struct EpiProj {
    static constexpr bool PERM = true, AFTER_DRAIN = false, PREFETCH = true;
    bf16_t* O; int ldc; const fx_t* ssq; float* kbar; fx_t* stats; const float* sa; const float* sw;
    __device__ __forceinline__ void prefetch(const Unit& u, PG8_LAS unsigned char* slot, int wid) const { epi_prefetch(ssq + u.pm * BM, sa ? sa + u.pm * BM : nullptr, sw + u.pn * BM, slot, wid); }
    template <class AccT> __device__ __forceinline__ void operator()(const AccT (&acc)[2][2][4][2], const Unit& u, int wr, int wc, int fr, int fq, const PG8_LAS unsigned char* slot) const {
        constexpr bool Q = AccIsInt<AccT>::v;
        const int row0 = u.pm * BM + wr * 64 + fr, col0 = u.pn * BM + wc * 32 + 8 * fq;
        f32x4 cw[2][2];
        if constexpr (Q) {
#pragma unroll
            for (int bj = 0; bj < 2; ++bj) { const PG8_LAS float* p = (const PG8_LAS float*)(slot + 3072) + bj * HALF + wc * 32 + 8 * fq; cw[bj][0] = *(const PG8_LAS f32x4*)p; cw[bj][1] = *(const PG8_LAS f32x4*)(p + 4); } }
        const bool do_k = (u.pn == 12 || u.pn == 13), do_s = (u.pn == 8 || u.pn == 9);
        float cs[2][8];
#pragma unroll
        for (int bj = 0; bj < 2; ++bj)
#pragma unroll
            for (int e = 0; e < 8; ++e) cs[bj][e] = 0.f;
#pragma unroll
        for (int ai = 0; ai < 2; ++ai)
#pragma unroll
            for (int m = 0; m < 4; ++m) { const int row = row0 + ai * HALF + m * 16; const int rloc = ai * HALF + wr * 64 + m * 16 + fr; float rs = __builtin_amdgcn_rsqf(fx_getl(slot, rloc) * (1.0f / 2048.0f) + 1e-6f); if constexpr (Q) rs *= *(const PG8_LAS float*)(slot + 2048 + 4 * rloc);
                bf16_t* rowp = O + (size_t)row * ldc + col0; float s1 = 0.f, s2 = 0.f;
#pragma unroll
                for (int bj = 0; bj < 2; ++bj) { f32x4 v0 = acc_f(acc[ai][bj][m][0]) * rs, v1 = acc_f(acc[ai][bj][m][1]) * rs; if constexpr (Q) { v0 *= cw[bj][0]; v1 *= cw[bj][1]; }
                    u32x4 w; w.x = cvt_pk_bf16(v0[0], v0[1]); w.y = cvt_pk_bf16(v0[2], v0[3]); w.z = cvt_pk_bf16(v1[0], v1[1]); w.w = cvt_pk_bf16(v1[2], v1[3]);
                    *(u32x4*)(rowp + bj * HALF) = w;
                    if (do_k) {
#pragma unroll
                        for (int e = 0; e < 4; ++e) { cs[bj][e] += v0[e]; cs[bj][4 + e] += v1[e]; } }
                    if (do_s) {
#pragma unroll
                        for (int e = 0; e < 4; ++e) { const float g0 = epi_gelu(v0[e]), g1 = epi_gelu(v1[e]); s1 += g0 + g1; s2 += g0 * g0 + g1 * g1; } } }
                if (do_s) { s1 += __shfl_xor(s1, 16); s1 += __shfl_xor(s1, 32); s2 += __shfl_xor(s2, 16); s2 += __shfl_xor(s2, 32);
                    if (fq == 0) { fx_add(stats + 2 * row, s1); fx_add(stats + 2 * row + 1, s2); } } }
        if (do_k) {
            const int bidx = (u.pm >> 3) * 8, n = u.pm & 7;
#pragma unroll
            for (int bj = 0; bj < 2; ++bj)
#pragma unroll
                for (int e = 0; e < 8; ++e) { float s = cs[bj][e]; s = epi_dpp_add<0xB1>(s); s = epi_dpp_add<0x4E>(s); s = epi_dpp_add<0x141>(s); s = epi_dpp_add<0x140>(s);
                    const int ck = col0 + bj * HALF + e - 3072;
                    if (fr == 0) unsafeAtomicAdd(kbar + ((bidx + (ck >> 6)) * 8 + n) * 64 + (ck & 63), s * (1.0f / 256.0f)); } }
    }
};
struct EpiGU {
    static constexpr bool PERM = true, AFTER_DRAIN = false, PREFETCH = false;
    bf16_t* O; int ldc; const fx_t* ssq; float oscale;
    __device__ __forceinline__ void operator()(const f32x4 (&acc)[2][2][4][2], const Unit& u, int wr, int wc, int fr, int fq, const PG8_LAS unsigned char* slot) const {
        const int row0 = u.pm * BM + wr * 64 + fr, col0 = u.pn * HALF + wc * 32 + 8 * fq;
#pragma unroll
        for (int ai = 0; ai < 2; ++ai)
#pragma unroll
            for (int m = 0; m < 4; ++m) { const int row = row0 + ai * HALF + m * 16; const float rs = __builtin_amdgcn_rsqf(fx_get(ssq + row) * (1.0f / 2048.0f) + 1e-6f) * oscale;
                float o[8];
#pragma unroll
                for (int n = 0; n < 2; ++n)
#pragma unroll
                    for (int e = 0; e < 4; ++e) { const float g = acc[ai][0][m][n][e] * rs, up = acc[ai][1][m][n][e] * rs;
                        o[n * 4 + e] = g * __builtin_amdgcn_rcpf(1.0f + __builtin_amdgcn_exp2f(-1.4426950408889634f * g)) * up; }
                u32x4 w; w.x = cvt_pk_bf16(o[0], o[1]); w.y = cvt_pk_bf16(o[2], o[3]); w.z = cvt_pk_bf16(o[4], o[5]); w.w = cvt_pk_bf16(o[6], o[7]);
                *(u32x4*)(O + (size_t)row * ldc + col0) = w; }
    }
};
__device__ __forceinline__ float epi_clamp8(float v) { return __builtin_amdgcn_fmed3f(v, -448.0f, 448.0f); }
struct EpiGU8 {
    static constexpr bool PERM = true, AFTER_DRAIN = false, PREFETCH = true;
    __device__ __forceinline__ void prefetch(const Unit& u, PG8_LAS unsigned char* slot, int wid) const { epi_prefetch(ssq + u.pm * BM, sa ? sa + u.pm * BM : nullptr, sw + u.pn * BM, slot, wid); }
    unsigned char* O; int ldc; const fx_t* ssq; float oscale, ascale; const float* sa; const float* sw;
    template <class AccT> __device__ __forceinline__ void operator()(const AccT (&acc)[2][2][4][2], const Unit& u, int wr, int wc, int fr, int fq, const PG8_LAS unsigned char* slot) const {
        constexpr bool Q = AccIsInt<AccT>::v;
        const int row0 = u.pm * BM + wr * 64 + fr, col0 = u.pn * HALF + wc * 32 + 8 * fq;
        f32x4 cw[2][2];
        if constexpr (Q) {
#pragma unroll
            for (int bj = 0; bj < 2; ++bj) { const PG8_LAS float* p = (const PG8_LAS float*)(slot + 3072) + bj * HALF + wc * 32 + 8 * fq; cw[bj][0] = *(const PG8_LAS f32x4*)p; cw[bj][1] = *(const PG8_LAS f32x4*)(p + 4); } }
#pragma unroll
        for (int ai = 0; ai < 2; ++ai)
#pragma unroll
            for (int m = 0; m < 4; ++m) { const int row = row0 + ai * HALF + m * 16; const int rloc = ai * HALF + wr * 64 + m * 16 + fr; float rs = __builtin_amdgcn_rsqf(fx_getl(slot, rloc) * (1.0f / 2048.0f) + 1e-6f) * oscale; if constexpr (Q) rs *= *(const PG8_LAS float*)(slot + 2048 + 4 * rloc);
                float o[8];
#pragma unroll
                for (int n = 0; n < 2; ++n) { f32x4 gv = acc_f(acc[ai][0][m][n]) * rs, uv = acc_f(acc[ai][1][m][n]) * rs; if constexpr (Q) { gv *= cw[0][n]; uv *= cw[1][n]; }
#pragma unroll
                    for (int e = 0; e < 4; ++e) { const float g = gv[e], up = uv[e];
                        o[n * 4 + e] = epi_clamp8(g * __builtin_amdgcn_rcpf(1.0f + __builtin_amdgcn_exp2f(-1.4426950408889634f * g)) * up * ascale); } }
                int f0 = __builtin_bit_cast(int, o[0]), f1 = __builtin_bit_cast(int, o[4]);
                f0 = __builtin_amdgcn_cvt_pk_fp8_f32(o[0], o[1], f0, false); f0 = __builtin_amdgcn_cvt_pk_fp8_f32(o[2], o[3], f0, true);
                f1 = __builtin_amdgcn_cvt_pk_fp8_f32(o[4], o[5], f1, false); f1 = __builtin_amdgcn_cvt_pk_fp8_f32(o[6], o[7], f1, true);
                *(u32x2*)(O + (size_t)row * ldc + col0) = (u32x2){(unsigned)f0, (unsigned)f1}; }
    }
};
struct EpiRes {
    static constexpr bool PERM = true, AFTER_DRAIN = false, PREFETCH = false;
    bf16_t* xb; fx_t* ssq; int ldc; unsigned char* xf; float oscale; const float* sa; const float* sw;
    template <class AccT> __device__ __forceinline__ void operator()(const AccT (&acc)[2][2][4][2], const Unit& u, int wr, int wc, int fr, int fq, const PG8_LAS unsigned char* slot) const {
        constexpr bool Q = AccIsInt<AccT>::v;
        const int row0 = u.pm * BM + wr * 64 + fr, col0 = u.pn * BM + wc * 32 + 8 * fq;
        f32x4 cw[2][2];
        if constexpr (Q) {
#pragma unroll
            for (int bj = 0; bj < 2; ++bj) { cw[bj][0] = *(const f32x4*)(sw + col0 + bj * HALF); cw[bj][1] = *(const f32x4*)(sw + col0 + bj * HALF + 4); } }
#pragma unroll
        for (int ai = 0; ai < 2; ++ai)
#pragma unroll
            for (int m = 0; m < 4; ++m) { const int row = row0 + ai * HALF + m * 16; bf16_t* rowp = xb + (size_t)row * ldc + col0; float s = 0.f; float osc = oscale; if constexpr (Q) osc = sa[row];
                u32x4 b[2];
#pragma unroll
                for (int bj = 0; bj < 2; ++bj) b[bj] = *(const u32x4*)(rowp + bj * HALF);
#pragma unroll
                for (int bj = 0; bj < 2; ++bj) { float o[8]; f32x4 a2[2] = {acc_f(acc[ai][bj][m][0]), acc_f(acc[ai][bj][m][1])}; if constexpr (Q) { a2[0] *= cw[bj][0]; a2[1] *= cw[bj][1]; }
#pragma unroll
                    for (int q = 0; q < 4; ++q) { o[2 * q] = __builtin_fmaf(a2[q >> 1][2 * (q & 1)], osc, __builtin_bit_cast(float, b[bj][q] << 16)); o[2 * q + 1] = __builtin_fmaf(a2[q >> 1][2 * (q & 1) + 1], osc, __builtin_bit_cast(float, b[bj][q] & 0xffff0000u)); }
                    u32x4 w; w.x = cvt_pk_bf16(o[0], o[1]); w.y = cvt_pk_bf16(o[2], o[3]); w.z = cvt_pk_bf16(o[4], o[5]); w.w = cvt_pk_bf16(o[6], o[7]);
                    *(u32x4*)(rowp + bj * HALF) = w;
                    if (xf) { int f0 = (int)b[bj][0], f1 = (int)b[bj][1]; f0 = __builtin_amdgcn_cvt_pk_fp8_f32(epi_clamp8(o[0]), epi_clamp8(o[1]), f0, false); f0 = __builtin_amdgcn_cvt_pk_fp8_f32(epi_clamp8(o[2]), epi_clamp8(o[3]), f0, true);
                        f1 = __builtin_amdgcn_cvt_pk_fp8_f32(epi_clamp8(o[4]), epi_clamp8(o[5]), f1, false); f1 = __builtin_amdgcn_cvt_pk_fp8_f32(epi_clamp8(o[6]), epi_clamp8(o[7]), f1, true);
                        *(u32x2*)(xf + (size_t)row * ldc + col0 + bj * HALF) = (u32x2){(unsigned)f0, (unsigned)f1}; }
                    if (ssq) {
#pragma unroll
                        for (int q = 0; q < 8; ++q) s += o[q] * o[q]; } }
                if (ssq) { s += __shfl_xor(s, 16); s += __shfl_xor(s, 32);
                    if (fq == 0) fx_add(ssq + row, s); } }
    }
};

struct EpiNull {
    static constexpr bool PERM = true, AFTER_DRAIN = false, PREFETCH = false;
    float* sink;
    template <class AccT> __device__ __forceinline__ void operator()(const AccT (&acc)[2][2][4][2], const Unit& u, int wr, int wc, int fr, int fq, const PG8_LAS unsigned char* slot) const {
        f32x4 s = {0.f, 0.f, 0.f, 0.f};
#pragma unroll
        for (int ai = 0; ai < 2; ++ai)
#pragma unroll
            for (int bj = 0; bj < 2; ++bj)
#pragma unroll
                for (int m = 0; m < 4; ++m)
#pragma unroll
                    for (int n = 0; n < 2; ++n) s += acc_f(acc[ai][bj][m][n]);
        if (s[0] + s[1] + s[2] + s[3] == 1.2345e30f) sink[0] = s[0];
    }
};

struct EpiProjDense {
    static constexpr bool PERM = true, AFTER_DRAIN = false, PREFETCH = false;
    bf16_t* O; const fx_t* ssq; const float* sa; const float* sw;
    template <class AccT> __device__ __forceinline__ void operator()(const AccT (&acc)[2][2][4][2], const Unit& u, int wr, int wc, int fr, int fq, const PG8_LAS unsigned char* slot) const {
        const int row0 = u.pm * BM + wr * 64 + fr, col0 = u.pn * BM + wc * 32 + 8 * fq;
        f32x4 cw[2][2];
#pragma unroll
        for (int bj = 0; bj < 2; ++bj) { cw[bj][0] = *(const f32x4*)(sw + col0 + bj * HALF); cw[bj][1] = *(const f32x4*)(sw + col0 + bj * HALF + 4); }
        bf16_t* base = O + ((size_t)(((u.pm * 24 + u.pn) & 255) * 8 + wr * 4 + wc) * 16) * 512 + (fq * 16 + fr) * 8;
#pragma unroll
        for (int ai = 0; ai < 2; ++ai)
#pragma unroll
            for (int m = 0; m < 4; ++m) { const int row = row0 + ai * HALF + m * 16; float rs = __builtin_amdgcn_rsqf(fx_get(ssq + row) * (1.0f / 2048.0f) + 1e-6f) * sa[row];
#pragma unroll
                for (int bj = 0; bj < 2; ++bj) { f32x4 v0 = acc_f(acc[ai][bj][m][0]) * rs * cw[bj][0], v1 = acc_f(acc[ai][bj][m][1]) * rs * cw[bj][1];
                    u32x4 w; w.x = cvt_pk_bf16(v0[0], v0[1]); w.y = cvt_pk_bf16(v0[2], v0[3]); w.z = cvt_pk_bf16(v1[0], v1[1]); w.w = cvt_pk_bf16(v1[2], v1[3]);
                    *(u32x4*)(base + ((ai * 4 + m) * 2 + bj) * 512) = w; } }
    }
};
typedef int i32x8_t __attribute__((ext_vector_type(8)));
constexpr int PG8_PRM_OFF = STAGE_BYTES + 1024;
__device__ __forceinline__ void mma16(f32x4& c, const bf16x8& a, const bf16x8& b) { c = __builtin_amdgcn_mfma_f32_16x16x32_bf16(a, b, c, 0, 0, 0); }
__device__ __forceinline__ void mma16(i32x4_t& c, const bf16x8& a, const bf16x8& b) { c = __builtin_amdgcn_mfma_i32_16x16x64_i8(__builtin_bit_cast(i32x4_t, a), __builtin_bit_cast(i32x4_t, b), c, 0, 0, 0); }
template <int EB> struct AccOf { typedef f32x4 type; };
template <> struct AccOf<1> { typedef i32x4_t type; };
template <class Epi, class Sched, bool ALIGN_EPI = false, bool SP2 = false, int EB = 2>
__device__ __forceinline__ void gemm_phase(PG8_LAS unsigned char* lds, const Gemm g, const Sched& S, const Epi& E) {
    int tid_ = g.wv * 64 + lane_now(); asm volatile("" : "+v"(tid_));
    const int tid = tid_, wid = __builtin_amdgcn_readfirstlane(tid >> 6), lane = tid & 63, wr = wid >> 2, wc = wid & 3, fr = lane & 15, fq = lane >> 4;
    const int K = g.K, nt = K * EB / (2 * BK);
    unsigned voffA[2], voffB[2];
#pragma unroll
    for (int i = 0; i < 2; ++i) { int R, C; stage_rc(tid * 16 + i * 8192, R, C); const int Rb = Epi::PERM ? ((R & ~31) + perm32(R & 31)) : R;
        voffA[i] = (unsigned)(R * K * EB + 2 * C); voffB[i] = (unsigned)(Rb * K * EB + 2 * C); }
    const unsigned kstep = (unsigned)(BK * 2);
    const unsigned hstep = (unsigned)HALF * K * EB;
    const unsigned tstep = 2 * hstep;
    const unsigned ldsw = (unsigned)wid * 1024u;
    const int aoff = lds_byte(wr * 64 + fr, fq * 8), boff = lds_byte(wc * 32 + fr, fq * 8);
#define PG8_SA(b, h) (((b) * 2 + (h)) * HTB)
#define PG8_SB(b, h) ((4 + (b) * 2 + (h)) * HTB)
#define PG8_STAGE(bufoff, rsrc, soff, voff) do { _Pragma("unroll") for (int _i = 0; _i < 2; ++_i) \
        __builtin_amdgcn_raw_ptr_buffer_load_lds(rsrc, (PG8_LAS void*)(lds + (bufoff) + ldsw + _i * 8192), 16, (int)(voff)[_i], (int)(soff), 0, 0); } while (0)
#define PG8_LDA(dst, b, h) do { _Pragma("unroll") for (int m = 0; m < 4; ++m) _Pragma("unroll") for (int k = 0; k < 2; ++k) dst[m][k] = *(const PG8_LAS bf16x8*)(lds + PG8_SA(b, h) + aoff + m * 2048 + k * 1024); } while (0)
#define PG8_LDB(dst, b, h) do { _Pragma("unroll") for (int n = 0; n < 2; ++n) _Pragma("unroll") for (int k = 0; k < 2; ++k) dst[n][k] = *(const PG8_LAS bf16x8*)(lds + PG8_SB(b, h) + boff + n * 2048 + k * 1024); } while (0)
#define PG8_MMA(ai, bj, At, Bt) do { __builtin_amdgcn_s_setprio(1); _Pragma("unroll") for (int m = 0; m < 4; ++m) _Pragma("unroll") for (int n = 0; n < 2; ++n) _Pragma("unroll") for (int k = 0; k < 2; ++k) \
        mma16(acc[ai][bj][m][n], Bt[n][k], At[m][k]); __builtin_amdgcn_s_setprio(0); } while (0)
#define PG8_WAIT_V(n) asm volatile("s_waitcnt vmcnt(" #n ")" ::: "memory")
#define PG8_WAIT_L(n) asm volatile("s_waitcnt lgkmcnt(" #n ")" ::: "memory")
#define PG8_BAR __builtin_amdgcn_s_barrier()
#define PG8_SCHED __builtin_amdgcn_sched_barrier(0)
    Unit cur, nxt; int ui = 0;
    if (!S.next(0, cur)) return;
    typedef typename AccOf<EB>::type acc_t; acc_t acc[2][2][4][2];
#pragma unroll
    for (int a = 0; a < 2; ++a)
#pragma unroll
        for (int b = 0; b < 2; ++b)
#pragma unroll
            for (int m = 0; m < 4; ++m)
#pragma unroll
                for (int n = 0; n < 2; ++n) acc[a][b][m][n] = acc_t{};
    bf16x8 At[4][2], B0[2][2], B1[2][2];
    const __amdgpu_buffer_rsrc_t rA = __builtin_amdgcn_make_buffer_rsrc((void*)g.A, (short)0, -1, 0x00020000), rB = __builtin_amdgcn_make_buffer_rsrc((void*)g.Bt, (short)0, -1, 0x00020000);
    unsigned cA = g.same ? 0u : (unsigned)cur.pm * tstep, cB = g.same ? 0u : (unsigned)cur.pn * tstep;
    S.a_ready(cur);
    if constexpr (SP2) {
        PG8_STAGE(PG8_SB(0, 0), rB, cB, voffB); PG8_STAGE(PG8_SB(0, 1), rB, cB + hstep, voffB); PG8_STAGE(PG8_SA(0, 0), rA, cA, voffA); PG8_STAGE(PG8_SA(0, 1), rA, cA + hstep, voffA);
        if (wr == 1) PG8_BAR;
        PG8_WAIT_V(2); PG8_BAR;
        PG8_STAGE(PG8_SB(1, 0), rB, cB + kstep, voffB); PG8_STAGE(PG8_SA(1, 0), rA, cA + kstep, voffA); PG8_STAGE(PG8_SB(1, 1), rB, cB + hstep + kstep, voffB);
        PG8_WAIT_V(6); PG8_BAR;
    } else {
        PG8_STAGE(PG8_SB(0, 0), rB, cB, voffB); PG8_STAGE(PG8_SA(0, 0), rA, cA, voffA); PG8_STAGE(PG8_SB(0, 1), rB, cB + hstep, voffB); PG8_STAGE(PG8_SA(0, 1), rA, cA + hstep, voffA);
        if (wr == 1) PG8_BAR;
        PG8_WAIT_V(4); PG8_BAR;
        PG8_STAGE(PG8_SB(1, 0), rB, cB + kstep, voffB); PG8_STAGE(PG8_SA(1, 0), rA, cA + kstep, voffA); PG8_STAGE(PG8_SB(1, 1), rB, cB + hstep + kstep, voffB);
        PG8_WAIT_V(6); PG8_BAR;
    }
    for (;;) {
        const bool has_next = S.next(ui + 1, nxt);
        const unsigned nA = (has_next && !g.same) ? (unsigned)nxt.pm * tstep : cA, nB = (has_next && !g.same) ? (unsigned)nxt.pn * tstep : cB;
        for (int t = 0; t < nt; t += 2) {
            const bool last = (t == nt - 2);
            const unsigned a1 = cA + (unsigned)(t + 1) * kstep;
            const unsigned a2 = last ? nA : cA + (unsigned)(t + 2) * kstep, b2 = last ? nB : cB + (unsigned)(t + 2) * kstep;
            const unsigned a3 = a2 + kstep, b3 = b2 + kstep;
            if (last && has_next) S.a_ready(nxt);
            if constexpr (Epi::PREFETCH) { if (t == 0) E.prefetch(cur, lds + PG8_PRM_OFF + (ui & 1) * 4096, wid); }
            if constexpr (SP2) {
            PG8_LDB(B0, 0, 0); PG8_LDB(B1, 0, 1); PG8_SCHED; PG8_LDA(At, 0, 0); PG8_STAGE(PG8_SA(1, 1), rA, a1 + hstep, voffA);
            PG8_WAIT_V(8); PG8_WAIT_L(0); PG8_BAR; PG8_MMA(0, 0, At, B0); PG8_MMA(0, 1, At, B1); PG8_BAR; PG8_SCHED;
            PG8_LDA(At, 0, 1); PG8_STAGE(PG8_SB(0, 0), rB, b2, voffB); PG8_STAGE(PG8_SB(0, 1), rB, b2 + hstep, voffB); PG8_STAGE(PG8_SA(0, 0), rA, a2, voffA);
            PG8_WAIT_V(8); PG8_WAIT_L(0); PG8_BAR; PG8_MMA(1, 0, At, B0); PG8_MMA(1, 1, At, B1); PG8_BAR; PG8_SCHED;
            PG8_LDB(B0, 1, 0); PG8_LDB(B1, 1, 1); PG8_SCHED; PG8_LDA(At, 1, 0); PG8_STAGE(PG8_SA(0, 1), rA, a2 + hstep, voffA);
            PG8_WAIT_V(8); PG8_WAIT_L(0); PG8_BAR; PG8_MMA(0, 0, At, B0); PG8_MMA(0, 1, At, B1); PG8_BAR; PG8_SCHED;
            PG8_LDA(At, 1, 1); PG8_STAGE(PG8_SB(1, 0), rB, b3, voffB); PG8_STAGE(PG8_SB(1, 1), rB, b3 + hstep, voffB); PG8_STAGE(PG8_SA(1, 0), rA, a3, voffA);
            PG8_WAIT_V(8); PG8_WAIT_L(0); PG8_BAR; PG8_MMA(1, 0, At, B0); PG8_MMA(1, 1, At, B1); PG8_BAR; PG8_SCHED;
            } else {
            PG8_LDB(B0, 0, 0); PG8_SCHED; PG8_LDA(At, 0, 0); PG8_STAGE(PG8_SA(1, 1), rA, a1 + hstep, voffA);
            PG8_WAIT_L(8); PG8_BAR; PG8_WAIT_L(0); PG8_MMA(0, 0, At, B0); PG8_BAR; PG8_SCHED;
            PG8_LDB(B1, 0, 1); PG8_STAGE(PG8_SB(0, 0), rB, b2, voffB);
            PG8_BAR; PG8_WAIT_L(0); PG8_MMA(0, 1, At, B1); PG8_BAR;
            PG8_LDA(At, 0, 1); PG8_STAGE(PG8_SA(0, 0), rA, a2, voffA);
            PG8_BAR; PG8_WAIT_L(0); PG8_MMA(1, 0, At, B0); PG8_BAR; PG8_SCHED;
            PG8_STAGE(PG8_SB(0, 1), rB, b2 + hstep, voffB);
            PG8_WAIT_V(6); PG8_BAR; PG8_MMA(1, 1, At, B1); PG8_BAR;
            PG8_LDB(B0, 1, 0); PG8_SCHED; PG8_LDA(At, 1, 0); PG8_STAGE(PG8_SA(0, 1), rA, a2 + hstep, voffA);
            PG8_WAIT_L(8); PG8_BAR; PG8_WAIT_L(0); PG8_MMA(0, 0, At, B0); PG8_BAR; PG8_SCHED;
            PG8_LDB(B1, 1, 1); PG8_STAGE(PG8_SB(1, 0), rB, b3, voffB);
            PG8_BAR; PG8_WAIT_L(0); PG8_MMA(0, 1, At, B1); PG8_BAR;
            PG8_LDA(At, 1, 1); PG8_STAGE(PG8_SA(1, 0), rA, a3, voffA);
            PG8_BAR; PG8_WAIT_L(0); PG8_MMA(1, 0, At, B0); PG8_BAR; PG8_SCHED;
            PG8_STAGE(PG8_SB(1, 1), rB, b3 + hstep, voffB);
            PG8_WAIT_V(6); PG8_BAR; PG8_MMA(1, 1, At, B1); PG8_BAR;
            }
        }
        if constexpr (ALIGN_EPI) { if (wr == 0) PG8_BAR; }
        if constexpr (!Epi::AFTER_DRAIN) { int ln_ = (int)__builtin_amdgcn_mbcnt_hi(~0u, __builtin_amdgcn_mbcnt_lo(~0u, 0u)); asm volatile("" : "+v"(ln_));
            E(acc, cur, wr, wc, ln_ & 15, ln_ >> 4, lds + PG8_PRM_OFF + (ui & 1) * 4096); S.done(cur); }
        if (!has_next) break;
#pragma unroll
        for (int a = 0; a < 2; ++a)
#pragma unroll
            for (int b = 0; b < 2; ++b)
#pragma unroll
                for (int m = 0; m < 4; ++m)
#pragma unroll
                    for (int n = 0; n < 2; ++n) acc[a][b][m][n] = acc_t{};
        cur = nxt; cA = nA; cB = nB; ++ui;
        if constexpr (ALIGN_EPI) { if (wr == 1) PG8_BAR; }
    }
    PG8_WAIT_V(0);
    if constexpr (!ALIGN_EPI) { if (wr == 0) PG8_BAR; }
    PG8_BAR;
    if constexpr (Epi::AFTER_DRAIN) { E.fused(acc, cur, wr, wc, fr, fq, lds, wid, lane); S.done(cur); }
#undef PG8_SA
#undef PG8_SB
#undef PG8_STAGE
#undef PG8_LDA
#undef PG8_LDB
#undef PG8_MMA
#undef PG8_WAIT_V
#undef PG8_WAIT_L
#undef PG8_BAR
#undef PG8_SCHED
}
template <class Epi, class Sched, bool ALIGN_EPI = false, bool SP2 = false>
__device__ __forceinline__ void gemm_phase_f8(PG8_LAS unsigned char* lds, const Gemm g, const Sched& S, const Epi& E) {
    int tid_ = g.wv * 64 + lane_now(); asm volatile("" : "+v"(tid_));
    const int tid = tid_, wid = __builtin_amdgcn_readfirstlane(tid >> 6), lane = tid & 63, wr = wid >> 2, wc = wid & 3, fr = lane & 15, fq = lane >> 4;
    const int K = g.K, nt = K / (2 * BK);
    unsigned voffA[2], voffB[2];
#pragma unroll
    for (int i = 0; i < 2; ++i) { int R, C; stage_rc(tid * 16 + i * 8192, R, C); const int Rb = Epi::PERM ? ((R & ~31) + perm32(R & 31)) : R;
        voffA[i] = (unsigned)(R * K + 2 * C); voffB[i] = (unsigned)(Rb * K + 2 * C); }
    const unsigned kstep = (unsigned)(BK * 2);
    const unsigned hstep = (unsigned)HALF * K;
    const unsigned tstep = 2 * hstep;
    const unsigned ldsw = (unsigned)wid * 1024u;
    const int aoff = lds_byte(wr * 64 + fr, fq * 16) ^ ((fq & 1) << 4), boff = lds_byte(wc * 32 + fr, fq * 16) ^ ((fq & 1) << 4), aoff2 = aoff ^ 16, boff2 = boff ^ 16;
#define PG8_SA(b, h) (((b) * 2 + (h)) * HTB)
#define PG8_SB(b, h) ((4 + (b) * 2 + (h)) * HTB)
#define PG8_STAGE(bufoff, rsrc, soff, voff) do { _Pragma("unroll") for (int _i = 0; _i < 2; ++_i) \
        __builtin_amdgcn_raw_ptr_buffer_load_lds(rsrc, (PG8_LAS void*)(lds + (bufoff) + ldsw + _i * 8192), 16, (int)(voff)[_i], (int)(soff), 0, 0); } while (0)
#define PG8_LDA(dst, b, h) do { _Pragma("unroll") for (int m = 0; m < 4; ++m) { const i32x4_t lo_ = *(const PG8_LAS i32x4_t*)(lds + PG8_SA(b, h) + aoff + m * 2048), hi_ = *(const PG8_LAS i32x4_t*)(lds + PG8_SA(b, h) + aoff2 + m * 2048); dst[m] = __builtin_shufflevector(lo_, hi_, 0, 1, 2, 3, 4, 5, 6, 7); } } while (0)
#define PG8_LDB(dst, b, h) do { _Pragma("unroll") for (int n = 0; n < 2; ++n) { const i32x4_t lo_ = *(const PG8_LAS i32x4_t*)(lds + PG8_SB(b, h) + boff + n * 2048), hi_ = *(const PG8_LAS i32x4_t*)(lds + PG8_SB(b, h) + boff2 + n * 2048); dst[n] = __builtin_shufflevector(lo_, hi_, 0, 1, 2, 3, 4, 5, 6, 7); } } while (0)
#define PG8_F8CAT(lo, hi) __builtin_shufflevector(__builtin_bit_cast(i32x4_t, lo), __builtin_bit_cast(i32x4_t, hi), 0, 1, 2, 3, 4, 5, 6, 7)
#define PG8_MMA(ai, bj, At, Bt) do { __builtin_amdgcn_s_setprio(1); _Pragma("unroll") for (int m = 0; m < 4; ++m) _Pragma("unroll") for (int n = 0; n < 2; ++n) \
        acc[ai][bj][m][n] = __builtin_amdgcn_mfma_scale_f32_16x16x128_f8f6f4(Bt[n], At[m], acc[ai][bj][m][n], 0, 0, 0, 0, 0, 0); __builtin_amdgcn_s_setprio(0); } while (0)
#define PG8_WAIT_V(n) asm volatile("s_waitcnt vmcnt(" #n ")" ::: "memory")
#define PG8_WAIT_L(n) asm volatile("s_waitcnt lgkmcnt(" #n ")" ::: "memory")
#define PG8_BAR __builtin_amdgcn_s_barrier()
#define PG8_SCHED __builtin_amdgcn_sched_barrier(0)
    Unit cur, nxt; int ui = 0;
    if (!S.next(0, cur)) return;
    f32x4 acc[2][2][4][2];
#pragma unroll
    for (int a = 0; a < 2; ++a)
#pragma unroll
        for (int b = 0; b < 2; ++b)
#pragma unroll
            for (int m = 0; m < 4; ++m)
#pragma unroll
                for (int n = 0; n < 2; ++n) acc[a][b][m][n] = (f32x4){0.f, 0.f, 0.f, 0.f};
    i32x8_t At[4], B0[2], B1[2];
    const __amdgpu_buffer_rsrc_t rA = __builtin_amdgcn_make_buffer_rsrc((void*)g.A, (short)0, -1, 0x00020000), rB = __builtin_amdgcn_make_buffer_rsrc((void*)g.Bt, (short)0, -1, 0x00020000);
    unsigned cA = g.same ? 0u : (unsigned)cur.pm * tstep, cB = g.same ? 0u : (unsigned)cur.pn * tstep;
    S.a_ready(cur);
    if constexpr (SP2) {
        PG8_STAGE(PG8_SB(0, 0), rB, cB, voffB); PG8_STAGE(PG8_SB(0, 1), rB, cB + hstep, voffB); PG8_STAGE(PG8_SA(0, 0), rA, cA, voffA); PG8_STAGE(PG8_SA(0, 1), rA, cA + hstep, voffA);
        if (wr == 1) PG8_BAR;
        PG8_WAIT_V(2); PG8_BAR;
        PG8_STAGE(PG8_SB(1, 0), rB, cB + kstep, voffB); PG8_STAGE(PG8_SA(1, 0), rA, cA + kstep, voffA); PG8_STAGE(PG8_SB(1, 1), rB, cB + hstep + kstep, voffB);
        PG8_WAIT_V(6); PG8_BAR;
    } else {
        PG8_STAGE(PG8_SB(0, 0), rB, cB, voffB); PG8_STAGE(PG8_SA(0, 0), rA, cA, voffA); PG8_STAGE(PG8_SB(0, 1), rB, cB + hstep, voffB); PG8_STAGE(PG8_SA(0, 1), rA, cA + hstep, voffA);
        if (wr == 1) PG8_BAR;
        PG8_WAIT_V(4); PG8_BAR;
        PG8_STAGE(PG8_SB(1, 0), rB, cB + kstep, voffB); PG8_STAGE(PG8_SA(1, 0), rA, cA + kstep, voffA); PG8_STAGE(PG8_SB(1, 1), rB, cB + hstep + kstep, voffB);
        PG8_WAIT_V(6); PG8_BAR;
    }
    for (;;) {
        const bool has_next = S.next(ui + 1, nxt);
        const unsigned nA = (has_next && !g.same) ? (unsigned)nxt.pm * tstep : cA, nB = (has_next && !g.same) ? (unsigned)nxt.pn * tstep : cB;
        for (int t = 0; t < nt; t += 2) {
            const bool last = (t == nt - 2);
            const unsigned a1 = cA + (unsigned)(t + 1) * kstep;
            const unsigned a2 = last ? nA : cA + (unsigned)(t + 2) * kstep, b2 = last ? nB : cB + (unsigned)(t + 2) * kstep;
            const unsigned a3 = a2 + kstep, b3 = b2 + kstep;
            if (last && has_next) S.a_ready(nxt);
            if constexpr (Epi::PREFETCH) { if (t == 0) E.prefetch(cur, lds + PG8_PRM_OFF + (ui & 1) * 4096, wid); }
            if constexpr (SP2) {
            PG8_LDB(B0, 0, 0); PG8_LDB(B1, 0, 1); PG8_SCHED; PG8_LDA(At, 0, 0); PG8_STAGE(PG8_SA(1, 1), rA, a1 + hstep, voffA);
            PG8_WAIT_V(8); PG8_WAIT_L(0); PG8_BAR; PG8_MMA(0, 0, At, B0); PG8_MMA(0, 1, At, B1); PG8_BAR; PG8_SCHED;
            PG8_LDA(At, 0, 1); PG8_STAGE(PG8_SB(0, 0), rB, b2, voffB); PG8_STAGE(PG8_SB(0, 1), rB, b2 + hstep, voffB); PG8_STAGE(PG8_SA(0, 0), rA, a2, voffA);
            PG8_WAIT_V(8); PG8_WAIT_L(0); PG8_BAR; PG8_MMA(1, 0, At, B0); PG8_MMA(1, 1, At, B1); PG8_BAR; PG8_SCHED;
            PG8_LDB(B0, 1, 0); PG8_LDB(B1, 1, 1); PG8_SCHED; PG8_LDA(At, 1, 0); PG8_STAGE(PG8_SA(0, 1), rA, a2 + hstep, voffA);
            PG8_WAIT_V(8); PG8_WAIT_L(0); PG8_BAR; PG8_MMA(0, 0, At, B0); PG8_MMA(0, 1, At, B1); PG8_BAR; PG8_SCHED;
            PG8_LDA(At, 1, 1); PG8_STAGE(PG8_SB(1, 0), rB, b3, voffB); PG8_STAGE(PG8_SB(1, 1), rB, b3 + hstep, voffB); PG8_STAGE(PG8_SA(1, 0), rA, a3, voffA);
            PG8_WAIT_V(8); PG8_WAIT_L(0); PG8_BAR; PG8_MMA(1, 0, At, B0); PG8_MMA(1, 1, At, B1); PG8_BAR; PG8_SCHED;
            } else {
            PG8_LDB(B0, 0, 0); PG8_SCHED; PG8_LDA(At, 0, 0); PG8_STAGE(PG8_SA(1, 1), rA, a1 + hstep, voffA);
            PG8_WAIT_L(8); PG8_BAR; PG8_WAIT_L(0); PG8_MMA(0, 0, At, B0); PG8_BAR; PG8_SCHED;
            PG8_LDB(B1, 0, 1); PG8_STAGE(PG8_SB(0, 0), rB, b2, voffB);
            PG8_BAR; PG8_WAIT_L(0); PG8_MMA(0, 1, At, B1); PG8_BAR;
            PG8_LDA(At, 0, 1); PG8_STAGE(PG8_SA(0, 0), rA, a2, voffA);
            PG8_BAR; PG8_WAIT_L(0); PG8_MMA(1, 0, At, B0); PG8_BAR; PG8_SCHED;
            PG8_STAGE(PG8_SB(0, 1), rB, b2 + hstep, voffB);
            PG8_WAIT_V(6); PG8_BAR; PG8_MMA(1, 1, At, B1); PG8_BAR;
            PG8_LDB(B0, 1, 0); PG8_SCHED; PG8_LDA(At, 1, 0); PG8_STAGE(PG8_SA(0, 1), rA, a2 + hstep, voffA);
            PG8_WAIT_L(8); PG8_BAR; PG8_WAIT_L(0); PG8_MMA(0, 0, At, B0); PG8_BAR; PG8_SCHED;
            PG8_LDB(B1, 1, 1); PG8_STAGE(PG8_SB(1, 0), rB, b3, voffB);
            PG8_BAR; PG8_WAIT_L(0); PG8_MMA(0, 1, At, B1); PG8_BAR;
            PG8_LDA(At, 1, 1); PG8_STAGE(PG8_SA(1, 0), rA, a3, voffA);
            PG8_BAR; PG8_WAIT_L(0); PG8_MMA(1, 0, At, B0); PG8_BAR; PG8_SCHED;
            PG8_STAGE(PG8_SB(1, 1), rB, b3 + hstep, voffB);
            PG8_WAIT_V(6); PG8_BAR; PG8_MMA(1, 1, At, B1); PG8_BAR;
            }
        }
        if constexpr (ALIGN_EPI) { if (wr == 0) PG8_BAR; }
        if constexpr (!Epi::AFTER_DRAIN) { int ln_ = (int)__builtin_amdgcn_mbcnt_hi(~0u, __builtin_amdgcn_mbcnt_lo(~0u, 0u)); asm volatile("" : "+v"(ln_));
            E(acc, cur, wr, wc, ln_ & 15, ln_ >> 4, lds + PG8_PRM_OFF + (ui & 1) * 4096); S.done(cur); }
        if (!has_next) break;
#pragma unroll
        for (int a = 0; a < 2; ++a)
#pragma unroll
            for (int b = 0; b < 2; ++b)
#pragma unroll
                for (int m = 0; m < 4; ++m)
#pragma unroll
                    for (int n = 0; n < 2; ++n) acc[a][b][m][n] = (f32x4){0.f, 0.f, 0.f, 0.f};
        cur = nxt; cA = nA; cB = nB; ++ui;
        if constexpr (ALIGN_EPI) { if (wr == 1) PG8_BAR; }
    }
    PG8_WAIT_V(0);
    if constexpr (!ALIGN_EPI) { if (wr == 0) PG8_BAR; }
    PG8_BAR;
    if constexpr (Epi::AFTER_DRAIN) { E.fused(acc, cur, wr, wc, fr, fq, lds, wid, lane); S.done(cur); }
#undef PG8_SA
#undef PG8_SB
#undef PG8_STAGE
#undef PG8_LDA
#undef PG8_LDB
#undef PG8_MMA
#undef PG8_WAIT_V
#undef PG8_WAIT_L
#undef PG8_BAR
#undef PG8_SCHED
#undef PG8_F8CAT
}
}

constexpr int NWAVES = 8, NTHR = NWAVES * 64;
constexpr int BATCH = 8, SEQ = 2048, DM = 2048, DEPTH = 2, HD = 64, GW = 512, NH = 8;
constexpr int M = BATCH * SEQ;
constexpr int NPROJ = 6080, NPROJ_P = 6144, DFF = 5632;
constexpr int CA_Q = 0, CA_K = 512, CA_V = 1024, CB_U = 1536, CB_V = 2048, CC_Q = 2560, CC_K = 3072, CC_V = 3584, CD = 4096;
constexpr int D_R = 0, D_WD = 512, D_K = 608, D_V = 1120, D_AD = 1632, D_GD = 1728, D_W = 1984;
constexpr float NORM_EPS = 1e-6f;
#ifndef N_LAUNCH_MODE
#define N_LAUNCH_MODE 0
#endif
#ifndef PG8_SP2
#define PG8_SP2 true
#endif
#ifndef FFN_FP8
#define FFN_FP8 1
#endif
#ifndef REPEAT
#define REPEAT 0
#endif
#ifndef GEMM_I8
#define GEMM_I8 3
#endif
#ifndef BFMASK
#define BFMASK 0x003C0Fu
#endif
#ifndef FFN1_I8
#define FFN1_I8 1
#endif
#define I8_IN ((GEMM_I8 & 1) != 0)
#define I8_OUT ((GEMM_I8 & 2) != 0)
constexpr int N_PHASES = 20;

constexpr size_t MiB = 1u << 20;
constexpr size_t WS_CTL = 0, CTL_ZERO_BYTES = 2 * MiB;
constexpr size_t WS_WIN = 2 * MiB, WS_WOUT = 26 * MiB, WS_WGU = 34 * MiB, WS_WDN = 78 * MiB, WS_SMALL = 100 * MiB;
constexpr size_t WS_XB = 104 * MiB, WS_PROJ = 168 * MiB, WS_YCAT = 360 * MiB, WS_SC2 = 424 * MiB, WS_YD = 456 * MiB, WS_G = 488 * MiB, WS_BC = 504 * MiB, WS_END = 506 * MiB;
constexpr size_t WS_XQ = WS_YD, WS_YQ = WS_PROJ;
constexpr size_t SC_ARR = (size_t)M * GW * 2;
constexpr size_t SM_TB = 0;
constexpr size_t SM_KBAR = 64 * 1024;
constexpr size_t SM_STATS = 256 * 1024;
constexpr size_t SM_SAX = 2048 * 1024, SM_SAY = SM_SAX + 64 * 1024;
constexpr size_t SM_SWIN = SM_SAY + 64 * 1024, SM_SWOUT = SM_SWIN + 32 * 1024, SM_SWGU = SM_SWOUT + 16 * 1024;
constexpr size_t SM_BIAS = 3072 * 1024;
constexpr size_t SM_WT = 1024 * 1024;
constexpr int CW_BAR = 4096;
constexpr int CW_Q = 8192;
constexpr int CW_SSQ = 65536;
constexpr size_t CTL_KBAR = 1024 * 1024;
constexpr size_t CTL_STATS = 1280 * 1024;
static_assert((size_t)CW_SSQ * 4 + 5 * (size_t)M * 8 <= CTL_KBAR && CTL_STATS + 2 * (size_t)M * 2 * 8 <= CTL_ZERO_BYTES, "CTL");

constexpr int RING_OFF = 0, RING_BYTES = 131072;
constexpr int LDS_BYTES = 163840, MISC_OFF = LDS_BYTES - 256;

#define GAS __attribute__((address_space(1)))
#define LAS __attribute__((address_space(3)))
typedef unsigned short bf16;
typedef unsigned v4u __attribute__((ext_vector_type(4)));
typedef unsigned v2u __attribute__((ext_vector_type(2)));
typedef float f32x4 __attribute__((ext_vector_type(4)));
typedef short bf16x8 __attribute__((ext_vector_type(8)));
typedef float f32x16 __attribute__((ext_vector_type(16)));
typedef GAS unsigned gu32;
#define RLX_AGENT __ATOMIC_RELAXED, __HIP_MEMORY_SCOPE_AGENT
#define LDS_WAIT() asm volatile("s_waitcnt lgkmcnt(0)" ::: "memory")
#define VM_WAIT() asm volatile("s_waitcnt vmcnt(0)" ::: "memory")
__device__ __forceinline__ unsigned f2bf(float f) { unsigned u = __builtin_bit_cast(unsigned, f); return (u + 0x7fffu + ((u >> 16) & 1u)) >> 16; }
__device__ __forceinline__ unsigned pk2(float lo, float hi) { return f2bf(lo) | (f2bf(hi) << 16); }
__device__ __forceinline__ float bf2f(unsigned short h) { return __builtin_bit_cast(float, (unsigned)h << 16); }
__device__ __forceinline__ float bflo(unsigned w) { return __builtin_bit_cast(float, w << 16); }
__device__ __forceinline__ float bfhi(unsigned w) { return __builtin_bit_cast(float, w & 0xffff0000u); }
__device__ __forceinline__ float sigmoidf_(float x) { return 1.0f / (1.0f + __expf(-x)); }
__device__ __forceinline__ float gelu_tanh(float x) { const float u = 0.7978845608028654f * (x + 0.044715f * x * x * x); const float e = __expf(2.0f * u); const float th = 1.0f - 2.0f / (e + 1.0f); return 0.5f * x * (1.0f + th); }
__device__ __forceinline__ float wave_sum(float v) {
#pragma unroll
    for (int o = 1; o < 64; o <<= 1) v += __shfl_xor(v, o);
    return v;
}

__device__ __forceinline__ float zero_v() { float z = 0.f; asm volatile("" : "+v"(z)); return z; }

__device__ __forceinline__ unsigned q8pack4(float a, float b, float c, float d, float inv) {
    const int ia = (int)__builtin_rintf(a * inv), ib = (int)__builtin_rintf(b * inv), ic = (int)__builtin_rintf(c * inv), id = (int)__builtin_rintf(d * inv);
    return ((unsigned)ia & 0xffu) | (((unsigned)ib & 0xffu) << 8) | (((unsigned)ic & 0xffu) << 16) | ((unsigned)id << 24); }
__device__ __forceinline__ float wave_max(float v) {
#pragma unroll
    for (int o = 1; o < 64; o <<= 1) v = fmaxf(v, __shfl_xor(v, o));
    return v;
}
#define UNPACK8(dst, o, W_) do { dst[(o)] = bflo((W_).x); dst[(o) + 1] = bfhi((W_).x); dst[(o) + 2] = bflo((W_).y); dst[(o) + 3] = bfhi((W_).y); dst[(o) + 4] = bflo((W_).z); dst[(o) + 5] = bfhi((W_).z); dst[(o) + 6] = bflo((W_).w); dst[(o) + 7] = bfhi((W_).w); } while (0)
#define XB_TMO      128
#define XB_XCNT(j)  (256  + 64 * (j))
#define XB_XSUB(j)  (1280 + 64 * (j))
#define XB_XGEN(j)  (2304 + 64 * (j))
#define XB_TOP      3328
#define XB_TOPGEN   3392
#define XCD_BAR_WORDS 3456
#define XB_SPIN_CAP (1u << 18)

__device__ __forceinline__ unsigned xb_ld(unsigned* p)              { return __hip_atomic_load(p, __ATOMIC_RELAXED, __HIP_MEMORY_SCOPE_AGENT); }
__device__ __forceinline__ unsigned xb_add(unsigned* p, unsigned v) { return __hip_atomic_fetch_add(p, v, __ATOMIC_RELAXED, __HIP_MEMORY_SCOPE_AGENT); }
__device__ __forceinline__ unsigned xb_xcc_id() { return (unsigned)__builtin_amdgcn_s_getreg((3 << 11) | 20) & 0xFu; }
#define XB_SPIN(cond, bar) do { unsigned _sp = 0; while (cond) { __builtin_amdgcn_s_sleep(1); \
    if ((++_sp & 255u) == 0u) { if (xb_ld(&(bar)[XB_TMO])) break; if (_sp > XB_SPIN_CAP) { atomicAdd(&(bar)[XB_TMO], 1u); break; } } } } while (0)

struct XcdBarrier {
    unsigned* bar; unsigned x; int wv;
    volatile LAS unsigned* st;
};

__device__ __forceinline__ XcdBarrier xcd_barrier_post(unsigned* bar, volatile LAS unsigned* st, int wv) {
    XcdBarrier b; b.bar = bar; b.x = xb_xcc_id(); b.st = st; b.wv = wv;
    if (wv == 0 && pg8::lane_now() == 0) (void)xb_add(&bar[XB_XCNT(b.x)], 1u);
    return b;
}
__device__ __forceinline__ void xcd_barrier_complete(unsigned* bar, unsigned x, unsigned& nloc, unsigned& nx) {
    const unsigned G = gridDim.x * gridDim.y * gridDim.z;
    unsigned sum, cnt, mine, sp = 0u;
    for (;;) {
        sum = 0u; cnt = 0u; mine = 0u;
#pragma unroll
        for (unsigned j = 0; j < 16; ++j) { const unsigned c = xb_ld(&bar[XB_XCNT(j)]); sum += c; cnt += (c > 0u) ? 1u : 0u; mine = (j == x) ? c : mine; }
        if (sum == G) break;
        __builtin_amdgcn_s_sleep(1);
        if ((++sp & 255u) == 0u) { if (xb_ld(&bar[XB_TMO])) break; if (sp > XB_SPIN_CAP) { atomicAdd(&bar[XB_TMO], 1u); break; } }
    }
    nloc = mine > 0u ? mine : 1u; nx = cnt > 0u ? cnt : 1u;
}

__device__ __forceinline__ void xcd_barrier(const XcdBarrier& b) {
    asm volatile("s_waitcnt vmcnt(0)" ::: "memory");
    __syncthreads();
    if (b.wv == 0 && pg8::lane_now() == 0) {
        unsigned* bar = b.bar;
        __builtin_amdgcn_s_waitcnt(0);
        unsigned nloc = b.st[0], nx = b.st[1];
        if (nloc == 0u) { xcd_barrier_complete(bar, b.x, nloc, nx); b.st[0] = nloc; b.st[1] = nx; }
        const unsigned old = xb_add(&bar[XB_XSUB(b.x)], 1u);
        const unsigned gen = old / nloc;
        if (old + 1u == (gen + 1u) * nloc) {
            __builtin_amdgcn_fence(__ATOMIC_RELEASE, "agent");
            asm volatile("s_waitcnt vmcnt(0)" ::: "memory");
            const unsigned og = xb_add(&bar[XB_TOP], 1u);
            const unsigned tg = og / nx;
            if (og + 1u == (tg + 1u) * nx) xb_add(&bar[XB_TOPGEN], 1u);
            else XB_SPIN(xb_ld(&bar[XB_TOPGEN]) == tg, bar);
            __builtin_amdgcn_fence(__ATOMIC_ACQUIRE, "agent");
            xb_add(&bar[XB_XGEN(b.x)], 1u);
            asm volatile("s_waitcnt vmcnt(0)" ::: "memory");
        } else {
            XB_SPIN(xb_ld(&bar[XB_XGEN(b.x)]) == gen, bar);
            __builtin_amdgcn_fence(__ATOMIC_ACQUIRE, "agent");
            asm volatile("s_waitcnt vmcnt(0)" ::: "memory");
        }
    }
    __syncthreads();
}

struct Args { const float* in[25]; float* out; unsigned char* ws; int ph_lo, ph_hi; };
struct Frame {
    LAS unsigned char* lds; int tid, lane, wave, G, vcu, gw, ngw;
};
typedef const __attribute__((address_space(4))) unsigned long long* karg_t;
__device__ __forceinline__ karg_t kargs() { karg_t ka = (karg_t)__builtin_amdgcn_kernarg_segment_ptr(); asm volatile("" : "+s"(ka)); return ka; }
__device__ __forceinline__ const float* inp(int i) { return (const float*)(const GAS float*)kargs()[i]; }
__device__ __forceinline__ float* outp() { return (float*)(GAS float*)kargs()[25]; }
__device__ __forceinline__ unsigned char* wsp() { return (unsigned char*)(GAS unsigned char*)kargs()[26]; }
__device__ __forceinline__ gu32* ctlp() { return (gu32*)(wsp() + WS_CTL); }

__device__ __forceinline__ void conv_item(const float* W, int K, int N, const float* g, bf16* WT, int kind, LAS float* scr, int item, int lane, int ncols = 0) {
    const int nblk = (ncols ? ncols : N) / 32, kb = item / nblk, nb = item % nblk, k0 = 64 * kb, n0 = 32 * nb;
    float ld[32];
    { const float* wp = W + (size_t)(k0 + (lane >> 5)) * N + n0 + (lane & 31);
#pragma unroll
      for (int i = 0; i < 32; ++i) ld[i] = wp[(size_t)(2 * i) * N]; }
    if (g) { const float* gp = g + k0 + (lane >> 5);
#pragma unroll
      for (int i = 0; i < 32; ++i) ld[i] *= gp[2 * i]; }
#pragma unroll
    for (int i = 0; i < 32; ++i) scr[(2 * i + (lane >> 5)) * 33 + (lane & 31)] = ld[i];
    LDS_WAIT(); asm volatile("" ::: "memory");
    const int c = lane & 7;
#pragma unroll
    for (int j = 0; j < 4; ++j) { const int n = (lane >> 3) + 8 * j; const LAS float* s = scr + (8 * c) * 33 + n;
        v4u o; o.x = pk2(s[0 * 33], s[1 * 33]); o.y = pk2(s[2 * 33], s[3 * 33]); o.z = pk2(s[4 * 33], s[5 * 33]); o.w = pk2(s[6 * 33], s[7 * 33]);
        const int nn = n0 + n;
        if (kind >= 3) {
            const int row = kind == 5 ? nn : ((nn >> 7) * 256 + (kind - 3) * 128 + (nn & 127)); int f0 = (int)o.x, f1 = (int)o.y;
            f0 = __builtin_amdgcn_cvt_pk_fp8_f32(64.f * s[0 * 33], 64.f * s[1 * 33], f0, false); f0 = __builtin_amdgcn_cvt_pk_fp8_f32(64.f * s[2 * 33], 64.f * s[3 * 33], f0, true);
            f1 = __builtin_amdgcn_cvt_pk_fp8_f32(64.f * s[4 * 33], 64.f * s[5 * 33], f1, false); f1 = __builtin_amdgcn_cvt_pk_fp8_f32(64.f * s[6 * 33], 64.f * s[7 * 33], f1, true);
            *(GAS v2u*)((unsigned char*)WT + (size_t)row * K + k0 + 8 * c) = (v2u){(unsigned)f0, (unsigned)f1};
        } else {
        const int row = kind == 0 ? nn : ((nn >> 7) * 256 + (kind - 1) * 128 + (nn & 127));
        *(GAS v4u*)(WT + (size_t)row * K + k0 + 8 * c) = o; } }
    LDS_WAIT(); asm volatile("" ::: "memory");
}
__device__ __forceinline__ void conv_cols_i8(const float* W, int K, int N, const float* g, unsigned char* WQ, float* SW, int nb, Frame& F, int orow0 = -1) {
    constexpr int CC_PITCH = 2 * DM + 16;
    LAS unsigned char* T = F.lds + RING_OFF; LAS float* red = (LAS float*)(F.lds + RING_OFF + 32 * CC_PITCH);
    static_assert(32 * CC_PITCH + 1024 <= MISC_OFF, "conv LDS");
    const int n0 = 32 * nb, lane = F.lane, nkb = K / 64, o0 = orow0 < 0 ? n0 : orow0;
    const float* wp0 = W + (size_t)(lane >> 5) * N + n0 + (lane & 31);
    float mx = 0.f;
    for (int kb = F.wave; kb < nkb; kb += NWAVES) {
        const float* wp = wp0 + (size_t)(64 * kb) * N; const float* gp = g + 64 * kb + (lane >> 5);
        float ld[32];
#pragma unroll
        for (int i = 0; i < 32; ++i) ld[i] = wp[(size_t)(2 * i) * N];
        LAS unsigned char* tp = T + (lane & 31) * CC_PITCH + 2 * (64 * kb + (lane >> 5));
#pragma unroll
        for (int i = 0; i < 32; ++i) { const unsigned h = f2bf(ld[i] * gp[2 * i]); mx = fmaxf(mx, fabsf(__builtin_bit_cast(float, h << 16))); *(LAS unsigned short*)(tp + 4 * i) = (unsigned short)h; }
    }
    mx = fmaxf(mx, __shfl_xor(mx, 32));
    if (lane < 32) red[F.wave * 32 + lane] = mx;
    __syncthreads();
#pragma unroll
    for (int j = 0; j < 4; ++j) { const int n = 4 * F.wave + j;
        float cm = 0.f;
#pragma unroll
        for (int w = 0; w < NWAVES; ++w) cm = fmaxf(cm, red[w * 32 + n]);
        const float inv = cm > 0.f ? 127.0f / cm : 0.f;
        if (lane == 0) SW[o0 + n] = cm * (1.0f / 127.0f);
        const LAS unsigned char* tr = T + n * CC_PITCH + 16 * lane; unsigned char* wq = WQ + (size_t)(o0 + n) * K + 8 * lane;
#pragma unroll
        for (int it = 0; it < 4; ++it) { const v4u w = *(const LAS v4u*)(tr + 1024 * it);
            *(GAS v2u*)(wq + 512 * it) = (v2u){q8pack4(bflo(w.x), bfhi(w.x), bflo(w.y), bfhi(w.y), inv), q8pack4(bflo(w.z), bfhi(w.z), bflo(w.w), bfhi(w.w), inv)}; }
    }
    __syncthreads();
}
__device__ __forceinline__ void conv_layer_items(Frame& F, int l, int gw, int ngw, bool do_in, bool do_rest) {
    LAS float* scr = (LAS float*)(F.lds + RING_OFF + F.wave * 16384);
    constexpr int I_IN = (DM / 64) * (NPROJ / 32), I_OUT = (DM / 64) * (DM / 32), I_G = (DM / 64) * (DFF / 32), I_D = (DFF / 64) * (DM / 32);
    const float* w_in = inp(2) + (size_t)l * DM * NPROJ; const float* w_out = inp(19) + (size_t)l * DM * DM;
    const float* w_g = inp(21) + (size_t)l * DM * DFF; const float* w_u = inp(22) + (size_t)l * DM * DFF; const float* w_d = inp(23) + (size_t)l * DFF * DM;
    const float* g_mix = inp(1) + l * DM; const float* g_br = inp(18) + l * DM; const float* g_ffn = inp(20) + l * DM;
    bf16* WIN = (bf16*)(wsp() + WS_WIN); bf16* WOUT = (bf16*)(wsp() + WS_WOUT); bf16* WGU = (bf16*)(wsp() + WS_WGU); bf16* WDN = (bf16*)(wsp() + WS_WDN);
    if (do_in) {
        for (int it = gw; it < I_IN; it += ngw) conv_item(w_in, DM, NPROJ, g_mix, WIN, 0, scr, it, F.lane);
    }
    if (do_rest) {
        for (int it = gw; it < (I8_OUT ? 0 : I_OUT) + (FFN1_I8 ? 0 : 2 * I_G) + I_D; it += ngw) {
            int r = it + (I8_OUT ? I_OUT : 0); if (FFN1_I8 && r >= I_OUT) r += 2 * I_G;
            if (r < I_OUT) { conv_item(w_out, DM, DM, g_br, WOUT, 0, scr, r, F.lane); continue; } r -= I_OUT;
            if (r < I_G) { conv_item(w_g, DM, DFF, g_ffn, WGU, FFN_FP8 ? 3 : 1, scr, r, F.lane); continue; } r -= I_G;
            if (r < I_G) { conv_item(w_u, DM, DFF, g_ffn, WGU, FFN_FP8 ? 4 : 2, scr, r, F.lane); continue; } r -= I_G;
            conv_item(w_d, DFF, DM, nullptr, WDN, FFN_FP8 ? 5 : 0, scr, r, F.lane);
        }
    }
}

constexpr int WINB_NB = 8 * __builtin_popcount(BFMASK), WINB_ITEMS = (DM / 64) * WINB_NB;
__device__ __forceinline__ bf16* winb_ptr() { return (bf16*)outp() + (size_t)6 * M * GW; }
__device__ __forceinline__ void conv_winb(Frame& F, int l, int item) {
    if (item >= WINB_ITEMS) return;
    const int kb = item / (WINB_NB ? WINB_NB : 1), r = item % (WINB_NB ? WINB_NB : 1); unsigned m = BFMASK; for (int j = 0; j < (r >> 3); ++j) m &= m - 1;
    conv_item(inp(2) + (size_t)l * DM * NPROJ, DM, NPROJ, inp(1) + l * DM, winb_ptr(), 0, (LAS float*)(F.lds + RING_OFF + F.wave * 16384), kb * (NPROJ / 32) + __builtin_ctz(m) * 8 + (r & 7), F.lane);
}
__device__ __forceinline__ void ph_prologue(Frame& F) {
    if (I8_IN) {
        for (int nb = blockIdx.x; nb < NPROJ / 32; nb += F.G) conv_cols_i8(inp(2), DM, NPROJ, inp(1), wsp() + WS_WIN, (float*)(wsp() + WS_SMALL + SM_SWIN), nb, F);
        unsigned char* WIN = wsp() + WS_WIN; float* SWIN = (float*)(wsp() + WS_SMALL + SM_SWIN);
        for (int i = F.gw * 64 + F.lane; i < 64 * DM / 16; i += F.ngw * 64) *(GAS v4u*)(WIN + (size_t)NPROJ * DM + (size_t)i * 16) = (v4u){0u, 0u, 0u, 0u};
        if (blockIdx.x == 0 && F.tid < NPROJ_P - NPROJ) SWIN[NPROJ + F.tid] = 0.f;
        for (int it = F.gw; it < WINB_ITEMS; it += F.ngw) conv_winb(F, 0, it);
    } else {
    conv_layer_items(F, 0, F.gw, F.ngw, true, false);
    { bf16* WIN = (bf16*)(wsp() + WS_WIN);
      for (int i = F.gw * 64 + F.lane; i < 64 * DM / 8; i += F.ngw * 64) *(GAS v4u*)(WIN + (size_t)NPROJ * DM + (size_t)i * 8) = (v4u){0u, 0u, 0u, 0u}; } }
    if (blockIdx.x == 0) {
        int* TB = (int*)(wsp() + WS_SMALL + SM_TB);
        for (int d = F.tid; d < 2049; d += NTHR) {
            int bkt = d;
            if (d >= 16) bkt = 16 + (d >= 22) + (d >= 30) + (d >= 40) + (d >= 54) + (d >= 73) + (d >= 99) + (d >= 134) + (d >= 182) + (d >= 246) + (d >= 332) + (d >= 450) + (d >= 609) + (d >= 825) + (d >= 1117) + (d >= 1513);
            TB[d] = bkt;
        }
    }
    if (blockIdx.x >= 1 && blockIdx.x <= 16) {
        const int hcol = blockIdx.x - 1; float* BT = (float*)(wsp() + WS_SMALL + SM_BIAS) + hcol * 2048; const float* pb = inp(3);
        for (int d = F.tid; d < 2048; d += NTHR) {
            int bkt = d;
            if (d >= 16) bkt = 16 + (d >= 22) + (d >= 30) + (d >= 40) + (d >= 54) + (d >= 73) + (d >= 99) + (d >= 134) + (d >= 182) + (d >= 246) + (d >= 332) + (d >= 450) + (d >= 609) + (d >= 825) + (d >= 1117) + (d >= 1513);
            BT[d] = pb[bkt * 16 + hcol] * 1.4426950408889634f;
        }
    }
    { bf16* WT = (bf16*)(wsp() + WS_SMALL + SM_WT); const float* w2 = inp(9); const float* a2 = inp(11); const float* g2 = inp(12);
      for (int idx = blockIdx.x * NTHR + F.tid; idx < DEPTH * 448 * GW; idx += F.G * NTHR) {
          const int c = idx % GW, k = (idx / GW) % 448, l = idx / (GW * 448);
          const float v = k < 96 ? w2[((size_t)l * 96 + k) * GW + c] : (k < 192 ? a2[((size_t)l * 96 + (k - 96)) * GW + c] : g2[((size_t)l * 256 + (k - 192)) * GW + c]);
          const int r32_ = c & 31, hct = c >> 5, ks_ = k >> 4, hh_ = (k >> 3) & 1;
          WT[(size_t)l * GW * 448 + (((size_t)hct * 28 + ks_) * 64 + 32 * hh_ + r32_) * 8 + (k & 7)] = (bf16)f2bf(v); } }
    const float* x = inp(0); bf16* XB = (bf16*)(wsp() + WS_XB); pg8::fx_t* ssq = (pg8::fx_t*)(ctlp() + CW_SSQ);
    for (int m = F.gw; m < M; m += F.ngw) {
        const GAS f32x4* xr = (const GAS f32x4*)(x + (size_t)m * DM) + F.lane; GAS v2u* o = (GAS v2u*)(XB + (size_t)m * DM) + F.lane; float s = 0.f;
#pragma unroll
        for (int j = 0; j < 8; ++j) { const f32x4 v = xr[64 * j]; s += (v.x * v.x + v.y * v.y) + (v.z * v.z + v.w * v.w); o[64 * j] = (v2u){pk2(v.x, v.y), pk2(v.z, v.w)}; }
        s = wave_sum(s); if (F.lane == 0) pg8::fx_add(ssq + m, s);
        if (I8_IN) {
            float mx = 0.f;
#pragma unroll
            for (int j = 0; j < 8; ++j) { const f32x4 v = xr[64 * j]; mx = fmaxf(fmaxf(mx, fmaxf(fabsf(v.x), fabsf(v.y))), fmaxf(fabsf(v.z), fabsf(v.w))); }
            mx = wave_max(mx); const float inv = mx > 0.f ? 127.0f / mx : 0.f; GAS unsigned* q = (GAS unsigned*)(wsp() + WS_XQ + (size_t)m * DM) + F.lane;
#pragma unroll
            for (int j = 0; j < 8; ++j) { const f32x4 v = xr[64 * j]; q[64 * j] = q8pack4(v.x, v.y, v.z, v.w, inv); }
            if (F.lane == 0) ((float*)(wsp() + WS_SMALL + SM_SAX))[m] = mx * (1.0f / 127.0f);
        }
    }
}

__device__ __forceinline__ void ph_quantx(Frame& F, pg8::fx_t* ssq) {
    const bf16* XB = (const bf16*)(wsp() + WS_XB); unsigned char* XQ = wsp() + WS_XQ; float* SAX = (float*)(wsp() + WS_SMALL + SM_SAX);
    for (int m = F.gw; m < M; m += F.ngw) {
        const GAS v4u* xr = (const GAS v4u*)(XB + (size_t)m * DM) + F.lane; v4u w[4]; float mx = 0.f;
#pragma unroll
        for (int j = 0; j < 4; ++j) w[j] = xr[64 * j];
        float sq = 0.f;
#pragma unroll
        for (int j = 0; j < 4; ++j) { const float e8[8] = {bflo(w[j].x), bfhi(w[j].x), bflo(w[j].y), bfhi(w[j].y), bflo(w[j].z), bfhi(w[j].z), bflo(w[j].w), bfhi(w[j].w)};
#pragma unroll
            for (int e = 0; e < 8; ++e) sq += e8[e] * e8[e]; }
        sq = wave_sum(sq);
#pragma unroll
        for (int j = 0; j < 4; ++j) { mx = fmaxf(fmaxf(mx, fmaxf(fabsf(bflo(w[j].x)), fabsf(bfhi(w[j].x)))), fmaxf(fabsf(bflo(w[j].y)), fabsf(bfhi(w[j].y))));
            mx = fmaxf(fmaxf(mx, fmaxf(fabsf(bflo(w[j].z)), fabsf(bfhi(w[j].z)))), fmaxf(fabsf(bflo(w[j].w)), fabsf(bfhi(w[j].w)))); }
        mx = wave_max(mx); const float inv = mx > 0.f ? 127.0f / mx : 0.f; GAS v2u* q = (GAS v2u*)(XQ + (size_t)m * DM) + F.lane;
#pragma unroll
        for (int j = 0; j < 4; ++j) q[64 * j] = (v2u){q8pack4(bflo(w[j].x), bfhi(w[j].x), bflo(w[j].y), bfhi(w[j].y), inv), q8pack4(bflo(w[j].z), bfhi(w[j].z), bflo(w[j].w), bfhi(w[j].w), inv)};
        if (F.lane == 0) { SAX[m] = mx * (1.0f / 127.0f); ssq[m] = (pg8::fx_t)(long long)__float2ll_rn(sq * 1073741824.0f); }
    }
}

constexpr int PR_PITCH = 912;
constexpr int PR_PRM_OFF = 32768, PR_MUA_OFF = PR_PRM_OFF + 8 * 512 * 4;
__device__ __forceinline__ float fast_tanh(float x) { return 1.0f - 2.0f * __builtin_amdgcn_rcpf(__expf(2.0f * x) + 1.0f); }
__device__ __forceinline__ float fast_sigmoid(float x) { return __builtin_amdgcn_rcpf(1.0f + __expf(-x)); }
constexpr int PR_OT_OFF = 51200, PR_OT_PITCH = 72, PR_OT_TILE = 32 * PR_OT_PITCH, PR_OT_WAVE = 6 * PR_OT_TILE;
static_assert(PR_OT_OFF + 8 * PR_OT_WAVE <= MISC_OFF, "prep LDS");
__device__ __forceinline__ void ph_prep(Frame& F, int l) {
    const bf16* PROJ = (const bf16*)(wsp() + WS_PROJ);
    bf16* R_ = (bf16*)outp();
    bf16* E_ = R_ + (size_t)M * GW; bf16* KP_ = E_ + (size_t)M * GW; bf16* V_ = KP_ + (size_t)M * GW;
    bf16* KK_ = (bf16*)outp() + (size_t)4 * M * GW; bf16* AS_ = KK_ + (size_t)M * GW; bf16* G_ = (bf16*)(wsp() + WS_G); float* BC = (float*)(wsp() + WS_BC);
    const bf16* WT = (const bf16*)(wsp() + WS_SMALL + SM_WT) + (size_t)l * GW * 448;
    LAS unsigned char* actL = F.lds + RING_OFF; LAS float* PRM = (LAS float*)(F.lds + PR_PRM_OFF); LAS float* MUA = (LAS float*)(F.lds + PR_MUA_OFF);
    { const float* mu = inp(7) + l * D_W; const float* w0 = inp(8) + l * GW; const float* a0 = inp(10) + l * GW; const float* k_k = inp(13) + l * GW; const float* k_a = inp(14) + l * GW; const float* r_k = inp(15) + l * GW;
      const int c = F.tid;
      PRM[c] = mu[D_R + c]; PRM[512 + c] = mu[D_K + c]; PRM[1024 + c] = mu[D_V + c]; PRM[1536 + c] = w0[c]; PRM[2048 + c] = a0[c]; PRM[2560 + c] = k_k[c]; PRM[3072 + c] = k_a[c]; PRM[3584 + c] = r_k[c];
      if (c < 448) MUA[c] = mu[c < 96 ? D_WD + c : (c < 192 ? D_AD + (c - 96) : D_GD + (c - 192))]; }
    __syncthreads();
    const int h = F.wave;
    for (int it = blockIdx.x; it < M / 32; it += F.G) {
        const int m0 = it * 32;
        int tid_ = F.wave * 64 + pg8::lane_now(); asm volatile("" : "+v"(tid_));
        const int tid = tid_, r32 = tid & 31, hh = (tid >> 5) & 1, lane = tid & 63;
        LAS unsigned char* OT = F.lds + PR_OT_OFF + h * PR_OT_WAVE;
        { v2u pc[7], pp[7];
#pragma unroll
          for (int i = 0; i < 7; ++i) { const int gi = tid + NTHR * i, t = gi / 112, k = 4 * (gi % 112), m = m0 + t;
              const int col = k < 96 ? D_WD + k : (k < 192 ? D_AD + (k - 96) : D_GD + (k - 192)); const bf16* src = PROJ + (size_t)m * NPROJ_P + CD + col;
              pc[i] = *(const GAS v2u*)src; pp[i] = (v2u){0u, 0u}; if ((m % SEQ) > 0) pp[i] = *(const GAS v2u*)(src - NPROJ_P); }
#pragma unroll
          for (int i = 0; i < 7; ++i) { const int gi = tid + NTHR * i, t = gi / 112, k = 4 * (gi % 112);
              const f32x4 mv = *(const LAS f32x4*)(MUA + k);
              float x[4] = {bflo(pc[i].x), bfhi(pc[i].x), bflo(pc[i].y), bfhi(pc[i].y)}; const float xp[4] = {bflo(pp[i].x), bfhi(pp[i].x), bflo(pp[i].y), bfhi(pp[i].y)};
#pragma unroll
              for (int e = 0; e < 4; ++e) { x[e] += (xp[e] - x[e]) * mv[e]; x[e] = k < 96 ? fast_tanh(x[e]) : (k < 192 ? x[e] : fast_sigmoid(x[e])); }
              *(LAS v2u*)(actL + t * PR_PITCH + 2 * k) = (v2u){pk2(x[0], x[1]), pk2(x[2], x[3])}; } }
        __syncthreads();
        const int m = m0 + r32; const bool has_prev = (m % SEQ) > 0;
        const bf16* pr = PROJ + (size_t)m * NPROJ_P + CD; const bf16* pq = pr - NPROJ_P;
        const LAS unsigned char* bp = actL + r32 * PR_PITCH + 16 * hh;
        float kkv[2][16]; float n2 = 0.f, bcv = 0.f;
#pragma unroll
        for (int ct = 0; ct < 2; ++ct) {
            const int cb = 64 * h + 32 * ct + 4 * hh;
            v4u xc[3][2], xp[3][2];
#pragma unroll
            for (int a = 0; a < 3; ++a)
#pragma unroll
                for (int i = 0; i < 2; ++i) { const int mm = m0 + (lane >> 2) + 16 * i; const bf16* src = PROJ + (size_t)mm * NPROJ_P + CD + (a == 0 ? D_R : (a == 1 ? D_K : D_V)) + 64 * h + 32 * ct + 8 * (lane & 3);
                    xc[a][i] = *(const GAS v4u*)src; xp[a][i] = (v4u){0u, 0u, 0u, 0u}; if ((mm % SEQ) > 0) xp[a][i] = *(const GAS v4u*)(src - NPROJ_P); }
            f32x16 aW, aA, aG;
            { const float z_ = zero_v();
#pragma unroll
            for (int i = 0; i < 16; ++i) { aW[i] = z_; aA[i] = z_; aG[i] = z_; } }
            const bf16* wt0 = WT + ((size_t)(2 * h + ct) * 28 * 64 + lane) * 8;
#pragma unroll
            for (int grp = 0; grp < 4; ++grp) {
                bf16x8 af[7];
#pragma unroll
                for (int q = 0; q < 7; ++q) af[q] = *(const GAS bf16x8*)(wt0 + 512 * (7 * grp + q));
#pragma unroll
                for (int q = 0; q < 7; ++q) { const int ks = 7 * grp + q; const bf16x8 bfr = *(const LAS bf16x8*)(bp + 32 * ks);
                    if (ks < 6) aW = __builtin_amdgcn_mfma_f32_32x32x16_bf16(af[q], bfr, aW, 0, 0, 0);
                    else if (ks < 12) aA = __builtin_amdgcn_mfma_f32_32x32x16_bf16(af[q], bfr, aA, 0, 0, 0);
                    else aG = __builtin_amdgcn_mfma_f32_32x32x16_bf16(af[q], bfr, aG, 0, 0, 0); }
                asm volatile("" ::: "memory");
            }
            LAS unsigned char* IN = OT + 3 * PR_OT_TILE;
#pragma unroll
            for (int a = 0; a < 3; ++a)
#pragma unroll
                for (int i = 0; i < 2; ++i) { const int cch = 64 * h + 32 * ct + 8 * (lane & 3); const f32x4 m0v = *(const LAS f32x4*)(PRM + a * 512 + cch), m1v = *(const LAS f32x4*)(PRM + a * 512 + cch + 4);
                    float xcu[8], xpu[8]; UNPACK8(xcu, 0, xc[a][i]); UNPACK8(xpu, 0, xp[a][i]); const float mw[8] = {m0v.x, m0v.y, m0v.z, m0v.w, m1v.x, m1v.y, m1v.z, m1v.w};
#pragma unroll
                    for (int e = 0; e < 8; ++e) xcu[e] += (xpu[e] - xcu[e]) * mw[e];
                    LAS unsigned char* dstp = IN + a * PR_OT_TILE + ((lane >> 2) + 16 * i) * PR_OT_PITCH + 16 * (lane & 3);
                    *(LAS v2u*)dstp = (v2u){pk2(xcu[0], xcu[1]), pk2(xcu[2], xcu[3])}; *(LAS v2u*)(dstp + 8) = (v2u){pk2(xcu[4], xcu[5]), pk2(xcu[6], xcu[7])}; }
            asm volatile("" ::: "memory");
            v2u oE[4], oK[4], oG[4];
#pragma unroll
            for (int g4 = 0; g4 < 4; ++g4) {
                const int c = cb + 8 * g4;
                const f32x4 w0v = *(const LAS f32x4*)(PRM + 1536 + c),
                            a0v = *(const LAS f32x4*)(PRM + 2048 + c), kkc = *(const LAS f32x4*)(PRM + 2560 + c), kac = *(const LAS f32x4*)(PRM + 3072 + c), rkc = *(const LAS f32x4*)(PRM + 3584 + c);
                const LAS unsigned char* inq = IN + r32 * PR_OT_PITCH + 2 * (8 * g4 + 4 * hh);
                const v2u rq = *(const LAS v2u*)inq, kq = *(const LAS v2u*)(inq + PR_OT_TILE), vq = *(const LAS v2u*)(inq + 2 * PR_OT_TILE);
                const float rsu[4] = {bflo(rq.x), bfhi(rq.x), bflo(rq.y), bfhi(rq.y)}, ksu[4] = {bflo(kq.x), bfhi(kq.x), bflo(kq.y), bfhi(kq.y)}, vsu[4] = {bflo(vq.x), bfhi(vq.x), bflo(vq.y), bfhi(vq.y)};
                float ro[4], eo[4], ko[4], vo[4], ao[4], go[4];
#pragma unroll
                for (int e = 0; e < 4; ++e) {
                    const float r = rsu[e], k = ksu[e], v = vsu[e];
                    const float ee = 0.6065306597126334f * fast_sigmoid(w0v[e] + aW[4 * g4 + e]);
                    const float as = fast_sigmoid(a0v[e] + aA[4 * g4 + e]);
                    const float kv = k * kkc[e]; kkv[ct][4 * g4 + e] = kv; n2 += kv * kv;
                    const float kp = k * (1.0f + (as - 1.0f) * kac[e]);
                    bcv += r * kp * rkc[e];
                    ro[e] = r; eo[e] = ee; ko[e] = kp; vo[e] = v; ao[e] = as; go[e] = aG[4 * g4 + e];
                }
                LAS unsigned char* ot = OT + r32 * PR_OT_PITCH + 2 * (8 * g4 + 4 * hh);
                *(LAS v2u*)(ot) = (v2u){pk2(ro[0], ro[1]), pk2(ro[2], ro[3])}; *(LAS v2u*)(ot + PR_OT_TILE) = (v2u){pk2(vo[0], vo[1]), pk2(vo[2], vo[3])}; *(LAS v2u*)(ot + 2 * PR_OT_TILE) = (v2u){pk2(ao[0], ao[1]), pk2(ao[2], ao[3])};
                oE[g4] = (v2u){pk2(eo[0], eo[1]), pk2(eo[2], eo[3])}; oK[g4] = (v2u){pk2(ko[0], ko[1]), pk2(ko[2], ko[3])}; oG[g4] = (v2u){pk2(go[0], go[1]), pk2(go[2], go[3])};
            }
            asm volatile("" ::: "memory");
#pragma unroll
            for (int batch = 0; batch < 2; ++batch) {
                bf16* const dst[3] = {batch == 0 ? R_ : E_, batch == 0 ? V_ : KP_, batch == 0 ? AS_ : G_};
                if (batch == 1) {
#pragma unroll
                    for (int g4 = 0; g4 < 4; ++g4) { LAS unsigned char* ot = OT + r32 * PR_OT_PITCH + 2 * (8 * g4 + 4 * hh); *(LAS v2u*)(ot) = oE[g4]; *(LAS v2u*)(ot + PR_OT_TILE) = oK[g4]; *(LAS v2u*)(ot + 2 * PR_OT_TILE) = oG[g4]; }
                    asm volatile("" ::: "memory"); }
#pragma unroll
                for (int a = 0; a < 3; ++a)
#pragma unroll
                    for (int i = 0; i < 2; ++i) { const int tk = (lane >> 2) + 16 * i, part = lane & 3; const LAS unsigned char* src = OT + a * PR_OT_TILE + tk * PR_OT_PITCH + 16 * part;
                        const v2u lo = *(const LAS v2u*)src, hi = *(const LAS v2u*)(src + 8);
                        *(GAS v4u*)(dst[a] + (size_t)(m0 + tk) * GW + 64 * h + 32 * ct + 8 * part) = (v4u){lo.x, lo.y, hi.x, hi.y}; }
                asm volatile("" ::: "memory");
            }
        }
        n2 += __shfl_xor(n2, 32); bcv += __shfl_xor(bcv, 32);
        const float inv = 1.0f / fmaxf(sqrtf(n2), 1e-12f);
#pragma unroll
        for (int ct = 0; ct < 2; ++ct)
#pragma unroll
            for (int g4 = 0; g4 < 4; ++g4) *(LAS v2u*)(OT + ct * PR_OT_TILE + r32 * PR_OT_PITCH + 2 * (8 * g4 + 4 * hh)) = (v2u){pk2(kkv[ct][4 * g4] * inv, kkv[ct][4 * g4 + 1] * inv), pk2(kkv[ct][4 * g4 + 2] * inv, kkv[ct][4 * g4 + 3] * inv)};
        asm volatile("" ::: "memory");
#pragma unroll
        for (int ct = 0; ct < 2; ++ct)
#pragma unroll
            for (int i = 0; i < 2; ++i) { const int tk = (lane >> 2) + 16 * i, part = lane & 3; const LAS unsigned char* src = OT + ct * PR_OT_TILE + tk * PR_OT_PITCH + 16 * part;
                const v2u lo = *(const LAS v2u*)src, hi = *(const LAS v2u*)(src + 8);
                *(GAS v4u*)(KK_ + (size_t)(m0 + tk) * GW + 64 * h + 32 * ct + 8 * part) = (v4u){lo.x, lo.y, hi.x, hi.y}; }
        asm volatile("" ::: "memory");
        if (hh == 0) BC[(size_t)m * NH + h] = bcv;
        __syncthreads();
    }
}

__device__ __forceinline__ Frame mkframe(LAS unsigned char* lds, int wv) {
    Frame F; F.lds = lds; { int t_ = wv * 64 + pg8::lane_now(); asm volatile("" : "+v"(t_)); F.tid = t_; } F.lane = F.tid & 63; F.wave = wv;
    F.G = gridDim.x; { const int bx = blockIdx.x; F.vcu = (F.G % 8 == 0) ? (bx % 8) * (F.G / 8) + bx / 8 : bx; }
    F.gw = blockIdx.x * NWAVES + F.wave; F.ngw = F.G * NWAVES; return F;
}

#ifndef UNPACK8
#define UNPACK8(dst, o, W_) do { dst[(o)] = bflo((W_).x); dst[(o) + 1] = bfhi((W_).x); dst[(o) + 2] = bflo((W_).y); dst[(o) + 3] = bfhi((W_).y); dst[(o) + 4] = bflo((W_).z); dst[(o) + 5] = bfhi((W_).z); dst[(o) + 6] = bflo((W_).w); dst[(o) + 7] = bfhi((W_).w); } while (0)
#endif
#define DOT8(q, o, W_) ((q)[(o)] * bflo((W_).x) + (q)[(o) + 1] * bfhi((W_).x) + (q)[(o) + 2] * bflo((W_).y) + (q)[(o) + 3] * bfhi((W_).y) + (q)[(o) + 4] * bflo((W_).z) + (q)[(o) + 5] * bfhi((W_).z) + (q)[(o) + 6] * bflo((W_).w) + (q)[(o) + 7] * bfhi((W_).w))
#define AXPY8(acc, o, sc, pe, W_) do { acc[(o)] = acc[(o)] * (sc) + (pe) * bflo((W_).x); acc[(o) + 1] = acc[(o) + 1] * (sc) + (pe) * bfhi((W_).x); acc[(o) + 2] = acc[(o) + 2] * (sc) + (pe) * bflo((W_).y); acc[(o) + 3] = acc[(o) + 3] * (sc) + (pe) * bfhi((W_).y); \
    acc[(o) + 4] = acc[(o) + 4] * (sc) + (pe) * bflo((W_).z); acc[(o) + 5] = acc[(o) + 5] * (sc) + (pe) * bfhi((W_).z); acc[(o) + 6] = acc[(o) + 6] * (sc) + (pe) * bflo((W_).w); acc[(o) + 7] = acc[(o) + 7] * (sc) + (pe) * bfhi((W_).w); } while (0)
__device__ __forceinline__ void mix_a_simple(Frame& F) {
    const bf16* PROJ = (const bf16*)(wsp() + WS_PROJ); bf16* YC = (bf16*)(wsp() + WS_YCAT); const int* TB = (const int*)(wsp() + WS_SMALL + SM_TB); const float* pb = inp(3);
    const int nthr = F.G * NTHR;
    for (int idx = blockIdx.x * NTHR + F.tid; idx < M * NH; idx += nthr) {
        const int m = idx >> 3, h = idx & 7, t = m % SEQ;
        float q[64], acc[64];
        { const GAS v4u* qp = (const GAS v4u*)(PROJ + (size_t)m * NPROJ_P + CA_Q + 64 * h);
#pragma unroll
          for (int i = 0; i < 8; ++i) { const v4u w = qp[i]; UNPACK8(q, 8 * i, w); } }
#pragma unroll
        for (int i = 0; i < 64; ++i) acc[i] = 0.f;
        float mx = -1e30f, l = 0.f;
        for (int p = 0; p < 3; ++p) { const int d = p == 0 ? 1 : (p == 1 ? 4 : 16);
            for (int j = 0; j <= 128; ++j) { const int kp = t - j * d; if (kp < 0) break;
                const bf16* row = PROJ + (size_t)(m - j * d) * NPROJ_P; const GAS v4u* kq = (const GAS v4u*)(row + CA_K + 64 * h); const GAS v4u* vq = (const GAS v4u*)(row + CA_V + 64 * h);
                float s = 0.f;
#pragma unroll
                for (int i = 0; i < 8; ++i) { const v4u w = kq[i]; s += DOT8(q, 8 * i, w); }
                s = s * 0.125f + pb[TB[j * d] * 16 + h];
                const float mn = fmaxf(mx, s), sc = __expf(mx - mn), pe = __expf(s - mn); mx = mn; l = l * sc + pe;
#pragma unroll
                for (int i = 0; i < 8; ++i) { const v4u w = vq[i]; AXPY8(acc, 8 * i, sc, pe, w); }
            } }
        const float inv = 1.0f / l; GAS v4u* op = (GAS v4u*)(YC + (size_t)m * DM + 0 * GW + 64 * h);
#pragma unroll
        for (int i = 0; i < 8; ++i) op[i] = (v4u){pk2(acc[8 * i] * inv, acc[8 * i + 1] * inv), pk2(acc[8 * i + 2] * inv, acc[8 * i + 3] * inv), pk2(acc[8 * i + 4] * inv, acc[8 * i + 5] * inv), pk2(acc[8 * i + 6] * inv, acc[8 * i + 7] * inv)};
    }
}
__device__ __forceinline__ void mix_c_simple(Frame& F, int l = 0) {
    const bf16* PROJ = (const bf16*)(wsp() + WS_PROJ); bf16* YC = (bf16*)(wsp() + WS_YCAT); const int* TB = (const int*)(wsp() + WS_SMALL + SM_TB); const float* pb = inp(3);
    const float* KBAR = (const float*)(wsp() + CTL_KBAR) + (size_t)l * 64 * 8 * 64;
    const int nthr = F.G * NTHR;
    for (int idx = blockIdx.x * NTHR + F.tid; idx < M * NH; idx += nthr) {
        const int m = idx >> 3, h = idx & 7, t = m % SEQ, b = m / SEQ, ob = t >> 8;
        float q[64], acc[64];
        { const GAS v4u* qp = (const GAS v4u*)(PROJ + (size_t)m * NPROJ_P + CC_Q + 64 * h);
#pragma unroll
          for (int i = 0; i < 8; ++i) { const v4u w = qp[i]; UNPACK8(q, 8 * i, w); } }
        float gate[8];
#pragma unroll
        for (int n = 0; n < 8; ++n) { float s = 0.f; if (n < ob) { const float* kb = KBAR + ((b * NH + h) * 8 + n) * 64;
#pragma unroll
                for (int i = 0; i < 64; ++i) s += q[i] * kb[i]; } gate[n] = s; }
        unsigned sel = 0u;
#pragma unroll
        for (int n = 0; n < 8; ++n) { int rank = 0;
#pragma unroll
            for (int n2 = 0; n2 < 8; ++n2) rank += (n2 < ob && n2 != n && (gate[n2] > gate[n] || (gate[n2] == gate[n] && n2 < n))) ? 1 : 0;
            if (n < ob && rank < 3) sel |= 1u << n; }
        sel |= 1u << ob;
#pragma unroll
        for (int i = 0; i < 64; ++i) acc[i] = 0.f;
        float mx = -1e30f, l = 0.f;
        for (int n = 0; n <= ob; ++n) { if (!((sel >> n) & 1u)) continue; const int kmax = n == ob ? (t & 255) : 255;
            for (int i2 = 0; i2 <= kmax; ++i2) { const int kp = 256 * n + i2;
                const bf16* row = PROJ + ((size_t)b * SEQ + kp) * NPROJ_P; const GAS v4u* kq = (const GAS v4u*)(row + CC_K + 64 * h); const GAS v4u* vq = (const GAS v4u*)(row + CC_V + 64 * h);
                float s = 0.f;
#pragma unroll
                for (int i = 0; i < 8; ++i) { const v4u w = kq[i]; s += DOT8(q, 8 * i, w); }
                s = s * 0.125f + pb[TB[t - kp] * 16 + 8 + h];
                const float mn = fmaxf(mx, s), sc = __expf(mx - mn), pe = __expf(s - mn); mx = mn; l = l * sc + pe;
#pragma unroll
                for (int i = 0; i < 8; ++i) { const v4u w = vq[i]; AXPY8(acc, 8 * i, sc, pe, w); }
            } }
        const float inv = 1.0f / l; GAS v4u* op = (GAS v4u*)(YC + (size_t)m * DM + 2 * GW + 64 * h);
#pragma unroll
        for (int i = 0; i < 8; ++i) op[i] = (v4u){pk2(acc[8 * i] * inv, acc[8 * i + 1] * inv), pk2(acc[8 * i + 2] * inv, acc[8 * i + 3] * inv), pk2(acc[8 * i + 4] * inv, acc[8 * i + 5] * inv), pk2(acc[8 * i + 6] * inv, acc[8 * i + 7] * inv)};
    }
}
__device__ __forceinline__ void mix_b_simple(Frame& F, int l) {
    const bf16* PROJ = (const bf16*)(wsp() + WS_PROJ); bf16* YC = (bf16*)(wsp() + WS_YCAT); const pg8::fx_t* ST = (const pg8::fx_t*)(wsp() + CTL_STATS) + (size_t)l * M * 2;
    const float* lng = inp(4) + l * GW; const float* sw = inp(5) + (size_t)l * NH * 128 * 128; const float* sb = inp(6) + l * NH * 128;
    const int nthr = F.G * NTHR;
    for (int idx = blockIdx.x * NTHR + F.tid; idx < M * GW; idx += nthr) {
        const int m = idx >> 9, c = idx & 511, g = c >> 6, tt = m & 127, m0 = m - tt;
        const float* wrow = sw + ((size_t)g * 128 + tt) * 128; const float gn = lng[c]; float s = 0.f;
        for (int s2 = 0; s2 <= tt; ++s2) { const int ms = m0 + s2; const float mu_ = pg8::fx_get(ST + 2 * ms) * (1.0f / 512.0f), rs_ = 1.0f / sqrtf(fmaxf(pg8::fx_get(ST + 2 * ms + 1) * (1.0f / 512.0f) - mu_ * mu_, 0.f) + 1e-5f); const float vv = (gelu_tanh(bf2f(PROJ[(size_t)ms * NPROJ_P + CB_V + c])) - mu_) * rs_ * gn; s += wrow[s2] * vv; }
        const float u = gelu_tanh(bf2f(PROJ[(size_t)m * NPROJ_P + CB_U + c]));
        YC[(size_t)m * DM + GW + c] = (bf16)f2bf(u * (s + sb[g * 128 + tt]));
    }
}
__device__ __forceinline__ float rdl(float v, int k) { return __builtin_bit_cast(float, __builtin_amdgcn_readlane(__builtin_bit_cast(int, v), k)); }
__device__ __forceinline__ void mix_d_simple(Frame& F) {
    const bf16* R_ = (const bf16*)outp();
    const bf16* E_ = R_ + (size_t)M * GW; const bf16* KP_ = E_ + (size_t)M * GW; const bf16* V_ = KP_ + (size_t)M * GW;
    const bf16* KK_ = (const bf16*)outp() + (size_t)4 * M * GW; const bf16* AS_ = KK_ + (size_t)M * GW; float* YD = (float*)(wsp() + WS_YD);
    for (int it = F.gw; it < BATCH * NH; it += F.ngw) {
        const int b = it >> 3, h = it & 7; float s[64];
#pragma unroll
        for (int k = 0; k < 64; ++k) s[k] = 0.f;
        for (int t = 0; t < SEQ; ++t) {
            const size_t o = ((size_t)b * SEQ + t) * GW + 64 * h + F.lane;
            const float r = bf2f(R_[o]), w = __expf(-bf2f(E_[o])), kp = bf2f(KP_[o]), v = bf2f(V_[o]), kk = bf2f(KK_[o]), as = bf2f(AS_[o]);
            const float a = -kk, bb = kk * as;
            float sa = 0.f;
#pragma unroll
            for (int k = 0; k < 64; ++k) sa += s[k] * rdl(a, k);
            float y = 0.f;
#pragma unroll
            for (int k = 0; k < 64; ++k) { s[k] = s[k] * rdl(w, k) + sa * rdl(bb, k) + v * rdl(kp, k); y += s[k] * rdl(r, k); }
            YD[o] = y;
        }
    }
}

constexpr float LOG2E = 1.4426950408889634f;

constexpr int SC_T = 32, SC_TOK = (5 * 64 + 32) * 4, SC_BUF = SC_T * SC_TOK, SC_YB = SC_T * 32 * 4, SC_LDS = 2 * SC_BUF + 2 * SC_YB;
template <int CTRL> __device__ __forceinline__ float dpp_add(float x) {
    const int y = __builtin_amdgcn_update_dpp(0, __builtin_bit_cast(int, x), CTRL, 0xF, 0xF, false);
    return x + __builtin_bit_cast(float, y);
}
__device__ __forceinline__ float red8(float x) { x = dpp_add<0xB1>(x); x = dpp_add<0x4E>(x); x = dpp_add<0x141>(x); return x; }
__device__ __forceinline__ void scan_unit(LAS unsigned char* lds, int unit, int tid) {
    const int half = unit & 1, h = (unit >> 1) & 7, b = unit >> 4;
    const bf16* R_ = (const bf16*)outp();
    const bf16* E_ = R_ + (size_t)M * GW; const bf16* KP_ = E_ + (size_t)M * GW; const bf16* V_ = KP_ + (size_t)M * GW;
    const bf16* KK_ = (const bf16*)outp() + (size_t)4 * M * GW; const bf16* AS_ = KK_ + (size_t)M * GW; float* YD = (float*)(wsp() + WS_YD);
    const int lane = tid & 63, wave = __builtin_amdgcn_readfirstlane(tid >> 6);
    const bool scanner = wave < 4;
    const int j = lane & 7, rowl = (wave & 3) * 8 + (lane >> 3);
    const int st = tid & 255, tt = st >> 3, cg = st & 7;
    const size_t gbase = ((size_t)b * SEQ) * GW + 64 * h + 8 * cg;
#define SC_STAGE(c, buf) do { const size_t o_ = gbase + (size_t)((c) * SC_T + tt) * GW; \
        const v4u g_r = *(const GAS v4u*)(R_ + o_), g_e = *(const GAS v4u*)(E_ + o_), g_k = *(const GAS v4u*)(KP_ + o_), g_v = *(const GAS v4u*)(V_ + o_), g_kk = *(const GAS v4u*)(KK_ + o_), g_as = *(const GAS v4u*)(AS_ + o_); \
        LAS float* p_ = (LAS float*)(lds + (buf) * SC_BUF + tt * SC_TOK) + 8 * cg; float kk_[8], x_[8], y_[8]; \
        UNPACK8(kk_, 0, g_kk); \
        *(LAS f32x4*)(p_) = (f32x4){-kk_[0], -kk_[1], -kk_[2], -kk_[3]}; *(LAS f32x4*)(p_ + 4) = (f32x4){-kk_[4], -kk_[5], -kk_[6], -kk_[7]}; \
        UNPACK8(x_, 0, g_e); *(LAS f32x4*)(p_ + 64) = (f32x4){__expf(-x_[0]), __expf(-x_[1]), __expf(-x_[2]), __expf(-x_[3])}; *(LAS f32x4*)(p_ + 68) = (f32x4){__expf(-x_[4]), __expf(-x_[5]), __expf(-x_[6]), __expf(-x_[7])}; \
        UNPACK8(y_, 0, g_as); *(LAS f32x4*)(p_ + 128) = (f32x4){kk_[0] * y_[0], kk_[1] * y_[1], kk_[2] * y_[2], kk_[3] * y_[3]}; *(LAS f32x4*)(p_ + 132) = (f32x4){kk_[4] * y_[4], kk_[5] * y_[5], kk_[6] * y_[6], kk_[7] * y_[7]}; \
        UNPACK8(x_, 0, g_k); *(LAS f32x4*)(p_ + 192) = (f32x4){x_[0], x_[1], x_[2], x_[3]}; *(LAS f32x4*)(p_ + 196) = (f32x4){x_[4], x_[5], x_[6], x_[7]}; \
        UNPACK8(x_, 0, g_r); *(LAS f32x4*)(p_ + 256) = (f32x4){x_[0], x_[1], x_[2], x_[3]}; *(LAS f32x4*)(p_ + 260) = (f32x4){x_[4], x_[5], x_[6], x_[7]}; \
        if ((cg >> 2) == half) { UNPACK8(x_, 0, g_v); LAS float* v_ = (LAS float*)(lds + (buf) * SC_BUF + tt * SC_TOK) + 320 + 8 * (cg & 3); \
            *(LAS f32x4*)(v_) = (f32x4){x_[0], x_[1], x_[2], x_[3]}; *(LAS f32x4*)(v_ + 4) = (f32x4){x_[4], x_[5], x_[6], x_[7]}; } } while (0)
    if (!scanner) SC_STAGE(0, 0);
    __syncthreads();
    f32x4 s0 = {0.f, 0.f, 0.f, 0.f}, s1 = {0.f, 0.f, 0.f, 0.f};
    float ykeep = 0.f;
    for (int c = 0; c < SEQ / SC_T; ++c) {
        const int cur = c & 1;
        LAS float* yb = (LAS float*)(lds + 2 * SC_BUF + cur * SC_YB);
        if (scanner) {
            const LAS float* base = (const LAS float*)(lds + cur * SC_BUF) + 8 * j;
            const LAS float* vbase = (const LAS float*)(lds + cur * SC_BUF) + 320 + rowl;
            f32x4 a0 = *(const LAS f32x4*)(base), a1 = *(const LAS f32x4*)(base + 4), w0 = *(const LAS f32x4*)(base + 64), w1 = *(const LAS f32x4*)(base + 68), b0 = *(const LAS f32x4*)(base + 128), b1 = *(const LAS f32x4*)(base + 132),
                  k0 = *(const LAS f32x4*)(base + 192), k1 = *(const LAS f32x4*)(base + 196), r0 = *(const LAS f32x4*)(base + 256), r1 = *(const LAS f32x4*)(base + 260);
            float vv = *vbase;
#pragma unroll
            for (int t = 0; t < SC_T; ++t) {
                f32x4 na0 = a0, na1 = a1, nw0 = w0, nw1 = w1, nb0 = b0, nb1 = b1, nk0 = k0, nk1 = k1, nr0 = r0, nr1 = r1; float nv = vv;
                if (t + 1 < SC_T) { const LAS float* p = base + (t + 1) * (SC_TOK / 4);
                    na0 = *(const LAS f32x4*)(p); na1 = *(const LAS f32x4*)(p + 4); nw0 = *(const LAS f32x4*)(p + 64); nw1 = *(const LAS f32x4*)(p + 68); nb0 = *(const LAS f32x4*)(p + 128); nb1 = *(const LAS f32x4*)(p + 132);
                    nk0 = *(const LAS f32x4*)(p + 192); nk1 = *(const LAS f32x4*)(p + 196); nr0 = *(const LAS f32x4*)(p + 256); nr1 = *(const LAS f32x4*)(p + 260);
                    nv = vbase[(t + 1) * (SC_TOK / 4)]; }
                const f32x4 pa = s0 * a0 + s1 * a1;
                float sa = (pa.x + pa.y) + (pa.z + pa.w);
                const f32x4 sw0 = s0 * w0 + vv * k0, sw1 = s1 * w1 + vv * k1;
                sa = red8(sa);
                s0 = sa * b0 + sw0; s1 = sa * b1 + sw1;
                const f32x4 py = s0 * r0 + s1 * r1;
                float y = (py.x + py.y) + (py.z + py.w);
                y = red8(y);
                ykeep = (j == (t & 7)) ? y : ykeep;
                if ((t & 7) == 7) yb[((t & ~7) + j) * 32 + rowl] = ykeep;
                a0 = na0; a1 = na1; w0 = nw0; w1 = nw1; b0 = nb0; b1 = nb1; k0 = nk0; k1 = nk1; r0 = nr0; r1 = nr1; vv = nv;
            }
        } else {
            if (c > 0) {
                const LAS float* ybp = (const LAS float*)(lds + 2 * SC_BUF + (cur ^ 1) * SC_YB); const int t2 = st >> 3, q4 = st & 7; const f32x4 v = *(const LAS f32x4*)(ybp + t2 * 32 + 4 * q4);
                *(GAS f32x4*)(YD + ((size_t)b * SEQ + (c - 1) * SC_T + t2) * GW + 64 * h + 32 * half + 4 * q4) = v; }
            if (c + 1 < SEQ / SC_T) SC_STAGE(c + 1, cur ^ 1);
        }
        __syncthreads();
    }
    if (!scanner) { const LAS float* ybp = (const LAS float*)(lds + 2 * SC_BUF + 1 * SC_YB); const int t2 = st >> 3, q4 = st & 7; const f32x4 v = *(const LAS f32x4*)(ybp + t2 * 32 + 4 * q4);
        *(GAS f32x4*)(YD + ((size_t)b * SEQ + (SEQ / SC_T - 1) * SC_T + t2) * GW + 64 * h + 32 * half + 4 * q4) = v; }
#undef SC_STAGE
    __syncthreads();
}

struct AttnSt { f32x16 o0, o1; float m, l; };
__device__ __forceinline__ void attn_init(AttnSt& st) {
    const float z_ = zero_v();
#pragma unroll
    for (int i = 0; i < 16; ++i) { st.o0[i] = z_; st.o1[i] = z_; }
    st.m = -1e30f; st.l = 0.f;
}
__device__ __forceinline__ void attn_tile(AttnSt& st, const bf16x8 (&qf)[4], const bf16* Kcol, const bf16* Vcol, int rowb, int kb, int ks, int qpos, int maxd, bool sel, const LAS float* biasT, int r32, int hh) {
    int kp_l = kb + r32 * ks; kp_l = kp_l < 0 ? 0 : kp_l;
    const bf16* kr_ = Kcol + (size_t)(rowb + kp_l) * NPROJ_P + 8 * hh;
    bf16x8 kf[4];
#pragma unroll
    for (int s = 0; s < 4; ++s) kf[s] = *(const GAS bf16x8*)(kr_ + 16 * s);
    f32x16 sc;
#pragma unroll
    for (int i = 0; i < 16; ++i) sc[i] = 0.f;
#pragma unroll
    for (int s = 0; s < 4; ++s) sc = __builtin_amdgcn_mfma_f32_32x32x16_bf16(kf[s], qf[s], sc, 0, 0, 0);
    unsigned vf[2][2][4];
#pragma unroll
    for (int s2 = 0; s2 < 2; ++s2)
#pragma unroll
        for (int jp = 0; jp < 4; ++jp) {
            const int j0 = 2 * jp, key0 = 16 * s2 + 8 * (j0 >> 2) + 4 * hh + (j0 & 3);
            int kp0 = kb + key0 * ks, kp1 = kp0 + ks; kp0 = kp0 < 0 ? 0 : kp0; kp1 = kp1 < 0 ? 0 : kp1;
            const bf16* v0 = Vcol + (size_t)(rowb + kp0) * NPROJ_P + r32; const bf16* v1 = Vcol + (size_t)(rowb + kp1) * NPROJ_P + r32;
            vf[0][s2][jp] = (unsigned)v0[0] | ((unsigned)v1[0] << 16); vf[1][s2][jp] = (unsigned)v0[32] | ((unsigned)v1[32] << 16);
        }
    float tmax = -INFINITY;
#pragma unroll
    for (int r = 0; r < 16; ++r) {
        const int kr = (r & 3) + 8 * (r >> 2) + 4 * hh, kp = kb + kr * ks, dist = qpos - kp;
        const bool ok = sel && dist >= 0 && dist <= maxd && kp >= 0;
        const float v = sc[r] * (0.125f * LOG2E) + biasT[ok ? dist : 0];
        sc[r] = ok ? v : -INFINITY; tmax = fmaxf(tmax, sc[r]);
    }
    tmax = fmaxf(tmax, __shfl_xor(tmax, 32));
    const float mn = fmaxf(st.m, tmax), scale = __builtin_amdgcn_exp2f(st.m - mn); st.m = mn;
    float ls = 0.f;
#pragma unroll
    for (int r = 0; r < 16; ++r) { sc[r] = __builtin_amdgcn_exp2f(sc[r] - mn); ls += sc[r]; }
    st.l = st.l * scale + ls;
#pragma unroll
    for (int i = 0; i < 16; ++i) { st.o0[i] *= scale; st.o1[i] *= scale; }
    typedef unsigned u32x4_t __attribute__((ext_vector_type(4)));
#pragma unroll
    for (int s2 = 0; s2 < 2; ++s2) {
        u32x4_t pw; pw.x = pg8::cvt_pk_bf16(sc[8 * s2], sc[8 * s2 + 1]); pw.y = pg8::cvt_pk_bf16(sc[8 * s2 + 2], sc[8 * s2 + 3]); pw.z = pg8::cvt_pk_bf16(sc[8 * s2 + 4], sc[8 * s2 + 5]); pw.w = pg8::cvt_pk_bf16(sc[8 * s2 + 6], sc[8 * s2 + 7]);
        const bf16x8 pf = __builtin_bit_cast(bf16x8, pw);
        u32x4_t a0 = {vf[0][s2][0], vf[0][s2][1], vf[0][s2][2], vf[0][s2][3]}, a1 = {vf[1][s2][0], vf[1][s2][1], vf[1][s2][2], vf[1][s2][3]};
        st.o0 = __builtin_amdgcn_mfma_f32_32x32x16_bf16(__builtin_bit_cast(bf16x8, a0), pf, st.o0, 0, 0, 0);
        st.o1 = __builtin_amdgcn_mfma_f32_32x32x16_bf16(__builtin_bit_cast(bf16x8, a1), pf, st.o1, 0, 0, 0);
    }
}
__device__ __forceinline__ void attn_loadq(bf16x8 (&qf)[4], const bf16* Qcol, int row, int hh) {
    const bf16* q = Qcol + (size_t)row * NPROJ_P + 8 * hh;
#pragma unroll
    for (int s = 0; s < 4; ++s) qf[s] = *(const GAS bf16x8*)(q + 16 * s);
}
__device__ __forceinline__ void attn_store(const f32x16& o0, const f32x16& o1, float inv, bf16* yrow, int hh) {
#pragma unroll
    for (int g = 0; g < 4; ++g) {
        *(GAS v2u*)(yrow + 8 * g + 4 * hh) = (v2u){pk2(o0[4 * g] * inv, o0[4 * g + 1] * inv), pk2(o0[4 * g + 2] * inv, o0[4 * g + 3] * inv)};
        *(GAS v2u*)(yrow + 32 + 8 * g + 4 * hh) = (v2u){pk2(o1[4 * g] * inv, o1[4 * g + 1] * inv), pk2(o1[4 * g + 2] * inv, o1[4 * g + 3] * inv)};
    }
}
__device__ __forceinline__ void build_bias(LAS float* biasT, int hcol, int tid) {
    const f32x4 bv = *(const GAS f32x4*)((const float*)(wsp() + WS_SMALL + SM_BIAS) + hcol * 2048 + 4 * tid); const v4u tv = *(const GAS v4u*)((const unsigned*)(wsp() + WS_SMALL + SM_TB) + 4 * tid);
    *(LAS f32x4*)(biasT + 4 * tid) = bv; *(LAS v4u*)((LAS unsigned*)(biasT + 2048) + 4 * tid) = tv;
}

constexpr int MC_KP = 144, MC_VP = 192, MC_KB = 128 * MC_KP, MC_VB = 128 * MC_VP, MC_K_OFF = 16384, MC_V_OFF = MC_K_OFF + 2 * MC_KB, MC_LDS = MC_V_OFF + 2 * MC_VB;
typedef short v4i16_t __attribute__((ext_vector_type(4)));
__device__ __forceinline__ float pl32_max(float a) { float x = a, y = a;
    asm volatile("s_nop 1\n\tv_permlane32_swap_b32_e32 %0, %1\n\ts_nop 0" : "+v"(x), "+v"(y));
    return fmaxf(x, y); }
template <int MODE> __device__ __forceinline__ void moba_tile(AttnSt& st, const bf16x8 (&qf)[4], const LAS unsigned char* Kt, const LAS unsigned char* Vt, const LAS float* biasT, const LAS int* TB, int dlo, bool sel, int lane, int r32, int hh) {
    bf16x8 kf[4];
#pragma unroll
    for (int s = 0; s < 4; ++s) kf[s] = *(const LAS bf16x8*)(Kt + r32 * MC_KP + 32 * s + 16 * hh);
    v4i16_t vt[2][2][2];
    { const LAS unsigned char* vb = Vt + (4 * hh + ((lane & 15) >> 2)) * MC_VP + (16 * ((lane >> 4) & 1) + 4 * (lane & 3)) * 2;
#pragma unroll
      for (int dh = 0; dh < 2; ++dh)
#pragma unroll
        for (int s2 = 0; s2 < 2; ++s2)
#pragma unroll
            for (int h8 = 0; h8 < 2; ++h8) vt[dh][s2][h8] = __builtin_amdgcn_ds_read_tr16_b64_v4i16((LAS v4i16_t*)(vb + (16 * s2 + 8 * h8) * MC_VP + 64 * dh)); }
    f32x16 sc;
#pragma unroll
    for (int i = 0; i < 16; ++i) sc[i] = 0.f;
#pragma unroll
    for (int s = 0; s < 4; ++s) sc = __builtin_amdgcn_mfma_f32_32x32x16_bf16(kf[s], qf[s], sc, 0, 0, 0);
    const int d0 = dlo + r32 + 31 - 4 * hh;
    const int dmin = dlo < 0 ? 0 : dlo, dmax = dlo + 62;
    const bool uni = __builtin_amdgcn_readfirstlane(TB[dmin]) == __builtin_amdgcn_readfirstlane(TB[dmax]);
    float tmax = -INFINITY;
    if (uni) { const float bu = biasT[dmin];
#pragma unroll
        for (int r = 0; r < 16; ++r) { float v = sc[r] * (0.125f * LOG2E) + bu; if (MODE == 1) { const int dist = d0 - (r & 3) - 8 * (r >> 2); v = dist >= 0 ? v : -INFINITY; } sc[r] = v; tmax = fmaxf(tmax, v); }
    } else {
#pragma unroll
        for (int r = 0; r < 16; ++r) { const int dist = d0 - (r & 3) - 8 * (r >> 2); float v = sc[r] * (0.125f * LOG2E) + biasT[dist < 0 ? 0 : dist]; if (MODE == 1) v = dist >= 0 ? v : -INFINITY; sc[r] = v; tmax = fmaxf(tmax, v); }
    }
    if (MODE == 2) tmax = sel ? tmax : -INFINITY;
    tmax = pl32_max(tmax);
    const float mn = fmaxf(st.m, tmax);
    if (__ballot(mn > st.m) != 0ull) { const float scale = __builtin_amdgcn_exp2f(st.m - mn); st.l *= scale;
#pragma unroll
        for (int i = 0; i < 16; ++i) { st.o0[i] *= scale; st.o1[i] *= scale; } }
    st.m = mn;
    const float msub = (MODE == 2 && !sel) ? INFINITY : mn;
    float ls = 0.f;
#pragma unroll
    for (int r = 0; r < 16; ++r) { sc[r] = __builtin_amdgcn_exp2f(sc[r] - msub); ls += sc[r]; }
    st.l += ls;
    typedef unsigned u32x4_t __attribute__((ext_vector_type(4)));
#pragma unroll
    for (int s2 = 0; s2 < 2; ++s2) {
        u32x4_t pw; pw.x = pg8::cvt_pk_bf16(sc[8 * s2], sc[8 * s2 + 1]); pw.y = pg8::cvt_pk_bf16(sc[8 * s2 + 2], sc[8 * s2 + 3]); pw.z = pg8::cvt_pk_bf16(sc[8 * s2 + 4], sc[8 * s2 + 5]); pw.w = pg8::cvt_pk_bf16(sc[8 * s2 + 6], sc[8 * s2 + 7]);
        const bf16x8 pf = __builtin_bit_cast(bf16x8, pw);
        const bf16x8 a0 = {vt[0][s2][0][0], vt[0][s2][0][1], vt[0][s2][0][2], vt[0][s2][0][3], vt[0][s2][1][0], vt[0][s2][1][1], vt[0][s2][1][2], vt[0][s2][1][3]};
        const bf16x8 a1 = {vt[1][s2][0][0], vt[1][s2][0][1], vt[1][s2][0][2], vt[1][s2][0][3], vt[1][s2][1][0], vt[1][s2][1][1], vt[1][s2][1][2], vt[1][s2][1][3]};
        st.o0 = __builtin_amdgcn_mfma_f32_32x32x16_bf16(a0, pf, st.o0, 0, 0, 0);
        st.o1 = __builtin_amdgcn_mfma_f32_32x32x16_bf16(a1, pf, st.o1, 0, 0, 0);
    }
}
__device__ __forceinline__ void moba_unit(LAS unsigned char* lds, int unit, int tid, int l) {
    const int ob = unit & 7, h = (unit >> 3) & 7, b = unit >> 6, lane = tid & 63, wave = __builtin_amdgcn_readfirstlane(tid >> 6), r32 = lane & 31, hh = lane >> 5;
    LAS float* biasT = (LAS float*)lds;
    build_bias(biasT, 8 + h, tid);
    const bf16* PROJ = (const bf16*)(wsp() + WS_PROJ); const float* KBAR = (const float*)(wsp() + CTL_KBAR) + (size_t)l * 64 * 8 * 64 + ((b * NH + h) * 8) * 64; const LAS int* TB = (const LAS int*)(biasT + 2048);
    const int rowb = b * SEQ, qpos = 256 * ob + 32 * wave + r32;
    bf16x8 qf[4]; attn_loadq(qf, PROJ + CC_Q + 64 * h, rowb + qpos, hh);
    float gate[8];
#pragma unroll
    for (int n = 0; n < 8; ++n) { float s = 0.f;
        if (n < ob) {
#pragma unroll
            for (int s4 = 0; s4 < 4; ++s4) { const f32x4 k0 = *(const GAS f32x4*)(KBAR + n * 64 + 16 * s4 + 8 * hh), k1 = *(const GAS f32x4*)(KBAR + n * 64 + 16 * s4 + 8 * hh + 4);
                const v4u qw = __builtin_bit_cast(v4u, qf[s4]);
                s += bflo(qw.x) * k0.x + bfhi(qw.x) * k0.y + bflo(qw.y) * k0.z + bfhi(qw.y) * k0.w + bflo(qw.z) * k1.x + bfhi(qw.z) * k1.y + bflo(qw.w) * k1.z + bfhi(qw.w) * k1.w; }
            s += __shfl_xor(s, 32); }
        gate[n] = s; }
    unsigned selm = 0u;
#pragma unroll
    for (int n = 0; n < 8; ++n) { int rank = 0;
#pragma unroll
        for (int n2 = 0; n2 < 8; ++n2) rank += (n2 < ob && n2 != n && (gate[n2] > gate[n] || (gate[n2] == gate[n] && n2 < n))) ? 1 : 0;
        if (n < ob && rank < 3) selm |= 1u << n; }
    AttnSt st; attn_init(st);
    const int skey = tid >> 2, spart = tid & 3;
    const bf16* Kg = PROJ + (size_t)rowb * NPROJ_P + CC_K + 64 * h + 16 * spart; const bf16* Vg = PROJ + (size_t)rowb * NPROJ_P + CC_V + 64 * h + 16 * spart;
    bf16x8 gk0, gk1, gv0, gv1;
#define MC_GLOAD(i) do { const size_t ro_ = (size_t)(128 * (i) + skey) * NPROJ_P; gk0 = *(const GAS bf16x8*)(Kg + ro_); gk1 = *(const GAS bf16x8*)(Kg + ro_ + 8); gv0 = *(const GAS bf16x8*)(Vg + ro_); gv1 = *(const GAS bf16x8*)(Vg + ro_ + 8); } while (0)
#define MC_LSTORE(bf) do { LAS unsigned char* kd_ = lds + MC_K_OFF + (bf) * MC_KB + skey * MC_KP + 32 * spart; *(LAS bf16x8*)(kd_) = gk0; *(LAS bf16x8*)(kd_ + 16) = gk1; \
        LAS unsigned char* vd_ = lds + MC_V_OFF + (bf) * MC_VB + skey * MC_VP + 32 * spart; *(LAS bf16x8*)(vd_) = gv0; *(LAS bf16x8*)(vd_ + 16) = gv1; } while (0)
    const int nst = 2 * (ob + 1);
    MC_GLOAD(0); MC_LSTORE(0);
    __syncthreads();
    for (int i = 0; i < nst; ++i) {
        if (i + 1 < nst) MC_GLOAD(i + 1);
        const int n = i >> 1, hf = i & 1; const bool own = n == ob, sel = own || ((selm >> n) & 1u);
        const LAS unsigned char* Kb = lds + MC_K_OFF + (i & 1) * MC_KB; const LAS unsigned char* Vb = lds + MC_V_OFF + (i & 1) * MC_VB;
        if (own) {
#pragma unroll 1
            for (int sub = 0; sub < 4; ++sub) { const int jt = 4 * hf + sub; if (jt > wave) break; const int dlo = 32 * wave - (32 * jt + 31);
                if (jt == wave) moba_tile<1>(st, qf, Kb + sub * 32 * MC_KP, Vb + sub * 32 * MC_VP, biasT, TB, dlo, true, lane, r32, hh);
                else moba_tile<0>(st, qf, Kb + sub * 32 * MC_KP, Vb + sub * 32 * MC_VP, biasT, TB, dlo, true, lane, r32, hh); }
        } else if (__ballot(sel) != 0ull) {
#pragma unroll 1
            for (int sub = 0; sub < 4; ++sub) { const int dlo = 256 * ob + 32 * wave - (256 * n + 128 * hf + 32 * sub + 31);
                moba_tile<2>(st, qf, Kb + sub * 32 * MC_KP, Vb + sub * 32 * MC_VP, biasT, TB, dlo, sel, lane, r32, hh); }
        }
        if (i + 1 < nst) MC_LSTORE((i + 1) & 1);
        __syncthreads();
    }
#undef MC_GLOAD
#undef MC_LSTORE
    const float lt = st.l + __shfl_xor(st.l, 32);
    attn_store(st.o0, st.o1, 1.0f / lt, (bf16*)(wsp() + WS_YCAT) + (size_t)(rowb + qpos) * DM + 2 * GW + 64 * h, hh);
}

constexpr int MA_PITCH = 144, MA_ML_OFF = 512 * MA_PITCH, MA_BIAS_OFF = MA_ML_OFF + 512 * 8, MA_V_OFF = MA_BIAS_OFF + 16384, MA_VW = 32 * MC_VP, MA_LDS = MA_V_OFF + 8 * MA_VW;
template <bool MASKED> __device__ __forceinline__ void dil_tile(AttnSt& st, const bf16x8 (&qf)[4], const bf16x8 (&kf)[4], const LAS unsigned char* Vt, const LAS float* biasT, const LAS int* TB, int dl0, int dstep, int kb, int lane, int r32, int hh) {
    v4i16_t vt[2][2][2];
    { const LAS unsigned char* vb = Vt + (4 * hh + ((lane & 15) >> 2)) * MC_VP + (16 * ((lane >> 4) & 1) + 4 * (lane & 3)) * 2;
#pragma unroll
      for (int dh = 0; dh < 2; ++dh)
#pragma unroll
        for (int s2 = 0; s2 < 2; ++s2)
#pragma unroll
            for (int h8 = 0; h8 < 2; ++h8) vt[dh][s2][h8] = __builtin_amdgcn_ds_read_tr16_b64_v4i16((LAS v4i16_t*)(vb + (16 * s2 + 8 * h8) * MC_VP + 64 * dh)); }
    f32x16 sc;
#pragma unroll
    for (int i = 0; i < 16; ++i) sc[i] = 0.f;
#pragma unroll
    for (int s = 0; s < 4; ++s) sc = __builtin_amdgcn_mfma_f32_32x32x16_bf16(kf[s], qf[s], sc, 0, 0, 0);
    const int e0 = dl0 + r32 - 4 * hh;
    int dmin = (dl0 - 31) * dstep, dmax = (dl0 + 31) * dstep; dmin = dmin < 0 ? 0 : dmin; dmax = dmax > 2047 ? 2047 : dmax;
    const bool uni = __builtin_amdgcn_readfirstlane(TB[dmin]) == __builtin_amdgcn_readfirstlane(TB[dmax]);
    const float bu = biasT[dmin];
    float tmax = -INFINITY;
#pragma unroll
    for (int r = 0; r < 16; ++r) {
        const int kr0 = (r & 3) + 8 * (r >> 2), delta = e0 - kr0;
        float bias = bu;
        if (!uni) { int di = delta * dstep; di = di < 0 ? 0 : (di > 2047 ? 2047 : di); bias = biasT[di]; }
        float v = sc[r] * (0.125f * LOG2E) + bias;
        if (MASKED) { const bool ok = delta >= 0 && delta <= 128 && (kb + (kr0 + 4 * hh) * dstep) >= 0; v = ok ? v : -INFINITY; }
        sc[r] = v; tmax = fmaxf(tmax, v);
    }
    tmax = pl32_max(tmax);
    const float mn = fmaxf(st.m, tmax);
    if (__ballot(mn > st.m) != 0ull) { const float scale = __builtin_amdgcn_exp2f(st.m - mn); st.l *= scale;
#pragma unroll
        for (int i = 0; i < 16; ++i) { st.o0[i] *= scale; st.o1[i] *= scale; } }
    st.m = mn;
    float ls = 0.f;
#pragma unroll
    for (int r = 0; r < 16; ++r) { sc[r] = __builtin_amdgcn_exp2f(sc[r] - mn); ls += sc[r]; }
    st.l += ls;
    typedef unsigned u32x4_t __attribute__((ext_vector_type(4)));
#pragma unroll
    for (int s2 = 0; s2 < 2; ++s2) {
        u32x4_t pw; pw.x = pg8::cvt_pk_bf16(sc[8 * s2], sc[8 * s2 + 1]); pw.y = pg8::cvt_pk_bf16(sc[8 * s2 + 2], sc[8 * s2 + 3]); pw.z = pg8::cvt_pk_bf16(sc[8 * s2 + 4], sc[8 * s2 + 5]); pw.w = pg8::cvt_pk_bf16(sc[8 * s2 + 6], sc[8 * s2 + 7]);
        const bf16x8 pf = __builtin_bit_cast(bf16x8, pw);
        const bf16x8 a0 = {vt[0][s2][0][0], vt[0][s2][0][1], vt[0][s2][0][2], vt[0][s2][0][3], vt[0][s2][1][0], vt[0][s2][1][1], vt[0][s2][1][2], vt[0][s2][1][3]};
        const bf16x8 a1 = {vt[1][s2][0][0], vt[1][s2][0][1], vt[1][s2][0][2], vt[1][s2][0][3], vt[1][s2][1][0], vt[1][s2][1][1], vt[1][s2][1][2], vt[1][s2][1][3]};
        st.o0 = __builtin_amdgcn_mfma_f32_32x32x16_bf16(a0, pf, st.o0, 0, 0, 0);
        st.o1 = __builtin_amdgcn_mfma_f32_32x32x16_bf16(a1, pf, st.o1, 0, 0, 0);
    }
}
__device__ __forceinline__ void dil_unit(LAS unsigned char* lds, int unit, int tid) {
    const int sp = unit & 3, h = (unit >> 2) & 7, b = unit >> 5, lane = tid & 63, wave = __builtin_amdgcn_readfirstlane(tid >> 6), r32 = lane & 31, hh = lane >> 5;
    LAS float* biasT = (LAS float*)(lds + MA_BIAS_OFF);
    build_bias(biasT, h, tid);
    __syncthreads();
    const bf16* PROJ = (const bf16*)(wsp() + WS_PROJ); const LAS int* TB = (const LAS int*)(biasT + 2048); const int rowb = b * SEQ, t0 = 512 * sp;
    const bf16* Qc = PROJ + CA_Q + 64 * h; const bf16* Kc = PROJ + CA_K + 64 * h; const bf16* Vc = PROJ + CA_V + 64 * h;
    LAS unsigned char* Vst = lds + MA_V_OFF + wave * MA_VW;
    const int vkey = lane >> 1, vhalf = lane & 1;
#pragma unroll 1
    for (int p = 0; p < 3; ++p) {
        const int d = p == 0 ? 1 : (p == 1 ? 4 : 16);
#pragma unroll 1
        for (int gi = 0; gi < 2; ++gi) {
            const int g = 2 * wave + gi;
            const int qb = t0 + (p == 0 ? 32 * g : (p == 1 ? 128 * (g >> 2) + (g & 3) : g));
            const int qpos = qb + r32 * d, qi = qpos - t0;
            bf16x8 qf[4]; attn_loadq(qf, Qc, rowb + qpos, hh);
            AttnSt st; attn_init(st);
            int jt = 0; while (qb + (32 * jt - 128 + 31) * d < 0) ++jt;
            bf16x8 kfn[4], vrn[4];
#define MA_GLOAD(JT) do { const int kb_ = qb + (32 * (JT) - 128) * d; int kp_ = kb_ + r32 * d; kp_ = kp_ < 0 ? 0 : kp_; const bf16* kr_ = Kc + (size_t)(rowb + kp_) * NPROJ_P + 8 * hh; \
                _Pragma("unroll") for (int s = 0; s < 4; ++s) kfn[s] = *(const GAS bf16x8*)(kr_ + 16 * s); \
                int vp_ = kb_ + vkey * d; vp_ = vp_ < 0 ? 0 : vp_; const bf16* vr_ = Vc + (size_t)(rowb + vp_) * NPROJ_P + 32 * vhalf; \
                _Pragma("unroll") for (int s = 0; s < 4; ++s) vrn[s] = *(const GAS bf16x8*)(vr_ + 8 * s); } while (0)
            MA_GLOAD(jt);
#pragma unroll 1
            for (; jt < 5; ++jt) {
                bf16x8 kf[4] = {kfn[0], kfn[1], kfn[2], kfn[3]};
                { LAS unsigned char* vd = Vst + vkey * MC_VP + 64 * vhalf;
#pragma unroll
                  for (int s = 0; s < 4; ++s) *(LAS bf16x8*)(vd + 16 * s) = vrn[s]; }
                asm volatile("" ::: "memory");
                if (jt + 1 < 5) MA_GLOAD(jt + 1);
                const int kb = qb + (32 * jt - 128) * d, dl0 = 128 - 32 * jt;
                if (jt == 0 || jt == 4 || kb < 0) dil_tile<true>(st, qf, kf, Vst, biasT, TB, dl0, d, kb, lane, r32, hh);
                else dil_tile<false>(st, qf, kf, Vst, biasT, TB, dl0, d, kb, lane, r32, hh);
            }
#undef MA_GLOAD
            float lt = st.l + __shfl_xor(st.l, 32);
            LAS unsigned char* orow = lds + qi * MA_PITCH; LAS float* ml = (LAS float*)(lds + MA_ML_OFF + qi * 8);
            if (p > 0) {
                const float mo = ml[0], lo = ml[1], mn = fmaxf(mo, st.m), fo = __builtin_amdgcn_exp2f(mo - mn), fc = __builtin_amdgcn_exp2f(st.m - mn);
                lt = lo * fo + lt * fc;
#pragma unroll
                for (int g4 = 0; g4 < 4; ++g4) { const v2u a = *(const LAS v2u*)(orow + 2 * (8 * g4 + 4 * hh)), c = *(const LAS v2u*)(orow + 64 + 2 * (8 * g4 + 4 * hh));
                    const float av[4] = {bflo(a.x), bfhi(a.x), bflo(a.y), bfhi(a.y)}, cv[4] = {bflo(c.x), bfhi(c.x), bflo(c.y), bfhi(c.y)};
#pragma unroll
                    for (int e = 0; e < 4; ++e) { st.o0[4 * g4 + e] = av[e] * fo + st.o0[4 * g4 + e] * fc; st.o1[4 * g4 + e] = cv[e] * fo + st.o1[4 * g4 + e] * fc; } }
                st.m = mn;
            }
            if (p < 2) {
#pragma unroll
                for (int g4 = 0; g4 < 4; ++g4) { *(LAS v2u*)(orow + 2 * (8 * g4 + 4 * hh)) = (v2u){pk2(st.o0[4 * g4], st.o0[4 * g4 + 1]), pk2(st.o0[4 * g4 + 2], st.o0[4 * g4 + 3])};
                    *(LAS v2u*)(orow + 64 + 2 * (8 * g4 + 4 * hh)) = (v2u){pk2(st.o1[4 * g4], st.o1[4 * g4 + 1]), pk2(st.o1[4 * g4 + 2], st.o1[4 * g4 + 3])}; }
                if (hh == 0) { ml[0] = st.m; ml[1] = lt; }
            } else attn_store(st.o0, st.o1, 1.0f / lt, (bf16*)(wsp() + WS_YCAT) + (size_t)(rowb + qpos) * DM + 0 * GW + 64 * h, hh);
        }
        __syncthreads();
    }
}

constexpr int SG_PITCH = 144, SG_WAVE = 128 * SG_PITCH, SG_OP = 272;
static_assert(8 * SG_WAVE <= MISC_OFF && 32 * SG_OP <= SG_WAVE, "SGU LDS");
__device__ __forceinline__ void sgu_unit(LAS unsigned char* lds, int unit, int tid, int l) {
    const int lane = tid & 63, g = __builtin_amdgcn_readfirstlane(tid >> 6), r32 = lane & 31, hh = lane >> 5, m0 = unit * 128;
    const bf16* PROJ = (const bf16*)(wsp() + WS_PROJ); bf16* YC = (bf16*)(wsp() + WS_YCAT); const pg8::fx_t* ST = (const pg8::fx_t*)(wsp() + CTL_STATS) + (size_t)l * M * 2;
    const float* lng = inp(4) + l * GW; const float* sw = inp(5) + ((size_t)l * NH + g) * 128 * 128; const float* sb = inp(6) + (l * NH + g) * 128;
    LAS unsigned char* T = lds + g * SG_WAVE;
    const int tk8 = lane >> 3, part = lane & 7;
    { const f32x4 g0 = *(const GAS f32x4*)(lng + 64 * g + 8 * part), g1 = *(const GAS f32x4*)(lng + 64 * g + 8 * part + 4);
      const float gn[8] = {g0.x, g0.y, g0.z, g0.w, g1.x, g1.y, g1.z, g1.w};
#pragma unroll 4
      for (int i = 0; i < 16; ++i) { const int tkn = tk8 + 8 * i, mm = m0 + tkn;
          const v4u w = *(const GAS v4u*)(PROJ + (size_t)mm * NPROJ_P + CB_V + 64 * g + 8 * part);
          const float mu = pg8::fx_get(ST + 2 * mm) * (1.0f / 512.0f), rs = __builtin_amdgcn_rsqf(fmaxf(pg8::fx_get(ST + 2 * mm + 1) * (1.0f / 512.0f) - mu * mu, 0.f) + 1e-5f);
          float x[8] = {bflo(w.x), bfhi(w.x), bflo(w.y), bfhi(w.y), bflo(w.z), bfhi(w.z), bflo(w.w), bfhi(w.w)};
#pragma unroll
          for (int e = 0; e < 8; ++e) x[e] = (gelu_tanh(x[e]) - mu) * rs * gn[e];
          *(LAS v4u*)(T + tkn * SG_PITCH + 16 * part) = (v4u){pk2(x[0], x[1]), pk2(x[2], x[3]), pk2(x[4], x[5]), pk2(x[6], x[7])}; } }
    asm volatile("" ::: "memory");
    f32x16 acc[4][2];
    const float z_ = zero_v();
#pragma unroll
    for (int tt = 0; tt < 4; ++tt)
#pragma unroll
        for (int ct = 0; ct < 2; ++ct)
#pragma unroll
            for (int i = 0; i < 16; ++i) acc[tt][ct][i] = z_;
    const LAS unsigned char* vb = T + (8 * hh + ((lane & 15) >> 2)) * SG_PITCH + (16 * ((lane >> 4) & 1) + 4 * (lane & 3)) * 2;
#pragma unroll
    for (int k = 0; k < 8; ++k) {
        v4i16_t t00 = __builtin_amdgcn_ds_read_tr16_b64_v4i16((LAS v4i16_t*)(vb + (16 * k) * SG_PITCH)), t01 = __builtin_amdgcn_ds_read_tr16_b64_v4i16((LAS v4i16_t*)(vb + (16 * k + 4) * SG_PITCH));
        v4i16_t t10 = __builtin_amdgcn_ds_read_tr16_b64_v4i16((LAS v4i16_t*)(vb + (16 * k) * SG_PITCH + 64)), t11 = __builtin_amdgcn_ds_read_tr16_b64_v4i16((LAS v4i16_t*)(vb + (16 * k + 4) * SG_PITCH + 64));
        const bf16x8 af0 = {t00[0], t00[1], t00[2], t00[3], t01[0], t01[1], t01[2], t01[3]}, af1 = {t10[0], t10[1], t10[2], t10[3], t11[0], t11[1], t11[2], t11[3]};
#pragma unroll
        for (int tt = 0; tt < 4; ++tt) { if (k < 2 * (tt + 1)) {
                const int t = 32 * tt + r32, s0 = 16 * k + 8 * hh; const float* wrow = sw + (size_t)t * 128 + s0;
                const f32x4 w0 = *(const GAS f32x4*)(wrow), w1 = *(const GAS f32x4*)(wrow + 4);
                float wv[8] = {w0.x, w0.y, w0.z, w0.w, w1.x, w1.y, w1.z, w1.w};
#pragma unroll
                for (int j = 0; j < 8; ++j) wv[j] = (s0 + j <= t) ? wv[j] : 0.f;
                const v4u bw = {pk2(wv[0], wv[1]), pk2(wv[2], wv[3]), pk2(wv[4], wv[5]), pk2(wv[6], wv[7])}; const bf16x8 bfr = __builtin_bit_cast(bf16x8, bw);
                acc[tt][0] = __builtin_amdgcn_mfma_f32_32x32x16_bf16(af0, bfr, acc[tt][0], 0, 0, 0); acc[tt][1] = __builtin_amdgcn_mfma_f32_32x32x16_bf16(af1, bfr, acc[tt][1], 0, 0, 0); } }
    }
    asm volatile("" ::: "memory");
#pragma unroll
    for (int tt = 0; tt < 4; ++tt) {
        const float bias = sb[32 * tt + r32];
#pragma unroll
        for (int ct = 0; ct < 2; ++ct)
#pragma unroll
            for (int g4 = 0; g4 < 4; ++g4) { const f32x16& a = acc[tt][ct];
                *(LAS f32x4*)(T + r32 * SG_OP + 4 * (32 * ct + 8 * g4 + 4 * hh)) = (f32x4){a[4 * g4] + bias, a[4 * g4 + 1] + bias, a[4 * g4 + 2] + bias, a[4 * g4 + 3] + bias}; }
        asm volatile("" ::: "memory");
#pragma unroll
        for (int i = 0; i < 4; ++i) { const int tkn = tk8 + 8 * i, mm = m0 + 32 * tt + tkn;
            const v4u uw = *(const GAS v4u*)(PROJ + (size_t)mm * NPROJ_P + CB_U + 64 * g + 8 * part);
            const f32x4 x0 = *(const LAS f32x4*)(T + tkn * SG_OP + 32 * part), x1 = *(const LAS f32x4*)(T + tkn * SG_OP + 32 * part + 16);
            const float u[8] = {bflo(uw.x), bfhi(uw.x), bflo(uw.y), bfhi(uw.y), bflo(uw.z), bfhi(uw.z), bflo(uw.w), bfhi(uw.w)};
            *(GAS v4u*)(YC + (size_t)mm * DM + GW + 64 * g + 8 * part) = (v4u){pk2(gelu_tanh(u[0]) * x0.x, gelu_tanh(u[1]) * x0.y), pk2(gelu_tanh(u[2]) * x0.z, gelu_tanh(u[3]) * x0.w), pk2(gelu_tanh(u[4]) * x1.x, gelu_tanh(u[5]) * x1.y), pk2(gelu_tanh(u[6]) * x1.z, gelu_tanh(u[7]) * x1.w)}; }
        asm volatile("" ::: "memory");
    }
}

#ifndef SIMPLE_A
#define SIMPLE_A 0
#endif
#ifndef SIMPLE_B
#define SIMPLE_B 0
#endif
#ifndef SIMPLE_C
#define SIMPLE_C 0
#endif
#ifndef SIMPLE_D
#define SIMPLE_D 0
#endif
__device__ __forceinline__ void ph_mixers(LAS unsigned char* L, int l, int phase, int qoff, int wv, int mask = 31) {
    Frame F = mkframe(L, wv);
    volatile LAS int* qslot = (volatile LAS int*)(L + MISC_OFF + 64);
    gu32* ctr = ctlp() + CW_Q + 64 * phase + qoff;
    constexpr int I_IN = (DM / 64) * (NPROJ / 32), I_REST = (I8_OUT ? 0 : (DM / 64) * (DM / 32)) + (FFN1_I8 ? 0 : 2 * (DM / 64) * (DFF / 32)) + (DFF / 64) * (DM / 32);
    const int n_scan = (SIMPLE_D || !(mask & 1)) ? 0 : 128, n_c = (SIMPLE_C || !(mask & 2)) ? 0 : 512, n_a = (SIMPLE_A || !(mask & 4)) ? 0 : 256, n_b = (SIMPLE_B || !(mask & 8)) ? 0 : 128;
    const int n_cin = ((l + 1 < DEPTH) && (mask & 16)) ? (I8_IN ? NPROJ / 32 + (WINB_ITEMS + 7) / 8 : (I_IN + 7) / 8) : 0, n_crest = (mask & 16) ? (I_REST + 7) / 8 : 0, n_cout = ((I8_OUT && (mask & 16)) ? DM / 32 : 0) + ((FFN1_I8 && (mask & 16)) ? 2 * (DFF / 32) : 0);
    const int e_scan = n_scan, e_a = e_scan + n_a, e_b = e_a + n_b, e_c = e_b + n_c, e_cout = e_c + n_cout, e_cin = e_cout + n_cin, e_crest = e_cin + n_crest;
    for (;;) {
        if (F.tid == 0) *qslot = (int)__hip_atomic_fetch_add(ctr, 1u, RLX_AGENT);
        __syncthreads();
        const int it = __builtin_amdgcn_readfirstlane(*qslot);
        __syncthreads();
        if (it >= e_crest) break;
        int tid = wv * 64 + pg8::lane_now(); asm volatile("" : "+v"(tid));
        if (it < e_scan) scan_unit(L, it, tid);
        else if (it < e_a) dil_unit(L, it - e_scan, tid);
        else if (it < e_b) { sgu_unit(L, it - e_a, tid, l); __syncthreads(); }
        else if (it < e_c) { const int i2 = it - e_b; moba_unit(L, (i2 & 63) * 8 + (7 - (i2 >> 6)), tid, l); }
        else if (it < e_cout) { Frame F2 = mkframe(L, wv); int r = it - e_c;
            if (I8_OUT && r < DM / 32) conv_cols_i8(inp(19) + (size_t)l * DM * DM, DM, DM, inp(18) + l * DM, wsp() + WS_WOUT, (float*)(wsp() + WS_SMALL + SM_SWOUT), r, F2);
            else { r -= I8_OUT ? DM / 32 : 0; const int up = r >= DFF / 32 ? 1 : 0, nb = r - up * (DFF / 32), n0 = 32 * nb;
                conv_cols_i8(inp(up ? 22 : 21) + (size_t)l * DM * DFF, DM, DFF, inp(20) + l * DM, wsp() + WS_WGU, (float*)(wsp() + WS_SMALL + SM_SWGU), nb, F2, (n0 >> 7) * 256 + up * 128 + (n0 & 127)); } }
        else if (it < e_cin) { Frame F2 = mkframe(L, wv);
            if (I8_IN) { if (it - e_cout < NPROJ / 32) conv_cols_i8(inp(2) + (size_t)(l + 1) * DM * NPROJ, DM, NPROJ, inp(1) + (l + 1) * DM, wsp() + WS_WIN, (float*)(wsp() + WS_SMALL + SM_SWIN), it - e_cout, F2);
                else conv_winb(F2, l + 1, (it - e_cout - NPROJ / 32) * 8 + F2.wave); }
            else conv_layer_items(F2, l + 1, (it - e_cout) * 8 + F2.wave, 1 << 30, true, false); }
        else { Frame F2 = mkframe(L, wv); conv_layer_items(F2, l, (it - e_cin) * 8 + F2.wave, 1 << 30, false, true); }
    }
    if (!I8_IN && l + 1 < DEPTH) {
        bf16* WIN = (bf16*)(wsp() + WS_WIN);
        Frame F3 = mkframe(L, wv);
        for (int i = F3.gw * 64 + F3.lane; i < 64 * DM / 8; i += F3.ngw * 64) { v4u z = {0u, 0u, 0u, 0u}; asm volatile("" : "+v"(z)); *(GAS v4u*)(WIN + (size_t)NPROJ * DM + (size_t)i * 8) = z; }
    }
    if (SIMPLE_D) mix_d_simple(F);
    if (SIMPLE_A) mix_a_simple(F);
    if (SIMPLE_C) mix_c_simple(F, l);
    if (SIMPLE_B) mix_b_simple(F, l);
}

__device__ __forceinline__ void ph_finalize(Frame& F, int l) {
    bf16* YC = (bf16*)(wsp() + WS_YCAT); const float* YD = (const float*)(wsp() + WS_YD); const bf16* V_ = (const bf16*)outp() + (size_t)3 * M * GW; const bf16* G_ = (const bf16*)(wsp() + WS_G); const float* BC = (const float*)(wsp() + WS_BC);
    const float* lng = inp(16) + l * GW; const float* lnb = inp(17) + l * GW;
    for (int m = F.gw; m < M; m += F.ngw) {
        const int c0 = 8 * F.lane, hd = F.lane >> 3;
        float y[8];
        { const GAS f32x4* yp = (const GAS f32x4*)(YD + (size_t)m * GW + c0); const f32x4 a = yp[0], b = yp[1]; y[0] = a.x; y[1] = a.y; y[2] = a.z; y[3] = a.w; y[4] = b.x; y[5] = b.y; y[6] = b.z; y[7] = b.w; }
        float s = 0.f;
#pragma unroll
        for (int i = 0; i < 8; ++i) s += y[i];
        s += __shfl_xor(s, 1); s += __shfl_xor(s, 2); s += __shfl_xor(s, 4); const float mean = s * (1.0f / 64.0f); float q = 0.f;
#pragma unroll
        for (int i = 0; i < 8; ++i) { const float d = y[i] - mean; q += d * d; }
        q += __shfl_xor(q, 1); q += __shfl_xor(q, 2); q += __shfl_xor(q, 4); const float rstd = 1.0f / sqrtf(q * (1.0f / 64.0f) + 64e-5f);
        const v4u vw = *(const GAS v4u*)(V_ + (size_t)m * GW + c0), gw4 = *(const GAS v4u*)(G_ + (size_t)m * GW + c0); const float bc = BC[(size_t)m * NH + hd];
        float vv[8], gg[8]; UNPACK8(vv, 0, vw); UNPACK8(gg, 0, gw4);
        float ss = 0.f;
#pragma unroll
        for (int i = 0; i < 8; ++i) { y[i] = ((y[i] - mean) * rstd * lng[c0 + i] + lnb[c0 + i] + bc * vv[i]) * gg[i]; ss += y[i] * y[i]; }
        if (I8_OUT) {
            float xn[3][8], mx = 0.f;
            { const float rs = 1.0f / sqrtf(wave_sum(ss) * (1.0f / 512.0f) + NORM_EPS);
#pragma unroll
              for (int i = 0; i < 8; ++i) { y[i] *= rs; mx = fmaxf(mx, fabsf(y[i])); } }
#pragma unroll
            for (int br = 0; br < 3; ++br) {
                const v4u w = *(const GAS v4u*)(YC + (size_t)m * DM + br * GW + c0); UNPACK8(xn[br], 0, w); float s2 = 0.f;
#pragma unroll
                for (int i = 0; i < 8; ++i) s2 += xn[br][i] * xn[br][i];
                const float rs = 1.0f / sqrtf(wave_sum(s2) * (1.0f / 512.0f) + NORM_EPS);
#pragma unroll
                for (int i = 0; i < 8; ++i) { xn[br][i] *= rs; mx = fmaxf(mx, fabsf(xn[br][i])); }
            }
            mx = wave_max(mx); const float inv = mx > 0.f ? 127.0f / mx : 0.f; unsigned char* yq = wsp() + WS_YQ + (size_t)m * DM + c0;
#pragma unroll
            for (int br = 0; br < 3; ++br) *(GAS v2u*)(yq + br * GW) = (v2u){q8pack4(xn[br][0], xn[br][1], xn[br][2], xn[br][3], inv), q8pack4(xn[br][4], xn[br][5], xn[br][6], xn[br][7], inv)};
            *(GAS v2u*)(yq + 3 * GW) = (v2u){q8pack4(y[0], y[1], y[2], y[3], inv), q8pack4(y[4], y[5], y[6], y[7], inv)};
            if (F.lane == 0) ((float*)(wsp() + WS_SMALL + SM_SAY))[m] = mx * (1.0f / 127.0f);
            continue;
        }
        { const float rs = 1.0f / sqrtf(wave_sum(ss) * (1.0f / 512.0f) + NORM_EPS);
          *(GAS v4u*)(YC + (size_t)m * DM + 3 * GW + c0) = (v4u){pk2(y[0] * rs, y[1] * rs), pk2(y[2] * rs, y[3] * rs), pk2(y[4] * rs, y[5] * rs), pk2(y[6] * rs, y[7] * rs)}; }
#pragma unroll
        for (int br = 0; br < 3; ++br) {
            GAS v4u* p = (GAS v4u*)(YC + (size_t)m * DM + br * GW + c0); const v4u w = *p;
            float x[8]; UNPACK8(x, 0, w); float s2 = 0.f;
#pragma unroll
            for (int i = 0; i < 8; ++i) s2 += x[i] * x[i];
            const float rs = 1.0f / sqrtf(wave_sum(s2) * (1.0f / 512.0f) + NORM_EPS);
            *p = (v4u){pk2(x[0] * rs, x[1] * rs), pk2(x[2] * rs, x[3] * rs), pk2(x[4] * rs, x[5] * rs), pk2(x[6] * rs, x[7] * rs)};
        }
    }
}
__device__ __forceinline__ void ph_final(Frame& F) {
    const pg8::fx_t* ssq = (const pg8::fx_t*)(ctlp() + CW_SSQ) + 4 * M; const float* g = inp(24); float* out = outp(); const bf16* XB = (const bf16*)(wsp() + WS_XB);
    for (int m = F.gw; m < M; m += F.ngw) {
        GAS f32x4* orow = (GAS f32x4*)(out + (size_t)m * DM); const GAS v4u* xr = (const GAS v4u*)(XB + (size_t)m * DM) + F.lane; const GAS f32x4* gp = (const GAS f32x4*)g;
        v4u wv4[4];
#pragma unroll
        for (int j = 0; j < 4; ++j) wv4[j] = xr[64 * j];
        float ssv;
        if (I8_IN) { float sq = 0.f;
#pragma unroll
            for (int j = 0; j < 4; ++j) { const float e8[8] = {bflo(wv4[j].x), bfhi(wv4[j].x), bflo(wv4[j].y), bfhi(wv4[j].y), bflo(wv4[j].z), bfhi(wv4[j].z), bflo(wv4[j].w), bfhi(wv4[j].w)};
#pragma unroll
                for (int e = 0; e < 8; ++e) sq += e8[e] * e8[e]; }
            ssv = wave_sum(sq); }
        else ssv = pg8::fx_get(ssq + m);
        const float rs = 1.0f / sqrtf(ssv * (1.0f / 2048.0f) + NORM_EPS);
#pragma unroll
        for (int j = 0; j < 4; ++j) { const v4u w = wv4[j]; const int c4 = 2 * (F.lane + 64 * j); const f32x4 g0 = gp[c4], g1 = gp[c4 + 1];
            orow[c4] = (f32x4){bflo(w.x) * rs * g0.x, bfhi(w.x) * rs * g0.y, bflo(w.y) * rs * g0.z, bfhi(w.y) * rs * g0.w};
            orow[c4 + 1] = (f32x4){bflo(w.z) * rs * g1.x, bfhi(w.z) * rs * g1.y, bflo(w.w) * rs * g1.z, bfhi(w.w) * rs * g1.w}; }
    }
}

#ifndef STAG
#define STAG 500
#endif
__device__ __forceinline__ void phase_stagger(int ticks) {
    const int grp = ((int)blockIdx.x >> 3) & 3;
    if (ticks > 0 && grp > 0) { const unsigned long long t0 = __builtin_amdgcn_s_memrealtime(); while ((long long)(__builtin_amdgcn_s_memrealtime() - t0) < (long long)grp * ticks) __builtin_amdgcn_s_sleep(32); }
}
__global__ void __launch_bounds__(NTHR, 2) hy_fwd(Args args) {
    extern __shared__ __attribute__((aligned(16))) unsigned char lds[];
    LAS unsigned char* L = (LAS unsigned char*)lds;
    volatile LAS unsigned* MISC = (volatile LAS unsigned*)(L + MISC_OFF);
    const int wv = __builtin_amdgcn_readfirstlane((int)threadIdx.x >> 6);
    if (wv == 0) MISC[pg8::lane_now()] = 0u;
    __syncthreads();
    XcdBarrier bar; bar.bar = (unsigned*)(ctlp() + CW_BAR); bar.x = 0; bar.st = nullptr; bar.wv = wv;
    if (N_LAUNCH_MODE == 0) bar = xcd_barrier_post((unsigned*)(ctlp() + CW_BAR), MISC + 8, wv);
    const int lo = args.ph_lo, hi = args.ph_hi;
#define IN(k) (lo <= (k) && (k) < hi)
#define SEAM(k) do { if (IN(k) && IN((k) + 1)) xcd_barrier(bar); } while (0)
    if (IN(0)) { Frame F = mkframe(L, wv); ph_prologue(F); if (REPEAT == 1) ph_prologue(F); }
    SEAM(0);
    auto layer = [&](const int l) __attribute__((always_inline)) {
        const int P = 1 + 9 * l;
        if (IN(P)) { phase_stagger(STAG);
            unsigned char* ws = wsp(); pg8::Gemm g{(const bf16*)(ws + WS_XB), (const bf16*)(ws + WS_WIN), M, NPROJ_P, DM, wv}; pg8::StaticOrder S; S.init(M, NPROJ_P, gridDim.x, (int)blockIdx.x);
            pg8::EpiProj E{(bf16*)(ws + WS_PROJ), NPROJ_P, (const pg8::fx_t*)((gu32*)ws + CW_SSQ) + (size_t)(2 * l) * M, (float*)(ws + CTL_KBAR) + (size_t)l * 64 * 8 * 64, (pg8::fx_t*)(ws + CTL_STATS) + (size_t)l * M * 2,
                           (const float*)(ws + WS_SMALL + SM_SAX), (const float*)(ws + WS_SMALL + SM_SWIN)};
            if (I8_IN) { g.A = (const bf16*)(ws + WS_XQ); pg8::MaskOrder S1; S1.init(M, 0xFFFFFFu & ~BFMASK, gridDim.x, (int)blockIdx.x);
                pg8::gemm_phase<pg8::EpiProj, pg8::MaskOrder, true, PG8_SP2, 1>(L + RING_OFF, g, S1, E);
                if (BFMASK) { pg8::Gemm gb{(const bf16*)(ws + WS_XB), winb_ptr(), M, NPROJ_P, DM, wv}; pg8::MaskOrder S2; S2.init(M, BFMASK, gridDim.x, (int)blockIdx.x);
                    pg8::gemm_phase<pg8::EpiProj, pg8::MaskOrder, true, PG8_SP2>(L + RING_OFF, gb, S2, E); } }
            else pg8::gemm_phase<pg8::EpiProj, pg8::StaticOrder, true, PG8_SP2>(L + RING_OFF, g, S, E);
            if (REPEAT == 21) { pg8::EpiNull E0{(float*)(ws + WS_YCAT)}; pg8::MaskOrder S1; S1.init(M, 0xFFFFFFu, gridDim.x, (int)blockIdx.x); pg8::gemm_phase<pg8::EpiNull, pg8::MaskOrder, true, PG8_SP2, 1>(L + RING_OFF, g, S1, E0); }
            if (REPEAT == 23) { pg8::EpiProjDense E3{(bf16*)(ws + WS_YCAT), E.ssq, E.sa, E.sw}; pg8::MaskOrder S1; S1.init(M, 0xFFFFFFu, gridDim.x, (int)blockIdx.x); pg8::gemm_phase<pg8::EpiProjDense, pg8::MaskOrder, true, PG8_SP2, 1>(L + RING_OFF, g, S1, E3); }
            if (REPEAT == 22) { pg8::EpiProj E2 = E; E2.kbar = (float*)(ws + WS_YCAT + 32 * MiB); E2.stats = (pg8::fx_t*)(ws + WS_YCAT + 40 * MiB); E2.O = (bf16*)(ws + WS_YCAT); E2.ldc = 256;
                pg8::MaskOrder S1; S1.init(M, 0xFFFFFFu, gridDim.x, (int)blockIdx.x); pg8::gemm_phase<pg8::EpiProj, pg8::MaskOrder, true, PG8_SP2, 1>(L + RING_OFF, g, S1, E2); }
            if (REPEAT == 2) { pg8::EpiProj E2 = E; E2.kbar = (float*)(ws + WS_YCAT); E2.stats = (pg8::fx_t*)(ws + WS_YCAT + 8 * MiB);
                if (I8_IN) { pg8::MaskOrder S1; S1.init(M, 0xFFFFFFu & ~BFMASK, gridDim.x, (int)blockIdx.x); pg8::gemm_phase<pg8::EpiProj, pg8::MaskOrder, true, PG8_SP2, 1>(L + RING_OFF, g, S1, E2);
                    if (BFMASK) { pg8::Gemm gb{(const bf16*)(ws + WS_XB), winb_ptr(), M, NPROJ_P, DM, wv}; pg8::MaskOrder S2; S2.init(M, BFMASK, gridDim.x, (int)blockIdx.x); pg8::gemm_phase<pg8::EpiProj, pg8::MaskOrder, true, PG8_SP2>(L + RING_OFF, gb, S2, E2); } }
                else pg8::gemm_phase<pg8::EpiProj, pg8::StaticOrder, true, PG8_SP2>(L + RING_OFF, g, S, E2); }
        }
        SEAM(P);
        if (IN(P + 1)) { Frame F = mkframe(L, wv); ph_prep(F, l); if (REPEAT == 3) ph_prep(F, l); }
        SEAM(P + 1);
        if (IN(P + 2)) { ph_mixers(L, l, P + 2, 0, wv); if (REPEAT == 4) ph_mixers(L, l, P + 2, 32, wv); if (REPEAT >= 40 && REPEAT < 50) ph_mixers(L, l, P + 2, 32, wv, REPEAT == 41 ? 1 : (REPEAT == 42 ? 2 : (REPEAT == 43 ? 4 : (REPEAT == 44 ? 8 : 16)))); if (REPEAT >= 430 && REPEAT < 446) ph_mixers(L, l, P + 2, 32, wv, 4); }
        SEAM(P + 2);
        if (IN(P + 3)) { Frame F = mkframe(L, wv); ph_finalize(F, l); if (REPEAT == 5) ph_finalize(F, l); }
        SEAM(P + 3);
        if (IN(P + 4)) { phase_stagger(STAG);
            unsigned char* ws = wsp(); pg8::Gemm g{(const bf16*)(ws + WS_YCAT), (const bf16*)(ws + WS_WOUT), M, DM, DM, wv}; pg8::StaticOrder S; S.init(M, DM, gridDim.x, (int)blockIdx.x);
            pg8::EpiRes E{(bf16*)(ws + WS_XB), FFN1_I8 ? (pg8::fx_t*)nullptr : (pg8::fx_t*)((gu32*)ws + CW_SSQ) + (size_t)(2 * l + 1) * M, DM, (FFN_FP8 && !FFN1_I8) ? (unsigned char*)(ws + WS_SC2) : nullptr, 1.0f, (const float*)(ws + WS_SMALL + SM_SAY), (const float*)(ws + WS_SMALL + SM_SWOUT)};
            if (I8_OUT) { g.A = (const bf16*)(ws + WS_YQ); pg8::gemm_phase<pg8::EpiRes, pg8::StaticOrder, true, PG8_SP2, 1>(L + RING_OFF, g, S, E); }
            else pg8::gemm_phase<pg8::EpiRes, pg8::StaticOrder, true, PG8_SP2>(L + RING_OFF, g, S, E);
            if (REPEAT == 7) { pg8::EpiRes E2 = E; E2.xb = (bf16*)(ws + WS_YCAT); E2.ssq = (pg8::fx_t*)(ws + WS_G); E2.xf = (unsigned char*)(ws + WS_YD);
                if (I8_OUT) pg8::gemm_phase<pg8::EpiRes, pg8::StaticOrder, true, PG8_SP2, 1>(L + RING_OFF, g, S, E2); else pg8::gemm_phase<pg8::EpiRes, pg8::StaticOrder, true, PG8_SP2>(L + RING_OFF, g, S, E2); }
        }
        SEAM(P + 4);
        if (FFN1_I8) { if (IN(P + 5)) { Frame F = mkframe(L, wv); ph_quantx(F, (pg8::fx_t*)(ctlp() + CW_SSQ) + (size_t)(2 * l + 1) * M); } SEAM(P + 5); }
        if (IN(P + 6)) {
            unsigned char* ws = wsp(); pg8::Gemm g{(const bf16*)(ws + (FFN1_I8 ? WS_XQ : (FFN_FP8 ? WS_SC2 : WS_XB))), (const bf16*)(ws + WS_WGU), M, 2 * DFF, DM, wv}; pg8::StaticOrder S; S.init(M, 2 * DFF, gridDim.x, (int)blockIdx.x);
            if (FFN_FP8) { pg8::EpiGU8 E{(unsigned char*)(ws + WS_PROJ), DFF, (const pg8::fx_t*)((gu32*)ws + CW_SSQ) + (size_t)(2 * l + 1) * M, FFN1_I8 ? 1.0f : 1.0f / 64.0f, 8.0f, (const float*)(ws + WS_SMALL + SM_SAX), (const float*)(ws + WS_SMALL + SM_SWGU)};
                if (FFN1_I8) pg8::gemm_phase<pg8::EpiGU8, pg8::StaticOrder, true, PG8_SP2, 1>(L + RING_OFF, g, S, E);
                else pg8::gemm_phase_f8<pg8::EpiGU8, pg8::StaticOrder, true, PG8_SP2>(L + RING_OFF, g, S, E);
                if (REPEAT == 6) { if (FFN1_I8) pg8::gemm_phase<pg8::EpiGU8, pg8::StaticOrder, true, PG8_SP2, 1>(L + RING_OFF, g, S, E); else pg8::gemm_phase_f8<pg8::EpiGU8, pg8::StaticOrder, true, PG8_SP2>(L + RING_OFF, g, S, E); }
            } else { pg8::EpiGU E{(bf16*)(ws + WS_PROJ), DFF, (const pg8::fx_t*)((gu32*)ws + CW_SSQ) + (size_t)(2 * l + 1) * M, 1.0f};
                pg8::gemm_phase<pg8::EpiGU, pg8::StaticOrder, true, PG8_SP2>(L + RING_OFF, g, S, E);
                if (REPEAT == 6) pg8::gemm_phase<pg8::EpiGU, pg8::StaticOrder, true, PG8_SP2>(L + RING_OFF, g, S, E); }
        }
        SEAM(P + 6);
        if (IN(P + 7)) { phase_stagger(STAG);
            unsigned char* ws = wsp(); pg8::Gemm g{(const bf16*)(ws + WS_PROJ), (const bf16*)(ws + WS_WDN), M, DM, DFF, wv}; pg8::StaticOrder S; S.init(M, DM, gridDim.x, (int)blockIdx.x);
            pg8::EpiRes E{(bf16*)(ws + WS_XB), I8_IN ? (pg8::fx_t*)nullptr : (pg8::fx_t*)((gu32*)ws + CW_SSQ) + (size_t)(2 * l + 2) * M, DM, nullptr, FFN_FP8 ? 1.0f / 512.0f : 1.0f, nullptr, nullptr};
            if (FFN_FP8) pg8::gemm_phase_f8<pg8::EpiRes, pg8::StaticOrder, true, PG8_SP2>(L + RING_OFF, g, S, E);
            else pg8::gemm_phase<pg8::EpiRes, pg8::StaticOrder, true, PG8_SP2>(L + RING_OFF, g, S, E);
            if (REPEAT == 8) { pg8::EpiRes E2 = E; E2.xb = (bf16*)(ws + WS_YCAT); E2.ssq = (pg8::fx_t*)(ws + WS_G);
                if (FFN_FP8) pg8::gemm_phase_f8<pg8::EpiRes, pg8::StaticOrder, true, PG8_SP2>(L + RING_OFF, g, S, E2); else pg8::gemm_phase<pg8::EpiRes, pg8::StaticOrder, true, PG8_SP2>(L + RING_OFF, g, S, E2); }
        }
        SEAM(P + 7);
        if (l + 1 < DEPTH) { if (I8_IN && IN(P + 8)) { Frame F = mkframe(L, wv); ph_quantx(F, (pg8::fx_t*)(ctlp() + CW_SSQ) + (size_t)(2 * l + 2) * M); } if (I8_IN) SEAM(P + 8); }
    };
    static_assert(DEPTH == 2, "layers are expanded by hand");
    layer(0); layer(1);
    if (IN(19)) { Frame F = mkframe(L, wv); ph_final(F); }
#undef IN
#undef SEAM
}

extern "C" void kernel_launch(void* const* d_in, const int* in_sizes, int n_in, void* d_out, int out_size, void* d_ws, size_t ws_size, hipStream_t stream) {
    static int grid = 0;
    if (grid == 0) {
        if (n_in != 25 || in_sizes[0] != M * DM || out_size != M * DM || ws_size < WS_END) { fprintf(stderr, "kernel_launch: shape/workspace mismatch: n_in %d in0 %d out %d ws %zu (need %zu)\n", n_in, n_in > 0 ? in_sizes[0] : -1, out_size, ws_size, (size_t)WS_END); grid = -1; return; }
        int dev = 0, cus = 0, per_cu = 0;
        if (hipGetDevice(&dev) != hipSuccess || hipDeviceGetAttribute(&cus, hipDeviceAttributeMultiprocessorCount, dev) != hipSuccess) { grid = -1; return; }
        if (hipFuncSetAttribute((const void*)hy_fwd, hipFuncAttributeMaxDynamicSharedMemorySize, LDS_BYTES) != hipSuccess) { fprintf(stderr, "kernel_launch: hipFuncSetAttribute failed\n"); grid = -1; return; }
        if (hipOccupancyMaxActiveBlocksPerMultiprocessor(&per_cu, (const void*)hy_fwd, NTHR, LDS_BYTES) != hipSuccess || per_cu < 1) fprintf(stderr, "kernel_launch: occupancy query reports %d\n", per_cu);
        (void)hipGetLastError();
        grid = cus;
    }
    if (grid < 0) return;
    if (hipMemsetAsync((char*)d_ws + WS_CTL, 0, CTL_ZERO_BYTES, stream) != hipSuccess) return;
    Args a{};
    for (int i = 0; i < 25; ++i) a.in[i] = (const float*)d_in[i];
    a.out = (float*)d_out; a.ws = (unsigned char*)d_ws;
    if (N_LAUNCH_MODE == 0) { a.ph_lo = 0; a.ph_hi = N_PHASES; hipLaunchKernelGGL(hy_fwd, dim3(grid), dim3(NTHR), LDS_BYTES, stream, a); }
    else for (int p = 0; p < N_PHASES; ++p) { a.ph_lo = p; a.ph_hi = p + 1; hipLaunchKernelGGL(hy_fwd, dim3(grid), dim3(NTHR), LDS_BYTES, stream, a); }
}
```

```cpp
#define N_LAUNCH_MODE 0
#define REPEAT 0
#define PG8_SP2 true
#define FFN_FP8 1
#define GEMM_I8 3
#define STAG 0
#define FFN1_I8 1
#define BFMASK 0x0u
#include <hip/hip_runtime.h>
#include <cstdio>
#include <cstdint>
namespace pg8 {
#define PG8_LAS __attribute__((address_space(3)))
typedef unsigned short bf16_t;
typedef short bf16x8 __attribute__((ext_vector_type(8)));
typedef float f32x4 __attribute__((ext_vector_type(4)));
typedef unsigned u32x4 __attribute__((ext_vector_type(4)));
constexpr int BM = 256, BK = 64, HALF = 128, HTB = HALF * BK * 2  , STAGE_BYTES = 8 * HTB, NXCD = 8, WGM = 8;

__host__ __device__ __forceinline__ int lds_byte(int r, int c) { const int st = (r >> 4) * 2 + (c >> 5), rr = r & 15, cc = c & 31, ob = rr * 64 + cc * 2; return st * 1024 + (ob ^ (((ob >> 9) & 1) << 5)); }
__host__ __device__ __forceinline__ void stage_rc(int b, int& R, int& C) { const int st = b / 1024, sb = b % 1024, swz = sb ^ (((sb >> 9) & 1) << 5); R = (st >> 1) * 16 + swz / 64; C = (st & 1) * 32 + (swz % 64) / 2; }
__host__ __device__ __forceinline__ int perm32(int rho) { const int n = rho >> 4, i = rho & 15; return 8 * (i >> 2) + 4 * n + (i & 3); }

__device__ __forceinline__ int lane_now() { int l; asm volatile("v_mbcnt_lo_u32_b32 %0, -1, 0\n\tv_mbcnt_hi_u32_b32 %0, -1, %0" : "=v"(l)); return l; }
struct Unit { int pm, pn; };
struct Gemm { const bf16_t* A; const bf16_t* Bt; int M, N, K, wv; int same = 0; };

struct StaticOrder {
    int nM, nN, nwg, G, c;
    __host__ __device__ void init(int M, int N, int G_, int c_) { nM = M / BM; nN = N / BM; nwg = nM * nN; G = G_; c = c_; }
    __host__ __device__ bool next(int i, Unit& u) const {
        const long L = (long)i * G + c; if (L >= nwg) return false;
        int wgid = (int)L; { const int q = nwg / NXCD, r = nwg % NXCD, xcd = wgid % NXCD, off = wgid / NXCD; wgid = (xcd < r ? xcd * (q + 1) : r * (q + 1) + (xcd - r) * q) + off; }
        const int nig = WGM * nN, gid = wgid / nig, fm = gid * WGM, gsz = (nM - fm) < WGM ? (nM - fm) : WGM;
        u.pm = fm + ((wgid % nig) % gsz); u.pn = (wgid % nig) / gsz; return true;
    }
    __device__ __forceinline__ void a_ready(const Unit&) const {}
    __device__ __forceinline__ void done(const Unit&) const {}
};

struct MapOrder {
    StaticOrder s; int from, add;
    __device__ __forceinline__ bool next(int i, Unit& u) const { if (!s.next(i, u)) return false; if (u.pn >= from) u.pn += add; return true; }
    __device__ __forceinline__ void a_ready(const Unit&) const {}
    __device__ __forceinline__ void done(const Unit&) const {}
};

struct MaskOrder {
    StaticOrder s; unsigned mask;
    __device__ __forceinline__ void init(int M, unsigned mask_, int G_, int c_) { mask = mask_; s.init(M, BM * __builtin_popcount(mask_), G_, c_); }
    __device__ __forceinline__ bool next(int i, Unit& u) const { if (!s.next(i, u)) return false; unsigned m = mask; for (int j = 0; j < u.pn; ++j) m &= m - 1; u.pn = __builtin_ctz(m); return true; }
    __device__ __forceinline__ void a_ready(const Unit&) const {}
    __device__ __forceinline__ void done(const Unit&) const {}
};

__device__ __forceinline__ unsigned cvt_pk_bf16(float lo, float hi) { unsigned r; asm volatile("v_cvt_pk_bf16_f32 %0, %1, %2" : "=v"(r) : "v"(lo), "v"(hi)); return r; }
typedef float f32x2 __attribute__((ext_vector_type(2)));

typedef unsigned u32x2 __attribute__((ext_vector_type(2)));
typedef unsigned long long fx_t;
__device__ __forceinline__ void fx_add(fx_t* p, float v) { atomicAdd(p, (fx_t)(long long)__float2ll_rn(v * 1073741824.0f)); }
__device__ __forceinline__ float fx_get(const fx_t* p) { return (float)(long long)(*p) * (1.0f / 1073741824.0f); }
__device__ __forceinline__ float epi_gelu(float x) { const float u = 0.7978845608028654f * (x + 0.044715f * x * x * x); const float e2 = __expf(2.0f * u); return x - x * __builtin_amdgcn_rcpf(e2 + 1.0f); }
template <int CTRL> __device__ __forceinline__ float epi_dpp_add(float x) { const int y = __builtin_amdgcn_update_dpp(0, __builtin_bit_cast(int, x), CTRL, 0xF, 0xF, false); return x + __builtin_bit_cast(float, y); }
typedef int i32x4_t __attribute__((ext_vector_type(4)));
__device__ __forceinline__ f32x4 acc_f(const f32x4& v) { return v; }
__device__ __forceinline__ f32x4 acc_f(const i32x4_t& v) { return __builtin_convertvector(v, f32x4); }
template <class T> struct AccIsInt { static constexpr bool v = false; };
template <> struct AccIsInt<i32x4_t> { static constexpr bool v = true; };
__device__ __forceinline__ void epi_prefetch(const fx_t* ssq_rows, const float* sa_rows, const float* sw_cols, PG8_LAS unsigned char* slot, int wid) {
    const int ln = lane_now();
    __builtin_amdgcn_global_load_lds((const __attribute__((address_space(1))) unsigned*)((const unsigned*)ssq_rows + wid * 64 + ln), (PG8_LAS unsigned*)(slot + wid * 256), 4, 0, 0);
    if (sa_rows) { const float* src = wid < 4 ? sa_rows + wid * 64 : sw_cols + (wid - 4) * 64;
        __builtin_amdgcn_global_load_lds((const __attribute__((address_space(1))) unsigned*)((const unsigned*)src + ln), (PG8_LAS unsigned*)(slot + 2048 + wid * 256), 4, 0, 0); }
}
__device__ __forceinline__ float fx_getl(const PG8_LAS unsigned char* slot, int rloc) { return (float)(long long)(*(const PG8_LAS fx_t*)(slot + 8 * rloc)) * (1.0f / 1073741824.0f); }
struct EpiProj {
    static constexpr bool PERM = true, AFTER_DRAIN = false, PREFETCH = true;
    bf16_t* O; int ldc; const fx_t* ssq; float* kbar; fx_t* stats; const float* sa; const float* sw;
    __device__ __forceinline__ void prefetch(const Unit& u, PG8_LAS unsigned char* slot, int wid) const { epi_prefetch(ssq + u.pm * BM, sa ? sa + u.pm * BM : nullptr, sw + u.pn * BM, slot, wid); }
    template <class AccT> __device__ __forceinline__ void operator()(const AccT (&acc)[2][2][4][2], const Unit& u, int wr, int wc, int fr, int fq, const PG8_LAS unsigned char* slot) const {
        constexpr bool Q = AccIsInt<AccT>::v;
        const int row0 = u.pm * BM + wr * 64 + fr, col0 = u.pn * BM + wc * 32 + 8 * fq;
        f32x4 cw[2][2];
        if constexpr (Q) {
#pragma unroll
            for (int bj = 0; bj < 2; ++bj) { const PG8_LAS float* p = (const PG8_LAS float*)(slot + 3072) + bj * HALF + wc * 32 + 8 * fq; cw[bj][0] = *(const PG8_LAS f32x4*)p; cw[bj][1] = *(const PG8_LAS f32x4*)(p + 4); } }
        const bool do_k = (u.pn == 12 || u.pn == 13), do_s = (u.pn == 8 || u.pn == 9);
        float cs[2][8];
#pragma unroll
        for (int bj = 0; bj < 2; ++bj)
#pragma unroll
            for (int e = 0; e < 8; ++e) cs[bj][e] = 0.f;
#pragma unroll
        for (int ai = 0; ai < 2; ++ai)
#pragma unroll
            for (int m = 0; m < 4; ++m) { const int row = row0 + ai * HALF + m * 16; const int rloc = ai * HALF + wr * 64 + m * 16 + fr; float rs = __builtin_amdgcn_rsqf(fx_getl(slot, rloc) * (1.0f / 2048.0f) + 1e-6f); if constexpr (Q) rs *= *(const PG8_LAS float*)(slot + 2048 + 4 * rloc);
                bf16_t* rowp = O + (size_t)row * ldc + col0; float s1 = 0.f, s2 = 0.f;
#pragma unroll
                for (int bj = 0; bj < 2; ++bj) { f32x4 v0 = acc_f(acc[ai][bj][m][0]) * rs, v1 = acc_f(acc[ai][bj][m][1]) * rs; if constexpr (Q) { v0 *= cw[bj][0]; v1 *= cw[bj][1]; }
                    u32x4 w; w.x = cvt_pk_bf16(v0[0], v0[1]); w.y = cvt_pk_bf16(v0[2], v0[3]); w.z = cvt_pk_bf16(v1[0], v1[1]); w.w = cvt_pk_bf16(v1[2], v1[3]);
                    *(u32x4*)(rowp + bj * HALF) = w;
                    if (do_k) {
#pragma unroll
                        for (int e = 0; e < 4; ++e) { cs[bj][e] += v0[e]; cs[bj][4 + e] += v1[e]; } }
                    if (do_s) {
#pragma unroll
                        for (int e = 0; e < 4; ++e) { const float g0 = epi_gelu(v0[e]), g1 = epi_gelu(v1[e]); s1 += g0 + g1; s2 += g0 * g0 + g1 * g1; } } }
                if (do_s) { s1 += __shfl_xor(s1, 16); s1 += __shfl_xor(s1, 32); s2 += __shfl_xor(s2, 16); s2 += __shfl_xor(s2, 32);
                    if (fq == 0) { fx_add(stats + 2 * row, s1); fx_add(stats + 2 * row + 1, s2); } } }
        if (do_k) {
            const int bidx = (u.pm >> 3) * 8, n = u.pm & 7;
#pragma unroll
            for (int bj = 0; bj < 2; ++bj)
#pragma unroll
                for (int e = 0; e < 8; ++e) { float s = cs[bj][e]; s = epi_dpp_add<0xB1>(s); s = epi_dpp_add<0x4E>(s); s = epi_dpp_add<0x141>(s); s = epi_dpp_add<0x140>(s);
                    const int ck = col0 + bj * HALF + e - 3072;
                    if (fr == 0) unsafeAtomicAdd(kbar + ((bidx + (ck >> 6)) * 8 + n) * 64 + (ck & 63), s * (1.0f / 256.0f)); } }
    }
};
struct EpiGU {
    static constexpr bool PERM = true, AFTER_DRAIN = false, PREFETCH = false;
    bf16_t* O; int ldc; const fx_t* ssq; float oscale;
    __device__ __forceinline__ void operator()(const f32x4 (&acc)[2][2][4][2], const Unit& u, int wr, int wc, int fr, int fq, const PG8_LAS unsigned char* slot) const {
        const int row0 = u.pm * BM + wr * 64 + fr, col0 = u.pn * HALF + wc * 32 + 8 * fq;
#pragma unroll
        for (int ai = 0; ai < 2; ++ai)
#pragma unroll
            for (int m = 0; m < 4; ++m) { const int row = row0 + ai * HALF + m * 16; const float rs = __builtin_amdgcn_rsqf(fx_get(ssq + row) * (1.0f / 2048.0f) + 1e-6f) * oscale;
                float o[8];
#pragma unroll
                for (int n = 0; n < 2; ++n)
#pragma unroll
                    for (int e = 0; e < 4; ++e) { const float g = acc[ai][0][m][n][e] * rs, up = acc[ai][1][m][n][e] * rs;
                        o[n * 4 + e] = g * __builtin_amdgcn_rcpf(1.0f + __builtin_amdgcn_exp2f(-1.4426950408889634f * g)) * up; }
                u32x4 w; w.x = cvt_pk_bf16(o[0], o[1]); w.y = cvt_pk_bf16(o[2], o[3]); w.z = cvt_pk_bf16(o[4], o[5]); w.w = cvt_pk_bf16(o[6], o[7]);
                *(u32x4*)(O + (size_t)row * ldc + col0) = w; }
    }
};
__device__ __forceinline__ float epi_clamp8(float v) { return __builtin_amdgcn_fmed3f(v, -448.0f, 448.0f); }
struct EpiGU8 {
    static constexpr bool PERM = true, AFTER_DRAIN = false, PREFETCH = true;
    __device__ __forceinline__ void prefetch(const Unit& u, PG8_LAS unsigned char* slot, int wid) const { epi_prefetch(ssq + u.pm * BM, sa ? sa + u.pm * BM : nullptr, sw + u.pn * BM, slot, wid); }
    unsigned char* O; int ldc; const fx_t* ssq; float oscale, ascale; const float* sa; const float* sw;
    template <class AccT> __device__ __forceinline__ void operator()(const AccT (&acc)[2][2][4][2], const Unit& u, int wr, int wc, int fr, int fq, const PG8_LAS unsigned char* slot) const {
        constexpr bool Q = AccIsInt<AccT>::v;
        const int row0 = u.pm * BM + wr * 64 + fr, col0 = u.pn * HALF + wc * 32 + 8 * fq;
        f32x4 cw[2][2];
        if constexpr (Q) {
#pragma unroll
            for (int bj = 0; bj < 2; ++bj) { const PG8_LAS float* p = (const PG8_LAS float*)(slot + 3072) + bj * HALF + wc * 32 + 8 * fq; cw[bj][0] = *(const PG8_LAS f32x4*)p; cw[bj][1] = *(const PG8_LAS f32x4*)(p + 4); } }
#pragma unroll
        for (int ai = 0; ai < 2; ++ai)
#pragma unroll
            for (int m = 0; m < 4; ++m) { const int row = row0 + ai * HALF + m * 16; const int rloc = ai * HALF + wr * 64 + m * 16 + fr; float rs = __builtin_amdgcn_rsqf(fx_getl(slot, rloc) * (1.0f / 2048.0f) + 1e-6f) * oscale; if constexpr (Q) rs *= *(const PG8_LAS float*)(slot + 2048 + 4 * rloc);
                float o[8];
#pragma unroll
                for (int n = 0; n < 2; ++n) { f32x4 gv = acc_f(acc[ai][0][m][n]) * rs, uv = acc_f(acc[ai][1][m][n]) * rs; if constexpr (Q) { gv *= cw[0][n]; uv *= cw[1][n]; }
#pragma unroll
                    for (int e = 0; e < 4; ++e) { const float g = gv[e], up = uv[e];
                        o[n * 4 + e] = epi_clamp8(g * __builtin_amdgcn_rcpf(1.0f + __builtin_amdgcn_exp2f(-1.4426950408889634f * g)) * up * ascale); } }
                int f0 = __builtin_bit_cast(int, o[0]), f1 = __builtin_bit_cast(int, o[4]);
                f0 = __builtin_amdgcn_cvt_pk_fp8_f32(o[0], o[1], f0, false); f0 = __builtin_amdgcn_cvt_pk_fp8_f32(o[2], o[3], f0, true);
                f1 = __builtin_amdgcn_cvt_pk_fp8_f32(o[4], o[5], f1, false); f1 = __builtin_amdgcn_cvt_pk_fp8_f32(o[6], o[7], f1, true);
                *(u32x2*)(O + (size_t)row * ldc + col0) = (u32x2){(unsigned)f0, (unsigned)f1}; }
    }
};
struct EpiRes {
    static constexpr bool PERM = true, AFTER_DRAIN = false, PREFETCH = false;
    bf16_t* xb; fx_t* ssq; int ldc; unsigned char* xf; float oscale; const float* sa; const float* sw;
    template <class AccT> __device__ __forceinline__ void operator()(const AccT (&acc)[2][2][4][2], const Unit& u, int wr, int wc, int fr, int fq, const PG8_LAS unsigned char* slot) const {
        constexpr bool Q = AccIsInt<AccT>::v;
        const int row0 = u.pm * BM + wr * 64 + fr, col0 = u.pn * BM + wc * 32 + 8 * fq;
        f32x4 cw[2][2];
        if constexpr (Q) {
#pragma unroll
            for (int bj = 0; bj < 2; ++bj) { cw[bj][0] = *(const f32x4*)(sw + col0 + bj * HALF); cw[bj][1] = *(const f32x4*)(sw + col0 + bj * HALF + 4); } }
#pragma unroll
        for (int ai = 0; ai < 2; ++ai)
#pragma unroll
            for (int m = 0; m < 4; ++m) { const int row = row0 + ai * HALF + m * 16; bf16_t* rowp = xb + (size_t)row * ldc + col0; float s = 0.f; float osc = oscale; if constexpr (Q) osc = sa[row];
                u32x4 b[2];
#pragma unroll
                for (int bj = 0; bj < 2; ++bj) b[bj] = *(const u32x4*)(rowp + bj * HALF);
#pragma unroll
                for (int bj = 0; bj < 2; ++bj) { float o[8]; f32x4 a2[2] = {acc_f(acc[ai][bj][m][0]), acc_f(acc[ai][bj][m][1])}; if constexpr (Q) { a2[0] *= cw[bj][0]; a2[1] *= cw[bj][1]; }
#pragma unroll
                    for (int q = 0; q < 4; ++q) { o[2 * q] = __builtin_fmaf(a2[q >> 1][2 * (q & 1)], osc, __builtin_bit_cast(float, b[bj][q] << 16)); o[2 * q + 1] = __builtin_fmaf(a2[q >> 1][2 * (q & 1) + 1], osc, __builtin_bit_cast(float, b[bj][q] & 0xffff0000u)); }
                    u32x4 w; w.x = cvt_pk_bf16(o[0], o[1]); w.y = cvt_pk_bf16(o[2], o[3]); w.z = cvt_pk_bf16(o[4], o[5]); w.w = cvt_pk_bf16(o[6], o[7]);
                    *(u32x4*)(rowp + bj * HALF) = w;
                    if (xf) { int f0 = (int)b[bj][0], f1 = (int)b[bj][1]; f0 = __builtin_amdgcn_cvt_pk_fp8_f32(epi_clamp8(o[0]), epi_clamp8(o[1]), f0, false); f0 = __builtin_amdgcn_cvt_pk_fp8_f32(epi_clamp8(o[2]), epi_clamp8(o[3]), f0, true);
                        f1 = __builtin_amdgcn_cvt_pk_fp8_f32(epi_clamp8(o[4]), epi_clamp8(o[5]), f1, false); f1 = __builtin_amdgcn_cvt_pk_fp8_f32(epi_clamp8(o[6]), epi_clamp8(o[7]), f1, true);
                        *(u32x2*)(xf + (size_t)row * ldc + col0 + bj * HALF) = (u32x2){(unsigned)f0, (unsigned)f1}; }
                    if (ssq) {
#pragma unroll
                        for (int q = 0; q < 8; ++q) s += o[q] * o[q]; } }
                if (ssq) { s += __shfl_xor(s, 16); s += __shfl_xor(s, 32);
                    if (fq == 0) fx_add(ssq + row, s); } }
    }
};

struct EpiNull {
    static constexpr bool PERM = true, AFTER_DRAIN = false, PREFETCH = false;
    float* sink;
    template <class AccT> __device__ __forceinline__ void operator()(const AccT (&acc)[2][2][4][2], const Unit& u, int wr, int wc, int fr, int fq, const PG8_LAS unsigned char* slot) const {
        f32x4 s = {0.f, 0.f, 0.f, 0.f};
#pragma unroll
        for (int ai = 0; ai < 2; ++ai)
#pragma unroll
            for (int bj = 0; bj < 2; ++bj)
#pragma unroll
                for (int m = 0; m < 4; ++m)
#pragma unroll
                    for (int n = 0; n < 2; ++n) s += acc_f(acc[ai][bj][m][n]);
        if (s[0] + s[1] + s[2] + s[3] == 1.2345e30f) sink[0] = s[0];
    }
};

struct EpiProjDense {
    static constexpr bool PERM = true, AFTER_DRAIN = false, PREFETCH = false;
    bf16_t* O; const fx_t* ssq; const float* sa; const float* sw;
    template <class AccT> __device__ __forceinline__ void operator()(const AccT (&acc)[2][2][4][2], const Unit& u, int wr, int wc, int fr, int fq, const PG8_LAS unsigned char* slot) const {
        const int row0 = u.pm * BM + wr * 64 + fr, col0 = u.pn * BM + wc * 32 + 8 * fq;
        f32x4 cw[2][2];
#pragma unroll
        for (int bj = 0; bj < 2; ++bj) { cw[bj][0] = *(const f32x4*)(sw + col0 + bj * HALF); cw[bj][1] = *(const f32x4*)(sw + col0 + bj * HALF + 4); }
        bf16_t* base = O + ((size_t)(((u.pm * 24 + u.pn) & 255) * 8 + wr * 4 + wc) * 16) * 512 + (fq * 16 + fr) * 8;
#pragma unroll
        for (int ai = 0; ai < 2; ++ai)
#pragma unroll
            for (int m = 0; m < 4; ++m) { const int row = row0 + ai * HALF + m * 16; float rs = __builtin_amdgcn_rsqf(fx_get(ssq + row) * (1.0f / 2048.0f) + 1e-6f) * sa[row];
#pragma unroll
                for (int bj = 0; bj < 2; ++bj) { f32x4 v0 = acc_f(acc[ai][bj][m][0]) * rs * cw[bj][0], v1 = acc_f(acc[ai][bj][m][1]) * rs * cw[bj][1];
                    u32x4 w; w.x = cvt_pk_bf16(v0[0], v0[1]); w.y = cvt_pk_bf16(v0[2], v0[3]); w.z = cvt_pk_bf16(v1[0], v1[1]); w.w = cvt_pk_bf16(v1[2], v1[3]);
                    *(u32x4*)(base + ((ai * 4 + m) * 2 + bj) * 512) = w; } }
    }
};
typedef int i32x8_t __attribute__((ext_vector_type(8)));
constexpr int PG8_PRM_OFF = STAGE_BYTES + 1024;
__device__ __forceinline__ void mma16(f32x4& c, const bf16x8& a, const bf16x8& b) { c = __builtin_amdgcn_mfma_f32_16x16x32_bf16(a, b, c, 0, 0, 0); }
__device__ __forceinline__ void mma16(i32x4_t& c, const bf16x8& a, const bf16x8& b) { c = __builtin_amdgcn_mfma_i32_16x16x64_i8(__builtin_bit_cast(i32x4_t, a), __builtin_bit_cast(i32x4_t, b), c, 0, 0, 0); }
template <int EB> struct AccOf { typedef f32x4 type; };
template <> struct AccOf<1> { typedef i32x4_t type; };
template <class Epi, class Sched, bool ALIGN_EPI = false, bool SP2 = false, int EB = 2>
__device__ __forceinline__ void gemm_phase(PG8_LAS unsigned char* lds, const Gemm g, const Sched& S, const Epi& E) {
    int tid_ = g.wv * 64 + lane_now(); asm volatile("" : "+v"(tid_));
    const int tid = tid_, wid = __builtin_amdgcn_readfirstlane(tid >> 6), lane = tid & 63, wr = wid >> 2, wc = wid & 3, fr = lane & 15, fq = lane >> 4;
    const int K = g.K, nt = K * EB / (2 * BK);
    unsigned voffA[2], voffB[2];
#pragma unroll
    for (int i = 0; i < 2; ++i) { int R, C; stage_rc(tid * 16 + i * 8192, R, C); const int Rb = Epi::PERM ? ((R & ~31) + perm32(R & 31)) : R;
        voffA[i] = (unsigned)(R * K * EB + 2 * C); voffB[i] = (unsigned)(Rb * K * EB + 2 * C); }
    const unsigned kstep = (unsigned)(BK * 2);
    const unsigned hstep = (unsigned)HALF * K * EB;
    const unsigned tstep = 2 * hstep;
    const unsigned ldsw = (unsigned)wid * 1024u;
    const int aoff = lds_byte(wr * 64 + fr, fq * 8), boff = lds_byte(wc * 32 + fr, fq * 8);
#define PG8_SA(b, h) (((b) * 2 + (h)) * HTB)
#define PG8_SB(b, h) ((4 + (b) * 2 + (h)) * HTB)
#define PG8_STAGE(bufoff, rsrc, soff, voff) do { _Pragma("unroll") for (int _i = 0; _i < 2; ++_i) \
        __builtin_amdgcn_raw_ptr_buffer_load_lds(rsrc, (PG8_LAS void*)(lds + (bufoff) + ldsw + _i * 8192), 16, (int)(voff)[_i], (int)(soff), 0, 0); } while (0)
#define PG8_LDA(dst, b, h) do { _Pragma("unroll") for (int m = 0; m < 4; ++m) _Pragma("unroll") for (int k = 0; k < 2; ++k) dst[m][k] = *(const PG8_LAS bf16x8*)(lds + PG8_SA(b, h) + aoff + m * 2048 + k * 1024); } while (0)
#define PG8_LDB(dst, b, h) do { _Pragma("unroll") for (int n = 0; n < 2; ++n) _Pragma("unroll") for (int k = 0; k < 2; ++k) dst[n][k] = *(const PG8_LAS bf16x8*)(lds + PG8_SB(b, h) + boff + n * 2048 + k * 1024); } while (0)
#define PG8_MMA(ai, bj, At, Bt) do { __builtin_amdgcn_s_setprio(1); _Pragma("unroll") for (int m = 0; m < 4; ++m) _Pragma("unroll") for (int n = 0; n < 2; ++n) _Pragma("unroll") for (int k = 0; k < 2; ++k) \
        mma16(acc[ai][bj][m][n], Bt[n][k], At[m][k]); __builtin_amdgcn_s_setprio(0); } while (0)
#define PG8_WAIT_V(n) asm volatile("s_waitcnt vmcnt(" #n ")" ::: "memory")
#define PG8_WAIT_L(n) asm volatile("s_waitcnt lgkmcnt(" #n ")" ::: "memory")
#define PG8_BAR __builtin_amdgcn_s_barrier()
#define PG8_SCHED __builtin_amdgcn_sched_barrier(0)
    Unit cur, nxt; int ui = 0;
    if (!S.next(0, cur)) return;
    typedef typename AccOf<EB>::type acc_t; acc_t acc[2][2][4][2];
#pragma unroll
    for (int a = 0; a < 2; ++a)
#pragma unroll
        for (int b = 0; b < 2; ++b)
#pragma unroll
            for (int m = 0; m < 4; ++m)
#pragma unroll
                for (int n = 0; n < 2; ++n) acc[a][b][m][n] = acc_t{};
    bf16x8 At[4][2], B0[2][2], B1[2][2];
    const __amdgpu_buffer_rsrc_t rA = __builtin_amdgcn_make_buffer_rsrc((void*)g.A, (short)0, -1, 0x00020000), rB = __builtin_amdgcn_make_buffer_rsrc((void*)g.Bt, (short)0, -1, 0x00020000);
    unsigned cA = g.same ? 0u : (unsigned)cur.pm * tstep, cB = g.same ? 0u : (unsigned)cur.pn * tstep;
    S.a_ready(cur);
    if constexpr (SP2) {
        PG8_STAGE(PG8_SB(0, 0), rB, cB, voffB); PG8_STAGE(PG8_SB(0, 1), rB, cB + hstep, voffB); PG8_STAGE(PG8_SA(0, 0), rA, cA, voffA); PG8_STAGE(PG8_SA(0, 1), rA, cA + hstep, voffA);
        if (wr == 1) PG8_BAR;
        PG8_WAIT_V(2); PG8_BAR;
        PG8_STAGE(PG8_SB(1, 0), rB, cB + kstep, voffB); PG8_STAGE(PG8_SA(1, 0), rA, cA + kstep, voffA); PG8_STAGE(PG8_SB(1, 1), rB, cB + hstep + kstep, voffB);
        PG8_WAIT_V(6); PG8_BAR;
    } else {
        PG8_STAGE(PG8_SB(0, 0), rB, cB, voffB); PG8_STAGE(PG8_SA(0, 0), rA, cA, voffA); PG8_STAGE(PG8_SB(0, 1), rB, cB + hstep, voffB); PG8_STAGE(PG8_SA(0, 1), rA, cA + hstep, voffA);
        if (wr == 1) PG8_BAR;
        PG8_WAIT_V(4); PG8_BAR;
        PG8_STAGE(PG8_SB(1, 0), rB, cB + kstep, voffB); PG8_STAGE(PG8_SA(1, 0), rA, cA + kstep, voffA); PG8_STAGE(PG8_SB(1, 1), rB, cB + hstep + kstep, voffB);
        PG8_WAIT_V(6); PG8_BAR;
    }
    for (;;) {
        const bool has_next = S.next(ui + 1, nxt);
        const unsigned nA = (has_next && !g.same) ? (unsigned)nxt.pm * tstep : cA, nB = (has_next && !g.same) ? (unsigned)nxt.pn * tstep : cB;
        for (int t = 0; t < nt; t += 2) {
            const bool last = (t == nt - 2);
            const unsigned a1 = cA + (unsigned)(t + 1) * kstep;
            const unsigned a2 = last ? nA : cA + (unsigned)(t + 2) * kstep, b2 = last ? nB : cB + (unsigned)(t + 2) * kstep;
            const unsigned a3 = a2 + kstep, b3 = b2 + kstep;
            if (last && has_next) S.a_ready(nxt);
            if constexpr (Epi::PREFETCH) { if (t == 0) E.prefetch(cur, lds + PG8_PRM_OFF + (ui & 1) * 4096, wid); }
            if constexpr (SP2) {
            PG8_LDB(B0, 0, 0); PG8_LDB(B1, 0, 1); PG8_SCHED; PG8_LDA(At, 0, 0); PG8_STAGE(PG8_SA(1, 1), rA, a1 + hstep, voffA);
            PG8_WAIT_V(8); PG8_WAIT_L(0); PG8_BAR; PG8_MMA(0, 0, At, B0); PG8_MMA(0, 1, At, B1); PG8_BAR; PG8_SCHED;
            PG8_LDA(At, 0, 1); PG8_STAGE(PG8_SB(0, 0), rB, b2, voffB); PG8_STAGE(PG8_SB(0, 1), rB, b2 + hstep, voffB); PG8_STAGE(PG8_SA(0, 0), rA, a2, voffA);
            PG8_WAIT_V(8); PG8_WAIT_L(0); PG8_BAR; PG8_MMA(1, 0, At, B0); PG8_MMA(1, 1, At, B1); PG8_BAR; PG8_SCHED;
            PG8_LDB(B0, 1, 0); PG8_LDB(B1, 1, 1); PG8_SCHED; PG8_LDA(At, 1, 0); PG8_STAGE(PG8_SA(0, 1), rA, a2 + hstep, voffA);
            PG8_WAIT_V(8); PG8_WAIT_L(0); PG8_BAR; PG8_MMA(0, 0, At, B0); PG8_MMA(0, 1, At, B1); PG8_BAR; PG8_SCHED;
            PG8_LDA(At, 1, 1); PG8_STAGE(PG8_SB(1, 0), rB, b3, voffB); PG8_STAGE(PG8_SB(1, 1), rB, b3 + hstep, voffB); PG8_STAGE(PG8_SA(1, 0), rA, a3, voffA);
            PG8_WAIT_V(8); PG8_WAIT_L(0); PG8_BAR; PG8_MMA(1, 0, At, B0); PG8_MMA(1, 1, At, B1); PG8_BAR; PG8_SCHED;
            } else {
            PG8_LDB(B0, 0, 0); PG8_SCHED; PG8_LDA(At, 0, 0); PG8_STAGE(PG8_SA(1, 1), rA, a1 + hstep, voffA);
            PG8_WAIT_L(8); PG8_BAR; PG8_WAIT_L(0); PG8_MMA(0, 0, At, B0); PG8_BAR; PG8_SCHED;
            PG8_LDB(B1, 0, 1); PG8_STAGE(PG8_SB(0, 0), rB, b2, voffB);
            PG8_BAR; PG8_WAIT_L(0); PG8_MMA(0, 1, At, B1); PG8_BAR;
            PG8_LDA(At, 0, 1); PG8_STAGE(PG8_SA(0, 0), rA, a2, voffA);
            PG8_BAR; PG8_WAIT_L(0); PG8_MMA(1, 0, At, B0); PG8_BAR; PG8_SCHED;
            PG8_STAGE(PG8_SB(0, 1), rB, b2 + hstep, voffB);
            PG8_WAIT_V(6); PG8_BAR; PG8_MMA(1, 1, At, B1); PG8_BAR;
            PG8_LDB(B0, 1, 0); PG8_SCHED; PG8_LDA(At, 1, 0); PG8_STAGE(PG8_SA(0, 1), rA, a2 + hstep, voffA);
            PG8_WAIT_L(8); PG8_BAR; PG8_WAIT_L(0); PG8_MMA(0, 0, At, B0); PG8_BAR; PG8_SCHED;
            PG8_LDB(B1, 1, 1); PG8_STAGE(PG8_SB(1, 0), rB, b3, voffB);
            PG8_BAR; PG8_WAIT_L(0); PG8_MMA(0, 1, At, B1); PG8_BAR;
            PG8_LDA(At, 1, 1); PG8_STAGE(PG8_SA(1, 0), rA, a3, voffA);
            PG8_BAR; PG8_WAIT_L(0); PG8_MMA(1, 0, At, B0); PG8_BAR; PG8_SCHED;
            PG8_STAGE(PG8_SB(1, 1), rB, b3 + hstep, voffB);
            PG8_WAIT_V(6); PG8_BAR; PG8_MMA(1, 1, At, B1); PG8_BAR;
            }
        }
        if constexpr (ALIGN_EPI) { if (wr == 0) PG8_BAR; }
        if constexpr (!Epi::AFTER_DRAIN) { int ln_ = (int)__builtin_amdgcn_mbcnt_hi(~0u, __builtin_amdgcn_mbcnt_lo(~0u, 0u)); asm volatile("" : "+v"(ln_));
            E(acc, cur, wr, wc, ln_ & 15, ln_ >> 4, lds + PG8_PRM_OFF + (ui & 1) * 4096); S.done(cur); }
        if (!has_next) break;
#pragma unroll
        for (int a = 0; a < 2; ++a)
#pragma unroll
            for (int b = 0; b < 2; ++b)
#pragma unroll
                for (int m = 0; m < 4; ++m)
#pragma unroll
                    for (int n = 0; n < 2; ++n) acc[a][b][m][n] = acc_t{};
        cur = nxt; cA = nA; cB = nB; ++ui;
        if constexpr (ALIGN_EPI) { if (wr == 1) PG8_BAR; }
    }
    PG8_WAIT_V(0);
    if constexpr (!ALIGN_EPI) { if (wr == 0) PG8_BAR; }
    PG8_BAR;
    if constexpr (Epi::AFTER_DRAIN) { E.fused(acc, cur, wr, wc, fr, fq, lds, wid, lane); S.done(cur); }
#undef PG8_SA
#undef PG8_SB
#undef PG8_STAGE
#undef PG8_LDA
#undef PG8_LDB
#undef PG8_MMA
#undef PG8_WAIT_V
#undef PG8_WAIT_L
#undef PG8_BAR
#undef PG8_SCHED
}
template <class Epi, class Sched, bool ALIGN_EPI = false, bool SP2 = false>
__device__ __forceinline__ void gemm_phase_f8(PG8_LAS unsigned char* lds, const Gemm g, const Sched& S, const Epi& E) {
    int tid_ = g.wv * 64 + lane_now(); asm volatile("" : "+v"(tid_));
    const int tid = tid_, wid = __builtin_amdgcn_readfirstlane(tid >> 6), lane = tid & 63, wr = wid >> 2, wc = wid & 3, fr = lane & 15, fq = lane >> 4;
    const int K = g.K, nt = K / (2 * BK);
    unsigned voffA[2], voffB[2];
#pragma unroll
    for (int i = 0; i < 2; ++i) { int R, C; stage_rc(tid * 16 + i * 8192, R, C); const int Rb = Epi::PERM ? ((R & ~31) + perm32(R & 31)) : R;
        voffA[i] = (unsigned)(R * K + 2 * C); voffB[i] = (unsigned)(Rb * K + 2 * C); }
    const unsigned kstep = (unsigned)(BK * 2);
    const unsigned hstep = (unsigned)HALF * K;
    const unsigned tstep = 2 * hstep;
    const unsigned ldsw = (unsigned)wid * 1024u;
    const int aoff = lds_byte(wr * 64 + fr, fq * 16) ^ ((fq & 1) << 4), boff = lds_byte(wc * 32 + fr, fq * 16) ^ ((fq & 1) << 4), aoff2 = aoff ^ 16, boff2 = boff ^ 16;
#define PG8_SA(b, h) (((b) * 2 + (h)) * HTB)
#define PG8_SB(b, h) ((4 + (b) * 2 + (h)) * HTB)
#define PG8_STAGE(bufoff, rsrc, soff, voff) do { _Pragma("unroll") for (int _i = 0; _i < 2; ++_i) \
        __builtin_amdgcn_raw_ptr_buffer_load_lds(rsrc, (PG8_LAS void*)(lds + (bufoff) + ldsw + _i * 8192), 16, (int)(voff)[_i], (int)(soff), 0, 0); } while (0)
#define PG8_LDA(dst, b, h) do { _Pragma("unroll") for (int m = 0; m < 4; ++m) { const i32x4_t lo_ = *(const PG8_LAS i32x4_t*)(lds + PG8_SA(b, h) + aoff + m * 2048), hi_ = *(const PG8_LAS i32x4_t*)(lds + PG8_SA(b, h) + aoff2 + m * 2048); dst[m] = __builtin_shufflevector(lo_, hi_, 0, 1, 2, 3, 4, 5, 6, 7); } } while (0)
#define PG8_LDB(dst, b, h) do { _Pragma("unroll") for (int n = 0; n < 2; ++n) { const i32x4_t lo_ = *(const PG8_LAS i32x4_t*)(lds + PG8_SB(b, h) + boff + n * 2048), hi_ = *(const PG8_LAS i32x4_t*)(lds + PG8_SB(b, h) + boff2 + n * 2048); dst[n] = __builtin_shufflevector(lo_, hi_, 0, 1, 2, 3, 4, 5, 6, 7); } } while (0)
#define PG8_F8CAT(lo, hi) __builtin_shufflevector(__builtin_bit_cast(i32x4_t, lo), __builtin_bit_cast(i32x4_t, hi), 0, 1, 2, 3, 4, 5, 6, 7)
#define PG8_MMA(ai, bj, At, Bt) do { __builtin_amdgcn_s_setprio(1); _Pragma("unroll") for (int m = 0; m < 4; ++m) _Pragma("unroll") for (int n = 0; n < 2; ++n) \
        acc[ai][bj][m][n] = __builtin_amdgcn_mfma_scale_f32_16x16x128_f8f6f4(Bt[n], At[m], acc[ai][bj][m][n], 0, 0, 0, 0, 0, 0); __builtin_amdgcn_s_setprio(0); } while (0)
#define PG8_WAIT_V(n) asm volatile("s_waitcnt vmcnt(" #n ")" ::: "memory")
#define PG8_WAIT_L(n) asm volatile("s_waitcnt lgkmcnt(" #n ")" ::: "memory")
#define PG8_BAR __builtin_amdgcn_s_barrier()
#define PG8_SCHED __builtin_amdgcn_sched_barrier(0)
    Unit cur, nxt; int ui = 0;
    if (!S.next(0, cur)) return;
    f32x4 acc[2][2][4][2];
#pragma unroll
    for (int a = 0; a < 2; ++a)
#pragma unroll
        for (int b = 0; b < 2; ++b)
#pragma unroll
            for (int m = 0; m < 4; ++m)
#pragma unroll
                for (int n = 0; n < 2; ++n) acc[a][b][m][n] = (f32x4){0.f, 0.f, 0.f, 0.f};
    i32x8_t At[4], B0[2], B1[2];
    const __amdgpu_buffer_rsrc_t rA = __builtin_amdgcn_make_buffer_rsrc((void*)g.A, (short)0, -1, 0x00020000), rB = __builtin_amdgcn_make_buffer_rsrc((void*)g.Bt, (short)0, -1, 0x00020000);
    unsigned cA = g.same ? 0u : (unsigned)cur.pm * tstep, cB = g.same ? 0u : (unsigned)cur.pn * tstep;
    S.a_ready(cur);
    if constexpr (SP2) {
        PG8_STAGE(PG8_SB(0, 0), rB, cB, voffB); PG8_STAGE(PG8_SB(0, 1), rB, cB + hstep, voffB); PG8_STAGE(PG8_SA(0, 0), rA, cA, voffA); PG8_STAGE(PG8_SA(0, 1), rA, cA + hstep, voffA);
        if (wr == 1) PG8_BAR;
        PG8_WAIT_V(2); PG8_BAR;
        PG8_STAGE(PG8_SB(1, 0), rB, cB + kstep, voffB); PG8_STAGE(PG8_SA(1, 0), rA, cA + kstep, voffA); PG8_STAGE(PG8_SB(1, 1), rB, cB + hstep + kstep, voffB);
        PG8_WAIT_V(6); PG8_BAR;
    } else {
        PG8_STAGE(PG8_SB(0, 0), rB, cB, voffB); PG8_STAGE(PG8_SA(0, 0), rA, cA, voffA); PG8_STAGE(PG8_SB(0, 1), rB, cB + hstep, voffB); PG8_STAGE(PG8_SA(0, 1), rA, cA + hstep, voffA);
        if (wr == 1) PG8_BAR;
        PG8_WAIT_V(4); PG8_BAR;
        PG8_STAGE(PG8_SB(1, 0), rB, cB + kstep, voffB); PG8_STAGE(PG8_SA(1, 0), rA, cA + kstep, voffA); PG8_STAGE(PG8_SB(1, 1), rB, cB + hstep + kstep, voffB);
        PG8_WAIT_V(6); PG8_BAR;
    }
    for (;;) {
        const bool has_next = S.next(ui + 1, nxt);
        const unsigned nA = (has_next && !g.same) ? (unsigned)nxt.pm * tstep : cA, nB = (has_next && !g.same) ? (unsigned)nxt.pn * tstep : cB;
        for (int t = 0; t < nt; t += 2) {
            const bool last = (t == nt - 2);
            const unsigned a1 = cA + (unsigned)(t + 1) * kstep;
            const unsigned a2 = last ? nA : cA + (unsigned)(t + 2) * kstep, b2 = last ? nB : cB + (unsigned)(t + 2) * kstep;
            const unsigned a3 = a2 + kstep, b3 = b2 + kstep;
            if (last && has_next) S.a_ready(nxt);
            if constexpr (Epi::PREFETCH) { if (t == 0) E.prefetch(cur, lds + PG8_PRM_OFF + (ui & 1) * 4096, wid); }
            if constexpr (SP2) {
            PG8_LDB(B0, 0, 0); PG8_LDB(B1, 0, 1); PG8_SCHED; PG8_LDA(At, 0, 0); PG8_STAGE(PG8_SA(1, 1), rA, a1 + hstep, voffA);
            PG8_WAIT_V(8); PG8_WAIT_L(0); PG8_BAR; PG8_MMA(0, 0, At, B0); PG8_MMA(0, 1, At, B1); PG8_BAR; PG8_SCHED;
            PG8_LDA(At, 0, 1); PG8_STAGE(PG8_SB(0, 0), rB, b2, voffB); PG8_STAGE(PG8_SB(0, 1), rB, b2 + hstep, voffB); PG8_STAGE(PG8_SA(0, 0), rA, a2, voffA);
            PG8_WAIT_V(8); PG8_WAIT_L(0); PG8_BAR; PG8_MMA(1, 0, At, B0); PG8_MMA(1, 1, At, B1); PG8_BAR; PG8_SCHED;
            PG8_LDB(B0, 1, 0); PG8_LDB(B1, 1, 1); PG8_SCHED; PG8_LDA(At, 1, 0); PG8_STAGE(PG8_SA(0, 1), rA, a2 + hstep, voffA);
            PG8_WAIT_V(8); PG8_WAIT_L(0); PG8_BAR; PG8_MMA(0, 0, At, B0); PG8_MMA(0, 1, At, B1); PG8_BAR; PG8_SCHED;
            PG8_LDA(At, 1, 1); PG8_STAGE(PG8_SB(1, 0), rB, b3, voffB); PG8_STAGE(PG8_SB(1, 1), rB, b3 + hstep, voffB); PG8_STAGE(PG8_SA(1, 0), rA, a3, voffA);
            PG8_WAIT_V(8); PG8_WAIT_L(0); PG8_BAR; PG8_MMA(1, 0, At, B0); PG8_MMA(1, 1, At, B1); PG8_BAR; PG8_SCHED;
            } else {
            PG8_LDB(B0, 0, 0); PG8_SCHED; PG8_LDA(At, 0, 0); PG8_STAGE(PG8_SA(1, 1), rA, a1 + hstep, voffA);
            PG8_WAIT_L(8); PG8_BAR; PG8_WAIT_L(0); PG8_MMA(0, 0, At, B0); PG8_BAR; PG8_SCHED;
            PG8_LDB(B1, 0, 1); PG8_STAGE(PG8_SB(0, 0), rB, b2, voffB);
            PG8_BAR; PG8_WAIT_L(0); PG8_MMA(0, 1, At, B1); PG8_BAR;
            PG8_LDA(At, 0, 1); PG8_STAGE(PG8_SA(0, 0), rA, a2, voffA);
            PG8_BAR; PG8_WAIT_L(0); PG8_MMA(1, 0, At, B0); PG8_BAR; PG8_SCHED;
            PG8_STAGE(PG8_SB(0, 1), rB, b2 + hstep, voffB);
            PG8_WAIT_V(6); PG8_BAR; PG8_MMA(1, 1, At, B1); PG8_BAR;
            PG8_LDB(B0, 1, 0); PG8_SCHED; PG8_LDA(At, 1, 0); PG8_STAGE(PG8_SA(0, 1), rA, a2 + hstep, voffA);
            PG8_WAIT_L(8); PG8_BAR; PG8_WAIT_L(0); PG8_MMA(0, 0, At, B0); PG8_BAR; PG8_SCHED;
            PG8_LDB(B1, 1, 1); PG8_STAGE(PG8_SB(1, 0), rB, b3, voffB);
            PG8_BAR; PG8_WAIT_L(0); PG8_MMA(0, 1, At, B1); PG8_BAR;
            PG8_LDA(At, 1, 1); PG8_STAGE(PG8_SA(1, 0), rA, a3, voffA);
            PG8_BAR; PG8_WAIT_L(0); PG8_MMA(1, 0, At, B0); PG8_BAR; PG8_SCHED;
            PG8_STAGE(PG8_SB(1, 1), rB, b3 + hstep, voffB);
            PG8_WAIT_V(6); PG8_BAR; PG8_MMA(1, 1, At, B1); PG8_BAR;
            }
        }
        if constexpr (ALIGN_EPI) { if (wr == 0) PG8_BAR; }
        if constexpr (!Epi::AFTER_DRAIN) { int ln_ = (int)__builtin_amdgcn_mbcnt_hi(~0u, __builtin_amdgcn_mbcnt_lo(~0u, 0u)); asm volatile("" : "+v"(ln_));
            E(acc, cur, wr, wc, ln_ & 15, ln_ >> 4, lds + PG8_PRM_OFF + (ui & 1) * 4096); S.done(cur); }
        if (!has_next) break;
#pragma unroll
        for (int a = 0; a < 2; ++a)
#pragma unroll
            for (int b = 0; b < 2; ++b)
#pragma unroll
                for (int m = 0; m < 4; ++m)
#pragma unroll
                    for (int n = 0; n < 2; ++n) acc[a][b][m][n] = (f32x4){0.f, 0.f, 0.f, 0.f};
        cur = nxt; cA = nA; cB = nB; ++ui;
        if constexpr (ALIGN_EPI) { if (wr == 1) PG8_BAR; }
    }
    PG8_WAIT_V(0);
    if constexpr (!ALIGN_EPI) { if (wr == 0) PG8_BAR; }
    PG8_BAR;
    if constexpr (Epi::AFTER_DRAIN) { E.fused(acc, cur, wr, wc, fr, fq, lds, wid, lane); S.done(cur); }
#undef PG8_SA
#undef PG8_SB
#undef PG8_STAGE
#undef PG8_LDA
#undef PG8_LDB
#undef PG8_MMA
#undef PG8_WAIT_V
#undef PG8_WAIT_L
#undef PG8_BAR
#undef PG8_SCHED
#undef PG8_F8CAT
}
}

constexpr int NWAVES = 8, NTHR = NWAVES * 64;
constexpr int BATCH = 8, SEQ = 2048, DM = 2048, DEPTH = 2, HD = 64, GW = 512, NH = 8;
constexpr int M = BATCH * SEQ;
constexpr int NPROJ = 6080, NPROJ_P = 6144, DFF = 5632;
constexpr int CA_Q = 0, CA_K = 512, CA_V = 1024, CB_U = 1536, CB_V = 2048, CC_Q = 2560, CC_K = 3072, CC_V = 3584, CD = 4096;
constexpr int D_R = 0, D_WD = 512, D_K = 608, D_V = 1120, D_AD = 1632, D_GD = 1728, D_W = 1984;
constexpr float NORM_EPS = 1e-6f;
#ifndef N_LAUNCH_MODE
#define N_LAUNCH_MODE 0
#endif
#ifndef PG8_SP2
#define PG8_SP2 true
#endif
#ifndef FFN_FP8
#define FFN_FP8 1
#endif
#ifndef REPEAT
#define REPEAT 0
#endif
#ifndef GEMM_I8
#define GEMM_I8 3
#endif
#ifndef BFMASK
#define BFMASK 0x003C0Fu
#endif
#ifndef FFN1_I8
#define FFN1_I8 1
#endif
#define I8_IN ((GEMM_I8 & 1) != 0)
#define I8_OUT ((GEMM_I8 & 2) != 0)
constexpr int N_PHASES = 20;

constexpr size_t MiB = 1u << 20;
constexpr size_t WS_CTL = 0, CTL_ZERO_BYTES = 2 * MiB;
constexpr size_t WS_WIN = 2 * MiB, WS_WOUT = 26 * MiB, WS_WGU = 34 * MiB, WS_WDN = 78 * MiB, WS_SMALL = 100 * MiB;
constexpr size_t WS_XB = 104 * MiB, WS_PROJ = 168 * MiB, WS_YCAT = 360 * MiB, WS_SC2 = 424 * MiB, WS_YD = 456 * MiB, WS_G = 488 * MiB, WS_BC = 504 * MiB, WS_END = 506 * MiB;
constexpr size_t WS_XQ = WS_YD, WS_YQ = WS_PROJ;
constexpr size_t SC_ARR = (size_t)M * GW * 2;
constexpr size_t SM_TB = 0;
constexpr size_t SM_KBAR = 64 * 1024;
constexpr size_t SM_STATS = 256 * 1024;
constexpr size_t SM_SAX = 2048 * 1024, SM_SAY = SM_SAX + 64 * 1024;
constexpr size_t SM_SWIN = SM_SAY + 64 * 1024, SM_SWOUT = SM_SWIN + 32 * 1024, SM_SWGU = SM_SWOUT + 16 * 1024;
constexpr size_t SM_BIAS = 3072 * 1024;
constexpr size_t SM_WT = 1024 * 1024;
constexpr int CW_BAR = 4096;
constexpr int CW_Q = 8192;
constexpr int CW_SSQ = 65536;
constexpr size_t CTL_KBAR = 1024 * 1024;
constexpr size_t CTL_STATS = 1280 * 1024;
static_assert((size_t)CW_SSQ * 4 + 5 * (size_t)M * 8 <= CTL_KBAR && CTL_STATS + 2 * (size_t)M * 2 * 8 <= CTL_ZERO_BYTES, "CTL");

constexpr int RING_OFF = 0, RING_BYTES = 131072;
constexpr int LDS_BYTES = 163840, MISC_OFF = LDS_BYTES - 256;

#define GAS __attribute__((address_space(1)))
#define LAS __attribute__((address_space(3)))
typedef unsigned short bf16;
typedef unsigned v4u __attribute__((ext_vector_type(4)));
typedef unsigned v2u __attribute__((ext_vector_type(2)));
typedef float f32x4 __attribute__((ext_vector_type(4)));
typedef short bf16x8 __attribute__((ext_vector_type(8)));
typedef float f32x16 __attribute__((ext_vector_type(16)));
typedef GAS unsigned gu32;
#define RLX_AGENT __ATOMIC_RELAXED, __HIP_MEMORY_SCOPE_AGENT
#define LDS_WAIT() asm volatile("s_waitcnt lgkmcnt(0)" ::: "memory")
#define VM_WAIT() asm volatile("s_waitcnt vmcnt(0)" ::: "memory")
__device__ __forceinline__ unsigned f2bf(float f) { unsigned u = __builtin_bit_cast(unsigned, f); return (u + 0x7fffu + ((u >> 16) & 1u)) >> 16; }
__device__ __forceinline__ unsigned pk2(float lo, float hi) { return f2bf(lo) | (f2bf(hi) << 16); }
__device__ __forceinline__ float bf2f(unsigned short h) { return __builtin_bit_cast(float, (unsigned)h << 16); }
__device__ __forceinline__ float bflo(unsigned w) { return __builtin_bit_cast(float, w << 16); }
__device__ __forceinline__ float bfhi(unsigned w) { return __builtin_bit_cast(float, w & 0xffff0000u); }
__device__ __forceinline__ float sigmoidf_(float x) { return 1.0f / (1.0f + __expf(-x)); }
__device__ __forceinline__ float gelu_tanh(float x) { const float u = 0.7978845608028654f * (x + 0.044715f * x * x * x); const float e = __expf(2.0f * u); return x - x * __builtin_amdgcn_rcpf(e + 1.0f); }
__device__ __forceinline__ float wave_sum(float v) {
#pragma unroll
    for (int o = 1; o < 64; o <<= 1) v += __shfl_xor(v, o);
    return v;
}

__device__ __forceinline__ float zero_v() { float z = 0.f; asm volatile("" : "+v"(z)); return z; }

__device__ __forceinline__ unsigned q8pack4(float a, float b, float c, float d, float inv) {
    const int ia = (int)__builtin_rintf(a * inv), ib = (int)__builtin_rintf(b * inv), ic = (int)__builtin_rintf(c * inv), id = (int)__builtin_rintf(d * inv);
    return ((unsigned)ia & 0xffu) | (((unsigned)ib & 0xffu) << 8) | (((unsigned)ic & 0xffu) << 16) | ((unsigned)id << 24); }
__device__ __forceinline__ float wave_max(float v) {
#pragma unroll
    for (int o = 1; o < 64; o <<= 1) v = fmaxf(v, __shfl_xor(v, o));
    return v;
}
#define UNPACK8(dst, o, W_) do { dst[(o)] = bflo((W_).x); dst[(o) + 1] = bfhi((W_).x); dst[(o) + 2] = bflo((W_).y); dst[(o) + 3] = bfhi((W_).y); dst[(o) + 4] = bflo((W_).z); dst[(o) + 5] = bfhi((W_).z); dst[(o) + 6] = bflo((W_).w); dst[(o) + 7] = bfhi((W_).w); } while (0)
#define XB_TMO      128
#define XB_XCNT(j)  (256  + 64 * (j))
#define XB_XSUB(j)  (1280 + 64 * (j))
#define XB_XGEN(j)  (2304 + 64 * (j))
#define XB_TOP      3328
#define XB_TOPGEN   3392
#define XCD_BAR_WORDS 3456
#define XB_SPIN_CAP (1u << 18)

__device__ __forceinline__ unsigned xb_ld(unsigned* p)              { return __hip_atomic_load(p, __ATOMIC_RELAXED, __HIP_MEMORY_SCOPE_AGENT); }
__device__ __forceinline__ unsigned xb_add(unsigned* p, unsigned v) { return __hip_atomic_fetch_add(p, v, __ATOMIC_RELAXED, __HIP_MEMORY_SCOPE_AGENT); }
__device__ __forceinline__ unsigned xb_xcc_id() { return (unsigned)__builtin_amdgcn_s_getreg((3 << 11) | 20) & 0xFu; }
#define XB_SPIN(cond, bar) do { unsigned _sp = 0; while (cond) { __builtin_amdgcn_s_sleep(1); \
    if ((++_sp & 255u) == 0u) { if (xb_ld(&(bar)[XB_TMO])) break; if (_sp > XB_SPIN_CAP) { atomicAdd(&(bar)[XB_TMO], 1u); break; } } } } while (0)

struct XcdBarrier {
    unsigned* bar; unsigned x; int wv;
    volatile LAS unsigned* st;
};

__device__ __forceinline__ XcdBarrier xcd_barrier_post(unsigned* bar, volatile LAS unsigned* st, int wv) {
    XcdBarrier b; b.bar = bar; b.x = xb_xcc_id(); b.st = st; b.wv = wv;
    if (wv == 0 && pg8::lane_now() == 0) (void)xb_add(&bar[XB_XCNT(b.x)], 1u);
    return b;
}
__device__ __forceinline__ void xcd_barrier_complete(unsigned* bar, unsigned x, unsigned& nloc, unsigned& nx) {
    const unsigned G = gridDim.x * gridDim.y * gridDim.z;
    unsigned sum, cnt, mine, sp = 0u;
    for (;;) {
        sum = 0u; cnt = 0u; mine = 0u;
#pragma unroll
        for (unsigned j = 0; j < 16; ++j) { const unsigned c = xb_ld(&bar[XB_XCNT(j)]); sum += c; cnt += (c > 0u) ? 1u : 0u; mine = (j == x) ? c : mine; }
        if (sum == G) break;
        __builtin_amdgcn_s_sleep(1);
        if ((++sp & 255u) == 0u) { if (xb_ld(&bar[XB_TMO])) break; if (sp > XB_SPIN_CAP) { atomicAdd(&bar[XB_TMO], 1u); break; } }
    }
    nloc = mine > 0u ? mine : 1u; nx = cnt > 0u ? cnt : 1u;
}

__device__ __forceinline__ void xcd_barrier(const XcdBarrier& b) {
    asm volatile("s_waitcnt vmcnt(0)" ::: "memory");
    __syncthreads();
    if (b.wv == 0 && pg8::lane_now() == 0) {
        unsigned* bar = b.bar;
        __builtin_amdgcn_s_waitcnt(0);
        unsigned nloc = b.st[0], nx = b.st[1];
        if (nloc == 0u) { xcd_barrier_complete(bar, b.x, nloc, nx); b.st[0] = nloc; b.st[1] = nx; }
        const unsigned old = xb_add(&bar[XB_XSUB(b.x)], 1u);
        const unsigned gen = old / nloc;
        if (old + 1u == (gen + 1u) * nloc) {
            __builtin_amdgcn_fence(__ATOMIC_RELEASE, "agent");
            asm volatile("s_waitcnt vmcnt(0)" ::: "memory");
            const unsigned og = xb_add(&bar[XB_TOP], 1u);
            const unsigned tg = og / nx;
            if (og + 1u == (tg + 1u) * nx) xb_add(&bar[XB_TOPGEN], 1u);
            else XB_SPIN(xb_ld(&bar[XB_TOPGEN]) == tg, bar);
            __builtin_amdgcn_fence(__ATOMIC_ACQUIRE, "agent");
            xb_add(&bar[XB_XGEN(b.x)], 1u);
            asm volatile("s_waitcnt vmcnt(0)" ::: "memory");
        } else {
            XB_SPIN(xb_ld(&bar[XB_XGEN(b.x)]) == gen, bar);
            __builtin_amdgcn_fence(__ATOMIC_ACQUIRE, "agent");
            asm volatile("s_waitcnt vmcnt(0)" ::: "memory");
        }
    }
    __syncthreads();
}

struct Args { const float* in[25]; float* out; unsigned char* ws; int ph_lo, ph_hi; };
struct Frame {
    LAS unsigned char* lds; int tid, lane, wave, G, vcu, gw, ngw;
};
typedef const __attribute__((address_space(4))) unsigned long long* karg_t;
__device__ __forceinline__ karg_t kargs() { karg_t ka = (karg_t)__builtin_amdgcn_kernarg_segment_ptr(); asm volatile("" : "+s"(ka)); return ka; }
__device__ __forceinline__ const float* inp(int i) { return (const float*)(const GAS float*)kargs()[i]; }
__device__ __forceinline__ float* outp() { return (float*)(GAS float*)kargs()[25]; }
__device__ __forceinline__ unsigned char* wsp() { return (unsigned char*)(GAS unsigned char*)kargs()[26]; }
__device__ __forceinline__ gu32* ctlp() { return (gu32*)(wsp() + WS_CTL); }

__device__ __forceinline__ void conv_item(const float* W, int K, int N, const float* g, bf16* WT, int kind, LAS float* scr, int item, int lane, int ncols = 0) {
    const int nblk = (ncols ? ncols : N) / 32, kb = item / nblk, nb = item % nblk, k0 = 64 * kb, n0 = 32 * nb;
    float ld[32];
    { const float* wp = W + (size_t)(k0 + (lane >> 5)) * N + n0 + (lane & 31);
#pragma unroll
      for (int i = 0; i < 32; ++i) ld[i] = wp[(size_t)(2 * i) * N]; }
    if (g) { const float* gp = g + k0 + (lane >> 5);
#pragma unroll
      for (int i = 0; i < 32; ++i) ld[i] *= gp[2 * i]; }
#pragma unroll
    for (int i = 0; i < 32; ++i) scr[(2 * i + (lane >> 5)) * 33 + (lane & 31)] = ld[i];
    LDS_WAIT(); asm volatile("" ::: "memory");
    const int c = lane & 7;
#pragma unroll
    for (int j = 0; j < 4; ++j) { const int n = (lane >> 3) + 8 * j; const LAS float* s = scr + (8 * c) * 33 + n;
        v4u o; o.x = pk2(s[0 * 33], s[1 * 33]); o.y = pk2(s[2 * 33], s[3 * 33]); o.z = pk2(s[4 * 33], s[5 * 33]); o.w = pk2(s[6 * 33], s[7 * 33]);
        const int nn = n0 + n;
        if (kind >= 3) {
            const int row = kind == 5 ? nn : ((nn >> 7) * 256 + (kind - 3) * 128 + (nn & 127)); int f0 = (int)o.x, f1 = (int)o.y;
            f0 = __builtin_amdgcn_cvt_pk_fp8_f32(64.f * s[0 * 33], 64.f * s[1 * 33], f0, false); f0 = __builtin_amdgcn_cvt_pk_fp8_f32(64.f * s[2 * 33], 64.f * s[3 * 33], f0, true);
            f1 = __builtin_amdgcn_cvt_pk_fp8_f32(64.f * s[4 * 33], 64.f * s[5 * 33], f1, false); f1 = __builtin_amdgcn_cvt_pk_fp8_f32(64.f * s[6 * 33], 64.f * s[7 * 33], f1, true);
            *(GAS v2u*)((unsigned char*)WT + (size_t)row * K + k0 + 8 * c) = (v2u){(unsigned)f0, (unsigned)f1};
        } else {
        const int row = kind == 0 ? nn : ((nn >> 7) * 256 + (kind - 1) * 128 + (nn & 127));
        *(GAS v4u*)(WT + (size_t)row * K + k0 + 8 * c) = o; } }
    LDS_WAIT(); asm volatile("" ::: "memory");
}
__device__ __forceinline__ void conv_cols_i8(const float* W, int K, int N, const float* g, unsigned char* WQ, float* SW, int nb, Frame& F, int orow0 = -1) {
    constexpr int CC_PITCH = 2 * DM + 16;
    LAS unsigned char* T = F.lds + RING_OFF; LAS float* red = (LAS float*)(F.lds + RING_OFF + 32 * CC_PITCH);
    static_assert(32 * CC_PITCH + 1024 <= MISC_OFF, "conv LDS");
    const int n0 = 32 * nb, lane = F.lane, nkb = K / 64, o0 = orow0 < 0 ? n0 : orow0;
    const float* wp0 = W + (size_t)(lane >> 5) * N + n0 + (lane & 31);
    float mx = 0.f;
    for (int kb = F.wave; kb < nkb; kb += NWAVES) {
        const float* wp = wp0 + (size_t)(64 * kb) * N; const float* gp = g + 64 * kb + (lane >> 5);
        float ld[32];
#pragma unroll
        for (int i = 0; i < 32; ++i) ld[i] = wp[(size_t)(2 * i) * N];
        LAS unsigned char* tp = T + (lane & 31) * CC_PITCH + 2 * (64 * kb + (lane >> 5));
#pragma unroll
        for (int i = 0; i < 32; ++i) { const unsigned h = f2bf(ld[i] * gp[2 * i]); mx = fmaxf(mx, fabsf(__builtin_bit_cast(float, h << 16))); *(LAS unsigned short*)(tp + 4 * i) = (unsigned short)h; }
    }
    mx = fmaxf(mx, __shfl_xor(mx, 32));
    if (lane < 32) red[F.wave * 32 + lane] = mx;
    __syncthreads();
#pragma unroll
    for (int j = 0; j < 4; ++j) { const int n = 4 * F.wave + j;
        float cm = 0.f;
#pragma unroll
        for (int w = 0; w < NWAVES; ++w) cm = fmaxf(cm, red[w * 32 + n]);
        const float inv = cm > 0.f ? 127.0f / cm : 0.f;
        if (lane == 0) SW[o0 + n] = cm * (1.0f / 127.0f);
        const LAS unsigned char* tr = T + n * CC_PITCH + 16 * lane; unsigned char* wq = WQ + (size_t)(o0 + n) * K + 8 * lane;
#pragma unroll
        for (int it = 0; it < 4; ++it) { const v4u w = *(const LAS v4u*)(tr + 1024 * it);
            *(GAS v2u*)(wq + 512 * it) = (v2u){q8pack4(bflo(w.x), bfhi(w.x), bflo(w.y), bfhi(w.y), inv), q8pack4(bflo(w.z), bfhi(w.z), bflo(w.w), bfhi(w.w), inv)}; }
    }
    __syncthreads();
}
__device__ __forceinline__ void conv_layer_items(Frame& F, int l, int gw, int ngw, bool do_in, bool do_rest) {
    LAS float* scr = (LAS float*)(F.lds + RING_OFF + F.wave * 16384);
    constexpr int I_IN = (DM / 64) * (NPROJ / 32), I_OUT = (DM / 64) * (DM / 32), I_G = (DM / 64) * (DFF / 32), I_D = (DFF / 64) * (DM / 32);
    const float* w_in = inp(2) + (size_t)l * DM * NPROJ; const float* w_out = inp(19) + (size_t)l * DM * DM;
    const float* w_g = inp(21) + (size_t)l * DM * DFF; const float* w_u = inp(22) + (size_t)l * DM * DFF; const float* w_d = inp(23) + (size_t)l * DFF * DM;
    const float* g_mix = inp(1) + l * DM; const float* g_br = inp(18) + l * DM; const float* g_ffn = inp(20) + l * DM;
    bf16* WIN = (bf16*)(wsp() + WS_WIN); bf16* WOUT = (bf16*)(wsp() + WS_WOUT); bf16* WGU = (bf16*)(wsp() + WS_WGU); bf16* WDN = (bf16*)(wsp() + WS_WDN);
    if (do_in) {
        for (int it = gw; it < I_IN; it += ngw) conv_item(w_in, DM, NPROJ, g_mix, WIN, 0, scr, it, F.lane);
    }
    if (do_rest) {
        for (int it = gw; it < (I8_OUT ? 0 : I_OUT) + (FFN1_I8 ? 0 : 2 * I_G) + I_D; it += ngw) {
            int r = it + (I8_OUT ? I_OUT : 0); if (FFN1_I8 && r >= I_OUT) r += 2 * I_G;
            if (r < I_OUT) { conv_item(w_out, DM, DM, g_br, WOUT, 0, scr, r, F.lane); continue; } r -= I_OUT;
            if (r < I_G) { conv_item(w_g, DM, DFF, g_ffn, WGU, FFN_FP8 ? 3 : 1, scr, r, F.lane); continue; } r -= I_G;
            if (r < I_G) { conv_item(w_u, DM, DFF, g_ffn, WGU, FFN_FP8 ? 4 : 2, scr, r, F.lane); continue; } r -= I_G;
            conv_item(w_d, DFF, DM, nullptr, WDN, FFN_FP8 ? 5 : 0, scr, r, F.lane);
        }
    }
}

constexpr int WINB_NB = 8 * __builtin_popcount(BFMASK), WINB_ITEMS = (DM / 64) * WINB_NB;
__device__ __forceinline__ bf16* winb_ptr() { return (bf16*)outp() + (size_t)6 * M * GW; }
__device__ __forceinline__ void conv_winb(Frame& F, int l, int item) {
    if (item >= WINB_ITEMS) return;
    const int kb = item / (WINB_NB ? WINB_NB : 1), r = item % (WINB_NB ? WINB_NB : 1); unsigned m = BFMASK; for (int j = 0; j < (r >> 3); ++j) m &= m - 1;
    conv_item(inp(2) + (size_t)l * DM * NPROJ, DM, NPROJ, inp(1) + l * DM, winb_ptr(), 0, (LAS float*)(F.lds + RING_OFF + F.wave * 16384), kb * (NPROJ / 32) + __builtin_ctz(m) * 8 + (r & 7), F.lane);
}
__device__ __forceinline__ void ph_prologue(Frame& F) {
    if (I8_IN) {
        for (int nb = blockIdx.x; nb < NPROJ / 32; nb += F.G) conv_cols_i8(inp(2), DM, NPROJ, inp(1), wsp() + WS_WIN, (float*)(wsp() + WS_SMALL + SM_SWIN), nb, F);
        unsigned char* WIN = wsp() + WS_WIN; float* SWIN = (float*)(wsp() + WS_SMALL + SM_SWIN);
        for (int i = F.gw * 64 + F.lane; i < 64 * DM / 16; i += F.ngw * 64) *(GAS v4u*)(WIN + (size_t)NPROJ * DM + (size_t)i * 16) = (v4u){0u, 0u, 0u, 0u};
        if (blockIdx.x == 0 && F.tid < NPROJ_P - NPROJ) SWIN[NPROJ + F.tid] = 0.f;
        for (int it = F.gw; it < WINB_ITEMS; it += F.ngw) conv_winb(F, 0, it);
    } else {
    conv_layer_items(F, 0, F.gw, F.ngw, true, false);
    { bf16* WIN = (bf16*)(wsp() + WS_WIN);
      for (int i = F.gw * 64 + F.lane; i < 64 * DM / 8; i += F.ngw * 64) *(GAS v4u*)(WIN + (size_t)NPROJ * DM + (size_t)i * 8) = (v4u){0u, 0u, 0u, 0u}; } }
    if (blockIdx.x == 0) {
        int* TB = (int*)(wsp() + WS_SMALL + SM_TB);
        for (int d = F.tid; d < 2049; d += NTHR) {
            int bkt = d;
            if (d >= 16) bkt = 16 + (d >= 22) + (d >= 30) + (d >= 40) + (d >= 54) + (d >= 73) + (d >= 99) + (d >= 134) + (d >= 182) + (d >= 246) + (d >= 332) + (d >= 450) + (d >= 609) + (d >= 825) + (d >= 1117) + (d >= 1513);
            TB[d] = bkt;
        }
    }
    if (blockIdx.x >= 1 && blockIdx.x <= 16) {
        const int hcol = blockIdx.x - 1; float* BT = (float*)(wsp() + WS_SMALL + SM_BIAS) + hcol * 2048; const float* pb = inp(3);
        for (int d = F.tid; d < 2048; d += NTHR) {
            int bkt = d;
            if (d >= 16) bkt = 16 + (d >= 22) + (d >= 30) + (d >= 40) + (d >= 54) + (d >= 73) + (d >= 99) + (d >= 134) + (d >= 182) + (d >= 246) + (d >= 332) + (d >= 450) + (d >= 609) + (d >= 825) + (d >= 1117) + (d >= 1513);
            BT[d] = pb[bkt * 16 + hcol] * 1.4426950408889634f;
        }
    }
    { bf16* WT = (bf16*)(wsp() + WS_SMALL + SM_WT); const float* w2 = inp(9); const float* a2 = inp(11); const float* g2 = inp(12);
      for (int idx = blockIdx.x * NTHR + F.tid; idx < DEPTH * 448 * GW; idx += F.G * NTHR) {
          const int c = idx % GW, k = (idx / GW) % 448, l = idx / (GW * 448);
          const float v = k < 96 ? w2[((size_t)l * 96 + k) * GW + c] : (k < 192 ? a2[((size_t)l * 96 + (k - 96)) * GW + c] : g2[((size_t)l * 256 + (k - 192)) * GW + c]);
          const int r32_ = c & 31, hct = c >> 5, ks_ = k >> 4, hh_ = (k >> 3) & 1;
          WT[(size_t)l * GW * 448 + (((size_t)hct * 28 + ks_) * 64 + 32 * hh_ + r32_) * 8 + (k & 7)] = (bf16)f2bf(v); } }
    const float* x = inp(0); bf16* XB = (bf16*)(wsp() + WS_XB); pg8::fx_t* ssq = (pg8::fx_t*)(ctlp() + CW_SSQ);
    for (int m = F.gw; m < M; m += F.ngw) {
        const GAS f32x4* xr = (const GAS f32x4*)(x + (size_t)m * DM) + F.lane; GAS v2u* o = (GAS v2u*)(XB + (size_t)m * DM) + F.lane; float s = 0.f;
#pragma unroll
        for (int j = 0; j < 8; ++j) { const f32x4 v = xr[64 * j]; s += (v.x * v.x + v.y * v.y) + (v.z * v.z + v.w * v.w); o[64 * j] = (v2u){pk2(v.x, v.y), pk2(v.z, v.w)}; }
        s = wave_sum(s); if (F.lane == 0) pg8::fx_add(ssq + m, s);
        if (I8_IN) {
            float mx = 0.f;
#pragma unroll
            for (int j = 0; j < 8; ++j) { const f32x4 v = xr[64 * j]; mx = fmaxf(fmaxf(mx, fmaxf(fabsf(v.x), fabsf(v.y))), fmaxf(fabsf(v.z), fabsf(v.w))); }
            mx = wave_max(mx); const float inv = mx > 0.f ? 127.0f / mx : 0.f; GAS unsigned* q = (GAS unsigned*)(wsp() + WS_XQ + (size_t)m * DM) + F.lane;
#pragma unroll
            for (int j = 0; j < 8; ++j) { const f32x4 v = xr[64 * j]; q[64 * j] = q8pack4(v.x, v.y, v.z, v.w, inv); }
            if (F.lane == 0) ((float*)(wsp() + WS_SMALL + SM_SAX))[m] = mx * (1.0f / 127.0f);
        }
    }
}

__device__ __forceinline__ void ph_quantx(Frame& F, pg8::fx_t* ssq) {
    const bf16* XB = (const bf16*)(wsp() + WS_XB); unsigned char* XQ = wsp() + WS_XQ; float* SAX = (float*)(wsp() + WS_SMALL + SM_SAX);
    for (int m = F.gw; m < M; m += F.ngw) {
        const GAS v4u* xr = (const GAS v4u*)(XB + (size_t)m * DM) + F.lane; v4u w[4]; float mx = 0.f;
#pragma unroll
        for (int j = 0; j < 4; ++j) w[j] = xr[64 * j];
        float sq = 0.f;
#pragma unroll
        for (int j = 0; j < 4; ++j) { const float e8[8] = {bflo(w[j].x), bfhi(w[j].x), bflo(w[j].y), bfhi(w[j].y), bflo(w[j].z), bfhi(w[j].z), bflo(w[j].w), bfhi(w[j].w)};
#pragma unroll
            for (int e = 0; e < 8; ++e) sq += e8[e] * e8[e]; }
        sq = wave_sum(sq);
#pragma unroll
        for (int j = 0; j < 4; ++j) { mx = fmaxf(fmaxf(mx, fmaxf(fabsf(bflo(w[j].x)), fabsf(bfhi(w[j].x)))), fmaxf(fabsf(bflo(w[j].y)), fabsf(bfhi(w[j].y))));
            mx = fmaxf(fmaxf(mx, fmaxf(fabsf(bflo(w[j].z)), fabsf(bfhi(w[j].z)))), fmaxf(fabsf(bflo(w[j].w)), fabsf(bfhi(w[j].w)))); }
        mx = wave_max(mx); const float inv = mx > 0.f ? 127.0f / mx : 0.f; GAS v2u* q = (GAS v2u*)(XQ + (size_t)m * DM) + F.lane;
#pragma unroll
        for (int j = 0; j < 4; ++j) q[64 * j] = (v2u){q8pack4(bflo(w[j].x), bfhi(w[j].x), bflo(w[j].y), bfhi(w[j].y), inv), q8pack4(bflo(w[j].z), bfhi(w[j].z), bflo(w[j].w), bfhi(w[j].w), inv)};
        if (F.lane == 0) { SAX[m] = mx * (1.0f / 127.0f); ssq[m] = (pg8::fx_t)(long long)__float2ll_rn(sq * 1073741824.0f); }
    }
}

constexpr int PR_PITCH = 912;
constexpr int PR_PRM_OFF = 32768, PR_MUA_OFF = PR_PRM_OFF + 8 * 512 * 4;
__device__ __forceinline__ float fast_tanh(float x) { return 1.0f - 2.0f * __builtin_amdgcn_rcpf(__expf(2.0f * x) + 1.0f); }
__device__ __forceinline__ float fast_sigmoid(float x) { return __builtin_amdgcn_rcpf(1.0f + __expf(-x)); }
constexpr int PR_OT_OFF = 51200, PR_OT_PITCH = 72, PR_OT_TILE = 32 * PR_OT_PITCH, PR_OT_WAVE = 6 * PR_OT_TILE;
static_assert(PR_OT_OFF + 8 * PR_OT_WAVE <= MISC_OFF, "prep LDS");
__device__ __forceinline__ void ph_prep(Frame& F, int l) {
    const bf16* PROJ = (const bf16*)(wsp() + WS_PROJ);
    bf16* R_ = (bf16*)outp();
    bf16* E_ = R_ + (size_t)M * GW; bf16* KP_ = E_ + (size_t)M * GW; bf16* V_ = KP_ + (size_t)M * GW;
    bf16* KK_ = (bf16*)outp() + (size_t)4 * M * GW; bf16* AS_ = KK_ + (size_t)M * GW; bf16* G_ = (bf16*)(wsp() + WS_G); float* BC = (float*)(wsp() + WS_BC);
    const bf16* WT = (const bf16*)(wsp() + WS_SMALL + SM_WT) + (size_t)l * GW * 448;
    LAS unsigned char* actL = F.lds + RING_OFF; LAS float* PRM = (LAS float*)(F.lds + PR_PRM_OFF); LAS float* MUA = (LAS float*)(F.lds + PR_MUA_OFF);
    { const float* mu = inp(7) + l * D_W; const float* w0 = inp(8) + l * GW; const float* a0 = inp(10) + l * GW; const float* k_k = inp(13) + l * GW; const float* k_a = inp(14) + l * GW; const float* r_k = inp(15) + l * GW;
      const int c = F.tid;
      PRM[c] = mu[D_R + c]; PRM[512 + c] = mu[D_K + c]; PRM[1024 + c] = mu[D_V + c]; PRM[1536 + c] = w0[c]; PRM[2048 + c] = a0[c]; PRM[2560 + c] = k_k[c]; PRM[3072 + c] = k_a[c]; PRM[3584 + c] = r_k[c];
      if (c < 448) MUA[c] = mu[c < 96 ? D_WD + c : (c < 192 ? D_AD + (c - 96) : D_GD + (c - 192))]; }
    __syncthreads();
    const int h = F.wave;
    for (int it = blockIdx.x; it < M / 32; it += F.G) {
        const int m0 = it * 32;
        int tid_ = F.wave * 64 + pg8::lane_now(); asm volatile("" : "+v"(tid_));
        const int tid = tid_, r32 = tid & 31, hh = (tid >> 5) & 1, lane = tid & 63;
        LAS unsigned char* OT = F.lds + PR_OT_OFF + h * PR_OT_WAVE;
        { v2u pc[7], pp[7];
#pragma unroll
          for (int i = 0; i < 7; ++i) { const int gi = tid + NTHR * i, t = gi / 112, k = 4 * (gi % 112), m = m0 + t;
              const int col = k < 96 ? D_WD + k : (k < 192 ? D_AD + (k - 96) : D_GD + (k - 192)); const bf16* src = PROJ + (size_t)m * NPROJ_P + CD + col;
              pc[i] = *(const GAS v2u*)src; pp[i] = (v2u){0u, 0u}; if ((m % SEQ) > 0) pp[i] = *(const GAS v2u*)(src - NPROJ_P); }
#pragma unroll
          for (int i = 0; i < 7; ++i) { const int gi = tid + NTHR * i, t = gi / 112, k = 4 * (gi % 112);
              const f32x4 mv = *(const LAS f32x4*)(MUA + k);
              float x[4] = {bflo(pc[i].x), bfhi(pc[i].x), bflo(pc[i].y), bfhi(pc[i].y)}; const float xp[4] = {bflo(pp[i].x), bfhi(pp[i].x), bflo(pp[i].y), bfhi(pp[i].y)};
#pragma unroll
              for (int e = 0; e < 4; ++e) { x[e] += (xp[e] - x[e]) * mv[e]; x[e] = k < 96 ? fast_tanh(x[e]) : (k < 192 ? x[e] : fast_sigmoid(x[e])); }
              *(LAS v2u*)(actL + t * PR_PITCH + 2 * k) = (v2u){pk2(x[0], x[1]), pk2(x[2], x[3])}; } }
        __syncthreads();
        const int m = m0 + r32; const bool has_prev = (m % SEQ) > 0;
        const bf16* pr = PROJ + (size_t)m * NPROJ_P + CD; const bf16* pq = pr - NPROJ_P;
        const LAS unsigned char* bp = actL + r32 * PR_PITCH + 16 * hh;
        float kkv[2][16]; float n2 = 0.f, bcv = 0.f;
#pragma unroll
        for (int ct = 0; ct < 2; ++ct) {
            const int cb = 64 * h + 32 * ct + 4 * hh;
            v4u xc[3][2], xp[3][2];
#pragma unroll
            for (int a = 0; a < 3; ++a)
#pragma unroll
                for (int i = 0; i < 2; ++i) { const int mm = m0 + (lane >> 2) + 16 * i; const bf16* src = PROJ + (size_t)mm * NPROJ_P + CD + (a == 0 ? D_R : (a == 1 ? D_K : D_V)) + 64 * h + 32 * ct + 8 * (lane & 3);
                    xc[a][i] = *(const GAS v4u*)src; xp[a][i] = (v4u){0u, 0u, 0u, 0u}; if ((mm % SEQ) > 0) xp[a][i] = *(const GAS v4u*)(src - NPROJ_P); }
            f32x16 aW, aA, aG;
            { const float z_ = zero_v();
#pragma unroll
            for (int i = 0; i < 16; ++i) { aW[i] = z_; aA[i] = z_; aG[i] = z_; } }
            const bf16* wt0 = WT + ((size_t)(2 * h + ct) * 28 * 64 + lane) * 8;
#pragma unroll
            for (int grp = 0; grp < 4; ++grp) {
                bf16x8 af[7];
#pragma unroll
                for (int q = 0; q < 7; ++q) af[q] = *(const GAS bf16x8*)(wt0 + 512 * (7 * grp + q));
#pragma unroll
                for (int q = 0; q < 7; ++q) { const int ks = 7 * grp + q; const bf16x8 bfr = *(const LAS bf16x8*)(bp + 32 * ks);
                    if (ks < 6) aW = __builtin_amdgcn_mfma_f32_32x32x16_bf16(af[q], bfr, aW, 0, 0, 0);
                    else if (ks < 12) aA = __builtin_amdgcn_mfma_f32_32x32x16_bf16(af[q], bfr, aA, 0, 0, 0);
                    else aG = __builtin_amdgcn_mfma_f32_32x32x16_bf16(af[q], bfr, aG, 0, 0, 0); }
                asm volatile("" ::: "memory");
            }
            LAS unsigned char* IN = OT + 3 * PR_OT_TILE;
#pragma unroll
            for (int a = 0; a < 3; ++a)
#pragma unroll
                for (int i = 0; i < 2; ++i) { const int cch = 64 * h + 32 * ct + 8 * (lane & 3); const f32x4 m0v = *(const LAS f32x4*)(PRM + a * 512 + cch), m1v = *(const LAS f32x4*)(PRM + a * 512 + cch + 4);
                    float xcu[8], xpu[8]; UNPACK8(xcu, 0, xc[a][i]); UNPACK8(xpu, 0, xp[a][i]); const float mw[8] = {m0v.x, m0v.y, m0v.z, m0v.w, m1v.x, m1v.y, m1v.z, m1v.w};
#pragma unroll
                    for (int e = 0; e < 8; ++e) xcu[e] += (xpu[e] - xcu[e]) * mw[e];
                    LAS unsigned char* dstp = IN + a * PR_OT_TILE + ((lane >> 2) + 16 * i) * PR_OT_PITCH + 16 * (lane & 3);
                    *(LAS v2u*)dstp = (v2u){pk2(xcu[0], xcu[1]), pk2(xcu[2], xcu[3])}; *(LAS v2u*)(dstp + 8) = (v2u){pk2(xcu[4], xcu[5]), pk2(xcu[6], xcu[7])}; }
            asm volatile("" ::: "memory");
            v2u oE[4], oK[4], oG[4];
#pragma unroll
            for (int g4 = 0; g4 < 4; ++g4) {
                const int c = cb + 8 * g4;
                const f32x4 w0v = *(const LAS f32x4*)(PRM + 1536 + c),
                            a0v = *(const LAS f32x4*)(PRM + 2048 + c), kkc = *(const LAS f32x4*)(PRM + 2560 + c), kac = *(const LAS f32x4*)(PRM + 3072 + c), rkc = *(const LAS f32x4*)(PRM + 3584 + c);
                const LAS unsigned char* inq = IN + r32 * PR_OT_PITCH + 2 * (8 * g4 + 4 * hh);
                const v2u rq = *(const LAS v2u*)inq, kq = *(const LAS v2u*)(inq + PR_OT_TILE), vq = *(const LAS v2u*)(inq + 2 * PR_OT_TILE);
                const float rsu[4] = {bflo(rq.x), bfhi(rq.x), bflo(rq.y), bfhi(rq.y)}, ksu[4] = {bflo(kq.x), bfhi(kq.x), bflo(kq.y), bfhi(kq.y)}, vsu[4] = {bflo(vq.x), bfhi(vq.x), bflo(vq.y), bfhi(vq.y)};
                float ro[4], eo[4], ko[4], vo[4], ao[4], go[4];
#pragma unroll
                for (int e = 0; e < 4; ++e) {
                    const float r = rsu[e], k = ksu[e], v = vsu[e];
                    const float ee = 0.6065306597126334f * fast_sigmoid(w0v[e] + aW[4 * g4 + e]);
                    const float as = fast_sigmoid(a0v[e] + aA[4 * g4 + e]);
                    const float kv = k * kkc[e]; kkv[ct][4 * g4 + e] = kv; n2 += kv * kv;
                    const float kp = k * (1.0f + (as - 1.0f) * kac[e]);
                    bcv += r * kp * rkc[e];
                    ro[e] = r; eo[e] = ee; ko[e] = kp; vo[e] = v; ao[e] = as; go[e] = aG[4 * g4 + e];
                }
                LAS unsigned char* ot = OT + r32 * PR_OT_PITCH + 2 * (8 * g4 + 4 * hh);
                *(LAS v2u*)(ot) = (v2u){pk2(ro[0], ro[1]), pk2(ro[2], ro[3])}; *(LAS v2u*)(ot + PR_OT_TILE) = (v2u){pk2(vo[0], vo[1]), pk2(vo[2], vo[3])}; *(LAS v2u*)(ot + 2 * PR_OT_TILE) = (v2u){pk2(ao[0], ao[1]), pk2(ao[2], ao[3])};
                oE[g4] = (v2u){pk2(eo[0], eo[1]), pk2(eo[2], eo[3])}; oK[g4] = (v2u){pk2(ko[0], ko[1]), pk2(ko[2], ko[3])}; oG[g4] = (v2u){pk2(go[0], go[1]), pk2(go[2], go[3])};
            }
            asm volatile("" ::: "memory");
#pragma unroll
            for (int batch = 0; batch < 2; ++batch) {
                bf16* const dst[3] = {batch == 0 ? R_ : E_, batch == 0 ? V_ : KP_, batch == 0 ? AS_ : G_};
                if (batch == 1) {
#pragma unroll
                    for (int g4 = 0; g4 < 4; ++g4) { LAS unsigned char* ot = OT + r32 * PR_OT_PITCH + 2 * (8 * g4 + 4 * hh); *(LAS v2u*)(ot) = oE[g4]; *(LAS v2u*)(ot + PR_OT_TILE) = oK[g4]; *(LAS v2u*)(ot + 2 * PR_OT_TILE) = oG[g4]; }
                    asm volatile("" ::: "memory"); }
#pragma unroll
                for (int a = 0; a < 3; ++a)
#pragma unroll
                    for (int i = 0; i < 2; ++i) { const int tk = (lane >> 2) + 16 * i, part = lane & 3; const LAS unsigned char* src = OT + a * PR_OT_TILE + tk * PR_OT_PITCH + 16 * part;
                        const v2u lo = *(const LAS v2u*)src, hi = *(const LAS v2u*)(src + 8);
                        *(GAS v4u*)(dst[a] + (size_t)(m0 + tk) * GW + 64 * h + 32 * ct + 8 * part) = (v4u){lo.x, lo.y, hi.x, hi.y}; }
                asm volatile("" ::: "memory");
            }
        }
        n2 += __shfl_xor(n2, 32); bcv += __shfl_xor(bcv, 32);
        const float inv = 1.0f / fmaxf(sqrtf(n2), 1e-12f);
#pragma unroll
        for (int ct = 0; ct < 2; ++ct)
#pragma unroll
            for (int g4 = 0; g4 < 4; ++g4) *(LAS v2u*)(OT + ct * PR_OT_TILE + r32 * PR_OT_PITCH + 2 * (8 * g4 + 4 * hh)) = (v2u){pk2(kkv[ct][4 * g4] * inv, kkv[ct][4 * g4 + 1] * inv), pk2(kkv[ct][4 * g4 + 2] * inv, kkv[ct][4 * g4 + 3] * inv)};
        asm volatile("" ::: "memory");
#pragma unroll
        for (int ct = 0; ct < 2; ++ct)
#pragma unroll
            for (int i = 0; i < 2; ++i) { const int tk = (lane >> 2) + 16 * i, part = lane & 3; const LAS unsigned char* src = OT + ct * PR_OT_TILE + tk * PR_OT_PITCH + 16 * part;
                const v2u lo = *(const LAS v2u*)src, hi = *(const LAS v2u*)(src + 8);
                *(GAS v4u*)(KK_ + (size_t)(m0 + tk) * GW + 64 * h + 32 * ct + 8 * part) = (v4u){lo.x, lo.y, hi.x, hi.y}; }
        asm volatile("" ::: "memory");
        if (hh == 0) BC[(size_t)m * NH + h] = bcv;
        __syncthreads();
    }
}

__device__ __forceinline__ Frame mkframe(LAS unsigned char* lds, int wv) {
    Frame F; F.lds = lds; { int t_ = wv * 64 + pg8::lane_now(); asm volatile("" : "+v"(t_)); F.tid = t_; } F.lane = F.tid & 63; F.wave = wv;
    F.G = gridDim.x; { const int bx = blockIdx.x; F.vcu = (F.G % 8 == 0) ? (bx % 8) * (F.G / 8) + bx / 8 : bx; }
    F.gw = blockIdx.x * NWAVES + F.wave; F.ngw = F.G * NWAVES; return F;
}

#ifndef UNPACK8
#define UNPACK8(dst, o, W_) do { dst[(o)] = bflo((W_).x); dst[(o) + 1] = bfhi((W_).x); dst[(o) + 2] = bflo((W_).y); dst[(o) + 3] = bfhi((W_).y); dst[(o) + 4] = bflo((W_).z); dst[(o) + 5] = bfhi((W_).z); dst[(o) + 6] = bflo((W_).w); dst[(o) + 7] = bfhi((W_).w); } while (0)
#endif
#define DOT8(q, o, W_) ((q)[(o)] * bflo((W_).x) + (q)[(o) + 1] * bfhi((W_).x) + (q)[(o) + 2] * bflo((W_).y) + (q)[(o) + 3] * bfhi((W_).y) + (q)[(o) + 4] * bflo((W_).z) + (q)[(o) + 5] * bfhi((W_).z) + (q)[(o) + 6] * bflo((W_).w) + (q)[(o) + 7] * bfhi((W_).w))
#define AXPY8(acc, o, sc, pe, W_) do { acc[(o)] = acc[(o)] * (sc) + (pe) * bflo((W_).x); acc[(o) + 1] = acc[(o) + 1] * (sc) + (pe) * bfhi((W_).x); acc[(o) + 2] = acc[(o) + 2] * (sc) + (pe) * bflo((W_).y); acc[(o) + 3] = acc[(o) + 3] * (sc) + (pe) * bfhi((W_).y); \
    acc[(o) + 4] = acc[(o) + 4] * (sc) + (pe) * bflo((W_).z); acc[(o) + 5] = acc[(o) + 5] * (sc) + (pe) * bfhi((W_).z); acc[(o) + 6] = acc[(o) + 6] * (sc) + (pe) * bflo((W_).w); acc[(o) + 7] = acc[(o) + 7] * (sc) + (pe) * bfhi((W_).w); } while (0)
__device__ __forceinline__ void mix_a_simple(Frame& F) {
    const bf16* PROJ = (const bf16*)(wsp() + WS_PROJ); bf16* YC = (bf16*)(wsp() + WS_YCAT); const int* TB = (const int*)(wsp() + WS_SMALL + SM_TB); const float* pb = inp(3);
    const int nthr = F.G * NTHR;
    for (int idx = blockIdx.x * NTHR + F.tid; idx < M * NH; idx += nthr) {
        const int m = idx >> 3, h = idx & 7, t = m % SEQ;
        float q[64], acc[64];
        { const GAS v4u* qp = (const GAS v4u*)(PROJ + (size_t)m * NPROJ_P + CA_Q + 64 * h);
#pragma unroll
          for (int i = 0; i < 8; ++i) { const v4u w = qp[i]; UNPACK8(q, 8 * i, w); } }
#pragma unroll
        for (int i = 0; i < 64; ++i) acc[i] = 0.f;
        float mx = -1e30f, l = 0.f;
        for (int p = 0; p < 3; ++p) { const int d = p == 0 ? 1 : (p == 1 ? 4 : 16);
            for (int j = 0; j <= 128; ++j) { const int kp = t - j * d; if (kp < 0) break;
                const bf16* row = PROJ + (size_t)(m - j * d) * NPROJ_P; const GAS v4u* kq = (const GAS v4u*)(row + CA_K + 64 * h); const GAS v4u* vq = (const GAS v4u*)(row + CA_V + 64 * h);
                float s = 0.f;
#pragma unroll
                for (int i = 0; i < 8; ++i) { const v4u w = kq[i]; s += DOT8(q, 8 * i, w); }
                s = s * 0.125f + pb[TB[j * d] * 16 + h];
                const float mn = fmaxf(mx, s), sc = __expf(mx - mn), pe = __expf(s - mn); mx = mn; l = l * sc + pe;
#pragma unroll
                for (int i = 0; i < 8; ++i) { const v4u w = vq[i]; AXPY8(acc, 8 * i, sc, pe, w); }
            } }
        const float inv = 1.0f / l; GAS v4u* op = (GAS v4u*)(YC + (size_t)m * DM + 0 * GW + 64 * h);
#pragma unroll
        for (int i = 0; i < 8; ++i) op[i] = (v4u){pk2(acc[8 * i] * inv, acc[8 * i + 1] * inv), pk2(acc[8 * i + 2] * inv, acc[8 * i + 3] * inv), pk2(acc[8 * i + 4] * inv, acc[8 * i + 5] * inv), pk2(acc[8 * i + 6] * inv, acc[8 * i + 7] * inv)};
    }
}
__device__ __forceinline__ void mix_c_simple(Frame& F, int l = 0) {
    const bf16* PROJ = (const bf16*)(wsp() + WS_PROJ); bf16* YC = (bf16*)(wsp() + WS_YCAT); const int* TB = (const int*)(wsp() + WS_SMALL + SM_TB); const float* pb = inp(3);
    const float* KBAR = (const float*)(wsp() + CTL_KBAR) + (size_t)l * 64 * 8 * 64;
    const int nthr = F.G * NTHR;
    for (int idx = blockIdx.x * NTHR + F.tid; idx < M * NH; idx += nthr) {
        const int m = idx >> 3, h = idx & 7, t = m % SEQ, b = m / SEQ, ob = t >> 8;
        float q[64], acc[64];
        { const GAS v4u* qp = (const GAS v4u*)(PROJ + (size_t)m * NPROJ_P + CC_Q + 64 * h);
#pragma unroll
          for (int i = 0; i < 8; ++i) { const v4u w = qp[i]; UNPACK8(q, 8 * i, w); } }
        float gate[8];
#pragma unroll
        for (int n = 0; n < 8; ++n) { float s = 0.f; if (n < ob) { const float* kb = KBAR + ((b * NH + h) * 8 + n) * 64;
#pragma unroll
                for (int i = 0; i < 64; ++i) s += q[i] * kb[i]; } gate[n] = s; }
        unsigned sel = 0u;
#pragma unroll
        for (int n = 0; n < 8; ++n) { int rank = 0;
#pragma unroll
            for (int n2 = 0; n2 < 8; ++n2) rank += (n2 < ob && n2 != n && (gate[n2] > gate[n] || (gate[n2] == gate[n] && n2 < n))) ? 1 : 0;
            if (n < ob && rank < 3) sel |= 1u << n; }
        sel |= 1u << ob;
#pragma unroll
        for (int i = 0; i < 64; ++i) acc[i] = 0.f;
        float mx = -1e30f, l = 0.f;
        for (int n = 0; n <= ob; ++n) { if (!((sel >> n) & 1u)) continue; const int kmax = n == ob ? (t & 255) : 255;
            for (int i2 = 0; i2 <= kmax; ++i2) { const int kp = 256 * n + i2;
                const bf16* row = PROJ + ((size_t)b * SEQ + kp) * NPROJ_P; const GAS v4u* kq = (const GAS v4u*)(row + CC_K + 64 * h); const GAS v4u* vq = (const GAS v4u*)(row + CC_V + 64 * h);
                float s = 0.f;
#pragma unroll
                for (int i = 0; i < 8; ++i) { const v4u w = kq[i]; s += DOT8(q, 8 * i, w); }
                s = s * 0.125f + pb[TB[t - kp] * 16 + 8 + h];
                const float mn = fmaxf(mx, s), sc = __expf(mx - mn), pe = __expf(s - mn); mx = mn; l = l * sc + pe;
#pragma unroll
                for (int i = 0; i < 8; ++i) { const v4u w = vq[i]; AXPY8(acc, 8 * i, sc, pe, w); }
            } }
        const float inv = 1.0f / l; GAS v4u* op = (GAS v4u*)(YC + (size_t)m * DM + 2 * GW + 64 * h);
#pragma unroll
        for (int i = 0; i < 8; ++i) op[i] = (v4u){pk2(acc[8 * i] * inv, acc[8 * i + 1] * inv), pk2(acc[8 * i + 2] * inv, acc[8 * i + 3] * inv), pk2(acc[8 * i + 4] * inv, acc[8 * i + 5] * inv), pk2(acc[8 * i + 6] * inv, acc[8 * i + 7] * inv)};
    }
}
__device__ __forceinline__ void mix_b_simple(Frame& F, int l) {
    const bf16* PROJ = (const bf16*)(wsp() + WS_PROJ); bf16* YC = (bf16*)(wsp() + WS_YCAT); const pg8::fx_t* ST = (const pg8::fx_t*)(wsp() + CTL_STATS) + (size_t)l * M * 2;
    const float* lng = inp(4) + l * GW; const float* sw = inp(5) + (size_t)l * NH * 128 * 128; const float* sb = inp(6) + l * NH * 128;
    const int nthr = F.G * NTHR;
    for (int idx = blockIdx.x * NTHR + F.tid; idx < M * GW; idx += nthr) {
        const int m = idx >> 9, c = idx & 511, g = c >> 6, tt = m & 127, m0 = m - tt;
        const float* wrow = sw + ((size_t)g * 128 + tt) * 128; const float gn = lng[c]; float s = 0.f;
        for (int s2 = 0; s2 <= tt; ++s2) { const int ms = m0 + s2; const float mu_ = pg8::fx_get(ST + 2 * ms) * (1.0f / 512.0f), rs_ = 1.0f / sqrtf(fmaxf(pg8::fx_get(ST + 2 * ms + 1) * (1.0f / 512.0f) - mu_ * mu_, 0.f) + 1e-5f); const float vv = (gelu_tanh(bf2f(PROJ[(size_t)ms * NPROJ_P + CB_V + c])) - mu_) * rs_ * gn; s += wrow[s2] * vv; }
        const float u = gelu_tanh(bf2f(PROJ[(size_t)m * NPROJ_P + CB_U + c]));
        YC[(size_t)m * DM + GW + c] = (bf16)f2bf(u * (s + sb[g * 128 + tt]));
    }
}
__device__ __forceinline__ float rdl(float v, int k) { return __builtin_bit_cast(float, __builtin_amdgcn_readlane(__builtin_bit_cast(int, v), k)); }
__device__ __forceinline__ void mix_d_simple(Frame& F) {
    const bf16* R_ = (const bf16*)outp();
    const bf16* E_ = R_ + (size_t)M * GW; const bf16* KP_ = E_ + (size_t)M * GW; const bf16* V_ = KP_ + (size_t)M * GW;
    const bf16* KK_ = (const bf16*)outp() + (size_t)4 * M * GW; const bf16* AS_ = KK_ + (size_t)M * GW; float* YD = (float*)(wsp() + WS_YD);
    for (int it = F.gw; it < BATCH * NH; it += F.ngw) {
        const int b = it >> 3, h = it & 7; float s[64];
#pragma unroll
        for (int k = 0; k < 64; ++k) s[k] = 0.f;
        for (int t = 0; t < SEQ; ++t) {
            const size_t o = ((size_t)b * SEQ + t) * GW + 64 * h + F.lane;
            const float r = bf2f(R_[o]), w = __expf(-bf2f(E_[o])), kp = bf2f(KP_[o]), v = bf2f(V_[o]), kk = bf2f(KK_[o]), as = bf2f(AS_[o]);
            const float a = -kk, bb = kk * as;
            float sa = 0.f;
#pragma unroll
            for (int k = 0; k < 64; ++k) sa += s[k] * rdl(a, k);
            float y = 0.f;
#pragma unroll
            for (int k = 0; k < 64; ++k) { s[k] = s[k] * rdl(w, k) + sa * rdl(bb, k) + v * rdl(kp, k); y += s[k] * rdl(r, k); }
            YD[o] = y;
        }
    }
}

constexpr float LOG2E = 1.4426950408889634f;

constexpr int SC_T = 32, SC_TOK = (5 * 64 + 32) * 4, SC_BUF = SC_T * SC_TOK, SC_YB = SC_T * 32 * 4, SC_LDS = 2 * SC_BUF + 2 * SC_YB;
template <int CTRL> __device__ __forceinline__ float dpp_add(float x) {
    const int y = __builtin_amdgcn_update_dpp(0, __builtin_bit_cast(int, x), CTRL, 0xF, 0xF, false);
    return x + __builtin_bit_cast(float, y);
}
__device__ __forceinline__ float red8(float x) { x = dpp_add<0xB1>(x); x = dpp_add<0x4E>(x); x = dpp_add<0x141>(x); return x; }
__device__ __forceinline__ void scan_unit(LAS unsigned char* lds, int unit, int tid) {
    const int half = unit & 1, h = (unit >> 1) & 7, b = unit >> 4;
    const bf16* R_ = (const bf16*)outp();
    const bf16* E_ = R_ + (size_t)M * GW; const bf16* KP_ = E_ + (size_t)M * GW; const bf16* V_ = KP_ + (size_t)M * GW;
    const bf16* KK_ = (const bf16*)outp() + (size_t)4 * M * GW; const bf16* AS_ = KK_ + (size_t)M * GW; float* YD = (float*)(wsp() + WS_YD);
    const int lane = tid & 63, wave = __builtin_amdgcn_readfirstlane(tid >> 6);
    const bool scanner = wave < 4;
    const int j = lane & 7, rowl = (wave & 3) * 8 + (lane >> 3);
    const int st = tid & 255, tt = st >> 3, cg = st & 7;
    const size_t gbase = ((size_t)b * SEQ) * GW + 64 * h + 8 * cg;
#define SC_STAGE(c, buf) do { const size_t o_ = gbase + (size_t)((c) * SC_T + tt) * GW; \
        const v4u g_r = *(const GAS v4u*)(R_ + o_), g_e = *(const GAS v4u*)(E_ + o_), g_k = *(const GAS v4u*)(KP_ + o_), g_v = *(const GAS v4u*)(V_ + o_), g_kk = *(const GAS v4u*)(KK_ + o_), g_as = *(const GAS v4u*)(AS_ + o_); \
        LAS float* p_ = (LAS float*)(lds + (buf) * SC_BUF + tt * SC_TOK) + 8 * cg; float kk_[8], x_[8], y_[8]; \
        UNPACK8(kk_, 0, g_kk); \
        *(LAS f32x4*)(p_) = (f32x4){-kk_[0], -kk_[1], -kk_[2], -kk_[3]}; *(LAS f32x4*)(p_ + 4) = (f32x4){-kk_[4], -kk_[5], -kk_[6], -kk_[7]}; \
        UNPACK8(x_, 0, g_e); *(LAS f32x4*)(p_ + 64) = (f32x4){__expf(-x_[0]), __expf(-x_[1]), __expf(-x_[2]), __expf(-x_[3])}; *(LAS f32x4*)(p_ + 68) = (f32x4){__expf(-x_[4]), __expf(-x_[5]), __expf(-x_[6]), __expf(-x_[7])}; \
        UNPACK8(y_, 0, g_as); *(LAS f32x4*)(p_ + 128) = (f32x4){kk_[0] * y_[0], kk_[1] * y_[1], kk_[2] * y_[2], kk_[3] * y_[3]}; *(LAS f32x4*)(p_ + 132) = (f32x4){kk_[4] * y_[4], kk_[5] * y_[5], kk_[6] * y_[6], kk_[7] * y_[7]}; \
        UNPACK8(x_, 0, g_k); *(LAS f32x4*)(p_ + 192) = (f32x4){x_[0], x_[1], x_[2], x_[3]}; *(LAS f32x4*)(p_ + 196) = (f32x4){x_[4], x_[5], x_[6], x_[7]}; \
        UNPACK8(x_, 0, g_r); *(LAS f32x4*)(p_ + 256) = (f32x4){x_[0], x_[1], x_[2], x_[3]}; *(LAS f32x4*)(p_ + 260) = (f32x4){x_[4], x_[5], x_[6], x_[7]}; \
        if ((cg >> 2) == half) { UNPACK8(x_, 0, g_v); LAS float* v_ = (LAS float*)(lds + (buf) * SC_BUF + tt * SC_TOK) + 320 + 8 * (cg & 3); \
            *(LAS f32x4*)(v_) = (f32x4){x_[0], x_[1], x_[2], x_[3]}; *(LAS f32x4*)(v_ + 4) = (f32x4){x_[4], x_[5], x_[6], x_[7]}; } } while (0)
    if (!scanner) SC_STAGE(0, 0);
    __syncthreads();
    f32x4 s0 = {0.f, 0.f, 0.f, 0.f}, s1 = {0.f, 0.f, 0.f, 0.f};
    float ykeep = 0.f;
    for (int c = 0; c < SEQ / SC_T; ++c) {
        const int cur = c & 1;
        LAS float* yb = (LAS float*)(lds + 2 * SC_BUF + cur * SC_YB);
        if (scanner) {
            const LAS float* base = (const LAS float*)(lds + cur * SC_BUF) + 8 * j;
            const LAS float* vbase = (const LAS float*)(lds + cur * SC_BUF) + 320 + rowl;
            f32x4 a0 = *(const LAS f32x4*)(base), a1 = *(const LAS f32x4*)(base + 4), w0 = *(const LAS f32x4*)(base + 64), w1 = *(const LAS f32x4*)(base + 68), b0 = *(const LAS f32x4*)(base + 128), b1 = *(const LAS f32x4*)(base + 132),
                  k0 = *(const LAS f32x4*)(base + 192), k1 = *(const LAS f32x4*)(base + 196), r0 = *(const LAS f32x4*)(base + 256), r1 = *(const LAS f32x4*)(base + 260);
            float vv = *vbase;
#pragma unroll
            for (int t = 0; t < SC_T; ++t) {
                f32x4 na0 = a0, na1 = a1, nw0 = w0, nw1 = w1, nb0 = b0, nb1 = b1, nk0 = k0, nk1 = k1, nr0 = r0, nr1 = r1; float nv = vv;
                if (t + 1 < SC_T) { const LAS float* p = base + (t + 1) * (SC_TOK / 4);
                    na0 = *(const LAS f32x4*)(p); na1 = *(const LAS f32x4*)(p + 4); nw0 = *(const LAS f32x4*)(p + 64); nw1 = *(const LAS f32x4*)(p + 68); nb0 = *(const LAS f32x4*)(p + 128); nb1 = *(const LAS f32x4*)(p + 132);
                    nk0 = *(const LAS f32x4*)(p + 192); nk1 = *(const LAS f32x4*)(p + 196); nr0 = *(const LAS f32x4*)(p + 256); nr1 = *(const LAS f32x4*)(p + 260);
                    nv = vbase[(t + 1) * (SC_TOK / 4)]; }
                const f32x4 pa = s0 * a0 + s1 * a1;
                float sa = (pa.x + pa.y) + (pa.z + pa.w);
                const f32x4 sw0 = s0 * w0 + vv * k0, sw1 = s1 * w1 + vv * k1;
                sa = red8(sa);
                s0 = sa * b0 + sw0; s1 = sa * b1 + sw1;
                const f32x4 py = s0 * r0 + s1 * r1;
                float y = (py.x + py.y) + (py.z + py.w);
                y = red8(y);
                ykeep = (j == (t & 7)) ? y : ykeep;
                if ((t & 7) == 7) yb[((t & ~7) + j) * 32 + rowl] = ykeep;
                a0 = na0; a1 = na1; w0 = nw0; w1 = nw1; b0 = nb0; b1 = nb1; k0 = nk0; k1 = nk1; r0 = nr0; r1 = nr1; vv = nv;
            }
        } else {
            if (c > 0) {
                const LAS float* ybp = (const LAS float*)(lds + 2 * SC_BUF + (cur ^ 1) * SC_YB); const int t2 = st >> 3, q4 = st & 7; const f32x4 v = *(const LAS f32x4*)(ybp + t2 * 32 + 4 * q4);
                *(GAS f32x4*)(YD + ((size_t)b * SEQ + (c - 1) * SC_T + t2) * GW + 64 * h + 32 * half + 4 * q4) = v; }
            if (c + 1 < SEQ / SC_T) SC_STAGE(c + 1, cur ^ 1);
        }
        __syncthreads();
    }
    if (!scanner) { const LAS float* ybp = (const LAS float*)(lds + 2 * SC_BUF + 1 * SC_YB); const int t2 = st >> 3, q4 = st & 7; const f32x4 v = *(const LAS f32x4*)(ybp + t2 * 32 + 4 * q4);
        *(GAS f32x4*)(YD + ((size_t)b * SEQ + (SEQ / SC_T - 1) * SC_T + t2) * GW + 64 * h + 32 * half + 4 * q4) = v; }
#undef SC_STAGE
    __syncthreads();
}

struct AttnSt { f32x16 o0, o1; float m, l; };
__device__ __forceinline__ void attn_init(AttnSt& st) {
    const float z_ = zero_v();
#pragma unroll
    for (int i = 0; i < 16; ++i) { st.o0[i] = z_; st.o1[i] = z_; }
    st.m = -1e30f; st.l = 0.f;
}
__device__ __forceinline__ void attn_tile(AttnSt& st, const bf16x8 (&qf)[4], const bf16* Kcol, const bf16* Vcol, int rowb, int kb, int ks, int qpos, int maxd, bool sel, const LAS float* biasT, int r32, int hh) {
    int kp_l = kb + r32 * ks; kp_l = kp_l < 0 ? 0 : kp_l;
    const bf16* kr_ = Kcol + (size_t)(rowb + kp_l) * NPROJ_P + 8 * hh;
    bf16x8 kf[4];
#pragma unroll
    for (int s = 0; s < 4; ++s) kf[s] = *(const GAS bf16x8*)(kr_ + 16 * s);
    f32x16 sc;
#pragma unroll
    for (int i = 0; i < 16; ++i) sc[i] = 0.f;
#pragma unroll
    for (int s = 0; s < 4; ++s) sc = __builtin_amdgcn_mfma_f32_32x32x16_bf16(kf[s], qf[s], sc, 0, 0, 0);
    unsigned vf[2][2][4];
#pragma unroll
    for (int s2 = 0; s2 < 2; ++s2)
#pragma unroll
        for (int jp = 0; jp < 4; ++jp) {
            const int j0 = 2 * jp, key0 = 16 * s2 + 8 * (j0 >> 2) + 4 * hh + (j0 & 3);
            int kp0 = kb + key0 * ks, kp1 = kp0 + ks; kp0 = kp0 < 0 ? 0 : kp0; kp1 = kp1 < 0 ? 0 : kp1;
            const bf16* v0 = Vcol + (size_t)(rowb + kp0) * NPROJ_P + r32; const bf16* v1 = Vcol + (size_t)(rowb + kp1) * NPROJ_P + r32;
            vf[0][s2][jp] = (unsigned)v0[0] | ((unsigned)v1[0] << 16); vf[1][s2][jp] = (unsigned)v0[32] | ((unsigned)v1[32] << 16);
        }
    float tmax = -INFINITY;
#pragma unroll
    for (int r = 0; r < 16; ++r) {
        const int kr = (r & 3) + 8 * (r >> 2) + 4 * hh, kp = kb + kr * ks, dist = qpos - kp;
        const bool ok = sel && dist >= 0 && dist <= maxd && kp >= 0;
        const float v = sc[r] * (0.125f * LOG2E) + biasT[ok ? dist : 0];
        sc[r] = ok ? v : -INFINITY; tmax = fmaxf(tmax, sc[r]);
    }
    tmax = fmaxf(tmax, __shfl_xor(tmax, 32));
    const float mn = fmaxf(st.m, tmax), scale = __builtin_amdgcn_exp2f(st.m - mn); st.m = mn;
    float ls = 0.f;
#pragma unroll
    for (int r = 0; r < 16; ++r) { sc[r] = __builtin_amdgcn_exp2f(sc[r] - mn); ls += sc[r]; }
    st.l = st.l * scale + ls;
#pragma unroll
    for (int i = 0; i < 16; ++i) { st.o0[i] *= scale; st.o1[i] *= scale; }
    typedef unsigned u32x4_t __attribute__((ext_vector_type(4)));
#pragma unroll
    for (int s2 = 0; s2 < 2; ++s2) {
        u32x4_t pw; pw.x = pg8::cvt_pk_bf16(sc[8 * s2], sc[8 * s2 + 1]); pw.y = pg8::cvt_pk_bf16(sc[8 * s2 + 2], sc[8 * s2 + 3]); pw.z = pg8::cvt_pk_bf16(sc[8 * s2 + 4], sc[8 * s2 + 5]); pw.w = pg8::cvt_pk_bf16(sc[8 * s2 + 6], sc[8 * s2 + 7]);
        const bf16x8 pf = __builtin_bit_cast(bf16x8, pw);
        u32x4_t a0 = {vf[0][s2][0], vf[0][s2][1], vf[0][s2][2], vf[0][s2][3]}, a1 = {vf[1][s2][0], vf[1][s2][1], vf[1][s2][2], vf[1][s2][3]};
        st.o0 = __builtin_amdgcn_mfma_f32_32x32x16_bf16(__builtin_bit_cast(bf16x8, a0), pf, st.o0, 0, 0, 0);
        st.o1 = __builtin_amdgcn_mfma_f32_32x32x16_bf16(__builtin_bit_cast(bf16x8, a1), pf, st.o1, 0, 0, 0);
    }
}
__device__ __forceinline__ void attn_loadq(bf16x8 (&qf)[4], const bf16* Qcol, int row, int hh) {
    const bf16* q = Qcol + (size_t)row * NPROJ_P + 8 * hh;
#pragma unroll
    for (int s = 0; s < 4; ++s) qf[s] = *(const GAS bf16x8*)(q + 16 * s);
}
__device__ __forceinline__ void attn_store(const f32x16& o0, const f32x16& o1, float inv, bf16* yrow, int hh) {
#pragma unroll
    for (int g = 0; g < 4; ++g) {
        *(GAS v2u*)(yrow + 8 * g + 4 * hh) = (v2u){pk2(o0[4 * g] * inv, o0[4 * g + 1] * inv), pk2(o0[4 * g + 2] * inv, o0[4 * g + 3] * inv)};
        *(GAS v2u*)(yrow + 32 + 8 * g + 4 * hh) = (v2u){pk2(o1[4 * g] * inv, o1[4 * g + 1] * inv), pk2(o1[4 * g + 2] * inv, o1[4 * g + 3] * inv)};
    }
}
__device__ __forceinline__ void build_bias(LAS float* biasT, int hcol, int tid) {
    const f32x4 bv = *(const GAS f32x4*)((const float*)(wsp() + WS_SMALL + SM_BIAS) + hcol * 2048 + 4 * tid); const v4u tv = *(const GAS v4u*)((const unsigned*)(wsp() + WS_SMALL + SM_TB) + 4 * tid);
    *(LAS f32x4*)(biasT + 4 * tid) = bv; *(LAS v4u*)((LAS unsigned*)(biasT + 2048) + 4 * tid) = tv;
}

constexpr int MC_KP = 144, MC_VP = 192, MC_KB = 128 * MC_KP, MC_VB = 128 * MC_VP, MC_K_OFF = 16384, MC_V_OFF = MC_K_OFF + 2 * MC_KB, MC_LDS = MC_V_OFF + 2 * MC_VB;
typedef short v4i16_t __attribute__((ext_vector_type(4)));
__device__ __forceinline__ float pl32_max(float a) { float x = a, y = a;
    asm volatile("s_nop 1\n\tv_permlane32_swap_b32_e32 %0, %1\n\ts_nop 0" : "+v"(x), "+v"(y));
    return fmaxf(x, y); }
template <int MODE> __device__ __forceinline__ void moba_tile(AttnSt& st, const bf16x8 (&qf)[4], const LAS unsigned char* Kt, const LAS unsigned char* Vt, const LAS float* biasT, const LAS int* TB, int dlo, bool sel, int lane, int r32, int hh) {
    bf16x8 kf[4];
#pragma unroll
    for (int s = 0; s < 4; ++s) kf[s] = *(const LAS bf16x8*)(Kt + r32 * MC_KP + 32 * s + 16 * hh);
    v4i16_t vt[2][2][2];
    { const LAS unsigned char* vb = Vt + (4 * hh + ((lane & 15) >> 2)) * MC_VP + (16 * ((lane >> 4) & 1) + 4 * (lane & 3)) * 2;
#pragma unroll
      for (int dh = 0; dh < 2; ++dh)
#pragma unroll
        for (int s2 = 0; s2 < 2; ++s2)
#pragma unroll
            for (int h8 = 0; h8 < 2; ++h8) vt[dh][s2][h8] = __builtin_amdgcn_ds_read_tr16_b64_v4i16((LAS v4i16_t*)(vb + (16 * s2 + 8 * h8) * MC_VP + 64 * dh)); }
    f32x16 sc;
#pragma unroll
    for (int i = 0; i < 16; ++i) sc[i] = 0.f;
#pragma unroll
    for (int s = 0; s < 4; ++s) sc = __builtin_amdgcn_mfma_f32_32x32x16_bf16(kf[s], qf[s], sc, 0, 0, 0);
    const int d0 = dlo + r32 + 31 - 4 * hh;
    const int dmin = dlo < 0 ? 0 : dlo, dmax = dlo + 62;
    const bool uni = __builtin_amdgcn_readfirstlane(TB[dmin]) == __builtin_amdgcn_readfirstlane(TB[dmax]);
    float tmax = -INFINITY;
    if (uni) { const float bu = biasT[dmin];
#pragma unroll
        for (int r = 0; r < 16; ++r) { float v = sc[r] * (0.125f * LOG2E) + bu; if (MODE == 1) { const int dist = d0 - (r & 3) - 8 * (r >> 2); v = dist >= 0 ? v : -INFINITY; } sc[r] = v; tmax = fmaxf(tmax, v); }
    } else {
#pragma unroll
        for (int r = 0; r < 16; ++r) { const int dist = d0 - (r & 3) - 8 * (r >> 2); float v = sc[r] * (0.125f * LOG2E) + biasT[dist < 0 ? 0 : dist]; if (MODE == 1) v = dist >= 0 ? v : -INFINITY; sc[r] = v; tmax = fmaxf(tmax, v); }
    }
    if (MODE == 2) tmax = sel ? tmax : -INFINITY;
    tmax = pl32_max(tmax);
    const float mn = fmaxf(st.m, tmax);
    if (__ballot(mn > st.m) != 0ull) { const float scale = __builtin_amdgcn_exp2f(st.m - mn); st.l *= scale;
#pragma unroll
        for (int i = 0; i < 16; ++i) { st.o0[i] *= scale; st.o1[i] *= scale; } }
    st.m = mn;
    const float msub = (MODE == 2 && !sel) ? INFINITY : mn;
    float ls = 0.f;
#pragma unroll
    for (int r = 0; r < 16; ++r) { sc[r] = __builtin_amdgcn_exp2f(sc[r] - msub); ls += sc[r]; }
    st.l += ls;
    typedef unsigned u32x4_t __attribute__((ext_vector_type(4)));
#pragma unroll
    for (int s2 = 0; s2 < 2; ++s2) {
        u32x4_t pw; pw.x = pg8::cvt_pk_bf16(sc[8 * s2], sc[8 * s2 + 1]); pw.y = pg8::cvt_pk_bf16(sc[8 * s2 + 2], sc[8 * s2 + 3]); pw.z = pg8::cvt_pk_bf16(sc[8 * s2 + 4], sc[8 * s2 + 5]); pw.w = pg8::cvt_pk_bf16(sc[8 * s2 + 6], sc[8 * s2 + 7]);
        const bf16x8 pf = __builtin_bit_cast(bf16x8, pw);
        const bf16x8 a0 = {vt[0][s2][0][0], vt[0][s2][0][1], vt[0][s2][0][2], vt[0][s2][0][3], vt[0][s2][1][0], vt[0][s2][1][1], vt[0][s2][1][2], vt[0][s2][1][3]};
        const bf16x8 a1 = {vt[1][s2][0][0], vt[1][s2][0][1], vt[1][s2][0][2], vt[1][s2][0][3], vt[1][s2][1][0], vt[1][s2][1][1], vt[1][s2][1][2], vt[1][s2][1][3]};
        st.o0 = __builtin_amdgcn_mfma_f32_32x32x16_bf16(a0, pf, st.o0, 0, 0, 0);
        st.o1 = __builtin_amdgcn_mfma_f32_32x32x16_bf16(a1, pf, st.o1, 0, 0, 0);
    }
}
__device__ __forceinline__ void moba_unit(LAS unsigned char* lds, int unit, int tid, int l) {
    const int ob = unit & 7, h = (unit >> 3) & 7, b = unit >> 6, lane = tid & 63, wave = __builtin_amdgcn_readfirstlane(tid >> 6), r32 = lane & 31, hh = lane >> 5;
    LAS float* biasT = (LAS float*)lds;
    build_bias(biasT, 8 + h, tid);
    const bf16* PROJ = (const bf16*)(wsp() + WS_PROJ); const float* KBAR = (const float*)(wsp() + CTL_KBAR) + (size_t)l * 64 * 8 * 64 + ((b * NH + h) * 8) * 64; const LAS int* TB = (const LAS int*)(biasT + 2048);
    const int rowb = b * SEQ, qpos = 256 * ob + 32 * wave + r32;
    bf16x8 qf[4]; attn_loadq(qf, PROJ + CC_Q + 64 * h, rowb + qpos, hh);
    float gate[8];
#pragma unroll
    for (int n = 0; n < 8; ++n) { float s = 0.f;
        if (n < ob) {
#pragma unroll
            for (int s4 = 0; s4 < 4; ++s4) { const f32x4 k0 = *(const GAS f32x4*)(KBAR + n * 64 + 16 * s4 + 8 * hh), k1 = *(const GAS f32x4*)(KBAR + n * 64 + 16 * s4 + 8 * hh + 4);
                const v4u qw = __builtin_bit_cast(v4u, qf[s4]);
                s += bflo(qw.x) * k0.x + bfhi(qw.x) * k0.y + bflo(qw.y) * k0.z + bfhi(qw.y) * k0.w + bflo(qw.z) * k1.x + bfhi(qw.z) * k1.y + bflo(qw.w) * k1.z + bfhi(qw.w) * k1.w; }
            s += __shfl_xor(s, 32); }
        gate[n] = s; }
    unsigned selm = 0u;
#pragma unroll
    for (int n = 0; n < 8; ++n) { int rank = 0;
#pragma unroll
        for (int n2 = 0; n2 < 8; ++n2) rank += (n2 < ob && n2 != n && (gate[n2] > gate[n] || (gate[n2] == gate[n] && n2 < n))) ? 1 : 0;
        if (n < ob && rank < 3) selm |= 1u << n; }
    AttnSt st; attn_init(st);
    const int skey = tid >> 2, spart = tid & 3;
    const bf16* Kg = PROJ + (size_t)rowb * NPROJ_P + CC_K + 64 * h + 16 * spart; const bf16* Vg = PROJ + (size_t)rowb * NPROJ_P + CC_V + 64 * h + 16 * spart;
    bf16x8 gk0, gk1, gv0, gv1;
#define MC_GLOAD(i) do { const size_t ro_ = (size_t)(128 * (i) + skey) * NPROJ_P; gk0 = *(const GAS bf16x8*)(Kg + ro_); gk1 = *(const GAS bf16x8*)(Kg + ro_ + 8); gv0 = *(const GAS bf16x8*)(Vg + ro_); gv1 = *(const GAS bf16x8*)(Vg + ro_ + 8); } while (0)
#define MC_LSTORE(bf) do { LAS unsigned char* kd_ = lds + MC_K_OFF + (bf) * MC_KB + skey * MC_KP + 32 * spart; *(LAS bf16x8*)(kd_) = gk0; *(LAS bf16x8*)(kd_ + 16) = gk1; \
        LAS unsigned char* vd_ = lds + MC_V_OFF + (bf) * MC_VB + skey * MC_VP + 32 * spart; *(LAS bf16x8*)(vd_) = gv0; *(LAS bf16x8*)(vd_ + 16) = gv1; } while (0)
    const int nst = 2 * (ob + 1);
    MC_GLOAD(0); MC_LSTORE(0);
    __syncthreads();
    for (int i = 0; i < nst; ++i) {
        if (i + 1 < nst) MC_GLOAD(i + 1);
        const int n = i >> 1, hf = i & 1; const bool own = n == ob, sel = own || ((selm >> n) & 1u);
        const LAS unsigned char* Kb = lds + MC_K_OFF + (i & 1) * MC_KB; const LAS unsigned char* Vb = lds + MC_V_OFF + (i & 1) * MC_VB;
        if (own) {
#pragma unroll 1
            for (int sub = 0; sub < 4; ++sub) { const int jt = 4 * hf + sub; if (jt > wave) break; const int dlo = 32 * wave - (32 * jt + 31);
                if (jt == wave) moba_tile<1>(st, qf, Kb + sub * 32 * MC_KP, Vb + sub * 32 * MC_VP, biasT, TB, dlo, true, lane, r32, hh);
                else moba_tile<0>(st, qf, Kb + sub * 32 * MC_KP, Vb + sub * 32 * MC_VP, biasT, TB, dlo, true, lane, r32, hh); }
        } else if (__ballot(sel) != 0ull) {
#pragma unroll 1
            for (int sub = 0; sub < 4; ++sub) { const int dlo = 256 * ob + 32 * wave - (256 * n + 128 * hf + 32 * sub + 31);
                moba_tile<2>(st, qf, Kb + sub * 32 * MC_KP, Vb + sub * 32 * MC_VP, biasT, TB, dlo, sel, lane, r32, hh); }
        }
        if (i + 1 < nst) MC_LSTORE((i + 1) & 1);
        __syncthreads();
    }
#undef MC_GLOAD
#undef MC_LSTORE
    const float lt = st.l + __shfl_xor(st.l, 32);
    attn_store(st.o0, st.o1, 1.0f / lt, (bf16*)(wsp() + WS_YCAT) + (size_t)(rowb + qpos) * DM + 2 * GW + 64 * h, hh);
}

constexpr int MA_PITCH = 144, MA_ML_OFF = 512 * MA_PITCH, MA_BIAS_OFF = MA_ML_OFF + 512 * 8, MA_V_OFF = MA_BIAS_OFF + 16384, MA_VW = 32 * MC_VP, MA_LDS = MA_V_OFF + 8 * MA_VW;
template <bool MASKED> __device__ __forceinline__ void dil_tile(AttnSt& st, const bf16x8 (&qf)[4], const bf16x8 (&kf)[4], const LAS unsigned char* Vt, const LAS float* biasT, const LAS int* TB, int dl0, int dstep, int kb, int lane, int r32, int hh) {
    v4i16_t vt[2][2][2];
    { const LAS unsigned char* vb = Vt + (4 * hh + ((lane & 15) >> 2)) * MC_VP + (16 * ((lane >> 4) & 1) + 4 * (lane & 3)) * 2;
#pragma unroll
      for (int dh = 0; dh < 2; ++dh)
#pragma unroll
        for (int s2 = 0; s2 < 2; ++s2)
#pragma unroll
            for (int h8 = 0; h8 < 2; ++h8) vt[dh][s2][h8] = __builtin_amdgcn_ds_read_tr16_b64_v4i16((LAS v4i16_t*)(vb + (16 * s2 + 8 * h8) * MC_VP + 64 * dh)); }
    f32x16 sc;
#pragma unroll
    for (int i = 0; i < 16; ++i) sc[i] = 0.f;
#pragma unroll
    for (int s = 0; s < 4; ++s) sc = __builtin_amdgcn_mfma_f32_32x32x16_bf16(kf[s], qf[s], sc, 0, 0, 0);
    const int e0 = dl0 + r32 - 4 * hh;
    int dmin = (dl0 - 31) * dstep, dmax = (dl0 + 31) * dstep; dmin = dmin < 0 ? 0 : dmin; dmax = dmax > 2047 ? 2047 : dmax;
    const bool uni = __builtin_amdgcn_readfirstlane(TB[dmin]) == __builtin_amdgcn_readfirstlane(TB[dmax]);
    const float bu = biasT[dmin];
    float tmax = -INFINITY;
#pragma unroll
    for (int r = 0; r < 16; ++r) {
        const int kr0 = (r & 3) + 8 * (r >> 2), delta = e0 - kr0;
        float bias = bu;
        if (!uni) { int di = delta * dstep; di = di < 0 ? 0 : (di > 2047 ? 2047 : di); bias = biasT[di]; }
        float v = sc[r] * (0.125f * LOG2E) + bias;
        if (MASKED) { const bool ok = delta >= 0 && delta <= 128 && (kb + (kr0 + 4 * hh) * dstep) >= 0; v = ok ? v : -INFINITY; }
        sc[r] = v; tmax = fmaxf(tmax, v);
    }
    tmax = pl32_max(tmax);
    const float mn = fmaxf(st.m, tmax);
    if (__ballot(mn > st.m) != 0ull) { const float scale = __builtin_amdgcn_exp2f(st.m - mn); st.l *= scale;
#pragma unroll
        for (int i = 0; i < 16; ++i) { st.o0[i] *= scale; st.o1[i] *= scale; } }
    st.m = mn;
    float ls = 0.f;
#pragma unroll
    for (int r = 0; r < 16; ++r) { sc[r] = __builtin_amdgcn_exp2f(sc[r] - mn); ls += sc[r]; }
    st.l += ls;
    typedef unsigned u32x4_t __attribute__((ext_vector_type(4)));
#pragma unroll
    for (int s2 = 0; s2 < 2; ++s2) {
        u32x4_t pw; pw.x = pg8::cvt_pk_bf16(sc[8 * s2], sc[8 * s2 + 1]); pw.y = pg8::cvt_pk_bf16(sc[8 * s2 + 2], sc[8 * s2 + 3]); pw.z = pg8::cvt_pk_bf16(sc[8 * s2 + 4], sc[8 * s2 + 5]); pw.w = pg8::cvt_pk_bf16(sc[8 * s2 + 6], sc[8 * s2 + 7]);
        const bf16x8 pf = __builtin_bit_cast(bf16x8, pw);
        const bf16x8 a0 = {vt[0][s2][0][0], vt[0][s2][0][1], vt[0][s2][0][2], vt[0][s2][0][3], vt[0][s2][1][0], vt[0][s2][1][1], vt[0][s2][1][2], vt[0][s2][1][3]};
        const bf16x8 a1 = {vt[1][s2][0][0], vt[1][s2][0][1], vt[1][s2][0][2], vt[1][s2][0][3], vt[1][s2][1][0], vt[1][s2][1][1], vt[1][s2][1][2], vt[1][s2][1][3]};
        st.o0 = __builtin_amdgcn_mfma_f32_32x32x16_bf16(a0, pf, st.o0, 0, 0, 0);
        st.o1 = __builtin_amdgcn_mfma_f32_32x32x16_bf16(a1, pf, st.o1, 0, 0, 0);
    }
}
__device__ __forceinline__ void dil_unit(LAS unsigned char* lds, int unit, int tid) {
    const int sp = unit & 3, h = (unit >> 2) & 7, b = unit >> 5, lane = tid & 63, wave = __builtin_amdgcn_readfirstlane(tid >> 6), r32 = lane & 31, hh = lane >> 5;
    LAS float* biasT = (LAS float*)(lds + MA_BIAS_OFF);
    build_bias(biasT, h, tid);
    __syncthreads();
    const bf16* PROJ = (const bf16*)(wsp() + WS_PROJ); const LAS int* TB = (const LAS int*)(biasT + 2048); const int rowb = b * SEQ, t0 = 512 * sp;
    const bf16* Qc = PROJ + CA_Q + 64 * h; const bf16* Kc = PROJ + CA_K + 64 * h; const bf16* Vc = PROJ + CA_V + 64 * h;
    LAS unsigned char* Vst = lds + MA_V_OFF + wave * MA_VW;
    const int vkey = lane >> 1, vhalf = lane & 1;
#pragma unroll 1
    for (int p = 0; p < 3; ++p) {
        const int d = p == 0 ? 1 : (p == 1 ? 4 : 16);
#pragma unroll 1
        for (int gi = 0; gi < 2; ++gi) {
            const int g = 2 * wave + gi;
            const int qb = t0 + (p == 0 ? 32 * g : (p == 1 ? 128 * (g >> 2) + (g & 3) : g));
            const int qpos = qb + r32 * d, qi = qpos - t0;
            bf16x8 qf[4]; attn_loadq(qf, Qc, rowb + qpos, hh);
            AttnSt st; attn_init(st);
            int jt = 0; while (qb + (32 * jt - 128 + 31) * d < 0) ++jt;
            bf16x8 kfn[4], vrn[4];
#define MA_GLOAD(JT) do { const int kb_ = qb + (32 * (JT) - 128) * d; int kp_ = kb_ + r32 * d; kp_ = kp_ < 0 ? 0 : kp_; const bf16* kr_ = Kc + (size_t)(rowb + kp_) * NPROJ_P + 8 * hh; \
                _Pragma("unroll") for (int s = 0; s < 4; ++s) kfn[s] = *(const GAS bf16x8*)(kr_ + 16 * s); \
                int vp_ = kb_ + vkey * d; vp_ = vp_ < 0 ? 0 : vp_; const bf16* vr_ = Vc + (size_t)(rowb + vp_) * NPROJ_P + 32 * vhalf; \
                _Pragma("unroll") for (int s = 0; s < 4; ++s) vrn[s] = *(const GAS bf16x8*)(vr_ + 8 * s); } while (0)
            MA_GLOAD(jt);
#pragma unroll 1
            for (; jt < 5; ++jt) {
                bf16x8 kf[4] = {kfn[0], kfn[1], kfn[2], kfn[3]};
                { LAS unsigned char* vd = Vst + vkey * MC_VP + 64 * vhalf;
#pragma unroll
                  for (int s = 0; s < 4; ++s) *(LAS bf16x8*)(vd + 16 * s) = vrn[s]; }
                asm volatile("" ::: "memory");
                if (jt + 1 < 5) MA_GLOAD(jt + 1);
                const int kb = qb + (32 * jt - 128) * d, dl0 = 128 - 32 * jt;
                if (jt == 0 || jt == 4 || kb < 0) dil_tile<true>(st, qf, kf, Vst, biasT, TB, dl0, d, kb, lane, r32, hh);
                else dil_tile<false>(st, qf, kf, Vst, biasT, TB, dl0, d, kb, lane, r32, hh);
            }
#undef MA_GLOAD
            float lt = st.l + __shfl_xor(st.l, 32);
            LAS unsigned char* orow = lds + qi * MA_PITCH; LAS float* ml = (LAS float*)(lds + MA_ML_OFF + qi * 8);
            if (p > 0) {
                const float mo = ml[0], lo = ml[1], mn = fmaxf(mo, st.m), fo = __builtin_amdgcn_exp2f(mo - mn), fc = __builtin_amdgcn_exp2f(st.m - mn);
                lt = lo * fo + lt * fc;
#pragma unroll
                for (int g4 = 0; g4 < 4; ++g4) { const v2u a = *(const LAS v2u*)(orow + 2 * (8 * g4 + 4 * hh)), c = *(const LAS v2u*)(orow + 64 + 2 * (8 * g4 + 4 * hh));
                    const float av[4] = {bflo(a.x), bfhi(a.x), bflo(a.y), bfhi(a.y)}, cv[4] = {bflo(c.x), bfhi(c.x), bflo(c.y), bfhi(c.y)};
#pragma unroll
                    for (int e = 0; e < 4; ++e) { st.o0[4 * g4 + e] = av[e] * fo + st.o0[4 * g4 + e] * fc; st.o1[4 * g4 + e] = cv[e] * fo + st.o1[4 * g4 + e] * fc; } }
                st.m = mn;
            }
            if (p < 2) {
#pragma unroll
                for (int g4 = 0; g4 < 4; ++g4) { *(LAS v2u*)(orow + 2 * (8 * g4 + 4 * hh)) = (v2u){pk2(st.o0[4 * g4], st.o0[4 * g4 + 1]), pk2(st.o0[4 * g4 + 2], st.o0[4 * g4 + 3])};
                    *(LAS v2u*)(orow + 64 + 2 * (8 * g4 + 4 * hh)) = (v2u){pk2(st.o1[4 * g4], st.o1[4 * g4 + 1]), pk2(st.o1[4 * g4 + 2], st.o1[4 * g4 + 3])}; }
                if (hh == 0) { ml[0] = st.m; ml[1] = lt; }
            } else attn_store(st.o0, st.o1, 1.0f / lt, (bf16*)(wsp() + WS_YCAT) + (size_t)(rowb + qpos) * DM + 0 * GW + 64 * h, hh);
        }
        __syncthreads();
    }
}

constexpr int SG_PITCH = 144, SG_WAVE = 128 * SG_PITCH, SG_OP = 272;
static_assert(8 * SG_WAVE <= MISC_OFF && 32 * SG_OP <= SG_WAVE, "SGU LDS");
__device__ __forceinline__ void sgu_unit(LAS unsigned char* lds, int unit, int tid, int l) {
    const int lane = tid & 63, g = __builtin_amdgcn_readfirstlane(tid >> 6), r32 = lane & 31, hh = lane >> 5, m0 = unit * 128;
    const bf16* PROJ = (const bf16*)(wsp() + WS_PROJ); bf16* YC = (bf16*)(wsp() + WS_YCAT); const pg8::fx_t* ST = (const pg8::fx_t*)(wsp() + CTL_STATS) + (size_t)l * M * 2;
    const float* lng = inp(4) + l * GW; const float* sw = inp(5) + ((size_t)l * NH + g) * 128 * 128; const float* sb = inp(6) + (l * NH + g) * 128;
    LAS unsigned char* T = lds + g * SG_WAVE;
    const int tk8 = lane >> 3, part = lane & 7;
    { const f32x4 g0 = *(const GAS f32x4*)(lng + 64 * g + 8 * part), g1 = *(const GAS f32x4*)(lng + 64 * g + 8 * part + 4);
      const float gn[8] = {g0.x, g0.y, g0.z, g0.w, g1.x, g1.y, g1.z, g1.w};
#pragma unroll 4
      for (int i = 0; i < 16; ++i) { const int tkn = tk8 + 8 * i, mm = m0 + tkn;
          const v4u w = *(const GAS v4u*)(PROJ + (size_t)mm * NPROJ_P + CB_V + 64 * g + 8 * part);
          const float mu = pg8::fx_get(ST + 2 * mm) * (1.0f / 512.0f), rs = __builtin_amdgcn_rsqf(fmaxf(pg8::fx_get(ST + 2 * mm + 1) * (1.0f / 512.0f) - mu * mu, 0.f) + 1e-5f);
          float x[8] = {bflo(w.x), bfhi(w.x), bflo(w.y), bfhi(w.y), bflo(w.z), bfhi(w.z), bflo(w.w), bfhi(w.w)};
#pragma unroll
          for (int e = 0; e < 8; ++e) x[e] = (gelu_tanh(x[e]) - mu) * rs * gn[e];
          *(LAS v4u*)(T + tkn * SG_PITCH + 16 * part) = (v4u){pk2(x[0], x[1]), pk2(x[2], x[3]), pk2(x[4], x[5]), pk2(x[6], x[7])}; } }
    asm volatile("" ::: "memory");
    f32x16 acc[4][2];
    const float z_ = zero_v();
#pragma unroll
    for (int tt = 0; tt < 4; ++tt)
#pragma unroll
        for (int ct = 0; ct < 2; ++ct)
#pragma unroll
            for (int i = 0; i < 16; ++i) acc[tt][ct][i] = z_;
    const LAS unsigned char* vb = T + (8 * hh + ((lane & 15) >> 2)) * SG_PITCH + (16 * ((lane >> 4) & 1) + 4 * (lane & 3)) * 2;
#pragma unroll
    for (int k = 0; k < 8; ++k) {
        v4i16_t t00 = __builtin_amdgcn_ds_read_tr16_b64_v4i16((LAS v4i16_t*)(vb + (16 * k) * SG_PITCH)), t01 = __builtin_amdgcn_ds_read_tr16_b64_v4i16((LAS v4i16_t*)(vb + (16 * k + 4) * SG_PITCH));
        v4i16_t t10 = __builtin_amdgcn_ds_read_tr16_b64_v4i16((LAS v4i16_t*)(vb + (16 * k) * SG_PITCH + 64)), t11 = __builtin_amdgcn_ds_read_tr16_b64_v4i16((LAS v4i16_t*)(vb + (16 * k + 4) * SG_PITCH + 64));
        const bf16x8 af0 = {t00[0], t00[1], t00[2], t00[3], t01[0], t01[1], t01[2], t01[3]}, af1 = {t10[0], t10[1], t10[2], t10[3], t11[0], t11[1], t11[2], t11[3]};
#pragma unroll
        for (int tt = 0; tt < 4; ++tt) { if (k < 2 * (tt + 1)) {
                const int t = 32 * tt + r32, s0 = 16 * k + 8 * hh; const float* wrow = sw + (size_t)t * 128 + s0;
                const f32x4 w0 = *(const GAS f32x4*)(wrow), w1 = *(const GAS f32x4*)(wrow + 4);
                float wv[8] = {w0.x, w0.y, w0.z, w0.w, w1.x, w1.y, w1.z, w1.w};
#pragma unroll
                for (int j = 0; j < 8; ++j) wv[j] = (s0 + j <= t) ? wv[j] : 0.f;
                const v4u bw = {pk2(wv[0], wv[1]), pk2(wv[2], wv[3]), pk2(wv[4], wv[5]), pk2(wv[6], wv[7])}; const bf16x8 bfr = __builtin_bit_cast(bf16x8, bw);
                acc[tt][0] = __builtin_amdgcn_mfma_f32_32x32x16_bf16(af0, bfr, acc[tt][0], 0, 0, 0); acc[tt][1] = __builtin_amdgcn_mfma_f32_32x32x16_bf16(af1, bfr, acc[tt][1], 0, 0, 0); } }
    }
    asm volatile("" ::: "memory");
#pragma unroll
    for (int tt = 0; tt < 4; ++tt) {
        const float bias = sb[32 * tt + r32];
#pragma unroll
        for (int ct = 0; ct < 2; ++ct)
#pragma unroll
            for (int g4 = 0; g4 < 4; ++g4) { const f32x16& a = acc[tt][ct];
                *(LAS f32x4*)(T + r32 * SG_OP + 4 * (32 * ct + 8 * g4 + 4 * hh)) = (f32x4){a[4 * g4] + bias, a[4 * g4 + 1] + bias, a[4 * g4 + 2] + bias, a[4 * g4 + 3] + bias}; }
        asm volatile("" ::: "memory");
#pragma unroll
        for (int i = 0; i < 4; ++i) { const int tkn = tk8 + 8 * i, mm = m0 + 32 * tt + tkn;
            const v4u uw = *(const GAS v4u*)(PROJ + (size_t)mm * NPROJ_P + CB_U + 64 * g + 8 * part);
            const f32x4 x0 = *(const LAS f32x4*)(T + tkn * SG_OP + 32 * part), x1 = *(const LAS f32x4*)(T + tkn * SG_OP + 32 * part + 16);
            const float u[8] = {bflo(uw.x), bfhi(uw.x), bflo(uw.y), bfhi(uw.y), bflo(uw.z), bfhi(uw.z), bflo(uw.w), bfhi(uw.w)};
            *(GAS v4u*)(YC + (size_t)mm * DM + GW + 64 * g + 8 * part) = (v4u){pk2(gelu_tanh(u[0]) * x0.x, gelu_tanh(u[1]) * x0.y), pk2(gelu_tanh(u[2]) * x0.z, gelu_tanh(u[3]) * x0.w), pk2(gelu_tanh(u[4]) * x1.x, gelu_tanh(u[5]) * x1.y), pk2(gelu_tanh(u[6]) * x1.z, gelu_tanh(u[7]) * x1.w)}; }
        asm volatile("" ::: "memory");
    }
}

#ifndef SIMPLE_A
#define SIMPLE_A 0
#endif
#ifndef SIMPLE_B
#define SIMPLE_B 0
#endif
#ifndef SIMPLE_C
#define SIMPLE_C 0
#endif
#ifndef SIMPLE_D
#define SIMPLE_D 0
#endif
__device__ __forceinline__ void ph_mixers(LAS unsigned char* L, int l, int phase, int qoff, int wv, int mask = 31) {
    Frame F = mkframe(L, wv);
    volatile LAS int* qslot = (volatile LAS int*)(L + MISC_OFF + 64);
    gu32* ctr = ctlp() + CW_Q + 64 * phase + qoff;
    constexpr int I_IN = (DM / 64) * (NPROJ / 32), I_REST = (I8_OUT ? 0 : (DM / 64) * (DM / 32)) + (FFN1_I8 ? 0 : 2 * (DM / 64) * (DFF / 32)) + (DFF / 64) * (DM / 32);
    const int n_scan = (SIMPLE_D || !(mask & 1)) ? 0 : 128, n_c = (SIMPLE_C || !(mask & 2)) ? 0 : 512, n_a = (SIMPLE_A || !(mask & 4)) ? 0 : 256, n_b = (SIMPLE_B || !(mask & 8)) ? 0 : 128;
    const int n_cin = ((l + 1 < DEPTH) && (mask & 16)) ? (I8_IN ? NPROJ / 32 + (WINB_ITEMS + 7) / 8 : (I_IN + 7) / 8) : 0, n_crest = (mask & 16) ? (I_REST + 7) / 8 : 0, n_cout = ((I8_OUT && (mask & 16)) ? DM / 32 : 0) + ((FFN1_I8 && (mask & 16)) ? 2 * (DFF / 32) : 0);
    const int e_scan = n_scan, e_a = e_scan + n_a, e_b = e_a + n_b, e_c = e_b + n_c, e_cout = e_c + n_cout, e_cin = e_cout + n_cin, e_crest = e_cin + n_crest;
    for (;;) {
        if (F.tid == 0) *qslot = (int)__hip_atomic_fetch_add(ctr, 1u, RLX_AGENT);
        __syncthreads();
        const int it = __builtin_amdgcn_readfirstlane(*qslot);
        __syncthreads();
        if (it >= e_crest) break;
        int tid = wv * 64 + pg8::lane_now(); asm volatile("" : "+v"(tid));
        if (it < e_scan) scan_unit(L, it, tid);
        else if (it < e_a) dil_unit(L, it - e_scan, tid);
        else if (it < e_b) { sgu_unit(L, it - e_a, tid, l); __syncthreads(); }
        else if (it < e_c) { const int i2 = it - e_b; moba_unit(L, (i2 & 63) * 8 + (7 - (i2 >> 6)), tid, l); }
        else if (it < e_cout) { Frame F2 = mkframe(L, wv); int r = it - e_c;
            if (I8_OUT && r < DM / 32) conv_cols_i8(inp(19) + (size_t)l * DM * DM, DM, DM, inp(18) + l * DM, wsp() + WS_WOUT, (float*)(wsp() + WS_SMALL + SM_SWOUT), r, F2);
            else { r -= I8_OUT ? DM / 32 : 0; const int up = r >= DFF / 32 ? 1 : 0, nb = r - up * (DFF / 32), n0 = 32 * nb;
                conv_cols_i8(inp(up ? 22 : 21) + (size_t)l * DM * DFF, DM, DFF, inp(20) + l * DM, wsp() + WS_WGU, (float*)(wsp() + WS_SMALL + SM_SWGU), nb, F2, (n0 >> 7) * 256 + up * 128 + (n0 & 127)); } }
        else if (it < e_cin) { Frame F2 = mkframe(L, wv);
            if (I8_IN) { if (it - e_cout < NPROJ / 32) conv_cols_i8(inp(2) + (size_t)(l + 1) * DM * NPROJ, DM, NPROJ, inp(1) + (l + 1) * DM, wsp() + WS_WIN, (float*)(wsp() + WS_SMALL + SM_SWIN), it - e_cout, F2);
                else conv_winb(F2, l + 1, (it - e_cout - NPROJ / 32) * 8 + F2.wave); }
            else conv_layer_items(F2, l + 1, (it - e_cout) * 8 + F2.wave, 1 << 30, true, false); }
        else { Frame F2 = mkframe(L, wv); conv_layer_items(F2, l, (it - e_cin) * 8 + F2.wave, 1 << 30, false, true); }
    }
    if (!I8_IN && l + 1 < DEPTH) {
        bf16* WIN = (bf16*)(wsp() + WS_WIN);
        Frame F3 = mkframe(L, wv);
        for (int i = F3.gw * 64 + F3.lane; i < 64 * DM / 8; i += F3.ngw * 64) { v4u z = {0u, 0u, 0u, 0u}; asm volatile("" : "+v"(z)); *(GAS v4u*)(WIN + (size_t)NPROJ * DM + (size_t)i * 8) = z; }
    }
    if (SIMPLE_D) mix_d_simple(F);
    if (SIMPLE_A) mix_a_simple(F);
    if (SIMPLE_C) mix_c_simple(F, l);
    if (SIMPLE_B) mix_b_simple(F, l);
}

__device__ __forceinline__ void ph_finalize(Frame& F, int l) {
    bf16* YC = (bf16*)(wsp() + WS_YCAT); const float* YD = (const float*)(wsp() + WS_YD); const bf16* V_ = (const bf16*)outp() + (size_t)3 * M * GW; const bf16* G_ = (const bf16*)(wsp() + WS_G); const float* BC = (const float*)(wsp() + WS_BC);
    const float* lng = inp(16) + l * GW; const float* lnb = inp(17) + l * GW;
    for (int m = F.gw; m < M; m += F.ngw) {
        const int c0 = 8 * F.lane, hd = F.lane >> 3;
        float y[8];
        { const GAS f32x4* yp = (const GAS f32x4*)(YD + (size_t)m * GW + c0); const f32x4 a = yp[0], b = yp[1]; y[0] = a.x; y[1] = a.y; y[2] = a.z; y[3] = a.w; y[4] = b.x; y[5] = b.y; y[6] = b.z; y[7] = b.w; }
        float s = 0.f;
#pragma unroll
        for (int i = 0; i < 8; ++i) s += y[i];
        s += __shfl_xor(s, 1); s += __shfl_xor(s, 2); s += __shfl_xor(s, 4); const float mean = s * (1.0f / 64.0f); float q = 0.f;
#pragma unroll
        for (int i = 0; i < 8; ++i) { const float d = y[i] - mean; q += d * d; }
        q += __shfl_xor(q, 1); q += __shfl_xor(q, 2); q += __shfl_xor(q, 4); const float rstd = 1.0f / sqrtf(q * (1.0f / 64.0f) + 64e-5f);
        const v4u vw = *(const GAS v4u*)(V_ + (size_t)m * GW + c0), gw4 = *(const GAS v4u*)(G_ + (size_t)m * GW + c0); const float bc = BC[(size_t)m * NH + hd];
        float vv[8], gg[8]; UNPACK8(vv, 0, vw); UNPACK8(gg, 0, gw4);
        float ss = 0.f;
#pragma unroll
        for (int i = 0; i < 8; ++i) { y[i] = ((y[i] - mean) * rstd * lng[c0 + i] + lnb[c0 + i] + bc * vv[i]) * gg[i]; ss += y[i] * y[i]; }
        if (I8_OUT) {
            float xn[3][8], mx = 0.f;
            { const float rs = 1.0f / sqrtf(wave_sum(ss) * (1.0f / 512.0f) + NORM_EPS);
#pragma unroll
              for (int i = 0; i < 8; ++i) { y[i] *= rs; mx = fmaxf(mx, fabsf(y[i])); } }
#pragma unroll
            for (int br = 0; br < 3; ++br) {
                const v4u w = *(const GAS v4u*)(YC + (size_t)m * DM + br * GW + c0); UNPACK8(xn[br], 0, w); float s2 = 0.f;
#pragma unroll
                for (int i = 0; i < 8; ++i) s2 += xn[br][i] * xn[br][i];
                const float rs = 1.0f / sqrtf(wave_sum(s2) * (1.0f / 512.0f) + NORM_EPS);
#pragma unroll
                for (int i = 0; i < 8; ++i) { xn[br][i] *= rs; mx = fmaxf(mx, fabsf(xn[br][i])); }
            }
            mx = wave_max(mx); const float inv = mx > 0.f ? 127.0f / mx : 0.f; unsigned char* yq = wsp() + WS_YQ + (size_t)m * DM + c0;
#pragma unroll
            for (int br = 0; br < 3; ++br) *(GAS v2u*)(yq + br * GW) = (v2u){q8pack4(xn[br][0], xn[br][1], xn[br][2], xn[br][3], inv), q8pack4(xn[br][4], xn[br][5], xn[br][6], xn[br][7], inv)};
            *(GAS v2u*)(yq + 3 * GW) = (v2u){q8pack4(y[0], y[1], y[2], y[3], inv), q8pack4(y[4], y[5], y[6], y[7], inv)};
            if (F.lane == 0) ((float*)(wsp() + WS_SMALL + SM_SAY))[m] = mx * (1.0f / 127.0f);
            continue;
        }
        { const float rs = 1.0f / sqrtf(wave_sum(ss) * (1.0f / 512.0f) + NORM_EPS);
          *(GAS v4u*)(YC + (size_t)m * DM + 3 * GW + c0) = (v4u){pk2(y[0] * rs, y[1] * rs), pk2(y[2] * rs, y[3] * rs), pk2(y[4] * rs, y[5] * rs), pk2(y[6] * rs, y[7] * rs)}; }
#pragma unroll
        for (int br = 0; br < 3; ++br) {
            GAS v4u* p = (GAS v4u*)(YC + (size_t)m * DM + br * GW + c0); const v4u w = *p;
            float x[8]; UNPACK8(x, 0, w); float s2 = 0.f;
#pragma unroll
            for (int i = 0; i < 8; ++i) s2 += x[i] * x[i];
            const float rs = 1.0f / sqrtf(wave_sum(s2) * (1.0f / 512.0f) + NORM_EPS);
            *p = (v4u){pk2(x[0] * rs, x[1] * rs), pk2(x[2] * rs, x[3] * rs), pk2(x[4] * rs, x[5] * rs), pk2(x[6] * rs, x[7] * rs)};
        }
    }
}
__device__ __forceinline__ void ph_final(Frame& F) {
    const pg8::fx_t* ssq = (const pg8::fx_t*)(ctlp() + CW_SSQ) + 4 * M; const float* g = inp(24); float* out = outp(); const bf16* XB = (const bf16*)(wsp() + WS_XB);
    for (int m = F.gw; m < M; m += F.ngw) {
        GAS f32x4* orow = (GAS f32x4*)(out + (size_t)m * DM); const GAS v4u* xr = (const GAS v4u*)(XB + (size_t)m * DM) + F.lane; const GAS f32x4* gp = (const GAS f32x4*)g;
        v4u wv4[4];
#pragma unroll
        for (int j = 0; j < 4; ++j) wv4[j] = xr[64 * j];
        float ssv;
        if (I8_IN) { float sq = 0.f;
#pragma unroll
            for (int j = 0; j < 4; ++j) { const float e8[8] = {bflo(wv4[j].x), bfhi(wv4[j].x), bflo(wv4[j].y), bfhi(wv4[j].y), bflo(wv4[j].z), bfhi(wv4[j].z), bflo(wv4[j].w), bfhi(wv4[j].w)};
#pragma unroll
                for (int e = 0; e < 8; ++e) sq += e8[e] * e8[e]; }
            ssv = wave_sum(sq); }
        else ssv = pg8::fx_get(ssq + m);
        const float rs = 1.0f / sqrtf(ssv * (1.0f / 2048.0f) + NORM_EPS);
#pragma unroll
        for (int j = 0; j < 4; ++j) { const v4u w = wv4[j]; const int c4 = 2 * (F.lane + 64 * j); const f32x4 g0 = gp[c4], g1 = gp[c4 + 1];
            orow[c4] = (f32x4){bflo(w.x) * rs * g0.x, bfhi(w.x) * rs * g0.y, bflo(w.y) * rs * g0.z, bfhi(w.y) * rs * g0.w};
            orow[c4 + 1] = (f32x4){bflo(w.z) * rs * g1.x, bfhi(w.z) * rs * g1.y, bflo(w.w) * rs * g1.z, bfhi(w.w) * rs * g1.w}; }
    }
}

#ifndef STAG
#define STAG 500
#endif
__device__ __forceinline__ void phase_stagger(int ticks) {
    const int grp = ((int)blockIdx.x >> 3) & 3;
    if (ticks > 0 && grp > 0) { const unsigned long long t0 = __builtin_amdgcn_s_memrealtime(); while ((long long)(__builtin_amdgcn_s_memrealtime() - t0) < (long long)grp * ticks) __builtin_amdgcn_s_sleep(32); }
}
__global__ void __launch_bounds__(NTHR, 2) hy_fwd(Args args) {
    extern __shared__ __attribute__((aligned(16))) unsigned char lds[];
    LAS unsigned char* L = (LAS unsigned char*)lds;
    volatile LAS unsigned* MISC = (volatile LAS unsigned*)(L + MISC_OFF);
    const int wv = __builtin_amdgcn_readfirstlane((int)threadIdx.x >> 6);
    if (wv == 0) MISC[pg8::lane_now()] = 0u;
    __syncthreads();
    XcdBarrier bar; bar.bar = (unsigned*)(ctlp() + CW_BAR); bar.x = 0; bar.st = nullptr; bar.wv = wv;
    if (N_LAUNCH_MODE == 0) bar = xcd_barrier_post((unsigned*)(ctlp() + CW_BAR), MISC + 8, wv);
    const int lo = args.ph_lo, hi = args.ph_hi;
#define IN(k) (lo <= (k) && (k) < hi)
#define SEAM(k) do { if (IN(k) && IN((k) + 1)) xcd_barrier(bar); } while (0)
    if (IN(0)) { Frame F = mkframe(L, wv); ph_prologue(F); if (REPEAT == 1) ph_prologue(F); }
    SEAM(0);
    auto layer = [&](const int l) __attribute__((always_inline)) {
        const int P = 1 + 9 * l;
        if (IN(P)) { phase_stagger(STAG);
            unsigned char* ws = wsp(); pg8::Gemm g{(const bf16*)(ws + WS_XB), (const bf16*)(ws + WS_WIN), M, NPROJ_P, DM, wv}; pg8::StaticOrder S; S.init(M, NPROJ_P, gridDim.x, (int)blockIdx.x);
            pg8::EpiProj E{(bf16*)(ws + WS_PROJ), NPROJ_P, (const pg8::fx_t*)((gu32*)ws + CW_SSQ) + (size_t)(2 * l) * M, (float*)(ws + CTL_KBAR) + (size_t)l * 64 * 8 * 64, (pg8::fx_t*)(ws + CTL_STATS) + (size_t)l * M * 2,
                           (const float*)(ws + WS_SMALL + SM_SAX), (const float*)(ws + WS_SMALL + SM_SWIN)};
            if (I8_IN) { g.A = (const bf16*)(ws + WS_XQ); pg8::MaskOrder S1; S1.init(M, 0xFFFFFFu & ~BFMASK, gridDim.x, (int)blockIdx.x);
                pg8::gemm_phase<pg8::EpiProj, pg8::MaskOrder, true, PG8_SP2, 1>(L + RING_OFF, g, S1, E);
                if (BFMASK) { pg8::Gemm gb{(const bf16*)(ws + WS_XB), winb_ptr(), M, NPROJ_P, DM, wv}; pg8::MaskOrder S2; S2.init(M, BFMASK, gridDim.x, (int)blockIdx.x);
                    pg8::gemm_phase<pg8::EpiProj, pg8::MaskOrder, true, PG8_SP2>(L + RING_OFF, gb, S2, E); } }
            else pg8::gemm_phase<pg8::EpiProj, pg8::StaticOrder, true, PG8_SP2>(L + RING_OFF, g, S, E);
            if (REPEAT == 21) { pg8::EpiNull E0{(float*)(ws + WS_YCAT)}; pg8::MaskOrder S1; S1.init(M, 0xFFFFFFu, gridDim.x, (int)blockIdx.x); pg8::gemm_phase<pg8::EpiNull, pg8::MaskOrder, true, PG8_SP2, 1>(L + RING_OFF, g, S1, E0); }
            if (REPEAT == 23) { pg8::EpiProjDense E3{(bf16*)(ws + WS_YCAT), E.ssq, E.sa, E.sw}; pg8::MaskOrder S1; S1.init(M, 0xFFFFFFu, gridDim.x, (int)blockIdx.x); pg8::gemm_phase<pg8::EpiProjDense, pg8::MaskOrder, true, PG8_SP2, 1>(L + RING_OFF, g, S1, E3); }
            if (REPEAT == 22) { pg8::EpiProj E2 = E; E2.kbar = (float*)(ws + WS_YCAT + 32 * MiB); E2.stats = (pg8::fx_t*)(ws + WS_YCAT + 40 * MiB); E2.O = (bf16*)(ws + WS_YCAT); E2.ldc = 256;
                pg8::MaskOrder S1; S1.init(M, 0xFFFFFFu, gridDim.x, (int)blockIdx.x); pg8::gemm_phase<pg8::EpiProj, pg8::MaskOrder, true, PG8_SP2, 1>(L + RING_OFF, g, S1, E2); }
            if (REPEAT == 2) { pg8::EpiProj E2 = E; E2.kbar = (float*)(ws + WS_YCAT); E2.stats = (pg8::fx_t*)(ws + WS_YCAT + 8 * MiB);
                if (I8_IN) { pg8::MaskOrder S1; S1.init(M, 0xFFFFFFu & ~BFMASK, gridDim.x, (int)blockIdx.x); pg8::gemm_phase<pg8::EpiProj, pg8::MaskOrder, true, PG8_SP2, 1>(L + RING_OFF, g, S1, E2);
                    if (BFMASK) { pg8::Gemm gb{(const bf16*)(ws + WS_XB), winb_ptr(), M, NPROJ_P, DM, wv}; pg8::MaskOrder S2; S2.init(M, BFMASK, gridDim.x, (int)blockIdx.x); pg8::gemm_phase<pg8::EpiProj, pg8::MaskOrder, true, PG8_SP2>(L + RING_OFF, gb, S2, E2); } }
                else pg8::gemm_phase<pg8::EpiProj, pg8::StaticOrder, true, PG8_SP2>(L + RING_OFF, g, S, E2); }
        }
        SEAM(P);
        if (IN(P + 1)) { Frame F = mkframe(L, wv); ph_prep(F, l); if (REPEAT == 3) ph_prep(F, l); }
        SEAM(P + 1);
        if (IN(P + 2)) { ph_mixers(L, l, P + 2, 0, wv); if (REPEAT == 4) ph_mixers(L, l, P + 2, 32, wv); if (REPEAT >= 40 && REPEAT < 50) ph_mixers(L, l, P + 2, 32, wv, REPEAT == 41 ? 1 : (REPEAT == 42 ? 2 : (REPEAT == 43 ? 4 : (REPEAT == 44 ? 8 : 16)))); if (REPEAT >= 430 && REPEAT < 446) ph_mixers(L, l, P + 2, 32, wv, 4); }
        SEAM(P + 2);
        if (IN(P + 3)) { Frame F = mkframe(L, wv); ph_finalize(F, l); if (REPEAT == 5) ph_finalize(F, l); }
        SEAM(P + 3);
        if (IN(P + 4)) { phase_stagger(STAG);
            unsigned char* ws = wsp(); pg8::Gemm g{(const bf16*)(ws + WS_YCAT), (const bf16*)(ws + WS_WOUT), M, DM, DM, wv}; pg8::StaticOrder S; S.init(M, DM, gridDim.x, (int)blockIdx.x);
            pg8::EpiRes E{(bf16*)(ws + WS_XB), FFN1_I8 ? (pg8::fx_t*)nullptr : (pg8::fx_t*)((gu32*)ws + CW_SSQ) + (size_t)(2 * l + 1) * M, DM, (FFN_FP8 && !FFN1_I8) ? (unsigned char*)(ws + WS_SC2) : nullptr, 1.0f, (const float*)(ws + WS_SMALL + SM_SAY), (const float*)(ws + WS_SMALL + SM_SWOUT)};
            if (I8_OUT) { g.A = (const bf16*)(ws + WS_YQ); pg8::gemm_phase<pg8::EpiRes, pg8::StaticOrder, true, PG8_SP2, 1>(L + RING_OFF, g, S, E); }
            else pg8::gemm_phase<pg8::EpiRes, pg8::StaticOrder, true, PG8_SP2>(L + RING_OFF, g, S, E);
            if (REPEAT == 7) { pg8::EpiRes E2 = E; E2.xb = (bf16*)(ws + WS_YCAT); E2.ssq = (pg8::fx_t*)(ws + WS_G); E2.xf = (unsigned char*)(ws + WS_YD);
                if (I8_OUT) pg8::gemm_phase<pg8::EpiRes, pg8::StaticOrder, true, PG8_SP2, 1>(L + RING_OFF, g, S, E2); else pg8::gemm_phase<pg8::EpiRes, pg8::StaticOrder, true, PG8_SP2>(L + RING_OFF, g, S, E2); }
        }
        SEAM(P + 4);
        if (FFN1_I8) { if (IN(P + 5)) { Frame F = mkframe(L, wv); ph_quantx(F, (pg8::fx_t*)(ctlp() + CW_SSQ) + (size_t)(2 * l + 1) * M); } SEAM(P + 5); }
        if (IN(P + 6)) {
            unsigned char* ws = wsp(); pg8::Gemm g{(const bf16*)(ws + (FFN1_I8 ? WS_XQ : (FFN_FP8 ? WS_SC2 : WS_XB))), (const bf16*)(ws + WS_WGU), M, 2 * DFF, DM, wv}; pg8::StaticOrder S; S.init(M, 2 * DFF, gridDim.x, (int)blockIdx.x);
            if (FFN_FP8) { pg8::EpiGU8 E{(unsigned char*)(ws + WS_PROJ), DFF, (const pg8::fx_t*)((gu32*)ws + CW_SSQ) + (size_t)(2 * l + 1) * M, FFN1_I8 ? 1.0f : 1.0f / 64.0f, 8.0f, (const float*)(ws + WS_SMALL + SM_SAX), (const float*)(ws + WS_SMALL + SM_SWGU)};
                if (FFN1_I8) pg8::gemm_phase<pg8::EpiGU8, pg8::StaticOrder, true, PG8_SP2, 1>(L + RING_OFF, g, S, E);
                else pg8::gemm_phase_f8<pg8::EpiGU8, pg8::StaticOrder, true, PG8_SP2>(L + RING_OFF, g, S, E);
                if (REPEAT == 6) { if (FFN1_I8) pg8::gemm_phase<pg8::EpiGU8, pg8::StaticOrder, true, PG8_SP2, 1>(L + RING_OFF, g, S, E); else pg8::gemm_phase_f8<pg8::EpiGU8, pg8::StaticOrder, true, PG8_SP2>(L + RING_OFF, g, S, E); }
            } else { pg8::EpiGU E{(bf16*)(ws + WS_PROJ), DFF, (const pg8::fx_t*)((gu32*)ws + CW_SSQ) + (size_t)(2 * l + 1) * M, 1.0f};
                pg8::gemm_phase<pg8::EpiGU, pg8::StaticOrder, true, PG8_SP2>(L + RING_OFF, g, S, E);
                if (REPEAT == 6) pg8::gemm_phase<pg8::EpiGU, pg8::StaticOrder, true, PG8_SP2>(L + RING_OFF, g, S, E); }
        }
        SEAM(P + 6);
        if (IN(P + 7)) { phase_stagger(STAG);
            unsigned char* ws = wsp(); pg8::Gemm g{(const bf16*)(ws + WS_PROJ), (const bf16*)(ws + WS_WDN), M, DM, DFF, wv}; pg8::StaticOrder S; S.init(M, DM, gridDim.x, (int)blockIdx.x);
            pg8::EpiRes E{(bf16*)(ws + WS_XB), I8_IN ? (pg8::fx_t*)nullptr : (pg8::fx_t*)((gu32*)ws + CW_SSQ) + (size_t)(2 * l + 2) * M, DM, nullptr, FFN_FP8 ? 1.0f / 512.0f : 1.0f, nullptr, nullptr};
            if (FFN_FP8) pg8::gemm_phase_f8<pg8::EpiRes, pg8::StaticOrder, true, PG8_SP2>(L + RING_OFF, g, S, E);
            else pg8::gemm_phase<pg8::EpiRes, pg8::StaticOrder, true, PG8_SP2>(L + RING_OFF, g, S, E);
            if (REPEAT == 8) { pg8::EpiRes E2 = E; E2.xb = (bf16*)(ws + WS_YCAT); E2.ssq = (pg8::fx_t*)(ws + WS_G);
                if (FFN_FP8) pg8::gemm_phase_f8<pg8::EpiRes, pg8::StaticOrder, true, PG8_SP2>(L + RING_OFF, g, S, E2); else pg8::gemm_phase<pg8::EpiRes, pg8::StaticOrder, true, PG8_SP2>(L + RING_OFF, g, S, E2); }
        }
        SEAM(P + 7);
        if (l + 1 < DEPTH) { if (I8_IN && IN(P + 8)) { Frame F = mkframe(L, wv); ph_quantx(F, (pg8::fx_t*)(ctlp() + CW_SSQ) + (size_t)(2 * l + 2) * M); } if (I8_IN) SEAM(P + 8); }
    };
    static_assert(DEPTH == 2, "layers are expanded by hand");
    layer(0); layer(1);
    if (IN(19)) { Frame F = mkframe(L, wv); ph_final(F); }
#undef IN
#undef SEAM
}

extern "C" void kernel_launch(void* const* d_in, const int* in_sizes, int n_in, void* d_out, int out_size, void* d_ws, size_t ws_size, hipStream_t stream) {
    static int grid = 0;
    if (grid == 0) {
        if (n_in != 25 || in_sizes[0] != M * DM || out_size != M * DM || ws_size < WS_END) { fprintf(stderr, "kernel_launch: shape/workspace mismatch: n_in %d in0 %d out %d ws %zu (need %zu)\n", n_in, n_in > 0 ? in_sizes[0] : -1, out_size, ws_size, (size_t)WS_END); grid = -1; return; }
        int dev = 0, cus = 0, per_cu = 0;
        if (hipGetDevice(&dev) != hipSuccess || hipDeviceGetAttribute(&cus, hipDeviceAttributeMultiprocessorCount, dev) != hipSuccess) { grid = -1; return; }
        if (hipFuncSetAttribute((const void*)hy_fwd, hipFuncAttributeMaxDynamicSharedMemorySize, LDS_BYTES) != hipSuccess) { fprintf(stderr, "kernel_launch: hipFuncSetAttribute failed\n"); grid = -1; return; }
        if (hipOccupancyMaxActiveBlocksPerMultiprocessor(&per_cu, (const void*)hy_fwd, NTHR, LDS_BYTES) != hipSuccess || per_cu < 1) fprintf(stderr, "kernel_launch: occupancy query reports %d\n", per_cu);
        (void)hipGetLastError();
        grid = cus;
    }
    if (grid < 0) return;
    if (hipMemsetAsync((char*)d_ws + WS_CTL, 0, CTL_ZERO_BYTES, stream) != hipSuccess) return;
    Args a{};
    for (int i = 0; i < 25; ++i) a.in[i] = (const float*)d_in[i];
    a.out = (float*)d_out; a.ws = (unsigned char*)d_ws;
    if (N_LAUNCH_MODE == 0) { a.ph_lo = 0; a.ph_hi = N_PHASES; hipLaunchKernelGGL(hy_fwd, dim3(grid), dim3(NTHR), LDS_BYTES, stream, a); }
    else for (int p = 0; p < N_PHASES; ++p) { a.ph_lo = p; a.ph_hi = p + 1; hipLaunchKernelGGL(hy_fwd, dim3(grid), dim3(NTHR), LDS_BYTES, stream, a); }
}
```

```cpp
#define N_LAUNCH_MODE 0
#define REPEAT 0
#define PG8_SP2 true
#define FFN_FP8 1
#define GEMM_I8 3
#define STAG 0
#define FFN1_I8 1
#define BFMASK 0x0u
#include <hip/hip_runtime.h>
#include <cstdio>
#include <cstdint>
namespace pg8 {
#define PG8_LAS __attribute__((address_space(3)))
typedef unsigned short bf16_t;
typedef short bf16x8 __attribute__((ext_vector_type(8)));
typedef float f32x4 __attribute__((ext_vector_type(4)));
typedef unsigned u32x4 __attribute__((ext_vector_type(4)));
constexpr int BM = 256, BK = 64, HALF = 128, HTB = HALF * BK * 2  , STAGE_BYTES = 8 * HTB, NXCD = 8, WGM = 8;

__host__ __device__ __forceinline__ int lds_byte(int r, int c) { const int st = (r >> 4) * 2 + (c >> 5), rr = r & 15, cc = c & 31, ob = rr * 64 + cc * 2; return st * 1024 + (ob ^ (((ob >> 9) & 1) << 5)); }
__host__ __device__ __forceinline__ void stage_rc(int b, int& R, int& C) { const int st = b / 1024, sb = b % 1024, swz = sb ^ (((sb >> 9) & 1) << 5); R = (st >> 1) * 16 + swz / 64; C = (st & 1) * 32 + (swz % 64) / 2; }
__host__ __device__ __forceinline__ int perm32(int rho) { const int n = rho >> 4, i = rho & 15; return 8 * (i >> 2) + 4 * n + (i & 3); }

__device__ __forceinline__ int lane_now() { int l; asm volatile("v_mbcnt_lo_u32_b32 %0, -1, 0\n\tv_mbcnt_hi_u32_b32 %0, -1, %0" : "=v"(l)); return l; }
struct Unit { int pm, pn; };
struct Gemm { const bf16_t* A; const bf16_t* Bt; int M, N, K, wv; int same = 0; };

struct StaticOrder {
    int nM, nN, nwg, G, c;
    __host__ __device__ void init(int M, int N, int G_, int c_) { nM = M / BM; nN = N / BM; nwg = nM * nN; G = G_; c = c_; }
    __host__ __device__ bool next(int i, Unit& u) const {
        const long L = (long)i * G + c; if (L >= nwg) return false;
        int wgid = (int)L; { const int q = nwg / NXCD, r = nwg % NXCD, xcd = wgid % NXCD, off = wgid / NXCD; wgid = (xcd < r ? xcd * (q + 1) : r * (q + 1) + (xcd - r) * q) + off; }
        const int nig = WGM * nN, gid = wgid / nig, fm = gid * WGM, gsz = (nM - fm) < WGM ? (nM - fm) : WGM;
        u.pm = fm + ((wgid % nig) % gsz); u.pn = (wgid % nig) / gsz; return true;
    }
    __device__ __forceinline__ void a_ready(const Unit&) const {}
    __device__ __forceinline__ void done(const Unit&) const {}
};

struct MapOrder {
    StaticOrder s; int from, add;
    __device__ __forceinline__ bool next(int i, Unit& u) const { if (!s.next(i, u)) return false; if (u.pn >= from) u.pn += add; return true; }
    __device__ __forceinline__ void a_ready(const Unit&) const {}
    __device__ __forceinline__ void done(const Unit&) const {}
};

struct MaskOrder {
    StaticOrder s; unsigned mask;
    __device__ __forceinline__ void init(int M, unsigned mask_, int G_, int c_) { mask = mask_; s.init(M, BM * __builtin_popcount(mask_), G_, c_); }
    __device__ __forceinline__ bool next(int i, Unit& u) const { if (!s.next(i, u)) return false; unsigned m = mask; for (int j = 0; j < u.pn; ++j) m &= m - 1; u.pn = __builtin_ctz(m); return true; }
    __device__ __forceinline__ void a_ready(const Unit&) const {}
    __device__ __forceinline__ void done(const Unit&) const {}
};

__device__ __forceinline__ unsigned cvt_pk_bf16(float lo, float hi) { unsigned r; asm volatile("v_cvt_pk_bf16_f32 %0, %1, %2" : "=v"(r) : "v"(lo), "v"(hi)); return r; }
typedef float f32x2 __attribute__((ext_vector_type(2)));

typedef unsigned u32x2 __attribute__((ext_vector_type(2)));
typedef unsigned long long fx_t;
__device__ __forceinline__ void fx_add(fx_t* p, float v) { atomicAdd(p, (fx_t)(long long)__float2ll_rn(v * 1073741824.0f)); }
__device__ __forceinline__ float fx_get(const fx_t* p) { return (float)(long long)(*p) * (1.0f / 1073741824.0f); }
__device__ __forceinline__ float epi_gelu(float x) { const float u = 0.7978845608028654f * (x + 0.044715f * x * x * x); const float e2 = __expf(2.0f * u); return x - x * __builtin_amdgcn_rcpf(e2 + 1.0f); }
template <int CTRL> __device__ __forceinline__ float epi_dpp_add(float x) { const int y = __builtin_amdgcn_update_dpp(0, __builtin_bit_cast(int, x), CTRL, 0xF, 0xF, false); return x + __builtin_bit_cast(float, y); }
typedef int i32x4_t __attribute__((ext_vector_type(4)));
__device__ __forceinline__ f32x4 acc_f(const f32x4& v) { return v; }
__device__ __forceinline__ f32x4 acc_f(const i32x4_t& v) { return __builtin_convertvector(v, f32x4); }
template <class T> struct AccIsInt { static constexpr bool v = false; };
template <> struct AccIsInt<i32x4_t> { static constexpr bool v = true; };
__device__ __forceinline__ void epi_prefetch(const fx_t* ssq_rows, const float* sa_rows, const float* sw_cols, PG8_LAS unsigned char* slot, int wid) {
    const int ln = lane_now();
    __builtin_amdgcn_global_load_lds((const __attribute__((address_space(1))) unsigned*)((const unsigned*)ssq_rows + wid * 64 + ln), (PG8_LAS unsigned*)(slot + wid * 256), 4, 0, 0);
    if (sa_rows) { const float* src = wid < 4 ? sa_rows + wid * 64 : sw_cols + (wid - 4) * 64;
        __builtin_amdgcn_global_load_lds((const __attribute__((address_space(1))) unsigned*)((const unsigned*)src + ln), (PG8_LAS unsigned*)(slot + 2048 + wid * 256), 4, 0, 0); }
}
__device__ __forceinline__ float fx_getl(const PG8_LAS unsigned char* slot, int rloc) { return (float)(long long)(*(const PG8_LAS fx_t*)(slot + 8 * rloc)) * (1.0f / 1073741824.0f); }
struct EpiProj {
    static constexpr bool PERM = true, AFTER_DRAIN = false, PREFETCH = true;
    bf16_t* O; int ldc; const fx_t* ssq; float* kbar; fx_t* stats; const float* sa; const float* sw;
    __device__ __forceinline__ void prefetch(const Unit& u, PG8_LAS unsigned char* slot, int wid) const { epi_prefetch(ssq + u.pm * BM, sa ? sa + u.pm * BM : nullptr, sw + u.pn * BM, slot, wid); }
    template <class AccT> __device__ __forceinline__ void operator()(const AccT (&acc)[2][2][4][2], const Unit& u, int wr, int wc, int fr, int fq, const PG8_LAS unsigned char* slot) const {
        constexpr bool Q = AccIsInt<AccT>::v;
        const int row0 = u.pm * BM + wr * 64 + fr, col0 = u.pn * BM + wc * 32 + 8 * fq;
        f32x4 cw[2][2];
        if constexpr (Q) {
#pragma unroll
            for (int bj = 0; bj < 2; ++bj) { const PG8_LAS float* p = (const PG8_LAS float*)(slot + 3072) + bj * HALF + wc * 32 + 8 * fq; cw[bj][0] = *(const PG8_LAS f32x4*)p; cw[bj][1] = *(const PG8_LAS f32x4*)(p + 4); } }
        const bool do_k = (u.pn == 12 || u.pn == 13), do_s = (u.pn == 8 || u.pn == 9);
        float cs[2][8];
#pragma unroll
        for (int bj = 0; bj < 2; ++bj)
#pragma unroll
            for (int e = 0; e < 8; ++e) cs[bj][e] = 0.f;
#pragma unroll
        for (int ai = 0; ai < 2; ++ai)
#pragma unroll
            for (int m = 0; m < 4; ++m) { const int row = row0 + ai * HALF + m * 16; const int rloc = ai * HALF + wr * 64 + m * 16 + fr; float rs = __builtin_amdgcn_rsqf(fx_getl(slot, rloc) * (1.0f / 2048.0f) + 1e-6f); if constexpr (Q) rs *= *(const PG8_LAS float*)(slot + 2048 + 4 * rloc);
                bf16_t* rowp = O + (size_t)row * ldc + col0; float s1 = 0.f, s2 = 0.f;
#pragma unroll
                for (int bj = 0; bj < 2; ++bj) { f32x4 v0 = acc_f(acc[ai][bj][m][0]) * rs, v1 = acc_f(acc[ai][bj][m][1]) * rs; if constexpr (Q) { v0 *= cw[bj][0]; v1 *= cw[bj][1]; }
                    u32x4 w; w.x = cvt_pk_bf16(v0[0], v0[1]); w.y = cvt_pk_bf16(v0[2], v0[3]); w.z = cvt_pk_bf16(v1[0], v1[1]); w.w = cvt_pk_bf16(v1[2], v1[3]);
                    *(u32x4*)(rowp + bj * HALF) = w;
                    if (do_k) {
#pragma unroll
                        for (int e = 0; e < 4; ++e) { cs[bj][e] += v0[e]; cs[bj][4 + e] += v1[e]; } }
                    if (do_s) {
#pragma unroll
                        for (int e = 0; e < 4; ++e) { const float g0 = epi_gelu(v0[e]), g1 = epi_gelu(v1[e]); s1 += g0 + g1; s2 += g0 * g0 + g1 * g1; } } }
                if (do_s) { s1 += __shfl_xor(s1, 16); s1 += __shfl_xor(s1, 32); s2 += __shfl_xor(s2, 16); s2 += __shfl_xor(s2, 32);
                    if (fq == 0) { fx_add(stats + 2 * row, s1); fx_add(stats + 2 * row + 1, s2); } } }
        if (do_k) {
            const int bidx = (u.pm >> 3) * 8, n = u.pm & 7;
#pragma unroll
            for (int bj = 0; bj < 2; ++bj)
#pragma unroll
                for (int e = 0; e < 8; ++e) { float s = cs[bj][e]; s = epi_dpp_add<0xB1>(s); s = epi_dpp_add<0x4E>(s); s = epi_dpp_add<0x141>(s); s = epi_dpp_add<0x140>(s);
                    const int ck = col0 + bj * HALF + e - 3072;
                    if (fr == 0) unsafeAtomicAdd(kbar + ((bidx + (ck >> 6)) * 8 + n) * 64 + (ck & 63), s * (1.0f / 256.0f)); } }
    }
};
struct EpiGU {
    static constexpr bool PERM = true, AFTER_DRAIN = false, PREFETCH = false;
    bf16_t* O; int ldc; const fx_t* ssq; float oscale;
    __device__ __forceinline__ void operator()(const f32x4 (&acc)[2][2][4][2], const Unit& u, int wr, int wc, int fr, int fq, const PG8_LAS unsigned char* slot) const {
        const int row0 = u.pm * BM + wr * 64 + fr, col0 = u.pn * HALF + wc * 32 + 8 * fq;
#pragma unroll
        for (int ai = 0; ai < 2; ++ai)
#pragma unroll
            for (int m = 0; m < 4; ++m) { const int row = row0 + ai * HALF + m * 16; const float rs = __builtin_amdgcn_rsqf(fx_get(ssq + row) * (1.0f / 2048.0f) + 1e-6f) * oscale;
                float o[8];
#pragma unroll
                for (int n = 0; n < 2; ++n)
#pragma unroll
                    for (int e = 0; e < 4; ++e) { const float g = acc[ai][0][m][n][e] * rs, up = acc[ai][1][m][n][e] * rs;
                        o[n * 4 + e] = g * __builtin_amdgcn_rcpf(1.0f + __builtin_amdgcn_exp2f(-1.4426950408889634f * g)) * up; }
                u32x4 w; w.x = cvt_pk_bf16(o[0], o[1]); w.y = cvt_pk_bf16(o[2], o[3]); w.z = cvt_pk_bf16(o[4], o[5]); w.w = cvt_pk_bf16(o[6], o[7]);
                *(u32x4*)(O + (size_t)row * ldc + col0) = w; }
    }
};
__device__ __forceinline__ float epi_clamp8(float v) { return __builtin_amdgcn_fmed3f(v, -448.0f, 448.0f); }
struct EpiGU8 {
    static constexpr bool PERM = true, AFTER_DRAIN = false, PREFETCH = true;
    __device__ __forceinline__ void prefetch(const Unit& u, PG8_LAS unsigned char* slot, int wid) const { epi_prefetch(ssq + u.pm * BM, sa ? sa + u.pm * BM : nullptr, sw + u.pn * BM, slot, wid); }
    unsigned char* O; int ldc; const fx_t* ssq; float oscale, ascale; const float* sa; const float* sw;
    template <class AccT> __device__ __forceinline__ void operator()(const AccT (&acc)[2][2][4][2], const Unit& u, int wr, int wc, int fr, int fq, const PG8_LAS unsigned char* slot) const {
        constexpr bool Q = AccIsInt<AccT>::v;
        const int row0 = u.pm * BM + wr * 64 + fr, col0 = u.pn * HALF + wc * 32 + 8 * fq;
        f32x4 cw[2][2];
        if constexpr (Q) {
#pragma unroll
            for (int bj = 0; bj < 2; ++bj) { const PG8_LAS float* p = (const PG8_LAS float*)(slot + 3072) + bj * HALF + wc * 32 + 8 * fq; cw[bj][0] = *(const PG8_LAS f32x4*)p; cw[bj][1] = *(const PG8_LAS f32x4*)(p + 4); } }
#pragma unroll
        for (int ai = 0; ai < 2; ++ai)
#pragma unroll
            for (int m = 0; m < 4; ++m) { const int row = row0 + ai * HALF + m * 16; const int rloc = ai * HALF + wr * 64 + m * 16 + fr; float rs = __builtin_amdgcn_rsqf(fx_getl(slot, rloc) * (1.0f / 2048.0f) + 1e-6f) * oscale; if constexpr (Q) rs *= *(const PG8_LAS float*)(slot + 2048 + 4 * rloc);
                float o[8];
#pragma unroll
                for (int n = 0; n < 2; ++n) { f32x4 gv = acc_f(acc[ai][0][m][n]) * rs, uv = acc_f(acc[ai][1][m][n]) * rs; if constexpr (Q) { gv *= cw[0][n]; uv *= cw[1][n]; }
#pragma unroll
                    for (int e = 0; e < 4; ++e) { const float g = gv[e], up = uv[e];
                        o[n * 4 + e] = epi_clamp8(g * __builtin_amdgcn_rcpf(1.0f + __builtin_amdgcn_exp2f(-1.4426950408889634f * g)) * up * ascale); } }
                int f0 = __builtin_bit_cast(int, o[0]), f1 = __builtin_bit_cast(int, o[4]);
                f0 = __builtin_amdgcn_cvt_pk_fp8_f32(o[0], o[1], f0, false); f0 = __builtin_amdgcn_cvt_pk_fp8_f32(o[2], o[3], f0, true);
                f1 = __builtin_amdgcn_cvt_pk_fp8_f32(o[4], o[5], f1, false); f1 = __builtin_amdgcn_cvt_pk_fp8_f32(o[6], o[7], f1, true);
                *(u32x2*)(O + (size_t)row * ldc + col0) = (u32x2){(unsigned)f0, (unsigned)f1}; }
    }
};
struct EpiRes {
    static constexpr bool PERM = true, AFTER_DRAIN = false, PREFETCH = false;
    bf16_t* xb; fx_t* ssq; int ldc; unsigned char* xf; float oscale; const float* sa; const float* sw;
    template <class AccT> __device__ __forceinline__ void operator()(const AccT (&acc)[2][2][4][2], const Unit& u, int wr, int wc, int fr, int fq, const PG8_LAS unsigned char* slot) const {
        constexpr bool Q = AccIsInt<AccT>::v;
        const int row0 = u.pm * BM + wr * 64 + fr, col0 = u.pn * BM + wc * 32 + 8 * fq;
        f32x4 cw[2][2];
        if constexpr (Q) {
#pragma unroll
            for (int bj = 0; bj < 2; ++bj) { cw[bj][0] = *(const f32x4*)(sw + col0 + bj * HALF); cw[bj][1] = *(const f32x4*)(sw + col0 + bj * HALF + 4); } }
#pragma unroll
        for (int ai = 0; ai < 2; ++ai)
#pragma unroll
            for (int m = 0; m < 4; ++m) { const int row = row0 + ai * HALF + m * 16; bf16_t* rowp = xb + (size_t)row * ldc + col0; float s = 0.f; float osc = oscale; if constexpr (Q) osc = sa[row];
                u32x4 b[2];
#pragma unroll
                for (int bj = 0; bj < 2; ++bj) b[bj] = *(const u32x4*)(rowp + bj * HALF);
#pragma unroll
                for (int bj = 0; bj < 2; ++bj) { float o[8]; f32x4 a2[2] = {acc_f(acc[ai][bj][m][0]), acc_f(acc[ai][bj][m][1])}; if constexpr (Q) { a2[0] *= cw[bj][0]; a2[1] *= cw[bj][1]; }
#pragma unroll
                    for (int q = 0; q < 4; ++q) { o[2 * q] = __builtin_fmaf(a2[q >> 1][2 * (q & 1)], osc, __builtin_bit_cast(float, b[bj][q] << 16)); o[2 * q + 1] = __builtin_fmaf(a2[q >> 1][2 * (q & 1) + 1], osc, __builtin_bit_cast(float, b[bj][q] & 0xffff0000u)); }
                    u32x4 w; w.x = cvt_pk_bf16(o[0], o[1]); w.y = cvt_pk_bf16(o[2], o[3]); w.z = cvt_pk_bf16(o[4], o[5]); w.w = cvt_pk_bf16(o[6], o[7]);
                    *(u32x4*)(rowp + bj * HALF) = w;
                    if (xf) { int f0 = (int)b[bj][0], f1 = (int)b[bj][1]; f0 = __builtin_amdgcn_cvt_pk_fp8_f32(epi_clamp8(o[0]), epi_clamp8(o[1]), f0, false); f0 = __builtin_amdgcn_cvt_pk_fp8_f32(epi_clamp8(o[2]), epi_clamp8(o[3]), f0, true);
                        f1 = __builtin_amdgcn_cvt_pk_fp8_f32(epi_clamp8(o[4]), epi_clamp8(o[5]), f1, false); f1 = __builtin_amdgcn_cvt_pk_fp8_f32(epi_clamp8(o[6]), epi_clamp8(o[7]), f1, true);
                        *(u32x2*)(xf + (size_t)row * ldc + col0 + bj * HALF) = (u32x2){(unsigned)f0, (unsigned)f1}; }
                    if (ssq) {
#pragma unroll
                        for (int q = 0; q < 8; ++q) s += o[q] * o[q]; } }
                if (ssq) { s += __shfl_xor(s, 16); s += __shfl_xor(s, 32);
                    if (fq == 0) fx_add(ssq + row, s); } }
    }
};

struct EpiNull {
    static constexpr bool PERM = true, AFTER_DRAIN = false, PREFETCH = false;
    float* sink;
    template <class AccT> __device__ __forceinline__ void operator()(const AccT (&acc)[2][2][4][2], const Unit& u, int wr, int wc, int fr, int fq, const PG8_LAS unsigned char* slot) const {
        f32x4 s = {0.f, 0.f, 0.f, 0.f};
#pragma unroll
        for (int ai = 0; ai < 2; ++ai)
#pragma unroll
            for (int bj = 0; bj < 2; ++bj)
#pragma unroll
                for (int m = 0; m < 4; ++m)
#pragma unroll
                    for (int n = 0; n < 2; ++n) s += acc_f(acc[ai][bj][m][n]);
        if (s[0] + s[1] + s[2] + s[3] == 1.2345e30f) sink[0] = s[0];
    }
};

struct EpiProjDense {
    static constexpr bool PERM = true, AFTER_DRAIN = false, PREFETCH = false;
    bf16_t* O; const fx_t* ssq; const float* sa; const float* sw;
    template <class AccT> __device__ __forceinline__ void operator()(const AccT (&acc)[2][2][4][2], const Unit& u, int wr, int wc, int fr, int fq, const PG8_LAS unsigned char* slot) const {
        const int row0 = u.pm * BM + wr * 64 + fr, col0 = u.pn * BM + wc * 32 + 8 * fq;
        f32x4 cw[2][2];
#pragma unroll
        for (int bj = 0; bj < 2; ++bj) { cw[bj][0] = *(const f32x4*)(sw + col0 + bj * HALF); cw[bj][1] = *(const f32x4*)(sw + col0 + bj * HALF + 4); }
        bf16_t* base = O + ((size_t)(((u.pm * 24 + u.pn) & 255) * 8 + wr * 4 + wc) * 16) * 512 + (fq * 16 + fr) * 8;
#pragma unroll
        for (int ai = 0; ai < 2; ++ai)
#pragma unroll
            for (int m = 0; m < 4; ++m) { const int row = row0 + ai * HALF + m * 16; float rs = __builtin_amdgcn_rsqf(fx_get(ssq + row) * (1.0f / 2048.0f) + 1e-6f) * sa[row];
#pragma unroll
                for (int bj = 0; bj < 2; ++bj) { f32x4 v0 = acc_f(acc[ai][bj][m][0]) * rs * cw[bj][0], v1 = acc_f(acc[ai][bj][m][1]) * rs * cw[bj][1];
                    u32x4 w; w.x = cvt_pk_bf16(v0[0], v0[1]); w.y = cvt_pk_bf16(v0[2], v0[3]); w.z = cvt_pk_bf16(v1[0], v1[1]); w.w = cvt_pk_bf16(v1[2], v1[3]);
                    *(u32x4*)(base + ((ai * 4 + m) * 2 + bj) * 512) = w; } }
    }
};
typedef int i32x8_t __attribute__((ext_vector_type(8)));
constexpr int PG8_PRM_OFF = STAGE_BYTES + 1024;
__device__ __forceinline__ void mma16(f32x4& c, const bf16x8& a, const bf16x8& b) { c = __builtin_amdgcn_mfma_f32_16x16x32_bf16(a, b, c, 0, 0, 0); }
__device__ __forceinline__ void mma16(i32x4_t& c, const bf16x8& a, const bf16x8& b) { c = __builtin_amdgcn_mfma_i32_16x16x64_i8(__builtin_bit_cast(i32x4_t, a), __builtin_bit_cast(i32x4_t, b), c, 0, 0, 0); }
template <int EB> struct AccOf { typedef f32x4 type; };
template <> struct AccOf<1> { typedef i32x4_t type; };
template <class Epi, class Sched, bool ALIGN_EPI = false, bool SP2 = false, int EB = 2>
__device__ __forceinline__ void gemm_phase(PG8_LAS unsigned char* lds, const Gemm g, const Sched& S, const Epi& E) {
    int tid_ = g.wv * 64 + lane_now(); asm volatile("" : "+v"(tid_));
    const int tid = tid_, wid = __builtin_amdgcn_readfirstlane(tid >> 6), lane = tid & 63, wr = wid >> 2, wc = wid & 3, fr = lane & 15, fq = lane >> 4;
    const int K = g.K, nt = K * EB / (2 * BK);
    unsigned voffA[2], voffB[2];
#pragma unroll
    for (int i = 0; i < 2; ++i) { int R, C; stage_rc(tid * 16 + i * 8192, R, C); const int Rb = Epi::PERM ? ((R & ~31) + perm32(R & 31)) : R;
        voffA[i] = (unsigned)(R * K * EB + 2 * C); voffB[i] = (unsigned)(Rb * K * EB + 2 * C); }
    const unsigned kstep = (unsigned)(BK * 2);
    const unsigned hstep = (unsigned)HALF * K * EB;
    const unsigned tstep = 2 * hstep;
    const unsigned ldsw = (unsigned)wid * 1024u;
    const int aoff = lds_byte(wr * 64 + fr, fq * 8), boff = lds_byte(wc * 32 + fr, fq * 8);
#define PG8_SA(b, h) (((b) * 2 + (h)) * HTB)
#define PG8_SB(b, h) ((4 + (b) * 2 + (h)) * HTB)
#define PG8_STAGE(bufoff, rsrc, soff, voff) do { _Pragma("unroll") for (int _i = 0; _i < 2; ++_i) \
        __builtin_amdgcn_raw_ptr_buffer_load_lds(rsrc, (PG8_LAS void*)(lds + (bufoff) + ldsw + _i * 8192), 16, (int)(voff)[_i], (int)(soff), 0, 0); } while (0)
#define PG8_LDA(dst, b, h) do { _Pragma("unroll") for (int m = 0; m < 4; ++m) _Pragma("unroll") for (int k = 0; k < 2; ++k) dst[m][k] = *(const PG8_LAS bf16x8*)(lds + PG8_SA(b, h) + aoff + m * 2048 + k * 1024); } while (0)
#define PG8_LDB(dst, b, h) do { _Pragma("unroll") for (int n = 0; n < 2; ++n) _Pragma("unroll") for (int k = 0; k < 2; ++k) dst[n][k] = *(const PG8_LAS bf16x8*)(lds + PG8_SB(b, h) + boff + n * 2048 + k * 1024); } while (0)
#define PG8_MMA(ai, bj, At, Bt) do { __builtin_amdgcn_s_setprio(1); _Pragma("unroll") for (int m = 0; m < 4; ++m) _Pragma("unroll") for (int n = 0; n < 2; ++n) _Pragma("unroll") for (int k = 0; k < 2; ++k) \
        mma16(acc[ai][bj][m][n], Bt[n][k], At[m][k]); __builtin_amdgcn_s_setprio(0); } while (0)
#define PG8_WAIT_V(n) asm volatile("s_waitcnt vmcnt(" #n ")" ::: "memory")
#define PG8_WAIT_L(n) asm volatile("s_waitcnt lgkmcnt(" #n ")" ::: "memory")
#define PG8_BAR __builtin_amdgcn_s_barrier()
#define PG8_SCHED __builtin_amdgcn_sched_barrier(0)
    Unit cur, nxt; int ui = 0;
    if (!S.next(0, cur)) return;
    typedef typename AccOf<EB>::type acc_t; acc_t acc[2][2][4][2];
#pragma unroll
    for (int a = 0; a < 2; ++a)
#pragma unroll
        for (int b = 0; b < 2; ++b)
#pragma unroll
            for (int m = 0; m < 4; ++m)
#pragma unroll
                for (int n = 0; n < 2; ++n) acc[a][b][m][n] = acc_t{};
    bf16x8 At[4][2], B0[2][2], B1[2][2];
    const __amdgpu_buffer_rsrc_t rA = __builtin_amdgcn_make_buffer_rsrc((void*)g.A, (short)0, -1, 0x00020000), rB = __builtin_amdgcn_make_buffer_rsrc((void*)g.Bt, (short)0, -1, 0x00020000);
    unsigned cA = g.same ? 0u : (unsigned)cur.pm * tstep, cB = g.same ? 0u : (unsigned)cur.pn * tstep;
    S.a_ready(cur);
    if constexpr (SP2) {
        PG8_STAGE(PG8_SB(0, 0), rB, cB, voffB); PG8_STAGE(PG8_SB(0, 1), rB, cB + hstep, voffB); PG8_STAGE(PG8_SA(0, 0), rA, cA, voffA); PG8_STAGE(PG8_SA(0, 1), rA, cA + hstep, voffA);
        if (wr == 1) PG8_BAR;
        PG8_WAIT_V(2); PG8_BAR;
        PG8_STAGE(PG8_SB(1, 0), rB, cB + kstep, voffB); PG8_STAGE(PG8_SA(1, 0), rA, cA + kstep, voffA); PG8_STAGE(PG8_SB(1, 1), rB, cB + hstep + kstep, voffB);
        PG8_WAIT_V(6); PG8_BAR;
    } else {
        PG8_STAGE(PG8_SB(0, 0), rB, cB, voffB); PG8_STAGE(PG8_SA(0, 0), rA, cA, voffA); PG8_STAGE(PG8_SB(0, 1), rB, cB + hstep, voffB); PG8_STAGE(PG8_SA(0, 1), rA, cA + hstep, voffA);
        if (wr == 1) PG8_BAR;
        PG8_WAIT_V(4); PG8_BAR;
        PG8_STAGE(PG8_SB(1, 0), rB, cB + kstep, voffB); PG8_STAGE(PG8_SA(1, 0), rA, cA + kstep, voffA); PG8_STAGE(PG8_SB(1, 1), rB, cB + hstep + kstep, voffB);
        PG8_WAIT_V(6); PG8_BAR;
    }
    for (;;) {
        const bool has_next = S.next(ui + 1, nxt);
        const unsigned nA = (has_next && !g.same) ? (unsigned)nxt.pm * tstep : cA, nB = (has_next && !g.same) ? (unsigned)nxt.pn * tstep : cB;
        for (int t = 0; t < nt; t += 2) {
            const bool last = (t == nt - 2);
            const unsigned a1 = cA + (unsigned)(t + 1) * kstep;
            const unsigned a2 = last ? nA : cA + (unsigned)(t + 2) * kstep, b2 = last ? nB : cB + (unsigned)(t + 2) * kstep;
            const unsigned a3 = a2 + kstep, b3 = b2 + kstep;
            if (last && has_next) S.a_ready(nxt);
            if constexpr (Epi::PREFETCH) { if (t == 0) E.prefetch(cur, lds + PG8_PRM_OFF + (ui & 1) * 4096, wid); }
            if constexpr (SP2) {
            PG8_LDB(B0, 0, 0); PG8_LDB(B1, 0, 1); PG8_SCHED; PG8_LDA(At, 0, 0); PG8_STAGE(PG8_SA(1, 1), rA, a1 + hstep, voffA);
            PG8_WAIT_V(8); PG8_WAIT_L(0); PG8_BAR; PG8_MMA(0, 0, At, B0); PG8_MMA(0, 1, At, B1); PG8_BAR; PG8_SCHED;
            PG8_LDA(At, 0, 1); PG8_STAGE(PG8_SB(0, 0), rB, b2, voffB); PG8_STAGE(PG8_SB(0, 1), rB, b2 + hstep, voffB); PG8_STAGE(PG8_SA(0, 0), rA, a2, voffA);
            PG8_WAIT_V(8); PG8_WAIT_L(0); PG8_BAR; PG8_MMA(1, 0, At, B0); PG8_MMA(1, 1, At, B1); PG8_BAR; PG8_SCHED;
            PG8_LDB(B0, 1, 0); PG8_LDB(B1, 1, 1); PG8_SCHED; PG8_LDA(At, 1, 0); PG8_STAGE(PG8_SA(0, 1), rA, a2 + hstep, voffA);
            PG8_WAIT_V(8); PG8_WAIT_L(0); PG8_BAR; PG8_MMA(0, 0, At, B0); PG8_MMA(0, 1, At, B1); PG8_BAR; PG8_SCHED;
            PG8_LDA(At, 1, 1); PG8_STAGE(PG8_SB(1, 0), rB, b3, voffB); PG8_STAGE(PG8_SB(1, 1), rB, b3 + hstep, voffB); PG8_STAGE(PG8_SA(1, 0), rA, a3, voffA);
            PG8_WAIT_V(8); PG8_WAIT_L(0); PG8_BAR; PG8_MMA(1, 0, At, B0); PG8_MMA(1, 1, At, B1); PG8_BAR; PG8_SCHED;
            } else {
            PG8_LDB(B0, 0, 0); PG8_SCHED; PG8_LDA(At, 0, 0); PG8_STAGE(PG8_SA(1, 1), rA, a1 + hstep, voffA);
            PG8_WAIT_L(8); PG8_BAR; PG8_WAIT_L(0); PG8_MMA(0, 0, At, B0); PG8_BAR; PG8_SCHED;
            PG8_LDB(B1, 0, 1); PG8_STAGE(PG8_SB(0, 0), rB, b2, voffB);
            PG8_BAR; PG8_WAIT_L(0); PG8_MMA(0, 1, At, B1); PG8_BAR;
            PG8_LDA(At, 0, 1); PG8_STAGE(PG8_SA(0, 0), rA, a2, voffA);
            PG8_BAR; PG8_WAIT_L(0); PG8_MMA(1, 0, At, B0); PG8_BAR; PG8_SCHED;
            PG8_STAGE(PG8_SB(0, 1), rB, b2 + hstep, voffB);
            PG8_WAIT_V(6); PG8_BAR; PG8_MMA(1, 1, At, B1); PG8_BAR;
            PG8_LDB(B0, 1, 0); PG8_SCHED; PG8_LDA(At, 1, 0); PG8_STAGE(PG8_SA(0, 1), rA, a2 + hstep, voffA);
            PG8_WAIT_L(8); PG8_BAR; PG8_WAIT_L(0); PG8_MMA(0, 0, At, B0); PG8_BAR; PG8_SCHED;
            PG8_LDB(B1, 1, 1); PG8_STAGE(PG8_SB(1, 0), rB, b3, voffB);
            PG8_BAR; PG8_WAIT_L(0); PG8_MMA(0, 1, At, B1); PG8_BAR;
            PG8_LDA(At, 1, 1); PG8_STAGE(PG8_SA(1, 0), rA, a3, voffA);
            PG8_BAR; PG8_WAIT_L(0); PG8_MMA(1, 0, At, B0); PG8_BAR; PG8_SCHED;
            PG8_STAGE(PG8_SB(1, 1), rB, b3 + hstep, voffB);
            PG8_WAIT_V(6); PG8_BAR; PG8_MMA(1, 1, At, B1); PG8_BAR;
            }
        }
        if constexpr (ALIGN_EPI) { if (wr == 0) PG8_BAR; }
        if constexpr (!Epi::AFTER_DRAIN) { int ln_ = (int)__builtin_amdgcn_mbcnt_hi(~0u, __builtin_amdgcn_mbcnt_lo(~0u, 0u)); asm volatile("" : "+v"(ln_));
            E(acc, cur, wr, wc, ln_ & 15, ln_ >> 4, lds + PG8_PRM_OFF + (ui & 1) * 4096); S.done(cur); }
        if (!has_next) break;
#pragma unroll
        for (int a = 0; a < 2; ++a)
#pragma unroll
            for (int b = 0; b < 2; ++b)
#pragma unroll
                for (int m = 0; m < 4; ++m)
#pragma unroll
                    for (int n = 0; n < 2; ++n) acc[a][b][m][n] = acc_t{};
        cur = nxt; cA = nA; cB = nB; ++ui;
        if constexpr (ALIGN_EPI) { if (wr == 1) PG8_BAR; }
    }
    PG8_WAIT_V(0);
    if constexpr (!ALIGN_EPI) { if (wr == 0) PG8_BAR; }
    PG8_BAR;
    if constexpr (Epi::AFTER_DRAIN) { E.fused(acc, cur, wr, wc, fr, fq, lds, wid, lane); S.done(cur); }
#undef PG8_SA
#undef PG8_SB
#undef PG8_STAGE
#undef PG8_LDA
#undef PG8_LDB
#undef PG8_MMA
#undef PG8_WAIT_V
#undef PG8_WAIT_L
#undef PG8_BAR
#undef PG8_SCHED
}
template <class Epi, class Sched, bool ALIGN_EPI = false, bool SP2 = false>
__device__ __forceinline__ void gemm_phase_f8(PG8_LAS unsigned char* lds, const Gemm g, const Sched& S, const Epi& E) {
    int tid_ = g.wv * 64 + lane_now(); asm volatile("" : "+v"(tid_));
    const int tid = tid_, wid = __builtin_amdgcn_readfirstlane(tid >> 6), lane = tid & 63, wr = wid >> 2, wc = wid & 3, fr = lane & 15, fq = lane >> 4;
    const int K = g.K, nt = K / (2 * BK);
    unsigned voffA[2], voffB[2];
#pragma unroll
    for (int i = 0; i < 2; ++i) { int R, C; stage_rc(tid * 16 + i * 8192, R, C); const int Rb = Epi::PERM ? ((R & ~31) + perm32(R & 31)) : R;
        voffA[i] = (unsigned)(R * K + 2 * C); voffB[i] = (unsigned)(Rb * K + 2 * C); }
    const unsigned kstep = (unsigned)(BK * 2);
    const unsigned hstep = (unsigned)HALF * K;
    const unsigned tstep = 2 * hstep;
    const unsigned ldsw = (unsigned)wid * 1024u;
    const int aoff = lds_byte(wr * 64 + fr, fq * 16) ^ ((fq & 1) << 4), boff = lds_byte(wc * 32 + fr, fq * 16) ^ ((fq & 1) << 4), aoff2 = aoff ^ 16, boff2 = boff ^ 16;
#define PG8_SA(b, h) (((b) * 2 + (h)) * HTB)
#define PG8_SB(b, h) ((4 + (b) * 2 + (h)) * HTB)
#define PG8_STAGE(bufoff, rsrc, soff, voff) do { _Pragma("unroll") for (int _i = 0; _i < 2; ++_i) \
        __builtin_amdgcn_raw_ptr_buffer_load_lds(rsrc, (PG8_LAS void*)(lds + (bufoff) + ldsw + _i * 8192), 16, (int)(voff)[_i], (int)(soff), 0, 0); } while (0)
#define PG8_LDA(dst, b, h) do { _Pragma("unroll") for (int m = 0; m < 4; ++m) { const i32x4_t lo_ = *(const PG8_LAS i32x4_t*)(lds + PG8_SA(b, h) + aoff + m * 2048), hi_ = *(const PG8_LAS i32x4_t*)(lds + PG8_SA(b, h) + aoff2 + m * 2048); dst[m] = __builtin_shufflevector(lo_, hi_, 0, 1, 2, 3, 4, 5, 6, 7); } } while (0)
#define PG8_LDB(dst, b, h) do { _Pragma("unroll") for (int n = 0; n < 2; ++n) { const i32x4_t lo_ = *(const PG8_LAS i32x4_t*)(lds + PG8_SB(b, h) + boff + n * 2048), hi_ = *(const PG8_LAS i32x4_t*)(lds + PG8_SB(b, h) + boff2 + n * 2048); dst[n] = __builtin_shufflevector(lo_, hi_, 0, 1, 2, 3, 4, 5, 6, 7); } } while (0)
#define PG8_F8CAT(lo, hi) __builtin_shufflevector(__builtin_bit_cast(i32x4_t, lo), __builtin_bit_cast(i32x4_t, hi), 0, 1, 2, 3, 4, 5, 6, 7)
#define PG8_MMA(ai, bj, At, Bt) do { __builtin_amdgcn_s_setprio(1); _Pragma("unroll") for (int m = 0; m < 4; ++m) _Pragma("unroll") for (int n = 0; n < 2; ++n) \
        acc[ai][bj][m][n] = __builtin_amdgcn_mfma_scale_f32_16x16x128_f8f6f4(Bt[n], At[m], acc[ai][bj][m][n], 0, 0, 0, 0, 0, 0); __builtin_amdgcn_s_setprio(0); } while (0)
#define PG8_WAIT_V(n) asm volatile("s_waitcnt vmcnt(" #n ")" ::: "memory")
#define PG8_WAIT_L(n) asm volatile("s_waitcnt lgkmcnt(" #n ")" ::: "memory")
#define PG8_BAR __builtin_amdgcn_s_barrier()
#define PG8_SCHED __builtin_amdgcn_sched_barrier(0)
    Unit cur, nxt; int ui = 0;
    if (!S.next(0, cur)) return;
    f32x4 acc[2][2][4][2];
#pragma unroll
    for (int a = 0; a < 2; ++a)
#pragma unroll
        for (int b = 0; b < 2; ++b)
#pragma unroll
            for (int m = 0; m < 4; ++m)
#pragma unroll
                for (int n = 0; n < 2; ++n) acc[a][b][m][n] = (f32x4){0.f, 0.f, 0.f, 0.f};
    i32x8_t At[4], B0[2], B1[2];
    const __amdgpu_buffer_rsrc_t rA = __builtin_amdgcn_make_buffer_rsrc((void*)g.A, (short)0, -1, 0x00020000), rB = __builtin_amdgcn_make_buffer_rsrc((void*)g.Bt, (short)0, -1, 0x00020000);
    unsigned cA = g.same ? 0u : (unsigned)cur.pm * tstep, cB = g.same ? 0u : (unsigned)cur.pn * tstep;
    S.a_ready(cur);
    if constexpr (SP2) {
        PG8_STAGE(PG8_SB(0, 0), rB, cB, voffB); PG8_STAGE(PG8_SB(0, 1), rB, cB + hstep, voffB); PG8_STAGE(PG8_SA(0, 0), rA, cA, voffA); PG8_STAGE(PG8_SA(0, 1), rA, cA + hstep, voffA);
        if (wr == 1) PG8_BAR;
        PG8_WAIT_V(2); PG8_BAR;
        PG8_STAGE(PG8_SB(1, 0), rB, cB + kstep, voffB); PG8_STAGE(PG8_SA(1, 0), rA, cA + kstep, voffA); PG8_STAGE(PG8_SB(1, 1), rB, cB + hstep + kstep, voffB);
        PG8_WAIT_V(6); PG8_BAR;
    } else {
        PG8_STAGE(PG8_SB(0, 0), rB, cB, voffB); PG8_STAGE(PG8_SA(0, 0), rA, cA, voffA); PG8_STAGE(PG8_SB(0, 1), rB, cB + hstep, voffB); PG8_STAGE(PG8_SA(0, 1), rA, cA + hstep, voffA);
        if (wr == 1) PG8_BAR;
        PG8_WAIT_V(4); PG8_BAR;
        PG8_STAGE(PG8_SB(1, 0), rB, cB + kstep, voffB); PG8_STAGE(PG8_SA(1, 0), rA, cA + kstep, voffA); PG8_STAGE(PG8_SB(1, 1), rB, cB + hstep + kstep, voffB);
        PG8_WAIT_V(6); PG8_BAR;
    }
    for (;;) {
        const bool has_next = S.next(ui + 1, nxt);
        const unsigned nA = (has_next && !g.same) ? (unsigned)nxt.pm * tstep : cA, nB = (has_next && !g.same) ? (unsigned)nxt.pn * tstep : cB;
        for (int t = 0; t < nt; t += 2) {
            const bool last = (t == nt - 2);
            const unsigned a1 = cA + (unsigned)(t + 1) * kstep;
            const unsigned a2 = last ? nA : cA + (unsigned)(t + 2) * kstep, b2 = last ? nB : cB + (unsigned)(t + 2) * kstep;
            const unsigned a3 = a2 + kstep, b3 = b2 + kstep;
            if (last && has_next) S.a_ready(nxt);
            if constexpr (Epi::PREFETCH) { if (t == 0) E.prefetch(cur, lds + PG8_PRM_OFF + (ui & 1) * 4096, wid); }
            if constexpr (SP2) {
            PG8_LDB(B0, 0, 0); PG8_LDB(B1, 0, 1); PG8_SCHED; PG8_LDA(At, 0, 0); PG8_STAGE(PG8_SA(1, 1), rA, a1 + hstep, voffA);
            PG8_WAIT_V(8); PG8_WAIT_L(0); PG8_BAR; PG8_MMA(0, 0, At, B0); PG8_MMA(0, 1, At, B1); PG8_BAR; PG8_SCHED;
            PG8_LDA(At, 0, 1); PG8_STAGE(PG8_SB(0, 0), rB, b2, voffB); PG8_STAGE(PG8_SB(0, 1), rB, b2 + hstep, voffB); PG8_STAGE(PG8_SA(0, 0), rA, a2, voffA);
            PG8_WAIT_V(8); PG8_WAIT_L(0); PG8_BAR; PG8_MMA(1, 0, At, B0); PG8_MMA(1, 1, At, B1); PG8_BAR; PG8_SCHED;
            PG8_LDB(B0, 1, 0); PG8_LDB(B1, 1, 1); PG8_SCHED; PG8_LDA(At, 1, 0); PG8_STAGE(PG8_SA(0, 1), rA, a2 + hstep, voffA);
            PG8_WAIT_V(8); PG8_WAIT_L(0); PG8_BAR; PG8_MMA(0, 0, At, B0); PG8_MMA(0, 1, At, B1); PG8_BAR; PG8_SCHED;
            PG8_LDA(At, 1, 1); PG8_STAGE(PG8_SB(1, 0), rB, b3, voffB); PG8_STAGE(PG8_SB(1, 1), rB, b3 + hstep, voffB); PG8_STAGE(PG8_SA(1, 0), rA, a3, voffA);
            PG8_WAIT_V(8); PG8_WAIT_L(0); PG8_BAR; PG8_MMA(1, 0, At, B0); PG8_MMA(1, 1, At, B1); PG8_BAR; PG8_SCHED;
            } else {
            PG8_LDB(B0, 0, 0); PG8_SCHED; PG8_LDA(At, 0, 0); PG8_STAGE(PG8_SA(1, 1), rA, a1 + hstep, voffA);
            PG8_WAIT_L(8); PG8_BAR; PG8_WAIT_L(0); PG8_MMA(0, 0, At, B0); PG8_BAR; PG8_SCHED;
            PG8_LDB(B1, 0, 1); PG8_STAGE(PG8_SB(0, 0), rB, b2, voffB);
            PG8_BAR; PG8_WAIT_L(0); PG8_MMA(0, 1, At, B1); PG8_BAR;
            PG8_LDA(At, 0, 1); PG8_STAGE(PG8_SA(0, 0), rA, a2, voffA);
            PG8_BAR; PG8_WAIT_L(0); PG8_MMA(1, 0, At, B0); PG8_BAR; PG8_SCHED;
            PG8_STAGE(PG8_SB(0, 1), rB, b2 + hstep, voffB);
            PG8_WAIT_V(6); PG8_BAR; PG8_MMA(1, 1, At, B1); PG8_BAR;
            PG8_LDB(B0, 1, 0); PG8_SCHED; PG8_LDA(At, 1, 0); PG8_STAGE(PG8_SA(0, 1), rA, a2 + hstep, voffA);
            PG8_WAIT_L(8); PG8_BAR; PG8_WAIT_L(0); PG8_MMA(0, 0, At, B0); PG8_BAR; PG8_SCHED;
            PG8_LDB(B1, 1, 1); PG8_STAGE(PG8_SB(1, 0), rB, b3, voffB);
            PG8_BAR; PG8_WAIT_L(0); PG8_MMA(0, 1, At, B1); PG8_BAR;
            PG8_LDA(At, 1, 1); PG8_STAGE(PG8_SA(1, 0), rA, a3, voffA);
            PG8_BAR; PG8_WAIT_L(0); PG8_MMA(1, 0, At, B0); PG8_BAR; PG8_SCHED;
            PG8_STAGE(PG8_SB(1, 1), rB, b3 + hstep, voffB);
            PG8_WAIT_V(6); PG8_BAR; PG8_MMA(1, 1, At, B1); PG8_BAR;
            }
        }
        if constexpr (ALIGN_EPI) { if (wr == 0) PG8_BAR; }
        if constexpr (!Epi::AFTER_DRAIN) { int ln_ = (int)__builtin_amdgcn_mbcnt_hi(~0u, __builtin_amdgcn_mbcnt_lo(~0u, 0u)); asm volatile("" : "+v"(ln_));
            E(acc, cur, wr, wc, ln_ & 15, ln_ >> 4, lds + PG8_PRM_OFF + (ui & 1) * 4096); S.done(cur); }
        if (!has_next) break;
#pragma unroll
        for (int a = 0; a < 2; ++a)
#pragma unroll
            for (int b = 0; b < 2; ++b)
#pragma unroll
                for (int m = 0; m < 4; ++m)
#pragma unroll
                    for (int n = 0; n < 2; ++n) acc[a][b][m][n] = (f32x4){0.f, 0.f, 0.f, 0.f};
        cur = nxt; cA = nA; cB = nB; ++ui;
        if constexpr (ALIGN_EPI) { if (wr == 1) PG8_BAR; }
    }
    PG8_WAIT_V(0);
    if constexpr (!ALIGN_EPI) { if (wr == 0) PG8_BAR; }
    PG8_BAR;
    if constexpr (Epi::AFTER_DRAIN) { E.fused(acc, cur, wr, wc, fr, fq, lds, wid, lane); S.done(cur); }
#undef PG8_SA
#undef PG8_SB
#undef PG8_STAGE
#undef PG8_LDA
#undef PG8_LDB
#undef PG8_MMA
#undef PG8_WAIT_V
#undef PG8_WAIT_L
#undef PG8_BAR
#undef PG8_SCHED
#undef PG8_F8CAT
}
}

constexpr int NWAVES = 8, NTHR = NWAVES * 64;
constexpr int BATCH = 8, SEQ = 2048, DM = 2048, DEPTH = 2, HD = 64, GW = 512, NH = 8;
constexpr int M = BATCH * SEQ;
constexpr int NPROJ = 6080, NPROJ_P = 6144, DFF = 5632;
constexpr int CA_Q = 0, CA_K = 512, CA_V = 1024, CB_U = 1536, CB_V = 2048, CC_Q = 2560, CC_K = 3072, CC_V = 3584, CD = 4096;
constexpr int D_R = 0, D_WD = 512, D_K = 608, D_V = 1120, D_AD = 1632, D_GD = 1728, D_W = 1984;
constexpr float NORM_EPS = 1e-6f;
#ifndef N_LAUNCH_MODE
#define N_LAUNCH_MODE 0
#endif
#ifndef PG8_SP2
#define PG8_SP2 true
#endif
#ifndef FFN_FP8
#define FFN_FP8 1
#endif
#ifndef REPEAT
#define REPEAT 0
#endif
#ifndef GEMM_I8
#define GEMM_I8 3
#endif
#ifndef BFMASK
#define BFMASK 0x003C0Fu
#endif
#ifndef FFN1_I8
#define FFN1_I8 1
#endif
#define I8_IN ((GEMM_I8 & 1) != 0)
#define I8_OUT ((GEMM_I8 & 2) != 0)
constexpr int N_PHASES = 20;

constexpr size_t MiB = 1u << 20;
constexpr size_t WS_CTL = 0, CTL_ZERO_BYTES = 2 * MiB;
constexpr size_t WS_WIN = 2 * MiB, WS_WOUT = 26 * MiB, WS_WGU = 34 * MiB, WS_WDN = 78 * MiB, WS_SMALL = 100 * MiB;
constexpr size_t WS_XB = 104 * MiB, WS_PROJ = 168 * MiB, WS_YCAT = 360 * MiB, WS_SC2 = 424 * MiB, WS_YD = 456 * MiB, WS_G = 488 * MiB, WS_BC = 504 * MiB, WS_END = 506 * MiB;
constexpr size_t WS_XQ = WS_YD, WS_YQ = WS_PROJ;
constexpr size_t SC_ARR = (size_t)M * GW * 2;
constexpr size_t SM_TB = 0;
constexpr size_t SM_KBAR = 64 * 1024;
constexpr size_t SM_STATS = 256 * 1024;
constexpr size_t SM_SAX = 2048 * 1024, SM_SAY = SM_SAX + 64 * 1024;
constexpr size_t SM_SWIN = SM_SAY + 64 * 1024, SM_SWOUT = SM_SWIN + 32 * 1024, SM_SWGU = SM_SWOUT + 16 * 1024;
constexpr size_t SM_BIAS = 3072 * 1024;
constexpr size_t SM_WT = 1024 * 1024;
constexpr int CW_BAR = 4096;
constexpr int CW_Q = 8192;
constexpr int CW_SSQ = 65536;
constexpr size_t CTL_KBAR = 1024 * 1024;
constexpr size_t CTL_STATS = 1280 * 1024;
static_assert((size_t)CW_SSQ * 4 + 5 * (size_t)M * 8 <= CTL_KBAR && CTL_STATS + 2 * (size_t)M * 2 * 8 <= CTL_ZERO_BYTES, "CTL");

constexpr int RING_OFF = 0, RING_BYTES = 131072;
constexpr int LDS_BYTES = 163840, MISC_OFF = LDS_BYTES - 256;

#define GAS __attribute__((address_space(1)))
#define LAS __attribute__((address_space(3)))
typedef unsigned short bf16;
typedef unsigned v4u __attribute__((ext_vector_type(4)));
typedef unsigned v2u __attribute__((ext_vector_type(2)));
typedef float f32x4 __attribute__((ext_vector_type(4)));
typedef short bf16x8 __attribute__((ext_vector_type(8)));
typedef float f32x16 __attribute__((ext_vector_type(16)));
typedef GAS unsigned gu32;
#define RLX_AGENT __ATOMIC_RELAXED, __HIP_MEMORY_SCOPE_AGENT
#define LDS_WAIT() asm volatile("s_waitcnt lgkmcnt(0)" ::: "memory")
#define VM_WAIT() asm volatile("s_waitcnt vmcnt(0)" ::: "memory")
__device__ __forceinline__ unsigned f2bf(float f) { unsigned u = __builtin_bit_cast(unsigned, f); return (u + 0x7fffu + ((u >> 16) & 1u)) >> 16; }
__device__ __forceinline__ unsigned pk2(float lo, float hi) { unsigned r; asm("v_cvt_pk_bf16_f32 %0, %1, %2" : "=v"(r) : "v"(lo), "v"(hi)); return r; }
__device__ __forceinline__ float bf2f(unsigned short h) { return __builtin_bit_cast(float, (unsigned)h << 16); }
__device__ __forceinline__ float bflo(unsigned w) { return __builtin_bit_cast(float, w << 16); }
__device__ __forceinline__ float bfhi(unsigned w) { return __builtin_bit_cast(float, w & 0xffff0000u); }
__device__ __forceinline__ float sigmoidf_(float x) { return 1.0f / (1.0f + __expf(-x)); }
__device__ __forceinline__ float gelu_tanh(float x) { const float u = 0.7978845608028654f * (x + 0.044715f * x * x * x); const float e = __expf(2.0f * u); return x - x * __builtin_amdgcn_rcpf(e + 1.0f); }
__device__ __forceinline__ float wave_sum(float v) {
#pragma unroll
    for (int o = 1; o < 64; o <<= 1) v += __shfl_xor(v, o);
    return v;
}

__device__ __forceinline__ float zero_v() { float z = 0.f; asm volatile("" : "+v"(z)); return z; }

__device__ __forceinline__ unsigned q8pack4(float a, float b, float c, float d, float inv) {
    const int ia = (int)__builtin_rintf(a * inv), ib = (int)__builtin_rintf(b * inv), ic = (int)__builtin_rintf(c * inv), id = (int)__builtin_rintf(d * inv);
    return ((unsigned)ia & 0xffu) | (((unsigned)ib & 0xffu) << 8) | (((unsigned)ic & 0xffu) << 16) | ((unsigned)id << 24); }
__device__ __forceinline__ float wave_max(float v) {
#pragma unroll
    for (int o = 1; o < 64; o <<= 1) v = fmaxf(v, __shfl_xor(v, o));
    return v;
}
#define UNPACK8(dst, o, W_) do { dst[(o)] = bflo((W_).x); dst[(o) + 1] = bfhi((W_).x); dst[(o) + 2] = bflo((W_).y); dst[(o) + 3] = bfhi((W_).y); dst[(o) + 4] = bflo((W_).z); dst[(o) + 5] = bfhi((W_).z); dst[(o) + 6] = bflo((W_).w); dst[(o) + 7] = bfhi((W_).w); } while (0)
#define XB_TMO      128
#define XB_XCNT(j)  (256  + 64 * (j))
#define XB_XSUB(j)  (1280 + 64 * (j))
#define XB_XGEN(j)  (2304 + 64 * (j))
#define XB_TOP      3328
#define XB_TOPGEN   3392
#define XCD_BAR_WORDS 3456
#define XB_SPIN_CAP (1u << 18)

__device__ __forceinline__ unsigned xb_ld(unsigned* p)              { return __hip_atomic_load(p, __ATOMIC_RELAXED, __HIP_MEMORY_SCOPE_AGENT); }
__device__ __forceinline__ unsigned xb_add(unsigned* p, unsigned v) { return __hip_atomic_fetch_add(p, v, __ATOMIC_RELAXED, __HIP_MEMORY_SCOPE_AGENT); }
__device__ __forceinline__ unsigned xb_xcc_id() { return (unsigned)__builtin_amdgcn_s_getreg((3 << 11) | 20) & 0xFu; }
#define XB_SPIN(cond, bar) do { unsigned _sp = 0; while (cond) { __builtin_amdgcn_s_sleep(1); \
    if ((++_sp & 255u) == 0u) { if (xb_ld(&(bar)[XB_TMO])) break; if (_sp > XB_SPIN_CAP) { atomicAdd(&(bar)[XB_TMO], 1u); break; } } } } while (0)

struct XcdBarrier {
    unsigned* bar; unsigned x; int wv;
    volatile LAS unsigned* st;
};

__device__ __forceinline__ XcdBarrier xcd_barrier_post(unsigned* bar, volatile LAS unsigned* st, int wv) {
    XcdBarrier b; b.bar = bar; b.x = xb_xcc_id(); b.st = st; b.wv = wv;
    if (wv == 0 && pg8::lane_now() == 0) (void)xb_add(&bar[XB_XCNT(b.x)], 1u);
    return b;
}
__device__ __forceinline__ void xcd_barrier_complete(unsigned* bar, unsigned x, unsigned& nloc, unsigned& nx) {
    const unsigned G = gridDim.x * gridDim.y * gridDim.z;
    unsigned sum, cnt, mine, sp = 0u;
    for (;;) {
        sum = 0u; cnt = 0u; mine = 0u;
#pragma unroll
        for (unsigned j = 0; j < 16; ++j) { const unsigned c = xb_ld(&bar[XB_XCNT(j)]); sum += c; cnt += (c > 0u) ? 1u : 0u; mine = (j == x) ? c : mine; }
        if (sum == G) break;
        __builtin_amdgcn_s_sleep(1);
        if ((++sp & 255u) == 0u) { if (xb_ld(&bar[XB_TMO])) break; if (sp > XB_SPIN_CAP) { atomicAdd(&bar[XB_TMO], 1u); break; } }
    }
    nloc = mine > 0u ? mine : 1u; nx = cnt > 0u ? cnt : 1u;
}

__device__ __forceinline__ void xcd_barrier(const XcdBarrier& b) {
    asm volatile("s_waitcnt vmcnt(0)" ::: "memory");
    __syncthreads();
    if (b.wv == 0 && pg8::lane_now() == 0) {
        unsigned* bar = b.bar;
        __builtin_amdgcn_s_waitcnt(0);
        unsigned nloc = b.st[0], nx = b.st[1];
        if (nloc == 0u) { xcd_barrier_complete(bar, b.x, nloc, nx); b.st[0] = nloc; b.st[1] = nx; }
        const unsigned old = xb_add(&bar[XB_XSUB(b.x)], 1u);
        const unsigned gen = old / nloc;
        if (old + 1u == (gen + 1u) * nloc) {
            __builtin_amdgcn_fence(__ATOMIC_RELEASE, "agent");
            asm volatile("s_waitcnt vmcnt(0)" ::: "memory");
            const unsigned og = xb_add(&bar[XB_TOP], 1u);
            const unsigned tg = og / nx;
            if (og + 1u == (tg + 1u) * nx) xb_add(&bar[XB_TOPGEN], 1u);
            else XB_SPIN(xb_ld(&bar[XB_TOPGEN]) == tg, bar);
            __builtin_amdgcn_fence(__ATOMIC_ACQUIRE, "agent");
            xb_add(&bar[XB_XGEN(b.x)], 1u);
            asm volatile("s_waitcnt vmcnt(0)" ::: "memory");
        } else {
            XB_SPIN(xb_ld(&bar[XB_XGEN(b.x)]) == gen, bar);
            __builtin_amdgcn_fence(__ATOMIC_ACQUIRE, "agent");
            asm volatile("s_waitcnt vmcnt(0)" ::: "memory");
        }
    }
    __syncthreads();
}

struct Args { const float* in[25]; float* out; unsigned char* ws; int ph_lo, ph_hi; };
struct Frame {
    LAS unsigned char* lds; int tid, lane, wave, G, vcu, gw, ngw;
};
typedef const __attribute__((address_space(4))) unsigned long long* karg_t;
__device__ __forceinline__ karg_t kargs() { karg_t ka = (karg_t)__builtin_amdgcn_kernarg_segment_ptr(); asm volatile("" : "+s"(ka)); return ka; }
__device__ __forceinline__ const float* inp(int i) { return (const float*)(const GAS float*)kargs()[i]; }
__device__ __forceinline__ float* outp() { return (float*)(GAS float*)kargs()[25]; }
__device__ __forceinline__ unsigned char* wsp() { return (unsigned char*)(GAS unsigned char*)kargs()[26]; }
__device__ __forceinline__ gu32* ctlp() { return (gu32*)(wsp() + WS_CTL); }

__device__ __forceinline__ void conv_item(const float* W, int K, int N, const float* g, bf16* WT, int kind, LAS float* scr, int item, int lane, int ncols = 0) {
    const int nblk = (ncols ? ncols : N) / 32, kb = item / nblk, nb = item % nblk, k0 = 64 * kb, n0 = 32 * nb;
    float ld[32];
    { const float* wp = W + (size_t)(k0 + (lane >> 5)) * N + n0 + (lane & 31);
#pragma unroll
      for (int i = 0; i < 32; ++i) ld[i] = wp[(size_t)(2 * i) * N]; }
    if (g) { const float* gp = g + k0 + (lane >> 5);
#pragma unroll
      for (int i = 0; i < 32; ++i) ld[i] *= gp[2 * i]; }
#pragma unroll
    for (int i = 0; i < 32; ++i) scr[(2 * i + (lane >> 5)) * 33 + (lane & 31)] = ld[i];
    LDS_WAIT(); asm volatile("" ::: "memory");
    const int c = lane & 7;
#pragma unroll
    for (int j = 0; j < 4; ++j) { const int n = (lane >> 3) + 8 * j; const LAS float* s = scr + (8 * c) * 33 + n;
        v4u o; o.x = pk2(s[0 * 33], s[1 * 33]); o.y = pk2(s[2 * 33], s[3 * 33]); o.z = pk2(s[4 * 33], s[5 * 33]); o.w = pk2(s[6 * 33], s[7 * 33]);
        const int nn = n0 + n;
        if (kind >= 3) {
            const int row = kind == 5 ? nn : ((nn >> 7) * 256 + (kind - 3) * 128 + (nn & 127)); int f0 = (int)o.x, f1 = (int)o.y;
            f0 = __builtin_amdgcn_cvt_pk_fp8_f32(64.f * s[0 * 33], 64.f * s[1 * 33], f0, false); f0 = __builtin_amdgcn_cvt_pk_fp8_f32(64.f * s[2 * 33], 64.f * s[3 * 33], f0, true);
            f1 = __builtin_amdgcn_cvt_pk_fp8_f32(64.f * s[4 * 33], 64.f * s[5 * 33], f1, false); f1 = __builtin_amdgcn_cvt_pk_fp8_f32(64.f * s[6 * 33], 64.f * s[7 * 33], f1, true);
            *(GAS v2u*)((unsigned char*)WT + (size_t)row * K + k0 + 8 * c) = (v2u){(unsigned)f0, (unsigned)f1};
        } else {
        const int row = kind == 0 ? nn : ((nn >> 7) * 256 + (kind - 1) * 128 + (nn & 127));
        *(GAS v4u*)(WT + (size_t)row * K + k0 + 8 * c) = o; } }
    LDS_WAIT(); asm volatile("" ::: "memory");
}
__device__ __forceinline__ void conv_cols_i8(const float* W, int K, int N, const float* g, unsigned char* WQ, float* SW, int nb, Frame& F, int orow0 = -1) {
    constexpr int CC_PITCH = 2 * DM + 16;
    LAS unsigned char* T = F.lds + RING_OFF; LAS float* red = (LAS float*)(F.lds + RING_OFF + 32 * CC_PITCH);
    static_assert(32 * CC_PITCH + 1024 <= MISC_OFF, "conv LDS");
    const int n0 = 32 * nb, lane = F.lane, nkb = K / 64, o0 = orow0 < 0 ? n0 : orow0;
    const float* wp0 = W + (size_t)(lane >> 5) * N + n0 + (lane & 31);
    float mx = 0.f;
    for (int kb = F.wave; kb < nkb; kb += NWAVES) {
        const float* wp = wp0 + (size_t)(64 * kb) * N; const float* gp = g + 64 * kb + (lane >> 5);
        float ld[32];
#pragma unroll
        for (int i = 0; i < 32; ++i) ld[i] = wp[(size_t)(2 * i) * N];
        LAS unsigned char* tp = T + (lane & 31) * CC_PITCH + 2 * (64 * kb + (lane >> 5));
#pragma unroll
        for (int i = 0; i < 32; ++i) { const unsigned h = f2bf(ld[i] * gp[2 * i]); mx = fmaxf(mx, fabsf(__builtin_bit_cast(float, h << 16))); *(LAS unsigned short*)(tp + 4 * i) = (unsigned short)h; }
    }
    mx = fmaxf(mx, __shfl_xor(mx, 32));
    if (lane < 32) red[F.wave * 32 + lane] = mx;
    __syncthreads();
#pragma unroll
    for (int j = 0; j < 4; ++j) { const int n = 4 * F.wave + j;
        float cm = 0.f;
#pragma unroll
        for (int w = 0; w < NWAVES; ++w) cm = fmaxf(cm, red[w * 32 + n]);
        const float inv = cm > 0.f ? 127.0f / cm : 0.f;
        if (lane == 0) SW[o0 + n] = cm * (1.0f / 127.0f);
        const LAS unsigned char* tr = T + n * CC_PITCH + 16 * lane; unsigned char* wq = WQ + (size_t)(o0 + n) * K + 8 * lane;
#pragma unroll
        for (int it = 0; it < 4; ++it) { const v4u w = *(const LAS v4u*)(tr + 1024 * it);
            *(GAS v2u*)(wq + 512 * it) = (v2u){q8pack4(bflo(w.x), bfhi(w.x), bflo(w.y), bfhi(w.y), inv), q8pack4(bflo(w.z), bfhi(w.z), bflo(w.w), bfhi(w.w), inv)}; }
    }
    __syncthreads();
}
__device__ __forceinline__ void conv_layer_items(Frame& F, int l, int gw, int ngw, bool do_in, bool do_rest) {
    LAS float* scr = (LAS float*)(F.lds + RING_OFF + F.wave * 16384);
    constexpr int I_IN = (DM / 64) * (NPROJ / 32), I_OUT = (DM / 64) * (DM / 32), I_G = (DM / 64) * (DFF / 32), I_D = (DFF / 64) * (DM / 32);
    const float* w_in = inp(2) + (size_t)l * DM * NPROJ; const float* w_out = inp(19) + (size_t)l * DM * DM;
    const float* w_g = inp(21) + (size_t)l * DM * DFF; const float* w_u = inp(22) + (size_t)l * DM * DFF; const float* w_d = inp(23) + (size_t)l * DFF * DM;
    const float* g_mix = inp(1) + l * DM; const float* g_br = inp(18) + l * DM; const float* g_ffn = inp(20) + l * DM;
    bf16* WIN = (bf16*)(wsp() + WS_WIN); bf16* WOUT = (bf16*)(wsp() + WS_WOUT); bf16* WGU = (bf16*)(wsp() + WS_WGU); bf16* WDN = (bf16*)(wsp() + WS_WDN);
    if (do_in) {
        for (int it = gw; it < I_IN; it += ngw) conv_item(w_in, DM, NPROJ, g_mix, WIN, 0, scr, it, F.lane);
    }
    if (do_rest) {
        for (int it = gw; it < (I8_OUT ? 0 : I_OUT) + (FFN1_I8 ? 0 : 2 * I_G) + I_D; it += ngw) {
            int r = it + (I8_OUT ? I_OUT : 0); if (FFN1_I8 && r >= I_OUT) r += 2 * I_G;
            if (r < I_OUT) { conv_item(w_out, DM, DM, g_br, WOUT, 0, scr, r, F.lane); continue; } r -= I_OUT;
            if (r < I_G) { conv_item(w_g, DM, DFF, g_ffn, WGU, FFN_FP8 ? 3 : 1, scr, r, F.lane); continue; } r -= I_G;
            if (r < I_G) { conv_item(w_u, DM, DFF, g_ffn, WGU, FFN_FP8 ? 4 : 2, scr, r, F.lane); continue; } r -= I_G;
            conv_item(w_d, DFF, DM, nullptr, WDN, FFN_FP8 ? 5 : 0, scr, r, F.lane);
        }
    }
}

constexpr int WINB_NB = 8 * __builtin_popcount(BFMASK), WINB_ITEMS = (DM / 64) * WINB_NB;
__device__ __forceinline__ bf16* winb_ptr() { return (bf16*)outp() + (size_t)6 * M * GW; }
__device__ __forceinline__ void conv_winb(Frame& F, int l, int item) {
    if (item >= WINB_ITEMS) return;
    const int kb = item / (WINB_NB ? WINB_NB : 1), r = item % (WINB_NB ? WINB_NB : 1); unsigned m = BFMASK; for (int j = 0; j < (r >> 3); ++j) m &= m - 1;
    conv_item(inp(2) + (size_t)l * DM * NPROJ, DM, NPROJ, inp(1) + l * DM, winb_ptr(), 0, (LAS float*)(F.lds + RING_OFF + F.wave * 16384), kb * (NPROJ / 32) + __builtin_ctz(m) * 8 + (r & 7), F.lane);
}
__device__ __forceinline__ void ph_prologue(Frame& F) {
    if (I8_IN) {
        for (int nb = blockIdx.x; nb < NPROJ / 32; nb += F.G) conv_cols_i8(inp(2), DM, NPROJ, inp(1), wsp() + WS_WIN, (float*)(wsp() + WS_SMALL + SM_SWIN), nb, F);
        unsigned char* WIN = wsp() + WS_WIN; float* SWIN = (float*)(wsp() + WS_SMALL + SM_SWIN);
        for (int i = F.gw * 64 + F.lane; i < 64 * DM / 16; i += F.ngw * 64) *(GAS v4u*)(WIN + (size_t)NPROJ * DM + (size_t)i * 16) = (v4u){0u, 0u, 0u, 0u};
        if (blockIdx.x == 0 && F.tid < NPROJ_P - NPROJ) SWIN[NPROJ + F.tid] = 0.f;
        for (int it = F.gw; it < WINB_ITEMS; it += F.ngw) conv_winb(F, 0, it);
    } else {
    conv_layer_items(F, 0, F.gw, F.ngw, true, false);
    { bf16* WIN = (bf16*)(wsp() + WS_WIN);
      for (int i = F.gw * 64 + F.lane; i < 64 * DM / 8; i += F.ngw * 64) *(GAS v4u*)(WIN + (size_t)NPROJ * DM + (size_t)i * 8) = (v4u){0u, 0u, 0u, 0u}; } }
    if (blockIdx.x == 0) {
        int* TB = (int*)(wsp() + WS_SMALL + SM_TB);
        for (int d = F.tid; d < 2049; d += NTHR) {
            int bkt = d;
            if (d >= 16) bkt = 16 + (d >= 22) + (d >= 30) + (d >= 40) + (d >= 54) + (d >= 73) + (d >= 99) + (d >= 134) + (d >= 182) + (d >= 246) + (d >= 332) + (d >= 450) + (d >= 609) + (d >= 825) + (d >= 1117) + (d >= 1513);
            TB[d] = bkt;
        }
    }
    if (blockIdx.x >= 1 && blockIdx.x <= 16) {
        const int hcol = blockIdx.x - 1; float* BT = (float*)(wsp() + WS_SMALL + SM_BIAS) + hcol * 2048; const float* pb = inp(3);
        for (int d = F.tid; d < 2048; d += NTHR) {
            int bkt = d;
            if (d >= 16) bkt = 16 + (d >= 22) + (d >= 30) + (d >= 40) + (d >= 54) + (d >= 73) + (d >= 99) + (d >= 134) + (d >= 182) + (d >= 246) + (d >= 332) + (d >= 450) + (d >= 609) + (d >= 825) + (d >= 1117) + (d >= 1513);
            BT[d] = pb[bkt * 16 + hcol] * 1.4426950408889634f;
        }
    }
    { bf16* WT = (bf16*)(wsp() + WS_SMALL + SM_WT); const float* w2 = inp(9); const float* a2 = inp(11); const float* g2 = inp(12);
      for (int idx = blockIdx.x * NTHR + F.tid; idx < DEPTH * 448 * GW; idx += F.G * NTHR) {
          const int c = idx % GW, k = (idx / GW) % 448, l = idx / (GW * 448);
          const float v = k < 96 ? w2[((size_t)l * 96 + k) * GW + c] : (k < 192 ? a2[((size_t)l * 96 + (k - 96)) * GW + c] : g2[((size_t)l * 256 + (k - 192)) * GW + c]);
          const int r32_ = c & 31, hct = c >> 5, ks_ = k >> 4, hh_ = (k >> 3) & 1;
          WT[(size_t)l * GW * 448 + (((size_t)hct * 28 + ks_) * 64 + 32 * hh_ + r32_) * 8 + (k & 7)] = (bf16)f2bf(v); } }
    const float* x = inp(0); bf16* XB = (bf16*)(wsp() + WS_XB); pg8::fx_t* ssq = (pg8::fx_t*)(ctlp() + CW_SSQ);
    for (int m = F.gw; m < M; m += F.ngw) {
        const GAS f32x4* xr = (const GAS f32x4*)(x + (size_t)m * DM) + F.lane; GAS v2u* o = (GAS v2u*)(XB + (size_t)m * DM) + F.lane; float s = 0.f;
#pragma unroll
        for (int j = 0; j < 8; ++j) { const f32x4 v = xr[64 * j]; s += (v.x * v.x + v.y * v.y) + (v.z * v.z + v.w * v.w); o[64 * j] = (v2u){pk2(v.x, v.y), pk2(v.z, v.w)}; }
        s = wave_sum(s); if (F.lane == 0) pg8::fx_add(ssq + m, s);
        if (I8_IN) {
            float mx = 0.f;
#pragma unroll
            for (int j = 0; j < 8; ++j) { const f32x4 v = xr[64 * j]; mx = fmaxf(fmaxf(mx, fmaxf(fabsf(v.x), fabsf(v.y))), fmaxf(fabsf(v.z), fabsf(v.w))); }
            mx = wave_max(mx); const float inv = mx > 0.f ? 127.0f / mx : 0.f; GAS unsigned* q = (GAS unsigned*)(wsp() + WS_XQ + (size_t)m * DM) + F.lane;
#pragma unroll
            for (int j = 0; j < 8; ++j) { const f32x4 v = xr[64 * j]; q[64 * j] = q8pack4(v.x, v.y, v.z, v.w, inv); }
            if (F.lane == 0) ((float*)(wsp() + WS_SMALL + SM_SAX))[m] = mx * (1.0f / 127.0f);
        }
    }
}

__device__ __forceinline__ void ph_quantx(Frame& F, pg8::fx_t* ssq) {
    const bf16* XB = (const bf16*)(wsp() + WS_XB); unsigned char* XQ = wsp() + WS_XQ; float* SAX = (float*)(wsp() + WS_SMALL + SM_SAX);
    for (int m = F.gw; m < M; m += F.ngw) {
        const GAS v4u* xr = (const GAS v4u*)(XB + (size_t)m * DM) + F.lane; v4u w[4]; float mx = 0.f;
#pragma unroll
        for (int j = 0; j < 4; ++j) w[j] = xr[64 * j];
        float sq = 0.f;
#pragma unroll
        for (int j = 0; j < 4; ++j) { const float e8[8] = {bflo(w[j].x), bfhi(w[j].x), bflo(w[j].y), bfhi(w[j].y), bflo(w[j].z), bfhi(w[j].z), bflo(w[j].w), bfhi(w[j].w)};
#pragma unroll
            for (int e = 0; e < 8; ++e) sq += e8[e] * e8[e]; }
        sq = wave_sum(sq);
#pragma unroll
        for (int j = 0; j < 4; ++j) { mx = fmaxf(fmaxf(mx, fmaxf(fabsf(bflo(w[j].x)), fabsf(bfhi(w[j].x)))), fmaxf(fabsf(bflo(w[j].y)), fabsf(bfhi(w[j].y))));
            mx = fmaxf(fmaxf(mx, fmaxf(fabsf(bflo(w[j].z)), fabsf(bfhi(w[j].z)))), fmaxf(fabsf(bflo(w[j].w)), fabsf(bfhi(w[j].w)))); }
        mx = wave_max(mx); const float inv = mx > 0.f ? 127.0f / mx : 0.f; GAS v2u* q = (GAS v2u*)(XQ + (size_t)m * DM) + F.lane;
#pragma unroll
        for (int j = 0; j < 4; ++j) q[64 * j] = (v2u){q8pack4(bflo(w[j].x), bfhi(w[j].x), bflo(w[j].y), bfhi(w[j].y), inv), q8pack4(bflo(w[j].z), bfhi(w[j].z), bflo(w[j].w), bfhi(w[j].w), inv)};
        if (F.lane == 0) { SAX[m] = mx * (1.0f / 127.0f); ssq[m] = (pg8::fx_t)(long long)__float2ll_rn(sq * 1073741824.0f); }
    }
}

constexpr int PR_PITCH = 912;
constexpr int PR_PRM_OFF = 32768, PR_MUA_OFF = PR_PRM_OFF + 8 * 512 * 4;
__device__ __forceinline__ float fast_tanh(float x) { return 1.0f - 2.0f * __builtin_amdgcn_rcpf(__expf(2.0f * x) + 1.0f); }
__device__ __forceinline__ float fast_sigmoid(float x) { return __builtin_amdgcn_rcpf(1.0f + __expf(-x)); }
constexpr int PR_OT_OFF = 51200, PR_OT_PITCH = 72, PR_OT_TILE = 32 * PR_OT_PITCH, PR_OT_WAVE = 6 * PR_OT_TILE;
static_assert(PR_OT_OFF + 8 * PR_OT_WAVE <= MISC_OFF, "prep LDS");
__device__ __forceinline__ void ph_prep(Frame& F, int l) {
    const bf16* PROJ = (const bf16*)(wsp() + WS_PROJ);
    bf16* R_ = (bf16*)outp();
    bf16* E_ = R_ + (size_t)M * GW; bf16* KP_ = E_ + (size_t)M * GW; bf16* V_ = KP_ + (size_t)M * GW;
    bf16* KK_ = (bf16*)outp() + (size_t)4 * M * GW; bf16* AS_ = KK_ + (size_t)M * GW; bf16* G_ = (bf16*)(wsp() + WS_G); float* BC = (float*)(wsp() + WS_BC);
    const bf16* WT = (const bf16*)(wsp() + WS_SMALL + SM_WT) + (size_t)l * GW * 448;
    LAS unsigned char* actL = F.lds + RING_OFF; LAS float* PRM = (LAS float*)(F.lds + PR_PRM_OFF); LAS float* MUA = (LAS float*)(F.lds + PR_MUA_OFF);
    { const float* mu = inp(7) + l * D_W; const float* w0 = inp(8) + l * GW; const float* a0 = inp(10) + l * GW; const float* k_k = inp(13) + l * GW; const float* k_a = inp(14) + l * GW; const float* r_k = inp(15) + l * GW;
      const int c = F.tid;
      PRM[c] = mu[D_R + c]; PRM[512 + c] = mu[D_K + c]; PRM[1024 + c] = mu[D_V + c]; PRM[1536 + c] = w0[c]; PRM[2048 + c] = a0[c]; PRM[2560 + c] = k_k[c]; PRM[3072 + c] = k_a[c]; PRM[3584 + c] = r_k[c];
      if (c < 448) MUA[c] = mu[c < 96 ? D_WD + c : (c < 192 ? D_AD + (c - 96) : D_GD + (c - 192))]; }
    __syncthreads();
    const int h = F.wave;
    for (int it = blockIdx.x; it < M / 32; it += F.G) {
        const int m0 = it * 32;
        int tid_ = F.wave * 64 + pg8::lane_now(); asm volatile("" : "+v"(tid_));
        const int tid = tid_, r32 = tid & 31, hh = (tid >> 5) & 1, lane = tid & 63;
        LAS unsigned char* OT = F.lds + PR_OT_OFF + h * PR_OT_WAVE;
        { v2u pc[7], pp[7];
#pragma unroll
          for (int i = 0; i < 7; ++i) { const int gi = tid + NTHR * i, t = gi / 112, k = 4 * (gi % 112), m = m0 + t;
              const int col = k < 96 ? D_WD + k : (k < 192 ? D_AD + (k - 96) : D_GD + (k - 192)); const bf16* src = PROJ + (size_t)m * NPROJ_P + CD + col;
              pc[i] = *(const GAS v2u*)src; pp[i] = (v2u){0u, 0u}; if ((m % SEQ) > 0) pp[i] = *(const GAS v2u*)(src - NPROJ_P); }
#pragma unroll
          for (int i = 0; i < 7; ++i) { const int gi = tid + NTHR * i, t = gi / 112, k = 4 * (gi % 112);
              const f32x4 mv = *(const LAS f32x4*)(MUA + k);
              float x[4] = {bflo(pc[i].x), bfhi(pc[i].x), bflo(pc[i].y), bfhi(pc[i].y)}; const float xp[4] = {bflo(pp[i].x), bfhi(pp[i].x), bflo(pp[i].y), bfhi(pp[i].y)};
#pragma unroll
              for (int e = 0; e < 4; ++e) { x[e] += (xp[e] - x[e]) * mv[e]; x[e] = k < 96 ? fast_tanh(x[e]) : (k < 192 ? x[e] : fast_sigmoid(x[e])); }
              *(LAS v2u*)(actL + t * PR_PITCH + 2 * k) = (v2u){pk2(x[0], x[1]), pk2(x[2], x[3])}; } }
        __syncthreads();
        const int m = m0 + r32; const bool has_prev = (m % SEQ) > 0;
        const bf16* pr = PROJ + (size_t)m * NPROJ_P + CD; const bf16* pq = pr - NPROJ_P;
        const LAS unsigned char* bp = actL + r32 * PR_PITCH + 16 * hh;
        float kkv[2][16]; float n2 = 0.f, bcv = 0.f;
#pragma unroll
        for (int ct = 0; ct < 2; ++ct) {
            const int cb = 64 * h + 32 * ct + 4 * hh;
            v4u xc[3][2], xp[3][2];
#pragma unroll
            for (int a = 0; a < 3; ++a)
#pragma unroll
                for (int i = 0; i < 2; ++i) { const int mm = m0 + (lane >> 2) + 16 * i; const bf16* src = PROJ + (size_t)mm * NPROJ_P + CD + (a == 0 ? D_R : (a == 1 ? D_K : D_V)) + 64 * h + 32 * ct + 8 * (lane & 3);
                    xc[a][i] = *(const GAS v4u*)src; xp[a][i] = (v4u){0u, 0u, 0u, 0u}; if ((mm % SEQ) > 0) xp[a][i] = *(const GAS v4u*)(src - NPROJ_P); }
            f32x16 aW, aA, aG;
            { const float z_ = zero_v();
#pragma unroll
            for (int i = 0; i < 16; ++i) { aW[i] = z_; aA[i] = z_; aG[i] = z_; } }
            const bf16* wt0 = WT + ((size_t)(2 * h + ct) * 28 * 64 + lane) * 8;
#pragma unroll
            for (int grp = 0; grp < 4; ++grp) {
                bf16x8 af[7];
#pragma unroll
                for (int q = 0; q < 7; ++q) af[q] = *(const GAS bf16x8*)(wt0 + 512 * (7 * grp + q));
#pragma unroll
                for (int q = 0; q < 7; ++q) { const int ks = 7 * grp + q; const bf16x8 bfr = *(const LAS bf16x8*)(bp + 32 * ks);
                    if (ks < 6) aW = __builtin_amdgcn_mfma_f32_32x32x16_bf16(af[q], bfr, aW, 0, 0, 0);
                    else if (ks < 12) aA = __builtin_amdgcn_mfma_f32_32x32x16_bf16(af[q], bfr, aA, 0, 0, 0);
                    else aG = __builtin_amdgcn_mfma_f32_32x32x16_bf16(af[q], bfr, aG, 0, 0, 0); }
                asm volatile("" ::: "memory");
            }
            LAS unsigned char* IN = OT + 3 * PR_OT_TILE;
#pragma unroll
            for (int a = 0; a < 3; ++a)
#pragma unroll
                for (int i = 0; i < 2; ++i) { const int cch = 64 * h + 32 * ct + 8 * (lane & 3); const f32x4 m0v = *(const LAS f32x4*)(PRM + a * 512 + cch), m1v = *(const LAS f32x4*)(PRM + a * 512 + cch + 4);
                    float xcu[8], xpu[8]; UNPACK8(xcu, 0, xc[a][i]); UNPACK8(xpu, 0, xp[a][i]); const float mw[8] = {m0v.x, m0v.y, m0v.z, m0v.w, m1v.x, m1v.y, m1v.z, m1v.w};
#pragma unroll
                    for (int e = 0; e < 8; ++e) xcu[e] += (xpu[e] - xcu[e]) * mw[e];
                    LAS unsigned char* dstp = IN + a * PR_OT_TILE + ((lane >> 2) + 16 * i) * PR_OT_PITCH + 16 * (lane & 3);
                    *(LAS v2u*)dstp = (v2u){pk2(xcu[0], xcu[1]), pk2(xcu[2], xcu[3])}; *(LAS v2u*)(dstp + 8) = (v2u){pk2(xcu[4], xcu[5]), pk2(xcu[6], xcu[7])}; }
            asm volatile("" ::: "memory");
            v2u oE[4], oK[4], oG[4];
#pragma unroll
            for (int g4 = 0; g4 < 4; ++g4) {
                const int c = cb + 8 * g4;
                const f32x4 w0v = *(const LAS f32x4*)(PRM + 1536 + c),
                            a0v = *(const LAS f32x4*)(PRM + 2048 + c), kkc = *(const LAS f32x4*)(PRM + 2560 + c), kac = *(const LAS f32x4*)(PRM + 3072 + c), rkc = *(const LAS f32x4*)(PRM + 3584 + c);
                const LAS unsigned char* inq = IN + r32 * PR_OT_PITCH + 2 * (8 * g4 + 4 * hh);
                const v2u rq = *(const LAS v2u*)inq, kq = *(const LAS v2u*)(inq + PR_OT_TILE), vq = *(const LAS v2u*)(inq + 2 * PR_OT_TILE);
                const float rsu[4] = {bflo(rq.x), bfhi(rq.x), bflo(rq.y), bfhi(rq.y)}, ksu[4] = {bflo(kq.x), bfhi(kq.x), bflo(kq.y), bfhi(kq.y)}, vsu[4] = {bflo(vq.x), bfhi(vq.x), bflo(vq.y), bfhi(vq.y)};
                float ro[4], eo[4], ko[4], vo[4], ao[4], go[4];
#pragma unroll
                for (int e = 0; e < 4; ++e) {
                    const float r = rsu[e], k = ksu[e], v = vsu[e];
                    const float ee = 0.6065306597126334f * fast_sigmoid(w0v[e] + aW[4 * g4 + e]);
                    const float as = fast_sigmoid(a0v[e] + aA[4 * g4 + e]);
                    const float kv = k * kkc[e]; kkv[ct][4 * g4 + e] = kv; n2 += kv * kv;
                    const float kp = k * (1.0f + (as - 1.0f) * kac[e]);
                    bcv += r * kp * rkc[e];
                    ro[e] = r; eo[e] = ee; ko[e] = kp; vo[e] = v; ao[e] = as; go[e] = aG[4 * g4 + e];
                }
                LAS unsigned char* ot = OT + r32 * PR_OT_PITCH + 2 * (8 * g4 + 4 * hh);
                *(LAS v2u*)(ot) = (v2u){pk2(ro[0], ro[1]), pk2(ro[2], ro[3])}; *(LAS v2u*)(ot + PR_OT_TILE) = (v2u){pk2(vo[0], vo[1]), pk2(vo[2], vo[3])}; *(LAS v2u*)(ot + 2 * PR_OT_TILE) = (v2u){pk2(ao[0], ao[1]), pk2(ao[2], ao[3])};
                oE[g4] = (v2u){pk2(eo[0], eo[1]), pk2(eo[2], eo[3])}; oK[g4] = (v2u){pk2(ko[0], ko[1]), pk2(ko[2], ko[3])}; oG[g4] = (v2u){pk2(go[0], go[1]), pk2(go[2], go[3])};
            }
            asm volatile("" ::: "memory");
#pragma unroll
            for (int batch = 0; batch < 2; ++batch) {
                bf16* const dst[3] = {batch == 0 ? R_ : E_, batch == 0 ? V_ : KP_, batch == 0 ? AS_ : G_};
                if (batch == 1) {
#pragma unroll
                    for (int g4 = 0; g4 < 4; ++g4) { LAS unsigned char* ot = OT + r32 * PR_OT_PITCH + 2 * (8 * g4 + 4 * hh); *(LAS v2u*)(ot) = oE[g4]; *(LAS v2u*)(ot + PR_OT_TILE) = oK[g4]; *(LAS v2u*)(ot + 2 * PR_OT_TILE) = oG[g4]; }
                    asm volatile("" ::: "memory"); }
#pragma unroll
                for (int a = 0; a < 3; ++a)
#pragma unroll
                    for (int i = 0; i < 2; ++i) { const int tk = (lane >> 2) + 16 * i, part = lane & 3; const LAS unsigned char* src = OT + a * PR_OT_TILE + tk * PR_OT_PITCH + 16 * part;
                        const v2u lo = *(const LAS v2u*)src, hi = *(const LAS v2u*)(src + 8);
                        *(GAS v4u*)(dst[a] + (size_t)(m0 + tk) * GW + 64 * h + 32 * ct + 8 * part) = (v4u){lo.x, lo.y, hi.x, hi.y}; }
                asm volatile("" ::: "memory");
            }
        }
        n2 += __shfl_xor(n2, 32); bcv += __shfl_xor(bcv, 32);
        const float inv = 1.0f / fmaxf(sqrtf(n2), 1e-12f);
#pragma unroll
        for (int ct = 0; ct < 2; ++ct)
#pragma unroll
            for (int g4 = 0; g4 < 4; ++g4) *(LAS v2u*)(OT + ct * PR_OT_TILE + r32 * PR_OT_PITCH + 2 * (8 * g4 + 4 * hh)) = (v2u){pk2(kkv[ct][4 * g4] * inv, kkv[ct][4 * g4 + 1] * inv), pk2(kkv[ct][4 * g4 + 2] * inv, kkv[ct][4 * g4 + 3] * inv)};
        asm volatile("" ::: "memory");
#pragma unroll
        for (int ct = 0; ct < 2; ++ct)
#pragma unroll
            for (int i = 0; i < 2; ++i) { const int tk = (lane >> 2) + 16 * i, part = lane & 3; const LAS unsigned char* src = OT + ct * PR_OT_TILE + tk * PR_OT_PITCH + 16 * part;
                const v2u lo = *(const LAS v2u*)src, hi = *(const LAS v2u*)(src + 8);
                *(GAS v4u*)(KK_ + (size_t)(m0 + tk) * GW + 64 * h + 32 * ct + 8 * part) = (v4u){lo.x, lo.y, hi.x, hi.y}; }
        asm volatile("" ::: "memory");
        if (hh == 0) BC[(size_t)m * NH + h] = bcv;
        __syncthreads();
    }
}

__device__ __forceinline__ Frame mkframe(LAS unsigned char* lds, int wv) {
    Frame F; F.lds = lds; { int t_ = wv * 64 + pg8::lane_now(); asm volatile("" : "+v"(t_)); F.tid = t_; } F.lane = F.tid & 63; F.wave = wv;
    F.G = gridDim.x; { const int bx = blockIdx.x; F.vcu = (F.G % 8 == 0) ? (bx % 8) * (F.G / 8) + bx / 8 : bx; }
    F.gw = blockIdx.x * NWAVES + F.wave; F.ngw = F.G * NWAVES; return F;
}

#ifndef UNPACK8
#define UNPACK8(dst, o, W_) do { dst[(o)] = bflo((W_).x); dst[(o) + 1] = bfhi((W_).x); dst[(o) + 2] = bflo((W_).y); dst[(o) + 3] = bfhi((W_).y); dst[(o) + 4] = bflo((W_).z); dst[(o) + 5] = bfhi((W_).z); dst[(o) + 6] = bflo((W_).w); dst[(o) + 7] = bfhi((W_).w); } while (0)
#endif
#define DOT8(q, o, W_) ((q)[(o)] * bflo((W_).x) + (q)[(o) + 1] * bfhi((W_).x) + (q)[(o) + 2] * bflo((W_).y) + (q)[(o) + 3] * bfhi((W_).y) + (q)[(o) + 4] * bflo((W_).z) + (q)[(o) + 5] * bfhi((W_).z) + (q)[(o) + 6] * bflo((W_).w) + (q)[(o) + 7] * bfhi((W_).w))
#define AXPY8(acc, o, sc, pe, W_) do { acc[(o)] = acc[(o)] * (sc) + (pe) * bflo((W_).x); acc[(o) + 1] = acc[(o) + 1] * (sc) + (pe) * bfhi((W_).x); acc[(o) + 2] = acc[(o) + 2] * (sc) + (pe) * bflo((W_).y); acc[(o) + 3] = acc[(o) + 3] * (sc) + (pe) * bfhi((W_).y); \
    acc[(o) + 4] = acc[(o) + 4] * (sc) + (pe) * bflo((W_).z); acc[(o) + 5] = acc[(o) + 5] * (sc) + (pe) * bfhi((W_).z); acc[(o) + 6] = acc[(o) + 6] * (sc) + (pe) * bflo((W_).w); acc[(o) + 7] = acc[(o) + 7] * (sc) + (pe) * bfhi((W_).w); } while (0)
__device__ __forceinline__ void mix_a_simple(Frame& F) {
    const bf16* PROJ = (const bf16*)(wsp() + WS_PROJ); bf16* YC = (bf16*)(wsp() + WS_YCAT); const int* TB = (const int*)(wsp() + WS_SMALL + SM_TB); const float* pb = inp(3);
    const int nthr = F.G * NTHR;
    for (int idx = blockIdx.x * NTHR + F.tid; idx < M * NH; idx += nthr) {
        const int m = idx >> 3, h = idx & 7, t = m % SEQ;
        float q[64], acc[64];
        { const GAS v4u* qp = (const GAS v4u*)(PROJ + (size_t)m * NPROJ_P + CA_Q + 64 * h);
#pragma unroll
          for (int i = 0; i < 8; ++i) { const v4u w = qp[i]; UNPACK8(q, 8 * i, w); } }
#pragma unroll
        for (int i = 0; i < 64; ++i) acc[i] = 0.f;
        float mx = -1e30f, l = 0.f;
        for (int p = 0; p < 3; ++p) { const int d = p == 0 ? 1 : (p == 1 ? 4 : 16);
            for (int j = 0; j <= 128; ++j) { const int kp = t - j * d; if (kp < 0) break;
                const bf16* row = PROJ + (size_t)(m - j * d) * NPROJ_P; const GAS v4u* kq = (const GAS v4u*)(row + CA_K + 64 * h); const GAS v4u* vq = (const GAS v4u*)(row + CA_V + 64 * h);
                float s = 0.f;
#pragma unroll
                for (int i = 0; i < 8; ++i) { const v4u w = kq[i]; s += DOT8(q, 8 * i, w); }
                s = s * 0.125f + pb[TB[j * d] * 16 + h];
                const float mn = fmaxf(mx, s), sc = __expf(mx - mn), pe = __expf(s - mn); mx = mn; l = l * sc + pe;
#pragma unroll
                for (int i = 0; i < 8; ++i) { const v4u w = vq[i]; AXPY8(acc, 8 * i, sc, pe, w); }
            } }
        const float inv = 1.0f / l; GAS v4u* op = (GAS v4u*)(YC + (size_t)m * DM + 0 * GW + 64 * h);
#pragma unroll
        for (int i = 0; i < 8; ++i) op[i] = (v4u){pk2(acc[8 * i] * inv, acc[8 * i + 1] * inv), pk2(acc[8 * i + 2] * inv, acc[8 * i + 3] * inv), pk2(acc[8 * i + 4] * inv, acc[8 * i + 5] * inv), pk2(acc[8 * i + 6] * inv, acc[8 * i + 7] * inv)};
    }
}
__device__ __forceinline__ void mix_c_simple(Frame& F, int l = 0) {
    const bf16* PROJ = (const bf16*)(wsp() + WS_PROJ); bf16* YC = (bf16*)(wsp() + WS_YCAT); const int* TB = (const int*)(wsp() + WS_SMALL + SM_TB); const float* pb = inp(3);
    const float* KBAR = (const float*)(wsp() + CTL_KBAR) + (size_t)l * 64 * 8 * 64;
    const int nthr = F.G * NTHR;
    for (int idx = blockIdx.x * NTHR + F.tid; idx < M * NH; idx += nthr) {
        const int m = idx >> 3, h = idx & 7, t = m % SEQ, b = m / SEQ, ob = t >> 8;
        float q[64], acc[64];
        { const GAS v4u* qp = (const GAS v4u*)(PROJ + (size_t)m * NPROJ_P + CC_Q + 64 * h);
#pragma unroll
          for (int i = 0; i < 8; ++i) { const v4u w = qp[i]; UNPACK8(q, 8 * i, w); } }
        float gate[8];
#pragma unroll
        for (int n = 0; n < 8; ++n) { float s = 0.f; if (n < ob) { const float* kb = KBAR + ((b * NH + h) * 8 + n) * 64;
#pragma unroll
                for (int i = 0; i < 64; ++i) s += q[i] * kb[i]; } gate[n] = s; }
        unsigned sel = 0u;
#pragma unroll
        for (int n = 0; n < 8; ++n) { int rank = 0;
#pragma unroll
            for (int n2 = 0; n2 < 8; ++n2) rank += (n2 < ob && n2 != n && (gate[n2] > gate[n] || (gate[n2] == gate[n] && n2 < n))) ? 1 : 0;
            if (n < ob && rank < 3) sel |= 1u << n; }
        sel |= 1u << ob;
#pragma unroll
        for (int i = 0; i < 64; ++i) acc[i] = 0.f;
        float mx = -1e30f, l = 0.f;
        for (int n = 0; n <= ob; ++n) { if (!((sel >> n) & 1u)) continue; const int kmax = n == ob ? (t & 255) : 255;
            for (int i2 = 0; i2 <= kmax; ++i2) { const int kp = 256 * n + i2;
                const bf16* row = PROJ + ((size_t)b * SEQ + kp) * NPROJ_P; const GAS v4u* kq = (const GAS v4u*)(row + CC_K + 64 * h); const GAS v4u* vq = (const GAS v4u*)(row + CC_V + 64 * h);
                float s = 0.f;
#pragma unroll
                for (int i = 0; i < 8; ++i) { const v4u w = kq[i]; s += DOT8(q, 8 * i, w); }
                s = s * 0.125f + pb[TB[t - kp] * 16 + 8 + h];
                const float mn = fmaxf(mx, s), sc = __expf(mx - mn), pe = __expf(s - mn); mx = mn; l = l * sc + pe;
#pragma unroll
                for (int i = 0; i < 8; ++i) { const v4u w = vq[i]; AXPY8(acc, 8 * i, sc, pe, w); }
            } }
        const float inv = 1.0f / l; GAS v4u* op = (GAS v4u*)(YC + (size_t)m * DM + 2 * GW + 64 * h);
#pragma unroll
        for (int i = 0; i < 8; ++i) op[i] = (v4u){pk2(acc[8 * i] * inv, acc[8 * i + 1] * inv), pk2(acc[8 * i + 2] * inv, acc[8 * i + 3] * inv), pk2(acc[8 * i + 4] * inv, acc[8 * i + 5] * inv), pk2(acc[8 * i + 6] * inv, acc[8 * i + 7] * inv)};
    }
}
__device__ __forceinline__ void mix_b_simple(Frame& F, int l) {
    const bf16* PROJ = (const bf16*)(wsp() + WS_PROJ); bf16* YC = (bf16*)(wsp() + WS_YCAT); const pg8::fx_t* ST = (const pg8::fx_t*)(wsp() + CTL_STATS) + (size_t)l * M * 2;
    const float* lng = inp(4) + l * GW; const float* sw = inp(5) + (size_t)l * NH * 128 * 128; const float* sb = inp(6) + l * NH * 128;
    const int nthr = F.G * NTHR;
    for (int idx = blockIdx.x * NTHR + F.tid; idx < M * GW; idx += nthr) {
        const int m = idx >> 9, c = idx & 511, g = c >> 6, tt = m & 127, m0 = m - tt;
        const float* wrow = sw + ((size_t)g * 128 + tt) * 128; const float gn = lng[c]; float s = 0.f;
        for (int s2 = 0; s2 <= tt; ++s2) { const int ms = m0 + s2; const float mu_ = pg8::fx_get(ST + 2 * ms) * (1.0f / 512.0f), rs_ = 1.0f / sqrtf(fmaxf(pg8::fx_get(ST + 2 * ms + 1) * (1.0f / 512.0f) - mu_ * mu_, 0.f) + 1e-5f); const float vv = (gelu_tanh(bf2f(PROJ[(size_t)ms * NPROJ_P + CB_V + c])) - mu_) * rs_ * gn; s += wrow[s2] * vv; }
        const float u = gelu_tanh(bf2f(PROJ[(size_t)m * NPROJ_P + CB_U + c]));
        YC[(size_t)m * DM + GW + c] = (bf16)f2bf(u * (s + sb[g * 128 + tt]));
    }
}
__device__ __forceinline__ float rdl(float v, int k) { return __builtin_bit_cast(float, __builtin_amdgcn_readlane(__builtin_bit_cast(int, v), k)); }
__device__ __forceinline__ void mix_d_simple(Frame& F) {
    const bf16* R_ = (const bf16*)outp();
    const bf16* E_ = R_ + (size_t)M * GW; const bf16* KP_ = E_ + (size_t)M * GW; const bf16* V_ = KP_ + (size_t)M * GW;
    const bf16* KK_ = (const bf16*)outp() + (size_t)4 * M * GW; const bf16* AS_ = KK_ + (size_t)M * GW; float* YD = (float*)(wsp() + WS_YD);
    for (int it = F.gw; it < BATCH * NH; it += F.ngw) {
        const int b = it >> 3, h = it & 7; float s[64];
#pragma unroll
        for (int k = 0; k < 64; ++k) s[k] = 0.f;
        for (int t = 0; t < SEQ; ++t) {
            const size_t o = ((size_t)b * SEQ + t) * GW + 64 * h + F.lane;
            const float r = bf2f(R_[o]), w = __expf(-bf2f(E_[o])), kp = bf2f(KP_[o]), v = bf2f(V_[o]), kk = bf2f(KK_[o]), as = bf2f(AS_[o]);
            const float a = -kk, bb = kk * as;
            float sa = 0.f;
#pragma unroll
            for (int k = 0; k < 64; ++k) sa += s[k] * rdl(a, k);
            float y = 0.f;
#pragma unroll
            for (int k = 0; k < 64; ++k) { s[k] = s[k] * rdl(w, k) + sa * rdl(bb, k) + v * rdl(kp, k); y += s[k] * rdl(r, k); }
            YD[o] = y;
        }
    }
}

constexpr float LOG2E = 1.4426950408889634f;

constexpr int SC_T = 32, SC_TOK = (5 * 64 + 32) * 4, SC_BUF = SC_T * SC_TOK, SC_YB = SC_T * 32 * 4, SC_LDS = 2 * SC_BUF + 2 * SC_YB;
template <int CTRL> __device__ __forceinline__ float dpp_add(float x) {
    const int y = __builtin_amdgcn_update_dpp(0, __builtin_bit_cast(int, x), CTRL, 0xF, 0xF, false);
    return x + __builtin_bit_cast(float, y);
}
__device__ __forceinline__ float red8(float x) { x = dpp_add<0xB1>(x); x = dpp_add<0x4E>(x); x = dpp_add<0x141>(x); return x; }
__device__ __forceinline__ void scan_unit(LAS unsigned char* lds, int unit, int tid) {
    const int half = unit & 1, h = (unit >> 1) & 7, b = unit >> 4;
    const bf16* R_ = (const bf16*)outp();
    const bf16* E_ = R_ + (size_t)M * GW; const bf16* KP_ = E_ + (size_t)M * GW; const bf16* V_ = KP_ + (size_t)M * GW;
    const bf16* KK_ = (const bf16*)outp() + (size_t)4 * M * GW; const bf16* AS_ = KK_ + (size_t)M * GW; float* YD = (float*)(wsp() + WS_YD);
    const int lane = tid & 63, wave = __builtin_amdgcn_readfirstlane(tid >> 6);
    const bool scanner = wave < 4;
    const int j = lane & 7, rowl = (wave & 3) * 8 + (lane >> 3);
    const int st = tid & 255, tt = st >> 3, cg = st & 7;
    const size_t gbase = ((size_t)b * SEQ) * GW + 64 * h + 8 * cg;
#define SC_STAGE(c, buf) do { const size_t o_ = gbase + (size_t)((c) * SC_T + tt) * GW; \
        const v4u g_r = *(const GAS v4u*)(R_ + o_), g_e = *(const GAS v4u*)(E_ + o_), g_k = *(const GAS v4u*)(KP_ + o_), g_v = *(const GAS v4u*)(V_ + o_), g_kk = *(const GAS v4u*)(KK_ + o_), g_as = *(const GAS v4u*)(AS_ + o_); \
        LAS float* p_ = (LAS float*)(lds + (buf) * SC_BUF + tt * SC_TOK) + 8 * cg; float kk_[8], x_[8], y_[8]; \
        UNPACK8(kk_, 0, g_kk); \
        *(LAS f32x4*)(p_) = (f32x4){-kk_[0], -kk_[1], -kk_[2], -kk_[3]}; *(LAS f32x4*)(p_ + 4) = (f32x4){-kk_[4], -kk_[5], -kk_[6], -kk_[7]}; \
        UNPACK8(x_, 0, g_e); *(LAS f32x4*)(p_ + 64) = (f32x4){__expf(-x_[0]), __expf(-x_[1]), __expf(-x_[2]), __expf(-x_[3])}; *(LAS f32x4*)(p_ + 68) = (f32x4){__expf(-x_[4]), __expf(-x_[5]), __expf(-x_[6]), __expf(-x_[7])}; \
        UNPACK8(y_, 0, g_as); *(LAS f32x4*)(p_ + 128) = (f32x4){kk_[0] * y_[0], kk_[1] * y_[1], kk_[2] * y_[2], kk_[3] * y_[3]}; *(LAS f32x4*)(p_ + 132) = (f32x4){kk_[4] * y_[4], kk_[5] * y_[5], kk_[6] * y_[6], kk_[7] * y_[7]}; \
        UNPACK8(x_, 0, g_k); *(LAS f32x4*)(p_ + 192) = (f32x4){x_[0], x_[1], x_[2], x_[3]}; *(LAS f32x4*)(p_ + 196) = (f32x4){x_[4], x_[5], x_[6], x_[7]}; \
        UNPACK8(x_, 0, g_r); *(LAS f32x4*)(p_ + 256) = (f32x4){x_[0], x_[1], x_[2], x_[3]}; *(LAS f32x4*)(p_ + 260) = (f32x4){x_[4], x_[5], x_[6], x_[7]}; \
        if ((cg >> 2) == half) { UNPACK8(x_, 0, g_v); LAS float* v_ = (LAS float*)(lds + (buf) * SC_BUF + tt * SC_TOK) + 320 + 8 * (cg & 3); \
            *(LAS f32x4*)(v_) = (f32x4){x_[0], x_[1], x_[2], x_[3]}; *(LAS f32x4*)(v_ + 4) = (f32x4){x_[4], x_[5], x_[6], x_[7]}; } } while (0)
    if (!scanner) SC_STAGE(0, 0);
    __syncthreads();
    f32x4 s0 = {0.f, 0.f, 0.f, 0.f}, s1 = {0.f, 0.f, 0.f, 0.f};
    float ykeep = 0.f;
    for (int c = 0; c < SEQ / SC_T; ++c) {
        const int cur = c & 1;
        LAS float* yb = (LAS float*)(lds + 2 * SC_BUF + cur * SC_YB);
        if (scanner) {
            const LAS float* base = (const LAS float*)(lds + cur * SC_BUF) + 8 * j;
            const LAS float* vbase = (const LAS float*)(lds + cur * SC_BUF) + 320 + rowl;
            f32x4 a0 = *(const LAS f32x4*)(base), a1 = *(const LAS f32x4*)(base + 4), w0 = *(const LAS f32x4*)(base + 64), w1 = *(const LAS f32x4*)(base + 68), b0 = *(const LAS f32x4*)(base + 128), b1 = *(const LAS f32x4*)(base + 132),
                  k0 = *(const LAS f32x4*)(base + 192), k1 = *(const LAS f32x4*)(base + 196), r0 = *(const LAS f32x4*)(base + 256), r1 = *(const LAS f32x4*)(base + 260);
            float vv = *vbase;
#pragma unroll
            for (int t = 0; t < SC_T; ++t) {
                f32x4 na0 = a0, na1 = a1, nw0 = w0, nw1 = w1, nb0 = b0, nb1 = b1, nk0 = k0, nk1 = k1, nr0 = r0, nr1 = r1; float nv = vv;
                if (t + 1 < SC_T) { const LAS float* p = base + (t + 1) * (SC_TOK / 4);
                    na0 = *(const LAS f32x4*)(p); na1 = *(const LAS f32x4*)(p + 4); nw0 = *(const LAS f32x4*)(p + 64); nw1 = *(const LAS f32x4*)(p + 68); nb0 = *(const LAS f32x4*)(p + 128); nb1 = *(const LAS f32x4*)(p + 132);
                    nk0 = *(const LAS f32x4*)(p + 192); nk1 = *(const LAS f32x4*)(p + 196); nr0 = *(const LAS f32x4*)(p + 256); nr1 = *(const LAS f32x4*)(p + 260);
                    nv = vbase[(t + 1) * (SC_TOK / 4)]; }
                const f32x4 pa = s0 * a0 + s1 * a1;
                float sa = (pa.x + pa.y) + (pa.z + pa.w);
                const f32x4 sw0 = s0 * w0 + vv * k0, sw1 = s1 * w1 + vv * k1;
                sa = red8(sa);
                s0 = sa * b0 + sw0; s1 = sa * b1 + sw1;
                const f32x4 py = s0 * r0 + s1 * r1;
                float y = (py.x + py.y) + (py.z + py.w);
                y = red8(y);
                ykeep = (j == (t & 7)) ? y : ykeep;
                if ((t & 7) == 7) yb[((t & ~7) + j) * 32 + rowl] = ykeep;
                a0 = na0; a1 = na1; w0 = nw0; w1 = nw1; b0 = nb0; b1 = nb1; k0 = nk0; k1 = nk1; r0 = nr0; r1 = nr1; vv = nv;
            }
        } else {
            if (c > 0) {
                const LAS float* ybp = (const LAS float*)(lds + 2 * SC_BUF + (cur ^ 1) * SC_YB); const int t2 = st >> 3, q4 = st & 7; const f32x4 v = *(const LAS f32x4*)(ybp + t2 * 32 + 4 * q4);
                *(GAS f32x4*)(YD + ((size_t)b * SEQ + (c - 1) * SC_T + t2) * GW + 64 * h + 32 * half + 4 * q4) = v; }
            if (c + 1 < SEQ / SC_T) SC_STAGE(c + 1, cur ^ 1);
        }
        __syncthreads();
    }
    if (!scanner) { const LAS float* ybp = (const LAS float*)(lds + 2 * SC_BUF + 1 * SC_YB); const int t2 = st >> 3, q4 = st & 7; const f32x4 v = *(const LAS f32x4*)(ybp + t2 * 32 + 4 * q4);
        *(GAS f32x4*)(YD + ((size_t)b * SEQ + (SEQ / SC_T - 1) * SC_T + t2) * GW + 64 * h + 32 * half + 4 * q4) = v; }
#undef SC_STAGE
    __syncthreads();
}

struct AttnSt { f32x16 o0, o1; float m, l; };
__device__ __forceinline__ void attn_init(AttnSt& st) {
    const float z_ = zero_v();
#pragma unroll
    for (int i = 0; i < 16; ++i) { st.o0[i] = z_; st.o1[i] = z_; }
    st.m = -1e30f; st.l = 0.f;
}
__device__ __forceinline__ void attn_tile(AttnSt& st, const bf16x8 (&qf)[4], const bf16* Kcol, const bf16* Vcol, int rowb, int kb, int ks, int qpos, int maxd, bool sel, const LAS float* biasT, int r32, int hh) {
    int kp_l = kb + r32 * ks; kp_l = kp_l < 0 ? 0 : kp_l;
    const bf16* kr_ = Kcol + (size_t)(rowb + kp_l) * NPROJ_P + 8 * hh;
    bf16x8 kf[4];
#pragma unroll
    for (int s = 0; s < 4; ++s) kf[s] = *(const GAS bf16x8*)(kr_ + 16 * s);
    f32x16 sc;
#pragma unroll
    for (int i = 0; i < 16; ++i) sc[i] = 0.f;
#pragma unroll
    for (int s = 0; s < 4; ++s) sc = __builtin_amdgcn_mfma_f32_32x32x16_bf16(kf[s], qf[s], sc, 0, 0, 0);
    unsigned vf[2][2][4];
#pragma unroll
    for (int s2 = 0; s2 < 2; ++s2)
#pragma unroll
        for (int jp = 0; jp < 4; ++jp) {
            const int j0 = 2 * jp, key0 = 16 * s2 + 8 * (j0 >> 2) + 4 * hh + (j0 & 3);
            int kp0 = kb + key0 * ks, kp1 = kp0 + ks; kp0 = kp0 < 0 ? 0 : kp0; kp1 = kp1 < 0 ? 0 : kp1;
            const bf16* v0 = Vcol + (size_t)(rowb + kp0) * NPROJ_P + r32; const bf16* v1 = Vcol + (size_t)(rowb + kp1) * NPROJ_P + r32;
            vf[0][s2][jp] = (unsigned)v0[0] | ((unsigned)v1[0] << 16); vf[1][s2][jp] = (unsigned)v0[32] | ((unsigned)v1[32] << 16);
        }
    float tmax = -INFINITY;
#pragma unroll
    for (int r = 0; r < 16; ++r) {
        const int kr = (r & 3) + 8 * (r >> 2) + 4 * hh, kp = kb + kr * ks, dist = qpos - kp;
        const bool ok = sel && dist >= 0 && dist <= maxd && kp >= 0;
        const float v = sc[r] * (0.125f * LOG2E) + biasT[ok ? dist : 0];
        sc[r] = ok ? v : -INFINITY; tmax = fmaxf(tmax, sc[r]);
    }
    tmax = fmaxf(tmax, __shfl_xor(tmax, 32));
    const float mn = fmaxf(st.m, tmax), scale = __builtin_amdgcn_exp2f(st.m - mn); st.m = mn;
    float ls = 0.f;
#pragma unroll
    for (int r = 0; r < 16; ++r) { sc[r] = __builtin_amdgcn_exp2f(sc[r] - mn); ls += sc[r]; }
    st.l = st.l * scale + ls;
#pragma unroll
    for (int i = 0; i < 16; ++i) { st.o0[i] *= scale; st.o1[i] *= scale; }
    typedef unsigned u32x4_t __attribute__((ext_vector_type(4)));
#pragma unroll
    for (int s2 = 0; s2 < 2; ++s2) {
        u32x4_t pw; pw.x = pg8::cvt_pk_bf16(sc[8 * s2], sc[8 * s2 + 1]); pw.y = pg8::cvt_pk_bf16(sc[8 * s2 + 2], sc[8 * s2 + 3]); pw.z = pg8::cvt_pk_bf16(sc[8 * s2 + 4], sc[8 * s2 + 5]); pw.w = pg8::cvt_pk_bf16(sc[8 * s2 + 6], sc[8 * s2 + 7]);
        const bf16x8 pf = __builtin_bit_cast(bf16x8, pw);
        u32x4_t a0 = {vf[0][s2][0], vf[0][s2][1], vf[0][s2][2], vf[0][s2][3]}, a1 = {vf[1][s2][0], vf[1][s2][1], vf[1][s2][2], vf[1][s2][3]};
        st.o0 = __builtin_amdgcn_mfma_f32_32x32x16_bf16(__builtin_bit_cast(bf16x8, a0), pf, st.o0, 0, 0, 0);
        st.o1 = __builtin_amdgcn_mfma_f32_32x32x16_bf16(__builtin_bit_cast(bf16x8, a1), pf, st.o1, 0, 0, 0);
    }
}
__device__ __forceinline__ void attn_loadq(bf16x8 (&qf)[4], const bf16* Qcol, int row, int hh) {
    const bf16* q = Qcol + (size_t)row * NPROJ_P + 8 * hh;
#pragma unroll
    for (int s = 0; s < 4; ++s) qf[s] = *(const GAS bf16x8*)(q + 16 * s);
}
__device__ __forceinline__ void attn_store(const f32x16& o0, const f32x16& o1, float inv, bf16* yrow, int hh) {
#pragma unroll
    for (int g = 0; g < 4; ++g) {
        *(GAS v2u*)(yrow + 8 * g + 4 * hh) = (v2u){pk2(o0[4 * g] * inv, o0[4 * g + 1] * inv), pk2(o0[4 * g + 2] * inv, o0[4 * g + 3] * inv)};
        *(GAS v2u*)(yrow + 32 + 8 * g + 4 * hh) = (v2u){pk2(o1[4 * g] * inv, o1[4 * g + 1] * inv), pk2(o1[4 * g + 2] * inv, o1[4 * g + 3] * inv)};
    }
}
__device__ __forceinline__ void build_bias(LAS float* biasT, int hcol, int tid) {
    const f32x4 bv = *(const GAS f32x4*)((const float*)(wsp() + WS_SMALL + SM_BIAS) + hcol * 2048 + 4 * tid); const v4u tv = *(const GAS v4u*)((const unsigned*)(wsp() + WS_SMALL + SM_TB) + 4 * tid);
    *(LAS f32x4*)(biasT + 4 * tid) = bv; *(LAS v4u*)((LAS unsigned*)(biasT + 2048) + 4 * tid) = tv;
}

constexpr int MC_KP = 144, MC_VP = 192, MC_KB = 128 * MC_KP, MC_VB = 128 * MC_VP, MC_K_OFF = 16384, MC_V_OFF = MC_K_OFF + 2 * MC_KB, MC_LDS = MC_V_OFF + 2 * MC_VB;
typedef short v4i16_t __attribute__((ext_vector_type(4)));
__device__ __forceinline__ float pl32_max(float a) { float x = a, y = a;
    asm volatile("s_nop 1\n\tv_permlane32_swap_b32_e32 %0, %1\n\ts_nop 0" : "+v"(x), "+v"(y));
    return fmaxf(x, y); }
template <int MODE> __device__ __forceinline__ void moba_tile(AttnSt& st, const bf16x8 (&qf)[4], const LAS unsigned char* Kt, const LAS unsigned char* Vt, const LAS float* biasT, const LAS int* TB, int dlo, bool sel, int lane, int r32, int hh) {
    bf16x8 kf[4];
#pragma unroll
    for (int s = 0; s < 4; ++s) kf[s] = *(const LAS bf16x8*)(Kt + r32 * MC_KP + 32 * s + 16 * hh);
    v4i16_t vt[2][2][2];
    { const LAS unsigned char* vb = Vt + (4 * hh + ((lane & 15) >> 2)) * MC_VP + (16 * ((lane >> 4) & 1) + 4 * (lane & 3)) * 2;
#pragma unroll
      for (int dh = 0; dh < 2; ++dh)
#pragma unroll
        for (int s2 = 0; s2 < 2; ++s2)
#pragma unroll
            for (int h8 = 0; h8 < 2; ++h8) vt[dh][s2][h8] = __builtin_amdgcn_ds_read_tr16_b64_v4i16((LAS v4i16_t*)(vb + (16 * s2 + 8 * h8) * MC_VP + 64 * dh)); }
    f32x16 sc;
#pragma unroll
    for (int i = 0; i < 16; ++i) sc[i] = 0.f;
#pragma unroll
    for (int s = 0; s < 4; ++s) sc = __builtin_amdgcn_mfma_f32_32x32x16_bf16(kf[s], qf[s], sc, 0, 0, 0);
    const int d0 = dlo + r32 + 31 - 4 * hh;
    const int dmin = dlo < 0 ? 0 : dlo, dmax = dlo + 62;
    const bool uni = __builtin_amdgcn_readfirstlane(TB[dmin]) == __builtin_amdgcn_readfirstlane(TB[dmax]);
    float tmax = -INFINITY;
    if (uni) { const float bu = biasT[dmin];
#pragma unroll
        for (int r = 0; r < 16; ++r) { float v = sc[r] * (0.125f * LOG2E) + bu; if (MODE == 1) { const int dist = d0 - (r & 3) - 8 * (r >> 2); v = dist >= 0 ? v : -INFINITY; } sc[r] = v; tmax = fmaxf(tmax, v); }
    } else {
#pragma unroll
        for (int r = 0; r < 16; ++r) { const int dist = d0 - (r & 3) - 8 * (r >> 2); float v = sc[r] * (0.125f * LOG2E) + biasT[dist < 0 ? 0 : dist]; if (MODE == 1) v = dist >= 0 ? v : -INFINITY; sc[r] = v; tmax = fmaxf(tmax, v); }
    }
    if (MODE == 2) tmax = sel ? tmax : -INFINITY;
    tmax = pl32_max(tmax);
    const float mn = fmaxf(st.m, tmax);
    if (__ballot(mn > st.m) != 0ull) { const float scale = __builtin_amdgcn_exp2f(st.m - mn); st.l *= scale;
#pragma unroll
        for (int i = 0; i < 16; ++i) { st.o0[i] *= scale; st.o1[i] *= scale; } }
    st.m = mn;
    const float msub = (MODE == 2 && !sel) ? INFINITY : mn;
    float ls = 0.f;
#pragma unroll
    for (int r = 0; r < 16; ++r) { sc[r] = __builtin_amdgcn_exp2f(sc[r] - msub); ls += sc[r]; }
    st.l += ls;
    typedef unsigned u32x4_t __attribute__((ext_vector_type(4)));
#pragma unroll
    for (int s2 = 0; s2 < 2; ++s2) {
        u32x4_t pw; pw.x = pg8::cvt_pk_bf16(sc[8 * s2], sc[8 * s2 + 1]); pw.y = pg8::cvt_pk_bf16(sc[8 * s2 + 2], sc[8 * s2 + 3]); pw.z = pg8::cvt_pk_bf16(sc[8 * s2 + 4], sc[8 * s2 + 5]); pw.w = pg8::cvt_pk_bf16(sc[8 * s2 + 6], sc[8 * s2 + 7]);
        const bf16x8 pf = __builtin_bit_cast(bf16x8, pw);
        const bf16x8 a0 = {vt[0][s2][0][0], vt[0][s2][0][1], vt[0][s2][0][2], vt[0][s2][0][3], vt[0][s2][1][0], vt[0][s2][1][1], vt[0][s2][1][2], vt[0][s2][1][3]};
        const bf16x8 a1 = {vt[1][s2][0][0], vt[1][s2][0][1], vt[1][s2][0][2], vt[1][s2][0][3], vt[1][s2][1][0], vt[1][s2][1][1], vt[1][s2][1][2], vt[1][s2][1][3]};
        st.o0 = __builtin_amdgcn_mfma_f32_32x32x16_bf16(a0, pf, st.o0, 0, 0, 0);
        st.o1 = __builtin_amdgcn_mfma_f32_32x32x16_bf16(a1, pf, st.o1, 0, 0, 0);
    }
}
__device__ __forceinline__ void moba_unit(LAS unsigned char* lds, int unit, int tid, int l) {
    const int ob = unit & 7, h = (unit >> 3) & 7, b = unit >> 6, lane = tid & 63, wave = __builtin_amdgcn_readfirstlane(tid >> 6), r32 = lane & 31, hh = lane >> 5;
    LAS float* biasT = (LAS float*)lds;
    build_bias(biasT, 8 + h, tid);
    const bf16* PROJ = (const bf16*)(wsp() + WS_PROJ); const float* KBAR = (const float*)(wsp() + CTL_KBAR) + (size_t)l * 64 * 8 * 64 + ((b * NH + h) * 8) * 64; const LAS int* TB = (const LAS int*)(biasT + 2048);
    const int rowb = b * SEQ, qpos = 256 * ob + 32 * wave + r32;
    bf16x8 qf[4]; attn_loadq(qf, PROJ + CC_Q + 64 * h, rowb + qpos, hh);
    float gate[8];
#pragma unroll
    for (int n = 0; n < 8; ++n) { float s = 0.f;
        if (n < ob) {
#pragma unroll
            for (int s4 = 0; s4 < 4; ++s4) { const f32x4 k0 = *(const GAS f32x4*)(KBAR + n * 64 + 16 * s4 + 8 * hh), k1 = *(const GAS f32x4*)(KBAR + n * 64 + 16 * s4 + 8 * hh + 4);
                const v4u qw = __builtin_bit_cast(v4u, qf[s4]);
                s += bflo(qw.x) * k0.x + bfhi(qw.x) * k0.y + bflo(qw.y) * k0.z + bfhi(qw.y) * k0.w + bflo(qw.z) * k1.x + bfhi(qw.z) * k1.y + bflo(qw.w) * k1.z + bfhi(qw.w) * k1.w; }
            s += __shfl_xor(s, 32); }
        gate[n] = s; }
    unsigned selm = 0u;
#pragma unroll
    for (int n = 0; n < 8; ++n) { int rank = 0;
#pragma unroll
        for (int n2 = 0; n2 < 8; ++n2) rank += (n2 < ob && n2 != n && (gate[n2] > gate[n] || (gate[n2] == gate[n] && n2 < n))) ? 1 : 0;
        if (n < ob && rank < 3) selm |= 1u << n; }
    AttnSt st; attn_init(st);
    const int skey = tid >> 2, spart = tid & 3;
    const bf16* Kg = PROJ + (size_t)rowb * NPROJ_P + CC_K + 64 * h + 16 * spart; const bf16* Vg = PROJ + (size_t)rowb * NPROJ_P + CC_V + 64 * h + 16 * spart;
    bf16x8 gk0, gk1, gv0, gv1;
#define MC_GLOAD(i) do { const size_t ro_ = (size_t)(128 * (i) + skey) * NPROJ_P; gk0 = *(const GAS bf16x8*)(Kg + ro_); gk1 = *(const GAS bf16x8*)(Kg + ro_ + 8); gv0 = *(const GAS bf16x8*)(Vg + ro_); gv1 = *(const GAS bf16x8*)(Vg + ro_ + 8); } while (0)
#define MC_LSTORE(bf) do { LAS unsigned char* kd_ = lds + MC_K_OFF + (bf) * MC_KB + skey * MC_KP + 32 * spart; *(LAS bf16x8*)(kd_) = gk0; *(LAS bf16x8*)(kd_ + 16) = gk1; \
        LAS unsigned char* vd_ = lds + MC_V_OFF + (bf) * MC_VB + skey * MC_VP + 32 * spart; *(LAS bf16x8*)(vd_) = gv0; *(LAS bf16x8*)(vd_ + 16) = gv1; } while (0)
    const int nst = 2 * (ob + 1);
    MC_GLOAD(0); MC_LSTORE(0);
    __syncthreads();
    for (int i = 0; i < nst; ++i) {
        if (i + 1 < nst) MC_GLOAD(i + 1);
        const int n = i >> 1, hf = i & 1; const bool own = n == ob, sel = own || ((selm >> n) & 1u);
        const LAS unsigned char* Kb = lds + MC_K_OFF + (i & 1) * MC_KB; const LAS unsigned char* Vb = lds + MC_V_OFF + (i & 1) * MC_VB;
        if (own) {
#pragma unroll 1
            for (int sub = 0; sub < 4; ++sub) { const int jt = 4 * hf + sub; if (jt > wave) break; const int dlo = 32 * wave - (32 * jt + 31);
                if (jt == wave) moba_tile<1>(st, qf, Kb + sub * 32 * MC_KP, Vb + sub * 32 * MC_VP, biasT, TB, dlo, true, lane, r32, hh);
                else moba_tile<0>(st, qf, Kb + sub * 32 * MC_KP, Vb + sub * 32 * MC_VP, biasT, TB, dlo, true, lane, r32, hh); }
        } else if (__ballot(sel) != 0ull) {
#pragma unroll 1
            for (int sub = 0; sub < 4; ++sub) { const int dlo = 256 * ob + 32 * wave - (256 * n + 128 * hf + 32 * sub + 31);
                moba_tile<2>(st, qf, Kb + sub * 32 * MC_KP, Vb + sub * 32 * MC_VP, biasT, TB, dlo, sel, lane, r32, hh); }
        }
        if (i + 1 < nst) MC_LSTORE((i + 1) & 1);
        __syncthreads();
    }
#undef MC_GLOAD
#undef MC_LSTORE
    const float lt = st.l + __shfl_xor(st.l, 32);
    attn_store(st.o0, st.o1, 1.0f / lt, (bf16*)(wsp() + WS_YCAT) + (size_t)(rowb + qpos) * DM + 2 * GW + 64 * h, hh);
}

constexpr int MA_PITCH = 144, MA_ML_OFF = 512 * MA_PITCH, MA_BIAS_OFF = MA_ML_OFF + 512 * 8, MA_V_OFF = MA_BIAS_OFF + 16384, MA_VW = 32 * MC_VP, MA_LDS = MA_V_OFF + 8 * MA_VW;
template <bool MASKED> __device__ __forceinline__ void dil_tile(AttnSt& st, const bf16x8 (&qf)[4], const bf16x8 (&kf)[4], const LAS unsigned char* Vt, const LAS float* biasT, const LAS int* TB, int dl0, int dstep, int kb, int lane, int r32, int hh) {
    v4i16_t vt[2][2][2];
    { const LAS unsigned char* vb = Vt + (4 * hh + ((lane & 15) >> 2)) * MC_VP + (16 * ((lane >> 4) & 1) + 4 * (lane & 3)) * 2;
#pragma unroll
      for (int dh = 0; dh < 2; ++dh)
#pragma unroll
        for (int s2 = 0; s2 < 2; ++s2)
#pragma unroll
            for (int h8 = 0; h8 < 2; ++h8) vt[dh][s2][h8] = __builtin_amdgcn_ds_read_tr16_b64_v4i16((LAS v4i16_t*)(vb + (16 * s2 + 8 * h8) * MC_VP + 64 * dh)); }
    f32x16 sc;
#pragma unroll
    for (int i = 0; i < 16; ++i) sc[i] = 0.f;
#pragma unroll
    for (int s = 0; s < 4; ++s) sc = __builtin_amdgcn_mfma_f32_32x32x16_bf16(kf[s], qf[s], sc, 0, 0, 0);
    const int e0 = dl0 + r32 - 4 * hh;
    int dmin = (dl0 - 31) * dstep, dmax = (dl0 + 31) * dstep; dmin = dmin < 0 ? 0 : dmin; dmax = dmax > 2047 ? 2047 : dmax;
    const bool uni = __builtin_amdgcn_readfirstlane(TB[dmin]) == __builtin_amdgcn_readfirstlane(TB[dmax]);
    const float bu = biasT[dmin];
    float tmax = -INFINITY;
#pragma unroll
    for (int r = 0; r < 16; ++r) {
        const int kr0 = (r & 3) + 8 * (r >> 2), delta = e0 - kr0;
        float bias = bu;
        if (!uni) { int di = delta * dstep; di = di < 0 ? 0 : (di > 2047 ? 2047 : di); bias = biasT[di]; }
        float v = sc[r] * (0.125f * LOG2E) + bias;
        if (MASKED) { const bool ok = delta >= 0 && delta <= 128 && (kb + (kr0 + 4 * hh) * dstep) >= 0; v = ok ? v : -INFINITY; }
        sc[r] = v; tmax = fmaxf(tmax, v);
    }
    tmax = pl32_max(tmax);
    const float mn = fmaxf(st.m, tmax);
    if (__ballot(mn > st.m) != 0ull) { const float scale = __builtin_amdgcn_exp2f(st.m - mn); st.l *= scale;
#pragma unroll
        for (int i = 0; i < 16; ++i) { st.o0[i] *= scale; st.o1[i] *= scale; } }
    st.m = mn;
    float ls = 0.f;
#pragma unroll
    for (int r = 0; r < 16; ++r) { sc[r] = __builtin_amdgcn_exp2f(sc[r] - mn); ls += sc[r]; }
    st.l += ls;
    typedef unsigned u32x4_t __attribute__((ext_vector_type(4)));
#pragma unroll
    for (int s2 = 0; s2 < 2; ++s2) {
        u32x4_t pw; pw.x = pg8::cvt_pk_bf16(sc[8 * s2], sc[8 * s2 + 1]); pw.y = pg8::cvt_pk_bf16(sc[8 * s2 + 2], sc[8 * s2 + 3]); pw.z = pg8::cvt_pk_bf16(sc[8 * s2 + 4], sc[8 * s2 + 5]); pw.w = pg8::cvt_pk_bf16(sc[8 * s2 + 6], sc[8 * s2 + 7]);
        const bf16x8 pf = __builtin_bit_cast(bf16x8, pw);
        const bf16x8 a0 = {vt[0][s2][0][0], vt[0][s2][0][1], vt[0][s2][0][2], vt[0][s2][0][3], vt[0][s2][1][0], vt[0][s2][1][1], vt[0][s2][1][2], vt[0][s2][1][3]};
        const bf16x8 a1 = {vt[1][s2][0][0], vt[1][s2][0][1], vt[1][s2][0][2], vt[1][s2][0][3], vt[1][s2][1][0], vt[1][s2][1][1], vt[1][s2][1][2], vt[1][s2][1][3]};
        st.o0 = __builtin_amdgcn_mfma_f32_32x32x16_bf16(a0, pf, st.o0, 0, 0, 0);
        st.o1 = __builtin_amdgcn_mfma_f32_32x32x16_bf16(a1, pf, st.o1, 0, 0, 0);
    }
}
__device__ __forceinline__ void dil_unit(LAS unsigned char* lds, int unit, int tid) {
    const int sp = unit & 3, h = (unit >> 2) & 7, b = unit >> 5, lane = tid & 63, wave = __builtin_amdgcn_readfirstlane(tid >> 6), r32 = lane & 31, hh = lane >> 5;
    LAS float* biasT = (LAS float*)(lds + MA_BIAS_OFF);
    build_bias(biasT, h, tid);
    __syncthreads();
    const bf16* PROJ = (const bf16*)(wsp() + WS_PROJ); const LAS int* TB = (const LAS int*)(biasT + 2048); const int rowb = b * SEQ, t0 = 512 * sp;
    const bf16* Qc = PROJ + CA_Q + 64 * h; const bf16* Kc = PROJ + CA_K + 64 * h; const bf16* Vc = PROJ + CA_V + 64 * h;
    LAS unsigned char* Vst = lds + MA_V_OFF + wave * MA_VW;
    const int vkey = lane >> 1, vhalf = lane & 1;
#pragma unroll 1
    for (int p = 0; p < 3; ++p) {
        const int d = p == 0 ? 1 : (p == 1 ? 4 : 16);
#pragma unroll 1
        for (int gi = 0; gi < 2; ++gi) {
            const int g = 2 * wave + gi;
            const int qb = t0 + (p == 0 ? 32 * g : (p == 1 ? 128 * (g >> 2) + (g & 3) : g));
            const int qpos = qb + r32 * d, qi = qpos - t0;
            bf16x8 qf[4]; attn_loadq(qf, Qc, rowb + qpos, hh);
            AttnSt st; attn_init(st);
            int jt = 0; while (qb + (32 * jt - 128 + 31) * d < 0) ++jt;
            bf16x8 kfn[4], vrn[4];
#define MA_GLOAD(JT) do { const int kb_ = qb + (32 * (JT) - 128) * d; int kp_ = kb_ + r32 * d; kp_ = kp_ < 0 ? 0 : kp_; const bf16* kr_ = Kc + (size_t)(rowb + kp_) * NPROJ_P + 8 * hh; \
                _Pragma("unroll") for (int s = 0; s < 4; ++s) kfn[s] = *(const GAS bf16x8*)(kr_ + 16 * s); \
                int vp_ = kb_ + vkey * d; vp_ = vp_ < 0 ? 0 : vp_; const bf16* vr_ = Vc + (size_t)(rowb + vp_) * NPROJ_P + 32 * vhalf; \
                _Pragma("unroll") for (int s = 0; s < 4; ++s) vrn[s] = *(const GAS bf16x8*)(vr_ + 8 * s); } while (0)
            MA_GLOAD(jt);
#pragma unroll 1
            for (; jt < 5; ++jt) {
                bf16x8 kf[4] = {kfn[0], kfn[1], kfn[2], kfn[3]};
                { LAS unsigned char* vd = Vst + vkey * MC_VP + 64 * vhalf;
#pragma unroll
                  for (int s = 0; s < 4; ++s) *(LAS bf16x8*)(vd + 16 * s) = vrn[s]; }
                asm volatile("" ::: "memory");
                if (jt + 1 < 5) MA_GLOAD(jt + 1);
                const int kb = qb + (32 * jt - 128) * d, dl0 = 128 - 32 * jt;
                if (jt == 0 || jt == 4 || kb < 0) dil_tile<true>(st, qf, kf, Vst, biasT, TB, dl0, d, kb, lane, r32, hh);
                else dil_tile<false>(st, qf, kf, Vst, biasT, TB, dl0, d, kb, lane, r32, hh);
            }
#undef MA_GLOAD
            float lt = st.l + __shfl_xor(st.l, 32);
            LAS unsigned char* orow = lds + qi * MA_PITCH; LAS float* ml = (LAS float*)(lds + MA_ML_OFF + qi * 8);
            if (p > 0) {
                const float mo = ml[0], lo = ml[1], mn = fmaxf(mo, st.m), fo = __builtin_amdgcn_exp2f(mo - mn), fc = __builtin_amdgcn_exp2f(st.m - mn);
                lt = lo * fo + lt * fc;
#pragma unroll
                for (int g4 = 0; g4 < 4; ++g4) { const v2u a = *(const LAS v2u*)(orow + 2 * (8 * g4 + 4 * hh)), c = *(const LAS v2u*)(orow + 64 + 2 * (8 * g4 + 4 * hh));
                    const float av[4] = {bflo(a.x), bfhi(a.x), bflo(a.y), bfhi(a.y)}, cv[4] = {bflo(c.x), bfhi(c.x), bflo(c.y), bfhi(c.y)};
#pragma unroll
                    for (int e = 0; e < 4; ++e) { st.o0[4 * g4 + e] = av[e] * fo + st.o0[4 * g4 + e] * fc; st.o1[4 * g4 + e] = cv[e] * fo + st.o1[4 * g4 + e] * fc; } }
                st.m = mn;
            }
            if (p < 2) {
#pragma unroll
                for (int g4 = 0; g4 < 4; ++g4) { *(LAS v2u*)(orow + 2 * (8 * g4 + 4 * hh)) = (v2u){pk2(st.o0[4 * g4], st.o0[4 * g4 + 1]), pk2(st.o0[4 * g4 + 2], st.o0[4 * g4 + 3])};
                    *(LAS v2u*)(orow + 64 + 2 * (8 * g4 + 4 * hh)) = (v2u){pk2(st.o1[4 * g4], st.o1[4 * g4 + 1]), pk2(st.o1[4 * g4 + 2], st.o1[4 * g4 + 3])}; }
                if (hh == 0) { ml[0] = st.m; ml[1] = lt; }
            } else attn_store(st.o0, st.o1, 1.0f / lt, (bf16*)(wsp() + WS_YCAT) + (size_t)(rowb + qpos) * DM + 0 * GW + 64 * h, hh);
        }
        __syncthreads();
    }
}

constexpr int SG_PITCH = 144, SG_WAVE = 128 * SG_PITCH, SG_OP = 272;
static_assert(8 * SG_WAVE <= MISC_OFF && 32 * SG_OP <= SG_WAVE, "SGU LDS");
__device__ __forceinline__ void sgu_unit(LAS unsigned char* lds, int unit, int tid, int l) {
    const int lane = tid & 63, g = __builtin_amdgcn_readfirstlane(tid >> 6), r32 = lane & 31, hh = lane >> 5, m0 = unit * 128;
    const bf16* PROJ = (const bf16*)(wsp() + WS_PROJ); bf16* YC = (bf16*)(wsp() + WS_YCAT); const pg8::fx_t* ST = (const pg8::fx_t*)(wsp() + CTL_STATS) + (size_t)l * M * 2;
    const float* lng = inp(4) + l * GW; const float* sw = inp(5) + ((size_t)l * NH + g) * 128 * 128; const float* sb = inp(6) + (l * NH + g) * 128;
    LAS unsigned char* T = lds + g * SG_WAVE;
    const int tk8 = lane >> 3, part = lane & 7;
    { const f32x4 g0 = *(const GAS f32x4*)(lng + 64 * g + 8 * part), g1 = *(const GAS f32x4*)(lng + 64 * g + 8 * part + 4);
      const float gn[8] = {g0.x, g0.y, g0.z, g0.w, g1.x, g1.y, g1.z, g1.w};
#pragma unroll 4
      for (int i = 0; i < 16; ++i) { const int tkn = tk8 + 8 * i, mm = m0 + tkn;
          const v4u w = *(const GAS v4u*)(PROJ + (size_t)mm * NPROJ_P + CB_V + 64 * g + 8 * part);
          const float mu = pg8::fx_get(ST + 2 * mm) * (1.0f / 512.0f), rs = __builtin_amdgcn_rsqf(fmaxf(pg8::fx_get(ST + 2 * mm + 1) * (1.0f / 512.0f) - mu * mu, 0.f) + 1e-5f);
          float x[8] = {bflo(w.x), bfhi(w.x), bflo(w.y), bfhi(w.y), bflo(w.z), bfhi(w.z), bflo(w.w), bfhi(w.w)};
#pragma unroll
          for (int e = 0; e < 8; ++e) x[e] = (gelu_tanh(x[e]) - mu) * rs * gn[e];
          *(LAS v4u*)(T + tkn * SG_PITCH + 16 * part) = (v4u){pk2(x[0], x[1]), pk2(x[2], x[3]), pk2(x[4], x[5]), pk2(x[6], x[7])}; } }
    asm volatile("" ::: "memory");
    f32x16 acc[4][2];
    const float z_ = zero_v();
#pragma unroll
    for (int tt = 0; tt < 4; ++tt)
#pragma unroll
        for (int ct = 0; ct < 2; ++ct)
#pragma unroll
            for (int i = 0; i < 16; ++i) acc[tt][ct][i] = z_;
    const LAS unsigned char* vb = T + (8 * hh + ((lane & 15) >> 2)) * SG_PITCH + (16 * ((lane >> 4) & 1) + 4 * (lane & 3)) * 2;
#pragma unroll
    for (int k = 0; k < 8; ++k) {
        v4i16_t t00 = __builtin_amdgcn_ds_read_tr16_b64_v4i16((LAS v4i16_t*)(vb + (16 * k) * SG_PITCH)), t01 = __builtin_amdgcn_ds_read_tr16_b64_v4i16((LAS v4i16_t*)(vb + (16 * k + 4) * SG_PITCH));
        v4i16_t t10 = __builtin_amdgcn_ds_read_tr16_b64_v4i16((LAS v4i16_t*)(vb + (16 * k) * SG_PITCH + 64)), t11 = __builtin_amdgcn_ds_read_tr16_b64_v4i16((LAS v4i16_t*)(vb + (16 * k + 4) * SG_PITCH + 64));
        const bf16x8 af0 = {t00[0], t00[1], t00[2], t00[3], t01[0], t01[1], t01[2], t01[3]}, af1 = {t10[0], t10[1], t10[2], t10[3], t11[0], t11[1], t11[2], t11[3]};
#pragma unroll
        for (int tt = 0; tt < 4; ++tt) { if (k < 2 * (tt + 1)) {
                const int t = 32 * tt + r32, s0 = 16 * k + 8 * hh; const float* wrow = sw + (size_t)t * 128 + s0;
                const f32x4 w0 = *(const GAS f32x4*)(wrow), w1 = *(const GAS f32x4*)(wrow + 4);
                float wv[8] = {w0.x, w0.y, w0.z, w0.w, w1.x, w1.y, w1.z, w1.w};
#pragma unroll
                for (int j = 0; j < 8; ++j) wv[j] = (s0 + j <= t) ? wv[j] : 0.f;
                const v4u bw = {pk2(wv[0], wv[1]), pk2(wv[2], wv[3]), pk2(wv[4], wv[5]), pk2(wv[6], wv[7])}; const bf16x8 bfr = __builtin_bit_cast(bf16x8, bw);
                acc[tt][0] = __builtin_amdgcn_mfma_f32_32x32x16_bf16(af0, bfr, acc[tt][0], 0, 0, 0); acc[tt][1] = __builtin_amdgcn_mfma_f32_32x32x16_bf16(af1, bfr, acc[tt][1], 0, 0, 0); } }
    }
    asm volatile("" ::: "memory");
#pragma unroll
    for (int tt = 0; tt < 4; ++tt) {
        const float bias = sb[32 * tt + r32];
#pragma unroll
        for (int ct = 0; ct < 2; ++ct)
#pragma unroll
            for (int g4 = 0; g4 < 4; ++g4) { const f32x16& a = acc[tt][ct];
                *(LAS f32x4*)(T + r32 * SG_OP + 4 * (32 * ct + 8 * g4 + 4 * hh)) = (f32x4){a[4 * g4] + bias, a[4 * g4 + 1] + bias, a[4 * g4 + 2] + bias, a[4 * g4 + 3] + bias}; }
        asm volatile("" ::: "memory");
#pragma unroll
        for (int i = 0; i < 4; ++i) { const int tkn = tk8 + 8 * i, mm = m0 + 32 * tt + tkn;
            const v4u uw = *(const GAS v4u*)(PROJ + (size_t)mm * NPROJ_P + CB_U + 64 * g + 8 * part);
            const f32x4 x0 = *(const LAS f32x4*)(T + tkn * SG_OP + 32 * part), x1 = *(const LAS f32x4*)(T + tkn * SG_OP + 32 * part + 16);
            const float u[8] = {bflo(uw.x), bfhi(uw.x), bflo(uw.y), bfhi(uw.y), bflo(uw.z), bfhi(uw.z), bflo(uw.w), bfhi(uw.w)};
            *(GAS v4u*)(YC + (size_t)mm * DM + GW + 64 * g + 8 * part) = (v4u){pk2(gelu_tanh(u[0]) * x0.x, gelu_tanh(u[1]) * x0.y), pk2(gelu_tanh(u[2]) * x0.z, gelu_tanh(u[3]) * x0.w), pk2(gelu_tanh(u[4]) * x1.x, gelu_tanh(u[5]) * x1.y), pk2(gelu_tanh(u[6]) * x1.z, gelu_tanh(u[7]) * x1.w)}; }
        asm volatile("" ::: "memory");
    }
}

#ifndef SIMPLE_A
#define SIMPLE_A 0
#endif
#ifndef SIMPLE_B
#define SIMPLE_B 0
#endif
#ifndef SIMPLE_C
#define SIMPLE_C 0
#endif
#ifndef SIMPLE_D
#define SIMPLE_D 0
#endif
__device__ __forceinline__ void ph_mixers(LAS unsigned char* L, int l, int phase, int qoff, int wv, int mask = 31) {
    Frame F = mkframe(L, wv);
    volatile LAS int* qslot = (volatile LAS int*)(L + MISC_OFF + 64);
    gu32* ctr = ctlp() + CW_Q + 64 * phase + qoff;
    constexpr int I_IN = (DM / 64) * (NPROJ / 32), I_REST = (I8_OUT ? 0 : (DM / 64) * (DM / 32)) + (FFN1_I8 ? 0 : 2 * (DM / 64) * (DFF / 32)) + (DFF / 64) * (DM / 32);
    const int n_scan = (SIMPLE_D || !(mask & 1)) ? 0 : 128, n_c = (SIMPLE_C || !(mask & 2)) ? 0 : 512, n_a = (SIMPLE_A || !(mask & 4)) ? 0 : 256, n_b = (SIMPLE_B || !(mask & 8)) ? 0 : 128;
    const int n_cin = ((l + 1 < DEPTH) && (mask & 16)) ? (I8_IN ? NPROJ / 32 + (WINB_ITEMS + 7) / 8 : (I_IN + 7) / 8) : 0, n_crest = (mask & 16) ? (I_REST + 7) / 8 : 0, n_cout = ((I8_OUT && (mask & 16)) ? DM / 32 : 0) + ((FFN1_I8 && (mask & 16)) ? 2 * (DFF / 32) : 0);
    const int e_scan = n_scan, e_a = e_scan + n_a, e_b = e_a + n_b, e_c = e_b + n_c, e_cout = e_c + n_cout, e_cin = e_cout + n_cin, e_crest = e_cin + n_crest;
    for (;;) {
        if (F.tid == 0) *qslot = (int)__hip_atomic_fetch_add(ctr, 1u, RLX_AGENT);
        __syncthreads();
        const int it = __builtin_amdgcn_readfirstlane(*qslot);
        __syncthreads();
        if (it >= e_crest) break;
        int tid = wv * 64 + pg8::lane_now(); asm volatile("" : "+v"(tid));
        if (it < e_scan) scan_unit(L, it, tid);
        else if (it < e_a) dil_unit(L, it - e_scan, tid);
        else if (it < e_b) { sgu_unit(L, it - e_a, tid, l); __syncthreads(); }
        else if (it < e_c) { const int i2 = it - e_b; moba_unit(L, (i2 & 63) * 8 + (7 - (i2 >> 6)), tid, l); }
        else if (it < e_cout) { Frame F2 = mkframe(L, wv); int r = it - e_c;
            if (I8_OUT && r < DM / 32) conv_cols_i8(inp(19) + (size_t)l * DM * DM, DM, DM, inp(18) + l * DM, wsp() + WS_WOUT, (float*)(wsp() + WS_SMALL + SM_SWOUT), r, F2);
            else { r -= I8_OUT ? DM / 32 : 0; const int up = r >= DFF / 32 ? 1 : 0, nb = r - up * (DFF / 32), n0 = 32 * nb;
                conv_cols_i8(inp(up ? 22 : 21) + (size_t)l * DM * DFF, DM, DFF, inp(20) + l * DM, wsp() + WS_WGU, (float*)(wsp() + WS_SMALL + SM_SWGU), nb, F2, (n0 >> 7) * 256 + up * 128 + (n0 & 127)); } }
        else if (it < e_cin) { Frame F2 = mkframe(L, wv);
            if (I8_IN) { if (it - e_cout < NPROJ / 32) conv_cols_i8(inp(2) + (size_t)(l + 1) * DM * NPROJ, DM, NPROJ, inp(1) + (l + 1) * DM, wsp() + WS_WIN, (float*)(wsp() + WS_SMALL + SM_SWIN), it - e_cout, F2);
                else conv_winb(F2, l + 1, (it - e_cout - NPROJ / 32) * 8 + F2.wave); }
            else conv_layer_items(F2, l + 1, (it - e_cout) * 8 + F2.wave, 1 << 30, true, false); }
        else { Frame F2 = mkframe(L, wv); conv_layer_items(F2, l, (it - e_cin) * 8 + F2.wave, 1 << 30, false, true); }
    }
    if (!I8_IN && l + 1 < DEPTH) {
        bf16* WIN = (bf16*)(wsp() + WS_WIN);
        Frame F3 = mkframe(L, wv);
        for (int i = F3.gw * 64 + F3.lane; i < 64 * DM / 8; i += F3.ngw * 64) { v4u z = {0u, 0u, 0u, 0u}; asm volatile("" : "+v"(z)); *(GAS v4u*)(WIN + (size_t)NPROJ * DM + (size_t)i * 8) = z; }
    }
    if (SIMPLE_D) mix_d_simple(F);
    if (SIMPLE_A) mix_a_simple(F);
    if (SIMPLE_C) mix_c_simple(F, l);
    if (SIMPLE_B) mix_b_simple(F, l);
}

__device__ __forceinline__ void ph_finalize(Frame& F, int l) {
    bf16* YC = (bf16*)(wsp() + WS_YCAT); const float* YD = (const float*)(wsp() + WS_YD); const bf16* V_ = (const bf16*)outp() + (size_t)3 * M * GW; const bf16* G_ = (const bf16*)(wsp() + WS_G); const float* BC = (const float*)(wsp() + WS_BC);
    const float* lng = inp(16) + l * GW; const float* lnb = inp(17) + l * GW;
    for (int m = F.gw; m < M; m += F.ngw) {
        const int c0 = 8 * F.lane, hd = F.lane >> 3;
        float y[8];
        { const GAS f32x4* yp = (const GAS f32x4*)(YD + (size_t)m * GW + c0); const f32x4 a = yp[0], b = yp[1]; y[0] = a.x; y[1] = a.y; y[2] = a.z; y[3] = a.w; y[4] = b.x; y[5] = b.y; y[6] = b.z; y[7] = b.w; }
        float s = 0.f;
#pragma unroll
        for (int i = 0; i < 8; ++i) s += y[i];
        s += __shfl_xor(s, 1); s += __shfl_xor(s, 2); s += __shfl_xor(s, 4); const float mean = s * (1.0f / 64.0f); float q = 0.f;
#pragma unroll
        for (int i = 0; i < 8; ++i) { const float d = y[i] - mean; q += d * d; }
        q += __shfl_xor(q, 1); q += __shfl_xor(q, 2); q += __shfl_xor(q, 4); const float rstd = 1.0f / sqrtf(q * (1.0f / 64.0f) + 64e-5f);
        const v4u vw = *(const GAS v4u*)(V_ + (size_t)m * GW + c0), gw4 = *(const GAS v4u*)(G_ + (size_t)m * GW + c0); const float bc = BC[(size_t)m * NH + hd];
        float vv[8], gg[8]; UNPACK8(vv, 0, vw); UNPACK8(gg, 0, gw4);
        float ss = 0.f;
#pragma unroll
        for (int i = 0; i < 8; ++i) { y[i] = ((y[i] - mean) * rstd * lng[c0 + i] + lnb[c0 + i] + bc * vv[i]) * gg[i]; ss += y[i] * y[i]; }
        if (I8_OUT) {
            float xn[3][8], mx = 0.f;
            { const float rs = 1.0f / sqrtf(wave_sum(ss) * (1.0f / 512.0f) + NORM_EPS);
#pragma unroll
              for (int i = 0; i < 8; ++i) { y[i] *= rs; mx = fmaxf(mx, fabsf(y[i])); } }
#pragma unroll
            for (int br = 0; br < 3; ++br) {
                const v4u w = *(const GAS v4u*)(YC + (size_t)m * DM + br * GW + c0); UNPACK8(xn[br], 0, w); float s2 = 0.f;
#pragma unroll
                for (int i = 0; i < 8; ++i) s2 += xn[br][i] * xn[br][i];
                const float rs = 1.0f / sqrtf(wave_sum(s2) * (1.0f / 512.0f) + NORM_EPS);
#pragma unroll
                for (int i = 0; i < 8; ++i) { xn[br][i] *= rs; mx = fmaxf(mx, fabsf(xn[br][i])); }
            }
            mx = wave_max(mx); const float inv = mx > 0.f ? 127.0f / mx : 0.f; unsigned char* yq = wsp() + WS_YQ + (size_t)m * DM + c0;
#pragma unroll
            for (int br = 0; br < 3; ++br) *(GAS v2u*)(yq + br * GW) = (v2u){q8pack4(xn[br][0], xn[br][1], xn[br][2], xn[br][3], inv), q8pack4(xn[br][4], xn[br][5], xn[br][6], xn[br][7], inv)};
            *(GAS v2u*)(yq + 3 * GW) = (v2u){q8pack4(y[0], y[1], y[2], y[3], inv), q8pack4(y[4], y[5], y[6], y[7], inv)};
            if (F.lane == 0) ((float*)(wsp() + WS_SMALL + SM_SAY))[m] = mx * (1.0f / 127.0f);
            continue;
        }
        { const float rs = 1.0f / sqrtf(wave_sum(ss) * (1.0f / 512.0f) + NORM_EPS);
          *(GAS v4u*)(YC + (size_t)m * DM + 3 * GW + c0) = (v4u){pk2(y[0] * rs, y[1] * rs), pk2(y[2] * rs, y[3] * rs), pk2(y[4] * rs, y[5] * rs), pk2(y[6] * rs, y[7] * rs)}; }
#pragma unroll
        for (int br = 0; br < 3; ++br) {
            GAS v4u* p = (GAS v4u*)(YC + (size_t)m * DM + br * GW + c0); const v4u w = *p;
            float x[8]; UNPACK8(x, 0, w); float s2 = 0.f;
#pragma unroll
            for (int i = 0; i < 8; ++i) s2 += x[i] * x[i];
            const float rs = 1.0f / sqrtf(wave_sum(s2) * (1.0f / 512.0f) + NORM_EPS);
            *p = (v4u){pk2(x[0] * rs, x[1] * rs), pk2(x[2] * rs, x[3] * rs), pk2(x[4] * rs, x[5] * rs), pk2(x[6] * rs, x[7] * rs)};
        }
    }
}
__device__ __forceinline__ void ph_final(Frame& F) {
    const pg8::fx_t* ssq = (const pg8::fx_t*)(ctlp() + CW_SSQ) + 4 * M; const float* g = inp(24); float* out = outp(); const bf16* XB = (const bf16*)(wsp() + WS_XB);
    for (int m = F.gw; m < M; m += F.ngw) {
        GAS f32x4* orow = (GAS f32x4*)(out + (size_t)m * DM); const GAS v4u* xr = (const GAS v4u*)(XB + (size_t)m * DM) + F.lane; const GAS f32x4* gp = (const GAS f32x4*)g;
        v4u wv4[4];
#pragma unroll
        for (int j = 0; j < 4; ++j) wv4[j] = xr[64 * j];
        float ssv;
        if (I8_IN) { float sq = 0.f;
#pragma unroll
            for (int j = 0; j < 4; ++j) { const float e8[8] = {bflo(wv4[j].x), bfhi(wv4[j].x), bflo(wv4[j].y), bfhi(wv4[j].y), bflo(wv4[j].z), bfhi(wv4[j].z), bflo(wv4[j].w), bfhi(wv4[j].w)};
#pragma unroll
                for (int e = 0; e < 8; ++e) sq += e8[e] * e8[e]; }
            ssv = wave_sum(sq); }
        else ssv = pg8::fx_get(ssq + m);
        const float rs = 1.0f / sqrtf(ssv * (1.0f / 2048.0f) + NORM_EPS);
#pragma unroll
        for (int j = 0; j < 4; ++j) { const v4u w = wv4[j]; const int c4 = 2 * (F.lane + 64 * j); const f32x4 g0 = gp[c4], g1 = gp[c4 + 1];
            orow[c4] = (f32x4){bflo(w.x) * rs * g0.x, bfhi(w.x) * rs * g0.y, bflo(w.y) * rs * g0.z, bfhi(w.y) * rs * g0.w};
            orow[c4 + 1] = (f32x4){bflo(w.z) * rs * g1.x, bfhi(w.z) * rs * g1.y, bflo(w.w) * rs * g1.z, bfhi(w.w) * rs * g1.w}; }
    }
}

#ifndef STAG
#define STAG 500
#endif
__device__ __forceinline__ void phase_stagger(int ticks) {
    const int grp = ((int)blockIdx.x >> 3) & 3;
    if (ticks > 0 && grp > 0) { const unsigned long long t0 = __builtin_amdgcn_s_memrealtime(); while ((long long)(__builtin_amdgcn_s_memrealtime() - t0) < (long long)grp * ticks) __builtin_amdgcn_s_sleep(32); }
}
__global__ void __launch_bounds__(NTHR, 2) hy_fwd(Args args) {
    extern __shared__ __attribute__((aligned(16))) unsigned char lds[];
    LAS unsigned char* L = (LAS unsigned char*)lds;
    volatile LAS unsigned* MISC = (volatile LAS unsigned*)(L + MISC_OFF);
    const int wv = __builtin_amdgcn_readfirstlane((int)threadIdx.x >> 6);
    if (wv == 0) MISC[pg8::lane_now()] = 0u;
    __syncthreads();
    XcdBarrier bar; bar.bar = (unsigned*)(ctlp() + CW_BAR); bar.x = 0; bar.st = nullptr; bar.wv = wv;
    if (N_LAUNCH_MODE == 0) bar = xcd_barrier_post((unsigned*)(ctlp() + CW_BAR), MISC + 8, wv);
    const int lo = args.ph_lo, hi = args.ph_hi;
#define IN(k) (lo <= (k) && (k) < hi)
#define SEAM(k) do { if (IN(k) && IN((k) + 1)) xcd_barrier(bar); } while (0)
    if (IN(0)) { Frame F = mkframe(L, wv); ph_prologue(F); if (REPEAT == 1) ph_prologue(F); }
    SEAM(0);
    auto layer = [&](const int l) __attribute__((always_inline)) {
        const int P = 1 + 9 * l;
        if (IN(P)) { phase_stagger(STAG);
            unsigned char* ws = wsp(); pg8::Gemm g{(const bf16*)(ws + WS_XB), (const bf16*)(ws + WS_WIN), M, NPROJ_P, DM, wv}; pg8::StaticOrder S; S.init(M, NPROJ_P, gridDim.x, (int)blockIdx.x);
            pg8::EpiProj E{(bf16*)(ws + WS_PROJ), NPROJ_P, (const pg8::fx_t*)((gu32*)ws + CW_SSQ) + (size_t)(2 * l) * M, (float*)(ws + CTL_KBAR) + (size_t)l * 64 * 8 * 64, (pg8::fx_t*)(ws + CTL_STATS) + (size_t)l * M * 2,
                           (const float*)(ws + WS_SMALL + SM_SAX), (const float*)(ws + WS_SMALL + SM_SWIN)};
            if (I8_IN) { g.A = (const bf16*)(ws + WS_XQ); pg8::MaskOrder S1; S1.init(M, 0xFFFFFFu & ~BFMASK, gridDim.x, (int)blockIdx.x);
                pg8::gemm_phase<pg8::EpiProj, pg8::MaskOrder, true, PG8_SP2, 1>(L + RING_OFF, g, S1, E);
                if (BFMASK) { pg8::Gemm gb{(const bf16*)(ws + WS_XB), winb_ptr(), M, NPROJ_P, DM, wv}; pg8::MaskOrder S2; S2.init(M, BFMASK, gridDim.x, (int)blockIdx.x);
                    pg8::gemm_phase<pg8::EpiProj, pg8::MaskOrder, true, PG8_SP2>(L + RING_OFF, gb, S2, E); } }
            else pg8::gemm_phase<pg8::EpiProj, pg8::StaticOrder, true, PG8_SP2>(L + RING_OFF, g, S, E);
            if (REPEAT == 21) { pg8::EpiNull E0{(float*)(ws + WS_YCAT)}; pg8::MaskOrder S1; S1.init(M, 0xFFFFFFu, gridDim.x, (int)blockIdx.x); pg8::gemm_phase<pg8::EpiNull, pg8::MaskOrder, true, PG8_SP2, 1>(L + RING_OFF, g, S1, E0); }
            if (REPEAT == 23) { pg8::EpiProjDense E3{(bf16*)(ws + WS_YCAT), E.ssq, E.sa, E.sw}; pg8::MaskOrder S1; S1.init(M, 0xFFFFFFu, gridDim.x, (int)blockIdx.x); pg8::gemm_phase<pg8::EpiProjDense, pg8::MaskOrder, true, PG8_SP2, 1>(L + RING_OFF, g, S1, E3); }
            if (REPEAT == 22) { pg8::EpiProj E2 = E; E2.kbar = (float*)(ws + WS_YCAT + 32 * MiB); E2.stats = (pg8::fx_t*)(ws + WS_YCAT + 40 * MiB); E2.O = (bf16*)(ws + WS_YCAT); E2.ldc = 256;
                pg8::MaskOrder S1; S1.init(M, 0xFFFFFFu, gridDim.x, (int)blockIdx.x); pg8::gemm_phase<pg8::EpiProj, pg8::MaskOrder, true, PG8_SP2, 1>(L + RING_OFF, g, S1, E2); }
            if (REPEAT == 2) { pg8::EpiProj E2 = E; E2.kbar = (float*)(ws + WS_YCAT); E2.stats = (pg8::fx_t*)(ws + WS_YCAT + 8 * MiB);
                if (I8_IN) { pg8::MaskOrder S1; S1.init(M, 0xFFFFFFu & ~BFMASK, gridDim.x, (int)blockIdx.x); pg8::gemm_phase<pg8::EpiProj, pg8::MaskOrder, true, PG8_SP2, 1>(L + RING_OFF, g, S1, E2);
                    if (BFMASK) { pg8::Gemm gb{(const bf16*)(ws + WS_XB), winb_ptr(), M, NPROJ_P, DM, wv}; pg8::MaskOrder S2; S2.init(M, BFMASK, gridDim.x, (int)blockIdx.x); pg8::gemm_phase<pg8::EpiProj, pg8::MaskOrder, true, PG8_SP2>(L + RING_OFF, gb, S2, E2); } }
                else pg8::gemm_phase<pg8::EpiProj, pg8::StaticOrder, true, PG8_SP2>(L + RING_OFF, g, S, E2); }
        }
        SEAM(P);
        if (IN(P + 1)) { Frame F = mkframe(L, wv); ph_prep(F, l); if (REPEAT == 3) ph_prep(F, l); }
        SEAM(P + 1);
        if (IN(P + 2)) { ph_mixers(L, l, P + 2, 0, wv); if (REPEAT == 4) ph_mixers(L, l, P + 2, 32, wv); if (REPEAT >= 40 && REPEAT < 50) ph_mixers(L, l, P + 2, 32, wv, REPEAT == 41 ? 1 : (REPEAT == 42 ? 2 : (REPEAT == 43 ? 4 : (REPEAT == 44 ? 8 : 16)))); if (REPEAT >= 430 && REPEAT < 446) ph_mixers(L, l, P + 2, 32, wv, 4); }
        SEAM(P + 2);
        if (IN(P + 3)) { Frame F = mkframe(L, wv); ph_finalize(F, l); if (REPEAT == 5) ph_finalize(F, l); }
        SEAM(P + 3);
        if (IN(P + 4)) { phase_stagger(STAG);
            unsigned char* ws = wsp(); pg8::Gemm g{(const bf16*)(ws + WS_YCAT), (const bf16*)(ws + WS_WOUT), M, DM, DM, wv}; pg8::StaticOrder S; S.init(M, DM, gridDim.x, (int)blockIdx.x);
            pg8::EpiRes E{(bf16*)(ws + WS_XB), FFN1_I8 ? (pg8::fx_t*)nullptr : (pg8::fx_t*)((gu32*)ws + CW_SSQ) + (size_t)(2 * l + 1) * M, DM, (FFN_FP8 && !FFN1_I8) ? (unsigned char*)(ws + WS_SC2) : nullptr, 1.0f, (const float*)(ws + WS_SMALL + SM_SAY), (const float*)(ws + WS_SMALL + SM_SWOUT)};
            if (I8_OUT) { g.A = (const bf16*)(ws + WS_YQ); pg8::gemm_phase<pg8::EpiRes, pg8::StaticOrder, true, PG8_SP2, 1>(L + RING_OFF, g, S, E); }
            else pg8::gemm_phase<pg8::EpiRes, pg8::StaticOrder, true, PG8_SP2>(L + RING_OFF, g, S, E);
            if (REPEAT == 7) { pg8::EpiRes E2 = E; E2.xb = (bf16*)(ws + WS_YCAT); E2.ssq = (pg8::fx_t*)(ws + WS_G); E2.xf = (unsigned char*)(ws + WS_YD);
                if (I8_OUT) pg8::gemm_phase<pg8::EpiRes, pg8::StaticOrder, true, PG8_SP2, 1>(L + RING_OFF, g, S, E2); else pg8::gemm_phase<pg8::EpiRes, pg8::StaticOrder, true, PG8_SP2>(L + RING_OFF, g, S, E2); }
        }
        SEAM(P + 4);
        if (FFN1_I8) { if (IN(P + 5)) { Frame F = mkframe(L, wv); ph_quantx(F, (pg8::fx_t*)(ctlp() + CW_SSQ) + (size_t)(2 * l + 1) * M); } SEAM(P + 5); }
        if (IN(P + 6)) {
            unsigned char* ws = wsp(); pg8::Gemm g{(const bf16*)(ws + (FFN1_I8 ? WS_XQ : (FFN_FP8 ? WS_SC2 : WS_XB))), (const bf16*)(ws + WS_WGU), M, 2 * DFF, DM, wv}; pg8::StaticOrder S; S.init(M, 2 * DFF, gridDim.x, (int)blockIdx.x);
            if (FFN_FP8) { pg8::EpiGU8 E{(unsigned char*)(ws + WS_PROJ), DFF, (const pg8::fx_t*)((gu32*)ws + CW_SSQ) + (size_t)(2 * l + 1) * M, FFN1_I8 ? 1.0f : 1.0f / 64.0f, 8.0f, (const float*)(ws + WS_SMALL + SM_SAX), (const float*)(ws + WS_SMALL + SM_SWGU)};
                if (FFN1_I8) pg8::gemm_phase<pg8::EpiGU8, pg8::StaticOrder, true, PG8_SP2, 1>(L + RING_OFF, g, S, E);
                else pg8::gemm_phase_f8<pg8::EpiGU8, pg8::StaticOrder, true, PG8_SP2>(L + RING_OFF, g, S, E);
                if (REPEAT == 6) { if (FFN1_I8) pg8::gemm_phase<pg8::EpiGU8, pg8::StaticOrder, true, PG8_SP2, 1>(L + RING_OFF, g, S, E); else pg8::gemm_phase_f8<pg8::EpiGU8, pg8::StaticOrder, true, PG8_SP2>(L + RING_OFF, g, S, E); }
            } else { pg8::EpiGU E{(bf16*)(ws + WS_PROJ), DFF, (const pg8::fx_t*)((gu32*)ws + CW_SSQ) + (size_t)(2 * l + 1) * M, 1.0f};
                pg8::gemm_phase<pg8::EpiGU, pg8::StaticOrder, true, PG8_SP2>(L + RING_OFF, g, S, E);
                if (REPEAT == 6) pg8::gemm_phase<pg8::EpiGU, pg8::StaticOrder, true, PG8_SP2>(L + RING_OFF, g, S, E); }
        }
        SEAM(P + 6);
        if (IN(P + 7)) { phase_stagger(STAG);
            unsigned char* ws = wsp(); pg8::Gemm g{(const bf16*)(ws + WS_PROJ), (const bf16*)(ws + WS_WDN), M, DM, DFF, wv}; pg8::StaticOrder S; S.init(M, DM, gridDim.x, (int)blockIdx.x);
            pg8::EpiRes E{(bf16*)(ws + WS_XB), I8_IN ? (pg8::fx_t*)nullptr : (pg8::fx_t*)((gu32*)ws + CW_SSQ) + (size_t)(2 * l + 2) * M, DM, nullptr, FFN_FP8 ? 1.0f / 512.0f : 1.0f, nullptr, nullptr};
            if (FFN_FP8) pg8::gemm_phase_f8<pg8::EpiRes, pg8::StaticOrder, true, PG8_SP2>(L + RING_OFF, g, S, E);
            else pg8::gemm_phase<pg8::EpiRes, pg8::StaticOrder, true, PG8_SP2>(L + RING_OFF, g, S, E);
            if (REPEAT == 8) { pg8::EpiRes E2 = E; E2.xb = (bf16*)(ws + WS_YCAT); E2.ssq = (pg8::fx_t*)(ws + WS_G);
                if (FFN_FP8) pg8::gemm_phase_f8<pg8::EpiRes, pg8::StaticOrder, true, PG8_SP2>(L + RING_OFF, g, S, E2); else pg8::gemm_phase<pg8::EpiRes, pg8::StaticOrder, true, PG8_SP2>(L + RING_OFF, g, S, E2); }
        }
        SEAM(P + 7);
        if (l + 1 < DEPTH) { if (I8_IN && IN(P + 8)) { Frame F = mkframe(L, wv); ph_quantx(F, (pg8::fx_t*)(ctlp() + CW_SSQ) + (size_t)(2 * l + 2) * M); } if (I8_IN) SEAM(P + 8); }
    };
    static_assert(DEPTH == 2, "layers are expanded by hand");
    layer(0); layer(1);
    if (IN(19)) { Frame F = mkframe(L, wv); ph_final(F); }
#undef IN
#undef SEAM
}

extern "C" void kernel_launch(void* const* d_in, const int* in_sizes, int n_in, void* d_out, int out_size, void* d_ws, size_t ws_size, hipStream_t stream) {
    static int grid = 0;
    if (grid == 0) {
        if (n_in != 25 || in_sizes[0] != M * DM || out_size != M * DM || ws_size < WS_END) { fprintf(stderr, "kernel_launch: shape/workspace mismatch: n_in %d in0 %d out %d ws %zu (need %zu)\n", n_in, n_in > 0 ? in_sizes[0] : -1, out_size, ws_size, (size_t)WS_END); grid = -1; return; }
        int dev = 0, cus = 0, per_cu = 0;
        if (hipGetDevice(&dev) != hipSuccess || hipDeviceGetAttribute(&cus, hipDeviceAttributeMultiprocessorCount, dev) != hipSuccess) { grid = -1; return; }
        if (hipFuncSetAttribute((const void*)hy_fwd, hipFuncAttributeMaxDynamicSharedMemorySize, LDS_BYTES) != hipSuccess) { fprintf(stderr, "kernel_launch: hipFuncSetAttribute failed\n"); grid = -1; return; }
        if (hipOccupancyMaxActiveBlocksPerMultiprocessor(&per_cu, (const void*)hy_fwd, NTHR, LDS_BYTES) != hipSuccess || per_cu < 1) fprintf(stderr, "kernel_launch: occupancy query reports %d\n", per_cu);
        (void)hipGetLastError();
        grid = cus;
    }
    if (grid < 0) return;
    if (hipMemsetAsync((char*)d_ws + WS_CTL, 0, CTL_ZERO_BYTES, stream) != hipSuccess) return;
    Args a{};
    for (int i = 0; i < 25; ++i) a.in[i] = (const float*)d_in[i];
    a.out = (float*)d_out; a.ws = (unsigned char*)d_ws;
    if (N_LAUNCH_MODE == 0) { a.ph_lo = 0; a.ph_hi = N_PHASES; hipLaunchKernelGGL(hy_fwd, dim3(grid), dim3(NTHR), LDS_BYTES, stream, a); }
    else for (int p = 0; p < N_PHASES; ++p) { a.ph_lo = p; a.ph_hi = p + 1; hipLaunchKernelGGL(hy_fwd, dim3(grid), dim3(NTHR), LDS_BYTES, stream, a); }
}
```

```cpp
#define N_LAUNCH_MODE 0
#define REPEAT 0
#define PG8_SP2 true
#define FFN_FP8 1
#define GEMM_I8 3
#define STAG 0
#define FFN1_I8 1
#define BFMASK 0x0u
#include <hip/hip_runtime.h>
#include <cstdio>
#include <cstdint>
namespace pg8 {
#define PG8_LAS __attribute__((address_space(3)))
typedef unsigned short bf16_t;
typedef short bf16x8 __attribute__((ext_vector_type(8)));
typedef float f32x4 __attribute__((ext_vector_type(4)));
typedef unsigned u32x4 __attribute__((ext_vector_type(4)));
constexpr int BM = 256, BK = 64, HALF = 128, HTB = HALF * BK * 2  , STAGE_BYTES = 8 * HTB, NXCD = 8, WGM = 8;

__host__ __device__ __forceinline__ int lds_byte(int r, int c) { const int st = (r >> 4) * 2 + (c >> 5), rr = r & 15, cc = c & 31, ob = rr * 64 + cc * 2; return st * 1024 + (ob ^ (((ob >> 9) & 1) << 5)); }
__host__ __device__ __forceinline__ void stage_rc(int b, int& R, int& C) { const int st = b / 1024, sb = b % 1024, swz = sb ^ (((sb >> 9) & 1) << 5); R = (st >> 1) * 16 + swz / 64; C = (st & 1) * 32 + (swz % 64) / 2; }
__host__ __device__ __forceinline__ int perm32(int rho) { const int n = rho >> 4, i = rho & 15; return 8 * (i >> 2) + 4 * n + (i & 3); }

__device__ __forceinline__ int lane_now() { int l; asm volatile("v_mbcnt_lo_u32_b32 %0, -1, 0\n\tv_mbcnt_hi_u32_b32 %0, -1, %0" : "=v"(l)); return l; }
struct Unit { int pm, pn; };
struct Gemm { const bf16_t* A; const bf16_t* Bt; int M, N, K, wv; int same = 0; };

struct StaticOrder {
    int nM, nN, nwg, G, c;
    __host__ __device__ void init(int M, int N, int G_, int c_) { nM = M / BM; nN = N / BM; nwg = nM * nN; G = G_; c = c_; }
    __host__ __device__ bool next(int i, Unit& u) const {
        const long L = (long)i * G + c; if (L >= nwg) return false;
        int wgid = (int)L; { const int q = nwg / NXCD, r = nwg % NXCD, xcd = wgid % NXCD, off = wgid / NXCD; wgid = (xcd < r ? xcd * (q + 1) : r * (q + 1) + (xcd - r) * q) + off; }
        const int nig = WGM * nN, gid = wgid / nig, fm = gid * WGM, gsz = (nM - fm) < WGM ? (nM - fm) : WGM;
        u.pm = fm + ((wgid % nig) % gsz); u.pn = (wgid % nig) / gsz; return true;
    }
    __device__ __forceinline__ void a_ready(const Unit&) const {}
    __device__ __forceinline__ void done(const Unit&) const {}
};

struct MapOrder {
    StaticOrder s; int from, add;
    __device__ __forceinline__ bool next(int i, Unit& u) const { if (!s.next(i, u)) return false; if (u.pn >= from) u.pn += add; return true; }
    __device__ __forceinline__ void a_ready(const Unit&) const {}
    __device__ __forceinline__ void done(const Unit&) const {}
};

struct MaskOrder {
    StaticOrder s; unsigned mask;
    __device__ __forceinline__ void init(int M, unsigned mask_, int G_, int c_) { mask = mask_; s.init(M, BM * __builtin_popcount(mask_), G_, c_); }
    __device__ __forceinline__ bool next(int i, Unit& u) const { if (!s.next(i, u)) return false; unsigned m = mask; for (int j = 0; j < u.pn; ++j) m &= m - 1; u.pn = __builtin_ctz(m); return true; }
    __device__ __forceinline__ void a_ready(const Unit&) const {}
    __device__ __forceinline__ void done(const Unit&) const {}
};

__device__ __forceinline__ unsigned cvt_pk_bf16(float lo, float hi) { unsigned r; asm volatile("v_cvt_pk_bf16_f32 %0, %1, %2" : "=v"(r) : "v"(lo), "v"(hi)); return r; }
typedef float f32x2 __attribute__((ext_vector_type(2)));

typedef unsigned u32x2 __attribute__((ext_vector_type(2)));
typedef unsigned long long fx_t;
__device__ __forceinline__ void fx_add(fx_t* p, float v) { atomicAdd(p, (fx_t)(long long)__float2ll_rn(v * 1073741824.0f)); }
__device__ __forceinline__ float fx_get(const fx_t* p) { return (float)(long long)(*p) * (1.0f / 1073741824.0f); }
__device__ __forceinline__ float epi_gelu(float x) { const float u = 0.7978845608028654f * (x + 0.044715f * x * x * x); const float e2 = __expf(2.0f * u); return x - x * __builtin_amdgcn_rcpf(e2 + 1.0f); }
template <int CTRL> __device__ __forceinline__ float epi_dpp_add(float x) { const int y = __builtin_amdgcn_update_dpp(0, __builtin_bit_cast(int, x), CTRL, 0xF, 0xF, false); return x + __builtin_bit_cast(float, y); }
typedef int i32x4_t __attribute__((ext_vector_type(4)));
__device__ __forceinline__ f32x4 acc_f(const f32x4& v) { return v; }
__device__ __forceinline__ f32x4 acc_f(const i32x4_t& v) { return __builtin_convertvector(v, f32x4); }
template <class T> struct AccIsInt { static constexpr bool v = false; };
template <> struct AccIsInt<i32x4_t> { static constexpr bool v = true; };
__device__ __forceinline__ void epi_prefetch(const fx_t* ssq_rows, const float* sa_rows, const float* sw_cols, PG8_LAS unsigned char* slot, int wid) {
    const int ln = lane_now();
    __builtin_amdgcn_global_load_lds((const __attribute__((address_space(1))) unsigned*)((const unsigned*)ssq_rows + wid * 64 + ln), (PG8_LAS unsigned*)(slot + wid * 256), 4, 0, 0);
    if (sa_rows) { const float* src = wid < 4 ? sa_rows + wid * 64 : sw_cols + (wid - 4) * 64;
        __builtin_amdgcn_global_load_lds((const __attribute__((address_space(1))) unsigned*)((const unsigned*)src + ln), (PG8_LAS unsigned*)(slot + 2048 + wid * 256), 4, 0, 0); }
}
__device__ __forceinline__ float fx_getl(const PG8_LAS unsigned char* slot, int rloc) { return (float)(long long)(*(const PG8_LAS fx_t*)(slot + 8 * rloc)) * (1.0f / 1073741824.0f); }
struct EpiProj {
    static constexpr bool PERM = true, AFTER_DRAIN = false, PREFETCH = true;
    bf16_t* O; int ldc; const fx_t* ssq; float* kbar; fx_t* stats; const float* sa; const float* sw;
    __device__ __forceinline__ void prefetch(const Unit& u, PG8_LAS unsigned char* slot, int wid) const { epi_prefetch(ssq + u.pm * BM, sa ? sa + u.pm * BM : nullptr, sw + u.pn * BM, slot, wid); }
    template <class AccT> __device__ __forceinline__ void operator()(const AccT (&acc)[2][2][4][2], const Unit& u, int wr, int wc, int fr, int fq, const PG8_LAS unsigned char* slot) const {
        constexpr bool Q = AccIsInt<AccT>::v;
        const int row0 = u.pm * BM + wr * 64 + fr, col0 = u.pn * BM + wc * 32 + 8 * fq;
        f32x4 cw[2][2];
        if constexpr (Q) {
#pragma unroll
            for (int bj = 0; bj < 2; ++bj) { const PG8_LAS float* p = (const PG8_LAS float*)(slot + 3072) + bj * HALF + wc * 32 + 8 * fq; cw[bj][0] = *(const PG8_LAS f32x4*)p; cw[bj][1] = *(const PG8_LAS f32x4*)(p + 4); } }
        const bool do_k = (u.pn == 12 || u.pn == 13), do_s = (u.pn == 8 || u.pn == 9);
        float cs[2][8];
#pragma unroll
        for (int bj = 0; bj < 2; ++bj)
#pragma unroll
            for (int e = 0; e < 8; ++e) cs[bj][e] = 0.f;
#pragma unroll
        for (int ai = 0; ai < 2; ++ai)
#pragma unroll
            for (int m = 0; m < 4; ++m) { const int row = row0 + ai * HALF + m * 16; const int rloc = ai * HALF + wr * 64 + m * 16 + fr; float rs = __builtin_amdgcn_rsqf(fx_getl(slot, rloc) * (1.0f / 2048.0f) + 1e-6f); if constexpr (Q) rs *= *(const PG8_LAS float*)(slot + 2048 + 4 * rloc);
                bf16_t* rowp = O + (size_t)row * ldc + col0; float s1 = 0.f, s2 = 0.f;
#pragma unroll
                for (int bj = 0; bj < 2; ++bj) { f32x4 v0 = acc_f(acc[ai][bj][m][0]) * rs, v1 = acc_f(acc[ai][bj][m][1]) * rs; if constexpr (Q) { v0 *= cw[bj][0]; v1 *= cw[bj][1]; }
                    u32x4 w; w.x = cvt_pk_bf16(v0[0], v0[1]); w.y = cvt_pk_bf16(v0[2], v0[3]); w.z = cvt_pk_bf16(v1[0], v1[1]); w.w = cvt_pk_bf16(v1[2], v1[3]);
                    *(u32x4*)(rowp + bj * HALF) = w;
                    if (do_k) {
#pragma unroll
                        for (int e = 0; e < 4; ++e) { cs[bj][e] += v0[e]; cs[bj][4 + e] += v1[e]; } }
                    if (do_s) {
#pragma unroll
                        for (int e = 0; e < 4; ++e) { const float g0 = epi_gelu(v0[e]), g1 = epi_gelu(v1[e]); s1 += g0 + g1; s2 += g0 * g0 + g1 * g1; } } }
                if (do_s) { s1 += __shfl_xor(s1, 16); s1 += __shfl_xor(s1, 32); s2 += __shfl_xor(s2, 16); s2 += __shfl_xor(s2, 32);
                    if (fq == 0) { fx_add(stats + 2 * row, s1); fx_add(stats + 2 * row + 1, s2); } } }
        if (do_k) {
            const int bidx = (u.pm >> 3) * 8, n = u.pm & 7;
#pragma unroll
            for (int bj = 0; bj < 2; ++bj)
#pragma unroll
                for (int e = 0; e < 8; ++e) { float s = cs[bj][e]; s = epi_dpp_add<0xB1>(s); s = epi_dpp_add<0x4E>(s); s = epi_dpp_add<0x141>(s); s = epi_dpp_add<0x140>(s);
                    const int ck = col0 + bj * HALF + e - 3072;
                    if (fr == 0) unsafeAtomicAdd(kbar + ((bidx + (ck >> 6)) * 8 + n) * 64 + (ck & 63), s * (1.0f / 256.0f)); } }
    }
};
struct EpiGU {
    static constexpr bool PERM = true, AFTER_DRAIN = false, PREFETCH = false;
    bf16_t* O; int ldc; const fx_t* ssq; float oscale;
    __device__ __forceinline__ void operator()(const f32x4 (&acc)[2][2][4][2], const Unit& u, int wr, int wc, int fr, int fq, const PG8_LAS unsigned char* slot) const {
        const int row0 = u.pm * BM + wr * 64 + fr, col0 = u.pn * HALF + wc * 32 + 8 * fq;
#pragma unroll
        for (int ai = 0; ai < 2; ++ai)
#pragma unroll
            for (int m = 0; m < 4; ++m) { const int row = row0 + ai * HALF + m * 16; const float rs = __builtin_amdgcn_rsqf(fx_get(ssq + row) * (1.0f / 2048.0f) + 1e-6f) * oscale;
                float o[8];
#pragma unroll
                for (int n = 0; n < 2; ++n)
#pragma unroll
                    for (int e = 0; e < 4; ++e) { const float g = acc[ai][0][m][n][e] * rs, up = acc[ai][1][m][n][e] * rs;
                        o[n * 4 + e] = g * __builtin_amdgcn_rcpf(1.0f + __builtin_amdgcn_exp2f(-1.4426950408889634f * g)) * up; }
                u32x4 w; w.x = cvt_pk_bf16(o[0], o[1]); w.y = cvt_pk_bf16(o[2], o[3]); w.z = cvt_pk_bf16(o[4], o[5]); w.w = cvt_pk_bf16(o[6], o[7]);
                *(u32x4*)(O + (size_t)row * ldc + col0) = w; }
    }
};
__device__ __forceinline__ float epi_clamp8(float v) { return __builtin_amdgcn_fmed3f(v, -448.0f, 448.0f); }
struct EpiGU8 {
    static constexpr bool PERM = true, AFTER_DRAIN = false, PREFETCH = true;
    __device__ __forceinline__ void prefetch(const Unit& u, PG8_LAS unsigned char* slot, int wid) const { epi_prefetch(ssq + u.pm * BM, sa ? sa + u.pm * BM : nullptr, sw + u.pn * BM, slot, wid); }
    unsigned char* O; int ldc; const fx_t* ssq; float oscale, ascale; const float* sa; const float* sw;
    template <class AccT> __device__ __forceinline__ void operator()(const AccT (&acc)[2][2][4][2], const Unit& u, int wr, int wc, int fr, int fq, const PG8_LAS unsigned char* slot) const {
        constexpr bool Q = AccIsInt<AccT>::v;
        const int row0 = u.pm * BM + wr * 64 + fr, col0 = u.pn * HALF + wc * 32 + 8 * fq;
        f32x4 cw[2][2];
        if constexpr (Q) {
#pragma unroll
            for (int bj = 0; bj < 2; ++bj) { const PG8_LAS float* p = (const PG8_LAS float*)(slot + 3072) + bj * HALF + wc * 32 + 8 * fq; cw[bj][0] = *(const PG8_LAS f32x4*)p; cw[bj][1] = *(const PG8_LAS f32x4*)(p + 4); } }
#pragma unroll
        for (int ai = 0; ai < 2; ++ai)
#pragma unroll
            for (int m = 0; m < 4; ++m) { const int row = row0 + ai * HALF + m * 16; const int rloc = ai * HALF + wr * 64 + m * 16 + fr; float rs = __builtin_amdgcn_rsqf(fx_getl(slot, rloc) * (1.0f / 2048.0f) + 1e-6f) * oscale; if constexpr (Q) rs *= *(const PG8_LAS float*)(slot + 2048 + 4 * rloc);
                float o[8];
#pragma unroll
                for (int n = 0; n < 2; ++n) { f32x4 gv = acc_f(acc[ai][0][m][n]) * rs, uv = acc_f(acc[ai][1][m][n]) * rs; if constexpr (Q) { gv *= cw[0][n]; uv *= cw[1][n]; }
#pragma unroll
                    for (int e = 0; e < 4; ++e) { const float g = gv[e], up = uv[e];
                        o[n * 4 + e] = epi_clamp8(g * __builtin_amdgcn_rcpf(1.0f + __builtin_amdgcn_exp2f(-1.4426950408889634f * g)) * up * ascale); } }
                int f0 = __builtin_bit_cast(int, o[0]), f1 = __builtin_bit_cast(int, o[4]);
                f0 = __builtin_amdgcn_cvt_pk_fp8_f32(o[0], o[1], f0, false); f0 = __builtin_amdgcn_cvt_pk_fp8_f32(o[2], o[3], f0, true);
                f1 = __builtin_amdgcn_cvt_pk_fp8_f32(o[4], o[5], f1, false); f1 = __builtin_amdgcn_cvt_pk_fp8_f32(o[6], o[7], f1, true);
                *(u32x2*)(O + (size_t)row * ldc + col0) = (u32x2){(unsigned)f0, (unsigned)f1}; }
    }
};
struct EpiRes {
    static constexpr bool PERM = true, AFTER_DRAIN = false, PREFETCH = false;
    bf16_t* xb; fx_t* ssq; int ldc; unsigned char* xf; float oscale; const float* sa; const float* sw;
    template <class AccT> __device__ __forceinline__ void operator()(const AccT (&acc)[2][2][4][2], const Unit& u, int wr, int wc, int fr, int fq, const PG8_LAS unsigned char* slot) const {
        constexpr bool Q = AccIsInt<AccT>::v;
        const int row0 = u.pm * BM + wr * 64 + fr, col0 = u.pn * BM + wc * 32 + 8 * fq;
        f32x4 cw[2][2];
        if constexpr (Q) {
#pragma unroll
            for (int bj = 0; bj < 2; ++bj) { cw[bj][0] = *(const f32x4*)(sw + col0 + bj * HALF); cw[bj][1] = *(const f32x4*)(sw + col0 + bj * HALF + 4); } }
#pragma unroll
        for (int ai = 0; ai < 2; ++ai)
#pragma unroll
            for (int m = 0; m < 4; ++m) { const int row = row0 + ai * HALF + m * 16; bf16_t* rowp = xb + (size_t)row * ldc + col0; float s = 0.f; float osc = oscale; if constexpr (Q) osc = sa[row];
                u32x4 b[2];
#pragma unroll
                for (int bj = 0; bj < 2; ++bj) b[bj] = *(const u32x4*)(rowp + bj * HALF);
#pragma unroll
                for (int bj = 0; bj < 2; ++bj) { float o[8]; f32x4 a2[2] = {acc_f(acc[ai][bj][m][0]), acc_f(acc[ai][bj][m][1])}; if constexpr (Q) { a2[0] *= cw[bj][0]; a2[1] *= cw[bj][1]; }
#pragma unroll
                    for (int q = 0; q < 4; ++q) { o[2 * q] = __builtin_fmaf(a2[q >> 1][2 * (q & 1)], osc, __builtin_bit_cast(float, b[bj][q] << 16)); o[2 * q + 1] = __builtin_fmaf(a2[q >> 1][2 * (q & 1) + 1], osc, __builtin_bit_cast(float, b[bj][q] & 0xffff0000u)); }
                    u32x4 w; w.x = cvt_pk_bf16(o[0], o[1]); w.y = cvt_pk_bf16(o[2], o[3]); w.z = cvt_pk_bf16(o[4], o[5]); w.w = cvt_pk_bf16(o[6], o[7]);
                    *(u32x4*)(rowp + bj * HALF) = w;
                    if (xf) { int f0 = (int)b[bj][0], f1 = (int)b[bj][1]; f0 = __builtin_amdgcn_cvt_pk_fp8_f32(epi_clamp8(o[0]), epi_clamp8(o[1]), f0, false); f0 = __builtin_amdgcn_cvt_pk_fp8_f32(epi_clamp8(o[2]), epi_clamp8(o[3]), f0, true);
                        f1 = __builtin_amdgcn_cvt_pk_fp8_f32(epi_clamp8(o[4]), epi_clamp8(o[5]), f1, false); f1 = __builtin_amdgcn_cvt_pk_fp8_f32(epi_clamp8(o[6]), epi_clamp8(o[7]), f1, true);
                        *(u32x2*)(xf + (size_t)row * ldc + col0 + bj * HALF) = (u32x2){(unsigned)f0, (unsigned)f1}; }
                    if (ssq) {
#pragma unroll
                        for (int q = 0; q < 8; ++q) s += o[q] * o[q]; } }
                if (ssq) { s += __shfl_xor(s, 16); s += __shfl_xor(s, 32);
                    if (fq == 0) fx_add(ssq + row, s); } }
    }
};

struct EpiNull {
    static constexpr bool PERM = true, AFTER_DRAIN = false, PREFETCH = false;
    float* sink;
    template <class AccT> __device__ __forceinline__ void operator()(const AccT (&acc)[2][2][4][2], const Unit& u, int wr, int wc, int fr, int fq, const PG8_LAS unsigned char* slot) const {
        f32x4 s = {0.f, 0.f, 0.f, 0.f};
#pragma unroll
        for (int ai = 0; ai < 2; ++ai)
#pragma unroll
            for (int bj = 0; bj < 2; ++bj)
#pragma unroll
                for (int m = 0; m < 4; ++m)
#pragma unroll
                    for (int n = 0; n < 2; ++n) s += acc_f(acc[ai][bj][m][n]);
        if (s[0] + s[1] + s[2] + s[3] == 1.2345e30f) sink[0] = s[0];
    }
};

struct EpiProjDense {
    static constexpr bool PERM = true, AFTER_DRAIN = false, PREFETCH = false;
    bf16_t* O; const fx_t* ssq; const float* sa; const float* sw;
    template <class AccT> __device__ __forceinline__ void operator()(const AccT (&acc)[2][2][4][2], const Unit& u, int wr, int wc, int fr, int fq, const PG8_LAS unsigned char* slot) const {
        const int row0 = u.pm * BM + wr * 64 + fr, col0 = u.pn * BM + wc * 32 + 8 * fq;
        f32x4 cw[2][2];
#pragma unroll
        for (int bj = 0; bj < 2; ++bj) { cw[bj][0] = *(const f32x4*)(sw + col0 + bj * HALF); cw[bj][1] = *(const f32x4*)(sw + col0 + bj * HALF + 4); }
        bf16_t* base = O + ((size_t)(((u.pm * 24 + u.pn) & 255) * 8 + wr * 4 + wc) * 16) * 512 + (fq * 16 + fr) * 8;
#pragma unroll
        for (int ai = 0; ai < 2; ++ai)
#pragma unroll
            for (int m = 0; m < 4; ++m) { const int row = row0 + ai * HALF + m * 16; float rs = __builtin_amdgcn_rsqf(fx_get(ssq + row) * (1.0f / 2048.0f) + 1e-6f) * sa[row];
#pragma unroll
                for (int bj = 0; bj < 2; ++bj) { f32x4 v0 = acc_f(acc[ai][bj][m][0]) * rs * cw[bj][0], v1 = acc_f(acc[ai][bj][m][1]) * rs * cw[bj][1];
                    u32x4 w; w.x = cvt_pk_bf16(v0[0], v0[1]); w.y = cvt_pk_bf16(v0[2], v0[3]); w.z = cvt_pk_bf16(v1[0], v1[1]); w.w = cvt_pk_bf16(v1[2], v1[3]);
                    *(u32x4*)(base + ((ai * 4 + m) * 2 + bj) * 512) = w; } }
    }
};
typedef int i32x8_t __attribute__((ext_vector_type(8)));
constexpr int PG8_PRM_OFF = STAGE_BYTES + 1024;
__device__ __forceinline__ void mma16(f32x4& c, const bf16x8& a, const bf16x8& b) { c = __builtin_amdgcn_mfma_f32_16x16x32_bf16(a, b, c, 0, 0, 0); }
__device__ __forceinline__ void mma16(i32x4_t& c, const bf16x8& a, const bf16x8& b) { c = __builtin_amdgcn_mfma_i32_16x16x64_i8(__builtin_bit_cast(i32x4_t, a), __builtin_bit_cast(i32x4_t, b), c, 0, 0, 0); }
template <int EB> struct AccOf { typedef f32x4 type; };
template <> struct AccOf<1> { typedef i32x4_t type; };
template <class Epi, class Sched, bool ALIGN_EPI = false, bool SP2 = false, int EB = 2>
__device__ __forceinline__ void gemm_phase(PG8_LAS unsigned char* lds, const Gemm g, const Sched& S, const Epi& E) {
    int tid_ = g.wv * 64 + lane_now(); asm volatile("" : "+v"(tid_));
    const int tid = tid_, wid = __builtin_amdgcn_readfirstlane(tid >> 6), lane = tid & 63, wr = wid >> 2, wc = wid & 3, fr = lane & 15, fq = lane >> 4;
    const int K = g.K, nt = K * EB / (2 * BK);
    unsigned voffA[2], voffB[2];
#pragma unroll
    for (int i = 0; i < 2; ++i) { int R, C; stage_rc(tid * 16 + i * 8192, R, C); const int Rb = Epi::PERM ? ((R & ~31) + perm32(R & 31)) : R;
        voffA[i] = (unsigned)(R * K * EB + 2 * C); voffB[i] = (unsigned)(Rb * K * EB + 2 * C); }
    const unsigned kstep = (unsigned)(BK * 2);
    const unsigned hstep = (unsigned)HALF * K * EB;
    const unsigned tstep = 2 * hstep;
    const unsigned ldsw = (unsigned)wid * 1024u;
    const int aoff = lds_byte(wr * 64 + fr, fq * 8), boff = lds_byte(wc * 32 + fr, fq * 8);
#define PG8_SA(b, h) (((b) * 2 + (h)) * HTB)
#define PG8_SB(b, h) ((4 + (b) * 2 + (h)) * HTB)
#define PG8_STAGE(bufoff, rsrc, soff, voff) do { _Pragma("unroll") for (int _i = 0; _i < 2; ++_i) \
        __builtin_amdgcn_raw_ptr_buffer_load_lds(rsrc, (PG8_LAS void*)(lds + (bufoff) + ldsw + _i * 8192), 16, (int)(voff)[_i], (int)(soff), 0, 0); } while (0)
#define PG8_LDA(dst, b, h) do { _Pragma("unroll") for (int m = 0; m < 4; ++m) _Pragma("unroll") for (int k = 0; k < 2; ++k) dst[m][k] = *(const PG8_LAS bf16x8*)(lds + PG8_SA(b, h) + aoff + m * 2048 + k * 1024); } while (0)
#define PG8_LDB(dst, b, h) do { _Pragma("unroll") for (int n = 0; n < 2; ++n) _Pragma("unroll") for (int k = 0; k < 2; ++k) dst[n][k] = *(const PG8_LAS bf16x8*)(lds + PG8_SB(b, h) + boff + n * 2048 + k * 1024); } while (0)
#define PG8_MMA(ai, bj, At, Bt) do { __builtin_amdgcn_s_setprio(1); _Pragma("unroll") for (int m = 0; m < 4; ++m) _Pragma("unroll") for (int n = 0; n < 2; ++n) _Pragma("unroll") for (int k = 0; k < 2; ++k) \
        mma16(acc[ai][bj][m][n], Bt[n][k], At[m][k]); __builtin_amdgcn_s_setprio(0); } while (0)
#define PG8_WAIT_V(n) asm volatile("s_waitcnt vmcnt(" #n ")" ::: "memory")
#define PG8_WAIT_L(n) asm volatile("s_waitcnt lgkmcnt(" #n ")" ::: "memory")
#define PG8_BAR __builtin_amdgcn_s_barrier()
#define PG8_SCHED __builtin_amdgcn_sched_barrier(0)
    Unit cur, nxt; int ui = 0;
    if (!S.next(0, cur)) return;
    typedef typename AccOf<EB>::type acc_t; acc_t acc[2][2][4][2];
#pragma unroll
    for (int a = 0; a < 2; ++a)
#pragma unroll
        for (int b = 0; b < 2; ++b)
#pragma unroll
            for (int m = 0; m < 4; ++m)
#pragma unroll
                for (int n = 0; n < 2; ++n) acc[a][b][m][n] = acc_t{};
    bf16x8 At[4][2], B0[2][2], B1[2][2];
    const __amdgpu_buffer_rsrc_t rA = __builtin_amdgcn_make_buffer_rsrc((void*)g.A, (short)0, -1, 0x00020000), rB = __builtin_amdgcn_make_buffer_rsrc((void*)g.Bt, (short)0, -1, 0x00020000);
    unsigned cA = g.same ? 0u : (unsigned)cur.pm * tstep, cB = g.same ? 0u : (unsigned)cur.pn * tstep;
    S.a_ready(cur);
    if constexpr (SP2) {
        PG8_STAGE(PG8_SB(0, 0), rB, cB, voffB); PG8_STAGE(PG8_SB(0, 1), rB, cB + hstep, voffB); PG8_STAGE(PG8_SA(0, 0), rA, cA, voffA); PG8_STAGE(PG8_SA(0, 1), rA, cA + hstep, voffA);
        if (wr == 1) PG8_BAR;
        PG8_WAIT_V(2); PG8_BAR;
        PG8_STAGE(PG8_SB(1, 0), rB, cB + kstep, voffB); PG8_STAGE(PG8_SA(1, 0), rA, cA + kstep, voffA); PG8_STAGE(PG8_SB(1, 1), rB, cB + hstep + kstep, voffB);
        PG8_WAIT_V(6); PG8_BAR;
    } else {
        PG8_STAGE(PG8_SB(0, 0), rB, cB, voffB); PG8_STAGE(PG8_SA(0, 0), rA, cA, voffA); PG8_STAGE(PG8_SB(0, 1), rB, cB + hstep, voffB); PG8_STAGE(PG8_SA(0, 1), rA, cA + hstep, voffA);
        if (wr == 1) PG8_BAR;
        PG8_WAIT_V(4); PG8_BAR;
        PG8_STAGE(PG8_SB(1, 0), rB, cB + kstep, voffB); PG8_STAGE(PG8_SA(1, 0), rA, cA + kstep, voffA); PG8_STAGE(PG8_SB(1, 1), rB, cB + hstep + kstep, voffB);
        PG8_WAIT_V(6); PG8_BAR;
    }
    for (;;) {
        const bool has_next = S.next(ui + 1, nxt);
        const unsigned nA = (has_next && !g.same) ? (unsigned)nxt.pm * tstep : cA, nB = (has_next && !g.same) ? (unsigned)nxt.pn * tstep : cB;
        for (int t = 0; t < nt; t += 2) {
            const bool last = (t == nt - 2);
            const unsigned a1 = cA + (unsigned)(t + 1) * kstep;
            const unsigned a2 = last ? nA : cA + (unsigned)(t + 2) * kstep, b2 = last ? nB : cB + (unsigned)(t + 2) * kstep;
            const unsigned a3 = a2 + kstep, b3 = b2 + kstep;
            if (last && has_next) S.a_ready(nxt);
            if constexpr (Epi::PREFETCH) { if (t == 0) E.prefetch(cur, lds + PG8_PRM_OFF + (ui & 1) * 4096, wid); }
            if constexpr (SP2) {
            PG8_LDB(B0, 0, 0); PG8_LDB(B1, 0, 1); PG8_SCHED; PG8_LDA(At, 0, 0); PG8_STAGE(PG8_SA(1, 1), rA, a1 + hstep, voffA);
            PG8_WAIT_V(8); PG8_WAIT_L(0); PG8_BAR; PG8_MMA(0, 0, At, B0); PG8_MMA(0, 1, At, B1); PG8_BAR; PG8_SCHED;
            PG8_LDA(At, 0, 1); PG8_STAGE(PG8_SB(0, 0), rB, b2, voffB); PG8_STAGE(PG8_SB(0, 1), rB, b2 + hstep, voffB); PG8_STAGE(PG8_SA(0, 0), rA, a2, voffA);
            PG8_WAIT_V(8); PG8_WAIT_L(0); PG8_BAR; PG8_MMA(1, 0, At, B0); PG8_MMA(1, 1, At, B1); PG8_BAR; PG8_SCHED;
            PG8_LDB(B0, 1, 0); PG8_LDB(B1, 1, 1); PG8_SCHED; PG8_LDA(At, 1, 0); PG8_STAGE(PG8_SA(0, 1), rA, a2 + hstep, voffA);
            PG8_WAIT_V(8); PG8_WAIT_L(0); PG8_BAR; PG8_MMA(0, 0, At, B0); PG8_MMA(0, 1, At, B1); PG8_BAR; PG8_SCHED;
            PG8_LDA(At, 1, 1); PG8_STAGE(PG8_SB(1, 0), rB, b3, voffB); PG8_STAGE(PG8_SB(1, 1), rB, b3 + hstep, voffB); PG8_STAGE(PG8_SA(1, 0), rA, a3, voffA);
            PG8_WAIT_V(8); PG8_WAIT_L(0); PG8_BAR; PG8_MMA(1, 0, At, B0); PG8_MMA(1, 1, At, B1); PG8_BAR; PG8_SCHED;
            } else {
            PG8_LDB(B0, 0, 0); PG8_SCHED; PG8_LDA(At, 0, 0); PG8_STAGE(PG8_SA(1, 1), rA, a1 + hstep, voffA);
            PG8_WAIT_L(8); PG8_BAR; PG8_WAIT_L(0); PG8_MMA(0, 0, At, B0); PG8_BAR; PG8_SCHED;
            PG8_LDB(B1, 0, 1); PG8_STAGE(PG8_SB(0, 0), rB, b2, voffB);
            PG8_BAR; PG8_WAIT_L(0); PG8_MMA(0, 1, At, B1); PG8_BAR;
            PG8_LDA(At, 0, 1); PG8_STAGE(PG8_SA(0, 0), rA, a2, voffA);
            PG8_BAR; PG8_WAIT_L(0); PG8_MMA(1, 0, At, B0); PG8_BAR; PG8_SCHED;
            PG8_STAGE(PG8_SB(0, 1), rB, b2 + hstep, voffB);
            PG8_WAIT_V(6); PG8_BAR; PG8_MMA(1, 1, At, B1); PG8_BAR;
            PG8_LDB(B0, 1, 0); PG8_SCHED; PG8_LDA(At, 1, 0); PG8_STAGE(PG8_SA(0, 1), rA, a2 + hstep, voffA);
            PG8_WAIT_L(8); PG8_BAR; PG8_WAIT_L(0); PG8_MMA(0, 0, At, B0); PG8_BAR; PG8_SCHED;
            PG8_LDB(B1, 1, 1); PG8_STAGE(PG8_SB(1, 0), rB, b3, voffB);
            PG8_BAR; PG8_WAIT_L(0); PG8_MMA(0, 1, At, B1); PG8_BAR;
            PG8_LDA(At, 1, 1); PG8_STAGE(PG8_SA(1, 0), rA, a3, voffA);
            PG8_BAR; PG8_WAIT_L(0); PG8_MMA(1, 0, At, B0); PG8_BAR; PG8_SCHED;
            PG8_STAGE(PG8_SB(1, 1), rB, b3 + hstep, voffB);
            PG8_WAIT_V(6); PG8_BAR; PG8_MMA(1, 1, At, B1); PG8_BAR;
            }
        }
        if constexpr (ALIGN_EPI) { if (wr == 0) PG8_BAR; }
        if constexpr (!Epi::AFTER_DRAIN) { int ln_ = (int)__builtin_amdgcn_mbcnt_hi(~0u, __builtin_amdgcn_mbcnt_lo(~0u, 0u)); asm volatile("" : "+v"(ln_));
            E(acc, cur, wr, wc, ln_ & 15, ln_ >> 4, lds + PG8_PRM_OFF + (ui & 1) * 4096); S.done(cur); }
        if (!has_next) break;
#pragma unroll
        for (int a = 0; a < 2; ++a)
#pragma unroll
            for (int b = 0; b < 2; ++b)
#pragma unroll
                for (int m = 0; m < 4; ++m)
#pragma unroll
                    for (int n = 0; n < 2; ++n) acc[a][b][m][n] = acc_t{};
        cur = nxt; cA = nA; cB = nB; ++ui;
        if constexpr (ALIGN_EPI) { if (wr == 1) PG8_BAR; }
    }
    PG8_WAIT_V(0);
    if constexpr (!ALIGN_EPI) { if (wr == 0) PG8_BAR; }
    PG8_BAR;
    if constexpr (Epi::AFTER_DRAIN) { E.fused(acc, cur, wr, wc, fr, fq, lds, wid, lane); S.done(cur); }
#undef PG8_SA
#undef PG8_SB
#undef PG8_STAGE
#undef PG8_LDA
#undef PG8_LDB
#undef PG8_MMA
#undef PG8_WAIT_V
#undef PG8_WAIT_L
#undef PG8_BAR
#undef PG8_SCHED
}
template <class Epi, class Sched, bool ALIGN_EPI = false, bool SP2 = false>
__device__ __forceinline__ void gemm_phase_f8(PG8_LAS unsigned char* lds, const Gemm g, const Sched& S, const Epi& E) {
    int tid_ = g.wv * 64 + lane_now(); asm volatile("" : "+v"(tid_));
    const int tid = tid_, wid = __builtin_amdgcn_readfirstlane(tid >> 6), lane = tid & 63, wr = wid >> 2, wc = wid & 3, fr = lane & 15, fq = lane >> 4;
    const int K = g.K, nt = K / (2 * BK);
    unsigned voffA[2], voffB[2];
#pragma unroll
    for (int i = 0; i < 2; ++i) { int R, C; stage_rc(tid * 16 + i * 8192, R, C); const int Rb = Epi::PERM ? ((R & ~31) + perm32(R & 31)) : R;
        voffA[i] = (unsigned)(R * K + 2 * C); voffB[i] = (unsigned)(Rb * K + 2 * C); }
    const unsigned kstep = (unsigned)(BK * 2);
    const unsigned hstep = (unsigned)HALF * K;
    const unsigned tstep = 2 * hstep;
    const unsigned ldsw = (unsigned)wid * 1024u;
    const int aoff = lds_byte(wr * 64 + fr, fq * 16) ^ ((fq & 1) << 4), boff = lds_byte(wc * 32 + fr, fq * 16) ^ ((fq & 1) << 4), aoff2 = aoff ^ 16, boff2 = boff ^ 16;
#define PG8_SA(b, h) (((b) * 2 + (h)) * HTB)
#define PG8_SB(b, h) ((4 + (b) * 2 + (h)) * HTB)
#define PG8_STAGE(bufoff, rsrc, soff, voff) do { _Pragma("unroll") for (int _i = 0; _i < 2; ++_i) \
        __builtin_amdgcn_raw_ptr_buffer_load_lds(rsrc, (PG8_LAS void*)(lds + (bufoff) + ldsw + _i * 8192), 16, (int)(voff)[_i], (int)(soff), 0, 0); } while (0)
#define PG8_LDA(dst, b, h) do { _Pragma("unroll") for (int m = 0; m < 4; ++m) { const i32x4_t lo_ = *(const PG8_LAS i32x4_t*)(lds + PG8_SA(b, h) + aoff + m * 2048), hi_ = *(const PG8_LAS i32x4_t*)(lds + PG8_SA(b, h) + aoff2 + m * 2048); dst[m] = __builtin_shufflevector(lo_, hi_, 0, 1, 2, 3, 4, 5, 6, 7); } } while (0)
#define PG8_LDB(dst, b, h) do { _Pragma("unroll") for (int n = 0; n < 2; ++n) { const i32x4_t lo_ = *(const PG8_LAS i32x4_t*)(lds + PG8_SB(b, h) + boff + n * 2048), hi_ = *(const PG8_LAS i32x4_t*)(lds + PG8_SB(b, h) + boff2 + n * 2048); dst[n] = __builtin_shufflevector(lo_, hi_, 0, 1, 2, 3, 4, 5, 6, 7); } } while (0)
#define PG8_F8CAT(lo, hi) __builtin_shufflevector(__builtin_bit_cast(i32x4_t, lo), __builtin_bit_cast(i32x4_t, hi), 0, 1, 2, 3, 4, 5, 6, 7)
#define PG8_MMA(ai, bj, At, Bt) do { __builtin_amdgcn_s_setprio(1); _Pragma("unroll") for (int m = 0; m < 4; ++m) _Pragma("unroll") for (int n = 0; n < 2; ++n) \
        acc[ai][bj][m][n] = __builtin_amdgcn_mfma_scale_f32_16x16x128_f8f6f4(Bt[n], At[m], acc[ai][bj][m][n], 0, 0, 0, 0, 0, 0); __builtin_amdgcn_s_setprio(0); } while (0)
#define PG8_WAIT_V(n) asm volatile("s_waitcnt vmcnt(" #n ")" ::: "memory")
#define PG8_WAIT_L(n) asm volatile("s_waitcnt lgkmcnt(" #n ")" ::: "memory")
#define PG8_BAR __builtin_amdgcn_s_barrier()
#define PG8_SCHED __builtin_amdgcn_sched_barrier(0)
    Unit cur, nxt; int ui = 0;
    if (!S.next(0, cur)) return;
    f32x4 acc[2][2][4][2];
#pragma unroll
    for (int a = 0; a < 2; ++a)
#pragma unroll
        for (int b = 0; b < 2; ++b)
#pragma unroll
            for (int m = 0; m < 4; ++m)
#pragma unroll
                for (int n = 0; n < 2; ++n) acc[a][b][m][n] = (f32x4){0.f, 0.f, 0.f, 0.f};
    i32x8_t At[4], B0[2], B1[2];
    const __amdgpu_buffer_rsrc_t rA = __builtin_amdgcn_make_buffer_rsrc((void*)g.A, (short)0, -1, 0x00020000), rB = __builtin_amdgcn_make_buffer_rsrc((void*)g.Bt, (short)0, -1, 0x00020000);
    unsigned cA = g.same ? 0u : (unsigned)cur.pm * tstep, cB = g.same ? 0u : (unsigned)cur.pn * tstep;
    S.a_ready(cur);
    if constexpr (SP2) {
        PG8_STAGE(PG8_SB(0, 0), rB, cB, voffB); PG8_STAGE(PG8_SB(0, 1), rB, cB + hstep, voffB); PG8_STAGE(PG8_SA(0, 0), rA, cA, voffA); PG8_STAGE(PG8_SA(0, 1), rA, cA + hstep, voffA);
        if (wr == 1) PG8_BAR;
        PG8_WAIT_V(2); PG8_BAR;
        PG8_STAGE(PG8_SB(1, 0), rB, cB + kstep, voffB); PG8_STAGE(PG8_SA(1, 0), rA, cA + kstep, voffA); PG8_STAGE(PG8_SB(1, 1), rB, cB + hstep + kstep, voffB);
        PG8_WAIT_V(6); PG8_BAR;
    } else {
        PG8_STAGE(PG8_SB(0, 0), rB, cB, voffB); PG8_STAGE(PG8_SA(0, 0), rA, cA, voffA); PG8_STAGE(PG8_SB(0, 1), rB, cB + hstep, voffB); PG8_STAGE(PG8_SA(0, 1), rA, cA + hstep, voffA);
        if (wr == 1) PG8_BAR;
        PG8_WAIT_V(4); PG8_BAR;
        PG8_STAGE(PG8_SB(1, 0), rB, cB + kstep, voffB); PG8_STAGE(PG8_SA(1, 0), rA, cA + kstep, voffA); PG8_STAGE(PG8_SB(1, 1), rB, cB + hstep + kstep, voffB);
        PG8_WAIT_V(6); PG8_BAR;
    }
    for (;;) {
        const bool has_next = S.next(ui + 1, nxt);
        const unsigned nA = (has_next && !g.same) ? (unsigned)nxt.pm * tstep : cA, nB = (has_next && !g.same) ? (unsigned)nxt.pn * tstep : cB;
        for (int t = 0; t < nt; t += 2) {
            const bool last = (t == nt - 2);
            const unsigned a1 = cA + (unsigned)(t + 1) * kstep;
            const unsigned a2 = last ? nA : cA + (unsigned)(t + 2) * kstep, b2 = last ? nB : cB + (unsigned)(t + 2) * kstep;
            const unsigned a3 = a2 + kstep, b3 = b2 + kstep;
            if (last && has_next) S.a_ready(nxt);
            if constexpr (Epi::PREFETCH) { if (t == 0) E.prefetch(cur, lds + PG8_PRM_OFF + (ui & 1) * 4096, wid); }
            if constexpr (SP2) {
            PG8_LDB(B0, 0, 0); PG8_LDB(B1, 0, 1); PG8_SCHED; PG8_LDA(At, 0, 0); PG8_STAGE(PG8_SA(1, 1), rA, a1 + hstep, voffA);
            PG8_WAIT_V(8); PG8_WAIT_L(0); PG8_BAR; PG8_MMA(0, 0, At, B0); PG8_MMA(0, 1, At, B1); PG8_BAR; PG8_SCHED;
            PG8_LDA(At, 0, 1); PG8_STAGE(PG8_SB(0, 0), rB, b2, voffB); PG8_STAGE(PG8_SB(0, 1), rB, b2 + hstep, voffB); PG8_STAGE(PG8_SA(0, 0), rA, a2, voffA);
            PG8_WAIT_V(8); PG8_WAIT_L(0); PG8_BAR; PG8_MMA(1, 0, At, B0); PG8_MMA(1, 1, At, B1); PG8_BAR; PG8_SCHED;
            PG8_LDB(B0, 1, 0); PG8_LDB(B1, 1, 1); PG8_SCHED; PG8_LDA(At, 1, 0); PG8_STAGE(PG8_SA(0, 1), rA, a2 + hstep, voffA);
            PG8_WAIT_V(8); PG8_WAIT_L(0); PG8_BAR; PG8_MMA(0, 0, At, B0); PG8_MMA(0, 1, At, B1); PG8_BAR; PG8_SCHED;
            PG8_LDA(At, 1, 1); PG8_STAGE(PG8_SB(1, 0), rB, b3, voffB); PG8_STAGE(PG8_SB(1, 1), rB, b3 + hstep, voffB); PG8_STAGE(PG8_SA(1, 0), rA, a3, voffA);
            PG8_WAIT_V(8); PG8_WAIT_L(0); PG8_BAR; PG8_MMA(1, 0, At, B0); PG8_MMA(1, 1, At, B1); PG8_BAR; PG8_SCHED;
            } else {
            PG8_LDB(B0, 0, 0); PG8_SCHED; PG8_LDA(At, 0, 0); PG8_STAGE(PG8_SA(1, 1), rA, a1 + hstep, voffA);
            PG8_WAIT_L(8); PG8_BAR; PG8_WAIT_L(0); PG8_MMA(0, 0, At, B0); PG8_BAR; PG8_SCHED;
            PG8_LDB(B1, 0, 1); PG8_STAGE(PG8_SB(0, 0), rB, b2, voffB);
            PG8_BAR; PG8_WAIT_L(0); PG8_MMA(0, 1, At, B1); PG8_BAR;
            PG8_LDA(At, 0, 1); PG8_STAGE(PG8_SA(0, 0), rA, a2, voffA);
            PG8_BAR; PG8_WAIT_L(0); PG8_MMA(1, 0, At, B0); PG8_BAR; PG8_SCHED;
            PG8_STAGE(PG8_SB(0, 1), rB, b2 + hstep, voffB);
            PG8_WAIT_V(6); PG8_BAR; PG8_MMA(1, 1, At, B1); PG8_BAR;
            PG8_LDB(B0, 1, 0); PG8_SCHED; PG8_LDA(At, 1, 0); PG8_STAGE(PG8_SA(0, 1), rA, a2 + hstep, voffA);
            PG8_WAIT_L(8); PG8_BAR; PG8_WAIT_L(0); PG8_MMA(0, 0, At, B0); PG8_BAR; PG8_SCHED;
            PG8_LDB(B1, 1, 1); PG8_STAGE(PG8_SB(1, 0), rB, b3, voffB);
            PG8_BAR; PG8_WAIT_L(0); PG8_MMA(0, 1, At, B1); PG8_BAR;
            PG8_LDA(At, 1, 1); PG8_STAGE(PG8_SA(1, 0), rA, a3, voffA);
            PG8_BAR; PG8_WAIT_L(0); PG8_MMA(1, 0, At, B0); PG8_BAR; PG8_SCHED;
            PG8_STAGE(PG8_SB(1, 1), rB, b3 + hstep, voffB);
            PG8_WAIT_V(6); PG8_BAR; PG8_MMA(1, 1, At, B1); PG8_BAR;
            }
        }
        if constexpr (ALIGN_EPI) { if (wr == 0) PG8_BAR; }
        if constexpr (!Epi::AFTER_DRAIN) { int ln_ = (int)__builtin_amdgcn_mbcnt_hi(~0u, __builtin_amdgcn_mbcnt_lo(~0u, 0u)); asm volatile("" : "+v"(ln_));
            E(acc, cur, wr, wc, ln_ & 15, ln_ >> 4, lds + PG8_PRM_OFF + (ui & 1) * 4096); S.done(cur); }
        if (!has_next) break;
#pragma unroll
        for (int a = 0; a < 2; ++a)
#pragma unroll
            for (int b = 0; b < 2; ++b)
#pragma unroll
                for (int m = 0; m < 4; ++m)
#pragma unroll
                    for (int n = 0; n < 2; ++n) acc[a][b][m][n] = (f32x4){0.f, 0.f, 0.f, 0.f};
        cur = nxt; cA = nA; cB = nB; ++ui;
        if constexpr (ALIGN_EPI) { if (wr == 1) PG8_BAR; }
    }
    PG8_WAIT_V(0);
    if constexpr (!ALIGN_EPI) { if (wr == 0) PG8_BAR; }
    PG8_BAR;
    if constexpr (Epi::AFTER_DRAIN) { E.fused(acc, cur, wr, wc, fr, fq, lds, wid, lane); S.done(cur); }
#undef PG8_SA
#undef PG8_SB
#undef PG8_STAGE
#undef PG8_LDA
#undef PG8_LDB
#undef PG8_MMA
#undef PG8_WAIT_V
#undef PG8_WAIT_L
#undef PG8_BAR
#undef PG8_SCHED
#undef PG8_F8CAT
}
}

constexpr int NWAVES = 8, NTHR = NWAVES * 64;
constexpr int BATCH = 8, SEQ = 2048, DM = 2048, DEPTH = 2, HD = 64, GW = 512, NH = 8;
constexpr int M = BATCH * SEQ;
constexpr int NPROJ = 6080, NPROJ_P = 6144, DFF = 5632;
constexpr int CA_Q = 0, CA_K = 512, CA_V = 1024, CB_U = 1536, CB_V = 2048, CC_Q = 2560, CC_K = 3072, CC_V = 3584, CD = 4096;
constexpr int D_R = 0, D_WD = 512, D_K = 608, D_V = 1120, D_AD = 1632, D_GD = 1728, D_W = 1984;
constexpr float NORM_EPS = 1e-6f;
#ifndef N_LAUNCH_MODE
#define N_LAUNCH_MODE 0
#endif
#ifndef PG8_SP2
#define PG8_SP2 true
#endif
#ifndef FFN_FP8
#define FFN_FP8 1
#endif
#ifndef REPEAT
#define REPEAT 0
#endif
#ifndef GEMM_I8
#define GEMM_I8 3
#endif
#ifndef BFMASK
#define BFMASK 0x003C0Fu
#endif
#ifndef FFN1_I8
#define FFN1_I8 1
#endif
#define I8_IN ((GEMM_I8 & 1) != 0)
#define I8_OUT ((GEMM_I8 & 2) != 0)
constexpr int N_PHASES = 20;

constexpr size_t MiB = 1u << 20;
constexpr size_t WS_CTL = 0, CTL_ZERO_BYTES = 2 * MiB;
constexpr size_t WS_WIN = 2 * MiB, WS_WOUT = 26 * MiB, WS_WGU = 34 * MiB, WS_WDN = 78 * MiB, WS_SMALL = 100 * MiB;
constexpr size_t WS_XB = 104 * MiB, WS_PROJ = 168 * MiB, WS_YCAT = 360 * MiB, WS_SC2 = 424 * MiB, WS_YD = 456 * MiB, WS_G = 488 * MiB, WS_BC = 504 * MiB, WS_END = 506 * MiB;
constexpr size_t WS_XQ = WS_YD, WS_YQ = WS_PROJ;
constexpr size_t SC_ARR = (size_t)M * GW * 2;
constexpr size_t SM_TB = 0;
constexpr size_t SM_KBAR = 64 * 1024;
constexpr size_t SM_STATS = 256 * 1024;
constexpr size_t SM_SAX = 2048 * 1024, SM_SAY = SM_SAX + 64 * 1024;
constexpr size_t SM_SWIN = SM_SAY + 64 * 1024, SM_SWOUT = SM_SWIN + 32 * 1024, SM_SWGU = SM_SWOUT + 16 * 1024;
constexpr size_t SM_BIAS = 3072 * 1024;
constexpr size_t SM_WT = 1024 * 1024;
constexpr int CW_BAR = 4096;
constexpr int CW_Q = 8192;
constexpr int CW_SSQ = 65536;
constexpr size_t CTL_KBAR = 1024 * 1024;
constexpr size_t CTL_STATS = 1280 * 1024;
static_assert((size_t)CW_SSQ * 4 + 5 * (size_t)M * 8 <= CTL_KBAR && CTL_STATS + 2 * (size_t)M * 2 * 8 <= CTL_ZERO_BYTES, "CTL");

constexpr int RING_OFF = 0, RING_BYTES = 131072;
constexpr int LDS_BYTES = 163840, MISC_OFF = LDS_BYTES - 256;

#define GAS __attribute__((address_space(1)))
#define LAS __attribute__((address_space(3)))
typedef unsigned short bf16;
typedef unsigned v4u __attribute__((ext_vector_type(4)));
typedef unsigned v2u __attribute__((ext_vector_type(2)));
typedef float f32x4 __attribute__((ext_vector_type(4)));
typedef short bf16x8 __attribute__((ext_vector_type(8)));
typedef float f32x16 __attribute__((ext_vector_type(16)));
typedef GAS unsigned gu32;
#define RLX_AGENT __ATOMIC_RELAXED, __HIP_MEMORY_SCOPE_AGENT
#define LDS_WAIT() asm volatile("s_waitcnt lgkmcnt(0)" ::: "memory")
#define VM_WAIT() asm volatile("s_waitcnt vmcnt(0)" ::: "memory")
__device__ __forceinline__ unsigned f2bf(float f) { unsigned u = __builtin_bit_cast(unsigned, f); return (u + 0x7fffu + ((u >> 16) & 1u)) >> 16; }
__device__ __forceinline__ unsigned pk2(float lo, float hi) { unsigned r; asm("v_cvt_pk_bf16_f32 %0, %1, %2" : "=v"(r) : "v"(lo), "v"(hi)); return r; }
__device__ __forceinline__ float bf2f(unsigned short h) { return __builtin_bit_cast(float, (unsigned)h << 16); }
__device__ __forceinline__ float bflo(unsigned w) { return __builtin_bit_cast(float, w << 16); }
__device__ __forceinline__ float bfhi(unsigned w) { return __builtin_bit_cast(float, w & 0xffff0000u); }
__device__ __forceinline__ float sigmoidf_(float x) { return 1.0f / (1.0f + __expf(-x)); }
__device__ __forceinline__ float gelu_tanh(float x) { const float u = 0.7978845608028654f * (x + 0.044715f * x * x * x); const float e = __expf(2.0f * u); return x - x * __builtin_amdgcn_rcpf(e + 1.0f); }
__device__ __forceinline__ float wave_sum(float v) {
#pragma unroll
    for (int o = 1; o < 64; o <<= 1) v += __shfl_xor(v, o);
    return v;
}

__device__ __forceinline__ float zero_v() { float z = 0.f; asm volatile("" : "+v"(z)); return z; }

__device__ __forceinline__ unsigned q8pack4(float a, float b, float c, float d, float inv) {
    const int ia = (int)__builtin_rintf(a * inv), ib = (int)__builtin_rintf(b * inv), ic = (int)__builtin_rintf(c * inv), id = (int)__builtin_rintf(d * inv);
    return ((unsigned)ia & 0xffu) | (((unsigned)ib & 0xffu) << 8) | (((unsigned)ic & 0xffu) << 16) | ((unsigned)id << 24); }
__device__ __forceinline__ float wave_max(float v) {
#pragma unroll
    for (int o = 1; o < 64; o <<= 1) v = fmaxf(v, __shfl_xor(v, o));
    return v;
}
#define UNPACK8(dst, o, W_) do { dst[(o)] = bflo((W_).x); dst[(o) + 1] = bfhi((W_).x); dst[(o) + 2] = bflo((W_).y); dst[(o) + 3] = bfhi((W_).y); dst[(o) + 4] = bflo((W_).z); dst[(o) + 5] = bfhi((W_).z); dst[(o) + 6] = bflo((W_).w); dst[(o) + 7] = bfhi((W_).w); } while (0)
#define XB_TMO      128
#define XB_XCNT(j)  (256  + 64 * (j))
#define XB_XSUB(j)  (1280 + 64 * (j))
#define XB_XGEN(j)  (2304 + 64 * (j))
#define XB_TOP      3328
#define XB_TOPGEN   3392
#define XCD_BAR_WORDS 3456
#define XB_SPIN_CAP (1u << 18)

__device__ __forceinline__ unsigned xb_ld(unsigned* p)              { return __hip_atomic_load(p, __ATOMIC_RELAXED, __HIP_MEMORY_SCOPE_AGENT); }
__device__ __forceinline__ unsigned xb_add(unsigned* p, unsigned v) { return __hip_atomic_fetch_add(p, v, __ATOMIC_RELAXED, __HIP_MEMORY_SCOPE_AGENT); }
__device__ __forceinline__ unsigned xb_xcc_id() { return (unsigned)__builtin_amdgcn_s_getreg((3 << 11) | 20) & 0xFu; }
#define XB_SPIN(cond, bar) do { unsigned _sp = 0; while (cond) { __builtin_amdgcn_s_sleep(1); \
    if ((++_sp & 255u) == 0u) { if (xb_ld(&(bar)[XB_TMO])) break; if (_sp > XB_SPIN_CAP) { atomicAdd(&(bar)[XB_TMO], 1u); break; } } } } while (0)

struct XcdBarrier {
    unsigned* bar; unsigned x; int wv;
    volatile LAS unsigned* st;
};

__device__ __forceinline__ XcdBarrier xcd_barrier_post(unsigned* bar, volatile LAS unsigned* st, int wv) {
    XcdBarrier b; b.bar = bar; b.x = xb_xcc_id(); b.st = st; b.wv = wv;
    if (wv == 0 && pg8::lane_now() == 0) (void)xb_add(&bar[XB_XCNT(b.x)], 1u);
    return b;
}
__device__ __forceinline__ void xcd_barrier_complete(unsigned* bar, unsigned x, unsigned& nloc, unsigned& nx) {
    const unsigned G = gridDim.x * gridDim.y * gridDim.z;
    unsigned sum, cnt, mine, sp = 0u;
    for (;;) {
        sum = 0u; cnt = 0u; mine = 0u;
#pragma unroll
        for (unsigned j = 0; j < 16; ++j) { const unsigned c = xb_ld(&bar[XB_XCNT(j)]); sum += c; cnt += (c > 0u) ? 1u : 0u; mine = (j == x) ? c : mine; }
        if (sum == G) break;
        __builtin_amdgcn_s_sleep(1);
        if ((++sp & 255u) == 0u) { if (xb_ld(&bar[XB_TMO])) break; if (sp > XB_SPIN_CAP) { atomicAdd(&bar[XB_TMO], 1u); break; } }
    }
    nloc = mine > 0u ? mine : 1u; nx = cnt > 0u ? cnt : 1u;
}

__device__ __forceinline__ void xcd_barrier(const XcdBarrier& b) {
    asm volatile("s_waitcnt vmcnt(0)" ::: "memory");
    __syncthreads();
    if (b.wv == 0 && pg8::lane_now() == 0) {
        unsigned* bar = b.bar;
        __builtin_amdgcn_s_waitcnt(0);
        unsigned nloc = b.st[0], nx = b.st[1];
        if (nloc == 0u) { xcd_barrier_complete(bar, b.x, nloc, nx); b.st[0] = nloc; b.st[1] = nx; }
        const unsigned old = xb_add(&bar[XB_XSUB(b.x)], 1u);
        const unsigned gen = old / nloc;
        if (old + 1u == (gen + 1u) * nloc) {
            __builtin_amdgcn_fence(__ATOMIC_RELEASE, "agent");
            asm volatile("s_waitcnt vmcnt(0)" ::: "memory");
            const unsigned og = xb_add(&bar[XB_TOP], 1u);
            const unsigned tg = og / nx;
            if (og + 1u == (tg + 1u) * nx) xb_add(&bar[XB_TOPGEN], 1u);
            else XB_SPIN(xb_ld(&bar[XB_TOPGEN]) == tg, bar);
            __builtin_amdgcn_fence(__ATOMIC_ACQUIRE, "agent");
            xb_add(&bar[XB_XGEN(b.x)], 1u);
            asm volatile("s_waitcnt vmcnt(0)" ::: "memory");
        } else {
            XB_SPIN(xb_ld(&bar[XB_XGEN(b.x)]) == gen, bar);
            __builtin_amdgcn_fence(__ATOMIC_ACQUIRE, "agent");
            asm volatile("s_waitcnt vmcnt(0)" ::: "memory");
        }
    }
    __syncthreads();
}

struct Args { const float* in[25]; float* out; unsigned char* ws; int ph_lo, ph_hi; };
struct Frame {
    LAS unsigned char* lds; int tid, lane, wave, G, vcu, gw, ngw;
};
typedef const __attribute__((address_space(4))) unsigned long long* karg_t;
__device__ __forceinline__ karg_t kargs() { karg_t ka = (karg_t)__builtin_amdgcn_kernarg_segment_ptr(); asm volatile("" : "+s"(ka)); return ka; }
__device__ __forceinline__ const float* inp(int i) { return (const float*)(const GAS float*)kargs()[i]; }
__device__ __forceinline__ float* outp() { return (float*)(GAS float*)kargs()[25]; }
__device__ __forceinline__ unsigned char* wsp() { return (unsigned char*)(GAS unsigned char*)kargs()[26]; }
__device__ __forceinline__ gu32* ctlp() { return (gu32*)(wsp() + WS_CTL); }

__device__ __forceinline__ void conv_item(const float* W, int K, int N, const float* g, bf16* WT, int kind, LAS float* scr, int item, int lane, int ncols = 0) {
    const int nblk = (ncols ? ncols : N) / 32, kb = item / nblk, nb = item % nblk, k0 = 64 * kb, n0 = 32 * nb;
    float ld[32];
    { const float* wp = W + (size_t)(k0 + (lane >> 5)) * N + n0 + (lane & 31);
#pragma unroll
      for (int i = 0; i < 32; ++i) ld[i] = wp[(size_t)(2 * i) * N]; }
    if (g) { const float* gp = g + k0 + (lane >> 5);
#pragma unroll
      for (int i = 0; i < 32; ++i) ld[i] *= gp[2 * i]; }
#pragma unroll
    for (int i = 0; i < 32; ++i) scr[(2 * i + (lane >> 5)) * 33 + (lane & 31)] = ld[i];
    LDS_WAIT(); asm volatile("" ::: "memory");
    const int c = lane & 7;
#pragma unroll
    for (int j = 0; j < 4; ++j) { const int n = (lane >> 3) + 8 * j; const LAS float* s = scr + (8 * c) * 33 + n;
        v4u o; o.x = pk2(s[0 * 33], s[1 * 33]); o.y = pk2(s[2 * 33], s[3 * 33]); o.z = pk2(s[4 * 33], s[5 * 33]); o.w = pk2(s[6 * 33], s[7 * 33]);
        const int nn = n0 + n;
        if (kind >= 3) {
            const int row = kind == 5 ? nn : ((nn >> 7) * 256 + (kind - 3) * 128 + (nn & 127)); int f0 = (int)o.x, f1 = (int)o.y;
            f0 = __builtin_amdgcn_cvt_pk_fp8_f32(64.f * s[0 * 33], 64.f * s[1 * 33], f0, false); f0 = __builtin_amdgcn_cvt_pk_fp8_f32(64.f * s[2 * 33], 64.f * s[3 * 33], f0, true);
            f1 = __builtin_amdgcn_cvt_pk_fp8_f32(64.f * s[4 * 33], 64.f * s[5 * 33], f1, false); f1 = __builtin_amdgcn_cvt_pk_fp8_f32(64.f * s[6 * 33], 64.f * s[7 * 33], f1, true);
            *(GAS v2u*)((unsigned char*)WT + (size_t)row * K + k0 + 8 * c) = (v2u){(unsigned)f0, (unsigned)f1};
        } else {
        const int row = kind == 0 ? nn : ((nn >> 7) * 256 + (kind - 1) * 128 + (nn & 127));
        *(GAS v4u*)(WT + (size_t)row * K + k0 + 8 * c) = o; } }
    LDS_WAIT(); asm volatile("" ::: "memory");
}
__device__ __forceinline__ void conv_cols_i8(const float* W, int K, int N, const float* g, unsigned char* WQ, float* SW, int nb, Frame& F, int orow0 = -1) {
    constexpr int CC_PITCH = 2 * DM + 16;
    LAS unsigned char* T = F.lds + RING_OFF; LAS float* red = (LAS float*)(F.lds + RING_OFF + 32 * CC_PITCH);
    static_assert(32 * CC_PITCH + 1024 <= MISC_OFF, "conv LDS");
    const int n0 = 32 * nb, lane = F.lane, nkb = K / 64, o0 = orow0 < 0 ? n0 : orow0;
    const float* wp0 = W + (size_t)(lane >> 5) * N + n0 + (lane & 31);
    float mx = 0.f;
    for (int kb = F.wave; kb < nkb; kb += NWAVES) {
        const float* wp = wp0 + (size_t)(64 * kb) * N; const float* gp = g + 64 * kb + (lane >> 5);
        float ld[32];
#pragma unroll
        for (int i = 0; i < 32; ++i) ld[i] = wp[(size_t)(2 * i) * N];
        LAS unsigned char* tp = T + (lane & 31) * CC_PITCH + 2 * (64 * kb + (lane >> 5));
#pragma unroll
        for (int i = 0; i < 32; ++i) { const unsigned h = f2bf(ld[i] * gp[2 * i]); mx = fmaxf(mx, fabsf(__builtin_bit_cast(float, h << 16))); *(LAS unsigned short*)(tp + 4 * i) = (unsigned short)h; }
    }
    mx = fmaxf(mx, __shfl_xor(mx, 32));
    if (lane < 32) red[F.wave * 32 + lane] = mx;
    __syncthreads();
#pragma unroll
    for (int j = 0; j < 4; ++j) { const int n = 4 * F.wave + j;
        float cm = 0.f;
#pragma unroll
        for (int w = 0; w < NWAVES; ++w) cm = fmaxf(cm, red[w * 32 + n]);
        const float inv = cm > 0.f ? 127.0f / cm : 0.f;
        if (lane == 0) SW[o0 + n] = cm * (1.0f / 127.0f);
        const LAS unsigned char* tr = T + n * CC_PITCH + 16 * lane; unsigned char* wq = WQ + (size_t)(o0 + n) * K + 8 * lane;
#pragma unroll
        for (int it = 0; it < 4; ++it) { const v4u w = *(const LAS v4u*)(tr + 1024 * it);
            *(GAS v2u*)(wq + 512 * it) = (v2u){q8pack4(bflo(w.x), bfhi(w.x), bflo(w.y), bfhi(w.y), inv), q8pack4(bflo(w.z), bfhi(w.z), bflo(w.w), bfhi(w.w), inv)}; }
    }
    __syncthreads();
}
__device__ __forceinline__ void conv_layer_items(Frame& F, int l, int gw, int ngw, bool do_in, bool do_rest) {
    LAS float* scr = (LAS float*)(F.lds + RING_OFF + F.wave * 16384);
    constexpr int I_IN = (DM / 64) * (NPROJ / 32), I_OUT = (DM / 64) * (DM / 32), I_G = (DM / 64) * (DFF / 32), I_D = (DFF / 64) * (DM / 32);
    const float* w_in = inp(2) + (size_t)l * DM * NPROJ; const float* w_out = inp(19) + (size_t)l * DM * DM;
    const float* w_g = inp(21) + (size_t)l * DM * DFF; const float* w_u = inp(22) + (size_t)l * DM * DFF; const float* w_d = inp(23) + (size_t)l * DFF * DM;
    const float* g_mix = inp(1) + l * DM; const float* g_br = inp(18) + l * DM; const float* g_ffn = inp(20) + l * DM;
    bf16* WIN = (bf16*)(wsp() + WS_WIN); bf16* WOUT = (bf16*)(wsp() + WS_WOUT); bf16* WGU = (bf16*)(wsp() + WS_WGU); bf16* WDN = (bf16*)(wsp() + WS_WDN);
    if (do_in) {
        for (int it = gw; it < I_IN; it += ngw) conv_item(w_in, DM, NPROJ, g_mix, WIN, 0, scr, it, F.lane);
    }
    if (do_rest) {
        for (int it = gw; it < (I8_OUT ? 0 : I_OUT) + (FFN1_I8 ? 0 : 2 * I_G) + I_D; it += ngw) {
            int r = it + (I8_OUT ? I_OUT : 0); if (FFN1_I8 && r >= I_OUT) r += 2 * I_G;
            if (r < I_OUT) { conv_item(w_out, DM, DM, g_br, WOUT, 0, scr, r, F.lane); continue; } r -= I_OUT;
            if (r < I_G) { conv_item(w_g, DM, DFF, g_ffn, WGU, FFN_FP8 ? 3 : 1, scr, r, F.lane); continue; } r -= I_G;
            if (r < I_G) { conv_item(w_u, DM, DFF, g_ffn, WGU, FFN_FP8 ? 4 : 2, scr, r, F.lane); continue; } r -= I_G;
            conv_item(w_d, DFF, DM, nullptr, WDN, FFN_FP8 ? 5 : 0, scr, r, F.lane);
        }
    }
}

constexpr int WINB_NB = 8 * __builtin_popcount(BFMASK), WINB_ITEMS = (DM / 64) * WINB_NB;
__device__ __forceinline__ bf16* winb_ptr() { return (bf16*)outp() + (size_t)6 * M * GW; }
__device__ __forceinline__ void conv_winb(Frame& F, int l, int item) {
    if (item >= WINB_ITEMS) return;
    const int kb = item / (WINB_NB ? WINB_NB : 1), r = item % (WINB_NB ? WINB_NB : 1); unsigned m = BFMASK; for (int j = 0; j < (r >> 3); ++j) m &= m - 1;
    conv_item(inp(2) + (size_t)l * DM * NPROJ, DM, NPROJ, inp(1) + l * DM, winb_ptr(), 0, (LAS float*)(F.lds + RING_OFF + F.wave * 16384), kb * (NPROJ / 32) + __builtin_ctz(m) * 8 + (r & 7), F.lane);
}
__device__ __forceinline__ void ph_prologue(Frame& F) {
    if (I8_IN) {
        for (int nb = blockIdx.x; nb < NPROJ / 32; nb += F.G) conv_cols_i8(inp(2), DM, NPROJ, inp(1), wsp() + WS_WIN, (float*)(wsp() + WS_SMALL + SM_SWIN), nb, F);
        unsigned char* WIN = wsp() + WS_WIN; float* SWIN = (float*)(wsp() + WS_SMALL + SM_SWIN);
        for (int i = F.gw * 64 + F.lane; i < 64 * DM / 16; i += F.ngw * 64) *(GAS v4u*)(WIN + (size_t)NPROJ * DM + (size_t)i * 16) = (v4u){0u, 0u, 0u, 0u};
        if (blockIdx.x == 0 && F.tid < NPROJ_P - NPROJ) SWIN[NPROJ + F.tid] = 0.f;
        for (int it = F.gw; it < WINB_ITEMS; it += F.ngw) conv_winb(F, 0, it);
    } else {
    conv_layer_items(F, 0, F.gw, F.ngw, true, false);
    { bf16* WIN = (bf16*)(wsp() + WS_WIN);
      for (int i = F.gw * 64 + F.lane; i < 64 * DM / 8; i += F.ngw * 64) *(GAS v4u*)(WIN + (size_t)NPROJ * DM + (size_t)i * 8) = (v4u){0u, 0u, 0u, 0u}; } }
    if (blockIdx.x == 0) {
        int* TB = (int*)(wsp() + WS_SMALL + SM_TB);
        for (int d = F.tid; d < 2049; d += NTHR) {
            int bkt = d;
            if (d >= 16) bkt = 16 + (d >= 22) + (d >= 30) + (d >= 40) + (d >= 54) + (d >= 73) + (d >= 99) + (d >= 134) + (d >= 182) + (d >= 246) + (d >= 332) + (d >= 450) + (d >= 609) + (d >= 825) + (d >= 1117) + (d >= 1513);
            TB[d] = bkt;
        }
    }
    if (blockIdx.x >= 1 && blockIdx.x <= 16) {
        const int hcol = blockIdx.x - 1; float* BT = (float*)(wsp() + WS_SMALL + SM_BIAS) + hcol * 2048; const float* pb = inp(3);
        for (int d = F.tid; d < 2048; d += NTHR) {
            int bkt = d;
            if (d >= 16) bkt = 16 + (d >= 22) + (d >= 30) + (d >= 40) + (d >= 54) + (d >= 73) + (d >= 99) + (d >= 134) + (d >= 182) + (d >= 246) + (d >= 332) + (d >= 450) + (d >= 609) + (d >= 825) + (d >= 1117) + (d >= 1513);
            BT[d] = pb[bkt * 16 + hcol] * 1.4426950408889634f;
        }
    }
    { bf16* WT = (bf16*)(wsp() + WS_SMALL + SM_WT); const float* w2 = inp(9); const float* a2 = inp(11); const float* g2 = inp(12);
      for (int idx = blockIdx.x * NTHR + F.tid; idx < DEPTH * 448 * GW; idx += F.G * NTHR) {
          const int c = idx % GW, k = (idx / GW) % 448, l = idx / (GW * 448);
          const float v = k < 96 ? w2[((size_t)l * 96 + k) * GW + c] : (k < 192 ? a2[((size_t)l * 96 + (k - 96)) * GW + c] : g2[((size_t)l * 256 + (k - 192)) * GW + c]);
          const int r32_ = c & 31, hct = c >> 5, ks_ = k >> 4, hh_ = (k >> 3) & 1;
          WT[(size_t)l * GW * 448 + (((size_t)hct * 28 + ks_) * 64 + 32 * hh_ + r32_) * 8 + (k & 7)] = (bf16)f2bf(v); } }
    const float* x = inp(0); bf16* XB = (bf16*)(wsp() + WS_XB); pg8::fx_t* ssq = (pg8::fx_t*)(ctlp() + CW_SSQ);
    for (int m = F.gw; m < M; m += F.ngw) {
        const GAS f32x4* xr = (const GAS f32x4*)(x + (size_t)m * DM) + F.lane; GAS v2u* o = (GAS v2u*)(XB + (size_t)m * DM) + F.lane; float s = 0.f;
#pragma unroll
        for (int j = 0; j < 8; ++j) { const f32x4 v = xr[64 * j]; s += (v.x * v.x + v.y * v.y) + (v.z * v.z + v.w * v.w); o[64 * j] = (v2u){pk2(v.x, v.y), pk2(v.z, v.w)}; }
        s = wave_sum(s); if (F.lane == 0) pg8::fx_add(ssq + m, s);
        if (I8_IN) {
            float mx = 0.f;
#pragma unroll
            for (int j = 0; j < 8; ++j) { const f32x4 v = xr[64 * j]; mx = fmaxf(fmaxf(mx, fmaxf(fabsf(v.x), fabsf(v.y))), fmaxf(fabsf(v.z), fabsf(v.w))); }
            mx = wave_max(mx); const float inv = mx > 0.f ? 127.0f / mx : 0.f; GAS unsigned* q = (GAS unsigned*)(wsp() + WS_XQ + (size_t)m * DM) + F.lane;
#pragma unroll
            for (int j = 0; j < 8; ++j) { const f32x4 v = xr[64 * j]; q[64 * j] = q8pack4(v.x, v.y, v.z, v.w, inv); }
            if (F.lane == 0) ((float*)(wsp() + WS_SMALL + SM_SAX))[m] = mx * (1.0f / 127.0f);
        }
    }
}

__device__ __forceinline__ void ph_quantx(Frame& F, pg8::fx_t* ssq) {
    const bf16* XB = (const bf16*)(wsp() + WS_XB); unsigned char* XQ = wsp() + WS_XQ; float* SAX = (float*)(wsp() + WS_SMALL + SM_SAX);
    for (int m = F.gw; m < M; m += F.ngw) {
        const GAS v4u* xr = (const GAS v4u*)(XB + (size_t)m * DM) + F.lane; v4u w[4]; float mx = 0.f;
#pragma unroll
        for (int j = 0; j < 4; ++j) w[j] = xr[64 * j];
        float sq = 0.f;
#pragma unroll
        for (int j = 0; j < 4; ++j) { const float e8[8] = {bflo(w[j].x), bfhi(w[j].x), bflo(w[j].y), bfhi(w[j].y), bflo(w[j].z), bfhi(w[j].z), bflo(w[j].w), bfhi(w[j].w)};
#pragma unroll
            for (int e = 0; e < 8; ++e) sq += e8[e] * e8[e]; }
        sq = wave_sum(sq);
#pragma unroll
        for (int j = 0; j < 4; ++j) { mx = fmaxf(fmaxf(mx, fmaxf(fabsf(bflo(w[j].x)), fabsf(bfhi(w[j].x)))), fmaxf(fabsf(bflo(w[j].y)), fabsf(bfhi(w[j].y))));
            mx = fmaxf(fmaxf(mx, fmaxf(fabsf(bflo(w[j].z)), fabsf(bfhi(w[j].z)))), fmaxf(fabsf(bflo(w[j].w)), fabsf(bfhi(w[j].w)))); }
        mx = wave_max(mx); const float inv = mx > 0.f ? 127.0f / mx : 0.f; GAS v2u* q = (GAS v2u*)(XQ + (size_t)m * DM) + F.lane;
#pragma unroll
        for (int j = 0; j < 4; ++j) q[64 * j] = (v2u){q8pack4(bflo(w[j].x), bfhi(w[j].x), bflo(w[j].y), bfhi(w[j].y), inv), q8pack4(bflo(w[j].z), bfhi(w[j].z), bflo(w[j].w), bfhi(w[j].w), inv)};
        if (F.lane == 0) { SAX[m] = mx * (1.0f / 127.0f); ssq[m] = (pg8::fx_t)(long long)__float2ll_rn(sq * 1073741824.0f); }
    }
}

constexpr int PR_PITCH = 912;
constexpr int PR_PRM_OFF = 32768, PR_MUA_OFF = PR_PRM_OFF + 8 * 512 * 4;
__device__ __forceinline__ float fast_tanh(float x) { return 1.0f - 2.0f * __builtin_amdgcn_rcpf(__expf(2.0f * x) + 1.0f); }
__device__ __forceinline__ float fast_sigmoid(float x) { return __builtin_amdgcn_rcpf(1.0f + __expf(-x)); }
constexpr int PR_OT_OFF = 51200, PR_OT_PITCH = 72, PR_OT_TILE = 32 * PR_OT_PITCH, PR_OT_WAVE = 6 * PR_OT_TILE;
static_assert(PR_OT_OFF + 8 * PR_OT_WAVE <= MISC_OFF, "prep LDS");
__device__ __forceinline__ void ph_prep(Frame& F, int l) {
    const bf16* PROJ = (const bf16*)(wsp() + WS_PROJ);
    bf16* R_ = (bf16*)outp();
    bf16* E_ = R_ + (size_t)M * GW; bf16* KP_ = E_ + (size_t)M * GW; bf16* V_ = KP_ + (size_t)M * GW;
    bf16* KK_ = (bf16*)outp() + (size_t)4 * M * GW; bf16* AS_ = KK_ + (size_t)M * GW; bf16* G_ = (bf16*)(wsp() + WS_G); float* BC = (float*)(wsp() + WS_BC);
    const bf16* WT = (const bf16*)(wsp() + WS_SMALL + SM_WT) + (size_t)l * GW * 448;
    LAS unsigned char* actL = F.lds + RING_OFF; LAS float* PRM = (LAS float*)(F.lds + PR_PRM_OFF); LAS float* MUA = (LAS float*)(F.lds + PR_MUA_OFF);
    { const float* mu = inp(7) + l * D_W; const float* w0 = inp(8) + l * GW; const float* a0 = inp(10) + l * GW; const float* k_k = inp(13) + l * GW; const float* k_a = inp(14) + l * GW; const float* r_k = inp(15) + l * GW;
      const int c = F.tid;
      PRM[c] = mu[D_R + c]; PRM[512 + c] = mu[D_K + c]; PRM[1024 + c] = mu[D_V + c]; PRM[1536 + c] = w0[c]; PRM[2048 + c] = a0[c]; PRM[2560 + c] = k_k[c]; PRM[3072 + c] = k_a[c]; PRM[3584 + c] = r_k[c];
      if (c < 448) MUA[c] = mu[c < 96 ? D_WD + c : (c < 192 ? D_AD + (c - 96) : D_GD + (c - 192))]; }
    __syncthreads();
    const int h = F.wave;
    for (int it = blockIdx.x; it < M / 32; it += F.G) {
        const int m0 = it * 32;
        int tid_ = F.wave * 64 + pg8::lane_now(); asm volatile("" : "+v"(tid_));
        const int tid = tid_, r32 = tid & 31, hh = (tid >> 5) & 1, lane = tid & 63;
        LAS unsigned char* OT = F.lds + PR_OT_OFF + h * PR_OT_WAVE;
        { v2u pc[7], pp[7];
#pragma unroll
          for (int i = 0; i < 7; ++i) { const int gi = tid + NTHR * i, t = gi / 112, k = 4 * (gi % 112), m = m0 + t;
              const int col = k < 96 ? D_WD + k : (k < 192 ? D_AD + (k - 96) : D_GD + (k - 192)); const bf16* src = PROJ + (size_t)m * NPROJ_P + CD + col;
              pc[i] = *(const GAS v2u*)src; pp[i] = (v2u){0u, 0u}; if ((m % SEQ) > 0) pp[i] = *(const GAS v2u*)(src - NPROJ_P); }
#pragma unroll
          for (int i = 0; i < 7; ++i) { const int gi = tid + NTHR * i, t = gi / 112, k = 4 * (gi % 112);
              const f32x4 mv = *(const LAS f32x4*)(MUA + k);
              float x[4] = {bflo(pc[i].x), bfhi(pc[i].x), bflo(pc[i].y), bfhi(pc[i].y)}; const float xp[4] = {bflo(pp[i].x), bfhi(pp[i].x), bflo(pp[i].y), bfhi(pp[i].y)};
#pragma unroll
              for (int e = 0; e < 4; ++e) { x[e] += (xp[e] - x[e]) * mv[e]; x[e] = k < 96 ? fast_tanh(x[e]) : (k < 192 ? x[e] : fast_sigmoid(x[e])); }
              *(LAS v2u*)(actL + t * PR_PITCH + 2 * k) = (v2u){pk2(x[0], x[1]), pk2(x[2], x[3])}; } }
        __syncthreads();
        const int m = m0 + r32; const bool has_prev = (m % SEQ) > 0;
        const bf16* pr = PROJ + (size_t)m * NPROJ_P + CD; const bf16* pq = pr - NPROJ_P;
        const LAS unsigned char* bp = actL + r32 * PR_PITCH + 16 * hh;
        float kkv[2][16]; float n2 = 0.f, bcv = 0.f;
#pragma unroll
        for (int ct = 0; ct < 2; ++ct) {
            const int cb = 64 * h + 32 * ct + 4 * hh;
            v4u xc[3][2], xp[3][2];
#pragma unroll
            for (int a = 0; a < 3; ++a)
#pragma unroll
                for (int i = 0; i < 2; ++i) { const int mm = m0 + (lane >> 2) + 16 * i; const bf16* src = PROJ + (size_t)mm * NPROJ_P + CD + (a == 0 ? D_R : (a == 1 ? D_K : D_V)) + 64 * h + 32 * ct + 8 * (lane & 3);
                    xc[a][i] = *(const GAS v4u*)src; xp[a][i] = (v4u){0u, 0u, 0u, 0u}; if ((mm % SEQ) > 0) xp[a][i] = *(const GAS v4u*)(src - NPROJ_P); }
            f32x16 aW, aA, aG;
            { const float z_ = zero_v();
#pragma unroll
            for (int i = 0; i < 16; ++i) { aW[i] = z_; aA[i] = z_; aG[i] = z_; } }
            const bf16* wt0 = WT + ((size_t)(2 * h + ct) * 28 * 64 + lane) * 8;
#pragma unroll
            for (int grp = 0; grp < 4; ++grp) {
                bf16x8 af[7];
#pragma unroll
                for (int q = 0; q < 7; ++q) af[q] = *(const GAS bf16x8*)(wt0 + 512 * (7 * grp + q));
#pragma unroll
                for (int q = 0; q < 7; ++q) { const int ks = 7 * grp + q; const bf16x8 bfr = *(const LAS bf16x8*)(bp + 32 * ks);
                    if (ks < 6) aW = __builtin_amdgcn_mfma_f32_32x32x16_bf16(af[q], bfr, aW, 0, 0, 0);
                    else if (ks < 12) aA = __builtin_amdgcn_mfma_f32_32x32x16_bf16(af[q], bfr, aA, 0, 0, 0);
                    else aG = __builtin_amdgcn_mfma_f32_32x32x16_bf16(af[q], bfr, aG, 0, 0, 0); }
                asm volatile("" ::: "memory");
            }
            LAS unsigned char* IN = OT + 3 * PR_OT_TILE;
#pragma unroll
            for (int a = 0; a < 3; ++a)
#pragma unroll
                for (int i = 0; i < 2; ++i) { const int cch = 64 * h + 32 * ct + 8 * (lane & 3); const f32x4 m0v = *(const LAS f32x4*)(PRM + a * 512 + cch), m1v = *(const LAS f32x4*)(PRM + a * 512 + cch + 4);
                    float xcu[8], xpu[8]; UNPACK8(xcu, 0, xc[a][i]); UNPACK8(xpu, 0, xp[a][i]); const float mw[8] = {m0v.x, m0v.y, m0v.z, m0v.w, m1v.x, m1v.y, m1v.z, m1v.w};
#pragma unroll
                    for (int e = 0; e < 8; ++e) xcu[e] += (xpu[e] - xcu[e]) * mw[e];
                    LAS unsigned char* dstp = IN + a * PR_OT_TILE + ((lane >> 2) + 16 * i) * PR_OT_PITCH + 16 * (lane & 3);
                    *(LAS v2u*)dstp = (v2u){pk2(xcu[0], xcu[1]), pk2(xcu[2], xcu[3])}; *(LAS v2u*)(dstp + 8) = (v2u){pk2(xcu[4], xcu[5]), pk2(xcu[6], xcu[7])}; }
            asm volatile("" ::: "memory");
            v2u oE[4], oK[4], oG[4];
#pragma unroll
            for (int g4 = 0; g4 < 4; ++g4) {
                const int c = cb + 8 * g4;
                const f32x4 w0v = *(const LAS f32x4*)(PRM + 1536 + c),
                            a0v = *(const LAS f32x4*)(PRM + 2048 + c), kkc = *(const LAS f32x4*)(PRM + 2560 + c), kac = *(const LAS f32x4*)(PRM + 3072 + c), rkc = *(const LAS f32x4*)(PRM + 3584 + c);
                const LAS unsigned char* inq = IN + r32 * PR_OT_PITCH + 2 * (8 * g4 + 4 * hh);
                const v2u rq = *(const LAS v2u*)inq, kq = *(const LAS v2u*)(inq + PR_OT_TILE), vq = *(const LAS v2u*)(inq + 2 * PR_OT_TILE);
                const float rsu[4] = {bflo(rq.x), bfhi(rq.x), bflo(rq.y), bfhi(rq.y)}, ksu[4] = {bflo(kq.x), bfhi(kq.x), bflo(kq.y), bfhi(kq.y)}, vsu[4] = {bflo(vq.x), bfhi(vq.x), bflo(vq.y), bfhi(vq.y)};
                float ro[4], eo[4], ko[4], vo[4], ao[4], go[4];
#pragma unroll
                for (int e = 0; e < 4; ++e) {
                    const float r = rsu[e], k = ksu[e], v = vsu[e];
                    const float ee = 0.6065306597126334f * fast_sigmoid(w0v[e] + aW[4 * g4 + e]);
                    const float as = fast_sigmoid(a0v[e] + aA[4 * g4 + e]);
                    const float kv = k * kkc[e]; kkv[ct][4 * g4 + e] = kv; n2 += kv * kv;
                    const float kp = k * (1.0f + (as - 1.0f) * kac[e]);
                    bcv += r * kp * rkc[e];
                    ro[e] = r; eo[e] = ee; ko[e] = kp; vo[e] = v; ao[e] = as; go[e] = aG[4 * g4 + e];
                }
                LAS unsigned char* ot = OT + r32 * PR_OT_PITCH + 2 * (8 * g4 + 4 * hh);
                *(LAS v2u*)(ot) = (v2u){pk2(ro[0], ro[1]), pk2(ro[2], ro[3])}; *(LAS v2u*)(ot + PR_OT_TILE) = (v2u){pk2(vo[0], vo[1]), pk2(vo[2], vo[3])}; *(LAS v2u*)(ot + 2 * PR_OT_TILE) = (v2u){pk2(ao[0], ao[1]), pk2(ao[2], ao[3])};
                oE[g4] = (v2u){pk2(eo[0], eo[1]), pk2(eo[2], eo[3])}; oK[g4] = (v2u){pk2(ko[0], ko[1]), pk2(ko[2], ko[3])}; oG[g4] = (v2u){pk2(go[0], go[1]), pk2(go[2], go[3])};
            }
            asm volatile("" ::: "memory");
#pragma unroll
            for (int batch = 0; batch < 2; ++batch) {
                bf16* const dst[3] = {batch == 0 ? R_ : E_, batch == 0 ? V_ : KP_, batch == 0 ? AS_ : G_};
                if (batch == 1) {
#pragma unroll
                    for (int g4 = 0; g4 < 4; ++g4) { LAS unsigned char* ot = OT + r32 * PR_OT_PITCH + 2 * (8 * g4 + 4 * hh); *(LAS v2u*)(ot) = oE[g4]; *(LAS v2u*)(ot + PR_OT_TILE) = oK[g4]; *(LAS v2u*)(ot + 2 * PR_OT_TILE) = oG[g4]; }
                    asm volatile("" ::: "memory"); }
#pragma unroll
                for (int a = 0; a < 3; ++a)
#pragma unroll
                    for (int i = 0; i < 2; ++i) { const int tk = (lane >> 2) + 16 * i, part = lane & 3; const LAS unsigned char* src = OT + a * PR_OT_TILE + tk * PR_OT_PITCH + 16 * part;
                        const v2u lo = *(const LAS v2u*)src, hi = *(const LAS v2u*)(src + 8);
                        *(GAS v4u*)(dst[a] + (size_t)(m0 + tk) * GW + 64 * h + 32 * ct + 8 * part) = (v4u){lo.x, lo.y, hi.x, hi.y}; }
                asm volatile("" ::: "memory");
            }
        }
        n2 += __shfl_xor(n2, 32); bcv += __shfl_xor(bcv, 32);
        const float inv = 1.0f / fmaxf(sqrtf(n2), 1e-12f);
#pragma unroll
        for (int ct = 0; ct < 2; ++ct)
#pragma unroll
            for (int g4 = 0; g4 < 4; ++g4) *(LAS v2u*)(OT + ct * PR_OT_TILE + r32 * PR_OT_PITCH + 2 * (8 * g4 + 4 * hh)) = (v2u){pk2(kkv[ct][4 * g4] * inv, kkv[ct][4 * g4 + 1] * inv), pk2(kkv[ct][4 * g4 + 2] * inv, kkv[ct][4 * g4 + 3] * inv)};
        asm volatile("" ::: "memory");
#pragma unroll
        for (int ct = 0; ct < 2; ++ct)
#pragma unroll
            for (int i = 0; i < 2; ++i) { const int tk = (lane >> 2) + 16 * i, part = lane & 3; const LAS unsigned char* src = OT + ct * PR_OT_TILE + tk * PR_OT_PITCH + 16 * part;
                const v2u lo = *(const LAS v2u*)src, hi = *(const LAS v2u*)(src + 8);
                *(GAS v4u*)(KK_ + (size_t)(m0 + tk) * GW + 64 * h + 32 * ct + 8 * part) = (v4u){lo.x, lo.y, hi.x, hi.y}; }
        asm volatile("" ::: "memory");
        if (hh == 0) BC[(size_t)m * NH + h] = bcv;
        __syncthreads();
    }
}

__device__ __forceinline__ Frame mkframe(LAS unsigned char* lds, int wv) {
    Frame F; F.lds = lds; { int t_ = wv * 64 + pg8::lane_now(); asm volatile("" : "+v"(t_)); F.tid = t_; } F.lane = F.tid & 63; F.wave = wv;
    F.G = gridDim.x; { const int bx = blockIdx.x; F.vcu = (F.G % 8 == 0) ? (bx % 8) * (F.G / 8) + bx / 8 : bx; }
    F.gw = blockIdx.x * NWAVES + F.wave; F.ngw = F.G * NWAVES; return F;
}

#ifndef UNPACK8
#define UNPACK8(dst, o, W_) do { dst[(o)] = bflo((W_).x); dst[(o) + 1] = bfhi((W_).x); dst[(o) + 2] = bflo((W_).y); dst[(o) + 3] = bfhi((W_).y); dst[(o) + 4] = bflo((W_).z); dst[(o) + 5] = bfhi((W_).z); dst[(o) + 6] = bflo((W_).w); dst[(o) + 7] = bfhi((W_).w); } while (0)
#endif
#define DOT8(q, o, W_) ((q)[(o)] * bflo((W_).x) + (q)[(o) + 1] * bfhi((W_).x) + (q)[(o) + 2] * bflo((W_).y) + (q)[(o) + 3] * bfhi((W_).y) + (q)[(o) + 4] * bflo((W_).z) + (q)[(o) + 5] * bfhi((W_).z) + (q)[(o) + 6] * bflo((W_).w) + (q)[(o) + 7] * bfhi((W_).w))
#define AXPY8(acc, o, sc, pe, W_) do { acc[(o)] = acc[(o)] * (sc) + (pe) * bflo((W_).x); acc[(o) + 1] = acc[(o) + 1] * (sc) + (pe) * bfhi((W_).x); acc[(o) + 2] = acc[(o) + 2] * (sc) + (pe) * bflo((W_).y); acc[(o) + 3] = acc[(o) + 3] * (sc) + (pe) * bfhi((W_).y); \
    acc[(o) + 4] = acc[(o) + 4] * (sc) + (pe) * bflo((W_).z); acc[(o) + 5] = acc[(o) + 5] * (sc) + (pe) * bfhi((W_).z); acc[(o) + 6] = acc[(o) + 6] * (sc) + (pe) * bflo((W_).w); acc[(o) + 7] = acc[(o) + 7] * (sc) + (pe) * bfhi((W_).w); } while (0)
__device__ __forceinline__ void mix_a_simple(Frame& F) {
    const bf16* PROJ = (const bf16*)(wsp() + WS_PROJ); bf16* YC = (bf16*)(wsp() + WS_YCAT); const int* TB = (const int*)(wsp() + WS_SMALL + SM_TB); const float* pb = inp(3);
    const int nthr = F.G * NTHR;
    for (int idx = blockIdx.x * NTHR + F.tid; idx < M * NH; idx += nthr) {
        const int m = idx >> 3, h = idx & 7, t = m % SEQ;
        float q[64], acc[64];
        { const GAS v4u* qp = (const GAS v4u*)(PROJ + (size_t)m * NPROJ_P + CA_Q + 64 * h);
#pragma unroll
          for (int i = 0; i < 8; ++i) { const v4u w = qp[i]; UNPACK8(q, 8 * i, w); } }
#pragma unroll
        for (int i = 0; i < 64; ++i) acc[i] = 0.f;
        float mx = -1e30f, l = 0.f;
        for (int p = 0; p < 3; ++p) { const int d = p == 0 ? 1 : (p == 1 ? 4 : 16);
            for (int j = 0; j <= 128; ++j) { const int kp = t - j * d; if (kp < 0) break;
                const bf16* row = PROJ + (size_t)(m - j * d) * NPROJ_P; const GAS v4u* kq = (const GAS v4u*)(row + CA_K + 64 * h); const GAS v4u* vq = (const GAS v4u*)(row + CA_V + 64 * h);
                float s = 0.f;
#pragma unroll
                for (int i = 0; i < 8; ++i) { const v4u w = kq[i]; s += DOT8(q, 8 * i, w); }
                s = s * 0.125f + pb[TB[j * d] * 16 + h];
                const float mn = fmaxf(mx, s), sc = __expf(mx - mn), pe = __expf(s - mn); mx = mn; l = l * sc + pe;
#pragma unroll
                for (int i = 0; i < 8; ++i) { const v4u w = vq[i]; AXPY8(acc, 8 * i, sc, pe, w); }
            } }
        const float inv = 1.0f / l; GAS v4u* op = (GAS v4u*)(YC + (size_t)m * DM + 0 * GW + 64 * h);
#pragma unroll
        for (int i = 0; i < 8; ++i) op[i] = (v4u){pk2(acc[8 * i] * inv, acc[8 * i + 1] * inv), pk2(acc[8 * i + 2] * inv, acc[8 * i + 3] * inv), pk2(acc[8 * i + 4] * inv, acc[8 * i + 5] * inv), pk2(acc[8 * i + 6] * inv, acc[8 * i + 7] * inv)};
    }
}
__device__ __forceinline__ void mix_c_simple(Frame& F, int l = 0) {
    const bf16* PROJ = (const bf16*)(wsp() + WS_PROJ); bf16* YC = (bf16*)(wsp() + WS_YCAT); const int* TB = (const int*)(wsp() + WS_SMALL + SM_TB); const float* pb = inp(3);
    const float* KBAR = (const float*)(wsp() + CTL_KBAR) + (size_t)l * 64 * 8 * 64;
    const int nthr = F.G * NTHR;
    for (int idx = blockIdx.x * NTHR + F.tid; idx < M * NH; idx += nthr) {
        const int m = idx >> 3, h = idx & 7, t = m % SEQ, b = m / SEQ, ob = t >> 8;
        float q[64], acc[64];
        { const GAS v4u* qp = (const GAS v4u*)(PROJ + (size_t)m * NPROJ_P + CC_Q + 64 * h);
#pragma unroll
          for (int i = 0; i < 8; ++i) { const v4u w = qp[i]; UNPACK8(q, 8 * i, w); } }
        float gate[8];
#pragma unroll
        for (int n = 0; n < 8; ++n) { float s = 0.f; if (n < ob) { const float* kb = KBAR + ((b * NH + h) * 8 + n) * 64;
#pragma unroll
                for (int i = 0; i < 64; ++i) s += q[i] * kb[i]; } gate[n] = s; }
        unsigned sel = 0u;
#pragma unroll
        for (int n = 0; n < 8; ++n) { int rank = 0;
#pragma unroll
            for (int n2 = 0; n2 < 8; ++n2) rank += (n2 < ob && n2 != n && (gate[n2] > gate[n] || (gate[n2] == gate[n] && n2 < n))) ? 1 : 0;
            if (n < ob && rank < 3) sel |= 1u << n; }
        sel |= 1u << ob;
#pragma unroll
        for (int i = 0; i < 64; ++i) acc[i] = 0.f;
        float mx = -1e30f, l = 0.f;
        for (int n = 0; n <= ob; ++n) { if (!((sel >> n) & 1u)) continue; const int kmax = n == ob ? (t & 255) : 255;
            for (int i2 = 0; i2 <= kmax; ++i2) { const int kp = 256 * n + i2;
                const bf16* row = PROJ + ((size_t)b * SEQ + kp) * NPROJ_P; const GAS v4u* kq = (const GAS v4u*)(row + CC_K + 64 * h); const GAS v4u* vq = (const GAS v4u*)(row + CC_V + 64 * h);
                float s = 0.f;
#pragma unroll
                for (int i = 0; i < 8; ++i) { const v4u w = kq[i]; s += DOT8(q, 8 * i, w); }
                s = s * 0.125f + pb[TB[t - kp] * 16 + 8 + h];
                const float mn = fmaxf(mx, s), sc = __expf(mx - mn), pe = __expf(s - mn); mx = mn; l = l * sc + pe;
#pragma unroll
                for (int i = 0; i < 8; ++i) { const v4u w = vq[i]; AXPY8(acc, 8 * i, sc, pe, w); }
            } }
        const float inv = 1.0f / l; GAS v4u* op = (GAS v4u*)(YC + (size_t)m * DM + 2 * GW + 64 * h);
#pragma unroll
        for (int i = 0; i < 8; ++i) op[i] = (v4u){pk2(acc[8 * i] * inv, acc[8 * i + 1] * inv), pk2(acc[8 * i + 2] * inv, acc[8 * i + 3] * inv), pk2(acc[8 * i + 4] * inv, acc[8 * i + 5] * inv), pk2(acc[8 * i + 6] * inv, acc[8 * i + 7] * inv)};
    }
}
__device__ __forceinline__ void mix_b_simple(Frame& F, int l) {
    const bf16* PROJ = (const bf16*)(wsp() + WS_PROJ); bf16* YC = (bf16*)(wsp() + WS_YCAT); const pg8::fx_t* ST = (const pg8::fx_t*)(wsp() + CTL_STATS) + (size_t)l * M * 2;
    const float* lng = inp(4) + l * GW; const float* sw = inp(5) + (size_t)l * NH * 128 * 128; const float* sb = inp(6) + l * NH * 128;
    const int nthr = F.G * NTHR;
    for (int idx = blockIdx.x * NTHR + F.tid; idx < M * GW; idx += nthr) {
        const int m = idx >> 9, c = idx & 511, g = c >> 6, tt = m & 127, m0 = m - tt;
        const float* wrow = sw + ((size_t)g * 128 + tt) * 128; const float gn = lng[c]; float s = 0.f;
        for (int s2 = 0; s2 <= tt; ++s2) { const int ms = m0 + s2; const float mu_ = pg8::fx_get(ST + 2 * ms) * (1.0f / 512.0f), rs_ = 1.0f / sqrtf(fmaxf(pg8::fx_get(ST + 2 * ms + 1) * (1.0f / 512.0f) - mu_ * mu_, 0.f) + 1e-5f); const float vv = (gelu_tanh(bf2f(PROJ[(size_t)ms * NPROJ_P + CB_V + c])) - mu_) * rs_ * gn; s += wrow[s2] * vv; }
        const float u = gelu_tanh(bf2f(PROJ[(size_t)m * NPROJ_P + CB_U + c]));
        YC[(size_t)m * DM + GW + c] = (bf16)f2bf(u * (s + sb[g * 128 + tt]));
    }
}
__device__ __forceinline__ float rdl(float v, int k) { return __builtin_bit_cast(float, __builtin_amdgcn_readlane(__builtin_bit_cast(int, v), k)); }
__device__ __forceinline__ void mix_d_simple(Frame& F) {
    const bf16* R_ = (const bf16*)outp();
    const bf16* E_ = R_ + (size_t)M * GW; const bf16* KP_ = E_ + (size_t)M * GW; const bf16* V_ = KP_ + (size_t)M * GW;
    const bf16* KK_ = (const bf16*)outp() + (size_t)4 * M * GW; const bf16* AS_ = KK_ + (size_t)M * GW; float* YD = (float*)(wsp() + WS_YD);
    for (int it = F.gw; it < BATCH * NH; it += F.ngw) {
        const int b = it >> 3, h = it & 7; float s[64];
#pragma unroll
        for (int k = 0; k < 64; ++k) s[k] = 0.f;
        for (int t = 0; t < SEQ; ++t) {
            const size_t o = ((size_t)b * SEQ + t) * GW + 64 * h + F.lane;
            const float r = bf2f(R_[o]), w = __expf(-bf2f(E_[o])), kp = bf2f(KP_[o]), v = bf2f(V_[o]), kk = bf2f(KK_[o]), as = bf2f(AS_[o]);
            const float a = -kk, bb = kk * as;
            float sa = 0.f;
#pragma unroll
            for (int k = 0; k < 64; ++k) sa += s[k] * rdl(a, k);
            float y = 0.f;
#pragma unroll
            for (int k = 0; k < 64; ++k) { s[k] = s[k] * rdl(w, k) + sa * rdl(bb, k) + v * rdl(kp, k); y += s[k] * rdl(r, k); }
            YD[o] = y;
        }
    }
}

constexpr float LOG2E = 1.4426950408889634f;

constexpr int SC_T = 32, SC_TOK = (5 * 64 + 32) * 4, SC_BUF = SC_T * SC_TOK, SC_YB = SC_T * 32 * 4, SC_LDS = 2 * SC_BUF + 2 * SC_YB;
template <int CTRL> __device__ __forceinline__ float dpp_add(float x) {
    const int y = __builtin_amdgcn_update_dpp(0, __builtin_bit_cast(int, x), CTRL, 0xF, 0xF, false);
    return x + __builtin_bit_cast(float, y);
}
__device__ __forceinline__ float red8(float x) { x = dpp_add<0xB1>(x); x = dpp_add<0x4E>(x); x = dpp_add<0x141>(x); return x; }
__device__ __forceinline__ void scan_unit(LAS unsigned char* lds, int unit, int tid) {
    const int half = unit & 1, h = (unit >> 1) & 7, b = unit >> 4;
    const bf16* R_ = (const bf16*)outp();
    const bf16* E_ = R_ + (size_t)M * GW; const bf16* KP_ = E_ + (size_t)M * GW; const bf16* V_ = KP_ + (size_t)M * GW;
    const bf16* KK_ = (const bf16*)outp() + (size_t)4 * M * GW; const bf16* AS_ = KK_ + (size_t)M * GW; float* YD = (float*)(wsp() + WS_YD);
    const int lane = tid & 63, wave = __builtin_amdgcn_readfirstlane(tid >> 6);
    const bool scanner = wave < 4;
    const int j = lane & 7, rowl = (wave & 3) * 8 + (lane >> 3);
    const int st = tid & 255, tt = st >> 3, cg = st & 7;
    const size_t gbase = ((size_t)b * SEQ) * GW + 64 * h + 8 * cg;
#define SC_STAGE(c, buf) do { const size_t o_ = gbase + (size_t)((c) * SC_T + tt) * GW; \
        const v4u g_r = *(const GAS v4u*)(R_ + o_), g_e = *(const GAS v4u*)(E_ + o_), g_k = *(const GAS v4u*)(KP_ + o_), g_v = *(const GAS v4u*)(V_ + o_), g_kk = *(const GAS v4u*)(KK_ + o_), g_as = *(const GAS v4u*)(AS_ + o_); \
        LAS float* p_ = (LAS float*)(lds + (buf) * SC_BUF + tt * SC_TOK) + 8 * cg; float kk_[8], x_[8], y_[8]; \
        UNPACK8(kk_, 0, g_kk); \
        *(LAS f32x4*)(p_) = (f32x4){-kk_[0], -kk_[1], -kk_[2], -kk_[3]}; *(LAS f32x4*)(p_ + 4) = (f32x4){-kk_[4], -kk_[5], -kk_[6], -kk_[7]}; \
        UNPACK8(x_, 0, g_e); *(LAS f32x4*)(p_ + 64) = (f32x4){__expf(-x_[0]), __expf(-x_[1]), __expf(-x_[2]), __expf(-x_[3])}; *(LAS f32x4*)(p_ + 68) = (f32x4){__expf(-x_[4]), __expf(-x_[5]), __expf(-x_[6]), __expf(-x_[7])}; \
        UNPACK8(y_, 0, g_as); *(LAS f32x4*)(p_ + 128) = (f32x4){kk_[0] * y_[0], kk_[1] * y_[1], kk_[2] * y_[2], kk_[3] * y_[3]}; *(LAS f32x4*)(p_ + 132) = (f32x4){kk_[4] * y_[4], kk_[5] * y_[5], kk_[6] * y_[6], kk_[7] * y_[7]}; \
        UNPACK8(x_, 0, g_k); *(LAS f32x4*)(p_ + 192) = (f32x4){x_[0], x_[1], x_[2], x_[3]}; *(LAS f32x4*)(p_ + 196) = (f32x4){x_[4], x_[5], x_[6], x_[7]}; \
        UNPACK8(x_, 0, g_r); *(LAS f32x4*)(p_ + 256) = (f32x4){x_[0], x_[1], x_[2], x_[3]}; *(LAS f32x4*)(p_ + 260) = (f32x4){x_[4], x_[5], x_[6], x_[7]}; \
        if ((cg >> 2) == half) { UNPACK8(x_, 0, g_v); LAS float* v_ = (LAS float*)(lds + (buf) * SC_BUF + tt * SC_TOK) + 320 + 8 * (cg & 3); \
            *(LAS f32x4*)(v_) = (f32x4){x_[0], x_[1], x_[2], x_[3]}; *(LAS f32x4*)(v_ + 4) = (f32x4){x_[4], x_[5], x_[6], x_[7]}; } } while (0)
    if (!scanner) SC_STAGE(0, 0);
    __syncthreads();
    f32x4 s0 = {0.f, 0.f, 0.f, 0.f}, s1 = {0.f, 0.f, 0.f, 0.f};
    float ykeep = 0.f;
    for (int c = 0; c < SEQ / SC_T; ++c) {
        const int cur = c & 1;
        LAS float* yb = (LAS float*)(lds + 2 * SC_BUF + cur * SC_YB);
        if (scanner) {
            const LAS float* base = (const LAS float*)(lds + cur * SC_BUF) + 8 * j;
            const LAS float* vbase = (const LAS float*)(lds + cur * SC_BUF) + 320 + rowl;
            f32x4 a0 = *(const LAS f32x4*)(base), a1 = *(const LAS f32x4*)(base + 4), w0 = *(const LAS f32x4*)(base + 64), w1 = *(const LAS f32x4*)(base + 68), b0 = *(const LAS f32x4*)(base + 128), b1 = *(const LAS f32x4*)(base + 132),
                  k0 = *(const LAS f32x4*)(base + 192), k1 = *(const LAS f32x4*)(base + 196), r0 = *(const LAS f32x4*)(base + 256), r1 = *(const LAS f32x4*)(base + 260);
            float vv = *vbase;
#pragma unroll
            for (int t = 0; t < SC_T; ++t) {
                f32x4 na0 = a0, na1 = a1, nw0 = w0, nw1 = w1, nb0 = b0, nb1 = b1, nk0 = k0, nk1 = k1, nr0 = r0, nr1 = r1; float nv = vv;
                if (t + 1 < SC_T) { const LAS float* p = base + (t + 1) * (SC_TOK / 4);
                    na0 = *(const LAS f32x4*)(p); na1 = *(const LAS f32x4*)(p + 4); nw0 = *(const LAS f32x4*)(p + 64); nw1 = *(const LAS f32x4*)(p + 68); nb0 = *(const LAS f32x4*)(p + 128); nb1 = *(const LAS f32x4*)(p + 132);
                    nk0 = *(const LAS f32x4*)(p + 192); nk1 = *(const LAS f32x4*)(p + 196); nr0 = *(const LAS f32x4*)(p + 256); nr1 = *(const LAS f32x4*)(p + 260);
                    nv = vbase[(t + 1) * (SC_TOK / 4)]; }
                const f32x4 pa = s0 * a0 + s1 * a1;
                float sa = (pa.x + pa.y) + (pa.z + pa.w);
                const f32x4 sw0 = s0 * w0 + vv * k0, sw1 = s1 * w1 + vv * k1;
                sa = red8(sa);
                s0 = sa * b0 + sw0; s1 = sa * b1 + sw1;
                const f32x4 py = s0 * r0 + s1 * r1;
                float y = (py.x + py.y) + (py.z + py.w);
                y = red8(y);
                ykeep = (j == (t & 7)) ? y : ykeep;
                if ((t & 7) == 7) yb[((t & ~7) + j) * 32 + rowl] = ykeep;
                a0 = na0; a1 = na1; w0 = nw0; w1 = nw1; b0 = nb0; b1 = nb1; k0 = nk0; k1 = nk1; r0 = nr0; r1 = nr1; vv = nv;
            }
        } else {
            if (c > 0) {
                const LAS float* ybp = (const LAS float*)(lds + 2 * SC_BUF + (cur ^ 1) * SC_YB); const int t2 = st >> 3, q4 = st & 7; const f32x4 v = *(const LAS f32x4*)(ybp + t2 * 32 + 4 * q4);
                *(GAS f32x4*)(YD + ((size_t)b * SEQ + (c - 1) * SC_T + t2) * GW + 64 * h + 32 * half + 4 * q4) = v; }
            if (c + 1 < SEQ / SC_T) SC_STAGE(c + 1, cur ^ 1);
        }
        __syncthreads();
    }
    if (!scanner) { const LAS float* ybp = (const LAS float*)(lds + 2 * SC_BUF + 1 * SC_YB); const int t2 = st >> 3, q4 = st & 7; const f32x4 v = *(const LAS f32x4*)(ybp + t2 * 32 + 4 * q4);
        *(GAS f32x4*)(YD + ((size_t)b * SEQ + (SEQ / SC_T - 1) * SC_T + t2) * GW + 64 * h + 32 * half + 4 * q4) = v; }
#undef SC_STAGE
    __syncthreads();
}

struct AttnSt { f32x16 o0, o1; float m, l; };
__device__ __forceinline__ void attn_init(AttnSt& st) {
    const float z_ = zero_v();
#pragma unroll
    for (int i = 0; i < 16; ++i) { st.o0[i] = z_; st.o1[i] = z_; }
    st.m = -1e30f; st.l = 0.f;
}
__device__ __forceinline__ void attn_tile(AttnSt& st, const bf16x8 (&qf)[4], const bf16* Kcol, const bf16* Vcol, int rowb, int kb, int ks, int qpos, int maxd, bool sel, const LAS float* biasT, int r32, int hh) {
    int kp_l = kb + r32 * ks; kp_l = kp_l < 0 ? 0 : kp_l;
    const bf16* kr_ = Kcol + (size_t)(rowb + kp_l) * NPROJ_P + 8 * hh;
    bf16x8 kf[4];
#pragma unroll
    for (int s = 0; s < 4; ++s) kf[s] = *(const GAS bf16x8*)(kr_ + 16 * s);
    f32x16 sc;
#pragma unroll
    for (int i = 0; i < 16; ++i) sc[i] = 0.f;
#pragma unroll
    for (int s = 0; s < 4; ++s) sc = __builtin_amdgcn_mfma_f32_32x32x16_bf16(kf[s], qf[s], sc, 0, 0, 0);
    unsigned vf[2][2][4];
#pragma unroll
    for (int s2 = 0; s2 < 2; ++s2)
#pragma unroll
        for (int jp = 0; jp < 4; ++jp) {
            const int j0 = 2 * jp, key0 = 16 * s2 + 8 * (j0 >> 2) + 4 * hh + (j0 & 3);
            int kp0 = kb + key0 * ks, kp1 = kp0 + ks; kp0 = kp0 < 0 ? 0 : kp0; kp1 = kp1 < 0 ? 0 : kp1;
            const bf16* v0 = Vcol + (size_t)(rowb + kp0) * NPROJ_P + r32; const bf16* v1 = Vcol + (size_t)(rowb + kp1) * NPROJ_P + r32;
            vf[0][s2][jp] = (unsigned)v0[0] | ((unsigned)v1[0] << 16); vf[1][s2][jp] = (unsigned)v0[32] | ((unsigned)v1[32] << 16);
        }
    float tmax = -INFINITY;
#pragma unroll
    for (int r = 0; r < 16; ++r) {
        const int kr = (r & 3) + 8 * (r >> 2) + 4 * hh, kp = kb + kr * ks, dist = qpos - kp;
        const bool ok = sel && dist >= 0 && dist <= maxd && kp >= 0;
        const float v = sc[r] * (0.125f * LOG2E) + biasT[ok ? dist : 0];
        sc[r] = ok ? v : -INFINITY; tmax = fmaxf(tmax, sc[r]);
    }
    tmax = fmaxf(tmax, __shfl_xor(tmax, 32));
    const float mn = fmaxf(st.m, tmax), scale = __builtin_amdgcn_exp2f(st.m - mn); st.m = mn;
    float ls = 0.f;
#pragma unroll
    for (int r = 0; r < 16; ++r) { sc[r] = __builtin_amdgcn_exp2f(sc[r] - mn); ls += sc[r]; }
    st.l = st.l * scale + ls;
#pragma unroll
    for (int i = 0; i < 16; ++i) { st.o0[i] *= scale; st.o1[i] *= scale; }
    typedef unsigned u32x4_t __attribute__((ext_vector_type(4)));
#pragma unroll
    for (int s2 = 0; s2 < 2; ++s2) {
        u32x4_t pw; pw.x = pg8::cvt_pk_bf16(sc[8 * s2], sc[8 * s2 + 1]); pw.y = pg8::cvt_pk_bf16(sc[8 * s2 + 2], sc[8 * s2 + 3]); pw.z = pg8::cvt_pk_bf16(sc[8 * s2 + 4], sc[8 * s2 + 5]); pw.w = pg8::cvt_pk_bf16(sc[8 * s2 + 6], sc[8 * s2 + 7]);
        const bf16x8 pf = __builtin_bit_cast(bf16x8, pw);
        u32x4_t a0 = {vf[0][s2][0], vf[0][s2][1], vf[0][s2][2], vf[0][s2][3]}, a1 = {vf[1][s2][0], vf[1][s2][1], vf[1][s2][2], vf[1][s2][3]};
        st.o0 = __builtin_amdgcn_mfma_f32_32x32x16_bf16(__builtin_bit_cast(bf16x8, a0), pf, st.o0, 0, 0, 0);
        st.o1 = __builtin_amdgcn_mfma_f32_32x32x16_bf16(__builtin_bit_cast(bf16x8, a1), pf, st.o1, 0, 0, 0);
    }
}
__device__ __forceinline__ void attn_loadq(bf16x8 (&qf)[4], const bf16* Qcol, int row, int hh) {
    const bf16* q = Qcol + (size_t)row * NPROJ_P + 8 * hh;
#pragma unroll
    for (int s = 0; s < 4; ++s) qf[s] = *(const GAS bf16x8*)(q + 16 * s);
}
__device__ __forceinline__ void attn_store(const f32x16& o0, const f32x16& o1, float inv, bf16* yrow, int hh) {
#pragma unroll
    for (int g = 0; g < 4; ++g) {
        *(GAS v2u*)(yrow + 8 * g + 4 * hh) = (v2u){pk2(o0[4 * g] * inv, o0[4 * g + 1] * inv), pk2(o0[4 * g + 2] * inv, o0[4 * g + 3] * inv)};
        *(GAS v2u*)(yrow + 32 + 8 * g + 4 * hh) = (v2u){pk2(o1[4 * g] * inv, o1[4 * g + 1] * inv), pk2(o1[4 * g + 2] * inv, o1[4 * g + 3] * inv)};
    }
}
__device__ __forceinline__ void build_bias(LAS float* biasT, int hcol, int tid) {
    const f32x4 bv = *(const GAS f32x4*)((const float*)(wsp() + WS_SMALL + SM_BIAS) + hcol * 2048 + 4 * tid); const v4u tv = *(const GAS v4u*)((const unsigned*)(wsp() + WS_SMALL + SM_TB) + 4 * tid);
    *(LAS f32x4*)(biasT + 4 * tid) = bv; *(LAS v4u*)((LAS unsigned*)(biasT + 2048) + 4 * tid) = tv;
}

constexpr int MC_KP = 144, MC_VP = 192, MC_KB = 128 * MC_KP, MC_VB = 128 * MC_VP, MC_K_OFF = 16384, MC_V_OFF = MC_K_OFF + 2 * MC_KB, MC_LDS = MC_V_OFF + 2 * MC_VB;
typedef short v4i16_t __attribute__((ext_vector_type(4)));
__device__ __forceinline__ float pl32_max(float a) { float x = a, y = a;
    asm volatile("s_nop 1\n\tv_permlane32_swap_b32_e32 %0, %1\n\ts_nop 0" : "+v"(x), "+v"(y));
    return fmaxf(x, y); }
template <int MODE> __device__ __forceinline__ void moba_tile(AttnSt& st, const bf16x8 (&qf)[4], const LAS unsigned char* Kt, const LAS unsigned char* Vt, const LAS float* biasT, const LAS int* TB, int dlo, bool sel, int lane, int r32, int hh) {
    bf16x8 kf[4];
#pragma unroll
    for (int s = 0; s < 4; ++s) kf[s] = *(const LAS bf16x8*)(Kt + r32 * MC_KP + 32 * s + 16 * hh);
    v4i16_t vt[2][2][2];
    { const LAS unsigned char* vb = Vt + (4 * hh + ((lane & 15) >> 2)) * MC_VP + (16 * ((lane >> 4) & 1) + 4 * (lane & 3)) * 2;
#pragma unroll
      for (int dh = 0; dh < 2; ++dh)
#pragma unroll
        for (int s2 = 0; s2 < 2; ++s2)
#pragma unroll
            for (int h8 = 0; h8 < 2; ++h8) vt[dh][s2][h8] = __builtin_amdgcn_ds_read_tr16_b64_v4i16((LAS v4i16_t*)(vb + (16 * s2 + 8 * h8) * MC_VP + 64 * dh)); }
    f32x16 sc;
#pragma unroll
    for (int i = 0; i < 16; ++i) sc[i] = 0.f;
#pragma unroll
    for (int s = 0; s < 4; ++s) sc = __builtin_amdgcn_mfma_f32_32x32x16_bf16(kf[s], qf[s], sc, 0, 0, 0);
    const int d0 = dlo + r32 + 31 - 4 * hh;
    const int dmin = dlo < 0 ? 0 : dlo, dmax = dlo + 62;
    const bool uni = __builtin_amdgcn_readfirstlane(TB[dmin]) == __builtin_amdgcn_readfirstlane(TB[dmax]);
    float tmax = -INFINITY;
    if (uni) { const float bu = biasT[dmin];
#pragma unroll
        for (int r = 0; r < 16; ++r) { float v = sc[r] * (0.125f * LOG2E) + bu; if (MODE == 1) { const int dist = d0 - (r & 3) - 8 * (r >> 2); v = dist >= 0 ? v : -INFINITY; } sc[r] = v; tmax = fmaxf(tmax, v); }
    } else {
#pragma unroll
        for (int r = 0; r < 16; ++r) { const int dist = d0 - (r & 3) - 8 * (r >> 2); float v = sc[r] * (0.125f * LOG2E) + biasT[dist < 0 ? 0 : dist]; if (MODE == 1) v = dist >= 0 ? v : -INFINITY; sc[r] = v; tmax = fmaxf(tmax, v); }
    }
    if (MODE == 2) tmax = sel ? tmax : -INFINITY;
    tmax = pl32_max(tmax);
    const float mn = fmaxf(st.m, tmax);
    if (__ballot(mn > st.m) != 0ull) { const float scale = __builtin_amdgcn_exp2f(st.m - mn); st.l *= scale;
#pragma unroll
        for (int i = 0; i < 16; ++i) { st.o0[i] *= scale; st.o1[i] *= scale; } }
    st.m = mn;
    const float msub = (MODE == 2 && !sel) ? INFINITY : mn;
    float ls = 0.f;
#pragma unroll
    for (int r = 0; r < 16; ++r) { sc[r] = __builtin_amdgcn_exp2f(sc[r] - msub); ls += sc[r]; }
    st.l += ls;
    typedef unsigned u32x4_t __attribute__((ext_vector_type(4)));
#pragma unroll
    for (int s2 = 0; s2 < 2; ++s2) {
        u32x4_t pw; pw.x = pg8::cvt_pk_bf16(sc[8 * s2], sc[8 * s2 + 1]); pw.y = pg8::cvt_pk_bf16(sc[8 * s2 + 2], sc[8 * s2 + 3]); pw.z = pg8::cvt_pk_bf16(sc[8 * s2 + 4], sc[8 * s2 + 5]); pw.w = pg8::cvt_pk_bf16(sc[8 * s2 + 6], sc[8 * s2 + 7]);
        const bf16x8 pf = __builtin_bit_cast(bf16x8, pw);
        const bf16x8 a0 = {vt[0][s2][0][0], vt[0][s2][0][1], vt[0][s2][0][2], vt[0][s2][0][3], vt[0][s2][1][0], vt[0][s2][1][1], vt[0][s2][1][2], vt[0][s2][1][3]};
        const bf16x8 a1 = {vt[1][s2][0][0], vt[1][s2][0][1], vt[1][s2][0][2], vt[1][s2][0][3], vt[1][s2][1][0], vt[1][s2][1][1], vt[1][s2][1][2], vt[1][s2][1][3]};
        st.o0 = __builtin_amdgcn_mfma_f32_32x32x16_bf16(a0, pf, st.o0, 0, 0, 0);
        st.o1 = __builtin_amdgcn_mfma_f32_32x32x16_bf16(a1, pf, st.o1, 0, 0, 0);
    }
}
__device__ __forceinline__ void moba_unit(LAS unsigned char* lds, int unit, int tid, int l) {
    const int ob = unit & 7, h = (unit >> 3) & 7, b = unit >> 6, lane = tid & 63, wave = __builtin_amdgcn_readfirstlane(tid >> 6), r32 = lane & 31, hh = lane >> 5;
    LAS float* biasT = (LAS float*)lds;
    build_bias(biasT, 8 + h, tid);
    const bf16* PROJ = (const bf16*)(wsp() + WS_PROJ); const float* KBAR = (const float*)(wsp() + CTL_KBAR) + (size_t)l * 64 * 8 * 64 + ((b * NH + h) * 8) * 64; const LAS int* TB = (const LAS int*)(biasT + 2048);
    const int rowb = b * SEQ, qpos = 256 * ob + 32 * wave + r32;
    bf16x8 qf[4]; attn_loadq(qf, PROJ + CC_Q + 64 * h, rowb + qpos, hh);
    float gate[8];
#pragma unroll
    for (int n = 0; n < 8; ++n) { float s = 0.f;
        if (n < ob) {
#pragma unroll
            for (int s4 = 0; s4 < 4; ++s4) { const f32x4 k0 = *(const GAS f32x4*)(KBAR + n * 64 + 16 * s4 + 8 * hh), k1 = *(const GAS f32x4*)(KBAR + n * 64 + 16 * s4 + 8 * hh + 4);
                const v4u qw = __builtin_bit_cast(v4u, qf[s4]);
                s += bflo(qw.x) * k0.x + bfhi(qw.x) * k0.y + bflo(qw.y) * k0.z + bfhi(qw.y) * k0.w + bflo(qw.z) * k1.x + bfhi(qw.z) * k1.y + bflo(qw.w) * k1.z + bfhi(qw.w) * k1.w; }
            s += __shfl_xor(s, 32); }
        gate[n] = s; }
    unsigned selm = 0u;
#pragma unroll
    for (int n = 0; n < 8; ++n) { int rank = 0;
#pragma unroll
        for (int n2 = 0; n2 < 8; ++n2) rank += (n2 < ob && n2 != n && (gate[n2] > gate[n] || (gate[n2] == gate[n] && n2 < n))) ? 1 : 0;
        if (n < ob && rank < 3) selm |= 1u << n; }
    AttnSt st; attn_init(st);
    const int skey = tid >> 2, spart = tid & 3;
    const bf16* Kg = PROJ + (size_t)rowb * NPROJ_P + CC_K + 64 * h + 16 * spart; const bf16* Vg = PROJ + (size_t)rowb * NPROJ_P + CC_V + 64 * h + 16 * spart;
    bf16x8 gk0, gk1, gv0, gv1;
#define MC_GLOAD(i) do { const size_t ro_ = (size_t)(128 * (i) + skey) * NPROJ_P; gk0 = *(const GAS bf16x8*)(Kg + ro_); gk1 = *(const GAS bf16x8*)(Kg + ro_ + 8); gv0 = *(const GAS bf16x8*)(Vg + ro_); gv1 = *(const GAS bf16x8*)(Vg + ro_ + 8); } while (0)
#define MC_LSTORE(bf) do { LAS unsigned char* kd_ = lds + MC_K_OFF + (bf) * MC_KB + skey * MC_KP + 32 * spart; *(LAS bf16x8*)(kd_) = gk0; *(LAS bf16x8*)(kd_ + 16) = gk1; \
        LAS unsigned char* vd_ = lds + MC_V_OFF + (bf) * MC_VB + skey * MC_VP + 32 * spart; *(LAS bf16x8*)(vd_) = gv0; *(LAS bf16x8*)(vd_ + 16) = gv1; } while (0)
    const int nst = 2 * (ob + 1);
    MC_GLOAD(0); MC_LSTORE(0);
    __syncthreads();
    for (int i = 0; i < nst; ++i) {
        if (i + 1 < nst) MC_GLOAD(i + 1);
        const int n = i >> 1, hf = i & 1; const bool own = n == ob, sel = own || ((selm >> n) & 1u);
        const LAS unsigned char* Kb = lds + MC_K_OFF + (i & 1) * MC_KB; const LAS unsigned char* Vb = lds + MC_V_OFF + (i & 1) * MC_VB;
        if (own) {
#pragma unroll 1
            for (int sub = 0; sub < 4; ++sub) { const int jt = 4 * hf + sub; if (jt > wave) break; const int dlo = 32 * wave - (32 * jt + 31);
                if (jt == wave) moba_tile<1>(st, qf, Kb + sub * 32 * MC_KP, Vb + sub * 32 * MC_VP, biasT, TB, dlo, true, lane, r32, hh);
                else moba_tile<0>(st, qf, Kb + sub * 32 * MC_KP, Vb + sub * 32 * MC_VP, biasT, TB, dlo, true, lane, r32, hh); }
        } else if (__ballot(sel) != 0ull) {
#pragma unroll 1
            for (int sub = 0; sub < 4; ++sub) { const int dlo = 256 * ob + 32 * wave - (256 * n + 128 * hf + 32 * sub + 31);
                moba_tile<2>(st, qf, Kb + sub * 32 * MC_KP, Vb + sub * 32 * MC_VP, biasT, TB, dlo, sel, lane, r32, hh); }
        }
        if (i + 1 < nst) MC_LSTORE((i + 1) & 1);
        __syncthreads();
    }
#undef MC_GLOAD
#undef MC_LSTORE
    const float lt = st.l + __shfl_xor(st.l, 32);
    attn_store(st.o0, st.o1, 1.0f / lt, (bf16*)(wsp() + WS_YCAT) + (size_t)(rowb + qpos) * DM + 2 * GW + 64 * h, hh);
}

constexpr int MA_PITCH = 144, MA_ML_OFF = 512 * MA_PITCH, MA_BIAS_OFF = MA_ML_OFF + 512 * 8, MA_V_OFF = MA_BIAS_OFF + 16384, MA_VW = 32 * MC_VP, MA_LDS = MA_V_OFF + 8 * MA_VW;
template <bool MASKED> __device__ __forceinline__ void dil_tile(AttnSt& st, const bf16x8 (&qf)[4], const bf16x8 (&kf)[4], const LAS unsigned char* Vt, const LAS float* biasT, const LAS int* TB, int dl0, int dstep, int kb, int lane, int r32, int hh) {
    v4i16_t vt[2][2][2];
    { const LAS unsigned char* vb = Vt + (4 * hh + ((lane & 15) >> 2)) * MC_VP + (16 * ((lane >> 4) & 1) + 4 * (lane & 3)) * 2;
#pragma unroll
      for (int dh = 0; dh < 2; ++dh)
#pragma unroll
        for (int s2 = 0; s2 < 2; ++s2)
#pragma unroll
            for (int h8 = 0; h8 < 2; ++h8) vt[dh][s2][h8] = __builtin_amdgcn_ds_read_tr16_b64_v4i16((LAS v4i16_t*)(vb + (16 * s2 + 8 * h8) * MC_VP + 64 * dh)); }
    f32x16 sc;
#pragma unroll
    for (int i = 0; i < 16; ++i) sc[i] = 0.f;
#pragma unroll
    for (int s = 0; s < 4; ++s) sc = __builtin_amdgcn_mfma_f32_32x32x16_bf16(kf[s], qf[s], sc, 0, 0, 0);
    const int e0 = dl0 + r32 - 4 * hh;
    int dmin = (dl0 - 31) * dstep, dmax = (dl0 + 31) * dstep; dmin = dmin < 0 ? 0 : dmin; dmax = dmax > 2047 ? 2047 : dmax;
    const bool uni = __builtin_amdgcn_readfirstlane(TB[dmin]) == __builtin_amdgcn_readfirstlane(TB[dmax]);
    const float bu = biasT[dmin];
    float tmax = -INFINITY;
#pragma unroll
    for (int r = 0; r < 16; ++r) {
        const int kr0 = (r & 3) + 8 * (r >> 2), delta = e0 - kr0;
        float bias = bu;
        if (!uni) { int di = delta * dstep; di = di < 0 ? 0 : (di > 2047 ? 2047 : di); bias = biasT[di]; }
        float v = sc[r] * (0.125f * LOG2E) + bias;
        if (MASKED) { const bool ok = delta >= 0 && delta <= 128 && (kb + (kr0 + 4 * hh) * dstep) >= 0; v = ok ? v : -INFINITY; }
        sc[r] = v; tmax = fmaxf(tmax, v);
    }
    tmax = pl32_max(tmax);
    const float mn = fmaxf(st.m, tmax);
    if (__ballot(mn > st.m) != 0ull) { const float scale = __builtin_amdgcn_exp2f(st.m - mn); st.l *= scale;
#pragma unroll
        for (int i = 0; i < 16; ++i) { st.o0[i] *= scale; st.o1[i] *= scale; } }
    st.m = mn;
    float ls = 0.f;
#pragma unroll
    for (int r = 0; r < 16; ++r) { sc[r] = __builtin_amdgcn_exp2f(sc[r] - mn); ls += sc[r]; }
    st.l += ls;
    typedef unsigned u32x4_t __attribute__((ext_vector_type(4)));
#pragma unroll
    for (int s2 = 0; s2 < 2; ++s2) {
        u32x4_t pw; pw.x = pg8::cvt_pk_bf16(sc[8 * s2], sc[8 * s2 + 1]); pw.y = pg8::cvt_pk_bf16(sc[8 * s2 + 2], sc[8 * s2 + 3]); pw.z = pg8::cvt_pk_bf16(sc[8 * s2 + 4], sc[8 * s2 + 5]); pw.w = pg8::cvt_pk_bf16(sc[8 * s2 + 6], sc[8 * s2 + 7]);
        const bf16x8 pf = __builtin_bit_cast(bf16x8, pw);
        const bf16x8 a0 = {vt[0][s2][0][0], vt[0][s2][0][1], vt[0][s2][0][2], vt[0][s2][0][3], vt[0][s2][1][0], vt[0][s2][1][1], vt[0][s2][1][2], vt[0][s2][1][3]};
        const bf16x8 a1 = {vt[1][s2][0][0], vt[1][s2][0][1], vt[1][s2][0][2], vt[1][s2][0][3], vt[1][s2][1][0], vt[1][s2][1][1], vt[1][s2][1][2], vt[1][s2][1][3]};
        st.o0 = __builtin_amdgcn_mfma_f32_32x32x16_bf16(a0, pf, st.o0, 0, 0, 0);
        st.o1 = __builtin_amdgcn_mfma_f32_32x32x16_bf16(a1, pf, st.o1, 0, 0, 0);
    }
}
__device__ __forceinline__ void dil_unit(LAS unsigned char* lds, int unit, int tid) {
    const int sp = unit & 3, h = (unit >> 2) & 7, b = unit >> 5, lane = tid & 63, wave = __builtin_amdgcn_readfirstlane(tid >> 6), r32 = lane & 31, hh = lane >> 5;
    LAS float* biasT = (LAS float*)(lds + MA_BIAS_OFF);
    build_bias(biasT, h, tid);
    __syncthreads();
    const bf16* PROJ = (const bf16*)(wsp() + WS_PROJ); const LAS int* TB = (const LAS int*)(biasT + 2048); const int rowb = b * SEQ, t0 = 512 * sp;
    const bf16* Qc = PROJ + CA_Q + 64 * h; const bf16* Kc = PROJ + CA_K + 64 * h; const bf16* Vc = PROJ + CA_V + 64 * h;
    LAS unsigned char* Vst = lds + MA_V_OFF + wave * MA_VW;
    const int vkey = lane >> 1, vhalf = lane & 1;
#pragma unroll 1
    for (int p = 0; p < 3; ++p) {
        const int d = p == 0 ? 1 : (p == 1 ? 4 : 16);
#pragma unroll 1
        for (int gi = 0; gi < 2; ++gi) {
            const int g = 2 * wave + gi;
            const int qb = t0 + (p == 0 ? 32 * g : (p == 1 ? 128 * (g >> 2) + (g & 3) : g));
            const int qpos = qb + r32 * d, qi = qpos - t0;
            bf16x8 qf[4]; attn_loadq(qf, Qc, rowb + qpos, hh);
            AttnSt st; attn_init(st);
            int jt = 0; while (qb + (32 * jt - 128 + 31) * d < 0) ++jt;
            bf16x8 kfn[4], vrn[4];
#define MA_GLOAD(JT) do { const int kb_ = qb + (32 * (JT) - 128) * d; int kp_ = kb_ + r32 * d; kp_ = kp_ < 0 ? 0 : kp_; const bf16* kr_ = Kc + (size_t)(rowb + kp_) * NPROJ_P + 8 * hh; \
                _Pragma("unroll") for (int s = 0; s < 4; ++s) kfn[s] = *(const GAS bf16x8*)(kr_ + 16 * s); \
                int vp_ = kb_ + vkey * d; vp_ = vp_ < 0 ? 0 : vp_; const bf16* vr_ = Vc + (size_t)(rowb + vp_) * NPROJ_P + 32 * vhalf; \
                _Pragma("unroll") for (int s = 0; s < 4; ++s) vrn[s] = *(const GAS bf16x8*)(vr_ + 8 * s); } while (0)
            MA_GLOAD(jt);
#pragma unroll 1
            for (; jt < 5; ++jt) {
                bf16x8 kf[4] = {kfn[0], kfn[1], kfn[2], kfn[3]};
                { LAS unsigned char* vd = Vst + vkey * MC_VP + 64 * vhalf;
#pragma unroll
                  for (int s = 0; s < 4; ++s) *(LAS bf16x8*)(vd + 16 * s) = vrn[s]; }
                asm volatile("" ::: "memory");
                if (jt + 1 < 5) MA_GLOAD(jt + 1);
                const int kb = qb + (32 * jt - 128) * d, dl0 = 128 - 32 * jt;
                if (jt == 0 || jt == 4 || kb < 0) dil_tile<true>(st, qf, kf, Vst, biasT, TB, dl0, d, kb, lane, r32, hh);
                else dil_tile<false>(st, qf, kf, Vst, biasT, TB, dl0, d, kb, lane, r32, hh);
            }
#undef MA_GLOAD
            float lt = st.l + __shfl_xor(st.l, 32);
            LAS unsigned char* orow = lds + qi * MA_PITCH; LAS float* ml = (LAS float*)(lds + MA_ML_OFF + qi * 8);
            if (p > 0) {
                const float mo = ml[0], lo = ml[1], mn = fmaxf(mo, st.m), fo = __builtin_amdgcn_exp2f(mo - mn), fc = __builtin_amdgcn_exp2f(st.m - mn);
                lt = lo * fo + lt * fc;
#pragma unroll
                for (int g4 = 0; g4 < 4; ++g4) { const v2u a = *(const LAS v2u*)(orow + 2 * (8 * g4 + 4 * hh)), c = *(const LAS v2u*)(orow + 64 + 2 * (8 * g4 + 4 * hh));
                    const float av[4] = {bflo(a.x), bfhi(a.x), bflo(a.y), bfhi(a.y)}, cv[4] = {bflo(c.x), bfhi(c.x), bflo(c.y), bfhi(c.y)};
#pragma unroll
                    for (int e = 0; e < 4; ++e) { st.o0[4 * g4 + e] = av[e] * fo + st.o0[4 * g4 + e] * fc; st.o1[4 * g4 + e] = cv[e] * fo + st.o1[4 * g4 + e] * fc; } }
                st.m = mn;
            }
            if (p < 2) {
#pragma unroll
                for (int g4 = 0; g4 < 4; ++g4) { *(LAS v2u*)(orow + 2 * (8 * g4 + 4 * hh)) = (v2u){pk2(st.o0[4 * g4], st.o0[4 * g4 + 1]), pk2(st.o0[4 * g4 + 2], st.o0[4 * g4 + 3])};
                    *(LAS v2u*)(orow + 64 + 2 * (8 * g4 + 4 * hh)) = (v2u){pk2(st.o1[4 * g4], st.o1[4 * g4 + 1]), pk2(st.o1[4 * g4 + 2], st.o1[4 * g4 + 3])}; }
                if (hh == 0) { ml[0] = st.m; ml[1] = lt; }
            } else attn_store(st.o0, st.o1, 1.0f / lt, (bf16*)(wsp() + WS_YCAT) + (size_t)(rowb + qpos) * DM + 0 * GW + 64 * h, hh);
        }
        __syncthreads();
    }
}

constexpr int SG_PITCH = 144, SG_WAVE = 128 * SG_PITCH, SG_OP = 272;
static_assert(8 * SG_WAVE <= MISC_OFF && 32 * SG_OP <= SG_WAVE, "SGU LDS");
__device__ __forceinline__ void sgu_unit(LAS unsigned char* lds, int unit, int tid, int l) {
    const int lane = tid & 63, g = __builtin_amdgcn_readfirstlane(tid >> 6), r32 = lane & 31, hh = lane >> 5, m0 = unit * 128;
    const bf16* PROJ = (const bf16*)(wsp() + WS_PROJ); bf16* YC = (bf16*)(wsp() + WS_YCAT); const pg8::fx_t* ST = (const pg8::fx_t*)(wsp() + CTL_STATS) + (size_t)l * M * 2;
    const float* lng = inp(4) + l * GW; const float* sw = inp(5) + ((size_t)l * NH + g) * 128 * 128; const float* sb = inp(6) + (l * NH + g) * 128;
    LAS unsigned char* T = lds + g * SG_WAVE;
    const int tk8 = lane >> 3, part = lane & 7;
    { const f32x4 g0 = *(const GAS f32x4*)(lng + 64 * g + 8 * part), g1 = *(const GAS f32x4*)(lng + 64 * g + 8 * part + 4);
      const float gn[8] = {g0.x, g0.y, g0.z, g0.w, g1.x, g1.y, g1.z, g1.w};
#pragma unroll 4
      for (int i = 0; i < 16; ++i) { const int tkn = tk8 + 8 * i, mm = m0 + tkn;
          const v4u w = *(const GAS v4u*)(PROJ + (size_t)mm * NPROJ_P + CB_V + 64 * g + 8 * part);
          const float mu = pg8::fx_get(ST + 2 * mm) * (1.0f / 512.0f), rs = __builtin_amdgcn_rsqf(fmaxf(pg8::fx_get(ST + 2 * mm + 1) * (1.0f / 512.0f) - mu * mu, 0.f) + 1e-5f);
          float x[8] = {bflo(w.x), bfhi(w.x), bflo(w.y), bfhi(w.y), bflo(w.z), bfhi(w.z), bflo(w.w), bfhi(w.w)};
#pragma unroll
          for (int e = 0; e < 8; ++e) x[e] = (gelu_tanh(x[e]) - mu) * rs * gn[e];
          *(LAS v4u*)(T + tkn * SG_PITCH + 16 * part) = (v4u){pk2(x[0], x[1]), pk2(x[2], x[3]), pk2(x[4], x[5]), pk2(x[6], x[7])}; } }
    asm volatile("" ::: "memory");
    f32x16 acc[4][2];
    const float z_ = zero_v();
#pragma unroll
    for (int tt = 0; tt < 4; ++tt)
#pragma unroll
        for (int ct = 0; ct < 2; ++ct)
#pragma unroll
            for (int i = 0; i < 16; ++i) acc[tt][ct][i] = z_;
    const LAS unsigned char* vb = T + (8 * hh + ((lane & 15) >> 2)) * SG_PITCH + (16 * ((lane >> 4) & 1) + 4 * (lane & 3)) * 2;
#pragma unroll
    for (int k = 0; k < 8; ++k) {
        v4i16_t t00 = __builtin_amdgcn_ds_read_tr16_b64_v4i16((LAS v4i16_t*)(vb + (16 * k) * SG_PITCH)), t01 = __builtin_amdgcn_ds_read_tr16_b64_v4i16((LAS v4i16_t*)(vb + (16 * k + 4) * SG_PITCH));
        v4i16_t t10 = __builtin_amdgcn_ds_read_tr16_b64_v4i16((LAS v4i16_t*)(vb + (16 * k) * SG_PITCH + 64)), t11 = __builtin_amdgcn_ds_read_tr16_b64_v4i16((LAS v4i16_t*)(vb + (16 * k + 4) * SG_PITCH + 64));
        const bf16x8 af0 = {t00[0], t00[1], t00[2], t00[3], t01[0], t01[1], t01[2], t01[3]}, af1 = {t10[0], t10[1], t10[2], t10[3], t11[0], t11[1], t11[2], t11[3]};
#pragma unroll
        for (int tt = 0; tt < 4; ++tt) { if (k < 2 * (tt + 1)) {
                const int t = 32 * tt + r32, s0 = 16 * k + 8 * hh; const float* wrow = sw + (size_t)t * 128 + s0;
                const f32x4 w0 = *(const GAS f32x4*)(wrow), w1 = *(const GAS f32x4*)(wrow + 4);
                float wv[8] = {w0.x, w0.y, w0.z, w0.w, w1.x, w1.y, w1.z, w1.w};
#pragma unroll
                for (int j = 0; j < 8; ++j) wv[j] = (s0 + j <= t) ? wv[j] : 0.f;
                const v4u bw = {pk2(wv[0], wv[1]), pk2(wv[2], wv[3]), pk2(wv[4], wv[5]), pk2(wv[6], wv[7])}; const bf16x8 bfr = __builtin_bit_cast(bf16x8, bw);
                acc[tt][0] = __builtin_amdgcn_mfma_f32_32x32x16_bf16(af0, bfr, acc[tt][0], 0, 0, 0); acc[tt][1] = __builtin_amdgcn_mfma_f32_32x32x16_bf16(af1, bfr, acc[tt][1], 0, 0, 0); } }
    }
    asm volatile("" ::: "memory");
#pragma unroll
    for (int tt = 0; tt < 4; ++tt) {
        const float bias = sb[32 * tt + r32];
#pragma unroll
        for (int ct = 0; ct < 2; ++ct)
#pragma unroll
            for (int g4 = 0; g4 < 4; ++g4) { const f32x16& a = acc[tt][ct];
                *(LAS f32x4*)(T + r32 * SG_OP + 4 * (32 * ct + 8 * g4 + 4 * hh)) = (f32x4){a[4 * g4] + bias, a[4 * g4 + 1] + bias, a[4 * g4 + 2] + bias, a[4 * g4 + 3] + bias}; }
        asm volatile("" ::: "memory");
#pragma unroll
        for (int i = 0; i < 4; ++i) { const int tkn = tk8 + 8 * i, mm = m0 + 32 * tt + tkn;
            const v4u uw = *(const GAS v4u*)(PROJ + (size_t)mm * NPROJ_P + CB_U + 64 * g + 8 * part);
            const f32x4 x0 = *(const LAS f32x4*)(T + tkn * SG_OP + 32 * part), x1 = *(const LAS f32x4*)(T + tkn * SG_OP + 32 * part + 16);
            const float u[8] = {bflo(uw.x), bfhi(uw.x), bflo(uw.y), bfhi(uw.y), bflo(uw.z), bfhi(uw.z), bflo(uw.w), bfhi(uw.w)};
            *(GAS v4u*)(YC + (size_t)mm * DM + GW + 64 * g + 8 * part) = (v4u){pk2(gelu_tanh(u[0]) * x0.x, gelu_tanh(u[1]) * x0.y), pk2(gelu_tanh(u[2]) * x0.z, gelu_tanh(u[3]) * x0.w), pk2(gelu_tanh(u[4]) * x1.x, gelu_tanh(u[5]) * x1.y), pk2(gelu_tanh(u[6]) * x1.z, gelu_tanh(u[7]) * x1.w)}; }
        asm volatile("" ::: "memory");
    }
}

#ifndef SIMPLE_A
#define SIMPLE_A 0
#endif
#ifndef SIMPLE_B
#define SIMPLE_B 0
#endif
#ifndef SIMPLE_C
#define SIMPLE_C 0
#endif
#ifndef SIMPLE_D
#define SIMPLE_D 0
#endif
__device__ __forceinline__ void ph_mixers(LAS unsigned char* L, int l, int phase, int qoff, int wv, int mask = 31) {
    Frame F = mkframe(L, wv);
    volatile LAS int* qslot = (volatile LAS int*)(L + MISC_OFF + 64);
    gu32* ctr = ctlp() + CW_Q + 64 * phase + qoff;
    constexpr int I_IN = (DM / 64) * (NPROJ / 32), I_REST = (I8_OUT ? 0 : (DM / 64) * (DM / 32)) + (FFN1_I8 ? 0 : 2 * (DM / 64) * (DFF / 32)) + (DFF / 64) * (DM / 32);
    const int n_scan = (SIMPLE_D || !(mask & 1)) ? 0 : 128, n_c = (SIMPLE_C || !(mask & 2)) ? 0 : 512, n_a = (SIMPLE_A || !(mask & 4)) ? 0 : 256, n_b = (SIMPLE_B || !(mask & 8)) ? 0 : 128;
    const int n_cin = ((l + 1 < DEPTH) && (mask & 16)) ? (I8_IN ? NPROJ / 32 + (WINB_ITEMS + 7) / 8 : (I_IN + 7) / 8) : 0, n_crest = (mask & 16) ? (I_REST + 7) / 8 : 0, n_cout = ((I8_OUT && (mask & 16)) ? DM / 32 : 0) + ((FFN1_I8 && (mask & 16)) ? 2 * (DFF / 32) : 0);
    const int e_scan = n_scan, e_a = e_scan + n_a, e_b = e_a + n_b, e_c = e_b + n_c, e_cout = e_c + n_cout, e_cin = e_cout + n_cin, e_crest = e_cin + n_crest;
    for (;;) {
        if (F.tid == 0) *qslot = (int)__hip_atomic_fetch_add(ctr, 1u, RLX_AGENT);
        __syncthreads();
        const int it = __builtin_amdgcn_readfirstlane(*qslot);
        __syncthreads();
        if (it >= e_crest) break;
        int tid = wv * 64 + pg8::lane_now(); asm volatile("" : "+v"(tid));
        if (it < e_scan) scan_unit(L, it, tid);
        else if (it < e_a) dil_unit(L, it - e_scan, tid);
        else if (it < e_b) { sgu_unit(L, it - e_a, tid, l); __syncthreads(); }
        else if (it < e_c) { const int i2 = it - e_b; moba_unit(L, (i2 & 63) * 8 + (7 - (i2 >> 6)), tid, l); }
        else if (it < e_cout) { Frame F2 = mkframe(L, wv); int r = it - e_c;
            if (I8_OUT && r < DM / 32) conv_cols_i8(inp(19) + (size_t)l * DM * DM, DM, DM, inp(18) + l * DM, wsp() + WS_WOUT, (float*)(wsp() + WS_SMALL + SM_SWOUT), r, F2);
            else { r -= I8_OUT ? DM / 32 : 0; const int up = r >= DFF / 32 ? 1 : 0, nb = r - up * (DFF / 32), n0 = 32 * nb;
                conv_cols_i8(inp(up ? 22 : 21) + (size_t)l * DM * DFF, DM, DFF, inp(20) + l * DM, wsp() + WS_WGU, (float*)(wsp() + WS_SMALL + SM_SWGU), nb, F2, (n0 >> 7) * 256 + up * 128 + (n0 & 127)); } }
        else if (it < e_cin) { Frame F2 = mkframe(L, wv);
            if (I8_IN) { if (it - e_cout < NPROJ / 32) conv_cols_i8(inp(2) + (size_t)(l + 1) * DM * NPROJ, DM, NPROJ, inp(1) + (l + 1) * DM, wsp() + WS_WIN, (float*)(wsp() + WS_SMALL + SM_SWIN), it - e_cout, F2);
                else conv_winb(F2, l + 1, (it - e_cout - NPROJ / 32) * 8 + F2.wave); }
            else conv_layer_items(F2, l + 1, (it - e_cout) * 8 + F2.wave, 1 << 30, true, false); }
        else { Frame F2 = mkframe(L, wv); conv_layer_items(F2, l, (it - e_cin) * 8 + F2.wave, 1 << 30, false, true); }
    }
    if (!I8_IN && l + 1 < DEPTH) {
        bf16* WIN = (bf16*)(wsp() + WS_WIN);
        Frame F3 = mkframe(L, wv);
        for (int i = F3.gw * 64 + F3.lane; i < 64 * DM / 8; i += F3.ngw * 64) { v4u z = {0u, 0u, 0u, 0u}; asm volatile("" : "+v"(z)); *(GAS v4u*)(WIN + (size_t)NPROJ * DM + (size_t)i * 8) = z; }
    }
    if (SIMPLE_D) mix_d_simple(F);
    if (SIMPLE_A) mix_a_simple(F);
    if (SIMPLE_C) mix_c_simple(F, l);
    if (SIMPLE_B) mix_b_simple(F, l);
}

__device__ __forceinline__ void ph_finalize(Frame& F, int l) {
    bf16* YC = (bf16*)(wsp() + WS_YCAT); const float* YD = (const float*)(wsp() + WS_YD); const bf16* V_ = (const bf16*)outp() + (size_t)3 * M * GW; const bf16* G_ = (const bf16*)(wsp() + WS_G); const float* BC = (const float*)(wsp() + WS_BC);
    const float* lng = inp(16) + l * GW; const float* lnb = inp(17) + l * GW;
    for (int m = F.gw; m < M; m += F.ngw) {
        const int c0 = 8 * F.lane, hd = F.lane >> 3;
        float y[8];
        { const GAS f32x4* yp = (const GAS f32x4*)(YD + (size_t)m * GW + c0); const f32x4 a = yp[0], b = yp[1]; y[0] = a.x; y[1] = a.y; y[2] = a.z; y[3] = a.w; y[4] = b.x; y[5] = b.y; y[6] = b.z; y[7] = b.w; }
        float s = 0.f;
#pragma unroll
        for (int i = 0; i < 8; ++i) s += y[i];
        s += __shfl_xor(s, 1); s += __shfl_xor(s, 2); s += __shfl_xor(s, 4); const float mean = s * (1.0f / 64.0f); float q = 0.f;
#pragma unroll
        for (int i = 0; i < 8; ++i) { const float d = y[i] - mean; q += d * d; }
        q += __shfl_xor(q, 1); q += __shfl_xor(q, 2); q += __shfl_xor(q, 4); const float rstd = __builtin_amdgcn_rsqf(q * (1.0f / 64.0f) + 64e-5f);
        const v4u vw = *(const GAS v4u*)(V_ + (size_t)m * GW + c0), gw4 = *(const GAS v4u*)(G_ + (size_t)m * GW + c0); const float bc = BC[(size_t)m * NH + hd];
        float vv[8], gg[8]; UNPACK8(vv, 0, vw); UNPACK8(gg, 0, gw4);
        float ss = 0.f;
#pragma unroll
        for (int i = 0; i < 8; ++i) { y[i] = ((y[i] - mean) * rstd * lng[c0 + i] + lnb[c0 + i] + bc * vv[i]) * gg[i]; ss += y[i] * y[i]; }
        if (I8_OUT) {
            float xn[3][8], mx = 0.f;
            { const float rs = __builtin_amdgcn_rsqf(wave_sum(ss) * (1.0f / 512.0f) + NORM_EPS);
#pragma unroll
              for (int i = 0; i < 8; ++i) { y[i] *= rs; mx = fmaxf(mx, fabsf(y[i])); } }
#pragma unroll
            for (int br = 0; br < 3; ++br) {
                const v4u w = *(const GAS v4u*)(YC + (size_t)m * DM + br * GW + c0); UNPACK8(xn[br], 0, w); float s2 = 0.f;
#pragma unroll
                for (int i = 0; i < 8; ++i) s2 += xn[br][i] * xn[br][i];
                const float rs = __builtin_amdgcn_rsqf(wave_sum(s2) * (1.0f / 512.0f) + NORM_EPS);
#pragma unroll
                for (int i = 0; i < 8; ++i) { xn[br][i] *= rs; mx = fmaxf(mx, fabsf(xn[br][i])); }
            }
            mx = wave_max(mx); const float inv = mx > 0.f ? 127.0f / mx : 0.f; unsigned char* yq = wsp() + WS_YQ + (size_t)m * DM + c0;
#pragma unroll
            for (int br = 0; br < 3; ++br) *(GAS v2u*)(yq + br * GW) = (v2u){q8pack4(xn[br][0], xn[br][1], xn[br][2], xn[br][3], inv), q8pack4(xn[br][4], xn[br][5], xn[br][6], xn[br][7], inv)};
            *(GAS v2u*)(yq + 3 * GW) = (v2u){q8pack4(y[0], y[1], y[2], y[3], inv), q8pack4(y[4], y[5], y[6], y[7], inv)};
            if (F.lane == 0) ((float*)(wsp() + WS_SMALL + SM_SAY))[m] = mx * (1.0f / 127.0f);
            continue;
        }
        { const float rs = __builtin_amdgcn_rsqf(wave_sum(ss) * (1.0f / 512.0f) + NORM_EPS);
          *(GAS v4u*)(YC + (size_t)m * DM + 3 * GW + c0) = (v4u){pk2(y[0] * rs, y[1] * rs), pk2(y[2] * rs, y[3] * rs), pk2(y[4] * rs, y[5] * rs), pk2(y[6] * rs, y[7] * rs)}; }
#pragma unroll
        for (int br = 0; br < 3; ++br) {
            GAS v4u* p = (GAS v4u*)(YC + (size_t)m * DM + br * GW + c0); const v4u w = *p;
            float x[8]; UNPACK8(x, 0, w); float s2 = 0.f;
#pragma unroll
            for (int i = 0; i < 8; ++i) s2 += x[i] * x[i];
            const float rs = __builtin_amdgcn_rsqf(wave_sum(s2) * (1.0f / 512.0f) + NORM_EPS);
            *p = (v4u){pk2(x[0] * rs, x[1] * rs), pk2(x[2] * rs, x[3] * rs), pk2(x[4] * rs, x[5] * rs), pk2(x[6] * rs, x[7] * rs)};
        }
    }
}
__device__ __forceinline__ void ph_final(Frame& F) {
    const pg8::fx_t* ssq = (const pg8::fx_t*)(ctlp() + CW_SSQ) + 4 * M; const float* g = inp(24); float* out = outp(); const bf16* XB = (const bf16*)(wsp() + WS_XB);
    for (int m = F.gw; m < M; m += F.ngw) {
        GAS f32x4* orow = (GAS f32x4*)(out + (size_t)m * DM); const GAS v4u* xr = (const GAS v4u*)(XB + (size_t)m * DM) + F.lane; const GAS f32x4* gp = (const GAS f32x4*)g;
        v4u wv4[4];
#pragma unroll
        for (int j = 0; j < 4; ++j) wv4[j] = xr[64 * j];
        float ssv;
        if (I8_IN) { float sq = 0.f;
#pragma unroll
            for (int j = 0; j < 4; ++j) { const float e8[8] = {bflo(wv4[j].x), bfhi(wv4[j].x), bflo(wv4[j].y), bfhi(wv4[j].y), bflo(wv4[j].z), bfhi(wv4[j].z), bflo(wv4[j].w), bfhi(wv4[j].w)};
#pragma unroll
                for (int e = 0; e < 8; ++e) sq += e8[e] * e8[e]; }
            ssv = wave_sum(sq); }
        else ssv = pg8::fx_get(ssq + m);
        const float rs = __builtin_amdgcn_rsqf(ssv * (1.0f / 2048.0f) + NORM_EPS);
#pragma unroll
        for (int j = 0; j < 4; ++j) { const v4u w = wv4[j]; const int c4 = 2 * (F.lane + 64 * j); const f32x4 g0 = gp[c4], g1 = gp[c4 + 1];
            orow[c4] = (f32x4){bflo(w.x) * rs * g0.x, bfhi(w.x) * rs * g0.y, bflo(w.y) * rs * g0.z, bfhi(w.y) * rs * g0.w};
            orow[c4 + 1] = (f32x4){bflo(w.z) * rs * g1.x, bfhi(w.z) * rs * g1.y, bflo(w.w) * rs * g1.z, bfhi(w.w) * rs * g1.w}; }
    }
}

#ifndef STAG
#define STAG 500
#endif
__device__ __forceinline__ void phase_stagger(int ticks) {
    const int grp = ((int)blockIdx.x >> 3) & 3;
    if (ticks > 0 && grp > 0) { const unsigned long long t0 = __builtin_amdgcn_s_memrealtime(); while ((long long)(__builtin_amdgcn_s_memrealtime() - t0) < (long long)grp * ticks) __builtin_amdgcn_s_sleep(32); }
}
__global__ void __launch_bounds__(NTHR, 2) hy_fwd(Args args) {
    extern __shared__ __attribute__((aligned(16))) unsigned char lds[];
    LAS unsigned char* L = (LAS unsigned char*)lds;
    volatile LAS unsigned* MISC = (volatile LAS unsigned*)(L + MISC_OFF);
    const int wv = __builtin_amdgcn_readfirstlane((int)threadIdx.x >> 6);
    if (wv == 0) MISC[pg8::lane_now()] = 0u;
    __syncthreads();
    XcdBarrier bar; bar.bar = (unsigned*)(ctlp() + CW_BAR); bar.x = 0; bar.st = nullptr; bar.wv = wv;
    if (N_LAUNCH_MODE == 0) bar = xcd_barrier_post((unsigned*)(ctlp() + CW_BAR), MISC + 8, wv);
    const int lo = args.ph_lo, hi = args.ph_hi;
#define IN(k) (lo <= (k) && (k) < hi)
#define SEAM(k) do { if (IN(k) && IN((k) + 1)) xcd_barrier(bar); } while (0)
    if (IN(0)) { Frame F = mkframe(L, wv); ph_prologue(F); if (REPEAT == 1) ph_prologue(F); }
    SEAM(0);
    auto layer = [&](const int l) __attribute__((always_inline)) {
        const int P = 1 + 9 * l;
        if (IN(P)) { phase_stagger(STAG);
            unsigned char* ws = wsp(); pg8::Gemm g{(const bf16*)(ws + WS_XB), (const bf16*)(ws + WS_WIN), M, NPROJ_P, DM, wv}; pg8::StaticOrder S; S.init(M, NPROJ_P, gridDim.x, (int)blockIdx.x);
            pg8::EpiProj E{(bf16*)(ws + WS_PROJ), NPROJ_P, (const pg8::fx_t*)((gu32*)ws + CW_SSQ) + (size_t)(2 * l) * M, (float*)(ws + CTL_KBAR) + (size_t)l * 64 * 8 * 64, (pg8::fx_t*)(ws + CTL_STATS) + (size_t)l * M * 2,
                           (const float*)(ws + WS_SMALL + SM_SAX), (const float*)(ws + WS_SMALL + SM_SWIN)};
            if (I8_IN) { g.A = (const bf16*)(ws + WS_XQ); pg8::MaskOrder S1; S1.init(M, 0xFFFFFFu & ~BFMASK, gridDim.x, (int)blockIdx.x);
                pg8::gemm_phase<pg8::EpiProj, pg8::MaskOrder, true, PG8_SP2, 1>(L + RING_OFF, g, S1, E);
                if (BFMASK) { pg8::Gemm gb{(const bf16*)(ws + WS_XB), winb_ptr(), M, NPROJ_P, DM, wv}; pg8::MaskOrder S2; S2.init(M, BFMASK, gridDim.x, (int)blockIdx.x);
                    pg8::gemm_phase<pg8::EpiProj, pg8::MaskOrder, true, PG8_SP2>(L + RING_OFF, gb, S2, E); } }
            else pg8::gemm_phase<pg8::EpiProj, pg8::StaticOrder, true, PG8_SP2>(L + RING_OFF, g, S, E);
            if (REPEAT == 21) { pg8::EpiNull E0{(float*)(ws + WS_YCAT)}; pg8::MaskOrder S1; S1.init(M, 0xFFFFFFu, gridDim.x, (int)blockIdx.x); pg8::gemm_phase<pg8::EpiNull, pg8::MaskOrder, true, PG8_SP2, 1>(L + RING_OFF, g, S1, E0); }
            if (REPEAT == 23) { pg8::EpiProjDense E3{(bf16*)(ws + WS_YCAT), E.ssq, E.sa, E.sw}; pg8::MaskOrder S1; S1.init(M, 0xFFFFFFu, gridDim.x, (int)blockIdx.x); pg8::gemm_phase<pg8::EpiProjDense, pg8::MaskOrder, true, PG8_SP2, 1>(L + RING_OFF, g, S1, E3); }
            if (REPEAT == 22) { pg8::EpiProj E2 = E; E2.kbar = (float*)(ws + WS_YCAT + 32 * MiB); E2.stats = (pg8::fx_t*)(ws + WS_YCAT + 40 * MiB); E2.O = (bf16*)(ws + WS_YCAT); E2.ldc = 256;
                pg8::MaskOrder S1; S1.init(M, 0xFFFFFFu, gridDim.x, (int)blockIdx.x); pg8::gemm_phase<pg8::EpiProj, pg8::MaskOrder, true, PG8_SP2, 1>(L + RING_OFF, g, S1, E2); }
            if (REPEAT == 2) { pg8::EpiProj E2 = E; E2.kbar = (float*)(ws + WS_YCAT); E2.stats = (pg8::fx_t*)(ws + WS_YCAT + 8 * MiB);
                if (I8_IN) { pg8::MaskOrder S1; S1.init(M, 0xFFFFFFu & ~BFMASK, gridDim.x, (int)blockIdx.x); pg8::gemm_phase<pg8::EpiProj, pg8::MaskOrder, true, PG8_SP2, 1>(L + RING_OFF, g, S1, E2);
                    if (BFMASK) { pg8::Gemm gb{(const bf16*)(ws + WS_XB), winb_ptr(), M, NPROJ_P, DM, wv}; pg8::MaskOrder S2; S2.init(M, BFMASK, gridDim.x, (int)blockIdx.x); pg8::gemm_phase<pg8::EpiProj, pg8::MaskOrder, true, PG8_SP2>(L + RING_OFF, gb, S2, E2); } }
                else pg8::gemm_phase<pg8::EpiProj, pg8::StaticOrder, true, PG8_SP2>(L + RING_OFF, g, S, E2); }
        }
        SEAM(P);
        if (IN(P + 1)) { Frame F = mkframe(L, wv); ph_prep(F, l); if (REPEAT == 3) ph_prep(F, l); }
        SEAM(P + 1);
        if (IN(P + 2)) { ph_mixers(L, l, P + 2, 0, wv); if (REPEAT == 4) ph_mixers(L, l, P + 2, 32, wv); if (REPEAT >= 40 && REPEAT < 50) ph_mixers(L, l, P + 2, 32, wv, REPEAT == 41 ? 1 : (REPEAT == 42 ? 2 : (REPEAT == 43 ? 4 : (REPEAT == 44 ? 8 : 16)))); if (REPEAT >= 430 && REPEAT < 446) ph_mixers(L, l, P + 2, 32, wv, 4); }
        SEAM(P + 2);
        if (IN(P + 3)) { Frame F = mkframe(L, wv); ph_finalize(F, l); if (REPEAT == 5) ph_finalize(F, l); }
        SEAM(P + 3);
        if (IN(P + 4)) { phase_stagger(STAG);
            unsigned char* ws = wsp(); pg8::Gemm g{(const bf16*)(ws + WS_YCAT), (const bf16*)(ws + WS_WOUT), M, DM, DM, wv}; pg8::StaticOrder S; S.init(M, DM, gridDim.x, (int)blockIdx.x);
            pg8::EpiRes E{(bf16*)(ws + WS_XB), FFN1_I8 ? (pg8::fx_t*)nullptr : (pg8::fx_t*)((gu32*)ws + CW_SSQ) + (size_t)(2 * l + 1) * M, DM, (FFN_FP8 && !FFN1_I8) ? (unsigned char*)(ws + WS_SC2) : nullptr, 1.0f, (const float*)(ws + WS_SMALL + SM_SAY), (const float*)(ws + WS_SMALL + SM_SWOUT)};
            if (I8_OUT) { g.A = (const bf16*)(ws + WS_YQ); pg8::gemm_phase<pg8::EpiRes, pg8::StaticOrder, true, PG8_SP2, 1>(L + RING_OFF, g, S, E); }
            else pg8::gemm_phase<pg8::EpiRes, pg8::StaticOrder, true, PG8_SP2>(L + RING_OFF, g, S, E);
            if (REPEAT == 7) { pg8::EpiRes E2 = E; E2.xb = (bf16*)(ws + WS_YCAT); E2.ssq = (pg8::fx_t*)(ws + WS_G); E2.xf = (unsigned char*)(ws + WS_YD);
                if (I8_OUT) pg8::gemm_phase<pg8::EpiRes, pg8::StaticOrder, true, PG8_SP2, 1>(L + RING_OFF, g, S, E2); else pg8::gemm_phase<pg8::EpiRes, pg8::StaticOrder, true, PG8_SP2>(L + RING_OFF, g, S, E2); }
        }
        SEAM(P + 4);
        if (FFN1_I8) { if (IN(P + 5)) { Frame F = mkframe(L, wv); ph_quantx(F, (pg8::fx_t*)(ctlp() + CW_SSQ) + (size_t)(2 * l + 1) * M); } SEAM(P + 5); }
        if (IN(P + 6)) {
            unsigned char* ws = wsp(); pg8::Gemm g{(const bf16*)(ws + (FFN1_I8 ? WS_XQ : (FFN_FP8 ? WS_SC2 : WS_XB))), (const bf16*)(ws + WS_WGU), M, 2 * DFF, DM, wv}; pg8::StaticOrder S; S.init(M, 2 * DFF, gridDim.x, (int)blockIdx.x);
            if (FFN_FP8) { pg8::EpiGU8 E{(unsigned char*)(ws + WS_PROJ), DFF, (const pg8::fx_t*)((gu32*)ws + CW_SSQ) + (size_t)(2 * l + 1) * M, FFN1_I8 ? 1.0f : 1.0f / 64.0f, 8.0f, (const float*)(ws + WS_SMALL + SM_SAX), (const float*)(ws + WS_SMALL + SM_SWGU)};
                if (FFN1_I8) pg8::gemm_phase<pg8::EpiGU8, pg8::StaticOrder, true, PG8_SP2, 1>(L + RING_OFF, g, S, E);
                else pg8::gemm_phase_f8<pg8::EpiGU8, pg8::StaticOrder, true, PG8_SP2>(L + RING_OFF, g, S, E);
                if (REPEAT == 6) { if (FFN1_I8) pg8::gemm_phase<pg8::EpiGU8, pg8::StaticOrder, true, PG8_SP2, 1>(L + RING_OFF, g, S, E); else pg8::gemm_phase_f8<pg8::EpiGU8, pg8::StaticOrder, true, PG8_SP2>(L + RING_OFF, g, S, E); }
            } else { pg8::EpiGU E{(bf16*)(ws + WS_PROJ), DFF, (const pg8::fx_t*)((gu32*)ws + CW_SSQ) + (size_t)(2 * l + 1) * M, 1.0f};
                pg8::gemm_phase<pg8::EpiGU, pg8::StaticOrder, true, PG8_SP2>(L + RING_OFF, g, S, E);
                if (REPEAT == 6) pg8::gemm_phase<pg8::EpiGU, pg8::StaticOrder, true, PG8_SP2>(L + RING_OFF, g, S, E); }
        }
        SEAM(P + 6);
        if (IN(P + 7)) { phase_stagger(STAG);
            unsigned char* ws = wsp(); pg8::Gemm g{(const bf16*)(ws + WS_PROJ), (const bf16*)(ws + WS_WDN), M, DM, DFF, wv}; pg8::StaticOrder S; S.init(M, DM, gridDim.x, (int)blockIdx.x);
            pg8::EpiRes E{(bf16*)(ws + WS_XB), I8_IN ? (pg8::fx_t*)nullptr : (pg8::fx_t*)((gu32*)ws + CW_SSQ) + (size_t)(2 * l + 2) * M, DM, nullptr, FFN_FP8 ? 1.0f / 512.0f : 1.0f, nullptr, nullptr};
            if (FFN_FP8) pg8::gemm_phase_f8<pg8::EpiRes, pg8::StaticOrder, true, PG8_SP2>(L + RING_OFF, g, S, E);
            else pg8::gemm_phase<pg8::EpiRes, pg8::StaticOrder, true, PG8_SP2>(L + RING_OFF, g, S, E);
            if (REPEAT == 8) { pg8::EpiRes E2 = E; E2.xb = (bf16*)(ws + WS_YCAT); E2.ssq = (pg8::fx_t*)(ws + WS_G);
                if (FFN_FP8) pg8::gemm_phase_f8<pg8::EpiRes, pg8::StaticOrder, true, PG8_SP2>(L + RING_OFF, g, S, E2); else pg8::gemm_phase<pg8::EpiRes, pg8::StaticOrder, true, PG8_SP2>(L + RING_OFF, g, S, E2); }
        }
        SEAM(P + 7);
        if (l + 1 < DEPTH) { if (I8_IN && IN(P + 8)) { Frame F = mkframe(L, wv); ph_quantx(F, (pg8::fx_t*)(ctlp() + CW_SSQ) + (size_t)(2 * l + 2) * M); } if (I8_IN) SEAM(P + 8); }
    };
    static_assert(DEPTH == 2, "layers are expanded by hand");
    layer(0); layer(1);
    if (IN(19)) { Frame F = mkframe(L, wv); ph_final(F); }
#undef IN
#undef SEAM
}

extern "C" void kernel_launch(void* const* d_in, const int* in_sizes, int n_in, void* d_out, int out_size, void* d_ws, size_t ws_size, hipStream_t stream) {
    static int grid = 0;
    if (grid == 0) {
        if (n_in != 25 || in_sizes[0] != M * DM || out_size != M * DM || ws_size < WS_END) { fprintf(stderr, "kernel_launch: shape/workspace mismatch: n_in %d in0 %d out %d ws %zu (need %zu)\n", n_in, n_in > 0 ? in_sizes[0] : -1, out_size, ws_size, (size_t)WS_END); grid = -1; return; }
        int dev = 0, cus = 0, per_cu = 0;
        if (hipGetDevice(&dev) != hipSuccess || hipDeviceGetAttribute(&cus, hipDeviceAttributeMultiprocessorCount, dev) != hipSuccess) { grid = -1; return; }
        if (hipFuncSetAttribute((const void*)hy_fwd, hipFuncAttributeMaxDynamicSharedMemorySize, LDS_BYTES) != hipSuccess) { fprintf(stderr, "kernel_launch: hipFuncSetAttribute failed\n"); grid = -1; return; }
        if (hipOccupancyMaxActiveBlocksPerMultiprocessor(&per_cu, (const void*)hy_fwd, NTHR, LDS_BYTES) != hipSuccess || per_cu < 1) fprintf(stderr, "kernel_launch: occupancy query reports %d\n", per_cu);
        (void)hipGetLastError();
        grid = cus;
    }
    if (grid < 0) return;
    if (hipMemsetAsync((char*)d_ws + WS_CTL, 0, CTL_ZERO_BYTES, stream) != hipSuccess) return;
    Args a{};
    for (int i = 0; i < 25; ++i) a.in[i] = (const float*)d_in[i];
    a.out = (float*)d_out; a.ws = (unsigned char*)d_ws;
    if (N_LAUNCH_MODE == 0) { a.ph_lo = 0; a.ph_hi = N_PHASES; hipLaunchKernelGGL(hy_fwd, dim3(grid), dim3(NTHR), LDS_BYTES, stream, a); }
    else for (int p = 0; p < N_PHASES; ++p) { a.ph_lo = p; a.ph_hi = p + 1; hipLaunchKernelGGL(hy_fwd, dim3(grid), dim3(NTHR), LDS_BYTES, stream, a); }
}
```
